# Optimizing an MI355X kernel written in HIP

```python
import jax, jax.numpy as jnp
from jax import lax
import numpy as np

D_MODEL = 1024
BATCH = 16
SEQ = 2048
DEPTH = 4

CHUNK = 64
HEAD_DIM = 64
FOX_HEADS = 8
HGRN_HEADS = 8
FOX_WIDTH = FOX_HEADS * HEAD_DIM
HGRN_WIDTH = HGRN_HEADS * HEAD_DIM
N_BRANCHES = 2
Q_BLOCK = 128
N_EXPERTS = 16
N_GROUPS = 4
EXPERTS_PER_GROUP = N_EXPERTS // N_GROUPS
TOP_K = 2
D_EXPERT = D_MODEL
MOE_BLOCK = 512
LN_EPS = 1e-5
RMS_EPS = 1e-6
MASK_VALUE = -1e30
ALPHA = (2 * DEPTH) ** 0.25
BETA = (8 * DEPTH) ** -0.25
IN_SIZES = (FOX_WIDTH, FOX_WIDTH, FOX_WIDTH, FOX_HEADS, HGRN_WIDTH, HGRN_WIDTH, HGRN_WIDTH, HGRN_WIDTH, N_BRANCHES * D_MODEL)
N_IN = sum(IN_SIZES)
VALUE_SLOTS = (2, 6)
FOX_F_SLOT = 3

kernel_name = 'hybrid_fox_hgrn2_grouped_moe_deepnorm'


def layer_norm(x, g, b):
    xf = x.astype(jnp.float32)
    mu = xf.mean(-1, keepdims=True)
    var = jnp.square(xf - mu).mean(-1, keepdims=True)
    return ((xf - mu) * lax.rsqrt(var + LN_EPS) * g + b).astype(x.dtype)


def split_cols(h, sizes):
    out, off = [], 0
    for s in sizes:
        out.append(h[..., off:off + s])
        off += s
    return out


def to_heads(t, n_heads):
    B, S, W = t.shape
    return t.reshape(B, S, n_heads, W // n_heads).transpose(0, 2, 1, 3)


def from_heads(t):
    B, H, S, d = t.shape
    return t.transpose(0, 2, 1, 3).reshape(B, S, H * d)


def fox_attention(q, k, v, logf):
    B, H, S, d = q.shape
    F = jnp.cumsum(logf, axis=-1)
    scale = d ** -0.5
    outs = []
    for blk in range(S // Q_BLOCK):
        q0, q1 = blk * Q_BLOCK, (blk + 1) * Q_BLOCK
        s = jnp.einsum('bhqd,bhkd->bhqk', q[:, :, q0:q1], k[:, :, :q1]).astype(jnp.float32) * scale
        s = s + F[:, :, q0:q1, None] - F[:, :, None, :q1]
        qpos = jnp.arange(q0, q1)[:, None]
        kpos = jnp.arange(q1)[None, :]
        s = jnp.where(kpos <= qpos, s, MASK_VALUE)
        p = jax.nn.softmax(s, axis=-1)
        outs.append(jnp.einsum('bhqk,bhkd->bhqd', p.astype(v.dtype), v[:, :, :q1]))
    return jnp.concatenate(outs, axis=2)


def hgrn2_chunkwise(q, k, v, logf):
    B, H, S, dk = q.shape
    dv = v.shape[-1]
    n = S // CHUNK

    def to_chunks(t):
        return jnp.moveaxis(t.reshape(B, H, n, CHUNK, t.shape[-1]), 2, 0)

    causal = jnp.tril(jnp.ones((CHUNK, CHUNK), dtype=bool))[:, :, None]

    def step(state, inp):
        qt, kt, vt, gt = inp
        b = jnp.cumsum(gt, axis=-2)
        b_last = b[:, :, -1:, :]
        inter = jnp.einsum('bhtd,bhde->bhte', qt * jnp.exp(b), state)
        diff = b[:, :, :, None, :] - b[:, :, None, :, :]
        decay = jnp.where(causal, jnp.exp(jnp.where(causal, diff, 0.0)), 0.0)
        scores = jnp.einsum('bhtsd,bhsd->bhts', qt[:, :, :, None, :] * decay, kt)
        intra = jnp.einsum('bhts,bhse->bhte', scores, vt)
        state = jnp.exp(b_last[:, :, 0, :, None]) * state + jnp.einsum('bhsd,bhse->bhde', kt * jnp.exp(b_last - b), vt)
        return state, inter + intra

    s0 = jnp.zeros((B, H, dk, dv), jnp.float32)
    _, o = lax.scan(step, s0, (to_chunks(q), to_chunks(k), to_chunks(v), to_chunks(logf)))
    return jnp.moveaxis(o, 0, 2).reshape(B, H, S, dv)


def grouped_top2_moe(x, router_w, router_b, w1, w3, w2):
    B, S, D = x.shape
    T = B * S
    xt = x.reshape(T, D)
    logits = (xt @ router_w).astype(jnp.float32) + router_b.astype(jnp.float32)
    probs = jax.nn.softmax(logits, axis=-1)
    grouped = probs.reshape(T, N_GROUPS, EXPERTS_PER_GROUP)
    g_sel = jnp.argmax(grouped.max(-1), axis=-1)
    in_group = jnp.take_along_axis(grouped, g_sel[:, None, None], axis=1)[:, 0]
    top_p, top_local = lax.top_k(in_group, TOP_K)
    expert_idx = g_sel[:, None] * EXPERTS_PER_GROUP + top_local
    gate = top_p / top_p.sum(-1, keepdims=True)

    A = T * TOP_K
    flat_e = expert_idx.reshape(A)
    flat_tok = jnp.repeat(jnp.arange(T, dtype=jnp.int32), TOP_K)
    flat_gate = gate.reshape(A)
    order = jnp.argsort(flat_e)
    sorted_e = flat_e[order]
    counts = jnp.bincount(flat_e, length=N_EXPERTS)
    padded = (counts + MOE_BLOCK - 1) // MOE_BLOCK * MOE_BLOCK
    start = jnp.cumsum(counts) - counts
    pend = jnp.cumsum(padded)
    pstart = pend - padded
    dest = pstart[sorted_e] + (jnp.arange(A) - start[sorted_e])
    n_blocks = (A + N_EXPERTS * (MOE_BLOCK - 1) + MOE_BLOCK - 1) // MOE_BLOCK
    P = n_blocks * MOE_BLOCK
    row_tok = jnp.full((P,), T, jnp.int32).at[dest].set(flat_tok[order])
    row_gate = jnp.zeros((P,), jnp.float32).at[dest].set(flat_gate[order])
    block_e = jnp.minimum(jnp.searchsorted(pend, jnp.arange(n_blocks) * MOE_BLOCK, side='right'), N_EXPERTS - 1)
    x_pad = jnp.concatenate([xt, jnp.zeros((1, D), xt.dtype)], axis=0)
    xb = x_pad[row_tok].reshape(n_blocks, MOE_BLOCK, D)

    def expert_rows(args):
        xr, e = args
        h = jax.nn.silu(xr @ w1[e]) * (xr @ w3[e])
        return h @ w2[e]

    yb = lax.map(expert_rows, (xb, block_e)).reshape(P, D)
    y = jax.ops.segment_sum(yb * row_gate[:, None].astype(yb.dtype), row_tok, num_segments=T + 1)[:T]
    return y.reshape(B, S, D).astype(x.dtype)


def setup_inputs(seed: int = 0) -> dict:
    key = jax.random.key(seed)
    ks = jax.random.split(key, 24)
    nrm = jax.random.normal
    f32 = jnp.float32
    col_scale = jnp.concatenate([jnp.full((s,), BETA if i in VALUE_SLOTS else 1.0, f32) for i, s in enumerate(IN_SIZES)])
    fox_f_off = sum(IN_SIZES[:FOX_F_SLOT])
    b_in = 0.02 * nrm(ks[4], (DEPTH, N_IN), f32)
    b_in = b_in.at[:, fox_f_off:fox_f_off + FOX_HEADS].add(jnp.linspace(1.0, 4.0, FOX_HEADS))
    return {
        'x': nrm(ks[0], (BATCH, SEQ, D_MODEL), f32),
        'ln_in_g': 1.0 + 0.02 * nrm(ks[1], (D_MODEL,), f32),
        'ln_in_b': 0.02 * nrm(ks[2], (D_MODEL,), f32),
        'w_in': nrm(ks[3], (DEPTH, D_MODEL, N_IN), f32) * D_MODEL ** -0.5 * col_scale,
        'b_in': b_in,
        'w_fox_branch': nrm(ks[5], (DEPTH, FOX_WIDTH, D_MODEL), f32) * FOX_WIDTH ** -0.5 * BETA,
        'hgrn_lb_logits': 0.1 * nrm(ks[6], (DEPTH, HGRN_WIDTH), f32),
        'hgrn_norm_g': 1.0 + 0.02 * nrm(ks[7], (DEPTH, HGRN_WIDTH), f32),
        'w_hgrn_branch': nrm(ks[8], (DEPTH, HGRN_WIDTH, D_MODEL), f32) * HGRN_WIDTH ** -0.5 * BETA,
        'w_mix_out': nrm(ks[9], (DEPTH, D_MODEL, D_MODEL), f32) * D_MODEL ** -0.5 * BETA,
        'b_mix_out': 0.02 * nrm(ks[10], (DEPTH, D_MODEL), f32),
        'ln1_g': 1.0 + 0.02 * nrm(ks[11], (DEPTH, D_MODEL), f32),
        'ln1_b': 0.02 * nrm(ks[12], (DEPTH, D_MODEL), f32),
        'router_w': nrm(ks[13], (D_MODEL, N_EXPERTS), f32) * D_MODEL ** -0.5,
        'router_b': 0.01 * nrm(ks[14], (N_EXPERTS,), f32),
        'expert_w1': nrm(ks[15], (DEPTH, N_EXPERTS, D_MODEL, D_EXPERT), f32) * D_MODEL ** -0.5,
        'expert_w3': nrm(ks[16], (DEPTH, N_EXPERTS, D_MODEL, D_EXPERT), f32) * D_MODEL ** -0.5 * BETA,
        'expert_w2': nrm(ks[17], (DEPTH, N_EXPERTS, D_EXPERT, D_MODEL), f32) * D_EXPERT ** -0.5 * BETA,
        'ln2_g': 1.0 + 0.02 * nrm(ks[18], (DEPTH, D_MODEL), f32),
        'ln2_b': 0.02 * nrm(ks[19], (DEPTH, D_MODEL), f32),
    }


def reference(x, ln_in_g, ln_in_b, w_in, b_in, w_fox_branch, hgrn_lb_logits, hgrn_norm_g, w_hgrn_branch,
              w_mix_out, b_mix_out, ln1_g, ln1_b, router_w, router_b, expert_w1, expert_w3, expert_w2,
              ln2_g, ln2_b):
    f32 = jnp.float32
    lb_p = jax.nn.softmax(hgrn_lb_logits.astype(f32), axis=0)
    lb_all = jnp.cumsum(lb_p, axis=0) - lb_p[0]
    x = layer_norm(x, ln_in_g, ln_in_b)
    for l in range(DEPTH):
        h = x @ w_in[l] + b_in[l]
        fq, fk, fv, ff, hq, hf, hi, hg, gates = split_cols(h, IN_SIZES)
        fox_logf = jax.nn.log_sigmoid(ff.astype(f32)).transpose(0, 2, 1)
        fox_o = fox_attention(to_heads(fq, FOX_HEADS), to_heads(fk, FOX_HEADS), to_heads(fv, FOX_HEADS), fox_logf)
        y_fox = from_heads(fox_o) @ w_fox_branch[l]
        lb = lb_all[l].reshape(HGRN_HEADS, 1, HEAD_DIM)
        z = to_heads(hf, HGRN_HEADS).astype(f32)
        f_gate = lb + (1.0 - lb) * jax.nn.sigmoid(z)
        logf = jnp.log(f_gate)
        k_in = (1.0 - lb) * jax.nn.sigmoid(-z)
        q_h = jax.nn.silu(to_heads(hq, HGRN_HEADS).astype(f32))
        o = hgrn2_chunkwise(q_h, k_in, to_heads(hi, HGRN_HEADS).astype(f32), logf)
        o = o * lax.rsqrt(jnp.mean(jnp.square(o), -1, keepdims=True) + RMS_EPS) * hgrn_norm_g[l].astype(f32).reshape(HGRN_HEADS, 1, HEAD_DIM)
        o = (from_heads(o) * jax.nn.silu(hg.astype(f32))).astype(x.dtype)
        y_hgrn = o @ w_hgrn_branch[l]
        g = jax.nn.sigmoid(gates)
        mixed = (g[..., :D_MODEL] * y_fox + g[..., D_MODEL:] * y_hgrn) @ w_mix_out[l] + b_mix_out[l]
        x = layer_norm(ALPHA * x + mixed, ln1_g[l], ln1_b[l])
        y_moe = grouped_top2_moe(x, router_w, router_b, expert_w1[l], expert_w3[l], expert_w2[l])
        x = layer_norm(ALPHA * x + y_moe, ln2_g[l], ln2_b[l])
    return x
```

```cpp
#include <hip/hip_runtime.h>
#include <stdint.h>
#include <stdio.h>

typedef unsigned short bf16_t;
typedef short bf16x8 __attribute__((ext_vector_type(8)));
typedef float f32x4 __attribute__((ext_vector_type(4)));
typedef unsigned u32x4 __attribute__((ext_vector_type(4)));
typedef unsigned u32x2 __attribute__((ext_vector_type(2)));

constexpr int BATCH = 16, SEQ = 2048, T = BATCH * SEQ, D = 1024, DEPTH = 4, NH = 8, HD = 64, NIN = 5640, NINP = 5888, NE = 16;
constexpr float LN_EPS = 1e-5f, RMS_EPS = 1e-6f;
constexpr float ALPHA = 1.681792830507429f;
constexpr float LOG2E = 1.4426950408889634f;
constexpr float C2 = 0.125f * LOG2E;
constexpr int TM = 128;

constexpr size_t MiB = 1u << 20;
constexpr size_t WS_CTL = 0, CTL_BYTES = 1 * MiB;
constexpr size_t WS_MISC = 1 * MiB;
constexpr size_t WS_WIN = 2 * MiB, WS_WBR = 14 * MiB, WS_WMIX = 16 * MiB, WS_W13 = 18 * MiB, WS_W2 = 82 * MiB;
constexpr size_t WS_XRES = 114 * MiB, WS_XN = 242 * MiB, WS_QO = 306 * MiB, WS_KV = 370 * MiB, WS_HB = 434 * MiB, WS_LOGF = 498 * MiB;
constexpr size_t WS_HG = 562 * MiB, WS_G = 594 * MiB, WS_FL = 722 * MiB, WS_F2 = 723 * MiB, WS_U1 = 724 * MiB, WS_U = 788 * MiB, WS_MIXED = 852 * MiB;
constexpr size_t WS_LIST = 916 * MiB, WS_TOK = 918 * MiB, WS_END = 919 * MiB;
constexpr size_t WS_H = WS_QO, WS_Y = 442 * MiB;
constexpr int CW_CNT = 1024;

__device__ __forceinline__ unsigned f2bf(float f) { unsigned u = __builtin_bit_cast(unsigned, f); return (u + 0x7fffu + ((u >> 16) & 1u)) >> 16; }
__device__ __forceinline__ float bf2f(unsigned h) { return __builtin_bit_cast(float, h << 16); }
__device__ __forceinline__ unsigned pk2(float lo, float hi) { return f2bf(lo) | (f2bf(hi) << 16); }
__device__ __forceinline__ float wave_sum(float v) {
#pragma unroll
    for (int o = 1; o < 64; o <<= 1) v += __shfl_xor(v, o);
    return v;
}
__device__ __forceinline__ float wave_max(float v) {
#pragma unroll
    for (int o = 1; o < 64; o <<= 1) v = fmaxf(v, __shfl_xor(v, o));
    return v;
}
__device__ __forceinline__ float sigmoidf_(float v) { return 1.0f / (1.0f + __expf(-v)); }
__device__ __forceinline__ float logsigmoidf_(float v) { return fminf(v, 0.f) - log1pf(__expf(-fabsf(v))); }

__global__ void k_lb(const float* lbl, float* lb_all) {
    const int c = blockIdx.x * blockDim.x + threadIdx.x; if (c >= 512) return;
    float v[DEPTH], m = -1e30f; for (int l = 0; l < DEPTH; ++l) { v[l] = lbl[l * 512 + c]; m = fmaxf(m, v[l]); }
    float s = 0.f; for (int l = 0; l < DEPTH; ++l) { v[l] = __expf(v[l] - m); s += v[l]; }
    float cum = 0.f; for (int l = 0; l < DEPTH; ++l) { const float p = v[l] / s; cum += p; lb_all[l * 512 + c] = cum - v[0] / s; }
}
__device__ __forceinline__ void ln_row(const f32x4 (&vin)[4], const float* g, const float* bta, int lane, float* of32, bf16_t* obf, float* of32b) {
    f32x4 v[4]; float s = 0.f;
#pragma unroll
    for (int j = 0; j < 4; ++j) { v[j] = vin[j]; s += (v[j].x + v[j].y) + (v[j].z + v[j].w); }
    const float mean = wave_sum(s) * (1.f / D); float s2 = 0.f;
#pragma unroll
    for (int j = 0; j < 4; ++j) { v[j] = v[j] - mean; s2 += (v[j].x * v[j].x + v[j].y * v[j].y) + (v[j].z * v[j].z + v[j].w * v[j].w); }
    const float rstd = rsqrtf(wave_sum(s2) * (1.f / D) + LN_EPS);
#pragma unroll
    for (int j = 0; j < 4; ++j) {
        const int c = 4 * lane + 256 * j;
        const f32x4 gg = *(const f32x4*)(g + c), bb = *(const f32x4*)(bta + c);
        f32x4 o = v[j] * rstd * gg + bb;
        if (of32) *(f32x4*)(of32 + c) = o;
        if (of32b) *(f32x4*)(of32b + c) = o;
        if (obf) { u32x2 w; w.x = pk2(o.x, o.y); w.y = pk2(o.z, o.w); *(u32x2*)(obf + c) = w; }
    }
}
__global__ void __launch_bounds__(256) k_ln_in(const float* x, const float* g, const float* b, float* xres, bf16_t* xn) {
    const int lane = threadIdx.x & 63, w = threadIdx.x >> 6;
    for (int row = blockIdx.x * 4 + w; row < T; row += gridDim.x * 4) {
        f32x4 v[4];
#pragma unroll
        for (int j = 0; j < 4; ++j) v[j] = *(const f32x4*)(x + (size_t)row * D + 4 * lane + 256 * j);
        ln_row(v, g, b, lane, xres + (size_t)row * D, xn + (size_t)row * D, nullptr);
    }
}

__device__ __forceinline__ void cvt_item(const float* W, int ldw, int k0, int srccol, int nvalid, bf16_t* WT, int ldt, int dstrow, int dstk, float* scr, int lane) {
#pragma unroll 8
    for (int i = 0; i < 32; ++i) { const int kk = 2 * i + (lane >> 5); const int n = lane & 31;
        scr[kk * 33 + n] = (n < nvalid) ? W[(size_t)(k0 + kk) * ldw + srccol + n] : 0.f; }
    asm volatile("s_waitcnt lgkmcnt(0)" ::: "memory");
    const int c = lane & 7;
#pragma unroll
    for (int j = 0; j < 4; ++j) { const int n = (lane >> 3) + 8 * j; const float* s = scr + (8 * c) * 33 + n;
        u32x4 o; o.x = pk2(s[0 * 33], s[1 * 33]); o.y = pk2(s[2 * 33], s[3 * 33]); o.z = pk2(s[4 * 33], s[5 * 33]); o.w = pk2(s[6 * 33], s[7 * 33]);
        *(u32x4*)(WT + (size_t)(dstrow + n) * ldt + dstk + k0 + 8 * c) = o; }
    asm volatile("s_waitcnt lgkmcnt(0)" ::: "memory");
}
struct CvtArgs { const float *w_in, *b_in, *w_fox, *w_hgrn, *w_mix, *w1, *w3, *w2; unsigned char* ws; int layer; int pad; };
__device__ __forceinline__ void convert_layer(const CvtArgs& a, float* scr, int gw, int ngw, int lane) {
    const int l = a.layer;
    bf16_t* WIN = (bf16_t*)(a.ws + WS_WIN); bf16_t* WBR = (bf16_t*)(a.ws + WS_WBR); bf16_t* WMIX = (bf16_t*)(a.ws + WS_WMIX);
    bf16_t* W13 = (bf16_t*)(a.ws + WS_W13); bf16_t* W2 = (bf16_t*)(a.ws + WS_W2);
    constexpr int I_IN = 16 * 184, I_BR = 8 * 32, I_MIX = 16 * 32, I_13 = 16 * 64 * NE, I_2 = 16 * 32 * NE;
    constexpr int NITEMS = I_IN + 2 * I_BR + I_MIX + I_13 + I_2;
    for (int it = gw; it < NITEMS; it += ngw) {
        int r = it;
        if (r < I_IN) { const int kb = r / 184, nb = r % 184, n0 = nb * 32;
            int src, nv = 32; if (n0 < 1536) src = n0; else if (n0 < 5632) src = n0 + 8; else if (n0 == 5632) { src = 1536; nv = 8; } else { src = 0; nv = 0; }
            cvt_item(a.w_in + (size_t)l * D * NIN, NIN, kb * 64, src, nv, WIN, D, n0, 0, scr, lane); continue; } r -= I_IN;
        if (r < I_BR) { const int kb = r / 32, nb = r % 32; cvt_item(a.w_fox + (size_t)l * 512 * D, D, kb * 64, nb * 32, 32, WBR, D, nb * 32, 0, scr, lane); continue; } r -= I_BR;
        if (r < I_BR) { const int kb = r / 32, nb = r % 32; cvt_item(a.w_hgrn + (size_t)l * 512 * D, D, kb * 64, nb * 32, 32, WBR, D, nb * 32, 512, scr, lane); continue; } r -= I_BR;
        if (r < I_MIX) { const int kb = r / 32, nb = r % 32; cvt_item(a.w_mix + (size_t)l * D * D, D, kb * 64, nb * 32, 32, WMIX, D, nb * 32, 0, scr, lane); continue; } r -= I_MIX;
        if (r < I_13) { const int e = r / 1024, q = r % 1024, kb = q / 64, nb = q % 64, n0 = nb * 32;
            const int j = n0 >> 8, rr = n0 & 255; const float* src = (rr < 128 ? a.w1 : a.w3) + ((size_t)l * NE + e) * D * D;
            cvt_item(src, D, kb * 64, 128 * j + (rr & 127), 32, W13 + (size_t)e * 2048 * D, D, n0, 0, scr, lane); continue; } r -= I_13;
        { const int e = r / 512, q = r % 512, kb = q / 32, nb = q % 32;
            cvt_item(a.w2 + ((size_t)l * NE + e) * D * D, D, kb * 64, nb * 32, 32, W2 + (size_t)e * D * D, D, nb * 32, 0, scr, lane); }
    }
    float* biasp = (float*)(a.ws + WS_MISC + 16384);
    for (int n = gw * 64 + lane; n < NINP; n += ngw * 64) {
        float v = 0.f; if (n < 1536) v = a.b_in[l * NIN + n]; else if (n < 5632) v = a.b_in[l * NIN + n + 8]; else if (n < 5640) v = a.b_in[l * NIN + 1536 + (n - 5632)];
        biasp[n] = v; }
}
__global__ void __launch_bounds__(256) k_convert(CvtArgs a) {
    __shared__ float scr[4][64 * 33];
    const int lane = threadIdx.x & 63, w = threadIdx.x >> 6;
    convert_layer(a, scr[w], blockIdx.x * 4 + w, gridDim.x * 4, lane);
}

struct GemmArgs { const bf16_t* A; const bf16_t* Bt; int lda, ldb, K, nN; const unsigned* cnt; const int* list; size_t bstride; };
struct MoeTile { int e, pos0, cnt; };
__device__ __forceinline__ bool moe_tile(const unsigned* cnt, int rt, MoeTile& mt) {
    int ts = 0;
    for (int e = 0; e < NE; ++e) { const int c = (int)cnt[e]; const int nt = (c + TM - 1) / TM; if (rt < ts + nt) { mt.e = e; mt.pos0 = (rt - ts) * TM; mt.cnt = c; return true; } ts += nt; }
    return false;
}
template <class Epi, int KIND>
__device__ __forceinline__ void epi_all(const Epi& E, const f32x4 (&acc)[4][8], int rt, int ct, int wr, int wc, int fr, int fq) {
    if constexpr (KIND < Epi::NKIND) {
#pragma unroll
        for (int m = 0; m < 4; ++m)
#pragma unroll
            for (int n = 0; n < 4; ++n)
#pragma unroll
                for (int j = 0; j < 4; ++j) {
                    const int row = rt * 128 + wr * 64 + m * 16 + fq * 4 + j, col = ct * 256 + wc * 64 + n * 16 + fr;
                    E.template apply<KIND>(row, col, acc[m][n][j], acc[m][n + 4][j]);
                }
    }
}
template <class Epi, int MODE>
__global__ void __launch_bounds__(256) gemm_simple(GemmArgs g, Epi E) {
    __shared__ __attribute__((aligned(16))) bf16_t sA[128 * 40];
    __shared__ __attribute__((aligned(16))) bf16_t sB[256 * 40];
    const int tid = threadIdx.x, lane = tid & 63, wid = tid >> 6, wr = wid >> 1, wc = wid & 1, fr = lane & 15, fq = lane >> 4;
    const int rt = blockIdx.x / g.nN, ct = blockIdx.x % g.nN;
    const bf16_t* Bt = g.Bt;
    MoeTile mt{0, 0, 0};
    if (MODE != 0) { if (!moe_tile(g.cnt, rt, mt)) return; Bt += (size_t)mt.e * g.bstride; }
    const bf16_t* ap[2]; int aoff[2];
#pragma unroll
    for (int i = 0; i < 2; ++i) { const int c = tid + i * 256, r = c >> 2, kc = (c & 3) * 8; aoff[i] = r * 40 + kc;
        size_t grow;
        if (MODE == 1) { const int pos = mt.pos0 + r; const int tok = (pos < mt.cnt) ? g.list[mt.e * T + pos] : 0; grow = (size_t)tok; }
        else grow = (size_t)rt * 128 + r;
        ap[i] = g.A + grow * g.lda + kc; }
    const bf16_t* bp[4]; int boff[4];
#pragma unroll
    for (int i = 0; i < 4; ++i) { const int c = tid + i * 256, r = c >> 2, kc = (c & 3) * 8; boff[i] = r * 40 + kc; bp[i] = Bt + (size_t)(ct * 256 + r) * g.ldb + kc; }
    f32x4 acc[4][8];
#pragma unroll
    for (int m = 0; m < 4; ++m)
#pragma unroll
        for (int n = 0; n < 8; ++n) acc[m][n] = (f32x4){0.f, 0.f, 0.f, 0.f};
    for (int k0 = 0; k0 < g.K; k0 += 32) {
        u32x4 ra[2], rb[4];
#pragma unroll
        for (int i = 0; i < 2; ++i) ra[i] = *(const u32x4*)(ap[i] + k0);
#pragma unroll
        for (int i = 0; i < 4; ++i) rb[i] = *(const u32x4*)(bp[i] + k0);
        __syncthreads();
#pragma unroll
        for (int i = 0; i < 2; ++i) *(u32x4*)(sA + aoff[i]) = ra[i];
#pragma unroll
        for (int i = 0; i < 4; ++i) *(u32x4*)(sB + boff[i]) = rb[i];
        __syncthreads();
        bf16x8 a[4], b[8];
#pragma unroll
        for (int m = 0; m < 4; ++m) a[m] = *(const bf16x8*)(sA + (wr * 64 + m * 16 + fr) * 40 + fq * 8);
#pragma unroll
        for (int n = 0; n < 8; ++n) b[n] = *(const bf16x8*)(sB + ((n >> 2) * 128 + wc * 64 + (n & 3) * 16 + fr) * 40 + fq * 8);
#pragma unroll
        for (int m = 0; m < 4; ++m)
#pragma unroll
            for (int n = 0; n < 8; ++n) acc[m][n] = __builtin_amdgcn_mfma_f32_16x16x32_bf16(a[m], b[n], acc[m][n], 0, 0, 0);
    }
    const int kind = E.kind(ct);
    if (kind == 0) epi_all<Epi, 0>(E, acc, rt, ct, wr, wc, fr, fq);
    else if (kind == 1) epi_all<Epi, 1>(E, acc, rt, ct, wr, wc, fr, fq);
    else if (kind == 2) epi_all<Epi, 2>(E, acc, rt, ct, wr, wc, fr, fq);
    else if (kind == 3) epi_all<Epi, 3>(E, acc, rt, ct, wr, wc, fr, fq);
    else if (kind == 4) epi_all<Epi, 4>(E, acc, rt, ct, wr, wc, fr, fq);
    else if (kind == 5) epi_all<Epi, 5>(E, acc, rt, ct, wr, wc, fr, fq);
    else if (kind == 6) epi_all<Epi, 6>(E, acc, rt, ct, wr, wc, fr, fq);
    else if (kind == 7) epi_all<Epi, 7>(E, acc, rt, ct, wr, wc, fr, fq);
    else epi_all<Epi, 8>(E, acc, rt, ct, wr, wc, fr, fq);
}

struct EpiInproj {
    static constexpr int NKIND = 9;
    const float* biasp; const float* lb; bf16_t *QO, *KV, *HB, *HG, *G; float *LOGF, *FL;
    __device__ __forceinline__ int kind(int ct) const { return ct < 2 ? 0 : ct < 4 ? 1 : ct < 6 ? 2 : ct < 8 ? 3 : ct < 10 ? 4 : ct < 12 ? 5 : ct < 14 ? 6 : ct < 22 ? 7 : 8; }
    template <int KIND> __device__ __forceinline__ void one(int row, int col, float v) const {
        v += biasp[col];
        const size_t r = (size_t)row;
        if (KIND == 0) QO[r * 1024 + col] = (bf16_t)f2bf(v * C2);
        else if (KIND == 1) KV[r * 1024 + (col - 512)] = (bf16_t)f2bf(v);
        else if (KIND == 2) KV[r * 1024 + 512 + (col - 1024)] = (bf16_t)f2bf(v);
        else if (KIND == 3) HB[r * 1024 + (col - 1536)] = (bf16_t)f2bf(v * sigmoidf_(v));
        else if (KIND == 4) { const int c = col - 2048; const float lbv = lb[c]; LOGF[r * 512 + c] = __logf(lbv + (1.f - lbv) * sigmoidf_(v)); }
        else if (KIND == 5) HB[r * 1024 + 512 + (col - 2560)] = (bf16_t)f2bf(v);
        else if (KIND == 6) HG[r * 512 + (col - 3072)] = (bf16_t)f2bf(v * sigmoidf_(v));
        else if (KIND == 7) G[r * 2048 + (col - 3584)] = (bf16_t)f2bf(sigmoidf_(v));
        else { if (col < 5640) FL[r * 8 + (col - 5632)] = logsigmoidf_(v); }
    }
    template <int KIND> __device__ __forceinline__ void apply(int row, int col, float va, float vb) const { one<KIND>(row, col, va); one<KIND>(row, col + 128, vb); }
};
struct EpiBr1 { static constexpr int NKIND = 1; const bf16_t* G; bf16_t* U1;
    __device__ __forceinline__ int kind(int) const { return 0; }
    __device__ __forceinline__ void one(int row, int col, float v) const { U1[(size_t)row * 1024 + col] = (bf16_t)f2bf(v * bf2f(G[(size_t)row * 2048 + col])); }
    template <int KIND> __device__ __forceinline__ void apply(int row, int col, float va, float vb) const { one(row, col, va); one(row, col + 128, vb); } };
struct EpiBr2 { static constexpr int NKIND = 1; const bf16_t* G; const bf16_t* U1; bf16_t* U;
    __device__ __forceinline__ int kind(int) const { return 0; }
    __device__ __forceinline__ void one(int row, int col, float v) const { U[(size_t)row * 1024 + col] = (bf16_t)f2bf(bf2f(U1[(size_t)row * 1024 + col]) + v * bf2f(G[(size_t)row * 2048 + 1024 + col])); }
    template <int KIND> __device__ __forceinline__ void apply(int row, int col, float va, float vb) const { one(row, col, va); one(row, col + 128, vb); } };
struct EpiMix { static constexpr int NKIND = 1; const float* bias; bf16_t* O;
    __device__ __forceinline__ int kind(int) const { return 0; }
    __device__ __forceinline__ void one(int row, int col, float v) const { O[(size_t)row * 1024 + col] = (bf16_t)f2bf(v + bias[col]); }
    template <int KIND> __device__ __forceinline__ void apply(int row, int col, float va, float vb) const { one(row, col, va); one(row, col + 128, vb); } };
struct EpiUp { static constexpr int NKIND = 1; bf16_t* H;
    __device__ __forceinline__ int kind(int) const { return 0; }
    template <int KIND> __device__ __forceinline__ void apply(int row, int col, float va, float vb) const { const int hc = (col >> 8) * 128 + (col & 127); H[(size_t)row * 1024 + hc] = (bf16_t)f2bf(va * sigmoidf_(va) * vb); } };
struct EpiDown { static constexpr int NKIND = 1; bf16_t* Y;
    __device__ __forceinline__ int kind(int) const { return 0; }
    __device__ __forceinline__ void one(int row, int col, float v) const { Y[(size_t)row * 1024 + col] = (bf16_t)f2bf(v); }
    template <int KIND> __device__ __forceinline__ void apply(int row, int col, float va, float vb) const { one(row, col, va); one(row, col + 128, vb); } };

__global__ void __launch_bounds__(256) k_fscan(const float* FL, float* F2) {
    __shared__ float wsum[4];
    const int bh = blockIdx.x, b = bh >> 3, h = bh & 7, tid = threadIdx.x, lane = tid & 63, w = tid >> 6;
    float v[8], run = 0.f;
#pragma unroll
    for (int i = 0; i < 8; ++i) { run += FL[((size_t)b * SEQ + tid * 8 + i) * 8 + h]; v[i] = run; }
    float incl = run;
#pragma unroll
    for (int o = 1; o < 64; o <<= 1) { const float u = __shfl_up(incl, o); if (lane >= o) incl += u; }
    if (lane == 63) wsum[w] = incl;
    __syncthreads();
    float base = incl - run; for (int i = 0; i < w; ++i) base += wsum[i];
#pragma unroll
    for (int i = 0; i < 8; ++i) F2[(size_t)bh * SEQ + tid * 8 + i] = (base + v[i]) * LOG2E;
}

__global__ void __launch_bounds__(256) k_attn_naive(const bf16_t* QO, const bf16_t* KV, const float* F2, bf16_t* O) {
    __shared__ float ps[4][64];
    const int lane = threadIdx.x & 63, w = threadIdx.x >> 6;
    const int gid = blockIdx.x * 4 + w;
    const int bh = gid / SEQ, t = (SEQ - 1) - (gid % SEQ), b = bh >> 3, h = bh & 7;
    float q[64];
    { const bf16_t* qp = QO + ((size_t)b * SEQ + t) * 1024 + h * 64;
#pragma unroll
      for (int c = 0; c < 8; ++c) { const u32x4 u = *(const u32x4*)(qp + c * 8);
        q[c * 8 + 0] = bf2f(u.x & 0xffff); q[c * 8 + 1] = bf2f(u.x >> 16); q[c * 8 + 2] = bf2f(u.y & 0xffff); q[c * 8 + 3] = bf2f(u.y >> 16);
        q[c * 8 + 4] = bf2f(u.z & 0xffff); q[c * 8 + 5] = bf2f(u.z >> 16); q[c * 8 + 6] = bf2f(u.w & 0xffff); q[c * 8 + 7] = bf2f(u.w >> 16); } }
    float m = -1e30f, l = 0.f, o = 0.f;
    const float* f2 = F2 + (size_t)bh * SEQ;
    for (int s0 = 0; s0 <= t; s0 += 64) {
        const int s = s0 + lane; const bool valid = s <= t;
        float sc = -1e30f;
        if (valid) { const bf16_t* kp = KV + ((size_t)b * SEQ + s) * 1024 + h * 64; float d = 0.f;
#pragma unroll
            for (int c = 0; c < 8; ++c) { const u32x4 u = *(const u32x4*)(kp + c * 8);
                d += q[c * 8 + 0] * bf2f(u.x & 0xffff) + q[c * 8 + 1] * bf2f(u.x >> 16) + q[c * 8 + 2] * bf2f(u.y & 0xffff) + q[c * 8 + 3] * bf2f(u.y >> 16)
                   + q[c * 8 + 4] * bf2f(u.z & 0xffff) + q[c * 8 + 5] * bf2f(u.z >> 16) + q[c * 8 + 6] * bf2f(u.w & 0xffff) + q[c * 8 + 7] * bf2f(u.w >> 16); }
            sc = d - f2[s]; }
        const float mn = fmaxf(m, wave_max(sc));
        const float p = valid ? exp2f(sc - mn) : 0.f;
        const float f = exp2f(m - mn);
        l = l * f + wave_sum(p); o *= f; m = mn;
        ps[w][lane] = p;
        asm volatile("s_waitcnt lgkmcnt(0)" ::: "memory");
        const int nk = min(64, t - s0 + 1);
        const bf16_t* vp = KV + ((size_t)b * SEQ + s0) * 1024 + 512 + h * 64 + lane;
        for (int j = 0; j < nk; ++j) o += ps[w][j] * bf2f(vp[(size_t)j * 1024]);
        asm volatile("s_waitcnt lgkmcnt(0)" ::: "memory");
    }
    O[((size_t)b * SEQ + t) * 1024 + h * 64 + lane] = (bf16_t)f2bf(o / l);
}

__global__ void __launch_bounds__(64) k_hgrn_naive(const bf16_t* HB, const float* LOGF, const bf16_t* HG, const float* norm_g, bf16_t* O) {
    __shared__ __attribute__((aligned(16))) float Lf[64 * 64];
    __shared__ __attribute__((aligned(16))) float Lk[64 * 64];
    __shared__ __attribute__((aligned(16))) float Lq[64 * 64];
    const int bh = blockIdx.x, b = bh >> 3, h = bh & 7, lane = threadIdx.x;
    float Sx[64];
#pragma unroll
    for (int d = 0; d < 64; ++d) Sx[d] = 0.f;
    const float ng = norm_g[h * 64 + lane];
    for (int c0 = 0; c0 < SEQ; c0 += 64) {
        __syncthreads();
        for (int tt = 0; tt < 64; ++tt) { const size_t row = (size_t)b * SEQ + c0 + tt;
            const float lf = LOGF[row * 512 + h * 64 + lane]; const float f = __expf(lf);
            Lf[tt * 64 + lane] = f; Lk[tt * 64 + lane] = 1.f - f; Lq[tt * 64 + lane] = bf2f(HB[row * 1024 + h * 64 + lane]); }
        __syncthreads();
        for (int tt = 0; tt < 64; ++tt) { const size_t row = (size_t)b * SEQ + c0 + tt;
            const float v = bf2f(HB[row * 1024 + 512 + h * 64 + lane]);
            float o = 0.f;
#pragma unroll
            for (int d = 0; d < 64; d += 4) { const f32x4 f4 = *(const f32x4*)(Lf + tt * 64 + d), k4 = *(const f32x4*)(Lk + tt * 64 + d), q4 = *(const f32x4*)(Lq + tt * 64 + d);
                Sx[d] = f4.x * Sx[d] + k4.x * v; o += Sx[d] * q4.x; Sx[d + 1] = f4.y * Sx[d + 1] + k4.y * v; o += Sx[d + 1] * q4.y;
                Sx[d + 2] = f4.z * Sx[d + 2] + k4.z * v; o += Sx[d + 2] * q4.z; Sx[d + 3] = f4.w * Sx[d + 3] + k4.w * v; o += Sx[d + 3] * q4.w; }
            const float ss = wave_sum(o * o);
            const float r = o * rsqrtf(ss * (1.f / 64.f) + RMS_EPS) * ng * bf2f(HG[row * 512 + h * 64 + lane]);
            O[row * 1024 + 512 + h * 64 + lane] = (bf16_t)f2bf(r); }
    }
}

__global__ void __launch_bounds__(256) k_ln1_router(float* xres, const bf16_t* mixed, const float* g, const float* bta, bf16_t* xn,
                                                    const float* router_w, const float* router_b, unsigned* cnt, int* list, unsigned* tokinfo) {
    __shared__ __attribute__((aligned(16))) float rw[NE * D];
    for (int i = threadIdx.x; i < NE * D; i += 256) { const int c = i >> 4, e = i & 15; rw[e * D + c] = router_w[i]; }
    __syncthreads();
    const int lane = threadIdx.x & 63, w = threadIdx.x >> 6;
    for (int row = blockIdx.x * 4 + w; row < T; row += gridDim.x * 4) {
        f32x4 v[4];
#pragma unroll
        for (int j = 0; j < 4; ++j) { const int c = 4 * lane + 256 * j; const f32x4 xv = *(const f32x4*)(xres + (size_t)row * D + c);
            const u32x2 mm = *(const u32x2*)(mixed + (size_t)row * D + c);
            v[j].x = ALPHA * xv.x + bf2f(mm.x & 0xffff); v[j].y = ALPHA * xv.y + bf2f(mm.x >> 16); v[j].z = ALPHA * xv.z + bf2f(mm.y & 0xffff); v[j].w = ALPHA * xv.w + bf2f(mm.y >> 16); }
        float s = 0.f;
#pragma unroll
        for (int j = 0; j < 4; ++j) s += (v[j].x + v[j].y) + (v[j].z + v[j].w);
        const float mean = wave_sum(s) * (1.f / D); float s2 = 0.f;
#pragma unroll
        for (int j = 0; j < 4; ++j) { v[j] = v[j] - mean; s2 += (v[j].x * v[j].x + v[j].y * v[j].y) + (v[j].z * v[j].z + v[j].w * v[j].w); }
        const float rstd = rsqrtf(wave_sum(s2) * (1.f / D) + LN_EPS);
#pragma unroll
        for (int j = 0; j < 4; ++j) { const int c = 4 * lane + 256 * j; const f32x4 gg = *(const f32x4*)(g + c), bb = *(const f32x4*)(bta + c);
            v[j] = v[j] * rstd * gg + bb;
            *(f32x4*)(xres + (size_t)row * D + c) = v[j];
            u32x2 wv; wv.x = pk2(v[j].x, v[j].y); wv.y = pk2(v[j].z, v[j].w); *(u32x2*)(xn + (size_t)row * D + c) = wv; }
        float lg[NE];
#pragma unroll
        for (int e = 0; e < NE; ++e) { float p = 0.f;
#pragma unroll
            for (int j = 0; j < 4; ++j) { const f32x4 r4 = *(const f32x4*)(rw + e * D + 4 * lane + 256 * j); p += v[j].x * r4.x + v[j].y * r4.y + v[j].z * r4.z + v[j].w * r4.w; }
            lg[e] = wave_sum(p) + router_b[e]; }
        if (lane == 0) {
            int gs = 0; float gbest = -3e38f;
#pragma unroll
            for (int gi = 0; gi < 4; ++gi) { const float mx = fmaxf(fmaxf(lg[gi * 4], lg[gi * 4 + 1]), fmaxf(lg[gi * 4 + 2], lg[gi * 4 + 3])); if (mx > gbest) { gbest = mx; gs = gi; } }
            float l4[4];
#pragma unroll
            for (int i = 0; i < 4; ++i) { float t0 = lg[i];
#pragma unroll
                for (int gi = 1; gi < 4; ++gi) t0 = (gs == gi) ? lg[gi * 4 + i] : t0; l4[i] = t0; }
            int i0 = 0; float b0 = l4[0];
#pragma unroll
            for (int i = 1; i < 4; ++i) if (l4[i] > b0) { b0 = l4[i]; i0 = i; }
            int i1 = -1; float b1 = -3e38f;
#pragma unroll
            for (int i = 0; i < 4; ++i) if (i != i0 && l4[i] > b1) { b1 = l4[i]; i1 = i; }
            const float e1 = __expf(b1 - b0); const float g0 = 1.f / (1.f + e1), g1 = e1 / (1.f + e1);
            const int ex0 = gs * 4 + i0, ex1 = gs * 4 + i1;
            const unsigned p0 = atomicAdd(cnt + ex0, 1u), p1 = atomicAdd(cnt + ex1, 1u);
            list[ex0 * T + p0] = row; list[ex1 * T + p1] = row;
            tokinfo[row * 4 + 0] = ((unsigned)ex0 << 24) | p0; tokinfo[row * 4 + 1] = ((unsigned)ex1 << 24) | p1;
            tokinfo[row * 4 + 2] = __float_as_uint(g0); tokinfo[row * 4 + 3] = __float_as_uint(g1);
        }
    }
}

__global__ void __launch_bounds__(256) k_combine_ln2(float* xres, const bf16_t* Y, const unsigned* tokinfo, const unsigned* cnt, const float* g, const float* bta, bf16_t* xn, float* out) {
    __shared__ int tstart[NE];
    if (threadIdx.x == 0) { int ts = 0; for (int e = 0; e < NE; ++e) { tstart[e] = ts; ts += ((int)cnt[e] + TM - 1) / TM; } }
    __syncthreads();
    const int lane = threadIdx.x & 63, w = threadIdx.x >> 6;
    for (int row = blockIdx.x * 4 + w; row < T; row += gridDim.x * 4) {
        const unsigned i0 = tokinfo[row * 4], i1 = tokinfo[row * 4 + 1]; const float g0 = __uint_as_float(tokinfo[row * 4 + 2]), g1 = __uint_as_float(tokinfo[row * 4 + 3]);
        const size_t s0 = (size_t)tstart[i0 >> 24] * TM + (i0 & 0xffffff), s1 = (size_t)tstart[i1 >> 24] * TM + (i1 & 0xffffff);
        f32x4 v[4];
#pragma unroll
        for (int j = 0; j < 4; ++j) { const int c = 4 * lane + 256 * j; const f32x4 xv = *(const f32x4*)(xres + (size_t)row * D + c);
            const u32x2 ya = *(const u32x2*)(Y + s0 * D + c), yb = *(const u32x2*)(Y + s1 * D + c);
            v[j].x = ALPHA * xv.x + g0 * bf2f(ya.x & 0xffff) + g1 * bf2f(yb.x & 0xffff); v[j].y = ALPHA * xv.y + g0 * bf2f(ya.x >> 16) + g1 * bf2f(yb.x >> 16);
            v[j].z = ALPHA * xv.z + g0 * bf2f(ya.y & 0xffff) + g1 * bf2f(yb.y & 0xffff); v[j].w = ALPHA * xv.w + g0 * bf2f(ya.y >> 16) + g1 * bf2f(yb.y >> 16); }
        ln_row(v, g, bta, lane, xres + (size_t)row * D, xn + (size_t)row * D, out ? out + (size_t)row * D : nullptr);
    }
}

extern "C" void kernel_launch(void* const* d_in, const int* in_sizes, int n_in, void* d_out, int out_size, void* d_ws, size_t ws_size, hipStream_t stream) {
    if (n_in != 20 || ws_size < WS_END) { fprintf(stderr, "kernel_launch: unexpected n_in %d / ws %zu\n", n_in, ws_size); return; }
    const float* x = (const float*)d_in[0]; const float* ln_in_g = (const float*)d_in[1]; const float* ln_in_b = (const float*)d_in[2];
    const float* w_in = (const float*)d_in[3]; const float* b_in = (const float*)d_in[4]; const float* w_fox = (const float*)d_in[5];
    const float* lbl = (const float*)d_in[6]; const float* norm_g = (const float*)d_in[7]; const float* w_hgrn = (const float*)d_in[8];
    const float* w_mix = (const float*)d_in[9]; const float* b_mix = (const float*)d_in[10]; const float* ln1_g = (const float*)d_in[11]; const float* ln1_b = (const float*)d_in[12];
    const float* router_w = (const float*)d_in[13]; const float* router_b = (const float*)d_in[14];
    const float* w1 = (const float*)d_in[15]; const float* w3 = (const float*)d_in[16]; const float* w2 = (const float*)d_in[17];
    const float* ln2_g = (const float*)d_in[18]; const float* ln2_b = (const float*)d_in[19];
    unsigned char* ws = (unsigned char*)d_ws;
    unsigned* ctl = (unsigned*)(ws + WS_CTL);
    float* lb_all = (float*)(ws + WS_MISC); float* biasp = (float*)(ws + WS_MISC + 16384);
    bf16_t *WIN = (bf16_t*)(ws + WS_WIN), *WBR = (bf16_t*)(ws + WS_WBR), *WMIX = (bf16_t*)(ws + WS_WMIX), *W13 = (bf16_t*)(ws + WS_W13), *W2 = (bf16_t*)(ws + WS_W2);
    float* XRES = (float*)(ws + WS_XRES); bf16_t* XN = (bf16_t*)(ws + WS_XN);
    bf16_t *QO = (bf16_t*)(ws + WS_QO), *KV = (bf16_t*)(ws + WS_KV), *HB = (bf16_t*)(ws + WS_HB), *HG = (bf16_t*)(ws + WS_HG), *G = (bf16_t*)(ws + WS_G);
    float *LOGF = (float*)(ws + WS_LOGF), *FL = (float*)(ws + WS_FL), *F2 = (float*)(ws + WS_F2);
    bf16_t *U1 = (bf16_t*)(ws + WS_U1), *U = (bf16_t*)(ws + WS_U), *MIXED = (bf16_t*)(ws + WS_MIXED), *Hb = (bf16_t*)(ws + WS_H), *Y = (bf16_t*)(ws + WS_Y);
    int* list = (int*)(ws + WS_LIST); unsigned* tokinfo = (unsigned*)(ws + WS_TOK);

    (void)hipMemsetAsync(ws + WS_CTL, 0, CTL_BYTES, stream);
    k_lb<<<2, 256, 0, stream>>>(lbl, lb_all);
    k_ln_in<<<2048, 256, 0, stream>>>(x, ln_in_g, ln_in_b, XRES, XN);
    constexpr int MAXRT = (2 * T + NE * (TM - 1)) / TM + 1;
    for (int l = 0; l < DEPTH; ++l) {
        CvtArgs ca{}; ca.w_in = w_in; ca.b_in = b_in; ca.w_fox = w_fox; ca.w_hgrn = w_hgrn; ca.w_mix = w_mix; ca.w1 = w1; ca.w3 = w3; ca.w2 = w2; ca.ws = ws; ca.layer = l; ca.pad = 0;
        k_convert<<<2048, 256, 0, stream>>>(ca);
        unsigned* cnt = ctl + CW_CNT + l * 64;
        { GemmArgs g{}; g.A = XN; g.Bt = WIN; g.lda = D; g.ldb = D; g.K = D; g.nN = NINP / 256; g.cnt = nullptr; g.list = nullptr; g.bstride = 0;
          EpiInproj E{biasp, lb_all + l * 512, QO, KV, HB, HG, G, LOGF, FL};
          gemm_simple<EpiInproj, 0><<<(T / 128) * g.nN, 256, 0, stream>>>(g, E); }
        k_fscan<<<BATCH * NH, 256, 0, stream>>>(FL, F2);
        k_hgrn_naive<<<BATCH * NH, 64, 0, stream>>>(HB, LOGF, HG, norm_g + l * 512, QO);
        k_attn_naive<<<BATCH * NH * SEQ / 4, 256, 0, stream>>>(QO, KV, F2, QO);
        { GemmArgs g{}; g.A = QO; g.Bt = WBR; g.lda = D; g.ldb = D; g.K = 512; g.nN = 4; EpiBr1 E{G, U1};
          gemm_simple<EpiBr1, 0><<<(T / 128) * 4, 256, 0, stream>>>(g, E); }
        { GemmArgs g{}; g.A = QO + 512; g.Bt = WBR + 512; g.lda = D; g.ldb = D; g.K = 512; g.nN = 4; EpiBr2 E{G, U1, U};
          gemm_simple<EpiBr2, 0><<<(T / 128) * 4, 256, 0, stream>>>(g, E); }
        { GemmArgs g{}; g.A = U; g.Bt = WMIX; g.lda = D; g.ldb = D; g.K = D; g.nN = 4; EpiMix E{b_mix + l * D, MIXED};
          gemm_simple<EpiMix, 0><<<(T / 128) * 4, 256, 0, stream>>>(g, E); }
        k_ln1_router<<<1024, 256, 0, stream>>>(XRES, MIXED, ln1_g + l * D, ln1_b + l * D, XN, router_w, router_b, cnt, list, tokinfo);
        { GemmArgs g{}; g.A = XN; g.Bt = W13; g.lda = D; g.ldb = D; g.K = D; g.nN = 8; g.cnt = cnt; g.list = list; g.bstride = (size_t)2048 * D; EpiUp E{Hb};
          gemm_simple<EpiUp, 1><<<MAXRT * 8, 256, 0, stream>>>(g, E); }
        { GemmArgs g{}; g.A = Hb; g.Bt = W2; g.lda = D; g.ldb = D; g.K = D; g.nN = 4; g.cnt = cnt; g.list = list; g.bstride = (size_t)D * D; EpiDown E{Y};
          gemm_simple<EpiDown, 2><<<MAXRT * 4, 256, 0, stream>>>(g, E); }
        k_combine_ln2<<<2048, 256, 0, stream>>>(XRES, Y, tokinfo, cnt, ln2_g + l * D, ln2_b + l * D, XN, (l == DEPTH - 1) ? (float*)d_out : nullptr);
    }
}
```

```cpp
#define MK_ONE_LAUNCH 1
#include <hip/hip_runtime.h>
#include <cstdio>
#include <cstdint>

typedef unsigned short bf16_t;
typedef short bf16x8 __attribute__((ext_vector_type(8)));
typedef float f32x4 __attribute__((ext_vector_type(4)));
typedef float f32x2 __attribute__((ext_vector_type(2)));
typedef unsigned u32x4 __attribute__((ext_vector_type(4)));
typedef unsigned u32x2 __attribute__((ext_vector_type(2)));
#define LAS __attribute__((address_space(3)))
#define GAS __attribute__((address_space(1)))

constexpr int BATCH = 16, SEQ = 2048, T = BATCH * SEQ, D = 1024, DEPTH = 4, NH = 8, HD = 64, NIN = 5640, NINP = 5888, NE = 16;
constexpr float LN_EPS = 1e-5f, RMS_EPS = 1e-6f;
constexpr float ALPHA = 1.681792830507429f;
constexpr float LOG2E = 1.4426950408889634f;
constexpr float C2 = 0.125f * LOG2E;
constexpr int TM = 256;

constexpr size_t MiB = 1u << 20;
constexpr size_t WS_CTL = 0, CTL_BYTES = 1 * MiB;
constexpr size_t WS_MISC = 1 * MiB;
constexpr size_t WS_WIN = 2 * MiB, WS_WBR = 14 * MiB, WS_WMIX = 16 * MiB, WS_W13 = 18 * MiB, WS_W2 = 82 * MiB;
constexpr size_t WS_XRES = 114 * MiB, WS_XN = 242 * MiB, WS_QO = 306 * MiB, WS_KV = 370 * MiB, WS_HB = 434 * MiB, WS_LOGF = 498 * MiB;
constexpr size_t WS_HG = 562 * MiB, WS_G = 594 * MiB, WS_FL = 722 * MiB, WS_F2 = 723 * MiB, WS_U1 = 724 * MiB, WS_U = 788 * MiB, WS_MIXED = 852 * MiB;
constexpr size_t WS_LIST = 916 * MiB, WS_TOK = 918 * MiB, WS_END = 919 * MiB;
constexpr size_t WS_H = WS_QO, WS_Y = 442 * MiB;
constexpr int CW_CNT = 1024;
constexpr int CW_BAR = 4096;

__device__ __forceinline__ unsigned f2bf(float f) { unsigned u = __builtin_bit_cast(unsigned, f); return (u + 0x7fffu + ((u >> 16) & 1u)) >> 16; }
__device__ __forceinline__ float bf2f(unsigned h) { return __builtin_bit_cast(float, h << 16); }
__device__ __forceinline__ float bflo(unsigned w) { return __builtin_bit_cast(float, w << 16); }
__device__ __forceinline__ float bfhi(unsigned w) { return __builtin_bit_cast(float, w & 0xffff0000u); }
__device__ __forceinline__ unsigned pk2(float lo, float hi) { return f2bf(lo) | (f2bf(hi) << 16); }
__device__ __forceinline__ float wave_sum(float v) {
#pragma unroll
    for (int o = 1; o < 64; o <<= 1) v += __shfl_xor(v, o);
    return v;
}
__device__ __forceinline__ float wave_max(float v) {
#pragma unroll
    for (int o = 1; o < 64; o <<= 1) v = fmaxf(v, __shfl_xor(v, o));
    return v;
}
__device__ __forceinline__ float fast_exp(float v) { return __builtin_amdgcn_exp2f(v * LOG2E); }
__device__ __forceinline__ float sigmoidf_(float v) { return __builtin_amdgcn_rcpf(1.0f + fast_exp(-v)); }
__device__ __forceinline__ float siluf_(float v) { return v * sigmoidf_(v); }
__device__ __forceinline__ float logsigmoidf_(float v) { return fminf(v, 0.f) - __logf(1.0f + fast_exp(-fabsf(v))); }

namespace pg8 {
constexpr int BM = 256, BK = 64, HALF = 128, HTB = HALF * BK * 2  , STAGE_BYTES = 8 * HTB, NXCD = 8, WGM = 8;
__host__ __device__ __forceinline__ int lds_byte(int r, int c) { const int st = (r >> 4) * 2 + (c >> 5), rr = r & 15, cc = c & 31, ob = rr * 64 + cc * 2; return st * 1024 + (ob ^ (((ob >> 9) & 1) << 5)); }
__host__ __device__ __forceinline__ void stage_rc(int b, int& R, int& C) { const int st = b / 1024, sb = b % 1024, swz = sb ^ (((sb >> 9) & 1) << 5); R = (st >> 1) * 16 + swz / 64; C = (st & 1) * 32 + (swz % 64) / 2; }
__host__ __device__ __forceinline__ int perm32(int rho) { const int n = rho >> 4, i = rho & 15; return 8 * (i >> 2) + 4 * n + (i & 3); }

struct Unit { int pm, pn, e; };
struct Gemm { const bf16_t* A; const bf16_t* Bt; int lda, ldb, K; };

struct StaticOrder {
    int nM, nN, nwg, G, c;
    __device__ void init(int M, int N, int G_, int c_) { nM = M / BM; nN = N / BM; nwg = nM * nN; G = G_; c = c_; }
    __device__ bool next(int i, Unit& u) const {
        const long L = (long)i * G + c; if (L >= nwg) return false;
        int wgid = (int)L; { const int q = nwg / NXCD, r = nwg % NXCD, xcd = wgid % NXCD, off = wgid / NXCD; wgid = (xcd < r ? xcd * (q + 1) : r * (q + 1) + (xcd - r) * q) + off; }
        const int nig = WGM * nN, gid = wgid / nig, fm = gid * WGM, gsz = (nM - fm) < WGM ? (nM - fm) : WGM;
        u.pm = fm + ((wgid % nig) % gsz); u.pn = (wgid % nig) / gsz; u.e = 0; return true;
    }
    __device__ __forceinline__ const char* a_tile(const Gemm& g, const Unit& u) const { return (const char*)g.A + (size_t)u.pm * BM * g.lda * 2; }
    __device__ __forceinline__ const char* b_tile(const Gemm& g, const Unit& u) const { return (const char*)g.Bt + (size_t)u.pn * BM * g.ldb * 2; }
    __device__ __forceinline__ void a_voff(const Gemm& g, const Unit&, const int (&R)[2], const int (&C)[2], unsigned (&v)[2][2]) const {
#pragma unroll
        for (int h = 0; h < 2; ++h)
#pragma unroll
            for (int i = 0; i < 2; ++i) v[h][i] = (unsigned)((h * HALF + R[i]) * g.lda + C[i]) * 2u;
    }
};
struct MoeOrder {
    int G, c, nN; const LAS int* tab; const int* list; bool gather; size_t bstride;
    __device__ bool next(int i, Unit& u) const {
        const int L = i * G + c; const int rt = L / nN; const int NT = tab[NE]; if (rt >= NT) return false;
        int e = 0;
#pragma unroll
        for (int k = 1; k < NE; ++k) e += (rt >= tab[k]) ? 1 : 0;
        u.pm = __builtin_amdgcn_readfirstlane(rt); u.pn = __builtin_amdgcn_readfirstlane(L % nN); u.e = __builtin_amdgcn_readfirstlane(e); return true;
    }
    __device__ __forceinline__ const char* a_tile(const Gemm& g, const Unit& u) const { return gather ? (const char*)g.A : (const char*)g.A + (size_t)u.pm * BM * g.lda * 2; }
    __device__ __forceinline__ const char* b_tile(const Gemm& g, const Unit& u) const { return (const char*)g.Bt + ((size_t)u.e * bstride + (size_t)u.pn * BM * g.ldb) * 2; }
    __device__ __forceinline__ void a_voff(const Gemm& g, const Unit& u, const int (&R)[2], const int (&C)[2], unsigned (&v)[2][2]) const {
        const int ts = tab[u.e], cn = tab[NE + 1 + u.e];
#pragma unroll
        for (int h = 0; h < 2; ++h)
#pragma unroll
            for (int i = 0; i < 2; ++i) {
                if (gather) { const int pos = (u.pm - ts) * BM + h * HALF + R[i]; const int tok = (pos < cn) ? list[u.e * T + pos] : 0; v[h][i] = (unsigned)(tok * g.lda + C[i]) * 2u; }
                else v[h][i] = (unsigned)((h * HALF + R[i]) * g.lda + C[i]) * 2u;
            }
    }
};

typedef __bf16 bf16x2_t __attribute__((ext_vector_type(2)));
__device__ __forceinline__ unsigned cvt_pk_bf16(float lo, float hi) { f32x2 v = {lo, hi}; bf16x2_t b = __builtin_convertvector(v, bf16x2_t); return __builtin_bit_cast(unsigned, b); }
__device__ __forceinline__ u32x4 pack8(const f32x4& v0, const f32x4& v1) { u32x4 w; w.x = cvt_pk_bf16(v0[0], v0[1]); w.y = cvt_pk_bf16(v0[2], v0[3]); w.z = cvt_pk_bf16(v1[0], v1[1]); w.w = cvt_pk_bf16(v1[2], v1[3]); return w; }
__device__ __forceinline__ void unpack8(const u32x4& w, f32x4& v0, f32x4& v1) { v0[0] = bflo(w.x); v0[1] = bfhi(w.x); v0[2] = bflo(w.y); v0[3] = bfhi(w.y); v1[0] = bflo(w.z); v1[1] = bfhi(w.z); v1[2] = bflo(w.w); v1[3] = bfhi(w.w); }
__device__ __forceinline__ f32x4 sig4(const f32x4& v) { f32x4 o; o[0] = sigmoidf_(v[0]); o[1] = sigmoidf_(v[1]); o[2] = sigmoidf_(v[2]); o[3] = sigmoidf_(v[3]); return o; }

struct EpiInproj {
    static constexpr bool PERM = true;
    const float* biasp; const float* lb; bf16_t *QO, *KV, *HB, *HG, *G; float *LOGF, *FL;
    template <int KIND> __device__ __forceinline__ void tile(const f32x4 (&acc)[2][2][4][2], const Unit& u, int wr, int wc, int fr, int fq) const {
        const int row0 = u.pm * BM + wr * 64 + fr, bcol0 = u.pn * BM + wc * 32 + 8 * fq;
        f32x4 bv[2][2];
#pragma unroll
        for (int bj = 0; bj < 2; ++bj)
#pragma unroll
            for (int n = 0; n < 2; ++n) bv[bj][n] = *(const f32x4*)(biasp + bcol0 + bj * HALF + 4 * n);
#pragma unroll
        for (int ai = 0; ai < 2; ++ai)
#pragma unroll
            for (int m = 0; m < 4; ++m) { const size_t row = (size_t)(row0 + ai * HALF + m * 16);
#pragma unroll
                for (int bj = 0; bj < 2; ++bj) { f32x4 v0 = acc[ai][bj][m][0] + bv[bj][0], v1 = acc[ai][bj][m][1] + bv[bj][1]; const int col = bcol0 + bj * HALF;
                    if (KIND == 0) { *(u32x4*)(QO + row * 1024 + col) = pack8(v0 * C2, v1 * C2); }
                    else if (KIND == 1) { *(u32x4*)(KV + row * 1024 + (col - 512)) = pack8(v0, v1); }
                    else if (KIND == 2) { *(u32x4*)(KV + row * 1024 + 512 + (col - 1024)) = pack8(v0, v1); }
                    else if (KIND == 3) { *(u32x4*)(HB + row * 1024 + (col - 1536)) = pack8(v0 * sig4(v0), v1 * sig4(v1)); }
                    else if (KIND == 4) { const int c = col - 2048; const f32x4 l0 = *(const f32x4*)(lb + c), l1 = *(const f32x4*)(lb + c + 4);
                        f32x4 f0 = l0 + (1.f - l0) * sig4(v0), f1 = l1 + (1.f - l1) * sig4(v1);
#pragma unroll
                        for (int q = 0; q < 4; ++q) { f0[q] = __logf(f0[q]); f1[q] = __logf(f1[q]); }
                        *(f32x4*)(LOGF + row * 512 + c) = f0; *(f32x4*)(LOGF + row * 512 + c + 4) = f1; }
                    else if (KIND == 5) { *(u32x4*)(HB + row * 1024 + 512 + (col - 2560)) = pack8(v0, v1); }
                    else if (KIND == 6) { *(u32x4*)(HG + row * 512 + (col - 3072)) = pack8(v0 * sig4(v0), v1 * sig4(v1)); }
                    else if (KIND == 7) { *(u32x4*)(G + row * 2048 + (col - 3584)) = pack8(sig4(v0), sig4(v1)); }
                    else { if (col == 5632) { f32x4 f0, f1;
#pragma unroll
                            for (int q = 0; q < 4; ++q) { f0[q] = logsigmoidf_(v0[q]); f1[q] = logsigmoidf_(v1[q]); }
                            *(f32x4*)(FL + row * 8) = f0; *(f32x4*)(FL + row * 8 + 4) = f1; } }
                } }
    }
    __device__ __forceinline__ void operator()(const f32x4 (&acc)[2][2][4][2], const Unit& u, int wr, int wc, int fr, int fq) const {
        const int ct = u.pn;
        if (ct < 2) tile<0>(acc, u, wr, wc, fr, fq); else if (ct < 4) tile<1>(acc, u, wr, wc, fr, fq); else if (ct < 6) tile<2>(acc, u, wr, wc, fr, fq);
        else if (ct < 8) tile<3>(acc, u, wr, wc, fr, fq); else if (ct < 10) tile<4>(acc, u, wr, wc, fr, fq); else if (ct < 12) tile<5>(acc, u, wr, wc, fr, fq);
        else if (ct < 14) tile<6>(acc, u, wr, wc, fr, fq); else if (ct < 22) tile<7>(acc, u, wr, wc, fr, fq); else tile<8>(acc, u, wr, wc, fr, fq);
    }
};
template <int MODE> struct EpiGate {
    static constexpr bool PERM = true;
    bf16_t* O; const float* bias; const bf16_t* Gt; int ldg; const bf16_t* P;
    __device__ __forceinline__ void operator()(const f32x4 (&acc)[2][2][4][2], const Unit& u, int wr, int wc, int fr, int fq) const {
        const int row0 = u.pm * BM + wr * 64 + fr, col0 = u.pn * BM + wc * 32 + 8 * fq;
        f32x4 bv[2][2];
        if (MODE == 0) {
#pragma unroll
            for (int bj = 0; bj < 2; ++bj)
#pragma unroll
                for (int n = 0; n < 2; ++n) bv[bj][n] = bias ? *(const f32x4*)(bias + col0 + bj * HALF + 4 * n) : (f32x4){0.f, 0.f, 0.f, 0.f};
        }
#pragma unroll
        for (int ai = 0; ai < 2; ++ai)
#pragma unroll
            for (int mh = 0; mh < 2; ++mh) {
                u32x4 gq[2][2], pq[2][2];
                if (MODE != 0) {
#pragma unroll
                    for (int mm = 0; mm < 2; ++mm)
#pragma unroll
                        for (int bj = 0; bj < 2; ++bj) { const size_t row = (size_t)(row0 + ai * HALF + (mh * 2 + mm) * 16); const int col = col0 + bj * HALF;
                            gq[mm][bj] = *(const u32x4*)(Gt + row * ldg + col);
                            if (MODE == 2) pq[mm][bj] = *(const u32x4*)(P + row * 1024 + col); }
                    asm volatile("s_waitcnt vmcnt(0)" ::: "memory");
                }
#pragma unroll
                for (int mm = 0; mm < 2; ++mm)
#pragma unroll
                    for (int bj = 0; bj < 2; ++bj) { const int m = mh * 2 + mm; const size_t row = (size_t)(row0 + ai * HALF + m * 16); const int col = col0 + bj * HALF;
                        f32x4 v0 = acc[ai][bj][m][0], v1 = acc[ai][bj][m][1];
                        if (MODE == 0) { v0 += bv[bj][0]; v1 += bv[bj][1]; }
                        else { f32x4 g0, g1; unpack8(gq[mm][bj], g0, g1); v0 *= g0; v1 *= g1;
                            if (MODE == 2) { f32x4 p0, p1; unpack8(pq[mm][bj], p0, p1); v0 += p0; v1 += p1; } }
                        *(u32x4*)(O + row * 1024 + col) = pack8(v0, v1); }
                if (MODE != 0) asm volatile("" ::: "memory");
            }
    }
};
struct EpiUp {
    static constexpr bool PERM = true;
    bf16_t* H;
    __device__ __forceinline__ void operator()(const f32x4 (&acc)[2][2][4][2], const Unit& u, int wr, int wc, int fr, int fq) const {
        const int row0 = u.pm * BM + wr * 64 + fr, col = u.pn * HALF + wc * 32 + 8 * fq;
#pragma unroll
        for (int ai = 0; ai < 2; ++ai)
#pragma unroll
            for (int m = 0; m < 4; ++m) { const size_t row = (size_t)(row0 + ai * HALF + m * 16);
                const f32x4 a0 = acc[ai][0][m][0], a1 = acc[ai][0][m][1], b0 = acc[ai][1][m][0], b1 = acc[ai][1][m][1];
                *(u32x4*)(H + row * 1024 + col) = pack8(a0 * sig4(a0) * b0, a1 * sig4(a1) * b1); }
    }
};

template <class Epi, class Sched, bool ALIGN_EPI>
__device__ __forceinline__ void gemm_phase(LAS unsigned char* lds, const Gemm g, const Sched& S, const Epi& E, const int tid) {
    const int wid = __builtin_amdgcn_readfirstlane(tid >> 6), lane = tid & 63, wr = wid >> 2, wc = wid & 3, fr = lane & 15, fq = lane >> 4;
    const int K = g.K, nt = K / BK;
    int RA[2], CA[2]; unsigned voffB[2];
#pragma unroll
    for (int i = 0; i < 2; ++i) { int R, C; stage_rc(tid * 16 + i * 8192, R, C); const int Rb = Epi::PERM ? ((R & ~31) + perm32(R & 31)) : R;
        RA[i] = R; CA[i] = C; voffB[i] = (unsigned)(Rb * g.ldb + C) * 2u; }
    const size_t kstep = (size_t)(BK * 2);
    const size_t hstepB = (size_t)HALF * g.ldb * 2;
    const unsigned ldsw = (unsigned)wid * 1024u;
    const int aoff = lds_byte(wr * 64 + fr, fq * 8), boff = lds_byte(wc * 32 + fr, fq * 8);
#define PG8_SA(b, h) (((b) * 2 + (h)) * HTB)
#define PG8_SB(b, h) ((4 + (b) * 2 + (h)) * HTB)
#define PG8_STAGE(bufoff, gbase, voff) do { _Pragma("unroll") for (int _i = 0; _i < 2; ++_i) \
        __builtin_amdgcn_global_load_lds((const unsigned*)((const char*)(gbase) + (voff)[_i]), (LAS unsigned*)(lds + (bufoff) + ldsw + _i * 8192), 16, 0, 0); } while (0)
#define PG8_LDA(dst, b, h) do { _Pragma("unroll") for (int m = 0; m < 4; ++m) _Pragma("unroll") for (int k = 0; k < 2; ++k) dst[m][k] = *(const LAS bf16x8*)(lds + PG8_SA(b, h) + aoff + m * 2048 + k * 1024); } while (0)
#define PG8_LDB(dst, b, h) do { _Pragma("unroll") for (int n = 0; n < 2; ++n) _Pragma("unroll") for (int k = 0; k < 2; ++k) dst[n][k] = *(const LAS bf16x8*)(lds + PG8_SB(b, h) + boff + n * 2048 + k * 1024); } while (0)
#define PG8_MMA(ai, bj, At, Bt) do { __builtin_amdgcn_s_setprio(1); _Pragma("unroll") for (int m = 0; m < 4; ++m) _Pragma("unroll") for (int n = 0; n < 2; ++n) _Pragma("unroll") for (int k = 0; k < 2; ++k) \
        acc[ai][bj][m][n] = __builtin_amdgcn_mfma_f32_16x16x32_bf16(Bt[n][k], At[m][k], acc[ai][bj][m][n], 0, 0, 0); __builtin_amdgcn_s_setprio(0); } while (0)
#define PG8_WAIT_V(n) asm volatile("s_waitcnt vmcnt(" #n ")" ::: "memory")
#define PG8_WAIT_L(n) asm volatile("s_waitcnt lgkmcnt(" #n ")" ::: "memory")
#define PG8_BAR __builtin_amdgcn_s_barrier()
#define PG8_SCHED __builtin_amdgcn_sched_barrier(0)
    Unit cur, nxt; int ui = 0;
    if (!S.next(0, cur)) return;
    f32x4 acc[2][2][4][2];
#pragma unroll
    for (int a = 0; a < 2; ++a)
#pragma unroll
        for (int b = 0; b < 2; ++b)
#pragma unroll
            for (int m = 0; m < 4; ++m)
#pragma unroll
                for (int n = 0; n < 2; ++n) acc[a][b][m][n] = (f32x4){0.f, 0.f, 0.f, 0.f};
    bf16x8 At[4][2], B0[2][2], B1[2][2];
    unsigned vA[2][2], nvA[2][2];
    S.a_voff(g, cur, RA, CA, vA);
    const char* cA = S.a_tile(g, cur); const char* cB = S.b_tile(g, cur);
    PG8_STAGE(PG8_SB(0, 0), cB, voffB); PG8_STAGE(PG8_SB(0, 1), cB + hstepB, voffB); PG8_STAGE(PG8_SA(0, 0), cA, vA[0]); PG8_STAGE(PG8_SA(0, 1), cA, vA[1]);
    if (wr == 1) PG8_BAR;
    PG8_WAIT_V(2); PG8_BAR;
    PG8_STAGE(PG8_SB(1, 0), cB + kstep, voffB); PG8_STAGE(PG8_SA(1, 0), cA + kstep, vA[0]); PG8_STAGE(PG8_SB(1, 1), cB + hstepB + kstep, voffB);
    PG8_WAIT_V(6); PG8_BAR;
    for (;;) {
        const bool has_next = S.next(ui + 1, nxt);
        const char* nA = has_next ? S.a_tile(g, nxt) : cA; const char* nB = has_next ? S.b_tile(g, nxt) : cB;
        if (has_next) S.a_voff(g, nxt, RA, CA, nvA);
        else {
#pragma unroll
            for (int h = 0; h < 2; ++h)
#pragma unroll
                for (int i = 0; i < 2; ++i) nvA[h][i] = vA[h][i]; }
        for (int t = 0; t < nt; t += 2) {
            const bool last = (t == nt - 2);
            const char* a1 = cA + (size_t)(t + 1) * kstep;
            const char* a2 = last ? nA : cA + (size_t)(t + 2) * kstep; const char* b2 = last ? nB : cB + (size_t)(t + 2) * kstep;
            const char* a3 = a2 + kstep; const char* b3 = b2 + kstep;
            unsigned wA0[2], wA1[2];
#pragma unroll
            for (int i = 0; i < 2; ++i) { wA0[i] = last ? nvA[0][i] : vA[0][i]; wA1[i] = last ? nvA[1][i] : vA[1][i]; }
            PG8_LDB(B0, 0, 0); PG8_LDB(B1, 0, 1); PG8_SCHED; PG8_LDA(At, 0, 0); PG8_STAGE(PG8_SA(1, 1), a1, vA[1]);
            PG8_WAIT_V(8); PG8_WAIT_L(0); PG8_BAR; PG8_MMA(0, 0, At, B0); PG8_MMA(0, 1, At, B1); PG8_BAR; PG8_SCHED;
            PG8_LDA(At, 0, 1); PG8_STAGE(PG8_SB(0, 0), b2, voffB); PG8_STAGE(PG8_SB(0, 1), b2 + hstepB, voffB); PG8_STAGE(PG8_SA(0, 0), a2, wA0);
            PG8_WAIT_V(8); PG8_WAIT_L(0); PG8_BAR; PG8_MMA(1, 0, At, B0); PG8_MMA(1, 1, At, B1); PG8_BAR; PG8_SCHED;
            PG8_LDB(B0, 1, 0); PG8_LDB(B1, 1, 1); PG8_SCHED; PG8_LDA(At, 1, 0); PG8_STAGE(PG8_SA(0, 1), a2, wA1);
            PG8_WAIT_V(8); PG8_WAIT_L(0); PG8_BAR; PG8_MMA(0, 0, At, B0); PG8_MMA(0, 1, At, B1); PG8_BAR; PG8_SCHED;
            PG8_LDA(At, 1, 1); PG8_STAGE(PG8_SB(1, 0), b3, voffB); PG8_STAGE(PG8_SB(1, 1), b3 + hstepB, voffB); PG8_STAGE(PG8_SA(1, 0), a3, wA0);
            PG8_WAIT_V(8); PG8_WAIT_L(0); PG8_BAR; PG8_MMA(1, 0, At, B0); PG8_MMA(1, 1, At, B1); PG8_BAR; PG8_SCHED;
        }
        if constexpr (ALIGN_EPI) { if (wr == 0) PG8_BAR; }
        E(acc, cur, wr, wc, fr, fq);
        if (!has_next) break;
#pragma unroll
        for (int a = 0; a < 2; ++a)
#pragma unroll
            for (int b = 0; b < 2; ++b)
#pragma unroll
                for (int m = 0; m < 4; ++m)
#pragma unroll
                    for (int n = 0; n < 2; ++n) acc[a][b][m][n] = (f32x4){0.f, 0.f, 0.f, 0.f};
        cur = nxt; cA = nA; cB = nB; ++ui;
#pragma unroll
        for (int h = 0; h < 2; ++h)
#pragma unroll
            for (int i = 0; i < 2; ++i) vA[h][i] = nvA[h][i];
        if constexpr (ALIGN_EPI) { if (wr == 1) PG8_BAR; }
    }
    PG8_WAIT_V(0);
    if constexpr (!ALIGN_EPI) { if (wr == 0) PG8_BAR; }
    PG8_BAR;
#undef PG8_SA
#undef PG8_SB
#undef PG8_STAGE
#undef PG8_LDA
#undef PG8_LDB
#undef PG8_MMA
#undef PG8_WAIT_V
#undef PG8_WAIT_L
#undef PG8_BAR
#undef PG8_SCHED
}
}


constexpr int NWAVES = 8;
constexpr int RING_OFF = 0, RING_BYTES = 131072;
constexpr int LDSCTL_OFF = RING_BYTES, MISC_OFF = LDSCTL_OFF + 320, TAB_OFF = LDSCTL_OFF + 1024;
constexpr int LDS_BYTES = 147456;
typedef GAS unsigned gu32;
#define RLX_AGENT __ATOMIC_RELAXED, __HIP_MEMORY_SCOPE_AGENT

#define XB_TMO      128
#define XB_XCNT(j)  (256  + 64 * (j))
#define XB_XSUB(j)  (1280 + 64 * (j))
#define XB_XGEN(j)  (2304 + 64 * (j))
#define XB_TOP      3328
#define XB_TOPGEN   3392
#define XCD_BAR_WORDS 3456
#define XB_SPIN_CAP (1u << 18)

__device__ __forceinline__ unsigned xb_ld(unsigned* p)              { return __hip_atomic_load(p, __ATOMIC_RELAXED, __HIP_MEMORY_SCOPE_AGENT); }
__device__ __forceinline__ unsigned xb_add(unsigned* p, unsigned v) { return __hip_atomic_fetch_add(p, v, __ATOMIC_RELAXED, __HIP_MEMORY_SCOPE_AGENT); }
__device__ __forceinline__ unsigned xb_xcc_id() { return (unsigned)__builtin_amdgcn_s_getreg((3 << 11) | 20) & 0xFu; }
#define XB_SPIN(cond, bar) do { unsigned _sp = 0; while (cond) { __builtin_amdgcn_s_sleep(1); \
    if ((++_sp & 255u) == 0u) { if (xb_ld(&(bar)[XB_TMO])) break; if (_sp > XB_SPIN_CAP) { atomicAdd(&(bar)[XB_TMO], 1u); break; } } } } while (0)

struct XcdBarrier {
    unsigned* bar; unsigned x;
    volatile LAS unsigned* st;
};

__device__ __forceinline__ XcdBarrier xcd_barrier_post(unsigned* bar, volatile LAS unsigned* st) {
    XcdBarrier b; b.bar = bar; b.x = xb_xcc_id(); b.st = st;
    if (threadIdx.x == 0) (void)xb_add(&bar[XB_XCNT(b.x)], 1u);
    return b;
}
__device__ __forceinline__ void xcd_barrier_complete(unsigned* bar, unsigned x, unsigned& nloc, unsigned& nx) {
    const unsigned G = gridDim.x * gridDim.y * gridDim.z;
    unsigned sum, cnt, mine, sp = 0u;
    for (;;) {
        sum = 0u; cnt = 0u; mine = 0u;
#pragma unroll
        for (unsigned j = 0; j < 16; ++j) { const unsigned c = xb_ld(&bar[XB_XCNT(j)]); sum += c; cnt += (c > 0u) ? 1u : 0u; mine = (j == x) ? c : mine; }
        if (sum == G) break;
        __builtin_amdgcn_s_sleep(1);
        if ((++sp & 255u) == 0u) { if (xb_ld(&bar[XB_TMO])) break; if (sp > XB_SPIN_CAP) { atomicAdd(&bar[XB_TMO], 1u); break; } }
    }
    nloc = mine > 0u ? mine : 1u; nx = cnt > 0u ? cnt : 1u;
}

__device__ __forceinline__ void xcd_barrier(const XcdBarrier& b) {
    asm volatile("s_waitcnt vmcnt(0)" ::: "memory");
    __syncthreads();
    if (threadIdx.x == 0) {
        unsigned* bar = b.bar;
        __builtin_amdgcn_s_waitcnt(0);
        unsigned nloc = b.st[0], nx = b.st[1];
        if (nloc == 0u) { xcd_barrier_complete(bar, b.x, nloc, nx); b.st[0] = nloc; b.st[1] = nx; }
        const unsigned old = xb_add(&bar[XB_XSUB(b.x)], 1u);
        const unsigned gen = old / nloc;
        if (old + 1u == (gen + 1u) * nloc) {
            __builtin_amdgcn_fence(__ATOMIC_RELEASE, "agent");
            asm volatile("s_waitcnt vmcnt(0)" ::: "memory");
            const unsigned og = xb_add(&bar[XB_TOP], 1u);
            const unsigned tg = og / nx;
            if (og + 1u == (tg + 1u) * nx) xb_add(&bar[XB_TOPGEN], 1u);
            else XB_SPIN(xb_ld(&bar[XB_TOPGEN]) == tg, bar);
            __builtin_amdgcn_fence(__ATOMIC_ACQUIRE, "agent");
            xb_add(&bar[XB_XGEN(b.x)], 1u);
            asm volatile("s_waitcnt vmcnt(0)" ::: "memory");
        } else {
            XB_SPIN(xb_ld(&bar[XB_XGEN(b.x)]) == gen, bar);
            __builtin_amdgcn_fence(__ATOMIC_ACQUIRE, "agent");
            asm volatile("s_waitcnt vmcnt(0)" ::: "memory");
        }
    }
    __syncthreads();
}


struct Args {
    const float *x, *ln_in_g, *ln_in_b, *w_in, *b_in, *w_fox, *lbl, *norm_g, *w_hgrn, *w_mix, *b_mix, *ln1_g, *ln1_b, *router_w, *router_b, *w1, *w3, *w2, *ln2_g, *ln2_b;
    float* out; unsigned char* ws; int ph_lo, ph_hi, use_bar, pad;
};
struct Frame { LAS unsigned char* lds; int tid, lane, wave, G, gw, ngw; };
#if defined(__HIP_DEVICE_COMPILE__)
typedef const __attribute__((address_space(4))) Args CArgs;
__device__ __forceinline__ CArgs* get_args() { CArgs* p = (CArgs*)__builtin_amdgcn_kernarg_segment_ptr(); asm volatile("" : "+s"(p)); return p; }
#define LOAD_ARGS() (*get_args())
#else
#define LOAD_ARGS() (args)
#endif

__device__ __forceinline__ void ln_rows16(f32x4 (&v)[4], const float* g, const float* bta, int lane) {
    float s = 0.f;
#pragma unroll
    for (int j = 0; j < 4; ++j) s += (v[j].x + v[j].y) + (v[j].z + v[j].w);
    const float mean = wave_sum(s) * (1.f / D); float s2 = 0.f;
#pragma unroll
    for (int j = 0; j < 4; ++j) { v[j] = v[j] - mean; s2 += (v[j].x * v[j].x + v[j].y * v[j].y) + (v[j].z * v[j].z + v[j].w * v[j].w); }
    const float rstd = rsqrtf(wave_sum(s2) * (1.f / D) + LN_EPS);
#pragma unroll
    for (int j = 0; j < 4; ++j) { const int c = 4 * lane + 256 * j; const f32x4 gg = *(const f32x4*)(g + c), bb = *(const f32x4*)(bta + c); v[j] = v[j] * rstd * gg + bb; }
}
__device__ __forceinline__ void store_row(const f32x4 (&v)[4], int lane, float* of32, bf16_t* obf, float* of32b) {
#pragma unroll
    for (int j = 0; j < 4; ++j) { const int c = 4 * lane + 256 * j;
        if (of32) *(f32x4*)(of32 + c) = v[j];
        if (of32b) *(f32x4*)(of32b + c) = v[j];
        if (obf) { u32x2 w; w.x = pk2(v[j].x, v[j].y); w.y = pk2(v[j].z, v[j].w); *(u32x2*)(obf + c) = w; } }
}

__device__ __forceinline__ void cvt_item(const float* W, int ldw, int k0, int srccol, int nvalid, bf16_t* WT, int ldt, int dstrow, int dstk, LAS float* scr, int lane) {
#pragma unroll 8
    for (int i = 0; i < 32; ++i) { const int kk = 2 * i + (lane >> 5); const int n = lane & 31;
        scr[kk * 33 + n] = (n < nvalid) ? W[(size_t)(k0 + kk) * ldw + srccol + n] : 0.f; }
    asm volatile("s_waitcnt lgkmcnt(0)" ::: "memory");
    const int c = lane & 7;
#pragma unroll
    for (int j = 0; j < 4; ++j) { const int n = (lane >> 3) + 8 * j; const LAS float* s = scr + (8 * c) * 33 + n;
        u32x4 o; o.x = pk2(s[0 * 33], s[1 * 33]); o.y = pk2(s[2 * 33], s[3 * 33]); o.z = pk2(s[4 * 33], s[5 * 33]); o.w = pk2(s[6 * 33], s[7 * 33]);
        *(u32x4*)(WT + (size_t)(dstrow + n) * ldt + dstk + k0 + 8 * c) = o; }
    asm volatile("s_waitcnt lgkmcnt(0)" ::: "memory");
}
__device__ __forceinline__ void convert_layer(const Args& a, const Frame& F, int l) {
    LAS float* scr = (LAS float*)(F.lds + RING_OFF + F.wave * 16384);
    const int gw = F.gw, ngw = F.ngw, lane = F.lane;
    bf16_t* WIN = (bf16_t*)(a.ws + WS_WIN); bf16_t* WBR = (bf16_t*)(a.ws + WS_WBR); bf16_t* WMIX = (bf16_t*)(a.ws + WS_WMIX);
    bf16_t* W13 = (bf16_t*)(a.ws + WS_W13); bf16_t* W2 = (bf16_t*)(a.ws + WS_W2);
    constexpr int I_IN = 16 * 184, I_BR = 8 * 32, I_MIX = 16 * 32, I_13 = 16 * 64 * NE, I_2 = 16 * 32 * NE;
    constexpr int NITEMS = I_IN + 2 * I_BR + I_MIX + I_13 + I_2;
    for (int it = gw; it < NITEMS; it += ngw) {
        int r = it;
        if (r < I_IN) { const int kb = r / 184, nb = r % 184, n0 = nb * 32;
            int src, nv = 32; if (n0 < 1536) src = n0; else if (n0 < 5632) src = n0 + 8; else if (n0 == 5632) { src = 1536; nv = 8; } else { src = 0; nv = 0; }
            cvt_item(a.w_in + (size_t)l * D * NIN, NIN, kb * 64, src, nv, WIN, D, n0, 0, scr, lane); continue; } r -= I_IN;
        if (r < I_BR) { const int kb = r / 32, nb = r % 32; cvt_item(a.w_fox + (size_t)l * 512 * D, D, kb * 64, nb * 32, 32, WBR, D, nb * 32, 0, scr, lane); continue; } r -= I_BR;
        if (r < I_BR) { const int kb = r / 32, nb = r % 32; cvt_item(a.w_hgrn + (size_t)l * 512 * D, D, kb * 64, nb * 32, 32, WBR, D, nb * 32, 512, scr, lane); continue; } r -= I_BR;
        if (r < I_MIX) { const int kb = r / 32, nb = r % 32; cvt_item(a.w_mix + (size_t)l * D * D, D, kb * 64, nb * 32, 32, WMIX, D, nb * 32, 0, scr, lane); continue; } r -= I_MIX;
        if (r < I_13) { const int e = r / 1024, q = r % 1024, kb = q / 64, nb = q % 64, n0 = nb * 32;
            const int j = n0 >> 8, rr = n0 & 255; const float* src = (rr < 128 ? a.w1 : a.w3) + ((size_t)l * NE + e) * D * D;
            cvt_item(src, D, kb * 64, 128 * j + (rr & 127), 32, W13 + (size_t)e * 2048 * D, D, n0, 0, scr, lane); continue; } r -= I_13;
        { const int e = r / 512, q = r % 512, kb = q / 32, nb = q % 32;
            cvt_item(a.w2 + ((size_t)l * NE + e) * D * D, D, kb * 64, nb * 32, 32, W2 + (size_t)e * D * D, D, nb * 32, 0, scr, lane); }
    }
    float* biasp = (float*)(a.ws + WS_MISC + 16384);
    for (int n = gw * 64 + lane; n < NINP; n += ngw * 64) {
        float v = 0.f; if (n < 1536) v = a.b_in[l * NIN + n]; else if (n < 5632) v = a.b_in[l * NIN + n + 8]; else if (n < 5640) v = a.b_in[l * NIN + 1536 + (n - 5632)];
        biasp[n] = v; }
}

__device__ __forceinline__ void phase_prep(const Args& a, const Frame& F) {
    if (blockIdx.x == 0) {
        float* lb_all = (float*)(a.ws + WS_MISC);
        const int c = F.tid;
        float v[DEPTH], m = -1e30f;
#pragma unroll
        for (int l = 0; l < DEPTH; ++l) { v[l] = a.lbl[l * 512 + c]; m = fmaxf(m, v[l]); }
        float s = 0.f;
#pragma unroll
        for (int l = 0; l < DEPTH; ++l) { v[l] = __expf(v[l] - m); s += v[l]; }
        float cum = 0.f;
#pragma unroll
        for (int l = 0; l < DEPTH; ++l) { const float p = v[l] / s; cum += p; lb_all[l * 512 + c] = cum - v[0] / s; }
    }
    float* XRES = (float*)(a.ws + WS_XRES); bf16_t* XN = (bf16_t*)(a.ws + WS_XN);
    for (int row = F.gw; row < T; row += F.ngw) {
        f32x4 v[4];
#pragma unroll
        for (int j = 0; j < 4; ++j) v[j] = *(const f32x4*)(a.x + (size_t)row * D + 4 * F.lane + 256 * j);
        ln_rows16(v, a.ln_in_g, a.ln_in_b, F.lane);
        store_row(v, F.lane, XRES + (size_t)row * D, XN + (size_t)row * D, nullptr);
    }
    convert_layer(a, F, 0);
}

__device__ __forceinline__ void phase_fscan(const Args& a, const Frame& F) {
    if (blockIdx.x >= BATCH * NH) return;
    const float* FL = (const float*)(a.ws + WS_FL); float* F2 = (float*)(a.ws + WS_F2);
    LAS float* wsum = (LAS float*)(F.lds + RING_OFF);
    const int bh = blockIdx.x, b = bh >> 3, h = bh & 7, tid = F.tid, lane = F.lane, w = F.wave;
    float v[4], run = 0.f;
#pragma unroll
    for (int i = 0; i < 4; ++i) { run += FL[((size_t)b * SEQ + tid * 4 + i) * 8 + h]; v[i] = run; }
    float incl = run;
#pragma unroll
    for (int o = 1; o < 64; o <<= 1) { const float u = __shfl_up(incl, o); if (lane >= o) incl += u; }
    if (lane == 63) wsum[w] = incl;
    __syncthreads();
    float base = incl - run; for (int i = 0; i < w; ++i) base += wsum[i];
#pragma unroll
    for (int i = 0; i < 4; ++i) F2[(size_t)bh * SEQ + tid * 4 + i] = (base + v[i]) * LOG2E;
    __syncthreads();
}

__device__ __forceinline__ void phase_attn_naive(const Args& a, const Frame& F) {
    const bf16_t* QO = (const bf16_t*)(a.ws + WS_QO); const bf16_t* KV = (const bf16_t*)(a.ws + WS_KV); const float* F2 = (const float*)(a.ws + WS_F2); bf16_t* O = (bf16_t*)(a.ws + WS_QO);
    LAS float* ps = (LAS float*)(F.lds + RING_OFF) + F.wave * 64;
    const int lane = F.lane;
    for (int gid = F.gw; gid < BATCH * NH * SEQ; gid += F.ngw) {
        const int bh = gid & 127, t = gid >> 7, b = bh >> 3, h = bh & 7;
        float q[64];
        { const bf16_t* qp = QO + ((size_t)b * SEQ + t) * 1024 + h * 64;
#pragma unroll
          for (int c = 0; c < 8; ++c) { const u32x4 u = *(const u32x4*)(qp + c * 8);
            q[c * 8 + 0] = bflo(u.x); q[c * 8 + 1] = bfhi(u.x); q[c * 8 + 2] = bflo(u.y); q[c * 8 + 3] = bfhi(u.y);
            q[c * 8 + 4] = bflo(u.z); q[c * 8 + 5] = bfhi(u.z); q[c * 8 + 6] = bflo(u.w); q[c * 8 + 7] = bfhi(u.w); } }
        float m = -1e30f, l = 0.f, o = 0.f;
        const float* f2 = F2 + (size_t)bh * SEQ;
        for (int s0 = 0; s0 <= t; s0 += 64) {
            const int s = s0 + lane; const bool valid = s <= t;
            float sc = -1e30f;
            if (valid) { const bf16_t* kp = KV + ((size_t)b * SEQ + s) * 1024 + h * 64; float d = 0.f;
#pragma unroll
                for (int c = 0; c < 8; ++c) { const u32x4 u = *(const u32x4*)(kp + c * 8);
                    d += q[c * 8 + 0] * bflo(u.x) + q[c * 8 + 1] * bfhi(u.x) + q[c * 8 + 2] * bflo(u.y) + q[c * 8 + 3] * bfhi(u.y)
                       + q[c * 8 + 4] * bflo(u.z) + q[c * 8 + 5] * bfhi(u.z) + q[c * 8 + 6] * bflo(u.w) + q[c * 8 + 7] * bfhi(u.w); }
                sc = d - f2[s]; }
            const float mn = fmaxf(m, wave_max(sc));
            const float p = valid ? exp2f(sc - mn) : 0.f;
            const float f = exp2f(m - mn);
            l = l * f + wave_sum(p); o *= f; m = mn;
            ps[lane] = p;
            asm volatile("s_waitcnt lgkmcnt(0)" ::: "memory");
            const int nk = min(64, t - s0 + 1);
            const bf16_t* vp = KV + ((size_t)b * SEQ + s0) * 1024 + 512 + h * 64 + lane;
            for (int j = 0; j < nk; ++j) o += ps[j] * bf2f(vp[(size_t)j * 1024]);
            asm volatile("s_waitcnt lgkmcnt(0)" ::: "memory");
        }
        O[((size_t)b * SEQ + t) * 1024 + h * 64 + lane] = (bf16_t)f2bf(o / l);
    }
}

__device__ __forceinline__ void phase_hgrn_naive(const Args& a, const Frame& F, int l) {
    if (blockIdx.x >= BATCH * NH || F.wave != 0) return;
    const bf16_t* HB = (const bf16_t*)(a.ws + WS_HB); const float* LOGF = (const float*)(a.ws + WS_LOGF); const bf16_t* HG = (const bf16_t*)(a.ws + WS_HG); bf16_t* O = (bf16_t*)(a.ws + WS_QO);
    LAS float* Lf = (LAS float*)(F.lds + RING_OFF + 1024); LAS float* Lk = Lf + 4096; LAS float* Lq = Lk + 4096;
    const int bh = blockIdx.x, b = bh >> 3, h = bh & 7, lane = F.lane;
    float Sx[64];
#pragma unroll
    for (int d = 0; d < 64; ++d) Sx[d] = 0.f;
    const float ng = a.norm_g[l * 512 + h * 64 + lane];
    for (int c0 = 0; c0 < SEQ; c0 += 64) {
        for (int tt = 0; tt < 64; ++tt) { const size_t row = (size_t)b * SEQ + c0 + tt;
            const float lf = LOGF[row * 512 + h * 64 + lane]; const float f = __expf(lf);
            Lf[tt * 64 + lane] = f; Lk[tt * 64 + lane] = 1.f - f; Lq[tt * 64 + lane] = bf2f(HB[row * 1024 + h * 64 + lane]); }
        asm volatile("s_waitcnt lgkmcnt(0)" ::: "memory");
        for (int tt = 0; tt < 64; ++tt) { const size_t row = (size_t)b * SEQ + c0 + tt;
            const float v = bf2f(HB[row * 1024 + 512 + h * 64 + lane]);
            float o = 0.f;
#pragma unroll
            for (int d = 0; d < 64; d += 4) { const f32x4 f4 = *(const LAS f32x4*)(Lf + tt * 64 + d), k4 = *(const LAS f32x4*)(Lk + tt * 64 + d), q4 = *(const LAS f32x4*)(Lq + tt * 64 + d);
                Sx[d] = f4.x * Sx[d] + k4.x * v; o += Sx[d] * q4.x; Sx[d + 1] = f4.y * Sx[d + 1] + k4.y * v; o += Sx[d + 1] * q4.y;
                Sx[d + 2] = f4.z * Sx[d + 2] + k4.z * v; o += Sx[d + 2] * q4.z; Sx[d + 3] = f4.w * Sx[d + 3] + k4.w * v; o += Sx[d + 3] * q4.w; }
            const float ss = wave_sum(o * o);
            const float r = o * rsqrtf(ss * (1.f / 64.f) + RMS_EPS) * ng * bf2f(HG[row * 512 + h * 64 + lane]);
            O[row * 1024 + 512 + h * 64 + lane] = (bf16_t)f2bf(r); }
        asm volatile("s_waitcnt lgkmcnt(0)" ::: "memory");
    }
}

__device__ __forceinline__ void phase_ln1_router(const Args& a, const Frame& F, int l) {
    float* xres = (float*)(a.ws + WS_XRES); const bf16_t* mixed = (const bf16_t*)(a.ws + WS_MIXED); bf16_t* xn = (bf16_t*)(a.ws + WS_XN);
    unsigned* cnt = (unsigned*)(a.ws + WS_CTL) + CW_CNT + l * 64; int* list = (int*)(a.ws + WS_LIST); unsigned* tokinfo = (unsigned*)(a.ws + WS_TOK);
    const float* g = a.ln1_g + l * D; const float* bta = a.ln1_b + l * D;
    LAS float* rw = (LAS float*)(F.lds + RING_OFF);
    for (int i = F.tid; i < NE * D; i += NWAVES * 64) { const int c = i >> 4, e = i & 15; rw[e * D + c] = a.router_w[i]; }
    __syncthreads();
    const int lane = F.lane;
    for (int row = F.gw; row < T; row += F.ngw) {
        f32x4 v[4];
#pragma unroll
        for (int j = 0; j < 4; ++j) { const int c = 4 * lane + 256 * j; const f32x4 xv = *(const f32x4*)(xres + (size_t)row * D + c);
            const u32x2 mm = *(const u32x2*)(mixed + (size_t)row * D + c);
            v[j].x = ALPHA * xv.x + bflo(mm.x); v[j].y = ALPHA * xv.y + bfhi(mm.x); v[j].z = ALPHA * xv.z + bflo(mm.y); v[j].w = ALPHA * xv.w + bfhi(mm.y); }
        ln_rows16(v, g, bta, lane);
        store_row(v, lane, xres + (size_t)row * D, xn + (size_t)row * D, nullptr);
        float lg[NE];
#pragma unroll
        for (int e = 0; e < NE; ++e) { float p = 0.f;
#pragma unroll
            for (int j = 0; j < 4; ++j) { const f32x4 r4 = *(const LAS f32x4*)(rw + e * D + 4 * lane + 256 * j); p += v[j].x * r4.x + v[j].y * r4.y + v[j].z * r4.z + v[j].w * r4.w; }
            lg[e] = wave_sum(p) + a.router_b[e]; asm volatile("" ::: "memory"); }
        if (lane == 0) {
            int gs = 0; float gbest = -3e38f;
#pragma unroll
            for (int gi = 0; gi < 4; ++gi) { const float mx = fmaxf(fmaxf(lg[gi * 4], lg[gi * 4 + 1]), fmaxf(lg[gi * 4 + 2], lg[gi * 4 + 3])); if (mx > gbest) { gbest = mx; gs = gi; } }
            float l4[4];
#pragma unroll
            for (int i = 0; i < 4; ++i) { float t0 = lg[i];
#pragma unroll
                for (int gi = 1; gi < 4; ++gi) t0 = (gs == gi) ? lg[gi * 4 + i] : t0; l4[i] = t0; }
            int i0 = 0; float b0 = l4[0];
#pragma unroll
            for (int i = 1; i < 4; ++i) if (l4[i] > b0) { b0 = l4[i]; i0 = i; }
            int i1 = 0; float b1 = -3e38f;
#pragma unroll
            for (int i = 0; i < 4; ++i) if (i != i0 && l4[i] > b1) { b1 = l4[i]; i1 = i; }
            const float e1 = __expf(b1 - b0); const float g0 = 1.f / (1.f + e1), g1 = e1 / (1.f + e1);
            const int ex0 = gs * 4 + i0, ex1 = gs * 4 + i1;
            const unsigned p0 = atomicAdd(cnt + ex0, 1u), p1 = atomicAdd(cnt + ex1, 1u);
            list[ex0 * T + p0] = row; list[ex1 * T + p1] = row;
            tokinfo[row * 4 + 0] = ((unsigned)ex0 << 24) | p0; tokinfo[row * 4 + 1] = ((unsigned)ex1 << 24) | p1;
            tokinfo[row * 4 + 2] = __float_as_uint(g0); tokinfo[row * 4 + 3] = __float_as_uint(g1);
        }
    }
    __syncthreads();
}

__device__ __forceinline__ void moe_table(const Args& a, const Frame& F, int l) {
    LAS int* tab = (LAS int*)(F.lds + TAB_OFF);
    const unsigned* cnt = (const unsigned*)(a.ws + WS_CTL) + CW_CNT + l * 64;
    if (F.tid == 0) { int ts = 0; for (int e = 0; e < NE; ++e) { const int c = (int)__hip_atomic_load(cnt + e, RLX_AGENT); tab[e] = ts; tab[NE + 1 + e] = c; ts += (c + TM - 1) / TM; } tab[NE] = ts; }
    __syncthreads();
}

__device__ __forceinline__ void phase_combine_ln2(const Args& a, const Frame& F, int l) {
    float* xres = (float*)(a.ws + WS_XRES); const bf16_t* Y = (const bf16_t*)(a.ws + WS_Y); const unsigned* tokinfo = (const unsigned*)(a.ws + WS_TOK); bf16_t* xn = (bf16_t*)(a.ws + WS_XN);
    const float* g = a.ln2_g + l * D; const float* bta = a.ln2_b + l * D; float* out = (l == DEPTH - 1) ? a.out : nullptr;
    const LAS int* tab = (const LAS int*)(F.lds + TAB_OFF);
    const int lane = F.lane;
    for (int row = F.gw; row < T; row += F.ngw) {
        const unsigned i0 = tokinfo[row * 4], i1 = tokinfo[row * 4 + 1]; const float g0 = __uint_as_float(tokinfo[row * 4 + 2]), g1 = __uint_as_float(tokinfo[row * 4 + 3]);
        const size_t s0 = (size_t)tab[i0 >> 24] * TM + (i0 & 0xffffff), s1 = (size_t)tab[i1 >> 24] * TM + (i1 & 0xffffff);
        f32x4 v[4];
#pragma unroll
        for (int j = 0; j < 4; ++j) { const int c = 4 * lane + 256 * j; const f32x4 xv = *(const f32x4*)(xres + (size_t)row * D + c);
            const u32x2 ya = *(const u32x2*)(Y + s0 * D + c), yb = *(const u32x2*)(Y + s1 * D + c);
            v[j].x = ALPHA * xv.x + g0 * bflo(ya.x) + g1 * bflo(yb.x); v[j].y = ALPHA * xv.y + g0 * bfhi(ya.x) + g1 * bfhi(yb.x);
            v[j].z = ALPHA * xv.z + g0 * bflo(ya.y) + g1 * bflo(yb.y); v[j].w = ALPHA * xv.w + g0 * bfhi(ya.y) + g1 * bfhi(yb.y); }
        ln_rows16(v, g, bta, lane);
        store_row(v, lane, xres + (size_t)row * D, xn + (size_t)row * D, out ? out + (size_t)row * D : nullptr);
    }
}


constexpr int PH_PER_LAYER = 10, N_PHASES = 1 + DEPTH * PH_PER_LAYER;
#ifndef MK_ONE_LAUNCH
#define MK_ONE_LAUNCH 1
#endif
#ifndef MK_FAST_ATTN
#define MK_FAST_ATTN 0
#endif
#ifndef MK_FAST_HGRN
#define MK_FAST_HGRN 0
#endif


#ifdef DBG_DUMP
#ifndef DBG_WHAT
#define DBG_WHAT 0
#endif
__device__ __forceinline__ void dbg_dump(const Args& a, const Frame& F) {
    unsigned char* ws = a.ws;
    const bf16_t *QO = (bf16_t*)(ws + WS_QO), *KV = (bf16_t*)(ws + WS_KV), *HB = (bf16_t*)(ws + WS_HB), *HG = (bf16_t*)(ws + WS_HG), *G = (bf16_t*)(ws + WS_G);
    const bf16_t *U1 = (bf16_t*)(ws + WS_U1), *U = (bf16_t*)(ws + WS_U), *MIXED = (bf16_t*)(ws + WS_MIXED), *XN = (bf16_t*)(ws + WS_XN);
    const float *LOGF = (float*)(ws + WS_LOGF), *FL = (float*)(ws + WS_FL), *XRES = (float*)(ws + WS_XRES);
    for (size_t i = (size_t)blockIdx.x * 512 + F.tid; i < (size_t)T * D; i += (size_t)gridDim.x * 512) {
        const size_t row = i >> 10; const int c = (int)(i & 1023);
        float v = 0.f;
        if (DBG_WHAT == 9) { v = bf2f(G[row * 2048 + c]) + bf2f(G[row * 2048 + 1024 + c]); }
        else if (DBG_DUMP == 1) { v = bf2f(KV[i]) + bf2f(HB[i]) + bf2f(G[row * 2048 + c]) + bf2f(G[row * 2048 + 1024 + c]);
            if (c < 512) v += LOGF[row * 512 + c] + bf2f(HG[row * 512 + c]) + bf2f(QO[i]); if (c < 8) v += FL[row * 8 + c]; }
        else if (DBG_DUMP == 2) { v = (c >= 512) ? bf2f(QO[i]) : 0.f; }
        else if (DBG_DUMP == 3) { v = bf2f(QO[i]); }
        else if (DBG_DUMP == 4) { v = bf2f(U1[i]); }
        else if (DBG_DUMP == 5) { v = bf2f(U[i]); }
        else if (DBG_DUMP == 6) { v = bf2f(MIXED[i]); }
        else if (DBG_DUMP == 7) { v = XRES[i] + bf2f(XN[i]); }
        a.out[i] = v;
    }
}
#endif
__global__ void __launch_bounds__(NWAVES * 64, 2) mk_fwd(Args args) {
    extern __shared__ __attribute__((aligned(16))) unsigned char lds_raw[];
    LAS unsigned char* const lds0 = (LAS unsigned char*)lds_raw;
    volatile LAS unsigned* MISC = (volatile LAS unsigned*)(lds0 + MISC_OFF);
    for (int u = threadIdx.x; u < (LDS_BYTES - LDSCTL_OFF) / 4; u += NWAVES * 64) ((LAS unsigned*)(lds0 + LDSCTL_OFF))[u] = 0u;
    __syncthreads();
    unsigned* ctl = (unsigned*)(args.ws + WS_CTL);
#define PH_BEGIN const Args a = LOAD_ARGS(); Frame F; F.lds = lds0; F.tid = threadIdx.x; asm volatile("" : "+v"(F.tid)); F.lane = F.tid & 63; F.wave = __builtin_amdgcn_readfirstlane(F.tid >> 6); \
    F.G = gridDim.x; F.gw = blockIdx.x * NWAVES + F.wave; F.ngw = F.G * NWAVES; unsigned char* const ws = a.ws; const LAS int* tab = (const LAS int*)(F.lds + TAB_OFF); (void)tab; (void)ws;
    XcdBarrier bar; bar.bar = ctl + CW_BAR; bar.x = 0; bar.st = nullptr;
    if (args.use_bar) bar = xcd_barrier_post(ctl + CW_BAR, MISC + 8);
    const int lo = args.ph_lo, hi = args.ph_hi;
#ifdef DBG_DUMP
#define IN(k) (lo <= (k) && (k) < hi && (k) <= DBG_DUMP)
#else
#define IN(k) (lo <= (k) && (k) < hi)
#endif
#define SEAM(k) do { if (IN(k) && IN((k) + 1)) xcd_barrier(bar); } while (0)

    if (IN(0)) { PH_BEGIN phase_prep(a, F); }
    SEAM(0);
    for (int l = 0; l < DEPTH; ++l) {
        const int pb = 1 + l * PH_PER_LAYER;
#ifdef DBG_DUMP
        if (l == 0 && lo <= DBG_DUMP + 1 && DBG_DUMP + 1 < hi) { PH_BEGIN dbg_dump(a, F); }
#endif
        if (IN(pb + 0)) { PH_BEGIN
            pg8::Gemm g{(bf16_t*)(ws + WS_XN), (bf16_t*)(ws + WS_WIN), D, D, D}; pg8::StaticOrder S; S.init(T, NINP, F.G, (int)blockIdx.x);
            pg8::EpiInproj E{(const float*)(ws + WS_MISC + 16384), (const float*)(ws + WS_MISC) + l * 512, (bf16_t*)(ws + WS_QO), (bf16_t*)(ws + WS_KV), (bf16_t*)(ws + WS_HB), (bf16_t*)(ws + WS_HG), (bf16_t*)(ws + WS_G), (float*)(ws + WS_LOGF), (float*)(ws + WS_FL)};
            pg8::gemm_phase<pg8::EpiInproj, pg8::StaticOrder, true>(F.lds + RING_OFF, g, S, E, F.tid);
        }
        SEAM(pb + 0);
        if (IN(pb + 1)) { PH_BEGIN
#if !MK_FAST_ATTN
            phase_fscan(a, F);
#endif
#if MK_FAST_HGRN
            phase_hgrn(a, F, l);
#else
            phase_hgrn_naive(a, F, l);
#endif
        }
        SEAM(pb + 1);
        if (IN(pb + 2)) { PH_BEGIN
#if MK_FAST_ATTN
            phase_attn(a, F);
#else
            phase_attn_naive(a, F);
#endif
        }
        SEAM(pb + 2);
        if (IN(pb + 3)) { PH_BEGIN
            pg8::Gemm g{(bf16_t*)(ws + WS_QO), (bf16_t*)(ws + WS_WBR), D, D, 512}; pg8::StaticOrder S; S.init(T, D, F.G, (int)blockIdx.x);
            pg8::EpiGate<1> E{(bf16_t*)(ws + WS_U1), nullptr, (bf16_t*)(ws + WS_G), 2048, nullptr};
            pg8::gemm_phase<pg8::EpiGate<1>, pg8::StaticOrder, true>(F.lds + RING_OFF, g, S, E, F.tid);
        }
        SEAM(pb + 3);
        if (IN(pb + 4)) { PH_BEGIN
            pg8::Gemm g{(bf16_t*)(ws + WS_QO) + 512, (bf16_t*)(ws + WS_WBR) + 512, D, D, 512}; pg8::StaticOrder S; S.init(T, D, F.G, (int)blockIdx.x);
            pg8::EpiGate<2> E{(bf16_t*)(ws + WS_U), nullptr, (bf16_t*)(ws + WS_G) + 1024, 2048, (bf16_t*)(ws + WS_U1)};
            pg8::gemm_phase<pg8::EpiGate<2>, pg8::StaticOrder, true>(F.lds + RING_OFF, g, S, E, F.tid);
        }
        SEAM(pb + 4);
        if (IN(pb + 5)) { PH_BEGIN
            pg8::Gemm g{(bf16_t*)(ws + WS_U), (bf16_t*)(ws + WS_WMIX), D, D, D}; pg8::StaticOrder S; S.init(T, D, F.G, (int)blockIdx.x);
            pg8::EpiGate<0> E{(bf16_t*)(ws + WS_MIXED), a.b_mix + l * D, nullptr, 0, nullptr};
            pg8::gemm_phase<pg8::EpiGate<0>, pg8::StaticOrder, true>(F.lds + RING_OFF, g, S, E, F.tid);
        }
        SEAM(pb + 5);
        if (IN(pb + 6)) { PH_BEGIN phase_ln1_router(a, F, l); }
        SEAM(pb + 6);
        if (IN(pb + 7)) { PH_BEGIN
            moe_table(a, F, l);
            pg8::Gemm g{(bf16_t*)(ws + WS_XN), (bf16_t*)(ws + WS_W13), D, D, D}; pg8::MoeOrder S{F.G, (int)blockIdx.x, 8, tab, (const int*)(ws + WS_LIST), true, (size_t)2048 * D};
            pg8::EpiUp E{(bf16_t*)(ws + WS_H)};
            pg8::gemm_phase<pg8::EpiUp, pg8::MoeOrder, true>(F.lds + RING_OFF, g, S, E, F.tid);
        }
        SEAM(pb + 7);
        if (IN(pb + 8)) { PH_BEGIN
            moe_table(a, F, l);
            pg8::Gemm g{(bf16_t*)(ws + WS_H), (bf16_t*)(ws + WS_W2), D, D, D}; pg8::MoeOrder S{F.G, (int)blockIdx.x, 4, tab, nullptr, false, (size_t)D * D};
            pg8::EpiGate<0> E{(bf16_t*)(ws + WS_Y), nullptr, nullptr, 0, nullptr};
            pg8::gemm_phase<pg8::EpiGate<0>, pg8::MoeOrder, true>(F.lds + RING_OFF, g, S, E, F.tid);
        }
        SEAM(pb + 8);
        if (IN(pb + 9)) { PH_BEGIN
            moe_table(a, F, l);
            phase_combine_ln2(a, F, l);
            if (l + 1 < DEPTH) { __syncthreads(); convert_layer(a, F, l + 1); }
        }
        SEAM(pb + 9);
    }
#undef IN
#undef SEAM
}

extern "C" void kernel_launch(void* const* d_in, const int* in_sizes, int n_in, void* d_out, int out_size, void* d_ws, size_t ws_size, hipStream_t stream) {
    static int grid = 0;
    if (grid == 0) {
        if (n_in != 20 || in_sizes[0] != T * D || out_size != T * D || ws_size < WS_END) { fprintf(stderr, "kernel_launch: unexpected shapes (n_in %d, ws %zu)\n", n_in, ws_size); grid = -1; return; }
        int dev = 0, cus = 0, per_cu = 0;
        if (hipGetDevice(&dev) != hipSuccess || hipDeviceGetAttribute(&cus, hipDeviceAttributeMultiprocessorCount, dev) != hipSuccess) { grid = -1; return; }
        if (hipFuncSetAttribute((const void*)mk_fwd, hipFuncAttributeMaxDynamicSharedMemorySize, LDS_BYTES) != hipSuccess) { fprintf(stderr, "kernel_launch: hipFuncSetAttribute failed\n"); grid = -1; return; }
        if (hipOccupancyMaxActiveBlocksPerMultiprocessor(&per_cu, (const void*)mk_fwd, NWAVES * 64, LDS_BYTES) != hipSuccess || per_cu < 1)
            fprintf(stderr, "kernel_launch: note: occupancy query reports %d workgroups per CU\n", per_cu);
        (void)hipGetLastError();
        grid = cus;
    }
    if (grid < 0) return;
    if (hipMemsetAsync((char*)d_ws + WS_CTL, 0, CTL_BYTES, stream) != hipSuccess) return;
    Args a{};
    a.x = (const float*)d_in[0]; a.ln_in_g = (const float*)d_in[1]; a.ln_in_b = (const float*)d_in[2]; a.w_in = (const float*)d_in[3]; a.b_in = (const float*)d_in[4];
    a.w_fox = (const float*)d_in[5]; a.lbl = (const float*)d_in[6]; a.norm_g = (const float*)d_in[7]; a.w_hgrn = (const float*)d_in[8]; a.w_mix = (const float*)d_in[9];
    a.b_mix = (const float*)d_in[10]; a.ln1_g = (const float*)d_in[11]; a.ln1_b = (const float*)d_in[12]; a.router_w = (const float*)d_in[13]; a.router_b = (const float*)d_in[14];
    a.w1 = (const float*)d_in[15]; a.w3 = (const float*)d_in[16]; a.w2 = (const float*)d_in[17]; a.ln2_g = (const float*)d_in[18]; a.ln2_b = (const float*)d_in[19];
    a.out = (float*)d_out; a.ws = (unsigned char*)d_ws; a.pad = 0;
#if MK_ONE_LAUNCH
    a.ph_lo = 0; a.ph_hi = N_PHASES; a.use_bar = 1;
    hipLaunchKernelGGL(mk_fwd, dim3(grid), dim3(NWAVES * 64), LDS_BYTES, stream, a);
#else
#ifdef DBG_DUMP
    const int np_ = DBG_DUMP + 2;
#else
    const int np_ = N_PHASES;
#endif
    for (int p = 0; p < np_; ++p) { a.ph_lo = p; a.ph_hi = p + 1; a.use_bar = 0;
        hipLaunchKernelGGL(mk_fwd, dim3(grid), dim3(NWAVES * 64), LDS_BYTES, stream, a); }
#endif
    const hipError_t le = hipPeekAtLastError();
    if (le != hipSuccess) fprintf(stderr, "kernel_launch: launch failed: %s\n", hipGetErrorName(le));
}
```

```cpp
#define MK_ONE_LAUNCH 1
#define MK_FAST_ATTN 1
#include <hip/hip_runtime.h>
#include <cstdio>
#include <cstdint>

typedef unsigned short bf16_t;
typedef short bf16x8 __attribute__((ext_vector_type(8)));
typedef float f32x4 __attribute__((ext_vector_type(4)));
typedef float f32x2 __attribute__((ext_vector_type(2)));
typedef unsigned u32x4 __attribute__((ext_vector_type(4)));
typedef unsigned u32x2 __attribute__((ext_vector_type(2)));
#define LAS __attribute__((address_space(3)))
#define GAS __attribute__((address_space(1)))

constexpr int BATCH = 16, SEQ = 2048, T = BATCH * SEQ, D = 1024, DEPTH = 4, NH = 8, HD = 64, NIN = 5640, NINP = 5888, NE = 16;
constexpr float LN_EPS = 1e-5f, RMS_EPS = 1e-6f;
constexpr float ALPHA = 1.681792830507429f;
constexpr float LOG2E = 1.4426950408889634f;
constexpr float C2 = 0.125f * LOG2E;
constexpr int TM = 256;

constexpr size_t MiB = 1u << 20;
constexpr size_t WS_CTL = 0, CTL_BYTES = 1 * MiB;
constexpr size_t WS_MISC = 1 * MiB;
constexpr size_t WS_WIN = 2 * MiB, WS_WBR = 14 * MiB, WS_WMIX = 16 * MiB, WS_W13 = 18 * MiB, WS_W2 = 82 * MiB;
constexpr size_t WS_XRES = 114 * MiB, WS_XN = 242 * MiB, WS_QO = 306 * MiB, WS_KV = 370 * MiB, WS_HB = 434 * MiB, WS_LOGF = 498 * MiB;
constexpr size_t WS_HG = 562 * MiB, WS_G = 594 * MiB, WS_FL = 722 * MiB, WS_F2 = 723 * MiB, WS_U1 = 724 * MiB, WS_U = 788 * MiB, WS_MIXED = 852 * MiB;
constexpr size_t WS_LIST = 916 * MiB, WS_TOK = 918 * MiB, WS_END = 919 * MiB;
constexpr size_t WS_H = WS_QO, WS_Y = 442 * MiB;
constexpr int CW_CNT = 1024;
constexpr int CW_BAR = 4096;

__device__ __forceinline__ unsigned f2bf(float f) { unsigned u = __builtin_bit_cast(unsigned, f); return (u + 0x7fffu + ((u >> 16) & 1u)) >> 16; }
__device__ __forceinline__ float bf2f(unsigned h) { return __builtin_bit_cast(float, h << 16); }
__device__ __forceinline__ float bflo(unsigned w) { return __builtin_bit_cast(float, w << 16); }
__device__ __forceinline__ float bfhi(unsigned w) { return __builtin_bit_cast(float, w & 0xffff0000u); }
__device__ __forceinline__ unsigned pk2(float lo, float hi) { return f2bf(lo) | (f2bf(hi) << 16); }
__device__ __forceinline__ float wave_sum(float v) {
#pragma unroll
    for (int o = 1; o < 64; o <<= 1) v += __shfl_xor(v, o);
    return v;
}
__device__ __forceinline__ float wave_max(float v) {
#pragma unroll
    for (int o = 1; o < 64; o <<= 1) v = fmaxf(v, __shfl_xor(v, o));
    return v;
}
__device__ __forceinline__ float fast_exp(float v) { return __builtin_amdgcn_exp2f(v * LOG2E); }
__device__ __forceinline__ float sigmoidf_(float v) { return __builtin_amdgcn_rcpf(1.0f + fast_exp(-v)); }
__device__ __forceinline__ float siluf_(float v) { return v * sigmoidf_(v); }
__device__ __forceinline__ float logsigmoidf_(float v) { return fminf(v, 0.f) - __logf(1.0f + fast_exp(-fabsf(v))); }

namespace pg8 {
constexpr int BM = 256, BK = 64, HALF = 128, HTB = HALF * BK * 2  , STAGE_BYTES = 8 * HTB, NXCD = 8, WGM = 8;
__host__ __device__ __forceinline__ int lds_byte(int r, int c) { const int st = (r >> 4) * 2 + (c >> 5), rr = r & 15, cc = c & 31, ob = rr * 64 + cc * 2; return st * 1024 + (ob ^ (((ob >> 9) & 1) << 5)); }
__host__ __device__ __forceinline__ void stage_rc(int b, int& R, int& C) { const int st = b / 1024, sb = b % 1024, swz = sb ^ (((sb >> 9) & 1) << 5); R = (st >> 1) * 16 + swz / 64; C = (st & 1) * 32 + (swz % 64) / 2; }
__host__ __device__ __forceinline__ int perm32(int rho) { const int n = rho >> 4, i = rho & 15; return 8 * (i >> 2) + 4 * n + (i & 3); }

struct Unit { int pm, pn, e; };
struct Gemm { const bf16_t* A; const bf16_t* Bt; int lda, ldb, K; };

struct StaticOrder {
    int nM, nN, nwg, G, c;
    __device__ void init(int M, int N, int G_, int c_) { nM = M / BM; nN = N / BM; nwg = nM * nN; G = G_; c = c_; }
    __device__ bool next(int i, Unit& u) const {
        const long L = (long)i * G + c; if (L >= nwg) return false;
        int wgid = (int)L; { const int q = nwg / NXCD, r = nwg % NXCD, xcd = wgid % NXCD, off = wgid / NXCD; wgid = (xcd < r ? xcd * (q + 1) : r * (q + 1) + (xcd - r) * q) + off; }
        const int nig = WGM * nN, gid = wgid / nig, fm = gid * WGM, gsz = (nM - fm) < WGM ? (nM - fm) : WGM;
        u.pm = fm + ((wgid % nig) % gsz); u.pn = (wgid % nig) / gsz; u.e = 0; return true;
    }
    __device__ __forceinline__ const char* a_tile(const Gemm& g, const Unit& u) const { return (const char*)g.A + (size_t)u.pm * BM * g.lda * 2; }
    __device__ __forceinline__ const char* b_tile(const Gemm& g, const Unit& u) const { return (const char*)g.Bt + (size_t)u.pn * BM * g.ldb * 2; }
    __device__ __forceinline__ void a_voff(const Gemm& g, const Unit&, const int (&R)[2], const int (&C)[2], unsigned (&v)[2][2]) const {
#pragma unroll
        for (int h = 0; h < 2; ++h)
#pragma unroll
            for (int i = 0; i < 2; ++i) v[h][i] = (unsigned)((h * HALF + R[i]) * g.lda + C[i]) * 2u;
    }
};
struct MoeOrder {
    int G, c, nN; const LAS int* tab; const int* list; bool gather; size_t bstride;
    __device__ bool next(int i, Unit& u) const {
        const int L = i * G + c; const int rt = L / nN; const int NT = tab[NE]; if (rt >= NT) return false;
        int e = 0;
#pragma unroll
        for (int k = 1; k < NE; ++k) e += (rt >= tab[k]) ? 1 : 0;
        u.pm = __builtin_amdgcn_readfirstlane(rt); u.pn = __builtin_amdgcn_readfirstlane(L % nN); u.e = __builtin_amdgcn_readfirstlane(e); return true;
    }
    __device__ __forceinline__ const char* a_tile(const Gemm& g, const Unit& u) const { return gather ? (const char*)g.A : (const char*)g.A + (size_t)u.pm * BM * g.lda * 2; }
    __device__ __forceinline__ const char* b_tile(const Gemm& g, const Unit& u) const { return (const char*)g.Bt + ((size_t)u.e * bstride + (size_t)u.pn * BM * g.ldb) * 2; }
    __device__ __forceinline__ void a_voff(const Gemm& g, const Unit& u, const int (&R)[2], const int (&C)[2], unsigned (&v)[2][2]) const {
        const int ts = tab[u.e], cn = tab[NE + 1 + u.e];
#pragma unroll
        for (int h = 0; h < 2; ++h)
#pragma unroll
            for (int i = 0; i < 2; ++i) {
                if (gather) { const int pos = (u.pm - ts) * BM + h * HALF + R[i]; const int tok = (pos < cn) ? list[u.e * T + pos] : 0; v[h][i] = (unsigned)(tok * g.lda + C[i]) * 2u; }
                else v[h][i] = (unsigned)((h * HALF + R[i]) * g.lda + C[i]) * 2u;
            }
    }
};

typedef __bf16 bf16x2_t __attribute__((ext_vector_type(2)));
__device__ __forceinline__ unsigned cvt_pk_bf16(float lo, float hi) { f32x2 v = {lo, hi}; bf16x2_t b = __builtin_convertvector(v, bf16x2_t); return __builtin_bit_cast(unsigned, b); }
__device__ __forceinline__ u32x4 pack8(const f32x4& v0, const f32x4& v1) { u32x4 w; w.x = cvt_pk_bf16(v0[0], v0[1]); w.y = cvt_pk_bf16(v0[2], v0[3]); w.z = cvt_pk_bf16(v1[0], v1[1]); w.w = cvt_pk_bf16(v1[2], v1[3]); return w; }
__device__ __forceinline__ void unpack8(const u32x4& w, f32x4& v0, f32x4& v1) { v0[0] = bflo(w.x); v0[1] = bfhi(w.x); v0[2] = bflo(w.y); v0[3] = bfhi(w.y); v1[0] = bflo(w.z); v1[1] = bfhi(w.z); v1[2] = bflo(w.w); v1[3] = bfhi(w.w); }
__device__ __forceinline__ f32x4 sig4(const f32x4& v) { f32x4 o; o[0] = sigmoidf_(v[0]); o[1] = sigmoidf_(v[1]); o[2] = sigmoidf_(v[2]); o[3] = sigmoidf_(v[3]); return o; }

struct EpiInproj {
    static constexpr bool PERM = true;
    unsigned char* ws; int layer;
    template <int KIND> __device__ __forceinline__ void tile(const f32x4 (&acc)[2][2][4][2], const Unit& u, int wr, int wc, int fr, int fq, unsigned char* w) const {
        const float* biasp = (const float*)(w + WS_MISC + 16384);
        const int row0 = u.pm * BM + wr * 64 + fr, bcol0 = u.pn * BM + wc * 32 + 8 * fq;
        f32x4 bv[2][2];
#pragma unroll
        for (int bj = 0; bj < 2; ++bj)
#pragma unroll
            for (int n = 0; n < 2; ++n) bv[bj][n] = *(const f32x4*)(biasp + bcol0 + bj * HALF + 4 * n);
#pragma unroll
        for (int ai = 0; ai < 2; ++ai)
#pragma unroll
            for (int m = 0; m < 4; ++m) { const size_t row = (size_t)(row0 + ai * HALF + m * 16);
#pragma unroll
                for (int bj = 0; bj < 2; ++bj) { f32x4 v0 = acc[ai][bj][m][0] + bv[bj][0], v1 = acc[ai][bj][m][1] + bv[bj][1]; const int col = bcol0 + bj * HALF;
                    if (KIND == 0) { *(u32x4*)((bf16_t*)(w + WS_QO) + row * 1024 + col) = pack8(v0 * C2, v1 * C2); }
                    else if (KIND == 1) { *(u32x4*)((bf16_t*)(w + WS_KV) + row * 1024 + (col - 512)) = pack8(v0, v1); }
                    else if (KIND == 2) { *(u32x4*)((bf16_t*)(w + WS_KV) + row * 1024 + 512 + (col - 1024)) = pack8(v0, v1); }
                    else if (KIND == 3) { *(u32x4*)((bf16_t*)(w + WS_HB) + row * 1024 + (col - 1536)) = pack8(v0 * sig4(v0), v1 * sig4(v1)); }
                    else if (KIND == 4) { const int c = col - 2048; const float* lb = (const float*)(w + WS_MISC) + layer * 512; const f32x4 l0 = *(const f32x4*)(lb + c), l1 = *(const f32x4*)(lb + c + 4);
                        f32x4 f0 = l0 + (1.f - l0) * sig4(v0), f1 = l1 + (1.f - l1) * sig4(v1);
#pragma unroll
                        for (int q = 0; q < 4; ++q) { f0[q] = __logf(f0[q]); f1[q] = __logf(f1[q]); }
                        float* LOGF = (float*)(w + WS_LOGF); *(f32x4*)(LOGF + row * 512 + c) = f0; *(f32x4*)(LOGF + row * 512 + c + 4) = f1; }
                    else if (KIND == 5) { *(u32x4*)((bf16_t*)(w + WS_HB) + row * 1024 + 512 + (col - 2560)) = pack8(v0, v1); }
                    else if (KIND == 6) { *(u32x4*)((bf16_t*)(w + WS_HG) + row * 512 + (col - 3072)) = pack8(v0 * sig4(v0), v1 * sig4(v1)); }
                    else if (KIND == 7) { *(u32x4*)((bf16_t*)(w + WS_G) + row * 2048 + (col - 3584)) = pack8(sig4(v0), sig4(v1)); }
                    else { if (col == 5632) { f32x4 f0, f1;
#pragma unroll
                            for (int q = 0; q < 4; ++q) { f0[q] = logsigmoidf_(v0[q]); f1[q] = logsigmoidf_(v1[q]); }
                            float* FL = (float*)(w + WS_FL); *(f32x4*)(FL + row * 8) = f0; *(f32x4*)(FL + row * 8 + 4) = f1; } }
                } }
    }
    __device__ __forceinline__ void operator()(const f32x4 (&acc)[2][2][4][2], const Unit& u, int wr, int wc, int fr, int fq) const {
        size_t z_ = 0; asm volatile("" : "+s"(z_)); unsigned char* w = ws + z_;
        const int ct = u.pn;
        if (ct < 2) tile<0>(acc, u, wr, wc, fr, fq, w); else if (ct < 4) tile<1>(acc, u, wr, wc, fr, fq, w); else if (ct < 6) tile<2>(acc, u, wr, wc, fr, fq, w);
        else if (ct < 8) tile<3>(acc, u, wr, wc, fr, fq, w); else if (ct < 10) tile<4>(acc, u, wr, wc, fr, fq, w); else if (ct < 12) tile<5>(acc, u, wr, wc, fr, fq, w);
        else if (ct < 14) tile<6>(acc, u, wr, wc, fr, fq, w); else if (ct < 22) tile<7>(acc, u, wr, wc, fr, fq, w); else tile<8>(acc, u, wr, wc, fr, fq, w);
    }
};
template <int MODE> struct EpiGate {
    static constexpr bool PERM = true;
    bf16_t* O; const float* bias; const bf16_t* Gt; int ldg; const bf16_t* P;
    __device__ __forceinline__ void operator()(const f32x4 (&acc)[2][2][4][2], const Unit& u, int wr, int wc, int fr, int fq) const {
        const int row0 = u.pm * BM + wr * 64 + fr, col0 = u.pn * BM + wc * 32 + 8 * fq;
        f32x4 bv[2][2];
        if (MODE == 0) {
#pragma unroll
            for (int bj = 0; bj < 2; ++bj)
#pragma unroll
                for (int n = 0; n < 2; ++n) bv[bj][n] = bias ? *(const f32x4*)(bias + col0 + bj * HALF + 4 * n) : (f32x4){0.f, 0.f, 0.f, 0.f};
        }
#pragma unroll
        for (int ai = 0; ai < 2; ++ai)
#pragma unroll
            for (int mh = 0; mh < 2; ++mh) {
                u32x4 gq[2][2], pq[2][2];
                if (MODE != 0) {
#pragma unroll
                    for (int mm = 0; mm < 2; ++mm)
#pragma unroll
                        for (int bj = 0; bj < 2; ++bj) { const size_t row = (size_t)(row0 + ai * HALF + (mh * 2 + mm) * 16); const int col = col0 + bj * HALF;
                            gq[mm][bj] = *(const u32x4*)(Gt + row * ldg + col);
                            if (MODE == 2) pq[mm][bj] = *(const u32x4*)(P + row * 1024 + col); }
                    asm volatile("s_waitcnt vmcnt(0)" ::: "memory");
                }
#pragma unroll
                for (int mm = 0; mm < 2; ++mm)
#pragma unroll
                    for (int bj = 0; bj < 2; ++bj) { const int m = mh * 2 + mm; const size_t row = (size_t)(row0 + ai * HALF + m * 16); const int col = col0 + bj * HALF;
                        f32x4 v0 = acc[ai][bj][m][0], v1 = acc[ai][bj][m][1];
                        if (MODE == 0) { v0 += bv[bj][0]; v1 += bv[bj][1]; }
                        else { f32x4 g0, g1; unpack8(gq[mm][bj], g0, g1); v0 *= g0; v1 *= g1;
                            if (MODE == 2) { f32x4 p0, p1; unpack8(pq[mm][bj], p0, p1); v0 += p0; v1 += p1; } }
                        *(u32x4*)(O + row * 1024 + col) = pack8(v0, v1); }
                if (MODE != 0) asm volatile("" ::: "memory");
            }
    }
};
struct EpiUp {
    static constexpr bool PERM = true;
    bf16_t* H;
    __device__ __forceinline__ void operator()(const f32x4 (&acc)[2][2][4][2], const Unit& u, int wr, int wc, int fr, int fq) const {
        const int row0 = u.pm * BM + wr * 64 + fr, col = u.pn * HALF + wc * 32 + 8 * fq;
#pragma unroll
        for (int ai = 0; ai < 2; ++ai)
#pragma unroll
            for (int m = 0; m < 4; ++m) { const size_t row = (size_t)(row0 + ai * HALF + m * 16);
                const f32x4 a0 = acc[ai][0][m][0], a1 = acc[ai][0][m][1], b0 = acc[ai][1][m][0], b1 = acc[ai][1][m][1];
                *(u32x4*)(H + row * 1024 + col) = pack8(a0 * sig4(a0) * b0, a1 * sig4(a1) * b1); }
    }
};

template <class Epi, class Sched, bool ALIGN_EPI>
__device__ __forceinline__ void gemm_phase(LAS unsigned char* lds, const Gemm g, const Sched& S, const Epi& E, const int tid) {
    const int wid = __builtin_amdgcn_readfirstlane(tid >> 6), lane = tid & 63, wr = wid >> 2, wc = wid & 3, fr = lane & 15, fq = lane >> 4;
    const int K = g.K, nt = K / BK;
    int RA[2], CA[2]; unsigned voffB[2];
#pragma unroll
    for (int i = 0; i < 2; ++i) { int R, C; stage_rc(tid * 16 + i * 8192, R, C); const int Rb = Epi::PERM ? ((R & ~31) + perm32(R & 31)) : R;
        RA[i] = R; CA[i] = C; voffB[i] = (unsigned)(Rb * g.ldb + C) * 2u; }
    const size_t kstep = (size_t)(BK * 2);
    const size_t hstepB = (size_t)HALF * g.ldb * 2;
    const unsigned ldsw = (unsigned)wid * 1024u;
    const int aoff = lds_byte(wr * 64 + fr, fq * 8), boff = lds_byte(wc * 32 + fr, fq * 8);
#define PG8_SA(b, h) (((b) * 2 + (h)) * HTB)
#define PG8_SB(b, h) ((4 + (b) * 2 + (h)) * HTB)
#define PG8_STAGE(bufoff, gbase, voff) do { _Pragma("unroll") for (int _i = 0; _i < 2; ++_i) \
        __builtin_amdgcn_global_load_lds((const unsigned*)((const char*)(gbase) + (voff)[_i]), (LAS unsigned*)(lds + (bufoff) + ldsw + _i * 8192), 16, 0, 0); } while (0)
#define PG8_LDA(dst, b, h) do { _Pragma("unroll") for (int m = 0; m < 4; ++m) _Pragma("unroll") for (int k = 0; k < 2; ++k) dst[m][k] = *(const LAS bf16x8*)(lds + PG8_SA(b, h) + aoff + m * 2048 + k * 1024); } while (0)
#define PG8_LDB(dst, b, h) do { _Pragma("unroll") for (int n = 0; n < 2; ++n) _Pragma("unroll") for (int k = 0; k < 2; ++k) dst[n][k] = *(const LAS bf16x8*)(lds + PG8_SB(b, h) + boff + n * 2048 + k * 1024); } while (0)
#define PG8_MMA(ai, bj, At, Bt) do { __builtin_amdgcn_s_setprio(1); _Pragma("unroll") for (int m = 0; m < 4; ++m) _Pragma("unroll") for (int n = 0; n < 2; ++n) _Pragma("unroll") for (int k = 0; k < 2; ++k) \
        acc[ai][bj][m][n] = __builtin_amdgcn_mfma_f32_16x16x32_bf16(Bt[n][k], At[m][k], acc[ai][bj][m][n], 0, 0, 0); __builtin_amdgcn_s_setprio(0); } while (0)
#define PG8_WAIT_V(n) asm volatile("s_waitcnt vmcnt(" #n ")" ::: "memory")
#define PG8_WAIT_L(n) asm volatile("s_waitcnt lgkmcnt(" #n ")" ::: "memory")
#define PG8_BAR __builtin_amdgcn_s_barrier()
#define PG8_SCHED __builtin_amdgcn_sched_barrier(0)
    Unit cur, nxt; int ui = 0;
    if (!S.next(0, cur)) return;
    f32x4 acc[2][2][4][2];
#pragma unroll
    for (int a = 0; a < 2; ++a)
#pragma unroll
        for (int b = 0; b < 2; ++b)
#pragma unroll
            for (int m = 0; m < 4; ++m)
#pragma unroll
                for (int n = 0; n < 2; ++n) acc[a][b][m][n] = (f32x4){0.f, 0.f, 0.f, 0.f};
    bf16x8 At[4][2], B0[2][2], B1[2][2];
    unsigned vA[2][2], nvA[2][2];
    S.a_voff(g, cur, RA, CA, vA);
    const char* cA = S.a_tile(g, cur); const char* cB = S.b_tile(g, cur);
    PG8_STAGE(PG8_SB(0, 0), cB, voffB); PG8_STAGE(PG8_SB(0, 1), cB + hstepB, voffB); PG8_STAGE(PG8_SA(0, 0), cA, vA[0]); PG8_STAGE(PG8_SA(0, 1), cA, vA[1]);
    if (wr == 1) PG8_BAR;
    PG8_WAIT_V(2); PG8_BAR;
    PG8_STAGE(PG8_SB(1, 0), cB + kstep, voffB); PG8_STAGE(PG8_SA(1, 0), cA + kstep, vA[0]); PG8_STAGE(PG8_SB(1, 1), cB + hstepB + kstep, voffB);
    PG8_WAIT_V(6); PG8_BAR;
    for (;;) {
        const bool has_next = S.next(ui + 1, nxt);
        const char* nA = has_next ? S.a_tile(g, nxt) : cA; const char* nB = has_next ? S.b_tile(g, nxt) : cB;
        if (has_next) S.a_voff(g, nxt, RA, CA, nvA);
        else {
#pragma unroll
            for (int h = 0; h < 2; ++h)
#pragma unroll
                for (int i = 0; i < 2; ++i) nvA[h][i] = vA[h][i]; }
        for (int t = 0; t < nt; t += 2) {
            const bool last = (t == nt - 2);
            const char* a1 = cA + (size_t)(t + 1) * kstep;
            const char* a2 = last ? nA : cA + (size_t)(t + 2) * kstep; const char* b2 = last ? nB : cB + (size_t)(t + 2) * kstep;
            const char* a3 = a2 + kstep; const char* b3 = b2 + kstep;
            unsigned wA0[2], wA1[2];
#pragma unroll
            for (int i = 0; i < 2; ++i) { wA0[i] = last ? nvA[0][i] : vA[0][i]; wA1[i] = last ? nvA[1][i] : vA[1][i]; }
            PG8_LDB(B0, 0, 0); PG8_LDB(B1, 0, 1); PG8_SCHED; PG8_LDA(At, 0, 0); PG8_STAGE(PG8_SA(1, 1), a1, vA[1]);
            PG8_WAIT_V(8); PG8_WAIT_L(0); PG8_BAR; PG8_MMA(0, 0, At, B0); PG8_MMA(0, 1, At, B1); PG8_BAR; PG8_SCHED;
            PG8_LDA(At, 0, 1); PG8_STAGE(PG8_SB(0, 0), b2, voffB); PG8_STAGE(PG8_SB(0, 1), b2 + hstepB, voffB); PG8_STAGE(PG8_SA(0, 0), a2, wA0);
            PG8_WAIT_V(8); PG8_WAIT_L(0); PG8_BAR; PG8_MMA(1, 0, At, B0); PG8_MMA(1, 1, At, B1); PG8_BAR; PG8_SCHED;
            PG8_LDB(B0, 1, 0); PG8_LDB(B1, 1, 1); PG8_SCHED; PG8_LDA(At, 1, 0); PG8_STAGE(PG8_SA(0, 1), a2, wA1);
            PG8_WAIT_V(8); PG8_WAIT_L(0); PG8_BAR; PG8_MMA(0, 0, At, B0); PG8_MMA(0, 1, At, B1); PG8_BAR; PG8_SCHED;
            PG8_LDA(At, 1, 1); PG8_STAGE(PG8_SB(1, 0), b3, voffB); PG8_STAGE(PG8_SB(1, 1), b3 + hstepB, voffB); PG8_STAGE(PG8_SA(1, 0), a3, wA0);
            PG8_WAIT_V(8); PG8_WAIT_L(0); PG8_BAR; PG8_MMA(1, 0, At, B0); PG8_MMA(1, 1, At, B1); PG8_BAR; PG8_SCHED;
        }
        if constexpr (ALIGN_EPI) { if (wr == 0) PG8_BAR; }
        E(acc, cur, wr, wc, fr, fq);
        if (!has_next) break;
#pragma unroll
        for (int a = 0; a < 2; ++a)
#pragma unroll
            for (int b = 0; b < 2; ++b)
#pragma unroll
                for (int m = 0; m < 4; ++m)
#pragma unroll
                    for (int n = 0; n < 2; ++n) acc[a][b][m][n] = (f32x4){0.f, 0.f, 0.f, 0.f};
        cur = nxt; cA = nA; cB = nB; ++ui;
#pragma unroll
        for (int h = 0; h < 2; ++h)
#pragma unroll
            for (int i = 0; i < 2; ++i) vA[h][i] = nvA[h][i];
        if constexpr (ALIGN_EPI) { if (wr == 1) PG8_BAR; }
    }
    PG8_WAIT_V(0);
    if constexpr (!ALIGN_EPI) { if (wr == 0) PG8_BAR; }
    PG8_BAR;
#undef PG8_SA
#undef PG8_SB
#undef PG8_STAGE
#undef PG8_LDA
#undef PG8_LDB
#undef PG8_MMA
#undef PG8_WAIT_V
#undef PG8_WAIT_L
#undef PG8_BAR
#undef PG8_SCHED
}
}


#include <hip/hip_bf16.h>
#include <cmath>
namespace attn_body {
using bf16=__hip_bfloat16;
using bf16x8=__attribute__((ext_vector_type(8)))short;
using s16x4=__attribute__((ext_vector_type(4)))short;
using f32x16=__attribute__((ext_vector_type(16)))float;
using u32x4=__attribute__((ext_vector_type(4)))unsigned;
constexpr int BATCH=16,NHEAD=8,SEQ=2048,D=64,DM=1024;
constexpr int NW=8,QBLK=32,QB=QBLK*NW,KVBLK=64,NQB=SEQ/QB;
constexpr int ATTN_PITCH=DM, ATTN_UNIT_ROWS=QB;
__device__ __forceinline__ int crow(int r,int hi){return (r&3)+8*(r>>2)+4*hi;}
#define SBAR() __builtin_amdgcn_sched_barrier(0)
__device__ __forceinline__ void cmask(f32x16&p0,f32x16&p1,int jb,int qrel,int hi){
  const float NEG=-INFINITY; int kb=64*jb+4*hi;
  #pragma unroll
  for(int r=0;r<16;++r){int kv=kb+(r&3)+8*(r>>2); if(kv>qrel)p0[r]=NEG; if(kv+32>qrel)p1[r]=NEG;}
}

constexpr int NSLOT=3, SLOTB=8192;
constexpr int LDS_K=0, LDS_V=NSLOT*SLOTB, LDS_WS=2*NSLOT*SLOTB, LDS_OST=LDS_WS+NW*64*4, LDS_BYTES=LDS_OST+NW*4096;
constexpr float C2=0.125f*1.4426950408889634f;
__device__ __forceinline__ void glds16(const void*gsrc,unsigned lds_dst){unsigned keep;
  asm volatile("s_mov_b32 %0, m0\n\ts_mov_b32 m0, %2\n\ts_nop 0\n\tglobal_load_lds_dwordx4 %1, off\n\ts_mov_b32 m0, %0":"=&s"(keep):"v"(gsrc),"s"(lds_dst):"memory");}
__device__ __forceinline__ float max3f(float a,float b,float c){float r;asm("v_max3_f32 %0, %1, %2, %3":"=v"(r):"v"(a),"v"(b),"v"(c));return r;}
__device__ __forceinline__ float max2f(float a,float b){float r;asm("v_max_f32_e32 %0, %1, %2":"=v"(r):"v"(a),"v"(b));return r;}
__device__ __forceinline__ float fadd_s(float a,float b){float r;asm("v_add_f32_e32 %0, %1, %2":"=v"(r):"v"(a),"v"(b));return r;}
__device__ __forceinline__ float fsub_s(float a,float b){float r;asm("v_sub_f32_e32 %0, %1, %2":"=v"(r):"v"(a),"v"(b));return r;}
typedef float f32x2_t __attribute__((ext_vector_type(2))); typedef __bf16 bf16x2_t __attribute__((ext_vector_type(2)));
__device__ __forceinline__ unsigned cvtpk_s(float lo,float hi){f32x2_t v={lo,hi};bf16x2_t b=__builtin_convertvector(v,bf16x2_t);return __builtin_bit_cast(unsigned,b);}
#define WAIT_BAR(N) asm volatile("s_waitcnt vmcnt(" #N ") lgkmcnt(0)\n\ts_barrier":::"memory")

__device__ __forceinline__ void qkt(f32x16&p0,f32x16&p1,const char*Kslot,const bf16x8*qr,const f32x16&negm,int r32,int hi){
  const char*kb=Kslot+hi*1024+r32*16;
  #pragma unroll
  for(int d0=0;d0<4;++d0){
    const bf16x8 b0=*reinterpret_cast<const bf16x8*>(kb+d0*2048);
    const bf16x8 b1=*reinterpret_cast<const bf16x8*>(kb+d0*2048+512);
    if(d0==0){p0=__builtin_amdgcn_mfma_f32_32x32x16_bf16(b0,qr[0],negm,0,0,0);p1=__builtin_amdgcn_mfma_f32_32x32x16_bf16(b1,qr[0],negm,0,0,0);}
    else{p0=__builtin_amdgcn_mfma_f32_32x32x16_bf16(b0,qr[d0],p0,0,0,0);p1=__builtin_amdgcn_mfma_f32_32x32x16_bf16(b1,qr[d0],p1,0,0,0);}}
}
typedef __attribute__((address_space(3))) const char* lds_cptr;
typedef short v4i16_t __attribute__((ext_vector_type(4)));
__device__ __forceinline__ void kload8(bf16x8*kf,lds_cptr kp){
  kf[0]=*(const __attribute__((address_space(3))) bf16x8*)(kp);      kf[1]=*(const __attribute__((address_space(3))) bf16x8*)(kp+512);
  kf[2]=*(const __attribute__((address_space(3))) bf16x8*)(kp+2048); kf[3]=*(const __attribute__((address_space(3))) bf16x8*)(kp+2560);
  kf[4]=*(const __attribute__((address_space(3))) bf16x8*)(kp+4096); kf[5]=*(const __attribute__((address_space(3))) bf16x8*)(kp+4608);
  kf[6]=*(const __attribute__((address_space(3))) bf16x8*)(kp+6144); kf[7]=*(const __attribute__((address_space(3))) bf16x8*)(kp+6656);
}
__device__ __forceinline__ void kload2(bf16x8*kf,lds_cptr kp,int j){ kf[2*j]=*(const __attribute__((address_space(3))) bf16x8*)(kp+j*2048); kf[2*j+1]=*(const __attribute__((address_space(3))) bf16x8*)(kp+j*2048+512); }
__device__ __forceinline__ s16x4 vtr(lds_cptr p){ return __builtin_bit_cast(s16x4,__builtin_amdgcn_ds_read_tr16_b64_v4i16((__attribute__((address_space(3))) v4i16_t*)p)); }
__device__ __forceinline__ float rowmax(const f32x16&p0,const f32x16&p1){
  float a=max3f(p0[0],p0[1],p1[0]),b=max3f(p0[2],p0[3],p1[1]);a=max3f(a,p1[2],p1[3]);
  #pragma unroll
  for(int r=4;r<16;r+=4){a=max3f(a,p0[r],p0[r+1]);b=max3f(b,p0[r+2],p0[r+3]);a=max3f(a,p1[r],p1[r+1]);b=max3f(b,p1[r+2],p1[r+3]);}
  const float m=max2f(a,b);
  auto rr=__builtin_amdgcn_permlane32_swap(__float_as_uint(m),__float_as_uint(m),false,false);
  return max2f(__uint_as_float(rr[0]),__uint_as_float(rr[1]));
}
__device__ __forceinline__ void pv(f32x16*o,int vb,bf16x8 pa0,bf16x8 pa1,bf16x8 pa2,bf16x8 pa3){
  #pragma unroll
  for(int d0=0;d0<2;++d0){s16x4 lo[4],hi[4];
    #pragma unroll
    for(int ks=0;ks<4;++ks){
      asm volatile("ds_read_b64_tr_b16 %0,%1 offset:%c2":"=&v"(lo[ks]):"v"(vb),"i"(d0*4096+ks*1024):"memory");
      asm volatile("ds_read_b64_tr_b16 %0,%1 offset:%c2":"=&v"(hi[ks]):"v"(vb),"i"(d0*4096+ks*1024+512):"memory");}
    asm volatile("s_waitcnt lgkmcnt(0)":::"memory");SBAR();
    #define PK(k) (bf16x8){lo[k][0],lo[k][1],lo[k][2],lo[k][3],hi[k][0],hi[k][1],hi[k][2],hi[k][3]}
    o[d0]=__builtin_amdgcn_mfma_f32_32x32x16_bf16(pa0,PK(0),o[d0],0,0,0);
    o[d0]=__builtin_amdgcn_mfma_f32_32x32x16_bf16(pa1,PK(1),o[d0],0,0,0);
    o[d0]=__builtin_amdgcn_mfma_f32_32x32x16_bf16(pa2,PK(2),o[d0],0,0,0);
    o[d0]=__builtin_amdgcn_mfma_f32_32x32x16_bf16(pa3,PK(3),o[d0],0,0,0);
    #undef PK
  }
}

#ifndef ATTN_STORE16
#define ATTN_STORE16(p,v) (*(u32x4*)(p)=(v))
#endif
template<int THRL> __device__ __forceinline__ void attn_unit(int b,int h,int qb,const bf16*Q,const bf16*__restrict__ K,const bf16*__restrict__ V,bf16*O,char*shm,const __attribute__((address_space(3))) float*f2,const int tid){
  #define BIAS_H(P,off,g0) { f32x4 x_[2]; _Pragma("unroll") for(int g_=0;g_<2;++g_) x_[g_]=*(const __attribute__((address_space(3))) f32x4*)(fb_+(off)+8*((g0)+g_)); \
      _Pragma("unroll") for(int g_=0;g_<2;++g_) _Pragma("unroll") for(int i_=0;i_<4;++i_) P[4*((g0)+g_)+i_]-=x_[g_][i_]; asm volatile("":::"memory"); }
  #define BIAS(P0,P1,t) do{ const __attribute__((address_space(3))) float* fb_=f2+64*(t)+4*hi; \
    BIAS_H(P0,0,0) BIAS_H(P0,0,2) BIAS_H(P1,32,0) BIAS_H(P1,32,2) }while(0)
  const int lane=tid&63,r32=lane&31,hi=lane>>5; const int wid=__builtin_amdgcn_readfirstlane(tid>>6);
  const long rowbase=(long)b*SEQ; const int q0=qb*QB;
  const bf16*Qw=Q+(rowbase+q0+wid*QBLK)*DM+h*D;
  const bf16*Kh=K+rowbase*DM+h*D,*Vh=V+rowbase*DM+h*D;
  const unsigned lds0=(unsigned)(uintptr_t)shm;
  float*wsf=(float*)(shm+LDS_WS)+wid*64;
  const bf16*ksrc=Kh+(long)lane*DM+wid*8;
  const bf16*vsrc=Vh+(long)(16*(wid&3)+(lane>>2))*DM+(wid>>2)*32+(lane&3)*8;
  const unsigned kdst=lds0+LDS_K+wid*1024, vdst=lds0+LDS_V+wid*1024;
  #define DMA_K(t,slot) glds16(ksrc+(long)(t)*KVBLK*DM,(unsigned)__builtin_amdgcn_readfirstlane(kdst+(slot)))
  #define DMA_V(t,slot) glds16(vsrc+(long)(t)*KVBLK*DM,(unsigned)__builtin_amdgcn_readfirstlane(vdst+(slot)))
  const int vb0=(int)(lds0+LDS_V)+((lane>>4)&1)*32+(lane&3)*8+(4*hi+((lane&15)>>2))*64;
  const char*Kbase=shm+LDS_K; bf16x8 kf[8];
  const lds_cptr shm3=(lds_cptr)shm; const lds_cptr kp0=shm3+LDS_K+hi*1024+r32*16; const lds_cptr vp0=shm3+LDS_V+((lane>>4)&1)*32+(lane&3)*8+(4*hi+((lane&15)>>2))*64;
  const int NT=(q0+QB)/KVBLK;
  DMA_K(0,0);DMA_V(0,0);DMA_K(1,SLOTB);
  bf16x8 qr[4];
  #pragma unroll
  for(int d0=0;d0<4;++d0)qr[d0]=*reinterpret_cast<const bf16x8*>(&Qw[(long)r32*DM+d0*16+hi*8]);
  float mhat=0.f,l_reg=0.f;f32x16 o[2];f32x16 negm; { float z_=0.f; asm volatile("":"+v"(z_)); _Pragma("unroll") for(int r=0;r<16;++r){o[0][r]=z_;o[1][r]=z_;negm[r]=z_;} } asm volatile("":"+v"(negm));
  const int qrel=wid*QBLK+r32;
  #define CMASK(P0,P1,t) do{int jb_=(t)-(NT-4); if(jb_>=0)cmask(P0,P1,jb_,qrel,hi);}while(0)
  bool resc=false;
  #define START(P0,P1) do{ const float rm=rowmax(P0,P1); resc=false; \
    { const float dl=rm; mhat=fadd_s(mhat,dl); \
      _Pragma("unroll") for(int r=0;r<16;++r){P0[r]=fsub_s(P0[r],dl);P1[r]=fsub_s(P1[r],dl);} \
      _Pragma("unroll") for(int r=0;r<16;++r)negm[r]=-mhat; asm volatile("":"+v"(negm)); } \
    _Pragma("unroll") for(int r=0;r<16;++r)P0[r]=__builtin_amdgcn_exp2f(P0[r]); }while(0)
  #define RESC() do{ if(resc){ asm volatile("s_waitcnt lgkmcnt(0)":::"memory"); \
      _Pragma("unroll") for(int d_=0;d_<2;++d_) _Pragma("unroll") for(int r=0;r<16;++r)o[d_][r]*=wsf[crow(r,hi)]; } }while(0)
  f32x16 pA0,pA1,pB0,pB1;
  int sl_prev=0,sl_cur=0,sl_next=SLOTB;
  #define ROT() do{sl_prev=sl_cur;sl_cur=sl_next;sl_next=(sl_next==(NSLOT-1)*SLOTB)?0:sl_next+SLOTB;}while(0)
  DMA_K(2,2*SLOTB);
  WAIT_BAR(3);
  qkt(pA0,pA1,Kbase,qr,negm,r32,hi);asm volatile("s_nop 15\n\ts_nop 7":"+v"(pA0),"+v"(pA1));CMASK(pA0,pA1,0);BIAS(pA0,pA1,0);
  START(pA0,pA1);
  _Pragma("unroll") for(int r=0;r<16;++r)pA1[r]=__builtin_amdgcn_exp2f(pA1[r]);
  WAIT_BAR(0);
  DMA_K(3,0);DMA_V(1,SLOTB);
  ROT();
  kload8(kf,kp0+sl_cur);
  WAIT_BAR(2);
  s16x4 vlo[8],vhi[8]; u32x4 pw0,pw1,pw2,pw3;
  #define PKW(P,B) cvtpk_s(P[B],P[B+1])
  #define PAF(k) __builtin_bit_cast(bf16x8,pw##k)
  #define VFR(i) (bf16x8){vlo[i][0],vlo[i][1],vlo[i][2],vlo[i][3],vhi[i][0],vhi[i][1],vhi[i][2],vhi[i][3]}
  #define PIN(x) asm volatile("":"+v"(x))
  #define MX3(a,b,c) __builtin_fmaxf(__builtin_fmaxf((a),(b)),(c))
  #define GAPA(MF,A0,A1,A2,A3,W0,W1,PW) do{ MF; sacc+=A0; sacc+=A1; sacc+=A2; sacc+=A3; PIN(sacc); W0; W1; PIN(PW); SBAR(); }while(0)
  #define EX(v) __builtin_amdgcn_exp2f(v)
  #define GAPB(MF,X,B) do{ MF; X[B]=EX(X[B]); X[B+1]=EX(X[B+1]); X[B+2]=EX(X[B+2]); X[B+3]=EX(X[B+3]); PIN(X); SBAR(); }while(0)
  #define VRD(i) do{ vlo[i]=vtr(vp_+(((i)>>2)*4096+((i)&3)*1024)); vhi[i]=vtr(vp_+(((i)>>2)*4096+((i)&3)*1024+512)); }while(0)
  #define KRD(G,j) do{ if(G){ kload2(kf,kp0+sl_next,j); SBAR(); } }while(0)
  #define STEP(C0,C1,P0,P1,t,GK,GV,GL) do{ SBAR(); \
    const lds_cptr vp_=vp0+sl_prev; \
    VRD(0); SBAR(); float sacc=(P0[0]+P0[1]); \
    GAPA(C0=__builtin_amdgcn_mfma_f32_32x32x16_bf16(kf[0],qr[0],negm,0,0,0), P0[2],P0[3],P0[4],P0[5],     pw0[0]=PKW(P0,0), pw0[1]=PKW(P0,2), pw0); \
    VRD(4); SBAR(); GAPA(C1=__builtin_amdgcn_mfma_f32_32x32x16_bf16(kf[1],qr[0],negm,0,0,0), P0[6],P0[7],P0[8],P0[9],     pw0[2]=PKW(P0,4), pw0[3]=PKW(P0,6), pw0); \
    VRD(1); SBAR(); GAPA(C0=__builtin_amdgcn_mfma_f32_32x32x16_bf16(kf[2],qr[1],C0,0,0,0),   P0[10],P0[11],P0[12],P0[13], pw1[0]=PKW(P0,8), pw1[1]=PKW(P0,10), pw1); \
    VRD(5); SBAR(); GAPA(C1=__builtin_amdgcn_mfma_f32_32x32x16_bf16(kf[3],qr[1],C1,0,0,0),   P0[14],P0[15],P1[0],P1[1],   pw1[2]=PKW(P0,12),pw1[3]=PKW(P0,14), pw1); \
    VRD(2); SBAR(); GAPA(C0=__builtin_amdgcn_mfma_f32_32x32x16_bf16(kf[4],qr[2],C0,0,0,0),   P1[2],P1[3],P1[4],P1[5],     pw2[0]=PKW(P1,0), pw2[1]=PKW(P1,2), pw2); \
    VRD(6); SBAR(); GAPA(C1=__builtin_amdgcn_mfma_f32_32x32x16_bf16(kf[5],qr[2],C1,0,0,0),   P1[6],P1[7],P1[8],P1[9],     pw2[2]=PKW(P1,4), pw2[3]=PKW(P1,6), pw2); \
    VRD(3); SBAR(); GAPA(C0=__builtin_amdgcn_mfma_f32_32x32x16_bf16(kf[6],qr[3],C0,0,0,0),   P1[10],P1[11],P1[12],P1[13], pw3[0]=PKW(P1,8), pw3[1]=PKW(P1,10), pw3); \
    VRD(7); SBAR(); GAPA(C1=__builtin_amdgcn_mfma_f32_32x32x16_bf16(kf[7],qr[3],C1,0,0,0),   P1[14],P1[15],0.f,0.f,       pw3[2]=PKW(P1,12),pw3[3]=PKW(P1,14), pw3); \
    l_reg+=sacc; \
    if(GK){DMA_K((t)+3,sl_cur);} if(GV){DMA_V((t)+1,sl_next);} \
    CMASK(C0,C1,t); BIAS(C0,C1,t); \
    { float a=MX3(C0[0],C0[1],C1[0]),b=MX3(C0[2],C0[3],C1[1]); a=MX3(a,C1[2],C1[3]); \
      _Pragma("unroll") for(int r=4;r<16;r+=4){a=MX3(a,C0[r],C0[r+1]);b=MX3(b,C0[r+2],C0[r+3]);a=MX3(a,C1[r],C1[r+1]);b=MX3(b,C1[r+2],C1[r+3]);} \
      float rm=__builtin_fmaxf(a,b); { auto rr=__builtin_amdgcn_permlane32_swap(__float_as_uint(rm),__float_as_uint(rm),false,false); rm=__builtin_fmaxf(__uint_as_float(rr[0]),__uint_as_float(rr[1])); } \
      resc=false; \
      if(__builtin_expect(__any(rm>(float)THRL),0)){ const float dl=__builtin_fmaxf(rm,0.f); mhat+=dl; \
        _Pragma("unroll") for(int r=0;r<16;++r){C0[r]-=dl;C1[r]-=dl;} \
        _Pragma("unroll") for(int r=0;r<16;++r)negm[r]=-mhat; asm volatile("":"+v"(negm)); \
        const float f=__builtin_amdgcn_exp2f(-dl); l_reg*=f; if(hi==0)wsf[r32]=f; resc=true; } } \
    SBAR(); \
    GAPB(o[0]=__builtin_amdgcn_mfma_f32_32x32x16_bf16(PAF(0),VFR(0),o[0],0,0,0), C0,0); \
    GAPB(o[1]=__builtin_amdgcn_mfma_f32_32x32x16_bf16(PAF(0),VFR(4),o[1],0,0,0), C0,4); \
    KRD(GL,0); GAPB(o[0]=__builtin_amdgcn_mfma_f32_32x32x16_bf16(PAF(1),VFR(1),o[0],0,0,0), C0,8); \
    KRD(GL,1); GAPB(o[1]=__builtin_amdgcn_mfma_f32_32x32x16_bf16(PAF(1),VFR(5),o[1],0,0,0), C0,12); \
    KRD(GL,2); GAPB(o[0]=__builtin_amdgcn_mfma_f32_32x32x16_bf16(PAF(2),VFR(2),o[0],0,0,0), C1,0); \
    KRD(GL,3); GAPB(o[1]=__builtin_amdgcn_mfma_f32_32x32x16_bf16(PAF(2),VFR(6),o[1],0,0,0), C1,4); \
    GAPB(o[0]=__builtin_amdgcn_mfma_f32_32x32x16_bf16(PAF(3),VFR(3),o[0],0,0,0), C1,8); \
    GAPB(o[1]=__builtin_amdgcn_mfma_f32_32x32x16_bf16(PAF(3),VFR(7),o[1],0,0,0), C1,12); \
    }while(0)
  int t=1;
  #undef CMASK
  #define CMASK(P0,P1,t) do{}while(0)
  for(;t+5<NT;t+=2){
    STEP(pB0,pB1,pA0,pA1,t,true,true,true);     WAIT_BAR(2); RESC(); ROT();
    STEP(pA0,pA1,pB0,pB1,t+1,true,true,true);   WAIT_BAR(2); RESC(); ROT();
  }
  #undef CMASK
  #define CMASK(P0,P1,t) do{int jb_=(t)-(NT-4); if(jb_>=0)cmask(P0,P1,jb_,qrel,hi);}while(0)
  #define ENDW(tt) do{ if((tt)+3<NT){WAIT_BAR(2);} else if((tt)+2<NT){WAIT_BAR(1);} else {WAIT_BAR(0);} }while(0)
  for(;t+1<NT;t+=2){
    STEP(pB0,pB1,pA0,pA1,t,(t+3<NT),(t+1<NT),(t+1<NT));       ENDW(t);   RESC(); ROT();
    STEP(pA0,pA1,pB0,pB1,t+1,(t+4<NT),(t+2<NT),(t+2<NT));     ENDW(t+1); RESC(); ROT();
  }
  STEP(pB0,pB1,pA0,pA1,NT-1,false,false,false); RESC();
  { float sacc=pB0[0]+pB0[1]; _Pragma("unroll") for(int r=2;r<16;++r)sacc+=pB0[r]; _Pragma("unroll") for(int r=0;r<16;++r)sacc+=pB1[r]; l_reg+=sacc;
    pw0=(u32x4){PKW(pB0,0),PKW(pB0,2),PKW(pB0,4),PKW(pB0,6)};pw1=(u32x4){PKW(pB0,8),PKW(pB0,10),PKW(pB0,12),PKW(pB0,14)};pw2=(u32x4){PKW(pB1,0),PKW(pB1,2),PKW(pB1,4),PKW(pB1,6)};pw3=(u32x4){PKW(pB1,8),PKW(pB1,10),PKW(pB1,12),PKW(pB1,14)};
    SBAR(); pv(o,vb0+sl_cur,PAF(0),PAF(1),PAF(2),PAF(3)); }
  #undef PKW
  #undef PAF
  #undef VFR
  #undef PIN
  #undef MX3
  #undef GAPA
  #undef GAPB
  #undef EX
  #undef VRD
  #undef KRD
  #undef STEP
  #undef ENDW
  {auto rr=__builtin_amdgcn_permlane32_swap(__float_as_uint(l_reg),__float_as_uint(l_reg),false,false);l_reg=__uint_as_float(rr[0])+__uint_as_float(rr[1]);}
  if(hi==0)wsf[32+r32]=l_reg;asm volatile("s_waitcnt lgkmcnt(0)":::"memory");
  float rli[16];
  #pragma unroll
  for(int r=0;r<16;++r)rli[r]=__builtin_amdgcn_rcpf(wsf[32+crow(r,hi)]);
  bf16*Ow=O+(rowbase+q0+wid*QBLK)*DM+h*D;
  { bf16*stg=(bf16*)(shm+LDS_OST)+wid*2048;
    #pragma unroll
    for(int r=0;r<16;++r){const int orow=crow(r,hi);
      #pragma unroll
      for(int d0=0;d0<2;++d0)stg[orow*64+d0*32+r32]=__float2bfloat16(o[d0][r]*rli[r]);}
    asm volatile("s_waitcnt lgkmcnt(0)":::"memory");
    #pragma unroll
    for(int i=0;i<4;++i){const int row=i*8+(lane>>3),ch=lane&7; const u32x4 v=*(const u32x4*)(stg+row*64+ch*8); ATTN_STORE16(Ow+(long)row*DM+ch*8,v);} }
  asm volatile("s_waitcnt lgkmcnt(0)\n\ts_barrier":::"memory");
  #undef BIAS
  #undef BIAS_H
  #undef DMA_K
  #undef DMA_V
  #undef CMASK
  #undef START
  #undef RESC
  #undef ROT
}
constexpr int ATTN_LDS_BYTES=LDS_BYTES;
#undef SBAR
#undef WAIT_BAR
}


constexpr int NWAVES = 8;
constexpr int RING_OFF = 0, RING_BYTES = 131072;
constexpr int LDSCTL_OFF = RING_BYTES, MISC_OFF = LDSCTL_OFF + 320, TAB_OFF = LDSCTL_OFF + 1024;
constexpr int LDS_BYTES = 147456;
typedef GAS unsigned gu32;
#define RLX_AGENT __ATOMIC_RELAXED, __HIP_MEMORY_SCOPE_AGENT

#define XB_TMO      128
#define XB_XCNT(j)  (256  + 64 * (j))
#define XB_XSUB(j)  (1280 + 64 * (j))
#define XB_XGEN(j)  (2304 + 64 * (j))
#define XB_TOP      3328
#define XB_TOPGEN   3392
#define XCD_BAR_WORDS 3456
#define XB_SPIN_CAP (1u << 18)

__device__ __forceinline__ unsigned xb_ld(unsigned* p)              { return __hip_atomic_load(p, __ATOMIC_RELAXED, __HIP_MEMORY_SCOPE_AGENT); }
__device__ __forceinline__ unsigned xb_add(unsigned* p, unsigned v) { return __hip_atomic_fetch_add(p, v, __ATOMIC_RELAXED, __HIP_MEMORY_SCOPE_AGENT); }
__device__ __forceinline__ unsigned xb_xcc_id() { return (unsigned)__builtin_amdgcn_s_getreg((3 << 11) | 20) & 0xFu; }
#define XB_SPIN(cond, bar) do { unsigned _sp = 0; while (cond) { __builtin_amdgcn_s_sleep(1); \
    if ((++_sp & 255u) == 0u) { if (xb_ld(&(bar)[XB_TMO])) break; if (_sp > XB_SPIN_CAP) { atomicAdd(&(bar)[XB_TMO], 1u); break; } } } } while (0)

struct XcdBarrier {
    unsigned* bar; unsigned x;
    volatile LAS unsigned* st;
};

__device__ __forceinline__ XcdBarrier xcd_barrier_post(unsigned* bar, volatile LAS unsigned* st) {
    XcdBarrier b; b.bar = bar; b.x = xb_xcc_id(); b.st = st;
    if (threadIdx.x == 0) (void)xb_add(&bar[XB_XCNT(b.x)], 1u);
    return b;
}
__device__ __forceinline__ void xcd_barrier_complete(unsigned* bar, unsigned x, unsigned& nloc, unsigned& nx) {
    const unsigned G = gridDim.x * gridDim.y * gridDim.z;
    unsigned sum, cnt, mine, sp = 0u;
    for (;;) {
        sum = 0u; cnt = 0u; mine = 0u;
#pragma unroll
        for (unsigned j = 0; j < 16; ++j) { const unsigned c = xb_ld(&bar[XB_XCNT(j)]); sum += c; cnt += (c > 0u) ? 1u : 0u; mine = (j == x) ? c : mine; }
        if (sum == G) break;
        __builtin_amdgcn_s_sleep(1);
        if ((++sp & 255u) == 0u) { if (xb_ld(&bar[XB_TMO])) break; if (sp > XB_SPIN_CAP) { atomicAdd(&bar[XB_TMO], 1u); break; } }
    }
    nloc = mine > 0u ? mine : 1u; nx = cnt > 0u ? cnt : 1u;
}

__device__ __forceinline__ void xcd_barrier(const XcdBarrier& b) {
    asm volatile("s_waitcnt vmcnt(0)" ::: "memory");
    __syncthreads();
    if (threadIdx.x == 0) {
        unsigned* bar = b.bar;
        __builtin_amdgcn_s_waitcnt(0);
        unsigned nloc = b.st[0], nx = b.st[1];
        if (nloc == 0u) { xcd_barrier_complete(bar, b.x, nloc, nx); b.st[0] = nloc; b.st[1] = nx; }
        const unsigned old = xb_add(&bar[XB_XSUB(b.x)], 1u);
        const unsigned gen = old / nloc;
        if (old + 1u == (gen + 1u) * nloc) {
            __builtin_amdgcn_fence(__ATOMIC_RELEASE, "agent");
            asm volatile("s_waitcnt vmcnt(0)" ::: "memory");
            const unsigned og = xb_add(&bar[XB_TOP], 1u);
            const unsigned tg = og / nx;
            if (og + 1u == (tg + 1u) * nx) xb_add(&bar[XB_TOPGEN], 1u);
            else XB_SPIN(xb_ld(&bar[XB_TOPGEN]) == tg, bar);
            __builtin_amdgcn_fence(__ATOMIC_ACQUIRE, "agent");
            xb_add(&bar[XB_XGEN(b.x)], 1u);
            asm volatile("s_waitcnt vmcnt(0)" ::: "memory");
        } else {
            XB_SPIN(xb_ld(&bar[XB_XGEN(b.x)]) == gen, bar);
            __builtin_amdgcn_fence(__ATOMIC_ACQUIRE, "agent");
            asm volatile("s_waitcnt vmcnt(0)" ::: "memory");
        }
    }
    __syncthreads();
}


struct Args {
    const float *x, *ln_in_g, *ln_in_b, *w_in, *b_in, *w_fox, *lbl, *norm_g, *w_hgrn, *w_mix, *b_mix, *ln1_g, *ln1_b, *router_w, *router_b, *w1, *w3, *w2, *ln2_g, *ln2_b;
    float* out; unsigned char* ws; int ph_lo, ph_hi, use_bar, pad;
};
struct Frame { LAS unsigned char* lds; int tid, lane, wave, G, gw, ngw, bid; };
#define LOAD_ARGS() launder_args(args)
__device__ __forceinline__ Args launder_args(const Args& args) { Args a = args; size_t z_ = 0; asm volatile("" : "+s"(z_)); a.ws = args.ws + z_; return a; }

__device__ __forceinline__ void ln_rows16(f32x4 (&v)[4], const float* g, const float* bta, int lane) {
    float s = 0.f;
#pragma unroll
    for (int j = 0; j < 4; ++j) s += (v[j].x + v[j].y) + (v[j].z + v[j].w);
    const float mean = wave_sum(s) * (1.f / D); float s2 = 0.f;
#pragma unroll
    for (int j = 0; j < 4; ++j) { v[j] = v[j] - mean; s2 += (v[j].x * v[j].x + v[j].y * v[j].y) + (v[j].z * v[j].z + v[j].w * v[j].w); }
    const float rstd = rsqrtf(wave_sum(s2) * (1.f / D) + LN_EPS);
#pragma unroll
    for (int j = 0; j < 4; ++j) { const int c = 4 * lane + 256 * j; const f32x4 gg = *(const f32x4*)(g + c), bb = *(const f32x4*)(bta + c); v[j] = v[j] * rstd * gg + bb; }
}
__device__ __forceinline__ void store_row(const f32x4 (&v)[4], int lane, float* of32, bf16_t* obf, float* of32b) {
#pragma unroll
    for (int j = 0; j < 4; ++j) { const int c = 4 * lane + 256 * j;
        if (of32) *(f32x4*)(of32 + c) = v[j];
        if (of32b) *(f32x4*)(of32b + c) = v[j];
        if (obf) { u32x2 w; w.x = pk2(v[j].x, v[j].y); w.y = pk2(v[j].z, v[j].w); *(u32x2*)(obf + c) = w; } }
}

__device__ __forceinline__ void cvt_item(const float* W, int ldw, int k0, int srccol, int nvalid, bf16_t* WT, int ldt, int dstrow, int dstk, LAS float* scr, int lane) {
#pragma unroll 8
    for (int i = 0; i < 32; ++i) { const int kk = 2 * i + (lane >> 5); const int n = lane & 31;
        scr[kk * 33 + n] = (n < nvalid) ? W[(size_t)(k0 + kk) * ldw + srccol + n] : 0.f; }
    asm volatile("s_waitcnt lgkmcnt(0)" ::: "memory");
    const int c = lane & 7;
#pragma unroll
    for (int j = 0; j < 4; ++j) { const int n = (lane >> 3) + 8 * j; const LAS float* s = scr + (8 * c) * 33 + n;
        u32x4 o; o.x = pk2(s[0 * 33], s[1 * 33]); o.y = pk2(s[2 * 33], s[3 * 33]); o.z = pk2(s[4 * 33], s[5 * 33]); o.w = pk2(s[6 * 33], s[7 * 33]);
        *(u32x4*)(WT + (size_t)(dstrow + n) * ldt + dstk + k0 + 8 * c) = o; }
    asm volatile("s_waitcnt lgkmcnt(0)" ::: "memory");
}
__device__ __forceinline__ void convert_layer(const Args& a, const Frame& F, int l) {
    LAS float* scr = (LAS float*)(F.lds + RING_OFF + F.wave * 16384);
    const int gw = F.gw, ngw = F.ngw, lane = F.lane;
    bf16_t* WIN = (bf16_t*)(a.ws + WS_WIN); bf16_t* WBR = (bf16_t*)(a.ws + WS_WBR); bf16_t* WMIX = (bf16_t*)(a.ws + WS_WMIX);
    bf16_t* W13 = (bf16_t*)(a.ws + WS_W13); bf16_t* W2 = (bf16_t*)(a.ws + WS_W2);
    constexpr int I_IN = 16 * 184, I_BR = 8 * 32, I_MIX = 16 * 32, I_13 = 16 * 64 * NE, I_2 = 16 * 32 * NE;
    constexpr int NITEMS = I_IN + 2 * I_BR + I_MIX + I_13 + I_2;
    for (int it = gw; it < NITEMS; it += ngw) {
        int r = it;
        if (r < I_IN) { const int kb = r / 184, nb = r % 184, n0 = nb * 32;
            int src, nv = 32; if (n0 < 1536) src = n0; else if (n0 < 5632) src = n0 + 8; else if (n0 == 5632) { src = 1536; nv = 8; } else { src = 0; nv = 0; }
            cvt_item(a.w_in + (size_t)l * D * NIN, NIN, kb * 64, src, nv, WIN, D, n0, 0, scr, lane); continue; } r -= I_IN;
        if (r < I_BR) { const int kb = r / 32, nb = r % 32; cvt_item(a.w_fox + (size_t)l * 512 * D, D, kb * 64, nb * 32, 32, WBR, D, nb * 32, 0, scr, lane); continue; } r -= I_BR;
        if (r < I_BR) { const int kb = r / 32, nb = r % 32; cvt_item(a.w_hgrn + (size_t)l * 512 * D, D, kb * 64, nb * 32, 32, WBR, D, nb * 32, 512, scr, lane); continue; } r -= I_BR;
        if (r < I_MIX) { const int kb = r / 32, nb = r % 32; cvt_item(a.w_mix + (size_t)l * D * D, D, kb * 64, nb * 32, 32, WMIX, D, nb * 32, 0, scr, lane); continue; } r -= I_MIX;
        if (r < I_13) { const int e = r / 1024, q = r % 1024, kb = q / 64, nb = q % 64, n0 = nb * 32;
            const int j = n0 >> 8, rr = n0 & 255; const float* src = (rr < 128 ? a.w1 : a.w3) + ((size_t)l * NE + e) * D * D;
            cvt_item(src, D, kb * 64, 128 * j + (rr & 127), 32, W13 + (size_t)e * 2048 * D, D, n0, 0, scr, lane); continue; } r -= I_13;
        { const int e = r / 512, q = r % 512, kb = q / 32, nb = q % 32;
            cvt_item(a.w2 + ((size_t)l * NE + e) * D * D, D, kb * 64, nb * 32, 32, W2 + (size_t)e * D * D, D, nb * 32, 0, scr, lane); }
    }
    float* biasp = (float*)(a.ws + WS_MISC + 16384);
    for (int n = gw * 64 + lane; n < NINP; n += ngw * 64) {
        float v = 0.f; if (n < 1536) v = a.b_in[l * NIN + n]; else if (n < 5632) v = a.b_in[l * NIN + n + 8]; else if (n < 5640) v = a.b_in[l * NIN + 1536 + (n - 5632)];
        biasp[n] = v; }
}

__device__ __forceinline__ void phase_prep(const Args& a, const Frame& F) {
    if (F.bid == 0) {
        float* lb_all = (float*)(a.ws + WS_MISC);
        const int c = F.tid;
        float v[DEPTH], m = -1e30f;
#pragma unroll
        for (int l = 0; l < DEPTH; ++l) { v[l] = a.lbl[l * 512 + c]; m = fmaxf(m, v[l]); }
        float s = 0.f;
#pragma unroll
        for (int l = 0; l < DEPTH; ++l) { v[l] = __expf(v[l] - m); s += v[l]; }
        float cum = 0.f;
#pragma unroll
        for (int l = 0; l < DEPTH; ++l) { const float p = v[l] / s; cum += p; lb_all[l * 512 + c] = cum - v[0] / s; }
    }
    float* XRES = (float*)(a.ws + WS_XRES); bf16_t* XN = (bf16_t*)(a.ws + WS_XN);
    for (int row = F.gw; row < T; row += F.ngw) {
        f32x4 v[4];
#pragma unroll
        for (int j = 0; j < 4; ++j) v[j] = *(const f32x4*)(a.x + (size_t)row * D + 4 * F.lane + 256 * j);
        ln_rows16(v, a.ln_in_g, a.ln_in_b, F.lane);
        store_row(v, F.lane, XRES + (size_t)row * D, XN + (size_t)row * D, nullptr);
    }
    convert_layer(a, F, 0);
}

__device__ __forceinline__ void phase_fscan(const Args& a, const Frame& F) {
    if (F.bid >= BATCH * NH) return;
    const float* FL = (const float*)(a.ws + WS_FL); float* F2 = (float*)(a.ws + WS_F2);
    LAS float* wsum = (LAS float*)(F.lds + RING_OFF);
    const int bh = F.bid, b = bh >> 3, h = bh & 7, tid = F.tid, lane = F.lane, w = F.wave;
    float v[4], run = 0.f;
#pragma unroll
    for (int i = 0; i < 4; ++i) { run += FL[((size_t)b * SEQ + tid * 4 + i) * 8 + h]; v[i] = run; }
    float incl = run;
#pragma unroll
    for (int o = 1; o < 64; o <<= 1) { const float u = __shfl_up(incl, o); if (lane >= o) incl += u; }
    if (lane == 63) wsum[w] = incl;
    __syncthreads();
    float base = incl - run; for (int i = 0; i < w; ++i) base += wsum[i];
#pragma unroll
    for (int i = 0; i < 4; ++i) F2[(size_t)bh * SEQ + tid * 4 + i] = (base + v[i]) * LOG2E;
    __syncthreads();
}

__device__ __forceinline__ void phase_attn_naive(const Args& a, const Frame& F) {
    const bf16_t* QO = (const bf16_t*)(a.ws + WS_QO); const bf16_t* KV = (const bf16_t*)(a.ws + WS_KV); const float* F2 = (const float*)(a.ws + WS_F2); bf16_t* O = (bf16_t*)(a.ws + WS_QO);
    LAS float* ps = (LAS float*)(F.lds + RING_OFF) + F.wave * 64;
    const int lane = F.lane;
    for (int gid = F.gw; gid < BATCH * NH * SEQ; gid += F.ngw) {
        const int bh = gid & 127, t = gid >> 7, b = bh >> 3, h = bh & 7;
        float q[64];
        { const bf16_t* qp = QO + ((size_t)b * SEQ + t) * 1024 + h * 64;
#pragma unroll
          for (int c = 0; c < 8; ++c) { const u32x4 u = *(const u32x4*)(qp + c * 8);
            q[c * 8 + 0] = bflo(u.x); q[c * 8 + 1] = bfhi(u.x); q[c * 8 + 2] = bflo(u.y); q[c * 8 + 3] = bfhi(u.y);
            q[c * 8 + 4] = bflo(u.z); q[c * 8 + 5] = bfhi(u.z); q[c * 8 + 6] = bflo(u.w); q[c * 8 + 7] = bfhi(u.w); } }
        float m = -1e30f, l = 0.f, o = 0.f;
        const float* f2 = F2 + (size_t)bh * SEQ;
        for (int s0 = 0; s0 <= t; s0 += 64) {
            const int s = s0 + lane; const bool valid = s <= t;
            float sc = -1e30f;
            if (valid) { const bf16_t* kp = KV + ((size_t)b * SEQ + s) * 1024 + h * 64; float d = 0.f;
#pragma unroll
                for (int c = 0; c < 8; ++c) { const u32x4 u = *(const u32x4*)(kp + c * 8);
                    d += q[c * 8 + 0] * bflo(u.x) + q[c * 8 + 1] * bfhi(u.x) + q[c * 8 + 2] * bflo(u.y) + q[c * 8 + 3] * bfhi(u.y)
                       + q[c * 8 + 4] * bflo(u.z) + q[c * 8 + 5] * bfhi(u.z) + q[c * 8 + 6] * bflo(u.w) + q[c * 8 + 7] * bfhi(u.w); }
                sc = d - f2[s]; }
            const float mn = fmaxf(m, wave_max(sc));
            const float p = valid ? exp2f(sc - mn) : 0.f;
            const float f = exp2f(m - mn);
            l = l * f + wave_sum(p); o *= f; m = mn;
            ps[lane] = p;
            asm volatile("s_waitcnt lgkmcnt(0)" ::: "memory");
            const int nk = min(64, t - s0 + 1);
            const bf16_t* vp = KV + ((size_t)b * SEQ + s0) * 1024 + 512 + h * 64 + lane;
            for (int j = 0; j < nk; ++j) o += ps[j] * bf2f(vp[(size_t)j * 1024]);
            asm volatile("s_waitcnt lgkmcnt(0)" ::: "memory");
        }
        O[((size_t)b * SEQ + t) * 1024 + h * 64 + lane] = (bf16_t)f2bf(o / l);
    }
}

__device__ __forceinline__ void phase_hgrn_naive(const Args& a, const Frame& F, int l) {
    if (F.bid >= BATCH * NH || F.wave != 0) return;
    const bf16_t* HB = (const bf16_t*)(a.ws + WS_HB); const float* LOGF = (const float*)(a.ws + WS_LOGF); const bf16_t* HG = (const bf16_t*)(a.ws + WS_HG); bf16_t* O = (bf16_t*)(a.ws + WS_QO);
    LAS float* Lf = (LAS float*)(F.lds + RING_OFF + 1024); LAS float* Lk = Lf + 4096; LAS float* Lq = Lk + 4096;
    const int bh = F.bid, b = bh >> 3, h = bh & 7, lane = F.lane;
    float Sx[64];
#pragma unroll
    for (int d = 0; d < 64; ++d) Sx[d] = 0.f;
    const float ng = a.norm_g[l * 512 + h * 64 + lane];
    for (int c0 = 0; c0 < SEQ; c0 += 64) {
        for (int tt = 0; tt < 64; ++tt) { const size_t row = (size_t)b * SEQ + c0 + tt;
            const float lf = LOGF[row * 512 + h * 64 + lane]; const float f = __expf(lf);
            Lf[tt * 64 + lane] = f; Lk[tt * 64 + lane] = 1.f - f; Lq[tt * 64 + lane] = bf2f(HB[row * 1024 + h * 64 + lane]); }
        asm volatile("s_waitcnt lgkmcnt(0)" ::: "memory");
        for (int tt = 0; tt < 64; ++tt) { const size_t row = (size_t)b * SEQ + c0 + tt;
            const float v = bf2f(HB[row * 1024 + 512 + h * 64 + lane]);
            float o = 0.f;
#pragma unroll
            for (int d = 0; d < 64; d += 4) { const f32x4 f4 = *(const LAS f32x4*)(Lf + tt * 64 + d), k4 = *(const LAS f32x4*)(Lk + tt * 64 + d), q4 = *(const LAS f32x4*)(Lq + tt * 64 + d);
                Sx[d] = f4.x * Sx[d] + k4.x * v; o += Sx[d] * q4.x; Sx[d + 1] = f4.y * Sx[d + 1] + k4.y * v; o += Sx[d + 1] * q4.y;
                Sx[d + 2] = f4.z * Sx[d + 2] + k4.z * v; o += Sx[d + 2] * q4.z; Sx[d + 3] = f4.w * Sx[d + 3] + k4.w * v; o += Sx[d + 3] * q4.w; }
            const float ss = wave_sum(o * o);
            const float r = o * rsqrtf(ss * (1.f / 64.f) + RMS_EPS) * ng * bf2f(HG[row * 512 + h * 64 + lane]);
            O[row * 1024 + 512 + h * 64 + lane] = (bf16_t)f2bf(r); }
        asm volatile("s_waitcnt lgkmcnt(0)" ::: "memory");
    }
}

__device__ __forceinline__ void phase_ln1_router(const Args& a, const Frame& F, int l) {
    float* xres = (float*)(a.ws + WS_XRES); const bf16_t* mixed = (const bf16_t*)(a.ws + WS_MIXED); bf16_t* xn = (bf16_t*)(a.ws + WS_XN);
    unsigned* cnt = (unsigned*)(a.ws + WS_CTL) + CW_CNT + l * 64; int* list = (int*)(a.ws + WS_LIST); unsigned* tokinfo = (unsigned*)(a.ws + WS_TOK);
    const float* g = a.ln1_g + l * D; const float* bta = a.ln1_b + l * D;
    LAS float* rw = (LAS float*)(F.lds + RING_OFF);
    for (int i = F.tid; i < NE * D; i += NWAVES * 64) { const int c = i >> 4, e = i & 15; rw[e * D + c] = a.router_w[i]; }
    __syncthreads();
    const int lane = F.lane;
    for (int row = F.gw; row < T; row += F.ngw) {
        f32x4 v[4];
#pragma unroll
        for (int j = 0; j < 4; ++j) { const int c = 4 * lane + 256 * j; const f32x4 xv = *(const f32x4*)(xres + (size_t)row * D + c);
            const u32x2 mm = *(const u32x2*)(mixed + (size_t)row * D + c);
            v[j].x = ALPHA * xv.x + bflo(mm.x); v[j].y = ALPHA * xv.y + bfhi(mm.x); v[j].z = ALPHA * xv.z + bflo(mm.y); v[j].w = ALPHA * xv.w + bfhi(mm.y); }
        ln_rows16(v, g, bta, lane);
        store_row(v, lane, xres + (size_t)row * D, xn + (size_t)row * D, nullptr);
        float lg[NE];
#pragma unroll
        for (int e = 0; e < NE; ++e) { float p = 0.f;
#pragma unroll
            for (int j = 0; j < 4; ++j) { const f32x4 r4 = *(const LAS f32x4*)(rw + e * D + 4 * lane + 256 * j); p += v[j].x * r4.x + v[j].y * r4.y + v[j].z * r4.z + v[j].w * r4.w; }
            lg[e] = wave_sum(p) + a.router_b[e]; asm volatile("" ::: "memory"); }
        if (lane == 0) {
            int gs = 0; float gbest = -3e38f;
#pragma unroll
            for (int gi = 0; gi < 4; ++gi) { const float mx = fmaxf(fmaxf(lg[gi * 4], lg[gi * 4 + 1]), fmaxf(lg[gi * 4 + 2], lg[gi * 4 + 3])); if (mx > gbest) { gbest = mx; gs = gi; } }
            float l4[4];
#pragma unroll
            for (int i = 0; i < 4; ++i) { float t0 = lg[i];
#pragma unroll
                for (int gi = 1; gi < 4; ++gi) t0 = (gs == gi) ? lg[gi * 4 + i] : t0; l4[i] = t0; }
            int i0 = 0; float b0 = l4[0];
#pragma unroll
            for (int i = 1; i < 4; ++i) if (l4[i] > b0) { b0 = l4[i]; i0 = i; }
            int i1 = 0; float b1 = -3e38f;
#pragma unroll
            for (int i = 0; i < 4; ++i) if (i != i0 && l4[i] > b1) { b1 = l4[i]; i1 = i; }
            const float e1 = __expf(b1 - b0); const float g0 = 1.f / (1.f + e1), g1 = e1 / (1.f + e1);
            const int ex0 = gs * 4 + i0, ex1 = gs * 4 + i1;
            const unsigned p0 = atomicAdd(cnt + ex0, 1u), p1 = atomicAdd(cnt + ex1, 1u);
            list[ex0 * T + p0] = row; list[ex1 * T + p1] = row;
            tokinfo[row * 4 + 0] = ((unsigned)ex0 << 24) | p0; tokinfo[row * 4 + 1] = ((unsigned)ex1 << 24) | p1;
            tokinfo[row * 4 + 2] = __float_as_uint(g0); tokinfo[row * 4 + 3] = __float_as_uint(g1);
        }
    }
    __syncthreads();
}

__device__ __forceinline__ void moe_table(const Args& a, const Frame& F, int l) {
    LAS int* tab = (LAS int*)(F.lds + TAB_OFF);
    const unsigned* cnt = (const unsigned*)(a.ws + WS_CTL) + CW_CNT + l * 64;
    if (F.tid == 0) { int ts = 0; for (int e = 0; e < NE; ++e) { const int c = (int)__hip_atomic_load(cnt + e, RLX_AGENT); tab[e] = ts; tab[NE + 1 + e] = c; ts += (c + TM - 1) / TM; } tab[NE] = ts; }
    __syncthreads();
}

__device__ __forceinline__ void phase_combine_ln2(const Args& a, const Frame& F, int l) {
    float* xres = (float*)(a.ws + WS_XRES); const bf16_t* Y = (const bf16_t*)(a.ws + WS_Y); const unsigned* tokinfo = (const unsigned*)(a.ws + WS_TOK); bf16_t* xn = (bf16_t*)(a.ws + WS_XN);
    const float* g = a.ln2_g + l * D; const float* bta = a.ln2_b + l * D; float* out = (l == DEPTH - 1) ? a.out : nullptr;
    const LAS int* tab = (const LAS int*)(F.lds + TAB_OFF);
    const int lane = F.lane;
    for (int row = F.gw; row < T; row += F.ngw) {
        const unsigned i0 = tokinfo[row * 4], i1 = tokinfo[row * 4 + 1]; const float g0 = __uint_as_float(tokinfo[row * 4 + 2]), g1 = __uint_as_float(tokinfo[row * 4 + 3]);
        const size_t s0 = (size_t)tab[i0 >> 24] * TM + (i0 & 0xffffff), s1 = (size_t)tab[i1 >> 24] * TM + (i1 & 0xffffff);
        f32x4 v[4];
#pragma unroll
        for (int j = 0; j < 4; ++j) { const int c = 4 * lane + 256 * j; const f32x4 xv = *(const f32x4*)(xres + (size_t)row * D + c);
            const u32x2 ya = *(const u32x2*)(Y + s0 * D + c), yb = *(const u32x2*)(Y + s1 * D + c);
            v[j].x = ALPHA * xv.x + g0 * bflo(ya.x) + g1 * bflo(yb.x); v[j].y = ALPHA * xv.y + g0 * bfhi(ya.x) + g1 * bfhi(yb.x);
            v[j].z = ALPHA * xv.z + g0 * bflo(ya.y) + g1 * bflo(yb.y); v[j].w = ALPHA * xv.w + g0 * bfhi(ya.y) + g1 * bfhi(yb.y); }
        ln_rows16(v, g, bta, lane);
        store_row(v, lane, xres + (size_t)row * D, xn + (size_t)row * D, out ? out + (size_t)row * D : nullptr);
    }
}


constexpr int ATT_F2_OFF = 86016;
__device__ __forceinline__ void phase_attn(const Args& a, const Frame& F, char* lds_generic) {
    const int c = F.bid, vcu = (F.G % 8 == 0) ? (c % 8) * (F.G / 8) + c / 8 : c;
    const attn_body::bf16* Q = (const attn_body::bf16*)(a.ws + WS_QO); const attn_body::bf16* K = (const attn_body::bf16*)(a.ws + WS_KV); const attn_body::bf16* V = K + 512;
    attn_body::bf16* O = (attn_body::bf16*)(a.ws + WS_QO);
    const float* FL = (const float*)(a.ws + WS_FL);
    LAS float* f2 = (LAS float*)(F.lds + ATT_F2_OFF); LAS float* wsum = f2 + 2048;
    { const int bh = vcu >> 1; if (bh >= BATCH * NH) return;
        const int b = bh >> 3, h = bh & 7, tid = F.tid, lane = F.lane, w = F.wave;
        float v[4], run = 0.f;
#pragma unroll
        for (int i = 0; i < 4; ++i) { run += FL[((size_t)b * SEQ + tid * 4 + i) * 8 + h]; v[i] = run; }
        float incl = run;
#pragma unroll
        for (int o = 1; o < 64; o <<= 1) { const float u = __shfl_up(incl, o); if (lane >= o) incl += u; }
        if (lane == 63) wsum[w] = incl;
        __syncthreads();
        float base = incl - run; for (int i = 0; i < w; ++i) base += wsum[i];
        f32x4 o4; o4[0] = (base + v[0]) * LOG2E; o4[1] = (base + v[1]) * LOG2E; o4[2] = (base + v[2]) * LOG2E; o4[3] = (base + v[3]) * LOG2E;
        *(LAS f32x4*)(f2 + tid * 4) = o4;
        __syncthreads();
        for (int i = 0; i < 4; ++i) { const int s = 2 * (vcu & 1) + (i >> 1); const int qb = (i & 1) ? 7 - s : s;
            int tid_u = F.tid; asm volatile("" : "+v"(tid_u));
            attn_body::attn_unit<8>(b, h, qb, Q, K, V, O, lds_generic + RING_OFF, f2, tid_u); }
        __syncthreads();
    }
}


constexpr int PH_PER_LAYER = 10, N_PHASES = 1 + DEPTH * PH_PER_LAYER;
#ifndef MK_ONE_LAUNCH
#define MK_ONE_LAUNCH 1
#endif
#ifndef MK_FAST_ATTN
#define MK_FAST_ATTN 0
#endif
#ifndef MK_FAST_HGRN
#define MK_FAST_HGRN 0
#endif


#ifdef DBG_DUMP
#ifndef DBG_WHAT
#define DBG_WHAT 0
#endif
__device__ __forceinline__ void dbg_dump(const Args& a, const Frame& F) {
    unsigned char* ws = a.ws;
    const bf16_t *QO = (bf16_t*)(ws + WS_QO), *KV = (bf16_t*)(ws + WS_KV), *HB = (bf16_t*)(ws + WS_HB), *HG = (bf16_t*)(ws + WS_HG), *G = (bf16_t*)(ws + WS_G);
    const bf16_t *U1 = (bf16_t*)(ws + WS_U1), *U = (bf16_t*)(ws + WS_U), *MIXED = (bf16_t*)(ws + WS_MIXED), *XN = (bf16_t*)(ws + WS_XN);
    const float *LOGF = (float*)(ws + WS_LOGF), *FL = (float*)(ws + WS_FL), *XRES = (float*)(ws + WS_XRES);
    for (size_t i = (size_t)F.bid * 512 + F.tid; i < (size_t)T * D; i += (size_t)gridDim.x * 512) {
        const size_t row = i >> 10; const int c = (int)(i & 1023);
        float v = 0.f;
        if (DBG_WHAT == 9) { v = bf2f(G[row * 2048 + c]) + bf2f(G[row * 2048 + 1024 + c]); }
        else if (DBG_DUMP == 1) { v = bf2f(KV[i]) + bf2f(HB[i]) + bf2f(G[row * 2048 + c]) + bf2f(G[row * 2048 + 1024 + c]);
            if (c < 512) v += LOGF[row * 512 + c] + bf2f(HG[row * 512 + c]) + bf2f(QO[i]); if (c < 8) v += FL[row * 8 + c]; }
        else if (DBG_DUMP == 2) { v = (c >= 512) ? bf2f(QO[i]) : 0.f; }
        else if (DBG_DUMP == 3) { v = bf2f(QO[i]); }
        else if (DBG_DUMP == 4) { v = bf2f(U1[i]); }
        else if (DBG_DUMP == 5) { v = bf2f(U[i]); }
        else if (DBG_DUMP == 6) { v = bf2f(MIXED[i]); }
        else if (DBG_DUMP == 7) { v = XRES[i] + bf2f(XN[i]); }
        a.out[i] = v;
    }
}
#endif
#define PH_BEGIN const Args a = LOAD_ARGS(); Frame F; F.lds = lds0; F.tid = threadIdx.x; asm volatile("" : "+v"(F.tid)); F.lane = F.tid & 63; F.wave = __builtin_amdgcn_readfirstlane(F.tid >> 6); \
    F.G = gridDim.x; F.bid = blockIdx.x; asm volatile("" : "+s"(F.bid)); F.gw = F.bid * NWAVES + F.wave; F.ngw = F.G * NWAVES; unsigned char* const ws = a.ws; const LAS int* tab = (const LAS int*)(F.lds + TAB_OFF); (void)tab; (void)ws;
#ifdef DBG_DUMP
#define IN(k) (lo <= (k) && (k) < hi && (k) <= DBG_DUMP)
#else
#define IN(k) (lo <= (k) && (k) < hi)
#endif
#define SEAM(k) do { if (IN(k) && IN((k) + 1)) { XcdBarrier b2_ = bar; { size_t z_ = 0; asm volatile("" : "+s"(z_), "+s"(b2_.x)); b2_.bar = bar.bar + z_; } xcd_barrier(b2_); } } while (0)
template <int l>
__device__ __forceinline__ void layer_body(const Args& args, const int lo, const int hi, const XcdBarrier& bar, LAS unsigned char* const lds0, unsigned char* lds_raw) {
        const int pb = 1 + l * PH_PER_LAYER;

#ifdef DBG_DUMP
        if (l == 0 && lo <= DBG_DUMP + 1 && DBG_DUMP + 1 < hi) { PH_BEGIN dbg_dump(a, F); }
#endif
        if (IN(pb + 0)) { PH_BEGIN
            pg8::Gemm g{(bf16_t*)(ws + WS_XN), (bf16_t*)(ws + WS_WIN), D, D, D}; pg8::StaticOrder S; S.init(T, NINP, F.G, F.bid);
            pg8::EpiInproj E{ws, l};
            pg8::gemm_phase<pg8::EpiInproj, pg8::StaticOrder, true>(F.lds + RING_OFF, g, S, E, F.tid);
        }
        SEAM(pb + 0);
        if (IN(pb + 1)) { PH_BEGIN
#if !MK_FAST_ATTN
            phase_fscan(a, F);
#endif
#if MK_FAST_HGRN
            phase_hgrn(a, F, l);
#else
            phase_hgrn_naive(a, F, l);
#endif
        }
        SEAM(pb + 1);
        if (IN(pb + 2)) { PH_BEGIN
#if MK_FAST_ATTN
            phase_attn(a, F, (char*)lds_raw);
#else
            phase_attn_naive(a, F);
#endif
        }
        SEAM(pb + 2);
        if (IN(pb + 3)) { PH_BEGIN
            pg8::Gemm g{(bf16_t*)(ws + WS_QO), (bf16_t*)(ws + WS_WBR), D, D, 512}; pg8::StaticOrder S; S.init(T, D, F.G, F.bid);
            pg8::EpiGate<1> E{(bf16_t*)(ws + WS_U1), nullptr, (bf16_t*)(ws + WS_G), 2048, nullptr};
            pg8::gemm_phase<pg8::EpiGate<1>, pg8::StaticOrder, true>(F.lds + RING_OFF, g, S, E, F.tid);
        }
        SEAM(pb + 3);
        if (IN(pb + 4)) { PH_BEGIN
            pg8::Gemm g{(bf16_t*)(ws + WS_QO) + 512, (bf16_t*)(ws + WS_WBR) + 512, D, D, 512}; pg8::StaticOrder S; S.init(T, D, F.G, F.bid);
            pg8::EpiGate<2> E{(bf16_t*)(ws + WS_U), nullptr, (bf16_t*)(ws + WS_G) + 1024, 2048, (bf16_t*)(ws + WS_U1)};
            pg8::gemm_phase<pg8::EpiGate<2>, pg8::StaticOrder, true>(F.lds + RING_OFF, g, S, E, F.tid);
        }
        SEAM(pb + 4);
        if (IN(pb + 5)) { PH_BEGIN
            pg8::Gemm g{(bf16_t*)(ws + WS_U), (bf16_t*)(ws + WS_WMIX), D, D, D}; pg8::StaticOrder S; S.init(T, D, F.G, F.bid);
            pg8::EpiGate<0> E{(bf16_t*)(ws + WS_MIXED), a.b_mix + l * D, nullptr, 0, nullptr};
            pg8::gemm_phase<pg8::EpiGate<0>, pg8::StaticOrder, true>(F.lds + RING_OFF, g, S, E, F.tid);
        }
        SEAM(pb + 5);
        if (IN(pb + 6)) { PH_BEGIN phase_ln1_router(a, F, l); }
        SEAM(pb + 6);
        if (IN(pb + 7)) { PH_BEGIN
            moe_table(a, F, l);
            pg8::Gemm g{(bf16_t*)(ws + WS_XN), (bf16_t*)(ws + WS_W13), D, D, D}; pg8::MoeOrder S{F.G, F.bid, 8, tab, (const int*)(ws + WS_LIST), true, (size_t)2048 * D};
            pg8::EpiUp E{(bf16_t*)(ws + WS_H)};
            pg8::gemm_phase<pg8::EpiUp, pg8::MoeOrder, true>(F.lds + RING_OFF, g, S, E, F.tid);
        }
        SEAM(pb + 7);
        if (IN(pb + 8)) { PH_BEGIN
            moe_table(a, F, l);
            pg8::Gemm g{(bf16_t*)(ws + WS_H), (bf16_t*)(ws + WS_W2), D, D, D}; pg8::MoeOrder S{F.G, F.bid, 4, tab, nullptr, false, (size_t)D * D};
            pg8::EpiGate<0> E{(bf16_t*)(ws + WS_Y), nullptr, nullptr, 0, nullptr};
            pg8::gemm_phase<pg8::EpiGate<0>, pg8::MoeOrder, true>(F.lds + RING_OFF, g, S, E, F.tid);
        }
        SEAM(pb + 8);
        if (IN(pb + 9)) { PH_BEGIN
            moe_table(a, F, l);
            phase_combine_ln2(a, F, l);
            if (l + 1 < DEPTH) { __syncthreads(); convert_layer(a, F, l + 1); }
        }
        SEAM(pb + 9);
    }

__global__ void __launch_bounds__(NWAVES * 64, 2) mk_fwd(Args args) {
    extern __shared__ __attribute__((aligned(16))) unsigned char lds_raw[];
    LAS unsigned char* const lds0 = (LAS unsigned char*)lds_raw;
    volatile LAS unsigned* MISC = (volatile LAS unsigned*)(lds0 + MISC_OFF);
    for (int u = threadIdx.x; u < (LDS_BYTES - LDSCTL_OFF) / 4; u += NWAVES * 64) ((LAS unsigned*)(lds0 + LDSCTL_OFF))[u] = 0u;
    __syncthreads();
    unsigned* ctl = (unsigned*)(args.ws + WS_CTL);
    XcdBarrier bar; bar.bar = ctl + CW_BAR; bar.x = 0; bar.st = nullptr;
    if (args.use_bar) bar = xcd_barrier_post(ctl + CW_BAR, MISC + 8);
    const int lo = args.ph_lo, hi = args.ph_hi;


    if (IN(0)) { PH_BEGIN phase_prep(a, F); }
    SEAM(0);
    layer_body<0>(args, lo, hi, bar, lds0, lds_raw); layer_body<1>(args, lo, hi, bar, lds0, lds_raw); layer_body<2>(args, lo, hi, bar, lds0, lds_raw); layer_body<3>(args, lo, hi, bar, lds0, lds_raw);
#undef IN
#undef SEAM
}

extern "C" void kernel_launch(void* const* d_in, const int* in_sizes, int n_in, void* d_out, int out_size, void* d_ws, size_t ws_size, hipStream_t stream) {
    static int grid = 0;
    if (grid == 0) {
        if (n_in != 20 || in_sizes[0] != T * D || out_size != T * D || ws_size < WS_END) { fprintf(stderr, "kernel_launch: unexpected shapes (n_in %d, ws %zu)\n", n_in, ws_size); grid = -1; return; }
        int dev = 0, cus = 0, per_cu = 0;
        if (hipGetDevice(&dev) != hipSuccess || hipDeviceGetAttribute(&cus, hipDeviceAttributeMultiprocessorCount, dev) != hipSuccess) { grid = -1; return; }
        if (hipFuncSetAttribute((const void*)mk_fwd, hipFuncAttributeMaxDynamicSharedMemorySize, LDS_BYTES) != hipSuccess) { fprintf(stderr, "kernel_launch: hipFuncSetAttribute failed\n"); grid = -1; return; }
        if (hipOccupancyMaxActiveBlocksPerMultiprocessor(&per_cu, (const void*)mk_fwd, NWAVES * 64, LDS_BYTES) != hipSuccess || per_cu < 1)
            fprintf(stderr, "kernel_launch: note: occupancy query reports %d workgroups per CU\n", per_cu);
        (void)hipGetLastError();
        grid = cus;
    }
    if (grid < 0) return;
    if (hipMemsetAsync((char*)d_ws + WS_CTL, 0, CTL_BYTES, stream) != hipSuccess) return;
    Args a{};
    a.x = (const float*)d_in[0]; a.ln_in_g = (const float*)d_in[1]; a.ln_in_b = (const float*)d_in[2]; a.w_in = (const float*)d_in[3]; a.b_in = (const float*)d_in[4];
    a.w_fox = (const float*)d_in[5]; a.lbl = (const float*)d_in[6]; a.norm_g = (const float*)d_in[7]; a.w_hgrn = (const float*)d_in[8]; a.w_mix = (const float*)d_in[9];
    a.b_mix = (const float*)d_in[10]; a.ln1_g = (const float*)d_in[11]; a.ln1_b = (const float*)d_in[12]; a.router_w = (const float*)d_in[13]; a.router_b = (const float*)d_in[14];
    a.w1 = (const float*)d_in[15]; a.w3 = (const float*)d_in[16]; a.w2 = (const float*)d_in[17]; a.ln2_g = (const float*)d_in[18]; a.ln2_b = (const float*)d_in[19];
    a.out = (float*)d_out; a.ws = (unsigned char*)d_ws; a.pad = 0;
#if MK_ONE_LAUNCH
    a.ph_lo = 0; a.ph_hi = N_PHASES; a.use_bar = 1;
    hipLaunchKernelGGL(mk_fwd, dim3(grid), dim3(NWAVES * 64), LDS_BYTES, stream, a);
#else
#ifdef DBG_DUMP
    const int np_ = DBG_DUMP + 2;
#else
    const int np_ = N_PHASES;
#endif
    for (int p = 0; p < np_; ++p) { a.ph_lo = p; a.ph_hi = p + 1; a.use_bar = 0;
        hipLaunchKernelGGL(mk_fwd, dim3(grid), dim3(NWAVES * 64), LDS_BYTES, stream, a); }
#endif
    const hipError_t le = hipPeekAtLastError();
    if (le != hipSuccess) fprintf(stderr, "kernel_launch: launch failed: %s\n", hipGetErrorName(le));
}
```

```cpp
#define MK_ONE_LAUNCH 1
#define MK_FAST_ATTN 1
#define MK_FAST_HGRN 1
#include <hip/hip_runtime.h>
#include <cstdio>
#include <cstdint>

typedef unsigned short bf16_t;
typedef short bf16x8 __attribute__((ext_vector_type(8)));
typedef float f32x4 __attribute__((ext_vector_type(4)));
typedef float f32x2 __attribute__((ext_vector_type(2)));
typedef unsigned u32x4 __attribute__((ext_vector_type(4)));
typedef unsigned u32x2 __attribute__((ext_vector_type(2)));
#define LAS __attribute__((address_space(3)))
#define GAS __attribute__((address_space(1)))

constexpr int BATCH = 16, SEQ = 2048, T = BATCH * SEQ, D = 1024, DEPTH = 4, NH = 8, HD = 64, NIN = 5640, NINP = 5888, NE = 16;
constexpr float LN_EPS = 1e-5f, RMS_EPS = 1e-6f;
constexpr float ALPHA = 1.681792830507429f;
constexpr float LOG2E = 1.4426950408889634f;
constexpr float C2 = 0.125f * LOG2E;
constexpr int TM = 256;

constexpr size_t MiB = 1u << 20;
constexpr size_t WS_CTL = 0, CTL_BYTES = 1 * MiB;
constexpr size_t WS_MISC = 1 * MiB;
constexpr size_t WS_WIN = 2 * MiB, WS_WBR = 14 * MiB, WS_WMIX = 16 * MiB, WS_W13 = 18 * MiB, WS_W2 = 82 * MiB;
constexpr size_t WS_XRES = 114 * MiB, WS_XN = 242 * MiB, WS_QO = 306 * MiB, WS_KV = 370 * MiB, WS_HB = 434 * MiB, WS_LOGF = 498 * MiB;
constexpr size_t WS_HG = 562 * MiB, WS_G = 594 * MiB, WS_FL = 722 * MiB, WS_F2 = 723 * MiB, WS_U1 = 724 * MiB, WS_U = 788 * MiB, WS_MIXED = 852 * MiB;
constexpr size_t WS_LIST = 916 * MiB, WS_TOK = 918 * MiB, WS_END = 919 * MiB;
constexpr size_t WS_H = WS_QO, WS_Y = 442 * MiB;
constexpr int CW_CNT = 1024;
constexpr int CW_BAR = 4096;

__device__ __forceinline__ unsigned f2bf(float f) { unsigned u = __builtin_bit_cast(unsigned, f); return (u + 0x7fffu + ((u >> 16) & 1u)) >> 16; }
__device__ __forceinline__ float bf2f(unsigned h) { return __builtin_bit_cast(float, h << 16); }
__device__ __forceinline__ float bflo(unsigned w) { return __builtin_bit_cast(float, w << 16); }
__device__ __forceinline__ float bfhi(unsigned w) { return __builtin_bit_cast(float, w & 0xffff0000u); }
__device__ __forceinline__ unsigned pk2(float lo, float hi) { return f2bf(lo) | (f2bf(hi) << 16); }
__device__ __forceinline__ float wave_sum(float v) {
#pragma unroll
    for (int o = 1; o < 64; o <<= 1) v += __shfl_xor(v, o);
    return v;
}
__device__ __forceinline__ float wave_max(float v) {
#pragma unroll
    for (int o = 1; o < 64; o <<= 1) v = fmaxf(v, __shfl_xor(v, o));
    return v;
}
__device__ __forceinline__ float fast_exp(float v) { return __builtin_amdgcn_exp2f(v * LOG2E); }
__device__ __forceinline__ float sigmoidf_(float v) { return __builtin_amdgcn_rcpf(1.0f + fast_exp(-v)); }
__device__ __forceinline__ float siluf_(float v) { return v * sigmoidf_(v); }
__device__ __forceinline__ float logsigmoidf_(float v) { return fminf(v, 0.f) - __logf(1.0f + fast_exp(-fabsf(v))); }

namespace pg8 {
constexpr int BM = 256, BK = 64, HALF = 128, HTB = HALF * BK * 2  , STAGE_BYTES = 8 * HTB, NXCD = 8, WGM = 8;
__host__ __device__ __forceinline__ int lds_byte(int r, int c) { const int st = (r >> 4) * 2 + (c >> 5), rr = r & 15, cc = c & 31, ob = rr * 64 + cc * 2; return st * 1024 + (ob ^ (((ob >> 9) & 1) << 5)); }
__host__ __device__ __forceinline__ void stage_rc(int b, int& R, int& C) { const int st = b / 1024, sb = b % 1024, swz = sb ^ (((sb >> 9) & 1) << 5); R = (st >> 1) * 16 + swz / 64; C = (st & 1) * 32 + (swz % 64) / 2; }
__host__ __device__ __forceinline__ int perm32(int rho) { const int n = rho >> 4, i = rho & 15; return 8 * (i >> 2) + 4 * n + (i & 3); }

struct Unit { int pm, pn, e; };
struct Gemm { const bf16_t* A; const bf16_t* Bt; int lda, ldb, K; };

struct StaticOrder {
    int nM, nN, nwg, G, c;
    __device__ void init(int M, int N, int G_, int c_) { nM = M / BM; nN = N / BM; nwg = nM * nN; G = G_; c = c_; }
    __device__ bool next(int i, Unit& u) const {
        const long L = (long)i * G + c; if (L >= nwg) return false;
        int wgid = (int)L; { const int q = nwg / NXCD, r = nwg % NXCD, xcd = wgid % NXCD, off = wgid / NXCD; wgid = (xcd < r ? xcd * (q + 1) : r * (q + 1) + (xcd - r) * q) + off; }
        const int nig = WGM * nN, gid = wgid / nig, fm = gid * WGM, gsz = (nM - fm) < WGM ? (nM - fm) : WGM;
        u.pm = fm + ((wgid % nig) % gsz); u.pn = (wgid % nig) / gsz; u.e = 0; return true;
    }
    __device__ __forceinline__ const char* a_tile(const Gemm& g, const Unit& u) const { return (const char*)g.A + (size_t)u.pm * BM * g.lda * 2; }
    __device__ __forceinline__ const char* b_tile(const Gemm& g, const Unit& u) const { return (const char*)g.Bt + (size_t)u.pn * BM * g.ldb * 2; }
    __device__ __forceinline__ void a_voff(const Gemm& g, const Unit&, const int (&R)[2], const int (&C)[2], unsigned (&v)[2][2]) const {
#pragma unroll
        for (int h = 0; h < 2; ++h)
#pragma unroll
            for (int i = 0; i < 2; ++i) v[h][i] = (unsigned)((h * HALF + R[i]) * g.lda + C[i]) * 2u;
    }
};
struct MoeOrder {
    int G, c, nN; const LAS int* tab; const int* list; bool gather; size_t bstride;
    __device__ bool next(int i, Unit& u) const {
        const int L = i * G + c; const int rt = L / nN; const int NT = tab[NE]; if (rt >= NT) return false;
        int e = 0;
#pragma unroll
        for (int k = 1; k < NE; ++k) e += (rt >= tab[k]) ? 1 : 0;
        u.pm = __builtin_amdgcn_readfirstlane(rt); u.pn = __builtin_amdgcn_readfirstlane(L % nN); u.e = __builtin_amdgcn_readfirstlane(e); return true;
    }
    __device__ __forceinline__ const char* a_tile(const Gemm& g, const Unit& u) const { return gather ? (const char*)g.A : (const char*)g.A + (size_t)u.pm * BM * g.lda * 2; }
    __device__ __forceinline__ const char* b_tile(const Gemm& g, const Unit& u) const { return (const char*)g.Bt + ((size_t)u.e * bstride + (size_t)u.pn * BM * g.ldb) * 2; }
    __device__ __forceinline__ void a_voff(const Gemm& g, const Unit& u, const int (&R)[2], const int (&C)[2], unsigned (&v)[2][2]) const {
        const int ts = tab[u.e], cn = tab[NE + 1 + u.e];
#pragma unroll
        for (int h = 0; h < 2; ++h)
#pragma unroll
            for (int i = 0; i < 2; ++i) {
                if (gather) { const int pos = (u.pm - ts) * BM + h * HALF + R[i]; const int tok = (pos < cn) ? list[u.e * T + pos] : 0; v[h][i] = (unsigned)(tok * g.lda + C[i]) * 2u; }
                else v[h][i] = (unsigned)((h * HALF + R[i]) * g.lda + C[i]) * 2u;
            }
    }
};

typedef __bf16 bf16x2_t __attribute__((ext_vector_type(2)));
__device__ __forceinline__ unsigned cvt_pk_bf16(float lo, float hi) { f32x2 v = {lo, hi}; bf16x2_t b = __builtin_convertvector(v, bf16x2_t); return __builtin_bit_cast(unsigned, b); }
__device__ __forceinline__ u32x4 pack8(const f32x4& v0, const f32x4& v1) { u32x4 w; w.x = cvt_pk_bf16(v0[0], v0[1]); w.y = cvt_pk_bf16(v0[2], v0[3]); w.z = cvt_pk_bf16(v1[0], v1[1]); w.w = cvt_pk_bf16(v1[2], v1[3]); return w; }
__device__ __forceinline__ void unpack8(const u32x4& w, f32x4& v0, f32x4& v1) { v0[0] = bflo(w.x); v0[1] = bfhi(w.x); v0[2] = bflo(w.y); v0[3] = bfhi(w.y); v1[0] = bflo(w.z); v1[1] = bfhi(w.z); v1[2] = bflo(w.w); v1[3] = bfhi(w.w); }
__device__ __forceinline__ f32x4 sig4(const f32x4& v) { f32x4 o; o[0] = sigmoidf_(v[0]); o[1] = sigmoidf_(v[1]); o[2] = sigmoidf_(v[2]); o[3] = sigmoidf_(v[3]); return o; }

struct EpiInproj {
    static constexpr bool PERM = true;
    unsigned char* ws; int layer;
    template <int KIND> __device__ __forceinline__ void tile(const f32x4 (&acc)[2][2][4][2], const Unit& u, int wr, int wc, int fr, int fq, unsigned char* w) const {
        const float* biasp = (const float*)(w + WS_MISC + 16384);
        const int row0 = u.pm * BM + wr * 64 + fr, bcol0 = u.pn * BM + wc * 32 + 8 * fq;
        f32x4 bv[2][2];
#pragma unroll
        for (int bj = 0; bj < 2; ++bj)
#pragma unroll
            for (int n = 0; n < 2; ++n) bv[bj][n] = *(const f32x4*)(biasp + bcol0 + bj * HALF + 4 * n);
#pragma unroll
        for (int ai = 0; ai < 2; ++ai)
#pragma unroll
            for (int m = 0; m < 4; ++m) { const size_t row = (size_t)(row0 + ai * HALF + m * 16);
#pragma unroll
                for (int bj = 0; bj < 2; ++bj) { f32x4 v0 = acc[ai][bj][m][0] + bv[bj][0], v1 = acc[ai][bj][m][1] + bv[bj][1]; const int col = bcol0 + bj * HALF;
                    if (KIND == 0) { *(u32x4*)((bf16_t*)(w + WS_QO) + row * 1024 + col) = pack8(v0 * C2, v1 * C2); }
                    else if (KIND == 1) { *(u32x4*)((bf16_t*)(w + WS_KV) + row * 1024 + (col - 512)) = pack8(v0, v1); }
                    else if (KIND == 2) { *(u32x4*)((bf16_t*)(w + WS_KV) + row * 1024 + 512 + (col - 1024)) = pack8(v0, v1); }
                    else if (KIND == 3) { *(u32x4*)((bf16_t*)(w + WS_HB) + row * 1024 + (col - 1536)) = pack8(v0 * sig4(v0), v1 * sig4(v1)); }
                    else if (KIND == 4) { const int c = col - 2048; const float* lb = (const float*)(w + WS_MISC) + layer * 512; const f32x4 l0 = *(const f32x4*)(lb + c), l1 = *(const f32x4*)(lb + c + 4);
                        f32x4 f0 = l0 + (1.f - l0) * sig4(v0), f1 = l1 + (1.f - l1) * sig4(v1);
#pragma unroll
                        for (int q = 0; q < 4; ++q) { f0[q] = __logf(f0[q]); f1[q] = __logf(f1[q]); }
                        float* LOGF = (float*)(w + WS_LOGF); *(f32x4*)(LOGF + row * 512 + c) = f0; *(f32x4*)(LOGF + row * 512 + c + 4) = f1; }
                    else if (KIND == 5) { *(u32x4*)((bf16_t*)(w + WS_HB) + row * 1024 + 512 + (col - 2560)) = pack8(v0, v1); }
                    else if (KIND == 6) { *(u32x4*)((bf16_t*)(w + WS_HG) + row * 512 + (col - 3072)) = pack8(v0 * sig4(v0), v1 * sig4(v1)); }
                    else if (KIND == 7) { *(u32x4*)((bf16_t*)(w + WS_G) + row * 2048 + (col - 3584)) = pack8(sig4(v0), sig4(v1)); }
                    else { if (col == 5632) { f32x4 f0, f1;
#pragma unroll
                            for (int q = 0; q < 4; ++q) { f0[q] = logsigmoidf_(v0[q]); f1[q] = logsigmoidf_(v1[q]); }
                            float* FL = (float*)(w + WS_FL); *(f32x4*)(FL + row * 8) = f0; *(f32x4*)(FL + row * 8 + 4) = f1; } }
                } }
    }
    __device__ __forceinline__ void operator()(const f32x4 (&acc)[2][2][4][2], const Unit& u, int wr, int wc, int fr, int fq) const {
        size_t z_ = 0; asm volatile("" : "+s"(z_)); unsigned char* w = ws + z_;
        const int ct = u.pn;
        if (ct < 2) tile<0>(acc, u, wr, wc, fr, fq, w); else if (ct < 4) tile<1>(acc, u, wr, wc, fr, fq, w); else if (ct < 6) tile<2>(acc, u, wr, wc, fr, fq, w);
        else if (ct < 8) tile<3>(acc, u, wr, wc, fr, fq, w); else if (ct < 10) tile<4>(acc, u, wr, wc, fr, fq, w); else if (ct < 12) tile<5>(acc, u, wr, wc, fr, fq, w);
        else if (ct < 14) tile<6>(acc, u, wr, wc, fr, fq, w); else if (ct < 22) tile<7>(acc, u, wr, wc, fr, fq, w); else tile<8>(acc, u, wr, wc, fr, fq, w);
    }
};
template <int MODE> struct EpiGate {
    static constexpr bool PERM = true;
    bf16_t* O; const float* bias; const bf16_t* Gt; int ldg; const bf16_t* P;
    __device__ __forceinline__ void operator()(const f32x4 (&acc)[2][2][4][2], const Unit& u, int wr, int wc, int fr, int fq) const {
        const int row0 = u.pm * BM + wr * 64 + fr, col0 = u.pn * BM + wc * 32 + 8 * fq;
        f32x4 bv[2][2];
        if (MODE == 0) {
#pragma unroll
            for (int bj = 0; bj < 2; ++bj)
#pragma unroll
                for (int n = 0; n < 2; ++n) bv[bj][n] = bias ? *(const f32x4*)(bias + col0 + bj * HALF + 4 * n) : (f32x4){0.f, 0.f, 0.f, 0.f};
        }
#pragma unroll
        for (int ai = 0; ai < 2; ++ai)
#pragma unroll
            for (int mh = 0; mh < 2; ++mh) {
                u32x4 gq[2][2], pq[2][2];
                if (MODE != 0) {
#pragma unroll
                    for (int mm = 0; mm < 2; ++mm)
#pragma unroll
                        for (int bj = 0; bj < 2; ++bj) { const size_t row = (size_t)(row0 + ai * HALF + (mh * 2 + mm) * 16); const int col = col0 + bj * HALF;
                            gq[mm][bj] = *(const u32x4*)(Gt + row * ldg + col);
                            if (MODE == 2) pq[mm][bj] = *(const u32x4*)(P + row * 1024 + col); }
                    asm volatile("s_waitcnt vmcnt(0)" ::: "memory");
                }
#pragma unroll
                for (int mm = 0; mm < 2; ++mm)
#pragma unroll
                    for (int bj = 0; bj < 2; ++bj) { const int m = mh * 2 + mm; const size_t row = (size_t)(row0 + ai * HALF + m * 16); const int col = col0 + bj * HALF;
                        f32x4 v0 = acc[ai][bj][m][0], v1 = acc[ai][bj][m][1];
                        if (MODE == 0) { v0 += bv[bj][0]; v1 += bv[bj][1]; }
                        else { f32x4 g0, g1; unpack8(gq[mm][bj], g0, g1); v0 *= g0; v1 *= g1;
                            if (MODE == 2) { f32x4 p0, p1; unpack8(pq[mm][bj], p0, p1); v0 += p0; v1 += p1; } }
                        *(u32x4*)(O + row * 1024 + col) = pack8(v0, v1); }
                if (MODE != 0) asm volatile("" ::: "memory");
            }
    }
};
struct EpiUp {
    static constexpr bool PERM = true;
    bf16_t* H;
    __device__ __forceinline__ void operator()(const f32x4 (&acc)[2][2][4][2], const Unit& u, int wr, int wc, int fr, int fq) const {
        const int row0 = u.pm * BM + wr * 64 + fr, col = u.pn * HALF + wc * 32 + 8 * fq;
#pragma unroll
        for (int ai = 0; ai < 2; ++ai)
#pragma unroll
            for (int m = 0; m < 4; ++m) { const size_t row = (size_t)(row0 + ai * HALF + m * 16);
                const f32x4 a0 = acc[ai][0][m][0], a1 = acc[ai][0][m][1], b0 = acc[ai][1][m][0], b1 = acc[ai][1][m][1];
                *(u32x4*)(H + row * 1024 + col) = pack8(a0 * sig4(a0) * b0, a1 * sig4(a1) * b1); }
    }
};

template <class Epi, class Sched, bool ALIGN_EPI>
__device__ __forceinline__ void gemm_phase(LAS unsigned char* lds, const Gemm g, const Sched& S, const Epi& E, const int tid) {
    const int wid = __builtin_amdgcn_readfirstlane(tid >> 6), lane = tid & 63, wr = wid >> 2, wc = wid & 3, fr = lane & 15, fq = lane >> 4;
    const int K = g.K, nt = K / BK;
    int RA[2], CA[2]; unsigned voffB[2];
#pragma unroll
    for (int i = 0; i < 2; ++i) { int R, C; stage_rc(tid * 16 + i * 8192, R, C); const int Rb = Epi::PERM ? ((R & ~31) + perm32(R & 31)) : R;
        RA[i] = R; CA[i] = C; voffB[i] = (unsigned)(Rb * g.ldb + C) * 2u; }
    const size_t kstep = (size_t)(BK * 2);
    const size_t hstepB = (size_t)HALF * g.ldb * 2;
    const unsigned ldsw = (unsigned)wid * 1024u;
    const int aoff = lds_byte(wr * 64 + fr, fq * 8), boff = lds_byte(wc * 32 + fr, fq * 8);
#define PG8_SA(b, h) (((b) * 2 + (h)) * HTB)
#define PG8_SB(b, h) ((4 + (b) * 2 + (h)) * HTB)
#define PG8_STAGE(bufoff, gbase, voff) do { _Pragma("unroll") for (int _i = 0; _i < 2; ++_i) \
        __builtin_amdgcn_global_load_lds((const unsigned*)((const char*)(gbase) + (voff)[_i]), (LAS unsigned*)(lds + (bufoff) + ldsw + _i * 8192), 16, 0, 0); } while (0)
#define PG8_LDA(dst, b, h) do { _Pragma("unroll") for (int m = 0; m < 4; ++m) _Pragma("unroll") for (int k = 0; k < 2; ++k) dst[m][k] = *(const LAS bf16x8*)(lds + PG8_SA(b, h) + aoff + m * 2048 + k * 1024); } while (0)
#define PG8_LDB(dst, b, h) do { _Pragma("unroll") for (int n = 0; n < 2; ++n) _Pragma("unroll") for (int k = 0; k < 2; ++k) dst[n][k] = *(const LAS bf16x8*)(lds + PG8_SB(b, h) + boff + n * 2048 + k * 1024); } while (0)
#define PG8_MMA(ai, bj, At, Bt) do { __builtin_amdgcn_s_setprio(1); _Pragma("unroll") for (int m = 0; m < 4; ++m) _Pragma("unroll") for (int n = 0; n < 2; ++n) _Pragma("unroll") for (int k = 0; k < 2; ++k) \
        acc[ai][bj][m][n] = __builtin_amdgcn_mfma_f32_16x16x32_bf16(Bt[n][k], At[m][k], acc[ai][bj][m][n], 0, 0, 0); __builtin_amdgcn_s_setprio(0); } while (0)
#define PG8_WAIT_V(n) asm volatile("s_waitcnt vmcnt(" #n ")" ::: "memory")
#define PG8_WAIT_L(n) asm volatile("s_waitcnt lgkmcnt(" #n ")" ::: "memory")
#define PG8_BAR __builtin_amdgcn_s_barrier()
#define PG8_SCHED __builtin_amdgcn_sched_barrier(0)
    Unit cur, nxt; int ui = 0;
    if (!S.next(0, cur)) return;
    f32x4 acc[2][2][4][2];
#pragma unroll
    for (int a = 0; a < 2; ++a)
#pragma unroll
        for (int b = 0; b < 2; ++b)
#pragma unroll
            for (int m = 0; m < 4; ++m)
#pragma unroll
                for (int n = 0; n < 2; ++n) acc[a][b][m][n] = (f32x4){0.f, 0.f, 0.f, 0.f};
    bf16x8 At[4][2], B0[2][2], B1[2][2];
    unsigned vA[2][2], nvA[2][2];
    S.a_voff(g, cur, RA, CA, vA);
    const char* cA = S.a_tile(g, cur); const char* cB = S.b_tile(g, cur);
    PG8_STAGE(PG8_SB(0, 0), cB, voffB); PG8_STAGE(PG8_SB(0, 1), cB + hstepB, voffB); PG8_STAGE(PG8_SA(0, 0), cA, vA[0]); PG8_STAGE(PG8_SA(0, 1), cA, vA[1]);
    if (wr == 1) PG8_BAR;
    PG8_WAIT_V(2); PG8_BAR;
    PG8_STAGE(PG8_SB(1, 0), cB + kstep, voffB); PG8_STAGE(PG8_SA(1, 0), cA + kstep, vA[0]); PG8_STAGE(PG8_SB(1, 1), cB + hstepB + kstep, voffB);
    PG8_WAIT_V(6); PG8_BAR;
    for (;;) {
        const bool has_next = S.next(ui + 1, nxt);
        const char* nA = has_next ? S.a_tile(g, nxt) : cA; const char* nB = has_next ? S.b_tile(g, nxt) : cB;
        if (has_next) S.a_voff(g, nxt, RA, CA, nvA);
        else {
#pragma unroll
            for (int h = 0; h < 2; ++h)
#pragma unroll
                for (int i = 0; i < 2; ++i) nvA[h][i] = vA[h][i]; }
        for (int t = 0; t < nt; t += 2) {
            const bool last = (t == nt - 2);
            const char* a1 = cA + (size_t)(t + 1) * kstep;
            const char* a2 = last ? nA : cA + (size_t)(t + 2) * kstep; const char* b2 = last ? nB : cB + (size_t)(t + 2) * kstep;
            const char* a3 = a2 + kstep; const char* b3 = b2 + kstep;
            unsigned wA0[2], wA1[2];
#pragma unroll
            for (int i = 0; i < 2; ++i) { wA0[i] = last ? nvA[0][i] : vA[0][i]; wA1[i] = last ? nvA[1][i] : vA[1][i]; }
            PG8_LDB(B0, 0, 0); PG8_LDB(B1, 0, 1); PG8_SCHED; PG8_LDA(At, 0, 0); PG8_STAGE(PG8_SA(1, 1), a1, vA[1]);
            PG8_WAIT_V(8); PG8_WAIT_L(0); PG8_BAR; PG8_MMA(0, 0, At, B0); PG8_MMA(0, 1, At, B1); PG8_BAR; PG8_SCHED;
            PG8_LDA(At, 0, 1); PG8_STAGE(PG8_SB(0, 0), b2, voffB); PG8_STAGE(PG8_SB(0, 1), b2 + hstepB, voffB); PG8_STAGE(PG8_SA(0, 0), a2, wA0);
            PG8_WAIT_V(8); PG8_WAIT_L(0); PG8_BAR; PG8_MMA(1, 0, At, B0); PG8_MMA(1, 1, At, B1); PG8_BAR; PG8_SCHED;
            PG8_LDB(B0, 1, 0); PG8_LDB(B1, 1, 1); PG8_SCHED; PG8_LDA(At, 1, 0); PG8_STAGE(PG8_SA(0, 1), a2, wA1);
            PG8_WAIT_V(8); PG8_WAIT_L(0); PG8_BAR; PG8_MMA(0, 0, At, B0); PG8_MMA(0, 1, At, B1); PG8_BAR; PG8_SCHED;
            PG8_LDA(At, 1, 1); PG8_STAGE(PG8_SB(1, 0), b3, voffB); PG8_STAGE(PG8_SB(1, 1), b3 + hstepB, voffB); PG8_STAGE(PG8_SA(1, 0), a3, wA0);
            PG8_WAIT_V(8); PG8_WAIT_L(0); PG8_BAR; PG8_MMA(1, 0, At, B0); PG8_MMA(1, 1, At, B1); PG8_BAR; PG8_SCHED;
        }
        if constexpr (ALIGN_EPI) { if (wr == 0) PG8_BAR; }
        E(acc, cur, wr, wc, fr, fq);
        if (!has_next) break;
#pragma unroll
        for (int a = 0; a < 2; ++a)
#pragma unroll
            for (int b = 0; b < 2; ++b)
#pragma unroll
                for (int m = 0; m < 4; ++m)
#pragma unroll
                    for (int n = 0; n < 2; ++n) acc[a][b][m][n] = (f32x4){0.f, 0.f, 0.f, 0.f};
        cur = nxt; cA = nA; cB = nB; ++ui;
#pragma unroll
        for (int h = 0; h < 2; ++h)
#pragma unroll
            for (int i = 0; i < 2; ++i) vA[h][i] = nvA[h][i];
        if constexpr (ALIGN_EPI) { if (wr == 1) PG8_BAR; }
    }
    PG8_WAIT_V(0);
    if constexpr (!ALIGN_EPI) { if (wr == 0) PG8_BAR; }
    PG8_BAR;
#undef PG8_SA
#undef PG8_SB
#undef PG8_STAGE
#undef PG8_LDA
#undef PG8_LDB
#undef PG8_MMA
#undef PG8_WAIT_V
#undef PG8_WAIT_L
#undef PG8_BAR
#undef PG8_SCHED
}
}


#include <hip/hip_bf16.h>
#include <cmath>
namespace attn_body {
using bf16=__hip_bfloat16;
using bf16x8=__attribute__((ext_vector_type(8)))short;
using s16x4=__attribute__((ext_vector_type(4)))short;
using f32x16=__attribute__((ext_vector_type(16)))float;
using u32x4=__attribute__((ext_vector_type(4)))unsigned;
constexpr int BATCH=16,NHEAD=8,SEQ=2048,D=64,DM=1024;
constexpr int NW=8,QBLK=32,QB=QBLK*NW,KVBLK=64,NQB=SEQ/QB;
constexpr int ATTN_PITCH=DM, ATTN_UNIT_ROWS=QB;
__device__ __forceinline__ int crow(int r,int hi){return (r&3)+8*(r>>2)+4*hi;}
#define SBAR() __builtin_amdgcn_sched_barrier(0)
__device__ __forceinline__ void cmask(f32x16&p0,f32x16&p1,int jb,int qrel,int hi){
  const float NEG=-INFINITY; int kb=64*jb+4*hi;
  #pragma unroll
  for(int r=0;r<16;++r){int kv=kb+(r&3)+8*(r>>2); if(kv>qrel)p0[r]=NEG; if(kv+32>qrel)p1[r]=NEG;}
}

constexpr int NSLOT=3, SLOTB=8192;
constexpr int LDS_K=0, LDS_V=NSLOT*SLOTB, LDS_WS=2*NSLOT*SLOTB, LDS_OST=LDS_WS+NW*64*4, LDS_BYTES=LDS_OST+NW*4096;
constexpr float C2=0.125f*1.4426950408889634f;
__device__ __forceinline__ void glds16(const void*gsrc,unsigned lds_dst){unsigned keep;
  asm volatile("s_mov_b32 %0, m0\n\ts_mov_b32 m0, %2\n\ts_nop 0\n\tglobal_load_lds_dwordx4 %1, off\n\ts_mov_b32 m0, %0":"=&s"(keep):"v"(gsrc),"s"(lds_dst):"memory");}
__device__ __forceinline__ float max3f(float a,float b,float c){float r;asm("v_max3_f32 %0, %1, %2, %3":"=v"(r):"v"(a),"v"(b),"v"(c));return r;}
__device__ __forceinline__ float max2f(float a,float b){float r;asm("v_max_f32_e32 %0, %1, %2":"=v"(r):"v"(a),"v"(b));return r;}
__device__ __forceinline__ float fadd_s(float a,float b){float r;asm("v_add_f32_e32 %0, %1, %2":"=v"(r):"v"(a),"v"(b));return r;}
__device__ __forceinline__ float fsub_s(float a,float b){float r;asm("v_sub_f32_e32 %0, %1, %2":"=v"(r):"v"(a),"v"(b));return r;}
typedef float f32x2_t __attribute__((ext_vector_type(2))); typedef __bf16 bf16x2_t __attribute__((ext_vector_type(2)));
__device__ __forceinline__ unsigned cvtpk_s(float lo,float hi){f32x2_t v={lo,hi};bf16x2_t b=__builtin_convertvector(v,bf16x2_t);return __builtin_bit_cast(unsigned,b);}
#define WAIT_BAR(N) asm volatile("s_waitcnt vmcnt(" #N ") lgkmcnt(0)\n\ts_barrier":::"memory")

__device__ __forceinline__ void qkt(f32x16&p0,f32x16&p1,const char*Kslot,const bf16x8*qr,const f32x16&negm,int r32,int hi){
  const char*kb=Kslot+hi*1024+r32*16;
  #pragma unroll
  for(int d0=0;d0<4;++d0){
    const bf16x8 b0=*reinterpret_cast<const bf16x8*>(kb+d0*2048);
    const bf16x8 b1=*reinterpret_cast<const bf16x8*>(kb+d0*2048+512);
    if(d0==0){p0=__builtin_amdgcn_mfma_f32_32x32x16_bf16(b0,qr[0],negm,0,0,0);p1=__builtin_amdgcn_mfma_f32_32x32x16_bf16(b1,qr[0],negm,0,0,0);}
    else{p0=__builtin_amdgcn_mfma_f32_32x32x16_bf16(b0,qr[d0],p0,0,0,0);p1=__builtin_amdgcn_mfma_f32_32x32x16_bf16(b1,qr[d0],p1,0,0,0);}}
}
typedef __attribute__((address_space(3))) const char* lds_cptr;
typedef short v4i16_t __attribute__((ext_vector_type(4)));
__device__ __forceinline__ void kload8(bf16x8*kf,lds_cptr kp){
  kf[0]=*(const __attribute__((address_space(3))) bf16x8*)(kp);      kf[1]=*(const __attribute__((address_space(3))) bf16x8*)(kp+512);
  kf[2]=*(const __attribute__((address_space(3))) bf16x8*)(kp+2048); kf[3]=*(const __attribute__((address_space(3))) bf16x8*)(kp+2560);
  kf[4]=*(const __attribute__((address_space(3))) bf16x8*)(kp+4096); kf[5]=*(const __attribute__((address_space(3))) bf16x8*)(kp+4608);
  kf[6]=*(const __attribute__((address_space(3))) bf16x8*)(kp+6144); kf[7]=*(const __attribute__((address_space(3))) bf16x8*)(kp+6656);
}
__device__ __forceinline__ void kload2(bf16x8*kf,lds_cptr kp,int j){ kf[2*j]=*(const __attribute__((address_space(3))) bf16x8*)(kp+j*2048); kf[2*j+1]=*(const __attribute__((address_space(3))) bf16x8*)(kp+j*2048+512); }
__device__ __forceinline__ s16x4 vtr(lds_cptr p){ return __builtin_bit_cast(s16x4,__builtin_amdgcn_ds_read_tr16_b64_v4i16((__attribute__((address_space(3))) v4i16_t*)p)); }
__device__ __forceinline__ float rowmax(const f32x16&p0,const f32x16&p1){
  float a=max3f(p0[0],p0[1],p1[0]),b=max3f(p0[2],p0[3],p1[1]);a=max3f(a,p1[2],p1[3]);
  #pragma unroll
  for(int r=4;r<16;r+=4){a=max3f(a,p0[r],p0[r+1]);b=max3f(b,p0[r+2],p0[r+3]);a=max3f(a,p1[r],p1[r+1]);b=max3f(b,p1[r+2],p1[r+3]);}
  const float m=max2f(a,b);
  auto rr=__builtin_amdgcn_permlane32_swap(__float_as_uint(m),__float_as_uint(m),false,false);
  return max2f(__uint_as_float(rr[0]),__uint_as_float(rr[1]));
}
__device__ __forceinline__ void pv(f32x16*o,int vb,bf16x8 pa0,bf16x8 pa1,bf16x8 pa2,bf16x8 pa3){
  #pragma unroll
  for(int d0=0;d0<2;++d0){s16x4 lo[4],hi[4];
    #pragma unroll
    for(int ks=0;ks<4;++ks){
      asm volatile("ds_read_b64_tr_b16 %0,%1 offset:%c2":"=&v"(lo[ks]):"v"(vb),"i"(d0*4096+ks*1024):"memory");
      asm volatile("ds_read_b64_tr_b16 %0,%1 offset:%c2":"=&v"(hi[ks]):"v"(vb),"i"(d0*4096+ks*1024+512):"memory");}
    asm volatile("s_waitcnt lgkmcnt(0)":::"memory");SBAR();
    #define PK(k) (bf16x8){lo[k][0],lo[k][1],lo[k][2],lo[k][3],hi[k][0],hi[k][1],hi[k][2],hi[k][3]}
    o[d0]=__builtin_amdgcn_mfma_f32_32x32x16_bf16(pa0,PK(0),o[d0],0,0,0);
    o[d0]=__builtin_amdgcn_mfma_f32_32x32x16_bf16(pa1,PK(1),o[d0],0,0,0);
    o[d0]=__builtin_amdgcn_mfma_f32_32x32x16_bf16(pa2,PK(2),o[d0],0,0,0);
    o[d0]=__builtin_amdgcn_mfma_f32_32x32x16_bf16(pa3,PK(3),o[d0],0,0,0);
    #undef PK
  }
}

#ifndef ATTN_STORE16
#define ATTN_STORE16(p,v) (*(u32x4*)(p)=(v))
#endif
template<int THRL> __device__ __forceinline__ void attn_unit(int b,int h,int qb,const bf16*Q,const bf16*__restrict__ K,const bf16*__restrict__ V,bf16*O,char*shm,const __attribute__((address_space(3))) float*f2,const int tid){
  #define BIAS_H(P,off,g0) { f32x4 x_[2]; _Pragma("unroll") for(int g_=0;g_<2;++g_) x_[g_]=*(const __attribute__((address_space(3))) f32x4*)(fb_+(off)+8*((g0)+g_)); \
      _Pragma("unroll") for(int g_=0;g_<2;++g_) _Pragma("unroll") for(int i_=0;i_<4;++i_) P[4*((g0)+g_)+i_]-=x_[g_][i_]; asm volatile("":::"memory"); }
  #define BIAS(P0,P1,t) do{ const __attribute__((address_space(3))) float* fb_=f2+64*(t)+4*hi; \
    BIAS_H(P0,0,0) BIAS_H(P0,0,2) BIAS_H(P1,32,0) BIAS_H(P1,32,2) }while(0)
  const int lane=tid&63,r32=lane&31,hi=lane>>5; const int wid=__builtin_amdgcn_readfirstlane(tid>>6);
  const long rowbase=(long)b*SEQ; const int q0=qb*QB;
  const bf16*Qw=Q+(rowbase+q0+wid*QBLK)*DM+h*D;
  const bf16*Kh=K+rowbase*DM+h*D,*Vh=V+rowbase*DM+h*D;
  const unsigned lds0=(unsigned)(uintptr_t)shm;
  float*wsf=(float*)(shm+LDS_WS)+wid*64;
  const bf16*ksrc=Kh+(long)lane*DM+wid*8;
  const bf16*vsrc=Vh+(long)(16*(wid&3)+(lane>>2))*DM+(wid>>2)*32+(lane&3)*8;
  const unsigned kdst=lds0+LDS_K+wid*1024, vdst=lds0+LDS_V+wid*1024;
  #define DMA_K(t,slot) glds16(ksrc+(long)(t)*KVBLK*DM,(unsigned)__builtin_amdgcn_readfirstlane(kdst+(slot)))
  #define DMA_V(t,slot) glds16(vsrc+(long)(t)*KVBLK*DM,(unsigned)__builtin_amdgcn_readfirstlane(vdst+(slot)))
  const int vb0=(int)(lds0+LDS_V)+((lane>>4)&1)*32+(lane&3)*8+(4*hi+((lane&15)>>2))*64;
  const char*Kbase=shm+LDS_K; bf16x8 kf[8];
  const lds_cptr shm3=(lds_cptr)shm; const lds_cptr kp0=shm3+LDS_K+hi*1024+r32*16; const lds_cptr vp0=shm3+LDS_V+((lane>>4)&1)*32+(lane&3)*8+(4*hi+((lane&15)>>2))*64;
  const int NT=(q0+QB)/KVBLK;
  DMA_K(0,0);DMA_V(0,0);DMA_K(1,SLOTB);
  bf16x8 qr[4];
  #pragma unroll
  for(int d0=0;d0<4;++d0)qr[d0]=*reinterpret_cast<const bf16x8*>(&Qw[(long)r32*DM+d0*16+hi*8]);
  float mhat=0.f,l_reg=0.f;f32x16 o[2];f32x16 negm; { float z_=0.f; asm volatile("":"+v"(z_)); _Pragma("unroll") for(int r=0;r<16;++r){o[0][r]=z_;o[1][r]=z_;negm[r]=z_;} } asm volatile("":"+v"(negm));
  const int qrel=wid*QBLK+r32;
  #define CMASK(P0,P1,t) do{int jb_=(t)-(NT-4); if(jb_>=0)cmask(P0,P1,jb_,qrel,hi);}while(0)
  bool resc=false;
  #define START(P0,P1) do{ const float rm=rowmax(P0,P1); resc=false; \
    { const float dl=rm; mhat=fadd_s(mhat,dl); \
      _Pragma("unroll") for(int r=0;r<16;++r){P0[r]=fsub_s(P0[r],dl);P1[r]=fsub_s(P1[r],dl);} \
      _Pragma("unroll") for(int r=0;r<16;++r)negm[r]=-mhat; asm volatile("":"+v"(negm)); } \
    _Pragma("unroll") for(int r=0;r<16;++r)P0[r]=__builtin_amdgcn_exp2f(P0[r]); }while(0)
  #define RESC() do{ if(resc){ asm volatile("s_waitcnt lgkmcnt(0)":::"memory"); \
      _Pragma("unroll") for(int d_=0;d_<2;++d_) _Pragma("unroll") for(int r=0;r<16;++r)o[d_][r]*=wsf[crow(r,hi)]; } }while(0)
  f32x16 pA0,pA1,pB0,pB1;
  int sl_prev=0,sl_cur=0,sl_next=SLOTB;
  #define ROT() do{sl_prev=sl_cur;sl_cur=sl_next;sl_next=(sl_next==(NSLOT-1)*SLOTB)?0:sl_next+SLOTB;}while(0)
  DMA_K(2,2*SLOTB);
  WAIT_BAR(3);
  qkt(pA0,pA1,Kbase,qr,negm,r32,hi);asm volatile("s_nop 15\n\ts_nop 7":"+v"(pA0),"+v"(pA1));CMASK(pA0,pA1,0);BIAS(pA0,pA1,0);
  START(pA0,pA1);
  _Pragma("unroll") for(int r=0;r<16;++r)pA1[r]=__builtin_amdgcn_exp2f(pA1[r]);
  WAIT_BAR(0);
  DMA_K(3,0);DMA_V(1,SLOTB);
  ROT();
  kload8(kf,kp0+sl_cur);
  WAIT_BAR(2);
  s16x4 vlo[8],vhi[8]; u32x4 pw0,pw1,pw2,pw3;
  #define PKW(P,B) cvtpk_s(P[B],P[B+1])
  #define PAF(k) __builtin_bit_cast(bf16x8,pw##k)
  #define VFR(i) (bf16x8){vlo[i][0],vlo[i][1],vlo[i][2],vlo[i][3],vhi[i][0],vhi[i][1],vhi[i][2],vhi[i][3]}
  #define PIN(x) asm volatile("":"+v"(x))
  #define MX3(a,b,c) __builtin_fmaxf(__builtin_fmaxf((a),(b)),(c))
  #define GAPA(MF,A0,A1,A2,A3,W0,W1,PW) do{ MF; sacc+=A0; sacc+=A1; sacc+=A2; sacc+=A3; PIN(sacc); W0; W1; PIN(PW); SBAR(); }while(0)
  #define EX(v) __builtin_amdgcn_exp2f(v)
  #define GAPB(MF,X,B) do{ MF; X[B]=EX(X[B]); X[B+1]=EX(X[B+1]); X[B+2]=EX(X[B+2]); X[B+3]=EX(X[B+3]); PIN(X); SBAR(); }while(0)
  #define VRD(i) do{ vlo[i]=vtr(vp_+(((i)>>2)*4096+((i)&3)*1024)); vhi[i]=vtr(vp_+(((i)>>2)*4096+((i)&3)*1024+512)); }while(0)
  #define KRD(G,j) do{ if(G){ kload2(kf,kp0+sl_next,j); SBAR(); } }while(0)
  #define STEP(C0,C1,P0,P1,t,GK,GV,GL) do{ SBAR(); \
    const lds_cptr vp_=vp0+sl_prev; \
    VRD(0); SBAR(); float sacc=(P0[0]+P0[1]); \
    GAPA(C0=__builtin_amdgcn_mfma_f32_32x32x16_bf16(kf[0],qr[0],negm,0,0,0), P0[2],P0[3],P0[4],P0[5],     pw0[0]=PKW(P0,0), pw0[1]=PKW(P0,2), pw0); \
    VRD(4); SBAR(); GAPA(C1=__builtin_amdgcn_mfma_f32_32x32x16_bf16(kf[1],qr[0],negm,0,0,0), P0[6],P0[7],P0[8],P0[9],     pw0[2]=PKW(P0,4), pw0[3]=PKW(P0,6), pw0); \
    VRD(1); SBAR(); GAPA(C0=__builtin_amdgcn_mfma_f32_32x32x16_bf16(kf[2],qr[1],C0,0,0,0),   P0[10],P0[11],P0[12],P0[13], pw1[0]=PKW(P0,8), pw1[1]=PKW(P0,10), pw1); \
    VRD(5); SBAR(); GAPA(C1=__builtin_amdgcn_mfma_f32_32x32x16_bf16(kf[3],qr[1],C1,0,0,0),   P0[14],P0[15],P1[0],P1[1],   pw1[2]=PKW(P0,12),pw1[3]=PKW(P0,14), pw1); \
    VRD(2); SBAR(); GAPA(C0=__builtin_amdgcn_mfma_f32_32x32x16_bf16(kf[4],qr[2],C0,0,0,0),   P1[2],P1[3],P1[4],P1[5],     pw2[0]=PKW(P1,0), pw2[1]=PKW(P1,2), pw2); \
    VRD(6); SBAR(); GAPA(C1=__builtin_amdgcn_mfma_f32_32x32x16_bf16(kf[5],qr[2],C1,0,0,0),   P1[6],P1[7],P1[8],P1[9],     pw2[2]=PKW(P1,4), pw2[3]=PKW(P1,6), pw2); \
    VRD(3); SBAR(); GAPA(C0=__builtin_amdgcn_mfma_f32_32x32x16_bf16(kf[6],qr[3],C0,0,0,0),   P1[10],P1[11],P1[12],P1[13], pw3[0]=PKW(P1,8), pw3[1]=PKW(P1,10), pw3); \
    VRD(7); SBAR(); GAPA(C1=__builtin_amdgcn_mfma_f32_32x32x16_bf16(kf[7],qr[3],C1,0,0,0),   P1[14],P1[15],0.f,0.f,       pw3[2]=PKW(P1,12),pw3[3]=PKW(P1,14), pw3); \
    l_reg+=sacc; \
    if(GK){DMA_K((t)+3,sl_cur);} if(GV){DMA_V((t)+1,sl_next);} \
    CMASK(C0,C1,t); BIAS(C0,C1,t); \
    { float a=MX3(C0[0],C0[1],C1[0]),b=MX3(C0[2],C0[3],C1[1]); a=MX3(a,C1[2],C1[3]); \
      _Pragma("unroll") for(int r=4;r<16;r+=4){a=MX3(a,C0[r],C0[r+1]);b=MX3(b,C0[r+2],C0[r+3]);a=MX3(a,C1[r],C1[r+1]);b=MX3(b,C1[r+2],C1[r+3]);} \
      float rm=__builtin_fmaxf(a,b); { auto rr=__builtin_amdgcn_permlane32_swap(__float_as_uint(rm),__float_as_uint(rm),false,false); rm=__builtin_fmaxf(__uint_as_float(rr[0]),__uint_as_float(rr[1])); } \
      resc=false; \
      if(__builtin_expect(__any(rm>(float)THRL),0)){ const float dl=__builtin_fmaxf(rm,0.f); mhat+=dl; \
        _Pragma("unroll") for(int r=0;r<16;++r){C0[r]-=dl;C1[r]-=dl;} \
        _Pragma("unroll") for(int r=0;r<16;++r)negm[r]=-mhat; asm volatile("":"+v"(negm)); \
        const float f=__builtin_amdgcn_exp2f(-dl); l_reg*=f; if(hi==0)wsf[r32]=f; resc=true; } } \
    SBAR(); \
    GAPB(o[0]=__builtin_amdgcn_mfma_f32_32x32x16_bf16(PAF(0),VFR(0),o[0],0,0,0), C0,0); \
    GAPB(o[1]=__builtin_amdgcn_mfma_f32_32x32x16_bf16(PAF(0),VFR(4),o[1],0,0,0), C0,4); \
    KRD(GL,0); GAPB(o[0]=__builtin_amdgcn_mfma_f32_32x32x16_bf16(PAF(1),VFR(1),o[0],0,0,0), C0,8); \
    KRD(GL,1); GAPB(o[1]=__builtin_amdgcn_mfma_f32_32x32x16_bf16(PAF(1),VFR(5),o[1],0,0,0), C0,12); \
    KRD(GL,2); GAPB(o[0]=__builtin_amdgcn_mfma_f32_32x32x16_bf16(PAF(2),VFR(2),o[0],0,0,0), C1,0); \
    KRD(GL,3); GAPB(o[1]=__builtin_amdgcn_mfma_f32_32x32x16_bf16(PAF(2),VFR(6),o[1],0,0,0), C1,4); \
    GAPB(o[0]=__builtin_amdgcn_mfma_f32_32x32x16_bf16(PAF(3),VFR(3),o[0],0,0,0), C1,8); \
    GAPB(o[1]=__builtin_amdgcn_mfma_f32_32x32x16_bf16(PAF(3),VFR(7),o[1],0,0,0), C1,12); \
    }while(0)
  int t=1;
  #undef CMASK
  #define CMASK(P0,P1,t) do{}while(0)
  for(;t+5<NT;t+=2){
    STEP(pB0,pB1,pA0,pA1,t,true,true,true);     WAIT_BAR(2); RESC(); ROT();
    STEP(pA0,pA1,pB0,pB1,t+1,true,true,true);   WAIT_BAR(2); RESC(); ROT();
  }
  #undef CMASK
  #define CMASK(P0,P1,t) do{int jb_=(t)-(NT-4); if(jb_>=0)cmask(P0,P1,jb_,qrel,hi);}while(0)
  #define ENDW(tt) do{ if((tt)+3<NT){WAIT_BAR(2);} else if((tt)+2<NT){WAIT_BAR(1);} else {WAIT_BAR(0);} }while(0)
  for(;t+1<NT;t+=2){
    STEP(pB0,pB1,pA0,pA1,t,(t+3<NT),(t+1<NT),(t+1<NT));       ENDW(t);   RESC(); ROT();
    STEP(pA0,pA1,pB0,pB1,t+1,(t+4<NT),(t+2<NT),(t+2<NT));     ENDW(t+1); RESC(); ROT();
  }
  STEP(pB0,pB1,pA0,pA1,NT-1,false,false,false); RESC();
  { float sacc=pB0[0]+pB0[1]; _Pragma("unroll") for(int r=2;r<16;++r)sacc+=pB0[r]; _Pragma("unroll") for(int r=0;r<16;++r)sacc+=pB1[r]; l_reg+=sacc;
    pw0=(u32x4){PKW(pB0,0),PKW(pB0,2),PKW(pB0,4),PKW(pB0,6)};pw1=(u32x4){PKW(pB0,8),PKW(pB0,10),PKW(pB0,12),PKW(pB0,14)};pw2=(u32x4){PKW(pB1,0),PKW(pB1,2),PKW(pB1,4),PKW(pB1,6)};pw3=(u32x4){PKW(pB1,8),PKW(pB1,10),PKW(pB1,12),PKW(pB1,14)};
    SBAR(); pv(o,vb0+sl_cur,PAF(0),PAF(1),PAF(2),PAF(3)); }
  #undef PKW
  #undef PAF
  #undef VFR
  #undef PIN
  #undef MX3
  #undef GAPA
  #undef GAPB
  #undef EX
  #undef VRD
  #undef KRD
  #undef STEP
  #undef ENDW
  {auto rr=__builtin_amdgcn_permlane32_swap(__float_as_uint(l_reg),__float_as_uint(l_reg),false,false);l_reg=__uint_as_float(rr[0])+__uint_as_float(rr[1]);}
  if(hi==0)wsf[32+r32]=l_reg;asm volatile("s_waitcnt lgkmcnt(0)":::"memory");
  float rli[16];
  #pragma unroll
  for(int r=0;r<16;++r)rli[r]=__builtin_amdgcn_rcpf(wsf[32+crow(r,hi)]);
  bf16*Ow=O+(rowbase+q0+wid*QBLK)*DM+h*D;
  { bf16*stg=(bf16*)(shm+LDS_OST)+wid*2048;
    #pragma unroll
    for(int r=0;r<16;++r){const int orow=crow(r,hi);
      #pragma unroll
      for(int d0=0;d0<2;++d0)stg[orow*64+d0*32+r32]=__float2bfloat16(o[d0][r]*rli[r]);}
    asm volatile("s_waitcnt lgkmcnt(0)":::"memory");
    #pragma unroll
    for(int i=0;i<4;++i){const int row=i*8+(lane>>3),ch=lane&7; const u32x4 v=*(const u32x4*)(stg+row*64+ch*8); ATTN_STORE16(Ow+(long)row*DM+ch*8,v);} }
  asm volatile("s_waitcnt lgkmcnt(0)\n\ts_barrier":::"memory");
  #undef BIAS
  #undef BIAS_H
  #undef DMA_K
  #undef DMA_V
  #undef CMASK
  #undef START
  #undef RESC
  #undef ROT
}
constexpr int ATTN_LDS_BYTES=LDS_BYTES;
#undef SBAR
#undef WAIT_BAR
}


constexpr int NWAVES = 8;
constexpr int RING_OFF = 0, RING_BYTES = 131072;
constexpr int LDSCTL_OFF = RING_BYTES, MISC_OFF = LDSCTL_OFF + 320, TAB_OFF = LDSCTL_OFF + 1024;
constexpr int LDS_BYTES = 147456;
typedef GAS unsigned gu32;
#define RLX_AGENT __ATOMIC_RELAXED, __HIP_MEMORY_SCOPE_AGENT

#define XB_TMO      128
#define XB_XCNT(j)  (256  + 64 * (j))
#define XB_XSUB(j)  (1280 + 64 * (j))
#define XB_XGEN(j)  (2304 + 64 * (j))
#define XB_TOP      3328
#define XB_TOPGEN   3392
#define XCD_BAR_WORDS 3456
#define XB_SPIN_CAP (1u << 18)

__device__ __forceinline__ unsigned xb_ld(unsigned* p)              { return __hip_atomic_load(p, __ATOMIC_RELAXED, __HIP_MEMORY_SCOPE_AGENT); }
__device__ __forceinline__ unsigned xb_add(unsigned* p, unsigned v) { return __hip_atomic_fetch_add(p, v, __ATOMIC_RELAXED, __HIP_MEMORY_SCOPE_AGENT); }
__device__ __forceinline__ unsigned xb_xcc_id() { return (unsigned)__builtin_amdgcn_s_getreg((3 << 11) | 20) & 0xFu; }
#define XB_SPIN(cond, bar) do { unsigned _sp = 0; while (cond) { __builtin_amdgcn_s_sleep(1); \
    if ((++_sp & 255u) == 0u) { if (xb_ld(&(bar)[XB_TMO])) break; if (_sp > XB_SPIN_CAP) { atomicAdd(&(bar)[XB_TMO], 1u); break; } } } } while (0)

struct XcdBarrier {
    unsigned* bar; unsigned x;
    volatile LAS unsigned* st;
};

__device__ __forceinline__ XcdBarrier xcd_barrier_post(unsigned* bar, volatile LAS unsigned* st) {
    XcdBarrier b; b.bar = bar; b.x = xb_xcc_id(); b.st = st;
    if (threadIdx.x == 0) (void)xb_add(&bar[XB_XCNT(b.x)], 1u);
    return b;
}
__device__ __forceinline__ void xcd_barrier_complete(unsigned* bar, unsigned x, unsigned& nloc, unsigned& nx) {
    const unsigned G = gridDim.x * gridDim.y * gridDim.z;
    unsigned sum, cnt, mine, sp = 0u;
    for (;;) {
        sum = 0u; cnt = 0u; mine = 0u;
#pragma unroll
        for (unsigned j = 0; j < 16; ++j) { const unsigned c = xb_ld(&bar[XB_XCNT(j)]); sum += c; cnt += (c > 0u) ? 1u : 0u; mine = (j == x) ? c : mine; }
        if (sum == G) break;
        __builtin_amdgcn_s_sleep(1);
        if ((++sp & 255u) == 0u) { if (xb_ld(&bar[XB_TMO])) break; if (sp > XB_SPIN_CAP) { atomicAdd(&bar[XB_TMO], 1u); break; } }
    }
    nloc = mine > 0u ? mine : 1u; nx = cnt > 0u ? cnt : 1u;
}

__device__ __forceinline__ void xcd_barrier(const XcdBarrier& b) {
    asm volatile("s_waitcnt vmcnt(0)" ::: "memory");
    __syncthreads();
    if (threadIdx.x == 0) {
        unsigned* bar = b.bar;
        __builtin_amdgcn_s_waitcnt(0);
        unsigned nloc = b.st[0], nx = b.st[1];
        if (nloc == 0u) { xcd_barrier_complete(bar, b.x, nloc, nx); b.st[0] = nloc; b.st[1] = nx; }
        const unsigned old = xb_add(&bar[XB_XSUB(b.x)], 1u);
        const unsigned gen = old / nloc;
        if (old + 1u == (gen + 1u) * nloc) {
            __builtin_amdgcn_fence(__ATOMIC_RELEASE, "agent");
            asm volatile("s_waitcnt vmcnt(0)" ::: "memory");
            const unsigned og = xb_add(&bar[XB_TOP], 1u);
            const unsigned tg = og / nx;
            if (og + 1u == (tg + 1u) * nx) xb_add(&bar[XB_TOPGEN], 1u);
            else XB_SPIN(xb_ld(&bar[XB_TOPGEN]) == tg, bar);
            __builtin_amdgcn_fence(__ATOMIC_ACQUIRE, "agent");
            xb_add(&bar[XB_XGEN(b.x)], 1u);
            asm volatile("s_waitcnt vmcnt(0)" ::: "memory");
        } else {
            XB_SPIN(xb_ld(&bar[XB_XGEN(b.x)]) == gen, bar);
            __builtin_amdgcn_fence(__ATOMIC_ACQUIRE, "agent");
            asm volatile("s_waitcnt vmcnt(0)" ::: "memory");
        }
    }
    __syncthreads();
}


struct Args {
    const float *x, *ln_in_g, *ln_in_b, *w_in, *b_in, *w_fox, *lbl, *norm_g, *w_hgrn, *w_mix, *b_mix, *ln1_g, *ln1_b, *router_w, *router_b, *w1, *w3, *w2, *ln2_g, *ln2_b;
    float* out; unsigned char* ws; int ph_lo, ph_hi, use_bar, pad;
};
struct Frame { LAS unsigned char* lds; int tid, lane, wave, G, gw, ngw, bid; };
#define LOAD_ARGS() launder_args(args)
__device__ __forceinline__ Args launder_args(const Args& args) { Args a = args; size_t z_ = 0; asm volatile("" : "+s"(z_)); a.ws = args.ws + z_; return a; }

__device__ __forceinline__ void ln_rows16(f32x4 (&v)[4], const float* g, const float* bta, int lane) {
    float s = 0.f;
#pragma unroll
    for (int j = 0; j < 4; ++j) s += (v[j].x + v[j].y) + (v[j].z + v[j].w);
    const float mean = wave_sum(s) * (1.f / D); float s2 = 0.f;
#pragma unroll
    for (int j = 0; j < 4; ++j) { v[j] = v[j] - mean; s2 += (v[j].x * v[j].x + v[j].y * v[j].y) + (v[j].z * v[j].z + v[j].w * v[j].w); }
    const float rstd = rsqrtf(wave_sum(s2) * (1.f / D) + LN_EPS);
#pragma unroll
    for (int j = 0; j < 4; ++j) { const int c = 4 * lane + 256 * j; const f32x4 gg = *(const f32x4*)(g + c), bb = *(const f32x4*)(bta + c); v[j] = v[j] * rstd * gg + bb; }
}
__device__ __forceinline__ void store_row(const f32x4 (&v)[4], int lane, float* of32, bf16_t* obf, float* of32b) {
#pragma unroll
    for (int j = 0; j < 4; ++j) { const int c = 4 * lane + 256 * j;
        if (of32) *(f32x4*)(of32 + c) = v[j];
        if (of32b) *(f32x4*)(of32b + c) = v[j];
        if (obf) { u32x2 w; w.x = pk2(v[j].x, v[j].y); w.y = pk2(v[j].z, v[j].w); *(u32x2*)(obf + c) = w; } }
}

__device__ __forceinline__ void cvt_item(const float* W, int ldw, int k0, int srccol, int nvalid, bf16_t* WT, int ldt, int dstrow, int dstk, LAS float* scr, int lane) {
#pragma unroll 8
    for (int i = 0; i < 32; ++i) { const int kk = 2 * i + (lane >> 5); const int n = lane & 31;
        scr[kk * 33 + n] = (n < nvalid) ? W[(size_t)(k0 + kk) * ldw + srccol + n] : 0.f; }
    asm volatile("s_waitcnt lgkmcnt(0)" ::: "memory");
    const int c = lane & 7;
#pragma unroll
    for (int j = 0; j < 4; ++j) { const int n = (lane >> 3) + 8 * j; const LAS float* s = scr + (8 * c) * 33 + n;
        u32x4 o; o.x = pk2(s[0 * 33], s[1 * 33]); o.y = pk2(s[2 * 33], s[3 * 33]); o.z = pk2(s[4 * 33], s[5 * 33]); o.w = pk2(s[6 * 33], s[7 * 33]);
        *(u32x4*)(WT + (size_t)(dstrow + n) * ldt + dstk + k0 + 8 * c) = o; }
    asm volatile("s_waitcnt lgkmcnt(0)" ::: "memory");
}
__device__ __forceinline__ void convert_layer(const Args& a, const Frame& F, int l) {
    LAS float* scr = (LAS float*)(F.lds + RING_OFF + F.wave * 16384);
    const int gw = F.gw, ngw = F.ngw, lane = F.lane;
    bf16_t* WIN = (bf16_t*)(a.ws + WS_WIN); bf16_t* WBR = (bf16_t*)(a.ws + WS_WBR); bf16_t* WMIX = (bf16_t*)(a.ws + WS_WMIX);
    bf16_t* W13 = (bf16_t*)(a.ws + WS_W13); bf16_t* W2 = (bf16_t*)(a.ws + WS_W2);
    constexpr int I_IN = 16 * 184, I_BR = 8 * 32, I_MIX = 16 * 32, I_13 = 16 * 64 * NE, I_2 = 16 * 32 * NE;
    constexpr int NITEMS = I_IN + 2 * I_BR + I_MIX + I_13 + I_2;
    for (int it = gw; it < NITEMS; it += ngw) {
        int r = it;
        if (r < I_IN) { const int kb = r / 184, nb = r % 184, n0 = nb * 32;
            int src, nv = 32; if (n0 < 1536) src = n0; else if (n0 < 5632) src = n0 + 8; else if (n0 == 5632) { src = 1536; nv = 8; } else { src = 0; nv = 0; }
            cvt_item(a.w_in + (size_t)l * D * NIN, NIN, kb * 64, src, nv, WIN, D, n0, 0, scr, lane); continue; } r -= I_IN;
        if (r < I_BR) { const int kb = r / 32, nb = r % 32; cvt_item(a.w_fox + (size_t)l * 512 * D, D, kb * 64, nb * 32, 32, WBR, D, nb * 32, 0, scr, lane); continue; } r -= I_BR;
        if (r < I_BR) { const int kb = r / 32, nb = r % 32; cvt_item(a.w_hgrn + (size_t)l * 512 * D, D, kb * 64, nb * 32, 32, WBR, D, nb * 32, 512, scr, lane); continue; } r -= I_BR;
        if (r < I_MIX) { const int kb = r / 32, nb = r % 32; cvt_item(a.w_mix + (size_t)l * D * D, D, kb * 64, nb * 32, 32, WMIX, D, nb * 32, 0, scr, lane); continue; } r -= I_MIX;
        if (r < I_13) { const int e = r / 1024, q = r % 1024, kb = q / 64, nb = q % 64, n0 = nb * 32;
            const int j = n0 >> 8, rr = n0 & 255; const float* src = (rr < 128 ? a.w1 : a.w3) + ((size_t)l * NE + e) * D * D;
            cvt_item(src, D, kb * 64, 128 * j + (rr & 127), 32, W13 + (size_t)e * 2048 * D, D, n0, 0, scr, lane); continue; } r -= I_13;
        { const int e = r / 512, q = r % 512, kb = q / 32, nb = q % 32;
            cvt_item(a.w2 + ((size_t)l * NE + e) * D * D, D, kb * 64, nb * 32, 32, W2 + (size_t)e * D * D, D, nb * 32, 0, scr, lane); }
    }
    float* biasp = (float*)(a.ws + WS_MISC + 16384);
    for (int n = gw * 64 + lane; n < NINP; n += ngw * 64) {
        float v = 0.f; if (n < 1536) v = a.b_in[l * NIN + n]; else if (n < 5632) v = a.b_in[l * NIN + n + 8]; else if (n < 5640) v = a.b_in[l * NIN + 1536 + (n - 5632)];
        biasp[n] = v; }
}

__device__ __forceinline__ void phase_prep(const Args& a, const Frame& F) {
    if (F.bid == 0) {
        float* lb_all = (float*)(a.ws + WS_MISC);
        const int c = F.tid;
        float v[DEPTH], m = -1e30f;
#pragma unroll
        for (int l = 0; l < DEPTH; ++l) { v[l] = a.lbl[l * 512 + c]; m = fmaxf(m, v[l]); }
        float s = 0.f;
#pragma unroll
        for (int l = 0; l < DEPTH; ++l) { v[l] = __expf(v[l] - m); s += v[l]; }
        float cum = 0.f;
#pragma unroll
        for (int l = 0; l < DEPTH; ++l) { const float p = v[l] / s; cum += p; lb_all[l * 512 + c] = cum - v[0] / s; }
    }
    float* XRES = (float*)(a.ws + WS_XRES); bf16_t* XN = (bf16_t*)(a.ws + WS_XN);
    for (int row = F.gw; row < T; row += F.ngw) {
        f32x4 v[4];
#pragma unroll
        for (int j = 0; j < 4; ++j) v[j] = *(const f32x4*)(a.x + (size_t)row * D + 4 * F.lane + 256 * j);
        ln_rows16(v, a.ln_in_g, a.ln_in_b, F.lane);
        store_row(v, F.lane, XRES + (size_t)row * D, XN + (size_t)row * D, nullptr);
    }
    convert_layer(a, F, 0);
}

__device__ __forceinline__ void phase_fscan(const Args& a, const Frame& F) {
    if (F.bid >= BATCH * NH) return;
    const float* FL = (const float*)(a.ws + WS_FL); float* F2 = (float*)(a.ws + WS_F2);
    LAS float* wsum = (LAS float*)(F.lds + RING_OFF);
    const int bh = F.bid, b = bh >> 3, h = bh & 7, tid = F.tid, lane = F.lane, w = F.wave;
    float v[4], run = 0.f;
#pragma unroll
    for (int i = 0; i < 4; ++i) { run += FL[((size_t)b * SEQ + tid * 4 + i) * 8 + h]; v[i] = run; }
    float incl = run;
#pragma unroll
    for (int o = 1; o < 64; o <<= 1) { const float u = __shfl_up(incl, o); if (lane >= o) incl += u; }
    if (lane == 63) wsum[w] = incl;
    __syncthreads();
    float base = incl - run; for (int i = 0; i < w; ++i) base += wsum[i];
#pragma unroll
    for (int i = 0; i < 4; ++i) F2[(size_t)bh * SEQ + tid * 4 + i] = (base + v[i]) * LOG2E;
    __syncthreads();
}

__device__ __forceinline__ void phase_attn_naive(const Args& a, const Frame& F) {
    const bf16_t* QO = (const bf16_t*)(a.ws + WS_QO); const bf16_t* KV = (const bf16_t*)(a.ws + WS_KV); const float* F2 = (const float*)(a.ws + WS_F2); bf16_t* O = (bf16_t*)(a.ws + WS_QO);
    LAS float* ps = (LAS float*)(F.lds + RING_OFF) + F.wave * 64;
    const int lane = F.lane;
    for (int gid = F.gw; gid < BATCH * NH * SEQ; gid += F.ngw) {
        const int bh = gid & 127, t = gid >> 7, b = bh >> 3, h = bh & 7;
        float q[64];
        { const bf16_t* qp = QO + ((size_t)b * SEQ + t) * 1024 + h * 64;
#pragma unroll
          for (int c = 0; c < 8; ++c) { const u32x4 u = *(const u32x4*)(qp + c * 8);
            q[c * 8 + 0] = bflo(u.x); q[c * 8 + 1] = bfhi(u.x); q[c * 8 + 2] = bflo(u.y); q[c * 8 + 3] = bfhi(u.y);
            q[c * 8 + 4] = bflo(u.z); q[c * 8 + 5] = bfhi(u.z); q[c * 8 + 6] = bflo(u.w); q[c * 8 + 7] = bfhi(u.w); } }
        float m = -1e30f, l = 0.f, o = 0.f;
        const float* f2 = F2 + (size_t)bh * SEQ;
        for (int s0 = 0; s0 <= t; s0 += 64) {
            const int s = s0 + lane; const bool valid = s <= t;
            float sc = -1e30f;
            if (valid) { const bf16_t* kp = KV + ((size_t)b * SEQ + s) * 1024 + h * 64; float d = 0.f;
#pragma unroll
                for (int c = 0; c < 8; ++c) { const u32x4 u = *(const u32x4*)(kp + c * 8);
                    d += q[c * 8 + 0] * bflo(u.x) + q[c * 8 + 1] * bfhi(u.x) + q[c * 8 + 2] * bflo(u.y) + q[c * 8 + 3] * bfhi(u.y)
                       + q[c * 8 + 4] * bflo(u.z) + q[c * 8 + 5] * bfhi(u.z) + q[c * 8 + 6] * bflo(u.w) + q[c * 8 + 7] * bfhi(u.w); }
                sc = d - f2[s]; }
            const float mn = fmaxf(m, wave_max(sc));
            const float p = valid ? exp2f(sc - mn) : 0.f;
            const float f = exp2f(m - mn);
            l = l * f + wave_sum(p); o *= f; m = mn;
            ps[lane] = p;
            asm volatile("s_waitcnt lgkmcnt(0)" ::: "memory");
            const int nk = min(64, t - s0 + 1);
            const bf16_t* vp = KV + ((size_t)b * SEQ + s0) * 1024 + 512 + h * 64 + lane;
            for (int j = 0; j < nk; ++j) o += ps[j] * bf2f(vp[(size_t)j * 1024]);
            asm volatile("s_waitcnt lgkmcnt(0)" ::: "memory");
        }
        O[((size_t)b * SEQ + t) * 1024 + h * 64 + lane] = (bf16_t)f2bf(o / l);
    }
}

__device__ __forceinline__ void phase_hgrn_naive(const Args& a, const Frame& F, int l) {
    if (F.bid >= BATCH * NH || F.wave != 0) return;
    const bf16_t* HB = (const bf16_t*)(a.ws + WS_HB); const float* LOGF = (const float*)(a.ws + WS_LOGF); const bf16_t* HG = (const bf16_t*)(a.ws + WS_HG); bf16_t* O = (bf16_t*)(a.ws + WS_QO);
    LAS float* Lf = (LAS float*)(F.lds + RING_OFF + 1024); LAS float* Lk = Lf + 4096; LAS float* Lq = Lk + 4096;
    const int bh = F.bid, b = bh >> 3, h = bh & 7, lane = F.lane;
    float Sx[64];
#pragma unroll
    for (int d = 0; d < 64; ++d) Sx[d] = 0.f;
    const float ng = a.norm_g[l * 512 + h * 64 + lane];
    for (int c0 = 0; c0 < SEQ; c0 += 64) {
        for (int tt = 0; tt < 64; ++tt) { const size_t row = (size_t)b * SEQ + c0 + tt;
            const float lf = LOGF[row * 512 + h * 64 + lane]; const float f = __expf(lf);
            Lf[tt * 64 + lane] = f; Lk[tt * 64 + lane] = 1.f - f; Lq[tt * 64 + lane] = bf2f(HB[row * 1024 + h * 64 + lane]); }
        asm volatile("s_waitcnt lgkmcnt(0)" ::: "memory");
        for (int tt = 0; tt < 64; ++tt) { const size_t row = (size_t)b * SEQ + c0 + tt;
            const float v = bf2f(HB[row * 1024 + 512 + h * 64 + lane]);
            float o = 0.f;
#pragma unroll
            for (int d = 0; d < 64; d += 4) { const f32x4 f4 = *(const LAS f32x4*)(Lf + tt * 64 + d), k4 = *(const LAS f32x4*)(Lk + tt * 64 + d), q4 = *(const LAS f32x4*)(Lq + tt * 64 + d);
                Sx[d] = f4.x * Sx[d] + k4.x * v; o += Sx[d] * q4.x; Sx[d + 1] = f4.y * Sx[d + 1] + k4.y * v; o += Sx[d + 1] * q4.y;
                Sx[d + 2] = f4.z * Sx[d + 2] + k4.z * v; o += Sx[d + 2] * q4.z; Sx[d + 3] = f4.w * Sx[d + 3] + k4.w * v; o += Sx[d + 3] * q4.w; }
            const float ss = wave_sum(o * o);
            const float r = o * rsqrtf(ss * (1.f / 64.f) + RMS_EPS) * ng * bf2f(HG[row * 512 + h * 64 + lane]);
            O[row * 1024 + 512 + h * 64 + lane] = (bf16_t)f2bf(r); }
        asm volatile("s_waitcnt lgkmcnt(0)" ::: "memory");
    }
}

__device__ __forceinline__ void phase_ln1_router(const Args& a, const Frame& F, int l) {
    float* xres = (float*)(a.ws + WS_XRES); const bf16_t* mixed = (const bf16_t*)(a.ws + WS_MIXED); bf16_t* xn = (bf16_t*)(a.ws + WS_XN);
    unsigned* cnt = (unsigned*)(a.ws + WS_CTL) + CW_CNT + l * 64; int* list = (int*)(a.ws + WS_LIST); unsigned* tokinfo = (unsigned*)(a.ws + WS_TOK);
    const float* g = a.ln1_g + l * D; const float* bta = a.ln1_b + l * D;
    LAS float* rw = (LAS float*)(F.lds + RING_OFF);
    for (int i = F.tid; i < NE * D; i += NWAVES * 64) { const int c = i >> 4, e = i & 15; rw[e * D + c] = a.router_w[i]; }
    __syncthreads();
    const int lane = F.lane;
    for (int row = F.gw; row < T; row += F.ngw) {
        f32x4 v[4];
#pragma unroll
        for (int j = 0; j < 4; ++j) { const int c = 4 * lane + 256 * j; const f32x4 xv = *(const f32x4*)(xres + (size_t)row * D + c);
            const u32x2 mm = *(const u32x2*)(mixed + (size_t)row * D + c);
            v[j].x = ALPHA * xv.x + bflo(mm.x); v[j].y = ALPHA * xv.y + bfhi(mm.x); v[j].z = ALPHA * xv.z + bflo(mm.y); v[j].w = ALPHA * xv.w + bfhi(mm.y); }
        ln_rows16(v, g, bta, lane);
        store_row(v, lane, xres + (size_t)row * D, xn + (size_t)row * D, nullptr);
        float lg[NE];
#pragma unroll
        for (int e = 0; e < NE; ++e) { float p = 0.f;
#pragma unroll
            for (int j = 0; j < 4; ++j) { const f32x4 r4 = *(const LAS f32x4*)(rw + e * D + 4 * lane + 256 * j); p += v[j].x * r4.x + v[j].y * r4.y + v[j].z * r4.z + v[j].w * r4.w; }
            lg[e] = wave_sum(p) + a.router_b[e]; asm volatile("" ::: "memory"); }
        if (lane == 0) {
            int gs = 0; float gbest = -3e38f;
#pragma unroll
            for (int gi = 0; gi < 4; ++gi) { const float mx = fmaxf(fmaxf(lg[gi * 4], lg[gi * 4 + 1]), fmaxf(lg[gi * 4 + 2], lg[gi * 4 + 3])); if (mx > gbest) { gbest = mx; gs = gi; } }
            float l4[4];
#pragma unroll
            for (int i = 0; i < 4; ++i) { float t0 = lg[i];
#pragma unroll
                for (int gi = 1; gi < 4; ++gi) t0 = (gs == gi) ? lg[gi * 4 + i] : t0; l4[i] = t0; }
            int i0 = 0; float b0 = l4[0];
#pragma unroll
            for (int i = 1; i < 4; ++i) if (l4[i] > b0) { b0 = l4[i]; i0 = i; }
            int i1 = 0; float b1 = -3e38f;
#pragma unroll
            for (int i = 0; i < 4; ++i) if (i != i0 && l4[i] > b1) { b1 = l4[i]; i1 = i; }
            const float e1 = __expf(b1 - b0); const float g0 = 1.f / (1.f + e1), g1 = e1 / (1.f + e1);
            const int ex0 = gs * 4 + i0, ex1 = gs * 4 + i1;
            const unsigned p0 = atomicAdd(cnt + ex0, 1u), p1 = atomicAdd(cnt + ex1, 1u);
            list[ex0 * T + p0] = row; list[ex1 * T + p1] = row;
            tokinfo[row * 4 + 0] = ((unsigned)ex0 << 24) | p0; tokinfo[row * 4 + 1] = ((unsigned)ex1 << 24) | p1;
            tokinfo[row * 4 + 2] = __float_as_uint(g0); tokinfo[row * 4 + 3] = __float_as_uint(g1);
        }
    }
    __syncthreads();
}

__device__ __forceinline__ void moe_table(const Args& a, const Frame& F, int l) {
    LAS int* tab = (LAS int*)(F.lds + TAB_OFF);
    const unsigned* cnt = (const unsigned*)(a.ws + WS_CTL) + CW_CNT + l * 64;
    if (F.tid == 0) { int ts = 0; for (int e = 0; e < NE; ++e) { const int c = (int)__hip_atomic_load(cnt + e, RLX_AGENT); tab[e] = ts; tab[NE + 1 + e] = c; ts += (c + TM - 1) / TM; } tab[NE] = ts; }
    __syncthreads();
}

__device__ __forceinline__ void phase_combine_ln2(const Args& a, const Frame& F, int l) {
    float* xres = (float*)(a.ws + WS_XRES); const bf16_t* Y = (const bf16_t*)(a.ws + WS_Y); const unsigned* tokinfo = (const unsigned*)(a.ws + WS_TOK); bf16_t* xn = (bf16_t*)(a.ws + WS_XN);
    const float* g = a.ln2_g + l * D; const float* bta = a.ln2_b + l * D; float* out = (l == DEPTH - 1) ? a.out : nullptr;
    const LAS int* tab = (const LAS int*)(F.lds + TAB_OFF);
    const int lane = F.lane;
    for (int row = F.gw; row < T; row += F.ngw) {
        const unsigned i0 = tokinfo[row * 4], i1 = tokinfo[row * 4 + 1]; const float g0 = __uint_as_float(tokinfo[row * 4 + 2]), g1 = __uint_as_float(tokinfo[row * 4 + 3]);
        const size_t s0 = (size_t)tab[i0 >> 24] * TM + (i0 & 0xffffff), s1 = (size_t)tab[i1 >> 24] * TM + (i1 & 0xffffff);
        f32x4 v[4];
#pragma unroll
        for (int j = 0; j < 4; ++j) { const int c = 4 * lane + 256 * j; const f32x4 xv = *(const f32x4*)(xres + (size_t)row * D + c);
            const u32x2 ya = *(const u32x2*)(Y + s0 * D + c), yb = *(const u32x2*)(Y + s1 * D + c);
            v[j].x = ALPHA * xv.x + g0 * bflo(ya.x) + g1 * bflo(yb.x); v[j].y = ALPHA * xv.y + g0 * bfhi(ya.x) + g1 * bfhi(yb.x);
            v[j].z = ALPHA * xv.z + g0 * bflo(ya.y) + g1 * bflo(yb.y); v[j].w = ALPHA * xv.w + g0 * bfhi(ya.y) + g1 * bfhi(yb.y); }
        ln_rows16(v, g, bta, lane);
        store_row(v, lane, xres + (size_t)row * D, xn + (size_t)row * D, out ? out + (size_t)row * D : nullptr);
    }
}


constexpr int ATT_F2_OFF = 86016;
__device__ __forceinline__ void phase_attn(const Args& a, const Frame& F, char* lds_generic) {
    const int c = F.bid, vcu = (F.G % 8 == 0) ? (c % 8) * (F.G / 8) + c / 8 : c;
    const attn_body::bf16* Q = (const attn_body::bf16*)(a.ws + WS_QO); const attn_body::bf16* K = (const attn_body::bf16*)(a.ws + WS_KV); const attn_body::bf16* V = K + 512;
    attn_body::bf16* O = (attn_body::bf16*)(a.ws + WS_QO);
    const float* FL = (const float*)(a.ws + WS_FL);
    LAS float* f2 = (LAS float*)(F.lds + ATT_F2_OFF); LAS float* wsum = f2 + 2048;
    { const int bh = vcu >> 1; if (bh >= BATCH * NH) return;
        const int b = bh >> 3, h = bh & 7, tid = F.tid, lane = F.lane, w = F.wave;
        float v[4], run = 0.f;
#pragma unroll
        for (int i = 0; i < 4; ++i) { run += FL[((size_t)b * SEQ + tid * 4 + i) * 8 + h]; v[i] = run; }
        float incl = run;
#pragma unroll
        for (int o = 1; o < 64; o <<= 1) { const float u = __shfl_up(incl, o); if (lane >= o) incl += u; }
        if (lane == 63) wsum[w] = incl;
        __syncthreads();
        float base = incl - run; for (int i = 0; i < w; ++i) base += wsum[i];
        f32x4 o4; o4[0] = (base + v[0]) * LOG2E; o4[1] = (base + v[1]) * LOG2E; o4[2] = (base + v[2]) * LOG2E; o4[3] = (base + v[3]) * LOG2E;
        *(LAS f32x4*)(f2 + tid * 4) = o4;
        __syncthreads();
        for (int i = 0; i < 4; ++i) { const int s = 2 * (vcu & 1) + (i >> 1); const int qb = (i & 1) ? 7 - s : s;
            int tid_u = F.tid; asm volatile("" : "+v"(tid_u));
            attn_body::attn_unit<8>(b, h, qb, Q, K, V, O, lds_generic + RING_OFF, f2, tid_u); }
        __syncthreads();
    }
}

namespace hg {
constexpr int PB = 144;
constexpr int O_QS = 0, O_KS = 9216, O_QI = 18432, O_KUT = 27648, O_VT = 36864, O_P = 46080, O_ST = 55296, O_TOT = 64512, O_EBL = 66560, O_RED = 66816, BYTES = 67328;
__device__ __forceinline__ float ex(float v) { return __builtin_amdgcn_exp2f(v * LOG2E); }
__device__ __forceinline__ unsigned short bf1(float v) { return (unsigned short)f2bf(v); }
}
__device__ __forceinline__ void phase_hgrn(const Args& a, const Frame& F, int l) {
    using namespace hg;
    if (F.bid >= BATCH * NH) return;
    const bf16_t* HB = (const bf16_t*)(a.ws + WS_HB); const float* LOGF = (const float*)(a.ws + WS_LOGF); const bf16_t* HG = (const bf16_t*)(a.ws + WS_HG); bf16_t* O = (bf16_t*)(a.ws + WS_QO);
    LAS unsigned char* L = F.lds + RING_OFF;
    const int bh = F.bid, b = bh >> 3, h = bh & 7, lane = F.lane, w = F.wave, tid = F.tid;
    const int fr = lane & 15, fq = lane >> 4;
    const int tr = w >> 1, tc0 = 2 * (w & 1);
    const float ng0 = a.norm_g[l * 512 + h * 64 + 16 * tc0 + fr], ng1 = a.norm_g[l * 512 + h * 64 + 16 * (tc0 + 1) + fr];
    f32x4 S0 = {0.f, 0.f, 0.f, 0.f}, S1 = {0.f, 0.f, 0.f, 0.f};
    for (int i = tid; i < 9216 / 4; i += NWAVES * 64) ((LAS unsigned*)(L + O_ST))[i] = 0u;
    const size_t rowbase = (size_t)b * SEQ;
    float g[8]; unsigned short qv[8], vv[8];
#pragma unroll
    for (int i = 0; i < 8; ++i) { const size_t row = rowbase + 8 * w + i; g[i] = LOGF[row * 512 + h * 64 + lane]; qv[i] = HB[row * 1024 + h * 64 + lane]; vv[i] = HB[row * 1024 + 512 + h * 64 + lane]; }
    for (int c0 = 0; c0 < SEQ; c0 += 64) {
        float bc[8]; { float run = 0.f;
#pragma unroll
            for (int i = 0; i < 8; ++i) { run += g[i]; bc[i] = run; } }
        ((LAS float*)(L + O_TOT))[w * 64 + lane] = bc[7];
        float qf[8], kf[8];
#pragma unroll
        for (int i = 0; i < 8; ++i) { qf[i] = bf2f(qv[i]); kf[i] = 1.f - ex(g[i]); }
        { u32x4 pk; pk.x = (unsigned)vv[0] | ((unsigned)vv[1] << 16); pk.y = (unsigned)vv[2] | ((unsigned)vv[3] << 16); pk.z = (unsigned)vv[4] | ((unsigned)vv[5] << 16); pk.w = (unsigned)vv[6] | ((unsigned)vv[7] << 16);
          *(LAS u32x4*)(L + O_VT + lane * PB + 16 * w) = pk; }
        __syncthreads();
        float base = 0.f, bm = 0.f, bl = 0.f;
#pragma unroll
        for (int ww = 0; ww < 8; ++ww) { const float tv = ((LAS float*)(L + O_TOT))[ww * 64 + lane]; if (ww < w) base += tv; if (ww < 4) bm += tv; bl += tv; }
        const float ebm = ex(bm), eblm = ex(bl - bm);
        if (w == 0) ((LAS float*)(L + O_EBL))[lane] = ex(bl);
        unsigned short ku[8];
#pragma unroll
        for (int i = 0; i < 8; ++i) { const float x = bc[i] + base - bm; const float e1 = ex(fminf(x, 80.f)), e2 = ex(fminf(-x, 80.f));
            const float qs = qf[i] * e1, ks = kf[i] * e2; const int r = 8 * w + i;
            *(LAS unsigned short*)(L + O_QS + r * PB + 2 * lane) = bf1(qs); *(LAS unsigned short*)(L + O_QI + r * PB + 2 * lane) = bf1(qs * ebm);
            *(LAS unsigned short*)(L + O_KS + r * PB + 2 * lane) = bf1(ks); ku[i] = bf1(ks * eblm); }
        { u32x4 pk; pk.x = (unsigned)ku[0] | ((unsigned)ku[1] << 16); pk.y = (unsigned)ku[2] | ((unsigned)ku[3] << 16); pk.z = (unsigned)ku[4] | ((unsigned)ku[5] << 16); pk.w = (unsigned)ku[6] | ((unsigned)ku[7] << 16);
          *(LAS u32x4*)(L + O_KUT + lane * PB + 16 * w) = pk; }
        if (c0 + 64 < SEQ) {
#pragma unroll
            for (int i = 0; i < 8; ++i) { const size_t row = rowbase + c0 + 64 + 8 * w + i; g[i] = LOGF[row * 512 + h * 64 + lane]; qv[i] = HB[row * 1024 + h * 64 + lane]; vv[i] = HB[row * 1024 + 512 + h * 64 + lane]; }
        }
        __syncthreads();
#pragma unroll
        for (int k2 = 0; k2 < 2; ++k2) { const int idx = 2 * w + k2, ti = idx >> 2, sj = idx & 3;
            f32x4 sc = {0.f, 0.f, 0.f, 0.f};
            if (sj <= ti) {
#pragma unroll
                for (int kk = 0; kk < 2; ++kk) { const bf16x8 af = *(const LAS bf16x8*)(L + O_QS + (16 * ti + fr) * PB + (32 * kk + 8 * fq) * 2), bfr = *(const LAS bf16x8*)(L + O_KS + (16 * sj + fr) * PB + (32 * kk + 8 * fq) * 2);
                    sc = __builtin_amdgcn_mfma_f32_16x16x32_bf16(af, bfr, sc, 0, 0, 0); }
            }
#pragma unroll
            for (int j = 0; j < 4; ++j) { const int t = 16 * ti + 4 * fq + j, s = 16 * sj + fr; *(LAS unsigned short*)(L + O_P + t * PB + 2 * s) = bf1(s <= t ? sc[j] : 0.f); }
        }
        __syncthreads();
        f32x4 o0 = {0.f, 0.f, 0.f, 0.f}, o1 = {0.f, 0.f, 0.f, 0.f}, u0 = {0.f, 0.f, 0.f, 0.f}, u1 = {0.f, 0.f, 0.f, 0.f};
#pragma unroll
        for (int kk = 0; kk < 2; ++kk) { const int ko = (32 * kk + 8 * fq) * 2;
            const bf16x8 pa = *(const LAS bf16x8*)(L + O_P + (16 * tr + fr) * PB + ko), qa = *(const LAS bf16x8*)(L + O_QI + (16 * tr + fr) * PB + ko), ka = *(const LAS bf16x8*)(L + O_KUT + (16 * tr + fr) * PB + ko);
            const bf16x8 v0 = *(const LAS bf16x8*)(L + O_VT + (16 * tc0 + fr) * PB + ko), v1 = *(const LAS bf16x8*)(L + O_VT + (16 * (tc0 + 1) + fr) * PB + ko);
            const bf16x8 s0 = *(const LAS bf16x8*)(L + O_ST + (16 * tc0 + fr) * PB + ko), s1 = *(const LAS bf16x8*)(L + O_ST + (16 * (tc0 + 1) + fr) * PB + ko);
            o0 = __builtin_amdgcn_mfma_f32_16x16x32_bf16(pa, v0, o0, 0, 0, 0); o1 = __builtin_amdgcn_mfma_f32_16x16x32_bf16(pa, v1, o1, 0, 0, 0);
            o0 = __builtin_amdgcn_mfma_f32_16x16x32_bf16(qa, s0, o0, 0, 0, 0); o1 = __builtin_amdgcn_mfma_f32_16x16x32_bf16(qa, s1, o1, 0, 0, 0);
            u0 = __builtin_amdgcn_mfma_f32_16x16x32_bf16(ka, v0, u0, 0, 0, 0); u1 = __builtin_amdgcn_mfma_f32_16x16x32_bf16(ka, v1, u1, 0, 0, 0); }
        { const f32x4 dec = *(const LAS f32x4*)(L + O_EBL + (16 * tr + 4 * fq) * 4); S0 = S0 * dec + u0; S1 = S1 * dec + u1; }
        { f32x4 q2 = o0 * o0 + o1 * o1;
#pragma unroll
          for (int m = 1; m < 16; m <<= 1) { q2[0] += __shfl_xor(q2[0], m); q2[1] += __shfl_xor(q2[1], m); q2[2] += __shfl_xor(q2[2], m); q2[3] += __shfl_xor(q2[3], m); }
          if (fr == 0) {
#pragma unroll
              for (int j = 0; j < 4; ++j) ((LAS float*)(L + O_RED))[(16 * tr + 4 * fq + j) * 2 + (w & 1)] = q2[j]; } }
        __syncthreads();
        { u32x2 p0, p1; p0.x = pk2(S0[0], S0[1]); p0.y = pk2(S0[2], S0[3]); p1.x = pk2(S1[0], S1[1]); p1.y = pk2(S1[2], S1[3]);
          *(LAS u32x2*)(L + O_ST + (16 * tc0 + fr) * PB + (16 * tr + 4 * fq) * 2) = p0; *(LAS u32x2*)(L + O_ST + (16 * (tc0 + 1) + fr) * PB + (16 * tr + 4 * fq) * 2) = p1; }
#pragma unroll
        for (int j = 0; j < 4; ++j) { const int t = 16 * tr + 4 * fq + j; const f32x2 rr = *(const LAS f32x2*)(L + O_RED + t * 8); const float rs = rsqrtf((rr[0] + rr[1]) * (1.f / 64.f) + RMS_EPS);
            *(LAS unsigned short*)(L + O_P + t * PB + 2 * (16 * tc0 + fr)) = bf1(o0[j] * rs * ng0); *(LAS unsigned short*)(L + O_P + t * PB + 2 * (16 * (tc0 + 1) + fr)) = bf1(o1[j] * rs * ng1); }
        __syncthreads();
        { const int t = tid >> 3, e8 = (tid & 7) * 8; const size_t row = rowbase + c0 + t;
          const u32x4 ov = *(const LAS u32x4*)(L + O_P + t * PB + e8 * 2), gv = *(const u32x4*)(HG + row * 512 + h * 64 + e8);
          u32x4 r; r.x = pk2(bflo(ov.x) * bflo(gv.x), bfhi(ov.x) * bfhi(gv.x)); r.y = pk2(bflo(ov.y) * bflo(gv.y), bfhi(ov.y) * bfhi(gv.y));
          r.z = pk2(bflo(ov.z) * bflo(gv.z), bfhi(ov.z) * bfhi(gv.z)); r.w = pk2(bflo(ov.w) * bflo(gv.w), bfhi(ov.w) * bfhi(gv.w));
          *(u32x4*)(O + row * 1024 + 512 + h * 64 + e8) = r; }
        __syncthreads();
    }
}


constexpr int PH_PER_LAYER = 10, N_PHASES = 1 + DEPTH * PH_PER_LAYER;
#ifndef MK_ONE_LAUNCH
#define MK_ONE_LAUNCH 1
#endif
#ifndef MK_FAST_ATTN
#define MK_FAST_ATTN 0
#endif
#ifndef MK_FAST_HGRN
#define MK_FAST_HGRN 0
#endif


#ifdef DBG_DUMP
#ifndef DBG_WHAT
#define DBG_WHAT 0
#endif
__device__ __forceinline__ void dbg_dump(const Args& a, const Frame& F) {
    unsigned char* ws = a.ws;
    const bf16_t *QO = (bf16_t*)(ws + WS_QO), *KV = (bf16_t*)(ws + WS_KV), *HB = (bf16_t*)(ws + WS_HB), *HG = (bf16_t*)(ws + WS_HG), *G = (bf16_t*)(ws + WS_G);
    const bf16_t *U1 = (bf16_t*)(ws + WS_U1), *U = (bf16_t*)(ws + WS_U), *MIXED = (bf16_t*)(ws + WS_MIXED), *XN = (bf16_t*)(ws + WS_XN);
    const float *LOGF = (float*)(ws + WS_LOGF), *FL = (float*)(ws + WS_FL), *XRES = (float*)(ws + WS_XRES);
    for (size_t i = (size_t)F.bid * 512 + F.tid; i < (size_t)T * D; i += (size_t)gridDim.x * 512) {
        const size_t row = i >> 10; const int c = (int)(i & 1023);
        float v = 0.f;
        if (DBG_WHAT == 9) { v = bf2f(G[row * 2048 + c]) + bf2f(G[row * 2048 + 1024 + c]); }
        else if (DBG_DUMP == 1) { v = bf2f(KV[i]) + bf2f(HB[i]) + bf2f(G[row * 2048 + c]) + bf2f(G[row * 2048 + 1024 + c]);
            if (c < 512) v += LOGF[row * 512 + c] + bf2f(HG[row * 512 + c]) + bf2f(QO[i]); if (c < 8) v += FL[row * 8 + c]; }
        else if (DBG_DUMP == 2) { v = (c >= 512) ? bf2f(QO[i]) : 0.f; }
        else if (DBG_DUMP == 3) { v = bf2f(QO[i]); }
        else if (DBG_DUMP == 4) { v = bf2f(U1[i]); }
        else if (DBG_DUMP == 5) { v = bf2f(U[i]); }
        else if (DBG_DUMP == 6) { v = bf2f(MIXED[i]); }
        else if (DBG_DUMP == 7) { v = XRES[i] + bf2f(XN[i]); }
        a.out[i] = v;
    }
}
#endif
#define PH_BEGIN const Args a = LOAD_ARGS(); Frame F; F.lds = lds0; F.tid = threadIdx.x; asm volatile("" : "+v"(F.tid)); F.lane = F.tid & 63; F.wave = __builtin_amdgcn_readfirstlane(F.tid >> 6); \
    F.G = gridDim.x; F.bid = blockIdx.x; asm volatile("" : "+s"(F.bid)); F.gw = F.bid * NWAVES + F.wave; F.ngw = F.G * NWAVES; unsigned char* const ws = a.ws; const LAS int* tab = (const LAS int*)(F.lds + TAB_OFF); (void)tab; (void)ws;
#ifdef DBG_DUMP
#define IN(k) (lo <= (k) && (k) < hi && (k) <= DBG_DUMP)
#else
#define IN(k) (lo <= (k) && (k) < hi)
#endif
#define SEAM(k) do { if (IN(k) && IN((k) + 1)) { XcdBarrier b2_ = bar; { size_t z_ = 0; asm volatile("" : "+s"(z_), "+s"(b2_.x)); b2_.bar = bar.bar + z_; } xcd_barrier(b2_); } } while (0)
template <int l>
__device__ __forceinline__ void layer_body(const Args& args, const int lo, const int hi, const XcdBarrier& bar, LAS unsigned char* const lds0, unsigned char* lds_raw) {
        const int pb = 1 + l * PH_PER_LAYER;

#ifdef DBG_DUMP
        if (l == 0 && lo <= DBG_DUMP + 1 && DBG_DUMP + 1 < hi) { PH_BEGIN dbg_dump(a, F); }
#endif
        if (IN(pb + 0)) { PH_BEGIN
            pg8::Gemm g{(bf16_t*)(ws + WS_XN), (bf16_t*)(ws + WS_WIN), D, D, D}; pg8::StaticOrder S; S.init(T, NINP, F.G, F.bid);
            pg8::EpiInproj E{ws, l};
            pg8::gemm_phase<pg8::EpiInproj, pg8::StaticOrder, true>(F.lds + RING_OFF, g, S, E, F.tid);
        }
        SEAM(pb + 0);
        if (IN(pb + 1)) { PH_BEGIN
#if !MK_FAST_ATTN
            phase_fscan(a, F);
#endif
#if MK_FAST_HGRN
            phase_hgrn(a, F, l);
#else
            phase_hgrn_naive(a, F, l);
#endif
        }
        SEAM(pb + 1);
        if (IN(pb + 2)) { PH_BEGIN
#if MK_FAST_ATTN
            phase_attn(a, F, (char*)lds_raw);
#else
            phase_attn_naive(a, F);
#endif
        }
        SEAM(pb + 2);
        if (IN(pb + 3)) { PH_BEGIN
            pg8::Gemm g{(bf16_t*)(ws + WS_QO), (bf16_t*)(ws + WS_WBR), D, D, 512}; pg8::StaticOrder S; S.init(T, D, F.G, F.bid);
            pg8::EpiGate<1> E{(bf16_t*)(ws + WS_U1), nullptr, (bf16_t*)(ws + WS_G), 2048, nullptr};
            pg8::gemm_phase<pg8::EpiGate<1>, pg8::StaticOrder, true>(F.lds + RING_OFF, g, S, E, F.tid);
        }
        SEAM(pb + 3);
        if (IN(pb + 4)) { PH_BEGIN
            pg8::Gemm g{(bf16_t*)(ws + WS_QO) + 512, (bf16_t*)(ws + WS_WBR) + 512, D, D, 512}; pg8::StaticOrder S; S.init(T, D, F.G, F.bid);
            pg8::EpiGate<2> E{(bf16_t*)(ws + WS_U), nullptr, (bf16_t*)(ws + WS_G) + 1024, 2048, (bf16_t*)(ws + WS_U1)};
            pg8::gemm_phase<pg8::EpiGate<2>, pg8::StaticOrder, true>(F.lds + RING_OFF, g, S, E, F.tid);
        }
        SEAM(pb + 4);
        if (IN(pb + 5)) { PH_BEGIN
            pg8::Gemm g{(bf16_t*)(ws + WS_U), (bf16_t*)(ws + WS_WMIX), D, D, D}; pg8::StaticOrder S; S.init(T, D, F.G, F.bid);
            pg8::EpiGate<0> E{(bf16_t*)(ws + WS_MIXED), a.b_mix + l * D, nullptr, 0, nullptr};
            pg8::gemm_phase<pg8::EpiGate<0>, pg8::StaticOrder, true>(F.lds + RING_OFF, g, S, E, F.tid);
        }
        SEAM(pb + 5);
        if (IN(pb + 6)) { PH_BEGIN phase_ln1_router(a, F, l); }
        SEAM(pb + 6);
        if (IN(pb + 7)) { PH_BEGIN
            moe_table(a, F, l);
            pg8::Gemm g{(bf16_t*)(ws + WS_XN), (bf16_t*)(ws + WS_W13), D, D, D}; pg8::MoeOrder S{F.G, F.bid, 8, tab, (const int*)(ws + WS_LIST), true, (size_t)2048 * D};
            pg8::EpiUp E{(bf16_t*)(ws + WS_H)};
            pg8::gemm_phase<pg8::EpiUp, pg8::MoeOrder, true>(F.lds + RING_OFF, g, S, E, F.tid);
        }
        SEAM(pb + 7);
        if (IN(pb + 8)) { PH_BEGIN
            moe_table(a, F, l);
            pg8::Gemm g{(bf16_t*)(ws + WS_H), (bf16_t*)(ws + WS_W2), D, D, D}; pg8::MoeOrder S{F.G, F.bid, 4, tab, nullptr, false, (size_t)D * D};
            pg8::EpiGate<0> E{(bf16_t*)(ws + WS_Y), nullptr, nullptr, 0, nullptr};
            pg8::gemm_phase<pg8::EpiGate<0>, pg8::MoeOrder, true>(F.lds + RING_OFF, g, S, E, F.tid);
        }
        SEAM(pb + 8);
        if (IN(pb + 9)) { PH_BEGIN
            moe_table(a, F, l);
            phase_combine_ln2(a, F, l);
            if (l + 1 < DEPTH) { __syncthreads(); convert_layer(a, F, l + 1); }
        }
        SEAM(pb + 9);
    }

__global__ void __launch_bounds__(NWAVES * 64, 2) mk_fwd(Args args) {
    extern __shared__ __attribute__((aligned(16))) unsigned char lds_raw[];
    LAS unsigned char* const lds0 = (LAS unsigned char*)lds_raw;
    volatile LAS unsigned* MISC = (volatile LAS unsigned*)(lds0 + MISC_OFF);
    for (int u = threadIdx.x; u < (LDS_BYTES - LDSCTL_OFF) / 4; u += NWAVES * 64) ((LAS unsigned*)(lds0 + LDSCTL_OFF))[u] = 0u;
    __syncthreads();
    unsigned* ctl = (unsigned*)(args.ws + WS_CTL);
    XcdBarrier bar; bar.bar = ctl + CW_BAR; bar.x = 0; bar.st = nullptr;
    if (args.use_bar) bar = xcd_barrier_post(ctl + CW_BAR, MISC + 8);
    const int lo = args.ph_lo, hi = args.ph_hi;


    if (IN(0)) { PH_BEGIN phase_prep(a, F); }
    SEAM(0);
    layer_body<0>(args, lo, hi, bar, lds0, lds_raw); layer_body<1>(args, lo, hi, bar, lds0, lds_raw); layer_body<2>(args, lo, hi, bar, lds0, lds_raw); layer_body<3>(args, lo, hi, bar, lds0, lds_raw);
#undef IN
#undef SEAM
}

extern "C" void kernel_launch(void* const* d_in, const int* in_sizes, int n_in, void* d_out, int out_size, void* d_ws, size_t ws_size, hipStream_t stream) {
    static int grid = 0;
    if (grid == 0) {
        if (n_in != 20 || in_sizes[0] != T * D || out_size != T * D || ws_size < WS_END) { fprintf(stderr, "kernel_launch: unexpected shapes (n_in %d, ws %zu)\n", n_in, ws_size); grid = -1; return; }
        int dev = 0, cus = 0, per_cu = 0;
        if (hipGetDevice(&dev) != hipSuccess || hipDeviceGetAttribute(&cus, hipDeviceAttributeMultiprocessorCount, dev) != hipSuccess) { grid = -1; return; }
        if (hipFuncSetAttribute((const void*)mk_fwd, hipFuncAttributeMaxDynamicSharedMemorySize, LDS_BYTES) != hipSuccess) { fprintf(stderr, "kernel_launch: hipFuncSetAttribute failed\n"); grid = -1; return; }
        if (hipOccupancyMaxActiveBlocksPerMultiprocessor(&per_cu, (const void*)mk_fwd, NWAVES * 64, LDS_BYTES) != hipSuccess || per_cu < 1)
            fprintf(stderr, "kernel_launch: note: occupancy query reports %d workgroups per CU\n", per_cu);
        (void)hipGetLastError();
        grid = cus;
    }
    if (grid < 0) return;
    if (hipMemsetAsync((char*)d_ws + WS_CTL, 0, CTL_BYTES, stream) != hipSuccess) return;
    Args a{};
    a.x = (const float*)d_in[0]; a.ln_in_g = (const float*)d_in[1]; a.ln_in_b = (const float*)d_in[2]; a.w_in = (const float*)d_in[3]; a.b_in = (const float*)d_in[4];
    a.w_fox = (const float*)d_in[5]; a.lbl = (const float*)d_in[6]; a.norm_g = (const float*)d_in[7]; a.w_hgrn = (const float*)d_in[8]; a.w_mix = (const float*)d_in[9];
    a.b_mix = (const float*)d_in[10]; a.ln1_g = (const float*)d_in[11]; a.ln1_b = (const float*)d_in[12]; a.router_w = (const float*)d_in[13]; a.router_b = (const float*)d_in[14];
    a.w1 = (const float*)d_in[15]; a.w3 = (const float*)d_in[16]; a.w2 = (const float*)d_in[17]; a.ln2_g = (const float*)d_in[18]; a.ln2_b = (const float*)d_in[19];
    a.out = (float*)d_out; a.ws = (unsigned char*)d_ws; a.pad = 0;
#if MK_ONE_LAUNCH
    a.ph_lo = 0; a.ph_hi = N_PHASES; a.use_bar = 1;
    hipLaunchKernelGGL(mk_fwd, dim3(grid), dim3(NWAVES * 64), LDS_BYTES, stream, a);
#else
#ifdef DBG_DUMP
    const int np_ = DBG_DUMP + 2;
#else
    const int np_ = N_PHASES;
#endif
    for (int p = 0; p < np_; ++p) { a.ph_lo = p; a.ph_hi = p + 1; a.use_bar = 0;
        hipLaunchKernelGGL(mk_fwd, dim3(grid), dim3(NWAVES * 64), LDS_BYTES, stream, a); }
#endif
    const hipError_t le = hipPeekAtLastError();
    if (le != hipSuccess) fprintf(stderr, "kernel_launch: launch failed: %s\n", hipGetErrorName(le));
}
```

```cpp
#define MK_ONE_LAUNCH 1
#define MK_FAST_ATTN 1
#define MK_FAST_HGRN 1
#include <hip/hip_runtime.h>
#include <cstdio>
#include <cstdint>

typedef unsigned short bf16_t;
typedef short bf16x8 __attribute__((ext_vector_type(8)));
typedef float f32x4 __attribute__((ext_vector_type(4)));
typedef float f32x2 __attribute__((ext_vector_type(2)));
typedef unsigned u32x4 __attribute__((ext_vector_type(4)));
typedef unsigned u32x2 __attribute__((ext_vector_type(2)));
#define LAS __attribute__((address_space(3)))
#define GAS __attribute__((address_space(1)))

constexpr int BATCH = 16, SEQ = 2048, T = BATCH * SEQ, D = 1024, DEPTH = 4, NH = 8, HD = 64, NIN = 5640, NINP = 5888, NE = 16;
constexpr float LN_EPS = 1e-5f, RMS_EPS = 1e-6f;
constexpr float ALPHA = 1.681792830507429f;
constexpr float LOG2E = 1.4426950408889634f;
constexpr float C2 = 0.125f * LOG2E;
constexpr int TM = 256;

constexpr size_t MiB = 1u << 20;
constexpr size_t WS_CTL = 0, CTL_BYTES = 1 * MiB;
constexpr size_t WS_MISC = 1 * MiB;
constexpr size_t WS_WIN = 2 * MiB, WS_WBR = 14 * MiB, WS_WMIX = 16 * MiB, WS_W13 = 18 * MiB, WS_W2 = 82 * MiB;
constexpr size_t WS_XRES = 114 * MiB, WS_XN = 242 * MiB, WS_QO = 306 * MiB, WS_KV = 370 * MiB, WS_HB = 434 * MiB, WS_LOGF = 498 * MiB;
constexpr size_t WS_HG = 562 * MiB, WS_G = 594 * MiB, WS_FL = 722 * MiB, WS_F2 = 723 * MiB, WS_U1 = 724 * MiB, WS_U = 788 * MiB, WS_MIXED = 852 * MiB;
constexpr size_t WS_LIST = 916 * MiB, WS_TOK = 918 * MiB, WS_END = 919 * MiB;
constexpr size_t WS_H = WS_QO, WS_Y = 442 * MiB;
constexpr int CW_CNT = 1024;
constexpr int CW_BAR = 4096;

__device__ __forceinline__ unsigned f2bf(float f) { unsigned u = __builtin_bit_cast(unsigned, f); return (u + 0x7fffu + ((u >> 16) & 1u)) >> 16; }
__device__ __forceinline__ float bf2f(unsigned h) { return __builtin_bit_cast(float, h << 16); }
__device__ __forceinline__ float bflo(unsigned w) { return __builtin_bit_cast(float, w << 16); }
__device__ __forceinline__ float bfhi(unsigned w) { return __builtin_bit_cast(float, w & 0xffff0000u); }
__device__ __forceinline__ unsigned pk2(float lo, float hi) { return f2bf(lo) | (f2bf(hi) << 16); }
__device__ __forceinline__ float wave_sum(float v) {
#pragma unroll
    for (int o = 1; o < 64; o <<= 1) v += __shfl_xor(v, o);
    return v;
}
__device__ __forceinline__ float wave_max(float v) {
#pragma unroll
    for (int o = 1; o < 64; o <<= 1) v = fmaxf(v, __shfl_xor(v, o));
    return v;
}
__device__ __forceinline__ float fast_exp(float v) { return __builtin_amdgcn_exp2f(v * LOG2E); }
__device__ __forceinline__ float sigmoidf_(float v) { return __builtin_amdgcn_rcpf(1.0f + fast_exp(-v)); }
__device__ __forceinline__ float siluf_(float v) { return v * sigmoidf_(v); }
__device__ __forceinline__ float logsigmoidf_(float v) { return fminf(v, 0.f) - __logf(1.0f + fast_exp(-fabsf(v))); }

namespace pg8 {
constexpr int BM = 256, BK = 64, HALF = 128, HTB = HALF * BK * 2  , STAGE_BYTES = 8 * HTB, NXCD = 8, WGM = 8;
__host__ __device__ __forceinline__ int lds_byte(int r, int c) { const int st = (r >> 4) * 2 + (c >> 5), rr = r & 15, cc = c & 31, ob = rr * 64 + cc * 2; return st * 1024 + (ob ^ (((ob >> 9) & 1) << 5)); }
__host__ __device__ __forceinline__ void stage_rc(int b, int& R, int& C) { const int st = b / 1024, sb = b % 1024, swz = sb ^ (((sb >> 9) & 1) << 5); R = (st >> 1) * 16 + swz / 64; C = (st & 1) * 32 + (swz % 64) / 2; }
__host__ __device__ __forceinline__ int perm32(int rho) { const int n = rho >> 4, i = rho & 15; return 8 * (i >> 2) + 4 * n + (i & 3); }

struct Unit { int pm, pn, e; };
struct Gemm { const bf16_t* A; const bf16_t* Bt; int lda, ldb, K; };

struct StaticOrder {
    int nM, nN, nwg, G, c;
    __device__ void init(int M, int N, int G_, int c_) { nM = M / BM; nN = N / BM; nwg = nM * nN; G = G_; c = c_; }
    __device__ bool next(int i, Unit& u) const {
        const long L = (long)i * G + c; if (L >= nwg) return false;
        int wgid = (int)L; { const int q = nwg / NXCD, r = nwg % NXCD, xcd = wgid % NXCD, off = wgid / NXCD; wgid = (xcd < r ? xcd * (q + 1) : r * (q + 1) + (xcd - r) * q) + off; }
        const int nig = WGM * nN, gid = wgid / nig, fm = gid * WGM, gsz = (nM - fm) < WGM ? (nM - fm) : WGM;
        u.pm = fm + ((wgid % nig) % gsz); u.pn = (wgid % nig) / gsz; u.e = 0; return true;
    }
    __device__ __forceinline__ const char* a_tile(const Gemm& g, const Unit& u) const { return (const char*)g.A + (size_t)u.pm * BM * g.lda * 2; }
    __device__ __forceinline__ const char* b_tile(const Gemm& g, const Unit& u) const { return (const char*)g.Bt + (size_t)u.pn * BM * g.ldb * 2; }
    __device__ __forceinline__ void a_voff(const Gemm& g, const Unit&, const int (&R)[2], const int (&C)[2], unsigned (&v)[2][2]) const {
#pragma unroll
        for (int h = 0; h < 2; ++h)
#pragma unroll
            for (int i = 0; i < 2; ++i) v[h][i] = (unsigned)((h * HALF + R[i]) * g.lda + C[i]) * 2u;
    }
};
struct MoeOrder {
    int G, c, nN; const LAS int* tab; const int* list; bool gather; size_t bstride;
    __device__ bool next(int i, Unit& u) const {
        const int L = i * G + c; const int rt = L / nN; const int NT = tab[NE]; if (rt >= NT) return false;
        int e = 0;
#pragma unroll
        for (int k = 1; k < NE; ++k) e += (rt >= tab[k]) ? 1 : 0;
        u.pm = __builtin_amdgcn_readfirstlane(rt); u.pn = __builtin_amdgcn_readfirstlane(L % nN); u.e = __builtin_amdgcn_readfirstlane(e); return true;
    }
    __device__ __forceinline__ const char* a_tile(const Gemm& g, const Unit& u) const { return gather ? (const char*)g.A : (const char*)g.A + (size_t)u.pm * BM * g.lda * 2; }
    __device__ __forceinline__ const char* b_tile(const Gemm& g, const Unit& u) const { return (const char*)g.Bt + ((size_t)u.e * bstride + (size_t)u.pn * BM * g.ldb) * 2; }
    __device__ __forceinline__ void a_voff(const Gemm& g, const Unit& u, const int (&R)[2], const int (&C)[2], unsigned (&v)[2][2]) const {
        const int ts = tab[u.e], cn = tab[NE + 1 + u.e];
#pragma unroll
        for (int h = 0; h < 2; ++h)
#pragma unroll
            for (int i = 0; i < 2; ++i) {
                if (gather) { const int pos = (u.pm - ts) * BM + h * HALF + R[i]; const int tok = (pos < cn) ? list[u.e * T + pos] : 0; v[h][i] = (unsigned)(tok * g.lda + C[i]) * 2u; }
                else v[h][i] = (unsigned)((h * HALF + R[i]) * g.lda + C[i]) * 2u;
            }
    }
};

typedef __bf16 bf16x2_t __attribute__((ext_vector_type(2)));
__device__ __forceinline__ unsigned cvt_pk_bf16(float lo, float hi) { f32x2 v = {lo, hi}; bf16x2_t b = __builtin_convertvector(v, bf16x2_t); return __builtin_bit_cast(unsigned, b); }
__device__ __forceinline__ u32x4 pack8(const f32x4& v0, const f32x4& v1) { u32x4 w; w.x = cvt_pk_bf16(v0[0], v0[1]); w.y = cvt_pk_bf16(v0[2], v0[3]); w.z = cvt_pk_bf16(v1[0], v1[1]); w.w = cvt_pk_bf16(v1[2], v1[3]); return w; }
__device__ __forceinline__ void unpack8(const u32x4& w, f32x4& v0, f32x4& v1) { v0[0] = bflo(w.x); v0[1] = bfhi(w.x); v0[2] = bflo(w.y); v0[3] = bfhi(w.y); v1[0] = bflo(w.z); v1[1] = bfhi(w.z); v1[2] = bflo(w.w); v1[3] = bfhi(w.w); }
__device__ __forceinline__ f32x4 sig4(const f32x4& v) { f32x4 o; o[0] = sigmoidf_(v[0]); o[1] = sigmoidf_(v[1]); o[2] = sigmoidf_(v[2]); o[3] = sigmoidf_(v[3]); return o; }

struct EpiInproj {
    static constexpr bool PERM = true;
    unsigned char* ws; int layer;
    template <int KIND> __device__ __forceinline__ void tile(const f32x4 (&acc)[2][2][4][2], const Unit& u, int wr, int wc, int fr, int fq, unsigned char* w) const {
        const float* biasp = (const float*)(w + WS_MISC + 16384);
        const int row0 = u.pm * BM + wr * 64 + fr, bcol0 = u.pn * BM + wc * 32 + 8 * fq;
        f32x4 bv[2][2];
#pragma unroll
        for (int bj = 0; bj < 2; ++bj)
#pragma unroll
            for (int n = 0; n < 2; ++n) bv[bj][n] = *(const f32x4*)(biasp + bcol0 + bj * HALF + 4 * n);
#pragma unroll
        for (int ai = 0; ai < 2; ++ai)
#pragma unroll
            for (int m = 0; m < 4; ++m) { const size_t row = (size_t)(row0 + ai * HALF + m * 16);
#pragma unroll
                for (int bj = 0; bj < 2; ++bj) { f32x4 v0 = acc[ai][bj][m][0] + bv[bj][0], v1 = acc[ai][bj][m][1] + bv[bj][1]; const int col = bcol0 + bj * HALF;
                    if (KIND == 0) { *(u32x4*)((bf16_t*)(w + WS_QO) + row * 1024 + col) = pack8(v0 * C2, v1 * C2); }
                    else if (KIND == 1) { *(u32x4*)((bf16_t*)(w + WS_KV) + row * 1024 + (col - 512)) = pack8(v0, v1); }
                    else if (KIND == 2) { *(u32x4*)((bf16_t*)(w + WS_KV) + row * 1024 + 512 + (col - 1024)) = pack8(v0, v1); }
                    else if (KIND == 3) { *(u32x4*)((bf16_t*)(w + WS_HB) + row * 1024 + (col - 1536)) = pack8(v0 * sig4(v0), v1 * sig4(v1)); }
                    else if (KIND == 4) { const int c = col - 2048; const float* lb = (const float*)(w + WS_MISC) + layer * 512; const f32x4 l0 = *(const f32x4*)(lb + c), l1 = *(const f32x4*)(lb + c + 4);
                        f32x4 f0 = l0 + (1.f - l0) * sig4(v0), f1 = l1 + (1.f - l1) * sig4(v1);
#pragma unroll
                        for (int q = 0; q < 4; ++q) { f0[q] = __logf(f0[q]); f1[q] = __logf(f1[q]); }
                        float* LOGF = (float*)(w + WS_LOGF); *(f32x4*)(LOGF + row * 512 + c) = f0; *(f32x4*)(LOGF + row * 512 + c + 4) = f1; }
                    else if (KIND == 5) { *(u32x4*)((bf16_t*)(w + WS_HB) + row * 1024 + 512 + (col - 2560)) = pack8(v0, v1); }
                    else if (KIND == 6) { *(u32x4*)((bf16_t*)(w + WS_HG) + row * 512 + (col - 3072)) = pack8(v0 * sig4(v0), v1 * sig4(v1)); }
                    else if (KIND == 7) { *(u32x4*)((bf16_t*)(w + WS_G) + row * 2048 + (col - 3584)) = pack8(sig4(v0), sig4(v1)); }
                    else { if (col == 5632) { f32x4 f0, f1;
#pragma unroll
                            for (int q = 0; q < 4; ++q) { f0[q] = logsigmoidf_(v0[q]); f1[q] = logsigmoidf_(v1[q]); }
                            float* FL = (float*)(w + WS_FL); *(f32x4*)(FL + row * 8) = f0; *(f32x4*)(FL + row * 8 + 4) = f1; } }
                } }
    }
    __device__ __forceinline__ void operator()(const f32x4 (&acc)[2][2][4][2], const Unit& u, int wr, int wc, int fr, int fq) const {
        size_t z_ = 0; asm volatile("" : "+s"(z_)); unsigned char* w = ws + z_;
        const int ct = u.pn;
        if (ct < 2) tile<0>(acc, u, wr, wc, fr, fq, w); else if (ct < 4) tile<1>(acc, u, wr, wc, fr, fq, w); else if (ct < 6) tile<2>(acc, u, wr, wc, fr, fq, w);
        else if (ct < 8) tile<3>(acc, u, wr, wc, fr, fq, w); else if (ct < 10) tile<4>(acc, u, wr, wc, fr, fq, w); else if (ct < 12) tile<5>(acc, u, wr, wc, fr, fq, w);
        else if (ct < 14) tile<6>(acc, u, wr, wc, fr, fq, w); else if (ct < 22) tile<7>(acc, u, wr, wc, fr, fq, w); else tile<8>(acc, u, wr, wc, fr, fq, w);
    }
};
template <int MODE> struct EpiGate {
    static constexpr bool PERM = true;
    bf16_t* O; const float* bias; const bf16_t* Gt; int ldg; const bf16_t* P;
    __device__ __forceinline__ void operator()(const f32x4 (&acc)[2][2][4][2], const Unit& u, int wr, int wc, int fr, int fq) const {
        const int row0 = u.pm * BM + wr * 64 + fr, col0 = u.pn * BM + wc * 32 + 8 * fq;
        f32x4 bv[2][2];
        if (MODE == 0) {
#pragma unroll
            for (int bj = 0; bj < 2; ++bj)
#pragma unroll
                for (int n = 0; n < 2; ++n) bv[bj][n] = bias ? *(const f32x4*)(bias + col0 + bj * HALF + 4 * n) : (f32x4){0.f, 0.f, 0.f, 0.f};
        }
#pragma unroll
        for (int ai = 0; ai < 2; ++ai)
#pragma unroll
            for (int mh = 0; mh < 2; ++mh) {
                u32x4 gq[2][2], pq[2][2];
                if (MODE != 0) {
#pragma unroll
                    for (int mm = 0; mm < 2; ++mm)
#pragma unroll
                        for (int bj = 0; bj < 2; ++bj) { const size_t row = (size_t)(row0 + ai * HALF + (mh * 2 + mm) * 16); const int col = col0 + bj * HALF;
                            gq[mm][bj] = *(const u32x4*)(Gt + row * ldg + col);
                            if (MODE == 2) pq[mm][bj] = *(const u32x4*)(P + row * 1024 + col); }
                    asm volatile("s_waitcnt vmcnt(0)" ::: "memory");
                }
#pragma unroll
                for (int mm = 0; mm < 2; ++mm)
#pragma unroll
                    for (int bj = 0; bj < 2; ++bj) { const int m = mh * 2 + mm; const size_t row = (size_t)(row0 + ai * HALF + m * 16); const int col = col0 + bj * HALF;
                        f32x4 v0 = acc[ai][bj][m][0], v1 = acc[ai][bj][m][1];
                        if (MODE == 0) { v0 += bv[bj][0]; v1 += bv[bj][1]; }
                        else { f32x4 g0, g1; unpack8(gq[mm][bj], g0, g1); v0 *= g0; v1 *= g1;
                            if (MODE == 2) { f32x4 p0, p1; unpack8(pq[mm][bj], p0, p1); v0 += p0; v1 += p1; } }
                        *(u32x4*)(O + row * 1024 + col) = pack8(v0, v1); }
                if (MODE != 0) asm volatile("" ::: "memory");
            }
    }
};
struct EpiUp {
    static constexpr bool PERM = true;
    bf16_t* H;
    __device__ __forceinline__ void operator()(const f32x4 (&acc)[2][2][4][2], const Unit& u, int wr, int wc, int fr, int fq) const {
        const int row0 = u.pm * BM + wr * 64 + fr, col = u.pn * HALF + wc * 32 + 8 * fq;
#pragma unroll
        for (int ai = 0; ai < 2; ++ai)
#pragma unroll
            for (int m = 0; m < 4; ++m) { const size_t row = (size_t)(row0 + ai * HALF + m * 16);
                const f32x4 a0 = acc[ai][0][m][0], a1 = acc[ai][0][m][1], b0 = acc[ai][1][m][0], b1 = acc[ai][1][m][1];
                *(u32x4*)(H + row * 1024 + col) = pack8(a0 * sig4(a0) * b0, a1 * sig4(a1) * b1); }
    }
};

template <class Epi, class Sched, bool ALIGN_EPI>
__device__ __forceinline__ void gemm_phase(LAS unsigned char* lds, const Gemm g, const Sched& S, const Epi& E, const int tid) {
    const int wid = __builtin_amdgcn_readfirstlane(tid >> 6), lane = tid & 63, wr = wid >> 2, wc = wid & 3, fr = lane & 15, fq = lane >> 4;
    const int K = g.K, nt = K / BK;
    int RA[2], CA[2]; unsigned voffB[2];
#pragma unroll
    for (int i = 0; i < 2; ++i) { int R, C; stage_rc(tid * 16 + i * 8192, R, C); const int Rb = Epi::PERM ? ((R & ~31) + perm32(R & 31)) : R;
        RA[i] = R; CA[i] = C; voffB[i] = (unsigned)(Rb * g.ldb + C) * 2u; }
    const size_t kstep = (size_t)(BK * 2);
    const size_t hstepB = (size_t)HALF * g.ldb * 2;
    const unsigned ldsw = (unsigned)wid * 1024u;
    const int aoff = lds_byte(wr * 64 + fr, fq * 8), boff = lds_byte(wc * 32 + fr, fq * 8);
#define PG8_SA(b, h) (((b) * 2 + (h)) * HTB)
#define PG8_SB(b, h) ((4 + (b) * 2 + (h)) * HTB)
#define PG8_STAGE(bufoff, gbase, voff) do { _Pragma("unroll") for (int _i = 0; _i < 2; ++_i) \
        __builtin_amdgcn_global_load_lds((const unsigned*)((const char*)(gbase) + (voff)[_i]), (LAS unsigned*)(lds + (bufoff) + ldsw + _i * 8192), 16, 0, 0); } while (0)
#define PG8_LDA(dst, b, h) do { _Pragma("unroll") for (int m = 0; m < 4; ++m) _Pragma("unroll") for (int k = 0; k < 2; ++k) dst[m][k] = *(const LAS bf16x8*)(lds + PG8_SA(b, h) + aoff + m * 2048 + k * 1024); } while (0)
#define PG8_LDB(dst, b, h) do { _Pragma("unroll") for (int n = 0; n < 2; ++n) _Pragma("unroll") for (int k = 0; k < 2; ++k) dst[n][k] = *(const LAS bf16x8*)(lds + PG8_SB(b, h) + boff + n * 2048 + k * 1024); } while (0)
#define PG8_MMA(ai, bj, At, Bt) do { __builtin_amdgcn_s_setprio(1); _Pragma("unroll") for (int m = 0; m < 4; ++m) _Pragma("unroll") for (int n = 0; n < 2; ++n) _Pragma("unroll") for (int k = 0; k < 2; ++k) \
        acc[ai][bj][m][n] = __builtin_amdgcn_mfma_f32_16x16x32_bf16(Bt[n][k], At[m][k], acc[ai][bj][m][n], 0, 0, 0); __builtin_amdgcn_s_setprio(0); } while (0)
#define PG8_WAIT_V(n) asm volatile("s_waitcnt vmcnt(" #n ")" ::: "memory")
#define PG8_WAIT_L(n) asm volatile("s_waitcnt lgkmcnt(" #n ")" ::: "memory")
#define PG8_BAR __builtin_amdgcn_s_barrier()
#define PG8_SCHED __builtin_amdgcn_sched_barrier(0)
    Unit cur, nxt; int ui = 0;
    if (!S.next(0, cur)) return;
    f32x4 acc[2][2][4][2];
#pragma unroll
    for (int a = 0; a < 2; ++a)
#pragma unroll
        for (int b = 0; b < 2; ++b)
#pragma unroll
            for (int m = 0; m < 4; ++m)
#pragma unroll
                for (int n = 0; n < 2; ++n) acc[a][b][m][n] = (f32x4){0.f, 0.f, 0.f, 0.f};
    bf16x8 At[4][2], B0[2][2], B1[2][2];
    unsigned vA[2][2], nvA[2][2];
    S.a_voff(g, cur, RA, CA, vA);
    const char* cA = S.a_tile(g, cur); const char* cB = S.b_tile(g, cur);
    PG8_STAGE(PG8_SB(0, 0), cB, voffB); PG8_STAGE(PG8_SB(0, 1), cB + hstepB, voffB); PG8_STAGE(PG8_SA(0, 0), cA, vA[0]); PG8_STAGE(PG8_SA(0, 1), cA, vA[1]);
    if (wr == 1) PG8_BAR;
    PG8_WAIT_V(2); PG8_BAR;
    PG8_STAGE(PG8_SB(1, 0), cB + kstep, voffB); PG8_STAGE(PG8_SA(1, 0), cA + kstep, vA[0]); PG8_STAGE(PG8_SB(1, 1), cB + hstepB + kstep, voffB);
    PG8_WAIT_V(6); PG8_BAR;
    for (;;) {
        const bool has_next = S.next(ui + 1, nxt);
        const char* nA = has_next ? S.a_tile(g, nxt) : cA; const char* nB = has_next ? S.b_tile(g, nxt) : cB;
        if (has_next) S.a_voff(g, nxt, RA, CA, nvA);
        else {
#pragma unroll
            for (int h = 0; h < 2; ++h)
#pragma unroll
                for (int i = 0; i < 2; ++i) nvA[h][i] = vA[h][i]; }
        for (int t = 0; t < nt; t += 2) {
            const bool last = (t == nt - 2);
            const char* a1 = cA + (size_t)(t + 1) * kstep;
            const char* a2 = last ? nA : cA + (size_t)(t + 2) * kstep; const char* b2 = last ? nB : cB + (size_t)(t + 2) * kstep;
            const char* a3 = a2 + kstep; const char* b3 = b2 + kstep;
            unsigned wA0[2], wA1[2];
#pragma unroll
            for (int i = 0; i < 2; ++i) { wA0[i] = last ? nvA[0][i] : vA[0][i]; wA1[i] = last ? nvA[1][i] : vA[1][i]; }
            PG8_LDB(B0, 0, 0); PG8_LDB(B1, 0, 1); PG8_SCHED; PG8_LDA(At, 0, 0); PG8_STAGE(PG8_SA(1, 1), a1, vA[1]);
            PG8_WAIT_V(8); PG8_WAIT_L(0); PG8_BAR; PG8_MMA(0, 0, At, B0); PG8_MMA(0, 1, At, B1); PG8_BAR; PG8_SCHED;
            PG8_LDA(At, 0, 1); PG8_STAGE(PG8_SB(0, 0), b2, voffB); PG8_STAGE(PG8_SB(0, 1), b2 + hstepB, voffB); PG8_STAGE(PG8_SA(0, 0), a2, wA0);
            PG8_WAIT_V(8); PG8_WAIT_L(0); PG8_BAR; PG8_MMA(1, 0, At, B0); PG8_MMA(1, 1, At, B1); PG8_BAR; PG8_SCHED;
            PG8_LDB(B0, 1, 0); PG8_LDB(B1, 1, 1); PG8_SCHED; PG8_LDA(At, 1, 0); PG8_STAGE(PG8_SA(0, 1), a2, wA1);
            PG8_WAIT_V(8); PG8_WAIT_L(0); PG8_BAR; PG8_MMA(0, 0, At, B0); PG8_MMA(0, 1, At, B1); PG8_BAR; PG8_SCHED;
            PG8_LDA(At, 1, 1); PG8_STAGE(PG8_SB(1, 0), b3, voffB); PG8_STAGE(PG8_SB(1, 1), b3 + hstepB, voffB); PG8_STAGE(PG8_SA(1, 0), a3, wA0);
            PG8_WAIT_V(8); PG8_WAIT_L(0); PG8_BAR; PG8_MMA(1, 0, At, B0); PG8_MMA(1, 1, At, B1); PG8_BAR; PG8_SCHED;
        }
        if constexpr (ALIGN_EPI) { if (wr == 0) PG8_BAR; }
        E(acc, cur, wr, wc, fr, fq);
        if (!has_next) break;
#pragma unroll
        for (int a = 0; a < 2; ++a)
#pragma unroll
            for (int b = 0; b < 2; ++b)
#pragma unroll
                for (int m = 0; m < 4; ++m)
#pragma unroll
                    for (int n = 0; n < 2; ++n) acc[a][b][m][n] = (f32x4){0.f, 0.f, 0.f, 0.f};
        cur = nxt; cA = nA; cB = nB; ++ui;
#pragma unroll
        for (int h = 0; h < 2; ++h)
#pragma unroll
            for (int i = 0; i < 2; ++i) vA[h][i] = nvA[h][i];
        if constexpr (ALIGN_EPI) { if (wr == 1) PG8_BAR; }
    }
    PG8_WAIT_V(0);
    if constexpr (!ALIGN_EPI) { if (wr == 0) PG8_BAR; }
    PG8_BAR;
#undef PG8_SA
#undef PG8_SB
#undef PG8_STAGE
#undef PG8_LDA
#undef PG8_LDB
#undef PG8_MMA
#undef PG8_WAIT_V
#undef PG8_WAIT_L
#undef PG8_BAR
#undef PG8_SCHED
}
}


#include <hip/hip_bf16.h>
#include <cmath>
namespace attn_body {
using bf16=__hip_bfloat16;
using bf16x8=__attribute__((ext_vector_type(8)))short;
using s16x4=__attribute__((ext_vector_type(4)))short;
using f32x16=__attribute__((ext_vector_type(16)))float;
using u32x4=__attribute__((ext_vector_type(4)))unsigned;
constexpr int BATCH=16,NHEAD=8,SEQ=2048,D=64,DM=1024;
constexpr int NW=8,QBLK=32,QB=QBLK*NW,KVBLK=64,NQB=SEQ/QB;
constexpr int ATTN_PITCH=DM, ATTN_UNIT_ROWS=QB;
__device__ __forceinline__ int crow(int r,int hi){return (r&3)+8*(r>>2)+4*hi;}
#define SBAR() __builtin_amdgcn_sched_barrier(0)
__device__ __forceinline__ void cmask(f32x16&p0,f32x16&p1,int jb,int qrel,int hi){
  const float NEG=-INFINITY; int kb=64*jb+4*hi;
  #pragma unroll
  for(int r=0;r<16;++r){int kv=kb+(r&3)+8*(r>>2); if(kv>qrel)p0[r]=NEG; if(kv+32>qrel)p1[r]=NEG;}
}

constexpr int NSLOT=3, SLOTB=8192;
constexpr int LDS_K=0, LDS_V=NSLOT*SLOTB, LDS_WS=2*NSLOT*SLOTB, LDS_OST=LDS_WS+NW*64*4, LDS_BYTES=LDS_OST+NW*4096;
constexpr float C2=0.125f*1.4426950408889634f;
__device__ __forceinline__ void glds16(const void*gsrc,unsigned lds_dst){unsigned keep;
  asm volatile("s_mov_b32 %0, m0\n\ts_mov_b32 m0, %2\n\ts_nop 0\n\tglobal_load_lds_dwordx4 %1, off\n\ts_mov_b32 m0, %0":"=&s"(keep):"v"(gsrc),"s"(lds_dst):"memory");}
__device__ __forceinline__ float max3f(float a,float b,float c){float r;asm("v_max3_f32 %0, %1, %2, %3":"=v"(r):"v"(a),"v"(b),"v"(c));return r;}
__device__ __forceinline__ float max2f(float a,float b){float r;asm("v_max_f32_e32 %0, %1, %2":"=v"(r):"v"(a),"v"(b));return r;}
__device__ __forceinline__ float fadd_s(float a,float b){float r;asm("v_add_f32_e32 %0, %1, %2":"=v"(r):"v"(a),"v"(b));return r;}
__device__ __forceinline__ float fsub_s(float a,float b){float r;asm("v_sub_f32_e32 %0, %1, %2":"=v"(r):"v"(a),"v"(b));return r;}
typedef float f32x2_t __attribute__((ext_vector_type(2))); typedef __bf16 bf16x2_t __attribute__((ext_vector_type(2)));
__device__ __forceinline__ unsigned cvtpk_s(float lo,float hi){f32x2_t v={lo,hi};bf16x2_t b=__builtin_convertvector(v,bf16x2_t);return __builtin_bit_cast(unsigned,b);}
#define WAIT_BAR(N) asm volatile("s_waitcnt vmcnt(" #N ") lgkmcnt(0)\n\ts_barrier":::"memory")

__device__ __forceinline__ void qkt(f32x16&p0,f32x16&p1,const char*Kslot,const bf16x8*qr,const f32x16&negm,int r32,int hi){
  const char*kb=Kslot+hi*1024+r32*16;
  #pragma unroll
  for(int d0=0;d0<4;++d0){
    const bf16x8 b0=*reinterpret_cast<const bf16x8*>(kb+d0*2048);
    const bf16x8 b1=*reinterpret_cast<const bf16x8*>(kb+d0*2048+512);
    if(d0==0){p0=__builtin_amdgcn_mfma_f32_32x32x16_bf16(b0,qr[0],negm,0,0,0);p1=__builtin_amdgcn_mfma_f32_32x32x16_bf16(b1,qr[0],negm,0,0,0);}
    else{p0=__builtin_amdgcn_mfma_f32_32x32x16_bf16(b0,qr[d0],p0,0,0,0);p1=__builtin_amdgcn_mfma_f32_32x32x16_bf16(b1,qr[d0],p1,0,0,0);}}
}
typedef __attribute__((address_space(3))) const char* lds_cptr;
typedef short v4i16_t __attribute__((ext_vector_type(4)));
__device__ __forceinline__ void kload8(bf16x8*kf,lds_cptr kp){
  kf[0]=*(const __attribute__((address_space(3))) bf16x8*)(kp);      kf[1]=*(const __attribute__((address_space(3))) bf16x8*)(kp+512);
  kf[2]=*(const __attribute__((address_space(3))) bf16x8*)(kp+2048); kf[3]=*(const __attribute__((address_space(3))) bf16x8*)(kp+2560);
  kf[4]=*(const __attribute__((address_space(3))) bf16x8*)(kp+4096); kf[5]=*(const __attribute__((address_space(3))) bf16x8*)(kp+4608);
  kf[6]=*(const __attribute__((address_space(3))) bf16x8*)(kp+6144); kf[7]=*(const __attribute__((address_space(3))) bf16x8*)(kp+6656);
}
__device__ __forceinline__ void kload2(bf16x8*kf,lds_cptr kp,int j){ kf[2*j]=*(const __attribute__((address_space(3))) bf16x8*)(kp+j*2048); kf[2*j+1]=*(const __attribute__((address_space(3))) bf16x8*)(kp+j*2048+512); }
__device__ __forceinline__ s16x4 vtr(lds_cptr p){ return __builtin_bit_cast(s16x4,__builtin_amdgcn_ds_read_tr16_b64_v4i16((__attribute__((address_space(3))) v4i16_t*)p)); }
__device__ __forceinline__ float rowmax(const f32x16&p0,const f32x16&p1){
  float a=max3f(p0[0],p0[1],p1[0]),b=max3f(p0[2],p0[3],p1[1]);a=max3f(a,p1[2],p1[3]);
  #pragma unroll
  for(int r=4;r<16;r+=4){a=max3f(a,p0[r],p0[r+1]);b=max3f(b,p0[r+2],p0[r+3]);a=max3f(a,p1[r],p1[r+1]);b=max3f(b,p1[r+2],p1[r+3]);}
  const float m=max2f(a,b);
  auto rr=__builtin_amdgcn_permlane32_swap(__float_as_uint(m),__float_as_uint(m),false,false);
  return max2f(__uint_as_float(rr[0]),__uint_as_float(rr[1]));
}
__device__ __forceinline__ void pv(f32x16*o,int vb,bf16x8 pa0,bf16x8 pa1,bf16x8 pa2,bf16x8 pa3){
  #pragma unroll
  for(int d0=0;d0<2;++d0){s16x4 lo[4],hi[4];
    #pragma unroll
    for(int ks=0;ks<4;++ks){
      asm volatile("ds_read_b64_tr_b16 %0,%1 offset:%c2":"=&v"(lo[ks]):"v"(vb),"i"(d0*4096+ks*1024):"memory");
      asm volatile("ds_read_b64_tr_b16 %0,%1 offset:%c2":"=&v"(hi[ks]):"v"(vb),"i"(d0*4096+ks*1024+512):"memory");}
    asm volatile("s_waitcnt lgkmcnt(0)":::"memory");SBAR();
    #define PK(k) (bf16x8){lo[k][0],lo[k][1],lo[k][2],lo[k][3],hi[k][0],hi[k][1],hi[k][2],hi[k][3]}
    o[d0]=__builtin_amdgcn_mfma_f32_32x32x16_bf16(pa0,PK(0),o[d0],0,0,0);
    o[d0]=__builtin_amdgcn_mfma_f32_32x32x16_bf16(pa1,PK(1),o[d0],0,0,0);
    o[d0]=__builtin_amdgcn_mfma_f32_32x32x16_bf16(pa2,PK(2),o[d0],0,0,0);
    o[d0]=__builtin_amdgcn_mfma_f32_32x32x16_bf16(pa3,PK(3),o[d0],0,0,0);
    #undef PK
  }
}

#ifndef ATTN_STORE16
#define ATTN_STORE16(p,v) (*(u32x4*)(p)=(v))
#endif
template<int THRL> __device__ __forceinline__ void attn_unit(int b,int h,int qb,const bf16*Q,const bf16*__restrict__ K,const bf16*__restrict__ V,bf16*O,char*shm,const __attribute__((address_space(3))) float*f2,const int tid){
  #define BIAS_H(P,off,g0) { f32x4 x_[2]; _Pragma("unroll") for(int g_=0;g_<2;++g_) x_[g_]=*(const __attribute__((address_space(3))) f32x4*)(fb_+(off)+8*((g0)+g_)); \
      _Pragma("unroll") for(int g_=0;g_<2;++g_) _Pragma("unroll") for(int i_=0;i_<4;++i_) P[4*((g0)+g_)+i_]-=x_[g_][i_]; asm volatile("":::"memory"); }
  #define BIAS(P0,P1,t) do{ const __attribute__((address_space(3))) float* fb_=f2+64*(t)+4*hi; \
    BIAS_H(P0,0,0) BIAS_H(P0,0,2) BIAS_H(P1,32,0) BIAS_H(P1,32,2) }while(0)
  const int lane=tid&63,r32=lane&31,hi=lane>>5; const int wid=__builtin_amdgcn_readfirstlane(tid>>6);
  const long rowbase=(long)b*SEQ; const int q0=qb*QB;
  const bf16*Qw=Q+(rowbase+q0+wid*QBLK)*DM+h*D;
  const bf16*Kh=K+rowbase*DM+h*D,*Vh=V+rowbase*DM+h*D;
  const unsigned lds0=(unsigned)(uintptr_t)shm;
  float*wsf=(float*)(shm+LDS_WS)+wid*64;
  const bf16*ksrc=Kh+(long)lane*DM+wid*8;
  const bf16*vsrc=Vh+(long)(16*(wid&3)+(lane>>2))*DM+(wid>>2)*32+(lane&3)*8;
  const unsigned kdst=lds0+LDS_K+wid*1024, vdst=lds0+LDS_V+wid*1024;
  #define DMA_K(t,slot) glds16(ksrc+(long)(t)*KVBLK*DM,(unsigned)__builtin_amdgcn_readfirstlane(kdst+(slot)))
  #define DMA_V(t,slot) glds16(vsrc+(long)(t)*KVBLK*DM,(unsigned)__builtin_amdgcn_readfirstlane(vdst+(slot)))
  const int vb0=(int)(lds0+LDS_V)+((lane>>4)&1)*32+(lane&3)*8+(4*hi+((lane&15)>>2))*64;
  const char*Kbase=shm+LDS_K; bf16x8 kf[8];
  const lds_cptr shm3=(lds_cptr)shm; const lds_cptr kp0=shm3+LDS_K+hi*1024+r32*16; const lds_cptr vp0=shm3+LDS_V+((lane>>4)&1)*32+(lane&3)*8+(4*hi+((lane&15)>>2))*64;
  const int NT=(q0+QB)/KVBLK;
  DMA_K(0,0);DMA_V(0,0);DMA_K(1,SLOTB);
  bf16x8 qr[4];
  #pragma unroll
  for(int d0=0;d0<4;++d0)qr[d0]=*reinterpret_cast<const bf16x8*>(&Qw[(long)r32*DM+d0*16+hi*8]);
  float mhat=0.f,l_reg=0.f;f32x16 o[2];f32x16 negm; { float z_=0.f; asm volatile("":"+v"(z_)); _Pragma("unroll") for(int r=0;r<16;++r){o[0][r]=z_;o[1][r]=z_;negm[r]=z_;} } asm volatile("":"+v"(negm));
  const int qrel=wid*QBLK+r32;
  #define CMASK(P0,P1,t) do{int jb_=(t)-(NT-4); if(jb_>=0)cmask(P0,P1,jb_,qrel,hi);}while(0)
  bool resc=false;
  #define START(P0,P1) do{ const float rm=rowmax(P0,P1); resc=false; \
    { const float dl=rm; mhat=fadd_s(mhat,dl); \
      _Pragma("unroll") for(int r=0;r<16;++r){P0[r]=fsub_s(P0[r],dl);P1[r]=fsub_s(P1[r],dl);} \
      _Pragma("unroll") for(int r=0;r<16;++r)negm[r]=-mhat; asm volatile("":"+v"(negm)); } \
    _Pragma("unroll") for(int r=0;r<16;++r)P0[r]=__builtin_amdgcn_exp2f(P0[r]); }while(0)
  #define RESC() do{ if(resc){ asm volatile("s_waitcnt lgkmcnt(0)":::"memory"); \
      _Pragma("unroll") for(int d_=0;d_<2;++d_) _Pragma("unroll") for(int r=0;r<16;++r)o[d_][r]*=wsf[crow(r,hi)]; } }while(0)
  f32x16 pA0,pA1,pB0,pB1;
  int sl_prev=0,sl_cur=0,sl_next=SLOTB;
  #define ROT() do{sl_prev=sl_cur;sl_cur=sl_next;sl_next=(sl_next==(NSLOT-1)*SLOTB)?0:sl_next+SLOTB;}while(0)
  DMA_K(2,2*SLOTB);
  WAIT_BAR(3);
  qkt(pA0,pA1,Kbase,qr,negm,r32,hi);asm volatile("s_nop 15\n\ts_nop 7":"+v"(pA0),"+v"(pA1));CMASK(pA0,pA1,0);BIAS(pA0,pA1,0);
  START(pA0,pA1);
  _Pragma("unroll") for(int r=0;r<16;++r)pA1[r]=__builtin_amdgcn_exp2f(pA1[r]);
  WAIT_BAR(0);
  DMA_K(3,0);DMA_V(1,SLOTB);
  ROT();
  kload8(kf,kp0+sl_cur);
  WAIT_BAR(2);
  s16x4 vlo[8],vhi[8]; u32x4 pw0,pw1,pw2,pw3;
  #define PKW(P,B) cvtpk_s(P[B],P[B+1])
  #define PAF(k) __builtin_bit_cast(bf16x8,pw##k)
  #define VFR(i) (bf16x8){vlo[i][0],vlo[i][1],vlo[i][2],vlo[i][3],vhi[i][0],vhi[i][1],vhi[i][2],vhi[i][3]}
  #define PIN(x) asm volatile("":"+v"(x))
  #define MX3(a,b,c) __builtin_fmaxf(__builtin_fmaxf((a),(b)),(c))
  #define GAPA(MF,A0,A1,A2,A3,W0,W1,PW) do{ MF; sacc+=A0; sacc+=A1; sacc+=A2; sacc+=A3; PIN(sacc); W0; W1; PIN(PW); SBAR(); }while(0)
  #define EX(v) __builtin_amdgcn_exp2f(v)
  #define GAPB(MF,X,B) do{ MF; X[B]=EX(X[B]); X[B+1]=EX(X[B+1]); X[B+2]=EX(X[B+2]); X[B+3]=EX(X[B+3]); PIN(X); SBAR(); }while(0)
  #define VRD(i) do{ vlo[i]=vtr(vp_+(((i)>>2)*4096+((i)&3)*1024)); vhi[i]=vtr(vp_+(((i)>>2)*4096+((i)&3)*1024+512)); }while(0)
  #define KRD(G,j) do{ if(G){ kload2(kf,kp0+sl_next,j); SBAR(); } }while(0)
  #define STEP(C0,C1,P0,P1,t,GK,GV,GL) do{ SBAR(); \
    const lds_cptr vp_=vp0+sl_prev; \
    VRD(0); SBAR(); float sacc=(P0[0]+P0[1]); \
    GAPA(C0=__builtin_amdgcn_mfma_f32_32x32x16_bf16(kf[0],qr[0],negm,0,0,0), P0[2],P0[3],P0[4],P0[5],     pw0[0]=PKW(P0,0), pw0[1]=PKW(P0,2), pw0); \
    VRD(4); SBAR(); GAPA(C1=__builtin_amdgcn_mfma_f32_32x32x16_bf16(kf[1],qr[0],negm,0,0,0), P0[6],P0[7],P0[8],P0[9],     pw0[2]=PKW(P0,4), pw0[3]=PKW(P0,6), pw0); \
    VRD(1); SBAR(); GAPA(C0=__builtin_amdgcn_mfma_f32_32x32x16_bf16(kf[2],qr[1],C0,0,0,0),   P0[10],P0[11],P0[12],P0[13], pw1[0]=PKW(P0,8), pw1[1]=PKW(P0,10), pw1); \
    VRD(5); SBAR(); GAPA(C1=__builtin_amdgcn_mfma_f32_32x32x16_bf16(kf[3],qr[1],C1,0,0,0),   P0[14],P0[15],P1[0],P1[1],   pw1[2]=PKW(P0,12),pw1[3]=PKW(P0,14), pw1); \
    VRD(2); SBAR(); GAPA(C0=__builtin_amdgcn_mfma_f32_32x32x16_bf16(kf[4],qr[2],C0,0,0,0),   P1[2],P1[3],P1[4],P1[5],     pw2[0]=PKW(P1,0), pw2[1]=PKW(P1,2), pw2); \
    VRD(6); SBAR(); GAPA(C1=__builtin_amdgcn_mfma_f32_32x32x16_bf16(kf[5],qr[2],C1,0,0,0),   P1[6],P1[7],P1[8],P1[9],     pw2[2]=PKW(P1,4), pw2[3]=PKW(P1,6), pw2); \
    VRD(3); SBAR(); GAPA(C0=__builtin_amdgcn_mfma_f32_32x32x16_bf16(kf[6],qr[3],C0,0,0,0),   P1[10],P1[11],P1[12],P1[13], pw3[0]=PKW(P1,8), pw3[1]=PKW(P1,10), pw3); \
    VRD(7); SBAR(); GAPA(C1=__builtin_amdgcn_mfma_f32_32x32x16_bf16(kf[7],qr[3],C1,0,0,0),   P1[14],P1[15],0.f,0.f,       pw3[2]=PKW(P1,12),pw3[3]=PKW(P1,14), pw3); \
    l_reg+=sacc; \
    if(GK){DMA_K((t)+3,sl_cur);} if(GV){DMA_V((t)+1,sl_next);} \
    CMASK(C0,C1,t); BIAS(C0,C1,t); \
    { float a=MX3(C0[0],C0[1],C1[0]),b=MX3(C0[2],C0[3],C1[1]); a=MX3(a,C1[2],C1[3]); \
      _Pragma("unroll") for(int r=4;r<16;r+=4){a=MX3(a,C0[r],C0[r+1]);b=MX3(b,C0[r+2],C0[r+3]);a=MX3(a,C1[r],C1[r+1]);b=MX3(b,C1[r+2],C1[r+3]);} \
      float rm=__builtin_fmaxf(a,b); { auto rr=__builtin_amdgcn_permlane32_swap(__float_as_uint(rm),__float_as_uint(rm),false,false); rm=__builtin_fmaxf(__uint_as_float(rr[0]),__uint_as_float(rr[1])); } \
      resc=false; \
      if(__builtin_expect(__any(rm>(float)THRL),0)){ const float dl=__builtin_fmaxf(rm,0.f); mhat+=dl; \
        _Pragma("unroll") for(int r=0;r<16;++r){C0[r]-=dl;C1[r]-=dl;} \
        _Pragma("unroll") for(int r=0;r<16;++r)negm[r]=-mhat; asm volatile("":"+v"(negm)); \
        const float f=__builtin_amdgcn_exp2f(-dl); l_reg*=f; if(hi==0)wsf[r32]=f; resc=true; } } \
    SBAR(); \
    GAPB(o[0]=__builtin_amdgcn_mfma_f32_32x32x16_bf16(PAF(0),VFR(0),o[0],0,0,0), C0,0); \
    GAPB(o[1]=__builtin_amdgcn_mfma_f32_32x32x16_bf16(PAF(0),VFR(4),o[1],0,0,0), C0,4); \
    KRD(GL,0); GAPB(o[0]=__builtin_amdgcn_mfma_f32_32x32x16_bf16(PAF(1),VFR(1),o[0],0,0,0), C0,8); \
    KRD(GL,1); GAPB(o[1]=__builtin_amdgcn_mfma_f32_32x32x16_bf16(PAF(1),VFR(5),o[1],0,0,0), C0,12); \
    KRD(GL,2); GAPB(o[0]=__builtin_amdgcn_mfma_f32_32x32x16_bf16(PAF(2),VFR(2),o[0],0,0,0), C1,0); \
    KRD(GL,3); GAPB(o[1]=__builtin_amdgcn_mfma_f32_32x32x16_bf16(PAF(2),VFR(6),o[1],0,0,0), C1,4); \
    GAPB(o[0]=__builtin_amdgcn_mfma_f32_32x32x16_bf16(PAF(3),VFR(3),o[0],0,0,0), C1,8); \
    GAPB(o[1]=__builtin_amdgcn_mfma_f32_32x32x16_bf16(PAF(3),VFR(7),o[1],0,0,0), C1,12); \
    }while(0)
  int t=1;
  #undef CMASK
  #define CMASK(P0,P1,t) do{}while(0)
  for(;t+5<NT;t+=2){
    STEP(pB0,pB1,pA0,pA1,t,true,true,true);     WAIT_BAR(2); RESC(); ROT();
    STEP(pA0,pA1,pB0,pB1,t+1,true,true,true);   WAIT_BAR(2); RESC(); ROT();
  }
  #undef CMASK
  #define CMASK(P0,P1,t) do{int jb_=(t)-(NT-4); if(jb_>=0)cmask(P0,P1,jb_,qrel,hi);}while(0)
  #define ENDW(tt) do{ if((tt)+3<NT){WAIT_BAR(2);} else if((tt)+2<NT){WAIT_BAR(1);} else {WAIT_BAR(0);} }while(0)
  for(;t+1<NT;t+=2){
    STEP(pB0,pB1,pA0,pA1,t,(t+3<NT),(t+1<NT),(t+1<NT));       ENDW(t);   RESC(); ROT();
    STEP(pA0,pA1,pB0,pB1,t+1,(t+4<NT),(t+2<NT),(t+2<NT));     ENDW(t+1); RESC(); ROT();
  }
  STEP(pB0,pB1,pA0,pA1,NT-1,false,false,false); RESC();
  { float sacc=pB0[0]+pB0[1]; _Pragma("unroll") for(int r=2;r<16;++r)sacc+=pB0[r]; _Pragma("unroll") for(int r=0;r<16;++r)sacc+=pB1[r]; l_reg+=sacc;
    pw0=(u32x4){PKW(pB0,0),PKW(pB0,2),PKW(pB0,4),PKW(pB0,6)};pw1=(u32x4){PKW(pB0,8),PKW(pB0,10),PKW(pB0,12),PKW(pB0,14)};pw2=(u32x4){PKW(pB1,0),PKW(pB1,2),PKW(pB1,4),PKW(pB1,6)};pw3=(u32x4){PKW(pB1,8),PKW(pB1,10),PKW(pB1,12),PKW(pB1,14)};
    SBAR(); pv(o,vb0+sl_cur,PAF(0),PAF(1),PAF(2),PAF(3)); }
  #undef PKW
  #undef PAF
  #undef VFR
  #undef PIN
  #undef MX3
  #undef GAPA
  #undef GAPB
  #undef EX
  #undef VRD
  #undef KRD
  #undef STEP
  #undef ENDW
  {auto rr=__builtin_amdgcn_permlane32_swap(__float_as_uint(l_reg),__float_as_uint(l_reg),false,false);l_reg=__uint_as_float(rr[0])+__uint_as_float(rr[1]);}
  if(hi==0)wsf[32+r32]=l_reg;asm volatile("s_waitcnt lgkmcnt(0)":::"memory");
  float rli[16];
  #pragma unroll
  for(int r=0;r<16;++r)rli[r]=__builtin_amdgcn_rcpf(wsf[32+crow(r,hi)]);
  bf16*Ow=O+(rowbase+q0+wid*QBLK)*DM+h*D;
  { bf16*stg=(bf16*)(shm+LDS_OST)+wid*2048;
    #pragma unroll
    for(int r=0;r<16;++r){const int orow=crow(r,hi);
      #pragma unroll
      for(int d0=0;d0<2;++d0)stg[orow*64+d0*32+r32]=__float2bfloat16(o[d0][r]*rli[r]);}
    asm volatile("s_waitcnt lgkmcnt(0)":::"memory");
    #pragma unroll
    for(int i=0;i<4;++i){const int row=i*8+(lane>>3),ch=lane&7; const u32x4 v=*(const u32x4*)(stg+row*64+ch*8); ATTN_STORE16(Ow+(long)row*DM+ch*8,v);} }
  asm volatile("s_waitcnt lgkmcnt(0)\n\ts_barrier":::"memory");
  #undef BIAS
  #undef BIAS_H
  #undef DMA_K
  #undef DMA_V
  #undef CMASK
  #undef START
  #undef RESC
  #undef ROT
}
constexpr int ATTN_LDS_BYTES=LDS_BYTES;
#undef SBAR
#undef WAIT_BAR
}


constexpr int NWAVES = 8;
constexpr int RING_OFF = 0, RING_BYTES = 131072;
constexpr int LDSCTL_OFF = RING_BYTES, MISC_OFF = LDSCTL_OFF + 320, TAB_OFF = LDSCTL_OFF + 1024;
constexpr int LDS_BYTES = 147456;
typedef GAS unsigned gu32;
#define RLX_AGENT __ATOMIC_RELAXED, __HIP_MEMORY_SCOPE_AGENT

#define XB_TMO      128
#define XB_XCNT(j)  (256  + 64 * (j))
#define XB_XSUB(j)  (1280 + 64 * (j))
#define XB_XGEN(j)  (2304 + 64 * (j))
#define XB_TOP      3328
#define XB_TOPGEN   3392
#define XCD_BAR_WORDS 3456
#define XB_SPIN_CAP (1u << 18)

__device__ __forceinline__ unsigned xb_ld(unsigned* p)              { return __hip_atomic_load(p, __ATOMIC_RELAXED, __HIP_MEMORY_SCOPE_AGENT); }
__device__ __forceinline__ unsigned xb_add(unsigned* p, unsigned v) { return __hip_atomic_fetch_add(p, v, __ATOMIC_RELAXED, __HIP_MEMORY_SCOPE_AGENT); }
__device__ __forceinline__ unsigned xb_xcc_id() { return (unsigned)__builtin_amdgcn_s_getreg((3 << 11) | 20) & 0xFu; }
#define XB_SPIN(cond, bar) do { unsigned _sp = 0; while (cond) { __builtin_amdgcn_s_sleep(1); \
    if ((++_sp & 255u) == 0u) { if (xb_ld(&(bar)[XB_TMO])) break; if (_sp > XB_SPIN_CAP) { atomicAdd(&(bar)[XB_TMO], 1u); break; } } } } while (0)

struct XcdBarrier {
    unsigned* bar; unsigned x;
    volatile LAS unsigned* st;
};

__device__ __forceinline__ XcdBarrier xcd_barrier_post(unsigned* bar, volatile LAS unsigned* st) {
    XcdBarrier b; b.bar = bar; b.x = xb_xcc_id(); b.st = st;
    if (threadIdx.x == 0) (void)xb_add(&bar[XB_XCNT(b.x)], 1u);
    return b;
}
__device__ __forceinline__ void xcd_barrier_complete(unsigned* bar, unsigned x, unsigned& nloc, unsigned& nx) {
    const unsigned G = gridDim.x * gridDim.y * gridDim.z;
    unsigned sum, cnt, mine, sp = 0u;
    for (;;) {
        sum = 0u; cnt = 0u; mine = 0u;
#pragma unroll
        for (unsigned j = 0; j < 16; ++j) { const unsigned c = xb_ld(&bar[XB_XCNT(j)]); sum += c; cnt += (c > 0u) ? 1u : 0u; mine = (j == x) ? c : mine; }
        if (sum == G) break;
        __builtin_amdgcn_s_sleep(1);
        if ((++sp & 255u) == 0u) { if (xb_ld(&bar[XB_TMO])) break; if (sp > XB_SPIN_CAP) { atomicAdd(&bar[XB_TMO], 1u); break; } }
    }
    nloc = mine > 0u ? mine : 1u; nx = cnt > 0u ? cnt : 1u;
}

__device__ __forceinline__ void xcd_barrier(const XcdBarrier& b) {
    asm volatile("s_waitcnt vmcnt(0)" ::: "memory");
    __syncthreads();
    if (threadIdx.x == 0) {
        unsigned* bar = b.bar;
        __builtin_amdgcn_s_waitcnt(0);
        unsigned nloc = b.st[0], nx = b.st[1];
        if (nloc == 0u) { xcd_barrier_complete(bar, b.x, nloc, nx); b.st[0] = nloc; b.st[1] = nx; }
        const unsigned old = xb_add(&bar[XB_XSUB(b.x)], 1u);
        const unsigned gen = old / nloc;
        if (old + 1u == (gen + 1u) * nloc) {
            __builtin_amdgcn_fence(__ATOMIC_RELEASE, "agent");
            asm volatile("s_waitcnt vmcnt(0)" ::: "memory");
            const unsigned og = xb_add(&bar[XB_TOP], 1u);
            const unsigned tg = og / nx;
            if (og + 1u == (tg + 1u) * nx) xb_add(&bar[XB_TOPGEN], 1u);
            else XB_SPIN(xb_ld(&bar[XB_TOPGEN]) == tg, bar);
            __builtin_amdgcn_fence(__ATOMIC_ACQUIRE, "agent");
            xb_add(&bar[XB_XGEN(b.x)], 1u);
            asm volatile("s_waitcnt vmcnt(0)" ::: "memory");
        } else {
            XB_SPIN(xb_ld(&bar[XB_XGEN(b.x)]) == gen, bar);
            __builtin_amdgcn_fence(__ATOMIC_ACQUIRE, "agent");
            asm volatile("s_waitcnt vmcnt(0)" ::: "memory");
        }
    }
    __syncthreads();
}


struct Args {
    const float *x, *ln_in_g, *ln_in_b, *w_in, *b_in, *w_fox, *lbl, *norm_g, *w_hgrn, *w_mix, *b_mix, *ln1_g, *ln1_b, *router_w, *router_b, *w1, *w3, *w2, *ln2_g, *ln2_b;
    float* out; unsigned char* ws; int ph_lo, ph_hi, use_bar, pad;
};
struct Frame { LAS unsigned char* lds; int tid, lane, wave, G, gw, ngw, bid; };
#define LOAD_ARGS() launder_args(args)
__device__ __forceinline__ Args launder_args(const Args& args) { Args a = args; size_t z_ = 0; asm volatile("" : "+s"(z_)); a.ws = args.ws + z_; return a; }

__device__ __forceinline__ void ln_rows16(f32x4 (&v)[4], const float* g, const float* bta, int lane) {
    float s = 0.f;
#pragma unroll
    for (int j = 0; j < 4; ++j) s += (v[j].x + v[j].y) + (v[j].z + v[j].w);
    const float mean = wave_sum(s) * (1.f / D); float s2 = 0.f;
#pragma unroll
    for (int j = 0; j < 4; ++j) { v[j] = v[j] - mean; s2 += (v[j].x * v[j].x + v[j].y * v[j].y) + (v[j].z * v[j].z + v[j].w * v[j].w); }
    const float rstd = rsqrtf(wave_sum(s2) * (1.f / D) + LN_EPS);
#pragma unroll
    for (int j = 0; j < 4; ++j) { const int c = 4 * lane + 256 * j; const f32x4 gg = *(const f32x4*)(g + c), bb = *(const f32x4*)(bta + c); v[j] = v[j] * rstd * gg + bb; }
}
__device__ __forceinline__ void store_row(const f32x4 (&v)[4], int lane, float* of32, bf16_t* obf, float* of32b) {
#pragma unroll
    for (int j = 0; j < 4; ++j) { const int c = 4 * lane + 256 * j;
        if (of32) *(f32x4*)(of32 + c) = v[j];
        if (of32b) *(f32x4*)(of32b + c) = v[j];
        if (obf) { u32x2 w; w.x = pk2(v[j].x, v[j].y); w.y = pk2(v[j].z, v[j].w); *(u32x2*)(obf + c) = w; } }
}

__device__ __forceinline__ void cvt_item(const float* W, int ldw, int k0, int srccol, int nvalid, bf16_t* WT, int ldt, int dstrow, int dstk, LAS float* scr, int lane) {
    const int ks = lane >> 3, n4 = (lane & 7) * 4;
    f32x4 v[8];
#pragma unroll
    for (int j = 0; j < 8; ++j) v[j] = (n4 < nvalid) ? *(const f32x4*)(W + (size_t)(k0 + 8 * j + ks) * ldw + srccol + n4) : (f32x4){0.f, 0.f, 0.f, 0.f};
#pragma unroll
    for (int j = 0; j < 8; ++j) { LAS float* d = scr + (8 * j + ks) * 33 + n4; d[0] = v[j][0]; d[1] = v[j][1]; d[2] = v[j][2]; d[3] = v[j][3]; }
    asm volatile("s_waitcnt lgkmcnt(0)" ::: "memory");
    const int c = lane & 7;
#pragma unroll
    for (int j = 0; j < 4; ++j) { const int n = (lane >> 3) + 8 * j; const LAS float* s = scr + (8 * c) * 33 + n;
        u32x4 o; o.x = pk2(s[0 * 33], s[1 * 33]); o.y = pk2(s[2 * 33], s[3 * 33]); o.z = pk2(s[4 * 33], s[5 * 33]); o.w = pk2(s[6 * 33], s[7 * 33]);
        *(u32x4*)(WT + (size_t)(dstrow + n) * ldt + dstk + k0 + 8 * c) = o; }
    asm volatile("s_waitcnt lgkmcnt(0)" ::: "memory");
}
__device__ __forceinline__ void convert_layer(const Args& a, const Frame& F, int l) {
    LAS float* scr = (LAS float*)(F.lds + RING_OFF + F.wave * 16384);
    const int gw = F.gw, ngw = F.ngw, lane = F.lane;
    bf16_t* WIN = (bf16_t*)(a.ws + WS_WIN); bf16_t* WBR = (bf16_t*)(a.ws + WS_WBR); bf16_t* WMIX = (bf16_t*)(a.ws + WS_WMIX);
    bf16_t* W13 = (bf16_t*)(a.ws + WS_W13); bf16_t* W2 = (bf16_t*)(a.ws + WS_W2);
    constexpr int I_IN = 16 * 184, I_BR = 8 * 32, I_MIX = 16 * 32, I_13 = 16 * 64 * NE, I_2 = 16 * 32 * NE;
    constexpr int NITEMS = I_IN + 2 * I_BR + I_MIX + I_13 + I_2;
    for (int it = gw; it < NITEMS; it += ngw) {
        int r = it;
        if (r < I_IN) { const int kb = r / 184, nb = r % 184, n0 = nb * 32;
            int src, nv = 32; if (n0 < 1536) src = n0; else if (n0 < 5632) src = n0 + 8; else if (n0 == 5632) { src = 1536; nv = 8; } else { src = 0; nv = 0; }
            cvt_item(a.w_in + (size_t)l * D * NIN, NIN, kb * 64, src, nv, WIN, D, n0, 0, scr, lane); continue; } r -= I_IN;
        if (r < I_BR) { const int kb = r / 32, nb = r % 32; cvt_item(a.w_fox + (size_t)l * 512 * D, D, kb * 64, nb * 32, 32, WBR, D, nb * 32, 0, scr, lane); continue; } r -= I_BR;
        if (r < I_BR) { const int kb = r / 32, nb = r % 32; cvt_item(a.w_hgrn + (size_t)l * 512 * D, D, kb * 64, nb * 32, 32, WBR, D, nb * 32, 512, scr, lane); continue; } r -= I_BR;
        if (r < I_MIX) { const int kb = r / 32, nb = r % 32; cvt_item(a.w_mix + (size_t)l * D * D, D, kb * 64, nb * 32, 32, WMIX, D, nb * 32, 0, scr, lane); continue; } r -= I_MIX;
        if (r < I_13) { const int e = r / 1024, q = r % 1024, kb = q / 64, nb = q % 64, n0 = nb * 32;
            const int j = n0 >> 8, rr = n0 & 255; const float* src = (rr < 128 ? a.w1 : a.w3) + ((size_t)l * NE + e) * D * D;
            cvt_item(src, D, kb * 64, 128 * j + (rr & 127), 32, W13 + (size_t)e * 2048 * D, D, n0, 0, scr, lane); continue; } r -= I_13;
        { const int e = r / 512, q = r % 512, kb = q / 32, nb = q % 32;
            cvt_item(a.w2 + ((size_t)l * NE + e) * D * D, D, kb * 64, nb * 32, 32, W2 + (size_t)e * D * D, D, nb * 32, 0, scr, lane); }
    }
    float* biasp = (float*)(a.ws + WS_MISC + 16384);
    for (int n = gw * 64 + lane; n < NINP; n += ngw * 64) {
        float v = 0.f; if (n < 1536) v = a.b_in[l * NIN + n]; else if (n < 5632) v = a.b_in[l * NIN + n + 8]; else if (n < 5640) v = a.b_in[l * NIN + 1536 + (n - 5632)];
        biasp[n] = v; }
}

__device__ __forceinline__ void phase_prep(const Args& a, const Frame& F) {
    if (F.bid == 0) {
        float* lb_all = (float*)(a.ws + WS_MISC);
        const int c = F.tid;
        float v[DEPTH], m = -1e30f;
#pragma unroll
        for (int l = 0; l < DEPTH; ++l) { v[l] = a.lbl[l * 512 + c]; m = fmaxf(m, v[l]); }
        float s = 0.f;
#pragma unroll
        for (int l = 0; l < DEPTH; ++l) { v[l] = __expf(v[l] - m); s += v[l]; }
        float cum = 0.f;
#pragma unroll
        for (int l = 0; l < DEPTH; ++l) { const float p = v[l] / s; cum += p; lb_all[l * 512 + c] = cum - v[0] / s; }
    }
    float* XRES = (float*)(a.ws + WS_XRES); bf16_t* XN = (bf16_t*)(a.ws + WS_XN);
    for (int row = F.gw; row < T; row += F.ngw) {
        f32x4 v[4];
#pragma unroll
        for (int j = 0; j < 4; ++j) v[j] = *(const f32x4*)(a.x + (size_t)row * D + 4 * F.lane + 256 * j);
        ln_rows16(v, a.ln_in_g, a.ln_in_b, F.lane);
        store_row(v, F.lane, XRES + (size_t)row * D, XN + (size_t)row * D, nullptr);
    }
    convert_layer(a, F, 0);
}

__device__ __forceinline__ void phase_fscan(const Args& a, const Frame& F) {
    if (F.bid >= BATCH * NH) return;
    const float* FL = (const float*)(a.ws + WS_FL); float* F2 = (float*)(a.ws + WS_F2);
    LAS float* wsum = (LAS float*)(F.lds + RING_OFF);
    const int bh = F.bid, b = bh >> 3, h = bh & 7, tid = F.tid, lane = F.lane, w = F.wave;
    float v[4], run = 0.f;
#pragma unroll
    for (int i = 0; i < 4; ++i) { run += FL[((size_t)b * SEQ + tid * 4 + i) * 8 + h]; v[i] = run; }
    float incl = run;
#pragma unroll
    for (int o = 1; o < 64; o <<= 1) { const float u = __shfl_up(incl, o); if (lane >= o) incl += u; }
    if (lane == 63) wsum[w] = incl;
    __syncthreads();
    float base = incl - run; for (int i = 0; i < w; ++i) base += wsum[i];
#pragma unroll
    for (int i = 0; i < 4; ++i) F2[(size_t)bh * SEQ + tid * 4 + i] = (base + v[i]) * LOG2E;
    __syncthreads();
}

__device__ __forceinline__ void phase_attn_naive(const Args& a, const Frame& F) {
    const bf16_t* QO = (const bf16_t*)(a.ws + WS_QO); const bf16_t* KV = (const bf16_t*)(a.ws + WS_KV); const float* F2 = (const float*)(a.ws + WS_F2); bf16_t* O = (bf16_t*)(a.ws + WS_QO);
    LAS float* ps = (LAS float*)(F.lds + RING_OFF) + F.wave * 64;
    const int lane = F.lane;
    for (int gid = F.gw; gid < BATCH * NH * SEQ; gid += F.ngw) {
        const int bh = gid & 127, t = gid >> 7, b = bh >> 3, h = bh & 7;
        float q[64];
        { const bf16_t* qp = QO + ((size_t)b * SEQ + t) * 1024 + h * 64;
#pragma unroll
          for (int c = 0; c < 8; ++c) { const u32x4 u = *(const u32x4*)(qp + c * 8);
            q[c * 8 + 0] = bflo(u.x); q[c * 8 + 1] = bfhi(u.x); q[c * 8 + 2] = bflo(u.y); q[c * 8 + 3] = bfhi(u.y);
            q[c * 8 + 4] = bflo(u.z); q[c * 8 + 5] = bfhi(u.z); q[c * 8 + 6] = bflo(u.w); q[c * 8 + 7] = bfhi(u.w); } }
        float m = -1e30f, l = 0.f, o = 0.f;
        const float* f2 = F2 + (size_t)bh * SEQ;
        for (int s0 = 0; s0 <= t; s0 += 64) {
            const int s = s0 + lane; const bool valid = s <= t;
            float sc = -1e30f;
            if (valid) { const bf16_t* kp = KV + ((size_t)b * SEQ + s) * 1024 + h * 64; float d = 0.f;
#pragma unroll
                for (int c = 0; c < 8; ++c) { const u32x4 u = *(const u32x4*)(kp + c * 8);
                    d += q[c * 8 + 0] * bflo(u.x) + q[c * 8 + 1] * bfhi(u.x) + q[c * 8 + 2] * bflo(u.y) + q[c * 8 + 3] * bfhi(u.y)
                       + q[c * 8 + 4] * bflo(u.z) + q[c * 8 + 5] * bfhi(u.z) + q[c * 8 + 6] * bflo(u.w) + q[c * 8 + 7] * bfhi(u.w); }
                sc = d - f2[s]; }
            const float mn = fmaxf(m, wave_max(sc));
            const float p = valid ? exp2f(sc - mn) : 0.f;
            const float f = exp2f(m - mn);
            l = l * f + wave_sum(p); o *= f; m = mn;
            ps[lane] = p;
            asm volatile("s_waitcnt lgkmcnt(0)" ::: "memory");
            const int nk = min(64, t - s0 + 1);
            const bf16_t* vp = KV + ((size_t)b * SEQ + s0) * 1024 + 512 + h * 64 + lane;
            for (int j = 0; j < nk; ++j) o += ps[j] * bf2f(vp[(size_t)j * 1024]);
            asm volatile("s_waitcnt lgkmcnt(0)" ::: "memory");
        }
        O[((size_t)b * SEQ + t) * 1024 + h * 64 + lane] = (bf16_t)f2bf(o / l);
    }
}

__device__ __forceinline__ void phase_hgrn_naive(const Args& a, const Frame& F, int l) {
    if (F.bid >= BATCH * NH || F.wave != 0) return;
    const bf16_t* HB = (const bf16_t*)(a.ws + WS_HB); const float* LOGF = (const float*)(a.ws + WS_LOGF); const bf16_t* HG = (const bf16_t*)(a.ws + WS_HG); bf16_t* O = (bf16_t*)(a.ws + WS_QO);
    LAS float* Lf = (LAS float*)(F.lds + RING_OFF + 1024); LAS float* Lk = Lf + 4096; LAS float* Lq = Lk + 4096;
    const int bh = F.bid, b = bh >> 3, h = bh & 7, lane = F.lane;
    float Sx[64];
#pragma unroll
    for (int d = 0; d < 64; ++d) Sx[d] = 0.f;
    const float ng = a.norm_g[l * 512 + h * 64 + lane];
    for (int c0 = 0; c0 < SEQ; c0 += 64) {
        for (int tt = 0; tt < 64; ++tt) { const size_t row = (size_t)b * SEQ + c0 + tt;
            const float lf = LOGF[row * 512 + h * 64 + lane]; const float f = __expf(lf);
            Lf[tt * 64 + lane] = f; Lk[tt * 64 + lane] = 1.f - f; Lq[tt * 64 + lane] = bf2f(HB[row * 1024 + h * 64 + lane]); }
        asm volatile("s_waitcnt lgkmcnt(0)" ::: "memory");
        for (int tt = 0; tt < 64; ++tt) { const size_t row = (size_t)b * SEQ + c0 + tt;
            const float v = bf2f(HB[row * 1024 + 512 + h * 64 + lane]);
            float o = 0.f;
#pragma unroll
            for (int d = 0; d < 64; d += 4) { const f32x4 f4 = *(const LAS f32x4*)(Lf + tt * 64 + d), k4 = *(const LAS f32x4*)(Lk + tt * 64 + d), q4 = *(const LAS f32x4*)(Lq + tt * 64 + d);
                Sx[d] = f4.x * Sx[d] + k4.x * v; o += Sx[d] * q4.x; Sx[d + 1] = f4.y * Sx[d + 1] + k4.y * v; o += Sx[d + 1] * q4.y;
                Sx[d + 2] = f4.z * Sx[d + 2] + k4.z * v; o += Sx[d + 2] * q4.z; Sx[d + 3] = f4.w * Sx[d + 3] + k4.w * v; o += Sx[d + 3] * q4.w; }
            const float ss = wave_sum(o * o);
            const float r = o * rsqrtf(ss * (1.f / 64.f) + RMS_EPS) * ng * bf2f(HG[row * 512 + h * 64 + lane]);
            O[row * 1024 + 512 + h * 64 + lane] = (bf16_t)f2bf(r); }
        asm volatile("s_waitcnt lgkmcnt(0)" ::: "memory");
    }
}

constexpr int LN1_RW = 0, LN1_LG = 65536, LN1_ASG = LN1_LG + 8 * 16 * 16 * 4, LN1_BASE = LN1_ASG + 128 * 16;
__device__ __forceinline__ void phase_ln1_router(const Args& a, const Frame& F, int l) {
    const float* xres = (const float*)(a.ws + WS_XRES); float* x1 = a.out; const bf16_t* mixed = (const bf16_t*)(a.ws + WS_MIXED); bf16_t* xn = (bf16_t*)(a.ws + WS_XN);
    unsigned* cnt = (unsigned*)(a.ws + WS_CTL) + CW_CNT + l * 64; int* list = (int*)(a.ws + WS_LIST); unsigned* tokinfo = (unsigned*)(a.ws + WS_TOK);
    const float* g = a.ln1_g + l * D; const float* bta = a.ln1_b + l * D;
    LAS float* rw = (LAS float*)(F.lds + RING_OFF + LN1_RW);
    LAS float* lgs = (LAS float*)(F.lds + RING_OFF + LN1_LG) + F.wave * 256;
    LAS u32x4* asg = (LAS u32x4*)(F.lds + RING_OFF + LN1_ASG);
    LAS unsigned* basep = (LAS unsigned*)(F.lds + RING_OFF + LN1_BASE);
    for (int i = F.tid; i < NE * D; i += NWAVES * 64) { const int c = i >> 4, e = i & 15; rw[e * D + c] = a.router_w[i]; }
    __syncthreads();
    const int lane = F.lane;
    for (int blk = F.bid; blk < T / 128; blk += F.G) {
        const int R0 = blk * 128 + F.wave * 16;
        for (int i = 0; i < 16; ++i) { const int row = R0 + i;
            f32x4 v[4];
#pragma unroll
            for (int j = 0; j < 4; ++j) { const int c = 4 * lane + 256 * j; const f32x4 xv = *(const f32x4*)(xres + (size_t)row * D + c);
                const u32x2 mm = *(const u32x2*)(mixed + (size_t)row * D + c);
                v[j].x = ALPHA * xv.x + bflo(mm.x); v[j].y = ALPHA * xv.y + bfhi(mm.x); v[j].z = ALPHA * xv.z + bflo(mm.y); v[j].w = ALPHA * xv.w + bfhi(mm.y); }
            ln_rows16(v, g, bta, lane);
            store_row(v, lane, x1 + (size_t)row * D, xn + (size_t)row * D, nullptr);
            float p[NE];
#pragma unroll
            for (int e = 0; e < NE; ++e) { float s = 0.f;
#pragma unroll
                for (int j = 0; j < 4; ++j) { const f32x4 r4 = *(const LAS f32x4*)(rw + e * D + 4 * lane + 256 * j); s += v[j].x * r4.x + v[j].y * r4.y + v[j].z * r4.z + v[j].w * r4.w; }
                p[e] = s; asm volatile("" ::: "memory"); }
            { const bool hi5 = (lane & 32) != 0;
#pragma unroll
              for (int k = 0; k < 8; ++k) { const float snd = hi5 ? p[k] : p[k + 8]; const float rcv = __shfl_xor(snd, 32); p[k] = (hi5 ? p[k + 8] : p[k]) + rcv; }
              const bool hi4 = (lane & 16) != 0;
#pragma unroll
              for (int k = 0; k < 4; ++k) { const float snd = hi4 ? p[k] : p[k + 4]; const float rcv = __shfl_xor(snd, 16); p[k] = (hi4 ? p[k + 4] : p[k]) + rcv; }
              const bool hi3 = (lane & 8) != 0;
#pragma unroll
              for (int k = 0; k < 2; ++k) { const float snd = hi3 ? p[k] : p[k + 2]; const float rcv = __shfl_xor(snd, 8); p[k] = (hi3 ? p[k + 2] : p[k]) + rcv; }
              const bool hi2 = (lane & 4) != 0;
              { const float snd = hi2 ? p[0] : p[1]; const float rcv = __shfl_xor(snd, 4); p[0] = (hi2 ? p[1] : p[0]) + rcv; }
              p[0] += __shfl_xor(p[0], 2); p[0] += __shfl_xor(p[0], 1);
              if ((lane & 3) == 0) lgs[i * 16 + (lane >> 2)] = p[0]; }
        }
        asm volatile("s_waitcnt lgkmcnt(0)" ::: "memory");
        if (lane < 16) {
            float lg[NE];
#pragma unroll
            for (int q = 0; q < 4; ++q) { const f32x4 t4 = *(const LAS f32x4*)(lgs + lane * 16 + 4 * q); lg[4 * q] = t4[0] + a.router_b[4 * q]; lg[4 * q + 1] = t4[1] + a.router_b[4 * q + 1]; lg[4 * q + 2] = t4[2] + a.router_b[4 * q + 2]; lg[4 * q + 3] = t4[3] + a.router_b[4 * q + 3]; }
            int gs = 0; float gbest = -3e38f;
#pragma unroll
            for (int gi = 0; gi < 4; ++gi) { const float mx = fmaxf(fmaxf(lg[gi * 4], lg[gi * 4 + 1]), fmaxf(lg[gi * 4 + 2], lg[gi * 4 + 3])); if (mx > gbest) { gbest = mx; gs = gi; } }
            float l4[4];
#pragma unroll
            for (int i = 0; i < 4; ++i) { float t0 = lg[i];
#pragma unroll
                for (int gi = 1; gi < 4; ++gi) t0 = (gs == gi) ? lg[gi * 4 + i] : t0; l4[i] = t0; }
            int i0 = 0; float b0 = l4[0];
#pragma unroll
            for (int i = 1; i < 4; ++i) if (l4[i] > b0) { b0 = l4[i]; i0 = i; }
            int i1 = 0; float b1 = -3e38f;
#pragma unroll
            for (int i = 0; i < 4; ++i) if (i != i0 && l4[i] > b1) { b1 = l4[i]; i1 = i; }
            const float e1 = __expf(b1 - b0); const float g0 = 1.f / (1.f + e1), g1 = e1 / (1.f + e1);
            u32x4 as; as.x = (unsigned)(gs * 4 + i0); as.y = (unsigned)(gs * 4 + i1); as.z = __float_as_uint(g0); as.w = __float_as_uint(g1);
            asg[F.wave * 16 + lane] = as;
        }
        __syncthreads();
        if (F.wave == 0) {
            const u32x4 A0 = asg[lane], A1 = asg[lane + 64];
            const unsigned ex[4] = {A0.x, A0.y, A1.x, A1.y};
            unsigned rank[4] = {0u, 0u, 0u, 0u}, mycount = 0u;
            const unsigned long long lt = (1ull << lane) - 1ull;
#pragma unroll 1
            for (unsigned e = 0; e < NE; ++e) { unsigned run = 0u;
#pragma unroll
                for (int s = 0; s < 4; ++s) { const unsigned long long m = __ballot(ex[s] == e); if (ex[s] == e) rank[s] = run + (unsigned)__popcll(m & lt); run += (unsigned)__popcll(m); }
                if ((unsigned)lane == e) mycount = run; }
            if (lane < NE) basep[lane] = atomicAdd(cnt + lane, mycount);
            asm volatile("s_waitcnt vmcnt(0) lgkmcnt(0)" ::: "memory");
            const unsigned p0 = basep[ex[0]] + rank[0], p1 = basep[ex[1]] + rank[1], p2 = basep[ex[2]] + rank[2], p3 = basep[ex[3]] + rank[3];
            const int ra = blk * 128 + lane, rb = ra + 64;
            list[ex[0] * T + p0] = ra; list[ex[1] * T + p1] = ra; list[ex[2] * T + p2] = rb; list[ex[3] * T + p3] = rb;
            u32x4 ta, tb; ta.x = (ex[0] << 24) | p0; ta.y = (ex[1] << 24) | p1; ta.z = A0.z; ta.w = A0.w; tb.x = (ex[2] << 24) | p2; tb.y = (ex[3] << 24) | p3; tb.z = A1.z; tb.w = A1.w;
            *(u32x4*)(tokinfo + (size_t)ra * 4) = ta; *(u32x4*)(tokinfo + (size_t)rb * 4) = tb;
        }
        __syncthreads();
    }
}

__device__ __forceinline__ void moe_table(const Args& a, const Frame& F, int l) {
    LAS int* tab = (LAS int*)(F.lds + TAB_OFF);
    const unsigned* cnt = (const unsigned*)(a.ws + WS_CTL) + CW_CNT + l * 64;
    if (F.tid == 0) { int ts = 0; for (int e = 0; e < NE; ++e) { const int c = (int)__hip_atomic_load(cnt + e, RLX_AGENT); tab[e] = ts; tab[NE + 1 + e] = c; ts += (c + TM - 1) / TM; } tab[NE] = ts; }
    __syncthreads();
}

__device__ __forceinline__ void phase_combine_ln2(const Args& a, const Frame& F, int l) {
    float* xres = (float*)(a.ws + WS_XRES); const float* x1 = a.out; const bf16_t* Y = (const bf16_t*)(a.ws + WS_Y); const unsigned* tokinfo = (const unsigned*)(a.ws + WS_TOK); bf16_t* xn = (bf16_t*)(a.ws + WS_XN);
    const float* g = a.ln2_g + l * D; const float* bta = a.ln2_b + l * D; float* out = (l == DEPTH - 1) ? a.out : nullptr;
    const LAS int* tab = (const LAS int*)(F.lds + TAB_OFF);
    const int lane = F.lane;
    for (int row = F.gw; row < T; row += F.ngw) {
        const unsigned i0 = tokinfo[row * 4], i1 = tokinfo[row * 4 + 1]; const float g0 = __uint_as_float(tokinfo[row * 4 + 2]), g1 = __uint_as_float(tokinfo[row * 4 + 3]);
        const size_t s0 = (size_t)tab[i0 >> 24] * TM + (i0 & 0xffffff), s1 = (size_t)tab[i1 >> 24] * TM + (i1 & 0xffffff);
        f32x4 v[4];
#pragma unroll
        for (int j = 0; j < 4; ++j) { const int c = 4 * lane + 256 * j; const f32x4 xv = *(const f32x4*)(x1 + (size_t)row * D + c);
            const u32x2 ya = *(const u32x2*)(Y + s0 * D + c), yb = *(const u32x2*)(Y + s1 * D + c);
            v[j].x = ALPHA * xv.x + g0 * bflo(ya.x) + g1 * bflo(yb.x); v[j].y = ALPHA * xv.y + g0 * bfhi(ya.x) + g1 * bfhi(yb.x);
            v[j].z = ALPHA * xv.z + g0 * bflo(ya.y) + g1 * bflo(yb.y); v[j].w = ALPHA * xv.w + g0 * bfhi(ya.y) + g1 * bfhi(yb.y); }
        ln_rows16(v, g, bta, lane);
        store_row(v, lane, xres + (size_t)row * D, xn + (size_t)row * D, out ? out + (size_t)row * D : nullptr);
    }
}


constexpr int ATT_F2_OFF = 86016;
__device__ __forceinline__ void phase_attn(const Args& a, const Frame& F, char* lds_generic) {
    const int c = F.bid, vcu = (F.G % 8 == 0) ? (c % 8) * (F.G / 8) + c / 8 : c;
    const attn_body::bf16* Q = (const attn_body::bf16*)(a.ws + WS_QO); const attn_body::bf16* K = (const attn_body::bf16*)(a.ws + WS_KV); const attn_body::bf16* V = K + 512;
    attn_body::bf16* O = (attn_body::bf16*)(a.ws + WS_QO);
    const float* FL = (const float*)(a.ws + WS_FL);
    LAS float* f2 = (LAS float*)(F.lds + ATT_F2_OFF); LAS float* wsum = f2 + 2048;
    { const int bh = vcu >> 1; if (bh >= BATCH * NH) return;
        const int b = bh >> 3, h = bh & 7, tid = F.tid, lane = F.lane, w = F.wave;
        float v[4], run = 0.f;
#pragma unroll
        for (int i = 0; i < 4; ++i) { run += FL[((size_t)b * SEQ + tid * 4 + i) * 8 + h]; v[i] = run; }
        float incl = run;
#pragma unroll
        for (int o = 1; o < 64; o <<= 1) { const float u = __shfl_up(incl, o); if (lane >= o) incl += u; }
        if (lane == 63) wsum[w] = incl;
        __syncthreads();
        float base = incl - run; for (int i = 0; i < w; ++i) base += wsum[i];
        f32x4 o4; o4[0] = (base + v[0]) * LOG2E; o4[1] = (base + v[1]) * LOG2E; o4[2] = (base + v[2]) * LOG2E; o4[3] = (base + v[3]) * LOG2E;
        *(LAS f32x4*)(f2 + tid * 4) = o4;
        __syncthreads();
        for (int i = 0; i < 4; ++i) { const int s = 2 * (vcu & 1) + (i >> 1); const int qb = (i & 1) ? 7 - s : s;
            int tid_u = F.tid; asm volatile("" : "+v"(tid_u));
            attn_body::attn_unit<8>(b, h, qb, Q, K, V, O, lds_generic + RING_OFF, f2, tid_u); }
        __syncthreads();
    }
}

namespace hg {
constexpr int PB = 144;
constexpr int O_QS = 0, O_KS = 9216, O_QI = 18432, O_KUT = 27648, O_VT = 36864, O_P = 46080, O_ST = 55296, O_TOT = 64512, O_EBL = 66560, O_RED = 66816, BYTES = 67328;
__device__ __forceinline__ float ex(float v) { return __builtin_amdgcn_exp2f(v * LOG2E); }
__device__ __forceinline__ unsigned short bf1(float v) { return (unsigned short)f2bf(v); }
}
__device__ __forceinline__ void phase_hgrn(const Args& a, const Frame& F, int l) {
    using namespace hg;
    if (F.bid >= BATCH * NH) return;
    const bf16_t* HB = (const bf16_t*)(a.ws + WS_HB); const float* LOGF = (const float*)(a.ws + WS_LOGF); const bf16_t* HG = (const bf16_t*)(a.ws + WS_HG); bf16_t* O = (bf16_t*)(a.ws + WS_QO);
    LAS unsigned char* L = F.lds + RING_OFF;
    const int bh = F.bid, b = bh >> 3, h = bh & 7, lane = F.lane, w = F.wave, tid = F.tid;
    const int fr = lane & 15, fq = lane >> 4;
    const int tr = w >> 1, tc0 = 2 * (w & 1);
    const float ng0 = a.norm_g[l * 512 + h * 64 + 16 * tc0 + fr], ng1 = a.norm_g[l * 512 + h * 64 + 16 * (tc0 + 1) + fr];
    f32x4 S0 = {0.f, 0.f, 0.f, 0.f}, S1 = {0.f, 0.f, 0.f, 0.f};
    for (int i = tid; i < 9216 / 4; i += NWAVES * 64) ((LAS unsigned*)(L + O_ST))[i] = 0u;
    const size_t rowbase = (size_t)b * SEQ;
    float g[8]; unsigned short qv[8], vv[8];
#pragma unroll
    for (int i = 0; i < 8; ++i) { const size_t row = rowbase + 8 * w + i; g[i] = LOGF[row * 512 + h * 64 + lane]; qv[i] = HB[row * 1024 + h * 64 + lane]; vv[i] = HB[row * 1024 + 512 + h * 64 + lane]; }
    for (int c0 = 0; c0 < SEQ; c0 += 64) {
        float bc[8]; { float run = 0.f;
#pragma unroll
            for (int i = 0; i < 8; ++i) { run += g[i]; bc[i] = run; } }
        ((LAS float*)(L + O_TOT))[w * 64 + lane] = bc[7];
        float qf[8], kf[8];
#pragma unroll
        for (int i = 0; i < 8; ++i) { qf[i] = bf2f(qv[i]); kf[i] = 1.f - ex(g[i]); }
        { u32x4 pk; pk.x = (unsigned)vv[0] | ((unsigned)vv[1] << 16); pk.y = (unsigned)vv[2] | ((unsigned)vv[3] << 16); pk.z = (unsigned)vv[4] | ((unsigned)vv[5] << 16); pk.w = (unsigned)vv[6] | ((unsigned)vv[7] << 16);
          *(LAS u32x4*)(L + O_VT + lane * PB + 16 * w) = pk; }
        __syncthreads();
        float base = 0.f, bm = 0.f, bl = 0.f;
#pragma unroll
        for (int ww = 0; ww < 8; ++ww) { const float tv = ((LAS float*)(L + O_TOT))[ww * 64 + lane]; if (ww < w) base += tv; if (ww < 4) bm += tv; bl += tv; }
        const float ebm = ex(bm), eblm = ex(bl - bm);
        if (w == 0) ((LAS float*)(L + O_EBL))[lane] = ex(bl);
        unsigned short ku[8];
#pragma unroll
        for (int i = 0; i < 8; ++i) { const float x = bc[i] + base - bm; const float e1 = ex(fminf(x, 80.f)), e2 = ex(fminf(-x, 80.f));
            const float qs = qf[i] * e1, ks = kf[i] * e2; const int r = 8 * w + i;
            *(LAS unsigned short*)(L + O_QS + r * PB + 2 * lane) = bf1(qs); *(LAS unsigned short*)(L + O_QI + r * PB + 2 * lane) = bf1(qs * ebm);
            *(LAS unsigned short*)(L + O_KS + r * PB + 2 * lane) = bf1(ks); ku[i] = bf1(ks * eblm); }
        { u32x4 pk; pk.x = (unsigned)ku[0] | ((unsigned)ku[1] << 16); pk.y = (unsigned)ku[2] | ((unsigned)ku[3] << 16); pk.z = (unsigned)ku[4] | ((unsigned)ku[5] << 16); pk.w = (unsigned)ku[6] | ((unsigned)ku[7] << 16);
          *(LAS u32x4*)(L + O_KUT + lane * PB + 16 * w) = pk; }
        if (c0 + 64 < SEQ) {
#pragma unroll
            for (int i = 0; i < 8; ++i) { const size_t row = rowbase + c0 + 64 + 8 * w + i; g[i] = LOGF[row * 512 + h * 64 + lane]; qv[i] = HB[row * 1024 + h * 64 + lane]; vv[i] = HB[row * 1024 + 512 + h * 64 + lane]; }
        }
        __syncthreads();
#pragma unroll
        for (int k2 = 0; k2 < 2; ++k2) { const int idx = 2 * w + k2, ti = idx >> 2, sj = idx & 3;
            f32x4 sc = {0.f, 0.f, 0.f, 0.f};
            if (sj <= ti) {
#pragma unroll
                for (int kk = 0; kk < 2; ++kk) { const bf16x8 af = *(const LAS bf16x8*)(L + O_QS + (16 * ti + fr) * PB + (32 * kk + 8 * fq) * 2), bfr = *(const LAS bf16x8*)(L + O_KS + (16 * sj + fr) * PB + (32 * kk + 8 * fq) * 2);
                    sc = __builtin_amdgcn_mfma_f32_16x16x32_bf16(af, bfr, sc, 0, 0, 0); }
            }
#pragma unroll
            for (int j = 0; j < 4; ++j) { const int t = 16 * ti + 4 * fq + j, s = 16 * sj + fr; *(LAS unsigned short*)(L + O_P + t * PB + 2 * s) = bf1(s <= t ? sc[j] : 0.f); }
        }
        __syncthreads();
        f32x4 o0 = {0.f, 0.f, 0.f, 0.f}, o1 = {0.f, 0.f, 0.f, 0.f}, u0 = {0.f, 0.f, 0.f, 0.f}, u1 = {0.f, 0.f, 0.f, 0.f};
#pragma unroll
        for (int kk = 0; kk < 2; ++kk) { const int ko = (32 * kk + 8 * fq) * 2;
            const bf16x8 pa = *(const LAS bf16x8*)(L + O_P + (16 * tr + fr) * PB + ko), qa = *(const LAS bf16x8*)(L + O_QI + (16 * tr + fr) * PB + ko), ka = *(const LAS bf16x8*)(L + O_KUT + (16 * tr + fr) * PB + ko);
            const bf16x8 v0 = *(const LAS bf16x8*)(L + O_VT + (16 * tc0 + fr) * PB + ko), v1 = *(const LAS bf16x8*)(L + O_VT + (16 * (tc0 + 1) + fr) * PB + ko);
            const bf16x8 s0 = *(const LAS bf16x8*)(L + O_ST + (16 * tc0 + fr) * PB + ko), s1 = *(const LAS bf16x8*)(L + O_ST + (16 * (tc0 + 1) + fr) * PB + ko);
            o0 = __builtin_amdgcn_mfma_f32_16x16x32_bf16(pa, v0, o0, 0, 0, 0); o1 = __builtin_amdgcn_mfma_f32_16x16x32_bf16(pa, v1, o1, 0, 0, 0);
            o0 = __builtin_amdgcn_mfma_f32_16x16x32_bf16(qa, s0, o0, 0, 0, 0); o1 = __builtin_amdgcn_mfma_f32_16x16x32_bf16(qa, s1, o1, 0, 0, 0);
            u0 = __builtin_amdgcn_mfma_f32_16x16x32_bf16(ka, v0, u0, 0, 0, 0); u1 = __builtin_amdgcn_mfma_f32_16x16x32_bf16(ka, v1, u1, 0, 0, 0); }
        { const f32x4 dec = *(const LAS f32x4*)(L + O_EBL + (16 * tr + 4 * fq) * 4); S0 = S0 * dec + u0; S1 = S1 * dec + u1; }
        { f32x4 q2 = o0 * o0 + o1 * o1;
#pragma unroll
          for (int m = 1; m < 16; m <<= 1) { q2[0] += __shfl_xor(q2[0], m); q2[1] += __shfl_xor(q2[1], m); q2[2] += __shfl_xor(q2[2], m); q2[3] += __shfl_xor(q2[3], m); }
          if (fr == 0) {
#pragma unroll
              for (int j = 0; j < 4; ++j) ((LAS float*)(L + O_RED))[(16 * tr + 4 * fq + j) * 2 + (w & 1)] = q2[j]; } }
        __syncthreads();
        { u32x2 p0, p1; p0.x = pk2(S0[0], S0[1]); p0.y = pk2(S0[2], S0[3]); p1.x = pk2(S1[0], S1[1]); p1.y = pk2(S1[2], S1[3]);
          *(LAS u32x2*)(L + O_ST + (16 * tc0 + fr) * PB + (16 * tr + 4 * fq) * 2) = p0; *(LAS u32x2*)(L + O_ST + (16 * (tc0 + 1) + fr) * PB + (16 * tr + 4 * fq) * 2) = p1; }
#pragma unroll
        for (int j = 0; j < 4; ++j) { const int t = 16 * tr + 4 * fq + j; const f32x2 rr = *(const LAS f32x2*)(L + O_RED + t * 8); const float rs = rsqrtf((rr[0] + rr[1]) * (1.f / 64.f) + RMS_EPS);
            *(LAS unsigned short*)(L + O_P + t * PB + 2 * (16 * tc0 + fr)) = bf1(o0[j] * rs * ng0); *(LAS unsigned short*)(L + O_P + t * PB + 2 * (16 * (tc0 + 1) + fr)) = bf1(o1[j] * rs * ng1); }
        __syncthreads();
        { const int t = tid >> 3, e8 = (tid & 7) * 8; const size_t row = rowbase + c0 + t;
          const u32x4 ov = *(const LAS u32x4*)(L + O_P + t * PB + e8 * 2), gv = *(const u32x4*)(HG + row * 512 + h * 64 + e8);
          u32x4 r; r.x = pk2(bflo(ov.x) * bflo(gv.x), bfhi(ov.x) * bfhi(gv.x)); r.y = pk2(bflo(ov.y) * bflo(gv.y), bfhi(ov.y) * bfhi(gv.y));
          r.z = pk2(bflo(ov.z) * bflo(gv.z), bfhi(ov.z) * bfhi(gv.z)); r.w = pk2(bflo(ov.w) * bflo(gv.w), bfhi(ov.w) * bfhi(gv.w));
          *(u32x4*)(O + row * 1024 + 512 + h * 64 + e8) = r; }
        __syncthreads();
    }
}


constexpr int PH_PER_LAYER = 10, N_PHASES = 1 + DEPTH * PH_PER_LAYER;
#ifndef MK_ONE_LAUNCH
#define MK_ONE_LAUNCH 1
#endif
#ifndef MK_FAST_ATTN
#define MK_FAST_ATTN 0
#endif
#ifndef MK_FAST_HGRN
#define MK_FAST_HGRN 0
#endif


#ifdef DBG_DUMP
#ifndef DBG_WHAT
#define DBG_WHAT 0
#endif
__device__ __forceinline__ void dbg_dump(const Args& a, const Frame& F) {
    unsigned char* ws = a.ws;
    const bf16_t *QO = (bf16_t*)(ws + WS_QO), *KV = (bf16_t*)(ws + WS_KV), *HB = (bf16_t*)(ws + WS_HB), *HG = (bf16_t*)(ws + WS_HG), *G = (bf16_t*)(ws + WS_G);
    const bf16_t *U1 = (bf16_t*)(ws + WS_U1), *U = (bf16_t*)(ws + WS_U), *MIXED = (bf16_t*)(ws + WS_MIXED), *XN = (bf16_t*)(ws + WS_XN);
    const float *LOGF = (float*)(ws + WS_LOGF), *FL = (float*)(ws + WS_FL), *XRES = (float*)(ws + WS_XRES);
    for (size_t i = (size_t)F.bid * 512 + F.tid; i < (size_t)T * D; i += (size_t)gridDim.x * 512) {
        const size_t row = i >> 10; const int c = (int)(i & 1023);
        float v = 0.f;
        if (DBG_WHAT == 9) { v = bf2f(G[row * 2048 + c]) + bf2f(G[row * 2048 + 1024 + c]); }
        else if (DBG_DUMP == 1) { v = bf2f(KV[i]) + bf2f(HB[i]) + bf2f(G[row * 2048 + c]) + bf2f(G[row * 2048 + 1024 + c]);
            if (c < 512) v += LOGF[row * 512 + c] + bf2f(HG[row * 512 + c]) + bf2f(QO[i]); if (c < 8) v += FL[row * 8 + c]; }
        else if (DBG_DUMP == 2) { v = (c >= 512) ? bf2f(QO[i]) : 0.f; }
        else if (DBG_DUMP == 3) { v = bf2f(QO[i]); }
        else if (DBG_DUMP == 4) { v = bf2f(U1[i]); }
        else if (DBG_DUMP == 5) { v = bf2f(U[i]); }
        else if (DBG_DUMP == 6) { v = bf2f(MIXED[i]); }
        else if (DBG_DUMP == 7) { v = XRES[i] + bf2f(XN[i]); }
        a.out[i] = v;
    }
}
#endif
#define PH_BEGIN const Args a = LOAD_ARGS(); Frame F; F.lds = lds0; F.tid = threadIdx.x; asm volatile("" : "+v"(F.tid)); F.lane = F.tid & 63; F.wave = __builtin_amdgcn_readfirstlane(F.tid >> 6); \
    F.G = gridDim.x; F.bid = blockIdx.x; asm volatile("" : "+s"(F.bid)); F.gw = F.bid * NWAVES + F.wave; F.ngw = F.G * NWAVES; unsigned char* const ws = a.ws; const LAS int* tab = (const LAS int*)(F.lds + TAB_OFF); (void)tab; (void)ws;
#ifdef DBG_DUMP
#define IN(k) (lo <= (k) && (k) < hi && (k) <= DBG_DUMP)
#else
#define IN(k) (lo <= (k) && (k) < hi)
#endif
#ifdef DBG_REPEAT
#define REP(k) for (int rep_ = 0; rep_ < ((DBG_REPEAT == (k)) ? 2 : 1); ++rep_)
#else
#define REP(k)
#endif
#define SEAM(k) do { if (IN(k) && IN((k) + 1)) { XcdBarrier b2_ = bar; { size_t z_ = 0; asm volatile("" : "+s"(z_), "+s"(b2_.x)); b2_.bar = bar.bar + z_; } xcd_barrier(b2_); } } while (0)
template <int l>
__device__ __forceinline__ void layer_body(const Args& args, const int lo, const int hi, const XcdBarrier& bar, LAS unsigned char* const lds0, unsigned char* lds_raw) {
        const int pb = 1 + l * PH_PER_LAYER;

#ifdef DBG_DUMP
        if (l == 0 && lo <= DBG_DUMP + 1 && DBG_DUMP + 1 < hi) { PH_BEGIN dbg_dump(a, F); }
#endif
        if (IN(pb + 0)) REP(0) { PH_BEGIN
            pg8::Gemm g{(bf16_t*)(ws + WS_XN), (bf16_t*)(ws + WS_WIN), D, D, D}; pg8::StaticOrder S; S.init(T, NINP, F.G, F.bid);
            pg8::EpiInproj E{ws, l};
            pg8::gemm_phase<pg8::EpiInproj, pg8::StaticOrder, true>(F.lds + RING_OFF, g, S, E, F.tid);
        }
        SEAM(pb + 0);
        if (IN(pb + 1)) REP(1) { PH_BEGIN
#if !MK_FAST_ATTN
            phase_fscan(a, F);
#endif
#if MK_FAST_HGRN
            phase_hgrn(a, F, l);
#else
            phase_hgrn_naive(a, F, l);
#endif
        }
        SEAM(pb + 1);
        if (IN(pb + 2)) REP(2) { PH_BEGIN
#if MK_FAST_ATTN
            phase_attn(a, F, (char*)lds_raw);
#else
            phase_attn_naive(a, F);
#endif
        }
        SEAM(pb + 2);
        if (IN(pb + 3)) REP(3) { PH_BEGIN
            pg8::Gemm g{(bf16_t*)(ws + WS_QO), (bf16_t*)(ws + WS_WBR), D, D, 512}; pg8::StaticOrder S; S.init(T, D, F.G, F.bid);
            pg8::EpiGate<1> E{(bf16_t*)(ws + WS_U1), nullptr, (bf16_t*)(ws + WS_G), 2048, nullptr};
            pg8::gemm_phase<pg8::EpiGate<1>, pg8::StaticOrder, true>(F.lds + RING_OFF, g, S, E, F.tid);
        }
        SEAM(pb + 3);
        if (IN(pb + 4)) REP(4) { PH_BEGIN
            pg8::Gemm g{(bf16_t*)(ws + WS_QO) + 512, (bf16_t*)(ws + WS_WBR) + 512, D, D, 512}; pg8::StaticOrder S; S.init(T, D, F.G, F.bid);
            pg8::EpiGate<2> E{(bf16_t*)(ws + WS_U), nullptr, (bf16_t*)(ws + WS_G) + 1024, 2048, (bf16_t*)(ws + WS_U1)};
            pg8::gemm_phase<pg8::EpiGate<2>, pg8::StaticOrder, true>(F.lds + RING_OFF, g, S, E, F.tid);
        }
        SEAM(pb + 4);
        if (IN(pb + 5)) REP(5) { PH_BEGIN
            pg8::Gemm g{(bf16_t*)(ws + WS_U), (bf16_t*)(ws + WS_WMIX), D, D, D}; pg8::StaticOrder S; S.init(T, D, F.G, F.bid);
            pg8::EpiGate<0> E{(bf16_t*)(ws + WS_MIXED), a.b_mix + l * D, nullptr, 0, nullptr};
            pg8::gemm_phase<pg8::EpiGate<0>, pg8::StaticOrder, true>(F.lds + RING_OFF, g, S, E, F.tid);
        }
        SEAM(pb + 5);
        if (IN(pb + 6)) REP(6) { PH_BEGIN phase_ln1_router(a, F, l); }
        SEAM(pb + 6);
        if (IN(pb + 7)) REP(7) { PH_BEGIN
            moe_table(a, F, l);
            pg8::Gemm g{(bf16_t*)(ws + WS_XN), (bf16_t*)(ws + WS_W13), D, D, D}; pg8::MoeOrder S{F.G, F.bid, 8, tab, (const int*)(ws + WS_LIST), true, (size_t)2048 * D};
            pg8::EpiUp E{(bf16_t*)(ws + WS_H)};
            pg8::gemm_phase<pg8::EpiUp, pg8::MoeOrder, true>(F.lds + RING_OFF, g, S, E, F.tid);
        }
        SEAM(pb + 7);
        if (IN(pb + 8)) REP(8) { PH_BEGIN
            moe_table(a, F, l);
            pg8::Gemm g{(bf16_t*)(ws + WS_H), (bf16_t*)(ws + WS_W2), D, D, D}; pg8::MoeOrder S{F.G, F.bid, 4, tab, nullptr, false, (size_t)D * D};
            pg8::EpiGate<0> E{(bf16_t*)(ws + WS_Y), nullptr, nullptr, 0, nullptr};
            pg8::gemm_phase<pg8::EpiGate<0>, pg8::MoeOrder, true>(F.lds + RING_OFF, g, S, E, F.tid);
        }
        SEAM(pb + 8);
        if (IN(pb + 9)) REP(9) { PH_BEGIN
            moe_table(a, F, l);
            phase_combine_ln2(a, F, l);
            if (l + 1 < DEPTH) { __syncthreads(); convert_layer(a, F, l + 1); }
        }
        SEAM(pb + 9);
    }

__global__ void __launch_bounds__(NWAVES * 64, 2) mk_fwd(Args args) {
    extern __shared__ __attribute__((aligned(16))) unsigned char lds_raw[];
    LAS unsigned char* const lds0 = (LAS unsigned char*)lds_raw;
    volatile LAS unsigned* MISC = (volatile LAS unsigned*)(lds0 + MISC_OFF);
    for (int u = threadIdx.x; u < (LDS_BYTES - LDSCTL_OFF) / 4; u += NWAVES * 64) ((LAS unsigned*)(lds0 + LDSCTL_OFF))[u] = 0u;
    __syncthreads();
    unsigned* ctl = (unsigned*)(args.ws + WS_CTL);
    XcdBarrier bar; bar.bar = ctl + CW_BAR; bar.x = 0; bar.st = nullptr;
    if (args.use_bar) bar = xcd_barrier_post(ctl + CW_BAR, MISC + 8);
    const int lo = args.ph_lo, hi = args.ph_hi;


    if (IN(0)) { PH_BEGIN phase_prep(a, F); }
    SEAM(0);
    layer_body<0>(args, lo, hi, bar, lds0, lds_raw); layer_body<1>(args, lo, hi, bar, lds0, lds_raw); layer_body<2>(args, lo, hi, bar, lds0, lds_raw); layer_body<3>(args, lo, hi, bar, lds0, lds_raw);
#undef IN
#undef SEAM
}

extern "C" void kernel_launch(void* const* d_in, const int* in_sizes, int n_in, void* d_out, int out_size, void* d_ws, size_t ws_size, hipStream_t stream) {
    static int grid = 0;
    if (grid == 0) {
        if (n_in != 20 || in_sizes[0] != T * D || out_size != T * D || ws_size < WS_END) { fprintf(stderr, "kernel_launch: unexpected shapes (n_in %d, ws %zu)\n", n_in, ws_size); grid = -1; return; }
        int dev = 0, cus = 0, per_cu = 0;
        if (hipGetDevice(&dev) != hipSuccess || hipDeviceGetAttribute(&cus, hipDeviceAttributeMultiprocessorCount, dev) != hipSuccess) { grid = -1; return; }
        if (hipFuncSetAttribute((const void*)mk_fwd, hipFuncAttributeMaxDynamicSharedMemorySize, LDS_BYTES) != hipSuccess) { fprintf(stderr, "kernel_launch: hipFuncSetAttribute failed\n"); grid = -1; return; }
        if (hipOccupancyMaxActiveBlocksPerMultiprocessor(&per_cu, (const void*)mk_fwd, NWAVES * 64, LDS_BYTES) != hipSuccess || per_cu < 1)
            fprintf(stderr, "kernel_launch: note: occupancy query reports %d workgroups per CU\n", per_cu);
        (void)hipGetLastError();
        grid = cus;
    }
    if (grid < 0) return;
    if (hipMemsetAsync((char*)d_ws + WS_CTL, 0, CTL_BYTES, stream) != hipSuccess) return;
    Args a{};
    a.x = (const float*)d_in[0]; a.ln_in_g = (const float*)d_in[1]; a.ln_in_b = (const float*)d_in[2]; a.w_in = (const float*)d_in[3]; a.b_in = (const float*)d_in[4];
    a.w_fox = (const float*)d_in[5]; a.lbl = (const float*)d_in[6]; a.norm_g = (const float*)d_in[7]; a.w_hgrn = (const float*)d_in[8]; a.w_mix = (const float*)d_in[9];
    a.b_mix = (const float*)d_in[10]; a.ln1_g = (const float*)d_in[11]; a.ln1_b = (const float*)d_in[12]; a.router_w = (const float*)d_in[13]; a.router_b = (const float*)d_in[14];
    a.w1 = (const float*)d_in[15]; a.w3 = (const float*)d_in[16]; a.w2 = (const float*)d_in[17]; a.ln2_g = (const float*)d_in[18]; a.ln2_b = (const float*)d_in[19];
    a.out = (float*)d_out; a.ws = (unsigned char*)d_ws; a.pad = 0;
#if MK_ONE_LAUNCH
    a.ph_lo = 0; a.ph_hi = N_PHASES; a.use_bar = 1;
    hipLaunchKernelGGL(mk_fwd, dim3(grid), dim3(NWAVES * 64), LDS_BYTES, stream, a);
#else
#ifdef DBG_DUMP
    const int np_ = DBG_DUMP + 2;
#else
    const int np_ = N_PHASES;
#endif
    for (int p = 0; p < np_; ++p) { a.ph_lo = p; a.ph_hi = p + 1; a.use_bar = 0;
        hipLaunchKernelGGL(mk_fwd, dim3(grid), dim3(NWAVES * 64), LDS_BYTES, stream, a); }
#endif
    const hipError_t le = hipPeekAtLastError();
    if (le != hipSuccess) fprintf(stderr, "kernel_launch: launch failed: %s\n", hipGetErrorName(le));
}
```

```cpp
#define MK_ONE_LAUNCH 1
#define MK_FAST_ATTN 1
#define MK_FAST_HGRN 1
#include <hip/hip_runtime.h>
#include <cstdio>
#include <cstdint>

typedef unsigned short bf16_t;
typedef short bf16x8 __attribute__((ext_vector_type(8)));
typedef float f32x4 __attribute__((ext_vector_type(4)));
typedef float f32x2 __attribute__((ext_vector_type(2)));
typedef unsigned u32x4 __attribute__((ext_vector_type(4)));
typedef unsigned u32x2 __attribute__((ext_vector_type(2)));
#define LAS __attribute__((address_space(3)))
#define GAS __attribute__((address_space(1)))

constexpr int BATCH = 16, SEQ = 2048, T = BATCH * SEQ, D = 1024, DEPTH = 4, NH = 8, HD = 64, NIN = 5640, NINP = 5888, NE = 16;
constexpr float LN_EPS = 1e-5f, RMS_EPS = 1e-6f;
constexpr float ALPHA = 1.681792830507429f;
constexpr float LOG2E = 1.4426950408889634f;
constexpr float C2 = 0.125f * LOG2E;
constexpr float SC_W = 64.f, SC_FOX = 16.f, SC_HGRN = 4.f, SC_U = 64.f, SC_H = 8.f;
constexpr int E8_1 = 0x7f7f7f7f, E8_W = 0x79797979, E8_FOX = 0x7b7b7b7b, E8_HGRN = 0x7d7d7d7d, E8_U = 0x79797979, E8_H = 0x7c7c7c7c;
constexpr int TM = 256;

constexpr size_t MiB = 1u << 20;
constexpr size_t WS_CTL = 0, CTL_BYTES = 1 * MiB;
constexpr size_t WS_MISC = 1 * MiB;
constexpr size_t WS_WIN = 2 * MiB, WS_WBR = 14 * MiB, WS_WMIX = 16 * MiB, WS_W13 = 18 * MiB, WS_W2 = 82 * MiB;
constexpr size_t WS_XRES = 114 * MiB, WS_XN = 242 * MiB, WS_QO = 306 * MiB, WS_KV = 370 * MiB, WS_HB = 434 * MiB, WS_LOGF = 498 * MiB;
constexpr size_t WS_HG = 562 * MiB, WS_G = 594 * MiB, WS_FL = 722 * MiB, WS_F2 = 723 * MiB, WS_U1 = 724 * MiB, WS_U = 788 * MiB, WS_MIXED = 852 * MiB;
constexpr size_t WS_LIST = 916 * MiB, WS_TOK = 918 * MiB, WS_END = 919 * MiB;
constexpr size_t WS_OX8 = 274 * MiB;
constexpr size_t WS_H = WS_QO, WS_Y = 442 * MiB;
constexpr int CW_CNT = 1024;
constexpr int CW_BAR = 4096;

__device__ __forceinline__ unsigned f2bf(float f) { unsigned u = __builtin_bit_cast(unsigned, f); return (u + 0x7fffu + ((u >> 16) & 1u)) >> 16; }
__device__ __forceinline__ float bf2f(unsigned h) { return __builtin_bit_cast(float, h << 16); }
__device__ __forceinline__ float bflo(unsigned w) { return __builtin_bit_cast(float, w << 16); }
__device__ __forceinline__ float bfhi(unsigned w) { return __builtin_bit_cast(float, w & 0xffff0000u); }
__device__ __forceinline__ unsigned pk2(float lo, float hi) { return f2bf(lo) | (f2bf(hi) << 16); }
__device__ __forceinline__ float wave_sum(float v) {
#pragma unroll
    for (int o = 1; o < 64; o <<= 1) v += __shfl_xor(v, o);
    return v;
}
__device__ __forceinline__ float wave_max(float v) {
#pragma unroll
    for (int o = 1; o < 64; o <<= 1) v = fmaxf(v, __shfl_xor(v, o));
    return v;
}
__device__ __forceinline__ float fast_exp(float v) { return __builtin_amdgcn_exp2f(v * LOG2E); }
__device__ __forceinline__ float sigmoidf_(float v) { return __builtin_amdgcn_rcpf(1.0f + fast_exp(-v)); }
__device__ __forceinline__ float siluf_(float v) { return v * sigmoidf_(v); }
__device__ __forceinline__ float logsigmoidf_(float v) { return fminf(v, 0.f) - __logf(1.0f + fast_exp(-fabsf(v))); }

namespace pg8 {
constexpr int BM = 256, BK = 64, HALF = 128, HTB = HALF * BK * 2  , STAGE_BYTES = 8 * HTB, NXCD = 8, WGM = 8;
__host__ __device__ __forceinline__ int lds_byte(int r, int c) { const int st = (r >> 4) * 2 + (c >> 5), rr = r & 15, cc = c & 31, ob = rr * 64 + cc * 2; return st * 1024 + (ob ^ (((ob >> 9) & 1) << 5)); }
__host__ __device__ __forceinline__ void stage_rc(int b, int& R, int& C) { const int st = b / 1024, sb = b % 1024, swz = sb ^ (((sb >> 9) & 1) << 5); R = (st >> 1) * 16 + swz / 64; C = (st & 1) * 32 + (swz % 64) / 2; }
__host__ __device__ __forceinline__ int perm32(int rho) { const int n = rho >> 4, i = rho & 15; return 8 * (i >> 2) + 4 * n + (i & 3); }

struct Unit { int pm, pn, e; };
struct Gemm { const bf16_t* A; const bf16_t* Bt; int lda, ldb, K; int sa, sb; };

struct StaticOrder {
    static constexpr bool GATHER = false;
    int nM, nN, nwg, G, c;
    __device__ void init(int M, int N, int G_, int c_) { nM = M / BM; nN = N / BM; nwg = nM * nN; G = G_; c = c_; }
    __device__ bool next(int i, Unit& u) const {
        const int L = i * G + c; if (L >= nwg) return false;
        int wgid = L; { const int q = nwg / NXCD, r = nwg % NXCD, xcd = wgid % NXCD, off = wgid / NXCD; wgid = (xcd < r ? xcd * (q + 1) : r * (q + 1) + (xcd - r) * q) + off; }
        const int nig = WGM * nN, gid = wgid / nig, fm = gid * WGM, gsz = (nM - fm) < WGM ? (nM - fm) : WGM;
        u.pm = fm + ((wgid % nig) % gsz); u.pn = (wgid % nig) / gsz; u.e = 0; return true;
    }
    __device__ __forceinline__ const char* a_tile(const Gemm& g, const Unit& u) const { return (const char*)g.A + (size_t)u.pm * BM * g.lda * 2; }
    __device__ __forceinline__ const char* b_tile(const Gemm& g, const Unit& u) const { return (const char*)g.Bt + (size_t)u.pn * BM * g.ldb * 2; }
    __device__ __forceinline__ void a_voff(const Gemm& g, const Unit&, const int (&R)[2], const int (&C)[2], unsigned (&v)[2][2]) const {
#pragma unroll
        for (int h = 0; h < 2; ++h)
#pragma unroll
            for (int i = 0; i < 2; ++i) v[h][i] = (unsigned)((h * HALF + R[i]) * g.lda + C[i]) * 2u;
    }
};
template <bool GATHER_> struct MoeOrder {
    static constexpr bool GATHER = GATHER_; static constexpr bool gather = GATHER_;
    int G, c, nN; const LAS int* tab; const int* list; size_t bstride;
    __device__ bool next(int i, Unit& u) const {
        const int L = i * G + c; const int rt = L / nN; const int NT = tab[NE]; if (rt >= NT) return false;
        int e = 0;
#pragma unroll
        for (int k = 1; k < NE; ++k) e += (rt >= tab[k]) ? 1 : 0;
        u.pm = __builtin_amdgcn_readfirstlane(rt); u.pn = __builtin_amdgcn_readfirstlane(L % nN); u.e = __builtin_amdgcn_readfirstlane(e); return true;
    }
    __device__ __forceinline__ const char* a_tile(const Gemm& g, const Unit& u) const { return gather ? (const char*)g.A : (const char*)g.A + (size_t)u.pm * BM * g.lda * 2; }
    __device__ __forceinline__ const char* b_tile(const Gemm& g, const Unit& u) const { return (const char*)g.Bt + ((size_t)u.e * bstride + (size_t)u.pn * BM * g.ldb) * 2; }
    __device__ __forceinline__ void a_voff(const Gemm& g, const Unit& u, const int (&R)[2], const int (&C)[2], unsigned (&v)[2][2]) const {
        const int ts = tab[u.e], cn = tab[NE + 1 + u.e];
#pragma unroll
        for (int h = 0; h < 2; ++h)
#pragma unroll
            for (int i = 0; i < 2; ++i) {
                if (gather) { const int pos = (u.pm - ts) * BM + h * HALF + R[i]; const int tok = (pos < cn) ? list[u.e * T + pos] : 0; v[h][i] = (unsigned)(tok * g.lda + C[i]) * 2u; }
                else v[h][i] = (unsigned)((h * HALF + R[i]) * g.lda + C[i]) * 2u;
            }
    }
};

typedef __bf16 bf16x2_t __attribute__((ext_vector_type(2)));
__device__ __forceinline__ unsigned cvt_pk_bf16(float lo, float hi) { f32x2 v = {lo, hi}; bf16x2_t b = __builtin_convertvector(v, bf16x2_t); return __builtin_bit_cast(unsigned, b); }
__device__ __forceinline__ u32x4 pack8(const f32x4& v0, const f32x4& v1) { u32x4 w; w.x = cvt_pk_bf16(v0[0], v0[1]); w.y = cvt_pk_bf16(v0[2], v0[3]); w.z = cvt_pk_bf16(v1[0], v1[1]); w.w = cvt_pk_bf16(v1[2], v1[3]); return w; }
__device__ __forceinline__ void unpack8(const u32x4& w, f32x4& v0, f32x4& v1) { v0[0] = bflo(w.x); v0[1] = bfhi(w.x); v0[2] = bflo(w.y); v0[3] = bfhi(w.y); v1[0] = bflo(w.z); v1[1] = bfhi(w.z); v1[2] = bflo(w.w); v1[3] = bfhi(w.w); }
typedef int v8i __attribute__((ext_vector_type(8)));
typedef int v4i __attribute__((ext_vector_type(4)));
__device__ __forceinline__ u32x2 pack8_fp8(const f32x4& v0, const f32x4& v1) {
    u32x2 w; int t = 0; t = __builtin_amdgcn_cvt_pk_fp8_f32(v0[0], v0[1], t, false); t = __builtin_amdgcn_cvt_pk_fp8_f32(v0[2], v0[3], t, true); w.x = (unsigned)t;
    int t2 = 0; t2 = __builtin_amdgcn_cvt_pk_fp8_f32(v1[0], v1[1], t2, false); t2 = __builtin_amdgcn_cvt_pk_fp8_f32(v1[2], v1[3], t2, true); w.y = (unsigned)t2; return w; }
__device__ __forceinline__ unsigned pack4_fp8(float a, float b, float c, float d) { int t = 0; t = __builtin_amdgcn_cvt_pk_fp8_f32(a, b, t, false); t = __builtin_amdgcn_cvt_pk_fp8_f32(c, d, t, true); return (unsigned)t; }
__device__ __forceinline__ f32x4 sig4(const f32x4& v) { f32x4 o; o[0] = sigmoidf_(v[0]); o[1] = sigmoidf_(v[1]); o[2] = sigmoidf_(v[2]); o[3] = sigmoidf_(v[3]); return o; }

struct EpiInproj {
    static constexpr bool PERM = true;
    unsigned char* ws; int layer;
    template <int KIND> __device__ __forceinline__ void tile(const f32x4 (&acc)[2][2][4][2], const Unit& u, int wr, int wc, int fr, int fq, unsigned char* w) const {
        const float* biasp = (const float*)(w + WS_MISC + 16384);
        const int row0 = u.pm * BM + wr * 64 + fr, bcol0 = u.pn * BM + wc * 32 + 8 * fq;
        f32x4 bv[2][2];
#pragma unroll
        for (int bj = 0; bj < 2; ++bj)
#pragma unroll
            for (int n = 0; n < 2; ++n) bv[bj][n] = *(const f32x4*)(biasp + bcol0 + bj * HALF + 4 * n);
#pragma unroll
        for (int ai = 0; ai < 2; ++ai)
#pragma unroll
            for (int m = 0; m < 4; ++m) { const size_t row = (size_t)(row0 + ai * HALF + m * 16);
#pragma unroll
                for (int bj = 0; bj < 2; ++bj) { f32x4 v0 = acc[ai][bj][m][0] + bv[bj][0], v1 = acc[ai][bj][m][1] + bv[bj][1]; const int col = bcol0 + bj * HALF;
                    if (KIND == 0) { *(u32x4*)((bf16_t*)(w + WS_QO) + row * 1024 + col) = pack8(v0 * C2, v1 * C2); }
                    else if (KIND == 1) { *(u32x4*)((bf16_t*)(w + WS_KV) + row * 1024 + (col - 512)) = pack8(v0, v1); }
                    else if (KIND == 2) { *(u32x4*)((bf16_t*)(w + WS_KV) + row * 1024 + 512 + (col - 1024)) = pack8(v0, v1); }
                    else if (KIND == 3) { *(u32x4*)((bf16_t*)(w + WS_HB) + row * 1024 + (col - 1536)) = pack8(v0 * sig4(v0), v1 * sig4(v1)); }
                    else if (KIND == 4) { const int c = col - 2048; const float* lb = (const float*)(w + WS_MISC) + layer * 512; const f32x4 l0 = *(const f32x4*)(lb + c), l1 = *(const f32x4*)(lb + c + 4);
                        f32x4 f0 = l0 + (1.f - l0) * sig4(v0), f1 = l1 + (1.f - l1) * sig4(v1);
#pragma unroll
                        for (int q = 0; q < 4; ++q) { f0[q] = __logf(f0[q]); f1[q] = __logf(f1[q]); }
                        float* LOGF = (float*)(w + WS_LOGF); *(f32x4*)(LOGF + row * 512 + c) = f0; *(f32x4*)(LOGF + row * 512 + c + 4) = f1; }
                    else if (KIND == 5) { *(u32x4*)((bf16_t*)(w + WS_HB) + row * 1024 + 512 + (col - 2560)) = pack8(v0, v1); }
                    else if (KIND == 6) { *(u32x4*)((bf16_t*)(w + WS_HG) + row * 512 + (col - 3072)) = pack8(v0 * sig4(v0), v1 * sig4(v1)); }
                    else if (KIND == 7) { *(u32x4*)((bf16_t*)(w + WS_G) + row * 2048 + (col - 3584)) = pack8(sig4(v0), sig4(v1)); }
                    else { if (col == 5632) { f32x4 f0, f1;
#pragma unroll
                            for (int q = 0; q < 4; ++q) { f0[q] = logsigmoidf_(v0[q]); f1[q] = logsigmoidf_(v1[q]); }
                            float* FL = (float*)(w + WS_FL); *(f32x4*)(FL + row * 8) = f0; *(f32x4*)(FL + row * 8 + 4) = f1; } }
                } }
    }
    __device__ __forceinline__ void operator()(const f32x4 (&acc)[2][2][4][2], const Unit& u, int wr, int wc, int fr, int fq) const {
        size_t z_ = 0; asm volatile("" : "+s"(z_)); unsigned char* w = ws + z_;
        const int ct = u.pn;
        if (ct < 2) tile<0>(acc, u, wr, wc, fr, fq, w); else if (ct < 4) tile<1>(acc, u, wr, wc, fr, fq, w); else if (ct < 6) tile<2>(acc, u, wr, wc, fr, fq, w);
        else if (ct < 8) tile<3>(acc, u, wr, wc, fr, fq, w); else if (ct < 10) tile<4>(acc, u, wr, wc, fr, fq, w); else if (ct < 12) tile<5>(acc, u, wr, wc, fr, fq, w);
        else if (ct < 14) tile<6>(acc, u, wr, wc, fr, fq, w); else if (ct < 22) tile<7>(acc, u, wr, wc, fr, fq, w); else tile<8>(acc, u, wr, wc, fr, fq, w);
    }
};
template <int MODE> struct EpiGate {
    static constexpr bool PERM = true;
    bf16_t* O; const float* bias; const bf16_t* Gt; int ldg; const bf16_t* P;
    __device__ __forceinline__ void operator()(const f32x4 (&acc)[2][2][4][2], const Unit& u, int wr, int wc, int fr, int fq) const {
        const int row0 = u.pm * BM + wr * 64 + fr, col0 = u.pn * BM + wc * 32 + 8 * fq;
        f32x4 bv[2][2];
        if (MODE == 0) {
#pragma unroll
            for (int bj = 0; bj < 2; ++bj)
#pragma unroll
                for (int n = 0; n < 2; ++n) bv[bj][n] = bias ? *(const f32x4*)(bias + col0 + bj * HALF + 4 * n) : (f32x4){0.f, 0.f, 0.f, 0.f};
        }
#pragma unroll
        for (int ai = 0; ai < 2; ++ai)
#pragma unroll
            for (int mh = 0; mh < 2; ++mh) {
                u32x4 gq[2][2], pq[2][2];
                if (MODE != 0) {
#pragma unroll
                    for (int mm = 0; mm < 2; ++mm)
#pragma unroll
                        for (int bj = 0; bj < 2; ++bj) { const size_t row = (size_t)(row0 + ai * HALF + (mh * 2 + mm) * 16); const int col = col0 + bj * HALF;
                            gq[mm][bj] = *(const u32x4*)(Gt + row * ldg + col);
                            if (MODE == 2) pq[mm][bj] = *(const u32x4*)(P + row * 1024 + col); }
                    asm volatile("s_waitcnt vmcnt(0)" ::: "memory");
                }
#pragma unroll
                for (int mm = 0; mm < 2; ++mm)
#pragma unroll
                    for (int bj = 0; bj < 2; ++bj) { const int m = mh * 2 + mm; const size_t row = (size_t)(row0 + ai * HALF + m * 16); const int col = col0 + bj * HALF;
                        f32x4 v0 = acc[ai][bj][m][0], v1 = acc[ai][bj][m][1];
                        if (MODE == 0) { v0 += bv[bj][0]; v1 += bv[bj][1]; }
                        else { f32x4 g0, g1; unpack8(gq[mm][bj], g0, g1); v0 *= g0; v1 *= g1;
                            if (MODE == 2) { f32x4 p0, p1; unpack8(pq[mm][bj], p0, p1); v0 += p0; v1 += p1; } }
                        if (MODE == 2) *(u32x2*)((unsigned char*)O + row * 1024 + col) = pack8_fp8(v0 * SC_U, v1 * SC_U); else *(u32x4*)(O + row * 1024 + col) = pack8(v0, v1); }
                if (MODE != 0) asm volatile("" ::: "memory");
            }
    }
};
struct EpiUp {
    static constexpr bool PERM = true;
    bf16_t* H;
    __device__ __forceinline__ void operator()(const f32x4 (&acc)[2][2][4][2], const Unit& u, int wr, int wc, int fr, int fq) const {
        const int row0 = u.pm * BM + wr * 64 + fr, col = u.pn * HALF + wc * 32 + 8 * fq;
#pragma unroll
        for (int ai = 0; ai < 2; ++ai)
#pragma unroll
            for (int m = 0; m < 4; ++m) { const size_t row = (size_t)(row0 + ai * HALF + m * 16);
                const f32x4 a0 = acc[ai][0][m][0], a1 = acc[ai][0][m][1], b0 = acc[ai][1][m][0], b1 = acc[ai][1][m][1];
                *(u32x2*)((unsigned char*)H + row * 1024 + col) = pack8_fp8(a0 * sig4(a0) * b0 * SC_H, a1 * sig4(a1) * b1 * SC_H); }
    }
};

__device__ __forceinline__ void glds16s(const char* sbase, unsigned voff, unsigned lds_dst) {
    unsigned keep;
    asm volatile("s_mov_b32 %0, m0\n\ts_mov_b32 m0, %3\n\ts_nop 0\n\tglobal_load_lds_dwordx4 %1, %2\n\ts_mov_b32 m0, %0" : "=&s"(keep) : "v"(voff), "s"(sbase), "s"(lds_dst) : "memory");
}
template <class Epi, class Sched, bool ALIGN_EPI>
__device__ __forceinline__ void gemm_phase(LAS unsigned char* lds, const Gemm g, const Sched& S, const Epi& E, const int tid) {
    const int wid = __builtin_amdgcn_readfirstlane(tid >> 6), lane = tid & 63, wr = wid >> 2, wc = wid & 3, fr = lane & 15, fq = lane >> 4;
    int K = g.K; asm volatile("" : "+s"(K));
    const int nt = K / BK;
    int RA[2], CA[2]; unsigned voffB[2];
#pragma unroll
    for (int i = 0; i < 2; ++i) { int R, C; stage_rc(tid * 16 + i * 8192, R, C); const int Rb = Epi::PERM ? ((R & ~31) + perm32(R & 31)) : R;
        RA[i] = R; CA[i] = C; voffB[i] = (unsigned)(Rb * g.ldb + C) * 2u; }
    const size_t kstep = (size_t)(BK * 2);
    const size_t hstepB = (size_t)HALF * g.ldb * 2;
    const unsigned ldsw = (unsigned)wid * 1024u;
    const unsigned ldsb = (unsigned)__builtin_amdgcn_readfirstlane((int)((unsigned)(uintptr_t)lds + ldsw));
    const int aoff = lds_byte(wr * 64 + fr, fq * 8), boff = lds_byte(wc * 32 + fr, fq * 8);
#define PG8_SA(b, h) (((b) * 2 + (h)) * HTB)
#define PG8_SB(b, h) ((4 + (b) * 2 + (h)) * HTB)
#define PG8_STAGE(bufoff, gbase, voff) do { _Pragma("unroll") for (int _i = 0; _i < 2; ++_i) glds16s((const char*)(gbase), (voff)[_i], ldsb + (unsigned)((bufoff) + _i * 8192)); } while (0)
#define PG8_LD8(p) __builtin_shufflevector(*(const LAS v4i*)(p), *(const LAS v4i*)((p) + 1024), 0, 1, 2, 3, 4, 5, 6, 7)
#define PG8_LDA(dst, b, h) do { _Pragma("unroll") for (int m = 0; m < 4; ++m) dst[m] = PG8_LD8(lds + PG8_SA(b, h) + aoff + m * 2048); } while (0)
#define PG8_LDB(dst, b, h) do { _Pragma("unroll") for (int n = 0; n < 2; ++n) dst[n] = PG8_LD8(lds + PG8_SB(b, h) + boff + n * 2048); } while (0)
#define PG8_MMA(ai, bj, At, Bt) do { __builtin_amdgcn_s_setprio(1); _Pragma("unroll") for (int m = 0; m < 4; ++m) _Pragma("unroll") for (int n = 0; n < 2; ++n) \
        asm volatile("v_mfma_scale_f32_16x16x128_f8f6f4 %0, %1, %2, %0, %3, %4 op_sel_hi:[0,0,0]" : "+v"(acc[ai][bj][m][n]) : "v"(Bt[n]), "v"(At[m]), "v"(sbv), "v"(sav)); \
        __builtin_amdgcn_s_setprio(0); } while (0)
#define PG8_WAIT_V(n) asm volatile("s_waitcnt vmcnt(" #n ")" ::: "memory")
#define PG8_WAIT_L(n) asm volatile("s_waitcnt lgkmcnt(" #n ")" ::: "memory")
#define PG8_BAR __builtin_amdgcn_s_barrier()
#define PG8_SCHED __builtin_amdgcn_sched_barrier(0)
    Unit cur, nxt; int ui = 0;
    if (!S.next(0, cur)) return;
    f32x4 acc[2][2][4][2];
#pragma unroll
    for (int a = 0; a < 2; ++a)
#pragma unroll
        for (int b = 0; b < 2; ++b)
#pragma unroll
            for (int m = 0; m < 4; ++m)
#pragma unroll
                for (int n = 0; n < 2; ++n) acc[a][b][m][n] = (f32x4){0.f, 0.f, 0.f, 0.f};
    int sav = g.sa, sbv = g.sb;
    v8i At[4], B0[2], B1[2];
    unsigned vA[2][2], nvA[2][2];
    S.a_voff(g, cur, RA, CA, vA);
    const char* cA = S.a_tile(g, cur); const char* cB = S.b_tile(g, cur);
    PG8_STAGE(PG8_SB(0, 0), cB, voffB); PG8_STAGE(PG8_SB(0, 1), cB + hstepB, voffB); PG8_STAGE(PG8_SA(0, 0), cA, vA[0]); PG8_STAGE(PG8_SA(0, 1), cA, vA[1]);
    if (wr == 1) PG8_BAR;
    PG8_WAIT_V(2); PG8_BAR;
    PG8_STAGE(PG8_SB(1, 0), cB + kstep, voffB); PG8_STAGE(PG8_SA(1, 0), cA + kstep, vA[0]); PG8_STAGE(PG8_SB(1, 1), cB + hstepB + kstep, voffB);
    PG8_WAIT_V(6); PG8_BAR;
    for (;;) {
        const bool has_next = S.next(ui + 1, nxt);
        const char* nA = has_next ? S.a_tile(g, nxt) : cA; const char* nB = has_next ? S.b_tile(g, nxt) : cB;
        if constexpr (Sched::GATHER) {
            if (has_next) { int RA2[2], CA2[2];
#pragma unroll
                for (int i = 0; i < 2; ++i) { int tq = tid; asm volatile("" : "+v"(tq)); stage_rc(tq * 16 + i * 8192, RA2[i], CA2[i]); }
                S.a_voff(g, nxt, RA2, CA2, nvA); }
            else {
#pragma unroll
                for (int h = 0; h < 2; ++h)
#pragma unroll
                    for (int i = 0; i < 2; ++i) nvA[h][i] = vA[h][i]; }
        }
        for (int t = 0; t < nt; t += 2) {
            const bool last = (t == nt - 2);
            const char* a1 = cA + (size_t)(t + 1) * kstep;
            const char* a2 = last ? nA : cA + (size_t)(t + 2) * kstep; const char* b2 = last ? nB : cB + (size_t)(t + 2) * kstep;
            const char* a3 = a2 + kstep; const char* b3 = b2 + kstep;
            unsigned wA0[2], wA1[2];
#pragma unroll
            for (int i = 0; i < 2; ++i) { if constexpr (Sched::GATHER) { wA0[i] = last ? nvA[0][i] : vA[0][i]; wA1[i] = last ? nvA[1][i] : vA[1][i]; } else { wA0[i] = vA[0][i]; wA1[i] = vA[1][i]; } }
            PG8_LDB(B0, 0, 0); PG8_LDB(B1, 0, 1); PG8_SCHED; PG8_LDA(At, 0, 0); PG8_STAGE(PG8_SA(1, 1), a1, vA[1]);
            PG8_WAIT_V(8); PG8_WAIT_L(0); PG8_BAR; PG8_MMA(0, 0, At, B0); PG8_MMA(0, 1, At, B1); PG8_BAR; PG8_SCHED;
            PG8_LDA(At, 0, 1); PG8_STAGE(PG8_SB(0, 0), b2, voffB); PG8_STAGE(PG8_SB(0, 1), b2 + hstepB, voffB); PG8_STAGE(PG8_SA(0, 0), a2, wA0);
            PG8_WAIT_V(8); PG8_WAIT_L(0); PG8_BAR; PG8_MMA(1, 0, At, B0); PG8_MMA(1, 1, At, B1); PG8_BAR; PG8_SCHED;
            PG8_LDB(B0, 1, 0); PG8_LDB(B1, 1, 1); PG8_SCHED; PG8_LDA(At, 1, 0); PG8_STAGE(PG8_SA(0, 1), a2, wA1);
            PG8_WAIT_V(8); PG8_WAIT_L(0); PG8_BAR; PG8_MMA(0, 0, At, B0); PG8_MMA(0, 1, At, B1); PG8_BAR; PG8_SCHED;
            PG8_LDA(At, 1, 1); PG8_STAGE(PG8_SB(1, 0), b3, voffB); PG8_STAGE(PG8_SB(1, 1), b3 + hstepB, voffB); PG8_STAGE(PG8_SA(1, 0), a3, wA0);
            PG8_WAIT_V(8); PG8_WAIT_L(0); PG8_BAR; PG8_MMA(1, 0, At, B0); PG8_MMA(1, 1, At, B1); PG8_BAR; PG8_SCHED;
        }
        if constexpr (ALIGN_EPI) { if (wr == 0) PG8_BAR; }
        asm volatile("s_nop 15\n\ts_nop 15" ::: "memory");
        E(acc, cur, wr, wc, fr, fq);
        if (!has_next) break;
#pragma unroll
        for (int a = 0; a < 2; ++a)
#pragma unroll
            for (int b = 0; b < 2; ++b)
#pragma unroll
                for (int m = 0; m < 4; ++m)
#pragma unroll
                    for (int n = 0; n < 2; ++n) acc[a][b][m][n] = (f32x4){0.f, 0.f, 0.f, 0.f};
        cur = nxt; cA = nA; cB = nB; ++ui;
        if constexpr (Sched::GATHER) {
#pragma unroll
            for (int h = 0; h < 2; ++h)
#pragma unroll
                for (int i = 0; i < 2; ++i) vA[h][i] = nvA[h][i]; }
        if constexpr (ALIGN_EPI) { if (wr == 1) PG8_BAR; }
    }
    PG8_WAIT_V(0);
    if constexpr (!ALIGN_EPI) { if (wr == 0) PG8_BAR; }
    PG8_BAR;
#undef PG8_SA
#undef PG8_SB
#undef PG8_STAGE
#undef PG8_LDA
#undef PG8_LDB
#undef PG8_MMA
#undef PG8_LD8
#undef PG8_WAIT_V
#undef PG8_WAIT_L
#undef PG8_BAR
#undef PG8_SCHED
}
}


#include <hip/hip_bf16.h>
#include <cmath>
namespace attn_body {
using bf16=__hip_bfloat16;
using bf16x8=__attribute__((ext_vector_type(8)))short;
using s16x4=__attribute__((ext_vector_type(4)))short;
using f32x16=__attribute__((ext_vector_type(16)))float;
using u32x4=__attribute__((ext_vector_type(4)))unsigned;
constexpr int BATCH=16,NHEAD=8,SEQ=2048,D=64,DM=1024;
constexpr int NW=8,QBLK=32,QB=QBLK*NW,KVBLK=64,NQB=SEQ/QB;
constexpr int ATTN_PITCH=DM, ATTN_UNIT_ROWS=QB;
__device__ __forceinline__ int crow(int r,int hi){return (r&3)+8*(r>>2)+4*hi;}
#define SBAR() __builtin_amdgcn_sched_barrier(0)
__device__ __forceinline__ void cmask(f32x16&p0,f32x16&p1,int jb,int qrel,int hi){
  const float NEG=-INFINITY; int kb=64*jb+4*hi;
  #pragma unroll
  for(int r=0;r<16;++r){int kv=kb+(r&3)+8*(r>>2); if(kv>qrel)p0[r]=NEG; if(kv+32>qrel)p1[r]=NEG;}
}

constexpr int NSLOT=3, SLOTB=8192;
constexpr int LDS_K=0, LDS_V=NSLOT*SLOTB, LDS_WS=2*NSLOT*SLOTB, LDS_OST=LDS_WS+NW*64*4, LDS_BYTES=LDS_OST+NW*4096;
constexpr float C2=0.125f*1.4426950408889634f;
__device__ __forceinline__ void glds16(const void*gsrc,unsigned lds_dst){unsigned keep;
  asm volatile("s_mov_b32 %0, m0\n\ts_mov_b32 m0, %2\n\ts_nop 0\n\tglobal_load_lds_dwordx4 %1, off\n\ts_mov_b32 m0, %0":"=&s"(keep):"v"(gsrc),"s"(lds_dst):"memory");}
__device__ __forceinline__ float max3f(float a,float b,float c){float r;asm("v_max3_f32 %0, %1, %2, %3":"=v"(r):"v"(a),"v"(b),"v"(c));return r;}
__device__ __forceinline__ float max2f(float a,float b){float r;asm("v_max_f32_e32 %0, %1, %2":"=v"(r):"v"(a),"v"(b));return r;}
__device__ __forceinline__ float fadd_s(float a,float b){float r;asm("v_add_f32_e32 %0, %1, %2":"=v"(r):"v"(a),"v"(b));return r;}
__device__ __forceinline__ float fsub_s(float a,float b){float r;asm("v_sub_f32_e32 %0, %1, %2":"=v"(r):"v"(a),"v"(b));return r;}
typedef float f32x2_t __attribute__((ext_vector_type(2))); typedef __bf16 bf16x2_t __attribute__((ext_vector_type(2)));
__device__ __forceinline__ unsigned cvtpk_s(float lo,float hi){f32x2_t v={lo,hi};bf16x2_t b=__builtin_convertvector(v,bf16x2_t);return __builtin_bit_cast(unsigned,b);}
#define WAIT_BAR(N) asm volatile("s_waitcnt vmcnt(" #N ") lgkmcnt(0)\n\ts_barrier":::"memory")

__device__ __forceinline__ void qkt(f32x16&p0,f32x16&p1,const char*Kslot,const bf16x8*qr,const f32x16&negm,int r32,int hi){
  const char*kb=Kslot+hi*1024+r32*16;
  #pragma unroll
  for(int d0=0;d0<4;++d0){
    const bf16x8 b0=*reinterpret_cast<const bf16x8*>(kb+d0*2048);
    const bf16x8 b1=*reinterpret_cast<const bf16x8*>(kb+d0*2048+512);
    if(d0==0){p0=__builtin_amdgcn_mfma_f32_32x32x16_bf16(b0,qr[0],negm,0,0,0);p1=__builtin_amdgcn_mfma_f32_32x32x16_bf16(b1,qr[0],negm,0,0,0);}
    else{p0=__builtin_amdgcn_mfma_f32_32x32x16_bf16(b0,qr[d0],p0,0,0,0);p1=__builtin_amdgcn_mfma_f32_32x32x16_bf16(b1,qr[d0],p1,0,0,0);}}
}
typedef __attribute__((address_space(3))) const char* lds_cptr;
typedef short v4i16_t __attribute__((ext_vector_type(4)));
__device__ __forceinline__ void kload8(bf16x8*kf,lds_cptr kp){
  kf[0]=*(const __attribute__((address_space(3))) bf16x8*)(kp);      kf[1]=*(const __attribute__((address_space(3))) bf16x8*)(kp+512);
  kf[2]=*(const __attribute__((address_space(3))) bf16x8*)(kp+2048); kf[3]=*(const __attribute__((address_space(3))) bf16x8*)(kp+2560);
  kf[4]=*(const __attribute__((address_space(3))) bf16x8*)(kp+4096); kf[5]=*(const __attribute__((address_space(3))) bf16x8*)(kp+4608);
  kf[6]=*(const __attribute__((address_space(3))) bf16x8*)(kp+6144); kf[7]=*(const __attribute__((address_space(3))) bf16x8*)(kp+6656);
}
__device__ __forceinline__ void kload2(bf16x8*kf,lds_cptr kp,int j){ kf[2*j]=*(const __attribute__((address_space(3))) bf16x8*)(kp+j*2048); kf[2*j+1]=*(const __attribute__((address_space(3))) bf16x8*)(kp+j*2048+512); }
__device__ __forceinline__ s16x4 vtr(lds_cptr p){ return __builtin_bit_cast(s16x4,__builtin_amdgcn_ds_read_tr16_b64_v4i16((__attribute__((address_space(3))) v4i16_t*)p)); }
__device__ __forceinline__ float rowmax(const f32x16&p0,const f32x16&p1){
  float a=max3f(p0[0],p0[1],p1[0]),b=max3f(p0[2],p0[3],p1[1]);a=max3f(a,p1[2],p1[3]);
  #pragma unroll
  for(int r=4;r<16;r+=4){a=max3f(a,p0[r],p0[r+1]);b=max3f(b,p0[r+2],p0[r+3]);a=max3f(a,p1[r],p1[r+1]);b=max3f(b,p1[r+2],p1[r+3]);}
  const float m=max2f(a,b);
  auto rr=__builtin_amdgcn_permlane32_swap(__float_as_uint(m),__float_as_uint(m),false,false);
  return max2f(__uint_as_float(rr[0]),__uint_as_float(rr[1]));
}
__device__ __forceinline__ void pv(f32x16*o,int vb,bf16x8 pa0,bf16x8 pa1,bf16x8 pa2,bf16x8 pa3){
  #pragma unroll
  for(int d0=0;d0<2;++d0){s16x4 lo[4],hi[4];
    #pragma unroll
    for(int ks=0;ks<4;++ks){
      asm volatile("ds_read_b64_tr_b16 %0,%1 offset:%c2":"=&v"(lo[ks]):"v"(vb),"i"(d0*4096+ks*1024):"memory");
      asm volatile("ds_read_b64_tr_b16 %0,%1 offset:%c2":"=&v"(hi[ks]):"v"(vb),"i"(d0*4096+ks*1024+512):"memory");}
    asm volatile("s_waitcnt lgkmcnt(0)":::"memory");SBAR();
    #define PK(k) (bf16x8){lo[k][0],lo[k][1],lo[k][2],lo[k][3],hi[k][0],hi[k][1],hi[k][2],hi[k][3]}
    o[d0]=__builtin_amdgcn_mfma_f32_32x32x16_bf16(pa0,PK(0),o[d0],0,0,0);
    o[d0]=__builtin_amdgcn_mfma_f32_32x32x16_bf16(pa1,PK(1),o[d0],0,0,0);
    o[d0]=__builtin_amdgcn_mfma_f32_32x32x16_bf16(pa2,PK(2),o[d0],0,0,0);
    o[d0]=__builtin_amdgcn_mfma_f32_32x32x16_bf16(pa3,PK(3),o[d0],0,0,0);
    #undef PK
  }
}

#ifndef ATTN_STORE16
#define ATTN_STORE16(p,v) (*(u32x4*)(p)=(v))
#endif
template<int THRL> __device__ __forceinline__ void attn_unit(int b,int h,int qb,const bf16*Q,const bf16*__restrict__ K,const bf16*__restrict__ V,bf16*O,char*shm,const __attribute__((address_space(3))) float*f2,const int tid){
  #define BIAS_H(P,off,g0) { f32x4 x_[2]; _Pragma("unroll") for(int g_=0;g_<2;++g_) x_[g_]=*(const __attribute__((address_space(3))) f32x4*)(fb_+(off)+8*((g0)+g_)); \
      _Pragma("unroll") for(int g_=0;g_<2;++g_) _Pragma("unroll") for(int i_=0;i_<4;++i_) P[4*((g0)+g_)+i_]-=x_[g_][i_]; asm volatile("":::"memory"); }
  #define BIAS(P0,P1,t) do{ const __attribute__((address_space(3))) float* fb_=f2+64*(t)+4*hi; \
    BIAS_H(P0,0,0) BIAS_H(P0,0,2) BIAS_H(P1,32,0) BIAS_H(P1,32,2) }while(0)
  const int lane=tid&63,r32=lane&31,hi=lane>>5; const int wid=__builtin_amdgcn_readfirstlane(tid>>6);
  const long rowbase=(long)b*SEQ; const int q0=qb*QB;
  const bf16*Qw=Q+(rowbase+q0+wid*QBLK)*DM+h*D;
  const bf16*Kh=K+rowbase*DM+h*D,*Vh=V+rowbase*DM+h*D;
  const unsigned lds0=(unsigned)(uintptr_t)shm;
  float*wsf=(float*)(shm+LDS_WS)+wid*64;
  const bf16*ksrc=Kh+(long)lane*DM+wid*8;
  const bf16*vsrc=Vh+(long)(16*(wid&3)+(lane>>2))*DM+(wid>>2)*32+(lane&3)*8;
  const unsigned kdst=lds0+LDS_K+wid*1024, vdst=lds0+LDS_V+wid*1024;
  #define DMA_K(t,slot) glds16(ksrc+(long)(t)*KVBLK*DM,(unsigned)__builtin_amdgcn_readfirstlane(kdst+(slot)))
  #define DMA_V(t,slot) glds16(vsrc+(long)(t)*KVBLK*DM,(unsigned)__builtin_amdgcn_readfirstlane(vdst+(slot)))
  const int vb0=(int)(lds0+LDS_V)+((lane>>4)&1)*32+(lane&3)*8+(4*hi+((lane&15)>>2))*64;
  const char*Kbase=shm+LDS_K; bf16x8 kf[8];
  const lds_cptr shm3=(lds_cptr)shm; const lds_cptr kp0=shm3+LDS_K+hi*1024+r32*16; const lds_cptr vp0=shm3+LDS_V+((lane>>4)&1)*32+(lane&3)*8+(4*hi+((lane&15)>>2))*64;
  const int NT=(q0+QB)/KVBLK;
  DMA_K(0,0);DMA_V(0,0);DMA_K(1,SLOTB);
  bf16x8 qr[4];
  #pragma unroll
  for(int d0=0;d0<4;++d0)qr[d0]=*reinterpret_cast<const bf16x8*>(&Qw[(long)r32*DM+d0*16+hi*8]);
  float mhat=0.f,l_reg=0.f;f32x16 o[2];f32x16 negm; { float z_=0.f; asm volatile("":"+v"(z_)); _Pragma("unroll") for(int r=0;r<16;++r){o[0][r]=z_;o[1][r]=z_;negm[r]=z_;} } asm volatile("":"+v"(negm));
  const int qrel=wid*QBLK+r32;
  #define CMASK(P0,P1,t) do{int jb_=(t)-(NT-4); if(jb_>=0)cmask(P0,P1,jb_,qrel,hi);}while(0)
  bool resc=false;
  #define START(P0,P1) do{ const float rm=rowmax(P0,P1); resc=false; \
    { const float dl=rm; mhat=fadd_s(mhat,dl); \
      _Pragma("unroll") for(int r=0;r<16;++r){P0[r]=fsub_s(P0[r],dl);P1[r]=fsub_s(P1[r],dl);} \
      _Pragma("unroll") for(int r=0;r<16;++r)negm[r]=-mhat; asm volatile("":"+v"(negm)); } \
    _Pragma("unroll") for(int r=0;r<16;++r)P0[r]=__builtin_amdgcn_exp2f(P0[r]); }while(0)
  #define RESC() do{ if(resc){ asm volatile("s_waitcnt lgkmcnt(0)":::"memory"); \
      _Pragma("unroll") for(int d_=0;d_<2;++d_) _Pragma("unroll") for(int r=0;r<16;++r)o[d_][r]*=wsf[crow(r,hi)]; } }while(0)
  f32x16 pA0,pA1,pB0,pB1;
  int sl_prev=0,sl_cur=0,sl_next=SLOTB;
  #define ROT() do{sl_prev=sl_cur;sl_cur=sl_next;sl_next=(sl_next==(NSLOT-1)*SLOTB)?0:sl_next+SLOTB;}while(0)
  DMA_K(2,2*SLOTB);
  WAIT_BAR(3);
  qkt(pA0,pA1,Kbase,qr,negm,r32,hi);asm volatile("s_nop 15\n\ts_nop 7":"+v"(pA0),"+v"(pA1));CMASK(pA0,pA1,0);BIAS(pA0,pA1,0);
  START(pA0,pA1);
  _Pragma("unroll") for(int r=0;r<16;++r)pA1[r]=__builtin_amdgcn_exp2f(pA1[r]);
  WAIT_BAR(0);
  DMA_K(3,0);DMA_V(1,SLOTB);
  ROT();
  kload8(kf,kp0+sl_cur);
  WAIT_BAR(2);
  s16x4 vlo[8],vhi[8]; u32x4 pw0,pw1,pw2,pw3;
  #define PKW(P,B) cvtpk_s(P[B],P[B+1])
  #define PAF(k) __builtin_bit_cast(bf16x8,pw##k)
  #define VFR(i) (bf16x8){vlo[i][0],vlo[i][1],vlo[i][2],vlo[i][3],vhi[i][0],vhi[i][1],vhi[i][2],vhi[i][3]}
  #define PIN(x) asm volatile("":"+v"(x))
  #define MX3(a,b,c) __builtin_fmaxf(__builtin_fmaxf((a),(b)),(c))
  #define GAPA(MF,A0,A1,A2,A3,W0,W1,PW) do{ MF; sacc+=A0; sacc+=A1; sacc+=A2; sacc+=A3; PIN(sacc); W0; W1; PIN(PW); SBAR(); }while(0)
  #define EX(v) __builtin_amdgcn_exp2f(v)
  #define GAPB(MF,X,B) do{ MF; X[B]=EX(X[B]); X[B+1]=EX(X[B+1]); X[B+2]=EX(X[B+2]); X[B+3]=EX(X[B+3]); PIN(X); SBAR(); }while(0)
  #define VRD(i) do{ vlo[i]=vtr(vp_+(((i)>>2)*4096+((i)&3)*1024)); vhi[i]=vtr(vp_+(((i)>>2)*4096+((i)&3)*1024+512)); }while(0)
  #define KRD(G,j) do{ if(G){ kload2(kf,kp0+sl_next,j); SBAR(); } }while(0)
  #define STEP(C0,C1,P0,P1,t,GK,GV,GL) do{ SBAR(); \
    const lds_cptr vp_=vp0+sl_prev; \
    VRD(0); SBAR(); float sacc=(P0[0]+P0[1]); \
    GAPA(C0=__builtin_amdgcn_mfma_f32_32x32x16_bf16(kf[0],qr[0],negm,0,0,0), P0[2],P0[3],P0[4],P0[5],     pw0[0]=PKW(P0,0), pw0[1]=PKW(P0,2), pw0); \
    VRD(4); SBAR(); GAPA(C1=__builtin_amdgcn_mfma_f32_32x32x16_bf16(kf[1],qr[0],negm,0,0,0), P0[6],P0[7],P0[8],P0[9],     pw0[2]=PKW(P0,4), pw0[3]=PKW(P0,6), pw0); \
    VRD(1); SBAR(); GAPA(C0=__builtin_amdgcn_mfma_f32_32x32x16_bf16(kf[2],qr[1],C0,0,0,0),   P0[10],P0[11],P0[12],P0[13], pw1[0]=PKW(P0,8), pw1[1]=PKW(P0,10), pw1); \
    VRD(5); SBAR(); GAPA(C1=__builtin_amdgcn_mfma_f32_32x32x16_bf16(kf[3],qr[1],C1,0,0,0),   P0[14],P0[15],P1[0],P1[1],   pw1[2]=PKW(P0,12),pw1[3]=PKW(P0,14), pw1); \
    VRD(2); SBAR(); GAPA(C0=__builtin_amdgcn_mfma_f32_32x32x16_bf16(kf[4],qr[2],C0,0,0,0),   P1[2],P1[3],P1[4],P1[5],     pw2[0]=PKW(P1,0), pw2[1]=PKW(P1,2), pw2); \
    VRD(6); SBAR(); GAPA(C1=__builtin_amdgcn_mfma_f32_32x32x16_bf16(kf[5],qr[2],C1,0,0,0),   P1[6],P1[7],P1[8],P1[9],     pw2[2]=PKW(P1,4), pw2[3]=PKW(P1,6), pw2); \
    VRD(3); SBAR(); GAPA(C0=__builtin_amdgcn_mfma_f32_32x32x16_bf16(kf[6],qr[3],C0,0,0,0),   P1[10],P1[11],P1[12],P1[13], pw3[0]=PKW(P1,8), pw3[1]=PKW(P1,10), pw3); \
    VRD(7); SBAR(); GAPA(C1=__builtin_amdgcn_mfma_f32_32x32x16_bf16(kf[7],qr[3],C1,0,0,0),   P1[14],P1[15],0.f,0.f,       pw3[2]=PKW(P1,12),pw3[3]=PKW(P1,14), pw3); \
    l_reg+=sacc; \
    if(GK){DMA_K((t)+3,sl_cur);} if(GV){DMA_V((t)+1,sl_next);} \
    CMASK(C0,C1,t); BIAS(C0,C1,t); \
    { float a=MX3(C0[0],C0[1],C1[0]),b=MX3(C0[2],C0[3],C1[1]); a=MX3(a,C1[2],C1[3]); \
      _Pragma("unroll") for(int r=4;r<16;r+=4){a=MX3(a,C0[r],C0[r+1]);b=MX3(b,C0[r+2],C0[r+3]);a=MX3(a,C1[r],C1[r+1]);b=MX3(b,C1[r+2],C1[r+3]);} \
      float rm=__builtin_fmaxf(a,b); { auto rr=__builtin_amdgcn_permlane32_swap(__float_as_uint(rm),__float_as_uint(rm),false,false); rm=__builtin_fmaxf(__uint_as_float(rr[0]),__uint_as_float(rr[1])); } \
      resc=false; \
      if(__builtin_expect(__any(rm>(float)THRL),0)){ const float dl=__builtin_fmaxf(rm,0.f); mhat+=dl; \
        _Pragma("unroll") for(int r=0;r<16;++r){C0[r]-=dl;C1[r]-=dl;} \
        _Pragma("unroll") for(int r=0;r<16;++r)negm[r]=-mhat; asm volatile("":"+v"(negm)); \
        const float f=__builtin_amdgcn_exp2f(-dl); l_reg*=f; if(hi==0)wsf[r32]=f; resc=true; } } \
    SBAR(); \
    GAPB(o[0]=__builtin_amdgcn_mfma_f32_32x32x16_bf16(PAF(0),VFR(0),o[0],0,0,0), C0,0); \
    GAPB(o[1]=__builtin_amdgcn_mfma_f32_32x32x16_bf16(PAF(0),VFR(4),o[1],0,0,0), C0,4); \
    KRD(GL,0); GAPB(o[0]=__builtin_amdgcn_mfma_f32_32x32x16_bf16(PAF(1),VFR(1),o[0],0,0,0), C0,8); \
    KRD(GL,1); GAPB(o[1]=__builtin_amdgcn_mfma_f32_32x32x16_bf16(PAF(1),VFR(5),o[1],0,0,0), C0,12); \
    KRD(GL,2); GAPB(o[0]=__builtin_amdgcn_mfma_f32_32x32x16_bf16(PAF(2),VFR(2),o[0],0,0,0), C1,0); \
    KRD(GL,3); GAPB(o[1]=__builtin_amdgcn_mfma_f32_32x32x16_bf16(PAF(2),VFR(6),o[1],0,0,0), C1,4); \
    GAPB(o[0]=__builtin_amdgcn_mfma_f32_32x32x16_bf16(PAF(3),VFR(3),o[0],0,0,0), C1,8); \
    GAPB(o[1]=__builtin_amdgcn_mfma_f32_32x32x16_bf16(PAF(3),VFR(7),o[1],0,0,0), C1,12); \
    }while(0)
  int t=1;
  #undef CMASK
  #define CMASK(P0,P1,t) do{}while(0)
  for(;t+5<NT;t+=2){
    STEP(pB0,pB1,pA0,pA1,t,true,true,true);     WAIT_BAR(2); RESC(); ROT();
    STEP(pA0,pA1,pB0,pB1,t+1,true,true,true);   WAIT_BAR(2); RESC(); ROT();
  }
  #undef CMASK
  #define CMASK(P0,P1,t) do{int jb_=(t)-(NT-4); if(jb_>=0)cmask(P0,P1,jb_,qrel,hi);}while(0)
  #define ENDW(tt) do{ if((tt)+3<NT){WAIT_BAR(2);} else if((tt)+2<NT){WAIT_BAR(1);} else {WAIT_BAR(0);} }while(0)
  for(;t+1<NT;t+=2){
    STEP(pB0,pB1,pA0,pA1,t,(t+3<NT),(t+1<NT),(t+1<NT));       ENDW(t);   RESC(); ROT();
    STEP(pA0,pA1,pB0,pB1,t+1,(t+4<NT),(t+2<NT),(t+2<NT));     ENDW(t+1); RESC(); ROT();
  }
  STEP(pB0,pB1,pA0,pA1,NT-1,false,false,false); RESC();
  { float sacc=pB0[0]+pB0[1]; _Pragma("unroll") for(int r=2;r<16;++r)sacc+=pB0[r]; _Pragma("unroll") for(int r=0;r<16;++r)sacc+=pB1[r]; l_reg+=sacc;
    pw0=(u32x4){PKW(pB0,0),PKW(pB0,2),PKW(pB0,4),PKW(pB0,6)};pw1=(u32x4){PKW(pB0,8),PKW(pB0,10),PKW(pB0,12),PKW(pB0,14)};pw2=(u32x4){PKW(pB1,0),PKW(pB1,2),PKW(pB1,4),PKW(pB1,6)};pw3=(u32x4){PKW(pB1,8),PKW(pB1,10),PKW(pB1,12),PKW(pB1,14)};
    SBAR(); pv(o,vb0+sl_cur,PAF(0),PAF(1),PAF(2),PAF(3)); }
  #undef PKW
  #undef PAF
  #undef VFR
  #undef PIN
  #undef MX3
  #undef GAPA
  #undef GAPB
  #undef EX
  #undef VRD
  #undef KRD
  #undef STEP
  #undef ENDW
  {auto rr=__builtin_amdgcn_permlane32_swap(__float_as_uint(l_reg),__float_as_uint(l_reg),false,false);l_reg=__uint_as_float(rr[0])+__uint_as_float(rr[1]);}
  if(hi==0)wsf[32+r32]=l_reg;asm volatile("s_waitcnt lgkmcnt(0)":::"memory");
  float rli[16];
  #pragma unroll
  for(int r=0;r<16;++r)rli[r]=__builtin_amdgcn_rcpf(wsf[32+crow(r,hi)]);
  { bf16*stg=(bf16*)(shm+LDS_OST)+wid*2048;
    #pragma unroll
    for(int r=0;r<16;++r){const int orow=crow(r,hi);
      #pragma unroll
      for(int d0=0;d0<2;++d0)stg[orow*64+d0*32+r32]=__float2bfloat16(o[d0][r]*rli[r]);}
    asm volatile("s_waitcnt lgkmcnt(0)":::"memory");
    unsigned char*O8w=(unsigned char*)O+(rowbase+q0+wid*QBLK)*DM+h*D;
    _Pragma("unroll") for(int i=0;i<4;++i){const int row=i*8+(lane>>3),ch=lane&7; const u32x4 v=*(const u32x4*)(stg+row*64+ch*8);
      u32x2 w8; w8.x=pg8::pack4_fp8(bflo(v.x)*SC_FOX,bfhi(v.x)*SC_FOX,bflo(v.y)*SC_FOX,bfhi(v.y)*SC_FOX); w8.y=pg8::pack4_fp8(bflo(v.z)*SC_FOX,bfhi(v.z)*SC_FOX,bflo(v.w)*SC_FOX,bfhi(v.w)*SC_FOX);
      *(u32x2*)(O8w+(long)row*DM+ch*8)=w8;} }
  asm volatile("s_waitcnt lgkmcnt(0)\n\ts_barrier":::"memory");
  #undef BIAS
  #undef BIAS_H
  #undef DMA_K
  #undef DMA_V
  #undef CMASK
  #undef START
  #undef RESC
  #undef ROT
}
constexpr int ATTN_LDS_BYTES=LDS_BYTES;
#undef SBAR
#undef WAIT_BAR
}


constexpr int NWAVES = 8;
constexpr int RING_OFF = 0, RING_BYTES = 131072;
constexpr int LDSCTL_OFF = RING_BYTES, MISC_OFF = LDSCTL_OFF + 320, TAB_OFF = LDSCTL_OFF + 1024;
constexpr int WTAB_OFF = LDSCTL_OFF + 2048;
constexpr int LDS_BYTES = 147456;
typedef GAS unsigned gu32;
__device__ __forceinline__ unsigned hw_wave_key() { return (unsigned)__builtin_amdgcn_s_getreg((5 << 11) | 4) & 63u; }
#define RLX_AGENT __ATOMIC_RELAXED, __HIP_MEMORY_SCOPE_AGENT

#define XB_TMO      128
#define XB_XCNT(j)  (256  + 64 * (j))
#define XB_XSUB(j)  (1280 + 64 * (j))
#define XB_XGEN(j)  (2304 + 64 * (j))
#define XB_TOP      3328
#define XB_TOPGEN   3392
#define XCD_BAR_WORDS 3456
#define XB_SPIN_CAP (1u << 18)

__device__ __forceinline__ unsigned xb_ld(unsigned* p)              { return __hip_atomic_load(p, __ATOMIC_RELAXED, __HIP_MEMORY_SCOPE_AGENT); }
__device__ __forceinline__ unsigned xb_add(unsigned* p, unsigned v) { return __hip_atomic_fetch_add(p, v, __ATOMIC_RELAXED, __HIP_MEMORY_SCOPE_AGENT); }
__device__ __forceinline__ unsigned xb_xcc_id() { return (unsigned)__builtin_amdgcn_s_getreg((3 << 11) | 20) & 0xFu; }
#define XB_SPIN(cond, bar) do { unsigned _sp = 0; while (cond) { __builtin_amdgcn_s_sleep(1); \
    if ((++_sp & 255u) == 0u) { if (xb_ld(&(bar)[XB_TMO])) break; if (_sp > XB_SPIN_CAP) { atomicAdd(&(bar)[XB_TMO], 1u); break; } } } } while (0)

struct XcdBarrier {
    unsigned* bar; unsigned x;
    volatile LAS unsigned* st;
};

__device__ __forceinline__ XcdBarrier xcd_barrier_post(unsigned* bar, volatile LAS unsigned* st) {
    XcdBarrier b; b.bar = bar; b.x = xb_xcc_id(); b.st = st;
    if (threadIdx.x == 0) (void)xb_add(&bar[XB_XCNT(b.x)], 1u);
    return b;
}
__device__ __forceinline__ void xcd_barrier_complete(unsigned* bar, unsigned x, unsigned& nloc, unsigned& nx) {
    const unsigned G = gridDim.x * gridDim.y * gridDim.z;
    unsigned sum, cnt, mine, sp = 0u;
    for (;;) {
        sum = 0u; cnt = 0u; mine = 0u;
#pragma unroll
        for (unsigned j = 0; j < 16; ++j) { const unsigned c = xb_ld(&bar[XB_XCNT(j)]); sum += c; cnt += (c > 0u) ? 1u : 0u; mine = (j == x) ? c : mine; }
        if (sum == G) break;
        __builtin_amdgcn_s_sleep(1);
        if ((++sp & 255u) == 0u) { if (xb_ld(&bar[XB_TMO])) break; if (sp > XB_SPIN_CAP) { atomicAdd(&bar[XB_TMO], 1u); break; } }
    }
    nloc = mine > 0u ? mine : 1u; nx = cnt > 0u ? cnt : 1u;
}

__device__ __forceinline__ void xcd_barrier(const XcdBarrier& b) {
    asm volatile("s_waitcnt vmcnt(0)" ::: "memory");
    __syncthreads();
    if (threadIdx.x == 0) {
        unsigned* bar = b.bar;
        __builtin_amdgcn_s_waitcnt(0);
        unsigned nloc = b.st[0], nx = b.st[1];
        if (nloc == 0u) { xcd_barrier_complete(bar, b.x, nloc, nx); b.st[0] = nloc; b.st[1] = nx; }
        const unsigned old = xb_add(&bar[XB_XSUB(b.x)], 1u);
        const unsigned gen = old / nloc;
        if (old + 1u == (gen + 1u) * nloc) {
            __builtin_amdgcn_fence(__ATOMIC_RELEASE, "agent");
            asm volatile("s_waitcnt vmcnt(0)" ::: "memory");
            const unsigned og = xb_add(&bar[XB_TOP], 1u);
            const unsigned tg = og / nx;
            if (og + 1u == (tg + 1u) * nx) xb_add(&bar[XB_TOPGEN], 1u);
            else XB_SPIN(xb_ld(&bar[XB_TOPGEN]) == tg, bar);
            __builtin_amdgcn_fence(__ATOMIC_ACQUIRE, "agent");
            xb_add(&bar[XB_XGEN(b.x)], 1u);
            asm volatile("s_waitcnt vmcnt(0)" ::: "memory");
        } else {
            XB_SPIN(xb_ld(&bar[XB_XGEN(b.x)]) == gen, bar);
            __builtin_amdgcn_fence(__ATOMIC_ACQUIRE, "agent");
            asm volatile("s_waitcnt vmcnt(0)" ::: "memory");
        }
    }
    __syncthreads();
}


struct Args {
    const float *x, *ln_in_g, *ln_in_b, *w_in, *b_in, *w_fox, *lbl, *norm_g, *w_hgrn, *w_mix, *b_mix, *ln1_g, *ln1_b, *router_w, *router_b, *w1, *w3, *w2, *ln2_g, *ln2_b;
    float* out; unsigned char* ws; int ph_lo, ph_hi, use_bar, pad;
};
struct Frame { LAS unsigned char* lds; int tid, lane, wave, G, gw, ngw, bid; };
#define LOAD_ARGS() launder_args(args)
__device__ __forceinline__ Args launder_args(const Args& args) { Args a = args; size_t z_ = 0; asm volatile("" : "+s"(z_)); a.ws = args.ws + z_; return a; }

__device__ __forceinline__ void ln_rows16(f32x4 (&v)[4], const float* g, const float* bta, int lane) {
    float s = 0.f;
#pragma unroll
    for (int j = 0; j < 4; ++j) s += (v[j].x + v[j].y) + (v[j].z + v[j].w);
    const float mean = wave_sum(s) * (1.f / D); float s2 = 0.f;
#pragma unroll
    for (int j = 0; j < 4; ++j) { v[j] = v[j] - mean; s2 += (v[j].x * v[j].x + v[j].y * v[j].y) + (v[j].z * v[j].z + v[j].w * v[j].w); }
    const float rstd = rsqrtf(wave_sum(s2) * (1.f / D) + LN_EPS);
#pragma unroll
    for (int j = 0; j < 4; ++j) { const int c = 4 * lane + 256 * j; const f32x4 gg = *(const f32x4*)(g + c), bb = *(const f32x4*)(bta + c); v[j] = v[j] * rstd * gg + bb; }
}
__device__ __forceinline__ void store_row(const f32x4 (&v)[4], int lane, float* of32, unsigned char* obf, float* of32b) {
#pragma unroll
    for (int j = 0; j < 4; ++j) { const int c = 4 * lane + 256 * j;
        if (of32) *(f32x4*)(of32 + c) = v[j];
        if (of32b) *(f32x4*)(of32b + c) = v[j];
        if (obf) *(unsigned*)(obf + c) = pg8::pack4_fp8(v[j].x, v[j].y, v[j].z, v[j].w); }
}

__device__ __forceinline__ void cvt_item(const float* W, int ldw, int k0, int srccol, int nvalid, unsigned char* WT, int ldt, int dstrow, int dstk, LAS float* scr, int lane) {
    const int ks = lane >> 3, n4 = (lane & 7) * 4;
    f32x4 v[8];
#pragma unroll
    for (int j = 0; j < 8; ++j) v[j] = (n4 < nvalid) ? *(const f32x4*)(W + (size_t)(k0 + 8 * j + ks) * ldw + srccol + n4) : (f32x4){0.f, 0.f, 0.f, 0.f};
#pragma unroll
    for (int j = 0; j < 8; ++j) { LAS float* d = scr + (8 * j + ks) * 33 + n4; d[0] = v[j][0]; d[1] = v[j][1]; d[2] = v[j][2]; d[3] = v[j][3]; }
    asm volatile("s_waitcnt lgkmcnt(0)" ::: "memory");
    const int c = lane & 7;
#pragma unroll
    for (int j = 0; j < 4; ++j) { const int n = (lane >> 3) + 8 * j; const LAS float* s = scr + (8 * c) * 33 + n;
        u32x2 o; o.x = pg8::pack4_fp8(s[0 * 33] * SC_W, s[1 * 33] * SC_W, s[2 * 33] * SC_W, s[3 * 33] * SC_W); o.y = pg8::pack4_fp8(s[4 * 33] * SC_W, s[5 * 33] * SC_W, s[6 * 33] * SC_W, s[7 * 33] * SC_W);
        *(u32x2*)(WT + (size_t)(dstrow + n) * ldt + dstk + k0 + 8 * c) = o; }
    asm volatile("s_waitcnt lgkmcnt(0)" ::: "memory");
}
__device__ __forceinline__ void convert_layer(const Args& a, const Frame& F, int l) {
    LAS float* scr = (LAS float*)(F.lds + RING_OFF + F.wave * 16384);
    const int gw = F.gw, ngw = F.ngw, lane = F.lane;
    unsigned char* WIN = a.ws + WS_WIN; unsigned char* WBR = a.ws + WS_WBR; unsigned char* WMIX = a.ws + WS_WMIX;
    unsigned char* W13 = a.ws + WS_W13; unsigned char* W2 = a.ws + WS_W2;
    constexpr int I_IN = 16 * 184, I_BR = 8 * 32, I_MIX = 16 * 32, I_13 = 16 * 64 * NE, I_2 = 16 * 32 * NE;
    constexpr int NITEMS = I_IN + 2 * I_BR + I_MIX + I_13 + I_2;
    for (int it = gw; it < NITEMS; it += ngw) {
        int r = it;
        if (r < I_IN) { const int kb = r / 184, nb = r % 184, n0 = nb * 32;
            int src, nv = 32; if (n0 < 1536) src = n0; else if (n0 < 5632) src = n0 + 8; else if (n0 == 5632) { src = 1536; nv = 8; } else { src = 0; nv = 0; }
            cvt_item(a.w_in + (size_t)l * D * NIN, NIN, kb * 64, src, nv, WIN, D, n0, 0, scr, lane); continue; } r -= I_IN;
        if (r < I_BR) { const int kb = r / 32, nb = r % 32; cvt_item(a.w_fox + (size_t)l * 512 * D, D, kb * 64, nb * 32, 32, WBR, D, nb * 32, 0, scr, lane); continue; } r -= I_BR;
        if (r < I_BR) { const int kb = r / 32, nb = r % 32; cvt_item(a.w_hgrn + (size_t)l * 512 * D, D, kb * 64, nb * 32, 32, WBR, D, nb * 32, 512, scr, lane); continue; } r -= I_BR;
        if (r < I_MIX) { const int kb = r / 32, nb = r % 32; cvt_item(a.w_mix + (size_t)l * D * D, D, kb * 64, nb * 32, 32, WMIX, D, nb * 32, 0, scr, lane); continue; } r -= I_MIX;
        if (r < I_13) { const int e = r / 1024, q = r % 1024, kb = q / 64, nb = q % 64, n0 = nb * 32;
            const int j = n0 >> 8, rr = n0 & 255; const float* src = (rr < 128 ? a.w1 : a.w3) + ((size_t)l * NE + e) * D * D;
            cvt_item(src, D, kb * 64, 128 * j + (rr & 127), 32, W13 + (size_t)e * 2048 * D, D, n0, 0, scr, lane); continue; } r -= I_13;
        { const int e = r / 512, q = r % 512, kb = q / 32, nb = q % 32;
            cvt_item(a.w2 + ((size_t)l * NE + e) * D * D, D, kb * 64, nb * 32, 32, W2 + (size_t)e * D * D, D, nb * 32, 0, scr, lane); }
    }
    float* biasp = (float*)(a.ws + WS_MISC + 16384);
    for (int n = gw * 64 + lane; n < NINP; n += ngw * 64) {
        float v = 0.f; if (n < 1536) v = a.b_in[l * NIN + n]; else if (n < 5632) v = a.b_in[l * NIN + n + 8]; else if (n < 5640) v = a.b_in[l * NIN + 1536 + (n - 5632)];
        biasp[n] = v; }
}

__device__ __forceinline__ void phase_prep(const Args& a, const Frame& F) {
    if (F.bid == 0) {
        float* lb_all = (float*)(a.ws + WS_MISC);
        const int c = F.tid;
        float v[DEPTH], m = -1e30f;
#pragma unroll
        for (int l = 0; l < DEPTH; ++l) { v[l] = a.lbl[l * 512 + c]; m = fmaxf(m, v[l]); }
        float s = 0.f;
#pragma unroll
        for (int l = 0; l < DEPTH; ++l) { v[l] = __expf(v[l] - m); s += v[l]; }
        float cum = 0.f;
#pragma unroll
        for (int l = 0; l < DEPTH; ++l) { const float p = v[l] / s; cum += p; lb_all[l * 512 + c] = cum - v[0] / s; }
    }
    float* XRES = (float*)(a.ws + WS_XRES); unsigned char* XN = a.ws + WS_XN;
    for (int row = F.gw; row < T; row += F.ngw) {
        f32x4 v[4];
#pragma unroll
        for (int j = 0; j < 4; ++j) v[j] = *(const f32x4*)(a.x + (size_t)row * D + 4 * F.lane + 256 * j);
        ln_rows16(v, a.ln_in_g, a.ln_in_b, F.lane);
        store_row(v, F.lane, XRES + (size_t)row * D, XN + (size_t)row * D, nullptr);
    }
    convert_layer(a, F, 0);
}

__device__ __forceinline__ void phase_fscan(const Args& a, const Frame& F) {
    if (F.bid >= BATCH * NH) return;
    const float* FL = (const float*)(a.ws + WS_FL); float* F2 = (float*)(a.ws + WS_F2);
    LAS float* wsum = (LAS float*)(F.lds + RING_OFF);
    const int bh = F.bid, b = bh >> 3, h = bh & 7, tid = F.tid, lane = F.lane, w = F.wave;
    float v[4], run = 0.f;
#pragma unroll
    for (int i = 0; i < 4; ++i) { run += FL[((size_t)b * SEQ + tid * 4 + i) * 8 + h]; v[i] = run; }
    float incl = run;
#pragma unroll
    for (int o = 1; o < 64; o <<= 1) { const float u = __shfl_up(incl, o); if (lane >= o) incl += u; }
    if (lane == 63) wsum[w] = incl;
    __syncthreads();
    float base = incl - run; for (int i = 0; i < w; ++i) base += wsum[i];
#pragma unroll
    for (int i = 0; i < 4; ++i) F2[(size_t)bh * SEQ + tid * 4 + i] = (base + v[i]) * LOG2E;
    __syncthreads();
}

__device__ __forceinline__ void phase_attn_naive(const Args& a, const Frame& F) {
    const bf16_t* QO = (const bf16_t*)(a.ws + WS_QO); const bf16_t* KV = (const bf16_t*)(a.ws + WS_KV); const float* F2 = (const float*)(a.ws + WS_F2); bf16_t* O = (bf16_t*)(a.ws + WS_QO);
    LAS float* ps = (LAS float*)(F.lds + RING_OFF) + F.wave * 64;
    const int lane = F.lane;
    for (int gid = F.gw; gid < BATCH * NH * SEQ; gid += F.ngw) {
        const int bh = gid & 127, t = gid >> 7, b = bh >> 3, h = bh & 7;
        float q[64];
        { const bf16_t* qp = QO + ((size_t)b * SEQ + t) * 1024 + h * 64;
#pragma unroll
          for (int c = 0; c < 8; ++c) { const u32x4 u = *(const u32x4*)(qp + c * 8);
            q[c * 8 + 0] = bflo(u.x); q[c * 8 + 1] = bfhi(u.x); q[c * 8 + 2] = bflo(u.y); q[c * 8 + 3] = bfhi(u.y);
            q[c * 8 + 4] = bflo(u.z); q[c * 8 + 5] = bfhi(u.z); q[c * 8 + 6] = bflo(u.w); q[c * 8 + 7] = bfhi(u.w); } }
        float m = -1e30f, l = 0.f, o = 0.f;
        const float* f2 = F2 + (size_t)bh * SEQ;
        for (int s0 = 0; s0 <= t; s0 += 64) {
            const int s = s0 + lane; const bool valid = s <= t;
            float sc = -1e30f;
            if (valid) { const bf16_t* kp = KV + ((size_t)b * SEQ + s) * 1024 + h * 64; float d = 0.f;
#pragma unroll
                for (int c = 0; c < 8; ++c) { const u32x4 u = *(const u32x4*)(kp + c * 8);
                    d += q[c * 8 + 0] * bflo(u.x) + q[c * 8 + 1] * bfhi(u.x) + q[c * 8 + 2] * bflo(u.y) + q[c * 8 + 3] * bfhi(u.y)
                       + q[c * 8 + 4] * bflo(u.z) + q[c * 8 + 5] * bfhi(u.z) + q[c * 8 + 6] * bflo(u.w) + q[c * 8 + 7] * bfhi(u.w); }
                sc = d - f2[s]; }
            const float mn = fmaxf(m, wave_max(sc));
            const float p = valid ? exp2f(sc - mn) : 0.f;
            const float f = exp2f(m - mn);
            l = l * f + wave_sum(p); o *= f; m = mn;
            ps[lane] = p;
            asm volatile("s_waitcnt lgkmcnt(0)" ::: "memory");
            const int nk = min(64, t - s0 + 1);
            const bf16_t* vp = KV + ((size_t)b * SEQ + s0) * 1024 + 512 + h * 64 + lane;
            for (int j = 0; j < nk; ++j) o += ps[j] * bf2f(vp[(size_t)j * 1024]);
            asm volatile("s_waitcnt lgkmcnt(0)" ::: "memory");
        }
        O[((size_t)b * SEQ + t) * 1024 + h * 64 + lane] = (bf16_t)f2bf(o / l);
    }
}

__device__ __forceinline__ void phase_hgrn_naive(const Args& a, const Frame& F, int l) {
    if (F.bid >= BATCH * NH || F.wave != 0) return;
    const bf16_t* HB = (const bf16_t*)(a.ws + WS_HB); const float* LOGF = (const float*)(a.ws + WS_LOGF); const bf16_t* HG = (const bf16_t*)(a.ws + WS_HG); bf16_t* O = (bf16_t*)(a.ws + WS_QO);
    LAS float* Lf = (LAS float*)(F.lds + RING_OFF + 1024); LAS float* Lk = Lf + 4096; LAS float* Lq = Lk + 4096;
    const int bh = F.bid, b = bh >> 3, h = bh & 7, lane = F.lane;
    float Sx[64];
#pragma unroll
    for (int d = 0; d < 64; ++d) Sx[d] = 0.f;
    const float ng = a.norm_g[l * 512 + h * 64 + lane];
    for (int c0 = 0; c0 < SEQ; c0 += 64) {
        for (int tt = 0; tt < 64; ++tt) { const size_t row = (size_t)b * SEQ + c0 + tt;
            const float lf = LOGF[row * 512 + h * 64 + lane]; const float f = __expf(lf);
            Lf[tt * 64 + lane] = f; Lk[tt * 64 + lane] = 1.f - f; Lq[tt * 64 + lane] = bf2f(HB[row * 1024 + h * 64 + lane]); }
        asm volatile("s_waitcnt lgkmcnt(0)" ::: "memory");
        for (int tt = 0; tt < 64; ++tt) { const size_t row = (size_t)b * SEQ + c0 + tt;
            const float v = bf2f(HB[row * 1024 + 512 + h * 64 + lane]);
            float o = 0.f;
#pragma unroll
            for (int d = 0; d < 64; d += 4) { const f32x4 f4 = *(const LAS f32x4*)(Lf + tt * 64 + d), k4 = *(const LAS f32x4*)(Lk + tt * 64 + d), q4 = *(const LAS f32x4*)(Lq + tt * 64 + d);
                Sx[d] = f4.x * Sx[d] + k4.x * v; o += Sx[d] * q4.x; Sx[d + 1] = f4.y * Sx[d + 1] + k4.y * v; o += Sx[d + 1] * q4.y;
                Sx[d + 2] = f4.z * Sx[d + 2] + k4.z * v; o += Sx[d + 2] * q4.z; Sx[d + 3] = f4.w * Sx[d + 3] + k4.w * v; o += Sx[d + 3] * q4.w; }
            const float ss = wave_sum(o * o);
            const float r = o * rsqrtf(ss * (1.f / 64.f) + RMS_EPS) * ng * bf2f(HG[row * 512 + h * 64 + lane]);
            O[row * 1024 + 512 + h * 64 + lane] = (bf16_t)f2bf(r); }
        asm volatile("s_waitcnt lgkmcnt(0)" ::: "memory");
    }
}

constexpr int LN1_RW = 0, LN1_LG = 65536, LN1_ASG = LN1_LG + 8 * 16 * 16 * 4, LN1_BASE = LN1_ASG + 128 * 16;
__device__ __forceinline__ void phase_ln1_router(const Args& a, const Frame& F, int l) {
    const float* xres = (const float*)(a.ws + WS_XRES); float* x1 = a.out; const bf16_t* mixed = (const bf16_t*)(a.ws + WS_MIXED); unsigned char* xn = a.ws + WS_XN;
    unsigned* cnt = (unsigned*)(a.ws + WS_CTL) + CW_CNT + l * 64; int* list = (int*)(a.ws + WS_LIST); unsigned* tokinfo = (unsigned*)(a.ws + WS_TOK);
    const float* g = a.ln1_g + l * D; const float* bta = a.ln1_b + l * D;
    LAS float* rw = (LAS float*)(F.lds + RING_OFF + LN1_RW);
    LAS float* lgs = (LAS float*)(F.lds + RING_OFF + LN1_LG) + F.wave * 256;
    LAS u32x4* asg = (LAS u32x4*)(F.lds + RING_OFF + LN1_ASG);
    LAS unsigned* basep = (LAS unsigned*)(F.lds + RING_OFF + LN1_BASE);
    for (int i = F.tid; i < NE * D; i += NWAVES * 64) { const int c = i >> 4, e = i & 15; rw[e * D + c] = a.router_w[i]; }
    __syncthreads();
    const int lane = F.lane;
    for (int blk = F.bid; blk < T / 128; blk += F.G) {
        const int R0 = blk * 128 + F.wave * 16;
        for (int i = 0; i < 16; ++i) { const int row = R0 + i;
            f32x4 v[4];
#pragma unroll
            for (int j = 0; j < 4; ++j) { const int c = 4 * lane + 256 * j; const f32x4 xv = *(const f32x4*)(xres + (size_t)row * D + c);
                const u32x2 mm = *(const u32x2*)(mixed + (size_t)row * D + c);
                v[j].x = ALPHA * xv.x + bflo(mm.x); v[j].y = ALPHA * xv.y + bfhi(mm.x); v[j].z = ALPHA * xv.z + bflo(mm.y); v[j].w = ALPHA * xv.w + bfhi(mm.y); }
            ln_rows16(v, g, bta, lane);
            store_row(v, lane, x1 + (size_t)row * D, xn + (size_t)row * D, nullptr);
            float p[NE];
#pragma unroll
            for (int e = 0; e < NE; ++e) { float s = 0.f;
#pragma unroll
                for (int j = 0; j < 4; ++j) { const f32x4 r4 = *(const LAS f32x4*)(rw + e * D + 4 * lane + 256 * j); s += v[j].x * r4.x + v[j].y * r4.y + v[j].z * r4.z + v[j].w * r4.w; }
                p[e] = s; asm volatile("" ::: "memory"); }
            { const bool hi5 = (lane & 32) != 0;
#pragma unroll
              for (int k = 0; k < 8; ++k) { const float snd = hi5 ? p[k] : p[k + 8]; const float rcv = __shfl_xor(snd, 32); p[k] = (hi5 ? p[k + 8] : p[k]) + rcv; }
              const bool hi4 = (lane & 16) != 0;
#pragma unroll
              for (int k = 0; k < 4; ++k) { const float snd = hi4 ? p[k] : p[k + 4]; const float rcv = __shfl_xor(snd, 16); p[k] = (hi4 ? p[k + 4] : p[k]) + rcv; }
              const bool hi3 = (lane & 8) != 0;
#pragma unroll
              for (int k = 0; k < 2; ++k) { const float snd = hi3 ? p[k] : p[k + 2]; const float rcv = __shfl_xor(snd, 8); p[k] = (hi3 ? p[k + 2] : p[k]) + rcv; }
              const bool hi2 = (lane & 4) != 0;
              { const float snd = hi2 ? p[0] : p[1]; const float rcv = __shfl_xor(snd, 4); p[0] = (hi2 ? p[1] : p[0]) + rcv; }
              p[0] += __shfl_xor(p[0], 2); p[0] += __shfl_xor(p[0], 1);
              if ((lane & 3) == 0) lgs[i * 16 + (lane >> 2)] = p[0]; }
        }
        asm volatile("s_waitcnt lgkmcnt(0)" ::: "memory");
        if (lane < 16) {
            float lg[NE];
#pragma unroll
            for (int q = 0; q < 4; ++q) { const f32x4 t4 = *(const LAS f32x4*)(lgs + lane * 16 + 4 * q); lg[4 * q] = t4[0] + a.router_b[4 * q]; lg[4 * q + 1] = t4[1] + a.router_b[4 * q + 1]; lg[4 * q + 2] = t4[2] + a.router_b[4 * q + 2]; lg[4 * q + 3] = t4[3] + a.router_b[4 * q + 3]; }
            int gs = 0; float gbest = -3e38f;
#pragma unroll
            for (int gi = 0; gi < 4; ++gi) { const float mx = fmaxf(fmaxf(lg[gi * 4], lg[gi * 4 + 1]), fmaxf(lg[gi * 4 + 2], lg[gi * 4 + 3])); if (mx > gbest) { gbest = mx; gs = gi; } }
            float l4[4];
#pragma unroll
            for (int i = 0; i < 4; ++i) { float t0 = lg[i];
#pragma unroll
                for (int gi = 1; gi < 4; ++gi) t0 = (gs == gi) ? lg[gi * 4 + i] : t0; l4[i] = t0; }
            int i0 = 0; float b0 = l4[0];
#pragma unroll
            for (int i = 1; i < 4; ++i) if (l4[i] > b0) { b0 = l4[i]; i0 = i; }
            int i1 = 0; float b1 = -3e38f;
#pragma unroll
            for (int i = 0; i < 4; ++i) if (i != i0 && l4[i] > b1) { b1 = l4[i]; i1 = i; }
            const float e1 = __expf(b1 - b0); const float g0 = 1.f / (1.f + e1), g1 = e1 / (1.f + e1);
            u32x4 as; as.x = (unsigned)(gs * 4 + i0); as.y = (unsigned)(gs * 4 + i1); as.z = __float_as_uint(g0); as.w = __float_as_uint(g1);
            asg[F.wave * 16 + lane] = as;
        }
        __syncthreads();
        if (F.wave == 0) {
            const u32x4 A0 = asg[lane], A1 = asg[lane + 64];
            const unsigned ex[4] = {A0.x, A0.y, A1.x, A1.y};
            unsigned rank[4] = {0u, 0u, 0u, 0u}, mycount = 0u;
            const unsigned long long lt = (1ull << lane) - 1ull;
#pragma unroll 1
            for (unsigned e = 0; e < NE; ++e) { unsigned run = 0u;
#pragma unroll
                for (int s = 0; s < 4; ++s) { const unsigned long long m = __ballot(ex[s] == e); if (ex[s] == e) rank[s] = run + (unsigned)__popcll(m & lt); run += (unsigned)__popcll(m); }
                if ((unsigned)lane == e) mycount = run; }
            if (lane < NE) basep[lane] = atomicAdd(cnt + lane, mycount);
            asm volatile("s_waitcnt vmcnt(0) lgkmcnt(0)" ::: "memory");
            const unsigned p0 = basep[ex[0]] + rank[0], p1 = basep[ex[1]] + rank[1], p2 = basep[ex[2]] + rank[2], p3 = basep[ex[3]] + rank[3];
            const int ra = blk * 128 + lane, rb = ra + 64;
            list[ex[0] * T + p0] = ra; list[ex[1] * T + p1] = ra; list[ex[2] * T + p2] = rb; list[ex[3] * T + p3] = rb;
            u32x4 ta, tb; ta.x = (ex[0] << 24) | p0; ta.y = (ex[1] << 24) | p1; ta.z = A0.z; ta.w = A0.w; tb.x = (ex[2] << 24) | p2; tb.y = (ex[3] << 24) | p3; tb.z = A1.z; tb.w = A1.w;
            *(u32x4*)(tokinfo + (size_t)ra * 4) = ta; *(u32x4*)(tokinfo + (size_t)rb * 4) = tb;
        }
        __syncthreads();
    }
}

__device__ __forceinline__ void moe_table(const Args& a, const Frame& F, int l) {
    LAS int* tab = (LAS int*)(F.lds + TAB_OFF);
    const unsigned* cnt = (const unsigned*)(a.ws + WS_CTL) + CW_CNT + l * 64;
    if (F.tid == 0) { int ts = 0; for (int e = 0; e < NE; ++e) { const int c = (int)__hip_atomic_load(cnt + e, RLX_AGENT); tab[e] = ts; tab[NE + 1 + e] = c; ts += (c + TM - 1) / TM; } tab[NE] = ts; }
    __syncthreads();
}

__device__ __forceinline__ void phase_combine_ln2(const Args& a, const Frame& F, int l) {
    float* xres = (float*)(a.ws + WS_XRES); const float* x1 = a.out; const bf16_t* Y = (const bf16_t*)(a.ws + WS_Y); const unsigned* tokinfo = (const unsigned*)(a.ws + WS_TOK); unsigned char* xn = a.ws + WS_XN;
    const float* g = a.ln2_g + l * D; const float* bta = a.ln2_b + l * D; float* out = (l == DEPTH - 1) ? a.out : nullptr;
    const LAS int* tab = (const LAS int*)(F.lds + TAB_OFF);
    const int lane = F.lane;
    for (int row = F.gw; row < T; row += F.ngw) {
        const unsigned i0 = tokinfo[row * 4], i1 = tokinfo[row * 4 + 1]; const float g0 = __uint_as_float(tokinfo[row * 4 + 2]), g1 = __uint_as_float(tokinfo[row * 4 + 3]);
        const size_t s0 = (size_t)tab[i0 >> 24] * TM + (i0 & 0xffffff), s1 = (size_t)tab[i1 >> 24] * TM + (i1 & 0xffffff);
        f32x4 v[4];
#pragma unroll
        for (int j = 0; j < 4; ++j) { const int c = 4 * lane + 256 * j; const f32x4 xv = *(const f32x4*)(x1 + (size_t)row * D + c);
            const u32x2 ya = *(const u32x2*)(Y + s0 * D + c), yb = *(const u32x2*)(Y + s1 * D + c);
            v[j].x = ALPHA * xv.x + g0 * bflo(ya.x) + g1 * bflo(yb.x); v[j].y = ALPHA * xv.y + g0 * bfhi(ya.x) + g1 * bfhi(yb.x);
            v[j].z = ALPHA * xv.z + g0 * bflo(ya.y) + g1 * bflo(yb.y); v[j].w = ALPHA * xv.w + g0 * bfhi(ya.y) + g1 * bfhi(yb.y); }
        ln_rows16(v, g, bta, lane);
        store_row(v, lane, xres + (size_t)row * D, xn + (size_t)row * D, out ? out + (size_t)row * D : nullptr);
    }
}


constexpr int ATT_F2_OFF = 86016;
__device__ __forceinline__ void phase_attn(const Args& a, const Frame& F, char* lds_generic) {
    const int c = F.bid, vcu = (F.G % 8 == 0) ? (c % 8) * (F.G / 8) + c / 8 : c;
    const attn_body::bf16* Q = (const attn_body::bf16*)(a.ws + WS_QO); const attn_body::bf16* K = (const attn_body::bf16*)(a.ws + WS_KV); const attn_body::bf16* V = K + 512;
    attn_body::bf16* O = (attn_body::bf16*)(a.ws + WS_OX8);
    const float* FL = (const float*)(a.ws + WS_FL);
    LAS float* f2 = (LAS float*)(F.lds + ATT_F2_OFF); LAS float* wsum = f2 + 2048;
    { const int bh = vcu >> 1; if (bh >= BATCH * NH) return;
        const int b = bh >> 3, h = bh & 7, tid = F.tid, lane = F.lane, w = F.wave;
        float v[4], run = 0.f;
#pragma unroll
        for (int i = 0; i < 4; ++i) { run += FL[((size_t)b * SEQ + tid * 4 + i) * 8 + h]; v[i] = run; }
        float incl = run;
#pragma unroll
        for (int o = 1; o < 64; o <<= 1) { const float u = __shfl_up(incl, o); if (lane >= o) incl += u; }
        if (lane == 63) wsum[w] = incl;
        __syncthreads();
        float base = incl - run; for (int i = 0; i < w; ++i) base += wsum[i];
        f32x4 o4; o4[0] = (base + v[0]) * LOG2E; o4[1] = (base + v[1]) * LOG2E; o4[2] = (base + v[2]) * LOG2E; o4[3] = (base + v[3]) * LOG2E;
        *(LAS f32x4*)(f2 + tid * 4) = o4;
        __syncthreads();
        for (int i = 0; i < 4; ++i) { const int s = 2 * (vcu & 1) + (i >> 1); const int qb = (i & 1) ? 7 - s : s;
            int tid_u = F.tid; asm volatile("" : "+v"(tid_u));
            attn_body::attn_unit<8>(b, h, qb, Q, K, V, O, lds_generic + RING_OFF, f2, tid_u); }
        __syncthreads();
    }
}

namespace hg {
constexpr int PB = 144;
constexpr int O_QS = 0, O_KS = 9216, O_QI = 18432, O_KUT = 27648, O_VT = 36864, O_P = 46080, O_ST = 55296, O_TOT = 64512, O_EBL = 66560, O_RED = 66816, BYTES = 67328;
__device__ __forceinline__ float ex(float v) { return __builtin_amdgcn_exp2f(v * LOG2E); }
__device__ __forceinline__ unsigned short bf1(float v) { return (unsigned short)f2bf(v); }
}
__device__ __forceinline__ void phase_hgrn(const Args& a, const Frame& F, int l) {
    using namespace hg;
    if (F.bid >= BATCH * NH) return;
    const bf16_t* HB = (const bf16_t*)(a.ws + WS_HB); const float* LOGF = (const float*)(a.ws + WS_LOGF); const bf16_t* HG = (const bf16_t*)(a.ws + WS_HG); unsigned char* O8 = a.ws + WS_OX8;
    LAS unsigned char* L = F.lds + RING_OFF;
    const int bh = F.bid, b = bh >> 3, h = bh & 7, lane = F.lane, w = F.wave, tid = F.tid;
    const int fr = lane & 15, fq = lane >> 4;
    const int tr = w >> 1, tc0 = 2 * (w & 1);
    const float ng0 = a.norm_g[l * 512 + h * 64 + 16 * tc0 + fr], ng1 = a.norm_g[l * 512 + h * 64 + 16 * (tc0 + 1) + fr];
    f32x4 S0 = {0.f, 0.f, 0.f, 0.f}, S1 = {0.f, 0.f, 0.f, 0.f};
    for (int i = tid; i < 9216 / 4; i += NWAVES * 64) ((LAS unsigned*)(L + O_ST))[i] = 0u;
    const size_t rowbase = (size_t)b * SEQ;
    float g[8]; unsigned short qv[8], vv[8];
#pragma unroll
    for (int i = 0; i < 8; ++i) { const size_t row = rowbase + 8 * w + i; g[i] = LOGF[row * 512 + h * 64 + lane]; qv[i] = HB[row * 1024 + h * 64 + lane]; vv[i] = HB[row * 1024 + 512 + h * 64 + lane]; }
    for (int c0 = 0; c0 < SEQ; c0 += 64) {
        float bc[8]; { float run = 0.f;
#pragma unroll
            for (int i = 0; i < 8; ++i) { run += g[i]; bc[i] = run; } }
        ((LAS float*)(L + O_TOT))[w * 64 + lane] = bc[7];
        float qf[8], kf[8];
#pragma unroll
        for (int i = 0; i < 8; ++i) { qf[i] = bf2f(qv[i]); kf[i] = 1.f - ex(g[i]); }
        { u32x4 pk; pk.x = (unsigned)vv[0] | ((unsigned)vv[1] << 16); pk.y = (unsigned)vv[2] | ((unsigned)vv[3] << 16); pk.z = (unsigned)vv[4] | ((unsigned)vv[5] << 16); pk.w = (unsigned)vv[6] | ((unsigned)vv[7] << 16);
          *(LAS u32x4*)(L + O_VT + lane * PB + 16 * w) = pk; }
        __syncthreads();
        float base = 0.f, bm = 0.f, bl = 0.f;
#pragma unroll
        for (int ww = 0; ww < 8; ++ww) { const float tv = ((LAS float*)(L + O_TOT))[ww * 64 + lane]; if (ww < w) base += tv; if (ww < 4) bm += tv; bl += tv; }
        const float ebm = ex(bm), eblm = ex(bl - bm);
        if (w == 0) ((LAS float*)(L + O_EBL))[lane] = ex(bl);
        unsigned short ku[8];
#pragma unroll
        for (int i = 0; i < 8; ++i) { const float x = bc[i] + base - bm; const float e1 = ex(fminf(x, 80.f)), e2 = ex(fminf(-x, 80.f));
            const float qs = qf[i] * e1, ks = kf[i] * e2; const int r = 8 * w + i;
            *(LAS unsigned short*)(L + O_QS + r * PB + 2 * lane) = bf1(qs); *(LAS unsigned short*)(L + O_QI + r * PB + 2 * lane) = bf1(qs * ebm);
            *(LAS unsigned short*)(L + O_KS + r * PB + 2 * lane) = bf1(ks); ku[i] = bf1(ks * eblm); }
        { u32x4 pk; pk.x = (unsigned)ku[0] | ((unsigned)ku[1] << 16); pk.y = (unsigned)ku[2] | ((unsigned)ku[3] << 16); pk.z = (unsigned)ku[4] | ((unsigned)ku[5] << 16); pk.w = (unsigned)ku[6] | ((unsigned)ku[7] << 16);
          *(LAS u32x4*)(L + O_KUT + lane * PB + 16 * w) = pk; }
        if (c0 + 64 < SEQ) {
#pragma unroll
            for (int i = 0; i < 8; ++i) { const size_t row = rowbase + c0 + 64 + 8 * w + i; g[i] = LOGF[row * 512 + h * 64 + lane]; qv[i] = HB[row * 1024 + h * 64 + lane]; vv[i] = HB[row * 1024 + 512 + h * 64 + lane]; }
        }
        __syncthreads();
#pragma unroll
        for (int k2 = 0; k2 < 2; ++k2) { const int idx = 2 * w + k2, ti = idx >> 2, sj = idx & 3;
            f32x4 sc = {0.f, 0.f, 0.f, 0.f};
            if (sj <= ti) {
#pragma unroll
                for (int kk = 0; kk < 2; ++kk) { const bf16x8 af = *(const LAS bf16x8*)(L + O_QS + (16 * ti + fr) * PB + (32 * kk + 8 * fq) * 2), bfr = *(const LAS bf16x8*)(L + O_KS + (16 * sj + fr) * PB + (32 * kk + 8 * fq) * 2);
                    sc = __builtin_amdgcn_mfma_f32_16x16x32_bf16(af, bfr, sc, 0, 0, 0); }
            }
#pragma unroll
            for (int j = 0; j < 4; ++j) { const int t = 16 * ti + 4 * fq + j, s = 16 * sj + fr; *(LAS unsigned short*)(L + O_P + t * PB + 2 * s) = bf1(s <= t ? sc[j] : 0.f); }
        }
        __syncthreads();
        f32x4 o0 = {0.f, 0.f, 0.f, 0.f}, o1 = {0.f, 0.f, 0.f, 0.f}, u0 = {0.f, 0.f, 0.f, 0.f}, u1 = {0.f, 0.f, 0.f, 0.f};
#pragma unroll
        for (int kk = 0; kk < 2; ++kk) { const int ko = (32 * kk + 8 * fq) * 2;
            const bf16x8 pa = *(const LAS bf16x8*)(L + O_P + (16 * tr + fr) * PB + ko), qa = *(const LAS bf16x8*)(L + O_QI + (16 * tr + fr) * PB + ko), ka = *(const LAS bf16x8*)(L + O_KUT + (16 * tr + fr) * PB + ko);
            const bf16x8 v0 = *(const LAS bf16x8*)(L + O_VT + (16 * tc0 + fr) * PB + ko), v1 = *(const LAS bf16x8*)(L + O_VT + (16 * (tc0 + 1) + fr) * PB + ko);
            const bf16x8 s0 = *(const LAS bf16x8*)(L + O_ST + (16 * tc0 + fr) * PB + ko), s1 = *(const LAS bf16x8*)(L + O_ST + (16 * (tc0 + 1) + fr) * PB + ko);
            o0 = __builtin_amdgcn_mfma_f32_16x16x32_bf16(pa, v0, o0, 0, 0, 0); o1 = __builtin_amdgcn_mfma_f32_16x16x32_bf16(pa, v1, o1, 0, 0, 0);
            o0 = __builtin_amdgcn_mfma_f32_16x16x32_bf16(qa, s0, o0, 0, 0, 0); o1 = __builtin_amdgcn_mfma_f32_16x16x32_bf16(qa, s1, o1, 0, 0, 0);
            u0 = __builtin_amdgcn_mfma_f32_16x16x32_bf16(ka, v0, u0, 0, 0, 0); u1 = __builtin_amdgcn_mfma_f32_16x16x32_bf16(ka, v1, u1, 0, 0, 0); }
        { const f32x4 dec = *(const LAS f32x4*)(L + O_EBL + (16 * tr + 4 * fq) * 4); S0 = S0 * dec + u0; S1 = S1 * dec + u1; }
        { f32x4 q2 = o0 * o0 + o1 * o1;
#pragma unroll
          for (int m = 1; m < 16; m <<= 1) { q2[0] += __shfl_xor(q2[0], m); q2[1] += __shfl_xor(q2[1], m); q2[2] += __shfl_xor(q2[2], m); q2[3] += __shfl_xor(q2[3], m); }
          if (fr == 0) {
#pragma unroll
              for (int j = 0; j < 4; ++j) ((LAS float*)(L + O_RED))[(16 * tr + 4 * fq + j) * 2 + (w & 1)] = q2[j]; } }
        __syncthreads();
        { u32x2 p0, p1; p0.x = pk2(S0[0], S0[1]); p0.y = pk2(S0[2], S0[3]); p1.x = pk2(S1[0], S1[1]); p1.y = pk2(S1[2], S1[3]);
          *(LAS u32x2*)(L + O_ST + (16 * tc0 + fr) * PB + (16 * tr + 4 * fq) * 2) = p0; *(LAS u32x2*)(L + O_ST + (16 * (tc0 + 1) + fr) * PB + (16 * tr + 4 * fq) * 2) = p1; }
#pragma unroll
        for (int j = 0; j < 4; ++j) { const int t = 16 * tr + 4 * fq + j; const f32x2 rr = *(const LAS f32x2*)(L + O_RED + t * 8); const float rs = rsqrtf((rr[0] + rr[1]) * (1.f / 64.f) + RMS_EPS);
            *(LAS unsigned short*)(L + O_P + t * PB + 2 * (16 * tc0 + fr)) = bf1(o0[j] * rs * ng0); *(LAS unsigned short*)(L + O_P + t * PB + 2 * (16 * (tc0 + 1) + fr)) = bf1(o1[j] * rs * ng1); }
        __syncthreads();
        { const int t = tid >> 3, e8 = (tid & 7) * 8; const size_t row = rowbase + c0 + t;
          const u32x4 ov = *(const LAS u32x4*)(L + O_P + t * PB + e8 * 2), gv = *(const u32x4*)(HG + row * 512 + h * 64 + e8);
          u32x2 r; r.x = pg8::pack4_fp8(bflo(ov.x) * bflo(gv.x) * SC_HGRN, bfhi(ov.x) * bfhi(gv.x) * SC_HGRN, bflo(ov.y) * bflo(gv.y) * SC_HGRN, bfhi(ov.y) * bfhi(gv.y) * SC_HGRN);
          r.y = pg8::pack4_fp8(bflo(ov.z) * bflo(gv.z) * SC_HGRN, bfhi(ov.z) * bfhi(gv.z) * SC_HGRN, bflo(ov.w) * bflo(gv.w) * SC_HGRN, bfhi(ov.w) * bfhi(gv.w) * SC_HGRN);
          *(u32x2*)(O8 + row * 1024 + 512 + h * 64 + e8) = r; }
        __syncthreads();
    }
}


constexpr int PH_PER_LAYER = 10, N_PHASES = 1 + DEPTH * PH_PER_LAYER;
#ifndef MK_ONE_LAUNCH
#define MK_ONE_LAUNCH 1
#endif
#ifndef MK_FAST_ATTN
#define MK_FAST_ATTN 0
#endif
#ifndef MK_FAST_HGRN
#define MK_FAST_HGRN 0
#endif


#ifdef DBG_DUMP
#ifndef DBG_WHAT
#define DBG_WHAT 0
#endif
__device__ __forceinline__ void dbg_dump(const Args& a, const Frame& F) {
    unsigned char* ws = a.ws;
    const bf16_t *QO = (bf16_t*)(ws + WS_QO), *KV = (bf16_t*)(ws + WS_KV), *HB = (bf16_t*)(ws + WS_HB), *HG = (bf16_t*)(ws + WS_HG), *G = (bf16_t*)(ws + WS_G);
    const bf16_t *U1 = (bf16_t*)(ws + WS_U1), *U = (bf16_t*)(ws + WS_U), *MIXED = (bf16_t*)(ws + WS_MIXED), *XN = (bf16_t*)(ws + WS_XN);
    const float *LOGF = (float*)(ws + WS_LOGF), *FL = (float*)(ws + WS_FL), *XRES = (float*)(ws + WS_XRES);
    for (size_t i = (size_t)F.bid * 512 + F.tid; i < (size_t)T * D; i += (size_t)gridDim.x * 512) {
        const size_t row = i >> 10; const int c = (int)(i & 1023);
        float v = 0.f;
        if (DBG_WHAT == 9) { v = bf2f(G[row * 2048 + c]) + bf2f(G[row * 2048 + 1024 + c]); }
        else if (DBG_DUMP == 1) { v = bf2f(KV[i]) + bf2f(HB[i]) + bf2f(G[row * 2048 + c]) + bf2f(G[row * 2048 + 1024 + c]);
            if (c < 512) v += LOGF[row * 512 + c] + bf2f(HG[row * 512 + c]) + bf2f(QO[i]); if (c < 8) v += FL[row * 8 + c]; }
        else if (DBG_DUMP == 2) { v = (c >= 512) ? bf2f(QO[i]) : 0.f; }
        else if (DBG_DUMP == 3) { v = bf2f(QO[i]); }
        else if (DBG_DUMP == 4) { v = bf2f(U1[i]); }
        else if (DBG_DUMP == 5) { v = bf2f(U[i]); }
        else if (DBG_DUMP == 6) { v = bf2f(MIXED[i]); }
        else if (DBG_DUMP == 7) { v = XRES[i] + bf2f(XN[i]); }
        a.out[i] = v;
    }
}
#endif
#define PH_BEGIN const Args a = LOAD_ARGS(); Frame F; F.lds = lds0; F.lane = (int)__builtin_amdgcn_mbcnt_hi(~0u, __builtin_amdgcn_mbcnt_lo(~0u, 0u)); asm volatile("" : "+v"(F.lane)); F.wave = __builtin_amdgcn_readfirstlane((int)((const volatile LAS unsigned*)(lds0 + WTAB_OFF))[hw_wave_key()]); F.tid = F.wave * 64 + F.lane; \
    F.G = gridDim.x; F.bid = blockIdx.x; asm volatile("" : "+s"(F.bid)); F.gw = F.bid * NWAVES + F.wave; F.ngw = F.G * NWAVES; unsigned char* const ws = a.ws; const LAS int* tab = (const LAS int*)(F.lds + TAB_OFF); (void)tab; (void)ws;
#ifdef DBG_DUMP
#define IN(k) (lo <= (k) && (k) < hi && (k) <= DBG_DUMP)
#else
#define IN(k) (lo <= (k) && (k) < hi)
#endif
#ifdef DBG_REPEAT
#define REP(k) for (int rep_ = 0; rep_ < ((DBG_REPEAT == (k)) ? 2 : 1); ++rep_)
#else
#define REP(k)
#endif
#define SEAM(k) do { if (IN(k) && IN((k) + 1)) { XcdBarrier b2_ = bar; { size_t z_ = 0; asm volatile("" : "+s"(z_), "+s"(b2_.x)); b2_.bar = bar.bar + z_; } xcd_barrier(b2_); } } while (0)
template <int l>
__device__ __forceinline__ void layer_body(const Args& args, const int lo, const int hi, const XcdBarrier& bar, LAS unsigned char* const lds0, unsigned char* lds_raw) {
        const int pb = 1 + l * PH_PER_LAYER;

#ifdef DBG_DUMP
        if (l == 0 && lo <= DBG_DUMP + 1 && DBG_DUMP + 1 < hi) { PH_BEGIN dbg_dump(a, F); }
#endif
        if (IN(pb + 0)) REP(0) { PH_BEGIN
            pg8::Gemm g{(bf16_t*)(ws + WS_XN), (bf16_t*)(ws + WS_WIN), D / 2, D / 2, D / 2, E8_1, E8_W}; pg8::StaticOrder S; S.init(T, NINP, F.G, F.bid);
            pg8::EpiInproj E{ws, l};
            pg8::gemm_phase<pg8::EpiInproj, pg8::StaticOrder, true>(F.lds + RING_OFF, g, S, E, F.tid);
        }
        SEAM(pb + 0);
        if (IN(pb + 1)) REP(1) { PH_BEGIN
#if !MK_FAST_ATTN
            phase_fscan(a, F);
#endif
#if MK_FAST_HGRN
            phase_hgrn(a, F, l);
#else
            phase_hgrn_naive(a, F, l);
#endif
        }
        SEAM(pb + 1);
        if (IN(pb + 2)) REP(2) { PH_BEGIN
#if MK_FAST_ATTN
            phase_attn(a, F, (char*)lds_raw);
#else
            phase_attn_naive(a, F);
#endif
        }
        SEAM(pb + 2);
        if (IN(pb + 3)) REP(3) { PH_BEGIN
            pg8::Gemm g{(bf16_t*)(ws + WS_OX8), (bf16_t*)(ws + WS_WBR), D / 2, D / 2, 256, E8_FOX, E8_W}; pg8::StaticOrder S; S.init(T, D, F.G, F.bid);
            pg8::EpiGate<1> E{(bf16_t*)(ws + WS_U1), nullptr, (bf16_t*)(ws + WS_G), 2048, nullptr};
            pg8::gemm_phase<pg8::EpiGate<1>, pg8::StaticOrder, true>(F.lds + RING_OFF, g, S, E, F.tid);
        }
        SEAM(pb + 3);
        if (IN(pb + 4)) REP(4) { PH_BEGIN
            pg8::Gemm g{(bf16_t*)(ws + WS_OX8) + 256, (bf16_t*)(ws + WS_WBR) + 256, D / 2, D / 2, 256, E8_HGRN, E8_W}; pg8::StaticOrder S; S.init(T, D, F.G, F.bid);
            pg8::EpiGate<2> E{(bf16_t*)(ws + WS_U), nullptr, (bf16_t*)(ws + WS_G) + 1024, 2048, (bf16_t*)(ws + WS_U1)};
            pg8::gemm_phase<pg8::EpiGate<2>, pg8::StaticOrder, true>(F.lds + RING_OFF, g, S, E, F.tid);
        }
        SEAM(pb + 4);
        if (IN(pb + 5)) REP(5) { PH_BEGIN
            pg8::Gemm g{(bf16_t*)(ws + WS_U), (bf16_t*)(ws + WS_WMIX), D / 2, D / 2, D / 2, E8_U, E8_W}; pg8::StaticOrder S; S.init(T, D, F.G, F.bid);
            pg8::EpiGate<0> E{(bf16_t*)(ws + WS_MIXED), a.b_mix + l * D, nullptr, 0, nullptr};
            pg8::gemm_phase<pg8::EpiGate<0>, pg8::StaticOrder, true>(F.lds + RING_OFF, g, S, E, F.tid);
        }
        SEAM(pb + 5);
        if (IN(pb + 6)) REP(6) { PH_BEGIN phase_ln1_router(a, F, l); }
        SEAM(pb + 6);
        if (IN(pb + 7)) REP(7) { PH_BEGIN
            moe_table(a, F, l);
            pg8::Gemm g{(bf16_t*)(ws + WS_XN), (bf16_t*)(ws + WS_W13), D / 2, D / 2, D / 2, E8_1, E8_W}; pg8::MoeOrder<true> S{F.G, F.bid, 8, tab, (const int*)(ws + WS_LIST), (size_t)2048 * (D / 2)};
            pg8::EpiUp E{(bf16_t*)(ws + WS_H)};
            pg8::gemm_phase<pg8::EpiUp, pg8::MoeOrder<true>, true>(F.lds + RING_OFF, g, S, E, F.tid);
        }
        SEAM(pb + 7);
        if (IN(pb + 8)) REP(8) { PH_BEGIN
            moe_table(a, F, l);
            pg8::Gemm g{(bf16_t*)(ws + WS_H), (bf16_t*)(ws + WS_W2), D / 2, D / 2, D / 2, E8_H, E8_W}; pg8::MoeOrder<false> S{F.G, F.bid, 4, tab, nullptr, (size_t)D * (D / 2)};
            pg8::EpiGate<0> E{(bf16_t*)(ws + WS_Y), nullptr, nullptr, 0, nullptr};
            pg8::gemm_phase<pg8::EpiGate<0>, pg8::MoeOrder<false>, true>(F.lds + RING_OFF, g, S, E, F.tid);
        }
        SEAM(pb + 8);
        if (IN(pb + 9)) REP(9) { PH_BEGIN
            moe_table(a, F, l);
            phase_combine_ln2(a, F, l);
            if (l + 1 < DEPTH) { __syncthreads(); convert_layer(a, F, l + 1); }
        }
        SEAM(pb + 9);
    }

__global__ void __launch_bounds__(NWAVES * 64, 2) mk_fwd(Args args) {
    extern __shared__ __attribute__((aligned(16))) unsigned char lds_raw[];
    LAS unsigned char* const lds0 = (LAS unsigned char*)lds_raw;
    volatile LAS unsigned* MISC = (volatile LAS unsigned*)(lds0 + MISC_OFF);
    for (int u = threadIdx.x; u < (LDS_BYTES - LDSCTL_OFF) / 4; u += NWAVES * 64) ((LAS unsigned*)(lds0 + LDSCTL_OFF))[u] = 0u;
    __syncthreads();
    if ((threadIdx.x & 63) == 0) ((volatile LAS unsigned*)(lds0 + WTAB_OFF))[hw_wave_key()] = threadIdx.x >> 6;
    __syncthreads();
    unsigned* ctl = (unsigned*)(args.ws + WS_CTL);
    XcdBarrier bar; bar.bar = ctl + CW_BAR; bar.x = 0; bar.st = nullptr;
    if (args.use_bar) bar = xcd_barrier_post(ctl + CW_BAR, MISC + 8);
    const int lo = args.ph_lo, hi = args.ph_hi;


    if (IN(0)) { PH_BEGIN phase_prep(a, F); }
    SEAM(0);
    layer_body<0>(args, lo, hi, bar, lds0, lds_raw); layer_body<1>(args, lo, hi, bar, lds0, lds_raw); layer_body<2>(args, lo, hi, bar, lds0, lds_raw); layer_body<3>(args, lo, hi, bar, lds0, lds_raw);
#undef IN
#undef SEAM
}

extern "C" void kernel_launch(void* const* d_in, const int* in_sizes, int n_in, void* d_out, int out_size, void* d_ws, size_t ws_size, hipStream_t stream) {
    static int grid = 0;
    if (grid == 0) {
        if (n_in != 20 || in_sizes[0] != T * D || out_size != T * D || ws_size < WS_END) { fprintf(stderr, "kernel_launch: unexpected shapes (n_in %d, ws %zu)\n", n_in, ws_size); grid = -1; return; }
        int dev = 0, cus = 0, per_cu = 0;
        if (hipGetDevice(&dev) != hipSuccess || hipDeviceGetAttribute(&cus, hipDeviceAttributeMultiprocessorCount, dev) != hipSuccess) { grid = -1; return; }
        if (hipFuncSetAttribute((const void*)mk_fwd, hipFuncAttributeMaxDynamicSharedMemorySize, LDS_BYTES) != hipSuccess) { fprintf(stderr, "kernel_launch: hipFuncSetAttribute failed\n"); grid = -1; return; }
        if (hipOccupancyMaxActiveBlocksPerMultiprocessor(&per_cu, (const void*)mk_fwd, NWAVES * 64, LDS_BYTES) != hipSuccess || per_cu < 1)
            fprintf(stderr, "kernel_launch: note: occupancy query reports %d workgroups per CU\n", per_cu);
        (void)hipGetLastError();
        grid = cus;
    }
    if (grid < 0) return;
    if (hipMemsetAsync((char*)d_ws + WS_CTL, 0, CTL_BYTES, stream) != hipSuccess) return;
    Args a{};
    a.x = (const float*)d_in[0]; a.ln_in_g = (const float*)d_in[1]; a.ln_in_b = (const float*)d_in[2]; a.w_in = (const float*)d_in[3]; a.b_in = (const float*)d_in[4];
    a.w_fox = (const float*)d_in[5]; a.lbl = (const float*)d_in[6]; a.norm_g = (const float*)d_in[7]; a.w_hgrn = (const float*)d_in[8]; a.w_mix = (const float*)d_in[9];
    a.b_mix = (const float*)d_in[10]; a.ln1_g = (const float*)d_in[11]; a.ln1_b = (const float*)d_in[12]; a.router_w = (const float*)d_in[13]; a.router_b = (const float*)d_in[14];
    a.w1 = (const float*)d_in[15]; a.w3 = (const float*)d_in[16]; a.w2 = (const float*)d_in[17]; a.ln2_g = (const float*)d_in[18]; a.ln2_b = (const float*)d_in[19];
    a.out = (float*)d_out; a.ws = (unsigned char*)d_ws; a.pad = 0;
#if MK_ONE_LAUNCH
    a.ph_lo = 0; a.ph_hi = N_PHASES; a.use_bar = 1;
    hipLaunchKernelGGL(mk_fwd, dim3(grid), dim3(NWAVES * 64), LDS_BYTES, stream, a);
#else
#ifdef DBG_DUMP
    const int np_ = DBG_DUMP + 2;
#else
    const int np_ = N_PHASES;
#endif
    for (int p = 0; p < np_; ++p) { a.ph_lo = p; a.ph_hi = p + 1; a.use_bar = 0;
        hipLaunchKernelGGL(mk_fwd, dim3(grid), dim3(NWAVES * 64), LDS_BYTES, stream, a); }
#endif
    const hipError_t le = hipPeekAtLastError();
    if (le != hipSuccess) fprintf(stderr, "kernel_launch: launch failed: %s\n", hipGetErrorName(le));
}
```

```cpp
#define MK_ONE_LAUNCH 1
#define MK_FAST_ATTN 1
#define MK_FAST_HGRN 1
#include <hip/hip_runtime.h>
#include <cstdio>
#include <cstdint>

typedef unsigned short bf16_t;
typedef short bf16x8 __attribute__((ext_vector_type(8)));
typedef float f32x4 __attribute__((ext_vector_type(4)));
typedef float f32x2 __attribute__((ext_vector_type(2)));
typedef unsigned u32x4 __attribute__((ext_vector_type(4)));
typedef unsigned u32x2 __attribute__((ext_vector_type(2)));
#define LAS __attribute__((address_space(3)))
#define GAS __attribute__((address_space(1)))

constexpr int BATCH = 16, SEQ = 2048, T = BATCH * SEQ, D = 1024, DEPTH = 4, NH = 8, HD = 64, NIN = 5640, NINP = 5888, NE = 16;
constexpr float LN_EPS = 1e-5f, RMS_EPS = 1e-6f;
constexpr float ALPHA = 1.681792830507429f;
constexpr float LOG2E = 1.4426950408889634f;
constexpr float C2 = 0.125f * LOG2E;
constexpr float SC_W = 64.f, SC_FOX = 16.f, SC_HGRN = 4.f, SC_U = 64.f, SC_H = 8.f;
constexpr int E8_1 = 0x7f7f7f7f, E8_W = 0x79797979, E8_FOX = 0x7b7b7b7b, E8_HGRN = 0x7d7d7d7d, E8_U = 0x79797979, E8_H = 0x7c7c7c7c;
constexpr int TM = 256;

constexpr size_t MiB = 1u << 20;
constexpr size_t WS_CTL = 0, CTL_BYTES = 1 * MiB;
constexpr size_t WS_MISC = 1 * MiB;
constexpr size_t WS_WSET = 2 * MiB, WSET_BYTES = 56 * MiB;
constexpr size_t WO_WIN = 0, WO_WBR = 6 * MiB, WO_WMIX = 7 * MiB, WO_W13 = 8 * MiB, WO_W2 = 40 * MiB;
__host__ __device__ constexpr size_t wset(int l) { return WS_WSET + (size_t)(l & 1) * WSET_BYTES; }
__host__ __device__ constexpr size_t biasoff(int l) { return WS_MISC + 16384 + (size_t)(l & 1) * 32768; }
constexpr size_t WS_XRES = 114 * MiB, WS_XN = 242 * MiB, WS_QO = 306 * MiB, WS_KV = 370 * MiB, WS_HB = 434 * MiB, WS_LOGF = 498 * MiB;
constexpr size_t WS_HG = 562 * MiB, WS_G = 594 * MiB, WS_FL = 722 * MiB, WS_F2 = 723 * MiB, WS_U1 = 724 * MiB, WS_U = 788 * MiB, WS_MIXED = 852 * MiB;
constexpr size_t WS_LIST = 916 * MiB, WS_TOK = 918 * MiB, WS_END = 919 * MiB;
constexpr size_t WS_OX8 = 274 * MiB;
constexpr size_t WS_H = WS_QO, WS_Y = 442 * MiB;
constexpr int CW_CNT = 1024;
constexpr int CW_BAR = 4096;

__device__ __forceinline__ unsigned f2bf(float f) { unsigned u = __builtin_bit_cast(unsigned, f); return (u + 0x7fffu + ((u >> 16) & 1u)) >> 16; }
__device__ __forceinline__ float bf2f(unsigned h) { return __builtin_bit_cast(float, h << 16); }
__device__ __forceinline__ float bflo(unsigned w) { return __builtin_bit_cast(float, w << 16); }
__device__ __forceinline__ float bfhi(unsigned w) { return __builtin_bit_cast(float, w & 0xffff0000u); }
__device__ __forceinline__ unsigned pk2(float lo, float hi) { return f2bf(lo) | (f2bf(hi) << 16); }
__device__ __forceinline__ float wave_sum(float v) {
#pragma unroll
    for (int o = 1; o < 64; o <<= 1) v += __shfl_xor(v, o);
    return v;
}
__device__ __forceinline__ float wave_max(float v) {
#pragma unroll
    for (int o = 1; o < 64; o <<= 1) v = fmaxf(v, __shfl_xor(v, o));
    return v;
}
__device__ __forceinline__ float fast_exp(float v) { return __builtin_amdgcn_exp2f(v * LOG2E); }
__device__ __forceinline__ float sigmoidf_(float v) { return __builtin_amdgcn_rcpf(1.0f + fast_exp(-v)); }
__device__ __forceinline__ float siluf_(float v) { return v * sigmoidf_(v); }
__device__ __forceinline__ float logsigmoidf_(float v) { return fminf(v, 0.f) - __logf(1.0f + fast_exp(-fabsf(v))); }

namespace pg8 {
constexpr int BM = 256, BK = 64, HALF = 128, HTB = HALF * BK * 2  , STAGE_BYTES = 8 * HTB, NXCD = 8, WGM = 8;
__host__ __device__ __forceinline__ int lds_byte(int r, int c) { const int st = (r >> 4) * 2 + (c >> 5), rr = r & 15, cc = c & 31, ob = rr * 64 + cc * 2; return st * 1024 + (ob ^ (((ob >> 9) & 1) << 5)); }
__host__ __device__ __forceinline__ void stage_rc(int b, int& R, int& C) { const int st = b / 1024, sb = b % 1024, swz = sb ^ (((sb >> 9) & 1) << 5); R = (st >> 1) * 16 + swz / 64; C = (st & 1) * 32 + (swz % 64) / 2; }
__host__ __device__ __forceinline__ int perm32(int rho) { const int n = rho >> 4, i = rho & 15; return 8 * (i >> 2) + 4 * n + (i & 3); }

struct Unit { int pm, pn, e; };
struct Gemm { const bf16_t* A; const bf16_t* Bt; int lda, ldb, K; int sa, sb; };

struct StaticOrder {
    static constexpr bool GATHER = false;
    int nM, nN, nwg, G, c;
    __device__ void init(int M, int N, int G_, int c_) { nM = M / BM; nN = N / BM; nwg = nM * nN; G = G_; c = c_; }
    __device__ bool next(int i, Unit& u) const {
        const int L = i * G + c; if (L >= nwg) return false;
        int wgid = L; { const int q = nwg / NXCD, r = nwg % NXCD, xcd = wgid % NXCD, off = wgid / NXCD; wgid = (xcd < r ? xcd * (q + 1) : r * (q + 1) + (xcd - r) * q) + off; }
        const int nig = WGM * nN, gid = wgid / nig, fm = gid * WGM, gsz = (nM - fm) < WGM ? (nM - fm) : WGM;
        u.pm = fm + ((wgid % nig) % gsz); u.pn = (wgid % nig) / gsz; u.e = 0; return true;
    }
    __device__ __forceinline__ const char* a_tile(const Gemm& g, const Unit& u) const { return (const char*)g.A + (size_t)u.pm * BM * g.lda * 2; }
    __device__ __forceinline__ const char* b_tile(const Gemm& g, const Unit& u) const { return (const char*)g.Bt + (size_t)u.pn * BM * g.ldb * 2; }
    __device__ __forceinline__ void a_voff(const Gemm& g, const Unit&, const int (&R)[2], const int (&C)[2], unsigned (&v)[2][2]) const {
#pragma unroll
        for (int h = 0; h < 2; ++h)
#pragma unroll
            for (int i = 0; i < 2; ++i) v[h][i] = (unsigned)((h * HALF + R[i]) * g.lda + C[i]) * 2u;
    }
};
template <bool GATHER_> struct MoeOrder {
    static constexpr bool GATHER = GATHER_; static constexpr bool gather = GATHER_;
    int G, c, nN; const LAS int* tab; const int* list; size_t bstride;
    __device__ bool next(int i, Unit& u) const {
        const int L = i * G + c; const int rt = L / nN; const int NT = tab[NE]; if (rt >= NT) return false;
        int e = 0;
#pragma unroll
        for (int k = 1; k < NE; ++k) e += (rt >= tab[k]) ? 1 : 0;
        u.pm = __builtin_amdgcn_readfirstlane(rt); u.pn = __builtin_amdgcn_readfirstlane(L % nN); u.e = __builtin_amdgcn_readfirstlane(e); return true;
    }
    __device__ __forceinline__ const char* a_tile(const Gemm& g, const Unit& u) const { return gather ? (const char*)g.A : (const char*)g.A + (size_t)u.pm * BM * g.lda * 2; }
    __device__ __forceinline__ const char* b_tile(const Gemm& g, const Unit& u) const { return (const char*)g.Bt + ((size_t)u.e * bstride + (size_t)u.pn * BM * g.ldb) * 2; }
    __device__ __forceinline__ void a_voff(const Gemm& g, const Unit& u, const int (&R)[2], const int (&C)[2], unsigned (&v)[2][2]) const {
        const int ts = tab[u.e], cn = tab[NE + 1 + u.e];
#pragma unroll
        for (int h = 0; h < 2; ++h)
#pragma unroll
            for (int i = 0; i < 2; ++i) {
                if (gather) { const int pos = (u.pm - ts) * BM + h * HALF + R[i]; const int tok = (pos < cn) ? list[u.e * T + pos] : 0; v[h][i] = (unsigned)(tok * g.lda + C[i]) * 2u; }
                else v[h][i] = (unsigned)((h * HALF + R[i]) * g.lda + C[i]) * 2u;
            }
    }
};

typedef __bf16 bf16x2_t __attribute__((ext_vector_type(2)));
__device__ __forceinline__ unsigned cvt_pk_bf16(float lo, float hi) { f32x2 v = {lo, hi}; bf16x2_t b = __builtin_convertvector(v, bf16x2_t); return __builtin_bit_cast(unsigned, b); }
__device__ __forceinline__ u32x4 pack8(const f32x4& v0, const f32x4& v1) { u32x4 w; w.x = cvt_pk_bf16(v0[0], v0[1]); w.y = cvt_pk_bf16(v0[2], v0[3]); w.z = cvt_pk_bf16(v1[0], v1[1]); w.w = cvt_pk_bf16(v1[2], v1[3]); return w; }
__device__ __forceinline__ void unpack8(const u32x4& w, f32x4& v0, f32x4& v1) { v0[0] = bflo(w.x); v0[1] = bfhi(w.x); v0[2] = bflo(w.y); v0[3] = bfhi(w.y); v1[0] = bflo(w.z); v1[1] = bfhi(w.z); v1[2] = bflo(w.w); v1[3] = bfhi(w.w); }
typedef int v8i __attribute__((ext_vector_type(8)));
typedef int v4i __attribute__((ext_vector_type(4)));
__device__ __forceinline__ u32x2 pack8_fp8(const f32x4& v0, const f32x4& v1) {
    u32x2 w; int t = 0; t = __builtin_amdgcn_cvt_pk_fp8_f32(v0[0], v0[1], t, false); t = __builtin_amdgcn_cvt_pk_fp8_f32(v0[2], v0[3], t, true); w.x = (unsigned)t;
    int t2 = 0; t2 = __builtin_amdgcn_cvt_pk_fp8_f32(v1[0], v1[1], t2, false); t2 = __builtin_amdgcn_cvt_pk_fp8_f32(v1[2], v1[3], t2, true); w.y = (unsigned)t2; return w; }
__device__ __forceinline__ unsigned pack4_fp8(float a, float b, float c, float d) { int t = 0; t = __builtin_amdgcn_cvt_pk_fp8_f32(a, b, t, false); t = __builtin_amdgcn_cvt_pk_fp8_f32(c, d, t, true); return (unsigned)t; }
__device__ __forceinline__ f32x4 sig4(const f32x4& v) { f32x4 o; o[0] = sigmoidf_(v[0]); o[1] = sigmoidf_(v[1]); o[2] = sigmoidf_(v[2]); o[3] = sigmoidf_(v[3]); return o; }

struct EpiInproj {
    static constexpr bool PERM = true;
    unsigned char* ws; int layer;
    template <int KIND> __device__ __forceinline__ void tile(const f32x4 (&acc)[2][2][4][2], const Unit& u, int wr, int wc, int fr, int fq, unsigned char* w) const {
        const float* biasp = (const float*)(w + biasoff(layer));
        const int row0 = u.pm * BM + wr * 64 + fr, bcol0 = u.pn * BM + wc * 32 + 8 * fq;
        f32x4 bv[2][2];
#pragma unroll
        for (int bj = 0; bj < 2; ++bj)
#pragma unroll
            for (int n = 0; n < 2; ++n) bv[bj][n] = *(const f32x4*)(biasp + bcol0 + bj * HALF + 4 * n);
#pragma unroll
        for (int ai = 0; ai < 2; ++ai)
#pragma unroll
            for (int m = 0; m < 4; ++m) { const size_t row = (size_t)(row0 + ai * HALF + m * 16);
#pragma unroll
                for (int bj = 0; bj < 2; ++bj) { f32x4 v0 = acc[ai][bj][m][0] + bv[bj][0], v1 = acc[ai][bj][m][1] + bv[bj][1]; const int col = bcol0 + bj * HALF;
                    if (KIND == 0) { *(u32x4*)((bf16_t*)(w + WS_QO) + row * 1024 + col) = pack8(v0 * C2, v1 * C2); }
                    else if (KIND == 1) { *(u32x4*)((bf16_t*)(w + WS_KV) + row * 1024 + (col - 512)) = pack8(v0, v1); }
                    else if (KIND == 2) { *(u32x4*)((bf16_t*)(w + WS_KV) + row * 1024 + 512 + (col - 1024)) = pack8(v0, v1); }
                    else if (KIND == 3) { *(u32x4*)((bf16_t*)(w + WS_HB) + row * 1024 + (col - 1536)) = pack8(v0 * sig4(v0), v1 * sig4(v1)); }
                    else if (KIND == 4) { const int c = col - 2048; const float* lb = (const float*)(w + WS_MISC) + layer * 512; const f32x4 l0 = *(const f32x4*)(lb + c), l1 = *(const f32x4*)(lb + c + 4);
                        f32x4 f0 = l0 + (1.f - l0) * sig4(v0), f1 = l1 + (1.f - l1) * sig4(v1);
#pragma unroll
                        for (int q = 0; q < 4; ++q) { f0[q] = __logf(f0[q]); f1[q] = __logf(f1[q]); }
                        float* LOGF = (float*)(w + WS_LOGF); *(f32x4*)(LOGF + row * 512 + c) = f0; *(f32x4*)(LOGF + row * 512 + c + 4) = f1; }
                    else if (KIND == 5) { *(u32x4*)((bf16_t*)(w + WS_HB) + row * 1024 + 512 + (col - 2560)) = pack8(v0, v1); }
                    else if (KIND == 6) { *(u32x4*)((bf16_t*)(w + WS_HG) + row * 512 + (col - 3072)) = pack8(v0 * sig4(v0), v1 * sig4(v1)); }
                    else if (KIND == 7) { *(u32x4*)((bf16_t*)(w + WS_G) + row * 2048 + (col - 3584)) = pack8(sig4(v0), sig4(v1)); }
                    else { if (col == 5632) { f32x4 f0, f1;
#pragma unroll
                            for (int q = 0; q < 4; ++q) { f0[q] = logsigmoidf_(v0[q]); f1[q] = logsigmoidf_(v1[q]); }
                            float* FL = (float*)(w + WS_FL); *(f32x4*)(FL + row * 8) = f0; *(f32x4*)(FL + row * 8 + 4) = f1; } }
                } }
    }
    __device__ __forceinline__ void operator()(const f32x4 (&acc)[2][2][4][2], const Unit& u, int wr, int wc, int fr, int fq) const {
        size_t z_ = 0; asm volatile("" : "+s"(z_)); unsigned char* w = ws + z_;
        const int ct = u.pn;
        if (ct < 2) tile<0>(acc, u, wr, wc, fr, fq, w); else if (ct < 4) tile<1>(acc, u, wr, wc, fr, fq, w); else if (ct < 6) tile<2>(acc, u, wr, wc, fr, fq, w);
        else if (ct < 8) tile<3>(acc, u, wr, wc, fr, fq, w); else if (ct < 10) tile<4>(acc, u, wr, wc, fr, fq, w); else if (ct < 12) tile<5>(acc, u, wr, wc, fr, fq, w);
        else if (ct < 14) tile<6>(acc, u, wr, wc, fr, fq, w); else if (ct < 22) tile<7>(acc, u, wr, wc, fr, fq, w); else tile<8>(acc, u, wr, wc, fr, fq, w);
    }
};
template <int MODE> struct EpiGate {
    static constexpr bool PERM = true;
    bf16_t* O; const float* bias; const bf16_t* Gt; int ldg; const bf16_t* P;
    __device__ __forceinline__ void operator()(const f32x4 (&acc)[2][2][4][2], const Unit& u, int wr, int wc, int fr, int fq) const {
        const int row0 = u.pm * BM + wr * 64 + fr, col0 = u.pn * BM + wc * 32 + 8 * fq;
        f32x4 bv[2][2];
        if (MODE == 0) {
#pragma unroll
            for (int bj = 0; bj < 2; ++bj)
#pragma unroll
                for (int n = 0; n < 2; ++n) bv[bj][n] = bias ? *(const f32x4*)(bias + col0 + bj * HALF + 4 * n) : (f32x4){0.f, 0.f, 0.f, 0.f};
        }
#pragma unroll
        for (int ai = 0; ai < 2; ++ai)
#pragma unroll
            for (int mh = 0; mh < 2; ++mh) {
                u32x4 gq[2][2], pq[2][2];
                if (MODE != 0) {
#pragma unroll
                    for (int mm = 0; mm < 2; ++mm)
#pragma unroll
                        for (int bj = 0; bj < 2; ++bj) { const size_t row = (size_t)(row0 + ai * HALF + (mh * 2 + mm) * 16); const int col = col0 + bj * HALF;
                            gq[mm][bj] = *(const u32x4*)(Gt + row * ldg + col);
                            if (MODE == 2) pq[mm][bj] = *(const u32x4*)(P + row * 1024 + col); }
                    asm volatile("s_waitcnt vmcnt(0)" ::: "memory");
                }
#pragma unroll
                for (int mm = 0; mm < 2; ++mm)
#pragma unroll
                    for (int bj = 0; bj < 2; ++bj) { const int m = mh * 2 + mm; const size_t row = (size_t)(row0 + ai * HALF + m * 16); const int col = col0 + bj * HALF;
                        f32x4 v0 = acc[ai][bj][m][0], v1 = acc[ai][bj][m][1];
                        if (MODE == 0) { v0 += bv[bj][0]; v1 += bv[bj][1]; }
                        else { f32x4 g0, g1; unpack8(gq[mm][bj], g0, g1); v0 *= g0; v1 *= g1;
                            if (MODE == 2) { f32x4 p0, p1; unpack8(pq[mm][bj], p0, p1); v0 += p0; v1 += p1; } }
                        if (MODE == 2) *(u32x2*)((unsigned char*)O + row * 1024 + col) = pack8_fp8(v0 * SC_U, v1 * SC_U); else *(u32x4*)(O + row * 1024 + col) = pack8(v0, v1); }
                if (MODE != 0) asm volatile("" ::: "memory");
            }
    }
};
struct EpiUp {
    static constexpr bool PERM = true;
    bf16_t* H;
    __device__ __forceinline__ void operator()(const f32x4 (&acc)[2][2][4][2], const Unit& u, int wr, int wc, int fr, int fq) const {
        const int row0 = u.pm * BM + wr * 64 + fr, col = u.pn * HALF + wc * 32 + 8 * fq;
#pragma unroll
        for (int ai = 0; ai < 2; ++ai)
#pragma unroll
            for (int m = 0; m < 4; ++m) { const size_t row = (size_t)(row0 + ai * HALF + m * 16);
                const f32x4 a0 = acc[ai][0][m][0], a1 = acc[ai][0][m][1], b0 = acc[ai][1][m][0], b1 = acc[ai][1][m][1];
                *(u32x2*)((unsigned char*)H + row * 1024 + col) = pack8_fp8(a0 * sig4(a0) * b0 * SC_H, a1 * sig4(a1) * b1 * SC_H); }
    }
};

__device__ __forceinline__ void glds16s(const char* sbase, unsigned voff, unsigned lds_dst) {
    unsigned keep;
    asm volatile("s_mov_b32 %0, m0\n\ts_mov_b32 m0, %3\n\ts_nop 0\n\tglobal_load_lds_dwordx4 %1, %2\n\ts_mov_b32 m0, %0" : "=&s"(keep) : "v"(voff), "s"(sbase), "s"(lds_dst) : "memory");
}
template <class Epi, class Sched, bool ALIGN_EPI>
__device__ __forceinline__ void gemm_phase(LAS unsigned char* lds, const Gemm g, const Sched& S, const Epi& E, const int tid) {
    const int wid = __builtin_amdgcn_readfirstlane(tid >> 6), lane = tid & 63, wr = wid >> 2, wc = wid & 3, fr = lane & 15, fq = lane >> 4;
    int K = g.K; asm volatile("" : "+s"(K));
    const int nt = K / BK;
    int RA[2], CA[2]; unsigned voffB[2];
#pragma unroll
    for (int i = 0; i < 2; ++i) { int R, C; stage_rc(tid * 16 + i * 8192, R, C); const int Rb = Epi::PERM ? ((R & ~31) + perm32(R & 31)) : R;
        RA[i] = R; CA[i] = C; voffB[i] = (unsigned)(Rb * g.ldb + C) * 2u; }
    const size_t kstep = (size_t)(BK * 2);
    const size_t hstepB = (size_t)HALF * g.ldb * 2;
    const unsigned ldsw = (unsigned)wid * 1024u;
    const unsigned ldsb = (unsigned)__builtin_amdgcn_readfirstlane((int)((unsigned)(uintptr_t)lds + ldsw));
    const int aoff = lds_byte(wr * 64 + fr, fq * 8), boff = lds_byte(wc * 32 + fr, fq * 8);
#define PG8_SA(b, h) (((b) * 2 + (h)) * HTB)
#define PG8_SB(b, h) ((4 + (b) * 2 + (h)) * HTB)
#define PG8_STAGE(bufoff, gbase, voff) do { _Pragma("unroll") for (int _i = 0; _i < 2; ++_i) glds16s((const char*)(gbase), (voff)[_i], ldsb + (unsigned)((bufoff) + _i * 8192)); } while (0)
#define PG8_LD8(p) __builtin_shufflevector(*(const LAS v4i*)(p), *(const LAS v4i*)((p) + 1024), 0, 1, 2, 3, 4, 5, 6, 7)
#define PG8_LDA(dst, b, h) do { _Pragma("unroll") for (int m = 0; m < 4; ++m) dst[m] = PG8_LD8(lds + PG8_SA(b, h) + aoff + m * 2048); } while (0)
#define PG8_LDB(dst, b, h) do { _Pragma("unroll") for (int n = 0; n < 2; ++n) dst[n] = PG8_LD8(lds + PG8_SB(b, h) + boff + n * 2048); } while (0)
#define PG8_MMA(ai, bj, At, Bt) do { __builtin_amdgcn_s_setprio(1); _Pragma("unroll") for (int m = 0; m < 4; ++m) _Pragma("unroll") for (int n = 0; n < 2; ++n) \
        asm volatile("v_mfma_scale_f32_16x16x128_f8f6f4 %0, %1, %2, %0, %3, %4 op_sel_hi:[0,0,0]" : "+v"(acc[ai][bj][m][n]) : "v"(Bt[n]), "v"(At[m]), "v"(sbv), "v"(sav)); \
        __builtin_amdgcn_s_setprio(0); } while (0)
#define PG8_WAIT_V(n) asm volatile("s_waitcnt vmcnt(" #n ")" ::: "memory")
#define PG8_WAIT_L(n) asm volatile("s_waitcnt lgkmcnt(" #n ")" ::: "memory")
#define PG8_BAR __builtin_amdgcn_s_barrier()
#define PG8_SCHED __builtin_amdgcn_sched_barrier(0)
    Unit cur, nxt; int ui = 0;
    if (!S.next(0, cur)) return;
    f32x4 acc[2][2][4][2];
#pragma unroll
    for (int a = 0; a < 2; ++a)
#pragma unroll
        for (int b = 0; b < 2; ++b)
#pragma unroll
            for (int m = 0; m < 4; ++m)
#pragma unroll
                for (int n = 0; n < 2; ++n) acc[a][b][m][n] = (f32x4){0.f, 0.f, 0.f, 0.f};
    int sav = g.sa, sbv = g.sb;
    v8i At[4], B0[2], B1[2];
    unsigned vA[2][2], nvA[2][2];
    S.a_voff(g, cur, RA, CA, vA);
    const char* cA = S.a_tile(g, cur); const char* cB = S.b_tile(g, cur);
    PG8_STAGE(PG8_SB(0, 0), cB, voffB); PG8_STAGE(PG8_SB(0, 1), cB + hstepB, voffB); PG8_STAGE(PG8_SA(0, 0), cA, vA[0]); PG8_STAGE(PG8_SA(0, 1), cA, vA[1]);
    if (wr == 1) PG8_BAR;
    PG8_WAIT_V(2); PG8_BAR;
    PG8_STAGE(PG8_SB(1, 0), cB + kstep, voffB); PG8_STAGE(PG8_SA(1, 0), cA + kstep, vA[0]); PG8_STAGE(PG8_SB(1, 1), cB + hstepB + kstep, voffB);
    PG8_WAIT_V(6); PG8_BAR;
    for (;;) {
        const bool has_next = S.next(ui + 1, nxt);
        const char* nA = has_next ? S.a_tile(g, nxt) : cA; const char* nB = has_next ? S.b_tile(g, nxt) : cB;
        if constexpr (Sched::GATHER) {
            if (has_next) { int RA2[2], CA2[2];
#pragma unroll
                for (int i = 0; i < 2; ++i) { int tq = tid; asm volatile("" : "+v"(tq)); stage_rc(tq * 16 + i * 8192, RA2[i], CA2[i]); }
                S.a_voff(g, nxt, RA2, CA2, nvA); }
            else {
#pragma unroll
                for (int h = 0; h < 2; ++h)
#pragma unroll
                    for (int i = 0; i < 2; ++i) nvA[h][i] = vA[h][i]; }
        }
        for (int t = 0; t < nt; t += 2) {
            const bool last = (t == nt - 2);
            const char* a1 = cA + (size_t)(t + 1) * kstep;
            const char* a2 = last ? nA : cA + (size_t)(t + 2) * kstep; const char* b2 = last ? nB : cB + (size_t)(t + 2) * kstep;
            const char* a3 = a2 + kstep; const char* b3 = b2 + kstep;
            unsigned wA0[2], wA1[2];
#pragma unroll
            for (int i = 0; i < 2; ++i) { if constexpr (Sched::GATHER) { wA0[i] = last ? nvA[0][i] : vA[0][i]; wA1[i] = last ? nvA[1][i] : vA[1][i]; } else { wA0[i] = vA[0][i]; wA1[i] = vA[1][i]; } }
            PG8_LDB(B0, 0, 0); PG8_LDB(B1, 0, 1); PG8_SCHED; PG8_LDA(At, 0, 0); PG8_STAGE(PG8_SA(1, 1), a1, vA[1]);
            PG8_WAIT_V(8); PG8_WAIT_L(0); PG8_BAR; PG8_MMA(0, 0, At, B0); PG8_MMA(0, 1, At, B1); PG8_BAR; PG8_SCHED;
            PG8_LDA(At, 0, 1); PG8_STAGE(PG8_SB(0, 0), b2, voffB); PG8_STAGE(PG8_SB(0, 1), b2 + hstepB, voffB); PG8_STAGE(PG8_SA(0, 0), a2, wA0);
            PG8_WAIT_V(8); PG8_WAIT_L(0); PG8_BAR; PG8_MMA(1, 0, At, B0); PG8_MMA(1, 1, At, B1); PG8_BAR; PG8_SCHED;
            PG8_LDB(B0, 1, 0); PG8_LDB(B1, 1, 1); PG8_SCHED; PG8_LDA(At, 1, 0); PG8_STAGE(PG8_SA(0, 1), a2, wA1);
            PG8_WAIT_V(8); PG8_WAIT_L(0); PG8_BAR; PG8_MMA(0, 0, At, B0); PG8_MMA(0, 1, At, B1); PG8_BAR; PG8_SCHED;
            PG8_LDA(At, 1, 1); PG8_STAGE(PG8_SB(1, 0), b3, voffB); PG8_STAGE(PG8_SB(1, 1), b3 + hstepB, voffB); PG8_STAGE(PG8_SA(1, 0), a3, wA0);
            PG8_WAIT_V(8); PG8_WAIT_L(0); PG8_BAR; PG8_MMA(1, 0, At, B0); PG8_MMA(1, 1, At, B1); PG8_BAR; PG8_SCHED;
        }
        if constexpr (ALIGN_EPI) { if (wr == 0) PG8_BAR; }
        asm volatile("s_nop 15\n\ts_nop 15" ::: "memory");
        E(acc, cur, wr, wc, fr, fq);
        if (!has_next) break;
#pragma unroll
        for (int a = 0; a < 2; ++a)
#pragma unroll
            for (int b = 0; b < 2; ++b)
#pragma unroll
                for (int m = 0; m < 4; ++m)
#pragma unroll
                    for (int n = 0; n < 2; ++n) acc[a][b][m][n] = (f32x4){0.f, 0.f, 0.f, 0.f};
        cur = nxt; cA = nA; cB = nB; ++ui;
        if constexpr (Sched::GATHER) {
#pragma unroll
            for (int h = 0; h < 2; ++h)
#pragma unroll
                for (int i = 0; i < 2; ++i) vA[h][i] = nvA[h][i]; }
        if constexpr (ALIGN_EPI) { if (wr == 1) PG8_BAR; }
    }
    PG8_WAIT_V(0);
    if constexpr (!ALIGN_EPI) { if (wr == 0) PG8_BAR; }
    PG8_BAR;
#undef PG8_SA
#undef PG8_SB
#undef PG8_STAGE
#undef PG8_LDA
#undef PG8_LDB
#undef PG8_MMA
#undef PG8_LD8
#undef PG8_WAIT_V
#undef PG8_WAIT_L
#undef PG8_BAR
#undef PG8_SCHED
}
}


#include <hip/hip_bf16.h>
#include <cmath>
namespace attn_body {
using bf16=__hip_bfloat16;
using bf16x8=__attribute__((ext_vector_type(8)))short;
using s16x4=__attribute__((ext_vector_type(4)))short;
using f32x16=__attribute__((ext_vector_type(16)))float;
using u32x4=__attribute__((ext_vector_type(4)))unsigned;
constexpr int BATCH=16,NHEAD=8,SEQ=2048,D=64,DM=1024;
constexpr int NW=8,QBLK=32,QB=QBLK*NW,KVBLK=64,NQB=SEQ/QB;
constexpr int ATTN_PITCH=DM, ATTN_UNIT_ROWS=QB;
__device__ __forceinline__ int crow(int r,int hi){return (r&3)+8*(r>>2)+4*hi;}
#define SBAR() __builtin_amdgcn_sched_barrier(0)
__device__ __forceinline__ void cmask(f32x16&p0,f32x16&p1,int jb,int qrel,int hi){
  const float NEG=-INFINITY; int kb=64*jb+4*hi;
  #pragma unroll
  for(int r=0;r<16;++r){int kv=kb+(r&3)+8*(r>>2); if(kv>qrel)p0[r]=NEG; if(kv+32>qrel)p1[r]=NEG;}
}

constexpr int NSLOT=3, SLOTB=8192;
constexpr int LDS_K=0, LDS_V=NSLOT*SLOTB, LDS_WS=2*NSLOT*SLOTB, LDS_OST=LDS_WS+NW*64*4, LDS_BYTES=LDS_OST+NW*4096;
constexpr float C2=0.125f*1.4426950408889634f;
__device__ __forceinline__ void glds16(const void*gsrc,unsigned lds_dst){unsigned keep;
  asm volatile("s_mov_b32 %0, m0\n\ts_mov_b32 m0, %2\n\ts_nop 0\n\tglobal_load_lds_dwordx4 %1, off\n\ts_mov_b32 m0, %0":"=&s"(keep):"v"(gsrc),"s"(lds_dst):"memory");}
__device__ __forceinline__ float max3f(float a,float b,float c){float r;asm("v_max3_f32 %0, %1, %2, %3":"=v"(r):"v"(a),"v"(b),"v"(c));return r;}
__device__ __forceinline__ float max2f(float a,float b){float r;asm("v_max_f32_e32 %0, %1, %2":"=v"(r):"v"(a),"v"(b));return r;}
__device__ __forceinline__ float fadd_s(float a,float b){float r;asm("v_add_f32_e32 %0, %1, %2":"=v"(r):"v"(a),"v"(b));return r;}
__device__ __forceinline__ float fsub_s(float a,float b){float r;asm("v_sub_f32_e32 %0, %1, %2":"=v"(r):"v"(a),"v"(b));return r;}
typedef float f32x2_t __attribute__((ext_vector_type(2))); typedef __bf16 bf16x2_t __attribute__((ext_vector_type(2)));
__device__ __forceinline__ unsigned cvtpk_s(float lo,float hi){f32x2_t v={lo,hi};bf16x2_t b=__builtin_convertvector(v,bf16x2_t);return __builtin_bit_cast(unsigned,b);}
#define WAIT_BAR(N) asm volatile("s_waitcnt vmcnt(" #N ") lgkmcnt(0)\n\ts_barrier":::"memory")

__device__ __forceinline__ void qkt(f32x16&p0,f32x16&p1,const char*Kslot,const bf16x8*qr,const f32x16&negm,int r32,int hi){
  const char*kb=Kslot+hi*1024+r32*16;
  #pragma unroll
  for(int d0=0;d0<4;++d0){
    const bf16x8 b0=*reinterpret_cast<const bf16x8*>(kb+d0*2048);
    const bf16x8 b1=*reinterpret_cast<const bf16x8*>(kb+d0*2048+512);
    if(d0==0){p0=__builtin_amdgcn_mfma_f32_32x32x16_bf16(b0,qr[0],negm,0,0,0);p1=__builtin_amdgcn_mfma_f32_32x32x16_bf16(b1,qr[0],negm,0,0,0);}
    else{p0=__builtin_amdgcn_mfma_f32_32x32x16_bf16(b0,qr[d0],p0,0,0,0);p1=__builtin_amdgcn_mfma_f32_32x32x16_bf16(b1,qr[d0],p1,0,0,0);}}
}
typedef __attribute__((address_space(3))) const char* lds_cptr;
typedef short v4i16_t __attribute__((ext_vector_type(4)));
__device__ __forceinline__ void kload8(bf16x8*kf,lds_cptr kp){
  kf[0]=*(const __attribute__((address_space(3))) bf16x8*)(kp);      kf[1]=*(const __attribute__((address_space(3))) bf16x8*)(kp+512);
  kf[2]=*(const __attribute__((address_space(3))) bf16x8*)(kp+2048); kf[3]=*(const __attribute__((address_space(3))) bf16x8*)(kp+2560);
  kf[4]=*(const __attribute__((address_space(3))) bf16x8*)(kp+4096); kf[5]=*(const __attribute__((address_space(3))) bf16x8*)(kp+4608);
  kf[6]=*(const __attribute__((address_space(3))) bf16x8*)(kp+6144); kf[7]=*(const __attribute__((address_space(3))) bf16x8*)(kp+6656);
}
__device__ __forceinline__ void kload2(bf16x8*kf,lds_cptr kp,int j){ kf[2*j]=*(const __attribute__((address_space(3))) bf16x8*)(kp+j*2048); kf[2*j+1]=*(const __attribute__((address_space(3))) bf16x8*)(kp+j*2048+512); }
__device__ __forceinline__ s16x4 vtr(lds_cptr p){ return __builtin_bit_cast(s16x4,__builtin_amdgcn_ds_read_tr16_b64_v4i16((__attribute__((address_space(3))) v4i16_t*)p)); }
__device__ __forceinline__ float rowmax(const f32x16&p0,const f32x16&p1){
  float a=max3f(p0[0],p0[1],p1[0]),b=max3f(p0[2],p0[3],p1[1]);a=max3f(a,p1[2],p1[3]);
  #pragma unroll
  for(int r=4;r<16;r+=4){a=max3f(a,p0[r],p0[r+1]);b=max3f(b,p0[r+2],p0[r+3]);a=max3f(a,p1[r],p1[r+1]);b=max3f(b,p1[r+2],p1[r+3]);}
  const float m=max2f(a,b);
  auto rr=__builtin_amdgcn_permlane32_swap(__float_as_uint(m),__float_as_uint(m),false,false);
  return max2f(__uint_as_float(rr[0]),__uint_as_float(rr[1]));
}
__device__ __forceinline__ void pv(f32x16*o,int vb,bf16x8 pa0,bf16x8 pa1,bf16x8 pa2,bf16x8 pa3){
  #pragma unroll
  for(int d0=0;d0<2;++d0){s16x4 lo[4],hi[4];
    #pragma unroll
    for(int ks=0;ks<4;++ks){
      asm volatile("ds_read_b64_tr_b16 %0,%1 offset:%c2":"=&v"(lo[ks]):"v"(vb),"i"(d0*4096+ks*1024):"memory");
      asm volatile("ds_read_b64_tr_b16 %0,%1 offset:%c2":"=&v"(hi[ks]):"v"(vb),"i"(d0*4096+ks*1024+512):"memory");}
    asm volatile("s_waitcnt lgkmcnt(0)":::"memory");SBAR();
    #define PK(k) (bf16x8){lo[k][0],lo[k][1],lo[k][2],lo[k][3],hi[k][0],hi[k][1],hi[k][2],hi[k][3]}
    o[d0]=__builtin_amdgcn_mfma_f32_32x32x16_bf16(pa0,PK(0),o[d0],0,0,0);
    o[d0]=__builtin_amdgcn_mfma_f32_32x32x16_bf16(pa1,PK(1),o[d0],0,0,0);
    o[d0]=__builtin_amdgcn_mfma_f32_32x32x16_bf16(pa2,PK(2),o[d0],0,0,0);
    o[d0]=__builtin_amdgcn_mfma_f32_32x32x16_bf16(pa3,PK(3),o[d0],0,0,0);
    #undef PK
  }
}

#ifndef ATTN_STORE16
#define ATTN_STORE16(p,v) (*(u32x4*)(p)=(v))
#endif
template<int THRL> __device__ __forceinline__ void attn_unit(int b,int h,int qb,const bf16*Q,const bf16*__restrict__ K,const bf16*__restrict__ V,bf16*O,char*shm,const __attribute__((address_space(3))) float*f2,const int tid){
  #define BIAS_H(P,off,g0) { f32x4 x_[2]; _Pragma("unroll") for(int g_=0;g_<2;++g_) x_[g_]=*(const __attribute__((address_space(3))) f32x4*)(fb_+(off)+8*((g0)+g_)); \
      _Pragma("unroll") for(int g_=0;g_<2;++g_) _Pragma("unroll") for(int i_=0;i_<4;++i_) P[4*((g0)+g_)+i_]-=x_[g_][i_]; asm volatile("":::"memory"); }
  #define BIAS(P0,P1,t) do{ const __attribute__((address_space(3))) float* fb_=f2+64*(t)+4*hi; \
    BIAS_H(P0,0,0) BIAS_H(P0,0,2) BIAS_H(P1,32,0) BIAS_H(P1,32,2) }while(0)
  const int lane=tid&63,r32=lane&31,hi=lane>>5; const int wid=__builtin_amdgcn_readfirstlane(tid>>6);
  const long rowbase=(long)b*SEQ; const int q0=qb*QB;
  const bf16*Qw=Q+(rowbase+q0+wid*QBLK)*DM+h*D;
  const bf16*Kh=K+rowbase*DM+h*D,*Vh=V+rowbase*DM+h*D;
  const unsigned lds0=(unsigned)(uintptr_t)shm;
  float*wsf=(float*)(shm+LDS_WS)+wid*64;
  const bf16*ksrc=Kh+(long)lane*DM+wid*8;
  const bf16*vsrc=Vh+(long)(16*(wid&3)+(lane>>2))*DM+(wid>>2)*32+(lane&3)*8;
  const unsigned kdst=lds0+LDS_K+wid*1024, vdst=lds0+LDS_V+wid*1024;
  #define DMA_K(t,slot) glds16(ksrc+(long)(t)*KVBLK*DM,(unsigned)__builtin_amdgcn_readfirstlane(kdst+(slot)))
  #define DMA_V(t,slot) glds16(vsrc+(long)(t)*KVBLK*DM,(unsigned)__builtin_amdgcn_readfirstlane(vdst+(slot)))
  const int vb0=(int)(lds0+LDS_V)+((lane>>4)&1)*32+(lane&3)*8+(4*hi+((lane&15)>>2))*64;
  const char*Kbase=shm+LDS_K; bf16x8 kf[8];
  const lds_cptr shm3=(lds_cptr)shm; const lds_cptr kp0=shm3+LDS_K+hi*1024+r32*16; const lds_cptr vp0=shm3+LDS_V+((lane>>4)&1)*32+(lane&3)*8+(4*hi+((lane&15)>>2))*64;
  const int NT=(q0+QB)/KVBLK;
  DMA_K(0,0);DMA_V(0,0);DMA_K(1,SLOTB);
  bf16x8 qr[4];
  #pragma unroll
  for(int d0=0;d0<4;++d0)qr[d0]=*reinterpret_cast<const bf16x8*>(&Qw[(long)r32*DM+d0*16+hi*8]);
  float mhat=0.f,l_reg=0.f;f32x16 o[2];f32x16 negm; { float z_=0.f; asm volatile("":"+v"(z_)); _Pragma("unroll") for(int r=0;r<16;++r){o[0][r]=z_;o[1][r]=z_;negm[r]=z_;} } asm volatile("":"+v"(negm));
  const int qrel=wid*QBLK+r32;
  #define CMASK(P0,P1,t) do{int jb_=(t)-(NT-4); if(jb_>=0)cmask(P0,P1,jb_,qrel,hi);}while(0)
  bool resc=false;
  #define START(P0,P1) do{ const float rm=rowmax(P0,P1); resc=false; \
    { const float dl=rm; mhat=fadd_s(mhat,dl); \
      _Pragma("unroll") for(int r=0;r<16;++r){P0[r]=fsub_s(P0[r],dl);P1[r]=fsub_s(P1[r],dl);} \
      _Pragma("unroll") for(int r=0;r<16;++r)negm[r]=-mhat; asm volatile("":"+v"(negm)); } \
    _Pragma("unroll") for(int r=0;r<16;++r)P0[r]=__builtin_amdgcn_exp2f(P0[r]); }while(0)
  #define RESC() do{ if(resc){ asm volatile("s_waitcnt lgkmcnt(0)":::"memory"); \
      _Pragma("unroll") for(int d_=0;d_<2;++d_) _Pragma("unroll") for(int r=0;r<16;++r)o[d_][r]*=wsf[crow(r,hi)]; } }while(0)
  f32x16 pA0,pA1,pB0,pB1;
  int sl_prev=0,sl_cur=0,sl_next=SLOTB;
  #define ROT() do{sl_prev=sl_cur;sl_cur=sl_next;sl_next=(sl_next==(NSLOT-1)*SLOTB)?0:sl_next+SLOTB;}while(0)
  DMA_K(2,2*SLOTB);
  WAIT_BAR(3);
  qkt(pA0,pA1,Kbase,qr,negm,r32,hi);asm volatile("s_nop 15\n\ts_nop 7":"+v"(pA0),"+v"(pA1));CMASK(pA0,pA1,0);BIAS(pA0,pA1,0);
  START(pA0,pA1);
  _Pragma("unroll") for(int r=0;r<16;++r)pA1[r]=__builtin_amdgcn_exp2f(pA1[r]);
  WAIT_BAR(0);
  DMA_K(3,0);DMA_V(1,SLOTB);
  ROT();
  kload8(kf,kp0+sl_cur);
  WAIT_BAR(2);
  s16x4 vlo[8],vhi[8]; u32x4 pw0,pw1,pw2,pw3;
  #define PKW(P,B) cvtpk_s(P[B],P[B+1])
  #define PAF(k) __builtin_bit_cast(bf16x8,pw##k)
  #define VFR(i) (bf16x8){vlo[i][0],vlo[i][1],vlo[i][2],vlo[i][3],vhi[i][0],vhi[i][1],vhi[i][2],vhi[i][3]}
  #define PIN(x) asm volatile("":"+v"(x))
  #define MX3(a,b,c) __builtin_fmaxf(__builtin_fmaxf((a),(b)),(c))
  #define GAPA(MF,A0,A1,A2,A3,W0,W1,PW) do{ MF; sacc+=A0; sacc+=A1; sacc+=A2; sacc+=A3; PIN(sacc); W0; W1; PIN(PW); SBAR(); }while(0)
  #define EX(v) __builtin_amdgcn_exp2f(v)
  #define GAPB(MF,X,B) do{ MF; X[B]=EX(X[B]); X[B+1]=EX(X[B+1]); X[B+2]=EX(X[B+2]); X[B+3]=EX(X[B+3]); PIN(X); SBAR(); }while(0)
  #define VRD(i) do{ vlo[i]=vtr(vp_+(((i)>>2)*4096+((i)&3)*1024)); vhi[i]=vtr(vp_+(((i)>>2)*4096+((i)&3)*1024+512)); }while(0)
  #define KRD(G,j) do{ if(G){ kload2(kf,kp0+sl_next,j); SBAR(); } }while(0)
  #define STEP(C0,C1,P0,P1,t,GK,GV,GL) do{ SBAR(); \
    const lds_cptr vp_=vp0+sl_prev; \
    VRD(0); SBAR(); float sacc=(P0[0]+P0[1]); \
    GAPA(C0=__builtin_amdgcn_mfma_f32_32x32x16_bf16(kf[0],qr[0],negm,0,0,0), P0[2],P0[3],P0[4],P0[5],     pw0[0]=PKW(P0,0), pw0[1]=PKW(P0,2), pw0); \
    VRD(4); SBAR(); GAPA(C1=__builtin_amdgcn_mfma_f32_32x32x16_bf16(kf[1],qr[0],negm,0,0,0), P0[6],P0[7],P0[8],P0[9],     pw0[2]=PKW(P0,4), pw0[3]=PKW(P0,6), pw0); \
    VRD(1); SBAR(); GAPA(C0=__builtin_amdgcn_mfma_f32_32x32x16_bf16(kf[2],qr[1],C0,0,0,0),   P0[10],P0[11],P0[12],P0[13], pw1[0]=PKW(P0,8), pw1[1]=PKW(P0,10), pw1); \
    VRD(5); SBAR(); GAPA(C1=__builtin_amdgcn_mfma_f32_32x32x16_bf16(kf[3],qr[1],C1,0,0,0),   P0[14],P0[15],P1[0],P1[1],   pw1[2]=PKW(P0,12),pw1[3]=PKW(P0,14), pw1); \
    VRD(2); SBAR(); GAPA(C0=__builtin_amdgcn_mfma_f32_32x32x16_bf16(kf[4],qr[2],C0,0,0,0),   P1[2],P1[3],P1[4],P1[5],     pw2[0]=PKW(P1,0), pw2[1]=PKW(P1,2), pw2); \
    VRD(6); SBAR(); GAPA(C1=__builtin_amdgcn_mfma_f32_32x32x16_bf16(kf[5],qr[2],C1,0,0,0),   P1[6],P1[7],P1[8],P1[9],     pw2[2]=PKW(P1,4), pw2[3]=PKW(P1,6), pw2); \
    VRD(3); SBAR(); GAPA(C0=__builtin_amdgcn_mfma_f32_32x32x16_bf16(kf[6],qr[3],C0,0,0,0),   P1[10],P1[11],P1[12],P1[13], pw3[0]=PKW(P1,8), pw3[1]=PKW(P1,10), pw3); \
    VRD(7); SBAR(); GAPA(C1=__builtin_amdgcn_mfma_f32_32x32x16_bf16(kf[7],qr[3],C1,0,0,0),   P1[14],P1[15],0.f,0.f,       pw3[2]=PKW(P1,12),pw3[3]=PKW(P1,14), pw3); \
    l_reg+=sacc; \
    if(GK){DMA_K((t)+3,sl_cur);} if(GV){DMA_V((t)+1,sl_next);} \
    CMASK(C0,C1,t); BIAS(C0,C1,t); \
    { float a=MX3(C0[0],C0[1],C1[0]),b=MX3(C0[2],C0[3],C1[1]); a=MX3(a,C1[2],C1[3]); \
      _Pragma("unroll") for(int r=4;r<16;r+=4){a=MX3(a,C0[r],C0[r+1]);b=MX3(b,C0[r+2],C0[r+3]);a=MX3(a,C1[r],C1[r+1]);b=MX3(b,C1[r+2],C1[r+3]);} \
      float rm=__builtin_fmaxf(a,b); { auto rr=__builtin_amdgcn_permlane32_swap(__float_as_uint(rm),__float_as_uint(rm),false,false); rm=__builtin_fmaxf(__uint_as_float(rr[0]),__uint_as_float(rr[1])); } \
      resc=false; \
      if(__builtin_expect(__any(rm>(float)THRL),0)){ const float dl=__builtin_fmaxf(rm,0.f); mhat+=dl; \
        _Pragma("unroll") for(int r=0;r<16;++r){C0[r]-=dl;C1[r]-=dl;} \
        _Pragma("unroll") for(int r=0;r<16;++r)negm[r]=-mhat; asm volatile("":"+v"(negm)); \
        const float f=__builtin_amdgcn_exp2f(-dl); l_reg*=f; if(hi==0)wsf[r32]=f; resc=true; } } \
    SBAR(); \
    GAPB(o[0]=__builtin_amdgcn_mfma_f32_32x32x16_bf16(PAF(0),VFR(0),o[0],0,0,0), C0,0); \
    GAPB(o[1]=__builtin_amdgcn_mfma_f32_32x32x16_bf16(PAF(0),VFR(4),o[1],0,0,0), C0,4); \
    KRD(GL,0); GAPB(o[0]=__builtin_amdgcn_mfma_f32_32x32x16_bf16(PAF(1),VFR(1),o[0],0,0,0), C0,8); \
    KRD(GL,1); GAPB(o[1]=__builtin_amdgcn_mfma_f32_32x32x16_bf16(PAF(1),VFR(5),o[1],0,0,0), C0,12); \
    KRD(GL,2); GAPB(o[0]=__builtin_amdgcn_mfma_f32_32x32x16_bf16(PAF(2),VFR(2),o[0],0,0,0), C1,0); \
    KRD(GL,3); GAPB(o[1]=__builtin_amdgcn_mfma_f32_32x32x16_bf16(PAF(2),VFR(6),o[1],0,0,0), C1,4); \
    GAPB(o[0]=__builtin_amdgcn_mfma_f32_32x32x16_bf16(PAF(3),VFR(3),o[0],0,0,0), C1,8); \
    GAPB(o[1]=__builtin_amdgcn_mfma_f32_32x32x16_bf16(PAF(3),VFR(7),o[1],0,0,0), C1,12); \
    }while(0)
  int t=1;
  #undef CMASK
  #define CMASK(P0,P1,t) do{}while(0)
  for(;t+5<NT;t+=2){
    STEP(pB0,pB1,pA0,pA1,t,true,true,true);     WAIT_BAR(2); RESC(); ROT();
    STEP(pA0,pA1,pB0,pB1,t+1,true,true,true);   WAIT_BAR(2); RESC(); ROT();
  }
  #undef CMASK
  #define CMASK(P0,P1,t) do{int jb_=(t)-(NT-4); if(jb_>=0)cmask(P0,P1,jb_,qrel,hi);}while(0)
  #define ENDW(tt) do{ if((tt)+3<NT){WAIT_BAR(2);} else if((tt)+2<NT){WAIT_BAR(1);} else {WAIT_BAR(0);} }while(0)
  for(;t+1<NT;t+=2){
    STEP(pB0,pB1,pA0,pA1,t,(t+3<NT),(t+1<NT),(t+1<NT));       ENDW(t);   RESC(); ROT();
    STEP(pA0,pA1,pB0,pB1,t+1,(t+4<NT),(t+2<NT),(t+2<NT));     ENDW(t+1); RESC(); ROT();
  }
  STEP(pB0,pB1,pA0,pA1,NT-1,false,false,false); RESC();
  { float sacc=pB0[0]+pB0[1]; _Pragma("unroll") for(int r=2;r<16;++r)sacc+=pB0[r]; _Pragma("unroll") for(int r=0;r<16;++r)sacc+=pB1[r]; l_reg+=sacc;
    pw0=(u32x4){PKW(pB0,0),PKW(pB0,2),PKW(pB0,4),PKW(pB0,6)};pw1=(u32x4){PKW(pB0,8),PKW(pB0,10),PKW(pB0,12),PKW(pB0,14)};pw2=(u32x4){PKW(pB1,0),PKW(pB1,2),PKW(pB1,4),PKW(pB1,6)};pw3=(u32x4){PKW(pB1,8),PKW(pB1,10),PKW(pB1,12),PKW(pB1,14)};
    SBAR(); pv(o,vb0+sl_cur,PAF(0),PAF(1),PAF(2),PAF(3)); }
  #undef PKW
  #undef PAF
  #undef VFR
  #undef PIN
  #undef MX3
  #undef GAPA
  #undef GAPB
  #undef EX
  #undef VRD
  #undef KRD
  #undef STEP
  #undef ENDW
  {auto rr=__builtin_amdgcn_permlane32_swap(__float_as_uint(l_reg),__float_as_uint(l_reg),false,false);l_reg=__uint_as_float(rr[0])+__uint_as_float(rr[1]);}
  if(hi==0)wsf[32+r32]=l_reg;asm volatile("s_waitcnt lgkmcnt(0)":::"memory");
  float rli[16];
  #pragma unroll
  for(int r=0;r<16;++r)rli[r]=__builtin_amdgcn_rcpf(wsf[32+crow(r,hi)]);
  { bf16*stg=(bf16*)(shm+LDS_OST)+wid*2048;
    #pragma unroll
    for(int r=0;r<16;++r){const int orow=crow(r,hi);
      #pragma unroll
      for(int d0=0;d0<2;++d0)stg[orow*64+d0*32+r32]=__float2bfloat16(o[d0][r]*rli[r]);}
    asm volatile("s_waitcnt lgkmcnt(0)":::"memory");
    unsigned char*O8w=(unsigned char*)O+(rowbase+q0+wid*QBLK)*DM+h*D;
    _Pragma("unroll") for(int i=0;i<4;++i){const int row=i*8+(lane>>3),ch=lane&7; const u32x4 v=*(const u32x4*)(stg+row*64+ch*8);
      u32x2 w8; w8.x=pg8::pack4_fp8(bflo(v.x)*SC_FOX,bfhi(v.x)*SC_FOX,bflo(v.y)*SC_FOX,bfhi(v.y)*SC_FOX); w8.y=pg8::pack4_fp8(bflo(v.z)*SC_FOX,bfhi(v.z)*SC_FOX,bflo(v.w)*SC_FOX,bfhi(v.w)*SC_FOX);
      *(u32x2*)(O8w+(long)row*DM+ch*8)=w8;} }
  asm volatile("s_waitcnt lgkmcnt(0)\n\ts_barrier":::"memory");
  #undef BIAS
  #undef BIAS_H
  #undef DMA_K
  #undef DMA_V
  #undef CMASK
  #undef START
  #undef RESC
  #undef ROT
}
constexpr int ATTN_LDS_BYTES=LDS_BYTES;
#undef SBAR
#undef WAIT_BAR
}


constexpr int NWAVES = 8;
constexpr int RING_OFF = 0, RING_BYTES = 131072;
constexpr int LDSCTL_OFF = RING_BYTES, MISC_OFF = LDSCTL_OFF + 320, TAB_OFF = LDSCTL_OFF + 1024;
constexpr int WTAB_OFF = LDSCTL_OFF + 2048;
constexpr int LDS_BYTES = 147456;
typedef GAS unsigned gu32;
__device__ __forceinline__ unsigned hw_wave_key() { return (unsigned)__builtin_amdgcn_s_getreg((5 << 11) | 4) & 63u; }
#define RLX_AGENT __ATOMIC_RELAXED, __HIP_MEMORY_SCOPE_AGENT

#define XB_TMO      128
#define XB_XCNT(j)  (256  + 64 * (j))
#define XB_XSUB(j)  (1280 + 64 * (j))
#define XB_XGEN(j)  (2304 + 64 * (j))
#define XB_TOP      3328
#define XB_TOPGEN   3392
#define XCD_BAR_WORDS 3456
#define XB_SPIN_CAP (1u << 18)

__device__ __forceinline__ unsigned xb_ld(unsigned* p)              { return __hip_atomic_load(p, __ATOMIC_RELAXED, __HIP_MEMORY_SCOPE_AGENT); }
__device__ __forceinline__ unsigned xb_add(unsigned* p, unsigned v) { return __hip_atomic_fetch_add(p, v, __ATOMIC_RELAXED, __HIP_MEMORY_SCOPE_AGENT); }
__device__ __forceinline__ unsigned xb_xcc_id() { return (unsigned)__builtin_amdgcn_s_getreg((3 << 11) | 20) & 0xFu; }
#define XB_SPIN(cond, bar) do { unsigned _sp = 0; while (cond) { __builtin_amdgcn_s_sleep(1); \
    if ((++_sp & 255u) == 0u) { if (xb_ld(&(bar)[XB_TMO])) break; if (_sp > XB_SPIN_CAP) { atomicAdd(&(bar)[XB_TMO], 1u); break; } } } } while (0)

struct XcdBarrier {
    unsigned* bar; unsigned x;
    volatile LAS unsigned* st;
};

__device__ __forceinline__ XcdBarrier xcd_barrier_post(unsigned* bar, volatile LAS unsigned* st) {
    XcdBarrier b; b.bar = bar; b.x = xb_xcc_id(); b.st = st;
    if (threadIdx.x == 0) (void)xb_add(&bar[XB_XCNT(b.x)], 1u);
    return b;
}
__device__ __forceinline__ void xcd_barrier_complete(unsigned* bar, unsigned x, unsigned& nloc, unsigned& nx) {
    const unsigned G = gridDim.x * gridDim.y * gridDim.z;
    unsigned sum, cnt, mine, sp = 0u;
    for (;;) {
        sum = 0u; cnt = 0u; mine = 0u;
#pragma unroll
        for (unsigned j = 0; j < 16; ++j) { const unsigned c = xb_ld(&bar[XB_XCNT(j)]); sum += c; cnt += (c > 0u) ? 1u : 0u; mine = (j == x) ? c : mine; }
        if (sum == G) break;
        __builtin_amdgcn_s_sleep(1);
        if ((++sp & 255u) == 0u) { if (xb_ld(&bar[XB_TMO])) break; if (sp > XB_SPIN_CAP) { atomicAdd(&bar[XB_TMO], 1u); break; } }
    }
    nloc = mine > 0u ? mine : 1u; nx = cnt > 0u ? cnt : 1u;
}

__device__ __forceinline__ void xcd_barrier(const XcdBarrier& b) {
    asm volatile("s_waitcnt vmcnt(0)" ::: "memory");
    __syncthreads();
    if (threadIdx.x == 0) {
        unsigned* bar = b.bar;
        __builtin_amdgcn_s_waitcnt(0);
        unsigned nloc = b.st[0], nx = b.st[1];
        if (nloc == 0u) { xcd_barrier_complete(bar, b.x, nloc, nx); b.st[0] = nloc; b.st[1] = nx; }
        const unsigned old = xb_add(&bar[XB_XSUB(b.x)], 1u);
        const unsigned gen = old / nloc;
        if (old + 1u == (gen + 1u) * nloc) {
            __builtin_amdgcn_fence(__ATOMIC_RELEASE, "agent");
            asm volatile("s_waitcnt vmcnt(0)" ::: "memory");
            const unsigned og = xb_add(&bar[XB_TOP], 1u);
            const unsigned tg = og / nx;
            if (og + 1u == (tg + 1u) * nx) xb_add(&bar[XB_TOPGEN], 1u);
            else XB_SPIN(xb_ld(&bar[XB_TOPGEN]) == tg, bar);
            __builtin_amdgcn_fence(__ATOMIC_ACQUIRE, "agent");
            xb_add(&bar[XB_XGEN(b.x)], 1u);
            asm volatile("s_waitcnt vmcnt(0)" ::: "memory");
        } else {
            XB_SPIN(xb_ld(&bar[XB_XGEN(b.x)]) == gen, bar);
            __builtin_amdgcn_fence(__ATOMIC_ACQUIRE, "agent");
            asm volatile("s_waitcnt vmcnt(0)" ::: "memory");
        }
    }
    __syncthreads();
}


struct Args {
    const float *x, *ln_in_g, *ln_in_b, *w_in, *b_in, *w_fox, *lbl, *norm_g, *w_hgrn, *w_mix, *b_mix, *ln1_g, *ln1_b, *router_w, *router_b, *w1, *w3, *w2, *ln2_g, *ln2_b;
    float* out; unsigned char* ws; int ph_lo, ph_hi, use_bar, pad;
};
struct Frame { LAS unsigned char* lds; int tid, lane, wave, G, gw, ngw, bid; };
#define LOAD_ARGS() launder_args(args)
__device__ __forceinline__ Args launder_args(const Args& args) { Args a = args; size_t z_ = 0; asm volatile("" : "+s"(z_)); a.ws = args.ws + z_; return a; }

__device__ __forceinline__ void ln_rows16(f32x4 (&v)[4], const float* g, const float* bta, int lane) {
    float s = 0.f;
#pragma unroll
    for (int j = 0; j < 4; ++j) s += (v[j].x + v[j].y) + (v[j].z + v[j].w);
    const float mean = wave_sum(s) * (1.f / D); float s2 = 0.f;
#pragma unroll
    for (int j = 0; j < 4; ++j) { v[j] = v[j] - mean; s2 += (v[j].x * v[j].x + v[j].y * v[j].y) + (v[j].z * v[j].z + v[j].w * v[j].w); }
    const float rstd = rsqrtf(wave_sum(s2) * (1.f / D) + LN_EPS);
#pragma unroll
    for (int j = 0; j < 4; ++j) { const int c = 4 * lane + 256 * j; const f32x4 gg = *(const f32x4*)(g + c), bb = *(const f32x4*)(bta + c); v[j] = v[j] * rstd * gg + bb; }
}
__device__ __forceinline__ void store_row(const f32x4 (&v)[4], int lane, float* of32, unsigned char* obf, float* of32b) {
#pragma unroll
    for (int j = 0; j < 4; ++j) { const int c = 4 * lane + 256 * j;
        if (of32) *(f32x4*)(of32 + c) = v[j];
        if (of32b) *(f32x4*)(of32b + c) = v[j];
        if (obf) *(unsigned*)(obf + c) = pg8::pack4_fp8(v[j].x, v[j].y, v[j].z, v[j].w); }
}

__device__ __forceinline__ void cvt_item(const float* W, int ldw, int k0, int srccol, int nvalid, unsigned char* WT, int ldt, int dstrow, int dstk, LAS float* scr, int lane) {
    const int ks = lane >> 3, n4 = (lane & 7) * 4;
    f32x4 v[8];
#pragma unroll
    for (int j = 0; j < 8; ++j) v[j] = (n4 < nvalid) ? *(const f32x4*)(W + (size_t)(k0 + 8 * j + ks) * ldw + srccol + n4) : (f32x4){0.f, 0.f, 0.f, 0.f};
#pragma unroll
    for (int j = 0; j < 8; ++j) { LAS float* d = scr + (8 * j + ks) * 33 + n4; d[0] = v[j][0]; d[1] = v[j][1]; d[2] = v[j][2]; d[3] = v[j][3]; }
    asm volatile("s_waitcnt lgkmcnt(0)" ::: "memory");
    const int c = lane & 7;
#pragma unroll
    for (int j = 0; j < 4; ++j) { const int n = (lane >> 3) + 8 * j; const LAS float* s = scr + (8 * c) * 33 + n;
        u32x2 o; o.x = pg8::pack4_fp8(s[0 * 33] * SC_W, s[1 * 33] * SC_W, s[2 * 33] * SC_W, s[3 * 33] * SC_W); o.y = pg8::pack4_fp8(s[4 * 33] * SC_W, s[5 * 33] * SC_W, s[6 * 33] * SC_W, s[7 * 33] * SC_W);
        *(u32x2*)(WT + (size_t)(dstrow + n) * ldt + dstk + k0 + 8 * c) = o; }
    asm volatile("s_waitcnt lgkmcnt(0)" ::: "memory");
}
__device__ __forceinline__ void convert_layer(const Args& a, const Frame& F, int l, int gw, int ngw) {
    LAS float* scr = (LAS float*)(F.lds + RING_OFF + F.wave * 16384);
    const int lane = F.lane;
    unsigned char* WS_ = a.ws + wset(l); unsigned char* WIN = WS_ + WO_WIN; unsigned char* WBR = WS_ + WO_WBR; unsigned char* WMIX = WS_ + WO_WMIX;
    unsigned char* W13 = WS_ + WO_W13; unsigned char* W2 = WS_ + WO_W2;
    constexpr int I_IN = 16 * 184, I_BR = 8 * 32, I_MIX = 16 * 32, I_13 = 16 * 64 * NE, I_2 = 16 * 32 * NE;
    constexpr int NITEMS = I_IN + 2 * I_BR + I_MIX + I_13 + I_2;
    for (int it = gw; it < NITEMS; it += ngw) {
        int r = it;
        if (r < I_IN) { const int kb = r / 184, nb = r % 184, n0 = nb * 32;
            int src, nv = 32; if (n0 < 1536) src = n0; else if (n0 < 5632) src = n0 + 8; else if (n0 == 5632) { src = 1536; nv = 8; } else { src = 0; nv = 0; }
            cvt_item(a.w_in + (size_t)l * D * NIN, NIN, kb * 64, src, nv, WIN, D, n0, 0, scr, lane); continue; } r -= I_IN;
        if (r < I_BR) { const int kb = r / 32, nb = r % 32; cvt_item(a.w_fox + (size_t)l * 512 * D, D, kb * 64, nb * 32, 32, WBR, D, nb * 32, 0, scr, lane); continue; } r -= I_BR;
        if (r < I_BR) { const int kb = r / 32, nb = r % 32; cvt_item(a.w_hgrn + (size_t)l * 512 * D, D, kb * 64, nb * 32, 32, WBR, D, nb * 32, 512, scr, lane); continue; } r -= I_BR;
        if (r < I_MIX) { const int kb = r / 32, nb = r % 32; cvt_item(a.w_mix + (size_t)l * D * D, D, kb * 64, nb * 32, 32, WMIX, D, nb * 32, 0, scr, lane); continue; } r -= I_MIX;
        if (r < I_13) { const int e = r / 1024, q = r % 1024, kb = q / 64, nb = q % 64, n0 = nb * 32;
            const int j = n0 >> 8, rr = n0 & 255; const float* src = (rr < 128 ? a.w1 : a.w3) + ((size_t)l * NE + e) * D * D;
            cvt_item(src, D, kb * 64, 128 * j + (rr & 127), 32, W13 + (size_t)e * 2048 * D, D, n0, 0, scr, lane); continue; } r -= I_13;
        { const int e = r / 512, q = r % 512, kb = q / 32, nb = q % 32;
            cvt_item(a.w2 + ((size_t)l * NE + e) * D * D, D, kb * 64, nb * 32, 32, W2 + (size_t)e * D * D, D, nb * 32, 0, scr, lane); }
    }
    float* biasp = (float*)(a.ws + biasoff(l));
    for (int n = gw * 64 + lane; n < NINP; n += ngw * 64) {
        float v = 0.f; if (n < 1536) v = a.b_in[l * NIN + n]; else if (n < 5632) v = a.b_in[l * NIN + n + 8]; else if (n < 5640) v = a.b_in[l * NIN + 1536 + (n - 5632)];
        biasp[n] = v; }
}

__device__ __forceinline__ void phase_prep(const Args& a, const Frame& F) {
    if (F.bid == 0) {
        float* lb_all = (float*)(a.ws + WS_MISC);
        const int c = F.tid;
        float v[DEPTH], m = -1e30f;
#pragma unroll
        for (int l = 0; l < DEPTH; ++l) { v[l] = a.lbl[l * 512 + c]; m = fmaxf(m, v[l]); }
        float s = 0.f;
#pragma unroll
        for (int l = 0; l < DEPTH; ++l) { v[l] = __expf(v[l] - m); s += v[l]; }
        float cum = 0.f;
#pragma unroll
        for (int l = 0; l < DEPTH; ++l) { const float p = v[l] / s; cum += p; lb_all[l * 512 + c] = cum - v[0] / s; }
    }
    float* XRES = (float*)(a.ws + WS_XRES); unsigned char* XN = a.ws + WS_XN;
    for (int row = F.gw; row < T; row += F.ngw) {
        f32x4 v[4];
#pragma unroll
        for (int j = 0; j < 4; ++j) v[j] = *(const f32x4*)(a.x + (size_t)row * D + 4 * F.lane + 256 * j);
        ln_rows16(v, a.ln_in_g, a.ln_in_b, F.lane);
        store_row(v, F.lane, XRES + (size_t)row * D, XN + (size_t)row * D, nullptr);
    }
    convert_layer(a, F, 0, F.gw, F.ngw);
}

__device__ __forceinline__ void phase_fscan(const Args& a, const Frame& F) {
    if (F.bid >= BATCH * NH) return;
    const float* FL = (const float*)(a.ws + WS_FL); float* F2 = (float*)(a.ws + WS_F2);
    LAS float* wsum = (LAS float*)(F.lds + RING_OFF);
    const int bh = F.bid, b = bh >> 3, h = bh & 7, tid = F.tid, lane = F.lane, w = F.wave;
    float v[4], run = 0.f;
#pragma unroll
    for (int i = 0; i < 4; ++i) { run += FL[((size_t)b * SEQ + tid * 4 + i) * 8 + h]; v[i] = run; }
    float incl = run;
#pragma unroll
    for (int o = 1; o < 64; o <<= 1) { const float u = __shfl_up(incl, o); if (lane >= o) incl += u; }
    if (lane == 63) wsum[w] = incl;
    __syncthreads();
    float base = incl - run; for (int i = 0; i < w; ++i) base += wsum[i];
#pragma unroll
    for (int i = 0; i < 4; ++i) F2[(size_t)bh * SEQ + tid * 4 + i] = (base + v[i]) * LOG2E;
    __syncthreads();
}

__device__ __forceinline__ void phase_attn_naive(const Args& a, const Frame& F) {
    const bf16_t* QO = (const bf16_t*)(a.ws + WS_QO); const bf16_t* KV = (const bf16_t*)(a.ws + WS_KV); const float* F2 = (const float*)(a.ws + WS_F2); bf16_t* O = (bf16_t*)(a.ws + WS_QO);
    LAS float* ps = (LAS float*)(F.lds + RING_OFF) + F.wave * 64;
    const int lane = F.lane;
    for (int gid = F.gw; gid < BATCH * NH * SEQ; gid += F.ngw) {
        const int bh = gid & 127, t = gid >> 7, b = bh >> 3, h = bh & 7;
        float q[64];
        { const bf16_t* qp = QO + ((size_t)b * SEQ + t) * 1024 + h * 64;
#pragma unroll
          for (int c = 0; c < 8; ++c) { const u32x4 u = *(const u32x4*)(qp + c * 8);
            q[c * 8 + 0] = bflo(u.x); q[c * 8 + 1] = bfhi(u.x); q[c * 8 + 2] = bflo(u.y); q[c * 8 + 3] = bfhi(u.y);
            q[c * 8 + 4] = bflo(u.z); q[c * 8 + 5] = bfhi(u.z); q[c * 8 + 6] = bflo(u.w); q[c * 8 + 7] = bfhi(u.w); } }
        float m = -1e30f, l = 0.f, o = 0.f;
        const float* f2 = F2 + (size_t)bh * SEQ;
        for (int s0 = 0; s0 <= t; s0 += 64) {
            const int s = s0 + lane; const bool valid = s <= t;
            float sc = -1e30f;
            if (valid) { const bf16_t* kp = KV + ((size_t)b * SEQ + s) * 1024 + h * 64; float d = 0.f;
#pragma unroll
                for (int c = 0; c < 8; ++c) { const u32x4 u = *(const u32x4*)(kp + c * 8);
                    d += q[c * 8 + 0] * bflo(u.x) + q[c * 8 + 1] * bfhi(u.x) + q[c * 8 + 2] * bflo(u.y) + q[c * 8 + 3] * bfhi(u.y)
                       + q[c * 8 + 4] * bflo(u.z) + q[c * 8 + 5] * bfhi(u.z) + q[c * 8 + 6] * bflo(u.w) + q[c * 8 + 7] * bfhi(u.w); }
                sc = d - f2[s]; }
            const float mn = fmaxf(m, wave_max(sc));
            const float p = valid ? exp2f(sc - mn) : 0.f;
            const float f = exp2f(m - mn);
            l = l * f + wave_sum(p); o *= f; m = mn;
            ps[lane] = p;
            asm volatile("s_waitcnt lgkmcnt(0)" ::: "memory");
            const int nk = min(64, t - s0 + 1);
            const bf16_t* vp = KV + ((size_t)b * SEQ + s0) * 1024 + 512 + h * 64 + lane;
            for (int j = 0; j < nk; ++j) o += ps[j] * bf2f(vp[(size_t)j * 1024]);
            asm volatile("s_waitcnt lgkmcnt(0)" ::: "memory");
        }
        O[((size_t)b * SEQ + t) * 1024 + h * 64 + lane] = (bf16_t)f2bf(o / l);
    }
}

__device__ __forceinline__ void phase_hgrn_naive(const Args& a, const Frame& F, int l) {
    if (F.bid >= BATCH * NH || F.wave != 0) return;
    const bf16_t* HB = (const bf16_t*)(a.ws + WS_HB); const float* LOGF = (const float*)(a.ws + WS_LOGF); const bf16_t* HG = (const bf16_t*)(a.ws + WS_HG); bf16_t* O = (bf16_t*)(a.ws + WS_QO);
    LAS float* Lf = (LAS float*)(F.lds + RING_OFF + 1024); LAS float* Lk = Lf + 4096; LAS float* Lq = Lk + 4096;
    const int bh = F.bid, b = bh >> 3, h = bh & 7, lane = F.lane;
    float Sx[64];
#pragma unroll
    for (int d = 0; d < 64; ++d) Sx[d] = 0.f;
    const float ng = a.norm_g[l * 512 + h * 64 + lane];
    for (int c0 = 0; c0 < SEQ; c0 += 64) {
        for (int tt = 0; tt < 64; ++tt) { const size_t row = (size_t)b * SEQ + c0 + tt;
            const float lf = LOGF[row * 512 + h * 64 + lane]; const float f = __expf(lf);
            Lf[tt * 64 + lane] = f; Lk[tt * 64 + lane] = 1.f - f; Lq[tt * 64 + lane] = bf2f(HB[row * 1024 + h * 64 + lane]); }
        asm volatile("s_waitcnt lgkmcnt(0)" ::: "memory");
        for (int tt = 0; tt < 64; ++tt) { const size_t row = (size_t)b * SEQ + c0 + tt;
            const float v = bf2f(HB[row * 1024 + 512 + h * 64 + lane]);
            float o = 0.f;
#pragma unroll
            for (int d = 0; d < 64; d += 4) { const f32x4 f4 = *(const LAS f32x4*)(Lf + tt * 64 + d), k4 = *(const LAS f32x4*)(Lk + tt * 64 + d), q4 = *(const LAS f32x4*)(Lq + tt * 64 + d);
                Sx[d] = f4.x * Sx[d] + k4.x * v; o += Sx[d] * q4.x; Sx[d + 1] = f4.y * Sx[d + 1] + k4.y * v; o += Sx[d + 1] * q4.y;
                Sx[d + 2] = f4.z * Sx[d + 2] + k4.z * v; o += Sx[d + 2] * q4.z; Sx[d + 3] = f4.w * Sx[d + 3] + k4.w * v; o += Sx[d + 3] * q4.w; }
            const float ss = wave_sum(o * o);
            const float r = o * rsqrtf(ss * (1.f / 64.f) + RMS_EPS) * ng * bf2f(HG[row * 512 + h * 64 + lane]);
            O[row * 1024 + 512 + h * 64 + lane] = (bf16_t)f2bf(r); }
        asm volatile("s_waitcnt lgkmcnt(0)" ::: "memory");
    }
}

constexpr int LN1_RW = 0, LN1_LG = 65536, LN1_ASG = LN1_LG + 8 * 16 * 16 * 4, LN1_BASE = LN1_ASG + 128 * 16;
__device__ __forceinline__ void phase_ln1_router(const Args& a, const Frame& F, int l) {
    const float* xres = (const float*)(a.ws + WS_XRES); float* x1 = a.out; const bf16_t* mixed = (const bf16_t*)(a.ws + WS_MIXED); unsigned char* xn = a.ws + WS_XN;
    unsigned* cnt = (unsigned*)(a.ws + WS_CTL) + CW_CNT + l * 64; int* list = (int*)(a.ws + WS_LIST); unsigned* tokinfo = (unsigned*)(a.ws + WS_TOK);
    const float* g = a.ln1_g + l * D; const float* bta = a.ln1_b + l * D;
    LAS float* rw = (LAS float*)(F.lds + RING_OFF + LN1_RW);
    LAS float* lgs = (LAS float*)(F.lds + RING_OFF + LN1_LG) + F.wave * 256;
    LAS u32x4* asg = (LAS u32x4*)(F.lds + RING_OFF + LN1_ASG);
    LAS unsigned* basep = (LAS unsigned*)(F.lds + RING_OFF + LN1_BASE);
    for (int i = F.tid; i < NE * D; i += NWAVES * 64) { const int c = i >> 4, e = i & 15; rw[e * D + c] = a.router_w[i]; }
    __syncthreads();
    const int lane = F.lane;
    for (int blk = F.bid; blk < T / 128; blk += F.G) {
        const int R0 = blk * 128 + F.wave * 16;
        for (int i = 0; i < 16; ++i) { const int row = R0 + i;
            f32x4 v[4];
#pragma unroll
            for (int j = 0; j < 4; ++j) { const int c = 4 * lane + 256 * j; const f32x4 xv = *(const f32x4*)(xres + (size_t)row * D + c);
                const u32x2 mm = *(const u32x2*)(mixed + (size_t)row * D + c);
                v[j].x = ALPHA * xv.x + bflo(mm.x); v[j].y = ALPHA * xv.y + bfhi(mm.x); v[j].z = ALPHA * xv.z + bflo(mm.y); v[j].w = ALPHA * xv.w + bfhi(mm.y); }
            ln_rows16(v, g, bta, lane);
            store_row(v, lane, x1 + (size_t)row * D, xn + (size_t)row * D, nullptr);
            float p[NE];
#pragma unroll
            for (int e = 0; e < NE; ++e) { float s = 0.f;
#pragma unroll
                for (int j = 0; j < 4; ++j) { const f32x4 r4 = *(const LAS f32x4*)(rw + e * D + 4 * lane + 256 * j); s += v[j].x * r4.x + v[j].y * r4.y + v[j].z * r4.z + v[j].w * r4.w; }
                p[e] = s; asm volatile("" ::: "memory"); }
            { const bool hi5 = (lane & 32) != 0;
#pragma unroll
              for (int k = 0; k < 8; ++k) { const float snd = hi5 ? p[k] : p[k + 8]; const float rcv = __shfl_xor(snd, 32); p[k] = (hi5 ? p[k + 8] : p[k]) + rcv; }
              const bool hi4 = (lane & 16) != 0;
#pragma unroll
              for (int k = 0; k < 4; ++k) { const float snd = hi4 ? p[k] : p[k + 4]; const float rcv = __shfl_xor(snd, 16); p[k] = (hi4 ? p[k + 4] : p[k]) + rcv; }
              const bool hi3 = (lane & 8) != 0;
#pragma unroll
              for (int k = 0; k < 2; ++k) { const float snd = hi3 ? p[k] : p[k + 2]; const float rcv = __shfl_xor(snd, 8); p[k] = (hi3 ? p[k + 2] : p[k]) + rcv; }
              const bool hi2 = (lane & 4) != 0;
              { const float snd = hi2 ? p[0] : p[1]; const float rcv = __shfl_xor(snd, 4); p[0] = (hi2 ? p[1] : p[0]) + rcv; }
              p[0] += __shfl_xor(p[0], 2); p[0] += __shfl_xor(p[0], 1);
              if ((lane & 3) == 0) lgs[i * 16 + (lane >> 2)] = p[0]; }
        }
        asm volatile("s_waitcnt lgkmcnt(0)" ::: "memory");
        if (lane < 16) {
            float lg[NE];
#pragma unroll
            for (int q = 0; q < 4; ++q) { const f32x4 t4 = *(const LAS f32x4*)(lgs + lane * 16 + 4 * q); lg[4 * q] = t4[0] + a.router_b[4 * q]; lg[4 * q + 1] = t4[1] + a.router_b[4 * q + 1]; lg[4 * q + 2] = t4[2] + a.router_b[4 * q + 2]; lg[4 * q + 3] = t4[3] + a.router_b[4 * q + 3]; }
            int gs = 0; float gbest = -3e38f;
#pragma unroll
            for (int gi = 0; gi < 4; ++gi) { const float mx = fmaxf(fmaxf(lg[gi * 4], lg[gi * 4 + 1]), fmaxf(lg[gi * 4 + 2], lg[gi * 4 + 3])); if (mx > gbest) { gbest = mx; gs = gi; } }
            float l4[4];
#pragma unroll
            for (int i = 0; i < 4; ++i) { float t0 = lg[i];
#pragma unroll
                for (int gi = 1; gi < 4; ++gi) t0 = (gs == gi) ? lg[gi * 4 + i] : t0; l4[i] = t0; }
            int i0 = 0; float b0 = l4[0];
#pragma unroll
            for (int i = 1; i < 4; ++i) if (l4[i] > b0) { b0 = l4[i]; i0 = i; }
            int i1 = 0; float b1 = -3e38f;
#pragma unroll
            for (int i = 0; i < 4; ++i) if (i != i0 && l4[i] > b1) { b1 = l4[i]; i1 = i; }
            const float e1 = __expf(b1 - b0); const float g0 = 1.f / (1.f + e1), g1 = e1 / (1.f + e1);
            u32x4 as; as.x = (unsigned)(gs * 4 + i0); as.y = (unsigned)(gs * 4 + i1); as.z = __float_as_uint(g0); as.w = __float_as_uint(g1);
            asg[F.wave * 16 + lane] = as;
        }
        __syncthreads();
        if (F.wave == 0) {
            const u32x4 A0 = asg[lane], A1 = asg[lane + 64];
            const unsigned ex[4] = {A0.x, A0.y, A1.x, A1.y};
            unsigned rank[4] = {0u, 0u, 0u, 0u}, mycount = 0u;
            const unsigned long long lt = (1ull << lane) - 1ull;
#pragma unroll 1
            for (unsigned e = 0; e < NE; ++e) { unsigned run = 0u;
#pragma unroll
                for (int s = 0; s < 4; ++s) { const unsigned long long m = __ballot(ex[s] == e); if (ex[s] == e) rank[s] = run + (unsigned)__popcll(m & lt); run += (unsigned)__popcll(m); }
                if ((unsigned)lane == e) mycount = run; }
            if (lane < NE) basep[lane] = atomicAdd(cnt + lane, mycount);
            asm volatile("s_waitcnt vmcnt(0) lgkmcnt(0)" ::: "memory");
            const unsigned p0 = basep[ex[0]] + rank[0], p1 = basep[ex[1]] + rank[1], p2 = basep[ex[2]] + rank[2], p3 = basep[ex[3]] + rank[3];
            const int ra = blk * 128 + lane, rb = ra + 64;
            list[ex[0] * T + p0] = ra; list[ex[1] * T + p1] = ra; list[ex[2] * T + p2] = rb; list[ex[3] * T + p3] = rb;
            u32x4 ta, tb; ta.x = (ex[0] << 24) | p0; ta.y = (ex[1] << 24) | p1; ta.z = A0.z; ta.w = A0.w; tb.x = (ex[2] << 24) | p2; tb.y = (ex[3] << 24) | p3; tb.z = A1.z; tb.w = A1.w;
            *(u32x4*)(tokinfo + (size_t)ra * 4) = ta; *(u32x4*)(tokinfo + (size_t)rb * 4) = tb;
        }
        __syncthreads();
    }
}

__device__ __forceinline__ void moe_table(const Args& a, const Frame& F, int l) {
    LAS int* tab = (LAS int*)(F.lds + TAB_OFF);
    const unsigned* cnt = (const unsigned*)(a.ws + WS_CTL) + CW_CNT + l * 64;
    if (F.tid == 0) { int ts = 0; for (int e = 0; e < NE; ++e) { const int c = (int)__hip_atomic_load(cnt + e, RLX_AGENT); tab[e] = ts; tab[NE + 1 + e] = c; ts += (c + TM - 1) / TM; } tab[NE] = ts; }
    __syncthreads();
}

__device__ __forceinline__ void phase_combine_ln2(const Args& a, const Frame& F, int l) {
    float* xres = (float*)(a.ws + WS_XRES); const float* x1 = a.out; const bf16_t* Y = (const bf16_t*)(a.ws + WS_Y); const unsigned* tokinfo = (const unsigned*)(a.ws + WS_TOK); unsigned char* xn = a.ws + WS_XN;
    const float* g = a.ln2_g + l * D; const float* bta = a.ln2_b + l * D; float* out = (l == DEPTH - 1) ? a.out : nullptr;
    const LAS int* tab = (const LAS int*)(F.lds + TAB_OFF);
    const int lane = F.lane;
    for (int row = F.gw; row < T; row += F.ngw) {
        const unsigned i0 = tokinfo[row * 4], i1 = tokinfo[row * 4 + 1]; const float g0 = __uint_as_float(tokinfo[row * 4 + 2]), g1 = __uint_as_float(tokinfo[row * 4 + 3]);
        const size_t s0 = (size_t)tab[i0 >> 24] * TM + (i0 & 0xffffff), s1 = (size_t)tab[i1 >> 24] * TM + (i1 & 0xffffff);
        f32x4 v[4];
#pragma unroll
        for (int j = 0; j < 4; ++j) { const int c = 4 * lane + 256 * j; const f32x4 xv = *(const f32x4*)(x1 + (size_t)row * D + c);
            const u32x2 ya = *(const u32x2*)(Y + s0 * D + c), yb = *(const u32x2*)(Y + s1 * D + c);
            v[j].x = ALPHA * xv.x + g0 * bflo(ya.x) + g1 * bflo(yb.x); v[j].y = ALPHA * xv.y + g0 * bfhi(ya.x) + g1 * bfhi(yb.x);
            v[j].z = ALPHA * xv.z + g0 * bflo(ya.y) + g1 * bflo(yb.y); v[j].w = ALPHA * xv.w + g0 * bfhi(ya.y) + g1 * bfhi(yb.y); }
        ln_rows16(v, g, bta, lane);
        store_row(v, lane, xres + (size_t)row * D, xn + (size_t)row * D, out ? out + (size_t)row * D : nullptr);
    }
}


constexpr int ATT_F2_OFF = 86016;
__device__ __forceinline__ void phase_attn(const Args& a, const Frame& F, char* lds_generic) {
    const int c = F.bid, vcu = (F.G % 8 == 0) ? (c % 8) * (F.G / 8) + c / 8 : c;
    const attn_body::bf16* Q = (const attn_body::bf16*)(a.ws + WS_QO); const attn_body::bf16* K = (const attn_body::bf16*)(a.ws + WS_KV); const attn_body::bf16* V = K + 512;
    attn_body::bf16* O = (attn_body::bf16*)(a.ws + WS_OX8);
    const float* FL = (const float*)(a.ws + WS_FL);
    LAS float* f2 = (LAS float*)(F.lds + ATT_F2_OFF); LAS float* wsum = f2 + 2048;
    { const int bh = vcu >> 1; if (bh >= BATCH * NH) return;
        const int b = bh >> 3, h = bh & 7, tid = F.tid, lane = F.lane, w = F.wave;
        float v[4], run = 0.f;
#pragma unroll
        for (int i = 0; i < 4; ++i) { run += FL[((size_t)b * SEQ + tid * 4 + i) * 8 + h]; v[i] = run; }
        float incl = run;
#pragma unroll
        for (int o = 1; o < 64; o <<= 1) { const float u = __shfl_up(incl, o); if (lane >= o) incl += u; }
        if (lane == 63) wsum[w] = incl;
        __syncthreads();
        float base = incl - run; for (int i = 0; i < w; ++i) base += wsum[i];
        f32x4 o4; o4[0] = (base + v[0]) * LOG2E; o4[1] = (base + v[1]) * LOG2E; o4[2] = (base + v[2]) * LOG2E; o4[3] = (base + v[3]) * LOG2E;
        *(LAS f32x4*)(f2 + tid * 4) = o4;
        __syncthreads();
        for (int i = 0; i < 4; ++i) { const int s = 2 * (vcu & 1) + (i >> 1); const int qb = (i & 1) ? 7 - s : s;
            int tid_u = F.tid; asm volatile("" : "+v"(tid_u));
            attn_body::attn_unit<40>(b, h, qb, Q, K, V, O, lds_generic + RING_OFF, f2, tid_u); }
        __syncthreads();
    }
}

namespace hg {
constexpr int PB = 144;
constexpr int O_QS = 0, O_KS = 9216, O_QI = 18432, O_KUT = 27648, O_VT = 36864, O_P = 46080, O_ST = 55296, O_TOT = 64512, O_EBL = 66560, O_RED = 66816, BYTES = 67328;
__device__ __forceinline__ float ex(float v) { return __builtin_amdgcn_exp2f(v * LOG2E); }
__device__ __forceinline__ unsigned short bf1(float v) { return (unsigned short)f2bf(v); }
}
__device__ __forceinline__ void phase_hgrn(const Args& a, const Frame& F, int l) {
    using namespace hg;
    if (F.bid >= BATCH * NH) return;
    const bf16_t* HB = (const bf16_t*)(a.ws + WS_HB); const float* LOGF = (const float*)(a.ws + WS_LOGF); const bf16_t* HG = (const bf16_t*)(a.ws + WS_HG); unsigned char* O8 = a.ws + WS_OX8;
    LAS unsigned char* L = F.lds + RING_OFF;
    const int bh = F.bid, b = bh >> 3, h = bh & 7, lane = F.lane, w = F.wave, tid = F.tid;
    const int fr = lane & 15, fq = lane >> 4;
    const int tr = w >> 1, tc0 = 2 * (w & 1);
    const float ng0 = a.norm_g[l * 512 + h * 64 + 16 * tc0 + fr], ng1 = a.norm_g[l * 512 + h * 64 + 16 * (tc0 + 1) + fr];
    f32x4 S0 = {0.f, 0.f, 0.f, 0.f}, S1 = {0.f, 0.f, 0.f, 0.f};
    for (int i = tid; i < 9216 / 4; i += NWAVES * 64) ((LAS unsigned*)(L + O_ST))[i] = 0u;
    const size_t rowbase = (size_t)b * SEQ;
    float g[8]; unsigned short qv[8], vv[8];
#pragma unroll
    for (int i = 0; i < 8; ++i) { const size_t row = rowbase + 8 * w + i; g[i] = LOGF[row * 512 + h * 64 + lane]; qv[i] = HB[row * 1024 + h * 64 + lane]; vv[i] = HB[row * 1024 + 512 + h * 64 + lane]; }
    for (int c0 = 0; c0 < SEQ; c0 += 64) {
        float bc[8]; { float run = 0.f;
#pragma unroll
            for (int i = 0; i < 8; ++i) { run += g[i]; bc[i] = run; } }
        ((LAS float*)(L + O_TOT))[w * 64 + lane] = bc[7];
        float qf[8], kf[8];
#pragma unroll
        for (int i = 0; i < 8; ++i) { qf[i] = bf2f(qv[i]); kf[i] = 1.f - ex(g[i]); }
        { u32x4 pk; pk.x = (unsigned)vv[0] | ((unsigned)vv[1] << 16); pk.y = (unsigned)vv[2] | ((unsigned)vv[3] << 16); pk.z = (unsigned)vv[4] | ((unsigned)vv[5] << 16); pk.w = (unsigned)vv[6] | ((unsigned)vv[7] << 16);
          *(LAS u32x4*)(L + O_VT + lane * PB + 16 * w) = pk; }
        __syncthreads();
        float base = 0.f, bm = 0.f, bl = 0.f;
#pragma unroll
        for (int ww = 0; ww < 8; ++ww) { const float tv = ((LAS float*)(L + O_TOT))[ww * 64 + lane]; if (ww < w) base += tv; if (ww < 4) bm += tv; bl += tv; }
        const float ebm = ex(bm), eblm = ex(bl - bm);
        if (w == 0) ((LAS float*)(L + O_EBL))[lane] = ex(bl);
        unsigned short ku[8];
#pragma unroll
        for (int i = 0; i < 8; ++i) { const float x = bc[i] + base - bm; const float e1 = ex(fminf(x, 80.f)), e2 = ex(fminf(-x, 80.f));
            const float qs = qf[i] * e1, ks = kf[i] * e2; const int r = 8 * w + i;
            *(LAS unsigned short*)(L + O_QS + r * PB + 2 * lane) = bf1(qs); *(LAS unsigned short*)(L + O_QI + r * PB + 2 * lane) = bf1(qs * ebm);
            *(LAS unsigned short*)(L + O_KS + r * PB + 2 * lane) = bf1(ks); ku[i] = bf1(ks * eblm); }
        { u32x4 pk; pk.x = (unsigned)ku[0] | ((unsigned)ku[1] << 16); pk.y = (unsigned)ku[2] | ((unsigned)ku[3] << 16); pk.z = (unsigned)ku[4] | ((unsigned)ku[5] << 16); pk.w = (unsigned)ku[6] | ((unsigned)ku[7] << 16);
          *(LAS u32x4*)(L + O_KUT + lane * PB + 16 * w) = pk; }
        if (c0 + 64 < SEQ) {
#pragma unroll
            for (int i = 0; i < 8; ++i) { const size_t row = rowbase + c0 + 64 + 8 * w + i; g[i] = LOGF[row * 512 + h * 64 + lane]; qv[i] = HB[row * 1024 + h * 64 + lane]; vv[i] = HB[row * 1024 + 512 + h * 64 + lane]; }
        }
        __syncthreads();
#pragma unroll
        for (int k2 = 0; k2 < 2; ++k2) { const int idx = 2 * w + k2, ti = idx >> 2, sj = idx & 3;
            f32x4 sc = {0.f, 0.f, 0.f, 0.f};
            if (sj <= ti) {
#pragma unroll
                for (int kk = 0; kk < 2; ++kk) { const bf16x8 af = *(const LAS bf16x8*)(L + O_QS + (16 * ti + fr) * PB + (32 * kk + 8 * fq) * 2), bfr = *(const LAS bf16x8*)(L + O_KS + (16 * sj + fr) * PB + (32 * kk + 8 * fq) * 2);
                    sc = __builtin_amdgcn_mfma_f32_16x16x32_bf16(af, bfr, sc, 0, 0, 0); }
            }
#pragma unroll
            for (int j = 0; j < 4; ++j) { const int t = 16 * ti + 4 * fq + j, s = 16 * sj + fr; *(LAS unsigned short*)(L + O_P + t * PB + 2 * s) = bf1(s <= t ? sc[j] : 0.f); }
        }
        __syncthreads();
        f32x4 o0 = {0.f, 0.f, 0.f, 0.f}, o1 = {0.f, 0.f, 0.f, 0.f}, u0 = {0.f, 0.f, 0.f, 0.f}, u1 = {0.f, 0.f, 0.f, 0.f};
#pragma unroll
        for (int kk = 0; kk < 2; ++kk) { const int ko = (32 * kk + 8 * fq) * 2;
            const bf16x8 pa = *(const LAS bf16x8*)(L + O_P + (16 * tr + fr) * PB + ko), qa = *(const LAS bf16x8*)(L + O_QI + (16 * tr + fr) * PB + ko), ka = *(const LAS bf16x8*)(L + O_KUT + (16 * tr + fr) * PB + ko);
            const bf16x8 v0 = *(const LAS bf16x8*)(L + O_VT + (16 * tc0 + fr) * PB + ko), v1 = *(const LAS bf16x8*)(L + O_VT + (16 * (tc0 + 1) + fr) * PB + ko);
            const bf16x8 s0 = *(const LAS bf16x8*)(L + O_ST + (16 * tc0 + fr) * PB + ko), s1 = *(const LAS bf16x8*)(L + O_ST + (16 * (tc0 + 1) + fr) * PB + ko);
            o0 = __builtin_amdgcn_mfma_f32_16x16x32_bf16(pa, v0, o0, 0, 0, 0); o1 = __builtin_amdgcn_mfma_f32_16x16x32_bf16(pa, v1, o1, 0, 0, 0);
            o0 = __builtin_amdgcn_mfma_f32_16x16x32_bf16(qa, s0, o0, 0, 0, 0); o1 = __builtin_amdgcn_mfma_f32_16x16x32_bf16(qa, s1, o1, 0, 0, 0);
            u0 = __builtin_amdgcn_mfma_f32_16x16x32_bf16(ka, v0, u0, 0, 0, 0); u1 = __builtin_amdgcn_mfma_f32_16x16x32_bf16(ka, v1, u1, 0, 0, 0); }
        { const f32x4 dec = *(const LAS f32x4*)(L + O_EBL + (16 * tr + 4 * fq) * 4); S0 = S0 * dec + u0; S1 = S1 * dec + u1; }
        { f32x4 q2 = o0 * o0 + o1 * o1;
#pragma unroll
          for (int m = 1; m < 16; m <<= 1) { q2[0] += __shfl_xor(q2[0], m); q2[1] += __shfl_xor(q2[1], m); q2[2] += __shfl_xor(q2[2], m); q2[3] += __shfl_xor(q2[3], m); }
          if (fr == 0) {
#pragma unroll
              for (int j = 0; j < 4; ++j) ((LAS float*)(L + O_RED))[(16 * tr + 4 * fq + j) * 2 + (w & 1)] = q2[j]; } }
        __syncthreads();
        { u32x2 p0, p1; p0.x = pk2(S0[0], S0[1]); p0.y = pk2(S0[2], S0[3]); p1.x = pk2(S1[0], S1[1]); p1.y = pk2(S1[2], S1[3]);
          *(LAS u32x2*)(L + O_ST + (16 * tc0 + fr) * PB + (16 * tr + 4 * fq) * 2) = p0; *(LAS u32x2*)(L + O_ST + (16 * (tc0 + 1) + fr) * PB + (16 * tr + 4 * fq) * 2) = p1; }
#pragma unroll
        for (int j = 0; j < 4; ++j) { const int t = 16 * tr + 4 * fq + j; const f32x2 rr = *(const LAS f32x2*)(L + O_RED + t * 8); const float rs = rsqrtf((rr[0] + rr[1]) * (1.f / 64.f) + RMS_EPS);
            *(LAS unsigned short*)(L + O_P + t * PB + 2 * (16 * tc0 + fr)) = bf1(o0[j] * rs * ng0); *(LAS unsigned short*)(L + O_P + t * PB + 2 * (16 * (tc0 + 1) + fr)) = bf1(o1[j] * rs * ng1); }
        __syncthreads();
        { const int t = tid >> 3, e8 = (tid & 7) * 8; const size_t row = rowbase + c0 + t;
          const u32x4 ov = *(const LAS u32x4*)(L + O_P + t * PB + e8 * 2), gv = *(const u32x4*)(HG + row * 512 + h * 64 + e8);
          u32x2 r; r.x = pg8::pack4_fp8(bflo(ov.x) * bflo(gv.x) * SC_HGRN, bfhi(ov.x) * bfhi(gv.x) * SC_HGRN, bflo(ov.y) * bflo(gv.y) * SC_HGRN, bfhi(ov.y) * bfhi(gv.y) * SC_HGRN);
          r.y = pg8::pack4_fp8(bflo(ov.z) * bflo(gv.z) * SC_HGRN, bfhi(ov.z) * bfhi(gv.z) * SC_HGRN, bflo(ov.w) * bflo(gv.w) * SC_HGRN, bfhi(ov.w) * bfhi(gv.w) * SC_HGRN);
          *(u32x2*)(O8 + row * 1024 + 512 + h * 64 + e8) = r; }
        __syncthreads();
    }
}


constexpr int PH_PER_LAYER = 10, N_PHASES = 1 + DEPTH * PH_PER_LAYER;
#ifndef MK_ONE_LAUNCH
#define MK_ONE_LAUNCH 1
#endif
#ifndef MK_FAST_ATTN
#define MK_FAST_ATTN 0
#endif
#ifndef MK_FAST_HGRN
#define MK_FAST_HGRN 0
#endif


#ifdef DBG_DUMP
#ifndef DBG_WHAT
#define DBG_WHAT 0
#endif
__device__ __forceinline__ void dbg_dump(const Args& a, const Frame& F) {
    unsigned char* ws = a.ws;
    const bf16_t *QO = (bf16_t*)(ws + WS_QO), *KV = (bf16_t*)(ws + WS_KV), *HB = (bf16_t*)(ws + WS_HB), *HG = (bf16_t*)(ws + WS_HG), *G = (bf16_t*)(ws + WS_G);
    const bf16_t *U1 = (bf16_t*)(ws + WS_U1), *U = (bf16_t*)(ws + WS_U), *MIXED = (bf16_t*)(ws + WS_MIXED), *XN = (bf16_t*)(ws + WS_XN);
    const float *LOGF = (float*)(ws + WS_LOGF), *FL = (float*)(ws + WS_FL), *XRES = (float*)(ws + WS_XRES);
    for (size_t i = (size_t)F.bid * 512 + F.tid; i < (size_t)T * D; i += (size_t)gridDim.x * 512) {
        const size_t row = i >> 10; const int c = (int)(i & 1023);
        float v = 0.f;
        if (DBG_WHAT == 9) { v = bf2f(G[row * 2048 + c]) + bf2f(G[row * 2048 + 1024 + c]); }
        else if (DBG_DUMP == 1) { v = bf2f(KV[i]) + bf2f(HB[i]) + bf2f(G[row * 2048 + c]) + bf2f(G[row * 2048 + 1024 + c]);
            if (c < 512) v += LOGF[row * 512 + c] + bf2f(HG[row * 512 + c]) + bf2f(QO[i]); if (c < 8) v += FL[row * 8 + c]; }
        else if (DBG_DUMP == 2) { v = (c >= 512) ? bf2f(QO[i]) : 0.f; }
        else if (DBG_DUMP == 3) { v = bf2f(QO[i]); }
        else if (DBG_DUMP == 4) { v = bf2f(U1[i]); }
        else if (DBG_DUMP == 5) { v = bf2f(U[i]); }
        else if (DBG_DUMP == 6) { v = bf2f(MIXED[i]); }
        else if (DBG_DUMP == 7) { v = XRES[i] + bf2f(XN[i]); }
        a.out[i] = v;
    }
}
#endif
#define PH_BEGIN const Args a = LOAD_ARGS(); Frame F; F.lds = lds0; F.lane = (int)__builtin_amdgcn_mbcnt_hi(~0u, __builtin_amdgcn_mbcnt_lo(~0u, 0u)); asm volatile("" : "+v"(F.lane)); F.wave = __builtin_amdgcn_readfirstlane((int)((const volatile LAS unsigned*)(lds0 + WTAB_OFF))[hw_wave_key()]); F.tid = F.wave * 64 + F.lane; \
    F.G = gridDim.x; F.bid = blockIdx.x; asm volatile("" : "+s"(F.bid)); F.gw = F.bid * NWAVES + F.wave; F.ngw = F.G * NWAVES; unsigned char* const ws = a.ws; const LAS int* tab = (const LAS int*)(F.lds + TAB_OFF); (void)tab; (void)ws;
#ifdef DBG_DUMP
#define IN(k) (lo <= (k) && (k) < hi && (k) <= DBG_DUMP)
#else
#define IN(k) (lo <= (k) && (k) < hi)
#endif
#ifdef DBG_REPEAT
#define REP(k) for (int rep_ = 0; rep_ < ((DBG_REPEAT == (k) && !((k) == 9 && l == DEPTH - 1)) ? 2 : 1); ++rep_)
#else
#define REP(k)
#endif
#define SEAM(k) do { if (IN(k) && IN((k) + 1)) { XcdBarrier b2_ = bar; { size_t z_ = 0; asm volatile("" : "+s"(z_), "+s"(b2_.x)); b2_.bar = bar.bar + z_; } xcd_barrier(b2_); } } while (0)
template <int l>
__device__ __forceinline__ void layer_body(const Args& args, const int lo, const int hi, const XcdBarrier& bar, LAS unsigned char* const lds0, unsigned char* lds_raw) {
        const int pb = 1 + l * PH_PER_LAYER;

#ifdef DBG_DUMP
        if (l == 0 && lo <= DBG_DUMP + 1 && DBG_DUMP + 1 < hi) { PH_BEGIN dbg_dump(a, F); }
#endif
        if (IN(pb + 0)) REP(0) { PH_BEGIN
            pg8::Gemm g{(bf16_t*)(ws + WS_XN), (bf16_t*)(ws + wset(l) + WO_WIN), D / 2, D / 2, D / 2, E8_1, E8_W}; pg8::StaticOrder S; S.init(T, NINP, F.G, F.bid);
            pg8::EpiInproj E{ws, l};
            pg8::gemm_phase<pg8::EpiInproj, pg8::StaticOrder, true>(F.lds + RING_OFF, g, S, E, F.tid);
        }
        SEAM(pb + 0);
        if (IN(pb + 1)) REP(1) { PH_BEGIN
#if !MK_FAST_ATTN
            phase_fscan(a, F);
#endif
#if MK_FAST_HGRN
            phase_hgrn(a, F, l);
            if (l + 1 < DEPTH && F.bid >= BATCH * NH) convert_layer(a, F, l + 1, (F.bid - BATCH * NH) * NWAVES + F.wave, (F.G - BATCH * NH) * NWAVES);
#else
            phase_hgrn_naive(a, F, l);
#endif
        }
        SEAM(pb + 1);
        if (IN(pb + 2)) REP(2) { PH_BEGIN
#if MK_FAST_ATTN
            phase_attn(a, F, (char*)lds_raw);
#else
            phase_attn_naive(a, F);
#endif
        }
        SEAM(pb + 2);
        if (IN(pb + 3)) REP(3) { PH_BEGIN
            pg8::Gemm g{(bf16_t*)(ws + WS_OX8), (bf16_t*)(ws + wset(l) + WO_WBR), D / 2, D / 2, 256, E8_FOX, E8_W}; pg8::StaticOrder S; S.init(T, D, F.G, F.bid);
            pg8::EpiGate<1> E{(bf16_t*)(ws + WS_U1), nullptr, (bf16_t*)(ws + WS_G), 2048, nullptr};
            pg8::gemm_phase<pg8::EpiGate<1>, pg8::StaticOrder, true>(F.lds + RING_OFF, g, S, E, F.tid);
        }
        SEAM(pb + 3);
        if (IN(pb + 4)) REP(4) { PH_BEGIN
            pg8::Gemm g{(bf16_t*)(ws + WS_OX8) + 256, (bf16_t*)(ws + wset(l) + WO_WBR) + 256, D / 2, D / 2, 256, E8_HGRN, E8_W}; pg8::StaticOrder S; S.init(T, D, F.G, F.bid);
            pg8::EpiGate<2> E{(bf16_t*)(ws + WS_U), nullptr, (bf16_t*)(ws + WS_G) + 1024, 2048, (bf16_t*)(ws + WS_U1)};
            pg8::gemm_phase<pg8::EpiGate<2>, pg8::StaticOrder, true>(F.lds + RING_OFF, g, S, E, F.tid);
        }
        SEAM(pb + 4);
        if (IN(pb + 5)) REP(5) { PH_BEGIN
            pg8::Gemm g{(bf16_t*)(ws + WS_U), (bf16_t*)(ws + wset(l) + WO_WMIX), D / 2, D / 2, D / 2, E8_U, E8_W}; pg8::StaticOrder S; S.init(T, D, F.G, F.bid);
            pg8::EpiGate<0> E{(bf16_t*)(ws + WS_MIXED), a.b_mix + l * D, nullptr, 0, nullptr};
            pg8::gemm_phase<pg8::EpiGate<0>, pg8::StaticOrder, true>(F.lds + RING_OFF, g, S, E, F.tid);
        }
        SEAM(pb + 5);
        if (IN(pb + 6)) REP(6) { PH_BEGIN phase_ln1_router(a, F, l); }
        SEAM(pb + 6);
        if (IN(pb + 7)) REP(7) { PH_BEGIN
            moe_table(a, F, l);
            pg8::Gemm g{(bf16_t*)(ws + WS_XN), (bf16_t*)(ws + wset(l) + WO_W13), D / 2, D / 2, D / 2, E8_1, E8_W}; pg8::MoeOrder<true> S{F.G, F.bid, 8, tab, (const int*)(ws + WS_LIST), (size_t)2048 * (D / 2)};
            pg8::EpiUp E{(bf16_t*)(ws + WS_H)};
            pg8::gemm_phase<pg8::EpiUp, pg8::MoeOrder<true>, true>(F.lds + RING_OFF, g, S, E, F.tid);
        }
        SEAM(pb + 7);
        if (IN(pb + 8)) REP(8) { PH_BEGIN
            moe_table(a, F, l);
            pg8::Gemm g{(bf16_t*)(ws + WS_H), (bf16_t*)(ws + wset(l) + WO_W2), D / 2, D / 2, D / 2, E8_H, E8_W}; pg8::MoeOrder<false> S{F.G, F.bid, 4, tab, nullptr, (size_t)D * (D / 2)};
            pg8::EpiGate<0> E{(bf16_t*)(ws + WS_Y), nullptr, nullptr, 0, nullptr};
            pg8::gemm_phase<pg8::EpiGate<0>, pg8::MoeOrder<false>, true>(F.lds + RING_OFF, g, S, E, F.tid);
        }
        SEAM(pb + 8);
        if (IN(pb + 9)) REP(9) { PH_BEGIN
            moe_table(a, F, l);
            phase_combine_ln2(a, F, l);
        }
        SEAM(pb + 9);
    }

__global__ void __launch_bounds__(NWAVES * 64, 2) mk_fwd(Args args) {
    extern __shared__ __attribute__((aligned(16))) unsigned char lds_raw[];
    LAS unsigned char* const lds0 = (LAS unsigned char*)lds_raw;
    volatile LAS unsigned* MISC = (volatile LAS unsigned*)(lds0 + MISC_OFF);
    for (int u = threadIdx.x; u < (LDS_BYTES - LDSCTL_OFF) / 4; u += NWAVES * 64) ((LAS unsigned*)(lds0 + LDSCTL_OFF))[u] = 0u;
    __syncthreads();
    if ((threadIdx.x & 63) == 0) ((volatile LAS unsigned*)(lds0 + WTAB_OFF))[hw_wave_key()] = threadIdx.x >> 6;
    __syncthreads();
    unsigned* ctl = (unsigned*)(args.ws + WS_CTL);
    XcdBarrier bar; bar.bar = ctl + CW_BAR; bar.x = 0; bar.st = nullptr;
    if (args.use_bar) bar = xcd_barrier_post(ctl + CW_BAR, MISC + 8);
    const int lo = args.ph_lo, hi = args.ph_hi;


    if (IN(0)) { PH_BEGIN phase_prep(a, F); }
    SEAM(0);
    layer_body<0>(args, lo, hi, bar, lds0, lds_raw); layer_body<1>(args, lo, hi, bar, lds0, lds_raw); layer_body<2>(args, lo, hi, bar, lds0, lds_raw); layer_body<3>(args, lo, hi, bar, lds0, lds_raw);
#undef IN
#undef SEAM
}

extern "C" void kernel_launch(void* const* d_in, const int* in_sizes, int n_in, void* d_out, int out_size, void* d_ws, size_t ws_size, hipStream_t stream) {
    static int grid = 0;
    if (grid == 0) {
        if (n_in != 20 || in_sizes[0] != T * D || out_size != T * D || ws_size < WS_END) { fprintf(stderr, "kernel_launch: unexpected shapes (n_in %d, ws %zu)\n", n_in, ws_size); grid = -1; return; }
        int dev = 0, cus = 0, per_cu = 0;
        if (hipGetDevice(&dev) != hipSuccess || hipDeviceGetAttribute(&cus, hipDeviceAttributeMultiprocessorCount, dev) != hipSuccess) { grid = -1; return; }
        if (hipFuncSetAttribute((const void*)mk_fwd, hipFuncAttributeMaxDynamicSharedMemorySize, LDS_BYTES) != hipSuccess) { fprintf(stderr, "kernel_launch: hipFuncSetAttribute failed\n"); grid = -1; return; }
        if (hipOccupancyMaxActiveBlocksPerMultiprocessor(&per_cu, (const void*)mk_fwd, NWAVES * 64, LDS_BYTES) != hipSuccess || per_cu < 1)
            fprintf(stderr, "kernel_launch: note: occupancy query reports %d workgroups per CU\n", per_cu);
        (void)hipGetLastError();
        grid = cus;
    }
    if (grid < 0) return;
    if (hipMemsetAsync((char*)d_ws + WS_CTL, 0, CTL_BYTES, stream) != hipSuccess) return;
    Args a{};
    a.x = (const float*)d_in[0]; a.ln_in_g = (const float*)d_in[1]; a.ln_in_b = (const float*)d_in[2]; a.w_in = (const float*)d_in[3]; a.b_in = (const float*)d_in[4];
    a.w_fox = (const float*)d_in[5]; a.lbl = (const float*)d_in[6]; a.norm_g = (const float*)d_in[7]; a.w_hgrn = (const float*)d_in[8]; a.w_mix = (const float*)d_in[9];
    a.b_mix = (const float*)d_in[10]; a.ln1_g = (const float*)d_in[11]; a.ln1_b = (const float*)d_in[12]; a.router_w = (const float*)d_in[13]; a.router_b = (const float*)d_in[14];
    a.w1 = (const float*)d_in[15]; a.w3 = (const float*)d_in[16]; a.w2 = (const float*)d_in[17]; a.ln2_g = (const float*)d_in[18]; a.ln2_b = (const float*)d_in[19];
    a.out = (float*)d_out; a.ws = (unsigned char*)d_ws; a.pad = 0;
#if MK_ONE_LAUNCH
    a.ph_lo = 0; a.ph_hi = N_PHASES; a.use_bar = 1;
    hipLaunchKernelGGL(mk_fwd, dim3(grid), dim3(NWAVES * 64), LDS_BYTES, stream, a);
#else
#ifdef DBG_DUMP
    const int np_ = DBG_DUMP + 2;
#else
    const int np_ = N_PHASES;
#endif
    for (int p = 0; p < np_; ++p) { a.ph_lo = p; a.ph_hi = p + 1; a.use_bar = 0;
        hipLaunchKernelGGL(mk_fwd, dim3(grid), dim3(NWAVES * 64), LDS_BYTES, stream, a); }
#endif
    const hipError_t le = hipPeekAtLastError();
    if (le != hipSuccess) fprintf(stderr, "kernel_launch: launch failed: %s\n", hipGetErrorName(le));
}
```

```cpp
#define MK_ONE_LAUNCH 1
#define MK_FAST_ATTN 1
#define MK_FAST_HGRN 1
#include <hip/hip_runtime.h>
#include <cstdio>
#include <cstdint>

typedef unsigned short bf16_t;
typedef short bf16x8 __attribute__((ext_vector_type(8)));
typedef float f32x4 __attribute__((ext_vector_type(4)));
typedef float f32x2 __attribute__((ext_vector_type(2)));
typedef unsigned u32x4 __attribute__((ext_vector_type(4)));
typedef unsigned u32x2 __attribute__((ext_vector_type(2)));
#define LAS __attribute__((address_space(3)))
#define GAS __attribute__((address_space(1)))

constexpr int BATCH = 16, SEQ = 2048, T = BATCH * SEQ, D = 1024, DEPTH = 4, NH = 8, HD = 64, NIN = 5640, NINP = 5632, NE = 16;
constexpr float LN_EPS = 1e-5f, RMS_EPS = 1e-6f;
constexpr float ALPHA = 1.681792830507429f;
constexpr float LOG2E = 1.4426950408889634f;
constexpr float C2 = 0.125f * LOG2E;
constexpr float SC_W = 64.f, SC_FOX = 16.f, SC_HGRN = 4.f, SC_U = 64.f, SC_H = 8.f;
constexpr int E8_1 = 0x7f7f7f7f, E8_W = 0x79797979, E8_FOX = 0x7b7b7b7b, E8_HGRN = 0x7d7d7d7d, E8_U = 0x79797979, E8_H = 0x7c7c7c7c;
constexpr int TM = 256;

constexpr size_t MiB = 1u << 20;
constexpr size_t WS_CTL = 0, CTL_BYTES = 1 * MiB;
constexpr size_t WS_MISC = 1 * MiB;
constexpr size_t WS_WSET = 2 * MiB, WSET_BYTES = 56 * MiB;
constexpr size_t WO_WIN = 0, WO_WBR = 6 * MiB, WO_WMIX = 7 * MiB, WO_W13 = 8 * MiB, WO_W2 = 40 * MiB;
__host__ __device__ constexpr size_t wset(int l) { return WS_WSET + (size_t)(l & 1) * WSET_BYTES; }
__host__ __device__ constexpr size_t biasoff(int l) { return WS_MISC + 16384 + (size_t)(l & 1) * 32768; }
constexpr size_t WS_XRES = 114 * MiB, WS_XN = 242 * MiB, WS_QO = 306 * MiB, WS_KV = 370 * MiB, WS_HB = 434 * MiB, WS_LOGF = 498 * MiB;
constexpr size_t WS_HG = 562 * MiB, WS_G = 594 * MiB, WS_FL = 722 * MiB, WS_F2 = 723 * MiB, WS_U1 = 724 * MiB, WS_U = 788 * MiB, WS_MIXED = 852 * MiB;
constexpr size_t WS_LIST = 916 * MiB, WS_TOK = 918 * MiB, WS_END = 919 * MiB;
constexpr size_t WS_OX8 = 274 * MiB;
constexpr size_t WS_H = WS_QO, WS_Y = 442 * MiB;
constexpr int CW_CNT = 1024;
constexpr int CW_BAR = 4096;

__device__ __forceinline__ unsigned f2bf(float f) { unsigned u = __builtin_bit_cast(unsigned, f); return (u + 0x7fffu + ((u >> 16) & 1u)) >> 16; }
__device__ __forceinline__ float bf2f(unsigned h) { return __builtin_bit_cast(float, h << 16); }
__device__ __forceinline__ float bflo(unsigned w) { return __builtin_bit_cast(float, w << 16); }
__device__ __forceinline__ float bfhi(unsigned w) { return __builtin_bit_cast(float, w & 0xffff0000u); }
__device__ __forceinline__ unsigned pk2(float lo, float hi) { return f2bf(lo) | (f2bf(hi) << 16); }
__device__ __forceinline__ float wave_sum(float v) {
#pragma unroll
    for (int o = 1; o < 64; o <<= 1) v += __shfl_xor(v, o);
    return v;
}
__device__ __forceinline__ float wave_max(float v) {
#pragma unroll
    for (int o = 1; o < 64; o <<= 1) v = fmaxf(v, __shfl_xor(v, o));
    return v;
}
__device__ __forceinline__ float fast_exp(float v) { return __builtin_amdgcn_exp2f(v * LOG2E); }
__device__ __forceinline__ float sigmoidf_(float v) { return __builtin_amdgcn_rcpf(1.0f + fast_exp(-v)); }
__device__ __forceinline__ float siluf_(float v) { return v * sigmoidf_(v); }
__device__ __forceinline__ float logsigmoidf_(float v) { return fminf(v, 0.f) - __logf(1.0f + fast_exp(-fabsf(v))); }

namespace pg8 {
constexpr int BM = 256, BK = 64, HALF = 128, HTB = HALF * BK * 2  , STAGE_BYTES = 8 * HTB, NXCD = 8, WGM = 8;
__host__ __device__ __forceinline__ int lds_byte(int r, int c) { const int st = (r >> 4) * 2 + (c >> 5), rr = r & 15, cc = c & 31, ob = rr * 64 + cc * 2; return st * 1024 + (ob ^ (((ob >> 9) & 1) << 5)); }
__host__ __device__ __forceinline__ void stage_rc(int b, int& R, int& C) { const int st = b / 1024, sb = b % 1024, swz = sb ^ (((sb >> 9) & 1) << 5); R = (st >> 1) * 16 + swz / 64; C = (st & 1) * 32 + (swz % 64) / 2; }
__host__ __device__ __forceinline__ int perm32(int rho) { const int n = rho >> 4, i = rho & 15; return 8 * (i >> 2) + 4 * n + (i & 3); }

struct Unit { int pm, pn, e; };
struct Gemm { const bf16_t* A; const bf16_t* Bt; int lda, ldb, K; int sa, sb; };

struct StaticOrder {
    static constexpr bool GATHER = false;
    int nM, nN, nwg, G, c;
    __device__ void init(int M, int N, int G_, int c_) { nM = M / BM; nN = N / BM; nwg = nM * nN; G = G_; c = c_; }
    __device__ bool next(int i, Unit& u) const {
        const int L = i * G + c; if (L >= nwg) return false;
        int wgid = L; { const int q = nwg / NXCD, r = nwg % NXCD, xcd = wgid % NXCD, off = wgid / NXCD; wgid = (xcd < r ? xcd * (q + 1) : r * (q + 1) + (xcd - r) * q) + off; }
        const int nig = WGM * nN, gid = wgid / nig, fm = gid * WGM, gsz = (nM - fm) < WGM ? (nM - fm) : WGM;
        u.pm = fm + ((wgid % nig) % gsz); u.pn = (wgid % nig) / gsz; u.e = 0; return true;
    }
    __device__ __forceinline__ const char* a_tile(const Gemm& g, const Unit& u) const { return (const char*)g.A + (size_t)u.pm * BM * g.lda * 2; }
    __device__ __forceinline__ const char* b_tile(const Gemm& g, const Unit& u) const { return (const char*)g.Bt + (size_t)u.pn * BM * g.ldb * 2; }
    __device__ __forceinline__ void a_voff(const Gemm& g, const Unit&, const int (&R)[2], const int (&C)[2], unsigned (&v)[2][2]) const {
#pragma unroll
        for (int h = 0; h < 2; ++h)
#pragma unroll
            for (int i = 0; i < 2; ++i) v[h][i] = (unsigned)((h * HALF + R[i]) * g.lda + C[i]) * 2u;
    }
};
template <bool GATHER_> struct MoeOrder {
    static constexpr bool GATHER = GATHER_; static constexpr bool gather = GATHER_;
    int G, c, nN; const LAS int* tab; const int* list; size_t bstride;
    __device__ bool next(int i, Unit& u) const {
        const int L = i * G + c; const int rt = L / nN; const int NT = tab[NE]; if (rt >= NT) return false;
        int e = 0;
#pragma unroll
        for (int k = 1; k < NE; ++k) e += (rt >= tab[k]) ? 1 : 0;
        u.pm = __builtin_amdgcn_readfirstlane(rt); u.pn = __builtin_amdgcn_readfirstlane(L % nN); u.e = __builtin_amdgcn_readfirstlane(e); return true;
    }
    __device__ __forceinline__ const char* a_tile(const Gemm& g, const Unit& u) const { return gather ? (const char*)g.A : (const char*)g.A + (size_t)u.pm * BM * g.lda * 2; }
    __device__ __forceinline__ const char* b_tile(const Gemm& g, const Unit& u) const { return (const char*)g.Bt + ((size_t)u.e * bstride + (size_t)u.pn * BM * g.ldb) * 2; }
    __device__ __forceinline__ void a_voff(const Gemm& g, const Unit& u, const int (&R)[2], const int (&C)[2], unsigned (&v)[2][2]) const {
        const int ts = tab[u.e], cn = tab[NE + 1 + u.e];
#pragma unroll
        for (int h = 0; h < 2; ++h)
#pragma unroll
            for (int i = 0; i < 2; ++i) {
                if (gather) { const int pos = (u.pm - ts) * BM + h * HALF + R[i]; const int tok = (pos < cn) ? list[u.e * T + pos] : 0; v[h][i] = (unsigned)(tok * g.lda + C[i]) * 2u; }
                else v[h][i] = (unsigned)((h * HALF + R[i]) * g.lda + C[i]) * 2u;
            }
    }
};

typedef __bf16 bf16x2_t __attribute__((ext_vector_type(2)));
__device__ __forceinline__ unsigned cvt_pk_bf16(float lo, float hi) { f32x2 v = {lo, hi}; bf16x2_t b = __builtin_convertvector(v, bf16x2_t); return __builtin_bit_cast(unsigned, b); }
__device__ __forceinline__ u32x4 pack8(const f32x4& v0, const f32x4& v1) { u32x4 w; w.x = cvt_pk_bf16(v0[0], v0[1]); w.y = cvt_pk_bf16(v0[2], v0[3]); w.z = cvt_pk_bf16(v1[0], v1[1]); w.w = cvt_pk_bf16(v1[2], v1[3]); return w; }
__device__ __forceinline__ void unpack8(const u32x4& w, f32x4& v0, f32x4& v1) { v0[0] = bflo(w.x); v0[1] = bfhi(w.x); v0[2] = bflo(w.y); v0[3] = bfhi(w.y); v1[0] = bflo(w.z); v1[1] = bfhi(w.z); v1[2] = bflo(w.w); v1[3] = bfhi(w.w); }
typedef int v8i __attribute__((ext_vector_type(8)));
typedef int v4i __attribute__((ext_vector_type(4)));
__device__ __forceinline__ u32x2 pack8_fp8(const f32x4& v0, const f32x4& v1) {
    u32x2 w; int t = 0; t = __builtin_amdgcn_cvt_pk_fp8_f32(v0[0], v0[1], t, false); t = __builtin_amdgcn_cvt_pk_fp8_f32(v0[2], v0[3], t, true); w.x = (unsigned)t;
    int t2 = 0; t2 = __builtin_amdgcn_cvt_pk_fp8_f32(v1[0], v1[1], t2, false); t2 = __builtin_amdgcn_cvt_pk_fp8_f32(v1[2], v1[3], t2, true); w.y = (unsigned)t2; return w; }
__device__ __forceinline__ unsigned pack4_fp8(float a, float b, float c, float d) { int t = 0; t = __builtin_amdgcn_cvt_pk_fp8_f32(a, b, t, false); t = __builtin_amdgcn_cvt_pk_fp8_f32(c, d, t, true); return (unsigned)t; }
__device__ __forceinline__ f32x4 sig4(const f32x4& v) { f32x4 o; o[0] = sigmoidf_(v[0]); o[1] = sigmoidf_(v[1]); o[2] = sigmoidf_(v[2]); o[3] = sigmoidf_(v[3]); return o; }

struct EpiInproj {
    static constexpr bool PERM = true;
    unsigned char* ws; int layer;
    template <int KIND> __device__ __forceinline__ void tile(const f32x4 (&acc)[2][2][4][2], const Unit& u, int wr, int wc, int fr, int fq, unsigned char* w) const {
        const float* biasp = (const float*)(w + biasoff(layer));
        const int row0 = u.pm * BM + wr * 64 + fr, bcol0 = u.pn * BM + wc * 32 + 8 * fq;
        f32x4 bv[2][2];
#pragma unroll
        for (int bj = 0; bj < 2; ++bj)
#pragma unroll
            for (int n = 0; n < 2; ++n) bv[bj][n] = *(const f32x4*)(biasp + bcol0 + bj * HALF + 4 * n);
#pragma unroll
        for (int ai = 0; ai < 2; ++ai)
#pragma unroll
            for (int m = 0; m < 4; ++m) { const size_t row = (size_t)(row0 + ai * HALF + m * 16);
#pragma unroll
                for (int bj = 0; bj < 2; ++bj) { f32x4 v0 = acc[ai][bj][m][0] + bv[bj][0], v1 = acc[ai][bj][m][1] + bv[bj][1]; const int col = bcol0 + bj * HALF;
                    if (KIND == 0) { *(u32x4*)((bf16_t*)(w + WS_QO) + row * 1024 + col) = pack8(v0 * C2, v1 * C2); }
                    else if (KIND == 1) { *(u32x4*)((bf16_t*)(w + WS_KV) + row * 1024 + (col - 512)) = pack8(v0, v1); }
                    else if (KIND == 2) { *(u32x4*)((bf16_t*)(w + WS_KV) + row * 1024 + 512 + (col - 1024)) = pack8(v0, v1); }
                    else if (KIND == 3) { *(u32x4*)((bf16_t*)(w + WS_HB) + row * 1024 + (col - 1536)) = pack8(v0 * sig4(v0), v1 * sig4(v1)); }
                    else if (KIND == 4) { const int c = col - 2048; const float* lb = (const float*)(w + WS_MISC) + layer * 512; const f32x4 l0 = *(const f32x4*)(lb + c), l1 = *(const f32x4*)(lb + c + 4);
                        f32x4 f0 = l0 + (1.f - l0) * sig4(v0), f1 = l1 + (1.f - l1) * sig4(v1);
#pragma unroll
                        for (int q = 0; q < 4; ++q) { f0[q] = __logf(f0[q]); f1[q] = __logf(f1[q]); }
                        float* LOGF = (float*)(w + WS_LOGF); *(f32x4*)(LOGF + row * 512 + c) = f0; *(f32x4*)(LOGF + row * 512 + c + 4) = f1; }
                    else if (KIND == 5) { *(u32x4*)((bf16_t*)(w + WS_HB) + row * 1024 + 512 + (col - 2560)) = pack8(v0, v1); }
                    else if (KIND == 6) { *(u32x4*)((bf16_t*)(w + WS_HG) + row * 512 + (col - 3072)) = pack8(v0 * sig4(v0), v1 * sig4(v1)); }
                    else { *(u32x4*)((bf16_t*)(w + WS_G) + row * 2048 + (col - 3584)) = pack8(sig4(v0), sig4(v1)); }
                } }
    }
    __device__ __forceinline__ void operator()(const f32x4 (&acc)[2][2][4][2], const Unit& u, int wr, int wc, int fr, int fq) const {
        size_t z_ = 0; asm volatile("" : "+s"(z_)); unsigned char* w = ws + z_;
        const int ct = u.pn;
        if (ct < 2) tile<0>(acc, u, wr, wc, fr, fq, w); else if (ct < 4) tile<1>(acc, u, wr, wc, fr, fq, w); else if (ct < 6) tile<2>(acc, u, wr, wc, fr, fq, w);
        else if (ct < 8) tile<3>(acc, u, wr, wc, fr, fq, w); else if (ct < 10) tile<4>(acc, u, wr, wc, fr, fq, w); else if (ct < 12) tile<5>(acc, u, wr, wc, fr, fq, w);
        else if (ct < 14) tile<6>(acc, u, wr, wc, fr, fq, w); else tile<7>(acc, u, wr, wc, fr, fq, w);
    }
};
template <int MODE> struct EpiGate {
    static constexpr bool PERM = true;
    bf16_t* O; const float* bias; const bf16_t* Gt; int ldg; const bf16_t* P;
    __device__ __forceinline__ void operator()(const f32x4 (&acc)[2][2][4][2], const Unit& u, int wr, int wc, int fr, int fq) const {
        const int row0 = u.pm * BM + wr * 64 + fr, col0 = u.pn * BM + wc * 32 + 8 * fq;
        f32x4 bv[2][2];
        if (MODE == 0) {
#pragma unroll
            for (int bj = 0; bj < 2; ++bj)
#pragma unroll
                for (int n = 0; n < 2; ++n) bv[bj][n] = bias ? *(const f32x4*)(bias + col0 + bj * HALF + 4 * n) : (f32x4){0.f, 0.f, 0.f, 0.f};
        }
#pragma unroll
        for (int ai = 0; ai < 2; ++ai)
#pragma unroll
            for (int mh = 0; mh < 2; ++mh) {
                u32x4 gq[2][2], pq[2][2];
                if (MODE != 0) {
#pragma unroll
                    for (int mm = 0; mm < 2; ++mm)
#pragma unroll
                        for (int bj = 0; bj < 2; ++bj) { const size_t row = (size_t)(row0 + ai * HALF + (mh * 2 + mm) * 16); const int col = col0 + bj * HALF;
                            gq[mm][bj] = *(const u32x4*)(Gt + row * ldg + col);
                            if (MODE == 2) pq[mm][bj] = __builtin_nontemporal_load((const u32x4*)(P + row * 1024 + col)); }
                    asm volatile("s_waitcnt vmcnt(0)" ::: "memory");
                }
#pragma unroll
                for (int mm = 0; mm < 2; ++mm)
#pragma unroll
                    for (int bj = 0; bj < 2; ++bj) { const int m = mh * 2 + mm; const size_t row = (size_t)(row0 + ai * HALF + m * 16); const int col = col0 + bj * HALF;
                        f32x4 v0 = acc[ai][bj][m][0], v1 = acc[ai][bj][m][1];
                        if (MODE == 0) { v0 += bv[bj][0]; v1 += bv[bj][1]; }
                        else { f32x4 g0, g1; unpack8(gq[mm][bj], g0, g1); v0 *= g0; v1 *= g1;
                            if (MODE == 2) { f32x4 p0, p1; unpack8(pq[mm][bj], p0, p1); v0 += p0; v1 += p1; } }
                        if (MODE == 2) *(u32x2*)((unsigned char*)O + row * 1024 + col) = pack8_fp8(v0 * SC_U, v1 * SC_U); else *(u32x4*)(O + row * 1024 + col) = pack8(v0, v1); }
                if (MODE != 0) asm volatile("" ::: "memory");
            }
    }
};
struct EpiUp {
    static constexpr bool PERM = true;
    bf16_t* H;
    __device__ __forceinline__ void operator()(const f32x4 (&acc)[2][2][4][2], const Unit& u, int wr, int wc, int fr, int fq) const {
        const int row0 = u.pm * BM + wr * 64 + fr, col = u.pn * HALF + wc * 32 + 8 * fq;
#pragma unroll
        for (int ai = 0; ai < 2; ++ai)
#pragma unroll
            for (int m = 0; m < 4; ++m) { const size_t row = (size_t)(row0 + ai * HALF + m * 16);
                const f32x4 a0 = acc[ai][0][m][0], a1 = acc[ai][0][m][1], b0 = acc[ai][1][m][0], b1 = acc[ai][1][m][1];
                *(u32x2*)((unsigned char*)H + row * 1024 + col) = pack8_fp8(a0 * sig4(a0) * b0 * SC_H, a1 * sig4(a1) * b1 * SC_H); }
    }
};

__device__ __forceinline__ void glds16s(const char* sbase, unsigned voff, unsigned lds_dst) {
    unsigned keep;
    asm volatile("s_mov_b32 %0, m0\n\ts_mov_b32 m0, %3\n\ts_nop 0\n\tglobal_load_lds_dwordx4 %1, %2\n\ts_mov_b32 m0, %0" : "=&s"(keep) : "v"(voff), "s"(sbase), "s"(lds_dst) : "memory");
}
template <class Epi, class Sched, bool ALIGN_EPI>
__device__ __forceinline__ void gemm_phase(LAS unsigned char* lds, const Gemm g, const Sched& S, const Epi& E, const int tid) {
    const int wid = __builtin_amdgcn_readfirstlane(tid >> 6), lane = tid & 63, wr = wid >> 2, wc = wid & 3, fr = lane & 15, fq = lane >> 4;
    int K = g.K; asm volatile("" : "+s"(K));
    const int nt = K / BK;
    int RA[2], CA[2]; unsigned voffB[2];
#pragma unroll
    for (int i = 0; i < 2; ++i) { int R, C; stage_rc(tid * 16 + i * 8192, R, C); const int Rb = Epi::PERM ? ((R & ~31) + perm32(R & 31)) : R;
        RA[i] = R; CA[i] = C; voffB[i] = (unsigned)(Rb * g.ldb + C) * 2u; }
    const size_t kstep = (size_t)(BK * 2);
    const size_t hstepB = (size_t)HALF * g.ldb * 2;
    const unsigned ldsw = (unsigned)wid * 1024u;
    const unsigned ldsb = (unsigned)__builtin_amdgcn_readfirstlane((int)((unsigned)(uintptr_t)lds + ldsw));
    const int aoff = lds_byte(wr * 64 + fr, fq * 8), boff = lds_byte(wc * 32 + fr, fq * 8);
#define PG8_SA(b, h) (((b) * 2 + (h)) * HTB)
#define PG8_SB(b, h) ((4 + (b) * 2 + (h)) * HTB)
#define PG8_STAGE(bufoff, gbase, voff) do { _Pragma("unroll") for (int _i = 0; _i < 2; ++_i) glds16s((const char*)(gbase), (voff)[_i], ldsb + (unsigned)((bufoff) + _i * 8192)); } while (0)
#define PG8_LD8(p) __builtin_shufflevector(*(const LAS v4i*)(p), *(const LAS v4i*)((p) + 1024), 0, 1, 2, 3, 4, 5, 6, 7)
#define PG8_LDA(dst, b, h) do { _Pragma("unroll") for (int m = 0; m < 4; ++m) dst[m] = PG8_LD8(lds + PG8_SA(b, h) + aoff + m * 2048); } while (0)
#define PG8_LDB(dst, b, h) do { _Pragma("unroll") for (int n = 0; n < 2; ++n) dst[n] = PG8_LD8(lds + PG8_SB(b, h) + boff + n * 2048); } while (0)
#define PG8_MMA(ai, bj, At, Bt) do { __builtin_amdgcn_s_setprio(1); _Pragma("unroll") for (int m = 0; m < 4; ++m) _Pragma("unroll") for (int n = 0; n < 2; ++n) \
        asm volatile("v_mfma_scale_f32_16x16x128_f8f6f4 %0, %1, %2, %0, %3, %4 op_sel_hi:[0,0,0]" : "+v"(acc[ai][bj][m][n]) : "v"(Bt[n]), "v"(At[m]), "v"(sbv), "v"(sav)); \
        __builtin_amdgcn_s_setprio(0); } while (0)
#define PG8_WAIT_V(n) asm volatile("s_waitcnt vmcnt(" #n ")" ::: "memory")
#define PG8_WAIT_L(n) asm volatile("s_waitcnt lgkmcnt(" #n ")" ::: "memory")
#define PG8_BAR __builtin_amdgcn_s_barrier()
#define PG8_SCHED __builtin_amdgcn_sched_barrier(0)
    Unit cur, nxt; int ui = 0;
    if (!S.next(0, cur)) return;
    f32x4 acc[2][2][4][2];
#pragma unroll
    for (int a = 0; a < 2; ++a)
#pragma unroll
        for (int b = 0; b < 2; ++b)
#pragma unroll
            for (int m = 0; m < 4; ++m)
#pragma unroll
                for (int n = 0; n < 2; ++n) acc[a][b][m][n] = (f32x4){0.f, 0.f, 0.f, 0.f};
    int sav = g.sa, sbv = g.sb;
    v8i At[4], B0[2], B1[2];
    unsigned vA[2][2], nvA[2][2];
    S.a_voff(g, cur, RA, CA, vA);
    const char* cA = S.a_tile(g, cur); const char* cB = S.b_tile(g, cur);
    PG8_STAGE(PG8_SB(0, 0), cB, voffB); PG8_STAGE(PG8_SB(0, 1), cB + hstepB, voffB); PG8_STAGE(PG8_SA(0, 0), cA, vA[0]); PG8_STAGE(PG8_SA(0, 1), cA, vA[1]);
    if (wr == 1) PG8_BAR;
    PG8_WAIT_V(2); PG8_BAR;
    PG8_STAGE(PG8_SB(1, 0), cB + kstep, voffB); PG8_STAGE(PG8_SA(1, 0), cA + kstep, vA[0]); PG8_STAGE(PG8_SB(1, 1), cB + hstepB + kstep, voffB);
    PG8_WAIT_V(6); PG8_BAR;
    for (;;) {
        const bool has_next = S.next(ui + 1, nxt);
        const char* nA = has_next ? S.a_tile(g, nxt) : cA; const char* nB = has_next ? S.b_tile(g, nxt) : cB;
        if constexpr (Sched::GATHER) {
            if (has_next) { int RA2[2], CA2[2];
#pragma unroll
                for (int i = 0; i < 2; ++i) { int tq = tid; asm volatile("" : "+v"(tq)); stage_rc(tq * 16 + i * 8192, RA2[i], CA2[i]); }
                S.a_voff(g, nxt, RA2, CA2, nvA); }
            else {
#pragma unroll
                for (int h = 0; h < 2; ++h)
#pragma unroll
                    for (int i = 0; i < 2; ++i) nvA[h][i] = vA[h][i]; }
        }
        for (int t = 0; t < nt; t += 2) {
            const bool last = (t == nt - 2);
            const char* a1 = cA + (size_t)(t + 1) * kstep;
            const char* a2 = last ? nA : cA + (size_t)(t + 2) * kstep; const char* b2 = last ? nB : cB + (size_t)(t + 2) * kstep;
            const char* a3 = a2 + kstep; const char* b3 = b2 + kstep;
            unsigned wA0[2], wA1[2];
#pragma unroll
            for (int i = 0; i < 2; ++i) { if constexpr (Sched::GATHER) { wA0[i] = last ? nvA[0][i] : vA[0][i]; wA1[i] = last ? nvA[1][i] : vA[1][i]; } else { wA0[i] = vA[0][i]; wA1[i] = vA[1][i]; } }
            PG8_LDB(B0, 0, 0); PG8_LDB(B1, 0, 1); PG8_SCHED; PG8_LDA(At, 0, 0); PG8_STAGE(PG8_SA(1, 1), a1, vA[1]);
            PG8_WAIT_V(8); PG8_WAIT_L(0); PG8_BAR; PG8_MMA(0, 0, At, B0); PG8_MMA(0, 1, At, B1); PG8_BAR; PG8_SCHED;
            PG8_LDA(At, 0, 1); PG8_STAGE(PG8_SB(0, 0), b2, voffB); PG8_STAGE(PG8_SB(0, 1), b2 + hstepB, voffB); PG8_STAGE(PG8_SA(0, 0), a2, wA0);
            PG8_WAIT_V(8); PG8_WAIT_L(0); PG8_BAR; PG8_MMA(1, 0, At, B0); PG8_MMA(1, 1, At, B1); PG8_BAR; PG8_SCHED;
            PG8_LDB(B0, 1, 0); PG8_LDB(B1, 1, 1); PG8_SCHED; PG8_LDA(At, 1, 0); PG8_STAGE(PG8_SA(0, 1), a2, wA1);
            PG8_WAIT_V(8); PG8_WAIT_L(0); PG8_BAR; PG8_MMA(0, 0, At, B0); PG8_MMA(0, 1, At, B1); PG8_BAR; PG8_SCHED;
            PG8_LDA(At, 1, 1); PG8_STAGE(PG8_SB(1, 0), b3, voffB); PG8_STAGE(PG8_SB(1, 1), b3 + hstepB, voffB); PG8_STAGE(PG8_SA(1, 0), a3, wA0);
            PG8_WAIT_V(8); PG8_WAIT_L(0); PG8_BAR; PG8_MMA(1, 0, At, B0); PG8_MMA(1, 1, At, B1); PG8_BAR; PG8_SCHED;
        }
        if constexpr (ALIGN_EPI) { if (wr == 0) PG8_BAR; }
        asm volatile("s_nop 15\n\ts_nop 15" ::: "memory");
        E(acc, cur, wr, wc, fr, fq);
        if (!has_next) break;
#pragma unroll
        for (int a = 0; a < 2; ++a)
#pragma unroll
            for (int b = 0; b < 2; ++b)
#pragma unroll
                for (int m = 0; m < 4; ++m)
#pragma unroll
                    for (int n = 0; n < 2; ++n) acc[a][b][m][n] = (f32x4){0.f, 0.f, 0.f, 0.f};
        cur = nxt; cA = nA; cB = nB; ++ui;
        if constexpr (Sched::GATHER) {
#pragma unroll
            for (int h = 0; h < 2; ++h)
#pragma unroll
                for (int i = 0; i < 2; ++i) vA[h][i] = nvA[h][i]; }
        if constexpr (ALIGN_EPI) { if (wr == 1) PG8_BAR; }
    }
    PG8_WAIT_V(0);
    if constexpr (!ALIGN_EPI) { if (wr == 0) PG8_BAR; }
    PG8_BAR;
#undef PG8_SA
#undef PG8_SB
#undef PG8_STAGE
#undef PG8_LDA
#undef PG8_LDB
#undef PG8_MMA
#undef PG8_LD8
#undef PG8_WAIT_V
#undef PG8_WAIT_L
#undef PG8_BAR
#undef PG8_SCHED
}
}


#include <hip/hip_bf16.h>
#include <cmath>
namespace attn_body {
using bf16=__hip_bfloat16;
using bf16x8=__attribute__((ext_vector_type(8)))short;
using s16x4=__attribute__((ext_vector_type(4)))short;
using f32x16=__attribute__((ext_vector_type(16)))float;
using u32x4=__attribute__((ext_vector_type(4)))unsigned;
constexpr int BATCH=16,NHEAD=8,SEQ=2048,D=64,DM=1024;
constexpr int NW=8,QBLK=32,QB=QBLK*NW,KVBLK=64,NQB=SEQ/QB;
constexpr int ATTN_PITCH=DM, ATTN_UNIT_ROWS=QB;
__device__ __forceinline__ int crow(int r,int hi){return (r&3)+8*(r>>2)+4*hi;}
#define SBAR() __builtin_amdgcn_sched_barrier(0)
__device__ __forceinline__ void cmask(f32x16&p0,f32x16&p1,int jb,int qrel,int hi){
  const float NEG=-INFINITY; int kb=64*jb+4*hi;
  #pragma unroll
  for(int r=0;r<16;++r){int kv=kb+(r&3)+8*(r>>2); if(kv>qrel)p0[r]=NEG; if(kv+32>qrel)p1[r]=NEG;}
}

constexpr int NSLOT=3, SLOTB=8192;
constexpr int LDS_K=0, LDS_V=NSLOT*SLOTB, LDS_WS=2*NSLOT*SLOTB, LDS_OST=LDS_WS+NW*64*4, LDS_BYTES=LDS_OST+NW*4096;
constexpr float C2=0.125f*1.4426950408889634f;
__device__ __forceinline__ void glds16(const void*gsrc,unsigned lds_dst){unsigned keep;
  asm volatile("s_mov_b32 %0, m0\n\ts_mov_b32 m0, %2\n\ts_nop 0\n\tglobal_load_lds_dwordx4 %1, off\n\ts_mov_b32 m0, %0":"=&s"(keep):"v"(gsrc),"s"(lds_dst):"memory");}
__device__ __forceinline__ float max3f(float a,float b,float c){float r;asm("v_max3_f32 %0, %1, %2, %3":"=v"(r):"v"(a),"v"(b),"v"(c));return r;}
__device__ __forceinline__ float max2f(float a,float b){float r;asm("v_max_f32_e32 %0, %1, %2":"=v"(r):"v"(a),"v"(b));return r;}
__device__ __forceinline__ float fadd_s(float a,float b){float r;asm("v_add_f32_e32 %0, %1, %2":"=v"(r):"v"(a),"v"(b));return r;}
__device__ __forceinline__ float fsub_s(float a,float b){float r;asm("v_sub_f32_e32 %0, %1, %2":"=v"(r):"v"(a),"v"(b));return r;}
typedef float f32x2_t __attribute__((ext_vector_type(2))); typedef __bf16 bf16x2_t __attribute__((ext_vector_type(2)));
__device__ __forceinline__ unsigned cvtpk_s(float lo,float hi){f32x2_t v={lo,hi};bf16x2_t b=__builtin_convertvector(v,bf16x2_t);return __builtin_bit_cast(unsigned,b);}
#define WAIT_BAR(N) asm volatile("s_waitcnt vmcnt(" #N ") lgkmcnt(0)\n\ts_barrier":::"memory")

__device__ __forceinline__ void qkt(f32x16&p0,f32x16&p1,const char*Kslot,const bf16x8*qr,const f32x16&negm,int r32,int hi){
  const char*kb=Kslot+hi*1024+r32*16;
  #pragma unroll
  for(int d0=0;d0<4;++d0){
    const bf16x8 b0=*reinterpret_cast<const bf16x8*>(kb+d0*2048);
    const bf16x8 b1=*reinterpret_cast<const bf16x8*>(kb+d0*2048+512);
    if(d0==0){p0=__builtin_amdgcn_mfma_f32_32x32x16_bf16(b0,qr[0],negm,0,0,0);p1=__builtin_amdgcn_mfma_f32_32x32x16_bf16(b1,qr[0],negm,0,0,0);}
    else{p0=__builtin_amdgcn_mfma_f32_32x32x16_bf16(b0,qr[d0],p0,0,0,0);p1=__builtin_amdgcn_mfma_f32_32x32x16_bf16(b1,qr[d0],p1,0,0,0);}}
}
typedef __attribute__((address_space(3))) const char* lds_cptr;
typedef short v4i16_t __attribute__((ext_vector_type(4)));
__device__ __forceinline__ void kload8(bf16x8*kf,lds_cptr kp){
  kf[0]=*(const __attribute__((address_space(3))) bf16x8*)(kp);      kf[1]=*(const __attribute__((address_space(3))) bf16x8*)(kp+512);
  kf[2]=*(const __attribute__((address_space(3))) bf16x8*)(kp+2048); kf[3]=*(const __attribute__((address_space(3))) bf16x8*)(kp+2560);
  kf[4]=*(const __attribute__((address_space(3))) bf16x8*)(kp+4096); kf[5]=*(const __attribute__((address_space(3))) bf16x8*)(kp+4608);
  kf[6]=*(const __attribute__((address_space(3))) bf16x8*)(kp+6144); kf[7]=*(const __attribute__((address_space(3))) bf16x8*)(kp+6656);
}
__device__ __forceinline__ void kload2(bf16x8*kf,lds_cptr kp,int j){ kf[2*j]=*(const __attribute__((address_space(3))) bf16x8*)(kp+j*2048); kf[2*j+1]=*(const __attribute__((address_space(3))) bf16x8*)(kp+j*2048+512); }
__device__ __forceinline__ s16x4 vtr(lds_cptr p){ return __builtin_bit_cast(s16x4,__builtin_amdgcn_ds_read_tr16_b64_v4i16((__attribute__((address_space(3))) v4i16_t*)p)); }
__device__ __forceinline__ float rowmax(const f32x16&p0,const f32x16&p1){
  float a=max3f(p0[0],p0[1],p1[0]),b=max3f(p0[2],p0[3],p1[1]);a=max3f(a,p1[2],p1[3]);
  #pragma unroll
  for(int r=4;r<16;r+=4){a=max3f(a,p0[r],p0[r+1]);b=max3f(b,p0[r+2],p0[r+3]);a=max3f(a,p1[r],p1[r+1]);b=max3f(b,p1[r+2],p1[r+3]);}
  const float m=max2f(a,b);
  auto rr=__builtin_amdgcn_permlane32_swap(__float_as_uint(m),__float_as_uint(m),false,false);
  return max2f(__uint_as_float(rr[0]),__uint_as_float(rr[1]));
}
__device__ __forceinline__ void pv(f32x16*o,int vb,bf16x8 pa0,bf16x8 pa1,bf16x8 pa2,bf16x8 pa3){
  #pragma unroll
  for(int d0=0;d0<2;++d0){s16x4 lo[4],hi[4];
    #pragma unroll
    for(int ks=0;ks<4;++ks){
      asm volatile("ds_read_b64_tr_b16 %0,%1 offset:%c2":"=&v"(lo[ks]):"v"(vb),"i"(d0*4096+ks*1024):"memory");
      asm volatile("ds_read_b64_tr_b16 %0,%1 offset:%c2":"=&v"(hi[ks]):"v"(vb),"i"(d0*4096+ks*1024+512):"memory");}
    asm volatile("s_waitcnt lgkmcnt(0)":::"memory");SBAR();
    #define PK(k) (bf16x8){lo[k][0],lo[k][1],lo[k][2],lo[k][3],hi[k][0],hi[k][1],hi[k][2],hi[k][3]}
    o[d0]=__builtin_amdgcn_mfma_f32_32x32x16_bf16(pa0,PK(0),o[d0],0,0,0);
    o[d0]=__builtin_amdgcn_mfma_f32_32x32x16_bf16(pa1,PK(1),o[d0],0,0,0);
    o[d0]=__builtin_amdgcn_mfma_f32_32x32x16_bf16(pa2,PK(2),o[d0],0,0,0);
    o[d0]=__builtin_amdgcn_mfma_f32_32x32x16_bf16(pa3,PK(3),o[d0],0,0,0);
    #undef PK
  }
}

#ifndef ATTN_STORE16
#define ATTN_STORE16(p,v) (*(u32x4*)(p)=(v))
#endif
template<int THRL> __device__ __forceinline__ void attn_unit(int b,int h,int qb,const bf16*Q,const bf16*__restrict__ K,const bf16*__restrict__ V,bf16*O,char*shm,const __attribute__((address_space(3))) float*f2,const int tid){
  #define BIAS_H(P,off,g0) { f32x4 x_[2]; _Pragma("unroll") for(int g_=0;g_<2;++g_) x_[g_]=*(const __attribute__((address_space(3))) f32x4*)(fb_+(off)+8*((g0)+g_)); \
      _Pragma("unroll") for(int g_=0;g_<2;++g_) _Pragma("unroll") for(int i_=0;i_<4;++i_) P[4*((g0)+g_)+i_]-=x_[g_][i_]; asm volatile("":::"memory"); }
  #define BIAS(P0,P1,t) do{ const __attribute__((address_space(3))) float* fb_=f2+64*(t)+4*hi; \
    BIAS_H(P0,0,0) BIAS_H(P0,0,2) BIAS_H(P1,32,0) BIAS_H(P1,32,2) }while(0)
  const int lane=tid&63,r32=lane&31,hi=lane>>5; const int wid=__builtin_amdgcn_readfirstlane(tid>>6);
  const long rowbase=(long)b*SEQ; const int q0=qb*QB;
  const bf16*Qw=Q+(rowbase+q0+wid*QBLK)*DM+h*D;
  const bf16*Kh=K+rowbase*DM+h*D,*Vh=V+rowbase*DM+h*D;
  const unsigned lds0=(unsigned)(uintptr_t)shm;
  float*wsf=(float*)(shm+LDS_WS)+wid*64;
  const bf16*ksrc=Kh+(long)lane*DM+wid*8;
  const bf16*vsrc=Vh+(long)(16*(wid&3)+(lane>>2))*DM+(wid>>2)*32+(lane&3)*8;
  const unsigned kdst=lds0+LDS_K+wid*1024, vdst=lds0+LDS_V+wid*1024;
  #define DMA_K(t,slot) glds16(ksrc+(long)(t)*KVBLK*DM,(unsigned)__builtin_amdgcn_readfirstlane(kdst+(slot)))
  #define DMA_V(t,slot) glds16(vsrc+(long)(t)*KVBLK*DM,(unsigned)__builtin_amdgcn_readfirstlane(vdst+(slot)))
  const int vb0=(int)(lds0+LDS_V)+((lane>>4)&1)*32+(lane&3)*8+(4*hi+((lane&15)>>2))*64;
  const char*Kbase=shm+LDS_K; bf16x8 kf[8];
  const lds_cptr shm3=(lds_cptr)shm; const lds_cptr kp0=shm3+LDS_K+hi*1024+r32*16; const lds_cptr vp0=shm3+LDS_V+((lane>>4)&1)*32+(lane&3)*8+(4*hi+((lane&15)>>2))*64;
  const int NT=(q0+QB)/KVBLK;
  DMA_K(0,0);DMA_V(0,0);DMA_K(1,SLOTB);
  bf16x8 qr[4];
  #pragma unroll
  for(int d0=0;d0<4;++d0)qr[d0]=*reinterpret_cast<const bf16x8*>(&Qw[(long)r32*DM+d0*16+hi*8]);
  float mhat=0.f,l_reg=0.f;f32x16 o[2];f32x16 negm; { float z_=0.f; asm volatile("":"+v"(z_)); _Pragma("unroll") for(int r=0;r<16;++r){o[0][r]=z_;o[1][r]=z_;negm[r]=z_;} } asm volatile("":"+v"(negm));
  const int qrel=wid*QBLK+r32;
  #define CMASK(P0,P1,t) do{int jb_=(t)-(NT-4); if(jb_>=0)cmask(P0,P1,jb_,qrel,hi);}while(0)
  bool resc=false;
  #define START(P0,P1) do{ const float rm=rowmax(P0,P1); resc=false; \
    { const float dl=rm; mhat=fadd_s(mhat,dl); \
      _Pragma("unroll") for(int r=0;r<16;++r){P0[r]=fsub_s(P0[r],dl);P1[r]=fsub_s(P1[r],dl);} \
      _Pragma("unroll") for(int r=0;r<16;++r)negm[r]=-mhat; asm volatile("":"+v"(negm)); } \
    _Pragma("unroll") for(int r=0;r<16;++r)P0[r]=__builtin_amdgcn_exp2f(P0[r]); }while(0)
  #define RESC() do{ if(resc){ asm volatile("s_waitcnt lgkmcnt(0)":::"memory"); \
      _Pragma("unroll") for(int d_=0;d_<2;++d_) _Pragma("unroll") for(int r=0;r<16;++r)o[d_][r]*=wsf[crow(r,hi)]; } }while(0)
  f32x16 pA0,pA1,pB0,pB1;
  int sl_prev=0,sl_cur=0,sl_next=SLOTB;
  #define ROT() do{sl_prev=sl_cur;sl_cur=sl_next;sl_next=(sl_next==(NSLOT-1)*SLOTB)?0:sl_next+SLOTB;}while(0)
  DMA_K(2,2*SLOTB);
  WAIT_BAR(3);
  qkt(pA0,pA1,Kbase,qr,negm,r32,hi);asm volatile("s_nop 15\n\ts_nop 7":"+v"(pA0),"+v"(pA1));CMASK(pA0,pA1,0);BIAS(pA0,pA1,0);
  START(pA0,pA1);
  _Pragma("unroll") for(int r=0;r<16;++r)pA1[r]=__builtin_amdgcn_exp2f(pA1[r]);
  WAIT_BAR(0);
  DMA_K(3,0);DMA_V(1,SLOTB);
  ROT();
  kload8(kf,kp0+sl_cur);
  WAIT_BAR(2);
  s16x4 vlo[8],vhi[8]; u32x4 pw0,pw1,pw2,pw3;
  #define PKW(P,B) cvtpk_s(P[B],P[B+1])
  #define PAF(k) __builtin_bit_cast(bf16x8,pw##k)
  #define VFR(i) (bf16x8){vlo[i][0],vlo[i][1],vlo[i][2],vlo[i][3],vhi[i][0],vhi[i][1],vhi[i][2],vhi[i][3]}
  #define PIN(x) asm volatile("":"+v"(x))
  #define MX3(a,b,c) __builtin_fmaxf(__builtin_fmaxf((a),(b)),(c))
  #define GAPA(MF,A0,A1,A2,A3,W0,W1,PW) do{ MF; sacc+=A0; sacc+=A1; sacc+=A2; sacc+=A3; PIN(sacc); W0; W1; PIN(PW); SBAR(); }while(0)
  #define EX(v) __builtin_amdgcn_exp2f(v)
  #define GAPB(MF,X,B) do{ MF; X[B]=EX(X[B]); X[B+1]=EX(X[B+1]); X[B+2]=EX(X[B+2]); X[B+3]=EX(X[B+3]); PIN(X); SBAR(); }while(0)
  #define VRD(i) do{ vlo[i]=vtr(vp_+(((i)>>2)*4096+((i)&3)*1024)); vhi[i]=vtr(vp_+(((i)>>2)*4096+((i)&3)*1024+512)); }while(0)
  #define KRD(G,j) do{ if(G){ kload2(kf,kp0+sl_next,j); SBAR(); } }while(0)
  #define STEP(C0,C1,P0,P1,t,GK,GV,GL) do{ SBAR(); \
    const lds_cptr vp_=vp0+sl_prev; \
    VRD(0); SBAR(); float sacc=(P0[0]+P0[1]); \
    GAPA(C0=__builtin_amdgcn_mfma_f32_32x32x16_bf16(kf[0],qr[0],negm,0,0,0), P0[2],P0[3],P0[4],P0[5],     pw0[0]=PKW(P0,0), pw0[1]=PKW(P0,2), pw0); \
    VRD(4); SBAR(); GAPA(C1=__builtin_amdgcn_mfma_f32_32x32x16_bf16(kf[1],qr[0],negm,0,0,0), P0[6],P0[7],P0[8],P0[9],     pw0[2]=PKW(P0,4), pw0[3]=PKW(P0,6), pw0); \
    VRD(1); SBAR(); GAPA(C0=__builtin_amdgcn_mfma_f32_32x32x16_bf16(kf[2],qr[1],C0,0,0,0),   P0[10],P0[11],P0[12],P0[13], pw1[0]=PKW(P0,8), pw1[1]=PKW(P0,10), pw1); \
    VRD(5); SBAR(); GAPA(C1=__builtin_amdgcn_mfma_f32_32x32x16_bf16(kf[3],qr[1],C1,0,0,0),   P0[14],P0[15],P1[0],P1[1],   pw1[2]=PKW(P0,12),pw1[3]=PKW(P0,14), pw1); \
    VRD(2); SBAR(); GAPA(C0=__builtin_amdgcn_mfma_f32_32x32x16_bf16(kf[4],qr[2],C0,0,0,0),   P1[2],P1[3],P1[4],P1[5],     pw2[0]=PKW(P1,0), pw2[1]=PKW(P1,2), pw2); \
    VRD(6); SBAR(); GAPA(C1=__builtin_amdgcn_mfma_f32_32x32x16_bf16(kf[5],qr[2],C1,0,0,0),   P1[6],P1[7],P1[8],P1[9],     pw2[2]=PKW(P1,4), pw2[3]=PKW(P1,6), pw2); \
    VRD(3); SBAR(); GAPA(C0=__builtin_amdgcn_mfma_f32_32x32x16_bf16(kf[6],qr[3],C0,0,0,0),   P1[10],P1[11],P1[12],P1[13], pw3[0]=PKW(P1,8), pw3[1]=PKW(P1,10), pw3); \
    VRD(7); SBAR(); GAPA(C1=__builtin_amdgcn_mfma_f32_32x32x16_bf16(kf[7],qr[3],C1,0,0,0),   P1[14],P1[15],0.f,0.f,       pw3[2]=PKW(P1,12),pw3[3]=PKW(P1,14), pw3); \
    l_reg+=sacc; \
    if(GK){DMA_K((t)+3,sl_cur);} if(GV){DMA_V((t)+1,sl_next);} \
    CMASK(C0,C1,t); BIAS(C0,C1,t); \
    { float a=MX3(C0[0],C0[1],C1[0]),b=MX3(C0[2],C0[3],C1[1]); a=MX3(a,C1[2],C1[3]); \
      _Pragma("unroll") for(int r=4;r<16;r+=4){a=MX3(a,C0[r],C0[r+1]);b=MX3(b,C0[r+2],C0[r+3]);a=MX3(a,C1[r],C1[r+1]);b=MX3(b,C1[r+2],C1[r+3]);} \
      float rm=__builtin_fmaxf(a,b); { auto rr=__builtin_amdgcn_permlane32_swap(__float_as_uint(rm),__float_as_uint(rm),false,false); rm=__builtin_fmaxf(__uint_as_float(rr[0]),__uint_as_float(rr[1])); } \
      resc=false; \
      if(__builtin_expect(__any(rm>(float)THRL),0)){ const float dl=__builtin_fmaxf(rm,0.f); mhat+=dl; \
        _Pragma("unroll") for(int r=0;r<16;++r){C0[r]-=dl;C1[r]-=dl;} \
        _Pragma("unroll") for(int r=0;r<16;++r)negm[r]=-mhat; asm volatile("":"+v"(negm)); \
        const float f=__builtin_amdgcn_exp2f(-dl); l_reg*=f; if(hi==0)wsf[r32]=f; resc=true; } } \
    SBAR(); \
    GAPB(o[0]=__builtin_amdgcn_mfma_f32_32x32x16_bf16(PAF(0),VFR(0),o[0],0,0,0), C0,0); \
    GAPB(o[1]=__builtin_amdgcn_mfma_f32_32x32x16_bf16(PAF(0),VFR(4),o[1],0,0,0), C0,4); \
    KRD(GL,0); GAPB(o[0]=__builtin_amdgcn_mfma_f32_32x32x16_bf16(PAF(1),VFR(1),o[0],0,0,0), C0,8); \
    KRD(GL,1); GAPB(o[1]=__builtin_amdgcn_mfma_f32_32x32x16_bf16(PAF(1),VFR(5),o[1],0,0,0), C0,12); \
    KRD(GL,2); GAPB(o[0]=__builtin_amdgcn_mfma_f32_32x32x16_bf16(PAF(2),VFR(2),o[0],0,0,0), C1,0); \
    KRD(GL,3); GAPB(o[1]=__builtin_amdgcn_mfma_f32_32x32x16_bf16(PAF(2),VFR(6),o[1],0,0,0), C1,4); \
    GAPB(o[0]=__builtin_amdgcn_mfma_f32_32x32x16_bf16(PAF(3),VFR(3),o[0],0,0,0), C1,8); \
    GAPB(o[1]=__builtin_amdgcn_mfma_f32_32x32x16_bf16(PAF(3),VFR(7),o[1],0,0,0), C1,12); \
    }while(0)
  int t=1;
  #undef CMASK
  #define CMASK(P0,P1,t) do{}while(0)
  for(;t+5<NT;t+=2){
    STEP(pB0,pB1,pA0,pA1,t,true,true,true);     WAIT_BAR(2); RESC(); ROT();
    STEP(pA0,pA1,pB0,pB1,t+1,true,true,true);   WAIT_BAR(2); RESC(); ROT();
  }
  #undef CMASK
  #define CMASK(P0,P1,t) do{int jb_=(t)-(NT-4); if(jb_>=0)cmask(P0,P1,jb_,qrel,hi);}while(0)
  #define ENDW(tt) do{ if((tt)+3<NT){WAIT_BAR(2);} else if((tt)+2<NT){WAIT_BAR(1);} else {WAIT_BAR(0);} }while(0)
  for(;t+1<NT;t+=2){
    STEP(pB0,pB1,pA0,pA1,t,(t+3<NT),(t+1<NT),(t+1<NT));       ENDW(t);   RESC(); ROT();
    STEP(pA0,pA1,pB0,pB1,t+1,(t+4<NT),(t+2<NT),(t+2<NT));     ENDW(t+1); RESC(); ROT();
  }
  STEP(pB0,pB1,pA0,pA1,NT-1,false,false,false); RESC();
  { float sacc=pB0[0]+pB0[1]; _Pragma("unroll") for(int r=2;r<16;++r)sacc+=pB0[r]; _Pragma("unroll") for(int r=0;r<16;++r)sacc+=pB1[r]; l_reg+=sacc;
    pw0=(u32x4){PKW(pB0,0),PKW(pB0,2),PKW(pB0,4),PKW(pB0,6)};pw1=(u32x4){PKW(pB0,8),PKW(pB0,10),PKW(pB0,12),PKW(pB0,14)};pw2=(u32x4){PKW(pB1,0),PKW(pB1,2),PKW(pB1,4),PKW(pB1,6)};pw3=(u32x4){PKW(pB1,8),PKW(pB1,10),PKW(pB1,12),PKW(pB1,14)};
    SBAR(); pv(o,vb0+sl_cur,PAF(0),PAF(1),PAF(2),PAF(3)); }
  #undef PKW
  #undef PAF
  #undef VFR
  #undef PIN
  #undef MX3
  #undef GAPA
  #undef GAPB
  #undef EX
  #undef VRD
  #undef KRD
  #undef STEP
  #undef ENDW
  {auto rr=__builtin_amdgcn_permlane32_swap(__float_as_uint(l_reg),__float_as_uint(l_reg),false,false);l_reg=__uint_as_float(rr[0])+__uint_as_float(rr[1]);}
  if(hi==0)wsf[32+r32]=l_reg;asm volatile("s_waitcnt lgkmcnt(0)":::"memory");
  float rli[16];
  #pragma unroll
  for(int r=0;r<16;++r)rli[r]=__builtin_amdgcn_rcpf(wsf[32+crow(r,hi)]);
  { bf16*stg=(bf16*)(shm+LDS_OST)+wid*2048;
    #pragma unroll
    for(int r=0;r<16;++r){const int orow=crow(r,hi);
      #pragma unroll
      for(int d0=0;d0<2;++d0)stg[orow*64+d0*32+r32]=__float2bfloat16(o[d0][r]*rli[r]);}
    asm volatile("s_waitcnt lgkmcnt(0)":::"memory");
    unsigned char*O8w=(unsigned char*)O+(rowbase+q0+wid*QBLK)*DM+h*D;
    _Pragma("unroll") for(int i=0;i<4;++i){const int row=i*8+(lane>>3),ch=lane&7; const u32x4 v=*(const u32x4*)(stg+row*64+ch*8);
      u32x2 w8; w8.x=pg8::pack4_fp8(bflo(v.x)*SC_FOX,bfhi(v.x)*SC_FOX,bflo(v.y)*SC_FOX,bfhi(v.y)*SC_FOX); w8.y=pg8::pack4_fp8(bflo(v.z)*SC_FOX,bfhi(v.z)*SC_FOX,bflo(v.w)*SC_FOX,bfhi(v.w)*SC_FOX);
      *(u32x2*)(O8w+(long)row*DM+ch*8)=w8;} }
  asm volatile("s_waitcnt lgkmcnt(0)\n\ts_barrier":::"memory");
  #undef BIAS
  #undef BIAS_H
  #undef DMA_K
  #undef DMA_V
  #undef CMASK
  #undef START
  #undef RESC
  #undef ROT
}
constexpr int ATTN_LDS_BYTES=LDS_BYTES;
#undef SBAR
#undef WAIT_BAR
}


constexpr int NWAVES = 8;
constexpr int RING_OFF = 0, RING_BYTES = 131072;
constexpr int LDSCTL_OFF = RING_BYTES, MISC_OFF = LDSCTL_OFF + 320, TAB_OFF = LDSCTL_OFF + 1024;
constexpr int WTAB_OFF = LDSCTL_OFF + 2048;
constexpr int LDS_BYTES = 147456;
typedef GAS unsigned gu32;
__device__ __forceinline__ unsigned hw_wave_key() { return (unsigned)__builtin_amdgcn_s_getreg((5 << 11) | 4) & 63u; }
#define RLX_AGENT __ATOMIC_RELAXED, __HIP_MEMORY_SCOPE_AGENT

#define XB_TMO      128
#define XB_XCNT(j)  (256  + 64 * (j))
#define XB_XSUB(j)  (1280 + 64 * (j))
#define XB_XGEN(j)  (2304 + 64 * (j))
#define XB_TOP      3328
#define XB_TOPGEN   3392
#define XCD_BAR_WORDS 3456
#define XB_SPIN_CAP (1u << 18)

__device__ __forceinline__ unsigned xb_ld(unsigned* p)              { return __hip_atomic_load(p, __ATOMIC_RELAXED, __HIP_MEMORY_SCOPE_AGENT); }
__device__ __forceinline__ unsigned xb_add(unsigned* p, unsigned v) { return __hip_atomic_fetch_add(p, v, __ATOMIC_RELAXED, __HIP_MEMORY_SCOPE_AGENT); }
__device__ __forceinline__ unsigned xb_xcc_id() { return (unsigned)__builtin_amdgcn_s_getreg((3 << 11) | 20) & 0xFu; }
#define XB_SPIN(cond, bar) do { unsigned _sp = 0; while (cond) { __builtin_amdgcn_s_sleep(1); \
    if ((++_sp & 255u) == 0u) { if (xb_ld(&(bar)[XB_TMO])) break; if (_sp > XB_SPIN_CAP) { atomicAdd(&(bar)[XB_TMO], 1u); break; } } } } while (0)

struct XcdBarrier {
    unsigned* bar; unsigned x;
    volatile LAS unsigned* st;
};

__device__ __forceinline__ XcdBarrier xcd_barrier_post(unsigned* bar, volatile LAS unsigned* st) {
    XcdBarrier b; b.bar = bar; b.x = xb_xcc_id(); b.st = st;
    if (threadIdx.x == 0) (void)xb_add(&bar[XB_XCNT(b.x)], 1u);
    return b;
}
__device__ __forceinline__ void xcd_barrier_complete(unsigned* bar, unsigned x, unsigned& nloc, unsigned& nx) {
    const unsigned G = gridDim.x * gridDim.y * gridDim.z;
    unsigned sum, cnt, mine, sp = 0u;
    for (;;) {
        sum = 0u; cnt = 0u; mine = 0u;
#pragma unroll
        for (unsigned j = 0; j < 16; ++j) { const unsigned c = xb_ld(&bar[XB_XCNT(j)]); sum += c; cnt += (c > 0u) ? 1u : 0u; mine = (j == x) ? c : mine; }
        if (sum == G) break;
        __builtin_amdgcn_s_sleep(1);
        if ((++sp & 255u) == 0u) { if (xb_ld(&bar[XB_TMO])) break; if (sp > XB_SPIN_CAP) { atomicAdd(&bar[XB_TMO], 1u); break; } }
    }
    nloc = mine > 0u ? mine : 1u; nx = cnt > 0u ? cnt : 1u;
}

__device__ __forceinline__ void xcd_barrier(const XcdBarrier& b) {
    asm volatile("s_waitcnt vmcnt(0)" ::: "memory");
    __syncthreads();
    if (threadIdx.x == 0) {
        unsigned* bar = b.bar;
        __builtin_amdgcn_s_waitcnt(0);
        unsigned nloc = b.st[0], nx = b.st[1];
        if (nloc == 0u) { xcd_barrier_complete(bar, b.x, nloc, nx); b.st[0] = nloc; b.st[1] = nx; }
        const unsigned old = xb_add(&bar[XB_XSUB(b.x)], 1u);
        const unsigned gen = old / nloc;
        if (old + 1u == (gen + 1u) * nloc) {
            __builtin_amdgcn_fence(__ATOMIC_RELEASE, "agent");
            asm volatile("s_waitcnt vmcnt(0)" ::: "memory");
            const unsigned og = xb_add(&bar[XB_TOP], 1u);
            const unsigned tg = og / nx;
            if (og + 1u == (tg + 1u) * nx) xb_add(&bar[XB_TOPGEN], 1u);
            else XB_SPIN(xb_ld(&bar[XB_TOPGEN]) == tg, bar);
            __builtin_amdgcn_fence(__ATOMIC_ACQUIRE, "agent");
            xb_add(&bar[XB_XGEN(b.x)], 1u);
            asm volatile("s_waitcnt vmcnt(0)" ::: "memory");
        } else {
            XB_SPIN(xb_ld(&bar[XB_XGEN(b.x)]) == gen, bar);
            __builtin_amdgcn_fence(__ATOMIC_ACQUIRE, "agent");
            asm volatile("s_waitcnt vmcnt(0)" ::: "memory");
        }
    }
    __syncthreads();
}


struct Args {
    const float *x, *ln_in_g, *ln_in_b, *w_in, *b_in, *w_fox, *lbl, *norm_g, *w_hgrn, *w_mix, *b_mix, *ln1_g, *ln1_b, *router_w, *router_b, *w1, *w3, *w2, *ln2_g, *ln2_b;
    float* out; unsigned char* ws; int ph_lo, ph_hi, use_bar, pad;
};
struct Frame { LAS unsigned char* lds; int tid, lane, wave, G, gw, ngw, bid; };
#define LOAD_ARGS() launder_args(args)
__device__ __forceinline__ Args launder_args(const Args& args) { Args a = args; size_t z_ = 0; asm volatile("" : "+s"(z_)); a.ws = args.ws + z_; return a; }

__device__ __forceinline__ void ln_rows16(f32x4 (&v)[4], const float* g, const float* bta, int lane) {
    float s = 0.f;
#pragma unroll
    for (int j = 0; j < 4; ++j) s += (v[j].x + v[j].y) + (v[j].z + v[j].w);
    const float mean = wave_sum(s) * (1.f / D); float s2 = 0.f;
#pragma unroll
    for (int j = 0; j < 4; ++j) { v[j] = v[j] - mean; s2 += (v[j].x * v[j].x + v[j].y * v[j].y) + (v[j].z * v[j].z + v[j].w * v[j].w); }
    const float rstd = rsqrtf(wave_sum(s2) * (1.f / D) + LN_EPS);
#pragma unroll
    for (int j = 0; j < 4; ++j) { const int c = 4 * lane + 256 * j; const f32x4 gg = *(const f32x4*)(g + c), bb = *(const f32x4*)(bta + c); v[j] = v[j] * rstd * gg + bb; }
}
__device__ __forceinline__ void store_row(const f32x4 (&v)[4], int lane, float* of32, unsigned char* obf, float* of32b) {
#pragma unroll
    for (int j = 0; j < 4; ++j) { const int c = 4 * lane + 256 * j;
        if (of32) *(f32x4*)(of32 + c) = v[j];
        if (of32b) *(f32x4*)(of32b + c) = v[j];
        if (obf) *(unsigned*)(obf + c) = pg8::pack4_fp8(v[j].x, v[j].y, v[j].z, v[j].w); }
}

struct CvtDesc { const float* W; int ldw, k0, srccol, nvalid; unsigned char* WT; int dstrow, dstk; };
__device__ __forceinline__ void cvt_load(const CvtDesc& d, f32x4 (&v)[8], int lane) {
    const int ks = lane >> 3, n4 = (lane & 7) * 4;
#pragma unroll
    for (int j = 0; j < 8; ++j) v[j] = (n4 < d.nvalid) ? *(const f32x4*)(d.W + (size_t)(d.k0 + 8 * j + ks) * d.ldw + d.srccol + n4) : (f32x4){0.f, 0.f, 0.f, 0.f};
}
__device__ __forceinline__ void cvt_store(const CvtDesc& d, const f32x4 (&v)[8], LAS float* scr, int lane) {
    const int ks = lane >> 3, n4 = (lane & 7) * 4;
#pragma unroll
    for (int j = 0; j < 8; ++j) { LAS float* p = scr + (8 * j + ks) * 33 + n4; p[0] = v[j][0]; p[1] = v[j][1]; p[2] = v[j][2]; p[3] = v[j][3]; }
    asm volatile("s_waitcnt lgkmcnt(0)" ::: "memory");
    const int c = lane & 7;
#pragma unroll
    for (int j = 0; j < 4; ++j) { const int n = (lane >> 3) + 8 * j; const LAS float* s = scr + (8 * c) * 33 + n;
        u32x2 o; o.x = pg8::pack4_fp8(s[0 * 33] * SC_W, s[1 * 33] * SC_W, s[2 * 33] * SC_W, s[3 * 33] * SC_W); o.y = pg8::pack4_fp8(s[4 * 33] * SC_W, s[5 * 33] * SC_W, s[6 * 33] * SC_W, s[7 * 33] * SC_W);
        *(u32x2*)(d.WT + (size_t)(d.dstrow + n) * 1024 + d.dstk + d.k0 + 8 * c) = o; }
    asm volatile("s_waitcnt lgkmcnt(0)" ::: "memory");
}
__device__ __forceinline__ CvtDesc cvt_decode(const Args& a, int l, int it) {
    unsigned char* WS_ = a.ws + wset(l);
    constexpr int I_IN = 16 * 176, I_BR = 8 * 32, I_MIX = 16 * 32, I_13 = 16 * 64 * NE;
    CvtDesc d; int r = it;
    if (r < I_IN) { const int kb = r / 176, nb = r % 176, n0 = nb * 32;
        const int src = (n0 < 1536) ? n0 : n0 + 8, nv = 32;
        d.W = a.w_in + (size_t)l * D * NIN; d.ldw = NIN; d.k0 = kb * 64; d.srccol = src; d.nvalid = nv; d.WT = WS_ + WO_WIN; d.dstrow = n0; d.dstk = 0; return d; } r -= I_IN;
    if (r < I_BR) { const int kb = r / 32, nb = r % 32; d.W = a.w_fox + (size_t)l * 512 * D; d.ldw = D; d.k0 = kb * 64; d.srccol = nb * 32; d.nvalid = 32; d.WT = WS_ + WO_WBR; d.dstrow = nb * 32; d.dstk = 0; return d; } r -= I_BR;
    if (r < I_BR) { const int kb = r / 32, nb = r % 32; d.W = a.w_hgrn + (size_t)l * 512 * D; d.ldw = D; d.k0 = kb * 64; d.srccol = nb * 32; d.nvalid = 32; d.WT = WS_ + WO_WBR; d.dstrow = nb * 32; d.dstk = 512; return d; } r -= I_BR;
    if (r < I_MIX) { const int kb = r / 32, nb = r % 32; d.W = a.w_mix + (size_t)l * D * D; d.ldw = D; d.k0 = kb * 64; d.srccol = nb * 32; d.nvalid = 32; d.WT = WS_ + WO_WMIX; d.dstrow = nb * 32; d.dstk = 0; return d; } r -= I_MIX;
    if (r < I_13) { const int e = r / 1024, q = r % 1024, kb = q / 64, nb = q % 64, n0 = nb * 32;
        const int j = n0 >> 8, rr = n0 & 255; d.W = (rr < 128 ? a.w1 : a.w3) + ((size_t)l * NE + e) * D * D; d.ldw = D; d.k0 = kb * 64; d.srccol = 128 * j + (rr & 127); d.nvalid = 32;
        d.WT = WS_ + WO_W13 + (size_t)e * 2048 * D; d.dstrow = n0; d.dstk = 0; return d; } r -= I_13;
    { const int e = r / 512, q = r % 512, kb = q / 32, nb = q % 32; d.W = a.w2 + ((size_t)l * NE + e) * D * D; d.ldw = D; d.k0 = kb * 64; d.srccol = nb * 32; d.nvalid = 32;
      d.WT = WS_ + WO_W2 + (size_t)e * D * D; d.dstrow = nb * 32; d.dstk = 0; return d; }
}
__device__ __forceinline__ void convert_layer(const Args& a, const Frame& F, int l, int gw, int ngw) {
    LAS float* scr = (LAS float*)(F.lds + RING_OFF + F.wave * 16384);
    const int lane = F.lane;
    constexpr int NITEMS = 16 * 176 + 2 * 8 * 32 + 16 * 32 + 16 * 64 * NE + 16 * 32 * NE;
    for (int it = gw; it < NITEMS; it += 2 * ngw) {
        const CvtDesc d0 = cvt_decode(a, l, it); f32x4 v0[8]; cvt_load(d0, v0, lane);
        const bool two = it + ngw < NITEMS;
        if (two) { const CvtDesc d1 = cvt_decode(a, l, it + ngw); f32x4 v1[8]; cvt_load(d1, v1, lane); cvt_store(d0, v0, scr, lane); cvt_store(d1, v1, scr, lane); }
        else cvt_store(d0, v0, scr, lane);
    }
    float* biasp = (float*)(a.ws + biasoff(l));
    for (int n = gw * 64 + lane; n < NINP; n += ngw * 64) {
        biasp[n] = (n < 1536) ? a.b_in[l * NIN + n] : a.b_in[l * NIN + n + 8]; }
}


constexpr int WFF_OFF = 65536 + 16384;
__device__ __forceinline__ void load_wff(const Args& a, const Frame& F, int l) {
    LAS float* wff = (LAS float*)(F.lds + RING_OFF + WFF_OFF);
    for (int i = F.tid; i < 8 * D; i += NWAVES * 64) { const int c = i >> 3, h = i & 7; wff[h * D + c] = a.w_in[((size_t)l * D + c) * NIN + 1536 + h]; }
}
__device__ __forceinline__ void fox_gates_row(const Args& a, const Frame& F, int l, const f32x4 (&v)[4], int row) {
    const LAS float* wff = (const LAS float*)(F.lds + RING_OFF + WFF_OFF); const int lane = F.lane;
    float p[8];
#pragma unroll
    for (int h = 0; h < 8; ++h) { float s = 0.f;
#pragma unroll
        for (int j = 0; j < 4; ++j) { const f32x4 r4 = *(const LAS f32x4*)(wff + h * D + 4 * lane + 256 * j); s += v[j].x * r4.x + v[j].y * r4.y + v[j].z * r4.z + v[j].w * r4.w; }
        p[h] = s; }
    const bool hi5 = (lane & 32) != 0;
#pragma unroll
    for (int k = 0; k < 4; ++k) { const float snd = hi5 ? p[k] : p[k + 4]; const float rcv = __shfl_xor(snd, 32); p[k] = (hi5 ? p[k + 4] : p[k]) + rcv; }
    const bool hi4 = (lane & 16) != 0;
#pragma unroll
    for (int k = 0; k < 2; ++k) { const float snd = hi4 ? p[k] : p[k + 2]; const float rcv = __shfl_xor(snd, 16); p[k] = (hi4 ? p[k + 2] : p[k]) + rcv; }
    const bool hi3 = (lane & 8) != 0;
    { const float snd = hi3 ? p[0] : p[1]; const float rcv = __shfl_xor(snd, 8); p[0] = (hi3 ? p[1] : p[0]) + rcv; }
    p[0] += __shfl_xor(p[0], 4); p[0] += __shfl_xor(p[0], 2); p[0] += __shfl_xor(p[0], 1);
    if ((lane & 7) == 0) { const int h = lane >> 3; ((float*)(a.ws + WS_FL))[(size_t)row * 8 + h] = logsigmoidf_(p[0] + a.b_in[l * NIN + 1536 + h]); }
}

__device__ __forceinline__ void phase_prep(const Args& a, const Frame& F) {
    if (F.bid == 0) {
        float* lb_all = (float*)(a.ws + WS_MISC);
        const int c = F.tid;
        float v[DEPTH], m = -1e30f;
#pragma unroll
        for (int l = 0; l < DEPTH; ++l) { v[l] = a.lbl[l * 512 + c]; m = fmaxf(m, v[l]); }
        float s = 0.f;
#pragma unroll
        for (int l = 0; l < DEPTH; ++l) { v[l] = __expf(v[l] - m); s += v[l]; }
        float cum = 0.f;
#pragma unroll
        for (int l = 0; l < DEPTH; ++l) { const float p = v[l] / s; cum += p; lb_all[l * 512 + c] = cum - v[0] / s; }
    }
    float* XRES = (float*)(a.ws + WS_XRES); unsigned char* XN = a.ws + WS_XN;
    load_wff(a, F, 0); __syncthreads();
    for (int row = F.gw; row < T; row += F.ngw) {
        f32x4 v[4];
#pragma unroll
        for (int j = 0; j < 4; ++j) v[j] = *(const f32x4*)(a.x + (size_t)row * D + 4 * F.lane + 256 * j);
        ln_rows16(v, a.ln_in_g, a.ln_in_b, F.lane);
        store_row(v, F.lane, XRES + (size_t)row * D, XN + (size_t)row * D, nullptr);
        fox_gates_row(a, F, 0, v, row);
    }
    __syncthreads();
    convert_layer(a, F, 0, F.gw, F.ngw);
}

__device__ __forceinline__ void phase_fscan(const Args& a, const Frame& F) {
    if (F.bid >= BATCH * NH) return;
    const float* FL = (const float*)(a.ws + WS_FL); float* F2 = (float*)(a.ws + WS_F2);
    LAS float* wsum = (LAS float*)(F.lds + RING_OFF);
    const int bh = F.bid, b = bh >> 3, h = bh & 7, tid = F.tid, lane = F.lane, w = F.wave;
    float v[4], run = 0.f;
#pragma unroll
    for (int i = 0; i < 4; ++i) { run += FL[((size_t)b * SEQ + tid * 4 + i) * 8 + h]; v[i] = run; }
    float incl = run;
#pragma unroll
    for (int o = 1; o < 64; o <<= 1) { const float u = __shfl_up(incl, o); if (lane >= o) incl += u; }
    if (lane == 63) wsum[w] = incl;
    __syncthreads();
    float base = incl - run; for (int i = 0; i < w; ++i) base += wsum[i];
#pragma unroll
    for (int i = 0; i < 4; ++i) F2[(size_t)bh * SEQ + tid * 4 + i] = (base + v[i]) * LOG2E;
    __syncthreads();
}

__device__ __forceinline__ void phase_attn_naive(const Args& a, const Frame& F) {
    const bf16_t* QO = (const bf16_t*)(a.ws + WS_QO); const bf16_t* KV = (const bf16_t*)(a.ws + WS_KV); const float* F2 = (const float*)(a.ws + WS_F2); bf16_t* O = (bf16_t*)(a.ws + WS_QO);
    LAS float* ps = (LAS float*)(F.lds + RING_OFF) + F.wave * 64;
    const int lane = F.lane;
    for (int gid = F.gw; gid < BATCH * NH * SEQ; gid += F.ngw) {
        const int bh = gid & 127, t = gid >> 7, b = bh >> 3, h = bh & 7;
        float q[64];
        { const bf16_t* qp = QO + ((size_t)b * SEQ + t) * 1024 + h * 64;
#pragma unroll
          for (int c = 0; c < 8; ++c) { const u32x4 u = *(const u32x4*)(qp + c * 8);
            q[c * 8 + 0] = bflo(u.x); q[c * 8 + 1] = bfhi(u.x); q[c * 8 + 2] = bflo(u.y); q[c * 8 + 3] = bfhi(u.y);
            q[c * 8 + 4] = bflo(u.z); q[c * 8 + 5] = bfhi(u.z); q[c * 8 + 6] = bflo(u.w); q[c * 8 + 7] = bfhi(u.w); } }
        float m = -1e30f, l = 0.f, o = 0.f;
        const float* f2 = F2 + (size_t)bh * SEQ;
        for (int s0 = 0; s0 <= t; s0 += 64) {
            const int s = s0 + lane; const bool valid = s <= t;
            float sc = -1e30f;
            if (valid) { const bf16_t* kp = KV + ((size_t)b * SEQ + s) * 1024 + h * 64; float d = 0.f;
#pragma unroll
                for (int c = 0; c < 8; ++c) { const u32x4 u = *(const u32x4*)(kp + c * 8);
                    d += q[c * 8 + 0] * bflo(u.x) + q[c * 8 + 1] * bfhi(u.x) + q[c * 8 + 2] * bflo(u.y) + q[c * 8 + 3] * bfhi(u.y)
                       + q[c * 8 + 4] * bflo(u.z) + q[c * 8 + 5] * bfhi(u.z) + q[c * 8 + 6] * bflo(u.w) + q[c * 8 + 7] * bfhi(u.w); }
                sc = d - f2[s]; }
            const float mn = fmaxf(m, wave_max(sc));
            const float p = valid ? exp2f(sc - mn) : 0.f;
            const float f = exp2f(m - mn);
            l = l * f + wave_sum(p); o *= f; m = mn;
            ps[lane] = p;
            asm volatile("s_waitcnt lgkmcnt(0)" ::: "memory");
            const int nk = min(64, t - s0 + 1);
            const bf16_t* vp = KV + ((size_t)b * SEQ + s0) * 1024 + 512 + h * 64 + lane;
            for (int j = 0; j < nk; ++j) o += ps[j] * bf2f(vp[(size_t)j * 1024]);
            asm volatile("s_waitcnt lgkmcnt(0)" ::: "memory");
        }
        O[((size_t)b * SEQ + t) * 1024 + h * 64 + lane] = (bf16_t)f2bf(o / l);
    }
}

__device__ __forceinline__ void phase_hgrn_naive(const Args& a, const Frame& F, int l) {
    if (F.bid >= BATCH * NH || F.wave != 0) return;
    const bf16_t* HB = (const bf16_t*)(a.ws + WS_HB); const float* LOGF = (const float*)(a.ws + WS_LOGF); const bf16_t* HG = (const bf16_t*)(a.ws + WS_HG); bf16_t* O = (bf16_t*)(a.ws + WS_QO);
    LAS float* Lf = (LAS float*)(F.lds + RING_OFF + 1024); LAS float* Lk = Lf + 4096; LAS float* Lq = Lk + 4096;
    const int bh = F.bid, b = bh >> 3, h = bh & 7, lane = F.lane;
    float Sx[64];
#pragma unroll
    for (int d = 0; d < 64; ++d) Sx[d] = 0.f;
    const float ng = a.norm_g[l * 512 + h * 64 + lane];
    for (int c0 = 0; c0 < SEQ; c0 += 64) {
        for (int tt = 0; tt < 64; ++tt) { const size_t row = (size_t)b * SEQ + c0 + tt;
            const float lf = LOGF[row * 512 + h * 64 + lane]; const float f = __expf(lf);
            Lf[tt * 64 + lane] = f; Lk[tt * 64 + lane] = 1.f - f; Lq[tt * 64 + lane] = bf2f(HB[row * 1024 + h * 64 + lane]); }
        asm volatile("s_waitcnt lgkmcnt(0)" ::: "memory");
        for (int tt = 0; tt < 64; ++tt) { const size_t row = (size_t)b * SEQ + c0 + tt;
            const float v = bf2f(HB[row * 1024 + 512 + h * 64 + lane]);
            float o = 0.f;
#pragma unroll
            for (int d = 0; d < 64; d += 4) { const f32x4 f4 = *(const LAS f32x4*)(Lf + tt * 64 + d), k4 = *(const LAS f32x4*)(Lk + tt * 64 + d), q4 = *(const LAS f32x4*)(Lq + tt * 64 + d);
                Sx[d] = f4.x * Sx[d] + k4.x * v; o += Sx[d] * q4.x; Sx[d + 1] = f4.y * Sx[d + 1] + k4.y * v; o += Sx[d + 1] * q4.y;
                Sx[d + 2] = f4.z * Sx[d + 2] + k4.z * v; o += Sx[d + 2] * q4.z; Sx[d + 3] = f4.w * Sx[d + 3] + k4.w * v; o += Sx[d + 3] * q4.w; }
            const float ss = wave_sum(o * o);
            const float r = o * rsqrtf(ss * (1.f / 64.f) + RMS_EPS) * ng * bf2f(HG[row * 512 + h * 64 + lane]);
            O[row * 1024 + 512 + h * 64 + lane] = (bf16_t)f2bf(r); }
        asm volatile("s_waitcnt lgkmcnt(0)" ::: "memory");
    }
}

constexpr int LN1_RW = 0, LN1_LG = 65536, LN1_ASG = LN1_LG + 8 * 16 * 16 * 4, LN1_BASE = LN1_ASG + 128 * 16;
__device__ __forceinline__ void phase_ln1_router(const Args& a, const Frame& F, int l) {
    const float* xres = (const float*)(a.ws + WS_XRES); float* x1 = a.out; const bf16_t* mixed = (const bf16_t*)(a.ws + WS_MIXED); unsigned char* xn = a.ws + WS_XN;
    unsigned* cnt = (unsigned*)(a.ws + WS_CTL) + CW_CNT + l * 64; int* list = (int*)(a.ws + WS_LIST); unsigned* tokinfo = (unsigned*)(a.ws + WS_TOK);
    const float* g = a.ln1_g + l * D; const float* bta = a.ln1_b + l * D;
    LAS float* rw = (LAS float*)(F.lds + RING_OFF + LN1_RW);
    LAS float* lgs = (LAS float*)(F.lds + RING_OFF + LN1_LG) + F.wave * 256;
    LAS u32x4* asg = (LAS u32x4*)(F.lds + RING_OFF + LN1_ASG);
    LAS unsigned* basep = (LAS unsigned*)(F.lds + RING_OFF + LN1_BASE);
    for (int i = F.tid; i < NE * D; i += NWAVES * 64) { const int c = i >> 4, e = i & 15; rw[e * D + c] = a.router_w[i]; }
    __syncthreads();
    const int lane = F.lane;
    for (int blk = F.bid; blk < T / 128; blk += F.G) {
        const int R0 = blk * 128 + F.wave * 16;
        f32x4 nx[4]; u32x2 nm[4];
#pragma unroll
        for (int j = 0; j < 4; ++j) { const int c = 4 * lane + 256 * j; nx[j] = *(const f32x4*)(xres + (size_t)R0 * D + c); nm[j] = *(const u32x2*)(mixed + (size_t)R0 * D + c); }
        for (int i = 0; i < 16; ++i) { const int row = R0 + i;
            f32x4 v[4];
#pragma unroll
            for (int j = 0; j < 4; ++j) { const f32x4 xv = nx[j]; const u32x2 mm = nm[j];
                v[j].x = ALPHA * xv.x + bflo(mm.x); v[j].y = ALPHA * xv.y + bfhi(mm.x); v[j].z = ALPHA * xv.z + bflo(mm.y); v[j].w = ALPHA * xv.w + bfhi(mm.y); }
            { const int rn = (i < 15) ? row + 1 : row;
#pragma unroll
              for (int j = 0; j < 4; ++j) { const int c = 4 * lane + 256 * j; nx[j] = *(const f32x4*)(xres + (size_t)rn * D + c); nm[j] = *(const u32x2*)(mixed + (size_t)rn * D + c); } }
            ln_rows16(v, g, bta, lane);
            store_row(v, lane, x1 + (size_t)row * D, xn + (size_t)row * D, nullptr);
            float p[NE];
#pragma unroll
            for (int e = 0; e < NE; ++e) { float s = 0.f;
#pragma unroll
                for (int j = 0; j < 4; ++j) { const f32x4 r4 = *(const LAS f32x4*)(rw + e * D + 4 * lane + 256 * j); s += v[j].x * r4.x + v[j].y * r4.y + v[j].z * r4.z + v[j].w * r4.w; }
                p[e] = s; asm volatile("" ::: "memory"); }
            { const bool hi5 = (lane & 32) != 0;
#pragma unroll
              for (int k = 0; k < 8; ++k) { const float snd = hi5 ? p[k] : p[k + 8]; const float rcv = __shfl_xor(snd, 32); p[k] = (hi5 ? p[k + 8] : p[k]) + rcv; }
              const bool hi4 = (lane & 16) != 0;
#pragma unroll
              for (int k = 0; k < 4; ++k) { const float snd = hi4 ? p[k] : p[k + 4]; const float rcv = __shfl_xor(snd, 16); p[k] = (hi4 ? p[k + 4] : p[k]) + rcv; }
              const bool hi3 = (lane & 8) != 0;
#pragma unroll
              for (int k = 0; k < 2; ++k) { const float snd = hi3 ? p[k] : p[k + 2]; const float rcv = __shfl_xor(snd, 8); p[k] = (hi3 ? p[k + 2] : p[k]) + rcv; }
              const bool hi2 = (lane & 4) != 0;
              { const float snd = hi2 ? p[0] : p[1]; const float rcv = __shfl_xor(snd, 4); p[0] = (hi2 ? p[1] : p[0]) + rcv; }
              p[0] += __shfl_xor(p[0], 2); p[0] += __shfl_xor(p[0], 1);
              if ((lane & 3) == 0) lgs[i * 16 + (lane >> 2)] = p[0]; }
        }
        asm volatile("s_waitcnt lgkmcnt(0)" ::: "memory");
        if (lane < 16) {
            float lg[NE];
#pragma unroll
            for (int q = 0; q < 4; ++q) { const f32x4 t4 = *(const LAS f32x4*)(lgs + lane * 16 + 4 * q); lg[4 * q] = t4[0] + a.router_b[4 * q]; lg[4 * q + 1] = t4[1] + a.router_b[4 * q + 1]; lg[4 * q + 2] = t4[2] + a.router_b[4 * q + 2]; lg[4 * q + 3] = t4[3] + a.router_b[4 * q + 3]; }
            int gs = 0; float gbest = -3e38f;
#pragma unroll
            for (int gi = 0; gi < 4; ++gi) { const float mx = fmaxf(fmaxf(lg[gi * 4], lg[gi * 4 + 1]), fmaxf(lg[gi * 4 + 2], lg[gi * 4 + 3])); if (mx > gbest) { gbest = mx; gs = gi; } }
            float l4[4];
#pragma unroll
            for (int i = 0; i < 4; ++i) { float t0 = lg[i];
#pragma unroll
                for (int gi = 1; gi < 4; ++gi) t0 = (gs == gi) ? lg[gi * 4 + i] : t0; l4[i] = t0; }
            int i0 = 0; float b0 = l4[0];
#pragma unroll
            for (int i = 1; i < 4; ++i) if (l4[i] > b0) { b0 = l4[i]; i0 = i; }
            int i1 = 0; float b1 = -3e38f;
#pragma unroll
            for (int i = 0; i < 4; ++i) if (i != i0 && l4[i] > b1) { b1 = l4[i]; i1 = i; }
            const float e1 = __expf(b1 - b0); const float g0 = 1.f / (1.f + e1), g1 = e1 / (1.f + e1);
            u32x4 as; as.x = (unsigned)(gs * 4 + i0); as.y = (unsigned)(gs * 4 + i1); as.z = __float_as_uint(g0); as.w = __float_as_uint(g1);
            asg[F.wave * 16 + lane] = as;
        }
        __syncthreads();
        if (F.wave == 0) {
            const u32x4 A0 = asg[lane], A1 = asg[lane + 64];
            const unsigned ex[4] = {A0.x, A0.y, A1.x, A1.y};
            unsigned rank[4] = {0u, 0u, 0u, 0u}, mycount = 0u;
            const unsigned long long lt = (1ull << lane) - 1ull;
#pragma unroll 1
            for (unsigned e = 0; e < NE; ++e) { unsigned run = 0u;
#pragma unroll
                for (int s = 0; s < 4; ++s) { const unsigned long long m = __ballot(ex[s] == e); if (ex[s] == e) rank[s] = run + (unsigned)__popcll(m & lt); run += (unsigned)__popcll(m); }
                if ((unsigned)lane == e) mycount = run; }
            if (lane < NE) basep[lane] = atomicAdd(cnt + lane, mycount);
            asm volatile("s_waitcnt vmcnt(0) lgkmcnt(0)" ::: "memory");
            const unsigned p0 = basep[ex[0]] + rank[0], p1 = basep[ex[1]] + rank[1], p2 = basep[ex[2]] + rank[2], p3 = basep[ex[3]] + rank[3];
            const int ra = blk * 128 + lane, rb = ra + 64;
            list[ex[0] * T + p0] = ra; list[ex[1] * T + p1] = ra; list[ex[2] * T + p2] = rb; list[ex[3] * T + p3] = rb;
            u32x4 ta, tb; ta.x = (ex[0] << 24) | p0; ta.y = (ex[1] << 24) | p1; ta.z = A0.z; ta.w = A0.w; tb.x = (ex[2] << 24) | p2; tb.y = (ex[3] << 24) | p3; tb.z = A1.z; tb.w = A1.w;
            *(u32x4*)(tokinfo + (size_t)ra * 4) = ta; *(u32x4*)(tokinfo + (size_t)rb * 4) = tb;
        }
        __syncthreads();
    }
}

__device__ __forceinline__ void moe_table(const Args& a, const Frame& F, int l) {
    LAS int* tab = (LAS int*)(F.lds + TAB_OFF);
    const unsigned* cnt = (const unsigned*)(a.ws + WS_CTL) + CW_CNT + l * 64;
    if (F.tid == 0) { int ts = 0; for (int e = 0; e < NE; ++e) { const int c = (int)__hip_atomic_load(cnt + e, RLX_AGENT); tab[e] = ts; tab[NE + 1 + e] = c; ts += (c + TM - 1) / TM; } tab[NE] = ts; }
    __syncthreads();
}

__device__ __forceinline__ void phase_combine_ln2(const Args& a, const Frame& F, int l) {
    float* xres = (float*)(a.ws + WS_XRES); const float* x1 = a.out; const bf16_t* Y = (const bf16_t*)(a.ws + WS_Y); const unsigned* tokinfo = (const unsigned*)(a.ws + WS_TOK); unsigned char* xn = a.ws + WS_XN;
    const float* g = a.ln2_g + l * D; const float* bta = a.ln2_b + l * D; float* out = (l == DEPTH - 1) ? a.out : nullptr;
    const LAS int* tab = (const LAS int*)(F.lds + TAB_OFF);
    const int lane = F.lane;
    for (int row = F.gw; row < T; row += F.ngw) {
        const unsigned i0 = tokinfo[row * 4], i1 = tokinfo[row * 4 + 1]; const float g0 = __uint_as_float(tokinfo[row * 4 + 2]), g1 = __uint_as_float(tokinfo[row * 4 + 3]);
        const size_t s0 = (size_t)tab[i0 >> 24] * TM + (i0 & 0xffffff), s1 = (size_t)tab[i1 >> 24] * TM + (i1 & 0xffffff);
        f32x4 v[4];
#pragma unroll
        for (int j = 0; j < 4; ++j) { const int c = 4 * lane + 256 * j; const f32x4 xv = *(const f32x4*)(x1 + (size_t)row * D + c);
            const u32x2 ya = *(const u32x2*)(Y + s0 * D + c), yb = *(const u32x2*)(Y + s1 * D + c);
            v[j].x = ALPHA * xv.x + g0 * bflo(ya.x) + g1 * bflo(yb.x); v[j].y = ALPHA * xv.y + g0 * bfhi(ya.x) + g1 * bfhi(yb.x);
            v[j].z = ALPHA * xv.z + g0 * bflo(ya.y) + g1 * bflo(yb.y); v[j].w = ALPHA * xv.w + g0 * bfhi(ya.y) + g1 * bfhi(yb.y); }
        ln_rows16(v, g, bta, lane);
        store_row(v, lane, xres + (size_t)row * D, xn + (size_t)row * D, out ? out + (size_t)row * D : nullptr);
        if (l + 1 < DEPTH) fox_gates_row(a, F, l + 1, v, row);
    }
}


constexpr int ATT_F2_OFF = 86016;
__device__ __forceinline__ void phase_attn(const Args& a, const Frame& F, char* lds_generic) {
    const int c = F.bid, vcu = (F.G % 8 == 0) ? (c % 8) * (F.G / 8) + c / 8 : c;
    const attn_body::bf16* Q = (const attn_body::bf16*)(a.ws + WS_QO); const attn_body::bf16* K = (const attn_body::bf16*)(a.ws + WS_KV); const attn_body::bf16* V = K + 512;
    attn_body::bf16* O = (attn_body::bf16*)(a.ws + WS_OX8);
    const float* FL = (const float*)(a.ws + WS_FL);
    LAS float* f2 = (LAS float*)(F.lds + ATT_F2_OFF); LAS float* wsum = f2 + 2048;
    { const int bh = vcu >> 1; if (bh >= BATCH * NH) return;
        const int b = bh >> 3, h = bh & 7, tid = F.tid, lane = F.lane, w = F.wave;
        float v[4], run = 0.f;
#pragma unroll
        for (int i = 0; i < 4; ++i) { run += FL[((size_t)b * SEQ + tid * 4 + i) * 8 + h]; v[i] = run; }
        float incl = run;
#pragma unroll
        for (int o = 1; o < 64; o <<= 1) { const float u = __shfl_up(incl, o); if (lane >= o) incl += u; }
        if (lane == 63) wsum[w] = incl;
        __syncthreads();
        float base = incl - run; for (int i = 0; i < w; ++i) base += wsum[i];
        f32x4 o4; o4[0] = (base + v[0]) * LOG2E; o4[1] = (base + v[1]) * LOG2E; o4[2] = (base + v[2]) * LOG2E; o4[3] = (base + v[3]) * LOG2E;
        *(LAS f32x4*)(f2 + tid * 4) = o4;
        __syncthreads();
        for (int i = 0; i < 4; ++i) { const int s = 2 * (vcu & 1) + (i >> 1); const int qb = (i & 1) ? 7 - s : s;
            int tid_u = F.tid; asm volatile("" : "+v"(tid_u));
            attn_body::attn_unit<40>(b, h, qb, Q, K, V, O, lds_generic + RING_OFF, f2, tid_u); }
        __syncthreads();
    }
}

namespace hg {
constexpr int PB = 144;
constexpr int O_QS = 0, O_KS = 9216, O_QI = 18432, O_KUT = 27648, O_VT = 36864, O_P = 46080, O_ST = 55296, O_TOT = 64512, O_EBL = 66560, O_RED = 66816, BYTES = 67328;
__device__ __forceinline__ float ex(float v) { return __builtin_amdgcn_exp2f(v * LOG2E); }
__device__ __forceinline__ unsigned short bf1(float v) { return (unsigned short)f2bf(v); }
}
__device__ __forceinline__ void phase_hgrn(const Args& a, const Frame& F, int l) {
    using namespace hg;
    if (F.bid >= BATCH * NH) return;
    const bf16_t* HB = (const bf16_t*)(a.ws + WS_HB); const float* LOGF = (const float*)(a.ws + WS_LOGF); const bf16_t* HG = (const bf16_t*)(a.ws + WS_HG); unsigned char* O8 = a.ws + WS_OX8;
    LAS unsigned char* L = F.lds + RING_OFF;
    const int bh = F.bid, b = bh >> 3, h = bh & 7, lane = F.lane, w = F.wave, tid = F.tid;
    const int fr = lane & 15, fq = lane >> 4;
    const int tr = w >> 1, tc0 = 2 * (w & 1);
    const float ng0 = a.norm_g[l * 512 + h * 64 + 16 * tc0 + fr], ng1 = a.norm_g[l * 512 + h * 64 + 16 * (tc0 + 1) + fr];
    f32x4 S0 = {0.f, 0.f, 0.f, 0.f}, S1 = {0.f, 0.f, 0.f, 0.f};
    for (int i = tid; i < 9216 / 4; i += NWAVES * 64) ((LAS unsigned*)(L + O_ST))[i] = 0u;
    const size_t rowbase = (size_t)b * SEQ;
    float g[8]; unsigned short qv[8], vv[8];
#pragma unroll
    for (int i = 0; i < 8; ++i) { const size_t row = rowbase + 8 * w + i; g[i] = LOGF[row * 512 + h * 64 + lane]; qv[i] = HB[row * 1024 + h * 64 + lane]; vv[i] = HB[row * 1024 + 512 + h * 64 + lane]; }
    for (int c0 = 0; c0 < SEQ; c0 += 64) {
        float bc[8]; { float run = 0.f;
#pragma unroll
            for (int i = 0; i < 8; ++i) { run += g[i]; bc[i] = run; } }
        ((LAS float*)(L + O_TOT))[w * 64 + lane] = bc[7];
        float qf[8], kf[8];
#pragma unroll
        for (int i = 0; i < 8; ++i) { qf[i] = bf2f(qv[i]); kf[i] = 1.f - ex(g[i]); }
        { u32x4 pk; pk.x = (unsigned)vv[0] | ((unsigned)vv[1] << 16); pk.y = (unsigned)vv[2] | ((unsigned)vv[3] << 16); pk.z = (unsigned)vv[4] | ((unsigned)vv[5] << 16); pk.w = (unsigned)vv[6] | ((unsigned)vv[7] << 16);
          *(LAS u32x4*)(L + O_VT + lane * PB + 16 * w) = pk; }
        __syncthreads();
        float base = 0.f, bm = 0.f, bl = 0.f;
#pragma unroll
        for (int ww = 0; ww < 8; ++ww) { const float tv = ((LAS float*)(L + O_TOT))[ww * 64 + lane]; if (ww < w) base += tv; if (ww < 4) bm += tv; bl += tv; }
        const float ebm = ex(bm), eblm = ex(bl - bm);
        if (w == 0) ((LAS float*)(L + O_EBL))[lane] = ex(bl);
        unsigned short ku[8];
#pragma unroll
        for (int i = 0; i < 8; ++i) { const float x = bc[i] + base - bm; const float e1 = ex(fminf(x, 80.f)), e2 = ex(fminf(-x, 80.f));
            const float qs = qf[i] * e1, ks = kf[i] * e2; const int r = 8 * w + i;
            *(LAS unsigned short*)(L + O_QS + r * PB + 2 * lane) = bf1(qs); *(LAS unsigned short*)(L + O_QI + r * PB + 2 * lane) = bf1(qs * ebm);
            *(LAS unsigned short*)(L + O_KS + r * PB + 2 * lane) = bf1(ks); ku[i] = bf1(ks * eblm); }
        { u32x4 pk; pk.x = (unsigned)ku[0] | ((unsigned)ku[1] << 16); pk.y = (unsigned)ku[2] | ((unsigned)ku[3] << 16); pk.z = (unsigned)ku[4] | ((unsigned)ku[5] << 16); pk.w = (unsigned)ku[6] | ((unsigned)ku[7] << 16);
          *(LAS u32x4*)(L + O_KUT + lane * PB + 16 * w) = pk; }
        if (c0 + 64 < SEQ) {
#pragma unroll
            for (int i = 0; i < 8; ++i) { const size_t row = rowbase + c0 + 64 + 8 * w + i; g[i] = LOGF[row * 512 + h * 64 + lane]; qv[i] = HB[row * 1024 + h * 64 + lane]; vv[i] = HB[row * 1024 + 512 + h * 64 + lane]; }
        }
        __syncthreads();
#pragma unroll
        for (int k2 = 0; k2 < 2; ++k2) { const int idx = 2 * w + k2, ti = idx >> 2, sj = idx & 3;
            f32x4 sc = {0.f, 0.f, 0.f, 0.f};
            if (sj <= ti) {
#pragma unroll
                for (int kk = 0; kk < 2; ++kk) { const bf16x8 af = *(const LAS bf16x8*)(L + O_QS + (16 * ti + fr) * PB + (32 * kk + 8 * fq) * 2), bfr = *(const LAS bf16x8*)(L + O_KS + (16 * sj + fr) * PB + (32 * kk + 8 * fq) * 2);
                    sc = __builtin_amdgcn_mfma_f32_16x16x32_bf16(af, bfr, sc, 0, 0, 0); }
            }
#pragma unroll
            for (int j = 0; j < 4; ++j) { const int t = 16 * ti + 4 * fq + j, s = 16 * sj + fr; *(LAS unsigned short*)(L + O_P + t * PB + 2 * s) = bf1(s <= t ? sc[j] : 0.f); }
        }
        __syncthreads();
        f32x4 o0 = {0.f, 0.f, 0.f, 0.f}, o1 = {0.f, 0.f, 0.f, 0.f}, u0 = {0.f, 0.f, 0.f, 0.f}, u1 = {0.f, 0.f, 0.f, 0.f};
#pragma unroll
        for (int kk = 0; kk < 2; ++kk) { const int ko = (32 * kk + 8 * fq) * 2;
            const bf16x8 pa = *(const LAS bf16x8*)(L + O_P + (16 * tr + fr) * PB + ko), qa = *(const LAS bf16x8*)(L + O_QI + (16 * tr + fr) * PB + ko), ka = *(const LAS bf16x8*)(L + O_KUT + (16 * tr + fr) * PB + ko);
            const bf16x8 v0 = *(const LAS bf16x8*)(L + O_VT + (16 * tc0 + fr) * PB + ko), v1 = *(const LAS bf16x8*)(L + O_VT + (16 * (tc0 + 1) + fr) * PB + ko);
            const bf16x8 s0 = *(const LAS bf16x8*)(L + O_ST + (16 * tc0 + fr) * PB + ko), s1 = *(const LAS bf16x8*)(L + O_ST + (16 * (tc0 + 1) + fr) * PB + ko);
            o0 = __builtin_amdgcn_mfma_f32_16x16x32_bf16(pa, v0, o0, 0, 0, 0); o1 = __builtin_amdgcn_mfma_f32_16x16x32_bf16(pa, v1, o1, 0, 0, 0);
            o0 = __builtin_amdgcn_mfma_f32_16x16x32_bf16(qa, s0, o0, 0, 0, 0); o1 = __builtin_amdgcn_mfma_f32_16x16x32_bf16(qa, s1, o1, 0, 0, 0);
            u0 = __builtin_amdgcn_mfma_f32_16x16x32_bf16(ka, v0, u0, 0, 0, 0); u1 = __builtin_amdgcn_mfma_f32_16x16x32_bf16(ka, v1, u1, 0, 0, 0); }
        { const f32x4 dec = *(const LAS f32x4*)(L + O_EBL + (16 * tr + 4 * fq) * 4); S0 = S0 * dec + u0; S1 = S1 * dec + u1; }
        { f32x4 q2 = o0 * o0 + o1 * o1;
#pragma unroll
          for (int m = 1; m < 16; m <<= 1) { q2[0] += __shfl_xor(q2[0], m); q2[1] += __shfl_xor(q2[1], m); q2[2] += __shfl_xor(q2[2], m); q2[3] += __shfl_xor(q2[3], m); }
          if (fr == 0) {
#pragma unroll
              for (int j = 0; j < 4; ++j) ((LAS float*)(L + O_RED))[(16 * tr + 4 * fq + j) * 2 + (w & 1)] = q2[j]; } }
        __syncthreads();
        { u32x2 p0, p1; p0.x = pk2(S0[0], S0[1]); p0.y = pk2(S0[2], S0[3]); p1.x = pk2(S1[0], S1[1]); p1.y = pk2(S1[2], S1[3]);
          *(LAS u32x2*)(L + O_ST + (16 * tc0 + fr) * PB + (16 * tr + 4 * fq) * 2) = p0; *(LAS u32x2*)(L + O_ST + (16 * (tc0 + 1) + fr) * PB + (16 * tr + 4 * fq) * 2) = p1; }
#pragma unroll
        for (int j = 0; j < 4; ++j) { const int t = 16 * tr + 4 * fq + j; const f32x2 rr = *(const LAS f32x2*)(L + O_RED + t * 8); const float rs = rsqrtf((rr[0] + rr[1]) * (1.f / 64.f) + RMS_EPS);
            *(LAS unsigned short*)(L + O_P + t * PB + 2 * (16 * tc0 + fr)) = bf1(o0[j] * rs * ng0); *(LAS unsigned short*)(L + O_P + t * PB + 2 * (16 * (tc0 + 1) + fr)) = bf1(o1[j] * rs * ng1); }
        __syncthreads();
        { const int t = tid >> 3, e8 = (tid & 7) * 8; const size_t row = rowbase + c0 + t;
          const u32x4 ov = *(const LAS u32x4*)(L + O_P + t * PB + e8 * 2), gv = *(const u32x4*)(HG + row * 512 + h * 64 + e8);
          u32x2 r; r.x = pg8::pack4_fp8(bflo(ov.x) * bflo(gv.x) * SC_HGRN, bfhi(ov.x) * bfhi(gv.x) * SC_HGRN, bflo(ov.y) * bflo(gv.y) * SC_HGRN, bfhi(ov.y) * bfhi(gv.y) * SC_HGRN);
          r.y = pg8::pack4_fp8(bflo(ov.z) * bflo(gv.z) * SC_HGRN, bfhi(ov.z) * bfhi(gv.z) * SC_HGRN, bflo(ov.w) * bflo(gv.w) * SC_HGRN, bfhi(ov.w) * bfhi(gv.w) * SC_HGRN);
          *(u32x2*)(O8 + row * 1024 + 512 + h * 64 + e8) = r; }
        __syncthreads();
    }
}


constexpr int PH_PER_LAYER = 10, N_PHASES = 1 + DEPTH * PH_PER_LAYER;
#ifndef MK_ONE_LAUNCH
#define MK_ONE_LAUNCH 1
#endif
#ifndef MK_FAST_ATTN
#define MK_FAST_ATTN 0
#endif
#ifndef MK_FAST_HGRN
#define MK_FAST_HGRN 0
#endif


#ifdef DBG_DUMP
#ifndef DBG_WHAT
#define DBG_WHAT 0
#endif
__device__ __forceinline__ void dbg_dump(const Args& a, const Frame& F) {
    unsigned char* ws = a.ws;
    const bf16_t *QO = (bf16_t*)(ws + WS_QO), *KV = (bf16_t*)(ws + WS_KV), *HB = (bf16_t*)(ws + WS_HB), *HG = (bf16_t*)(ws + WS_HG), *G = (bf16_t*)(ws + WS_G);
    const bf16_t *U1 = (bf16_t*)(ws + WS_U1), *U = (bf16_t*)(ws + WS_U), *MIXED = (bf16_t*)(ws + WS_MIXED), *XN = (bf16_t*)(ws + WS_XN);
    const float *LOGF = (float*)(ws + WS_LOGF), *FL = (float*)(ws + WS_FL), *XRES = (float*)(ws + WS_XRES);
    for (size_t i = (size_t)F.bid * 512 + F.tid; i < (size_t)T * D; i += (size_t)gridDim.x * 512) {
        const size_t row = i >> 10; const int c = (int)(i & 1023);
        float v = 0.f;
        if (DBG_WHAT == 9) { v = bf2f(G[row * 2048 + c]) + bf2f(G[row * 2048 + 1024 + c]); }
        else if (DBG_DUMP == 1) { v = bf2f(KV[i]) + bf2f(HB[i]) + bf2f(G[row * 2048 + c]) + bf2f(G[row * 2048 + 1024 + c]);
            if (c < 512) v += LOGF[row * 512 + c] + bf2f(HG[row * 512 + c]) + bf2f(QO[i]); if (c < 8) v += FL[row * 8 + c]; }
        else if (DBG_DUMP == 2) { v = (c >= 512) ? bf2f(QO[i]) : 0.f; }
        else if (DBG_DUMP == 3) { v = bf2f(QO[i]); }
        else if (DBG_DUMP == 4) { v = bf2f(U1[i]); }
        else if (DBG_DUMP == 5) { v = bf2f(U[i]); }
        else if (DBG_DUMP == 6) { v = bf2f(MIXED[i]); }
        else if (DBG_DUMP == 7) { v = XRES[i] + bf2f(XN[i]); }
        a.out[i] = v;
    }
}
#endif
#define PH_BEGIN const Args a = LOAD_ARGS(); Frame F; F.lds = lds0; F.lane = (int)__builtin_amdgcn_mbcnt_hi(~0u, __builtin_amdgcn_mbcnt_lo(~0u, 0u)); asm volatile("" : "+v"(F.lane)); F.wave = __builtin_amdgcn_readfirstlane((int)((const volatile LAS unsigned*)(lds0 + WTAB_OFF))[hw_wave_key()]); F.tid = F.wave * 64 + F.lane; \
    F.G = gridDim.x; F.bid = blockIdx.x; asm volatile("" : "+s"(F.bid)); F.gw = F.bid * NWAVES + F.wave; F.ngw = F.G * NWAVES; unsigned char* const ws = a.ws; const LAS int* tab = (const LAS int*)(F.lds + TAB_OFF); (void)tab; (void)ws;
#ifdef DBG_DUMP
#define IN(k) (lo <= (k) && (k) < hi && (k) <= DBG_DUMP)
#else
#define IN(k) (lo <= (k) && (k) < hi)
#endif
#ifdef DBG_REPEAT
#define REP(k) for (int rep_ = 0; rep_ < ((DBG_REPEAT == (k) && !((k) == 9 && l == DEPTH - 1)) ? 2 : 1); ++rep_)
#else
#define REP(k)
#endif
#define SEAM(k) do { if (IN(k) && IN((k) + 1)) { XcdBarrier b2_ = bar; { size_t z_ = 0; asm volatile("" : "+s"(z_), "+s"(b2_.x)); b2_.bar = bar.bar + z_; } xcd_barrier(b2_); } } while (0)
template <int l>
__device__ __forceinline__ void layer_body(const Args& args, const int lo, const int hi, const XcdBarrier& bar, LAS unsigned char* const lds0, unsigned char* lds_raw) {
        const int pb = 1 + l * PH_PER_LAYER;

#ifdef DBG_DUMP
        if (l == 0 && lo <= DBG_DUMP + 1 && DBG_DUMP + 1 < hi) { PH_BEGIN dbg_dump(a, F); }
#endif
        if (IN(pb + 0)) REP(0) { PH_BEGIN
            pg8::Gemm g{(bf16_t*)(ws + WS_XN), (bf16_t*)(ws + wset(l) + WO_WIN), D / 2, D / 2, D / 2, E8_1, E8_W}; pg8::StaticOrder S; S.init(T, NINP, F.G, F.bid);
            pg8::EpiInproj E{ws, l};
            pg8::gemm_phase<pg8::EpiInproj, pg8::StaticOrder, true>(F.lds + RING_OFF, g, S, E, F.tid);
        }
        SEAM(pb + 0);
        if (IN(pb + 1)) REP(1) { PH_BEGIN
#if !MK_FAST_ATTN
            phase_fscan(a, F);
#endif
#if MK_FAST_HGRN
            phase_hgrn(a, F, l);
            if (l + 1 < DEPTH && F.bid >= BATCH * NH) convert_layer(a, F, l + 1, (F.bid - BATCH * NH) * NWAVES + F.wave, (F.G - BATCH * NH) * NWAVES);
#else
            phase_hgrn_naive(a, F, l);
#endif
        }
        SEAM(pb + 1);
        if (IN(pb + 2)) REP(2) { PH_BEGIN
#if MK_FAST_ATTN
            phase_attn(a, F, (char*)lds_raw);
#else
            phase_attn_naive(a, F);
#endif
        }
        SEAM(pb + 2);
        if (IN(pb + 3)) REP(3) { PH_BEGIN
            pg8::Gemm g{(bf16_t*)(ws + WS_OX8), (bf16_t*)(ws + wset(l) + WO_WBR), D / 2, D / 2, 256, E8_FOX, E8_W}; pg8::StaticOrder S; S.init(T, D, F.G, F.bid);
            pg8::EpiGate<1> E{(bf16_t*)(ws + WS_U1), nullptr, (bf16_t*)(ws + WS_G), 2048, nullptr};
            pg8::gemm_phase<pg8::EpiGate<1>, pg8::StaticOrder, true>(F.lds + RING_OFF, g, S, E, F.tid);
        }
        if (IN(pb + 3) && IN(pb + 4)) __syncthreads(); else SEAM(pb + 3);
        if (IN(pb + 4)) REP(4) { PH_BEGIN
            pg8::Gemm g{(bf16_t*)(ws + WS_OX8) + 256, (bf16_t*)(ws + wset(l) + WO_WBR) + 256, D / 2, D / 2, 256, E8_HGRN, E8_W}; pg8::StaticOrder S; S.init(T, D, F.G, F.bid);
            pg8::EpiGate<2> E{(bf16_t*)(ws + WS_U), nullptr, (bf16_t*)(ws + WS_G) + 1024, 2048, (bf16_t*)(ws + WS_U1)};
            pg8::gemm_phase<pg8::EpiGate<2>, pg8::StaticOrder, true>(F.lds + RING_OFF, g, S, E, F.tid);
        }
        SEAM(pb + 4);
        if (IN(pb + 5)) REP(5) { PH_BEGIN
            pg8::Gemm g{(bf16_t*)(ws + WS_U), (bf16_t*)(ws + wset(l) + WO_WMIX), D / 2, D / 2, D / 2, E8_U, E8_W}; pg8::StaticOrder S; S.init(T, D, F.G, F.bid);
            pg8::EpiGate<0> E{(bf16_t*)(ws + WS_MIXED), a.b_mix + l * D, nullptr, 0, nullptr};
            pg8::gemm_phase<pg8::EpiGate<0>, pg8::StaticOrder, true>(F.lds + RING_OFF, g, S, E, F.tid);
        }
        SEAM(pb + 5);
        if (IN(pb + 6)) REP(6) { PH_BEGIN phase_ln1_router(a, F, l); }
        SEAM(pb + 6);
        if (IN(pb + 7)) REP(7) { PH_BEGIN
            moe_table(a, F, l);
            pg8::Gemm g{(bf16_t*)(ws + WS_XN), (bf16_t*)(ws + wset(l) + WO_W13), D / 2, D / 2, D / 2, E8_1, E8_W}; pg8::MoeOrder<true> S{F.G, F.bid, 8, tab, (const int*)(ws + WS_LIST), (size_t)2048 * (D / 2)};
            pg8::EpiUp E{(bf16_t*)(ws + WS_H)};
            pg8::gemm_phase<pg8::EpiUp, pg8::MoeOrder<true>, true>(F.lds + RING_OFF, g, S, E, F.tid);
        }
        SEAM(pb + 7);
        if (IN(pb + 8)) REP(8) { PH_BEGIN
            moe_table(a, F, l);
            pg8::Gemm g{(bf16_t*)(ws + WS_H), (bf16_t*)(ws + wset(l) + WO_W2), D / 2, D / 2, D / 2, E8_H, E8_W}; pg8::MoeOrder<false> S{F.G, F.bid, 4, tab, nullptr, (size_t)D * (D / 2)};
            pg8::EpiGate<0> E{(bf16_t*)(ws + WS_Y), nullptr, nullptr, 0, nullptr};
            pg8::gemm_phase<pg8::EpiGate<0>, pg8::MoeOrder<false>, true>(F.lds + RING_OFF, g, S, E, F.tid);
        }
        SEAM(pb + 8);
        if (IN(pb + 9)) REP(9) { PH_BEGIN
            if (l + 1 < DEPTH) load_wff(a, F, l + 1);
            moe_table(a, F, l);
            phase_combine_ln2(a, F, l);
        }
        SEAM(pb + 9);
    }

__global__ void __launch_bounds__(NWAVES * 64, 2) mk_fwd(Args args) {
    extern __shared__ __attribute__((aligned(16))) unsigned char lds_raw[];
    LAS unsigned char* const lds0 = (LAS unsigned char*)lds_raw;
    volatile LAS unsigned* MISC = (volatile LAS unsigned*)(lds0 + MISC_OFF);
    for (int u = threadIdx.x; u < (LDS_BYTES - LDSCTL_OFF) / 4; u += NWAVES * 64) ((LAS unsigned*)(lds0 + LDSCTL_OFF))[u] = 0u;
    __syncthreads();
    if ((threadIdx.x & 63) == 0) ((volatile LAS unsigned*)(lds0 + WTAB_OFF))[hw_wave_key()] = threadIdx.x >> 6;
    __syncthreads();
    unsigned* ctl = (unsigned*)(args.ws + WS_CTL);
    XcdBarrier bar; bar.bar = ctl + CW_BAR; bar.x = 0; bar.st = nullptr;
    if (args.use_bar) bar = xcd_barrier_post(ctl + CW_BAR, MISC + 8);
    const int lo = args.ph_lo, hi = args.ph_hi;


    if (IN(0)) { PH_BEGIN phase_prep(a, F); }
    SEAM(0);
    layer_body<0>(args, lo, hi, bar, lds0, lds_raw); layer_body<1>(args, lo, hi, bar, lds0, lds_raw); layer_body<2>(args, lo, hi, bar, lds0, lds_raw); layer_body<3>(args, lo, hi, bar, lds0, lds_raw);
#undef IN
#undef SEAM
}

extern "C" void kernel_launch(void* const* d_in, const int* in_sizes, int n_in, void* d_out, int out_size, void* d_ws, size_t ws_size, hipStream_t stream) {
    static int grid = 0;
    if (grid == 0) {
        if (n_in != 20 || in_sizes[0] != T * D || out_size != T * D || ws_size < WS_END) { fprintf(stderr, "kernel_launch: unexpected shapes (n_in %d, ws %zu)\n", n_in, ws_size); grid = -1; return; }
        int dev = 0, cus = 0, per_cu = 0;
        if (hipGetDevice(&dev) != hipSuccess || hipDeviceGetAttribute(&cus, hipDeviceAttributeMultiprocessorCount, dev) != hipSuccess) { grid = -1; return; }
        if (hipFuncSetAttribute((const void*)mk_fwd, hipFuncAttributeMaxDynamicSharedMemorySize, LDS_BYTES) != hipSuccess) { fprintf(stderr, "kernel_launch: hipFuncSetAttribute failed\n"); grid = -1; return; }
        if (hipOccupancyMaxActiveBlocksPerMultiprocessor(&per_cu, (const void*)mk_fwd, NWAVES * 64, LDS_BYTES) != hipSuccess || per_cu < 1)
            fprintf(stderr, "kernel_launch: note: occupancy query reports %d workgroups per CU\n", per_cu);
        (void)hipGetLastError();
        grid = cus;
    }
    if (grid < 0) return;
    if (hipMemsetAsync((char*)d_ws + WS_CTL, 0, CTL_BYTES, stream) != hipSuccess) return;
    Args a{};
    a.x = (const float*)d_in[0]; a.ln_in_g = (const float*)d_in[1]; a.ln_in_b = (const float*)d_in[2]; a.w_in = (const float*)d_in[3]; a.b_in = (const float*)d_in[4];
    a.w_fox = (const float*)d_in[5]; a.lbl = (const float*)d_in[6]; a.norm_g = (const float*)d_in[7]; a.w_hgrn = (const float*)d_in[8]; a.w_mix = (const float*)d_in[9];
    a.b_mix = (const float*)d_in[10]; a.ln1_g = (const float*)d_in[11]; a.ln1_b = (const float*)d_in[12]; a.router_w = (const float*)d_in[13]; a.router_b = (const float*)d_in[14];
    a.w1 = (const float*)d_in[15]; a.w3 = (const float*)d_in[16]; a.w2 = (const float*)d_in[17]; a.ln2_g = (const float*)d_in[18]; a.ln2_b = (const float*)d_in[19];
    a.out = (float*)d_out; a.ws = (unsigned char*)d_ws; a.pad = 0;
#if MK_ONE_LAUNCH
    a.ph_lo = 0; a.ph_hi = N_PHASES; a.use_bar = 1;
    hipLaunchKernelGGL(mk_fwd, dim3(grid), dim3(NWAVES * 64), LDS_BYTES, stream, a);
#else
#ifdef DBG_DUMP
    const int np_ = DBG_DUMP + 2;
#else
    const int np_ = N_PHASES;
#endif
    for (int p = 0; p < np_; ++p) { a.ph_lo = p; a.ph_hi = p + 1; a.use_bar = 0;
        hipLaunchKernelGGL(mk_fwd, dim3(grid), dim3(NWAVES * 64), LDS_BYTES, stream, a); }
#endif
    const hipError_t le = hipPeekAtLastError();
    if (le != hipSuccess) fprintf(stderr, "kernel_launch: launch failed: %s\n", hipGetErrorName(le));
}
```

```cpp
#define MK_ONE_LAUNCH 1
#define MK_FAST_ATTN 1
#define MK_FAST_HGRN 1
#include <hip/hip_runtime.h>
#include <cstdio>
#include <cstdint>

typedef unsigned short bf16_t;
typedef short bf16x8 __attribute__((ext_vector_type(8)));
typedef float f32x4 __attribute__((ext_vector_type(4)));
typedef float f32x2 __attribute__((ext_vector_type(2)));
typedef unsigned u32x4 __attribute__((ext_vector_type(4)));
typedef unsigned u32x2 __attribute__((ext_vector_type(2)));
#define LAS __attribute__((address_space(3)))
#define GAS __attribute__((address_space(1)))

constexpr int BATCH = 16, SEQ = 2048, T = BATCH * SEQ, D = 1024, DEPTH = 4, NH = 8, HD = 64, NIN = 5640, NINP = 5632, NE = 16;
constexpr float LN_EPS = 1e-5f, RMS_EPS = 1e-6f;
constexpr float ALPHA = 1.681792830507429f;
constexpr float LOG2E = 1.4426950408889634f;
constexpr float C2 = 0.125f * LOG2E;
constexpr float SC_W = 64.f, SC_FOX = 16.f, SC_HGRN = 4.f, SC_U = 64.f, SC_H = 8.f;
constexpr int E8_1 = 0x7f7f7f7f, E8_W = 0x79797979, E8_FOX = 0x7b7b7b7b, E8_HGRN = 0x7d7d7d7d, E8_U = 0x79797979, E8_H = 0x7c7c7c7c;
constexpr int TM = 256;

constexpr size_t MiB = 1u << 20;
constexpr size_t WS_CTL = 0, CTL_BYTES = 1 * MiB;
constexpr size_t WS_MISC = 1 * MiB;
constexpr size_t WS_WSET = 2 * MiB, WSET_BYTES = 56 * MiB;
constexpr size_t WO_WIN = 0, WO_WBR = 6 * MiB, WO_WMIX = 7 * MiB, WO_W13 = 8 * MiB, WO_W2 = 40 * MiB;
__host__ __device__ constexpr size_t wset(int l) { return WS_WSET + (size_t)(l & 1) * WSET_BYTES; }
__host__ __device__ constexpr size_t biasoff(int l) { return WS_MISC + 16384 + (size_t)(l & 1) * 32768; }
constexpr size_t WS_XRES = 114 * MiB, WS_XN = 242 * MiB, WS_QO = 306 * MiB, WS_KV = 370 * MiB, WS_HB = 434 * MiB, WS_LOGF = 498 * MiB;
constexpr size_t WS_HG = 562 * MiB, WS_G = 594 * MiB, WS_FL = 722 * MiB, WS_F2 = 723 * MiB, WS_U1 = 724 * MiB, WS_U = 788 * MiB, WS_MIXED = 852 * MiB;
constexpr size_t WS_LIST = 916 * MiB, WS_TOK = 918 * MiB, WS_X1B = 920 * MiB, WS_END = 984 * MiB;
constexpr size_t WS_OX8 = 274 * MiB;
constexpr size_t WS_H = WS_QO, WS_Y = 442 * MiB;
constexpr int CW_CNT = 1024;
constexpr int CW_BAR = 4096;

__device__ __forceinline__ unsigned f2bf(float f) { unsigned u = __builtin_bit_cast(unsigned, f); return (u + 0x7fffu + ((u >> 16) & 1u)) >> 16; }
__device__ __forceinline__ float bf2f(unsigned h) { return __builtin_bit_cast(float, h << 16); }
__device__ __forceinline__ float bflo(unsigned w) { return __builtin_bit_cast(float, w << 16); }
__device__ __forceinline__ float bfhi(unsigned w) { return __builtin_bit_cast(float, w & 0xffff0000u); }
__device__ __forceinline__ unsigned pk2(float lo, float hi) { return f2bf(lo) | (f2bf(hi) << 16); }
__device__ __forceinline__ float wave_sum(float v) {
#pragma unroll
    for (int o = 1; o < 64; o <<= 1) v += __shfl_xor(v, o);
    return v;
}
__device__ __forceinline__ float wave_max(float v) {
#pragma unroll
    for (int o = 1; o < 64; o <<= 1) v = fmaxf(v, __shfl_xor(v, o));
    return v;
}
__device__ __forceinline__ float fast_exp(float v) { return __builtin_amdgcn_exp2f(v * LOG2E); }
__device__ __forceinline__ float sigmoidf_(float v) { return __builtin_amdgcn_rcpf(1.0f + fast_exp(-v)); }
__device__ __forceinline__ float siluf_(float v) { return v * sigmoidf_(v); }
__device__ __forceinline__ float logsigmoidf_(float v) { return fminf(v, 0.f) - __logf(1.0f + fast_exp(-fabsf(v))); }

namespace pg8 {
constexpr int BM = 256, BK = 64, HALF = 128, HTB = HALF * BK * 2  , STAGE_BYTES = 8 * HTB, NXCD = 8, WGM = 8;
__host__ __device__ __forceinline__ int lds_byte(int r, int c) { const int st = (r >> 4) * 2 + (c >> 5), rr = r & 15, cc = c & 31, ob = rr * 64 + cc * 2; return st * 1024 + (ob ^ (((ob >> 9) & 1) << 5)); }
__host__ __device__ __forceinline__ void stage_rc(int b, int& R, int& C) { const int st = b / 1024, sb = b % 1024, swz = sb ^ (((sb >> 9) & 1) << 5); R = (st >> 1) * 16 + swz / 64; C = (st & 1) * 32 + (swz % 64) / 2; }
__host__ __device__ __forceinline__ int perm32(int rho) { const int n = rho >> 4, i = rho & 15; return 8 * (i >> 2) + 4 * n + (i & 3); }

struct Unit { int pm, pn, e; };
struct Gemm { const bf16_t* A; const bf16_t* Bt; int lda, ldb, K; int sa, sb; };

struct StaticOrder {
    static constexpr bool GATHER = false;
    int nM, nN, nwg, G, c;
    __device__ void init(int M, int N, int G_, int c_) { nM = M / BM; nN = N / BM; nwg = nM * nN; G = G_; c = c_; }
    __device__ bool next(int i, Unit& u) const {
        const int L = i * G + c; if (L >= nwg) return false;
        int wgid = L; { const int q = nwg / NXCD, r = nwg % NXCD, xcd = wgid % NXCD, off = wgid / NXCD; wgid = (xcd < r ? xcd * (q + 1) : r * (q + 1) + (xcd - r) * q) + off; }
        const int nig = WGM * nN, gid = wgid / nig, fm = gid * WGM, gsz = (nM - fm) < WGM ? (nM - fm) : WGM;
        u.pm = fm + ((wgid % nig) % gsz); u.pn = (wgid % nig) / gsz; u.e = 0; return true;
    }
    __device__ __forceinline__ const char* a_tile(const Gemm& g, const Unit& u) const { return (const char*)g.A + (size_t)u.pm * BM * g.lda * 2; }
    __device__ __forceinline__ const char* b_tile(const Gemm& g, const Unit& u) const { return (const char*)g.Bt + (size_t)u.pn * BM * g.ldb * 2; }
    __device__ __forceinline__ void a_voff(const Gemm& g, const Unit&, const int (&R)[2], const int (&C)[2], unsigned (&v)[2][2]) const {
#pragma unroll
        for (int h = 0; h < 2; ++h)
#pragma unroll
            for (int i = 0; i < 2; ++i) v[h][i] = (unsigned)((h * HALF + R[i]) * g.lda + C[i]) * 2u;
    }
};
template <bool GATHER_> struct MoeOrder {
    static constexpr bool GATHER = GATHER_; static constexpr bool gather = GATHER_;
    int G, c, nN; const LAS int* tab; const int* list; size_t bstride;
    __device__ bool next(int i, Unit& u) const {
        const int L = i * G + c; const int rt = L / nN; const int NT = tab[NE]; if (rt >= NT) return false;
        int e = 0;
#pragma unroll
        for (int k = 1; k < NE; ++k) e += (rt >= tab[k]) ? 1 : 0;
        u.pm = __builtin_amdgcn_readfirstlane(rt); u.pn = __builtin_amdgcn_readfirstlane(L % nN); u.e = __builtin_amdgcn_readfirstlane(e); return true;
    }
    __device__ __forceinline__ const char* a_tile(const Gemm& g, const Unit& u) const { return gather ? (const char*)g.A : (const char*)g.A + (size_t)u.pm * BM * g.lda * 2; }
    __device__ __forceinline__ const char* b_tile(const Gemm& g, const Unit& u) const { return (const char*)g.Bt + ((size_t)u.e * bstride + (size_t)u.pn * BM * g.ldb) * 2; }
    __device__ __forceinline__ void a_voff(const Gemm& g, const Unit& u, const int (&R)[2], const int (&C)[2], unsigned (&v)[2][2]) const {
        const int ts = tab[u.e], cn = tab[NE + 1 + u.e];
#pragma unroll
        for (int h = 0; h < 2; ++h)
#pragma unroll
            for (int i = 0; i < 2; ++i) {
                if (gather) { const int pos = (u.pm - ts) * BM + h * HALF + R[i]; const int tok = (pos < cn) ? list[u.e * T + pos] : 0; v[h][i] = (unsigned)(tok * g.lda + C[i]) * 2u; }
                else v[h][i] = (unsigned)((h * HALF + R[i]) * g.lda + C[i]) * 2u;
            }
    }
};

typedef __bf16 bf16x2_t __attribute__((ext_vector_type(2)));
__device__ __forceinline__ unsigned cvt_pk_bf16(float lo, float hi) { f32x2 v = {lo, hi}; bf16x2_t b = __builtin_convertvector(v, bf16x2_t); return __builtin_bit_cast(unsigned, b); }
__device__ __forceinline__ u32x4 pack8(const f32x4& v0, const f32x4& v1) { u32x4 w; w.x = cvt_pk_bf16(v0[0], v0[1]); w.y = cvt_pk_bf16(v0[2], v0[3]); w.z = cvt_pk_bf16(v1[0], v1[1]); w.w = cvt_pk_bf16(v1[2], v1[3]); return w; }
__device__ __forceinline__ void unpack8(const u32x4& w, f32x4& v0, f32x4& v1) { v0[0] = bflo(w.x); v0[1] = bfhi(w.x); v0[2] = bflo(w.y); v0[3] = bfhi(w.y); v1[0] = bflo(w.z); v1[1] = bfhi(w.z); v1[2] = bflo(w.w); v1[3] = bfhi(w.w); }
typedef int v8i __attribute__((ext_vector_type(8)));
typedef int v4i __attribute__((ext_vector_type(4)));
__device__ __forceinline__ u32x2 pack8_fp8(const f32x4& v0, const f32x4& v1) {
    u32x2 w; int t = 0; t = __builtin_amdgcn_cvt_pk_fp8_f32(v0[0], v0[1], t, false); t = __builtin_amdgcn_cvt_pk_fp8_f32(v0[2], v0[3], t, true); w.x = (unsigned)t;
    int t2 = 0; t2 = __builtin_amdgcn_cvt_pk_fp8_f32(v1[0], v1[1], t2, false); t2 = __builtin_amdgcn_cvt_pk_fp8_f32(v1[2], v1[3], t2, true); w.y = (unsigned)t2; return w; }
__device__ __forceinline__ unsigned pack4_fp8(float a, float b, float c, float d) { int t = 0; t = __builtin_amdgcn_cvt_pk_fp8_f32(a, b, t, false); t = __builtin_amdgcn_cvt_pk_fp8_f32(c, d, t, true); return (unsigned)t; }
__device__ __forceinline__ f32x4 sig4(const f32x4& v) { f32x4 o; o[0] = sigmoidf_(v[0]); o[1] = sigmoidf_(v[1]); o[2] = sigmoidf_(v[2]); o[3] = sigmoidf_(v[3]); return o; }

struct EpiInproj {
    static constexpr bool PERM = true;
    unsigned char* ws; int layer;
    template <int KIND> __device__ __forceinline__ void tile(const f32x4 (&acc)[2][2][4][2], const Unit& u, int wr, int wc, int fr, int fq, unsigned char* w) const {
        const float* biasp = (const float*)(w + biasoff(layer));
        const int row0 = u.pm * BM + wr * 64 + fr, bcol0 = u.pn * BM + wc * 32 + 8 * fq;
        f32x4 bv[2][2];
#pragma unroll
        for (int bj = 0; bj < 2; ++bj)
#pragma unroll
            for (int n = 0; n < 2; ++n) bv[bj][n] = *(const f32x4*)(biasp + bcol0 + bj * HALF + 4 * n);
#pragma unroll
        for (int ai = 0; ai < 2; ++ai)
#pragma unroll
            for (int m = 0; m < 4; ++m) { const size_t row = (size_t)(row0 + ai * HALF + m * 16);
#pragma unroll
                for (int bj = 0; bj < 2; ++bj) { f32x4 v0 = acc[ai][bj][m][0] + bv[bj][0], v1 = acc[ai][bj][m][1] + bv[bj][1]; const int col = bcol0 + bj * HALF;
                    if (KIND == 0) { *(u32x4*)((bf16_t*)(w + WS_QO) + row * 1024 + col) = pack8(v0 * C2, v1 * C2); }
                    else if (KIND == 1) { *(u32x4*)((bf16_t*)(w + WS_KV) + row * 1024 + (col - 512)) = pack8(v0, v1); }
                    else if (KIND == 2) { *(u32x4*)((bf16_t*)(w + WS_KV) + row * 1024 + 512 + (col - 1024)) = pack8(v0, v1); }
                    else if (KIND == 3) { *(u32x4*)((bf16_t*)(w + WS_HB) + row * 1024 + (col - 1536)) = pack8(v0 * sig4(v0), v1 * sig4(v1)); }
                    else if (KIND == 4) { const int c = col - 2048; const float* lb = (const float*)(w + WS_MISC) + layer * 512; const f32x4 l0 = *(const f32x4*)(lb + c), l1 = *(const f32x4*)(lb + c + 4);
                        f32x4 f0 = l0 + (1.f - l0) * sig4(v0), f1 = l1 + (1.f - l1) * sig4(v1);
#pragma unroll
                        for (int q = 0; q < 4; ++q) { f0[q] = __logf(f0[q]); f1[q] = __logf(f1[q]); }
                        float* LOGF = (float*)(w + WS_LOGF); *(f32x4*)(LOGF + row * 512 + c) = f0; *(f32x4*)(LOGF + row * 512 + c + 4) = f1; }
                    else if (KIND == 5) { *(u32x4*)((bf16_t*)(w + WS_HB) + row * 1024 + 512 + (col - 2560)) = pack8(v0, v1); }
                    else if (KIND == 6) { *(u32x4*)((bf16_t*)(w + WS_HG) + row * 512 + (col - 3072)) = pack8(v0 * sig4(v0), v1 * sig4(v1)); }
                    else { *(u32x4*)((bf16_t*)(w + WS_G) + row * 2048 + (col - 3584)) = pack8(sig4(v0), sig4(v1)); }
                } }
    }
    __device__ __forceinline__ void operator()(const f32x4 (&acc)[2][2][4][2], const Unit& u, int wr, int wc, int fr, int fq) const {
        size_t z_ = 0; asm volatile("" : "+s"(z_)); unsigned char* w = ws + z_;
        const int ct = u.pn;
        if (ct < 2) tile<0>(acc, u, wr, wc, fr, fq, w); else if (ct < 4) tile<1>(acc, u, wr, wc, fr, fq, w); else if (ct < 6) tile<2>(acc, u, wr, wc, fr, fq, w);
        else if (ct < 8) tile<3>(acc, u, wr, wc, fr, fq, w); else if (ct < 10) tile<4>(acc, u, wr, wc, fr, fq, w); else if (ct < 12) tile<5>(acc, u, wr, wc, fr, fq, w);
        else if (ct < 14) tile<6>(acc, u, wr, wc, fr, fq, w); else tile<7>(acc, u, wr, wc, fr, fq, w);
    }
};
template <int MODE> struct EpiGate {
    static constexpr bool PERM = true;
    bf16_t* O; const float* bias; const bf16_t* Gt; int ldg; const bf16_t* P;
    __device__ __forceinline__ void operator()(const f32x4 (&acc)[2][2][4][2], const Unit& u, int wr, int wc, int fr, int fq) const {
        const int row0 = u.pm * BM + wr * 64 + fr, col0 = u.pn * BM + wc * 32 + 8 * fq;
        f32x4 bv[2][2];
        if (MODE == 0) {
#pragma unroll
            for (int bj = 0; bj < 2; ++bj)
#pragma unroll
                for (int n = 0; n < 2; ++n) bv[bj][n] = bias ? *(const f32x4*)(bias + col0 + bj * HALF + 4 * n) : (f32x4){0.f, 0.f, 0.f, 0.f};
        }
#pragma unroll
        for (int ai = 0; ai < 2; ++ai)
#pragma unroll
            for (int mh = 0; mh < 2; ++mh) {
                u32x4 gq[2][2], pq[2][2];
                if (MODE != 0) {
#pragma unroll
                    for (int mm = 0; mm < 2; ++mm)
#pragma unroll
                        for (int bj = 0; bj < 2; ++bj) { const size_t row = (size_t)(row0 + ai * HALF + (mh * 2 + mm) * 16); const int col = col0 + bj * HALF;
                            gq[mm][bj] = *(const u32x4*)(Gt + row * ldg + col);
                            if (MODE == 2) pq[mm][bj] = __builtin_nontemporal_load((const u32x4*)(P + row * 1024 + col)); }
                    asm volatile("s_waitcnt vmcnt(0)" ::: "memory");
                }
#pragma unroll
                for (int mm = 0; mm < 2; ++mm)
#pragma unroll
                    for (int bj = 0; bj < 2; ++bj) { const int m = mh * 2 + mm; const size_t row = (size_t)(row0 + ai * HALF + m * 16); const int col = col0 + bj * HALF;
                        f32x4 v0 = acc[ai][bj][m][0], v1 = acc[ai][bj][m][1];
                        if (MODE == 0) { v0 += bv[bj][0]; v1 += bv[bj][1]; }
                        else { f32x4 g0, g1; unpack8(gq[mm][bj], g0, g1); v0 *= g0; v1 *= g1;
                            if (MODE == 2) { f32x4 p0, p1; unpack8(pq[mm][bj], p0, p1); v0 += p0; v1 += p1; } }
                        if (MODE == 2) *(u32x2*)((unsigned char*)O + row * 1024 + col) = pack8_fp8(v0 * SC_U, v1 * SC_U); else *(u32x4*)(O + row * 1024 + col) = pack8(v0, v1); }
                if (MODE != 0) asm volatile("" ::: "memory");
            }
    }
};
struct EpiUp {
    static constexpr bool PERM = true;
    bf16_t* H;
    __device__ __forceinline__ void operator()(const f32x4 (&acc)[2][2][4][2], const Unit& u, int wr, int wc, int fr, int fq) const {
        const int row0 = u.pm * BM + wr * 64 + fr, col = u.pn * HALF + wc * 32 + 8 * fq;
#pragma unroll
        for (int ai = 0; ai < 2; ++ai)
#pragma unroll
            for (int m = 0; m < 4; ++m) { const size_t row = (size_t)(row0 + ai * HALF + m * 16);
                const f32x4 a0 = acc[ai][0][m][0], a1 = acc[ai][0][m][1], b0 = acc[ai][1][m][0], b1 = acc[ai][1][m][1];
                *(u32x2*)((unsigned char*)H + row * 1024 + col) = pack8_fp8(a0 * sig4(a0) * b0 * SC_H, a1 * sig4(a1) * b1 * SC_H); }
    }
};

__device__ __forceinline__ void glds16s(const char* sbase, unsigned voff, unsigned lds_dst) {
    unsigned keep;
    asm volatile("s_mov_b32 %0, m0\n\ts_mov_b32 m0, %3\n\ts_nop 0\n\tglobal_load_lds_dwordx4 %1, %2\n\ts_mov_b32 m0, %0" : "=&s"(keep) : "v"(voff), "s"(sbase), "s"(lds_dst) : "memory");
}
template <class Epi, class Sched, bool ALIGN_EPI>
__device__ __forceinline__ void gemm_phase(LAS unsigned char* lds, const Gemm g, const Sched& S, const Epi& E, const int tid) {
    const int wid = __builtin_amdgcn_readfirstlane(tid >> 6), lane = tid & 63, wr = wid >> 2, wc = wid & 3, fr = lane & 15, fq = lane >> 4;
    int K = g.K; asm volatile("" : "+s"(K));
    const int nt = K / BK;
    int RA[2], CA[2]; unsigned voffB[2];
#pragma unroll
    for (int i = 0; i < 2; ++i) { int R, C; stage_rc(tid * 16 + i * 8192, R, C); const int Rb = Epi::PERM ? ((R & ~31) + perm32(R & 31)) : R;
        RA[i] = R; CA[i] = C; voffB[i] = (unsigned)(Rb * g.ldb + C) * 2u; }
    const size_t kstep = (size_t)(BK * 2);
    const size_t hstepB = (size_t)HALF * g.ldb * 2;
    const unsigned ldsw = (unsigned)wid * 1024u;
    const unsigned ldsb = (unsigned)__builtin_amdgcn_readfirstlane((int)((unsigned)(uintptr_t)lds + ldsw));
    const int aoff = lds_byte(wr * 64 + fr, fq * 8), boff = lds_byte(wc * 32 + fr, fq * 8);
#define PG8_SA(b, h) (((b) * 2 + (h)) * HTB)
#define PG8_SB(b, h) ((4 + (b) * 2 + (h)) * HTB)
#define PG8_STAGE(bufoff, gbase, voff) do { _Pragma("unroll") for (int _i = 0; _i < 2; ++_i) glds16s((const char*)(gbase), (voff)[_i], ldsb + (unsigned)((bufoff) + _i * 8192)); } while (0)
#define PG8_LD8(p) __builtin_shufflevector(*(const LAS v4i*)(p), *(const LAS v4i*)((p) + 1024), 0, 1, 2, 3, 4, 5, 6, 7)
#define PG8_LDA(dst, b, h) do { _Pragma("unroll") for (int m = 0; m < 4; ++m) dst[m] = PG8_LD8(lds + PG8_SA(b, h) + aoff + m * 2048); } while (0)
#define PG8_LDB(dst, b, h) do { _Pragma("unroll") for (int n = 0; n < 2; ++n) dst[n] = PG8_LD8(lds + PG8_SB(b, h) + boff + n * 2048); } while (0)
#define PG8_MMA(ai, bj, At, Bt) do { __builtin_amdgcn_s_setprio(1); _Pragma("unroll") for (int m = 0; m < 4; ++m) _Pragma("unroll") for (int n = 0; n < 2; ++n) \
        asm volatile("v_mfma_scale_f32_16x16x128_f8f6f4 %0, %1, %2, %0, %3, %4 op_sel_hi:[0,0,0]" : "+v"(acc[ai][bj][m][n]) : "v"(Bt[n]), "v"(At[m]), "v"(sbv), "v"(sav)); \
        __builtin_amdgcn_s_setprio(0); } while (0)
#define PG8_WAIT_V(n) asm volatile("s_waitcnt vmcnt(" #n ")" ::: "memory")
#define PG8_WAIT_L(n) asm volatile("s_waitcnt lgkmcnt(" #n ")" ::: "memory")
#define PG8_BAR __builtin_amdgcn_s_barrier()
#define PG8_SCHED __builtin_amdgcn_sched_barrier(0)
    Unit cur, nxt; int ui = 0;
    if (!S.next(0, cur)) return;
    f32x4 acc[2][2][4][2];
#pragma unroll
    for (int a = 0; a < 2; ++a)
#pragma unroll
        for (int b = 0; b < 2; ++b)
#pragma unroll
            for (int m = 0; m < 4; ++m)
#pragma unroll
                for (int n = 0; n < 2; ++n) acc[a][b][m][n] = (f32x4){0.f, 0.f, 0.f, 0.f};
    int sav = g.sa, sbv = g.sb;
    v8i At[4], B0[2], B1[2];
    unsigned vA[2][2], nvA[2][2];
    S.a_voff(g, cur, RA, CA, vA);
    const char* cA = S.a_tile(g, cur); const char* cB = S.b_tile(g, cur);
    PG8_STAGE(PG8_SB(0, 0), cB, voffB); PG8_STAGE(PG8_SB(0, 1), cB + hstepB, voffB); PG8_STAGE(PG8_SA(0, 0), cA, vA[0]); PG8_STAGE(PG8_SA(0, 1), cA, vA[1]);
    if (wr == 1) PG8_BAR;
    PG8_WAIT_V(2); PG8_BAR;
    PG8_STAGE(PG8_SB(1, 0), cB + kstep, voffB); PG8_STAGE(PG8_SA(1, 0), cA + kstep, vA[0]); PG8_STAGE(PG8_SB(1, 1), cB + hstepB + kstep, voffB);
    PG8_WAIT_V(6); PG8_BAR;
    for (;;) {
        const bool has_next = S.next(ui + 1, nxt);
        const char* nA = has_next ? S.a_tile(g, nxt) : cA; const char* nB = has_next ? S.b_tile(g, nxt) : cB;
        if constexpr (Sched::GATHER) {
            if (has_next) { int RA2[2], CA2[2];
#pragma unroll
                for (int i = 0; i < 2; ++i) { int tq = tid; asm volatile("" : "+v"(tq)); stage_rc(tq * 16 + i * 8192, RA2[i], CA2[i]); }
                S.a_voff(g, nxt, RA2, CA2, nvA); }
            else {
#pragma unroll
                for (int h = 0; h < 2; ++h)
#pragma unroll
                    for (int i = 0; i < 2; ++i) nvA[h][i] = vA[h][i]; }
        }
        for (int t = 0; t < nt; t += 2) {
            const bool last = (t == nt - 2);
            const char* a1 = cA + (size_t)(t + 1) * kstep;
            const char* a2 = last ? nA : cA + (size_t)(t + 2) * kstep; const char* b2 = last ? nB : cB + (size_t)(t + 2) * kstep;
            const char* a3 = a2 + kstep; const char* b3 = b2 + kstep;
            unsigned wA0[2], wA1[2];
#pragma unroll
            for (int i = 0; i < 2; ++i) { if constexpr (Sched::GATHER) { wA0[i] = last ? nvA[0][i] : vA[0][i]; wA1[i] = last ? nvA[1][i] : vA[1][i]; } else { wA0[i] = vA[0][i]; wA1[i] = vA[1][i]; } }
            PG8_LDB(B0, 0, 0); PG8_LDB(B1, 0, 1); PG8_SCHED; PG8_LDA(At, 0, 0); PG8_STAGE(PG8_SA(1, 1), a1, vA[1]);
            PG8_WAIT_V(8); PG8_WAIT_L(0); PG8_BAR; PG8_MMA(0, 0, At, B0); PG8_MMA(0, 1, At, B1); PG8_BAR; PG8_SCHED;
            PG8_LDA(At, 0, 1); PG8_STAGE(PG8_SB(0, 0), b2, voffB); PG8_STAGE(PG8_SB(0, 1), b2 + hstepB, voffB); PG8_STAGE(PG8_SA(0, 0), a2, wA0);
            PG8_WAIT_V(8); PG8_WAIT_L(0); PG8_BAR; PG8_MMA(1, 0, At, B0); PG8_MMA(1, 1, At, B1); PG8_BAR; PG8_SCHED;
            PG8_LDB(B0, 1, 0); PG8_LDB(B1, 1, 1); PG8_SCHED; PG8_LDA(At, 1, 0); PG8_STAGE(PG8_SA(0, 1), a2, wA1);
            PG8_WAIT_V(8); PG8_WAIT_L(0); PG8_BAR; PG8_MMA(0, 0, At, B0); PG8_MMA(0, 1, At, B1); PG8_BAR; PG8_SCHED;
            PG8_LDA(At, 1, 1); PG8_STAGE(PG8_SB(1, 0), b3, voffB); PG8_STAGE(PG8_SB(1, 1), b3 + hstepB, voffB); PG8_STAGE(PG8_SA(1, 0), a3, wA0);
            PG8_WAIT_V(8); PG8_WAIT_L(0); PG8_BAR; PG8_MMA(1, 0, At, B0); PG8_MMA(1, 1, At, B1); PG8_BAR; PG8_SCHED;
        }
        if constexpr (ALIGN_EPI) { if (wr == 0) PG8_BAR; }
        asm volatile("s_nop 15\n\ts_nop 15" ::: "memory");
        E(acc, cur, wr, wc, fr, fq);
        if (!has_next) break;
#pragma unroll
        for (int a = 0; a < 2; ++a)
#pragma unroll
            for (int b = 0; b < 2; ++b)
#pragma unroll
                for (int m = 0; m < 4; ++m)
#pragma unroll
                    for (int n = 0; n < 2; ++n) acc[a][b][m][n] = (f32x4){0.f, 0.f, 0.f, 0.f};
        cur = nxt; cA = nA; cB = nB; ++ui;
        if constexpr (Sched::GATHER) {
#pragma unroll
            for (int h = 0; h < 2; ++h)
#pragma unroll
                for (int i = 0; i < 2; ++i) vA[h][i] = nvA[h][i]; }
        if constexpr (ALIGN_EPI) { if (wr == 1) PG8_BAR; }
    }
    PG8_WAIT_V(0);
    if constexpr (!ALIGN_EPI) { if (wr == 0) PG8_BAR; }
    PG8_BAR;
#undef PG8_SA
#undef PG8_SB
#undef PG8_STAGE
#undef PG8_LDA
#undef PG8_LDB
#undef PG8_MMA
#undef PG8_LD8
#undef PG8_WAIT_V
#undef PG8_WAIT_L
#undef PG8_BAR
#undef PG8_SCHED
}
}


#include <hip/hip_bf16.h>
#include <cmath>
namespace attn_body {
using bf16=__hip_bfloat16;
using bf16x8=__attribute__((ext_vector_type(8)))short;
using s16x4=__attribute__((ext_vector_type(4)))short;
using f32x16=__attribute__((ext_vector_type(16)))float;
using u32x4=__attribute__((ext_vector_type(4)))unsigned;
constexpr int BATCH=16,NHEAD=8,SEQ=2048,D=64,DM=1024;
constexpr int NW=8,QBLK=32,QB=QBLK*NW,KVBLK=64,NQB=SEQ/QB;
constexpr int ATTN_PITCH=DM, ATTN_UNIT_ROWS=QB;
__device__ __forceinline__ int crow(int r,int hi){return (r&3)+8*(r>>2)+4*hi;}
#define SBAR() __builtin_amdgcn_sched_barrier(0)
__device__ __forceinline__ void cmask(f32x16&p0,f32x16&p1,int jb,int qrel,int hi){
  const float NEG=-INFINITY; int kb=64*jb+4*hi;
  #pragma unroll
  for(int r=0;r<16;++r){int kv=kb+(r&3)+8*(r>>2); if(kv>qrel)p0[r]=NEG; if(kv+32>qrel)p1[r]=NEG;}
}

constexpr int NSLOT=3, SLOTB=8192;
constexpr int LDS_K=0, LDS_V=NSLOT*SLOTB, LDS_WS=2*NSLOT*SLOTB, LDS_OST=LDS_WS+NW*64*4, LDS_BYTES=LDS_OST+NW*4096;
constexpr float C2=0.125f*1.4426950408889634f;
__device__ __forceinline__ void glds16(const void*gsrc,unsigned lds_dst){unsigned keep;
  asm volatile("s_mov_b32 %0, m0\n\ts_mov_b32 m0, %2\n\ts_nop 0\n\tglobal_load_lds_dwordx4 %1, off\n\ts_mov_b32 m0, %0":"=&s"(keep):"v"(gsrc),"s"(lds_dst):"memory");}
__device__ __forceinline__ float max3f(float a,float b,float c){float r;asm("v_max3_f32 %0, %1, %2, %3":"=v"(r):"v"(a),"v"(b),"v"(c));return r;}
__device__ __forceinline__ float max2f(float a,float b){float r;asm("v_max_f32_e32 %0, %1, %2":"=v"(r):"v"(a),"v"(b));return r;}
__device__ __forceinline__ float fadd_s(float a,float b){float r;asm("v_add_f32_e32 %0, %1, %2":"=v"(r):"v"(a),"v"(b));return r;}
__device__ __forceinline__ float fsub_s(float a,float b){float r;asm("v_sub_f32_e32 %0, %1, %2":"=v"(r):"v"(a),"v"(b));return r;}
typedef float f32x2_t __attribute__((ext_vector_type(2))); typedef __bf16 bf16x2_t __attribute__((ext_vector_type(2)));
__device__ __forceinline__ unsigned cvtpk_s(float lo,float hi){f32x2_t v={lo,hi};bf16x2_t b=__builtin_convertvector(v,bf16x2_t);return __builtin_bit_cast(unsigned,b);}
#define WAIT_BAR(N) asm volatile("s_waitcnt vmcnt(" #N ") lgkmcnt(0)\n\ts_barrier":::"memory")

__device__ __forceinline__ void qkt(f32x16&p0,f32x16&p1,const char*Kslot,const bf16x8*qr,const f32x16&negm,int r32,int hi){
  const char*kb=Kslot+hi*1024+r32*16;
  #pragma unroll
  for(int d0=0;d0<4;++d0){
    const bf16x8 b0=*reinterpret_cast<const bf16x8*>(kb+d0*2048);
    const bf16x8 b1=*reinterpret_cast<const bf16x8*>(kb+d0*2048+512);
    if(d0==0){p0=__builtin_amdgcn_mfma_f32_32x32x16_bf16(b0,qr[0],negm,0,0,0);p1=__builtin_amdgcn_mfma_f32_32x32x16_bf16(b1,qr[0],negm,0,0,0);}
    else{p0=__builtin_amdgcn_mfma_f32_32x32x16_bf16(b0,qr[d0],p0,0,0,0);p1=__builtin_amdgcn_mfma_f32_32x32x16_bf16(b1,qr[d0],p1,0,0,0);}}
}
typedef __attribute__((address_space(3))) const char* lds_cptr;
typedef short v4i16_t __attribute__((ext_vector_type(4)));
__device__ __forceinline__ void kload8(bf16x8*kf,lds_cptr kp){
  kf[0]=*(const __attribute__((address_space(3))) bf16x8*)(kp);      kf[1]=*(const __attribute__((address_space(3))) bf16x8*)(kp+512);
  kf[2]=*(const __attribute__((address_space(3))) bf16x8*)(kp+2048); kf[3]=*(const __attribute__((address_space(3))) bf16x8*)(kp+2560);
  kf[4]=*(const __attribute__((address_space(3))) bf16x8*)(kp+4096); kf[5]=*(const __attribute__((address_space(3))) bf16x8*)(kp+4608);
  kf[6]=*(const __attribute__((address_space(3))) bf16x8*)(kp+6144); kf[7]=*(const __attribute__((address_space(3))) bf16x8*)(kp+6656);
}
__device__ __forceinline__ void kload2(bf16x8*kf,lds_cptr kp,int j){ kf[2*j]=*(const __attribute__((address_space(3))) bf16x8*)(kp+j*2048); kf[2*j+1]=*(const __attribute__((address_space(3))) bf16x8*)(kp+j*2048+512); }
__device__ __forceinline__ s16x4 vtr(lds_cptr p){ return __builtin_bit_cast(s16x4,__builtin_amdgcn_ds_read_tr16_b64_v4i16((__attribute__((address_space(3))) v4i16_t*)p)); }
__device__ __forceinline__ float rowmax(const f32x16&p0,const f32x16&p1){
  float a=max3f(p0[0],p0[1],p1[0]),b=max3f(p0[2],p0[3],p1[1]);a=max3f(a,p1[2],p1[3]);
  #pragma unroll
  for(int r=4;r<16;r+=4){a=max3f(a,p0[r],p0[r+1]);b=max3f(b,p0[r+2],p0[r+3]);a=max3f(a,p1[r],p1[r+1]);b=max3f(b,p1[r+2],p1[r+3]);}
  const float m=max2f(a,b);
  auto rr=__builtin_amdgcn_permlane32_swap(__float_as_uint(m),__float_as_uint(m),false,false);
  return max2f(__uint_as_float(rr[0]),__uint_as_float(rr[1]));
}
__device__ __forceinline__ void pv(f32x16*o,int vb,bf16x8 pa0,bf16x8 pa1,bf16x8 pa2,bf16x8 pa3){
  #pragma unroll
  for(int d0=0;d0<2;++d0){s16x4 lo[4],hi[4];
    #pragma unroll
    for(int ks=0;ks<4;++ks){
      asm volatile("ds_read_b64_tr_b16 %0,%1 offset:%c2":"=&v"(lo[ks]):"v"(vb),"i"(d0*4096+ks*1024):"memory");
      asm volatile("ds_read_b64_tr_b16 %0,%1 offset:%c2":"=&v"(hi[ks]):"v"(vb),"i"(d0*4096+ks*1024+512):"memory");}
    asm volatile("s_waitcnt lgkmcnt(0)":::"memory");SBAR();
    #define PK(k) (bf16x8){lo[k][0],lo[k][1],lo[k][2],lo[k][3],hi[k][0],hi[k][1],hi[k][2],hi[k][3]}
    o[d0]=__builtin_amdgcn_mfma_f32_32x32x16_bf16(pa0,PK(0),o[d0],0,0,0);
    o[d0]=__builtin_amdgcn_mfma_f32_32x32x16_bf16(pa1,PK(1),o[d0],0,0,0);
    o[d0]=__builtin_amdgcn_mfma_f32_32x32x16_bf16(pa2,PK(2),o[d0],0,0,0);
    o[d0]=__builtin_amdgcn_mfma_f32_32x32x16_bf16(pa3,PK(3),o[d0],0,0,0);
    #undef PK
  }
}

#ifndef ATTN_STORE16
#define ATTN_STORE16(p,v) (*(u32x4*)(p)=(v))
#endif
template<int THRL> __device__ __forceinline__ void attn_unit(int b,int h,int qb,const bf16*Q,const bf16*__restrict__ K,const bf16*__restrict__ V,bf16*O,char*shm,const __attribute__((address_space(3))) float*f2,const int tid){
  #define BIAS_H(P,off,g0) { f32x4 x_[2]; _Pragma("unroll") for(int g_=0;g_<2;++g_) x_[g_]=*(const __attribute__((address_space(3))) f32x4*)(fb_+(off)+8*((g0)+g_)); \
      _Pragma("unroll") for(int g_=0;g_<2;++g_) _Pragma("unroll") for(int i_=0;i_<4;++i_) P[4*((g0)+g_)+i_]-=x_[g_][i_]; asm volatile("":::"memory"); }
  #define BIAS(P0,P1,t) do{ const __attribute__((address_space(3))) float* fb_=f2+64*(t)+4*hi; \
    BIAS_H(P0,0,0) BIAS_H(P0,0,2) BIAS_H(P1,32,0) BIAS_H(P1,32,2) }while(0)
  const int lane=tid&63,r32=lane&31,hi=lane>>5; const int wid=__builtin_amdgcn_readfirstlane(tid>>6);
  const long rowbase=(long)b*SEQ; const int q0=qb*QB;
  const bf16*Qw=Q+(rowbase+q0+wid*QBLK)*DM+h*D;
  const bf16*Kh=K+rowbase*DM+h*D,*Vh=V+rowbase*DM+h*D;
  const unsigned lds0=(unsigned)(uintptr_t)shm;
  float*wsf=(float*)(shm+LDS_WS)+wid*64;
  const bf16*ksrc=Kh+(long)lane*DM+wid*8;
  const bf16*vsrc=Vh+(long)(16*(wid&3)+(lane>>2))*DM+(wid>>2)*32+(lane&3)*8;
  const unsigned kdst=lds0+LDS_K+wid*1024, vdst=lds0+LDS_V+wid*1024;
  #define DMA_K(t,slot) glds16(ksrc+(long)(t)*KVBLK*DM,(unsigned)__builtin_amdgcn_readfirstlane(kdst+(slot)))
  #define DMA_V(t,slot) glds16(vsrc+(long)(t)*KVBLK*DM,(unsigned)__builtin_amdgcn_readfirstlane(vdst+(slot)))
  const int vb0=(int)(lds0+LDS_V)+((lane>>4)&1)*32+(lane&3)*8+(4*hi+((lane&15)>>2))*64;
  const char*Kbase=shm+LDS_K; bf16x8 kf[8];
  const lds_cptr shm3=(lds_cptr)shm; const lds_cptr kp0=shm3+LDS_K+hi*1024+r32*16; const lds_cptr vp0=shm3+LDS_V+((lane>>4)&1)*32+(lane&3)*8+(4*hi+((lane&15)>>2))*64;
  const int NT=(q0+QB)/KVBLK;
  DMA_K(0,0);DMA_V(0,0);DMA_K(1,SLOTB);
  bf16x8 qr[4];
  #pragma unroll
  for(int d0=0;d0<4;++d0)qr[d0]=*reinterpret_cast<const bf16x8*>(&Qw[(long)r32*DM+d0*16+hi*8]);
  float mhat=0.f,l_reg=0.f;f32x16 o[2];f32x16 negm; { float z_=0.f; asm volatile("":"+v"(z_)); _Pragma("unroll") for(int r=0;r<16;++r){o[0][r]=z_;o[1][r]=z_;negm[r]=z_;} } asm volatile("":"+v"(negm));
  const int qrel=wid*QBLK+r32;
  #define CMASK(P0,P1,t) do{int jb_=(t)-(NT-4); if(jb_>=0)cmask(P0,P1,jb_,qrel,hi);}while(0)
  bool resc=false;
  #define START(P0,P1) do{ const float rm=rowmax(P0,P1); resc=false; \
    { const float dl=rm; mhat=fadd_s(mhat,dl); \
      _Pragma("unroll") for(int r=0;r<16;++r){P0[r]=fsub_s(P0[r],dl);P1[r]=fsub_s(P1[r],dl);} \
      _Pragma("unroll") for(int r=0;r<16;++r)negm[r]=-mhat; asm volatile("":"+v"(negm)); } \
    _Pragma("unroll") for(int r=0;r<16;++r)P0[r]=__builtin_amdgcn_exp2f(P0[r]); }while(0)
  #define RESC() do{ if(resc){ asm volatile("s_waitcnt lgkmcnt(0)":::"memory"); \
      _Pragma("unroll") for(int d_=0;d_<2;++d_) _Pragma("unroll") for(int r=0;r<16;++r)o[d_][r]*=wsf[crow(r,hi)]; } }while(0)
  f32x16 pA0,pA1,pB0,pB1;
  int sl_prev=0,sl_cur=0,sl_next=SLOTB;
  #define ROT() do{sl_prev=sl_cur;sl_cur=sl_next;sl_next=(sl_next==(NSLOT-1)*SLOTB)?0:sl_next+SLOTB;}while(0)
  DMA_K(2,2*SLOTB);
  WAIT_BAR(3);
  qkt(pA0,pA1,Kbase,qr,negm,r32,hi);asm volatile("s_nop 15\n\ts_nop 7":"+v"(pA0),"+v"(pA1));CMASK(pA0,pA1,0);BIAS(pA0,pA1,0);
  START(pA0,pA1);
  _Pragma("unroll") for(int r=0;r<16;++r)pA1[r]=__builtin_amdgcn_exp2f(pA1[r]);
  WAIT_BAR(0);
  DMA_K(3,0);DMA_V(1,SLOTB);
  ROT();
  kload8(kf,kp0+sl_cur);
  WAIT_BAR(2);
  s16x4 vlo[8],vhi[8]; u32x4 pw0,pw1,pw2,pw3;
  #define PKW(P,B) cvtpk_s(P[B],P[B+1])
  #define PAF(k) __builtin_bit_cast(bf16x8,pw##k)
  #define VFR(i) (bf16x8){vlo[i][0],vlo[i][1],vlo[i][2],vlo[i][3],vhi[i][0],vhi[i][1],vhi[i][2],vhi[i][3]}
  #define PIN(x) asm volatile("":"+v"(x))
  #define MX3(a,b,c) __builtin_fmaxf(__builtin_fmaxf((a),(b)),(c))
  #define GAPA(MF,A0,A1,A2,A3,W0,W1,PW) do{ MF; sacc+=A0; sacc+=A1; sacc+=A2; sacc+=A3; PIN(sacc); W0; W1; PIN(PW); SBAR(); }while(0)
  #define EX(v) __builtin_amdgcn_exp2f(v)
  #define GAPB(MF,X,B) do{ MF; X[B]=EX(X[B]); X[B+1]=EX(X[B+1]); X[B+2]=EX(X[B+2]); X[B+3]=EX(X[B+3]); PIN(X); SBAR(); }while(0)
  #define VRD(i) do{ vlo[i]=vtr(vp_+(((i)>>2)*4096+((i)&3)*1024)); vhi[i]=vtr(vp_+(((i)>>2)*4096+((i)&3)*1024+512)); }while(0)
  #define KRD(G,j) do{ if(G){ kload2(kf,kp0+sl_next,j); SBAR(); } }while(0)
  #define STEP(C0,C1,P0,P1,t,GK,GV,GL) do{ SBAR(); \
    const lds_cptr vp_=vp0+sl_prev; \
    VRD(0); SBAR(); float sacc=(P0[0]+P0[1]); \
    GAPA(C0=__builtin_amdgcn_mfma_f32_32x32x16_bf16(kf[0],qr[0],negm,0,0,0), P0[2],P0[3],P0[4],P0[5],     pw0[0]=PKW(P0,0), pw0[1]=PKW(P0,2), pw0); \
    VRD(4); SBAR(); GAPA(C1=__builtin_amdgcn_mfma_f32_32x32x16_bf16(kf[1],qr[0],negm,0,0,0), P0[6],P0[7],P0[8],P0[9],     pw0[2]=PKW(P0,4), pw0[3]=PKW(P0,6), pw0); \
    VRD(1); SBAR(); GAPA(C0=__builtin_amdgcn_mfma_f32_32x32x16_bf16(kf[2],qr[1],C0,0,0,0),   P0[10],P0[11],P0[12],P0[13], pw1[0]=PKW(P0,8), pw1[1]=PKW(P0,10), pw1); \
    VRD(5); SBAR(); GAPA(C1=__builtin_amdgcn_mfma_f32_32x32x16_bf16(kf[3],qr[1],C1,0,0,0),   P0[14],P0[15],P1[0],P1[1],   pw1[2]=PKW(P0,12),pw1[3]=PKW(P0,14), pw1); \
    VRD(2); SBAR(); GAPA(C0=__builtin_amdgcn_mfma_f32_32x32x16_bf16(kf[4],qr[2],C0,0,0,0),   P1[2],P1[3],P1[4],P1[5],     pw2[0]=PKW(P1,0), pw2[1]=PKW(P1,2), pw2); \
    VRD(6); SBAR(); GAPA(C1=__builtin_amdgcn_mfma_f32_32x32x16_bf16(kf[5],qr[2],C1,0,0,0),   P1[6],P1[7],P1[8],P1[9],     pw2[2]=PKW(P1,4), pw2[3]=PKW(P1,6), pw2); \
    VRD(3); SBAR(); GAPA(C0=__builtin_amdgcn_mfma_f32_32x32x16_bf16(kf[6],qr[3],C0,0,0,0),   P1[10],P1[11],P1[12],P1[13], pw3[0]=PKW(P1,8), pw3[1]=PKW(P1,10), pw3); \
    VRD(7); SBAR(); GAPA(C1=__builtin_amdgcn_mfma_f32_32x32x16_bf16(kf[7],qr[3],C1,0,0,0),   P1[14],P1[15],0.f,0.f,       pw3[2]=PKW(P1,12),pw3[3]=PKW(P1,14), pw3); \
    l_reg+=sacc; \
    if(GK){DMA_K((t)+3,sl_cur);} if(GV){DMA_V((t)+1,sl_next);} \
    CMASK(C0,C1,t); BIAS(C0,C1,t); \
    { float a=MX3(C0[0],C0[1],C1[0]),b=MX3(C0[2],C0[3],C1[1]); a=MX3(a,C1[2],C1[3]); \
      _Pragma("unroll") for(int r=4;r<16;r+=4){a=MX3(a,C0[r],C0[r+1]);b=MX3(b,C0[r+2],C0[r+3]);a=MX3(a,C1[r],C1[r+1]);b=MX3(b,C1[r+2],C1[r+3]);} \
      float rm=__builtin_fmaxf(a,b); { auto rr=__builtin_amdgcn_permlane32_swap(__float_as_uint(rm),__float_as_uint(rm),false,false); rm=__builtin_fmaxf(__uint_as_float(rr[0]),__uint_as_float(rr[1])); } \
      resc=false; \
      if(__builtin_expect(__any(rm>(float)THRL),0)){ const float dl=__builtin_fmaxf(rm,0.f); mhat+=dl; \
        _Pragma("unroll") for(int r=0;r<16;++r){C0[r]-=dl;C1[r]-=dl;} \
        _Pragma("unroll") for(int r=0;r<16;++r)negm[r]=-mhat; asm volatile("":"+v"(negm)); \
        const float f=__builtin_amdgcn_exp2f(-dl); l_reg*=f; if(hi==0)wsf[r32]=f; resc=true; } } \
    SBAR(); \
    GAPB(o[0]=__builtin_amdgcn_mfma_f32_32x32x16_bf16(PAF(0),VFR(0),o[0],0,0,0), C0,0); \
    GAPB(o[1]=__builtin_amdgcn_mfma_f32_32x32x16_bf16(PAF(0),VFR(4),o[1],0,0,0), C0,4); \
    KRD(GL,0); GAPB(o[0]=__builtin_amdgcn_mfma_f32_32x32x16_bf16(PAF(1),VFR(1),o[0],0,0,0), C0,8); \
    KRD(GL,1); GAPB(o[1]=__builtin_amdgcn_mfma_f32_32x32x16_bf16(PAF(1),VFR(5),o[1],0,0,0), C0,12); \
    KRD(GL,2); GAPB(o[0]=__builtin_amdgcn_mfma_f32_32x32x16_bf16(PAF(2),VFR(2),o[0],0,0,0), C1,0); \
    KRD(GL,3); GAPB(o[1]=__builtin_amdgcn_mfma_f32_32x32x16_bf16(PAF(2),VFR(6),o[1],0,0,0), C1,4); \
    GAPB(o[0]=__builtin_amdgcn_mfma_f32_32x32x16_bf16(PAF(3),VFR(3),o[0],0,0,0), C1,8); \
    GAPB(o[1]=__builtin_amdgcn_mfma_f32_32x32x16_bf16(PAF(3),VFR(7),o[1],0,0,0), C1,12); \
    }while(0)
  int t=1;
  #undef CMASK
  #define CMASK(P0,P1,t) do{}while(0)
  for(;t+5<NT;t+=2){
    STEP(pB0,pB1,pA0,pA1,t,true,true,true);     WAIT_BAR(2); RESC(); ROT();
    STEP(pA0,pA1,pB0,pB1,t+1,true,true,true);   WAIT_BAR(2); RESC(); ROT();
  }
  #undef CMASK
  #define CMASK(P0,P1,t) do{int jb_=(t)-(NT-4); if(jb_>=0)cmask(P0,P1,jb_,qrel,hi);}while(0)
  #define ENDW(tt) do{ if((tt)+3<NT){WAIT_BAR(2);} else if((tt)+2<NT){WAIT_BAR(1);} else {WAIT_BAR(0);} }while(0)
  for(;t+1<NT;t+=2){
    STEP(pB0,pB1,pA0,pA1,t,(t+3<NT),(t+1<NT),(t+1<NT));       ENDW(t);   RESC(); ROT();
    STEP(pA0,pA1,pB0,pB1,t+1,(t+4<NT),(t+2<NT),(t+2<NT));     ENDW(t+1); RESC(); ROT();
  }
  STEP(pB0,pB1,pA0,pA1,NT-1,false,false,false); RESC();
  { float sacc=pB0[0]+pB0[1]; _Pragma("unroll") for(int r=2;r<16;++r)sacc+=pB0[r]; _Pragma("unroll") for(int r=0;r<16;++r)sacc+=pB1[r]; l_reg+=sacc;
    pw0=(u32x4){PKW(pB0,0),PKW(pB0,2),PKW(pB0,4),PKW(pB0,6)};pw1=(u32x4){PKW(pB0,8),PKW(pB0,10),PKW(pB0,12),PKW(pB0,14)};pw2=(u32x4){PKW(pB1,0),PKW(pB1,2),PKW(pB1,4),PKW(pB1,6)};pw3=(u32x4){PKW(pB1,8),PKW(pB1,10),PKW(pB1,12),PKW(pB1,14)};
    SBAR(); pv(o,vb0+sl_cur,PAF(0),PAF(1),PAF(2),PAF(3)); }
  #undef PKW
  #undef PAF
  #undef VFR
  #undef PIN
  #undef MX3
  #undef GAPA
  #undef GAPB
  #undef EX
  #undef VRD
  #undef KRD
  #undef STEP
  #undef ENDW
  {auto rr=__builtin_amdgcn_permlane32_swap(__float_as_uint(l_reg),__float_as_uint(l_reg),false,false);l_reg=__uint_as_float(rr[0])+__uint_as_float(rr[1]);}
  if(hi==0)wsf[32+r32]=l_reg;asm volatile("s_waitcnt lgkmcnt(0)":::"memory");
  float rli[16];
  #pragma unroll
  for(int r=0;r<16;++r)rli[r]=__builtin_amdgcn_rcpf(wsf[32+crow(r,hi)]);
  { bf16*stg=(bf16*)(shm+LDS_OST)+wid*2048;
    #pragma unroll
    for(int r=0;r<16;++r){const int orow=crow(r,hi);
      #pragma unroll
      for(int d0=0;d0<2;++d0)stg[orow*64+d0*32+r32]=__float2bfloat16(o[d0][r]*rli[r]);}
    asm volatile("s_waitcnt lgkmcnt(0)":::"memory");
    unsigned char*O8w=(unsigned char*)O+(rowbase+q0+wid*QBLK)*DM+h*D;
    _Pragma("unroll") for(int i=0;i<4;++i){const int row=i*8+(lane>>3),ch=lane&7; const u32x4 v=*(const u32x4*)(stg+row*64+ch*8);
      u32x2 w8; w8.x=pg8::pack4_fp8(bflo(v.x)*SC_FOX,bfhi(v.x)*SC_FOX,bflo(v.y)*SC_FOX,bfhi(v.y)*SC_FOX); w8.y=pg8::pack4_fp8(bflo(v.z)*SC_FOX,bfhi(v.z)*SC_FOX,bflo(v.w)*SC_FOX,bfhi(v.w)*SC_FOX);
      *(u32x2*)(O8w+(long)row*DM+ch*8)=w8;} }
  asm volatile("s_waitcnt lgkmcnt(0)\n\ts_barrier":::"memory");
  #undef BIAS
  #undef BIAS_H
  #undef DMA_K
  #undef DMA_V
  #undef CMASK
  #undef START
  #undef RESC
  #undef ROT
}
constexpr int ATTN_LDS_BYTES=LDS_BYTES;
#undef SBAR
#undef WAIT_BAR
}


constexpr int NWAVES = 8;
constexpr int RING_OFF = 0, RING_BYTES = 131072;
constexpr int LDSCTL_OFF = RING_BYTES, MISC_OFF = LDSCTL_OFF + 320, TAB_OFF = LDSCTL_OFF + 1024;
constexpr int WTAB_OFF = LDSCTL_OFF + 2048;
constexpr int LDS_BYTES = 147456;
typedef GAS unsigned gu32;
__device__ __forceinline__ unsigned hw_wave_key() { return (unsigned)__builtin_amdgcn_s_getreg((5 << 11) | 4) & 63u; }
#define RLX_AGENT __ATOMIC_RELAXED, __HIP_MEMORY_SCOPE_AGENT

#define XB_TMO      128
#define XB_XCNT(j)  (256  + 64 * (j))
#define XB_XSUB(j)  (1280 + 64 * (j))
#define XB_XGEN(j)  (2304 + 64 * (j))
#define XB_TOP      3328
#define XB_TOPGEN   3392
#define XCD_BAR_WORDS 3456
#define XB_SPIN_CAP (1u << 18)

__device__ __forceinline__ unsigned xb_ld(unsigned* p)              { return __hip_atomic_load(p, __ATOMIC_RELAXED, __HIP_MEMORY_SCOPE_AGENT); }
__device__ __forceinline__ unsigned xb_add(unsigned* p, unsigned v) { return __hip_atomic_fetch_add(p, v, __ATOMIC_RELAXED, __HIP_MEMORY_SCOPE_AGENT); }
__device__ __forceinline__ unsigned xb_xcc_id() { return (unsigned)__builtin_amdgcn_s_getreg((3 << 11) | 20) & 0xFu; }
#define XB_SPIN(cond, bar) do { unsigned _sp = 0; while (cond) { __builtin_amdgcn_s_sleep(1); \
    if ((++_sp & 255u) == 0u) { if (xb_ld(&(bar)[XB_TMO])) break; if (_sp > XB_SPIN_CAP) { atomicAdd(&(bar)[XB_TMO], 1u); break; } } } } while (0)

struct XcdBarrier {
    unsigned* bar; unsigned x;
    volatile LAS unsigned* st;
};

__device__ __forceinline__ XcdBarrier xcd_barrier_post(unsigned* bar, volatile LAS unsigned* st) {
    XcdBarrier b; b.bar = bar; b.x = xb_xcc_id(); b.st = st;
    if (threadIdx.x == 0) (void)xb_add(&bar[XB_XCNT(b.x)], 1u);
    return b;
}
__device__ __forceinline__ void xcd_barrier_complete(unsigned* bar, unsigned x, unsigned& nloc, unsigned& nx) {
    const unsigned G = gridDim.x * gridDim.y * gridDim.z;
    unsigned sum, cnt, mine, sp = 0u;
    for (;;) {
        sum = 0u; cnt = 0u; mine = 0u;
#pragma unroll
        for (unsigned j = 0; j < 16; ++j) { const unsigned c = xb_ld(&bar[XB_XCNT(j)]); sum += c; cnt += (c > 0u) ? 1u : 0u; mine = (j == x) ? c : mine; }
        if (sum == G) break;
        __builtin_amdgcn_s_sleep(1);
        if ((++sp & 255u) == 0u) { if (xb_ld(&bar[XB_TMO])) break; if (sp > XB_SPIN_CAP) { atomicAdd(&bar[XB_TMO], 1u); break; } }
    }
    nloc = mine > 0u ? mine : 1u; nx = cnt > 0u ? cnt : 1u;
}

__device__ __forceinline__ void xcd_barrier(const XcdBarrier& b) {
    asm volatile("s_waitcnt vmcnt(0)" ::: "memory");
    __syncthreads();
    if (threadIdx.x == 0) {
        unsigned* bar = b.bar;
        __builtin_amdgcn_s_waitcnt(0);
        unsigned nloc = b.st[0], nx = b.st[1];
        if (nloc == 0u) { xcd_barrier_complete(bar, b.x, nloc, nx); b.st[0] = nloc; b.st[1] = nx; }
        const unsigned old = xb_add(&bar[XB_XSUB(b.x)], 1u);
        const unsigned gen = old / nloc;
        if (old + 1u == (gen + 1u) * nloc) {
            __builtin_amdgcn_fence(__ATOMIC_RELEASE, "agent");
            asm volatile("s_waitcnt vmcnt(0)" ::: "memory");
            const unsigned og = xb_add(&bar[XB_TOP], 1u);
            const unsigned tg = og / nx;
            if (og + 1u == (tg + 1u) * nx) xb_add(&bar[XB_TOPGEN], 1u);
            else XB_SPIN(xb_ld(&bar[XB_TOPGEN]) == tg, bar);
            __builtin_amdgcn_fence(__ATOMIC_ACQUIRE, "agent");
            xb_add(&bar[XB_XGEN(b.x)], 1u);
            asm volatile("s_waitcnt vmcnt(0)" ::: "memory");
        } else {
            XB_SPIN(xb_ld(&bar[XB_XGEN(b.x)]) == gen, bar);
            __builtin_amdgcn_fence(__ATOMIC_ACQUIRE, "agent");
            asm volatile("s_waitcnt vmcnt(0)" ::: "memory");
        }
    }
    __syncthreads();
}


struct Args {
    const float *x, *ln_in_g, *ln_in_b, *w_in, *b_in, *w_fox, *lbl, *norm_g, *w_hgrn, *w_mix, *b_mix, *ln1_g, *ln1_b, *router_w, *router_b, *w1, *w3, *w2, *ln2_g, *ln2_b;
    float* out; unsigned char* ws; int ph_lo, ph_hi, use_bar, pad;
};
struct Frame { LAS unsigned char* lds; int tid, lane, wave, G, gw, ngw, bid; };
#define LOAD_ARGS() launder_args(args)
__device__ __forceinline__ Args launder_args(const Args& args) { Args a = args; size_t z_ = 0; asm volatile("" : "+s"(z_)); a.ws = args.ws + z_; return a; }

__device__ __forceinline__ void ln_rows16(f32x4 (&v)[4], const float* g, const float* bta, int lane) {
    float s = 0.f;
#pragma unroll
    for (int j = 0; j < 4; ++j) s += (v[j].x + v[j].y) + (v[j].z + v[j].w);
    const float mean = wave_sum(s) * (1.f / D); float s2 = 0.f;
#pragma unroll
    for (int j = 0; j < 4; ++j) { v[j] = v[j] - mean; s2 += (v[j].x * v[j].x + v[j].y * v[j].y) + (v[j].z * v[j].z + v[j].w * v[j].w); }
    const float rstd = rsqrtf(wave_sum(s2) * (1.f / D) + LN_EPS);
#pragma unroll
    for (int j = 0; j < 4; ++j) { const int c = 4 * lane + 256 * j; const f32x4 gg = *(const f32x4*)(g + c), bb = *(const f32x4*)(bta + c); v[j] = v[j] * rstd * gg + bb; }
}
__device__ __forceinline__ void store_row(const f32x4 (&v)[4], int lane, bf16_t* ores, unsigned char* obf, float* of32b) {
#pragma unroll
    for (int j = 0; j < 4; ++j) { const int c = 4 * lane + 256 * j;
        if (ores) { u32x2 w; w.x = pk2(v[j].x, v[j].y); w.y = pk2(v[j].z, v[j].w); *(u32x2*)(ores + c) = w; }
        if (of32b) *(f32x4*)(of32b + c) = v[j];
        if (obf) *(unsigned*)(obf + c) = pg8::pack4_fp8(v[j].x, v[j].y, v[j].z, v[j].w); }
}

struct CvtDesc { const float* W; int ldw, k0, srccol, nvalid; unsigned char* WT; int dstrow, dstk; };
__device__ __forceinline__ void cvt_load(const CvtDesc& d, f32x4 (&v)[8], int lane) {
    const int ks = lane >> 3, n4 = (lane & 7) * 4;
#pragma unroll
    for (int j = 0; j < 8; ++j) v[j] = (n4 < d.nvalid) ? *(const f32x4*)(d.W + (size_t)(d.k0 + 8 * j + ks) * d.ldw + d.srccol + n4) : (f32x4){0.f, 0.f, 0.f, 0.f};
}
__device__ __forceinline__ void cvt_store(const CvtDesc& d, const f32x4 (&v)[8], LAS float* scr, int lane) {
    const int ks = lane >> 3, n4 = (lane & 7) * 4;
#pragma unroll
    for (int j = 0; j < 8; ++j) { LAS float* p = scr + (8 * j + ks) * 33 + n4; p[0] = v[j][0]; p[1] = v[j][1]; p[2] = v[j][2]; p[3] = v[j][3]; }
    asm volatile("s_waitcnt lgkmcnt(0)" ::: "memory");
    const int c = lane & 7;
#pragma unroll
    for (int j = 0; j < 4; ++j) { const int n = (lane >> 3) + 8 * j; const LAS float* s = scr + (8 * c) * 33 + n;
        u32x2 o; o.x = pg8::pack4_fp8(s[0 * 33] * SC_W, s[1 * 33] * SC_W, s[2 * 33] * SC_W, s[3 * 33] * SC_W); o.y = pg8::pack4_fp8(s[4 * 33] * SC_W, s[5 * 33] * SC_W, s[6 * 33] * SC_W, s[7 * 33] * SC_W);
        *(u32x2*)(d.WT + (size_t)(d.dstrow + n) * 1024 + d.dstk + d.k0 + 8 * c) = o; }
    asm volatile("s_waitcnt lgkmcnt(0)" ::: "memory");
}
__device__ __forceinline__ CvtDesc cvt_decode(const Args& a, int l, int it) {
    unsigned char* WS_ = a.ws + wset(l);
    constexpr int I_IN = 16 * 176, I_BR = 8 * 32, I_MIX = 16 * 32, I_13 = 16 * 64 * NE;
    CvtDesc d; int r = it;
    if (r < I_IN) { const int kb = r / 176, nb = r % 176, n0 = nb * 32;
        const int src = (n0 < 1536) ? n0 : n0 + 8, nv = 32;
        d.W = a.w_in + (size_t)l * D * NIN; d.ldw = NIN; d.k0 = kb * 64; d.srccol = src; d.nvalid = nv; d.WT = WS_ + WO_WIN; d.dstrow = n0; d.dstk = 0; return d; } r -= I_IN;
    if (r < I_BR) { const int kb = r / 32, nb = r % 32; d.W = a.w_fox + (size_t)l * 512 * D; d.ldw = D; d.k0 = kb * 64; d.srccol = nb * 32; d.nvalid = 32; d.WT = WS_ + WO_WBR; d.dstrow = nb * 32; d.dstk = 0; return d; } r -= I_BR;
    if (r < I_BR) { const int kb = r / 32, nb = r % 32; d.W = a.w_hgrn + (size_t)l * 512 * D; d.ldw = D; d.k0 = kb * 64; d.srccol = nb * 32; d.nvalid = 32; d.WT = WS_ + WO_WBR; d.dstrow = nb * 32; d.dstk = 512; return d; } r -= I_BR;
    if (r < I_MIX) { const int kb = r / 32, nb = r % 32; d.W = a.w_mix + (size_t)l * D * D; d.ldw = D; d.k0 = kb * 64; d.srccol = nb * 32; d.nvalid = 32; d.WT = WS_ + WO_WMIX; d.dstrow = nb * 32; d.dstk = 0; return d; } r -= I_MIX;
    if (r < I_13) { const int e = r / 1024, q = r % 1024, kb = q / 64, nb = q % 64, n0 = nb * 32;
        const int j = n0 >> 8, rr = n0 & 255; d.W = (rr < 128 ? a.w1 : a.w3) + ((size_t)l * NE + e) * D * D; d.ldw = D; d.k0 = kb * 64; d.srccol = 128 * j + (rr & 127); d.nvalid = 32;
        d.WT = WS_ + WO_W13 + (size_t)e * 2048 * D; d.dstrow = n0; d.dstk = 0; return d; } r -= I_13;
    { const int e = r / 512, q = r % 512, kb = q / 32, nb = q % 32; d.W = a.w2 + ((size_t)l * NE + e) * D * D; d.ldw = D; d.k0 = kb * 64; d.srccol = nb * 32; d.nvalid = 32;
      d.WT = WS_ + WO_W2 + (size_t)e * D * D; d.dstrow = nb * 32; d.dstk = 0; return d; }
}
__device__ __forceinline__ void convert_layer(const Args& a, const Frame& F, int l, int gw, int ngw) {
    LAS float* scr = (LAS float*)(F.lds + RING_OFF + F.wave * 16384);
    const int lane = F.lane;
    constexpr int NITEMS = 16 * 176 + 2 * 8 * 32 + 16 * 32 + 16 * 64 * NE + 16 * 32 * NE;
    for (int it = gw; it < NITEMS; it += 2 * ngw) {
        const CvtDesc d0 = cvt_decode(a, l, it); f32x4 v0[8]; cvt_load(d0, v0, lane);
        const bool two = it + ngw < NITEMS;
        if (two) { const CvtDesc d1 = cvt_decode(a, l, it + ngw); f32x4 v1[8]; cvt_load(d1, v1, lane); cvt_store(d0, v0, scr, lane); cvt_store(d1, v1, scr, lane); }
        else cvt_store(d0, v0, scr, lane);
    }
    float* biasp = (float*)(a.ws + biasoff(l));
    for (int n = gw * 64 + lane; n < NINP; n += ngw * 64) {
        biasp[n] = (n < 1536) ? a.b_in[l * NIN + n] : a.b_in[l * NIN + n + 8]; }
}


constexpr int WFF_OFF = 65536 + 16384;
__device__ __forceinline__ void load_wff(const Args& a, const Frame& F, int l) {
    LAS float* wff = (LAS float*)(F.lds + RING_OFF + WFF_OFF);
    for (int i = F.tid; i < 8 * D; i += NWAVES * 64) { const int c = i >> 3, h = i & 7; wff[h * D + c] = a.w_in[((size_t)l * D + c) * NIN + 1536 + h]; }
}
__device__ __forceinline__ void fox_gates_row(const Args& a, const Frame& F, int l, const f32x4 (&v)[4], int row) {
    const LAS float* wff = (const LAS float*)(F.lds + RING_OFF + WFF_OFF); const int lane = F.lane;
    float p[8];
#pragma unroll
    for (int h = 0; h < 8; ++h) { float s = 0.f;
#pragma unroll
        for (int j = 0; j < 4; ++j) { const f32x4 r4 = *(const LAS f32x4*)(wff + h * D + 4 * lane + 256 * j); s += v[j].x * r4.x + v[j].y * r4.y + v[j].z * r4.z + v[j].w * r4.w; }
        p[h] = s; }
    const bool hi5 = (lane & 32) != 0;
#pragma unroll
    for (int k = 0; k < 4; ++k) { const float snd = hi5 ? p[k] : p[k + 4]; const float rcv = __shfl_xor(snd, 32); p[k] = (hi5 ? p[k + 4] : p[k]) + rcv; }
    const bool hi4 = (lane & 16) != 0;
#pragma unroll
    for (int k = 0; k < 2; ++k) { const float snd = hi4 ? p[k] : p[k + 2]; const float rcv = __shfl_xor(snd, 16); p[k] = (hi4 ? p[k + 2] : p[k]) + rcv; }
    const bool hi3 = (lane & 8) != 0;
    { const float snd = hi3 ? p[0] : p[1]; const float rcv = __shfl_xor(snd, 8); p[0] = (hi3 ? p[1] : p[0]) + rcv; }
    p[0] += __shfl_xor(p[0], 4); p[0] += __shfl_xor(p[0], 2); p[0] += __shfl_xor(p[0], 1);
    if ((lane & 7) == 0) { const int h = lane >> 3; ((float*)(a.ws + WS_FL))[(size_t)row * 8 + h] = logsigmoidf_(p[0] + a.b_in[l * NIN + 1536 + h]); }
}

__device__ __forceinline__ void phase_prep(const Args& a, const Frame& F) {
    if (F.bid == 0) {
        float* lb_all = (float*)(a.ws + WS_MISC);
        const int c = F.tid;
        float v[DEPTH], m = -1e30f;
#pragma unroll
        for (int l = 0; l < DEPTH; ++l) { v[l] = a.lbl[l * 512 + c]; m = fmaxf(m, v[l]); }
        float s = 0.f;
#pragma unroll
        for (int l = 0; l < DEPTH; ++l) { v[l] = __expf(v[l] - m); s += v[l]; }
        float cum = 0.f;
#pragma unroll
        for (int l = 0; l < DEPTH; ++l) { const float p = v[l] / s; cum += p; lb_all[l * 512 + c] = cum - v[0] / s; }
    }
    bf16_t* XRES = (bf16_t*)(a.ws + WS_XRES); unsigned char* XN = a.ws + WS_XN;
    load_wff(a, F, 0); __syncthreads();
    for (int row = F.gw; row < T; row += F.ngw) {
        f32x4 v[4];
#pragma unroll
        for (int j = 0; j < 4; ++j) v[j] = *(const f32x4*)(a.x + (size_t)row * D + 4 * F.lane + 256 * j);
        ln_rows16(v, a.ln_in_g, a.ln_in_b, F.lane);
        store_row(v, F.lane, XRES + (size_t)row * D, XN + (size_t)row * D, nullptr);
        fox_gates_row(a, F, 0, v, row);
    }
    __syncthreads();
    convert_layer(a, F, 0, F.gw, F.ngw);
}

__device__ __forceinline__ void phase_fscan(const Args& a, const Frame& F) {
    if (F.bid >= BATCH * NH) return;
    const float* FL = (const float*)(a.ws + WS_FL); float* F2 = (float*)(a.ws + WS_F2);
    LAS float* wsum = (LAS float*)(F.lds + RING_OFF);
    const int bh = F.bid, b = bh >> 3, h = bh & 7, tid = F.tid, lane = F.lane, w = F.wave;
    float v[4], run = 0.f;
#pragma unroll
    for (int i = 0; i < 4; ++i) { run += FL[((size_t)b * SEQ + tid * 4 + i) * 8 + h]; v[i] = run; }
    float incl = run;
#pragma unroll
    for (int o = 1; o < 64; o <<= 1) { const float u = __shfl_up(incl, o); if (lane >= o) incl += u; }
    if (lane == 63) wsum[w] = incl;
    __syncthreads();
    float base = incl - run; for (int i = 0; i < w; ++i) base += wsum[i];
#pragma unroll
    for (int i = 0; i < 4; ++i) F2[(size_t)bh * SEQ + tid * 4 + i] = (base + v[i]) * LOG2E;
    __syncthreads();
}

__device__ __forceinline__ void phase_attn_naive(const Args& a, const Frame& F) {
    const bf16_t* QO = (const bf16_t*)(a.ws + WS_QO); const bf16_t* KV = (const bf16_t*)(a.ws + WS_KV); const float* F2 = (const float*)(a.ws + WS_F2); bf16_t* O = (bf16_t*)(a.ws + WS_QO);
    LAS float* ps = (LAS float*)(F.lds + RING_OFF) + F.wave * 64;
    const int lane = F.lane;
    for (int gid = F.gw; gid < BATCH * NH * SEQ; gid += F.ngw) {
        const int bh = gid & 127, t = gid >> 7, b = bh >> 3, h = bh & 7;
        float q[64];
        { const bf16_t* qp = QO + ((size_t)b * SEQ + t) * 1024 + h * 64;
#pragma unroll
          for (int c = 0; c < 8; ++c) { const u32x4 u = *(const u32x4*)(qp + c * 8);
            q[c * 8 + 0] = bflo(u.x); q[c * 8 + 1] = bfhi(u.x); q[c * 8 + 2] = bflo(u.y); q[c * 8 + 3] = bfhi(u.y);
            q[c * 8 + 4] = bflo(u.z); q[c * 8 + 5] = bfhi(u.z); q[c * 8 + 6] = bflo(u.w); q[c * 8 + 7] = bfhi(u.w); } }
        float m = -1e30f, l = 0.f, o = 0.f;
        const float* f2 = F2 + (size_t)bh * SEQ;
        for (int s0 = 0; s0 <= t; s0 += 64) {
            const int s = s0 + lane; const bool valid = s <= t;
            float sc = -1e30f;
            if (valid) { const bf16_t* kp = KV + ((size_t)b * SEQ + s) * 1024 + h * 64; float d = 0.f;
#pragma unroll
                for (int c = 0; c < 8; ++c) { const u32x4 u = *(const u32x4*)(kp + c * 8);
                    d += q[c * 8 + 0] * bflo(u.x) + q[c * 8 + 1] * bfhi(u.x) + q[c * 8 + 2] * bflo(u.y) + q[c * 8 + 3] * bfhi(u.y)
                       + q[c * 8 + 4] * bflo(u.z) + q[c * 8 + 5] * bfhi(u.z) + q[c * 8 + 6] * bflo(u.w) + q[c * 8 + 7] * bfhi(u.w); }
                sc = d - f2[s]; }
            const float mn = fmaxf(m, wave_max(sc));
            const float p = valid ? exp2f(sc - mn) : 0.f;
            const float f = exp2f(m - mn);
            l = l * f + wave_sum(p); o *= f; m = mn;
            ps[lane] = p;
            asm volatile("s_waitcnt lgkmcnt(0)" ::: "memory");
            const int nk = min(64, t - s0 + 1);
            const bf16_t* vp = KV + ((size_t)b * SEQ + s0) * 1024 + 512 + h * 64 + lane;
            for (int j = 0; j < nk; ++j) o += ps[j] * bf2f(vp[(size_t)j * 1024]);
            asm volatile("s_waitcnt lgkmcnt(0)" ::: "memory");
        }
        O[((size_t)b * SEQ + t) * 1024 + h * 64 + lane] = (bf16_t)f2bf(o / l);
    }
}

__device__ __forceinline__ void phase_hgrn_naive(const Args& a, const Frame& F, int l) {
    if (F.bid >= BATCH * NH || F.wave != 0) return;
    const bf16_t* HB = (const bf16_t*)(a.ws + WS_HB); const float* LOGF = (const float*)(a.ws + WS_LOGF); const bf16_t* HG = (const bf16_t*)(a.ws + WS_HG); bf16_t* O = (bf16_t*)(a.ws + WS_QO);
    LAS float* Lf = (LAS float*)(F.lds + RING_OFF + 1024); LAS float* Lk = Lf + 4096; LAS float* Lq = Lk + 4096;
    const int bh = F.bid, b = bh >> 3, h = bh & 7, lane = F.lane;
    float Sx[64];
#pragma unroll
    for (int d = 0; d < 64; ++d) Sx[d] = 0.f;
    const float ng = a.norm_g[l * 512 + h * 64 + lane];
    for (int c0 = 0; c0 < SEQ; c0 += 64) {
        for (int tt = 0; tt < 64; ++tt) { const size_t row = (size_t)b * SEQ + c0 + tt;
            const float lf = LOGF[row * 512 + h * 64 + lane]; const float f = __expf(lf);
            Lf[tt * 64 + lane] = f; Lk[tt * 64 + lane] = 1.f - f; Lq[tt * 64 + lane] = bf2f(HB[row * 1024 + h * 64 + lane]); }
        asm volatile("s_waitcnt lgkmcnt(0)" ::: "memory");
        for (int tt = 0; tt < 64; ++tt) { const size_t row = (size_t)b * SEQ + c0 + tt;
            const float v = bf2f(HB[row * 1024 + 512 + h * 64 + lane]);
            float o = 0.f;
#pragma unroll
            for (int d = 0; d < 64; d += 4) { const f32x4 f4 = *(const LAS f32x4*)(Lf + tt * 64 + d), k4 = *(const LAS f32x4*)(Lk + tt * 64 + d), q4 = *(const LAS f32x4*)(Lq + tt * 64 + d);
                Sx[d] = f4.x * Sx[d] + k4.x * v; o += Sx[d] * q4.x; Sx[d + 1] = f4.y * Sx[d + 1] + k4.y * v; o += Sx[d + 1] * q4.y;
                Sx[d + 2] = f4.z * Sx[d + 2] + k4.z * v; o += Sx[d + 2] * q4.z; Sx[d + 3] = f4.w * Sx[d + 3] + k4.w * v; o += Sx[d + 3] * q4.w; }
            const float ss = wave_sum(o * o);
            const float r = o * rsqrtf(ss * (1.f / 64.f) + RMS_EPS) * ng * bf2f(HG[row * 512 + h * 64 + lane]);
            O[row * 1024 + 512 + h * 64 + lane] = (bf16_t)f2bf(r); }
        asm volatile("s_waitcnt lgkmcnt(0)" ::: "memory");
    }
}

constexpr int LN1_RW = 0, LN1_LG = 65536, LN1_ASG = LN1_LG + 8 * 16 * 16 * 4, LN1_BASE = LN1_ASG + 128 * 16;
__device__ __forceinline__ void phase_ln1_router(const Args& a, const Frame& F, int l) {
    const bf16_t* xres = (const bf16_t*)(a.ws + WS_XRES); bf16_t* x1 = (bf16_t*)(a.ws + WS_X1B); const bf16_t* mixed = (const bf16_t*)(a.ws + WS_MIXED); unsigned char* xn = a.ws + WS_XN;
    unsigned* cnt = (unsigned*)(a.ws + WS_CTL) + CW_CNT + l * 64; int* list = (int*)(a.ws + WS_LIST); unsigned* tokinfo = (unsigned*)(a.ws + WS_TOK);
    const float* g = a.ln1_g + l * D; const float* bta = a.ln1_b + l * D;
    LAS float* rw = (LAS float*)(F.lds + RING_OFF + LN1_RW);
    LAS float* lgs = (LAS float*)(F.lds + RING_OFF + LN1_LG) + F.wave * 256;
    LAS u32x4* asg = (LAS u32x4*)(F.lds + RING_OFF + LN1_ASG);
    LAS unsigned* basep = (LAS unsigned*)(F.lds + RING_OFF + LN1_BASE);
    for (int i = F.tid; i < NE * D; i += NWAVES * 64) { const int c = i >> 4, e = i & 15; rw[e * D + c] = a.router_w[i]; }
    __syncthreads();
    const int lane = F.lane;
    for (int blk = F.bid; blk < T / 128; blk += F.G) {
        const int R0 = blk * 128 + F.wave * 16;
        u32x2 nx[4]; u32x2 nm[4];
#pragma unroll
        for (int j = 0; j < 4; ++j) { const int c = 4 * lane + 256 * j; nx[j] = *(const u32x2*)(xres + (size_t)R0 * D + c); nm[j] = *(const u32x2*)(mixed + (size_t)R0 * D + c); }
        for (int i = 0; i < 16; ++i) { const int row = R0 + i;
            f32x4 v[4];
#pragma unroll
            for (int j = 0; j < 4; ++j) { const u32x2 xv = nx[j]; const u32x2 mm = nm[j];
                v[j].x = ALPHA * bflo(xv.x) + bflo(mm.x); v[j].y = ALPHA * bfhi(xv.x) + bfhi(mm.x); v[j].z = ALPHA * bflo(xv.y) + bflo(mm.y); v[j].w = ALPHA * bfhi(xv.y) + bfhi(mm.y); }
            { const int rn = (i < 15) ? row + 1 : row;
#pragma unroll
              for (int j = 0; j < 4; ++j) { const int c = 4 * lane + 256 * j; nx[j] = *(const u32x2*)(xres + (size_t)rn * D + c); nm[j] = *(const u32x2*)(mixed + (size_t)rn * D + c); } }
            ln_rows16(v, g, bta, lane);
            store_row(v, lane, x1 + (size_t)row * D, xn + (size_t)row * D, nullptr);
            float p[NE];
#pragma unroll
            for (int e = 0; e < NE; ++e) { float s = 0.f;
#pragma unroll
                for (int j = 0; j < 4; ++j) { const f32x4 r4 = *(const LAS f32x4*)(rw + e * D + 4 * lane + 256 * j); s += v[j].x * r4.x + v[j].y * r4.y + v[j].z * r4.z + v[j].w * r4.w; }
                p[e] = s; asm volatile("" ::: "memory"); }
            { const bool hi5 = (lane & 32) != 0;
#pragma unroll
              for (int k = 0; k < 8; ++k) { const float snd = hi5 ? p[k] : p[k + 8]; const float rcv = __shfl_xor(snd, 32); p[k] = (hi5 ? p[k + 8] : p[k]) + rcv; }
              const bool hi4 = (lane & 16) != 0;
#pragma unroll
              for (int k = 0; k < 4; ++k) { const float snd = hi4 ? p[k] : p[k + 4]; const float rcv = __shfl_xor(snd, 16); p[k] = (hi4 ? p[k + 4] : p[k]) + rcv; }
              const bool hi3 = (lane & 8) != 0;
#pragma unroll
              for (int k = 0; k < 2; ++k) { const float snd = hi3 ? p[k] : p[k + 2]; const float rcv = __shfl_xor(snd, 8); p[k] = (hi3 ? p[k + 2] : p[k]) + rcv; }
              const bool hi2 = (lane & 4) != 0;
              { const float snd = hi2 ? p[0] : p[1]; const float rcv = __shfl_xor(snd, 4); p[0] = (hi2 ? p[1] : p[0]) + rcv; }
              p[0] += __shfl_xor(p[0], 2); p[0] += __shfl_xor(p[0], 1);
              if ((lane & 3) == 0) lgs[i * 16 + (lane >> 2)] = p[0]; }
        }
        asm volatile("s_waitcnt lgkmcnt(0)" ::: "memory");
        if (lane < 16) {
            float lg[NE];
#pragma unroll
            for (int q = 0; q < 4; ++q) { const f32x4 t4 = *(const LAS f32x4*)(lgs + lane * 16 + 4 * q); lg[4 * q] = t4[0] + a.router_b[4 * q]; lg[4 * q + 1] = t4[1] + a.router_b[4 * q + 1]; lg[4 * q + 2] = t4[2] + a.router_b[4 * q + 2]; lg[4 * q + 3] = t4[3] + a.router_b[4 * q + 3]; }
            int gs = 0; float gbest = -3e38f;
#pragma unroll
            for (int gi = 0; gi < 4; ++gi) { const float mx = fmaxf(fmaxf(lg[gi * 4], lg[gi * 4 + 1]), fmaxf(lg[gi * 4 + 2], lg[gi * 4 + 3])); if (mx > gbest) { gbest = mx; gs = gi; } }
            float l4[4];
#pragma unroll
            for (int i = 0; i < 4; ++i) { float t0 = lg[i];
#pragma unroll
                for (int gi = 1; gi < 4; ++gi) t0 = (gs == gi) ? lg[gi * 4 + i] : t0; l4[i] = t0; }
            int i0 = 0; float b0 = l4[0];
#pragma unroll
            for (int i = 1; i < 4; ++i) if (l4[i] > b0) { b0 = l4[i]; i0 = i; }
            int i1 = 0; float b1 = -3e38f;
#pragma unroll
            for (int i = 0; i < 4; ++i) if (i != i0 && l4[i] > b1) { b1 = l4[i]; i1 = i; }
            const float e1 = __expf(b1 - b0); const float g0 = 1.f / (1.f + e1), g1 = e1 / (1.f + e1);
            u32x4 as; as.x = (unsigned)(gs * 4 + i0); as.y = (unsigned)(gs * 4 + i1); as.z = __float_as_uint(g0); as.w = __float_as_uint(g1);
            asg[F.wave * 16 + lane] = as;
        }
        __syncthreads();
        if (F.wave == 0) {
            const u32x4 A0 = asg[lane], A1 = asg[lane + 64];
            const unsigned ex[4] = {A0.x, A0.y, A1.x, A1.y};
            unsigned rank[4] = {0u, 0u, 0u, 0u}, mycount = 0u;
            const unsigned long long lt = (1ull << lane) - 1ull;
#pragma unroll 1
            for (unsigned e = 0; e < NE; ++e) { unsigned run = 0u;
#pragma unroll
                for (int s = 0; s < 4; ++s) { const unsigned long long m = __ballot(ex[s] == e); if (ex[s] == e) rank[s] = run + (unsigned)__popcll(m & lt); run += (unsigned)__popcll(m); }
                if ((unsigned)lane == e) mycount = run; }
            if (lane < NE) basep[lane] = atomicAdd(cnt + lane, mycount);
            asm volatile("s_waitcnt vmcnt(0) lgkmcnt(0)" ::: "memory");
            const unsigned p0 = basep[ex[0]] + rank[0], p1 = basep[ex[1]] + rank[1], p2 = basep[ex[2]] + rank[2], p3 = basep[ex[3]] + rank[3];
            const int ra = blk * 128 + lane, rb = ra + 64;
            list[ex[0] * T + p0] = ra; list[ex[1] * T + p1] = ra; list[ex[2] * T + p2] = rb; list[ex[3] * T + p3] = rb;
            u32x4 ta, tb; ta.x = (ex[0] << 24) | p0; ta.y = (ex[1] << 24) | p1; ta.z = A0.z; ta.w = A0.w; tb.x = (ex[2] << 24) | p2; tb.y = (ex[3] << 24) | p3; tb.z = A1.z; tb.w = A1.w;
            *(u32x4*)(tokinfo + (size_t)ra * 4) = ta; *(u32x4*)(tokinfo + (size_t)rb * 4) = tb;
        }
        __syncthreads();
    }
}

__device__ __forceinline__ void moe_table(const Args& a, const Frame& F, int l) {
    LAS int* tab = (LAS int*)(F.lds + TAB_OFF);
    const unsigned* cnt = (const unsigned*)(a.ws + WS_CTL) + CW_CNT + l * 64;
    if (F.tid == 0) { int ts = 0; for (int e = 0; e < NE; ++e) { const int c = (int)__hip_atomic_load(cnt + e, RLX_AGENT); tab[e] = ts; tab[NE + 1 + e] = c; ts += (c + TM - 1) / TM; } tab[NE] = ts; }
    __syncthreads();
}

__device__ __forceinline__ void phase_combine_ln2(const Args& a, const Frame& F, int l) {
    bf16_t* xres = (bf16_t*)(a.ws + WS_XRES); const bf16_t* x1 = (const bf16_t*)(a.ws + WS_X1B); const bf16_t* Y = (const bf16_t*)(a.ws + WS_Y); const unsigned* tokinfo = (const unsigned*)(a.ws + WS_TOK); unsigned char* xn = a.ws + WS_XN;
    const float* g = a.ln2_g + l * D; const float* bta = a.ln2_b + l * D; float* out = (l == DEPTH - 1) ? a.out : nullptr;
    const LAS int* tab = (const LAS int*)(F.lds + TAB_OFF);
    const int lane = F.lane;
    for (int row = F.gw; row < T; row += F.ngw) {
        const unsigned i0 = tokinfo[row * 4], i1 = tokinfo[row * 4 + 1]; const float g0 = __uint_as_float(tokinfo[row * 4 + 2]), g1 = __uint_as_float(tokinfo[row * 4 + 3]);
        const size_t s0 = (size_t)tab[i0 >> 24] * TM + (i0 & 0xffffff), s1 = (size_t)tab[i1 >> 24] * TM + (i1 & 0xffffff);
        f32x4 v[4];
#pragma unroll
        for (int j = 0; j < 4; ++j) { const int c = 4 * lane + 256 * j; const u32x2 xw = *(const u32x2*)(x1 + (size_t)row * D + c); const f32x4 xv = {bflo(xw.x), bfhi(xw.x), bflo(xw.y), bfhi(xw.y)};
            const u32x2 ya = *(const u32x2*)(Y + s0 * D + c), yb = *(const u32x2*)(Y + s1 * D + c);
            v[j].x = ALPHA * xv.x + g0 * bflo(ya.x) + g1 * bflo(yb.x); v[j].y = ALPHA * xv.y + g0 * bfhi(ya.x) + g1 * bfhi(yb.x);
            v[j].z = ALPHA * xv.z + g0 * bflo(ya.y) + g1 * bflo(yb.y); v[j].w = ALPHA * xv.w + g0 * bfhi(ya.y) + g1 * bfhi(yb.y); }
        ln_rows16(v, g, bta, lane);
        store_row(v, lane, xres + (size_t)row * D, xn + (size_t)row * D, out ? out + (size_t)row * D : nullptr);
        if (l + 1 < DEPTH) fox_gates_row(a, F, l + 1, v, row);
    }
}


constexpr int ATT_F2_OFF = 86016;
__device__ __forceinline__ void phase_attn(const Args& a, const Frame& F, char* lds_generic) {
    const int c = F.bid, vcu = (F.G % 8 == 0) ? (c % 8) * (F.G / 8) + c / 8 : c;
    const attn_body::bf16* Q = (const attn_body::bf16*)(a.ws + WS_QO); const attn_body::bf16* K = (const attn_body::bf16*)(a.ws + WS_KV); const attn_body::bf16* V = K + 512;
    attn_body::bf16* O = (attn_body::bf16*)(a.ws + WS_OX8);
    const float* FL = (const float*)(a.ws + WS_FL);
    LAS float* f2 = (LAS float*)(F.lds + ATT_F2_OFF); LAS float* wsum = f2 + 2048;
    { const int bh = vcu >> 1; if (bh >= BATCH * NH) return;
        const int b = bh >> 3, h = bh & 7, tid = F.tid, lane = F.lane, w = F.wave;
        float v[4], run = 0.f;
#pragma unroll
        for (int i = 0; i < 4; ++i) { run += FL[((size_t)b * SEQ + tid * 4 + i) * 8 + h]; v[i] = run; }
        float incl = run;
#pragma unroll
        for (int o = 1; o < 64; o <<= 1) { const float u = __shfl_up(incl, o); if (lane >= o) incl += u; }
        if (lane == 63) wsum[w] = incl;
        __syncthreads();
        float base = incl - run; for (int i = 0; i < w; ++i) base += wsum[i];
        f32x4 o4; o4[0] = (base + v[0]) * LOG2E; o4[1] = (base + v[1]) * LOG2E; o4[2] = (base + v[2]) * LOG2E; o4[3] = (base + v[3]) * LOG2E;
        *(LAS f32x4*)(f2 + tid * 4) = o4;
        __syncthreads();
        const int nun = (vcu & 1) ? 6 : 2;
        for (int i = 0; i < nun; ++i) { const int qb = (vcu & 1) ? ((i < 4) ? 6 - i : 5 - i) : ((i == 0) ? 7 : 2);
            int tid_u = F.tid; asm volatile("" : "+v"(tid_u));
            attn_body::attn_unit<40>(b, h, qb, Q, K, V, O, lds_generic + RING_OFF, f2, tid_u); }
        __syncthreads();
    }
}

namespace hg {
constexpr int PB = 144;
constexpr int O_QS = 0, O_KS = 9216, O_QI = 18432, O_KUT = 27648, O_VT = 36864, O_P = 46080, O_ST = 55296, O_TOT = 64512, O_EBL = 66560, O_RED = 66816, BYTES = 67328;
__device__ __forceinline__ float ex(float v) { return __builtin_amdgcn_exp2f(v * LOG2E); }
__device__ __forceinline__ unsigned short bf1(float v) { return (unsigned short)f2bf(v); }
}
__device__ __forceinline__ void phase_hgrn(const Args& a, const Frame& F, int l, int bh) {
    using namespace hg;
    const bf16_t* HB = (const bf16_t*)(a.ws + WS_HB); const float* LOGF = (const float*)(a.ws + WS_LOGF); const bf16_t* HG = (const bf16_t*)(a.ws + WS_HG); unsigned char* O8 = a.ws + WS_OX8;
    LAS unsigned char* L = F.lds + RING_OFF;
    const int b = bh >> 3, h = bh & 7, lane = F.lane, w = F.wave, tid = F.tid;
    const int fr = lane & 15, fq = lane >> 4;
    const int tr = w >> 1, tc0 = 2 * (w & 1);
    const float ng0 = a.norm_g[l * 512 + h * 64 + 16 * tc0 + fr], ng1 = a.norm_g[l * 512 + h * 64 + 16 * (tc0 + 1) + fr];
    f32x4 S0 = {0.f, 0.f, 0.f, 0.f}, S1 = {0.f, 0.f, 0.f, 0.f};
    for (int i = tid; i < 9216 / 4; i += NWAVES * 64) ((LAS unsigned*)(L + O_ST))[i] = 0u;
    const size_t rowbase = (size_t)b * SEQ;
    float g[8]; unsigned short qv[8], vv[8];
#pragma unroll
    for (int i = 0; i < 8; ++i) { const size_t row = rowbase + 8 * w + i; g[i] = LOGF[row * 512 + h * 64 + lane]; qv[i] = HB[row * 1024 + h * 64 + lane]; vv[i] = HB[row * 1024 + 512 + h * 64 + lane]; }
    for (int c0 = 0; c0 < SEQ; c0 += 64) {
        float bc[8]; { float run = 0.f;
#pragma unroll
            for (int i = 0; i < 8; ++i) { run += g[i]; bc[i] = run; } }
        ((LAS float*)(L + O_TOT))[w * 64 + lane] = bc[7];
        float qf[8], kf[8];
#pragma unroll
        for (int i = 0; i < 8; ++i) { qf[i] = bf2f(qv[i]); kf[i] = 1.f - ex(g[i]); }
        { u32x4 pk; pk.x = (unsigned)vv[0] | ((unsigned)vv[1] << 16); pk.y = (unsigned)vv[2] | ((unsigned)vv[3] << 16); pk.z = (unsigned)vv[4] | ((unsigned)vv[5] << 16); pk.w = (unsigned)vv[6] | ((unsigned)vv[7] << 16);
          *(LAS u32x4*)(L + O_VT + lane * PB + 16 * w) = pk; }
        __syncthreads();
        float base = 0.f, bm = 0.f, bl = 0.f;
#pragma unroll
        for (int ww = 0; ww < 8; ++ww) { const float tv = ((LAS float*)(L + O_TOT))[ww * 64 + lane]; if (ww < w) base += tv; if (ww < 4) bm += tv; bl += tv; }
        const float ebm = ex(bm), eblm = ex(bl - bm);
        if (w == 0) ((LAS float*)(L + O_EBL))[lane] = ex(bl);
        unsigned short ku[8];
#pragma unroll
        for (int i = 0; i < 8; ++i) { const float x = bc[i] + base - bm; const float e1 = ex(fminf(x, 80.f)), e2 = ex(fminf(-x, 80.f));
            const float qs = qf[i] * e1, ks = kf[i] * e2; const int r = 8 * w + i;
            *(LAS unsigned short*)(L + O_QS + r * PB + 2 * lane) = bf1(qs); *(LAS unsigned short*)(L + O_QI + r * PB + 2 * lane) = bf1(qs * ebm);
            *(LAS unsigned short*)(L + O_KS + r * PB + 2 * lane) = bf1(ks); ku[i] = bf1(ks * eblm); }
        { u32x4 pk; pk.x = (unsigned)ku[0] | ((unsigned)ku[1] << 16); pk.y = (unsigned)ku[2] | ((unsigned)ku[3] << 16); pk.z = (unsigned)ku[4] | ((unsigned)ku[5] << 16); pk.w = (unsigned)ku[6] | ((unsigned)ku[7] << 16);
          *(LAS u32x4*)(L + O_KUT + lane * PB + 16 * w) = pk; }
        if (c0 + 64 < SEQ) {
#pragma unroll
            for (int i = 0; i < 8; ++i) { const size_t row = rowbase + c0 + 64 + 8 * w + i; g[i] = LOGF[row * 512 + h * 64 + lane]; qv[i] = HB[row * 1024 + h * 64 + lane]; vv[i] = HB[row * 1024 + 512 + h * 64 + lane]; }
        }
        __syncthreads();
#pragma unroll
        for (int k2 = 0; k2 < 2; ++k2) { const int idx = 2 * w + k2, ti = idx >> 2, sj = idx & 3;
            f32x4 sc = {0.f, 0.f, 0.f, 0.f};
            if (sj <= ti) {
#pragma unroll
                for (int kk = 0; kk < 2; ++kk) { const bf16x8 af = *(const LAS bf16x8*)(L + O_QS + (16 * ti + fr) * PB + (32 * kk + 8 * fq) * 2), bfr = *(const LAS bf16x8*)(L + O_KS + (16 * sj + fr) * PB + (32 * kk + 8 * fq) * 2);
                    sc = __builtin_amdgcn_mfma_f32_16x16x32_bf16(af, bfr, sc, 0, 0, 0); }
            }
#pragma unroll
            for (int j = 0; j < 4; ++j) { const int t = 16 * ti + 4 * fq + j, s = 16 * sj + fr; *(LAS unsigned short*)(L + O_P + t * PB + 2 * s) = bf1(s <= t ? sc[j] : 0.f); }
        }
        __syncthreads();
        f32x4 o0 = {0.f, 0.f, 0.f, 0.f}, o1 = {0.f, 0.f, 0.f, 0.f}, u0 = {0.f, 0.f, 0.f, 0.f}, u1 = {0.f, 0.f, 0.f, 0.f};
#pragma unroll
        for (int kk = 0; kk < 2; ++kk) { const int ko = (32 * kk + 8 * fq) * 2;
            const bf16x8 pa = *(const LAS bf16x8*)(L + O_P + (16 * tr + fr) * PB + ko), qa = *(const LAS bf16x8*)(L + O_QI + (16 * tr + fr) * PB + ko), ka = *(const LAS bf16x8*)(L + O_KUT + (16 * tr + fr) * PB + ko);
            const bf16x8 v0 = *(const LAS bf16x8*)(L + O_VT + (16 * tc0 + fr) * PB + ko), v1 = *(const LAS bf16x8*)(L + O_VT + (16 * (tc0 + 1) + fr) * PB + ko);
            const bf16x8 s0 = *(const LAS bf16x8*)(L + O_ST + (16 * tc0 + fr) * PB + ko), s1 = *(const LAS bf16x8*)(L + O_ST + (16 * (tc0 + 1) + fr) * PB + ko);
            o0 = __builtin_amdgcn_mfma_f32_16x16x32_bf16(pa, v0, o0, 0, 0, 0); o1 = __builtin_amdgcn_mfma_f32_16x16x32_bf16(pa, v1, o1, 0, 0, 0);
            o0 = __builtin_amdgcn_mfma_f32_16x16x32_bf16(qa, s0, o0, 0, 0, 0); o1 = __builtin_amdgcn_mfma_f32_16x16x32_bf16(qa, s1, o1, 0, 0, 0);
            u0 = __builtin_amdgcn_mfma_f32_16x16x32_bf16(ka, v0, u0, 0, 0, 0); u1 = __builtin_amdgcn_mfma_f32_16x16x32_bf16(ka, v1, u1, 0, 0, 0); }
        { const f32x4 dec = *(const LAS f32x4*)(L + O_EBL + (16 * tr + 4 * fq) * 4); S0 = S0 * dec + u0; S1 = S1 * dec + u1; }
        { f32x4 q2 = o0 * o0 + o1 * o1;
#pragma unroll
          for (int m = 1; m < 16; m <<= 1) { q2[0] += __shfl_xor(q2[0], m); q2[1] += __shfl_xor(q2[1], m); q2[2] += __shfl_xor(q2[2], m); q2[3] += __shfl_xor(q2[3], m); }
          if (fr == 0) {
#pragma unroll
              for (int j = 0; j < 4; ++j) ((LAS float*)(L + O_RED))[(16 * tr + 4 * fq + j) * 2 + (w & 1)] = q2[j]; } }
        __syncthreads();
        { u32x2 p0, p1; p0.x = pk2(S0[0], S0[1]); p0.y = pk2(S0[2], S0[3]); p1.x = pk2(S1[0], S1[1]); p1.y = pk2(S1[2], S1[3]);
          *(LAS u32x2*)(L + O_ST + (16 * tc0 + fr) * PB + (16 * tr + 4 * fq) * 2) = p0; *(LAS u32x2*)(L + O_ST + (16 * (tc0 + 1) + fr) * PB + (16 * tr + 4 * fq) * 2) = p1; }
#pragma unroll
        for (int j = 0; j < 4; ++j) { const int t = 16 * tr + 4 * fq + j; const f32x2 rr = *(const LAS f32x2*)(L + O_RED + t * 8); const float rs = rsqrtf((rr[0] + rr[1]) * (1.f / 64.f) + RMS_EPS);
            *(LAS unsigned short*)(L + O_P + t * PB + 2 * (16 * tc0 + fr)) = bf1(o0[j] * rs * ng0); *(LAS unsigned short*)(L + O_P + t * PB + 2 * (16 * (tc0 + 1) + fr)) = bf1(o1[j] * rs * ng1); }
        __syncthreads();
        { const int t = tid >> 3, e8 = (tid & 7) * 8; const size_t row = rowbase + c0 + t;
          const u32x4 ov = *(const LAS u32x4*)(L + O_P + t * PB + e8 * 2), gv = *(const u32x4*)(HG + row * 512 + h * 64 + e8);
          u32x2 r; r.x = pg8::pack4_fp8(bflo(ov.x) * bflo(gv.x) * SC_HGRN, bfhi(ov.x) * bfhi(gv.x) * SC_HGRN, bflo(ov.y) * bflo(gv.y) * SC_HGRN, bfhi(ov.y) * bfhi(gv.y) * SC_HGRN);
          r.y = pg8::pack4_fp8(bflo(ov.z) * bflo(gv.z) * SC_HGRN, bfhi(ov.z) * bfhi(gv.z) * SC_HGRN, bflo(ov.w) * bflo(gv.w) * SC_HGRN, bfhi(ov.w) * bfhi(gv.w) * SC_HGRN);
          *(u32x2*)(O8 + row * 1024 + 512 + h * 64 + e8) = r; }
        __syncthreads();
    }
}


constexpr int PH_PER_LAYER = 10, N_PHASES = 1 + DEPTH * PH_PER_LAYER;
#ifndef MK_ONE_LAUNCH
#define MK_ONE_LAUNCH 1
#endif
#ifndef MK_FAST_ATTN
#define MK_FAST_ATTN 0
#endif
#ifndef MK_FAST_HGRN
#define MK_FAST_HGRN 0
#endif


#ifdef DBG_DUMP
#ifndef DBG_WHAT
#define DBG_WHAT 0
#endif
__device__ __forceinline__ void dbg_dump(const Args& a, const Frame& F) {
    unsigned char* ws = a.ws;
    const bf16_t *QO = (bf16_t*)(ws + WS_QO), *KV = (bf16_t*)(ws + WS_KV), *HB = (bf16_t*)(ws + WS_HB), *HG = (bf16_t*)(ws + WS_HG), *G = (bf16_t*)(ws + WS_G);
    const bf16_t *U1 = (bf16_t*)(ws + WS_U1), *U = (bf16_t*)(ws + WS_U), *MIXED = (bf16_t*)(ws + WS_MIXED), *XN = (bf16_t*)(ws + WS_XN);
    const float *LOGF = (float*)(ws + WS_LOGF), *FL = (float*)(ws + WS_FL), *XRES = (float*)(ws + WS_XRES);
    for (size_t i = (size_t)F.bid * 512 + F.tid; i < (size_t)T * D; i += (size_t)gridDim.x * 512) {
        const size_t row = i >> 10; const int c = (int)(i & 1023);
        float v = 0.f;
        if (DBG_WHAT == 9) { v = bf2f(G[row * 2048 + c]) + bf2f(G[row * 2048 + 1024 + c]); }
        else if (DBG_DUMP == 1) { v = bf2f(KV[i]) + bf2f(HB[i]) + bf2f(G[row * 2048 + c]) + bf2f(G[row * 2048 + 1024 + c]);
            if (c < 512) v += LOGF[row * 512 + c] + bf2f(HG[row * 512 + c]) + bf2f(QO[i]); if (c < 8) v += FL[row * 8 + c]; }
        else if (DBG_DUMP == 2) { v = (c >= 512) ? bf2f(QO[i]) : 0.f; }
        else if (DBG_DUMP == 3) { v = bf2f(QO[i]); }
        else if (DBG_DUMP == 4) { v = bf2f(U1[i]); }
        else if (DBG_DUMP == 5) { v = bf2f(U[i]); }
        else if (DBG_DUMP == 6) { v = bf2f(MIXED[i]); }
        else if (DBG_DUMP == 7) { v = XRES[i] + bf2f(XN[i]); }
        a.out[i] = v;
    }
}
#endif
#define PH_BEGIN const Args a = LOAD_ARGS(); Frame F; F.lds = lds0; F.lane = (int)__builtin_amdgcn_mbcnt_hi(~0u, __builtin_amdgcn_mbcnt_lo(~0u, 0u)); asm volatile("" : "+v"(F.lane)); F.wave = __builtin_amdgcn_readfirstlane((int)((const volatile LAS unsigned*)(lds0 + WTAB_OFF))[hw_wave_key()]); F.tid = F.wave * 64 + F.lane; \
    F.G = gridDim.x; F.bid = blockIdx.x; asm volatile("" : "+s"(F.bid)); F.gw = F.bid * NWAVES + F.wave; F.ngw = F.G * NWAVES; unsigned char* const ws = a.ws; const LAS int* tab = (const LAS int*)(F.lds + TAB_OFF); (void)tab; (void)ws;
#ifdef DBG_DUMP
#define IN(k) (lo <= (k) && (k) < hi && (k) <= DBG_DUMP)
#else
#define IN(k) (lo <= (k) && (k) < hi)
#endif
#ifdef DBG_REPEAT
#define REP(k) for (int rep_ = 0; rep_ < ((DBG_REPEAT == (k) && !((k) == 9 && l == DEPTH - 1)) ? 2 : 1); ++rep_)
#else
#define REP(k)
#endif
#define SEAM(k) do { if (IN(k) && IN((k) + 1)) { XcdBarrier b2_ = bar; { size_t z_ = 0; asm volatile("" : "+s"(z_), "+s"(b2_.x)); b2_.bar = bar.bar + z_; } xcd_barrier(b2_); } } while (0)
template <int l>
__device__ __forceinline__ void layer_body(const Args& args, const int lo, const int hi, const XcdBarrier& bar, LAS unsigned char* const lds0, unsigned char* lds_raw) {
        const int pb = 1 + l * PH_PER_LAYER;

#ifdef DBG_DUMP
        if (l == 0 && lo <= DBG_DUMP + 1 && DBG_DUMP + 1 < hi) { PH_BEGIN dbg_dump(a, F); }
#endif
        if (IN(pb + 0)) REP(0) { PH_BEGIN
            pg8::Gemm g{(bf16_t*)(ws + WS_XN), (bf16_t*)(ws + wset(l) + WO_WIN), D / 2, D / 2, D / 2, E8_1, E8_W}; pg8::StaticOrder S; S.init(T, NINP, F.G, F.bid);
            pg8::EpiInproj E{ws, l};
            pg8::gemm_phase<pg8::EpiInproj, pg8::StaticOrder, true>(F.lds + RING_OFF, g, S, E, F.tid);
        }
        SEAM(pb + 0);
        if (IN(pb + 1)) REP(1) { PH_BEGIN
            const int vcu = (F.G % 8 == 0) ? (F.bid % 8) * (F.G / 8) + F.bid / 8 : F.bid;
            if ((vcu & 1) == 0 && (vcu >> 1) < BATCH * NH) { phase_hgrn(a, F, l, vcu >> 1); __syncthreads(); }
            phase_attn(a, F, (char*)lds_raw);
            if (l + 1 < DEPTH) { __syncthreads(); convert_layer(a, F, l + 1, F.gw, F.ngw); }
        }
        SEAM(pb + 1);
        if (IN(pb + 3)) REP(3) { PH_BEGIN
            pg8::Gemm g{(bf16_t*)(ws + WS_OX8), (bf16_t*)(ws + wset(l) + WO_WBR), D / 2, D / 2, 256, E8_FOX, E8_W}; pg8::StaticOrder S; S.init(T, D, F.G, F.bid);
            pg8::EpiGate<1> E{(bf16_t*)(ws + WS_U1), nullptr, (bf16_t*)(ws + WS_G), 2048, nullptr};
            pg8::gemm_phase<pg8::EpiGate<1>, pg8::StaticOrder, true>(F.lds + RING_OFF, g, S, E, F.tid);
        }
        if (IN(pb + 3) && IN(pb + 4)) __syncthreads(); else SEAM(pb + 3);
        if (IN(pb + 4)) REP(4) { PH_BEGIN
            pg8::Gemm g{(bf16_t*)(ws + WS_OX8) + 256, (bf16_t*)(ws + wset(l) + WO_WBR) + 256, D / 2, D / 2, 256, E8_HGRN, E8_W}; pg8::StaticOrder S; S.init(T, D, F.G, F.bid);
            pg8::EpiGate<2> E{(bf16_t*)(ws + WS_U), nullptr, (bf16_t*)(ws + WS_G) + 1024, 2048, (bf16_t*)(ws + WS_U1)};
            pg8::gemm_phase<pg8::EpiGate<2>, pg8::StaticOrder, true>(F.lds + RING_OFF, g, S, E, F.tid);
        }
        SEAM(pb + 4);
        if (IN(pb + 5)) REP(5) { PH_BEGIN
            pg8::Gemm g{(bf16_t*)(ws + WS_U), (bf16_t*)(ws + wset(l) + WO_WMIX), D / 2, D / 2, D / 2, E8_U, E8_W}; pg8::StaticOrder S; S.init(T, D, F.G, F.bid);
            pg8::EpiGate<0> E{(bf16_t*)(ws + WS_MIXED), a.b_mix + l * D, nullptr, 0, nullptr};
            pg8::gemm_phase<pg8::EpiGate<0>, pg8::StaticOrder, true>(F.lds + RING_OFF, g, S, E, F.tid);
        }
        SEAM(pb + 5);
        if (IN(pb + 6)) REP(6) { PH_BEGIN phase_ln1_router(a, F, l); }
        SEAM(pb + 6);
        if (IN(pb + 7)) REP(7) { PH_BEGIN
            moe_table(a, F, l);
            pg8::Gemm g{(bf16_t*)(ws + WS_XN), (bf16_t*)(ws + wset(l) + WO_W13), D / 2, D / 2, D / 2, E8_1, E8_W}; pg8::MoeOrder<true> S{F.G, F.bid, 8, tab, (const int*)(ws + WS_LIST), (size_t)2048 * (D / 2)};
            pg8::EpiUp E{(bf16_t*)(ws + WS_H)};
            pg8::gemm_phase<pg8::EpiUp, pg8::MoeOrder<true>, true>(F.lds + RING_OFF, g, S, E, F.tid);
        }
        SEAM(pb + 7);
        if (IN(pb + 8)) REP(8) { PH_BEGIN
            moe_table(a, F, l);
            pg8::Gemm g{(bf16_t*)(ws + WS_H), (bf16_t*)(ws + wset(l) + WO_W2), D / 2, D / 2, D / 2, E8_H, E8_W}; pg8::MoeOrder<false> S{F.G, F.bid, 4, tab, nullptr, (size_t)D * (D / 2)};
            pg8::EpiGate<0> E{(bf16_t*)(ws + WS_Y), nullptr, nullptr, 0, nullptr};
            pg8::gemm_phase<pg8::EpiGate<0>, pg8::MoeOrder<false>, true>(F.lds + RING_OFF, g, S, E, F.tid);
        }
        SEAM(pb + 8);
        if (IN(pb + 9)) REP(9) { PH_BEGIN
            if (l + 1 < DEPTH) load_wff(a, F, l + 1);
            moe_table(a, F, l);
            phase_combine_ln2(a, F, l);
        }
        SEAM(pb + 9);
    }

__global__ void __launch_bounds__(NWAVES * 64, 2) mk_fwd(Args args) {
    extern __shared__ __attribute__((aligned(16))) unsigned char lds_raw[];
    LAS unsigned char* const lds0 = (LAS unsigned char*)lds_raw;
    volatile LAS unsigned* MISC = (volatile LAS unsigned*)(lds0 + MISC_OFF);
    for (int u = threadIdx.x; u < (LDS_BYTES - LDSCTL_OFF) / 4; u += NWAVES * 64) ((LAS unsigned*)(lds0 + LDSCTL_OFF))[u] = 0u;
    __syncthreads();
    if ((threadIdx.x & 63) == 0) ((volatile LAS unsigned*)(lds0 + WTAB_OFF))[hw_wave_key()] = threadIdx.x >> 6;
    __syncthreads();
    unsigned* ctl = (unsigned*)(args.ws + WS_CTL);
    XcdBarrier bar; bar.bar = ctl + CW_BAR; bar.x = 0; bar.st = nullptr;
    if (args.use_bar) bar = xcd_barrier_post(ctl + CW_BAR, MISC + 8);
    const int lo = args.ph_lo, hi = args.ph_hi;


    if (IN(0)) { PH_BEGIN phase_prep(a, F); }
    SEAM(0);
    layer_body<0>(args, lo, hi, bar, lds0, lds_raw); layer_body<1>(args, lo, hi, bar, lds0, lds_raw); layer_body<2>(args, lo, hi, bar, lds0, lds_raw); layer_body<3>(args, lo, hi, bar, lds0, lds_raw);
#undef IN
#undef SEAM
}

extern "C" void kernel_launch(void* const* d_in, const int* in_sizes, int n_in, void* d_out, int out_size, void* d_ws, size_t ws_size, hipStream_t stream) {
    static int grid = 0;
    if (grid == 0) {
        if (n_in != 20 || in_sizes[0] != T * D || out_size != T * D || ws_size < WS_END) { fprintf(stderr, "kernel_launch: unexpected shapes (n_in %d, ws %zu)\n", n_in, ws_size); grid = -1; return; }
        int dev = 0, cus = 0, per_cu = 0;
        if (hipGetDevice(&dev) != hipSuccess || hipDeviceGetAttribute(&cus, hipDeviceAttributeMultiprocessorCount, dev) != hipSuccess) { grid = -1; return; }
        if (hipFuncSetAttribute((const void*)mk_fwd, hipFuncAttributeMaxDynamicSharedMemorySize, LDS_BYTES) != hipSuccess) { fprintf(stderr, "kernel_launch: hipFuncSetAttribute failed\n"); grid = -1; return; }
        if (hipOccupancyMaxActiveBlocksPerMultiprocessor(&per_cu, (const void*)mk_fwd, NWAVES * 64, LDS_BYTES) != hipSuccess || per_cu < 1)
            fprintf(stderr, "kernel_launch: note: occupancy query reports %d workgroups per CU\n", per_cu);
        (void)hipGetLastError();
        grid = cus;
    }
    if (grid < 0) return;
    if (hipMemsetAsync((char*)d_ws + WS_CTL, 0, CTL_BYTES, stream) != hipSuccess) return;
    Args a{};
    a.x = (const float*)d_in[0]; a.ln_in_g = (const float*)d_in[1]; a.ln_in_b = (const float*)d_in[2]; a.w_in = (const float*)d_in[3]; a.b_in = (const float*)d_in[4];
    a.w_fox = (const float*)d_in[5]; a.lbl = (const float*)d_in[6]; a.norm_g = (const float*)d_in[7]; a.w_hgrn = (const float*)d_in[8]; a.w_mix = (const float*)d_in[9];
    a.b_mix = (const float*)d_in[10]; a.ln1_g = (const float*)d_in[11]; a.ln1_b = (const float*)d_in[12]; a.router_w = (const float*)d_in[13]; a.router_b = (const float*)d_in[14];
    a.w1 = (const float*)d_in[15]; a.w3 = (const float*)d_in[16]; a.w2 = (const float*)d_in[17]; a.ln2_g = (const float*)d_in[18]; a.ln2_b = (const float*)d_in[19];
    a.out = (float*)d_out; a.ws = (unsigned char*)d_ws; a.pad = 0;
#if MK_ONE_LAUNCH
    a.ph_lo = 0; a.ph_hi = N_PHASES; a.use_bar = 1;
    hipLaunchKernelGGL(mk_fwd, dim3(grid), dim3(NWAVES * 64), LDS_BYTES, stream, a);
#else
#ifdef DBG_DUMP
    const int np_ = DBG_DUMP + 2;
#else
    const int np_ = N_PHASES;
#endif
    for (int p = 0; p < np_; ++p) { a.ph_lo = p; a.ph_hi = p + 1; a.use_bar = 0;
        hipLaunchKernelGGL(mk_fwd, dim3(grid), dim3(NWAVES * 64), LDS_BYTES, stream, a); }
#endif
    const hipError_t le = hipPeekAtLastError();
    if (le != hipSuccess) fprintf(stderr, "kernel_launch: launch failed: %s\n", hipGetErrorName(le));
}
```

```cpp
#define MK_ONE_LAUNCH 1
#define MK_FAST_ATTN 1
#define MK_FAST_HGRN 1
#include <hip/hip_runtime.h>
#include <cstdio>
#include <cstdint>

typedef unsigned short bf16_t;
typedef short bf16x8 __attribute__((ext_vector_type(8)));
typedef float f32x4 __attribute__((ext_vector_type(4)));
typedef float f32x2 __attribute__((ext_vector_type(2)));
typedef unsigned u32x4 __attribute__((ext_vector_type(4)));
typedef unsigned u32x2 __attribute__((ext_vector_type(2)));
#define LAS __attribute__((address_space(3)))
#define GAS __attribute__((address_space(1)))

constexpr int BATCH = 16, SEQ = 2048, T = BATCH * SEQ, D = 1024, DEPTH = 4, NH = 8, HD = 64, NIN = 5640, NINP = 5632, NE = 16;
constexpr float LN_EPS = 1e-5f, RMS_EPS = 1e-6f;
constexpr float ALPHA = 1.681792830507429f;
constexpr float LOG2E = 1.4426950408889634f;
constexpr float C2 = 0.125f * LOG2E;
constexpr float SC_W = 64.f, SC_FOX = 16.f, SC_HGRN = 4.f, SC_U = 64.f, SC_H = 8.f, SC_MIX = 32.f, SC_Y = 64.f;
constexpr int E8_1 = 0x7f7f7f7f, E8_W = 0x79797979, E8_FOX = 0x7b7b7b7b, E8_HGRN = 0x7d7d7d7d, E8_U = 0x79797979, E8_H = 0x7c7c7c7c;
constexpr int TM = 256;

constexpr size_t MiB = 1u << 20;
constexpr size_t WS_CTL = 0, CTL_BYTES = 1 * MiB;
constexpr size_t WS_MISC = 1 * MiB;
constexpr size_t WS_WSET = 2 * MiB, WSET_BYTES = 56 * MiB;
constexpr size_t WO_WIN = 0, WO_WBR = 6 * MiB, WO_WMIX = 7 * MiB, WO_W13 = 8 * MiB, WO_W2 = 40 * MiB;
__host__ __device__ constexpr size_t wset(int l) { return WS_WSET + (size_t)(l & 1) * WSET_BYTES; }
__host__ __device__ constexpr size_t biasoff(int l) { return WS_MISC + 16384 + (size_t)(l & 1) * 32768; }
constexpr size_t WS_XRES = 114 * MiB, WS_XN = 242 * MiB, WS_QO = 306 * MiB, WS_KV = 370 * MiB, WS_HB = 434 * MiB, WS_LOGF = 498 * MiB;
constexpr size_t WS_HG = 562 * MiB, WS_G = 594 * MiB, WS_FL = 722 * MiB, WS_F2 = 723 * MiB, WS_U1 = 724 * MiB, WS_U = 788 * MiB, WS_MIXED = 852 * MiB;
constexpr size_t WS_LIST = 916 * MiB, WS_TOK = 918 * MiB, WS_X1B = 920 * MiB, WS_END = 984 * MiB;
constexpr size_t WS_OX8 = 274 * MiB;
constexpr size_t WS_H = WS_QO, WS_Y = 442 * MiB;
constexpr int CW_CNT = 1024;
constexpr int CW_BAR = 4096;

__device__ __forceinline__ unsigned f2bf(float f) { unsigned u = __builtin_bit_cast(unsigned, f); return (u + 0x7fffu + ((u >> 16) & 1u)) >> 16; }
__device__ __forceinline__ float bf2f(unsigned h) { return __builtin_bit_cast(float, h << 16); }
__device__ __forceinline__ float bflo(unsigned w) { return __builtin_bit_cast(float, w << 16); }
__device__ __forceinline__ float bfhi(unsigned w) { return __builtin_bit_cast(float, w & 0xffff0000u); }
__device__ __forceinline__ unsigned pk2(float lo, float hi) { return f2bf(lo) | (f2bf(hi) << 16); }
__device__ __forceinline__ float wave_sum(float v) {
#pragma unroll
    for (int o = 1; o < 64; o <<= 1) v += __shfl_xor(v, o);
    return v;
}
__device__ __forceinline__ float wave_max(float v) {
#pragma unroll
    for (int o = 1; o < 64; o <<= 1) v = fmaxf(v, __shfl_xor(v, o));
    return v;
}
__device__ __forceinline__ float fast_exp(float v) { return __builtin_amdgcn_exp2f(v * LOG2E); }
__device__ __forceinline__ float sigmoidf_(float v) { return __builtin_amdgcn_rcpf(1.0f + fast_exp(-v)); }
__device__ __forceinline__ float siluf_(float v) { return v * sigmoidf_(v); }
__device__ __forceinline__ float logsigmoidf_(float v) { return fminf(v, 0.f) - __logf(1.0f + fast_exp(-fabsf(v))); }

namespace pg8 {
constexpr int BM = 256, BK = 64, HALF = 128, HTB = HALF * BK * 2  , STAGE_BYTES = 8 * HTB, NXCD = 8, WGM = 8;
__host__ __device__ __forceinline__ int lds_byte(int r, int c) { const int st = (r >> 4) * 2 + (c >> 5), rr = r & 15, cc = c & 31, ob = rr * 64 + cc * 2; return st * 1024 + (ob ^ (((ob >> 9) & 1) << 5)); }
__host__ __device__ __forceinline__ void stage_rc(int b, int& R, int& C) { const int st = b / 1024, sb = b % 1024, swz = sb ^ (((sb >> 9) & 1) << 5); R = (st >> 1) * 16 + swz / 64; C = (st & 1) * 32 + (swz % 64) / 2; }
__host__ __device__ __forceinline__ int perm32(int rho) { const int n = rho >> 4, i = rho & 15; return 8 * (i >> 2) + 4 * n + (i & 3); }

struct Unit { int pm, pn, e; };
struct Gemm { const bf16_t* A; const bf16_t* Bt; int lda, ldb, K; int sa, sb; };

struct StaticOrder {
    static constexpr bool GATHER = false;
    int nM, nN, nwg, G, c;
    __device__ void init(int M, int N, int G_, int c_) { nM = M / BM; nN = N / BM; nwg = nM * nN; G = G_; c = c_; }
    __device__ bool next(int i, Unit& u) const {
        const int L = i * G + c; if (L >= nwg) return false;
        int wgid = L; { const int q = nwg / NXCD, r = nwg % NXCD, xcd = wgid % NXCD, off = wgid / NXCD; wgid = (xcd < r ? xcd * (q + 1) : r * (q + 1) + (xcd - r) * q) + off; }
        const int nig = WGM * nN, gid = wgid / nig, fm = gid * WGM, gsz = (nM - fm) < WGM ? (nM - fm) : WGM;
        u.pm = fm + ((wgid % nig) % gsz); u.pn = (wgid % nig) / gsz; u.e = 0; return true;
    }
    __device__ __forceinline__ const char* a_tile(const Gemm& g, const Unit& u) const { return (const char*)g.A + (size_t)u.pm * BM * g.lda * 2; }
    __device__ __forceinline__ const char* b_tile(const Gemm& g, const Unit& u) const { return (const char*)g.Bt + (size_t)u.pn * BM * g.ldb * 2; }
    __device__ __forceinline__ void a_voff(const Gemm& g, const Unit&, const int (&R)[2], const int (&C)[2], unsigned (&v)[2][2]) const {
#pragma unroll
        for (int h = 0; h < 2; ++h)
#pragma unroll
            for (int i = 0; i < 2; ++i) v[h][i] = (unsigned)((h * HALF + R[i]) * g.lda + C[i]) * 2u;
    }
};
template <bool GATHER_> struct MoeOrder {
    static constexpr bool GATHER = GATHER_; static constexpr bool gather = GATHER_;
    int G, c, nN; const LAS int* tab; const int* list; size_t bstride;
    __device__ bool next(int i, Unit& u) const {
        const int L = i * G + c; const int rt = L / nN; const int NT = tab[NE]; if (rt >= NT) return false;
        int e = 0;
#pragma unroll
        for (int k = 1; k < NE; ++k) e += (rt >= tab[k]) ? 1 : 0;
        u.pm = __builtin_amdgcn_readfirstlane(rt); u.pn = __builtin_amdgcn_readfirstlane(L % nN); u.e = __builtin_amdgcn_readfirstlane(e); return true;
    }
    __device__ __forceinline__ const char* a_tile(const Gemm& g, const Unit& u) const { return gather ? (const char*)g.A : (const char*)g.A + (size_t)u.pm * BM * g.lda * 2; }
    __device__ __forceinline__ const char* b_tile(const Gemm& g, const Unit& u) const { return (const char*)g.Bt + ((size_t)u.e * bstride + (size_t)u.pn * BM * g.ldb) * 2; }
    __device__ __forceinline__ void a_voff(const Gemm& g, const Unit& u, const int (&R)[2], const int (&C)[2], unsigned (&v)[2][2]) const {
        const int ts = tab[u.e], cn = tab[NE + 1 + u.e];
#pragma unroll
        for (int h = 0; h < 2; ++h)
#pragma unroll
            for (int i = 0; i < 2; ++i) {
                if (gather) { const int pos = (u.pm - ts) * BM + h * HALF + R[i]; const int tok = (pos < cn) ? list[u.e * T + pos] : 0; v[h][i] = (unsigned)(tok * g.lda + C[i]) * 2u; }
                else v[h][i] = (unsigned)((h * HALF + R[i]) * g.lda + C[i]) * 2u;
            }
    }
};

typedef __bf16 bf16x2_t __attribute__((ext_vector_type(2)));
__device__ __forceinline__ unsigned cvt_pk_bf16(float lo, float hi) { f32x2 v = {lo, hi}; bf16x2_t b = __builtin_convertvector(v, bf16x2_t); return __builtin_bit_cast(unsigned, b); }
__device__ __forceinline__ u32x4 pack8(const f32x4& v0, const f32x4& v1) { u32x4 w; w.x = cvt_pk_bf16(v0[0], v0[1]); w.y = cvt_pk_bf16(v0[2], v0[3]); w.z = cvt_pk_bf16(v1[0], v1[1]); w.w = cvt_pk_bf16(v1[2], v1[3]); return w; }
__device__ __forceinline__ void unpack8(const u32x4& w, f32x4& v0, f32x4& v1) { v0[0] = bflo(w.x); v0[1] = bfhi(w.x); v0[2] = bflo(w.y); v0[3] = bfhi(w.y); v1[0] = bflo(w.z); v1[1] = bfhi(w.z); v1[2] = bflo(w.w); v1[3] = bfhi(w.w); }
typedef int v8i __attribute__((ext_vector_type(8)));
typedef int v4i __attribute__((ext_vector_type(4)));
__device__ __forceinline__ u32x2 pack8_fp8(const f32x4& v0, const f32x4& v1) {
    u32x2 w; int t = 0; t = __builtin_amdgcn_cvt_pk_fp8_f32(v0[0], v0[1], t, false); t = __builtin_amdgcn_cvt_pk_fp8_f32(v0[2], v0[3], t, true); w.x = (unsigned)t;
    int t2 = 0; t2 = __builtin_amdgcn_cvt_pk_fp8_f32(v1[0], v1[1], t2, false); t2 = __builtin_amdgcn_cvt_pk_fp8_f32(v1[2], v1[3], t2, true); w.y = (unsigned)t2; return w; }
__device__ __forceinline__ unsigned pack4_fp8(float a, float b, float c, float d) { int t = 0; t = __builtin_amdgcn_cvt_pk_fp8_f32(a, b, t, false); t = __builtin_amdgcn_cvt_pk_fp8_f32(c, d, t, true); return (unsigned)t; }
__device__ __forceinline__ f32x4 sig4(const f32x4& v) { f32x4 o; o[0] = sigmoidf_(v[0]); o[1] = sigmoidf_(v[1]); o[2] = sigmoidf_(v[2]); o[3] = sigmoidf_(v[3]); return o; }

struct EpiInproj {
    static constexpr bool PERM = true;
    unsigned char* ws; int layer;
    template <int KIND> __device__ __forceinline__ void tile(const f32x4 (&acc)[2][2][4][2], const Unit& u, int wr, int wc, int fr, int fq, unsigned char* w) const {
        const float* biasp = (const float*)(w + biasoff(layer));
        const int row0 = u.pm * BM + wr * 64 + fr, bcol0 = u.pn * BM + wc * 32 + 8 * fq;
        f32x4 bv[2][2];
#pragma unroll
        for (int bj = 0; bj < 2; ++bj)
#pragma unroll
            for (int n = 0; n < 2; ++n) bv[bj][n] = *(const f32x4*)(biasp + bcol0 + bj * HALF + 4 * n);
#pragma unroll
        for (int ai = 0; ai < 2; ++ai)
#pragma unroll
            for (int m = 0; m < 4; ++m) { const size_t row = (size_t)(row0 + ai * HALF + m * 16);
#pragma unroll
                for (int bj = 0; bj < 2; ++bj) { f32x4 v0 = acc[ai][bj][m][0] + bv[bj][0], v1 = acc[ai][bj][m][1] + bv[bj][1]; const int col = bcol0 + bj * HALF;
                    if (KIND == 0) { *(u32x4*)((bf16_t*)(w + WS_QO) + row * 1024 + col) = pack8(v0 * C2, v1 * C2); }
                    else if (KIND == 1) { *(u32x4*)((bf16_t*)(w + WS_KV) + row * 1024 + (col - 512)) = pack8(v0, v1); }
                    else if (KIND == 2) { *(u32x4*)((bf16_t*)(w + WS_KV) + row * 1024 + 512 + (col - 1024)) = pack8(v0, v1); }
                    else if (KIND == 3) { *(u32x4*)((bf16_t*)(w + WS_HB) + row * 1024 + (col - 1536)) = pack8(v0 * sig4(v0), v1 * sig4(v1)); }
                    else if (KIND == 4) { const int c = col - 2048; const float* lb = (const float*)(w + WS_MISC) + layer * 512; const f32x4 l0 = *(const f32x4*)(lb + c), l1 = *(const f32x4*)(lb + c + 4);
                        f32x4 f0 = l0 + (1.f - l0) * sig4(v0), f1 = l1 + (1.f - l1) * sig4(v1);
#pragma unroll
                        for (int q = 0; q < 4; ++q) { f0[q] = __logf(f0[q]); f1[q] = __logf(f1[q]); }
                        float* LOGF = (float*)(w + WS_LOGF); *(f32x4*)(LOGF + row * 512 + c) = f0; *(f32x4*)(LOGF + row * 512 + c + 4) = f1; }
                    else if (KIND == 5) { *(u32x4*)((bf16_t*)(w + WS_HB) + row * 1024 + 512 + (col - 2560)) = pack8(v0, v1); }
                    else if (KIND == 6) { *(u32x4*)((bf16_t*)(w + WS_HG) + row * 512 + (col - 3072)) = pack8(v0 * sig4(v0), v1 * sig4(v1)); }
                    else { *(u32x4*)((bf16_t*)(w + WS_G) + row * 2048 + (col - 3584)) = pack8(sig4(v0), sig4(v1)); }
                } }
    }
    __device__ __forceinline__ void operator()(const f32x4 (&acc)[2][2][4][2], const Unit& u, int wr, int wc, int fr, int fq) const {
        size_t z_ = 0; asm volatile("" : "+s"(z_)); unsigned char* w = ws + z_;
        const int ct = u.pn;
        if (ct < 2) tile<0>(acc, u, wr, wc, fr, fq, w); else if (ct < 4) tile<1>(acc, u, wr, wc, fr, fq, w); else if (ct < 6) tile<2>(acc, u, wr, wc, fr, fq, w);
        else if (ct < 8) tile<3>(acc, u, wr, wc, fr, fq, w); else if (ct < 10) tile<4>(acc, u, wr, wc, fr, fq, w); else if (ct < 12) tile<5>(acc, u, wr, wc, fr, fq, w);
        else if (ct < 14) tile<6>(acc, u, wr, wc, fr, fq, w); else tile<7>(acc, u, wr, wc, fr, fq, w);
    }
};
template <int MODE> struct EpiGate {
    static constexpr bool PERM = true;
    bf16_t* O; const float* bias; const bf16_t* Gt; int ldg; const bf16_t* P; float osc;
    __device__ __forceinline__ void operator()(const f32x4 (&acc)[2][2][4][2], const Unit& u, int wr, int wc, int fr, int fq) const {
        const int row0 = u.pm * BM + wr * 64 + fr, col0 = u.pn * BM + wc * 32 + 8 * fq;
        f32x4 bv[2][2];
        if (MODE == 0) {
#pragma unroll
            for (int bj = 0; bj < 2; ++bj)
#pragma unroll
                for (int n = 0; n < 2; ++n) bv[bj][n] = bias ? *(const f32x4*)(bias + col0 + bj * HALF + 4 * n) : (f32x4){0.f, 0.f, 0.f, 0.f};
        }
#pragma unroll
        for (int ai = 0; ai < 2; ++ai)
#pragma unroll
            for (int mh = 0; mh < 2; ++mh) {
                u32x4 gq[2][2], pq[2][2];
                if (MODE != 0) {
#pragma unroll
                    for (int mm = 0; mm < 2; ++mm)
#pragma unroll
                        for (int bj = 0; bj < 2; ++bj) { const size_t row = (size_t)(row0 + ai * HALF + (mh * 2 + mm) * 16); const int col = col0 + bj * HALF;
                            gq[mm][bj] = *(const u32x4*)(Gt + row * ldg + col);
                            if (MODE == 2) pq[mm][bj] = __builtin_nontemporal_load((const u32x4*)(P + row * 1024 + col)); }
                    asm volatile("s_waitcnt vmcnt(0)" ::: "memory");
                }
#pragma unroll
                for (int mm = 0; mm < 2; ++mm)
#pragma unroll
                    for (int bj = 0; bj < 2; ++bj) { const int m = mh * 2 + mm; const size_t row = (size_t)(row0 + ai * HALF + m * 16); const int col = col0 + bj * HALF;
                        f32x4 v0 = acc[ai][bj][m][0], v1 = acc[ai][bj][m][1];
                        if (MODE == 0) { v0 += bv[bj][0]; v1 += bv[bj][1]; }
                        else { f32x4 g0, g1; unpack8(gq[mm][bj], g0, g1); v0 *= g0; v1 *= g1;
                            if (MODE == 2) { f32x4 p0, p1; unpack8(pq[mm][bj], p0, p1); v0 += p0; v1 += p1; } }
                        if (MODE == 2) *(u32x2*)((unsigned char*)O + row * 1024 + col) = pack8_fp8(v0 * SC_U, v1 * SC_U);
                        else if (MODE == 0 && osc != 0.f) *(u32x2*)((unsigned char*)O + row * 1024 + col) = pack8_fp8(v0 * osc, v1 * osc);
                        else *(u32x4*)(O + row * 1024 + col) = pack8(v0, v1); }
                if (MODE != 0) asm volatile("" ::: "memory");
            }
    }
};
struct EpiUp {
    static constexpr bool PERM = true;
    bf16_t* H;
    __device__ __forceinline__ void operator()(const f32x4 (&acc)[2][2][4][2], const Unit& u, int wr, int wc, int fr, int fq) const {
        const int row0 = u.pm * BM + wr * 64 + fr, col = u.pn * HALF + wc * 32 + 8 * fq;
#pragma unroll
        for (int ai = 0; ai < 2; ++ai)
#pragma unroll
            for (int m = 0; m < 4; ++m) { const size_t row = (size_t)(row0 + ai * HALF + m * 16);
                const f32x4 a0 = acc[ai][0][m][0], a1 = acc[ai][0][m][1], b0 = acc[ai][1][m][0], b1 = acc[ai][1][m][1];
                *(u32x2*)((unsigned char*)H + row * 1024 + col) = pack8_fp8(a0 * sig4(a0) * b0 * SC_H, a1 * sig4(a1) * b1 * SC_H); }
    }
};

__device__ __forceinline__ void glds16s(const char* sbase, unsigned voff, unsigned lds_dst) {
    unsigned keep;
    asm volatile("s_mov_b32 %0, m0\n\ts_mov_b32 m0, %3\n\ts_nop 0\n\tglobal_load_lds_dwordx4 %1, %2\n\ts_mov_b32 m0, %0" : "=&s"(keep) : "v"(voff), "s"(sbase), "s"(lds_dst) : "memory");
}
template <class Epi, class Sched, bool ALIGN_EPI>
__device__ __forceinline__ void gemm_phase(LAS unsigned char* lds, const Gemm g, const Sched& S, const Epi& E, const int tid) {
    const int wid = __builtin_amdgcn_readfirstlane(tid >> 6), lane = tid & 63, wr = wid >> 2, wc = wid & 3, fr = lane & 15, fq = lane >> 4;
    int K = g.K; asm volatile("" : "+s"(K));
    const int nt = K / BK;
    int RA[2], CA[2]; unsigned voffB[2];
#pragma unroll
    for (int i = 0; i < 2; ++i) { int R, C; stage_rc(tid * 16 + i * 8192, R, C); const int Rb = Epi::PERM ? ((R & ~31) + perm32(R & 31)) : R;
        RA[i] = R; CA[i] = C; voffB[i] = (unsigned)(Rb * g.ldb + C) * 2u; }
    const size_t kstep = (size_t)(BK * 2);
    const size_t hstepB = (size_t)HALF * g.ldb * 2;
    const unsigned ldsw = (unsigned)wid * 1024u;
    const unsigned ldsb = (unsigned)__builtin_amdgcn_readfirstlane((int)((unsigned)(uintptr_t)lds + ldsw));
    const int aoff = lds_byte(wr * 64 + fr, fq * 8), boff = lds_byte(wc * 32 + fr, fq * 8);
#define PG8_SA(b, h) (((b) * 2 + (h)) * HTB)
#define PG8_SB(b, h) ((4 + (b) * 2 + (h)) * HTB)
#define PG8_STAGE(bufoff, gbase, voff) do { _Pragma("unroll") for (int _i = 0; _i < 2; ++_i) glds16s((const char*)(gbase), (voff)[_i], ldsb + (unsigned)((bufoff) + _i * 8192)); } while (0)
#define PG8_LD8(p) __builtin_shufflevector(*(const LAS v4i*)(p), *(const LAS v4i*)((p) + 1024), 0, 1, 2, 3, 4, 5, 6, 7)
#define PG8_LDA(dst, b, h) do { _Pragma("unroll") for (int m = 0; m < 4; ++m) dst[m] = PG8_LD8(lds + PG8_SA(b, h) + aoff + m * 2048); } while (0)
#define PG8_LDB(dst, b, h) do { _Pragma("unroll") for (int n = 0; n < 2; ++n) dst[n] = PG8_LD8(lds + PG8_SB(b, h) + boff + n * 2048); } while (0)
#define PG8_MMA(ai, bj, At, Bt) do { __builtin_amdgcn_s_setprio(1); _Pragma("unroll") for (int m = 0; m < 4; ++m) _Pragma("unroll") for (int n = 0; n < 2; ++n) \
        asm volatile("v_mfma_scale_f32_16x16x128_f8f6f4 %0, %1, %2, %0, %3, %4 op_sel_hi:[0,0,0]" : "+v"(acc[ai][bj][m][n]) : "v"(Bt[n]), "v"(At[m]), "v"(sbv), "v"(sav)); \
        __builtin_amdgcn_s_setprio(0); } while (0)
#define PG8_WAIT_V(n) asm volatile("s_waitcnt vmcnt(" #n ")" ::: "memory")
#define PG8_WAIT_L(n) asm volatile("s_waitcnt lgkmcnt(" #n ")" ::: "memory")
#define PG8_BAR __builtin_amdgcn_s_barrier()
#define PG8_SCHED __builtin_amdgcn_sched_barrier(0)
    Unit cur, nxt; int ui = 0;
    if (!S.next(0, cur)) return;
    f32x4 acc[2][2][4][2];
#pragma unroll
    for (int a = 0; a < 2; ++a)
#pragma unroll
        for (int b = 0; b < 2; ++b)
#pragma unroll
            for (int m = 0; m < 4; ++m)
#pragma unroll
                for (int n = 0; n < 2; ++n) acc[a][b][m][n] = (f32x4){0.f, 0.f, 0.f, 0.f};
    int sav = g.sa, sbv = g.sb;
    v8i At[4], B0[2], B1[2];
    unsigned vA[2][2], nvA[2][2];
    S.a_voff(g, cur, RA, CA, vA);
    const char* cA = S.a_tile(g, cur); const char* cB = S.b_tile(g, cur);
    PG8_STAGE(PG8_SB(0, 0), cB, voffB); PG8_STAGE(PG8_SB(0, 1), cB + hstepB, voffB); PG8_STAGE(PG8_SA(0, 0), cA, vA[0]); PG8_STAGE(PG8_SA(0, 1), cA, vA[1]);
    if (wr == 1) PG8_BAR;
    PG8_WAIT_V(2); PG8_BAR;
    PG8_STAGE(PG8_SB(1, 0), cB + kstep, voffB); PG8_STAGE(PG8_SA(1, 0), cA + kstep, vA[0]); PG8_STAGE(PG8_SB(1, 1), cB + hstepB + kstep, voffB);
    PG8_WAIT_V(6); PG8_BAR;
    for (;;) {
        const bool has_next = S.next(ui + 1, nxt);
        const char* nA = has_next ? S.a_tile(g, nxt) : cA; const char* nB = has_next ? S.b_tile(g, nxt) : cB;
        if constexpr (Sched::GATHER) {
            if (has_next) { int RA2[2], CA2[2];
#pragma unroll
                for (int i = 0; i < 2; ++i) { int tq = tid; asm volatile("" : "+v"(tq)); stage_rc(tq * 16 + i * 8192, RA2[i], CA2[i]); }
                S.a_voff(g, nxt, RA2, CA2, nvA); }
            else {
#pragma unroll
                for (int h = 0; h < 2; ++h)
#pragma unroll
                    for (int i = 0; i < 2; ++i) nvA[h][i] = vA[h][i]; }
        }
        for (int t = 0; t < nt; t += 2) {
            const bool last = (t == nt - 2);
            const char* a1 = cA + (size_t)(t + 1) * kstep;
            const char* a2 = last ? nA : cA + (size_t)(t + 2) * kstep; const char* b2 = last ? nB : cB + (size_t)(t + 2) * kstep;
            const char* a3 = a2 + kstep; const char* b3 = b2 + kstep;
            unsigned wA0[2], wA1[2];
#pragma unroll
            for (int i = 0; i < 2; ++i) { if constexpr (Sched::GATHER) { wA0[i] = last ? nvA[0][i] : vA[0][i]; wA1[i] = last ? nvA[1][i] : vA[1][i]; } else { wA0[i] = vA[0][i]; wA1[i] = vA[1][i]; } }
            PG8_LDB(B0, 0, 0); PG8_LDB(B1, 0, 1); PG8_SCHED; PG8_LDA(At, 0, 0); PG8_STAGE(PG8_SA(1, 1), a1, vA[1]);
            PG8_WAIT_V(8); PG8_WAIT_L(0); PG8_BAR; PG8_MMA(0, 0, At, B0); PG8_MMA(0, 1, At, B1); PG8_BAR; PG8_SCHED;
            PG8_LDA(At, 0, 1); PG8_STAGE(PG8_SB(0, 0), b2, voffB); PG8_STAGE(PG8_SB(0, 1), b2 + hstepB, voffB); PG8_STAGE(PG8_SA(0, 0), a2, wA0);
            PG8_WAIT_V(8); PG8_WAIT_L(0); PG8_BAR; PG8_MMA(1, 0, At, B0); PG8_MMA(1, 1, At, B1); PG8_BAR; PG8_SCHED;
            PG8_LDB(B0, 1, 0); PG8_LDB(B1, 1, 1); PG8_SCHED; PG8_LDA(At, 1, 0); PG8_STAGE(PG8_SA(0, 1), a2, wA1);
            PG8_WAIT_V(8); PG8_WAIT_L(0); PG8_BAR; PG8_MMA(0, 0, At, B0); PG8_MMA(0, 1, At, B1); PG8_BAR; PG8_SCHED;
            PG8_LDA(At, 1, 1); PG8_STAGE(PG8_SB(1, 0), b3, voffB); PG8_STAGE(PG8_SB(1, 1), b3 + hstepB, voffB); PG8_STAGE(PG8_SA(1, 0), a3, wA0);
            PG8_WAIT_V(8); PG8_WAIT_L(0); PG8_BAR; PG8_MMA(1, 0, At, B0); PG8_MMA(1, 1, At, B1); PG8_BAR; PG8_SCHED;
        }
        if constexpr (ALIGN_EPI) { if (wr == 0) PG8_BAR; }
        asm volatile("s_nop 15\n\ts_nop 15" ::: "memory");
        E(acc, cur, wr, wc, fr, fq);
        if (!has_next) break;
#pragma unroll
        for (int a = 0; a < 2; ++a)
#pragma unroll
            for (int b = 0; b < 2; ++b)
#pragma unroll
                for (int m = 0; m < 4; ++m)
#pragma unroll
                    for (int n = 0; n < 2; ++n) acc[a][b][m][n] = (f32x4){0.f, 0.f, 0.f, 0.f};
        cur = nxt; cA = nA; cB = nB; ++ui;
        if constexpr (Sched::GATHER) {
#pragma unroll
            for (int h = 0; h < 2; ++h)
#pragma unroll
                for (int i = 0; i < 2; ++i) vA[h][i] = nvA[h][i]; }
        if constexpr (ALIGN_EPI) { if (wr == 1) PG8_BAR; }
    }
    PG8_WAIT_V(0);
    if constexpr (!ALIGN_EPI) { if (wr == 0) PG8_BAR; }
    PG8_BAR;
#undef PG8_SA
#undef PG8_SB
#undef PG8_STAGE
#undef PG8_LDA
#undef PG8_LDB
#undef PG8_MMA
#undef PG8_LD8
#undef PG8_WAIT_V
#undef PG8_WAIT_L
#undef PG8_BAR
#undef PG8_SCHED
}
}


#include <hip/hip_bf16.h>
#include <cmath>
namespace attn_body {
using bf16=__hip_bfloat16;
using bf16x8=__attribute__((ext_vector_type(8)))short;
using s16x4=__attribute__((ext_vector_type(4)))short;
using f32x16=__attribute__((ext_vector_type(16)))float;
using u32x4=__attribute__((ext_vector_type(4)))unsigned;
constexpr int BATCH=16,NHEAD=8,SEQ=2048,D=64,DM=1024;
constexpr int NW=8,QBLK=32,QB=QBLK*NW,KVBLK=64,NQB=SEQ/QB;
constexpr int ATTN_PITCH=DM, ATTN_UNIT_ROWS=QB;
__device__ __forceinline__ int crow(int r,int hi){return (r&3)+8*(r>>2)+4*hi;}
#define SBAR() __builtin_amdgcn_sched_barrier(0)
__device__ __forceinline__ void cmask(f32x16&p0,f32x16&p1,int jb,int qrel,int hi){
  const float NEG=-INFINITY; int kb=64*jb+4*hi;
  #pragma unroll
  for(int r=0;r<16;++r){int kv=kb+(r&3)+8*(r>>2); if(kv>qrel)p0[r]=NEG; if(kv+32>qrel)p1[r]=NEG;}
}

constexpr int NSLOT=3, SLOTB=8192;
constexpr int LDS_K=0, LDS_V=NSLOT*SLOTB, LDS_WS=2*NSLOT*SLOTB, LDS_OST=LDS_WS+NW*64*4, LDS_BYTES=LDS_OST+NW*4096;
constexpr float C2=0.125f*1.4426950408889634f;
__device__ __forceinline__ void glds16(const void*gsrc,unsigned lds_dst){unsigned keep;
  asm volatile("s_mov_b32 %0, m0\n\ts_mov_b32 m0, %2\n\ts_nop 0\n\tglobal_load_lds_dwordx4 %1, off\n\ts_mov_b32 m0, %0":"=&s"(keep):"v"(gsrc),"s"(lds_dst):"memory");}
__device__ __forceinline__ float max3f(float a,float b,float c){float r;asm("v_max3_f32 %0, %1, %2, %3":"=v"(r):"v"(a),"v"(b),"v"(c));return r;}
__device__ __forceinline__ float max2f(float a,float b){float r;asm("v_max_f32_e32 %0, %1, %2":"=v"(r):"v"(a),"v"(b));return r;}
__device__ __forceinline__ float fadd_s(float a,float b){float r;asm("v_add_f32_e32 %0, %1, %2":"=v"(r):"v"(a),"v"(b));return r;}
__device__ __forceinline__ float fsub_s(float a,float b){float r;asm("v_sub_f32_e32 %0, %1, %2":"=v"(r):"v"(a),"v"(b));return r;}
typedef float f32x2_t __attribute__((ext_vector_type(2))); typedef __bf16 bf16x2_t __attribute__((ext_vector_type(2)));
__device__ __forceinline__ unsigned cvtpk_s(float lo,float hi){f32x2_t v={lo,hi};bf16x2_t b=__builtin_convertvector(v,bf16x2_t);return __builtin_bit_cast(unsigned,b);}
#define WAIT_BAR(N) asm volatile("s_waitcnt vmcnt(" #N ") lgkmcnt(0)\n\ts_barrier":::"memory")

__device__ __forceinline__ void qkt(f32x16&p0,f32x16&p1,const char*Kslot,const bf16x8*qr,const f32x16&negm,int r32,int hi){
  const char*kb=Kslot+hi*1024+r32*16;
  #pragma unroll
  for(int d0=0;d0<4;++d0){
    const bf16x8 b0=*reinterpret_cast<const bf16x8*>(kb+d0*2048);
    const bf16x8 b1=*reinterpret_cast<const bf16x8*>(kb+d0*2048+512);
    if(d0==0){p0=__builtin_amdgcn_mfma_f32_32x32x16_bf16(b0,qr[0],negm,0,0,0);p1=__builtin_amdgcn_mfma_f32_32x32x16_bf16(b1,qr[0],negm,0,0,0);}
    else{p0=__builtin_amdgcn_mfma_f32_32x32x16_bf16(b0,qr[d0],p0,0,0,0);p1=__builtin_amdgcn_mfma_f32_32x32x16_bf16(b1,qr[d0],p1,0,0,0);}}
}
typedef __attribute__((address_space(3))) const char* lds_cptr;
typedef short v4i16_t __attribute__((ext_vector_type(4)));
__device__ __forceinline__ void kload8(bf16x8*kf,lds_cptr kp){
  kf[0]=*(const __attribute__((address_space(3))) bf16x8*)(kp);      kf[1]=*(const __attribute__((address_space(3))) bf16x8*)(kp+512);
  kf[2]=*(const __attribute__((address_space(3))) bf16x8*)(kp+2048); kf[3]=*(const __attribute__((address_space(3))) bf16x8*)(kp+2560);
  kf[4]=*(const __attribute__((address_space(3))) bf16x8*)(kp+4096); kf[5]=*(const __attribute__((address_space(3))) bf16x8*)(kp+4608);
  kf[6]=*(const __attribute__((address_space(3))) bf16x8*)(kp+6144); kf[7]=*(const __attribute__((address_space(3))) bf16x8*)(kp+6656);
}
__device__ __forceinline__ void kload2(bf16x8*kf,lds_cptr kp,int j){ kf[2*j]=*(const __attribute__((address_space(3))) bf16x8*)(kp+j*2048); kf[2*j+1]=*(const __attribute__((address_space(3))) bf16x8*)(kp+j*2048+512); }
__device__ __forceinline__ s16x4 vtr(lds_cptr p){ return __builtin_bit_cast(s16x4,__builtin_amdgcn_ds_read_tr16_b64_v4i16((__attribute__((address_space(3))) v4i16_t*)p)); }
__device__ __forceinline__ float rowmax(const f32x16&p0,const f32x16&p1){
  float a=max3f(p0[0],p0[1],p1[0]),b=max3f(p0[2],p0[3],p1[1]);a=max3f(a,p1[2],p1[3]);
  #pragma unroll
  for(int r=4;r<16;r+=4){a=max3f(a,p0[r],p0[r+1]);b=max3f(b,p0[r+2],p0[r+3]);a=max3f(a,p1[r],p1[r+1]);b=max3f(b,p1[r+2],p1[r+3]);}
  const float m=max2f(a,b);
  auto rr=__builtin_amdgcn_permlane32_swap(__float_as_uint(m),__float_as_uint(m),false,false);
  return max2f(__uint_as_float(rr[0]),__uint_as_float(rr[1]));
}
__device__ __forceinline__ void pv(f32x16*o,int vb,bf16x8 pa0,bf16x8 pa1,bf16x8 pa2,bf16x8 pa3){
  #pragma unroll
  for(int d0=0;d0<2;++d0){s16x4 lo[4],hi[4];
    #pragma unroll
    for(int ks=0;ks<4;++ks){
      asm volatile("ds_read_b64_tr_b16 %0,%1 offset:%c2":"=&v"(lo[ks]):"v"(vb),"i"(d0*4096+ks*1024):"memory");
      asm volatile("ds_read_b64_tr_b16 %0,%1 offset:%c2":"=&v"(hi[ks]):"v"(vb),"i"(d0*4096+ks*1024+512):"memory");}
    asm volatile("s_waitcnt lgkmcnt(0)":::"memory");SBAR();
    #define PK(k) (bf16x8){lo[k][0],lo[k][1],lo[k][2],lo[k][3],hi[k][0],hi[k][1],hi[k][2],hi[k][3]}
    o[d0]=__builtin_amdgcn_mfma_f32_32x32x16_bf16(pa0,PK(0),o[d0],0,0,0);
    o[d0]=__builtin_amdgcn_mfma_f32_32x32x16_bf16(pa1,PK(1),o[d0],0,0,0);
    o[d0]=__builtin_amdgcn_mfma_f32_32x32x16_bf16(pa2,PK(2),o[d0],0,0,0);
    o[d0]=__builtin_amdgcn_mfma_f32_32x32x16_bf16(pa3,PK(3),o[d0],0,0,0);
    #undef PK
  }
}

#ifndef ATTN_STORE16
#define ATTN_STORE16(p,v) (*(u32x4*)(p)=(v))
#endif
template<int THRL> __device__ __forceinline__ void attn_unit(int b,int h,int qb,const bf16*Q,const bf16*__restrict__ K,const bf16*__restrict__ V,bf16*O,char*shm,const __attribute__((address_space(3))) float*f2,const int tid){
  #define BIAS_H(P,off,g0) { f32x4 x_[2]; _Pragma("unroll") for(int g_=0;g_<2;++g_) x_[g_]=*(const __attribute__((address_space(3))) f32x4*)(fb_+(off)+8*((g0)+g_)); \
      _Pragma("unroll") for(int g_=0;g_<2;++g_) _Pragma("unroll") for(int i_=0;i_<4;++i_) P[4*((g0)+g_)+i_]-=x_[g_][i_]; asm volatile("":::"memory"); }
  #define BIAS(P0,P1,t) do{ const __attribute__((address_space(3))) float* fb_=f2+64*(t)+4*hi; \
    BIAS_H(P0,0,0) BIAS_H(P0,0,2) BIAS_H(P1,32,0) BIAS_H(P1,32,2) }while(0)
  const int lane=tid&63,r32=lane&31,hi=lane>>5; const int wid=__builtin_amdgcn_readfirstlane(tid>>6);
  const long rowbase=(long)b*SEQ; const int q0=qb*QB;
  const bf16*Qw=Q+(rowbase+q0+wid*QBLK)*DM+h*D;
  const bf16*Kh=K+rowbase*DM+h*D,*Vh=V+rowbase*DM+h*D;
  const unsigned lds0=(unsigned)(uintptr_t)shm;
  float*wsf=(float*)(shm+LDS_WS)+wid*64;
  const bf16*ksrc=Kh+(long)lane*DM+wid*8;
  const bf16*vsrc=Vh+(long)(16*(wid&3)+(lane>>2))*DM+(wid>>2)*32+(lane&3)*8;
  const unsigned kdst=lds0+LDS_K+wid*1024, vdst=lds0+LDS_V+wid*1024;
  #define DMA_K(t,slot) glds16(ksrc+(long)(t)*KVBLK*DM,(unsigned)__builtin_amdgcn_readfirstlane(kdst+(slot)))
  #define DMA_V(t,slot) glds16(vsrc+(long)(t)*KVBLK*DM,(unsigned)__builtin_amdgcn_readfirstlane(vdst+(slot)))
  const int vb0=(int)(lds0+LDS_V)+((lane>>4)&1)*32+(lane&3)*8+(4*hi+((lane&15)>>2))*64;
  const char*Kbase=shm+LDS_K; bf16x8 kf[8];
  const lds_cptr shm3=(lds_cptr)shm; const lds_cptr kp0=shm3+LDS_K+hi*1024+r32*16; const lds_cptr vp0=shm3+LDS_V+((lane>>4)&1)*32+(lane&3)*8+(4*hi+((lane&15)>>2))*64;
  const int NT=(q0+QB)/KVBLK;
  DMA_K(0,0);DMA_V(0,0);DMA_K(1,SLOTB);
  bf16x8 qr[4];
  #pragma unroll
  for(int d0=0;d0<4;++d0)qr[d0]=*reinterpret_cast<const bf16x8*>(&Qw[(long)r32*DM+d0*16+hi*8]);
  float mhat=0.f,l_reg=0.f;f32x16 o[2];f32x16 negm; { float z_=0.f; asm volatile("":"+v"(z_)); _Pragma("unroll") for(int r=0;r<16;++r){o[0][r]=z_;o[1][r]=z_;negm[r]=z_;} } asm volatile("":"+v"(negm));
  const int qrel=wid*QBLK+r32;
  #define CMASK(P0,P1,t) do{int jb_=(t)-(NT-4); if(jb_>=0)cmask(P0,P1,jb_,qrel,hi);}while(0)
  bool resc=false;
  #define START(P0,P1) do{ const float rm=rowmax(P0,P1); resc=false; \
    { const float dl=rm; mhat=fadd_s(mhat,dl); \
      _Pragma("unroll") for(int r=0;r<16;++r){P0[r]=fsub_s(P0[r],dl);P1[r]=fsub_s(P1[r],dl);} \
      _Pragma("unroll") for(int r=0;r<16;++r)negm[r]=-mhat; asm volatile("":"+v"(negm)); } \
    _Pragma("unroll") for(int r=0;r<16;++r)P0[r]=__builtin_amdgcn_exp2f(P0[r]); }while(0)
  #define RESC() do{ if(resc){ asm volatile("s_waitcnt lgkmcnt(0)":::"memory"); \
      _Pragma("unroll") for(int d_=0;d_<2;++d_) _Pragma("unroll") for(int r=0;r<16;++r)o[d_][r]*=wsf[crow(r,hi)]; } }while(0)
  f32x16 pA0,pA1,pB0,pB1;
  int sl_prev=0,sl_cur=0,sl_next=SLOTB;
  #define ROT() do{sl_prev=sl_cur;sl_cur=sl_next;sl_next=(sl_next==(NSLOT-1)*SLOTB)?0:sl_next+SLOTB;}while(0)
  DMA_K(2,2*SLOTB);
  WAIT_BAR(3);
  qkt(pA0,pA1,Kbase,qr,negm,r32,hi);asm volatile("s_nop 15\n\ts_nop 7":"+v"(pA0),"+v"(pA1));CMASK(pA0,pA1,0);BIAS(pA0,pA1,0);
  START(pA0,pA1);
  _Pragma("unroll") for(int r=0;r<16;++r)pA1[r]=__builtin_amdgcn_exp2f(pA1[r]);
  WAIT_BAR(0);
  DMA_K(3,0);DMA_V(1,SLOTB);
  ROT();
  kload8(kf,kp0+sl_cur);
  WAIT_BAR(2);
  s16x4 vlo[8],vhi[8]; u32x4 pw0,pw1,pw2,pw3;
  #define PKW(P,B) cvtpk_s(P[B],P[B+1])
  #define PAF(k) __builtin_bit_cast(bf16x8,pw##k)
  #define VFR(i) (bf16x8){vlo[i][0],vlo[i][1],vlo[i][2],vlo[i][3],vhi[i][0],vhi[i][1],vhi[i][2],vhi[i][3]}
  #define PIN(x) asm volatile("":"+v"(x))
  #define MX3(a,b,c) __builtin_fmaxf(__builtin_fmaxf((a),(b)),(c))
  #define GAPA(MF,A0,A1,A2,A3,W0,W1,PW) do{ MF; sacc+=A0; sacc+=A1; sacc+=A2; sacc+=A3; PIN(sacc); W0; W1; PIN(PW); SBAR(); }while(0)
  #define EX(v) __builtin_amdgcn_exp2f(v)
  #define GAPB(MF,X,B) do{ MF; X[B]=EX(X[B]); X[B+1]=EX(X[B+1]); X[B+2]=EX(X[B+2]); X[B+3]=EX(X[B+3]); PIN(X); SBAR(); }while(0)
  #define VRD(i) do{ vlo[i]=vtr(vp_+(((i)>>2)*4096+((i)&3)*1024)); vhi[i]=vtr(vp_+(((i)>>2)*4096+((i)&3)*1024+512)); }while(0)
  #define KRD(G,j) do{ if(G){ kload2(kf,kp0+sl_next,j); SBAR(); } }while(0)
  #define STEP(C0,C1,P0,P1,t,GK,GV,GL) do{ SBAR(); \
    const lds_cptr vp_=vp0+sl_prev; \
    VRD(0); SBAR(); float sacc=(P0[0]+P0[1]); \
    GAPA(C0=__builtin_amdgcn_mfma_f32_32x32x16_bf16(kf[0],qr[0],negm,0,0,0), P0[2],P0[3],P0[4],P0[5],     pw0[0]=PKW(P0,0), pw0[1]=PKW(P0,2), pw0); \
    VRD(4); SBAR(); GAPA(C1=__builtin_amdgcn_mfma_f32_32x32x16_bf16(kf[1],qr[0],negm,0,0,0), P0[6],P0[7],P0[8],P0[9],     pw0[2]=PKW(P0,4), pw0[3]=PKW(P0,6), pw0); \
    VRD(1); SBAR(); GAPA(C0=__builtin_amdgcn_mfma_f32_32x32x16_bf16(kf[2],qr[1],C0,0,0,0),   P0[10],P0[11],P0[12],P0[13], pw1[0]=PKW(P0,8), pw1[1]=PKW(P0,10), pw1); \
    VRD(5); SBAR(); GAPA(C1=__builtin_amdgcn_mfma_f32_32x32x16_bf16(kf[3],qr[1],C1,0,0,0),   P0[14],P0[15],P1[0],P1[1],   pw1[2]=PKW(P0,12),pw1[3]=PKW(P0,14), pw1); \
    VRD(2); SBAR(); GAPA(C0=__builtin_amdgcn_mfma_f32_32x32x16_bf16(kf[4],qr[2],C0,0,0,0),   P1[2],P1[3],P1[4],P1[5],     pw2[0]=PKW(P1,0), pw2[1]=PKW(P1,2), pw2); \
    VRD(6); SBAR(); GAPA(C1=__builtin_amdgcn_mfma_f32_32x32x16_bf16(kf[5],qr[2],C1,0,0,0),   P1[6],P1[7],P1[8],P1[9],     pw2[2]=PKW(P1,4), pw2[3]=PKW(P1,6), pw2); \
    VRD(3); SBAR(); GAPA(C0=__builtin_amdgcn_mfma_f32_32x32x16_bf16(kf[6],qr[3],C0,0,0,0),   P1[10],P1[11],P1[12],P1[13], pw3[0]=PKW(P1,8), pw3[1]=PKW(P1,10), pw3); \
    VRD(7); SBAR(); GAPA(C1=__builtin_amdgcn_mfma_f32_32x32x16_bf16(kf[7],qr[3],C1,0,0,0),   P1[14],P1[15],0.f,0.f,       pw3[2]=PKW(P1,12),pw3[3]=PKW(P1,14), pw3); \
    l_reg+=sacc; \
    if(GK){DMA_K((t)+3,sl_cur);} if(GV){DMA_V((t)+1,sl_next);} \
    CMASK(C0,C1,t); BIAS(C0,C1,t); \
    { float a=MX3(C0[0],C0[1],C1[0]),b=MX3(C0[2],C0[3],C1[1]); a=MX3(a,C1[2],C1[3]); \
      _Pragma("unroll") for(int r=4;r<16;r+=4){a=MX3(a,C0[r],C0[r+1]);b=MX3(b,C0[r+2],C0[r+3]);a=MX3(a,C1[r],C1[r+1]);b=MX3(b,C1[r+2],C1[r+3]);} \
      float rm=__builtin_fmaxf(a,b); { auto rr=__builtin_amdgcn_permlane32_swap(__float_as_uint(rm),__float_as_uint(rm),false,false); rm=__builtin_fmaxf(__uint_as_float(rr[0]),__uint_as_float(rr[1])); } \
      resc=false; \
      if(__builtin_expect(__any(rm>(float)THRL),0)){ const float dl=__builtin_fmaxf(rm,0.f); mhat+=dl; \
        _Pragma("unroll") for(int r=0;r<16;++r){C0[r]-=dl;C1[r]-=dl;} \
        _Pragma("unroll") for(int r=0;r<16;++r)negm[r]=-mhat; asm volatile("":"+v"(negm)); \
        const float f=__builtin_amdgcn_exp2f(-dl); l_reg*=f; if(hi==0)wsf[r32]=f; resc=true; } } \
    SBAR(); \
    GAPB(o[0]=__builtin_amdgcn_mfma_f32_32x32x16_bf16(PAF(0),VFR(0),o[0],0,0,0), C0,0); \
    GAPB(o[1]=__builtin_amdgcn_mfma_f32_32x32x16_bf16(PAF(0),VFR(4),o[1],0,0,0), C0,4); \
    KRD(GL,0); GAPB(o[0]=__builtin_amdgcn_mfma_f32_32x32x16_bf16(PAF(1),VFR(1),o[0],0,0,0), C0,8); \
    KRD(GL,1); GAPB(o[1]=__builtin_amdgcn_mfma_f32_32x32x16_bf16(PAF(1),VFR(5),o[1],0,0,0), C0,12); \
    KRD(GL,2); GAPB(o[0]=__builtin_amdgcn_mfma_f32_32x32x16_bf16(PAF(2),VFR(2),o[0],0,0,0), C1,0); \
    KRD(GL,3); GAPB(o[1]=__builtin_amdgcn_mfma_f32_32x32x16_bf16(PAF(2),VFR(6),o[1],0,0,0), C1,4); \
    GAPB(o[0]=__builtin_amdgcn_mfma_f32_32x32x16_bf16(PAF(3),VFR(3),o[0],0,0,0), C1,8); \
    GAPB(o[1]=__builtin_amdgcn_mfma_f32_32x32x16_bf16(PAF(3),VFR(7),o[1],0,0,0), C1,12); \
    }while(0)
  int t=1;
  #undef CMASK
  #define CMASK(P0,P1,t) do{}while(0)
  for(;t+5<NT;t+=2){
    STEP(pB0,pB1,pA0,pA1,t,true,true,true);     WAIT_BAR(2); RESC(); ROT();
    STEP(pA0,pA1,pB0,pB1,t+1,true,true,true);   WAIT_BAR(2); RESC(); ROT();
  }
  #undef CMASK
  #define CMASK(P0,P1,t) do{int jb_=(t)-(NT-4); if(jb_>=0)cmask(P0,P1,jb_,qrel,hi);}while(0)
  #define ENDW(tt) do{ if((tt)+3<NT){WAIT_BAR(2);} else if((tt)+2<NT){WAIT_BAR(1);} else {WAIT_BAR(0);} }while(0)
  for(;t+1<NT;t+=2){
    STEP(pB0,pB1,pA0,pA1,t,(t+3<NT),(t+1<NT),(t+1<NT));       ENDW(t);   RESC(); ROT();
    STEP(pA0,pA1,pB0,pB1,t+1,(t+4<NT),(t+2<NT),(t+2<NT));     ENDW(t+1); RESC(); ROT();
  }
  STEP(pB0,pB1,pA0,pA1,NT-1,false,false,false); RESC();
  { float sacc=pB0[0]+pB0[1]; _Pragma("unroll") for(int r=2;r<16;++r)sacc+=pB0[r]; _Pragma("unroll") for(int r=0;r<16;++r)sacc+=pB1[r]; l_reg+=sacc;
    pw0=(u32x4){PKW(pB0,0),PKW(pB0,2),PKW(pB0,4),PKW(pB0,6)};pw1=(u32x4){PKW(pB0,8),PKW(pB0,10),PKW(pB0,12),PKW(pB0,14)};pw2=(u32x4){PKW(pB1,0),PKW(pB1,2),PKW(pB1,4),PKW(pB1,6)};pw3=(u32x4){PKW(pB1,8),PKW(pB1,10),PKW(pB1,12),PKW(pB1,14)};
    SBAR(); pv(o,vb0+sl_cur,PAF(0),PAF(1),PAF(2),PAF(3)); }
  #undef PKW
  #undef PAF
  #undef VFR
  #undef PIN
  #undef MX3
  #undef GAPA
  #undef GAPB
  #undef EX
  #undef VRD
  #undef KRD
  #undef STEP
  #undef ENDW
  {auto rr=__builtin_amdgcn_permlane32_swap(__float_as_uint(l_reg),__float_as_uint(l_reg),false,false);l_reg=__uint_as_float(rr[0])+__uint_as_float(rr[1]);}
  if(hi==0)wsf[32+r32]=l_reg;asm volatile("s_waitcnt lgkmcnt(0)":::"memory");
  float rli[16];
  #pragma unroll
  for(int r=0;r<16;++r)rli[r]=__builtin_amdgcn_rcpf(wsf[32+crow(r,hi)]);
  { bf16*stg=(bf16*)(shm+LDS_OST)+wid*2048;
    #pragma unroll
    for(int r=0;r<16;++r){const int orow=crow(r,hi);
      #pragma unroll
      for(int d0=0;d0<2;++d0)stg[orow*64+d0*32+r32]=__float2bfloat16(o[d0][r]*rli[r]);}
    asm volatile("s_waitcnt lgkmcnt(0)":::"memory");
    unsigned char*O8w=(unsigned char*)O+(rowbase+q0+wid*QBLK)*DM+h*D;
    _Pragma("unroll") for(int i=0;i<4;++i){const int row=i*8+(lane>>3),ch=lane&7; const u32x4 v=*(const u32x4*)(stg+row*64+ch*8);
      u32x2 w8; w8.x=pg8::pack4_fp8(bflo(v.x)*SC_FOX,bfhi(v.x)*SC_FOX,bflo(v.y)*SC_FOX,bfhi(v.y)*SC_FOX); w8.y=pg8::pack4_fp8(bflo(v.z)*SC_FOX,bfhi(v.z)*SC_FOX,bflo(v.w)*SC_FOX,bfhi(v.w)*SC_FOX);
      *(u32x2*)(O8w+(long)row*DM+ch*8)=w8;} }
  asm volatile("s_waitcnt lgkmcnt(0)\n\ts_barrier":::"memory");
  #undef BIAS
  #undef BIAS_H
  #undef DMA_K
  #undef DMA_V
  #undef CMASK
  #undef START
  #undef RESC
  #undef ROT
}
constexpr int ATTN_LDS_BYTES=LDS_BYTES;
#undef SBAR
#undef WAIT_BAR
}


constexpr int NWAVES = 8;
constexpr int RING_OFF = 0, RING_BYTES = 131072;
constexpr int LDSCTL_OFF = RING_BYTES, MISC_OFF = LDSCTL_OFF + 320, TAB_OFF = LDSCTL_OFF + 1024;
constexpr int WTAB_OFF = LDSCTL_OFF + 2048;
constexpr int LDS_BYTES = 147456;
typedef GAS unsigned gu32;
__device__ __forceinline__ unsigned hw_wave_key() { return (unsigned)__builtin_amdgcn_s_getreg((5 << 11) | 4) & 63u; }
#define RLX_AGENT __ATOMIC_RELAXED, __HIP_MEMORY_SCOPE_AGENT

#define XB_TMO      128
#define XB_XCNT(j)  (256  + 64 * (j))
#define XB_XSUB(j)  (1280 + 64 * (j))
#define XB_XGEN(j)  (2304 + 64 * (j))
#define XB_TOP      3328
#define XB_TOPGEN   3392
#define XCD_BAR_WORDS 3456
#define XB_SPIN_CAP (1u << 18)

__device__ __forceinline__ unsigned xb_ld(unsigned* p)              { return __hip_atomic_load(p, __ATOMIC_RELAXED, __HIP_MEMORY_SCOPE_AGENT); }
__device__ __forceinline__ unsigned xb_add(unsigned* p, unsigned v) { return __hip_atomic_fetch_add(p, v, __ATOMIC_RELAXED, __HIP_MEMORY_SCOPE_AGENT); }
__device__ __forceinline__ unsigned xb_xcc_id() { return (unsigned)__builtin_amdgcn_s_getreg((3 << 11) | 20) & 0xFu; }
#define XB_SPIN(cond, bar) do { unsigned _sp = 0; while (cond) { __builtin_amdgcn_s_sleep(1); \
    if ((++_sp & 255u) == 0u) { if (xb_ld(&(bar)[XB_TMO])) break; if (_sp > XB_SPIN_CAP) { atomicAdd(&(bar)[XB_TMO], 1u); break; } } } } while (0)

struct XcdBarrier {
    unsigned* bar; unsigned x;
    volatile LAS unsigned* st;
};

__device__ __forceinline__ XcdBarrier xcd_barrier_post(unsigned* bar, volatile LAS unsigned* st) {
    XcdBarrier b; b.bar = bar; b.x = xb_xcc_id(); b.st = st;
    if (threadIdx.x == 0) (void)xb_add(&bar[XB_XCNT(b.x)], 1u);
    return b;
}
__device__ __forceinline__ void xcd_barrier_complete(unsigned* bar, unsigned x, unsigned& nloc, unsigned& nx) {
    const unsigned G = gridDim.x * gridDim.y * gridDim.z;
    unsigned sum, cnt, mine, sp = 0u;
    for (;;) {
        sum = 0u; cnt = 0u; mine = 0u;
#pragma unroll
        for (unsigned j = 0; j < 16; ++j) { const unsigned c = xb_ld(&bar[XB_XCNT(j)]); sum += c; cnt += (c > 0u) ? 1u : 0u; mine = (j == x) ? c : mine; }
        if (sum == G) break;
        __builtin_amdgcn_s_sleep(1);
        if ((++sp & 255u) == 0u) { if (xb_ld(&bar[XB_TMO])) break; if (sp > XB_SPIN_CAP) { atomicAdd(&bar[XB_TMO], 1u); break; } }
    }
    nloc = mine > 0u ? mine : 1u; nx = cnt > 0u ? cnt : 1u;
}

__device__ __forceinline__ void xcd_barrier(const XcdBarrier& b) {
    asm volatile("s_waitcnt vmcnt(0)" ::: "memory");
    __syncthreads();
    if (threadIdx.x == 0) {
        unsigned* bar = b.bar;
        __builtin_amdgcn_s_waitcnt(0);
        unsigned nloc = b.st[0], nx = b.st[1];
        if (nloc == 0u) { xcd_barrier_complete(bar, b.x, nloc, nx); b.st[0] = nloc; b.st[1] = nx; }
        const unsigned old = xb_add(&bar[XB_XSUB(b.x)], 1u);
        const unsigned gen = old / nloc;
        if (old + 1u == (gen + 1u) * nloc) {
            __builtin_amdgcn_fence(__ATOMIC_RELEASE, "agent");
            asm volatile("s_waitcnt vmcnt(0)" ::: "memory");
            const unsigned og = xb_add(&bar[XB_TOP], 1u);
            const unsigned tg = og / nx;
            if (og + 1u == (tg + 1u) * nx) xb_add(&bar[XB_TOPGEN], 1u);
            else XB_SPIN(xb_ld(&bar[XB_TOPGEN]) == tg, bar);
            __builtin_amdgcn_fence(__ATOMIC_ACQUIRE, "agent");
            xb_add(&bar[XB_XGEN(b.x)], 1u);
            asm volatile("s_waitcnt vmcnt(0)" ::: "memory");
        } else {
            XB_SPIN(xb_ld(&bar[XB_XGEN(b.x)]) == gen, bar);
            __builtin_amdgcn_fence(__ATOMIC_ACQUIRE, "agent");
            asm volatile("s_waitcnt vmcnt(0)" ::: "memory");
        }
    }
    __syncthreads();
}


struct Args {
    const float *x, *ln_in_g, *ln_in_b, *w_in, *b_in, *w_fox, *lbl, *norm_g, *w_hgrn, *w_mix, *b_mix, *ln1_g, *ln1_b, *router_w, *router_b, *w1, *w3, *w2, *ln2_g, *ln2_b;
    float* out; unsigned char* ws; int ph_lo, ph_hi, use_bar, pad;
};
struct Frame { LAS unsigned char* lds; int tid, lane, wave, G, gw, ngw, bid; };
#define LOAD_ARGS() launder_args(args)
__device__ __forceinline__ Args launder_args(const Args& args) { Args a = args; size_t z_ = 0; asm volatile("" : "+s"(z_)); a.ws = args.ws + z_; return a; }

__device__ __forceinline__ void ln_rows16(f32x4 (&v)[4], const float* g, const float* bta, int lane) {
    float s = 0.f;
#pragma unroll
    for (int j = 0; j < 4; ++j) s += (v[j].x + v[j].y) + (v[j].z + v[j].w);
    const float mean = wave_sum(s) * (1.f / D); float s2 = 0.f;
#pragma unroll
    for (int j = 0; j < 4; ++j) { v[j] = v[j] - mean; s2 += (v[j].x * v[j].x + v[j].y * v[j].y) + (v[j].z * v[j].z + v[j].w * v[j].w); }
    const float rstd = rsqrtf(wave_sum(s2) * (1.f / D) + LN_EPS);
#pragma unroll
    for (int j = 0; j < 4; ++j) { const int c = 4 * lane + 256 * j; const f32x4 gg = *(const f32x4*)(g + c), bb = *(const f32x4*)(bta + c); v[j] = v[j] * rstd * gg + bb; }
}
__device__ __forceinline__ void store_row(const f32x4 (&v)[4], int lane, bf16_t* ores, unsigned char* obf, float* of32b) {
#pragma unroll
    for (int j = 0; j < 4; ++j) { const int c = 4 * lane + 256 * j;
        if (ores) { u32x2 w; w.x = pk2(v[j].x, v[j].y); w.y = pk2(v[j].z, v[j].w); *(u32x2*)(ores + c) = w; }
        if (of32b) *(f32x4*)(of32b + c) = v[j];
        if (obf) *(unsigned*)(obf + c) = pg8::pack4_fp8(v[j].x, v[j].y, v[j].z, v[j].w); }
}

struct CvtDesc { const float* W; int ldw, k0, srccol, nvalid; unsigned char* WT; int dstrow, dstk; };
__device__ __forceinline__ void cvt_load(const CvtDesc& d, f32x4 (&v)[8], int lane) {
    const int ks = lane >> 3, n4 = (lane & 7) * 4;
#pragma unroll
    for (int j = 0; j < 8; ++j) v[j] = (n4 < d.nvalid) ? *(const f32x4*)(d.W + (size_t)(d.k0 + 8 * j + ks) * d.ldw + d.srccol + n4) : (f32x4){0.f, 0.f, 0.f, 0.f};
}
__device__ __forceinline__ void cvt_store(const CvtDesc& d, const f32x4 (&v)[8], LAS float* scr, int lane) {
    const int ks = lane >> 3, n4 = (lane & 7) * 4;
#pragma unroll
    for (int j = 0; j < 8; ++j) { LAS float* p = scr + (8 * j + ks) * 33 + n4; p[0] = v[j][0]; p[1] = v[j][1]; p[2] = v[j][2]; p[3] = v[j][3]; }
    asm volatile("s_waitcnt lgkmcnt(0)" ::: "memory");
    const int c = lane & 7;
#pragma unroll
    for (int j = 0; j < 4; ++j) { const int n = (lane >> 3) + 8 * j; const LAS float* s = scr + (8 * c) * 33 + n;
        u32x2 o; o.x = pg8::pack4_fp8(s[0 * 33] * SC_W, s[1 * 33] * SC_W, s[2 * 33] * SC_W, s[3 * 33] * SC_W); o.y = pg8::pack4_fp8(s[4 * 33] * SC_W, s[5 * 33] * SC_W, s[6 * 33] * SC_W, s[7 * 33] * SC_W);
        *(u32x2*)(d.WT + (size_t)(d.dstrow + n) * 1024 + d.dstk + d.k0 + 8 * c) = o; }
    asm volatile("s_waitcnt lgkmcnt(0)" ::: "memory");
}
__device__ __forceinline__ CvtDesc cvt_decode(const Args& a, int l, int it) {
    unsigned char* WS_ = a.ws + wset(l);
    constexpr int I_IN = 16 * 176, I_BR = 8 * 32, I_MIX = 16 * 32, I_13 = 16 * 64 * NE;
    CvtDesc d; int r = it;
    if (r < I_IN) { const int kb = r / 176, nb = r % 176, n0 = nb * 32;
        const int src = (n0 < 1536) ? n0 : n0 + 8, nv = 32;
        d.W = a.w_in + (size_t)l * D * NIN; d.ldw = NIN; d.k0 = kb * 64; d.srccol = src; d.nvalid = nv; d.WT = WS_ + WO_WIN; d.dstrow = n0; d.dstk = 0; return d; } r -= I_IN;
    if (r < I_BR) { const int kb = r / 32, nb = r % 32; d.W = a.w_fox + (size_t)l * 512 * D; d.ldw = D; d.k0 = kb * 64; d.srccol = nb * 32; d.nvalid = 32; d.WT = WS_ + WO_WBR; d.dstrow = nb * 32; d.dstk = 0; return d; } r -= I_BR;
    if (r < I_BR) { const int kb = r / 32, nb = r % 32; d.W = a.w_hgrn + (size_t)l * 512 * D; d.ldw = D; d.k0 = kb * 64; d.srccol = nb * 32; d.nvalid = 32; d.WT = WS_ + WO_WBR; d.dstrow = nb * 32; d.dstk = 512; return d; } r -= I_BR;
    if (r < I_MIX) { const int kb = r / 32, nb = r % 32; d.W = a.w_mix + (size_t)l * D * D; d.ldw = D; d.k0 = kb * 64; d.srccol = nb * 32; d.nvalid = 32; d.WT = WS_ + WO_WMIX; d.dstrow = nb * 32; d.dstk = 0; return d; } r -= I_MIX;
    if (r < I_13) { const int e = r / 1024, q = r % 1024, kb = q / 64, nb = q % 64, n0 = nb * 32;
        const int j = n0 >> 8, rr = n0 & 255; d.W = (rr < 128 ? a.w1 : a.w3) + ((size_t)l * NE + e) * D * D; d.ldw = D; d.k0 = kb * 64; d.srccol = 128 * j + (rr & 127); d.nvalid = 32;
        d.WT = WS_ + WO_W13 + (size_t)e * 2048 * D; d.dstrow = n0; d.dstk = 0; return d; } r -= I_13;
    { const int e = r / 512, q = r % 512, kb = q / 32, nb = q % 32; d.W = a.w2 + ((size_t)l * NE + e) * D * D; d.ldw = D; d.k0 = kb * 64; d.srccol = nb * 32; d.nvalid = 32;
      d.WT = WS_ + WO_W2 + (size_t)e * D * D; d.dstrow = nb * 32; d.dstk = 0; return d; }
}
__device__ __forceinline__ void convert_layer(const Args& a, const Frame& F, int l, int gw, int ngw) {
    LAS float* scr = (LAS float*)(F.lds + RING_OFF + F.wave * 16384);
    const int lane = F.lane;
    constexpr int NITEMS = 16 * 176 + 2 * 8 * 32 + 16 * 32 + 16 * 64 * NE + 16 * 32 * NE;
    for (int it = gw; it < NITEMS; it += 2 * ngw) {
        const CvtDesc d0 = cvt_decode(a, l, it); f32x4 v0[8]; cvt_load(d0, v0, lane);
        const bool two = it + ngw < NITEMS;
        if (two) { const CvtDesc d1 = cvt_decode(a, l, it + ngw); f32x4 v1[8]; cvt_load(d1, v1, lane); cvt_store(d0, v0, scr, lane); cvt_store(d1, v1, scr, lane); }
        else cvt_store(d0, v0, scr, lane);
    }
    float* biasp = (float*)(a.ws + biasoff(l));
    for (int n = gw * 64 + lane; n < NINP; n += ngw * 64) {
        biasp[n] = (n < 1536) ? a.b_in[l * NIN + n] : a.b_in[l * NIN + n + 8]; }
}


constexpr int WFF_OFF = 65536 + 16384;
__device__ __forceinline__ void load_wff(const Args& a, const Frame& F, int l) {
    LAS float* wff = (LAS float*)(F.lds + RING_OFF + WFF_OFF);
    for (int i = F.tid; i < 8 * D; i += NWAVES * 64) { const int c = i >> 3, h = i & 7; wff[h * D + c] = a.w_in[((size_t)l * D + c) * NIN + 1536 + h]; }
}
__device__ __forceinline__ void fox_gates_row(const Args& a, const Frame& F, int l, const f32x4 (&v)[4], int row) {
    const LAS float* wff = (const LAS float*)(F.lds + RING_OFF + WFF_OFF); const int lane = F.lane;
    float p[8];
#pragma unroll
    for (int h = 0; h < 8; ++h) { float s = 0.f;
#pragma unroll
        for (int j = 0; j < 4; ++j) { const f32x4 r4 = *(const LAS f32x4*)(wff + h * D + 4 * lane + 256 * j); s += v[j].x * r4.x + v[j].y * r4.y + v[j].z * r4.z + v[j].w * r4.w; }
        p[h] = s; }
    const bool hi5 = (lane & 32) != 0;
#pragma unroll
    for (int k = 0; k < 4; ++k) { const float snd = hi5 ? p[k] : p[k + 4]; const float rcv = __shfl_xor(snd, 32); p[k] = (hi5 ? p[k + 4] : p[k]) + rcv; }
    const bool hi4 = (lane & 16) != 0;
#pragma unroll
    for (int k = 0; k < 2; ++k) { const float snd = hi4 ? p[k] : p[k + 2]; const float rcv = __shfl_xor(snd, 16); p[k] = (hi4 ? p[k + 2] : p[k]) + rcv; }
    const bool hi3 = (lane & 8) != 0;
    { const float snd = hi3 ? p[0] : p[1]; const float rcv = __shfl_xor(snd, 8); p[0] = (hi3 ? p[1] : p[0]) + rcv; }
    p[0] += __shfl_xor(p[0], 4); p[0] += __shfl_xor(p[0], 2); p[0] += __shfl_xor(p[0], 1);
    if ((lane & 7) == 0) { const int h = lane >> 3; ((float*)(a.ws + WS_FL))[(size_t)row * 8 + h] = logsigmoidf_(p[0] + a.b_in[l * NIN + 1536 + h]); }
}

__device__ __forceinline__ void phase_prep(const Args& a, const Frame& F) {
    if (F.bid == 0) {
        float* lb_all = (float*)(a.ws + WS_MISC);
        const int c = F.tid;
        float v[DEPTH], m = -1e30f;
#pragma unroll
        for (int l = 0; l < DEPTH; ++l) { v[l] = a.lbl[l * 512 + c]; m = fmaxf(m, v[l]); }
        float s = 0.f;
#pragma unroll
        for (int l = 0; l < DEPTH; ++l) { v[l] = __expf(v[l] - m); s += v[l]; }
        float cum = 0.f;
#pragma unroll
        for (int l = 0; l < DEPTH; ++l) { const float p = v[l] / s; cum += p; lb_all[l * 512 + c] = cum - v[0] / s; }
    }
    bf16_t* XRES = (bf16_t*)(a.ws + WS_XRES); unsigned char* XN = a.ws + WS_XN;
    load_wff(a, F, 0); __syncthreads();
    for (int row = F.gw; row < T; row += F.ngw) {
        f32x4 v[4];
#pragma unroll
        for (int j = 0; j < 4; ++j) v[j] = *(const f32x4*)(a.x + (size_t)row * D + 4 * F.lane + 256 * j);
        ln_rows16(v, a.ln_in_g, a.ln_in_b, F.lane);
        store_row(v, F.lane, XRES + (size_t)row * D, XN + (size_t)row * D, nullptr);
        fox_gates_row(a, F, 0, v, row);
    }
    __syncthreads();
    convert_layer(a, F, 0, F.gw, F.ngw);
}

__device__ __forceinline__ void phase_fscan(const Args& a, const Frame& F) {
    if (F.bid >= BATCH * NH) return;
    const float* FL = (const float*)(a.ws + WS_FL); float* F2 = (float*)(a.ws + WS_F2);
    LAS float* wsum = (LAS float*)(F.lds + RING_OFF);
    const int bh = F.bid, b = bh >> 3, h = bh & 7, tid = F.tid, lane = F.lane, w = F.wave;
    float v[4], run = 0.f;
#pragma unroll
    for (int i = 0; i < 4; ++i) { run += FL[((size_t)b * SEQ + tid * 4 + i) * 8 + h]; v[i] = run; }
    float incl = run;
#pragma unroll
    for (int o = 1; o < 64; o <<= 1) { const float u = __shfl_up(incl, o); if (lane >= o) incl += u; }
    if (lane == 63) wsum[w] = incl;
    __syncthreads();
    float base = incl - run; for (int i = 0; i < w; ++i) base += wsum[i];
#pragma unroll
    for (int i = 0; i < 4; ++i) F2[(size_t)bh * SEQ + tid * 4 + i] = (base + v[i]) * LOG2E;
    __syncthreads();
}

__device__ __forceinline__ void phase_attn_naive(const Args& a, const Frame& F) {
    const bf16_t* QO = (const bf16_t*)(a.ws + WS_QO); const bf16_t* KV = (const bf16_t*)(a.ws + WS_KV); const float* F2 = (const float*)(a.ws + WS_F2); bf16_t* O = (bf16_t*)(a.ws + WS_QO);
    LAS float* ps = (LAS float*)(F.lds + RING_OFF) + F.wave * 64;
    const int lane = F.lane;
    for (int gid = F.gw; gid < BATCH * NH * SEQ; gid += F.ngw) {
        const int bh = gid & 127, t = gid >> 7, b = bh >> 3, h = bh & 7;
        float q[64];
        { const bf16_t* qp = QO + ((size_t)b * SEQ + t) * 1024 + h * 64;
#pragma unroll
          for (int c = 0; c < 8; ++c) { const u32x4 u = *(const u32x4*)(qp + c * 8);
            q[c * 8 + 0] = bflo(u.x); q[c * 8 + 1] = bfhi(u.x); q[c * 8 + 2] = bflo(u.y); q[c * 8 + 3] = bfhi(u.y);
            q[c * 8 + 4] = bflo(u.z); q[c * 8 + 5] = bfhi(u.z); q[c * 8 + 6] = bflo(u.w); q[c * 8 + 7] = bfhi(u.w); } }
        float m = -1e30f, l = 0.f, o = 0.f;
        const float* f2 = F2 + (size_t)bh * SEQ;
        for (int s0 = 0; s0 <= t; s0 += 64) {
            const int s = s0 + lane; const bool valid = s <= t;
            float sc = -1e30f;
            if (valid) { const bf16_t* kp = KV + ((size_t)b * SEQ + s) * 1024 + h * 64; float d = 0.f;
#pragma unroll
                for (int c = 0; c < 8; ++c) { const u32x4 u = *(const u32x4*)(kp + c * 8);
                    d += q[c * 8 + 0] * bflo(u.x) + q[c * 8 + 1] * bfhi(u.x) + q[c * 8 + 2] * bflo(u.y) + q[c * 8 + 3] * bfhi(u.y)
                       + q[c * 8 + 4] * bflo(u.z) + q[c * 8 + 5] * bfhi(u.z) + q[c * 8 + 6] * bflo(u.w) + q[c * 8 + 7] * bfhi(u.w); }
                sc = d - f2[s]; }
            const float mn = fmaxf(m, wave_max(sc));
            const float p = valid ? exp2f(sc - mn) : 0.f;
            const float f = exp2f(m - mn);
            l = l * f + wave_sum(p); o *= f; m = mn;
            ps[lane] = p;
            asm volatile("s_waitcnt lgkmcnt(0)" ::: "memory");
            const int nk = min(64, t - s0 + 1);
            const bf16_t* vp = KV + ((size_t)b * SEQ + s0) * 1024 + 512 + h * 64 + lane;
            for (int j = 0; j < nk; ++j) o += ps[j] * bf2f(vp[(size_t)j * 1024]);
            asm volatile("s_waitcnt lgkmcnt(0)" ::: "memory");
        }
        O[((size_t)b * SEQ + t) * 1024 + h * 64 + lane] = (bf16_t)f2bf(o / l);
    }
}

__device__ __forceinline__ void phase_hgrn_naive(const Args& a, const Frame& F, int l) {
    if (F.bid >= BATCH * NH || F.wave != 0) return;
    const bf16_t* HB = (const bf16_t*)(a.ws + WS_HB); const float* LOGF = (const float*)(a.ws + WS_LOGF); const bf16_t* HG = (const bf16_t*)(a.ws + WS_HG); bf16_t* O = (bf16_t*)(a.ws + WS_QO);
    LAS float* Lf = (LAS float*)(F.lds + RING_OFF + 1024); LAS float* Lk = Lf + 4096; LAS float* Lq = Lk + 4096;
    const int bh = F.bid, b = bh >> 3, h = bh & 7, lane = F.lane;
    float Sx[64];
#pragma unroll
    for (int d = 0; d < 64; ++d) Sx[d] = 0.f;
    const float ng = a.norm_g[l * 512 + h * 64 + lane];
    for (int c0 = 0; c0 < SEQ; c0 += 64) {
        for (int tt = 0; tt < 64; ++tt) { const size_t row = (size_t)b * SEQ + c0 + tt;
            const float lf = LOGF[row * 512 + h * 64 + lane]; const float f = __expf(lf);
            Lf[tt * 64 + lane] = f; Lk[tt * 64 + lane] = 1.f - f; Lq[tt * 64 + lane] = bf2f(HB[row * 1024 + h * 64 + lane]); }
        asm volatile("s_waitcnt lgkmcnt(0)" ::: "memory");
        for (int tt = 0; tt < 64; ++tt) { const size_t row = (size_t)b * SEQ + c0 + tt;
            const float v = bf2f(HB[row * 1024 + 512 + h * 64 + lane]);
            float o = 0.f;
#pragma unroll
            for (int d = 0; d < 64; d += 4) { const f32x4 f4 = *(const LAS f32x4*)(Lf + tt * 64 + d), k4 = *(const LAS f32x4*)(Lk + tt * 64 + d), q4 = *(const LAS f32x4*)(Lq + tt * 64 + d);
                Sx[d] = f4.x * Sx[d] + k4.x * v; o += Sx[d] * q4.x; Sx[d + 1] = f4.y * Sx[d + 1] + k4.y * v; o += Sx[d + 1] * q4.y;
                Sx[d + 2] = f4.z * Sx[d + 2] + k4.z * v; o += Sx[d + 2] * q4.z; Sx[d + 3] = f4.w * Sx[d + 3] + k4.w * v; o += Sx[d + 3] * q4.w; }
            const float ss = wave_sum(o * o);
            const float r = o * rsqrtf(ss * (1.f / 64.f) + RMS_EPS) * ng * bf2f(HG[row * 512 + h * 64 + lane]);
            O[row * 1024 + 512 + h * 64 + lane] = (bf16_t)f2bf(r); }
        asm volatile("s_waitcnt lgkmcnt(0)" ::: "memory");
    }
}

constexpr int LN1_RW = 0, LN1_LG = 65536, LN1_ASG = LN1_LG + 8 * 16 * 16 * 4, LN1_BASE = LN1_ASG + 128 * 16;
__device__ __forceinline__ void phase_ln1_router(const Args& a, const Frame& F, int l) {
    const bf16_t* xres = (const bf16_t*)(a.ws + WS_XRES); bf16_t* x1 = (bf16_t*)(a.ws + WS_X1B); const unsigned char* mixed = a.ws + WS_MIXED;   unsigned char* xn = a.ws + WS_XN;
    unsigned* cnt = (unsigned*)(a.ws + WS_CTL) + CW_CNT + l * 64; int* list = (int*)(a.ws + WS_LIST); unsigned* tokinfo = (unsigned*)(a.ws + WS_TOK);
    const float* g = a.ln1_g + l * D; const float* bta = a.ln1_b + l * D;
    LAS float* rw = (LAS float*)(F.lds + RING_OFF + LN1_RW);
    LAS float* lgs = (LAS float*)(F.lds + RING_OFF + LN1_LG) + F.wave * 256;
    LAS u32x4* asg = (LAS u32x4*)(F.lds + RING_OFF + LN1_ASG);
    LAS unsigned* basep = (LAS unsigned*)(F.lds + RING_OFF + LN1_BASE);
    for (int i = F.tid; i < NE * D; i += NWAVES * 64) { const int c = i >> 4, e = i & 15; rw[e * D + c] = a.router_w[i]; }
    __syncthreads();
    const int lane = F.lane;
    for (int blk = F.bid; blk < T / 128; blk += F.G) {
        const int R0 = blk * 128 + F.wave * 16;
        u32x2 nx[4]; unsigned nm[4];
#pragma unroll
        for (int j = 0; j < 4; ++j) { const int c = 4 * lane + 256 * j; nx[j] = *(const u32x2*)(xres + (size_t)R0 * D + c); nm[j] = *(const unsigned*)(mixed + (size_t)R0 * D + c); }
        for (int i = 0; i < 16; ++i) { const int row = R0 + i;
            f32x4 v[4];
#pragma unroll
            for (int j = 0; j < 4; ++j) { const u32x2 xv = nx[j]; const f32x2 m01 = __builtin_amdgcn_cvt_pk_f32_fp8((int)nm[j], false), m23 = __builtin_amdgcn_cvt_pk_f32_fp8((int)nm[j], true);
                v[j].x = ALPHA * bflo(xv.x) + m01[0] * (1.f / SC_MIX); v[j].y = ALPHA * bfhi(xv.x) + m01[1] * (1.f / SC_MIX); v[j].z = ALPHA * bflo(xv.y) + m23[0] * (1.f / SC_MIX); v[j].w = ALPHA * bfhi(xv.y) + m23[1] * (1.f / SC_MIX); }
            { const int rn = (i < 15) ? row + 1 : row;
#pragma unroll
              for (int j = 0; j < 4; ++j) { const int c = 4 * lane + 256 * j; nx[j] = *(const u32x2*)(xres + (size_t)rn * D + c); nm[j] = *(const unsigned*)(mixed + (size_t)rn * D + c); } }
            ln_rows16(v, g, bta, lane);
            store_row(v, lane, x1 + (size_t)row * D, xn + (size_t)row * D, nullptr);
            float p[NE];
#pragma unroll
            for (int e = 0; e < NE; ++e) { float s = 0.f;
#pragma unroll
                for (int j = 0; j < 4; ++j) { const f32x4 r4 = *(const LAS f32x4*)(rw + e * D + 4 * lane + 256 * j); s += v[j].x * r4.x + v[j].y * r4.y + v[j].z * r4.z + v[j].w * r4.w; }
                p[e] = s; asm volatile("" ::: "memory"); }
            { const bool hi5 = (lane & 32) != 0;
#pragma unroll
              for (int k = 0; k < 8; ++k) { const float snd = hi5 ? p[k] : p[k + 8]; const float rcv = __shfl_xor(snd, 32); p[k] = (hi5 ? p[k + 8] : p[k]) + rcv; }
              const bool hi4 = (lane & 16) != 0;
#pragma unroll
              for (int k = 0; k < 4; ++k) { const float snd = hi4 ? p[k] : p[k + 4]; const float rcv = __shfl_xor(snd, 16); p[k] = (hi4 ? p[k + 4] : p[k]) + rcv; }
              const bool hi3 = (lane & 8) != 0;
#pragma unroll
              for (int k = 0; k < 2; ++k) { const float snd = hi3 ? p[k] : p[k + 2]; const float rcv = __shfl_xor(snd, 8); p[k] = (hi3 ? p[k + 2] : p[k]) + rcv; }
              const bool hi2 = (lane & 4) != 0;
              { const float snd = hi2 ? p[0] : p[1]; const float rcv = __shfl_xor(snd, 4); p[0] = (hi2 ? p[1] : p[0]) + rcv; }
              p[0] += __shfl_xor(p[0], 2); p[0] += __shfl_xor(p[0], 1);
              if ((lane & 3) == 0) lgs[i * 16 + (lane >> 2)] = p[0]; }
        }
        asm volatile("s_waitcnt lgkmcnt(0)" ::: "memory");
        if (lane < 16) {
            float lg[NE];
#pragma unroll
            for (int q = 0; q < 4; ++q) { const f32x4 t4 = *(const LAS f32x4*)(lgs + lane * 16 + 4 * q); lg[4 * q] = t4[0] + a.router_b[4 * q]; lg[4 * q + 1] = t4[1] + a.router_b[4 * q + 1]; lg[4 * q + 2] = t4[2] + a.router_b[4 * q + 2]; lg[4 * q + 3] = t4[3] + a.router_b[4 * q + 3]; }
            int gs = 0; float gbest = -3e38f;
#pragma unroll
            for (int gi = 0; gi < 4; ++gi) { const float mx = fmaxf(fmaxf(lg[gi * 4], lg[gi * 4 + 1]), fmaxf(lg[gi * 4 + 2], lg[gi * 4 + 3])); if (mx > gbest) { gbest = mx; gs = gi; } }
            float l4[4];
#pragma unroll
            for (int i = 0; i < 4; ++i) { float t0 = lg[i];
#pragma unroll
                for (int gi = 1; gi < 4; ++gi) t0 = (gs == gi) ? lg[gi * 4 + i] : t0; l4[i] = t0; }
            int i0 = 0; float b0 = l4[0];
#pragma unroll
            for (int i = 1; i < 4; ++i) if (l4[i] > b0) { b0 = l4[i]; i0 = i; }
            int i1 = 0; float b1 = -3e38f;
#pragma unroll
            for (int i = 0; i < 4; ++i) if (i != i0 && l4[i] > b1) { b1 = l4[i]; i1 = i; }
            const float e1 = __expf(b1 - b0); const float g0 = 1.f / (1.f + e1), g1 = e1 / (1.f + e1);
            u32x4 as; as.x = (unsigned)(gs * 4 + i0); as.y = (unsigned)(gs * 4 + i1); as.z = __float_as_uint(g0); as.w = __float_as_uint(g1);
            asg[F.wave * 16 + lane] = as;
        }
        __syncthreads();
        if (F.wave == 0) {
            const u32x4 A0 = asg[lane], A1 = asg[lane + 64];
            const unsigned ex[4] = {A0.x, A0.y, A1.x, A1.y};
            unsigned rank[4] = {0u, 0u, 0u, 0u}, mycount = 0u;
            const unsigned long long lt = (1ull << lane) - 1ull;
#pragma unroll 1
            for (unsigned e = 0; e < NE; ++e) { unsigned run = 0u;
#pragma unroll
                for (int s = 0; s < 4; ++s) { const unsigned long long m = __ballot(ex[s] == e); if (ex[s] == e) rank[s] = run + (unsigned)__popcll(m & lt); run += (unsigned)__popcll(m); }
                if ((unsigned)lane == e) mycount = run; }
            if (lane < NE) basep[lane] = atomicAdd(cnt + lane, mycount);
            asm volatile("s_waitcnt vmcnt(0) lgkmcnt(0)" ::: "memory");
            const unsigned p0 = basep[ex[0]] + rank[0], p1 = basep[ex[1]] + rank[1], p2 = basep[ex[2]] + rank[2], p3 = basep[ex[3]] + rank[3];
            const int ra = blk * 128 + lane, rb = ra + 64;
            list[ex[0] * T + p0] = ra; list[ex[1] * T + p1] = ra; list[ex[2] * T + p2] = rb; list[ex[3] * T + p3] = rb;
            u32x4 ta, tb; ta.x = (ex[0] << 24) | p0; ta.y = (ex[1] << 24) | p1; ta.z = A0.z; ta.w = A0.w; tb.x = (ex[2] << 24) | p2; tb.y = (ex[3] << 24) | p3; tb.z = A1.z; tb.w = A1.w;
            *(u32x4*)(tokinfo + (size_t)ra * 4) = ta; *(u32x4*)(tokinfo + (size_t)rb * 4) = tb;
        }
        __syncthreads();
    }
}

__device__ __forceinline__ void moe_table(const Args& a, const Frame& F, int l) {
    LAS int* tab = (LAS int*)(F.lds + TAB_OFF);
    const unsigned* cnt = (const unsigned*)(a.ws + WS_CTL) + CW_CNT + l * 64;
    if (F.tid == 0) { int ts = 0; for (int e = 0; e < NE; ++e) { const int c = (int)__hip_atomic_load(cnt + e, RLX_AGENT); tab[e] = ts; tab[NE + 1 + e] = c; ts += (c + TM - 1) / TM; } tab[NE] = ts; }
    __syncthreads();
}

__device__ __forceinline__ void phase_combine_ln2(const Args& a, const Frame& F, int l) {
    bf16_t* xres = (bf16_t*)(a.ws + WS_XRES); const bf16_t* x1 = (const bf16_t*)(a.ws + WS_X1B); const unsigned char* Y = a.ws + WS_Y;   const unsigned* tokinfo = (const unsigned*)(a.ws + WS_TOK); unsigned char* xn = a.ws + WS_XN;
    const float* g = a.ln2_g + l * D; const float* bta = a.ln2_b + l * D; float* out = (l == DEPTH - 1) ? a.out : nullptr;
    const LAS int* tab = (const LAS int*)(F.lds + TAB_OFF);
    const int lane = F.lane;
    for (int row = F.gw; row < T; row += F.ngw) {
        const unsigned i0 = tokinfo[row * 4], i1 = tokinfo[row * 4 + 1]; const float g0 = __uint_as_float(tokinfo[row * 4 + 2]), g1 = __uint_as_float(tokinfo[row * 4 + 3]);
        const size_t s0 = (size_t)tab[i0 >> 24] * TM + (i0 & 0xffffff), s1 = (size_t)tab[i1 >> 24] * TM + (i1 & 0xffffff);
        f32x4 v[4];
#pragma unroll
        for (int j = 0; j < 4; ++j) { const int c = 4 * lane + 256 * j; const u32x2 xw = *(const u32x2*)(x1 + (size_t)row * D + c); const f32x4 xv = {bflo(xw.x), bfhi(xw.x), bflo(xw.y), bfhi(xw.y)};
            const unsigned ya = *(const unsigned*)(Y + s0 * D + c), yb = *(const unsigned*)(Y + s1 * D + c);
            const f32x2 a01 = __builtin_amdgcn_cvt_pk_f32_fp8((int)ya, false), a23 = __builtin_amdgcn_cvt_pk_f32_fp8((int)ya, true), b01 = __builtin_amdgcn_cvt_pk_f32_fp8((int)yb, false), b23 = __builtin_amdgcn_cvt_pk_f32_fp8((int)yb, true);
            const float h0 = g0 * (1.f / SC_Y), h1 = g1 * (1.f / SC_Y);
            v[j].x = ALPHA * xv.x + h0 * a01[0] + h1 * b01[0]; v[j].y = ALPHA * xv.y + h0 * a01[1] + h1 * b01[1];
            v[j].z = ALPHA * xv.z + h0 * a23[0] + h1 * b23[0]; v[j].w = ALPHA * xv.w + h0 * a23[1] + h1 * b23[1]; }
        ln_rows16(v, g, bta, lane);
        store_row(v, lane, xres + (size_t)row * D, xn + (size_t)row * D, out ? out + (size_t)row * D : nullptr);
        if (l + 1 < DEPTH) fox_gates_row(a, F, l + 1, v, row);
    }
}


constexpr int ATT_F2_OFF = 86016;
__device__ __forceinline__ void phase_attn(const Args& a, const Frame& F, char* lds_generic) {
    const int c = F.bid, vcu = (F.G % 8 == 0) ? (c % 8) * (F.G / 8) + c / 8 : c;
    const attn_body::bf16* Q = (const attn_body::bf16*)(a.ws + WS_QO); const attn_body::bf16* K = (const attn_body::bf16*)(a.ws + WS_KV); const attn_body::bf16* V = K + 512;
    attn_body::bf16* O = (attn_body::bf16*)(a.ws + WS_OX8);
    const float* FL = (const float*)(a.ws + WS_FL);
    LAS float* f2 = (LAS float*)(F.lds + ATT_F2_OFF); LAS float* wsum = f2 + 2048;
    { const int bh = vcu >> 1; if (bh >= BATCH * NH) return;
        const int b = bh >> 3, h = bh & 7, tid = F.tid, lane = F.lane, w = F.wave;
        float v[4], run = 0.f;
#pragma unroll
        for (int i = 0; i < 4; ++i) { run += FL[((size_t)b * SEQ + tid * 4 + i) * 8 + h]; v[i] = run; }
        float incl = run;
#pragma unroll
        for (int o = 1; o < 64; o <<= 1) { const float u = __shfl_up(incl, o); if (lane >= o) incl += u; }
        if (lane == 63) wsum[w] = incl;
        __syncthreads();
        float base = incl - run; for (int i = 0; i < w; ++i) base += wsum[i];
        f32x4 o4; o4[0] = (base + v[0]) * LOG2E; o4[1] = (base + v[1]) * LOG2E; o4[2] = (base + v[2]) * LOG2E; o4[3] = (base + v[3]) * LOG2E;
        *(LAS f32x4*)(f2 + tid * 4) = o4;
        __syncthreads();
        const int nun = (vcu & 1) ? 6 : 2;
        for (int i = 0; i < nun; ++i) { const int qb = (vcu & 1) ? ((i < 4) ? 6 - i : 5 - i) : ((i == 0) ? 7 : 2);
            int tid_u = F.tid; asm volatile("" : "+v"(tid_u));
            attn_body::attn_unit<40>(b, h, qb, Q, K, V, O, lds_generic + RING_OFF, f2, tid_u); }
        __syncthreads();
    }
}

namespace hg {
constexpr int PB = 144;
constexpr int O_QS = 0, O_KS = 9216, O_QI = 18432, O_KUT = 27648, O_VT = 36864, O_P = 46080, O_ST = 55296, O_TOT = 64512, O_EBL = 66560, O_RED = 66816, BYTES = 67328;
__device__ __forceinline__ float ex(float v) { return __builtin_amdgcn_exp2f(v * LOG2E); }
__device__ __forceinline__ unsigned short bf1(float v) { return (unsigned short)f2bf(v); }
}
__device__ __forceinline__ void phase_hgrn(const Args& a, const Frame& F, int l, int bh) {
    using namespace hg;
    const bf16_t* HB = (const bf16_t*)(a.ws + WS_HB); const float* LOGF = (const float*)(a.ws + WS_LOGF); const bf16_t* HG = (const bf16_t*)(a.ws + WS_HG); unsigned char* O8 = a.ws + WS_OX8;
    LAS unsigned char* L = F.lds + RING_OFF;
    const int b = bh >> 3, h = bh & 7, lane = F.lane, w = F.wave, tid = F.tid;
    const int fr = lane & 15, fq = lane >> 4;
    const int tr = w >> 1, tc0 = 2 * (w & 1);
    const float ng0 = a.norm_g[l * 512 + h * 64 + 16 * tc0 + fr], ng1 = a.norm_g[l * 512 + h * 64 + 16 * (tc0 + 1) + fr];
    f32x4 S0 = {0.f, 0.f, 0.f, 0.f}, S1 = {0.f, 0.f, 0.f, 0.f};
    for (int i = tid; i < 9216 / 4; i += NWAVES * 64) ((LAS unsigned*)(L + O_ST))[i] = 0u;
    const size_t rowbase = (size_t)b * SEQ;
    float g[8]; unsigned short qv[8], vv[8];
#pragma unroll
    for (int i = 0; i < 8; ++i) { const size_t row = rowbase + 8 * w + i; g[i] = LOGF[row * 512 + h * 64 + lane]; qv[i] = HB[row * 1024 + h * 64 + lane]; vv[i] = HB[row * 1024 + 512 + h * 64 + lane]; }
    for (int c0 = 0; c0 < SEQ; c0 += 64) {
        float bc[8]; { float run = 0.f;
#pragma unroll
            for (int i = 0; i < 8; ++i) { run += g[i]; bc[i] = run; } }
        ((LAS float*)(L + O_TOT))[w * 64 + lane] = bc[7];
        float qf[8], kf[8];
#pragma unroll
        for (int i = 0; i < 8; ++i) { qf[i] = bf2f(qv[i]); kf[i] = 1.f - ex(g[i]); }
        { u32x4 pk; pk.x = (unsigned)vv[0] | ((unsigned)vv[1] << 16); pk.y = (unsigned)vv[2] | ((unsigned)vv[3] << 16); pk.z = (unsigned)vv[4] | ((unsigned)vv[5] << 16); pk.w = (unsigned)vv[6] | ((unsigned)vv[7] << 16);
          *(LAS u32x4*)(L + O_VT + lane * PB + 16 * w) = pk; }
        __syncthreads();
        float base = 0.f, bm = 0.f, bl = 0.f;
#pragma unroll
        for (int ww = 0; ww < 8; ++ww) { const float tv = ((LAS float*)(L + O_TOT))[ww * 64 + lane]; if (ww < w) base += tv; if (ww < 4) bm += tv; bl += tv; }
        const float ebm = ex(bm), eblm = ex(bl - bm);
        if (w == 0) ((LAS float*)(L + O_EBL))[lane] = ex(bl);
        unsigned short ku[8];
#pragma unroll
        for (int i = 0; i < 8; ++i) { const float x = bc[i] + base - bm; const float e1 = ex(fminf(x, 80.f)), e2 = ex(fminf(-x, 80.f));
            const float qs = qf[i] * e1, ks = kf[i] * e2; const int r = 8 * w + i;
            *(LAS unsigned short*)(L + O_QS + r * PB + 2 * lane) = bf1(qs); *(LAS unsigned short*)(L + O_QI + r * PB + 2 * lane) = bf1(qs * ebm);
            *(LAS unsigned short*)(L + O_KS + r * PB + 2 * lane) = bf1(ks); ku[i] = bf1(ks * eblm); }
        { u32x4 pk; pk.x = (unsigned)ku[0] | ((unsigned)ku[1] << 16); pk.y = (unsigned)ku[2] | ((unsigned)ku[3] << 16); pk.z = (unsigned)ku[4] | ((unsigned)ku[5] << 16); pk.w = (unsigned)ku[6] | ((unsigned)ku[7] << 16);
          *(LAS u32x4*)(L + O_KUT + lane * PB + 16 * w) = pk; }
        if (c0 + 64 < SEQ) {
#pragma unroll
            for (int i = 0; i < 8; ++i) { const size_t row = rowbase + c0 + 64 + 8 * w + i; g[i] = LOGF[row * 512 + h * 64 + lane]; qv[i] = HB[row * 1024 + h * 64 + lane]; vv[i] = HB[row * 1024 + 512 + h * 64 + lane]; }
        }
        __syncthreads();
#pragma unroll
        for (int k2 = 0; k2 < 2; ++k2) { const int idx = 2 * w + k2, ti = idx >> 2, sj = idx & 3;
            f32x4 sc = {0.f, 0.f, 0.f, 0.f};
            if (sj <= ti) {
#pragma unroll
                for (int kk = 0; kk < 2; ++kk) { const bf16x8 af = *(const LAS bf16x8*)(L + O_QS + (16 * ti + fr) * PB + (32 * kk + 8 * fq) * 2), bfr = *(const LAS bf16x8*)(L + O_KS + (16 * sj + fr) * PB + (32 * kk + 8 * fq) * 2);
                    sc = __builtin_amdgcn_mfma_f32_16x16x32_bf16(af, bfr, sc, 0, 0, 0); }
            }
#pragma unroll
            for (int j = 0; j < 4; ++j) { const int t = 16 * ti + 4 * fq + j, s = 16 * sj + fr; *(LAS unsigned short*)(L + O_P + t * PB + 2 * s) = bf1(s <= t ? sc[j] : 0.f); }
        }
        __syncthreads();
        f32x4 o0 = {0.f, 0.f, 0.f, 0.f}, o1 = {0.f, 0.f, 0.f, 0.f}, u0 = {0.f, 0.f, 0.f, 0.f}, u1 = {0.f, 0.f, 0.f, 0.f};
#pragma unroll
        for (int kk = 0; kk < 2; ++kk) { const int ko = (32 * kk + 8 * fq) * 2;
            const bf16x8 pa = *(const LAS bf16x8*)(L + O_P + (16 * tr + fr) * PB + ko), qa = *(const LAS bf16x8*)(L + O_QI + (16 * tr + fr) * PB + ko), ka = *(const LAS bf16x8*)(L + O_KUT + (16 * tr + fr) * PB + ko);
            const bf16x8 v0 = *(const LAS bf16x8*)(L + O_VT + (16 * tc0 + fr) * PB + ko), v1 = *(const LAS bf16x8*)(L + O_VT + (16 * (tc0 + 1) + fr) * PB + ko);
            const bf16x8 s0 = *(const LAS bf16x8*)(L + O_ST + (16 * tc0 + fr) * PB + ko), s1 = *(const LAS bf16x8*)(L + O_ST + (16 * (tc0 + 1) + fr) * PB + ko);
            o0 = __builtin_amdgcn_mfma_f32_16x16x32_bf16(pa, v0, o0, 0, 0, 0); o1 = __builtin_amdgcn_mfma_f32_16x16x32_bf16(pa, v1, o1, 0, 0, 0);
            o0 = __builtin_amdgcn_mfma_f32_16x16x32_bf16(qa, s0, o0, 0, 0, 0); o1 = __builtin_amdgcn_mfma_f32_16x16x32_bf16(qa, s1, o1, 0, 0, 0);
            u0 = __builtin_amdgcn_mfma_f32_16x16x32_bf16(ka, v0, u0, 0, 0, 0); u1 = __builtin_amdgcn_mfma_f32_16x16x32_bf16(ka, v1, u1, 0, 0, 0); }
        { const f32x4 dec = *(const LAS f32x4*)(L + O_EBL + (16 * tr + 4 * fq) * 4); S0 = S0 * dec + u0; S1 = S1 * dec + u1; }
        { f32x4 q2 = o0 * o0 + o1 * o1;
#pragma unroll
          for (int m = 1; m < 16; m <<= 1) { q2[0] += __shfl_xor(q2[0], m); q2[1] += __shfl_xor(q2[1], m); q2[2] += __shfl_xor(q2[2], m); q2[3] += __shfl_xor(q2[3], m); }
          if (fr == 0) {
#pragma unroll
              for (int j = 0; j < 4; ++j) ((LAS float*)(L + O_RED))[(16 * tr + 4 * fq + j) * 2 + (w & 1)] = q2[j]; } }
        __syncthreads();
        { u32x2 p0, p1; p0.x = pk2(S0[0], S0[1]); p0.y = pk2(S0[2], S0[3]); p1.x = pk2(S1[0], S1[1]); p1.y = pk2(S1[2], S1[3]);
          *(LAS u32x2*)(L + O_ST + (16 * tc0 + fr) * PB + (16 * tr + 4 * fq) * 2) = p0; *(LAS u32x2*)(L + O_ST + (16 * (tc0 + 1) + fr) * PB + (16 * tr + 4 * fq) * 2) = p1; }
#pragma unroll
        for (int j = 0; j < 4; ++j) { const int t = 16 * tr + 4 * fq + j; const f32x2 rr = *(const LAS f32x2*)(L + O_RED + t * 8); const float rs = rsqrtf((rr[0] + rr[1]) * (1.f / 64.f) + RMS_EPS);
            *(LAS unsigned short*)(L + O_P + t * PB + 2 * (16 * tc0 + fr)) = bf1(o0[j] * rs * ng0); *(LAS unsigned short*)(L + O_P + t * PB + 2 * (16 * (tc0 + 1) + fr)) = bf1(o1[j] * rs * ng1); }
        __syncthreads();
        { const int t = tid >> 3, e8 = (tid & 7) * 8; const size_t row = rowbase + c0 + t;
          const u32x4 ov = *(const LAS u32x4*)(L + O_P + t * PB + e8 * 2), gv = *(const u32x4*)(HG + row * 512 + h * 64 + e8);
          u32x2 r; r.x = pg8::pack4_fp8(bflo(ov.x) * bflo(gv.x) * SC_HGRN, bfhi(ov.x) * bfhi(gv.x) * SC_HGRN, bflo(ov.y) * bflo(gv.y) * SC_HGRN, bfhi(ov.y) * bfhi(gv.y) * SC_HGRN);
          r.y = pg8::pack4_fp8(bflo(ov.z) * bflo(gv.z) * SC_HGRN, bfhi(ov.z) * bfhi(gv.z) * SC_HGRN, bflo(ov.w) * bflo(gv.w) * SC_HGRN, bfhi(ov.w) * bfhi(gv.w) * SC_HGRN);
          *(u32x2*)(O8 + row * 1024 + 512 + h * 64 + e8) = r; }
        __syncthreads();
    }
}


constexpr int PH_PER_LAYER = 10, N_PHASES = 1 + DEPTH * PH_PER_LAYER;
#ifndef MK_ONE_LAUNCH
#define MK_ONE_LAUNCH 1
#endif
#ifndef MK_FAST_ATTN
#define MK_FAST_ATTN 0
#endif
#ifndef MK_FAST_HGRN
#define MK_FAST_HGRN 0
#endif


#ifdef DBG_DUMP
#ifndef DBG_WHAT
#define DBG_WHAT 0
#endif
__device__ __forceinline__ void dbg_dump(const Args& a, const Frame& F) {
    unsigned char* ws = a.ws;
    const bf16_t *QO = (bf16_t*)(ws + WS_QO), *KV = (bf16_t*)(ws + WS_KV), *HB = (bf16_t*)(ws + WS_HB), *HG = (bf16_t*)(ws + WS_HG), *G = (bf16_t*)(ws + WS_G);
    const bf16_t *U1 = (bf16_t*)(ws + WS_U1), *U = (bf16_t*)(ws + WS_U), *MIXED = (bf16_t*)(ws + WS_MIXED), *XN = (bf16_t*)(ws + WS_XN);
    const float *LOGF = (float*)(ws + WS_LOGF), *FL = (float*)(ws + WS_FL), *XRES = (float*)(ws + WS_XRES);
    for (size_t i = (size_t)F.bid * 512 + F.tid; i < (size_t)T * D; i += (size_t)gridDim.x * 512) {
        const size_t row = i >> 10; const int c = (int)(i & 1023);
        float v = 0.f;
        if (DBG_WHAT == 9) { v = bf2f(G[row * 2048 + c]) + bf2f(G[row * 2048 + 1024 + c]); }
        else if (DBG_DUMP == 1) { v = bf2f(KV[i]) + bf2f(HB[i]) + bf2f(G[row * 2048 + c]) + bf2f(G[row * 2048 + 1024 + c]);
            if (c < 512) v += LOGF[row * 512 + c] + bf2f(HG[row * 512 + c]) + bf2f(QO[i]); if (c < 8) v += FL[row * 8 + c]; }
        else if (DBG_DUMP == 2) { v = (c >= 512) ? bf2f(QO[i]) : 0.f; }
        else if (DBG_DUMP == 3) { v = bf2f(QO[i]); }
        else if (DBG_DUMP == 4) { v = bf2f(U1[i]); }
        else if (DBG_DUMP == 5) { v = bf2f(U[i]); }
        else if (DBG_DUMP == 6) { v = bf2f(MIXED[i]); }
        else if (DBG_DUMP == 7) { v = XRES[i] + bf2f(XN[i]); }
        a.out[i] = v;
    }
}
#endif
#define PH_BEGIN const Args a = LOAD_ARGS(); Frame F; F.lds = lds0; F.lane = (int)__builtin_amdgcn_mbcnt_hi(~0u, __builtin_amdgcn_mbcnt_lo(~0u, 0u)); asm volatile("" : "+v"(F.lane)); F.wave = __builtin_amdgcn_readfirstlane((int)((const volatile LAS unsigned*)(lds0 + WTAB_OFF))[hw_wave_key()]); F.tid = F.wave * 64 + F.lane; \
    F.G = gridDim.x; F.bid = blockIdx.x; asm volatile("" : "+s"(F.bid)); F.gw = F.bid * NWAVES + F.wave; F.ngw = F.G * NWAVES; unsigned char* const ws = a.ws; const LAS int* tab = (const LAS int*)(F.lds + TAB_OFF); (void)tab; (void)ws;
#ifdef DBG_DUMP
#define IN(k) (lo <= (k) && (k) < hi && (k) <= DBG_DUMP)
#else
#define IN(k) (lo <= (k) && (k) < hi)
#endif
#ifdef DBG_REPEAT
#define REP(k) for (int rep_ = 0; rep_ < ((DBG_REPEAT == (k) && !((k) == 9 && l == DEPTH - 1)) ? 2 : 1); ++rep_)
#else
#define REP(k)
#endif
#define SEAM(k) do { if (IN(k) && IN((k) + 1)) { XcdBarrier b2_ = bar; { size_t z_ = 0; asm volatile("" : "+s"(z_), "+s"(b2_.x)); b2_.bar = bar.bar + z_; } xcd_barrier(b2_); } } while (0)
template <int l>
__device__ __forceinline__ void layer_body(const Args& args, const int lo, const int hi, const XcdBarrier& bar, LAS unsigned char* const lds0, unsigned char* lds_raw) {
        const int pb = 1 + l * PH_PER_LAYER;

#ifdef DBG_DUMP
        if (l == 0 && lo <= DBG_DUMP + 1 && DBG_DUMP + 1 < hi) { PH_BEGIN dbg_dump(a, F); }
#endif
        if (IN(pb + 0)) REP(0) { PH_BEGIN
            pg8::Gemm g{(bf16_t*)(ws + WS_XN), (bf16_t*)(ws + wset(l) + WO_WIN), D / 2, D / 2, D / 2, E8_1, E8_W}; pg8::StaticOrder S; S.init(T, NINP, F.G, F.bid);
            pg8::EpiInproj E{ws, l};
            pg8::gemm_phase<pg8::EpiInproj, pg8::StaticOrder, true>(F.lds + RING_OFF, g, S, E, F.tid);
        }
        SEAM(pb + 0);
        if (IN(pb + 1)) REP(1) { PH_BEGIN
            const int vcu = (F.G % 8 == 0) ? (F.bid % 8) * (F.G / 8) + F.bid / 8 : F.bid;
            if ((vcu & 1) == 0 && (vcu >> 1) < BATCH * NH) { phase_hgrn(a, F, l, vcu >> 1); __syncthreads(); }
            phase_attn(a, F, (char*)lds_raw);
            if (l + 1 < DEPTH) { __syncthreads(); convert_layer(a, F, l + 1, F.gw, F.ngw); }
        }
        SEAM(pb + 1);
        if (IN(pb + 3)) REP(3) { PH_BEGIN
            pg8::Gemm g{(bf16_t*)(ws + WS_OX8), (bf16_t*)(ws + wset(l) + WO_WBR), D / 2, D / 2, 256, E8_FOX, E8_W}; pg8::StaticOrder S; S.init(T, D, F.G, F.bid);
            pg8::EpiGate<1> E{(bf16_t*)(ws + WS_U1), nullptr, (bf16_t*)(ws + WS_G), 2048, nullptr, 0.f};
            pg8::gemm_phase<pg8::EpiGate<1>, pg8::StaticOrder, true>(F.lds + RING_OFF, g, S, E, F.tid);
        }
        if (IN(pb + 3) && IN(pb + 4)) __syncthreads(); else SEAM(pb + 3);
        if (IN(pb + 4)) REP(4) { PH_BEGIN
            pg8::Gemm g{(bf16_t*)(ws + WS_OX8) + 256, (bf16_t*)(ws + wset(l) + WO_WBR) + 256, D / 2, D / 2, 256, E8_HGRN, E8_W}; pg8::StaticOrder S; S.init(T, D, F.G, F.bid);
            pg8::EpiGate<2> E{(bf16_t*)(ws + WS_U), nullptr, (bf16_t*)(ws + WS_G) + 1024, 2048, (bf16_t*)(ws + WS_U1), 0.f};
            pg8::gemm_phase<pg8::EpiGate<2>, pg8::StaticOrder, true>(F.lds + RING_OFF, g, S, E, F.tid);
        }
        SEAM(pb + 4);
        if (IN(pb + 5)) REP(5) { PH_BEGIN
            pg8::Gemm g{(bf16_t*)(ws + WS_U), (bf16_t*)(ws + wset(l) + WO_WMIX), D / 2, D / 2, D / 2, E8_U, E8_W}; pg8::StaticOrder S; S.init(T, D, F.G, F.bid);
            pg8::EpiGate<0> E{(bf16_t*)(ws + WS_MIXED), a.b_mix + l * D, nullptr, 0, nullptr, SC_MIX};
            pg8::gemm_phase<pg8::EpiGate<0>, pg8::StaticOrder, true>(F.lds + RING_OFF, g, S, E, F.tid);
        }
        SEAM(pb + 5);
        if (IN(pb + 6)) REP(6) { PH_BEGIN phase_ln1_router(a, F, l); }
        SEAM(pb + 6);
        if (IN(pb + 7)) REP(7) { PH_BEGIN
            moe_table(a, F, l);
            pg8::Gemm g{(bf16_t*)(ws + WS_XN), (bf16_t*)(ws + wset(l) + WO_W13), D / 2, D / 2, D / 2, E8_1, E8_W}; pg8::MoeOrder<true> S{F.G, F.bid, 8, tab, (const int*)(ws + WS_LIST), (size_t)2048 * (D / 2)};
            pg8::EpiUp E{(bf16_t*)(ws + WS_H)};
            pg8::gemm_phase<pg8::EpiUp, pg8::MoeOrder<true>, true>(F.lds + RING_OFF, g, S, E, F.tid);
        }
        SEAM(pb + 7);
        if (IN(pb + 8)) REP(8) { PH_BEGIN
            moe_table(a, F, l);
            pg8::Gemm g{(bf16_t*)(ws + WS_H), (bf16_t*)(ws + wset(l) + WO_W2), D / 2, D / 2, D / 2, E8_H, E8_W}; pg8::MoeOrder<false> S{F.G, F.bid, 4, tab, nullptr, (size_t)D * (D / 2)};
            pg8::EpiGate<0> E{(bf16_t*)(ws + WS_Y), nullptr, nullptr, 0, nullptr, SC_Y};
            pg8::gemm_phase<pg8::EpiGate<0>, pg8::MoeOrder<false>, true>(F.lds + RING_OFF, g, S, E, F.tid);
        }
        SEAM(pb + 8);
        if (IN(pb + 9)) REP(9) { PH_BEGIN
            if (l + 1 < DEPTH) load_wff(a, F, l + 1);
            moe_table(a, F, l);
            phase_combine_ln2(a, F, l);
        }
        SEAM(pb + 9);
    }

__global__ void __launch_bounds__(NWAVES * 64, 2) mk_fwd(Args args) {
    extern __shared__ __attribute__((aligned(16))) unsigned char lds_raw[];
    LAS unsigned char* const lds0 = (LAS unsigned char*)lds_raw;
    volatile LAS unsigned* MISC = (volatile LAS unsigned*)(lds0 + MISC_OFF);
    for (int u = threadIdx.x; u < (LDS_BYTES - LDSCTL_OFF) / 4; u += NWAVES * 64) ((LAS unsigned*)(lds0 + LDSCTL_OFF))[u] = 0u;
    __syncthreads();
    if ((threadIdx.x & 63) == 0) ((volatile LAS unsigned*)(lds0 + WTAB_OFF))[hw_wave_key()] = threadIdx.x >> 6;
    __syncthreads();
    unsigned* ctl = (unsigned*)(args.ws + WS_CTL);
    XcdBarrier bar; bar.bar = ctl + CW_BAR; bar.x = 0; bar.st = nullptr;
    if (args.use_bar) bar = xcd_barrier_post(ctl + CW_BAR, MISC + 8);
    const int lo = args.ph_lo, hi = args.ph_hi;


    if (IN(0)) { PH_BEGIN phase_prep(a, F); }
    SEAM(0);
    layer_body<0>(args, lo, hi, bar, lds0, lds_raw); layer_body<1>(args, lo, hi, bar, lds0, lds_raw); layer_body<2>(args, lo, hi, bar, lds0, lds_raw); layer_body<3>(args, lo, hi, bar, lds0, lds_raw);
#undef IN
#undef SEAM
}

extern "C" void kernel_launch(void* const* d_in, const int* in_sizes, int n_in, void* d_out, int out_size, void* d_ws, size_t ws_size, hipStream_t stream) {
    static int grid = 0;
    if (grid == 0) {
        if (n_in != 20 || in_sizes[0] != T * D || out_size != T * D || ws_size < WS_END) { fprintf(stderr, "kernel_launch: unexpected shapes (n_in %d, ws %zu)\n", n_in, ws_size); grid = -1; return; }
        int dev = 0, cus = 0, per_cu = 0;
        if (hipGetDevice(&dev) != hipSuccess || hipDeviceGetAttribute(&cus, hipDeviceAttributeMultiprocessorCount, dev) != hipSuccess) { grid = -1; return; }
        if (hipFuncSetAttribute((const void*)mk_fwd, hipFuncAttributeMaxDynamicSharedMemorySize, LDS_BYTES) != hipSuccess) { fprintf(stderr, "kernel_launch: hipFuncSetAttribute failed\n"); grid = -1; return; }
        if (hipOccupancyMaxActiveBlocksPerMultiprocessor(&per_cu, (const void*)mk_fwd, NWAVES * 64, LDS_BYTES) != hipSuccess || per_cu < 1)
            fprintf(stderr, "kernel_launch: note: occupancy query reports %d workgroups per CU\n", per_cu);
        (void)hipGetLastError();
        grid = cus;
    }
    if (grid < 0) return;
    if (hipMemsetAsync((char*)d_ws + WS_CTL, 0, CTL_BYTES, stream) != hipSuccess) return;
    Args a{};
    a.x = (const float*)d_in[0]; a.ln_in_g = (const float*)d_in[1]; a.ln_in_b = (const float*)d_in[2]; a.w_in = (const float*)d_in[3]; a.b_in = (const float*)d_in[4];
    a.w_fox = (const float*)d_in[5]; a.lbl = (const float*)d_in[6]; a.norm_g = (const float*)d_in[7]; a.w_hgrn = (const float*)d_in[8]; a.w_mix = (const float*)d_in[9];
    a.b_mix = (const float*)d_in[10]; a.ln1_g = (const float*)d_in[11]; a.ln1_b = (const float*)d_in[12]; a.router_w = (const float*)d_in[13]; a.router_b = (const float*)d_in[14];
    a.w1 = (const float*)d_in[15]; a.w3 = (const float*)d_in[16]; a.w2 = (const float*)d_in[17]; a.ln2_g = (const float*)d_in[18]; a.ln2_b = (const float*)d_in[19];
    a.out = (float*)d_out; a.ws = (unsigned char*)d_ws; a.pad = 0;
#if MK_ONE_LAUNCH
    a.ph_lo = 0; a.ph_hi = N_PHASES; a.use_bar = 1;
    hipLaunchKernelGGL(mk_fwd, dim3(grid), dim3(NWAVES * 64), LDS_BYTES, stream, a);
#else
#ifdef DBG_DUMP
    const int np_ = DBG_DUMP + 2;
#else
    const int np_ = N_PHASES;
#endif
    for (int p = 0; p < np_; ++p) { a.ph_lo = p; a.ph_hi = p + 1; a.use_bar = 0;
        hipLaunchKernelGGL(mk_fwd, dim3(grid), dim3(NWAVES * 64), LDS_BYTES, stream, a); }
#endif
    const hipError_t le = hipPeekAtLastError();
    if (le != hipSuccess) fprintf(stderr, "kernel_launch: launch failed: %s\n", hipGetErrorName(le));
}
```

```cpp
#define MK_ONE_LAUNCH 1
#define MK_FAST_ATTN 1
#define MK_FAST_HGRN 1
#include <hip/hip_runtime.h>
#include <cstdio>
#include <cstdint>

typedef unsigned short bf16_t;
typedef short bf16x8 __attribute__((ext_vector_type(8)));
typedef float f32x4 __attribute__((ext_vector_type(4)));
typedef float f32x2 __attribute__((ext_vector_type(2)));
typedef unsigned u32x4 __attribute__((ext_vector_type(4)));
typedef unsigned u32x2 __attribute__((ext_vector_type(2)));
#define LAS __attribute__((address_space(3)))
#define GAS __attribute__((address_space(1)))

constexpr int BATCH = 16, SEQ = 2048, T = BATCH * SEQ, D = 1024, DEPTH = 4, NH = 8, HD = 64, NIN = 5640, NINP = 5632, NE = 16;
constexpr float LN_EPS = 1e-5f, RMS_EPS = 1e-6f;
constexpr float ALPHA = 1.681792830507429f;
constexpr float LOG2E = 1.4426950408889634f;
constexpr float C2 = 0.125f * LOG2E;
constexpr float SC_W = 64.f, SC_FOX = 16.f, SC_HGRN = 4.f, SC_U = 64.f, SC_H = 8.f, SC_MIX = 32.f, SC_Y = 64.f;
constexpr int E8_1 = 0x7f7f7f7f, E8_W = 0x79797979, E8_FOX = 0x7b7b7b7b, E8_HGRN = 0x7d7d7d7d, E8_U = 0x79797979, E8_H = 0x7c7c7c7c;
constexpr int TM = 256;

constexpr size_t MiB = 1u << 20;
constexpr size_t WS_CTL = 0, CTL_BYTES = 1 * MiB;
constexpr size_t WS_MISC = 1 * MiB;
constexpr size_t WS_WSET = 2 * MiB, WSET_BYTES = 56 * MiB;
constexpr size_t WO_WIN = 0, WO_WBR = 6 * MiB, WO_WMIX = 7 * MiB, WO_W13 = 8 * MiB, WO_W2 = 40 * MiB;
__host__ __device__ constexpr size_t wset(int l) { return WS_WSET + (size_t)(l & 1) * WSET_BYTES; }
__host__ __device__ constexpr size_t biasoff(int l) { return WS_MISC + 16384 + (size_t)(l & 1) * 32768; }
constexpr size_t WS_XRES = 114 * MiB, WS_XN = 242 * MiB, WS_QO = 306 * MiB, WS_KV = 370 * MiB, WS_HB = 434 * MiB, WS_LOGF = 498 * MiB;
constexpr size_t WS_HG = 562 * MiB, WS_G = 594 * MiB, WS_FL = 722 * MiB, WS_F2 = 723 * MiB, WS_U1 = 724 * MiB, WS_U = 788 * MiB, WS_MIXED = 852 * MiB;
constexpr size_t WS_LIST = 916 * MiB, WS_TOK = 918 * MiB, WS_X1B = 920 * MiB, WS_END = 984 * MiB;
constexpr size_t WS_OX8 = 274 * MiB;
constexpr size_t WS_H = WS_QO, WS_Y = 442 * MiB;
constexpr int CW_CNT = 1024;
constexpr int CW_BAR = 4096;

__device__ __forceinline__ unsigned f2bf(float f) { unsigned u = __builtin_bit_cast(unsigned, f); return (u + 0x7fffu + ((u >> 16) & 1u)) >> 16; }
__device__ __forceinline__ float bf2f(unsigned h) { return __builtin_bit_cast(float, h << 16); }
__device__ __forceinline__ float bflo(unsigned w) { return __builtin_bit_cast(float, w << 16); }
__device__ __forceinline__ float bfhi(unsigned w) { return __builtin_bit_cast(float, w & 0xffff0000u); }
typedef __bf16 bf16x2v_t __attribute__((ext_vector_type(2)));
__device__ __forceinline__ unsigned pk2(float lo, float hi) { f32x2 v = {lo, hi}; bf16x2v_t b = __builtin_convertvector(v, bf16x2v_t); return __builtin_bit_cast(unsigned, b); }
__device__ __forceinline__ float wave_sum(float v) {
#pragma unroll
    for (int o = 1; o < 64; o <<= 1) v += __shfl_xor(v, o);
    return v;
}
__device__ __forceinline__ float wave_max(float v) {
#pragma unroll
    for (int o = 1; o < 64; o <<= 1) v = fmaxf(v, __shfl_xor(v, o));
    return v;
}
__device__ __forceinline__ float fast_exp(float v) { return __builtin_amdgcn_exp2f(v * LOG2E); }
__device__ __forceinline__ float sigmoidf_(float v) { return __builtin_amdgcn_rcpf(1.0f + fast_exp(-v)); }
__device__ __forceinline__ float siluf_(float v) { return v * sigmoidf_(v); }
__device__ __forceinline__ float logsigmoidf_(float v) { return fminf(v, 0.f) - __logf(1.0f + fast_exp(-fabsf(v))); }

namespace pg8 {
constexpr int BM = 256, BK = 64, HALF = 128, HTB = HALF * BK * 2  , STAGE_BYTES = 8 * HTB, NXCD = 8, WGM = 8;
__host__ __device__ __forceinline__ int lds_byte(int r, int c) { const int st = (r >> 4) * 2 + (c >> 5), rr = r & 15, cc = c & 31, ob = rr * 64 + cc * 2; return st * 1024 + (ob ^ (((ob >> 9) & 1) << 5)); }
__host__ __device__ __forceinline__ void stage_rc(int b, int& R, int& C) { const int st = b / 1024, sb = b % 1024, swz = sb ^ (((sb >> 9) & 1) << 5); R = (st >> 1) * 16 + swz / 64; C = (st & 1) * 32 + (swz % 64) / 2; }
__host__ __device__ __forceinline__ int perm32(int rho) { const int n = rho >> 4, i = rho & 15; return 8 * (i >> 2) + 4 * n + (i & 3); }

struct Unit { int pm, pn, e; };
struct Gemm { const bf16_t* A; const bf16_t* Bt; int lda, ldb, K; int sa, sb; };

struct StaticOrder {
    static constexpr bool GATHER = false;
    int nM, nN, nwg, G, c;
    __device__ void init(int M, int N, int G_, int c_) { nM = M / BM; nN = N / BM; nwg = nM * nN; G = G_; c = c_; }
    __device__ bool next(int i, Unit& u) const {
        const int L = i * G + c; if (L >= nwg) return false;
        int wgid = L; { const int q = nwg / NXCD, r = nwg % NXCD, xcd = wgid % NXCD, off = wgid / NXCD; wgid = (xcd < r ? xcd * (q + 1) : r * (q + 1) + (xcd - r) * q) + off; }
        const int nig = WGM * nN, gid = wgid / nig, fm = gid * WGM, gsz = (nM - fm) < WGM ? (nM - fm) : WGM;
        u.pm = fm + ((wgid % nig) % gsz); u.pn = (wgid % nig) / gsz; u.e = 0; return true;
    }
    __device__ __forceinline__ const char* a_tile(const Gemm& g, const Unit& u) const { return (const char*)g.A + (size_t)u.pm * BM * g.lda * 2; }
    __device__ __forceinline__ const char* b_tile(const Gemm& g, const Unit& u) const { return (const char*)g.Bt + (size_t)u.pn * BM * g.ldb * 2; }
    __device__ __forceinline__ void a_voff(const Gemm& g, const Unit&, const int (&R)[2], const int (&C)[2], unsigned (&v)[2][2]) const {
#pragma unroll
        for (int h = 0; h < 2; ++h)
#pragma unroll
            for (int i = 0; i < 2; ++i) v[h][i] = (unsigned)((h * HALF + R[i]) * g.lda + C[i]) * 2u;
    }
};
template <bool GATHER_> struct MoeOrder {
    static constexpr bool GATHER = GATHER_; static constexpr bool gather = GATHER_;
    int G, c, nN; const LAS int* tab; const int* list; size_t bstride;
    __device__ bool next(int i, Unit& u) const {
        const int L = i * G + c; const int rt = L / nN; const int NT = tab[NE]; if (rt >= NT) return false;
        int e = 0;
#pragma unroll
        for (int k = 1; k < NE; ++k) e += (rt >= tab[k]) ? 1 : 0;
        u.pm = __builtin_amdgcn_readfirstlane(rt); u.pn = __builtin_amdgcn_readfirstlane(L % nN); u.e = __builtin_amdgcn_readfirstlane(e); return true;
    }
    __device__ __forceinline__ const char* a_tile(const Gemm& g, const Unit& u) const { return gather ? (const char*)g.A : (const char*)g.A + (size_t)u.pm * BM * g.lda * 2; }
    __device__ __forceinline__ const char* b_tile(const Gemm& g, const Unit& u) const { return (const char*)g.Bt + ((size_t)u.e * bstride + (size_t)u.pn * BM * g.ldb) * 2; }
    __device__ __forceinline__ void a_voff(const Gemm& g, const Unit& u, const int (&R)[2], const int (&C)[2], unsigned (&v)[2][2]) const {
        const int ts = tab[u.e], cn = tab[NE + 1 + u.e];
#pragma unroll
        for (int h = 0; h < 2; ++h)
#pragma unroll
            for (int i = 0; i < 2; ++i) {
                if (gather) { const int pos = (u.pm - ts) * BM + h * HALF + R[i]; const int tok = (pos < cn) ? list[u.e * T + pos] : 0; v[h][i] = (unsigned)(tok * g.lda + C[i]) * 2u; }
                else v[h][i] = (unsigned)((h * HALF + R[i]) * g.lda + C[i]) * 2u;
            }
    }
};

typedef __bf16 bf16x2_t __attribute__((ext_vector_type(2)));
__device__ __forceinline__ unsigned cvt_pk_bf16(float lo, float hi) { f32x2 v = {lo, hi}; bf16x2_t b = __builtin_convertvector(v, bf16x2_t); return __builtin_bit_cast(unsigned, b); }
__device__ __forceinline__ u32x4 pack8(const f32x4& v0, const f32x4& v1) { u32x4 w; w.x = cvt_pk_bf16(v0[0], v0[1]); w.y = cvt_pk_bf16(v0[2], v0[3]); w.z = cvt_pk_bf16(v1[0], v1[1]); w.w = cvt_pk_bf16(v1[2], v1[3]); return w; }
__device__ __forceinline__ void unpack8(const u32x4& w, f32x4& v0, f32x4& v1) { v0[0] = bflo(w.x); v0[1] = bfhi(w.x); v0[2] = bflo(w.y); v0[3] = bfhi(w.y); v1[0] = bflo(w.z); v1[1] = bfhi(w.z); v1[2] = bflo(w.w); v1[3] = bfhi(w.w); }
typedef int v8i __attribute__((ext_vector_type(8)));
typedef int v4i __attribute__((ext_vector_type(4)));
__device__ __forceinline__ u32x2 pack8_fp8(const f32x4& v0, const f32x4& v1) {
    u32x2 w; int t = 0; t = __builtin_amdgcn_cvt_pk_fp8_f32(v0[0], v0[1], t, false); t = __builtin_amdgcn_cvt_pk_fp8_f32(v0[2], v0[3], t, true); w.x = (unsigned)t;
    int t2 = 0; t2 = __builtin_amdgcn_cvt_pk_fp8_f32(v1[0], v1[1], t2, false); t2 = __builtin_amdgcn_cvt_pk_fp8_f32(v1[2], v1[3], t2, true); w.y = (unsigned)t2; return w; }
__device__ __forceinline__ unsigned pack4_fp8(float a, float b, float c, float d) { int t = 0; t = __builtin_amdgcn_cvt_pk_fp8_f32(a, b, t, false); t = __builtin_amdgcn_cvt_pk_fp8_f32(c, d, t, true); return (unsigned)t; }
__device__ __forceinline__ f32x4 sig4(const f32x4& v) { f32x4 o; o[0] = sigmoidf_(v[0]); o[1] = sigmoidf_(v[1]); o[2] = sigmoidf_(v[2]); o[3] = sigmoidf_(v[3]); return o; }

struct EpiInproj {
    static constexpr bool PERM = true;
    unsigned char* ws; int layer;
    template <int KIND> __device__ __forceinline__ void tile(const f32x4 (&acc)[2][2][4][2], const Unit& u, int wr, int wc, int fr, int fq, unsigned char* w) const {
        const float* biasp = (const float*)(w + biasoff(layer));
        const int row0 = u.pm * BM + wr * 64 + fr, bcol0 = u.pn * BM + wc * 32 + 8 * fq;
        f32x4 bv[2][2];
#pragma unroll
        for (int bj = 0; bj < 2; ++bj)
#pragma unroll
            for (int n = 0; n < 2; ++n) bv[bj][n] = *(const f32x4*)(biasp + bcol0 + bj * HALF + 4 * n);
#pragma unroll
        for (int ai = 0; ai < 2; ++ai)
#pragma unroll
            for (int m = 0; m < 4; ++m) { const size_t row = (size_t)(row0 + ai * HALF + m * 16);
#pragma unroll
                for (int bj = 0; bj < 2; ++bj) { f32x4 v0 = acc[ai][bj][m][0] + bv[bj][0], v1 = acc[ai][bj][m][1] + bv[bj][1]; const int col = bcol0 + bj * HALF;
                    if (KIND == 0) { *(u32x4*)((bf16_t*)(w + WS_QO) + row * 1024 + col) = pack8(v0 * C2, v1 * C2); }
                    else if (KIND == 1) { *(u32x4*)((bf16_t*)(w + WS_KV) + row * 1024 + (col - 512)) = pack8(v0, v1); }
                    else if (KIND == 2) { *(u32x4*)((bf16_t*)(w + WS_KV) + row * 1024 + 512 + (col - 1024)) = pack8(v0, v1); }
                    else if (KIND == 3) { *(u32x4*)((bf16_t*)(w + WS_HB) + row * 1024 + (col - 1536)) = pack8(v0 * sig4(v0), v1 * sig4(v1)); }
                    else if (KIND == 4) { const int c = col - 2048; const float* lb = (const float*)(w + WS_MISC) + layer * 512; const f32x4 l0 = *(const f32x4*)(lb + c), l1 = *(const f32x4*)(lb + c + 4);
                        f32x4 f0 = l0 + (1.f - l0) * sig4(v0), f1 = l1 + (1.f - l1) * sig4(v1);
#pragma unroll
                        for (int q = 0; q < 4; ++q) { f0[q] = __logf(f0[q]); f1[q] = __logf(f1[q]); }
                        float* LOGF = (float*)(w + WS_LOGF); *(f32x4*)(LOGF + row * 512 + c) = f0; *(f32x4*)(LOGF + row * 512 + c + 4) = f1; }
                    else if (KIND == 5) { *(u32x4*)((bf16_t*)(w + WS_HB) + row * 1024 + 512 + (col - 2560)) = pack8(v0, v1); }
                    else if (KIND == 6) { *(u32x4*)((bf16_t*)(w + WS_HG) + row * 512 + (col - 3072)) = pack8(v0 * sig4(v0), v1 * sig4(v1)); }
                    else { *(u32x4*)((bf16_t*)(w + WS_G) + row * 2048 + (col - 3584)) = pack8(sig4(v0), sig4(v1)); }
                } }
    }
    __device__ __forceinline__ void operator()(const f32x4 (&acc)[2][2][4][2], const Unit& u, int wr, int wc, int fr, int fq) const {
        size_t z_ = 0; asm volatile("" : "+s"(z_)); unsigned char* w = ws + z_;
        const int ct = u.pn;
        if (ct < 2) tile<0>(acc, u, wr, wc, fr, fq, w); else if (ct < 4) tile<1>(acc, u, wr, wc, fr, fq, w); else if (ct < 6) tile<2>(acc, u, wr, wc, fr, fq, w);
        else if (ct < 8) tile<3>(acc, u, wr, wc, fr, fq, w); else if (ct < 10) tile<4>(acc, u, wr, wc, fr, fq, w); else if (ct < 12) tile<5>(acc, u, wr, wc, fr, fq, w);
        else if (ct < 14) tile<6>(acc, u, wr, wc, fr, fq, w); else tile<7>(acc, u, wr, wc, fr, fq, w);
    }
};
template <int MODE> struct EpiGate {
    static constexpr bool PERM = true;
    bf16_t* O; const float* bias; const bf16_t* Gt; int ldg; const bf16_t* P; float osc;
    __device__ __forceinline__ void operator()(const f32x4 (&acc)[2][2][4][2], const Unit& u, int wr, int wc, int fr, int fq) const {
        const int row0 = u.pm * BM + wr * 64 + fr, col0 = u.pn * BM + wc * 32 + 8 * fq;
        f32x4 bv[2][2];
        if (MODE == 0) {
#pragma unroll
            for (int bj = 0; bj < 2; ++bj)
#pragma unroll
                for (int n = 0; n < 2; ++n) bv[bj][n] = bias ? *(const f32x4*)(bias + col0 + bj * HALF + 4 * n) : (f32x4){0.f, 0.f, 0.f, 0.f};
        }
#pragma unroll
        for (int ai = 0; ai < 2; ++ai)
#pragma unroll
            for (int mh = 0; mh < 2; ++mh) {
                u32x4 gq[2][2], pq[2][2];
                if (MODE != 0) {
#pragma unroll
                    for (int mm = 0; mm < 2; ++mm)
#pragma unroll
                        for (int bj = 0; bj < 2; ++bj) { const size_t row = (size_t)(row0 + ai * HALF + (mh * 2 + mm) * 16); const int col = col0 + bj * HALF;
                            gq[mm][bj] = *(const u32x4*)(Gt + row * ldg + col);
                            if (MODE == 2) pq[mm][bj] = __builtin_nontemporal_load((const u32x4*)(P + row * 1024 + col)); }
                    asm volatile("s_waitcnt vmcnt(0)" ::: "memory");
                }
#pragma unroll
                for (int mm = 0; mm < 2; ++mm)
#pragma unroll
                    for (int bj = 0; bj < 2; ++bj) { const int m = mh * 2 + mm; const size_t row = (size_t)(row0 + ai * HALF + m * 16); const int col = col0 + bj * HALF;
                        f32x4 v0 = acc[ai][bj][m][0], v1 = acc[ai][bj][m][1];
                        if (MODE == 0) { v0 += bv[bj][0]; v1 += bv[bj][1]; }
                        else { f32x4 g0, g1; unpack8(gq[mm][bj], g0, g1); v0 *= g0; v1 *= g1;
                            if (MODE == 2) { f32x4 p0, p1; unpack8(pq[mm][bj], p0, p1); v0 += p0; v1 += p1; } }
                        if (MODE == 2) *(u32x2*)((unsigned char*)O + row * 1024 + col) = pack8_fp8(v0 * SC_U, v1 * SC_U);
                        else if (MODE == 0 && osc != 0.f) *(u32x2*)((unsigned char*)O + row * 1024 + col) = pack8_fp8(v0 * osc, v1 * osc);
                        else *(u32x4*)(O + row * 1024 + col) = pack8(v0, v1); }
                if (MODE != 0) asm volatile("" ::: "memory");
            }
    }
};
struct EpiUp {
    static constexpr bool PERM = true;
    bf16_t* H;
    __device__ __forceinline__ void operator()(const f32x4 (&acc)[2][2][4][2], const Unit& u, int wr, int wc, int fr, int fq) const {
        const int row0 = u.pm * BM + wr * 64 + fr, col = u.pn * HALF + wc * 32 + 8 * fq;
#pragma unroll
        for (int ai = 0; ai < 2; ++ai)
#pragma unroll
            for (int m = 0; m < 4; ++m) { const size_t row = (size_t)(row0 + ai * HALF + m * 16);
                const f32x4 a0 = acc[ai][0][m][0], a1 = acc[ai][0][m][1], b0 = acc[ai][1][m][0], b1 = acc[ai][1][m][1];
                *(u32x2*)((unsigned char*)H + row * 1024 + col) = pack8_fp8(a0 * sig4(a0) * b0 * SC_H, a1 * sig4(a1) * b1 * SC_H); }
    }
};

__device__ __forceinline__ void glds16s(const char* sbase, unsigned voff, unsigned lds_dst) {
    unsigned keep;
    asm volatile("s_mov_b32 %0, m0\n\ts_mov_b32 m0, %3\n\ts_nop 0\n\tglobal_load_lds_dwordx4 %1, %2\n\ts_mov_b32 m0, %0" : "=&s"(keep) : "v"(voff), "s"(sbase), "s"(lds_dst) : "memory");
}
template <class Epi, class Sched, bool ALIGN_EPI>
__device__ __forceinline__ void gemm_phase(LAS unsigned char* lds, const Gemm g, const Sched& S, const Epi& E, const int tid) {
    const int wid = __builtin_amdgcn_readfirstlane(tid >> 6), lane = tid & 63, wr = wid >> 2, wc = wid & 3, fr = lane & 15, fq = lane >> 4;
    int K = g.K; asm volatile("" : "+s"(K));
    const int nt = K / BK;
    int RA[2], CA[2]; unsigned voffB[2];
#pragma unroll
    for (int i = 0; i < 2; ++i) { int R, C; stage_rc(tid * 16 + i * 8192, R, C); const int Rb = Epi::PERM ? ((R & ~31) + perm32(R & 31)) : R;
        RA[i] = R; CA[i] = C; voffB[i] = (unsigned)(Rb * g.ldb + C) * 2u; }
    const size_t kstep = (size_t)(BK * 2);
    const size_t hstepB = (size_t)HALF * g.ldb * 2;
    const unsigned ldsw = (unsigned)wid * 1024u;
    const unsigned ldsb = (unsigned)__builtin_amdgcn_readfirstlane((int)((unsigned)(uintptr_t)lds + ldsw));
    const int aoff = lds_byte(wr * 64 + fr, fq * 8), boff = lds_byte(wc * 32 + fr, fq * 8);
#define PG8_SA(b, h) (((b) * 2 + (h)) * HTB)
#define PG8_SB(b, h) ((4 + (b) * 2 + (h)) * HTB)
#define PG8_STAGE(bufoff, gbase, voff) do { _Pragma("unroll") for (int _i = 0; _i < 2; ++_i) glds16s((const char*)(gbase), (voff)[_i], ldsb + (unsigned)((bufoff) + _i * 8192)); } while (0)
#define PG8_LD8(p) __builtin_shufflevector(*(const LAS v4i*)(p), *(const LAS v4i*)((p) + 1024), 0, 1, 2, 3, 4, 5, 6, 7)
#define PG8_LDA(dst, b, h) do { _Pragma("unroll") for (int m = 0; m < 4; ++m) dst[m] = PG8_LD8(lds + PG8_SA(b, h) + aoff + m * 2048); } while (0)
#define PG8_LDB(dst, b, h) do { _Pragma("unroll") for (int n = 0; n < 2; ++n) dst[n] = PG8_LD8(lds + PG8_SB(b, h) + boff + n * 2048); } while (0)
#define PG8_MMA(ai, bj, At, Bt) do { __builtin_amdgcn_s_setprio(1); _Pragma("unroll") for (int m = 0; m < 4; ++m) _Pragma("unroll") for (int n = 0; n < 2; ++n) \
        asm volatile("v_mfma_scale_f32_16x16x128_f8f6f4 %0, %1, %2, %0, %3, %4 op_sel_hi:[0,0,0]" : "+v"(acc[ai][bj][m][n]) : "v"(Bt[n]), "v"(At[m]), "v"(sbv), "v"(sav)); \
        __builtin_amdgcn_s_setprio(0); } while (0)
#define PG8_WAIT_V(n) asm volatile("s_waitcnt vmcnt(" #n ")" ::: "memory")
#define PG8_WAIT_L(n) asm volatile("s_waitcnt lgkmcnt(" #n ")" ::: "memory")
#define PG8_BAR __builtin_amdgcn_s_barrier()
#define PG8_SCHED __builtin_amdgcn_sched_barrier(0)
    Unit cur, nxt; int ui = 0;
    if (!S.next(0, cur)) return;
    f32x4 acc[2][2][4][2];
#pragma unroll
    for (int a = 0; a < 2; ++a)
#pragma unroll
        for (int b = 0; b < 2; ++b)
#pragma unroll
            for (int m = 0; m < 4; ++m)
#pragma unroll
                for (int n = 0; n < 2; ++n) acc[a][b][m][n] = (f32x4){0.f, 0.f, 0.f, 0.f};
    int sav = g.sa, sbv = g.sb;
    v8i At[4], B0[2], B1[2];
    unsigned vA[2][2], nvA[2][2];
    S.a_voff(g, cur, RA, CA, vA);
    const char* cA = S.a_tile(g, cur); const char* cB = S.b_tile(g, cur);
    PG8_STAGE(PG8_SB(0, 0), cB, voffB); PG8_STAGE(PG8_SB(0, 1), cB + hstepB, voffB); PG8_STAGE(PG8_SA(0, 0), cA, vA[0]); PG8_STAGE(PG8_SA(0, 1), cA, vA[1]);
    if (wr == 1) PG8_BAR;
    PG8_WAIT_V(2); PG8_BAR;
    PG8_STAGE(PG8_SB(1, 0), cB + kstep, voffB); PG8_STAGE(PG8_SA(1, 0), cA + kstep, vA[0]); PG8_STAGE(PG8_SB(1, 1), cB + hstepB + kstep, voffB);
    PG8_WAIT_V(6); PG8_BAR;
    for (;;) {
        const bool has_next = S.next(ui + 1, nxt);
        const char* nA = has_next ? S.a_tile(g, nxt) : cA; const char* nB = has_next ? S.b_tile(g, nxt) : cB;
        if constexpr (Sched::GATHER) {
            if (has_next) { int RA2[2], CA2[2];
#pragma unroll
                for (int i = 0; i < 2; ++i) { int tq = tid; asm volatile("" : "+v"(tq)); stage_rc(tq * 16 + i * 8192, RA2[i], CA2[i]); }
                S.a_voff(g, nxt, RA2, CA2, nvA); }
            else {
#pragma unroll
                for (int h = 0; h < 2; ++h)
#pragma unroll
                    for (int i = 0; i < 2; ++i) nvA[h][i] = vA[h][i]; }
        }
        for (int t = 0; t < nt; t += 2) {
            const bool last = (t == nt - 2);
            const char* a1 = cA + (size_t)(t + 1) * kstep;
            const char* a2 = last ? nA : cA + (size_t)(t + 2) * kstep; const char* b2 = last ? nB : cB + (size_t)(t + 2) * kstep;
            const char* a3 = a2 + kstep; const char* b3 = b2 + kstep;
            unsigned wA0[2], wA1[2];
#pragma unroll
            for (int i = 0; i < 2; ++i) { if constexpr (Sched::GATHER) { wA0[i] = last ? nvA[0][i] : vA[0][i]; wA1[i] = last ? nvA[1][i] : vA[1][i]; } else { wA0[i] = vA[0][i]; wA1[i] = vA[1][i]; } }
            PG8_LDB(B0, 0, 0); PG8_LDB(B1, 0, 1); PG8_SCHED; PG8_LDA(At, 0, 0); PG8_STAGE(PG8_SA(1, 1), a1, vA[1]);
            PG8_WAIT_V(8); PG8_WAIT_L(0); PG8_BAR; PG8_MMA(0, 0, At, B0); PG8_MMA(0, 1, At, B1); PG8_BAR; PG8_SCHED;
            PG8_LDA(At, 0, 1); PG8_STAGE(PG8_SB(0, 0), b2, voffB); PG8_STAGE(PG8_SB(0, 1), b2 + hstepB, voffB); PG8_STAGE(PG8_SA(0, 0), a2, wA0);
            PG8_WAIT_V(8); PG8_WAIT_L(0); PG8_BAR; PG8_MMA(1, 0, At, B0); PG8_MMA(1, 1, At, B1); PG8_BAR; PG8_SCHED;
            PG8_LDB(B0, 1, 0); PG8_LDB(B1, 1, 1); PG8_SCHED; PG8_LDA(At, 1, 0); PG8_STAGE(PG8_SA(0, 1), a2, wA1);
            PG8_WAIT_V(8); PG8_WAIT_L(0); PG8_BAR; PG8_MMA(0, 0, At, B0); PG8_MMA(0, 1, At, B1); PG8_BAR; PG8_SCHED;
            PG8_LDA(At, 1, 1); PG8_STAGE(PG8_SB(1, 0), b3, voffB); PG8_STAGE(PG8_SB(1, 1), b3 + hstepB, voffB); PG8_STAGE(PG8_SA(1, 0), a3, wA0);
            PG8_WAIT_V(8); PG8_WAIT_L(0); PG8_BAR; PG8_MMA(1, 0, At, B0); PG8_MMA(1, 1, At, B1); PG8_BAR; PG8_SCHED;
        }
        if constexpr (ALIGN_EPI) { if (wr == 0) PG8_BAR; }
        asm volatile("s_nop 15\n\ts_nop 15" ::: "memory");
        E(acc, cur, wr, wc, fr, fq);
        if (!has_next) break;
#pragma unroll
        for (int a = 0; a < 2; ++a)
#pragma unroll
            for (int b = 0; b < 2; ++b)
#pragma unroll
                for (int m = 0; m < 4; ++m)
#pragma unroll
                    for (int n = 0; n < 2; ++n) acc[a][b][m][n] = (f32x4){0.f, 0.f, 0.f, 0.f};
        cur = nxt; cA = nA; cB = nB; ++ui;
        if constexpr (Sched::GATHER) {
#pragma unroll
            for (int h = 0; h < 2; ++h)
#pragma unroll
                for (int i = 0; i < 2; ++i) vA[h][i] = nvA[h][i]; }
        if constexpr (ALIGN_EPI) { if (wr == 1) PG8_BAR; }
    }
    PG8_WAIT_V(0);
    if constexpr (!ALIGN_EPI) { if (wr == 0) PG8_BAR; }
    PG8_BAR;
#undef PG8_SA
#undef PG8_SB
#undef PG8_STAGE
#undef PG8_LDA
#undef PG8_LDB
#undef PG8_MMA
#undef PG8_LD8
#undef PG8_WAIT_V
#undef PG8_WAIT_L
#undef PG8_BAR
#undef PG8_SCHED
}
}


#include <hip/hip_bf16.h>
#include <cmath>
namespace attn_body {
using bf16=__hip_bfloat16;
using bf16x8=__attribute__((ext_vector_type(8)))short;
using s16x4=__attribute__((ext_vector_type(4)))short;
using f32x16=__attribute__((ext_vector_type(16)))float;
using u32x4=__attribute__((ext_vector_type(4)))unsigned;
constexpr int BATCH=16,NHEAD=8,SEQ=2048,D=64,DM=1024;
constexpr int NW=8,QBLK=32,QB=QBLK*NW,KVBLK=64,NQB=SEQ/QB;
constexpr int ATTN_PITCH=DM, ATTN_UNIT_ROWS=QB;
__device__ __forceinline__ int crow(int r,int hi){return (r&3)+8*(r>>2)+4*hi;}
#define SBAR() __builtin_amdgcn_sched_barrier(0)
__device__ __forceinline__ void cmask(f32x16&p0,f32x16&p1,int jb,int qrel,int hi){
  const float NEG=-INFINITY; int kb=64*jb+4*hi;
  #pragma unroll
  for(int r=0;r<16;++r){int kv=kb+(r&3)+8*(r>>2); if(kv>qrel)p0[r]=NEG; if(kv+32>qrel)p1[r]=NEG;}
}

constexpr int NSLOT=3, SLOTB=8192;
constexpr int LDS_K=0, LDS_V=NSLOT*SLOTB, LDS_WS=2*NSLOT*SLOTB, LDS_OST=LDS_WS+NW*64*4, LDS_BYTES=LDS_OST+NW*4096;
constexpr float C2=0.125f*1.4426950408889634f;
__device__ __forceinline__ void glds16(const void*gsrc,unsigned lds_dst){unsigned keep;
  asm volatile("s_mov_b32 %0, m0\n\ts_mov_b32 m0, %2\n\ts_nop 0\n\tglobal_load_lds_dwordx4 %1, off\n\ts_mov_b32 m0, %0":"=&s"(keep):"v"(gsrc),"s"(lds_dst):"memory");}
__device__ __forceinline__ float max3f(float a,float b,float c){float r;asm("v_max3_f32 %0, %1, %2, %3":"=v"(r):"v"(a),"v"(b),"v"(c));return r;}
__device__ __forceinline__ float max2f(float a,float b){float r;asm("v_max_f32_e32 %0, %1, %2":"=v"(r):"v"(a),"v"(b));return r;}
__device__ __forceinline__ float fadd_s(float a,float b){float r;asm("v_add_f32_e32 %0, %1, %2":"=v"(r):"v"(a),"v"(b));return r;}
__device__ __forceinline__ float fsub_s(float a,float b){float r;asm("v_sub_f32_e32 %0, %1, %2":"=v"(r):"v"(a),"v"(b));return r;}
typedef float f32x2_t __attribute__((ext_vector_type(2))); typedef __bf16 bf16x2_t __attribute__((ext_vector_type(2)));
__device__ __forceinline__ unsigned cvtpk_s(float lo,float hi){f32x2_t v={lo,hi};bf16x2_t b=__builtin_convertvector(v,bf16x2_t);return __builtin_bit_cast(unsigned,b);}
#define WAIT_BAR(N) asm volatile("s_waitcnt vmcnt(" #N ") lgkmcnt(0)\n\ts_barrier":::"memory")

__device__ __forceinline__ void qkt(f32x16&p0,f32x16&p1,const char*Kslot,const bf16x8*qr,const f32x16&negm,int r32,int hi){
  const char*kb=Kslot+hi*1024+r32*16;
  #pragma unroll
  for(int d0=0;d0<4;++d0){
    const bf16x8 b0=*reinterpret_cast<const bf16x8*>(kb+d0*2048);
    const bf16x8 b1=*reinterpret_cast<const bf16x8*>(kb+d0*2048+512);
    if(d0==0){p0=__builtin_amdgcn_mfma_f32_32x32x16_bf16(b0,qr[0],negm,0,0,0);p1=__builtin_amdgcn_mfma_f32_32x32x16_bf16(b1,qr[0],negm,0,0,0);}
    else{p0=__builtin_amdgcn_mfma_f32_32x32x16_bf16(b0,qr[d0],p0,0,0,0);p1=__builtin_amdgcn_mfma_f32_32x32x16_bf16(b1,qr[d0],p1,0,0,0);}}
}
typedef __attribute__((address_space(3))) const char* lds_cptr;
typedef short v4i16_t __attribute__((ext_vector_type(4)));
__device__ __forceinline__ void kload8(bf16x8*kf,lds_cptr kp){
  kf[0]=*(const __attribute__((address_space(3))) bf16x8*)(kp);      kf[1]=*(const __attribute__((address_space(3))) bf16x8*)(kp+512);
  kf[2]=*(const __attribute__((address_space(3))) bf16x8*)(kp+2048); kf[3]=*(const __attribute__((address_space(3))) bf16x8*)(kp+2560);
  kf[4]=*(const __attribute__((address_space(3))) bf16x8*)(kp+4096); kf[5]=*(const __attribute__((address_space(3))) bf16x8*)(kp+4608);
  kf[6]=*(const __attribute__((address_space(3))) bf16x8*)(kp+6144); kf[7]=*(const __attribute__((address_space(3))) bf16x8*)(kp+6656);
}
__device__ __forceinline__ void kload2(bf16x8*kf,lds_cptr kp,int j){ kf[2*j]=*(const __attribute__((address_space(3))) bf16x8*)(kp+j*2048); kf[2*j+1]=*(const __attribute__((address_space(3))) bf16x8*)(kp+j*2048+512); }
__device__ __forceinline__ s16x4 vtr(lds_cptr p){ return __builtin_bit_cast(s16x4,__builtin_amdgcn_ds_read_tr16_b64_v4i16((__attribute__((address_space(3))) v4i16_t*)p)); }
__device__ __forceinline__ float rowmax(const f32x16&p0,const f32x16&p1){
  float a=max3f(p0[0],p0[1],p1[0]),b=max3f(p0[2],p0[3],p1[1]);a=max3f(a,p1[2],p1[3]);
  #pragma unroll
  for(int r=4;r<16;r+=4){a=max3f(a,p0[r],p0[r+1]);b=max3f(b,p0[r+2],p0[r+3]);a=max3f(a,p1[r],p1[r+1]);b=max3f(b,p1[r+2],p1[r+3]);}
  const float m=max2f(a,b);
  auto rr=__builtin_amdgcn_permlane32_swap(__float_as_uint(m),__float_as_uint(m),false,false);
  return max2f(__uint_as_float(rr[0]),__uint_as_float(rr[1]));
}
__device__ __forceinline__ void pv(f32x16*o,int vb,bf16x8 pa0,bf16x8 pa1,bf16x8 pa2,bf16x8 pa3){
  #pragma unroll
  for(int d0=0;d0<2;++d0){s16x4 lo[4],hi[4];
    #pragma unroll
    for(int ks=0;ks<4;++ks){
      asm volatile("ds_read_b64_tr_b16 %0,%1 offset:%c2":"=&v"(lo[ks]):"v"(vb),"i"(d0*4096+ks*1024):"memory");
      asm volatile("ds_read_b64_tr_b16 %0,%1 offset:%c2":"=&v"(hi[ks]):"v"(vb),"i"(d0*4096+ks*1024+512):"memory");}
    asm volatile("s_waitcnt lgkmcnt(0)":::"memory");SBAR();
    #define PK(k) (bf16x8){lo[k][0],lo[k][1],lo[k][2],lo[k][3],hi[k][0],hi[k][1],hi[k][2],hi[k][3]}
    o[d0]=__builtin_amdgcn_mfma_f32_32x32x16_bf16(pa0,PK(0),o[d0],0,0,0);
    o[d0]=__builtin_amdgcn_mfma_f32_32x32x16_bf16(pa1,PK(1),o[d0],0,0,0);
    o[d0]=__builtin_amdgcn_mfma_f32_32x32x16_bf16(pa2,PK(2),o[d0],0,0,0);
    o[d0]=__builtin_amdgcn_mfma_f32_32x32x16_bf16(pa3,PK(3),o[d0],0,0,0);
    #undef PK
  }
}

#ifndef ATTN_STORE16
#define ATTN_STORE16(p,v) (*(u32x4*)(p)=(v))
#endif
template<int THRL> __device__ __forceinline__ void attn_unit(int b,int h,int qb,const bf16*Q,const bf16*__restrict__ K,const bf16*__restrict__ V,bf16*O,char*shm,const __attribute__((address_space(3))) float*f2,const int tid){
  #define BIAS_H(P,off,g0) { f32x4 x_[2]; _Pragma("unroll") for(int g_=0;g_<2;++g_) x_[g_]=*(const __attribute__((address_space(3))) f32x4*)(fb_+(off)+8*((g0)+g_)); \
      _Pragma("unroll") for(int g_=0;g_<2;++g_) _Pragma("unroll") for(int i_=0;i_<4;++i_) P[4*((g0)+g_)+i_]-=x_[g_][i_]; asm volatile("":::"memory"); }
  #define BIAS(P0,P1,t) do{ const __attribute__((address_space(3))) float* fb_=f2+64*(t)+4*hi; \
    BIAS_H(P0,0,0) BIAS_H(P0,0,2) BIAS_H(P1,32,0) BIAS_H(P1,32,2) }while(0)
  const int lane=tid&63,r32=lane&31,hi=lane>>5; const int wid=__builtin_amdgcn_readfirstlane(tid>>6);
  const long rowbase=(long)b*SEQ; const int q0=qb*QB;
  const bf16*Qw=Q+(rowbase+q0+wid*QBLK)*DM+h*D;
  const bf16*Kh=K+rowbase*DM+h*D,*Vh=V+rowbase*DM+h*D;
  const unsigned lds0=(unsigned)(uintptr_t)shm;
  float*wsf=(float*)(shm+LDS_WS)+wid*64;
  const bf16*ksrc=Kh+(long)lane*DM+wid*8;
  const bf16*vsrc=Vh+(long)(16*(wid&3)+(lane>>2))*DM+(wid>>2)*32+(lane&3)*8;
  const unsigned kdst=lds0+LDS_K+wid*1024, vdst=lds0+LDS_V+wid*1024;
  #define DMA_K(t,slot) glds16(ksrc+(long)(t)*KVBLK*DM,(unsigned)__builtin_amdgcn_readfirstlane(kdst+(slot)))
  #define DMA_V(t,slot) glds16(vsrc+(long)(t)*KVBLK*DM,(unsigned)__builtin_amdgcn_readfirstlane(vdst+(slot)))
  const int vb0=(int)(lds0+LDS_V)+((lane>>4)&1)*32+(lane&3)*8+(4*hi+((lane&15)>>2))*64;
  const char*Kbase=shm+LDS_K; bf16x8 kf[8];
  const lds_cptr shm3=(lds_cptr)shm; const lds_cptr kp0=shm3+LDS_K+hi*1024+r32*16; const lds_cptr vp0=shm3+LDS_V+((lane>>4)&1)*32+(lane&3)*8+(4*hi+((lane&15)>>2))*64;
  const int NT=(q0+QB)/KVBLK;
  DMA_K(0,0);DMA_V(0,0);DMA_K(1,SLOTB);
  bf16x8 qr[4];
  #pragma unroll
  for(int d0=0;d0<4;++d0)qr[d0]=*reinterpret_cast<const bf16x8*>(&Qw[(long)r32*DM+d0*16+hi*8]);
  float mhat=0.f,l_reg=0.f;f32x16 o[2];f32x16 negm; { float z_=0.f; asm volatile("":"+v"(z_)); _Pragma("unroll") for(int r=0;r<16;++r){o[0][r]=z_;o[1][r]=z_;negm[r]=z_;} } asm volatile("":"+v"(negm));
  const int qrel=wid*QBLK+r32;
  #define CMASK(P0,P1,t) do{int jb_=(t)-(NT-4); if(jb_>=0)cmask(P0,P1,jb_,qrel,hi);}while(0)
  bool resc=false;
  #define START(P0,P1) do{ const float rm=rowmax(P0,P1); resc=false; \
    { const float dl=rm; mhat=fadd_s(mhat,dl); \
      _Pragma("unroll") for(int r=0;r<16;++r){P0[r]=fsub_s(P0[r],dl);P1[r]=fsub_s(P1[r],dl);} \
      _Pragma("unroll") for(int r=0;r<16;++r)negm[r]=-mhat; asm volatile("":"+v"(negm)); } \
    _Pragma("unroll") for(int r=0;r<16;++r)P0[r]=__builtin_amdgcn_exp2f(P0[r]); }while(0)
  #define RESC() do{ if(resc){ asm volatile("s_waitcnt lgkmcnt(0)":::"memory"); \
      _Pragma("unroll") for(int d_=0;d_<2;++d_) _Pragma("unroll") for(int r=0;r<16;++r)o[d_][r]*=wsf[crow(r,hi)]; } }while(0)
  f32x16 pA0,pA1,pB0,pB1;
  int sl_prev=0,sl_cur=0,sl_next=SLOTB;
  #define ROT() do{sl_prev=sl_cur;sl_cur=sl_next;sl_next=(sl_next==(NSLOT-1)*SLOTB)?0:sl_next+SLOTB;}while(0)
  DMA_K(2,2*SLOTB);
  WAIT_BAR(3);
  qkt(pA0,pA1,Kbase,qr,negm,r32,hi);asm volatile("s_nop 15\n\ts_nop 7":"+v"(pA0),"+v"(pA1));CMASK(pA0,pA1,0);BIAS(pA0,pA1,0);
  START(pA0,pA1);
  _Pragma("unroll") for(int r=0;r<16;++r)pA1[r]=__builtin_amdgcn_exp2f(pA1[r]);
  WAIT_BAR(0);
  DMA_K(3,0);DMA_V(1,SLOTB);
  ROT();
  kload8(kf,kp0+sl_cur);
  WAIT_BAR(2);
  s16x4 vlo[8],vhi[8]; u32x4 pw0,pw1,pw2,pw3;
  #define PKW(P,B) cvtpk_s(P[B],P[B+1])
  #define PAF(k) __builtin_bit_cast(bf16x8,pw##k)
  #define VFR(i) (bf16x8){vlo[i][0],vlo[i][1],vlo[i][2],vlo[i][3],vhi[i][0],vhi[i][1],vhi[i][2],vhi[i][3]}
  #define PIN(x) asm volatile("":"+v"(x))
  #define MX3(a,b,c) __builtin_fmaxf(__builtin_fmaxf((a),(b)),(c))
  #define GAPA(MF,A0,A1,A2,A3,W0,W1,PW) do{ MF; sacc+=A0; sacc+=A1; sacc+=A2; sacc+=A3; PIN(sacc); W0; W1; PIN(PW); SBAR(); }while(0)
  #define EX(v) __builtin_amdgcn_exp2f(v)
  #define GAPB(MF,X,B) do{ MF; X[B]=EX(X[B]); X[B+1]=EX(X[B+1]); X[B+2]=EX(X[B+2]); X[B+3]=EX(X[B+3]); PIN(X); SBAR(); }while(0)
  #define VRD(i) do{ vlo[i]=vtr(vp_+(((i)>>2)*4096+((i)&3)*1024)); vhi[i]=vtr(vp_+(((i)>>2)*4096+((i)&3)*1024+512)); }while(0)
  #define KRD(G,j) do{ if(G){ kload2(kf,kp0+sl_next,j); SBAR(); } }while(0)
  #define STEP(C0,C1,P0,P1,t,GK,GV,GL) do{ SBAR(); \
    const lds_cptr vp_=vp0+sl_prev; \
    VRD(0); SBAR(); float sacc=(P0[0]+P0[1]); \
    GAPA(C0=__builtin_amdgcn_mfma_f32_32x32x16_bf16(kf[0],qr[0],negm,0,0,0), P0[2],P0[3],P0[4],P0[5],     pw0[0]=PKW(P0,0), pw0[1]=PKW(P0,2), pw0); \
    VRD(4); SBAR(); GAPA(C1=__builtin_amdgcn_mfma_f32_32x32x16_bf16(kf[1],qr[0],negm,0,0,0), P0[6],P0[7],P0[8],P0[9],     pw0[2]=PKW(P0,4), pw0[3]=PKW(P0,6), pw0); \
    VRD(1); SBAR(); GAPA(C0=__builtin_amdgcn_mfma_f32_32x32x16_bf16(kf[2],qr[1],C0,0,0,0),   P0[10],P0[11],P0[12],P0[13], pw1[0]=PKW(P0,8), pw1[1]=PKW(P0,10), pw1); \
    VRD(5); SBAR(); GAPA(C1=__builtin_amdgcn_mfma_f32_32x32x16_bf16(kf[3],qr[1],C1,0,0,0),   P0[14],P0[15],P1[0],P1[1],   pw1[2]=PKW(P0,12),pw1[3]=PKW(P0,14), pw1); \
    VRD(2); SBAR(); GAPA(C0=__builtin_amdgcn_mfma_f32_32x32x16_bf16(kf[4],qr[2],C0,0,0,0),   P1[2],P1[3],P1[4],P1[5],     pw2[0]=PKW(P1,0), pw2[1]=PKW(P1,2), pw2); \
    VRD(6); SBAR(); GAPA(C1=__builtin_amdgcn_mfma_f32_32x32x16_bf16(kf[5],qr[2],C1,0,0,0),   P1[6],P1[7],P1[8],P1[9],     pw2[2]=PKW(P1,4), pw2[3]=PKW(P1,6), pw2); \
    VRD(3); SBAR(); GAPA(C0=__builtin_amdgcn_mfma_f32_32x32x16_bf16(kf[6],qr[3],C0,0,0,0),   P1[10],P1[11],P1[12],P1[13], pw3[0]=PKW(P1,8), pw3[1]=PKW(P1,10), pw3); \
    VRD(7); SBAR(); GAPA(C1=__builtin_amdgcn_mfma_f32_32x32x16_bf16(kf[7],qr[3],C1,0,0,0),   P1[14],P1[15],0.f,0.f,       pw3[2]=PKW(P1,12),pw3[3]=PKW(P1,14), pw3); \
    l_reg+=sacc; \
    if(GK){DMA_K((t)+3,sl_cur);} if(GV){DMA_V((t)+1,sl_next);} \
    CMASK(C0,C1,t); BIAS(C0,C1,t); \
    { float a=MX3(C0[0],C0[1],C1[0]),b=MX3(C0[2],C0[3],C1[1]); a=MX3(a,C1[2],C1[3]); \
      _Pragma("unroll") for(int r=4;r<16;r+=4){a=MX3(a,C0[r],C0[r+1]);b=MX3(b,C0[r+2],C0[r+3]);a=MX3(a,C1[r],C1[r+1]);b=MX3(b,C1[r+2],C1[r+3]);} \
      float rm=__builtin_fmaxf(a,b); { auto rr=__builtin_amdgcn_permlane32_swap(__float_as_uint(rm),__float_as_uint(rm),false,false); rm=__builtin_fmaxf(__uint_as_float(rr[0]),__uint_as_float(rr[1])); } \
      resc=false; \
      if(__builtin_expect(__any(rm>(float)THRL),0)){ const float dl=__builtin_fmaxf(rm,0.f); mhat+=dl; \
        _Pragma("unroll") for(int r=0;r<16;++r){C0[r]-=dl;C1[r]-=dl;} \
        _Pragma("unroll") for(int r=0;r<16;++r)negm[r]=-mhat; asm volatile("":"+v"(negm)); \
        const float f=__builtin_amdgcn_exp2f(-dl); l_reg*=f; if(hi==0)wsf[r32]=f; resc=true; } } \
    SBAR(); \
    GAPB(o[0]=__builtin_amdgcn_mfma_f32_32x32x16_bf16(PAF(0),VFR(0),o[0],0,0,0), C0,0); \
    GAPB(o[1]=__builtin_amdgcn_mfma_f32_32x32x16_bf16(PAF(0),VFR(4),o[1],0,0,0), C0,4); \
    KRD(GL,0); GAPB(o[0]=__builtin_amdgcn_mfma_f32_32x32x16_bf16(PAF(1),VFR(1),o[0],0,0,0), C0,8); \
    KRD(GL,1); GAPB(o[1]=__builtin_amdgcn_mfma_f32_32x32x16_bf16(PAF(1),VFR(5),o[1],0,0,0), C0,12); \
    KRD(GL,2); GAPB(o[0]=__builtin_amdgcn_mfma_f32_32x32x16_bf16(PAF(2),VFR(2),o[0],0,0,0), C1,0); \
    KRD(GL,3); GAPB(o[1]=__builtin_amdgcn_mfma_f32_32x32x16_bf16(PAF(2),VFR(6),o[1],0,0,0), C1,4); \
    GAPB(o[0]=__builtin_amdgcn_mfma_f32_32x32x16_bf16(PAF(3),VFR(3),o[0],0,0,0), C1,8); \
    GAPB(o[1]=__builtin_amdgcn_mfma_f32_32x32x16_bf16(PAF(3),VFR(7),o[1],0,0,0), C1,12); \
    }while(0)
  int t=1;
  #undef CMASK
  #define CMASK(P0,P1,t) do{}while(0)
  for(;t+5<NT;t+=2){
    STEP(pB0,pB1,pA0,pA1,t,true,true,true);     WAIT_BAR(2); RESC(); ROT();
    STEP(pA0,pA1,pB0,pB1,t+1,true,true,true);   WAIT_BAR(2); RESC(); ROT();
  }
  #undef CMASK
  #define CMASK(P0,P1,t) do{int jb_=(t)-(NT-4); if(jb_>=0)cmask(P0,P1,jb_,qrel,hi);}while(0)
  #define ENDW(tt) do{ if((tt)+3<NT){WAIT_BAR(2);} else if((tt)+2<NT){WAIT_BAR(1);} else {WAIT_BAR(0);} }while(0)
  for(;t+1<NT;t+=2){
    STEP(pB0,pB1,pA0,pA1,t,(t+3<NT),(t+1<NT),(t+1<NT));       ENDW(t);   RESC(); ROT();
    STEP(pA0,pA1,pB0,pB1,t+1,(t+4<NT),(t+2<NT),(t+2<NT));     ENDW(t+1); RESC(); ROT();
  }
  STEP(pB0,pB1,pA0,pA1,NT-1,false,false,false); RESC();
  { float sacc=pB0[0]+pB0[1]; _Pragma("unroll") for(int r=2;r<16;++r)sacc+=pB0[r]; _Pragma("unroll") for(int r=0;r<16;++r)sacc+=pB1[r]; l_reg+=sacc;
    pw0=(u32x4){PKW(pB0,0),PKW(pB0,2),PKW(pB0,4),PKW(pB0,6)};pw1=(u32x4){PKW(pB0,8),PKW(pB0,10),PKW(pB0,12),PKW(pB0,14)};pw2=(u32x4){PKW(pB1,0),PKW(pB1,2),PKW(pB1,4),PKW(pB1,6)};pw3=(u32x4){PKW(pB1,8),PKW(pB1,10),PKW(pB1,12),PKW(pB1,14)};
    SBAR(); pv(o,vb0+sl_cur,PAF(0),PAF(1),PAF(2),PAF(3)); }
  #undef PKW
  #undef PAF
  #undef VFR
  #undef PIN
  #undef MX3
  #undef GAPA
  #undef GAPB
  #undef EX
  #undef VRD
  #undef KRD
  #undef STEP
  #undef ENDW
  {auto rr=__builtin_amdgcn_permlane32_swap(__float_as_uint(l_reg),__float_as_uint(l_reg),false,false);l_reg=__uint_as_float(rr[0])+__uint_as_float(rr[1]);}
  if(hi==0)wsf[32+r32]=l_reg;asm volatile("s_waitcnt lgkmcnt(0)":::"memory");
  float rli[16];
  #pragma unroll
  for(int r=0;r<16;++r)rli[r]=__builtin_amdgcn_rcpf(wsf[32+crow(r,hi)]);
  { bf16*stg=(bf16*)(shm+LDS_OST)+wid*2048;
    #pragma unroll
    for(int r=0;r<16;++r){const int orow=crow(r,hi);
      #pragma unroll
      for(int d0=0;d0<2;++d0)stg[orow*64+d0*32+r32]=__float2bfloat16(o[d0][r]*rli[r]);}
    asm volatile("s_waitcnt lgkmcnt(0)":::"memory");
    unsigned char*O8w=(unsigned char*)O+(rowbase+q0+wid*QBLK)*DM+h*D;
    _Pragma("unroll") for(int i=0;i<4;++i){const int row=i*8+(lane>>3),ch=lane&7; const u32x4 v=*(const u32x4*)(stg+row*64+ch*8);
      u32x2 w8; w8.x=pg8::pack4_fp8(bflo(v.x)*SC_FOX,bfhi(v.x)*SC_FOX,bflo(v.y)*SC_FOX,bfhi(v.y)*SC_FOX); w8.y=pg8::pack4_fp8(bflo(v.z)*SC_FOX,bfhi(v.z)*SC_FOX,bflo(v.w)*SC_FOX,bfhi(v.w)*SC_FOX);
      *(u32x2*)(O8w+(long)row*DM+ch*8)=w8;} }
  asm volatile("s_waitcnt lgkmcnt(0)\n\ts_barrier":::"memory");
  #undef BIAS
  #undef BIAS_H
  #undef DMA_K
  #undef DMA_V
  #undef CMASK
  #undef START
  #undef RESC
  #undef ROT
}
constexpr int ATTN_LDS_BYTES=LDS_BYTES;
#undef SBAR
#undef WAIT_BAR
}


constexpr int NWAVES = 8;
constexpr int RING_OFF = 0, RING_BYTES = 131072;
constexpr int LDSCTL_OFF = RING_BYTES, MISC_OFF = LDSCTL_OFF + 320, TAB_OFF = LDSCTL_OFF + 1024;
constexpr int WTAB_OFF = LDSCTL_OFF + 2048;
constexpr int LDS_BYTES = 147456;
typedef GAS unsigned gu32;
__device__ __forceinline__ unsigned hw_wave_key() { return (unsigned)__builtin_amdgcn_s_getreg((5 << 11) | 4) & 63u; }
#define RLX_AGENT __ATOMIC_RELAXED, __HIP_MEMORY_SCOPE_AGENT

#define XB_TMO      128
#define XB_XCNT(j)  (256  + 64 * (j))
#define XB_XSUB(j)  (1280 + 64 * (j))
#define XB_XGEN(j)  (2304 + 64 * (j))
#define XB_TOP      3328
#define XB_TOPGEN   3392
#define XCD_BAR_WORDS 3456
#define XB_SPIN_CAP (1u << 18)

__device__ __forceinline__ unsigned xb_ld(unsigned* p)              { return __hip_atomic_load(p, __ATOMIC_RELAXED, __HIP_MEMORY_SCOPE_AGENT); }
__device__ __forceinline__ unsigned xb_add(unsigned* p, unsigned v) { return __hip_atomic_fetch_add(p, v, __ATOMIC_RELAXED, __HIP_MEMORY_SCOPE_AGENT); }
__device__ __forceinline__ unsigned xb_xcc_id() { return (unsigned)__builtin_amdgcn_s_getreg((3 << 11) | 20) & 0xFu; }
#define XB_SPIN(cond, bar) do { unsigned _sp = 0; while (cond) { __builtin_amdgcn_s_sleep(1); \
    if ((++_sp & 255u) == 0u) { if (xb_ld(&(bar)[XB_TMO])) break; if (_sp > XB_SPIN_CAP) { atomicAdd(&(bar)[XB_TMO], 1u); break; } } } } while (0)

struct XcdBarrier {
    unsigned* bar; unsigned x;
    volatile LAS unsigned* st;
};

__device__ __forceinline__ XcdBarrier xcd_barrier_post(unsigned* bar, volatile LAS unsigned* st) {
    XcdBarrier b; b.bar = bar; b.x = xb_xcc_id(); b.st = st;
    if (threadIdx.x == 0) (void)xb_add(&bar[XB_XCNT(b.x)], 1u);
    return b;
}
__device__ __forceinline__ void xcd_barrier_complete(unsigned* bar, unsigned x, unsigned& nloc, unsigned& nx) {
    const unsigned G = gridDim.x * gridDim.y * gridDim.z;
    unsigned sum, cnt, mine, sp = 0u;
    for (;;) {
        sum = 0u; cnt = 0u; mine = 0u;
#pragma unroll
        for (unsigned j = 0; j < 16; ++j) { const unsigned c = xb_ld(&bar[XB_XCNT(j)]); sum += c; cnt += (c > 0u) ? 1u : 0u; mine = (j == x) ? c : mine; }
        if (sum == G) break;
        __builtin_amdgcn_s_sleep(1);
        if ((++sp & 255u) == 0u) { if (xb_ld(&bar[XB_TMO])) break; if (sp > XB_SPIN_CAP) { atomicAdd(&bar[XB_TMO], 1u); break; } }
    }
    nloc = mine > 0u ? mine : 1u; nx = cnt > 0u ? cnt : 1u;
}

__device__ __forceinline__ void xcd_barrier(const XcdBarrier& b) {
    asm volatile("s_waitcnt vmcnt(0)" ::: "memory");
    __syncthreads();
    if (threadIdx.x == 0) {
        unsigned* bar = b.bar;
        __builtin_amdgcn_s_waitcnt(0);
        unsigned nloc = b.st[0], nx = b.st[1];
        if (nloc == 0u) { xcd_barrier_complete(bar, b.x, nloc, nx); b.st[0] = nloc; b.st[1] = nx; }
        const unsigned old = xb_add(&bar[XB_XSUB(b.x)], 1u);
        const unsigned gen = old / nloc;
        if (old + 1u == (gen + 1u) * nloc) {
            __builtin_amdgcn_fence(__ATOMIC_RELEASE, "agent");
            asm volatile("s_waitcnt vmcnt(0)" ::: "memory");
            const unsigned og = xb_add(&bar[XB_TOP], 1u);
            const unsigned tg = og / nx;
            if (og + 1u == (tg + 1u) * nx) xb_add(&bar[XB_TOPGEN], 1u);
            else XB_SPIN(xb_ld(&bar[XB_TOPGEN]) == tg, bar);
            __builtin_amdgcn_fence(__ATOMIC_ACQUIRE, "agent");
            xb_add(&bar[XB_XGEN(b.x)], 1u);
            asm volatile("s_waitcnt vmcnt(0)" ::: "memory");
        } else {
            XB_SPIN(xb_ld(&bar[XB_XGEN(b.x)]) == gen, bar);
            __builtin_amdgcn_fence(__ATOMIC_ACQUIRE, "agent");
            asm volatile("s_waitcnt vmcnt(0)" ::: "memory");
        }
    }
    __syncthreads();
}


struct Args {
    const float *x, *ln_in_g, *ln_in_b, *w_in, *b_in, *w_fox, *lbl, *norm_g, *w_hgrn, *w_mix, *b_mix, *ln1_g, *ln1_b, *router_w, *router_b, *w1, *w3, *w2, *ln2_g, *ln2_b;
    float* out; unsigned char* ws; int ph_lo, ph_hi, use_bar, pad;
};
struct Frame { LAS unsigned char* lds; int tid, lane, wave, G, gw, ngw, bid; };
#define LOAD_ARGS() launder_args(args)
__device__ __forceinline__ Args launder_args(const Args& args) { Args a = args; size_t z_ = 0; asm volatile("" : "+s"(z_)); a.ws = args.ws + z_; return a; }

__device__ __forceinline__ void ln_rows16(f32x4 (&v)[4], const float* g, const float* bta, int lane) {
    float s = 0.f;
#pragma unroll
    for (int j = 0; j < 4; ++j) s += (v[j].x + v[j].y) + (v[j].z + v[j].w);
    const float mean = wave_sum(s) * (1.f / D); float s2 = 0.f;
#pragma unroll
    for (int j = 0; j < 4; ++j) { v[j] = v[j] - mean; s2 += (v[j].x * v[j].x + v[j].y * v[j].y) + (v[j].z * v[j].z + v[j].w * v[j].w); }
    const float rstd = rsqrtf(wave_sum(s2) * (1.f / D) + LN_EPS);
#pragma unroll
    for (int j = 0; j < 4; ++j) { const int c = 4 * lane + 256 * j; const f32x4 gg = *(const f32x4*)(g + c), bb = *(const f32x4*)(bta + c); v[j] = v[j] * rstd * gg + bb; }
}
__device__ __forceinline__ void store_row(const f32x4 (&v)[4], int lane, bf16_t* ores, unsigned char* obf, float* of32b) {
#pragma unroll
    for (int j = 0; j < 4; ++j) { const int c = 4 * lane + 256 * j;
        if (ores) { u32x2 w; w.x = pk2(v[j].x, v[j].y); w.y = pk2(v[j].z, v[j].w); *(u32x2*)(ores + c) = w; }
        if (of32b) *(f32x4*)(of32b + c) = v[j];
        if (obf) *(unsigned*)(obf + c) = pg8::pack4_fp8(v[j].x, v[j].y, v[j].z, v[j].w); }
}

struct CvtDesc { const float* W; int ldw, k0, srccol, nvalid; unsigned char* WT; int dstrow, dstk; };
__device__ __forceinline__ void cvt_load(const CvtDesc& d, f32x4 (&v)[8], int lane) {
    const int ks = lane >> 3, n4 = (lane & 7) * 4;
#pragma unroll
    for (int j = 0; j < 8; ++j) v[j] = (n4 < d.nvalid) ? *(const f32x4*)(d.W + (size_t)(d.k0 + 8 * j + ks) * d.ldw + d.srccol + n4) : (f32x4){0.f, 0.f, 0.f, 0.f};
}
__device__ __forceinline__ void cvt_store(const CvtDesc& d, const f32x4 (&v)[8], LAS float* scr, int lane) {
    const int ks = lane >> 3, n4 = (lane & 7) * 4;
#pragma unroll
    for (int j = 0; j < 8; ++j) { LAS float* p = scr + (8 * j + ks) * 33 + n4; p[0] = v[j][0]; p[1] = v[j][1]; p[2] = v[j][2]; p[3] = v[j][3]; }
    asm volatile("s_waitcnt lgkmcnt(0)" ::: "memory");
    const int c = lane & 7;
#pragma unroll
    for (int j = 0; j < 4; ++j) { const int n = (lane >> 3) + 8 * j; const LAS float* s = scr + (8 * c) * 33 + n;
        u32x2 o; o.x = pg8::pack4_fp8(s[0 * 33] * SC_W, s[1 * 33] * SC_W, s[2 * 33] * SC_W, s[3 * 33] * SC_W); o.y = pg8::pack4_fp8(s[4 * 33] * SC_W, s[5 * 33] * SC_W, s[6 * 33] * SC_W, s[7 * 33] * SC_W);
        *(u32x2*)(d.WT + (size_t)(d.dstrow + n) * 1024 + d.dstk + d.k0 + 8 * c) = o; }
    asm volatile("s_waitcnt lgkmcnt(0)" ::: "memory");
}
__device__ __forceinline__ CvtDesc cvt_decode(const Args& a, int l, int it) {
    unsigned char* WS_ = a.ws + wset(l);
    constexpr int I_IN = 16 * 176, I_BR = 8 * 32, I_MIX = 16 * 32, I_13 = 16 * 64 * NE;
    CvtDesc d; int r = it;
    if (r < I_IN) { const int kb = r / 176, nb = r % 176, n0 = nb * 32;
        const int src = (n0 < 1536) ? n0 : n0 + 8, nv = 32;
        d.W = a.w_in + (size_t)l * D * NIN; d.ldw = NIN; d.k0 = kb * 64; d.srccol = src; d.nvalid = nv; d.WT = WS_ + WO_WIN; d.dstrow = n0; d.dstk = 0; return d; } r -= I_IN;
    if (r < I_BR) { const int kb = r / 32, nb = r % 32; d.W = a.w_fox + (size_t)l * 512 * D; d.ldw = D; d.k0 = kb * 64; d.srccol = nb * 32; d.nvalid = 32; d.WT = WS_ + WO_WBR; d.dstrow = nb * 32; d.dstk = 0; return d; } r -= I_BR;
    if (r < I_BR) { const int kb = r / 32, nb = r % 32; d.W = a.w_hgrn + (size_t)l * 512 * D; d.ldw = D; d.k0 = kb * 64; d.srccol = nb * 32; d.nvalid = 32; d.WT = WS_ + WO_WBR; d.dstrow = nb * 32; d.dstk = 512; return d; } r -= I_BR;
    if (r < I_MIX) { const int kb = r / 32, nb = r % 32; d.W = a.w_mix + (size_t)l * D * D; d.ldw = D; d.k0 = kb * 64; d.srccol = nb * 32; d.nvalid = 32; d.WT = WS_ + WO_WMIX; d.dstrow = nb * 32; d.dstk = 0; return d; } r -= I_MIX;
    if (r < I_13) { const int e = r / 1024, q = r % 1024, kb = q / 64, nb = q % 64, n0 = nb * 32;
        const int j = n0 >> 8, rr = n0 & 255; d.W = (rr < 128 ? a.w1 : a.w3) + ((size_t)l * NE + e) * D * D; d.ldw = D; d.k0 = kb * 64; d.srccol = 128 * j + (rr & 127); d.nvalid = 32;
        d.WT = WS_ + WO_W13 + (size_t)e * 2048 * D; d.dstrow = n0; d.dstk = 0; return d; } r -= I_13;
    { const int e = r / 512, q = r % 512, kb = q / 32, nb = q % 32; d.W = a.w2 + ((size_t)l * NE + e) * D * D; d.ldw = D; d.k0 = kb * 64; d.srccol = nb * 32; d.nvalid = 32;
      d.WT = WS_ + WO_W2 + (size_t)e * D * D; d.dstrow = nb * 32; d.dstk = 0; return d; }
}
__device__ __forceinline__ void convert_layer(const Args& a, const Frame& F, int l, int gw, int ngw) {
    LAS float* scr = (LAS float*)(F.lds + RING_OFF + F.wave * 16384);
    const int lane = F.lane;
    constexpr int NITEMS = 16 * 176 + 2 * 8 * 32 + 16 * 32 + 16 * 64 * NE + 16 * 32 * NE;
    for (int it = gw; it < NITEMS; it += 2 * ngw) {
        const CvtDesc d0 = cvt_decode(a, l, it); f32x4 v0[8]; cvt_load(d0, v0, lane);
        const bool two = it + ngw < NITEMS;
        if (two) { const CvtDesc d1 = cvt_decode(a, l, it + ngw); f32x4 v1[8]; cvt_load(d1, v1, lane); cvt_store(d0, v0, scr, lane); cvt_store(d1, v1, scr, lane); }
        else cvt_store(d0, v0, scr, lane);
    }
    float* biasp = (float*)(a.ws + biasoff(l));
    for (int n = gw * 64 + lane; n < NINP; n += ngw * 64) {
        biasp[n] = (n < 1536) ? a.b_in[l * NIN + n] : a.b_in[l * NIN + n + 8]; }
}


constexpr int WFF_OFF = 65536 + 16384;
__device__ __forceinline__ void load_wff(const Args& a, const Frame& F, int l) {
    LAS float* wff = (LAS float*)(F.lds + RING_OFF + WFF_OFF);
    for (int i = F.tid; i < 8 * D; i += NWAVES * 64) { const int c = i >> 3, h = i & 7; wff[h * D + c] = a.w_in[((size_t)l * D + c) * NIN + 1536 + h]; }
}
__device__ __forceinline__ void fox_gates_row(const Args& a, const Frame& F, int l, const f32x4 (&v)[4], int row) {
    const LAS float* wff = (const LAS float*)(F.lds + RING_OFF + WFF_OFF); const int lane = F.lane;
    float p[8];
#pragma unroll
    for (int h = 0; h < 8; ++h) { float s = 0.f;
#pragma unroll
        for (int j = 0; j < 4; ++j) { const f32x4 r4 = *(const LAS f32x4*)(wff + h * D + 4 * lane + 256 * j); s += v[j].x * r4.x + v[j].y * r4.y + v[j].z * r4.z + v[j].w * r4.w; }
        p[h] = s; }
    const bool hi5 = (lane & 32) != 0;
#pragma unroll
    for (int k = 0; k < 4; ++k) { const float snd = hi5 ? p[k] : p[k + 4]; const float rcv = __shfl_xor(snd, 32); p[k] = (hi5 ? p[k + 4] : p[k]) + rcv; }
    const bool hi4 = (lane & 16) != 0;
#pragma unroll
    for (int k = 0; k < 2; ++k) { const float snd = hi4 ? p[k] : p[k + 2]; const float rcv = __shfl_xor(snd, 16); p[k] = (hi4 ? p[k + 2] : p[k]) + rcv; }
    const bool hi3 = (lane & 8) != 0;
    { const float snd = hi3 ? p[0] : p[1]; const float rcv = __shfl_xor(snd, 8); p[0] = (hi3 ? p[1] : p[0]) + rcv; }
    p[0] += __shfl_xor(p[0], 4); p[0] += __shfl_xor(p[0], 2); p[0] += __shfl_xor(p[0], 1);
    if ((lane & 7) == 0) { const int h = lane >> 3; ((float*)(a.ws + WS_FL))[(size_t)row * 8 + h] = logsigmoidf_(p[0] + a.b_in[l * NIN + 1536 + h]); }
}

__device__ __forceinline__ void phase_prep(const Args& a, const Frame& F) {
    if (F.bid == 0) {
        float* lb_all = (float*)(a.ws + WS_MISC);
        const int c = F.tid;
        float v[DEPTH], m = -1e30f;
#pragma unroll
        for (int l = 0; l < DEPTH; ++l) { v[l] = a.lbl[l * 512 + c]; m = fmaxf(m, v[l]); }
        float s = 0.f;
#pragma unroll
        for (int l = 0; l < DEPTH; ++l) { v[l] = __expf(v[l] - m); s += v[l]; }
        float cum = 0.f;
#pragma unroll
        for (int l = 0; l < DEPTH; ++l) { const float p = v[l] / s; cum += p; lb_all[l * 512 + c] = cum - v[0] / s; }
    }
    bf16_t* XRES = (bf16_t*)(a.ws + WS_XRES); unsigned char* XN = a.ws + WS_XN;
    load_wff(a, F, 0); __syncthreads();
    for (int row = F.gw; row < T; row += F.ngw) {
        f32x4 v[4];
#pragma unroll
        for (int j = 0; j < 4; ++j) v[j] = *(const f32x4*)(a.x + (size_t)row * D + 4 * F.lane + 256 * j);
        ln_rows16(v, a.ln_in_g, a.ln_in_b, F.lane);
        store_row(v, F.lane, XRES + (size_t)row * D, XN + (size_t)row * D, nullptr);
        fox_gates_row(a, F, 0, v, row);
    }
    __syncthreads();
    convert_layer(a, F, 0, F.gw, F.ngw);
}

__device__ __forceinline__ void phase_fscan(const Args& a, const Frame& F) {
    if (F.bid >= BATCH * NH) return;
    const float* FL = (const float*)(a.ws + WS_FL); float* F2 = (float*)(a.ws + WS_F2);
    LAS float* wsum = (LAS float*)(F.lds + RING_OFF);
    const int bh = F.bid, b = bh >> 3, h = bh & 7, tid = F.tid, lane = F.lane, w = F.wave;
    float v[4], run = 0.f;
#pragma unroll
    for (int i = 0; i < 4; ++i) { run += FL[((size_t)b * SEQ + tid * 4 + i) * 8 + h]; v[i] = run; }
    float incl = run;
#pragma unroll
    for (int o = 1; o < 64; o <<= 1) { const float u = __shfl_up(incl, o); if (lane >= o) incl += u; }
    if (lane == 63) wsum[w] = incl;
    __syncthreads();
    float base = incl - run; for (int i = 0; i < w; ++i) base += wsum[i];
#pragma unroll
    for (int i = 0; i < 4; ++i) F2[(size_t)bh * SEQ + tid * 4 + i] = (base + v[i]) * LOG2E;
    __syncthreads();
}

__device__ __forceinline__ void phase_attn_naive(const Args& a, const Frame& F) {
    const bf16_t* QO = (const bf16_t*)(a.ws + WS_QO); const bf16_t* KV = (const bf16_t*)(a.ws + WS_KV); const float* F2 = (const float*)(a.ws + WS_F2); bf16_t* O = (bf16_t*)(a.ws + WS_QO);
    LAS float* ps = (LAS float*)(F.lds + RING_OFF) + F.wave * 64;
    const int lane = F.lane;
    for (int gid = F.gw; gid < BATCH * NH * SEQ; gid += F.ngw) {
        const int bh = gid & 127, t = gid >> 7, b = bh >> 3, h = bh & 7;
        float q[64];
        { const bf16_t* qp = QO + ((size_t)b * SEQ + t) * 1024 + h * 64;
#pragma unroll
          for (int c = 0; c < 8; ++c) { const u32x4 u = *(const u32x4*)(qp + c * 8);
            q[c * 8 + 0] = bflo(u.x); q[c * 8 + 1] = bfhi(u.x); q[c * 8 + 2] = bflo(u.y); q[c * 8 + 3] = bfhi(u.y);
            q[c * 8 + 4] = bflo(u.z); q[c * 8 + 5] = bfhi(u.z); q[c * 8 + 6] = bflo(u.w); q[c * 8 + 7] = bfhi(u.w); } }
        float m = -1e30f, l = 0.f, o = 0.f;
        const float* f2 = F2 + (size_t)bh * SEQ;
        for (int s0 = 0; s0 <= t; s0 += 64) {
            const int s = s0 + lane; const bool valid = s <= t;
            float sc = -1e30f;
            if (valid) { const bf16_t* kp = KV + ((size_t)b * SEQ + s) * 1024 + h * 64; float d = 0.f;
#pragma unroll
                for (int c = 0; c < 8; ++c) { const u32x4 u = *(const u32x4*)(kp + c * 8);
                    d += q[c * 8 + 0] * bflo(u.x) + q[c * 8 + 1] * bfhi(u.x) + q[c * 8 + 2] * bflo(u.y) + q[c * 8 + 3] * bfhi(u.y)
                       + q[c * 8 + 4] * bflo(u.z) + q[c * 8 + 5] * bfhi(u.z) + q[c * 8 + 6] * bflo(u.w) + q[c * 8 + 7] * bfhi(u.w); }
                sc = d - f2[s]; }
            const float mn = fmaxf(m, wave_max(sc));
            const float p = valid ? exp2f(sc - mn) : 0.f;
            const float f = exp2f(m - mn);
            l = l * f + wave_sum(p); o *= f; m = mn;
            ps[lane] = p;
            asm volatile("s_waitcnt lgkmcnt(0)" ::: "memory");
            const int nk = min(64, t - s0 + 1);
            const bf16_t* vp = KV + ((size_t)b * SEQ + s0) * 1024 + 512 + h * 64 + lane;
            for (int j = 0; j < nk; ++j) o += ps[j] * bf2f(vp[(size_t)j * 1024]);
            asm volatile("s_waitcnt lgkmcnt(0)" ::: "memory");
        }
        O[((size_t)b * SEQ + t) * 1024 + h * 64 + lane] = (bf16_t)f2bf(o / l);
    }
}

__device__ __forceinline__ void phase_hgrn_naive(const Args& a, const Frame& F, int l) {
    if (F.bid >= BATCH * NH || F.wave != 0) return;
    const bf16_t* HB = (const bf16_t*)(a.ws + WS_HB); const float* LOGF = (const float*)(a.ws + WS_LOGF); const bf16_t* HG = (const bf16_t*)(a.ws + WS_HG); bf16_t* O = (bf16_t*)(a.ws + WS_QO);
    LAS float* Lf = (LAS float*)(F.lds + RING_OFF + 1024); LAS float* Lk = Lf + 4096; LAS float* Lq = Lk + 4096;
    const int bh = F.bid, b = bh >> 3, h = bh & 7, lane = F.lane;
    float Sx[64];
#pragma unroll
    for (int d = 0; d < 64; ++d) Sx[d] = 0.f;
    const float ng = a.norm_g[l * 512 + h * 64 + lane];
    for (int c0 = 0; c0 < SEQ; c0 += 64) {
        for (int tt = 0; tt < 64; ++tt) { const size_t row = (size_t)b * SEQ + c0 + tt;
            const float lf = LOGF[row * 512 + h * 64 + lane]; const float f = __expf(lf);
            Lf[tt * 64 + lane] = f; Lk[tt * 64 + lane] = 1.f - f; Lq[tt * 64 + lane] = bf2f(HB[row * 1024 + h * 64 + lane]); }
        asm volatile("s_waitcnt lgkmcnt(0)" ::: "memory");
        for (int tt = 0; tt < 64; ++tt) { const size_t row = (size_t)b * SEQ + c0 + tt;
            const float v = bf2f(HB[row * 1024 + 512 + h * 64 + lane]);
            float o = 0.f;
#pragma unroll
            for (int d = 0; d < 64; d += 4) { const f32x4 f4 = *(const LAS f32x4*)(Lf + tt * 64 + d), k4 = *(const LAS f32x4*)(Lk + tt * 64 + d), q4 = *(const LAS f32x4*)(Lq + tt * 64 + d);
                Sx[d] = f4.x * Sx[d] + k4.x * v; o += Sx[d] * q4.x; Sx[d + 1] = f4.y * Sx[d + 1] + k4.y * v; o += Sx[d + 1] * q4.y;
                Sx[d + 2] = f4.z * Sx[d + 2] + k4.z * v; o += Sx[d + 2] * q4.z; Sx[d + 3] = f4.w * Sx[d + 3] + k4.w * v; o += Sx[d + 3] * q4.w; }
            const float ss = wave_sum(o * o);
            const float r = o * rsqrtf(ss * (1.f / 64.f) + RMS_EPS) * ng * bf2f(HG[row * 512 + h * 64 + lane]);
            O[row * 1024 + 512 + h * 64 + lane] = (bf16_t)f2bf(r); }
        asm volatile("s_waitcnt lgkmcnt(0)" ::: "memory");
    }
}

constexpr int LN1_RW = 0, LN1_LG = 65536, LN1_ASG = LN1_LG + 8 * 16 * 16 * 4, LN1_BASE = LN1_ASG + 128 * 16;
__device__ __forceinline__ void phase_ln1_router(const Args& a, const Frame& F, int l) {
    const bf16_t* xres = (const bf16_t*)(a.ws + WS_XRES); bf16_t* x1 = (bf16_t*)(a.ws + WS_X1B); const unsigned char* mixed = a.ws + WS_MIXED;   unsigned char* xn = a.ws + WS_XN;
    unsigned* cnt = (unsigned*)(a.ws + WS_CTL) + CW_CNT + l * 64; int* list = (int*)(a.ws + WS_LIST); unsigned* tokinfo = (unsigned*)(a.ws + WS_TOK);
    const float* g = a.ln1_g + l * D; const float* bta = a.ln1_b + l * D;
    LAS float* rw = (LAS float*)(F.lds + RING_OFF + LN1_RW);
    LAS float* lgs = (LAS float*)(F.lds + RING_OFF + LN1_LG) + F.wave * 256;
    LAS u32x4* asg = (LAS u32x4*)(F.lds + RING_OFF + LN1_ASG);
    LAS unsigned* basep = (LAS unsigned*)(F.lds + RING_OFF + LN1_BASE);
    for (int i = F.tid; i < NE * D; i += NWAVES * 64) { const int c = i >> 4, e = i & 15; rw[e * D + c] = a.router_w[i]; }
    __syncthreads();
    const int lane = F.lane;
    for (int blk = F.bid; blk < T / 128; blk += F.G) {
        const int R0 = blk * 128 + F.wave * 16;
        u32x2 nx[4]; unsigned nm[4];
#pragma unroll
        for (int j = 0; j < 4; ++j) { const int c = 4 * lane + 256 * j; nx[j] = *(const u32x2*)(xres + (size_t)R0 * D + c); nm[j] = *(const unsigned*)(mixed + (size_t)R0 * D + c); }
        for (int i = 0; i < 16; ++i) { const int row = R0 + i;
            f32x4 v[4];
#pragma unroll
            for (int j = 0; j < 4; ++j) { const u32x2 xv = nx[j]; const f32x2 m01 = __builtin_amdgcn_cvt_pk_f32_fp8((int)nm[j], false), m23 = __builtin_amdgcn_cvt_pk_f32_fp8((int)nm[j], true);
                v[j].x = ALPHA * bflo(xv.x) + m01[0] * (1.f / SC_MIX); v[j].y = ALPHA * bfhi(xv.x) + m01[1] * (1.f / SC_MIX); v[j].z = ALPHA * bflo(xv.y) + m23[0] * (1.f / SC_MIX); v[j].w = ALPHA * bfhi(xv.y) + m23[1] * (1.f / SC_MIX); }
            { const int rn = (i < 15) ? row + 1 : row;
#pragma unroll
              for (int j = 0; j < 4; ++j) { const int c = 4 * lane + 256 * j; nx[j] = *(const u32x2*)(xres + (size_t)rn * D + c); nm[j] = *(const unsigned*)(mixed + (size_t)rn * D + c); } }
            ln_rows16(v, g, bta, lane);
            store_row(v, lane, x1 + (size_t)row * D, xn + (size_t)row * D, nullptr);
            float p[NE];
#pragma unroll
            for (int e = 0; e < NE; ++e) { float s = 0.f;
#pragma unroll
                for (int j = 0; j < 4; ++j) { const f32x4 r4 = *(const LAS f32x4*)(rw + e * D + 4 * lane + 256 * j); s += v[j].x * r4.x + v[j].y * r4.y + v[j].z * r4.z + v[j].w * r4.w; }
                p[e] = s; asm volatile("" ::: "memory"); }
            { const bool hi5 = (lane & 32) != 0;
#pragma unroll
              for (int k = 0; k < 8; ++k) { const float snd = hi5 ? p[k] : p[k + 8]; const float rcv = __shfl_xor(snd, 32); p[k] = (hi5 ? p[k + 8] : p[k]) + rcv; }
              const bool hi4 = (lane & 16) != 0;
#pragma unroll
              for (int k = 0; k < 4; ++k) { const float snd = hi4 ? p[k] : p[k + 4]; const float rcv = __shfl_xor(snd, 16); p[k] = (hi4 ? p[k + 4] : p[k]) + rcv; }
              const bool hi3 = (lane & 8) != 0;
#pragma unroll
              for (int k = 0; k < 2; ++k) { const float snd = hi3 ? p[k] : p[k + 2]; const float rcv = __shfl_xor(snd, 8); p[k] = (hi3 ? p[k + 2] : p[k]) + rcv; }
              const bool hi2 = (lane & 4) != 0;
              { const float snd = hi2 ? p[0] : p[1]; const float rcv = __shfl_xor(snd, 4); p[0] = (hi2 ? p[1] : p[0]) + rcv; }
              p[0] += __shfl_xor(p[0], 2); p[0] += __shfl_xor(p[0], 1);
              if ((lane & 3) == 0) lgs[i * 16 + (lane >> 2)] = p[0]; }
        }
        asm volatile("s_waitcnt lgkmcnt(0)" ::: "memory");
        if (lane < 16) {
            float lg[NE];
#pragma unroll
            for (int q = 0; q < 4; ++q) { const f32x4 t4 = *(const LAS f32x4*)(lgs + lane * 16 + 4 * q); lg[4 * q] = t4[0] + a.router_b[4 * q]; lg[4 * q + 1] = t4[1] + a.router_b[4 * q + 1]; lg[4 * q + 2] = t4[2] + a.router_b[4 * q + 2]; lg[4 * q + 3] = t4[3] + a.router_b[4 * q + 3]; }
            int gs = 0; float gbest = -3e38f;
#pragma unroll
            for (int gi = 0; gi < 4; ++gi) { const float mx = fmaxf(fmaxf(lg[gi * 4], lg[gi * 4 + 1]), fmaxf(lg[gi * 4 + 2], lg[gi * 4 + 3])); if (mx > gbest) { gbest = mx; gs = gi; } }
            float l4[4];
#pragma unroll
            for (int i = 0; i < 4; ++i) { float t0 = lg[i];
#pragma unroll
                for (int gi = 1; gi < 4; ++gi) t0 = (gs == gi) ? lg[gi * 4 + i] : t0; l4[i] = t0; }
            int i0 = 0; float b0 = l4[0];
#pragma unroll
            for (int i = 1; i < 4; ++i) if (l4[i] > b0) { b0 = l4[i]; i0 = i; }
            int i1 = 0; float b1 = -3e38f;
#pragma unroll
            for (int i = 0; i < 4; ++i) if (i != i0 && l4[i] > b1) { b1 = l4[i]; i1 = i; }
            const float e1 = __expf(b1 - b0); const float g0 = 1.f / (1.f + e1), g1 = e1 / (1.f + e1);
            u32x4 as; as.x = (unsigned)(gs * 4 + i0); as.y = (unsigned)(gs * 4 + i1); as.z = __float_as_uint(g0); as.w = __float_as_uint(g1);
            asg[F.wave * 16 + lane] = as;
        }
        __syncthreads();
        if (F.wave == 0) {
            const u32x4 A0 = asg[lane], A1 = asg[lane + 64];
            const unsigned ex[4] = {A0.x, A0.y, A1.x, A1.y};
            unsigned rank[4] = {0u, 0u, 0u, 0u}, mycount = 0u;
            const unsigned long long lt = (1ull << lane) - 1ull;
#pragma unroll 1
            for (unsigned e = 0; e < NE; ++e) { unsigned run = 0u;
#pragma unroll
                for (int s = 0; s < 4; ++s) { const unsigned long long m = __ballot(ex[s] == e); if (ex[s] == e) rank[s] = run + (unsigned)__popcll(m & lt); run += (unsigned)__popcll(m); }
                if ((unsigned)lane == e) mycount = run; }
            if (lane < NE) basep[lane] = atomicAdd(cnt + lane, mycount);
            asm volatile("s_waitcnt vmcnt(0) lgkmcnt(0)" ::: "memory");
            const unsigned p0 = basep[ex[0]] + rank[0], p1 = basep[ex[1]] + rank[1], p2 = basep[ex[2]] + rank[2], p3 = basep[ex[3]] + rank[3];
            const int ra = blk * 128 + lane, rb = ra + 64;
            list[ex[0] * T + p0] = ra; list[ex[1] * T + p1] = ra; list[ex[2] * T + p2] = rb; list[ex[3] * T + p3] = rb;
            u32x4 ta, tb; ta.x = (ex[0] << 24) | p0; ta.y = (ex[1] << 24) | p1; ta.z = A0.z; ta.w = A0.w; tb.x = (ex[2] << 24) | p2; tb.y = (ex[3] << 24) | p3; tb.z = A1.z; tb.w = A1.w;
            *(u32x4*)(tokinfo + (size_t)ra * 4) = ta; *(u32x4*)(tokinfo + (size_t)rb * 4) = tb;
        }
        __syncthreads();
    }
}

__device__ __forceinline__ void moe_table(const Args& a, const Frame& F, int l) {
    LAS int* tab = (LAS int*)(F.lds + TAB_OFF);
    const unsigned* cnt = (const unsigned*)(a.ws + WS_CTL) + CW_CNT + l * 64;
    if (F.tid == 0) { int ts = 0; for (int e = 0; e < NE; ++e) { const int c = (int)__hip_atomic_load(cnt + e, RLX_AGENT); tab[e] = ts; tab[NE + 1 + e] = c; ts += (c + TM - 1) / TM; } tab[NE] = ts; }
    __syncthreads();
}

__device__ __forceinline__ void phase_combine_ln2(const Args& a, const Frame& F, int l) {
    bf16_t* xres = (bf16_t*)(a.ws + WS_XRES); const bf16_t* x1 = (const bf16_t*)(a.ws + WS_X1B); const unsigned char* Y = a.ws + WS_Y;   const unsigned* tokinfo = (const unsigned*)(a.ws + WS_TOK); unsigned char* xn = a.ws + WS_XN;
    const float* g = a.ln2_g + l * D; const float* bta = a.ln2_b + l * D; float* out = (l == DEPTH - 1) ? a.out : nullptr;
    const LAS int* tab = (const LAS int*)(F.lds + TAB_OFF);
    const int lane = F.lane;
    for (int row = F.gw; row < T; row += F.ngw) {
        const unsigned i0 = tokinfo[row * 4], i1 = tokinfo[row * 4 + 1]; const float g0 = __uint_as_float(tokinfo[row * 4 + 2]), g1 = __uint_as_float(tokinfo[row * 4 + 3]);
        const size_t s0 = (size_t)tab[i0 >> 24] * TM + (i0 & 0xffffff), s1 = (size_t)tab[i1 >> 24] * TM + (i1 & 0xffffff);
        f32x4 v[4];
#pragma unroll
        for (int j = 0; j < 4; ++j) { const int c = 4 * lane + 256 * j; const u32x2 xw = *(const u32x2*)(x1 + (size_t)row * D + c); const f32x4 xv = {bflo(xw.x), bfhi(xw.x), bflo(xw.y), bfhi(xw.y)};
            const unsigned ya = *(const unsigned*)(Y + s0 * D + c), yb = *(const unsigned*)(Y + s1 * D + c);
            const f32x2 a01 = __builtin_amdgcn_cvt_pk_f32_fp8((int)ya, false), a23 = __builtin_amdgcn_cvt_pk_f32_fp8((int)ya, true), b01 = __builtin_amdgcn_cvt_pk_f32_fp8((int)yb, false), b23 = __builtin_amdgcn_cvt_pk_f32_fp8((int)yb, true);
            const float h0 = g0 * (1.f / SC_Y), h1 = g1 * (1.f / SC_Y);
            v[j].x = ALPHA * xv.x + h0 * a01[0] + h1 * b01[0]; v[j].y = ALPHA * xv.y + h0 * a01[1] + h1 * b01[1];
            v[j].z = ALPHA * xv.z + h0 * a23[0] + h1 * b23[0]; v[j].w = ALPHA * xv.w + h0 * a23[1] + h1 * b23[1]; }
        ln_rows16(v, g, bta, lane);
        store_row(v, lane, xres + (size_t)row * D, xn + (size_t)row * D, out ? out + (size_t)row * D : nullptr);
        if (l + 1 < DEPTH) fox_gates_row(a, F, l + 1, v, row);
    }
}


constexpr int ATT_F2_OFF = 86016;
__device__ __forceinline__ void phase_attn(const Args& a, const Frame& F, char* lds_generic) {
    const int c = F.bid, vcu = (F.G % 8 == 0) ? (c % 8) * (F.G / 8) + c / 8 : c;
    const attn_body::bf16* Q = (const attn_body::bf16*)(a.ws + WS_QO); const attn_body::bf16* K = (const attn_body::bf16*)(a.ws + WS_KV); const attn_body::bf16* V = K + 512;
    attn_body::bf16* O = (attn_body::bf16*)(a.ws + WS_OX8);
    const float* FL = (const float*)(a.ws + WS_FL);
    LAS float* f2 = (LAS float*)(F.lds + ATT_F2_OFF); LAS float* wsum = f2 + 2048;
    { const int bh = vcu >> 1; if (bh >= BATCH * NH) return;
        const int b = bh >> 3, h = bh & 7, tid = F.tid, lane = F.lane, w = F.wave;
        float v[4], run = 0.f;
#pragma unroll
        for (int i = 0; i < 4; ++i) { run += FL[((size_t)b * SEQ + tid * 4 + i) * 8 + h]; v[i] = run; }
        float incl = run;
#pragma unroll
        for (int o = 1; o < 64; o <<= 1) { const float u = __shfl_up(incl, o); if (lane >= o) incl += u; }
        if (lane == 63) wsum[w] = incl;
        __syncthreads();
        float base = incl - run; for (int i = 0; i < w; ++i) base += wsum[i];
        f32x4 o4; o4[0] = (base + v[0]) * LOG2E; o4[1] = (base + v[1]) * LOG2E; o4[2] = (base + v[2]) * LOG2E; o4[3] = (base + v[3]) * LOG2E;
        *(LAS f32x4*)(f2 + tid * 4) = o4;
        __syncthreads();
        const int nun = (vcu & 1) ? 6 : 2;
        for (int i = 0; i < nun; ++i) { const int qb = (vcu & 1) ? ((i < 4) ? 6 - i : 5 - i) : ((i == 0) ? 7 : 2);
            int tid_u = F.tid; asm volatile("" : "+v"(tid_u));
            attn_body::attn_unit<40>(b, h, qb, Q, K, V, O, lds_generic + RING_OFF, f2, tid_u); }
        __syncthreads();
    }
}

namespace hg {
constexpr int PB = 144;
constexpr int O_QS = 0, O_KS = 9216, O_QI = 18432, O_KUT = 27648, O_VT = 36864, O_P = 46080, O_ST = 55296, O_TOT = 64512, O_EBL = 66560, O_RED = 66816, BYTES = 67328;
__device__ __forceinline__ float ex(float v) { return __builtin_amdgcn_exp2f(v * LOG2E); }
__device__ __forceinline__ unsigned short bf1(float v) { return (unsigned short)pk2(v, v); }
}
__device__ __forceinline__ void phase_hgrn(const Args& a, const Frame& F, int l, int bh) {
    using namespace hg;
    const bf16_t* HB = (const bf16_t*)(a.ws + WS_HB); const float* LOGF = (const float*)(a.ws + WS_LOGF); const bf16_t* HG = (const bf16_t*)(a.ws + WS_HG); unsigned char* O8 = a.ws + WS_OX8;
    LAS unsigned char* L = F.lds + RING_OFF;
    const int b = bh >> 3, h = bh & 7, lane = F.lane, w = F.wave, tid = F.tid;
    const int fr = lane & 15, fq = lane >> 4;
    const int tr = w >> 1, tc0 = 2 * (w & 1);
    const float ng0 = a.norm_g[l * 512 + h * 64 + 16 * tc0 + fr], ng1 = a.norm_g[l * 512 + h * 64 + 16 * (tc0 + 1) + fr];
    f32x4 S0 = {0.f, 0.f, 0.f, 0.f}, S1 = {0.f, 0.f, 0.f, 0.f};
    for (int i = tid; i < 9216 / 4; i += NWAVES * 64) ((LAS unsigned*)(L + O_ST))[i] = 0u;
    const size_t rowbase = (size_t)b * SEQ;
    float g[8]; unsigned short qv[8], vv[8];
#pragma unroll
    for (int i = 0; i < 8; ++i) { const size_t row = rowbase + 8 * w + i; g[i] = LOGF[row * 512 + h * 64 + lane]; qv[i] = HB[row * 1024 + h * 64 + lane]; vv[i] = HB[row * 1024 + 512 + h * 64 + lane]; }
    for (int c0 = 0; c0 < SEQ; c0 += 64) {
        float bc[8]; { float run = 0.f;
#pragma unroll
            for (int i = 0; i < 8; ++i) { run += g[i]; bc[i] = run; } }
        ((LAS float*)(L + O_TOT))[w * 64 + lane] = bc[7];
        float qf[8], kf[8];
#pragma unroll
        for (int i = 0; i < 8; ++i) { qf[i] = bf2f(qv[i]); kf[i] = 1.f - ex(g[i]); }
        { u32x4 pk; pk.x = (unsigned)vv[0] | ((unsigned)vv[1] << 16); pk.y = (unsigned)vv[2] | ((unsigned)vv[3] << 16); pk.z = (unsigned)vv[4] | ((unsigned)vv[5] << 16); pk.w = (unsigned)vv[6] | ((unsigned)vv[7] << 16);
          *(LAS u32x4*)(L + O_VT + lane * PB + 16 * w) = pk; }
        __syncthreads();
        float base = 0.f, bm = 0.f, bl = 0.f;
#pragma unroll
        for (int ww = 0; ww < 8; ++ww) { const float tv = ((LAS float*)(L + O_TOT))[ww * 64 + lane]; if (ww < w) base += tv; if (ww < 4) bm += tv; bl += tv; }
        const float ebm = ex(bm), eblm = ex(bl - bm);
        if (w == 0) ((LAS float*)(L + O_EBL))[lane] = ex(bl);
        unsigned short ku[8];
#pragma unroll
        for (int i = 0; i < 8; ++i) { const float x = bc[i] + base - bm; const float e1 = ex(fminf(x, 80.f)), e2 = ex(fminf(-x, 80.f));
            const float qs = qf[i] * e1, ks = kf[i] * e2; const int r = 8 * w + i;
            *(LAS unsigned short*)(L + O_QS + r * PB + 2 * lane) = bf1(qs); *(LAS unsigned short*)(L + O_QI + r * PB + 2 * lane) = bf1(qs * ebm);
            *(LAS unsigned short*)(L + O_KS + r * PB + 2 * lane) = bf1(ks); ku[i] = bf1(ks * eblm); }
        { u32x4 pk; pk.x = (unsigned)ku[0] | ((unsigned)ku[1] << 16); pk.y = (unsigned)ku[2] | ((unsigned)ku[3] << 16); pk.z = (unsigned)ku[4] | ((unsigned)ku[5] << 16); pk.w = (unsigned)ku[6] | ((unsigned)ku[7] << 16);
          *(LAS u32x4*)(L + O_KUT + lane * PB + 16 * w) = pk; }
        if (c0 + 64 < SEQ) {
#pragma unroll
            for (int i = 0; i < 8; ++i) { const size_t row = rowbase + c0 + 64 + 8 * w + i; g[i] = LOGF[row * 512 + h * 64 + lane]; qv[i] = HB[row * 1024 + h * 64 + lane]; vv[i] = HB[row * 1024 + 512 + h * 64 + lane]; }
        }
        __syncthreads();
#pragma unroll
        for (int k2 = 0; k2 < 2; ++k2) { const int idx = 2 * w + k2, ti = idx >> 2, sj = idx & 3;
            f32x4 sc = {0.f, 0.f, 0.f, 0.f};
            if (sj <= ti) {
#pragma unroll
                for (int kk = 0; kk < 2; ++kk) { const bf16x8 af = *(const LAS bf16x8*)(L + O_QS + (16 * ti + fr) * PB + (32 * kk + 8 * fq) * 2), bfr = *(const LAS bf16x8*)(L + O_KS + (16 * sj + fr) * PB + (32 * kk + 8 * fq) * 2);
                    sc = __builtin_amdgcn_mfma_f32_16x16x32_bf16(af, bfr, sc, 0, 0, 0); }
            }
#pragma unroll
            for (int j = 0; j < 4; ++j) { const int t = 16 * ti + 4 * fq + j, s = 16 * sj + fr; *(LAS unsigned short*)(L + O_P + t * PB + 2 * s) = bf1(s <= t ? sc[j] : 0.f); }
        }
        __syncthreads();
        f32x4 o0 = {0.f, 0.f, 0.f, 0.f}, o1 = {0.f, 0.f, 0.f, 0.f}, u0 = {0.f, 0.f, 0.f, 0.f}, u1 = {0.f, 0.f, 0.f, 0.f};
#pragma unroll
        for (int kk = 0; kk < 2; ++kk) { const int ko = (32 * kk + 8 * fq) * 2;
            const bf16x8 pa = *(const LAS bf16x8*)(L + O_P + (16 * tr + fr) * PB + ko), qa = *(const LAS bf16x8*)(L + O_QI + (16 * tr + fr) * PB + ko), ka = *(const LAS bf16x8*)(L + O_KUT + (16 * tr + fr) * PB + ko);
            const bf16x8 v0 = *(const LAS bf16x8*)(L + O_VT + (16 * tc0 + fr) * PB + ko), v1 = *(const LAS bf16x8*)(L + O_VT + (16 * (tc0 + 1) + fr) * PB + ko);
            const bf16x8 s0 = *(const LAS bf16x8*)(L + O_ST + (16 * tc0 + fr) * PB + ko), s1 = *(const LAS bf16x8*)(L + O_ST + (16 * (tc0 + 1) + fr) * PB + ko);
            o0 = __builtin_amdgcn_mfma_f32_16x16x32_bf16(pa, v0, o0, 0, 0, 0); o1 = __builtin_amdgcn_mfma_f32_16x16x32_bf16(pa, v1, o1, 0, 0, 0);
            o0 = __builtin_amdgcn_mfma_f32_16x16x32_bf16(qa, s0, o0, 0, 0, 0); o1 = __builtin_amdgcn_mfma_f32_16x16x32_bf16(qa, s1, o1, 0, 0, 0);
            u0 = __builtin_amdgcn_mfma_f32_16x16x32_bf16(ka, v0, u0, 0, 0, 0); u1 = __builtin_amdgcn_mfma_f32_16x16x32_bf16(ka, v1, u1, 0, 0, 0); }
        { const f32x4 dec = *(const LAS f32x4*)(L + O_EBL + (16 * tr + 4 * fq) * 4); S0 = S0 * dec + u0; S1 = S1 * dec + u1; }
        { f32x4 q2 = o0 * o0 + o1 * o1;
#pragma unroll
          for (int m = 1; m < 16; m <<= 1) { q2[0] += __shfl_xor(q2[0], m); q2[1] += __shfl_xor(q2[1], m); q2[2] += __shfl_xor(q2[2], m); q2[3] += __shfl_xor(q2[3], m); }
          if (fr == 0) {
#pragma unroll
              for (int j = 0; j < 4; ++j) ((LAS float*)(L + O_RED))[(16 * tr + 4 * fq + j) * 2 + (w & 1)] = q2[j]; } }
        __syncthreads();
        { u32x2 p0, p1; p0.x = pk2(S0[0], S0[1]); p0.y = pk2(S0[2], S0[3]); p1.x = pk2(S1[0], S1[1]); p1.y = pk2(S1[2], S1[3]);
          *(LAS u32x2*)(L + O_ST + (16 * tc0 + fr) * PB + (16 * tr + 4 * fq) * 2) = p0; *(LAS u32x2*)(L + O_ST + (16 * (tc0 + 1) + fr) * PB + (16 * tr + 4 * fq) * 2) = p1; }
#pragma unroll
        for (int j = 0; j < 4; ++j) { const int t = 16 * tr + 4 * fq + j; const f32x2 rr = *(const LAS f32x2*)(L + O_RED + t * 8); const float rs = rsqrtf((rr[0] + rr[1]) * (1.f / 64.f) + RMS_EPS);
            *(LAS unsigned short*)(L + O_P + t * PB + 2 * (16 * tc0 + fr)) = bf1(o0[j] * rs * ng0); *(LAS unsigned short*)(L + O_P + t * PB + 2 * (16 * (tc0 + 1) + fr)) = bf1(o1[j] * rs * ng1); }
        __syncthreads();
        { const int t = tid >> 3, e8 = (tid & 7) * 8; const size_t row = rowbase + c0 + t;
          const u32x4 ov = *(const LAS u32x4*)(L + O_P + t * PB + e8 * 2), gv = *(const u32x4*)(HG + row * 512 + h * 64 + e8);
          u32x2 r; r.x = pg8::pack4_fp8(bflo(ov.x) * bflo(gv.x) * SC_HGRN, bfhi(ov.x) * bfhi(gv.x) * SC_HGRN, bflo(ov.y) * bflo(gv.y) * SC_HGRN, bfhi(ov.y) * bfhi(gv.y) * SC_HGRN);
          r.y = pg8::pack4_fp8(bflo(ov.z) * bflo(gv.z) * SC_HGRN, bfhi(ov.z) * bfhi(gv.z) * SC_HGRN, bflo(ov.w) * bflo(gv.w) * SC_HGRN, bfhi(ov.w) * bfhi(gv.w) * SC_HGRN);
          *(u32x2*)(O8 + row * 1024 + 512 + h * 64 + e8) = r; }
        __syncthreads();
    }
}


constexpr int PH_PER_LAYER = 10, N_PHASES = 1 + DEPTH * PH_PER_LAYER;
#ifndef MK_ONE_LAUNCH
#define MK_ONE_LAUNCH 1
#endif
#ifndef MK_FAST_ATTN
#define MK_FAST_ATTN 0
#endif
#ifndef MK_FAST_HGRN
#define MK_FAST_HGRN 0
#endif


#ifdef DBG_DUMP
#ifndef DBG_WHAT
#define DBG_WHAT 0
#endif
__device__ __forceinline__ void dbg_dump(const Args& a, const Frame& F) {
    unsigned char* ws = a.ws;
    const bf16_t *QO = (bf16_t*)(ws + WS_QO), *KV = (bf16_t*)(ws + WS_KV), *HB = (bf16_t*)(ws + WS_HB), *HG = (bf16_t*)(ws + WS_HG), *G = (bf16_t*)(ws + WS_G);
    const bf16_t *U1 = (bf16_t*)(ws + WS_U1), *U = (bf16_t*)(ws + WS_U), *MIXED = (bf16_t*)(ws + WS_MIXED), *XN = (bf16_t*)(ws + WS_XN);
    const float *LOGF = (float*)(ws + WS_LOGF), *FL = (float*)(ws + WS_FL), *XRES = (float*)(ws + WS_XRES);
    for (size_t i = (size_t)F.bid * 512 + F.tid; i < (size_t)T * D; i += (size_t)gridDim.x * 512) {
        const size_t row = i >> 10; const int c = (int)(i & 1023);
        float v = 0.f;
        if (DBG_WHAT == 9) { v = bf2f(G[row * 2048 + c]) + bf2f(G[row * 2048 + 1024 + c]); }
        else if (DBG_DUMP == 1) { v = bf2f(KV[i]) + bf2f(HB[i]) + bf2f(G[row * 2048 + c]) + bf2f(G[row * 2048 + 1024 + c]);
            if (c < 512) v += LOGF[row * 512 + c] + bf2f(HG[row * 512 + c]) + bf2f(QO[i]); if (c < 8) v += FL[row * 8 + c]; }
        else if (DBG_DUMP == 2) { v = (c >= 512) ? bf2f(QO[i]) : 0.f; }
        else if (DBG_DUMP == 3) { v = bf2f(QO[i]); }
        else if (DBG_DUMP == 4) { v = bf2f(U1[i]); }
        else if (DBG_DUMP == 5) { v = bf2f(U[i]); }
        else if (DBG_DUMP == 6) { v = bf2f(MIXED[i]); }
        else if (DBG_DUMP == 7) { v = XRES[i] + bf2f(XN[i]); }
        a.out[i] = v;
    }
}
#endif
#define PH_BEGIN const Args a = LOAD_ARGS(); Frame F; F.lds = lds0; F.lane = (int)__builtin_amdgcn_mbcnt_hi(~0u, __builtin_amdgcn_mbcnt_lo(~0u, 0u)); asm volatile("" : "+v"(F.lane)); F.wave = __builtin_amdgcn_readfirstlane((int)((const volatile LAS unsigned*)(lds0 + WTAB_OFF))[hw_wave_key()]); F.tid = F.wave * 64 + F.lane; \
    F.G = gridDim.x; F.bid = blockIdx.x; asm volatile("" : "+s"(F.bid)); F.gw = F.bid * NWAVES + F.wave; F.ngw = F.G * NWAVES; unsigned char* const ws = a.ws; const LAS int* tab = (const LAS int*)(F.lds + TAB_OFF); (void)tab; (void)ws;
#ifdef DBG_DUMP
#define IN(k) (lo <= (k) && (k) < hi && (k) <= DBG_DUMP)
#else
#define IN(k) (lo <= (k) && (k) < hi)
#endif
#ifdef DBG_REPEAT
#define REP(k) for (int rep_ = 0; rep_ < ((DBG_REPEAT == (k) && !((k) == 9 && l == DEPTH - 1)) ? 2 : 1); ++rep_)
#else
#define REP(k)
#endif
#define SEAM(k) do { if (IN(k) && IN((k) + 1)) { XcdBarrier b2_ = bar; { size_t z_ = 0; asm volatile("" : "+s"(z_), "+s"(b2_.x)); b2_.bar = bar.bar + z_; } xcd_barrier(b2_); } } while (0)
template <int l>
__device__ __forceinline__ void layer_body(const Args& args, const int lo, const int hi, const XcdBarrier& bar, LAS unsigned char* const lds0, unsigned char* lds_raw) {
        const int pb = 1 + l * PH_PER_LAYER;

#ifdef DBG_DUMP
        if (l == 0 && lo <= DBG_DUMP + 1 && DBG_DUMP + 1 < hi) { PH_BEGIN dbg_dump(a, F); }
#endif
        if (IN(pb + 0)) REP(0) { PH_BEGIN
            pg8::Gemm g{(bf16_t*)(ws + WS_XN), (bf16_t*)(ws + wset(l) + WO_WIN), D / 2, D / 2, D / 2, E8_1, E8_W}; pg8::StaticOrder S; S.init(T, NINP, F.G, F.bid);
            pg8::EpiInproj E{ws, l};
            pg8::gemm_phase<pg8::EpiInproj, pg8::StaticOrder, true>(F.lds + RING_OFF, g, S, E, F.tid);
        }
        SEAM(pb + 0);
        if (IN(pb + 1)) REP(1) { PH_BEGIN
            const int vcu = (F.G % 8 == 0) ? (F.bid % 8) * (F.G / 8) + F.bid / 8 : F.bid;
            if ((vcu & 1) == 0 && (vcu >> 1) < BATCH * NH) { phase_hgrn(a, F, l, vcu >> 1); __syncthreads(); }
            phase_attn(a, F, (char*)lds_raw);
            if (l + 1 < DEPTH) { __syncthreads(); convert_layer(a, F, l + 1, F.gw, F.ngw); }
        }
        SEAM(pb + 1);
        if (IN(pb + 3)) REP(3) { PH_BEGIN
            pg8::Gemm g{(bf16_t*)(ws + WS_OX8), (bf16_t*)(ws + wset(l) + WO_WBR), D / 2, D / 2, 256, E8_FOX, E8_W}; pg8::StaticOrder S; S.init(T, D, F.G, F.bid);
            pg8::EpiGate<1> E{(bf16_t*)(ws + WS_U1), nullptr, (bf16_t*)(ws + WS_G), 2048, nullptr, 0.f};
            pg8::gemm_phase<pg8::EpiGate<1>, pg8::StaticOrder, true>(F.lds + RING_OFF, g, S, E, F.tid);
        }
        if (IN(pb + 3) && IN(pb + 4)) __syncthreads(); else SEAM(pb + 3);
        if (IN(pb + 4)) REP(4) { PH_BEGIN
            pg8::Gemm g{(bf16_t*)(ws + WS_OX8) + 256, (bf16_t*)(ws + wset(l) + WO_WBR) + 256, D / 2, D / 2, 256, E8_HGRN, E8_W}; pg8::StaticOrder S; S.init(T, D, F.G, F.bid);
            pg8::EpiGate<2> E{(bf16_t*)(ws + WS_U), nullptr, (bf16_t*)(ws + WS_G) + 1024, 2048, (bf16_t*)(ws + WS_U1), 0.f};
            pg8::gemm_phase<pg8::EpiGate<2>, pg8::StaticOrder, true>(F.lds + RING_OFF, g, S, E, F.tid);
        }
        SEAM(pb + 4);
        if (IN(pb + 5)) REP(5) { PH_BEGIN
            pg8::Gemm g{(bf16_t*)(ws + WS_U), (bf16_t*)(ws + wset(l) + WO_WMIX), D / 2, D / 2, D / 2, E8_U, E8_W}; pg8::StaticOrder S; S.init(T, D, F.G, F.bid);
            pg8::EpiGate<0> E{(bf16_t*)(ws + WS_MIXED), a.b_mix + l * D, nullptr, 0, nullptr, SC_MIX};
            pg8::gemm_phase<pg8::EpiGate<0>, pg8::StaticOrder, true>(F.lds + RING_OFF, g, S, E, F.tid);
        }
        SEAM(pb + 5);
        if (IN(pb + 6)) REP(6) { PH_BEGIN phase_ln1_router(a, F, l); }
        SEAM(pb + 6);
        if (IN(pb + 7)) REP(7) { PH_BEGIN
            moe_table(a, F, l);
            pg8::Gemm g{(bf16_t*)(ws + WS_XN), (bf16_t*)(ws + wset(l) + WO_W13), D / 2, D / 2, D / 2, E8_1, E8_W}; pg8::MoeOrder<true> S{F.G, F.bid, 8, tab, (const int*)(ws + WS_LIST), (size_t)2048 * (D / 2)};
            pg8::EpiUp E{(bf16_t*)(ws + WS_H)};
            pg8::gemm_phase<pg8::EpiUp, pg8::MoeOrder<true>, true>(F.lds + RING_OFF, g, S, E, F.tid);
        }
        SEAM(pb + 7);
        if (IN(pb + 8)) REP(8) { PH_BEGIN
            moe_table(a, F, l);
            pg8::Gemm g{(bf16_t*)(ws + WS_H), (bf16_t*)(ws + wset(l) + WO_W2), D / 2, D / 2, D / 2, E8_H, E8_W}; pg8::MoeOrder<false> S{F.G, F.bid, 4, tab, nullptr, (size_t)D * (D / 2)};
            pg8::EpiGate<0> E{(bf16_t*)(ws + WS_Y), nullptr, nullptr, 0, nullptr, SC_Y};
            pg8::gemm_phase<pg8::EpiGate<0>, pg8::MoeOrder<false>, true>(F.lds + RING_OFF, g, S, E, F.tid);
        }
        SEAM(pb + 8);
        if (IN(pb + 9)) REP(9) { PH_BEGIN
            if (l + 1 < DEPTH) load_wff(a, F, l + 1);
            moe_table(a, F, l);
            phase_combine_ln2(a, F, l);
        }
        SEAM(pb + 9);
    }

__global__ void __launch_bounds__(NWAVES * 64, 2) mk_fwd(Args args) {
    extern __shared__ __attribute__((aligned(16))) unsigned char lds_raw[];
    LAS unsigned char* const lds0 = (LAS unsigned char*)lds_raw;
    volatile LAS unsigned* MISC = (volatile LAS unsigned*)(lds0 + MISC_OFF);
    for (int u = threadIdx.x; u < (LDS_BYTES - LDSCTL_OFF) / 4; u += NWAVES * 64) ((LAS unsigned*)(lds0 + LDSCTL_OFF))[u] = 0u;
    __syncthreads();
    if ((threadIdx.x & 63) == 0) ((volatile LAS unsigned*)(lds0 + WTAB_OFF))[hw_wave_key()] = threadIdx.x >> 6;
    __syncthreads();
    unsigned* ctl = (unsigned*)(args.ws + WS_CTL);
    XcdBarrier bar; bar.bar = ctl + CW_BAR; bar.x = 0; bar.st = nullptr;
    if (args.use_bar) bar = xcd_barrier_post(ctl + CW_BAR, MISC + 8);
    const int lo = args.ph_lo, hi = args.ph_hi;


    if (IN(0)) { PH_BEGIN phase_prep(a, F); }
    SEAM(0);
    layer_body<0>(args, lo, hi, bar, lds0, lds_raw); layer_body<1>(args, lo, hi, bar, lds0, lds_raw); layer_body<2>(args, lo, hi, bar, lds0, lds_raw); layer_body<3>(args, lo, hi, bar, lds0, lds_raw);
#undef IN
#undef SEAM
}

extern "C" void kernel_launch(void* const* d_in, const int* in_sizes, int n_in, void* d_out, int out_size, void* d_ws, size_t ws_size, hipStream_t stream) {
    static int grid = 0;
    if (grid == 0) {
        if (n_in != 20 || in_sizes[0] != T * D || out_size != T * D || ws_size < WS_END) { fprintf(stderr, "kernel_launch: unexpected shapes (n_in %d, ws %zu)\n", n_in, ws_size); grid = -1; return; }
        int dev = 0, cus = 0, per_cu = 0;
        if (hipGetDevice(&dev) != hipSuccess || hipDeviceGetAttribute(&cus, hipDeviceAttributeMultiprocessorCount, dev) != hipSuccess) { grid = -1; return; }
        if (hipFuncSetAttribute((const void*)mk_fwd, hipFuncAttributeMaxDynamicSharedMemorySize, LDS_BYTES) != hipSuccess) { fprintf(stderr, "kernel_launch: hipFuncSetAttribute failed\n"); grid = -1; return; }
        if (hipOccupancyMaxActiveBlocksPerMultiprocessor(&per_cu, (const void*)mk_fwd, NWAVES * 64, LDS_BYTES) != hipSuccess || per_cu < 1)
            fprintf(stderr, "kernel_launch: note: occupancy query reports %d workgroups per CU\n", per_cu);
        (void)hipGetLastError();
        grid = cus;
    }
    if (grid < 0) return;
    if (hipMemsetAsync((char*)d_ws + WS_CTL, 0, CTL_BYTES, stream) != hipSuccess) return;
    Args a{};
    a.x = (const float*)d_in[0]; a.ln_in_g = (const float*)d_in[1]; a.ln_in_b = (const float*)d_in[2]; a.w_in = (const float*)d_in[3]; a.b_in = (const float*)d_in[4];
    a.w_fox = (const float*)d_in[5]; a.lbl = (const float*)d_in[6]; a.norm_g = (const float*)d_in[7]; a.w_hgrn = (const float*)d_in[8]; a.w_mix = (const float*)d_in[9];
    a.b_mix = (const float*)d_in[10]; a.ln1_g = (const float*)d_in[11]; a.ln1_b = (const float*)d_in[12]; a.router_w = (const float*)d_in[13]; a.router_b = (const float*)d_in[14];
    a.w1 = (const float*)d_in[15]; a.w3 = (const float*)d_in[16]; a.w2 = (const float*)d_in[17]; a.ln2_g = (const float*)d_in[18]; a.ln2_b = (const float*)d_in[19];
    a.out = (float*)d_out; a.ws = (unsigned char*)d_ws; a.pad = 0;
#if MK_ONE_LAUNCH
    a.ph_lo = 0; a.ph_hi = N_PHASES; a.use_bar = 1;
    hipLaunchKernelGGL(mk_fwd, dim3(grid), dim3(NWAVES * 64), LDS_BYTES, stream, a);
#else
#ifdef DBG_DUMP
    const int np_ = DBG_DUMP + 2;
#else
    const int np_ = N_PHASES;
#endif
    for (int p = 0; p < np_; ++p) { a.ph_lo = p; a.ph_hi = p + 1; a.use_bar = 0;
        hipLaunchKernelGGL(mk_fwd, dim3(grid), dim3(NWAVES * 64), LDS_BYTES, stream, a); }
#endif
    const hipError_t le = hipPeekAtLastError();
    if (le != hipSuccess) fprintf(stderr, "kernel_launch: launch failed: %s\n", hipGetErrorName(le));
}
```

```cpp
#define MK_ONE_LAUNCH 1
#define MK_FAST_ATTN 1
#define MK_FAST_HGRN 1
#include <hip/hip_runtime.h>
#include <cstdio>
#include <cstdint>

typedef unsigned short bf16_t;
typedef short bf16x8 __attribute__((ext_vector_type(8)));
typedef float f32x4 __attribute__((ext_vector_type(4)));
typedef float f32x2 __attribute__((ext_vector_type(2)));
typedef unsigned u32x4 __attribute__((ext_vector_type(4)));
typedef unsigned u32x2 __attribute__((ext_vector_type(2)));
#define LAS __attribute__((address_space(3)))
#define GAS __attribute__((address_space(1)))

constexpr int BATCH = 16, SEQ = 2048, T = BATCH * SEQ, D = 1024, DEPTH = 4, NH = 8, HD = 64, NIN = 5640, NINP = 5632, NE = 16;
constexpr float LN_EPS = 1e-5f, RMS_EPS = 1e-6f;
constexpr float ALPHA = 1.681792830507429f;
constexpr float LOG2E = 1.4426950408889634f;
constexpr float C2 = 0.125f * LOG2E;
constexpr float SC_W = 64.f, SC_FOX = 16.f, SC_HGRN = 4.f, SC_U = 64.f, SC_H = 8.f, SC_MIX = 32.f, SC_Y = 64.f;
constexpr int E8_1 = 0x7f7f7f7f, E8_W = 0x79797979, E8_FOX = 0x7b7b7b7b, E8_HGRN = 0x7d7d7d7d, E8_U = 0x79797979, E8_H = 0x7c7c7c7c;
constexpr int TM = 256;

constexpr size_t MiB = 1u << 20;
constexpr size_t WS_CTL = 0, CTL_BYTES = 1 * MiB;
constexpr size_t WS_MISC = 1 * MiB;
constexpr size_t WS_WSET = 2 * MiB, WSET_BYTES = 56 * MiB;
constexpr size_t WO_WIN = 0, WO_WBR = 6 * MiB, WO_WMIX = 7 * MiB, WO_W13 = 8 * MiB, WO_W2 = 40 * MiB;
__host__ __device__ constexpr size_t wset(int l) { return WS_WSET + (size_t)(l & 1) * WSET_BYTES; }
__host__ __device__ constexpr size_t biasoff(int l) { return WS_MISC + 16384 + (size_t)(l & 1) * 32768; }
constexpr size_t WS_XRES = 114 * MiB, WS_XN = 242 * MiB, WS_QO = 306 * MiB, WS_KV = 370 * MiB, WS_HB = 434 * MiB, WS_LOGF = 498 * MiB;
constexpr size_t WS_HG = 562 * MiB, WS_G = 594 * MiB, WS_FL = 722 * MiB, WS_F2 = 723 * MiB, WS_U1 = 724 * MiB, WS_U = 788 * MiB, WS_MIXED = 852 * MiB;
constexpr size_t WS_LIST = 916 * MiB, WS_TOK = 918 * MiB, WS_X1B = 920 * MiB, WS_END = 984 * MiB;
constexpr size_t WS_OX8 = 274 * MiB;
constexpr size_t WS_H = WS_QO, WS_Y = 442 * MiB;
constexpr int CW_CNT = 1024;
constexpr int CW_BAR = 4096;

__device__ __forceinline__ unsigned f2bf(float f) { unsigned u = __builtin_bit_cast(unsigned, f); return (u + 0x7fffu + ((u >> 16) & 1u)) >> 16; }
__device__ __forceinline__ float bf2f(unsigned h) { return __builtin_bit_cast(float, h << 16); }
__device__ __forceinline__ float bflo(unsigned w) { return __builtin_bit_cast(float, w << 16); }
__device__ __forceinline__ float bfhi(unsigned w) { return __builtin_bit_cast(float, w & 0xffff0000u); }
typedef __bf16 bf16x2v_t __attribute__((ext_vector_type(2)));
__device__ __forceinline__ unsigned pk2(float lo, float hi) { f32x2 v = {lo, hi}; bf16x2v_t b = __builtin_convertvector(v, bf16x2v_t); return __builtin_bit_cast(unsigned, b); }
__device__ __forceinline__ float wave_sum(float v) {
#pragma unroll
    for (int o = 1; o < 64; o <<= 1) v += __shfl_xor(v, o);
    return v;
}
__device__ __forceinline__ float wave_max(float v) {
#pragma unroll
    for (int o = 1; o < 64; o <<= 1) v = fmaxf(v, __shfl_xor(v, o));
    return v;
}
__device__ __forceinline__ float fast_exp(float v) { return __builtin_amdgcn_exp2f(v * LOG2E); }
__device__ __forceinline__ float sigmoidf_(float v) { return __builtin_amdgcn_rcpf(1.0f + fast_exp(-v)); }
__device__ __forceinline__ float siluf_(float v) { return v * sigmoidf_(v); }
__device__ __forceinline__ float logsigmoidf_(float v) { return fminf(v, 0.f) - __logf(1.0f + fast_exp(-fabsf(v))); }

namespace pg8 {
constexpr int BM = 256, BK = 64, HALF = 128, HTB = HALF * BK * 2  , STAGE_BYTES = 8 * HTB, NXCD = 8, WGM = 8;
__host__ __device__ __forceinline__ int lds_byte(int r, int c) { const int st = (r >> 4) * 2 + (c >> 5), rr = r & 15, cc = c & 31, ob = rr * 64 + cc * 2; return st * 1024 + (ob ^ (((ob >> 9) & 1) << 5)); }
__host__ __device__ __forceinline__ void stage_rc(int b, int& R, int& C) { const int st = b / 1024, sb = b % 1024, swz = sb ^ (((sb >> 9) & 1) << 5); R = (st >> 1) * 16 + swz / 64; C = (st & 1) * 32 + (swz % 64) / 2; }
__host__ __device__ __forceinline__ int perm32(int rho) { const int n = rho >> 4, i = rho & 15; return 8 * (i >> 2) + 4 * n + (i & 3); }

struct Unit { int pm, pn, e; };
struct Gemm { const bf16_t* A; const bf16_t* Bt; int lda, ldb, K; int sa, sb; };

struct StaticOrder {
    static constexpr bool GATHER = false;
    int nM, nN, nwg, G, c;
    __device__ void init(int M, int N, int G_, int c_) { nM = M / BM; nN = N / BM; nwg = nM * nN; G = G_; c = c_; }
    __device__ bool next(int i, Unit& u) const {
        const int L = i * G + c; if (L >= nwg) return false;
        int wgid = L; { const int q = nwg / NXCD, r = nwg % NXCD, xcd = wgid % NXCD, off = wgid / NXCD; wgid = (xcd < r ? xcd * (q + 1) : r * (q + 1) + (xcd - r) * q) + off; }
        const int nig = WGM * nN, gid = wgid / nig, fm = gid * WGM, gsz = (nM - fm) < WGM ? (nM - fm) : WGM;
        u.pm = fm + ((wgid % nig) % gsz); u.pn = (wgid % nig) / gsz; u.e = 0; return true;
    }
    __device__ __forceinline__ const char* a_tile(const Gemm& g, const Unit& u) const { return (const char*)g.A + (size_t)u.pm * BM * g.lda * 2; }
    __device__ __forceinline__ const char* b_tile(const Gemm& g, const Unit& u) const { return (const char*)g.Bt + (size_t)u.pn * BM * g.ldb * 2; }
    __device__ __forceinline__ void a_voff(const Gemm& g, const Unit&, int, const int (&R)[2], const int (&C)[2], unsigned (&v)[2][2]) const {
#pragma unroll
        for (int h = 0; h < 2; ++h)
#pragma unroll
            for (int i = 0; i < 2; ++i) v[h][i] = (unsigned)((h * HALF + R[i]) * g.lda + C[i]) * 2u;
    }
};
template <bool GATHER_> struct MoeOrder {
    static constexpr bool GATHER = GATHER_; static constexpr bool gather = GATHER_;
    int G, c, nN; const LAS int* tab; const int* list; size_t bstride; const LAS int* tok;
    __device__ bool next(int i, Unit& u) const {
        const int L = i * G + c; const int rt = L / nN; const int NT = tab[NE]; if (rt >= NT) return false;
        int e = 0;
#pragma unroll
        for (int k = 1; k < NE; ++k) e += (rt >= tab[k]) ? 1 : 0;
        u.pm = __builtin_amdgcn_readfirstlane(rt); u.pn = __builtin_amdgcn_readfirstlane(L % nN); u.e = __builtin_amdgcn_readfirstlane(e); return true;
    }
    __device__ __forceinline__ const char* a_tile(const Gemm& g, const Unit& u) const { return gather ? (const char*)g.A : (const char*)g.A + (size_t)u.pm * BM * g.lda * 2; }
    __device__ __forceinline__ const char* b_tile(const Gemm& g, const Unit& u) const { return (const char*)g.Bt + ((size_t)u.e * bstride + (size_t)u.pn * BM * g.ldb) * 2; }
    __device__ __forceinline__ void a_voff(const Gemm& g, const Unit& u, int ui, const int (&R)[2], const int (&C)[2], unsigned (&v)[2][2]) const {
#pragma unroll
        for (int h = 0; h < 2; ++h)
#pragma unroll
            for (int i = 0; i < 2; ++i) {
                if (gather) { const int tk = tok[ui * BM + h * HALF + R[i]]; v[h][i] = (unsigned)(tk * g.lda + C[i]) * 2u; }
                else v[h][i] = (unsigned)((h * HALF + R[i]) * g.lda + C[i]) * 2u;
            }
    }
    __device__ __forceinline__ void preload_tokens(LAS int* tokw, int tid) const {
        Unit u;
        for (int i = 0; next(i, u); ++i) { const int ts = tab[u.e], cn = tab[NE + 1 + u.e];
            for (int r = tid; r < BM; r += 512) { const int pos = (u.pm - ts) * BM + r; tokw[i * BM + r] = (pos < cn) ? list[u.e * T + pos] : 0; } }
    }
};

typedef __bf16 bf16x2_t __attribute__((ext_vector_type(2)));
__device__ __forceinline__ unsigned cvt_pk_bf16(float lo, float hi) { f32x2 v = {lo, hi}; bf16x2_t b = __builtin_convertvector(v, bf16x2_t); return __builtin_bit_cast(unsigned, b); }
__device__ __forceinline__ u32x4 pack8(const f32x4& v0, const f32x4& v1) { u32x4 w; w.x = cvt_pk_bf16(v0[0], v0[1]); w.y = cvt_pk_bf16(v0[2], v0[3]); w.z = cvt_pk_bf16(v1[0], v1[1]); w.w = cvt_pk_bf16(v1[2], v1[3]); return w; }
__device__ __forceinline__ void unpack8(const u32x4& w, f32x4& v0, f32x4& v1) { v0[0] = bflo(w.x); v0[1] = bfhi(w.x); v0[2] = bflo(w.y); v0[3] = bfhi(w.y); v1[0] = bflo(w.z); v1[1] = bfhi(w.z); v1[2] = bflo(w.w); v1[3] = bfhi(w.w); }
typedef int v8i __attribute__((ext_vector_type(8)));
typedef int v4i __attribute__((ext_vector_type(4)));
__device__ __forceinline__ u32x2 pack8_fp8(const f32x4& v0, const f32x4& v1) {
    u32x2 w; int t = 0; t = __builtin_amdgcn_cvt_pk_fp8_f32(v0[0], v0[1], t, false); t = __builtin_amdgcn_cvt_pk_fp8_f32(v0[2], v0[3], t, true); w.x = (unsigned)t;
    int t2 = 0; t2 = __builtin_amdgcn_cvt_pk_fp8_f32(v1[0], v1[1], t2, false); t2 = __builtin_amdgcn_cvt_pk_fp8_f32(v1[2], v1[3], t2, true); w.y = (unsigned)t2; return w; }
__device__ __forceinline__ unsigned pack4_fp8(float a, float b, float c, float d) { int t = 0; t = __builtin_amdgcn_cvt_pk_fp8_f32(a, b, t, false); t = __builtin_amdgcn_cvt_pk_fp8_f32(c, d, t, true); return (unsigned)t; }
__device__ __forceinline__ f32x4 sig4(const f32x4& v) { f32x4 o; o[0] = sigmoidf_(v[0]); o[1] = sigmoidf_(v[1]); o[2] = sigmoidf_(v[2]); o[3] = sigmoidf_(v[3]); return o; }

__device__ __forceinline__ void gld16(f32x4& r, const void* p) { asm volatile("global_load_dwordx4 %0, %1, off" : "=v"(r) : "v"(p) : "memory"); }
__device__ __forceinline__ void gld16u(u32x4& r, const void* p) { asm volatile("global_load_dwordx4 %0, %1, off" : "=v"(r) : "v"(p) : "memory"); }
__device__ __forceinline__ void gld16u_nt(u32x4& r, const void* p) { asm volatile("global_load_dwordx4 %0, %1, off nt" : "=v"(r) : "v"(p) : "memory"); }
#define GWAIT4F(a, b, c, d) asm volatile("s_waitcnt vmcnt(0)" : "+v"(a), "+v"(b), "+v"(c), "+v"(d) :: "memory")
#define GWAIT4U(a, b, c, d) asm volatile("s_waitcnt vmcnt(0)" : "+v"(a), "+v"(b), "+v"(c), "+v"(d) :: "memory")
struct EpiInproj {
    static constexpr bool PERM = true;
    unsigned char* ws; int layer;
    template <int KIND> __device__ __forceinline__ void tile(const f32x4 (&acc)[2][2][4][2], const Unit& u, int wr, int wc, int fr, int fq, unsigned char* w) const {
        const float* biasp = (const float*)(w + biasoff(layer));
        const int row0 = u.pm * BM + wr * 64 + fr, bcol0 = u.pn * BM + wc * 32 + 8 * fq;
        f32x4 bv[2][2], lbv[2][2];
#pragma unroll
        for (int bj = 0; bj < 2; ++bj)
#pragma unroll
            for (int n = 0; n < 2; ++n) gld16(bv[bj][n], biasp + bcol0 + bj * HALF + 4 * n);
        if (KIND == 4) { const float* lb = (const float*)(w + WS_MISC) + layer * 512;
#pragma unroll
            for (int bj = 0; bj < 2; ++bj)
#pragma unroll
                for (int n = 0; n < 2; ++n) gld16(lbv[bj][n], lb + (bcol0 - 2048) + bj * HALF + 4 * n);
            GWAIT4F(lbv[0][0], lbv[0][1], lbv[1][0], lbv[1][1]); }
        GWAIT4F(bv[0][0], bv[0][1], bv[1][0], bv[1][1]);
#pragma unroll
        for (int ai = 0; ai < 2; ++ai)
#pragma unroll
            for (int m = 0; m < 4; ++m) { const size_t row = (size_t)(row0 + ai * HALF + m * 16);
#pragma unroll
                for (int bj = 0; bj < 2; ++bj) { f32x4 v0 = acc[ai][bj][m][0] + bv[bj][0], v1 = acc[ai][bj][m][1] + bv[bj][1]; const int col = bcol0 + bj * HALF;
                    if (KIND == 0) { *(u32x4*)((bf16_t*)(w + WS_QO) + row * 1024 + col) = pack8(v0 * C2, v1 * C2); }
                    else if (KIND == 1) { *(u32x4*)((bf16_t*)(w + WS_KV) + row * 1024 + (col - 512)) = pack8(v0, v1); }
                    else if (KIND == 2) { *(u32x4*)((bf16_t*)(w + WS_KV) + row * 1024 + 512 + (col - 1024)) = pack8(v0, v1); }
                    else if (KIND == 3) { *(u32x4*)((bf16_t*)(w + WS_HB) + row * 1024 + (col - 1536)) = pack8(v0 * sig4(v0), v1 * sig4(v1)); }
                    else if (KIND == 4) { const int c = col - 2048; const f32x4 l0 = lbv[bj][0], l1 = lbv[bj][1];
                        f32x4 f0 = l0 + (1.f - l0) * sig4(v0), f1 = l1 + (1.f - l1) * sig4(v1);
#pragma unroll
                        for (int q = 0; q < 4; ++q) { f0[q] = __logf(f0[q]); f1[q] = __logf(f1[q]); }
                        float* LOGF = (float*)(w + WS_LOGF); *(f32x4*)(LOGF + row * 512 + c) = f0; *(f32x4*)(LOGF + row * 512 + c + 4) = f1; }
                    else if (KIND == 5) { *(u32x4*)((bf16_t*)(w + WS_HB) + row * 1024 + 512 + (col - 2560)) = pack8(v0, v1); }
                    else if (KIND == 6) { *(u32x4*)((bf16_t*)(w + WS_HG) + row * 512 + (col - 3072)) = pack8(v0 * sig4(v0), v1 * sig4(v1)); }
                    else { f32x4 t0 = acc[ai][bj][m][0] * (-LOG2E) + bv[bj][0] * (-LOG2E), t1 = acc[ai][bj][m][1] * (-LOG2E) + bv[bj][1] * (-LOG2E);
#pragma unroll
                        for (int q = 0; q < 4; ++q) { t0[q] = __builtin_amdgcn_rcpf(1.0f + __builtin_amdgcn_exp2f(t0[q])); t1[q] = __builtin_amdgcn_rcpf(1.0f + __builtin_amdgcn_exp2f(t1[q])); }
                        *(u32x4*)((bf16_t*)(w + WS_G) + row * 2048 + (col - 3584)) = pack8(t0, t1); }
                } }
    }
    __device__ __forceinline__ void operator()(const f32x4 (&acc)[2][2][4][2], const Unit& u, int wr, int wc, int fr, int fq) const {
        size_t z_ = 0; asm volatile("" : "+s"(z_)); unsigned char* w = ws + z_;
        const int ct = u.pn;
        if (ct < 2) tile<0>(acc, u, wr, wc, fr, fq, w); else if (ct < 4) tile<1>(acc, u, wr, wc, fr, fq, w); else if (ct < 6) tile<2>(acc, u, wr, wc, fr, fq, w);
        else if (ct < 8) tile<3>(acc, u, wr, wc, fr, fq, w); else if (ct < 10) tile<4>(acc, u, wr, wc, fr, fq, w); else if (ct < 12) tile<5>(acc, u, wr, wc, fr, fq, w);
        else if (ct < 14) tile<6>(acc, u, wr, wc, fr, fq, w); else tile<7>(acc, u, wr, wc, fr, fq, w);
    }
};
template <int MODE> struct EpiGate {
    static constexpr bool PERM = true;
    bf16_t* O; const float* bias; const bf16_t* Gt; int ldg; const bf16_t* P; float osc;
    __device__ __forceinline__ void operator()(const f32x4 (&acc)[2][2][4][2], const Unit& u, int wr, int wc, int fr, int fq) const {
        const int row0 = u.pm * BM + wr * 64 + fr, col0 = u.pn * BM + wc * 32 + 8 * fq;
        f32x4 bv[2][2];
        if (MODE == 0) {
            if (bias) {
#pragma unroll
                for (int bj = 0; bj < 2; ++bj)
#pragma unroll
                    for (int n = 0; n < 2; ++n) gld16(bv[bj][n], bias + col0 + bj * HALF + 4 * n);
                GWAIT4F(bv[0][0], bv[0][1], bv[1][0], bv[1][1]);
            } else {
#pragma unroll
                for (int bj = 0; bj < 2; ++bj)
#pragma unroll
                    for (int n = 0; n < 2; ++n) bv[bj][n] = (f32x4){0.f, 0.f, 0.f, 0.f}; }
        }
#pragma unroll
        for (int ai = 0; ai < 2; ++ai)
#pragma unroll
            for (int mh = 0; mh < 2; ++mh) {
                u32x4 gq[2][2], pq[2][2];
                if (MODE != 0) {
#pragma unroll
                    for (int mm = 0; mm < 2; ++mm)
#pragma unroll
                        for (int bj = 0; bj < 2; ++bj) { const size_t row = (size_t)(row0 + ai * HALF + (mh * 2 + mm) * 16); const int col = col0 + bj * HALF;
                            gld16u(gq[mm][bj], Gt + row * ldg + col);
                            if (MODE == 2) gld16u_nt(pq[mm][bj], P + row * 1024 + col); }
                    GWAIT4U(gq[0][0], gq[0][1], gq[1][0], gq[1][1]);
                    if (MODE == 2) GWAIT4U(pq[0][0], pq[0][1], pq[1][0], pq[1][1]);
                }
#pragma unroll
                for (int mm = 0; mm < 2; ++mm)
#pragma unroll
                    for (int bj = 0; bj < 2; ++bj) { const int m = mh * 2 + mm; const size_t row = (size_t)(row0 + ai * HALF + m * 16); const int col = col0 + bj * HALF;
                        f32x4 v0 = acc[ai][bj][m][0], v1 = acc[ai][bj][m][1];
                        if (MODE == 0) { v0 += bv[bj][0]; v1 += bv[bj][1]; }
                        else { f32x4 g0, g1; unpack8(gq[mm][bj], g0, g1); v0 *= g0; v1 *= g1;
                            if (MODE == 2) { f32x4 p0, p1; unpack8(pq[mm][bj], p0, p1); v0 += p0; v1 += p1; } }
                        if (MODE == 2) *(u32x2*)((unsigned char*)O + row * 1024 + col) = pack8_fp8(v0 * SC_U, v1 * SC_U);
                        else if (MODE == 0 && osc != 0.f) *(u32x2*)((unsigned char*)O + row * 1024 + col) = pack8_fp8(v0 * osc, v1 * osc);
                        else *(u32x4*)(O + row * 1024 + col) = pack8(v0, v1); }
                if (MODE != 0) asm volatile("" ::: "memory");
            }
    }
};
struct EpiUp {
    static constexpr bool PERM = true;
    bf16_t* H;
    __device__ __forceinline__ void operator()(const f32x4 (&acc)[2][2][4][2], const Unit& u, int wr, int wc, int fr, int fq) const {
        const int row0 = u.pm * BM + wr * 64 + fr, col = u.pn * HALF + wc * 32 + 8 * fq;
#pragma unroll
        for (int ai = 0; ai < 2; ++ai)
#pragma unroll
            for (int m = 0; m < 4; ++m) { const size_t row = (size_t)(row0 + ai * HALF + m * 16);
                const f32x4 a0 = acc[ai][0][m][0], a1 = acc[ai][0][m][1], b0 = acc[ai][1][m][0], b1 = acc[ai][1][m][1];
                *(u32x2*)((unsigned char*)H + row * 1024 + col) = pack8_fp8(a0 * sig4(a0) * b0 * SC_H, a1 * sig4(a1) * b1 * SC_H); }
    }
};

__device__ __forceinline__ void glds16s(const char* sbase, unsigned voff, unsigned lds_dst) {
    unsigned keep;
    asm volatile("s_mov_b32 %0, m0\n\ts_mov_b32 m0, %3\n\ts_nop 0\n\tglobal_load_lds_dwordx4 %1, %2\n\ts_mov_b32 m0, %0" : "=&s"(keep) : "v"(voff), "s"(sbase), "s"(lds_dst) : "memory");
}
template <class Epi, class Sched, bool ALIGN_EPI>
__device__ __forceinline__ void gemm_phase(LAS unsigned char* lds, const Gemm g, const Sched& S, const Epi& E, const int tid) {
    const int wid = __builtin_amdgcn_readfirstlane(tid >> 6), lane = tid & 63, wr = wid >> 2, wc = wid & 3, fr = lane & 15, fq = lane >> 4;
    int K = g.K; asm volatile("" : "+s"(K));
    const int nt = K / BK;
    int RA[2], CA[2]; unsigned voffB[2];
#pragma unroll
    for (int i = 0; i < 2; ++i) { int R, C; stage_rc(tid * 16 + i * 8192, R, C); const int Rb = Epi::PERM ? ((R & ~31) + perm32(R & 31)) : R;
        RA[i] = R; CA[i] = C; voffB[i] = (unsigned)(Rb * g.ldb + C) * 2u; }
    const size_t kstep = (size_t)(BK * 2);
    const size_t hstepB = (size_t)HALF * g.ldb * 2;
    const unsigned ldsw = (unsigned)wid * 1024u;
    const unsigned ldsb = (unsigned)__builtin_amdgcn_readfirstlane((int)((unsigned)(uintptr_t)lds + ldsw));
    const int aoff = lds_byte(wr * 64 + fr, fq * 8), boff = lds_byte(wc * 32 + fr, fq * 8);
#define PG8_SA(b, h) (((b) * 2 + (h)) * HTB)
#define PG8_SB(b, h) ((4 + (b) * 2 + (h)) * HTB)
#define PG8_STAGE(bufoff, gbase, voff) do { _Pragma("unroll") for (int _i = 0; _i < 2; ++_i) glds16s((const char*)(gbase), (voff)[_i], ldsb + (unsigned)((bufoff) + _i * 8192)); } while (0)
#define PG8_LD8(p) __builtin_shufflevector(*(const LAS v4i*)(p), *(const LAS v4i*)((p) + 1024), 0, 1, 2, 3, 4, 5, 6, 7)
#define PG8_LDA(dst, b, h) do { _Pragma("unroll") for (int m = 0; m < 4; ++m) dst[m] = PG8_LD8(lds + PG8_SA(b, h) + aoff + m * 2048); } while (0)
#define PG8_LDB(dst, b, h) do { _Pragma("unroll") for (int n = 0; n < 2; ++n) dst[n] = PG8_LD8(lds + PG8_SB(b, h) + boff + n * 2048); } while (0)
#define PG8_MMA(ai, bj, At, Bt) do { __builtin_amdgcn_s_setprio(1); _Pragma("unroll") for (int m = 0; m < 4; ++m) _Pragma("unroll") for (int n = 0; n < 2; ++n) \
        asm volatile("v_mfma_scale_f32_16x16x128_f8f6f4 %0, %1, %2, %0, %3, %4 op_sel_hi:[0,0,0]" : "+v"(acc[ai][bj][m][n]) : "v"(Bt[n]), "v"(At[m]), "v"(sbv), "v"(sav)); \
        __builtin_amdgcn_s_setprio(0); } while (0)
#define PG8_WAIT_V(n) asm volatile("s_waitcnt vmcnt(" #n ")" ::: "memory")
#define PG8_WAIT_L(n) asm volatile("s_waitcnt lgkmcnt(" #n ")" ::: "memory")
#define PG8_BAR __builtin_amdgcn_s_barrier()
#define PG8_SCHED __builtin_amdgcn_sched_barrier(0)
    Unit cur, nxt; int ui = 0;
    if (!S.next(0, cur)) return;
    f32x4 acc[2][2][4][2];
#pragma unroll
    for (int a = 0; a < 2; ++a)
#pragma unroll
        for (int b = 0; b < 2; ++b)
#pragma unroll
            for (int m = 0; m < 4; ++m)
#pragma unroll
                for (int n = 0; n < 2; ++n) acc[a][b][m][n] = (f32x4){0.f, 0.f, 0.f, 0.f};
    int sav = g.sa, sbv = g.sb;
    v8i At[4], B0[2], B1[2];
    unsigned vA[2][2], nvA[2][2];
    S.a_voff(g, cur, 0, RA, CA, vA);
    const char* cA = S.a_tile(g, cur); const char* cB = S.b_tile(g, cur);
    PG8_STAGE(PG8_SB(0, 0), cB, voffB); PG8_STAGE(PG8_SB(0, 1), cB + hstepB, voffB); PG8_STAGE(PG8_SA(0, 0), cA, vA[0]); PG8_STAGE(PG8_SA(0, 1), cA, vA[1]);
    if (wr == 1) PG8_BAR;
    PG8_WAIT_V(2); PG8_BAR;
    PG8_STAGE(PG8_SB(1, 0), cB + kstep, voffB); PG8_STAGE(PG8_SA(1, 0), cA + kstep, vA[0]); PG8_STAGE(PG8_SB(1, 1), cB + hstepB + kstep, voffB);
    PG8_WAIT_V(6); PG8_BAR;
    for (;;) {
        const bool has_next = S.next(ui + 1, nxt);
        const char* nA = has_next ? S.a_tile(g, nxt) : cA; const char* nB = has_next ? S.b_tile(g, nxt) : cB;
        if constexpr (Sched::GATHER) {
            if (has_next) { int RA2[2], CA2[2];
#pragma unroll
                for (int i = 0; i < 2; ++i) { int tq = tid; asm volatile("" : "+v"(tq)); stage_rc(tq * 16 + i * 8192, RA2[i], CA2[i]); }
                S.a_voff(g, nxt, ui + 1, RA2, CA2, nvA); }
            else {
#pragma unroll
                for (int h = 0; h < 2; ++h)
#pragma unroll
                    for (int i = 0; i < 2; ++i) nvA[h][i] = vA[h][i]; }
        }
        for (int t = 0; t < nt; t += 2) {
            const bool last = (t == nt - 2);
            const char* a1 = cA + (size_t)(t + 1) * kstep;
            const char* a2 = last ? nA : cA + (size_t)(t + 2) * kstep; const char* b2 = last ? nB : cB + (size_t)(t + 2) * kstep;
            const char* a3 = a2 + kstep; const char* b3 = b2 + kstep;
            unsigned wA0[2], wA1[2];
#pragma unroll
            for (int i = 0; i < 2; ++i) { if constexpr (Sched::GATHER) { wA0[i] = last ? nvA[0][i] : vA[0][i]; wA1[i] = last ? nvA[1][i] : vA[1][i]; } else { wA0[i] = vA[0][i]; wA1[i] = vA[1][i]; } }
            PG8_LDB(B0, 0, 0); PG8_LDB(B1, 0, 1); PG8_SCHED; PG8_LDA(At, 0, 0); PG8_STAGE(PG8_SA(1, 1), a1, vA[1]);
            PG8_WAIT_V(8); PG8_WAIT_L(0); PG8_BAR; PG8_MMA(0, 0, At, B0); PG8_MMA(0, 1, At, B1); PG8_BAR; PG8_SCHED;
            PG8_LDA(At, 0, 1); PG8_STAGE(PG8_SB(0, 0), b2, voffB); PG8_STAGE(PG8_SB(0, 1), b2 + hstepB, voffB); PG8_STAGE(PG8_SA(0, 0), a2, wA0);
            PG8_WAIT_V(8); PG8_WAIT_L(0); PG8_BAR; PG8_MMA(1, 0, At, B0); PG8_MMA(1, 1, At, B1); PG8_BAR; PG8_SCHED;
            PG8_LDB(B0, 1, 0); PG8_LDB(B1, 1, 1); PG8_SCHED; PG8_LDA(At, 1, 0); PG8_STAGE(PG8_SA(0, 1), a2, wA1);
            PG8_WAIT_V(8); PG8_WAIT_L(0); PG8_BAR; PG8_MMA(0, 0, At, B0); PG8_MMA(0, 1, At, B1); PG8_BAR; PG8_SCHED;
            PG8_LDA(At, 1, 1); PG8_STAGE(PG8_SB(1, 0), b3, voffB); PG8_STAGE(PG8_SB(1, 1), b3 + hstepB, voffB); PG8_STAGE(PG8_SA(1, 0), a3, wA0);
            PG8_WAIT_V(8); PG8_WAIT_L(0); PG8_BAR; PG8_MMA(1, 0, At, B0); PG8_MMA(1, 1, At, B1); PG8_BAR; PG8_SCHED;
        }
        if constexpr (ALIGN_EPI) { if (wr == 0) PG8_BAR; }
        asm volatile("s_nop 15\n\ts_nop 15" ::: "memory");
        E(acc, cur, wr, wc, fr, fq);
        if (!has_next) break;
#pragma unroll
        for (int a = 0; a < 2; ++a)
#pragma unroll
            for (int b = 0; b < 2; ++b)
#pragma unroll
                for (int m = 0; m < 4; ++m)
#pragma unroll
                    for (int n = 0; n < 2; ++n) acc[a][b][m][n] = (f32x4){0.f, 0.f, 0.f, 0.f};
        cur = nxt; cA = nA; cB = nB; ++ui;
        if constexpr (Sched::GATHER) {
#pragma unroll
            for (int h = 0; h < 2; ++h)
#pragma unroll
                for (int i = 0; i < 2; ++i) vA[h][i] = nvA[h][i]; }
        if constexpr (ALIGN_EPI) { if (wr == 1) PG8_BAR; }
    }
    PG8_WAIT_V(0);
    if constexpr (!ALIGN_EPI) { if (wr == 0) PG8_BAR; }
    PG8_BAR;
#undef PG8_SA
#undef PG8_SB
#undef PG8_STAGE
#undef PG8_LDA
#undef PG8_LDB
#undef PG8_MMA
#undef PG8_LD8
#undef PG8_WAIT_V
#undef PG8_WAIT_L
#undef PG8_BAR
#undef PG8_SCHED
}
}


#include <hip/hip_bf16.h>
#include <cmath>
namespace attn_body {
using bf16=__hip_bfloat16;
using bf16x8=__attribute__((ext_vector_type(8)))short;
using s16x4=__attribute__((ext_vector_type(4)))short;
using f32x16=__attribute__((ext_vector_type(16)))float;
using u32x4=__attribute__((ext_vector_type(4)))unsigned;
constexpr int BATCH=16,NHEAD=8,SEQ=2048,D=64,DM=1024;
constexpr int NW=8,QBLK=32,QB=QBLK*NW,KVBLK=64,NQB=SEQ/QB;
constexpr int ATTN_PITCH=DM, ATTN_UNIT_ROWS=QB;
__device__ __forceinline__ int crow(int r,int hi){return (r&3)+8*(r>>2)+4*hi;}
#define SBAR() __builtin_amdgcn_sched_barrier(0)
__device__ __forceinline__ void cmask(f32x16&p0,f32x16&p1,int jb,int qrel,int hi){
  const float NEG=-INFINITY; int kb=64*jb+4*hi;
  #pragma unroll
  for(int r=0;r<16;++r){int kv=kb+(r&3)+8*(r>>2); if(kv>qrel)p0[r]=NEG; if(kv+32>qrel)p1[r]=NEG;}
}

constexpr int NSLOT=3, SLOTB=8192;
constexpr int LDS_K=0, LDS_V=NSLOT*SLOTB, LDS_WS=2*NSLOT*SLOTB, LDS_OST=LDS_WS+NW*64*4, LDS_BYTES=LDS_OST+NW*4096;
constexpr float C2=0.125f*1.4426950408889634f;
__device__ __forceinline__ void glds16(const void*gsrc,unsigned lds_dst){unsigned keep;
  asm volatile("s_mov_b32 %0, m0\n\ts_mov_b32 m0, %2\n\ts_nop 0\n\tglobal_load_lds_dwordx4 %1, off\n\ts_mov_b32 m0, %0":"=&s"(keep):"v"(gsrc),"s"(lds_dst):"memory");}
__device__ __forceinline__ float max3f(float a,float b,float c){float r;asm("v_max3_f32 %0, %1, %2, %3":"=v"(r):"v"(a),"v"(b),"v"(c));return r;}
__device__ __forceinline__ float max2f(float a,float b){float r;asm("v_max_f32_e32 %0, %1, %2":"=v"(r):"v"(a),"v"(b));return r;}
__device__ __forceinline__ float fadd_s(float a,float b){float r;asm("v_add_f32_e32 %0, %1, %2":"=v"(r):"v"(a),"v"(b));return r;}
__device__ __forceinline__ float fsub_s(float a,float b){float r;asm("v_sub_f32_e32 %0, %1, %2":"=v"(r):"v"(a),"v"(b));return r;}
typedef float f32x2_t __attribute__((ext_vector_type(2))); typedef __bf16 bf16x2_t __attribute__((ext_vector_type(2)));
__device__ __forceinline__ unsigned cvtpk_s(float lo,float hi){f32x2_t v={lo,hi};bf16x2_t b=__builtin_convertvector(v,bf16x2_t);return __builtin_bit_cast(unsigned,b);}
#define WAIT_BAR(N) asm volatile("s_waitcnt vmcnt(" #N ") lgkmcnt(0)\n\ts_barrier":::"memory")

__device__ __forceinline__ void qkt(f32x16&p0,f32x16&p1,const char*Kslot,const bf16x8*qr,const f32x16&negm,int r32,int hi){
  const char*kb=Kslot+hi*1024+r32*16;
  #pragma unroll
  for(int d0=0;d0<4;++d0){
    const bf16x8 b0=*reinterpret_cast<const bf16x8*>(kb+d0*2048);
    const bf16x8 b1=*reinterpret_cast<const bf16x8*>(kb+d0*2048+512);
    if(d0==0){p0=__builtin_amdgcn_mfma_f32_32x32x16_bf16(b0,qr[0],negm,0,0,0);p1=__builtin_amdgcn_mfma_f32_32x32x16_bf16(b1,qr[0],negm,0,0,0);}
    else{p0=__builtin_amdgcn_mfma_f32_32x32x16_bf16(b0,qr[d0],p0,0,0,0);p1=__builtin_amdgcn_mfma_f32_32x32x16_bf16(b1,qr[d0],p1,0,0,0);}}
}
typedef __attribute__((address_space(3))) const char* lds_cptr;
typedef short v4i16_t __attribute__((ext_vector_type(4)));
__device__ __forceinline__ void kload8(bf16x8*kf,lds_cptr kp){
  kf[0]=*(const __attribute__((address_space(3))) bf16x8*)(kp);      kf[1]=*(const __attribute__((address_space(3))) bf16x8*)(kp+512);
  kf[2]=*(const __attribute__((address_space(3))) bf16x8*)(kp+2048); kf[3]=*(const __attribute__((address_space(3))) bf16x8*)(kp+2560);
  kf[4]=*(const __attribute__((address_space(3))) bf16x8*)(kp+4096); kf[5]=*(const __attribute__((address_space(3))) bf16x8*)(kp+4608);
  kf[6]=*(const __attribute__((address_space(3))) bf16x8*)(kp+6144); kf[7]=*(const __attribute__((address_space(3))) bf16x8*)(kp+6656);
}
__device__ __forceinline__ void kload2(bf16x8*kf,lds_cptr kp,int j){ kf[2*j]=*(const __attribute__((address_space(3))) bf16x8*)(kp+j*2048); kf[2*j+1]=*(const __attribute__((address_space(3))) bf16x8*)(kp+j*2048+512); }
__device__ __forceinline__ s16x4 vtr(lds_cptr p){ return __builtin_bit_cast(s16x4,__builtin_amdgcn_ds_read_tr16_b64_v4i16((__attribute__((address_space(3))) v4i16_t*)p)); }
__device__ __forceinline__ float rowmax(const f32x16&p0,const f32x16&p1){
  float a=max3f(p0[0],p0[1],p1[0]),b=max3f(p0[2],p0[3],p1[1]);a=max3f(a,p1[2],p1[3]);
  #pragma unroll
  for(int r=4;r<16;r+=4){a=max3f(a,p0[r],p0[r+1]);b=max3f(b,p0[r+2],p0[r+3]);a=max3f(a,p1[r],p1[r+1]);b=max3f(b,p1[r+2],p1[r+3]);}
  const float m=max2f(a,b);
  auto rr=__builtin_amdgcn_permlane32_swap(__float_as_uint(m),__float_as_uint(m),false,false);
  return max2f(__uint_as_float(rr[0]),__uint_as_float(rr[1]));
}
__device__ __forceinline__ void pv(f32x16*o,int vb,bf16x8 pa0,bf16x8 pa1,bf16x8 pa2,bf16x8 pa3){
  #pragma unroll
  for(int d0=0;d0<2;++d0){s16x4 lo[4],hi[4];
    #pragma unroll
    for(int ks=0;ks<4;++ks){
      asm volatile("ds_read_b64_tr_b16 %0,%1 offset:%c2":"=&v"(lo[ks]):"v"(vb),"i"(d0*4096+ks*1024):"memory");
      asm volatile("ds_read_b64_tr_b16 %0,%1 offset:%c2":"=&v"(hi[ks]):"v"(vb),"i"(d0*4096+ks*1024+512):"memory");}
    asm volatile("s_waitcnt lgkmcnt(0)":::"memory");SBAR();
    #define PK(k) (bf16x8){lo[k][0],lo[k][1],lo[k][2],lo[k][3],hi[k][0],hi[k][1],hi[k][2],hi[k][3]}
    o[d0]=__builtin_amdgcn_mfma_f32_32x32x16_bf16(pa0,PK(0),o[d0],0,0,0);
    o[d0]=__builtin_amdgcn_mfma_f32_32x32x16_bf16(pa1,PK(1),o[d0],0,0,0);
    o[d0]=__builtin_amdgcn_mfma_f32_32x32x16_bf16(pa2,PK(2),o[d0],0,0,0);
    o[d0]=__builtin_amdgcn_mfma_f32_32x32x16_bf16(pa3,PK(3),o[d0],0,0,0);
    #undef PK
  }
}

#ifndef ATTN_STORE16
#define ATTN_STORE16(p,v) (*(u32x4*)(p)=(v))
#endif
template<int THRL> __device__ __forceinline__ void attn_unit(int b,int h,int qb,const bf16*Q,const bf16*__restrict__ K,const bf16*__restrict__ V,bf16*O,char*shm,const __attribute__((address_space(3))) float*f2,const int tid){
  #define BIAS_H(P,off,g0) { f32x4 x_[2]; _Pragma("unroll") for(int g_=0;g_<2;++g_) x_[g_]=*(const __attribute__((address_space(3))) f32x4*)(fb_+(off)+8*((g0)+g_)); \
      _Pragma("unroll") for(int g_=0;g_<2;++g_) _Pragma("unroll") for(int i_=0;i_<4;++i_) P[4*((g0)+g_)+i_]-=x_[g_][i_]; asm volatile("":::"memory"); }
  #define BIAS(P0,P1,t) do{ const __attribute__((address_space(3))) float* fb_=f2+64*(t)+4*hi; \
    BIAS_H(P0,0,0) BIAS_H(P0,0,2) BIAS_H(P1,32,0) BIAS_H(P1,32,2) }while(0)
  const int lane=tid&63,r32=lane&31,hi=lane>>5; const int wid=__builtin_amdgcn_readfirstlane(tid>>6);
  const long rowbase=(long)b*SEQ; const int q0=qb*QB;
  const bf16*Qw=Q+(rowbase+q0+wid*QBLK)*DM+h*D;
  const bf16*Kh=K+rowbase*DM+h*D,*Vh=V+rowbase*DM+h*D;
  const unsigned lds0=(unsigned)(uintptr_t)shm;
  float*wsf=(float*)(shm+LDS_WS)+wid*64;
  const bf16*ksrc=Kh+(long)lane*DM+wid*8;
  const bf16*vsrc=Vh+(long)(16*(wid&3)+(lane>>2))*DM+(wid>>2)*32+(lane&3)*8;
  const unsigned kdst=lds0+LDS_K+wid*1024, vdst=lds0+LDS_V+wid*1024;
  #define DMA_K(t,slot) glds16(ksrc+(long)(t)*KVBLK*DM,(unsigned)__builtin_amdgcn_readfirstlane(kdst+(slot)))
  #define DMA_V(t,slot) glds16(vsrc+(long)(t)*KVBLK*DM,(unsigned)__builtin_amdgcn_readfirstlane(vdst+(slot)))
  const int vb0=(int)(lds0+LDS_V)+((lane>>4)&1)*32+(lane&3)*8+(4*hi+((lane&15)>>2))*64;
  const char*Kbase=shm+LDS_K; bf16x8 kf[8];
  const lds_cptr shm3=(lds_cptr)shm; const lds_cptr kp0=shm3+LDS_K+hi*1024+r32*16; const lds_cptr vp0=shm3+LDS_V+((lane>>4)&1)*32+(lane&3)*8+(4*hi+((lane&15)>>2))*64;
  const int NT=(q0+QB)/KVBLK;
  DMA_K(0,0);DMA_V(0,0);DMA_K(1,SLOTB);
  bf16x8 qr[4];
  #pragma unroll
  for(int d0=0;d0<4;++d0)qr[d0]=*reinterpret_cast<const bf16x8*>(&Qw[(long)r32*DM+d0*16+hi*8]);
  float mhat=0.f,l_reg=0.f;f32x16 o[2];f32x16 negm; { float z_=0.f; asm volatile("":"+v"(z_)); _Pragma("unroll") for(int r=0;r<16;++r){o[0][r]=z_;o[1][r]=z_;negm[r]=z_;} } asm volatile("":"+v"(negm));
  const int qrel=wid*QBLK+r32;
  #define CMASK(P0,P1,t) do{int jb_=(t)-(NT-4); if(jb_>=0)cmask(P0,P1,jb_,qrel,hi);}while(0)
  bool resc=false;
  #define START(P0,P1) do{ const float rm=rowmax(P0,P1); resc=false; \
    { const float dl=rm; mhat=fadd_s(mhat,dl); \
      _Pragma("unroll") for(int r=0;r<16;++r){P0[r]=fsub_s(P0[r],dl);P1[r]=fsub_s(P1[r],dl);} \
      _Pragma("unroll") for(int r=0;r<16;++r)negm[r]=-mhat; asm volatile("":"+v"(negm)); } \
    _Pragma("unroll") for(int r=0;r<16;++r)P0[r]=__builtin_amdgcn_exp2f(P0[r]); }while(0)
  #define RESC() do{ if(resc){ asm volatile("s_waitcnt lgkmcnt(0)":::"memory"); \
      _Pragma("unroll") for(int d_=0;d_<2;++d_) _Pragma("unroll") for(int r=0;r<16;++r)o[d_][r]*=wsf[crow(r,hi)]; } }while(0)
  f32x16 pA0,pA1,pB0,pB1;
  int sl_prev=0,sl_cur=0,sl_next=SLOTB;
  #define ROT() do{sl_prev=sl_cur;sl_cur=sl_next;sl_next=(sl_next==(NSLOT-1)*SLOTB)?0:sl_next+SLOTB;}while(0)
  DMA_K(2,2*SLOTB);
  WAIT_BAR(3);
  qkt(pA0,pA1,Kbase,qr,negm,r32,hi);asm volatile("s_nop 15\n\ts_nop 7":"+v"(pA0),"+v"(pA1));CMASK(pA0,pA1,0);BIAS(pA0,pA1,0);
  START(pA0,pA1);
  _Pragma("unroll") for(int r=0;r<16;++r)pA1[r]=__builtin_amdgcn_exp2f(pA1[r]);
  WAIT_BAR(0);
  DMA_K(3,0);DMA_V(1,SLOTB);
  ROT();
  kload8(kf,kp0+sl_cur);
  WAIT_BAR(2);
  s16x4 vlo[8],vhi[8]; u32x4 pw0,pw1,pw2,pw3;
  #define PKW(P,B) cvtpk_s(P[B],P[B+1])
  #define PAF(k) __builtin_bit_cast(bf16x8,pw##k)
  #define VFR(i) (bf16x8){vlo[i][0],vlo[i][1],vlo[i][2],vlo[i][3],vhi[i][0],vhi[i][1],vhi[i][2],vhi[i][3]}
  #define PIN(x) asm volatile("":"+v"(x))
  #define MX3(a,b,c) __builtin_fmaxf(__builtin_fmaxf((a),(b)),(c))
  #define GAPA(MF,A0,A1,A2,A3,W0,W1,PW) do{ MF; sacc+=A0; sacc+=A1; sacc+=A2; sacc+=A3; PIN(sacc); W0; W1; PIN(PW); SBAR(); }while(0)
  #define EX(v) __builtin_amdgcn_exp2f(v)
  #define GAPB(MF,X,B) do{ MF; X[B]=EX(X[B]); X[B+1]=EX(X[B+1]); X[B+2]=EX(X[B+2]); X[B+3]=EX(X[B+3]); PIN(X); SBAR(); }while(0)
  #define VRD(i) do{ vlo[i]=vtr(vp_+(((i)>>2)*4096+((i)&3)*1024)); vhi[i]=vtr(vp_+(((i)>>2)*4096+((i)&3)*1024+512)); }while(0)
  #define KRD(G,j) do{ if(G){ kload2(kf,kp0+sl_next,j); SBAR(); } }while(0)
  #define STEP(C0,C1,P0,P1,t,GK,GV,GL) do{ SBAR(); \
    const lds_cptr vp_=vp0+sl_prev; \
    VRD(0); SBAR(); float sacc=(P0[0]+P0[1]); \
    GAPA(C0=__builtin_amdgcn_mfma_f32_32x32x16_bf16(kf[0],qr[0],negm,0,0,0), P0[2],P0[3],P0[4],P0[5],     pw0[0]=PKW(P0,0), pw0[1]=PKW(P0,2), pw0); \
    VRD(4); SBAR(); GAPA(C1=__builtin_amdgcn_mfma_f32_32x32x16_bf16(kf[1],qr[0],negm,0,0,0), P0[6],P0[7],P0[8],P0[9],     pw0[2]=PKW(P0,4), pw0[3]=PKW(P0,6), pw0); \
    VRD(1); SBAR(); GAPA(C0=__builtin_amdgcn_mfma_f32_32x32x16_bf16(kf[2],qr[1],C0,0,0,0),   P0[10],P0[11],P0[12],P0[13], pw1[0]=PKW(P0,8), pw1[1]=PKW(P0,10), pw1); \
    VRD(5); SBAR(); GAPA(C1=__builtin_amdgcn_mfma_f32_32x32x16_bf16(kf[3],qr[1],C1,0,0,0),   P0[14],P0[15],P1[0],P1[1],   pw1[2]=PKW(P0,12),pw1[3]=PKW(P0,14), pw1); \
    VRD(2); SBAR(); GAPA(C0=__builtin_amdgcn_mfma_f32_32x32x16_bf16(kf[4],qr[2],C0,0,0,0),   P1[2],P1[3],P1[4],P1[5],     pw2[0]=PKW(P1,0), pw2[1]=PKW(P1,2), pw2); \
    VRD(6); SBAR(); GAPA(C1=__builtin_amdgcn_mfma_f32_32x32x16_bf16(kf[5],qr[2],C1,0,0,0),   P1[6],P1[7],P1[8],P1[9],     pw2[2]=PKW(P1,4), pw2[3]=PKW(P1,6), pw2); \
    VRD(3); SBAR(); GAPA(C0=__builtin_amdgcn_mfma_f32_32x32x16_bf16(kf[6],qr[3],C0,0,0,0),   P1[10],P1[11],P1[12],P1[13], pw3[0]=PKW(P1,8), pw3[1]=PKW(P1,10), pw3); \
    VRD(7); SBAR(); GAPA(C1=__builtin_amdgcn_mfma_f32_32x32x16_bf16(kf[7],qr[3],C1,0,0,0),   P1[14],P1[15],0.f,0.f,       pw3[2]=PKW(P1,12),pw3[3]=PKW(P1,14), pw3); \
    l_reg+=sacc; \
    if(GK){DMA_K((t)+3,sl_cur);} if(GV){DMA_V((t)+1,sl_next);} \
    CMASK(C0,C1,t); BIAS(C0,C1,t); \
    { float a=MX3(C0[0],C0[1],C1[0]),b=MX3(C0[2],C0[3],C1[1]); a=MX3(a,C1[2],C1[3]); \
      _Pragma("unroll") for(int r=4;r<16;r+=4){a=MX3(a,C0[r],C0[r+1]);b=MX3(b,C0[r+2],C0[r+3]);a=MX3(a,C1[r],C1[r+1]);b=MX3(b,C1[r+2],C1[r+3]);} \
      float rm=__builtin_fmaxf(a,b); { auto rr=__builtin_amdgcn_permlane32_swap(__float_as_uint(rm),__float_as_uint(rm),false,false); rm=__builtin_fmaxf(__uint_as_float(rr[0]),__uint_as_float(rr[1])); } \
      resc=false; \
      if(__builtin_expect(__any(rm>(float)THRL),0)){ const float dl=__builtin_fmaxf(rm,0.f); mhat+=dl; \
        _Pragma("unroll") for(int r=0;r<16;++r){C0[r]-=dl;C1[r]-=dl;} \
        _Pragma("unroll") for(int r=0;r<16;++r)negm[r]=-mhat; asm volatile("":"+v"(negm)); \
        const float f=__builtin_amdgcn_exp2f(-dl); l_reg*=f; if(hi==0)wsf[r32]=f; resc=true; } } \
    SBAR(); \
    GAPB(o[0]=__builtin_amdgcn_mfma_f32_32x32x16_bf16(PAF(0),VFR(0),o[0],0,0,0), C0,0); \
    GAPB(o[1]=__builtin_amdgcn_mfma_f32_32x32x16_bf16(PAF(0),VFR(4),o[1],0,0,0), C0,4); \
    KRD(GL,0); GAPB(o[0]=__builtin_amdgcn_mfma_f32_32x32x16_bf16(PAF(1),VFR(1),o[0],0,0,0), C0,8); \
    KRD(GL,1); GAPB(o[1]=__builtin_amdgcn_mfma_f32_32x32x16_bf16(PAF(1),VFR(5),o[1],0,0,0), C0,12); \
    KRD(GL,2); GAPB(o[0]=__builtin_amdgcn_mfma_f32_32x32x16_bf16(PAF(2),VFR(2),o[0],0,0,0), C1,0); \
    KRD(GL,3); GAPB(o[1]=__builtin_amdgcn_mfma_f32_32x32x16_bf16(PAF(2),VFR(6),o[1],0,0,0), C1,4); \
    GAPB(o[0]=__builtin_amdgcn_mfma_f32_32x32x16_bf16(PAF(3),VFR(3),o[0],0,0,0), C1,8); \
    GAPB(o[1]=__builtin_amdgcn_mfma_f32_32x32x16_bf16(PAF(3),VFR(7),o[1],0,0,0), C1,12); \
    }while(0)
  int t=1;
  #undef CMASK
  #define CMASK(P0,P1,t) do{}while(0)
  for(;t+5<NT;t+=2){
    STEP(pB0,pB1,pA0,pA1,t,true,true,true);     WAIT_BAR(2); RESC(); ROT();
    STEP(pA0,pA1,pB0,pB1,t+1,true,true,true);   WAIT_BAR(2); RESC(); ROT();
  }
  #undef CMASK
  #define CMASK(P0,P1,t) do{int jb_=(t)-(NT-4); if(jb_>=0)cmask(P0,P1,jb_,qrel,hi);}while(0)
  #define ENDW(tt) do{ if((tt)+3<NT){WAIT_BAR(2);} else if((tt)+2<NT){WAIT_BAR(1);} else {WAIT_BAR(0);} }while(0)
  for(;t+1<NT;t+=2){
    STEP(pB0,pB1,pA0,pA1,t,(t+3<NT),(t+1<NT),(t+1<NT));       ENDW(t);   RESC(); ROT();
    STEP(pA0,pA1,pB0,pB1,t+1,(t+4<NT),(t+2<NT),(t+2<NT));     ENDW(t+1); RESC(); ROT();
  }
  STEP(pB0,pB1,pA0,pA1,NT-1,false,false,false); RESC();
  { float sacc=pB0[0]+pB0[1]; _Pragma("unroll") for(int r=2;r<16;++r)sacc+=pB0[r]; _Pragma("unroll") for(int r=0;r<16;++r)sacc+=pB1[r]; l_reg+=sacc;
    pw0=(u32x4){PKW(pB0,0),PKW(pB0,2),PKW(pB0,4),PKW(pB0,6)};pw1=(u32x4){PKW(pB0,8),PKW(pB0,10),PKW(pB0,12),PKW(pB0,14)};pw2=(u32x4){PKW(pB1,0),PKW(pB1,2),PKW(pB1,4),PKW(pB1,6)};pw3=(u32x4){PKW(pB1,8),PKW(pB1,10),PKW(pB1,12),PKW(pB1,14)};
    SBAR(); pv(o,vb0+sl_cur,PAF(0),PAF(1),PAF(2),PAF(3)); }
  #undef PKW
  #undef PAF
  #undef VFR
  #undef PIN
  #undef MX3
  #undef GAPA
  #undef GAPB
  #undef EX
  #undef VRD
  #undef KRD
  #undef STEP
  #undef ENDW
  {auto rr=__builtin_amdgcn_permlane32_swap(__float_as_uint(l_reg),__float_as_uint(l_reg),false,false);l_reg=__uint_as_float(rr[0])+__uint_as_float(rr[1]);}
  if(hi==0)wsf[32+r32]=l_reg;asm volatile("s_waitcnt lgkmcnt(0)":::"memory");
  float rli[16];
  #pragma unroll
  for(int r=0;r<16;++r)rli[r]=__builtin_amdgcn_rcpf(wsf[32+crow(r,hi)]);
  { bf16*stg=(bf16*)(shm+LDS_OST)+wid*2048;
    #pragma unroll
    for(int r=0;r<16;++r){const int orow=crow(r,hi);
      #pragma unroll
      for(int d0=0;d0<2;++d0)stg[orow*64+d0*32+r32]=__float2bfloat16(o[d0][r]*rli[r]);}
    asm volatile("s_waitcnt lgkmcnt(0)":::"memory");
    unsigned char*O8w=(unsigned char*)O+(rowbase+q0+wid*QBLK)*DM+h*D;
    _Pragma("unroll") for(int i=0;i<4;++i){const int row=i*8+(lane>>3),ch=lane&7; const u32x4 v=*(const u32x4*)(stg+row*64+ch*8);
      u32x2 w8; w8.x=pg8::pack4_fp8(bflo(v.x)*SC_FOX,bfhi(v.x)*SC_FOX,bflo(v.y)*SC_FOX,bfhi(v.y)*SC_FOX); w8.y=pg8::pack4_fp8(bflo(v.z)*SC_FOX,bfhi(v.z)*SC_FOX,bflo(v.w)*SC_FOX,bfhi(v.w)*SC_FOX);
      *(u32x2*)(O8w+(long)row*DM+ch*8)=w8;} }
  asm volatile("s_waitcnt lgkmcnt(0)\n\ts_barrier":::"memory");
  #undef BIAS
  #undef BIAS_H
  #undef DMA_K
  #undef DMA_V
  #undef CMASK
  #undef START
  #undef RESC
  #undef ROT
}
constexpr int ATTN_LDS_BYTES=LDS_BYTES;
#undef SBAR
#undef WAIT_BAR
}


constexpr int NWAVES = 8;
constexpr int RING_OFF = 0, RING_BYTES = 131072;
constexpr int LDSCTL_OFF = RING_BYTES, MISC_OFF = LDSCTL_OFF + 320, TAB_OFF = LDSCTL_OFF + 1024;
constexpr int WTAB_OFF = LDSCTL_OFF + 2048;
constexpr int TOK_OFF = LDSCTL_OFF + 4096;
constexpr int LDS_BYTES = 147456;
typedef GAS unsigned gu32;
__device__ __forceinline__ unsigned hw_wave_key() { return (unsigned)__builtin_amdgcn_s_getreg((5 << 11) | 4) & 63u; }
#define RLX_AGENT __ATOMIC_RELAXED, __HIP_MEMORY_SCOPE_AGENT

#define XB_TMO      128
#define XB_XCNT(j)  (256  + 64 * (j))
#define XB_XSUB(j)  (1280 + 64 * (j))
#define XB_XGEN(j)  (2304 + 64 * (j))
#define XB_TOP      3328
#define XB_TOPGEN   3392
#define XCD_BAR_WORDS 3456
#define XB_SPIN_CAP (1u << 18)

__device__ __forceinline__ unsigned xb_ld(unsigned* p)              { return __hip_atomic_load(p, __ATOMIC_RELAXED, __HIP_MEMORY_SCOPE_AGENT); }
__device__ __forceinline__ unsigned xb_add(unsigned* p, unsigned v) { return __hip_atomic_fetch_add(p, v, __ATOMIC_RELAXED, __HIP_MEMORY_SCOPE_AGENT); }
__device__ __forceinline__ unsigned xb_xcc_id() { return (unsigned)__builtin_amdgcn_s_getreg((3 << 11) | 20) & 0xFu; }
#define XB_SPIN(cond, bar) do { unsigned _sp = 0; while (cond) { __builtin_amdgcn_s_sleep(1); \
    if ((++_sp & 255u) == 0u) { if (xb_ld(&(bar)[XB_TMO])) break; if (_sp > XB_SPIN_CAP) { atomicAdd(&(bar)[XB_TMO], 1u); break; } } } } while (0)

struct XcdBarrier {
    unsigned* bar; unsigned x;
    volatile LAS unsigned* st;
};

__device__ __forceinline__ XcdBarrier xcd_barrier_post(unsigned* bar, volatile LAS unsigned* st) {
    XcdBarrier b; b.bar = bar; b.x = xb_xcc_id(); b.st = st;
    if (threadIdx.x == 0) (void)xb_add(&bar[XB_XCNT(b.x)], 1u);
    return b;
}
__device__ __forceinline__ void xcd_barrier_complete(unsigned* bar, unsigned x, unsigned& nloc, unsigned& nx) {
    const unsigned G = gridDim.x * gridDim.y * gridDim.z;
    unsigned sum, cnt, mine, sp = 0u;
    for (;;) {
        sum = 0u; cnt = 0u; mine = 0u;
#pragma unroll
        for (unsigned j = 0; j < 16; ++j) { const unsigned c = xb_ld(&bar[XB_XCNT(j)]); sum += c; cnt += (c > 0u) ? 1u : 0u; mine = (j == x) ? c : mine; }
        if (sum == G) break;
        __builtin_amdgcn_s_sleep(1);
        if ((++sp & 255u) == 0u) { if (xb_ld(&bar[XB_TMO])) break; if (sp > XB_SPIN_CAP) { atomicAdd(&bar[XB_TMO], 1u); break; } }
    }
    nloc = mine > 0u ? mine : 1u; nx = cnt > 0u ? cnt : 1u;
}

__device__ __forceinline__ void xcd_barrier(const XcdBarrier& b) {
    asm volatile("s_waitcnt vmcnt(0)" ::: "memory");
    __syncthreads();
    if (threadIdx.x == 0) {
        unsigned* bar = b.bar;
        __builtin_amdgcn_s_waitcnt(0);
        unsigned nloc = b.st[0], nx = b.st[1];
        if (nloc == 0u) { xcd_barrier_complete(bar, b.x, nloc, nx); b.st[0] = nloc; b.st[1] = nx; }
        const unsigned old = xb_add(&bar[XB_XSUB(b.x)], 1u);
        const unsigned gen = old / nloc;
        if (old + 1u == (gen + 1u) * nloc) {
            __builtin_amdgcn_fence(__ATOMIC_RELEASE, "agent");
            asm volatile("s_waitcnt vmcnt(0)" ::: "memory");
            const unsigned og = xb_add(&bar[XB_TOP], 1u);
            const unsigned tg = og / nx;
            if (og + 1u == (tg + 1u) * nx) xb_add(&bar[XB_TOPGEN], 1u);
            else XB_SPIN(xb_ld(&bar[XB_TOPGEN]) == tg, bar);
            __builtin_amdgcn_fence(__ATOMIC_ACQUIRE, "agent");
            xb_add(&bar[XB_XGEN(b.x)], 1u);
            asm volatile("s_waitcnt vmcnt(0)" ::: "memory");
        } else {
            XB_SPIN(xb_ld(&bar[XB_XGEN(b.x)]) == gen, bar);
            __builtin_amdgcn_fence(__ATOMIC_ACQUIRE, "agent");
            asm volatile("s_waitcnt vmcnt(0)" ::: "memory");
        }
    }
    __syncthreads();
}


struct Args {
    const float *x, *ln_in_g, *ln_in_b, *w_in, *b_in, *w_fox, *lbl, *norm_g, *w_hgrn, *w_mix, *b_mix, *ln1_g, *ln1_b, *router_w, *router_b, *w1, *w3, *w2, *ln2_g, *ln2_b;
    float* out; unsigned char* ws; int ph_lo, ph_hi, use_bar, pad;
};
struct Frame { LAS unsigned char* lds; int tid, lane, wave, G, gw, ngw, bid; };
#define LOAD_ARGS() launder_args(args)
__device__ __forceinline__ Args launder_args(const Args& args) { Args a = args; size_t z_ = 0; asm volatile("" : "+s"(z_)); a.ws = args.ws + z_; return a; }

__device__ __forceinline__ void ln_rows16(f32x4 (&v)[4], const float* g, const float* bta, int lane) {
    float s = 0.f;
#pragma unroll
    for (int j = 0; j < 4; ++j) s += (v[j].x + v[j].y) + (v[j].z + v[j].w);
    const float mean = wave_sum(s) * (1.f / D); float s2 = 0.f;
#pragma unroll
    for (int j = 0; j < 4; ++j) { v[j] = v[j] - mean; s2 += (v[j].x * v[j].x + v[j].y * v[j].y) + (v[j].z * v[j].z + v[j].w * v[j].w); }
    const float rstd = rsqrtf(wave_sum(s2) * (1.f / D) + LN_EPS);
#pragma unroll
    for (int j = 0; j < 4; ++j) { const int c = 4 * lane + 256 * j; const f32x4 gg = *(const f32x4*)(g + c), bb = *(const f32x4*)(bta + c); v[j] = v[j] * rstd * gg + bb; }
}
__device__ __forceinline__ void store_row(const f32x4 (&v)[4], int lane, bf16_t* ores, unsigned char* obf, float* of32b) {
#pragma unroll
    for (int j = 0; j < 4; ++j) { const int c = 4 * lane + 256 * j;
        if (ores) { u32x2 w; w.x = pk2(v[j].x, v[j].y); w.y = pk2(v[j].z, v[j].w); *(u32x2*)(ores + c) = w; }
        if (of32b) *(f32x4*)(of32b + c) = v[j];
        if (obf) *(unsigned*)(obf + c) = pg8::pack4_fp8(v[j].x, v[j].y, v[j].z, v[j].w); }
}

struct CvtDesc { const float* W; int ldw, k0, srccol, nvalid; unsigned char* WT; int dstrow, dstk; };
__device__ __forceinline__ void cvt_load(const CvtDesc& d, f32x4 (&v)[8], int lane) {
    const int ks = lane >> 3, n4 = (lane & 7) * 4;
#pragma unroll
    for (int j = 0; j < 8; ++j) v[j] = (n4 < d.nvalid) ? *(const f32x4*)(d.W + (size_t)(d.k0 + 8 * j + ks) * d.ldw + d.srccol + n4) : (f32x4){0.f, 0.f, 0.f, 0.f};
}
__device__ __forceinline__ void cvt_store(const CvtDesc& d, const f32x4 (&v)[8], LAS float* scr, int lane) {
    const int ks = lane >> 3, n4 = (lane & 7) * 4;
#pragma unroll
    for (int j = 0; j < 8; ++j) { LAS float* p = scr + (8 * j + ks) * 33 + n4; p[0] = v[j][0]; p[1] = v[j][1]; p[2] = v[j][2]; p[3] = v[j][3]; }
    asm volatile("s_waitcnt lgkmcnt(0)" ::: "memory");
    const int c = lane & 7;
#pragma unroll
    for (int j = 0; j < 4; ++j) { const int n = (lane >> 3) + 8 * j; const LAS float* s = scr + (8 * c) * 33 + n;
        u32x2 o; o.x = pg8::pack4_fp8(s[0 * 33] * SC_W, s[1 * 33] * SC_W, s[2 * 33] * SC_W, s[3 * 33] * SC_W); o.y = pg8::pack4_fp8(s[4 * 33] * SC_W, s[5 * 33] * SC_W, s[6 * 33] * SC_W, s[7 * 33] * SC_W);
        *(u32x2*)(d.WT + (size_t)(d.dstrow + n) * 1024 + d.dstk + d.k0 + 8 * c) = o; }
    asm volatile("s_waitcnt lgkmcnt(0)" ::: "memory");
}
__device__ __forceinline__ CvtDesc cvt_decode(const Args& a, int l, int it) {
    unsigned char* WS_ = a.ws + wset(l);
    constexpr int I_IN = 16 * 176, I_BR = 8 * 32, I_MIX = 16 * 32, I_13 = 16 * 64 * NE;
    CvtDesc d; int r = it;
    if (r < I_IN) { const int kb = r / 176, nb = r % 176, n0 = nb * 32;
        const int src = (n0 < 1536) ? n0 : n0 + 8, nv = 32;
        d.W = a.w_in + (size_t)l * D * NIN; d.ldw = NIN; d.k0 = kb * 64; d.srccol = src; d.nvalid = nv; d.WT = WS_ + WO_WIN; d.dstrow = n0; d.dstk = 0; return d; } r -= I_IN;
    if (r < I_BR) { const int kb = r / 32, nb = r % 32; d.W = a.w_fox + (size_t)l * 512 * D; d.ldw = D; d.k0 = kb * 64; d.srccol = nb * 32; d.nvalid = 32; d.WT = WS_ + WO_WBR; d.dstrow = nb * 32; d.dstk = 0; return d; } r -= I_BR;
    if (r < I_BR) { const int kb = r / 32, nb = r % 32; d.W = a.w_hgrn + (size_t)l * 512 * D; d.ldw = D; d.k0 = kb * 64; d.srccol = nb * 32; d.nvalid = 32; d.WT = WS_ + WO_WBR; d.dstrow = nb * 32; d.dstk = 512; return d; } r -= I_BR;
    if (r < I_MIX) { const int kb = r / 32, nb = r % 32; d.W = a.w_mix + (size_t)l * D * D; d.ldw = D; d.k0 = kb * 64; d.srccol = nb * 32; d.nvalid = 32; d.WT = WS_ + WO_WMIX; d.dstrow = nb * 32; d.dstk = 0; return d; } r -= I_MIX;
    if (r < I_13) { const int e = r / 1024, q = r % 1024, kb = q / 64, nb = q % 64, n0 = nb * 32;
        const int j = n0 >> 8, rr = n0 & 255; d.W = (rr < 128 ? a.w1 : a.w3) + ((size_t)l * NE + e) * D * D; d.ldw = D; d.k0 = kb * 64; d.srccol = 128 * j + (rr & 127); d.nvalid = 32;
        d.WT = WS_ + WO_W13 + (size_t)e * 2048 * D; d.dstrow = n0; d.dstk = 0; return d; } r -= I_13;
    { const int e = r / 512, q = r % 512, kb = q / 32, nb = q % 32; d.W = a.w2 + ((size_t)l * NE + e) * D * D; d.ldw = D; d.k0 = kb * 64; d.srccol = nb * 32; d.nvalid = 32;
      d.WT = WS_ + WO_W2 + (size_t)e * D * D; d.dstrow = nb * 32; d.dstk = 0; return d; }
}
__device__ __forceinline__ void convert_layer(const Args& a, const Frame& F, int l, int gw, int ngw) {
    LAS float* scr = (LAS float*)(F.lds + RING_OFF + F.wave * 16384);
    const int lane = F.lane;
    constexpr int NITEMS = 16 * 176 + 2 * 8 * 32 + 16 * 32 + 16 * 64 * NE + 16 * 32 * NE;
    for (int it = gw; it < NITEMS; it += 2 * ngw) {
        const CvtDesc d0 = cvt_decode(a, l, it); f32x4 v0[8]; cvt_load(d0, v0, lane);
        const bool two = it + ngw < NITEMS;
        if (two) { const CvtDesc d1 = cvt_decode(a, l, it + ngw); f32x4 v1[8]; cvt_load(d1, v1, lane); cvt_store(d0, v0, scr, lane); cvt_store(d1, v1, scr, lane); }
        else cvt_store(d0, v0, scr, lane);
    }
    float* biasp = (float*)(a.ws + biasoff(l));
    for (int n = gw * 64 + lane; n < NINP; n += ngw * 64) {
        biasp[n] = (n < 1536) ? a.b_in[l * NIN + n] : a.b_in[l * NIN + n + 8]; }
}


constexpr int WFF_OFF = 65536 + 16384;
__device__ __forceinline__ void load_wff(const Args& a, const Frame& F, int l) {
    LAS float* wff = (LAS float*)(F.lds + RING_OFF + WFF_OFF);
    for (int i = F.tid; i < 8 * D; i += NWAVES * 64) { const int c = i >> 3, h = i & 7; wff[h * D + c] = a.w_in[((size_t)l * D + c) * NIN + 1536 + h]; }
}
__device__ __forceinline__ void fox_gates_row(const Args& a, const Frame& F, int l, const f32x4 (&v)[4], int row) {
    const LAS float* wff = (const LAS float*)(F.lds + RING_OFF + WFF_OFF); const int lane = F.lane;
    float p[8];
#pragma unroll
    for (int h = 0; h < 8; ++h) { float s = 0.f;
#pragma unroll
        for (int j = 0; j < 4; ++j) { const f32x4 r4 = *(const LAS f32x4*)(wff + h * D + 4 * lane + 256 * j); s += v[j].x * r4.x + v[j].y * r4.y + v[j].z * r4.z + v[j].w * r4.w; }
        p[h] = s; }
    const bool hi5 = (lane & 32) != 0;
#pragma unroll
    for (int k = 0; k < 4; ++k) { const float snd = hi5 ? p[k] : p[k + 4]; const float rcv = __shfl_xor(snd, 32); p[k] = (hi5 ? p[k + 4] : p[k]) + rcv; }
    const bool hi4 = (lane & 16) != 0;
#pragma unroll
    for (int k = 0; k < 2; ++k) { const float snd = hi4 ? p[k] : p[k + 2]; const float rcv = __shfl_xor(snd, 16); p[k] = (hi4 ? p[k + 2] : p[k]) + rcv; }
    const bool hi3 = (lane & 8) != 0;
    { const float snd = hi3 ? p[0] : p[1]; const float rcv = __shfl_xor(snd, 8); p[0] = (hi3 ? p[1] : p[0]) + rcv; }
    p[0] += __shfl_xor(p[0], 4); p[0] += __shfl_xor(p[0], 2); p[0] += __shfl_xor(p[0], 1);
    if ((lane & 7) == 0) { const int h = lane >> 3; ((float*)(a.ws + WS_FL))[(size_t)row * 8 + h] = logsigmoidf_(p[0] + a.b_in[l * NIN + 1536 + h]); }
}

__device__ __forceinline__ void phase_prep(const Args& a, const Frame& F) {
    if (F.bid == 0) {
        float* lb_all = (float*)(a.ws + WS_MISC);
        const int c = F.tid;
        float v[DEPTH], m = -1e30f;
#pragma unroll
        for (int l = 0; l < DEPTH; ++l) { v[l] = a.lbl[l * 512 + c]; m = fmaxf(m, v[l]); }
        float s = 0.f;
#pragma unroll
        for (int l = 0; l < DEPTH; ++l) { v[l] = __expf(v[l] - m); s += v[l]; }
        float cum = 0.f;
#pragma unroll
        for (int l = 0; l < DEPTH; ++l) { const float p = v[l] / s; cum += p; lb_all[l * 512 + c] = cum - v[0] / s; }
    }
    bf16_t* XRES = (bf16_t*)(a.ws + WS_XRES); unsigned char* XN = a.ws + WS_XN;
    load_wff(a, F, 0); __syncthreads();
    for (int row = F.gw; row < T; row += F.ngw) {
        f32x4 v[4];
#pragma unroll
        for (int j = 0; j < 4; ++j) v[j] = *(const f32x4*)(a.x + (size_t)row * D + 4 * F.lane + 256 * j);
        ln_rows16(v, a.ln_in_g, a.ln_in_b, F.lane);
        store_row(v, F.lane, XRES + (size_t)row * D, XN + (size_t)row * D, nullptr);
        fox_gates_row(a, F, 0, v, row);
    }
    __syncthreads();
    convert_layer(a, F, 0, F.gw, F.ngw);
}

__device__ __forceinline__ void phase_fscan(const Args& a, const Frame& F) {
    if (F.bid >= BATCH * NH) return;
    const float* FL = (const float*)(a.ws + WS_FL); float* F2 = (float*)(a.ws + WS_F2);
    LAS float* wsum = (LAS float*)(F.lds + RING_OFF);
    const int bh = F.bid, b = bh >> 3, h = bh & 7, tid = F.tid, lane = F.lane, w = F.wave;
    float v[4], run = 0.f;
#pragma unroll
    for (int i = 0; i < 4; ++i) { run += FL[((size_t)b * SEQ + tid * 4 + i) * 8 + h]; v[i] = run; }
    float incl = run;
#pragma unroll
    for (int o = 1; o < 64; o <<= 1) { const float u = __shfl_up(incl, o); if (lane >= o) incl += u; }
    if (lane == 63) wsum[w] = incl;
    __syncthreads();
    float base = incl - run; for (int i = 0; i < w; ++i) base += wsum[i];
#pragma unroll
    for (int i = 0; i < 4; ++i) F2[(size_t)bh * SEQ + tid * 4 + i] = (base + v[i]) * LOG2E;
    __syncthreads();
}

__device__ __forceinline__ void phase_attn_naive(const Args& a, const Frame& F) {
    const bf16_t* QO = (const bf16_t*)(a.ws + WS_QO); const bf16_t* KV = (const bf16_t*)(a.ws + WS_KV); const float* F2 = (const float*)(a.ws + WS_F2); bf16_t* O = (bf16_t*)(a.ws + WS_QO);
    LAS float* ps = (LAS float*)(F.lds + RING_OFF) + F.wave * 64;
    const int lane = F.lane;
    for (int gid = F.gw; gid < BATCH * NH * SEQ; gid += F.ngw) {
        const int bh = gid & 127, t = gid >> 7, b = bh >> 3, h = bh & 7;
        float q[64];
        { const bf16_t* qp = QO + ((size_t)b * SEQ + t) * 1024 + h * 64;
#pragma unroll
          for (int c = 0; c < 8; ++c) { const u32x4 u = *(const u32x4*)(qp + c * 8);
            q[c * 8 + 0] = bflo(u.x); q[c * 8 + 1] = bfhi(u.x); q[c * 8 + 2] = bflo(u.y); q[c * 8 + 3] = bfhi(u.y);
            q[c * 8 + 4] = bflo(u.z); q[c * 8 + 5] = bfhi(u.z); q[c * 8 + 6] = bflo(u.w); q[c * 8 + 7] = bfhi(u.w); } }
        float m = -1e30f, l = 0.f, o = 0.f;
        const float* f2 = F2 + (size_t)bh * SEQ;
        for (int s0 = 0; s0 <= t; s0 += 64) {
            const int s = s0 + lane; const bool valid = s <= t;
            float sc = -1e30f;
            if (valid) { const bf16_t* kp = KV + ((size_t)b * SEQ + s) * 1024 + h * 64; float d = 0.f;
#pragma unroll
                for (int c = 0; c < 8; ++c) { const u32x4 u = *(const u32x4*)(kp + c * 8);
                    d += q[c * 8 + 0] * bflo(u.x) + q[c * 8 + 1] * bfhi(u.x) + q[c * 8 + 2] * bflo(u.y) + q[c * 8 + 3] * bfhi(u.y)
                       + q[c * 8 + 4] * bflo(u.z) + q[c * 8 + 5] * bfhi(u.z) + q[c * 8 + 6] * bflo(u.w) + q[c * 8 + 7] * bfhi(u.w); }
                sc = d - f2[s]; }
            const float mn = fmaxf(m, wave_max(sc));
            const float p = valid ? exp2f(sc - mn) : 0.f;
            const float f = exp2f(m - mn);
            l = l * f + wave_sum(p); o *= f; m = mn;
            ps[lane] = p;
            asm volatile("s_waitcnt lgkmcnt(0)" ::: "memory");
            const int nk = min(64, t - s0 + 1);
            const bf16_t* vp = KV + ((size_t)b * SEQ + s0) * 1024 + 512 + h * 64 + lane;
            for (int j = 0; j < nk; ++j) o += ps[j] * bf2f(vp[(size_t)j * 1024]);
            asm volatile("s_waitcnt lgkmcnt(0)" ::: "memory");
        }
        O[((size_t)b * SEQ + t) * 1024 + h * 64 + lane] = (bf16_t)f2bf(o / l);
    }
}

__device__ __forceinline__ void phase_hgrn_naive(const Args& a, const Frame& F, int l) {
    if (F.bid >= BATCH * NH || F.wave != 0) return;
    const bf16_t* HB = (const bf16_t*)(a.ws + WS_HB); const float* LOGF = (const float*)(a.ws + WS_LOGF); const bf16_t* HG = (const bf16_t*)(a.ws + WS_HG); bf16_t* O = (bf16_t*)(a.ws + WS_QO);
    LAS float* Lf = (LAS float*)(F.lds + RING_OFF + 1024); LAS float* Lk = Lf + 4096; LAS float* Lq = Lk + 4096;
    const int bh = F.bid, b = bh >> 3, h = bh & 7, lane = F.lane;
    float Sx[64];
#pragma unroll
    for (int d = 0; d < 64; ++d) Sx[d] = 0.f;
    const float ng = a.norm_g[l * 512 + h * 64 + lane];
    for (int c0 = 0; c0 < SEQ; c0 += 64) {
        for (int tt = 0; tt < 64; ++tt) { const size_t row = (size_t)b * SEQ + c0 + tt;
            const float lf = LOGF[row * 512 + h * 64 + lane]; const float f = __expf(lf);
            Lf[tt * 64 + lane] = f; Lk[tt * 64 + lane] = 1.f - f; Lq[tt * 64 + lane] = bf2f(HB[row * 1024 + h * 64 + lane]); }
        asm volatile("s_waitcnt lgkmcnt(0)" ::: "memory");
        for (int tt = 0; tt < 64; ++tt) { const size_t row = (size_t)b * SEQ + c0 + tt;
            const float v = bf2f(HB[row * 1024 + 512 + h * 64 + lane]);
            float o = 0.f;
#pragma unroll
            for (int d = 0; d < 64; d += 4) { const f32x4 f4 = *(const LAS f32x4*)(Lf + tt * 64 + d), k4 = *(const LAS f32x4*)(Lk + tt * 64 + d), q4 = *(const LAS f32x4*)(Lq + tt * 64 + d);
                Sx[d] = f4.x * Sx[d] + k4.x * v; o += Sx[d] * q4.x; Sx[d + 1] = f4.y * Sx[d + 1] + k4.y * v; o += Sx[d + 1] * q4.y;
                Sx[d + 2] = f4.z * Sx[d + 2] + k4.z * v; o += Sx[d + 2] * q4.z; Sx[d + 3] = f4.w * Sx[d + 3] + k4.w * v; o += Sx[d + 3] * q4.w; }
            const float ss = wave_sum(o * o);
            const float r = o * rsqrtf(ss * (1.f / 64.f) + RMS_EPS) * ng * bf2f(HG[row * 512 + h * 64 + lane]);
            O[row * 1024 + 512 + h * 64 + lane] = (bf16_t)f2bf(r); }
        asm volatile("s_waitcnt lgkmcnt(0)" ::: "memory");
    }
}

constexpr int LN1_RW = 0, LN1_LG = 65536, LN1_ASG = LN1_LG + 8 * 16 * 16 * 4, LN1_BASE = LN1_ASG + 128 * 16;
__device__ __forceinline__ void phase_ln1_router(const Args& a, const Frame& F, int l) {
    const bf16_t* xres = (const bf16_t*)(a.ws + WS_XRES); bf16_t* x1 = (bf16_t*)(a.ws + WS_X1B); const unsigned char* mixed = a.ws + WS_MIXED;   unsigned char* xn = a.ws + WS_XN;
    unsigned* cnt = (unsigned*)(a.ws + WS_CTL) + CW_CNT + l * 64; int* list = (int*)(a.ws + WS_LIST); unsigned* tokinfo = (unsigned*)(a.ws + WS_TOK);
    const float* g = a.ln1_g + l * D; const float* bta = a.ln1_b + l * D;
    LAS float* rw = (LAS float*)(F.lds + RING_OFF + LN1_RW);
    LAS float* lgs = (LAS float*)(F.lds + RING_OFF + LN1_LG) + F.wave * 256;
    LAS u32x4* asg = (LAS u32x4*)(F.lds + RING_OFF + LN1_ASG);
    LAS unsigned* basep = (LAS unsigned*)(F.lds + RING_OFF + LN1_BASE);
    for (int i = F.tid; i < NE * D; i += NWAVES * 64) { const int c = i >> 4, e = i & 15; rw[e * D + c] = a.router_w[i]; }
    __syncthreads();
    const int lane = F.lane;
    for (int blk = F.bid; blk < T / 128; blk += F.G) {
        const int R0 = blk * 128 + F.wave * 16;
        u32x2 nx[4]; unsigned nm[4];
#pragma unroll
        for (int j = 0; j < 4; ++j) { const int c = 4 * lane + 256 * j; nx[j] = *(const u32x2*)(xres + (size_t)R0 * D + c); nm[j] = *(const unsigned*)(mixed + (size_t)R0 * D + c); }
        for (int i = 0; i < 16; ++i) { const int row = R0 + i;
            f32x4 v[4];
#pragma unroll
            for (int j = 0; j < 4; ++j) { const u32x2 xv = nx[j]; const f32x2 m01 = __builtin_amdgcn_cvt_pk_f32_fp8((int)nm[j], false), m23 = __builtin_amdgcn_cvt_pk_f32_fp8((int)nm[j], true);
                v[j].x = ALPHA * bflo(xv.x) + m01[0] * (1.f / SC_MIX); v[j].y = ALPHA * bfhi(xv.x) + m01[1] * (1.f / SC_MIX); v[j].z = ALPHA * bflo(xv.y) + m23[0] * (1.f / SC_MIX); v[j].w = ALPHA * bfhi(xv.y) + m23[1] * (1.f / SC_MIX); }
            { const int rn = (i < 15) ? row + 1 : row;
#pragma unroll
              for (int j = 0; j < 4; ++j) { const int c = 4 * lane + 256 * j; nx[j] = *(const u32x2*)(xres + (size_t)rn * D + c); nm[j] = *(const unsigned*)(mixed + (size_t)rn * D + c); } }
            ln_rows16(v, g, bta, lane);
            store_row(v, lane, x1 + (size_t)row * D, xn + (size_t)row * D, nullptr);
            float p[NE];
#pragma unroll
            for (int e = 0; e < NE; ++e) { float s = 0.f;
#pragma unroll
                for (int j = 0; j < 4; ++j) { const f32x4 r4 = *(const LAS f32x4*)(rw + e * D + 4 * lane + 256 * j); s += v[j].x * r4.x + v[j].y * r4.y + v[j].z * r4.z + v[j].w * r4.w; }
                p[e] = s; asm volatile("" ::: "memory"); }
            { const bool hi5 = (lane & 32) != 0;
#pragma unroll
              for (int k = 0; k < 8; ++k) { const float snd = hi5 ? p[k] : p[k + 8]; const float rcv = __shfl_xor(snd, 32); p[k] = (hi5 ? p[k + 8] : p[k]) + rcv; }
              const bool hi4 = (lane & 16) != 0;
#pragma unroll
              for (int k = 0; k < 4; ++k) { const float snd = hi4 ? p[k] : p[k + 4]; const float rcv = __shfl_xor(snd, 16); p[k] = (hi4 ? p[k + 4] : p[k]) + rcv; }
              const bool hi3 = (lane & 8) != 0;
#pragma unroll
              for (int k = 0; k < 2; ++k) { const float snd = hi3 ? p[k] : p[k + 2]; const float rcv = __shfl_xor(snd, 8); p[k] = (hi3 ? p[k + 2] : p[k]) + rcv; }
              const bool hi2 = (lane & 4) != 0;
              { const float snd = hi2 ? p[0] : p[1]; const float rcv = __shfl_xor(snd, 4); p[0] = (hi2 ? p[1] : p[0]) + rcv; }
              p[0] += __shfl_xor(p[0], 2); p[0] += __shfl_xor(p[0], 1);
              if ((lane & 3) == 0) lgs[i * 16 + (lane >> 2)] = p[0]; }
        }
        asm volatile("s_waitcnt lgkmcnt(0)" ::: "memory");
        if (lane < 16) {
            float lg[NE];
#pragma unroll
            for (int q = 0; q < 4; ++q) { const f32x4 t4 = *(const LAS f32x4*)(lgs + lane * 16 + 4 * q); lg[4 * q] = t4[0] + a.router_b[4 * q]; lg[4 * q + 1] = t4[1] + a.router_b[4 * q + 1]; lg[4 * q + 2] = t4[2] + a.router_b[4 * q + 2]; lg[4 * q + 3] = t4[3] + a.router_b[4 * q + 3]; }
            int gs = 0; float gbest = -3e38f;
#pragma unroll
            for (int gi = 0; gi < 4; ++gi) { const float mx = fmaxf(fmaxf(lg[gi * 4], lg[gi * 4 + 1]), fmaxf(lg[gi * 4 + 2], lg[gi * 4 + 3])); if (mx > gbest) { gbest = mx; gs = gi; } }
            float l4[4];
#pragma unroll
            for (int i = 0; i < 4; ++i) { float t0 = lg[i];
#pragma unroll
                for (int gi = 1; gi < 4; ++gi) t0 = (gs == gi) ? lg[gi * 4 + i] : t0; l4[i] = t0; }
            int i0 = 0; float b0 = l4[0];
#pragma unroll
            for (int i = 1; i < 4; ++i) if (l4[i] > b0) { b0 = l4[i]; i0 = i; }
            int i1 = 0; float b1 = -3e38f;
#pragma unroll
            for (int i = 0; i < 4; ++i) if (i != i0 && l4[i] > b1) { b1 = l4[i]; i1 = i; }
            const float e1 = __expf(b1 - b0); const float g0 = 1.f / (1.f + e1), g1 = e1 / (1.f + e1);
            u32x4 as; as.x = (unsigned)(gs * 4 + i0); as.y = (unsigned)(gs * 4 + i1); as.z = __float_as_uint(g0); as.w = __float_as_uint(g1);
            asg[F.wave * 16 + lane] = as;
        }
        __syncthreads();
        if (F.wave == 0) {
            const u32x4 A0 = asg[lane], A1 = asg[lane + 64];
            const unsigned ex[4] = {A0.x, A0.y, A1.x, A1.y};
            unsigned rank[4] = {0u, 0u, 0u, 0u}, mycount = 0u;
            const unsigned long long lt = (1ull << lane) - 1ull;
#pragma unroll 1
            for (unsigned e = 0; e < NE; ++e) { unsigned run = 0u;
#pragma unroll
                for (int s = 0; s < 4; ++s) { const unsigned long long m = __ballot(ex[s] == e); if (ex[s] == e) rank[s] = run + (unsigned)__popcll(m & lt); run += (unsigned)__popcll(m); }
                if ((unsigned)lane == e) mycount = run; }
            if (lane < NE) basep[lane] = atomicAdd(cnt + lane, mycount);
            asm volatile("s_waitcnt vmcnt(0) lgkmcnt(0)" ::: "memory");
            const unsigned p0 = basep[ex[0]] + rank[0], p1 = basep[ex[1]] + rank[1], p2 = basep[ex[2]] + rank[2], p3 = basep[ex[3]] + rank[3];
            const int ra = blk * 128 + lane, rb = ra + 64;
            list[ex[0] * T + p0] = ra; list[ex[1] * T + p1] = ra; list[ex[2] * T + p2] = rb; list[ex[3] * T + p3] = rb;
            u32x4 ta, tb; ta.x = (ex[0] << 24) | p0; ta.y = (ex[1] << 24) | p1; ta.z = A0.z; ta.w = A0.w; tb.x = (ex[2] << 24) | p2; tb.y = (ex[3] << 24) | p3; tb.z = A1.z; tb.w = A1.w;
            *(u32x4*)(tokinfo + (size_t)ra * 4) = ta; *(u32x4*)(tokinfo + (size_t)rb * 4) = tb;
        }
        __syncthreads();
    }
}

__device__ __forceinline__ void moe_table(const Args& a, const Frame& F, int l) {
    LAS int* tab = (LAS int*)(F.lds + TAB_OFF);
    const unsigned* cnt = (const unsigned*)(a.ws + WS_CTL) + CW_CNT + l * 64;
    if (F.tid == 0) { int ts = 0; for (int e = 0; e < NE; ++e) { const int c = (int)__hip_atomic_load(cnt + e, RLX_AGENT); tab[e] = ts; tab[NE + 1 + e] = c; ts += (c + TM - 1) / TM; } tab[NE] = ts; }
    __syncthreads();
}

__device__ __forceinline__ void phase_combine_ln2(const Args& a, const Frame& F, int l) {
    bf16_t* xres = (bf16_t*)(a.ws + WS_XRES); const bf16_t* x1 = (const bf16_t*)(a.ws + WS_X1B); const unsigned char* Y = a.ws + WS_Y;   const unsigned* tokinfo = (const unsigned*)(a.ws + WS_TOK); unsigned char* xn = a.ws + WS_XN;
    const float* g = a.ln2_g + l * D; const float* bta = a.ln2_b + l * D; float* out = (l == DEPTH - 1) ? a.out : nullptr;
    const LAS int* tab = (const LAS int*)(F.lds + TAB_OFF);
    const int lane = F.lane;
    for (int row = F.gw; row < T; row += F.ngw) {
        const unsigned i0 = tokinfo[row * 4], i1 = tokinfo[row * 4 + 1]; const float g0 = __uint_as_float(tokinfo[row * 4 + 2]), g1 = __uint_as_float(tokinfo[row * 4 + 3]);
        const size_t s0 = (size_t)tab[i0 >> 24] * TM + (i0 & 0xffffff), s1 = (size_t)tab[i1 >> 24] * TM + (i1 & 0xffffff);
        f32x4 v[4];
#pragma unroll
        for (int j = 0; j < 4; ++j) { const int c = 4 * lane + 256 * j; const u32x2 xw = *(const u32x2*)(x1 + (size_t)row * D + c); const f32x4 xv = {bflo(xw.x), bfhi(xw.x), bflo(xw.y), bfhi(xw.y)};
            const unsigned ya = *(const unsigned*)(Y + s0 * D + c), yb = *(const unsigned*)(Y + s1 * D + c);
            const f32x2 a01 = __builtin_amdgcn_cvt_pk_f32_fp8((int)ya, false), a23 = __builtin_amdgcn_cvt_pk_f32_fp8((int)ya, true), b01 = __builtin_amdgcn_cvt_pk_f32_fp8((int)yb, false), b23 = __builtin_amdgcn_cvt_pk_f32_fp8((int)yb, true);
            const float h0 = g0 * (1.f / SC_Y), h1 = g1 * (1.f / SC_Y);
            v[j].x = ALPHA * xv.x + h0 * a01[0] + h1 * b01[0]; v[j].y = ALPHA * xv.y + h0 * a01[1] + h1 * b01[1];
            v[j].z = ALPHA * xv.z + h0 * a23[0] + h1 * b23[0]; v[j].w = ALPHA * xv.w + h0 * a23[1] + h1 * b23[1]; }
        ln_rows16(v, g, bta, lane);
        store_row(v, lane, xres + (size_t)row * D, xn + (size_t)row * D, out ? out + (size_t)row * D : nullptr);
        if (l + 1 < DEPTH) fox_gates_row(a, F, l + 1, v, row);
    }
}


constexpr int ATT_F2_OFF = 86016;
__device__ __forceinline__ void phase_attn(const Args& a, const Frame& F, char* lds_generic) {
    const int c = F.bid, vcu = (F.G % 8 == 0) ? (c % 8) * (F.G / 8) + c / 8 : c;
    const attn_body::bf16* Q = (const attn_body::bf16*)(a.ws + WS_QO); const attn_body::bf16* K = (const attn_body::bf16*)(a.ws + WS_KV); const attn_body::bf16* V = K + 512;
    attn_body::bf16* O = (attn_body::bf16*)(a.ws + WS_OX8);
    const float* FL = (const float*)(a.ws + WS_FL);
    LAS float* f2 = (LAS float*)(F.lds + ATT_F2_OFF); LAS float* wsum = f2 + 2048;
    { const int bh = vcu >> 1; if (bh >= BATCH * NH) return;
        const int b = bh >> 3, h = bh & 7, tid = F.tid, lane = F.lane, w = F.wave;
        float v[4], run = 0.f;
#pragma unroll
        for (int i = 0; i < 4; ++i) { run += FL[((size_t)b * SEQ + tid * 4 + i) * 8 + h]; v[i] = run; }
        float incl = run;
#pragma unroll
        for (int o = 1; o < 64; o <<= 1) { const float u = __shfl_up(incl, o); if (lane >= o) incl += u; }
        if (lane == 63) wsum[w] = incl;
        __syncthreads();
        float base = incl - run; for (int i = 0; i < w; ++i) base += wsum[i];
        f32x4 o4; o4[0] = (base + v[0]) * LOG2E; o4[1] = (base + v[1]) * LOG2E; o4[2] = (base + v[2]) * LOG2E; o4[3] = (base + v[3]) * LOG2E;
        *(LAS f32x4*)(f2 + tid * 4) = o4;
        __syncthreads();
        const int nun = (vcu & 1) ? 6 : 2;
        for (int i = 0; i < nun; ++i) { const int qb = (vcu & 1) ? ((i < 4) ? 6 - i : 5 - i) : ((i == 0) ? 7 : 2);
            int tid_u = F.tid; asm volatile("" : "+v"(tid_u));
            attn_body::attn_unit<40>(b, h, qb, Q, K, V, O, lds_generic + RING_OFF, f2, tid_u); }
        __syncthreads();
    }
}

namespace hg {
constexpr int PB = 144;
constexpr int O_QS = 0, O_KS = 9216, O_QI = 18432, O_KUT = 27648, O_VT = 36864, O_P = 46080, O_ST = 55296, O_TOT = 64512, O_EBL = 66560, O_RED = 66816, BYTES = 67328;
__device__ __forceinline__ float ex(float v) { return __builtin_amdgcn_exp2f(v * LOG2E); }
__device__ __forceinline__ unsigned short bf1(float v) { return (unsigned short)pk2(v, v); }
}
__device__ __forceinline__ void phase_hgrn(const Args& a, const Frame& F, int l, int bh) {
    using namespace hg;
    const bf16_t* HB = (const bf16_t*)(a.ws + WS_HB); const float* LOGF = (const float*)(a.ws + WS_LOGF); const bf16_t* HG = (const bf16_t*)(a.ws + WS_HG); unsigned char* O8 = a.ws + WS_OX8;
    LAS unsigned char* L = F.lds + RING_OFF;
    const int b = bh >> 3, h = bh & 7, lane = F.lane, w = F.wave, tid = F.tid;
    const int fr = lane & 15, fq = lane >> 4;
    const int tr = w >> 1, tc0 = 2 * (w & 1);
    const float ng0 = a.norm_g[l * 512 + h * 64 + 16 * tc0 + fr], ng1 = a.norm_g[l * 512 + h * 64 + 16 * (tc0 + 1) + fr];
    f32x4 S0 = {0.f, 0.f, 0.f, 0.f}, S1 = {0.f, 0.f, 0.f, 0.f};
    for (int i = tid; i < 9216 / 4; i += NWAVES * 64) ((LAS unsigned*)(L + O_ST))[i] = 0u;
    const size_t rowbase = (size_t)b * SEQ;
    float g[8]; unsigned short qv[8], vv[8];
#pragma unroll
    for (int i = 0; i < 8; ++i) { const size_t row = rowbase + 8 * w + i; g[i] = LOGF[row * 512 + h * 64 + lane]; qv[i] = HB[row * 1024 + h * 64 + lane]; vv[i] = HB[row * 1024 + 512 + h * 64 + lane]; }
    for (int c0 = 0; c0 < SEQ; c0 += 64) {
        float bc[8]; { float run = 0.f;
#pragma unroll
            for (int i = 0; i < 8; ++i) { run += g[i]; bc[i] = run; } }
        ((LAS float*)(L + O_TOT))[w * 64 + lane] = bc[7];
        float qf[8], kf[8];
#pragma unroll
        for (int i = 0; i < 8; ++i) { qf[i] = bf2f(qv[i]); kf[i] = 1.f - ex(g[i]); }
        { u32x4 pk; pk.x = (unsigned)vv[0] | ((unsigned)vv[1] << 16); pk.y = (unsigned)vv[2] | ((unsigned)vv[3] << 16); pk.z = (unsigned)vv[4] | ((unsigned)vv[5] << 16); pk.w = (unsigned)vv[6] | ((unsigned)vv[7] << 16);
          *(LAS u32x4*)(L + O_VT + lane * PB + 16 * w) = pk; }
        __syncthreads();
        float base = 0.f, bm = 0.f, bl = 0.f;
#pragma unroll
        for (int ww = 0; ww < 8; ++ww) { const float tv = ((LAS float*)(L + O_TOT))[ww * 64 + lane]; if (ww < w) base += tv; if (ww < 4) bm += tv; bl += tv; }
        const float ebm = ex(bm), eblm = ex(bl - bm);
        if (w == 0) ((LAS float*)(L + O_EBL))[lane] = ex(bl);
        unsigned short ku[8];
#pragma unroll
        for (int i = 0; i < 8; ++i) { const float x = bc[i] + base - bm; const float e1 = ex(fminf(x, 80.f)), e2 = ex(fminf(-x, 80.f));
            const float qs = qf[i] * e1, ks = kf[i] * e2; const int r = 8 * w + i;
            *(LAS unsigned short*)(L + O_QS + r * PB + 2 * lane) = bf1(qs); *(LAS unsigned short*)(L + O_QI + r * PB + 2 * lane) = bf1(qs * ebm);
            *(LAS unsigned short*)(L + O_KS + r * PB + 2 * lane) = bf1(ks); ku[i] = bf1(ks * eblm); }
        { u32x4 pk; pk.x = (unsigned)ku[0] | ((unsigned)ku[1] << 16); pk.y = (unsigned)ku[2] | ((unsigned)ku[3] << 16); pk.z = (unsigned)ku[4] | ((unsigned)ku[5] << 16); pk.w = (unsigned)ku[6] | ((unsigned)ku[7] << 16);
          *(LAS u32x4*)(L + O_KUT + lane * PB + 16 * w) = pk; }
        if (c0 + 64 < SEQ) {
#pragma unroll
            for (int i = 0; i < 8; ++i) { const size_t row = rowbase + c0 + 64 + 8 * w + i; g[i] = LOGF[row * 512 + h * 64 + lane]; qv[i] = HB[row * 1024 + h * 64 + lane]; vv[i] = HB[row * 1024 + 512 + h * 64 + lane]; }
        }
        __syncthreads();
#pragma unroll
        for (int k2 = 0; k2 < 2; ++k2) { const int idx = 2 * w + k2, ti = idx >> 2, sj = idx & 3;
            f32x4 sc = {0.f, 0.f, 0.f, 0.f};
            if (sj <= ti) {
#pragma unroll
                for (int kk = 0; kk < 2; ++kk) { const bf16x8 af = *(const LAS bf16x8*)(L + O_QS + (16 * ti + fr) * PB + (32 * kk + 8 * fq) * 2), bfr = *(const LAS bf16x8*)(L + O_KS + (16 * sj + fr) * PB + (32 * kk + 8 * fq) * 2);
                    sc = __builtin_amdgcn_mfma_f32_16x16x32_bf16(af, bfr, sc, 0, 0, 0); }
            }
#pragma unroll
            for (int j = 0; j < 4; ++j) { const int t = 16 * ti + 4 * fq + j, s = 16 * sj + fr; *(LAS unsigned short*)(L + O_P + t * PB + 2 * s) = bf1(s <= t ? sc[j] : 0.f); }
        }
        __syncthreads();
        f32x4 o0 = {0.f, 0.f, 0.f, 0.f}, o1 = {0.f, 0.f, 0.f, 0.f}, u0 = {0.f, 0.f, 0.f, 0.f}, u1 = {0.f, 0.f, 0.f, 0.f};
#pragma unroll
        for (int kk = 0; kk < 2; ++kk) { const int ko = (32 * kk + 8 * fq) * 2;
            const bf16x8 pa = *(const LAS bf16x8*)(L + O_P + (16 * tr + fr) * PB + ko), qa = *(const LAS bf16x8*)(L + O_QI + (16 * tr + fr) * PB + ko), ka = *(const LAS bf16x8*)(L + O_KUT + (16 * tr + fr) * PB + ko);
            const bf16x8 v0 = *(const LAS bf16x8*)(L + O_VT + (16 * tc0 + fr) * PB + ko), v1 = *(const LAS bf16x8*)(L + O_VT + (16 * (tc0 + 1) + fr) * PB + ko);
            const bf16x8 s0 = *(const LAS bf16x8*)(L + O_ST + (16 * tc0 + fr) * PB + ko), s1 = *(const LAS bf16x8*)(L + O_ST + (16 * (tc0 + 1) + fr) * PB + ko);
            o0 = __builtin_amdgcn_mfma_f32_16x16x32_bf16(pa, v0, o0, 0, 0, 0); o1 = __builtin_amdgcn_mfma_f32_16x16x32_bf16(pa, v1, o1, 0, 0, 0);
            o0 = __builtin_amdgcn_mfma_f32_16x16x32_bf16(qa, s0, o0, 0, 0, 0); o1 = __builtin_amdgcn_mfma_f32_16x16x32_bf16(qa, s1, o1, 0, 0, 0);
            u0 = __builtin_amdgcn_mfma_f32_16x16x32_bf16(ka, v0, u0, 0, 0, 0); u1 = __builtin_amdgcn_mfma_f32_16x16x32_bf16(ka, v1, u1, 0, 0, 0); }
        { const f32x4 dec = *(const LAS f32x4*)(L + O_EBL + (16 * tr + 4 * fq) * 4); S0 = S0 * dec + u0; S1 = S1 * dec + u1; }
        { f32x4 q2 = o0 * o0 + o1 * o1;
#pragma unroll
          for (int m = 1; m < 16; m <<= 1) { q2[0] += __shfl_xor(q2[0], m); q2[1] += __shfl_xor(q2[1], m); q2[2] += __shfl_xor(q2[2], m); q2[3] += __shfl_xor(q2[3], m); }
          if (fr == 0) {
#pragma unroll
              for (int j = 0; j < 4; ++j) ((LAS float*)(L + O_RED))[(16 * tr + 4 * fq + j) * 2 + (w & 1)] = q2[j]; } }
        __syncthreads();
        { u32x2 p0, p1; p0.x = pk2(S0[0], S0[1]); p0.y = pk2(S0[2], S0[3]); p1.x = pk2(S1[0], S1[1]); p1.y = pk2(S1[2], S1[3]);
          *(LAS u32x2*)(L + O_ST + (16 * tc0 + fr) * PB + (16 * tr + 4 * fq) * 2) = p0; *(LAS u32x2*)(L + O_ST + (16 * (tc0 + 1) + fr) * PB + (16 * tr + 4 * fq) * 2) = p1; }
#pragma unroll
        for (int j = 0; j < 4; ++j) { const int t = 16 * tr + 4 * fq + j; const f32x2 rr = *(const LAS f32x2*)(L + O_RED + t * 8); const float rs = rsqrtf((rr[0] + rr[1]) * (1.f / 64.f) + RMS_EPS);
            *(LAS unsigned short*)(L + O_P + t * PB + 2 * (16 * tc0 + fr)) = bf1(o0[j] * rs * ng0); *(LAS unsigned short*)(L + O_P + t * PB + 2 * (16 * (tc0 + 1) + fr)) = bf1(o1[j] * rs * ng1); }
        __syncthreads();
        { const int t = tid >> 3, e8 = (tid & 7) * 8; const size_t row = rowbase + c0 + t;
          const u32x4 ov = *(const LAS u32x4*)(L + O_P + t * PB + e8 * 2), gv = *(const u32x4*)(HG + row * 512 + h * 64 + e8);
          u32x2 r; r.x = pg8::pack4_fp8(bflo(ov.x) * bflo(gv.x) * SC_HGRN, bfhi(ov.x) * bfhi(gv.x) * SC_HGRN, bflo(ov.y) * bflo(gv.y) * SC_HGRN, bfhi(ov.y) * bfhi(gv.y) * SC_HGRN);
          r.y = pg8::pack4_fp8(bflo(ov.z) * bflo(gv.z) * SC_HGRN, bfhi(ov.z) * bfhi(gv.z) * SC_HGRN, bflo(ov.w) * bflo(gv.w) * SC_HGRN, bfhi(ov.w) * bfhi(gv.w) * SC_HGRN);
          *(u32x2*)(O8 + row * 1024 + 512 + h * 64 + e8) = r; }
        __syncthreads();
    }
}


constexpr int PH_PER_LAYER = 10, N_PHASES = 1 + DEPTH * PH_PER_LAYER;
#ifndef MK_ONE_LAUNCH
#define MK_ONE_LAUNCH 1
#endif
#ifndef MK_FAST_ATTN
#define MK_FAST_ATTN 0
#endif
#ifndef MK_FAST_HGRN
#define MK_FAST_HGRN 0
#endif


#ifdef DBG_DUMP
#ifndef DBG_WHAT
#define DBG_WHAT 0
#endif
__device__ __forceinline__ void dbg_dump(const Args& a, const Frame& F) {
    unsigned char* ws = a.ws;
    const bf16_t *QO = (bf16_t*)(ws + WS_QO), *KV = (bf16_t*)(ws + WS_KV), *HB = (bf16_t*)(ws + WS_HB), *HG = (bf16_t*)(ws + WS_HG), *G = (bf16_t*)(ws + WS_G);
    const bf16_t *U1 = (bf16_t*)(ws + WS_U1), *U = (bf16_t*)(ws + WS_U), *MIXED = (bf16_t*)(ws + WS_MIXED), *XN = (bf16_t*)(ws + WS_XN);
    const float *LOGF = (float*)(ws + WS_LOGF), *FL = (float*)(ws + WS_FL), *XRES = (float*)(ws + WS_XRES);
    for (size_t i = (size_t)F.bid * 512 + F.tid; i < (size_t)T * D; i += (size_t)gridDim.x * 512) {
        const size_t row = i >> 10; const int c = (int)(i & 1023);
        float v = 0.f;
        if (DBG_WHAT == 9) { v = bf2f(G[row * 2048 + c]) + bf2f(G[row * 2048 + 1024 + c]); }
        else if (DBG_DUMP == 1) { v = bf2f(KV[i]) + bf2f(HB[i]) + bf2f(G[row * 2048 + c]) + bf2f(G[row * 2048 + 1024 + c]);
            if (c < 512) v += LOGF[row * 512 + c] + bf2f(HG[row * 512 + c]) + bf2f(QO[i]); if (c < 8) v += FL[row * 8 + c]; }
        else if (DBG_DUMP == 2) { v = (c >= 512) ? bf2f(QO[i]) : 0.f; }
        else if (DBG_DUMP == 3) { v = bf2f(QO[i]); }
        else if (DBG_DUMP == 4) { v = bf2f(U1[i]); }
        else if (DBG_DUMP == 5) { v = bf2f(U[i]); }
        else if (DBG_DUMP == 6) { v = bf2f(MIXED[i]); }
        else if (DBG_DUMP == 7) { v = XRES[i] + bf2f(XN[i]); }
        a.out[i] = v;
    }
}
#endif
#define PH_BEGIN const Args a = LOAD_ARGS(); Frame F; F.lds = lds0; F.lane = (int)__builtin_amdgcn_mbcnt_hi(~0u, __builtin_amdgcn_mbcnt_lo(~0u, 0u)); asm volatile("" : "+v"(F.lane)); F.wave = __builtin_amdgcn_readfirstlane((int)((const volatile LAS unsigned*)(lds0 + WTAB_OFF))[hw_wave_key()]); F.tid = F.wave * 64 + F.lane; \
    F.G = gridDim.x; F.bid = blockIdx.x; asm volatile("" : "+s"(F.bid)); F.gw = F.bid * NWAVES + F.wave; F.ngw = F.G * NWAVES; unsigned char* const ws = a.ws; const LAS int* tab = (const LAS int*)(F.lds + TAB_OFF); (void)tab; (void)ws;
#ifdef DBG_DUMP
#define IN(k) (lo <= (k) && (k) < hi && (k) <= DBG_DUMP)
#else
#define IN(k) (lo <= (k) && (k) < hi)
#endif
#ifdef DBG_REPEAT
#define REP(k) for (int rep_ = 0; rep_ < ((DBG_REPEAT == (k) && !((k) == 9 && l == DEPTH - 1)) ? 2 : 1); ++rep_)
#else
#define REP(k)
#endif
#define SEAM(k) do { if (IN(k) && IN((k) + 1)) { XcdBarrier b2_ = bar; { size_t z_ = 0; asm volatile("" : "+s"(z_), "+s"(b2_.x)); b2_.bar = bar.bar + z_; } xcd_barrier(b2_); } } while (0)
template <int l>
__device__ __forceinline__ void layer_body(const Args& args, const int lo, const int hi, const XcdBarrier& bar, LAS unsigned char* const lds0, unsigned char* lds_raw) {
        const int pb = 1 + l * PH_PER_LAYER;

#ifdef DBG_DUMP
        if (l == 0 && lo <= DBG_DUMP + 1 && DBG_DUMP + 1 < hi) { PH_BEGIN dbg_dump(a, F); }
#endif
        if (IN(pb + 0)) REP(0) { PH_BEGIN
            pg8::Gemm g{(bf16_t*)(ws + WS_XN), (bf16_t*)(ws + wset(l) + WO_WIN), D / 2, D / 2, D / 2, E8_1, E8_W}; pg8::StaticOrder S; S.init(T, NINP, F.G, F.bid);
            pg8::EpiInproj E{ws, l};
            pg8::gemm_phase<pg8::EpiInproj, pg8::StaticOrder, true>(F.lds + RING_OFF, g, S, E, F.tid);
        }
        SEAM(pb + 0);
        if (IN(pb + 1)) REP(1) { PH_BEGIN
            const int vcu = (F.G % 8 == 0) ? (F.bid % 8) * (F.G / 8) + F.bid / 8 : F.bid;
            if ((vcu & 1) == 0 && (vcu >> 1) < BATCH * NH) { phase_hgrn(a, F, l, vcu >> 1); __syncthreads(); }
            phase_attn(a, F, (char*)lds_raw);
            if (l + 1 < DEPTH) { __syncthreads(); convert_layer(a, F, l + 1, F.gw, F.ngw); }
        }
        SEAM(pb + 1);
        if (IN(pb + 3)) REP(3) { PH_BEGIN
            pg8::Gemm g{(bf16_t*)(ws + WS_OX8), (bf16_t*)(ws + wset(l) + WO_WBR), D / 2, D / 2, 256, E8_FOX, E8_W}; pg8::StaticOrder S; S.init(T, D, F.G, F.bid);
            pg8::EpiGate<1> E{(bf16_t*)(ws + WS_U1), nullptr, (bf16_t*)(ws + WS_G), 2048, nullptr, 0.f};
            pg8::gemm_phase<pg8::EpiGate<1>, pg8::StaticOrder, true>(F.lds + RING_OFF, g, S, E, F.tid);
        }
        if (IN(pb + 3) && IN(pb + 4)) __syncthreads(); else SEAM(pb + 3);
        if (IN(pb + 4)) REP(4) { PH_BEGIN
            pg8::Gemm g{(bf16_t*)(ws + WS_OX8) + 256, (bf16_t*)(ws + wset(l) + WO_WBR) + 256, D / 2, D / 2, 256, E8_HGRN, E8_W}; pg8::StaticOrder S; S.init(T, D, F.G, F.bid);
            pg8::EpiGate<2> E{(bf16_t*)(ws + WS_U), nullptr, (bf16_t*)(ws + WS_G) + 1024, 2048, (bf16_t*)(ws + WS_U1), 0.f};
            pg8::gemm_phase<pg8::EpiGate<2>, pg8::StaticOrder, true>(F.lds + RING_OFF, g, S, E, F.tid);
        }
        SEAM(pb + 4);
        if (IN(pb + 5)) REP(5) { PH_BEGIN
            pg8::Gemm g{(bf16_t*)(ws + WS_U), (bf16_t*)(ws + wset(l) + WO_WMIX), D / 2, D / 2, D / 2, E8_U, E8_W}; pg8::StaticOrder S; S.init(T, D, F.G, F.bid);
            pg8::EpiGate<0> E{(bf16_t*)(ws + WS_MIXED), a.b_mix + l * D, nullptr, 0, nullptr, SC_MIX};
            pg8::gemm_phase<pg8::EpiGate<0>, pg8::StaticOrder, true>(F.lds + RING_OFF, g, S, E, F.tid);
        }
        SEAM(pb + 5);
        if (IN(pb + 6)) REP(6) { PH_BEGIN phase_ln1_router(a, F, l); }
        SEAM(pb + 6);
        if (IN(pb + 7)) REP(7) { PH_BEGIN
            moe_table(a, F, l);
            pg8::Gemm g{(bf16_t*)(ws + WS_XN), (bf16_t*)(ws + wset(l) + WO_W13), D / 2, D / 2, D / 2, E8_1, E8_W}; pg8::MoeOrder<true> S{F.G, F.bid, 8, tab, (const int*)(ws + WS_LIST), (size_t)2048 * (D / 2), (const LAS int*)(F.lds + TOK_OFF)};
            S.preload_tokens((LAS int*)(F.lds + TOK_OFF), F.tid); __syncthreads();
            pg8::EpiUp E{(bf16_t*)(ws + WS_H)};
            pg8::gemm_phase<pg8::EpiUp, pg8::MoeOrder<true>, true>(F.lds + RING_OFF, g, S, E, F.tid);
        }
        SEAM(pb + 7);
        if (IN(pb + 8)) REP(8) { PH_BEGIN
            moe_table(a, F, l);
            pg8::Gemm g{(bf16_t*)(ws + WS_H), (bf16_t*)(ws + wset(l) + WO_W2), D / 2, D / 2, D / 2, E8_H, E8_W}; pg8::MoeOrder<false> S{F.G, F.bid, 4, tab, nullptr, (size_t)D * (D / 2), nullptr};
            pg8::EpiGate<0> E{(bf16_t*)(ws + WS_Y), nullptr, nullptr, 0, nullptr, SC_Y};
            pg8::gemm_phase<pg8::EpiGate<0>, pg8::MoeOrder<false>, true>(F.lds + RING_OFF, g, S, E, F.tid);
        }
        SEAM(pb + 8);
        if (IN(pb + 9)) REP(9) { PH_BEGIN
            if (l + 1 < DEPTH) load_wff(a, F, l + 1);
            moe_table(a, F, l);
            phase_combine_ln2(a, F, l);
        }
        SEAM(pb + 9);
    }

__global__ void __launch_bounds__(NWAVES * 64, 2) mk_fwd(Args args) {
    extern __shared__ __attribute__((aligned(16))) unsigned char lds_raw[];
    LAS unsigned char* const lds0 = (LAS unsigned char*)lds_raw;
    volatile LAS unsigned* MISC = (volatile LAS unsigned*)(lds0 + MISC_OFF);
    for (int u = threadIdx.x; u < (LDS_BYTES - LDSCTL_OFF) / 4; u += NWAVES * 64) ((LAS unsigned*)(lds0 + LDSCTL_OFF))[u] = 0u;
    __syncthreads();
    if ((threadIdx.x & 63) == 0) ((volatile LAS unsigned*)(lds0 + WTAB_OFF))[hw_wave_key()] = threadIdx.x >> 6;
    __syncthreads();
    unsigned* ctl = (unsigned*)(args.ws + WS_CTL);
    XcdBarrier bar; bar.bar = ctl + CW_BAR; bar.x = 0; bar.st = nullptr;
    if (args.use_bar) bar = xcd_barrier_post(ctl + CW_BAR, MISC + 8);
    const int lo = args.ph_lo, hi = args.ph_hi;


    if (IN(0)) { PH_BEGIN phase_prep(a, F); }
    SEAM(0);
    layer_body<0>(args, lo, hi, bar, lds0, lds_raw); layer_body<1>(args, lo, hi, bar, lds0, lds_raw); layer_body<2>(args, lo, hi, bar, lds0, lds_raw); layer_body<3>(args, lo, hi, bar, lds0, lds_raw);
#undef IN
#undef SEAM
}

extern "C" void kernel_launch(void* const* d_in, const int* in_sizes, int n_in, void* d_out, int out_size, void* d_ws, size_t ws_size, hipStream_t stream) {
    static int grid = 0;
    if (grid == 0) {
        if (n_in != 20 || in_sizes[0] != T * D || out_size != T * D || ws_size < WS_END) { fprintf(stderr, "kernel_launch: unexpected shapes (n_in %d, ws %zu)\n", n_in, ws_size); grid = -1; return; }
        int dev = 0, cus = 0, per_cu = 0;
        if (hipGetDevice(&dev) != hipSuccess || hipDeviceGetAttribute(&cus, hipDeviceAttributeMultiprocessorCount, dev) != hipSuccess) { grid = -1; return; }
        if (hipFuncSetAttribute((const void*)mk_fwd, hipFuncAttributeMaxDynamicSharedMemorySize, LDS_BYTES) != hipSuccess) { fprintf(stderr, "kernel_launch: hipFuncSetAttribute failed\n"); grid = -1; return; }
        if (hipOccupancyMaxActiveBlocksPerMultiprocessor(&per_cu, (const void*)mk_fwd, NWAVES * 64, LDS_BYTES) != hipSuccess || per_cu < 1)
            fprintf(stderr, "kernel_launch: note: occupancy query reports %d workgroups per CU\n", per_cu);
        (void)hipGetLastError();
        grid = cus;
    }
    if (grid < 0) return;
    if (hipMemsetAsync((char*)d_ws + WS_CTL, 0, CTL_BYTES, stream) != hipSuccess) return;
    Args a{};
    a.x = (const float*)d_in[0]; a.ln_in_g = (const float*)d_in[1]; a.ln_in_b = (const float*)d_in[2]; a.w_in = (const float*)d_in[3]; a.b_in = (const float*)d_in[4];
    a.w_fox = (const float*)d_in[5]; a.lbl = (const float*)d_in[6]; a.norm_g = (const float*)d_in[7]; a.w_hgrn = (const float*)d_in[8]; a.w_mix = (const float*)d_in[9];
    a.b_mix = (const float*)d_in[10]; a.ln1_g = (const float*)d_in[11]; a.ln1_b = (const float*)d_in[12]; a.router_w = (const float*)d_in[13]; a.router_b = (const float*)d_in[14];
    a.w1 = (const float*)d_in[15]; a.w3 = (const float*)d_in[16]; a.w2 = (const float*)d_in[17]; a.ln2_g = (const float*)d_in[18]; a.ln2_b = (const float*)d_in[19];
    a.out = (float*)d_out; a.ws = (unsigned char*)d_ws; a.pad = 0;
#if MK_ONE_LAUNCH
    a.ph_lo = 0; a.ph_hi = N_PHASES; a.use_bar = 1;
    hipLaunchKernelGGL(mk_fwd, dim3(grid), dim3(NWAVES * 64), LDS_BYTES, stream, a);
#else
#ifdef DBG_DUMP
    const int np_ = DBG_DUMP + 2;
#else
    const int np_ = N_PHASES;
#endif
    for (int p = 0; p < np_; ++p) { a.ph_lo = p; a.ph_hi = p + 1; a.use_bar = 0;
        hipLaunchKernelGGL(mk_fwd, dim3(grid), dim3(NWAVES * 64), LDS_BYTES, stream, a); }
#endif
    const hipError_t le = hipPeekAtLastError();
    if (le != hipSuccess) fprintf(stderr, "kernel_launch: launch failed: %s\n", hipGetErrorName(le));
}
```

```cpp
#define MK_ONE_LAUNCH 1
#define MK_FAST_ATTN 1
#define MK_FAST_HGRN 1
#include <hip/hip_runtime.h>
#include <cstdio>
#include <cstdint>

typedef unsigned short bf16_t;
typedef short bf16x8 __attribute__((ext_vector_type(8)));
typedef float f32x4 __attribute__((ext_vector_type(4)));
typedef float f32x2 __attribute__((ext_vector_type(2)));
typedef unsigned u32x4 __attribute__((ext_vector_type(4)));
typedef unsigned u32x2 __attribute__((ext_vector_type(2)));
#define LAS __attribute__((address_space(3)))
#define GAS __attribute__((address_space(1)))

constexpr int BATCH = 16, SEQ = 2048, T = BATCH * SEQ, D = 1024, DEPTH = 4, NH = 8, HD = 64, NIN = 5640, NINP = 5632, NE = 16;
constexpr float LN_EPS = 1e-5f, RMS_EPS = 1e-6f;
constexpr float ALPHA = 1.681792830507429f;
constexpr float LOG2E = 1.4426950408889634f;
constexpr float C2 = 0.125f * LOG2E;
constexpr float SC_W = 64.f, SC_FOX = 16.f, SC_HGRN = 4.f, SC_U = 64.f, SC_H = 8.f, SC_MIX = 32.f, SC_Y = 64.f;
constexpr int E8_1 = 0x7f7f7f7f, E8_W = 0x79797979, E8_FOX = 0x7b7b7b7b, E8_HGRN = 0x7d7d7d7d, E8_U = 0x79797979, E8_H = 0x7c7c7c7c;
constexpr int TM = 256;

constexpr size_t MiB = 1u << 20;
constexpr size_t WS_CTL = 0, CTL_BYTES = 1 * MiB;
constexpr size_t WS_MISC = 1 * MiB;
constexpr size_t WS_WSET = 2 * MiB, WSET_BYTES = 56 * MiB;
constexpr size_t WO_WIN = 0, WO_WBR = 6 * MiB, WO_WMIX = 7 * MiB, WO_W13 = 8 * MiB, WO_W2 = 40 * MiB;
__host__ __device__ constexpr size_t wset(int l) { return WS_WSET + (size_t)(l & 1) * WSET_BYTES; }
__host__ __device__ constexpr size_t biasoff(int l) { return WS_MISC + 16384 + (size_t)(l & 1) * 32768; }
constexpr size_t WS_XRES = 114 * MiB, WS_XN = 242 * MiB, WS_QO = 306 * MiB, WS_KV = 370 * MiB, WS_HB = 434 * MiB, WS_LOGF = 498 * MiB;
constexpr size_t WS_HG = 562 * MiB, WS_G = 594 * MiB, WS_FL = 722 * MiB, WS_F2 = 723 * MiB, WS_U1 = 724 * MiB, WS_U = 788 * MiB, WS_MIXED = 852 * MiB;
constexpr size_t WS_LIST = 916 * MiB, WS_TOK = 918 * MiB, WS_X1B = 920 * MiB, WS_END = 984 * MiB;
constexpr size_t WS_OX8 = 274 * MiB;
constexpr size_t WS_H = WS_QO, WS_Y = 442 * MiB;
constexpr int CW_CNT = 1024;
constexpr int CW_BAR = 4096;

__device__ __forceinline__ unsigned f2bf(float f) { unsigned u = __builtin_bit_cast(unsigned, f); return (u + 0x7fffu + ((u >> 16) & 1u)) >> 16; }
__device__ __forceinline__ float bf2f(unsigned h) { return __builtin_bit_cast(float, h << 16); }
__device__ __forceinline__ float bflo(unsigned w) { return __builtin_bit_cast(float, w << 16); }
__device__ __forceinline__ float bfhi(unsigned w) { return __builtin_bit_cast(float, w & 0xffff0000u); }
typedef __bf16 bf16x2v_t __attribute__((ext_vector_type(2)));
__device__ __forceinline__ unsigned pk2(float lo, float hi) { f32x2 v = {lo, hi}; bf16x2v_t b = __builtin_convertvector(v, bf16x2v_t); return __builtin_bit_cast(unsigned, b); }
__device__ __forceinline__ float wave_sum(float v) {
#pragma unroll
    for (int o = 1; o < 64; o <<= 1) v += __shfl_xor(v, o);
    return v;
}
__device__ __forceinline__ float wave_max(float v) {
#pragma unroll
    for (int o = 1; o < 64; o <<= 1) v = fmaxf(v, __shfl_xor(v, o));
    return v;
}
__device__ __forceinline__ float fast_exp(float v) { return __builtin_amdgcn_exp2f(v * LOG2E); }
__device__ __forceinline__ float sigmoidf_(float v) { return __builtin_amdgcn_rcpf(1.0f + fast_exp(-v)); }
__device__ __forceinline__ float siluf_(float v) { return v * sigmoidf_(v); }
__device__ __forceinline__ float logsigmoidf_(float v) { return fminf(v, 0.f) - __logf(1.0f + fast_exp(-fabsf(v))); }

namespace pg8 {
constexpr int BM = 256, BK = 64, HALF = 128, HTB = HALF * BK * 2  , STAGE_BYTES = 8 * HTB, NXCD = 8, WGM = 8;
__host__ __device__ __forceinline__ int lds_byte(int r, int c) { const int st = (r >> 4) * 2 + (c >> 5), rr = r & 15, cc = c & 31, ob = rr * 64 + cc * 2; return st * 1024 + (ob ^ (((ob >> 9) & 1) << 5)); }
__host__ __device__ __forceinline__ void stage_rc(int b, int& R, int& C) { const int st = b / 1024, sb = b % 1024, swz = sb ^ (((sb >> 9) & 1) << 5); R = (st >> 1) * 16 + swz / 64; C = (st & 1) * 32 + (swz % 64) / 2; }
__host__ __device__ __forceinline__ int perm32(int rho) { const int n = rho >> 4, i = rho & 15; return 8 * (i >> 2) + 4 * n + (i & 3); }

struct Unit { int pm, pn, e; };
struct Gemm { const bf16_t* A; const bf16_t* Bt; int lda, ldb, K; int sa, sb; };

struct StaticOrder {
    static constexpr bool GATHER = false;
    int nM, nN, nwg, G, c;
    __device__ void init(int M, int N, int G_, int c_) { nM = M / BM; nN = N / BM; nwg = nM * nN; G = G_; c = c_; }
    __device__ bool next(int i, Unit& u) const {
        const int L = i * G + c; if (L >= nwg) return false;
        int wgid = L; { const int q = nwg / NXCD, r = nwg % NXCD, xcd = wgid % NXCD, off = wgid / NXCD; wgid = (xcd < r ? xcd * (q + 1) : r * (q + 1) + (xcd - r) * q) + off; }
        const int nig = WGM * nN, gid = wgid / nig, fm = gid * WGM, gsz = (nM - fm) < WGM ? (nM - fm) : WGM;
        u.pm = fm + ((wgid % nig) % gsz); u.pn = (wgid % nig) / gsz; u.e = 0; return true;
    }
    __device__ __forceinline__ const char* a_tile(const Gemm& g, const Unit& u) const { return (const char*)g.A + (size_t)u.pm * BM * g.lda * 2; }
    __device__ __forceinline__ const char* b_tile(const Gemm& g, const Unit& u) const { return (const char*)g.Bt + (size_t)u.pn * BM * g.ldb * 2; }
    __device__ __forceinline__ void a_voff(const Gemm& g, const Unit&, int, const int (&R)[2], const int (&C)[2], unsigned (&v)[2][2]) const {
#pragma unroll
        for (int h = 0; h < 2; ++h)
#pragma unroll
            for (int i = 0; i < 2; ++i) v[h][i] = (unsigned)((h * HALF + R[i]) * g.lda + C[i]) * 2u;
    }
};
template <bool GATHER_> struct MoeOrder {
    static constexpr bool GATHER = GATHER_; static constexpr bool gather = GATHER_;
    int G, c, nN; const LAS int* tab; const int* list; size_t bstride; const LAS int* tok;
    __device__ bool next(int i, Unit& u) const {
        const int L = i * G + c; const int rt = L / nN; const int NT = tab[NE]; if (rt >= NT) return false;
        int e = 0;
#pragma unroll
        for (int k = 1; k < NE; ++k) e += (rt >= tab[k]) ? 1 : 0;
        u.pm = __builtin_amdgcn_readfirstlane(rt); u.pn = __builtin_amdgcn_readfirstlane(L % nN); u.e = __builtin_amdgcn_readfirstlane(e); return true;
    }
    __device__ __forceinline__ const char* a_tile(const Gemm& g, const Unit& u) const { return gather ? (const char*)g.A : (const char*)g.A + (size_t)u.pm * BM * g.lda * 2; }
    __device__ __forceinline__ const char* b_tile(const Gemm& g, const Unit& u) const { return (const char*)g.Bt + ((size_t)u.e * bstride + (size_t)u.pn * BM * g.ldb) * 2; }
    __device__ __forceinline__ void a_voff(const Gemm& g, const Unit& u, int ui, const int (&R)[2], const int (&C)[2], unsigned (&v)[2][2]) const {
#pragma unroll
        for (int h = 0; h < 2; ++h)
#pragma unroll
            for (int i = 0; i < 2; ++i) {
                if (gather) { const int tk = tok[ui * BM + h * HALF + R[i]]; v[h][i] = (unsigned)(tk * g.lda + C[i]) * 2u; }
                else v[h][i] = (unsigned)((h * HALF + R[i]) * g.lda + C[i]) * 2u;
            }
    }
    __device__ __forceinline__ void preload_tokens(LAS int* tokw, int tid) const {
        Unit u;
        for (int i = 0; next(i, u); ++i) { const int ts = tab[u.e], cn = tab[NE + 1 + u.e];
            for (int r = tid; r < BM; r += 512) { const int pos = (u.pm - ts) * BM + r; tokw[i * BM + r] = (pos < cn) ? list[u.e * T + pos] : 0; } }
    }
};

typedef __bf16 bf16x2_t __attribute__((ext_vector_type(2)));
__device__ __forceinline__ unsigned cvt_pk_bf16(float lo, float hi) { f32x2 v = {lo, hi}; bf16x2_t b = __builtin_convertvector(v, bf16x2_t); return __builtin_bit_cast(unsigned, b); }
__device__ __forceinline__ u32x4 pack8(const f32x4& v0, const f32x4& v1) { u32x4 w; w.x = cvt_pk_bf16(v0[0], v0[1]); w.y = cvt_pk_bf16(v0[2], v0[3]); w.z = cvt_pk_bf16(v1[0], v1[1]); w.w = cvt_pk_bf16(v1[2], v1[3]); return w; }
__device__ __forceinline__ void unpack8(const u32x4& w, f32x4& v0, f32x4& v1) { v0[0] = bflo(w.x); v0[1] = bfhi(w.x); v0[2] = bflo(w.y); v0[3] = bfhi(w.y); v1[0] = bflo(w.z); v1[1] = bfhi(w.z); v1[2] = bflo(w.w); v1[3] = bfhi(w.w); }
typedef int v8i __attribute__((ext_vector_type(8)));
typedef int v4i __attribute__((ext_vector_type(4)));
__device__ __forceinline__ u32x2 pack8_fp8(const f32x4& v0, const f32x4& v1) {
    u32x2 w; int t = 0; t = __builtin_amdgcn_cvt_pk_fp8_f32(v0[0], v0[1], t, false); t = __builtin_amdgcn_cvt_pk_fp8_f32(v0[2], v0[3], t, true); w.x = (unsigned)t;
    int t2 = 0; t2 = __builtin_amdgcn_cvt_pk_fp8_f32(v1[0], v1[1], t2, false); t2 = __builtin_amdgcn_cvt_pk_fp8_f32(v1[2], v1[3], t2, true); w.y = (unsigned)t2; return w; }
__device__ __forceinline__ unsigned pack4_fp8(float a, float b, float c, float d) { int t = 0; t = __builtin_amdgcn_cvt_pk_fp8_f32(a, b, t, false); t = __builtin_amdgcn_cvt_pk_fp8_f32(c, d, t, true); return (unsigned)t; }
__device__ __forceinline__ f32x4 sig4(const f32x4& v) { f32x4 o; o[0] = sigmoidf_(v[0]); o[1] = sigmoidf_(v[1]); o[2] = sigmoidf_(v[2]); o[3] = sigmoidf_(v[3]); return o; }

__device__ __forceinline__ void gld16(f32x4& r, const void* p) { asm volatile("global_load_dwordx4 %0, %1, off" : "=v"(r) : "v"(p) : "memory"); }
__device__ __forceinline__ void gld16u(u32x4& r, const void* p) { asm volatile("global_load_dwordx4 %0, %1, off" : "=v"(r) : "v"(p) : "memory"); }
__device__ __forceinline__ void gld16u_nt(u32x4& r, const void* p) { asm volatile("global_load_dwordx4 %0, %1, off nt" : "=v"(r) : "v"(p) : "memory"); }
__device__ __forceinline__ void gld16x4s(f32x4 (&r)[2][2], const void* sbase, unsigned voff) {
    asm volatile("global_load_dwordx4 %0, %4, %5\n\tglobal_load_dwordx4 %1, %4, %5 offset:16\n\tglobal_load_dwordx4 %2, %4, %5 offset:512\n\tglobal_load_dwordx4 %3, %4, %5 offset:528"
                 : "=&v"(r[0][0]), "=&v"(r[0][1]), "=&v"(r[1][0]), "=&v"(r[1][1]) : "v"(voff), "s"(sbase) : "memory"); }
#define GWAIT4F(a, b, c, d) asm volatile("s_waitcnt vmcnt(0)" : "+v"(a), "+v"(b), "+v"(c), "+v"(d) :: "memory")
#define GWAIT4U(a, b, c, d) asm volatile("s_waitcnt vmcnt(0)" : "+v"(a), "+v"(b), "+v"(c), "+v"(d) :: "memory")
struct EpiInproj {
    static constexpr bool PERM = true;
    static constexpr int NPRE = 4, NVM = 16;
    unsigned char* ws; int layer;
    __device__ __forceinline__ void prefetch(f32x4 (&pre)[2][2], const Unit& u, int wr, int wc, int fr, int fq) const {
        gld16x4s(pre, ws + biasoff(layer), (unsigned)(u.pn * BM + wc * 32 + 8 * fq) * 4u); }
    template <int KIND> __device__ __forceinline__ void tile(const f32x4 (&acc)[2][2][4][2], const Unit& u, int wr, int wc, int fr, int fq, unsigned char* w, const f32x4 (&bv)[2][2]) const {
        const int row0 = u.pm * BM + wr * 64 + fr, bcol0 = u.pn * BM + wc * 32 + 8 * fq;
        f32x4 lbv[2][2];
        if (KIND == 4) { const float* lb = (const float*)(w + WS_MISC) + layer * 512;
#pragma unroll
            for (int bj = 0; bj < 2; ++bj)
#pragma unroll
                for (int n = 0; n < 2; ++n) gld16(lbv[bj][n], lb + (bcol0 - 2048) + bj * HALF + 4 * n);
            GWAIT4F(lbv[0][0], lbv[0][1], lbv[1][0], lbv[1][1]); }
#pragma unroll
        for (int ai = 0; ai < 2; ++ai)
#pragma unroll
            for (int m = 0; m < 4; ++m) { const size_t row = (size_t)(row0 + ai * HALF + m * 16);
#pragma unroll
                for (int bj = 0; bj < 2; ++bj) { f32x4 v0 = acc[ai][bj][m][0] + bv[bj][0], v1 = acc[ai][bj][m][1] + bv[bj][1]; const int col = bcol0 + bj * HALF;
                    if (KIND == 0) { *(u32x4*)((bf16_t*)(w + WS_QO) + row * 1024 + col) = pack8(v0 * C2, v1 * C2); }
                    else if (KIND == 1) { *(u32x4*)((bf16_t*)(w + WS_KV) + row * 1024 + (col - 512)) = pack8(v0, v1); }
                    else if (KIND == 2) { *(u32x4*)((bf16_t*)(w + WS_KV) + row * 1024 + 512 + (col - 1024)) = pack8(v0, v1); }
                    else if (KIND == 3) { *(u32x4*)((bf16_t*)(w + WS_HB) + row * 1024 + (col - 1536)) = pack8(v0 * sig4(v0), v1 * sig4(v1)); }
                    else if (KIND == 4) { const int c = col - 2048; const f32x4 l0 = lbv[bj][0], l1 = lbv[bj][1];
                        f32x4 f0 = l0 + (1.f - l0) * sig4(v0), f1 = l1 + (1.f - l1) * sig4(v1);
#pragma unroll
                        for (int q = 0; q < 4; ++q) { f0[q] = __logf(f0[q]); f1[q] = __logf(f1[q]); }
                        float* LOGF = (float*)(w + WS_LOGF); *(f32x4*)(LOGF + row * 512 + c) = f0; *(f32x4*)(LOGF + row * 512 + c + 4) = f1; }
                    else if (KIND == 5) { *(u32x4*)((bf16_t*)(w + WS_HB) + row * 1024 + 512 + (col - 2560)) = pack8(v0, v1); }
                    else if (KIND == 6) { *(u32x4*)((bf16_t*)(w + WS_HG) + row * 512 + (col - 3072)) = pack8(v0 * sig4(v0), v1 * sig4(v1)); }
                    else { f32x4 t0 = acc[ai][bj][m][0] * (-LOG2E) + bv[bj][0] * (-LOG2E), t1 = acc[ai][bj][m][1] * (-LOG2E) + bv[bj][1] * (-LOG2E);
#pragma unroll
                        for (int q = 0; q < 4; ++q) { t0[q] = __builtin_amdgcn_rcpf(1.0f + __builtin_amdgcn_exp2f(t0[q])); t1[q] = __builtin_amdgcn_rcpf(1.0f + __builtin_amdgcn_exp2f(t1[q])); }
                        *(u32x4*)((bf16_t*)(w + WS_G) + row * 2048 + (col - 3584)) = pack8(t0, t1); }
                } }
    }
    __device__ __forceinline__ void operator()(const f32x4 (&acc)[2][2][4][2], const Unit& u, int wr, int wc, int fr, int fq, const f32x4 (&pre)[2][2]) const {
        size_t z_ = 0; asm volatile("" : "+s"(z_)); unsigned char* w = ws + z_;
        const int ct = u.pn;
        if (ct < 2) tile<0>(acc, u, wr, wc, fr, fq, w, pre); else if (ct < 4) tile<1>(acc, u, wr, wc, fr, fq, w, pre); else if (ct < 6) tile<2>(acc, u, wr, wc, fr, fq, w, pre);
        else if (ct < 8) tile<3>(acc, u, wr, wc, fr, fq, w, pre); else if (ct < 10) tile<4>(acc, u, wr, wc, fr, fq, w, pre); else if (ct < 12) tile<5>(acc, u, wr, wc, fr, fq, w, pre);
        else if (ct < 14) tile<6>(acc, u, wr, wc, fr, fq, w, pre); else tile<7>(acc, u, wr, wc, fr, fq, w, pre);
    }
};
template <int MODE> struct EpiGate {
    static constexpr bool PERM = true;
    static constexpr int NPRE = (MODE == 0) ? 4 : 0, NVM = 16;
    bf16_t* O; const float* bias; const bf16_t* Gt; int ldg; const bf16_t* P; float osc;
    __device__ __forceinline__ void prefetch(f32x4 (&pre)[2][2], const Unit& u, int wr, int wc, int fr, int fq) const {
        if (MODE == 0) gld16x4s(pre, bias, (unsigned)(u.pn * BM + wc * 32 + 8 * fq) * 4u); }
    __device__ __forceinline__ void operator()(const f32x4 (&acc)[2][2][4][2], const Unit& u, int wr, int wc, int fr, int fq, const f32x4 (&bv)[2][2]) const {
        const int row0 = u.pm * BM + wr * 64 + fr, col0 = u.pn * BM + wc * 32 + 8 * fq;
#pragma unroll
        for (int ai = 0; ai < 2; ++ai)
#pragma unroll
            for (int mh = 0; mh < 2; ++mh) {
                u32x4 gq[2][2], pq[2][2];
                if (MODE != 0) {
#pragma unroll
                    for (int mm = 0; mm < 2; ++mm)
#pragma unroll
                        for (int bj = 0; bj < 2; ++bj) { const size_t row = (size_t)(row0 + ai * HALF + (mh * 2 + mm) * 16); const int col = col0 + bj * HALF;
                            gld16u(gq[mm][bj], Gt + row * ldg + col);
                            if (MODE == 2) gld16u_nt(pq[mm][bj], P + row * 1024 + col); }
                    GWAIT4U(gq[0][0], gq[0][1], gq[1][0], gq[1][1]);
                    if (MODE == 2) GWAIT4U(pq[0][0], pq[0][1], pq[1][0], pq[1][1]);
                }
#pragma unroll
                for (int mm = 0; mm < 2; ++mm)
#pragma unroll
                    for (int bj = 0; bj < 2; ++bj) { const int m = mh * 2 + mm; const size_t row = (size_t)(row0 + ai * HALF + m * 16); const int col = col0 + bj * HALF;
                        f32x4 v0 = acc[ai][bj][m][0], v1 = acc[ai][bj][m][1];
                        if (MODE == 0) { v0 += bv[bj][0]; v1 += bv[bj][1]; }
                        else { f32x4 g0, g1; unpack8(gq[mm][bj], g0, g1); v0 *= g0; v1 *= g1;
                            if (MODE == 2) { f32x4 p0, p1; unpack8(pq[mm][bj], p0, p1); v0 += p0; v1 += p1; } }
                        if (MODE == 2) *(u32x2*)((unsigned char*)O + row * 1024 + col) = pack8_fp8(v0 * SC_U, v1 * SC_U);
                        else if (MODE == 0 && osc != 0.f) *(u32x2*)((unsigned char*)O + row * 1024 + col) = pack8_fp8(v0 * osc, v1 * osc);
                        else *(u32x4*)(O + row * 1024 + col) = pack8(v0, v1); }
                if (MODE != 0) asm volatile("" ::: "memory");
            }
    }
};
struct EpiUp {
    static constexpr bool PERM = true;
    static constexpr int NPRE = 0, NVM = 8;
    bf16_t* H;
    __device__ __forceinline__ void prefetch(f32x4 (&)[2][2], const Unit&, int, int, int, int) const {}
    __device__ __forceinline__ void operator()(const f32x4 (&acc)[2][2][4][2], const Unit& u, int wr, int wc, int fr, int fq, const f32x4 (&)[2][2]) const {
        const int row0 = u.pm * BM + wr * 64 + fr, col = u.pn * HALF + wc * 32 + 8 * fq;
#pragma unroll
        for (int ai = 0; ai < 2; ++ai)
#pragma unroll
            for (int m = 0; m < 4; ++m) { const size_t row = (size_t)(row0 + ai * HALF + m * 16);
                const f32x4 a0 = acc[ai][0][m][0], a1 = acc[ai][0][m][1], b0 = acc[ai][1][m][0], b1 = acc[ai][1][m][1];
                *(u32x2*)((unsigned char*)H + row * 1024 + col) = pack8_fp8(a0 * sig4(a0) * b0 * SC_H, a1 * sig4(a1) * b1 * SC_H); }
    }
};

__device__ __forceinline__ void glds16s(const char* sbase, unsigned voff, unsigned lds_dst) {
    unsigned keep;
    asm volatile("s_mov_b32 %0, m0\n\ts_mov_b32 m0, %3\n\ts_nop 0\n\tglobal_load_lds_dwordx4 %1, %2\n\ts_mov_b32 m0, %0" : "=&s"(keep) : "v"(voff), "s"(sbase), "s"(lds_dst) : "memory");
}
template <class Epi, class Sched, bool ALIGN_EPI>
__device__ __forceinline__ void gemm_phase(LAS unsigned char* lds, const Gemm g, const Sched& S, const Epi& E, const int tid) {
    const int wid = __builtin_amdgcn_readfirstlane(tid >> 6), lane = tid & 63, wr = wid >> 2, wc = wid & 3, fr = lane & 15, fq = lane >> 4;
    int K = g.K; asm volatile("" : "+s"(K));
    const int nt = K / BK;
    int RA[2], CA[2]; unsigned voffB[2];
#pragma unroll
    for (int i = 0; i < 2; ++i) { int R, C; stage_rc(tid * 16 + i * 8192, R, C); const int Rb = Epi::PERM ? ((R & ~31) + perm32(R & 31)) : R;
        RA[i] = R; CA[i] = C; voffB[i] = (unsigned)(Rb * g.ldb + C) * 2u; }
    const size_t kstep = (size_t)(BK * 2);
    const size_t hstepB = (size_t)HALF * g.ldb * 2;
    const unsigned ldsw = (unsigned)wid * 1024u;
    const unsigned ldsb = (unsigned)__builtin_amdgcn_readfirstlane((int)((unsigned)(uintptr_t)lds + ldsw));
    const int aoff = lds_byte(wr * 64 + fr, fq * 8), boff = lds_byte(wc * 32 + fr, fq * 8);
#define PG8_SA(b, h) (((b) * 2 + (h)) * HTB)
#define PG8_SB(b, h) ((4 + (b) * 2 + (h)) * HTB)
#define PG8_STAGE(bufoff, gbase, voff) do { _Pragma("unroll") for (int _i = 0; _i < 2; ++_i) glds16s((const char*)(gbase), (voff)[_i], ldsb + (unsigned)((bufoff) + _i * 8192)); } while (0)
#define PG8_LD8(p) __builtin_shufflevector(*(const LAS v4i*)(p), *(const LAS v4i*)((p) + 1024), 0, 1, 2, 3, 4, 5, 6, 7)
#define PG8_LDA(dst, b, h) do { _Pragma("unroll") for (int m = 0; m < 4; ++m) dst[m] = PG8_LD8(lds + PG8_SA(b, h) + aoff + m * 2048); } while (0)
#define PG8_LDB(dst, b, h) do { _Pragma("unroll") for (int n = 0; n < 2; ++n) dst[n] = PG8_LD8(lds + PG8_SB(b, h) + boff + n * 2048); } while (0)
#define PG8_MMA(ai, bj, At, Bt) do { __builtin_amdgcn_s_setprio(1); _Pragma("unroll") for (int m = 0; m < 4; ++m) _Pragma("unroll") for (int n = 0; n < 2; ++n) \
        asm volatile("v_mfma_scale_f32_16x16x128_f8f6f4 %0, %1, %2, %0, %3, %4 op_sel_hi:[0,0,0]" : "+v"(acc[ai][bj][m][n]) : "v"(Bt[n]), "v"(At[m]), "v"(sbv), "v"(sav)); \
        __builtin_amdgcn_s_setprio(0); } while (0)
#define PG8_WAIT_V(n) asm volatile("s_waitcnt vmcnt(" #n ")" ::: "memory")
#define PG8_WAIT_VN(n) do { const int n_ = (n); if (n_ == 8) PG8_WAIT_V(8); else if (n_ == 12) PG8_WAIT_V(12); else if (n_ == 16) PG8_WAIT_V(16); else if (n_ == 20) PG8_WAIT_V(20); else if (n_ == 24) PG8_WAIT_V(24); else if (n_ == 28) PG8_WAIT_V(28); else PG8_WAIT_V(8); } while (0)
#define PG8_WAIT_L(n) asm volatile("s_waitcnt lgkmcnt(" #n ")" ::: "memory")
#define PG8_BAR __builtin_amdgcn_s_barrier()
#define PG8_SCHED __builtin_amdgcn_sched_barrier(0)
    Unit cur, nxt; int ui = 0;
    if (!S.next(0, cur)) return;
    f32x4 pre[2][2]; asm volatile("" : "=v"(pre[0][0]), "=v"(pre[0][1]), "=v"(pre[1][0]), "=v"(pre[1][1]));
    f32x4 acc[2][2][4][2];
#pragma unroll
    for (int a = 0; a < 2; ++a)
#pragma unroll
        for (int b = 0; b < 2; ++b)
#pragma unroll
            for (int m = 0; m < 4; ++m)
#pragma unroll
                for (int n = 0; n < 2; ++n) acc[a][b][m][n] = (f32x4){0.f, 0.f, 0.f, 0.f};
    int sav = g.sa, sbv = g.sb;
    v8i At[4], B0[2], B1[2];
    unsigned vA[2][2], nvA[2][2];
    S.a_voff(g, cur, 0, RA, CA, vA);
    const char* cA = S.a_tile(g, cur); const char* cB = S.b_tile(g, cur);
    PG8_STAGE(PG8_SB(0, 0), cB, voffB); PG8_STAGE(PG8_SB(0, 1), cB + hstepB, voffB); PG8_STAGE(PG8_SA(0, 0), cA, vA[0]); PG8_STAGE(PG8_SA(0, 1), cA, vA[1]);
    if (wr == 1) PG8_BAR;
    PG8_WAIT_V(2); PG8_BAR;
    PG8_STAGE(PG8_SB(1, 0), cB + kstep, voffB); PG8_STAGE(PG8_SA(1, 0), cA + kstep, vA[0]); PG8_STAGE(PG8_SB(1, 1), cB + hstepB + kstep, voffB);
    PG8_WAIT_V(6); PG8_BAR;
    for (;;) {
        const bool has_next = S.next(ui + 1, nxt);
        const char* nA = has_next ? S.a_tile(g, nxt) : cA; const char* nB = has_next ? S.b_tile(g, nxt) : cB;
        if constexpr (Sched::GATHER) {
            if (has_next) { int RA2[2], CA2[2];
#pragma unroll
                for (int i = 0; i < 2; ++i) { int tq = tid; asm volatile("" : "+v"(tq)); stage_rc(tq * 16 + i * 8192, RA2[i], CA2[i]); }
                S.a_voff(g, nxt, ui + 1, RA2, CA2, nvA); }
            else {
#pragma unroll
                for (int h = 0; h < 2; ++h)
#pragma unroll
                    for (int i = 0; i < 2; ++i) nvA[h][i] = vA[h][i]; }
        }
        for (int t = 0; t < nt; t += 2) {
            const bool last = (t == nt - 2);
            const int xs = (ui > 0 && t == 0) ? Epi::NVM : 0, xp = (last && Epi::NPRE) ? Epi::NPRE : 0;
            const char* a1 = cA + (size_t)(t + 1) * kstep;
            const char* a2 = last ? nA : cA + (size_t)(t + 2) * kstep; const char* b2 = last ? nB : cB + (size_t)(t + 2) * kstep;
            const char* a3 = a2 + kstep; const char* b3 = b2 + kstep;
            unsigned wA0[2], wA1[2];
#pragma unroll
            for (int i = 0; i < 2; ++i) { if constexpr (Sched::GATHER) { wA0[i] = last ? nvA[0][i] : vA[0][i]; wA1[i] = last ? nvA[1][i] : vA[1][i]; } else { wA0[i] = vA[0][i]; wA1[i] = vA[1][i]; } }
            PG8_LDB(B0, 0, 0); PG8_LDB(B1, 0, 1); PG8_SCHED; PG8_LDA(At, 0, 0); PG8_STAGE(PG8_SA(1, 1), a1, vA[1]);
            if (Epi::NPRE) { if (last) E.prefetch(pre, cur, wr, wc, fr, fq); }
            PG8_WAIT_VN(8 + xs + xp); PG8_WAIT_L(0); PG8_BAR; PG8_MMA(0, 0, At, B0); PG8_MMA(0, 1, At, B1); PG8_BAR; PG8_SCHED;
            PG8_LDA(At, 0, 1); PG8_STAGE(PG8_SB(0, 0), b2, voffB); PG8_STAGE(PG8_SB(0, 1), b2 + hstepB, voffB); PG8_STAGE(PG8_SA(0, 0), a2, wA0);
            PG8_WAIT_VN(8 + xs + xp); PG8_WAIT_L(0); PG8_BAR; PG8_MMA(1, 0, At, B0); PG8_MMA(1, 1, At, B1); PG8_BAR; PG8_SCHED;
            PG8_LDB(B0, 1, 0); PG8_LDB(B1, 1, 1); PG8_SCHED; PG8_LDA(At, 1, 0); PG8_STAGE(PG8_SA(0, 1), a2, wA1);
            PG8_WAIT_VN(8 + xp); PG8_WAIT_L(0); PG8_BAR; PG8_MMA(0, 0, At, B0); PG8_MMA(0, 1, At, B1); PG8_BAR; PG8_SCHED;
            PG8_LDA(At, 1, 1); PG8_STAGE(PG8_SB(1, 0), b3, voffB); PG8_STAGE(PG8_SB(1, 1), b3 + hstepB, voffB); PG8_STAGE(PG8_SA(1, 0), a3, wA0);
            PG8_WAIT_V(8); PG8_WAIT_L(0); PG8_BAR; PG8_MMA(1, 0, At, B0); PG8_MMA(1, 1, At, B1); PG8_BAR; PG8_SCHED;
        }
        if constexpr (ALIGN_EPI) { if (wr == 0) PG8_BAR; }
        asm volatile("s_nop 15\n\ts_nop 15" ::: "memory");
        if (Epi::NPRE) asm volatile("" : "+v"(pre[0][0]), "+v"(pre[0][1]), "+v"(pre[1][0]), "+v"(pre[1][1]));
        E(acc, cur, wr, wc, fr, fq, pre);
        if (!has_next) break;
#pragma unroll
        for (int a = 0; a < 2; ++a)
#pragma unroll
            for (int b = 0; b < 2; ++b)
#pragma unroll
                for (int m = 0; m < 4; ++m)
#pragma unroll
                    for (int n = 0; n < 2; ++n) acc[a][b][m][n] = (f32x4){0.f, 0.f, 0.f, 0.f};
        cur = nxt; cA = nA; cB = nB; ++ui;
        if constexpr (Sched::GATHER) {
#pragma unroll
            for (int h = 0; h < 2; ++h)
#pragma unroll
                for (int i = 0; i < 2; ++i) vA[h][i] = nvA[h][i]; }
        if constexpr (ALIGN_EPI) { if (wr == 1) PG8_BAR; }
    }
    PG8_WAIT_V(0);
    if constexpr (!ALIGN_EPI) { if (wr == 0) PG8_BAR; }
    PG8_BAR;
#undef PG8_SA
#undef PG8_SB
#undef PG8_STAGE
#undef PG8_LDA
#undef PG8_LDB
#undef PG8_MMA
#undef PG8_LD8
#undef PG8_WAIT_V
#undef PG8_WAIT_VN
#undef PG8_WAIT_L
#undef PG8_BAR
#undef PG8_SCHED
}
}


#include <hip/hip_bf16.h>
#include <cmath>
namespace attn_body {
using bf16=__hip_bfloat16;
using bf16x8=__attribute__((ext_vector_type(8)))short;
using s16x4=__attribute__((ext_vector_type(4)))short;
using f32x16=__attribute__((ext_vector_type(16)))float;
using u32x4=__attribute__((ext_vector_type(4)))unsigned;
constexpr int BATCH=16,NHEAD=8,SEQ=2048,D=64,DM=1024;
constexpr int NW=8,QBLK=32,QB=QBLK*NW,KVBLK=64,NQB=SEQ/QB;
constexpr int ATTN_PITCH=DM, ATTN_UNIT_ROWS=QB;
__device__ __forceinline__ int crow(int r,int hi){return (r&3)+8*(r>>2)+4*hi;}
#define SBAR() __builtin_amdgcn_sched_barrier(0)
__device__ __forceinline__ void cmask(f32x16&p0,f32x16&p1,int jb,int qrel,int hi){
  const float NEG=-INFINITY; int kb=64*jb+4*hi;
  #pragma unroll
  for(int r=0;r<16;++r){int kv=kb+(r&3)+8*(r>>2); if(kv>qrel)p0[r]=NEG; if(kv+32>qrel)p1[r]=NEG;}
}

constexpr int NSLOT=3, SLOTB=8192;
constexpr int LDS_K=0, LDS_V=NSLOT*SLOTB, LDS_WS=2*NSLOT*SLOTB, LDS_OST=LDS_WS+NW*64*4, LDS_BYTES=LDS_OST+NW*4096;
constexpr float C2=0.125f*1.4426950408889634f;
__device__ __forceinline__ void glds16(const void*gsrc,unsigned lds_dst){unsigned keep;
  asm volatile("s_mov_b32 %0, m0\n\ts_mov_b32 m0, %2\n\ts_nop 0\n\tglobal_load_lds_dwordx4 %1, off\n\ts_mov_b32 m0, %0":"=&s"(keep):"v"(gsrc),"s"(lds_dst):"memory");}
__device__ __forceinline__ float max3f(float a,float b,float c){float r;asm("v_max3_f32 %0, %1, %2, %3":"=v"(r):"v"(a),"v"(b),"v"(c));return r;}
__device__ __forceinline__ float max2f(float a,float b){float r;asm("v_max_f32_e32 %0, %1, %2":"=v"(r):"v"(a),"v"(b));return r;}
__device__ __forceinline__ float fadd_s(float a,float b){float r;asm("v_add_f32_e32 %0, %1, %2":"=v"(r):"v"(a),"v"(b));return r;}
__device__ __forceinline__ float fsub_s(float a,float b){float r;asm("v_sub_f32_e32 %0, %1, %2":"=v"(r):"v"(a),"v"(b));return r;}
typedef float f32x2_t __attribute__((ext_vector_type(2))); typedef __bf16 bf16x2_t __attribute__((ext_vector_type(2)));
__device__ __forceinline__ unsigned cvtpk_s(float lo,float hi){f32x2_t v={lo,hi};bf16x2_t b=__builtin_convertvector(v,bf16x2_t);return __builtin_bit_cast(unsigned,b);}
#define WAIT_BAR(N) asm volatile("s_waitcnt vmcnt(" #N ") lgkmcnt(0)\n\ts_barrier":::"memory")

__device__ __forceinline__ void qkt(f32x16&p0,f32x16&p1,const char*Kslot,const bf16x8*qr,const f32x16&negm,int r32,int hi){
  const char*kb=Kslot+hi*1024+r32*16;
  #pragma unroll
  for(int d0=0;d0<4;++d0){
    const bf16x8 b0=*reinterpret_cast<const bf16x8*>(kb+d0*2048);
    const bf16x8 b1=*reinterpret_cast<const bf16x8*>(kb+d0*2048+512);
    if(d0==0){p0=__builtin_amdgcn_mfma_f32_32x32x16_bf16(b0,qr[0],negm,0,0,0);p1=__builtin_amdgcn_mfma_f32_32x32x16_bf16(b1,qr[0],negm,0,0,0);}
    else{p0=__builtin_amdgcn_mfma_f32_32x32x16_bf16(b0,qr[d0],p0,0,0,0);p1=__builtin_amdgcn_mfma_f32_32x32x16_bf16(b1,qr[d0],p1,0,0,0);}}
}
typedef __attribute__((address_space(3))) const char* lds_cptr;
typedef short v4i16_t __attribute__((ext_vector_type(4)));
__device__ __forceinline__ void kload8(bf16x8*kf,lds_cptr kp){
  kf[0]=*(const __attribute__((address_space(3))) bf16x8*)(kp);      kf[1]=*(const __attribute__((address_space(3))) bf16x8*)(kp+512);
  kf[2]=*(const __attribute__((address_space(3))) bf16x8*)(kp+2048); kf[3]=*(const __attribute__((address_space(3))) bf16x8*)(kp+2560);
  kf[4]=*(const __attribute__((address_space(3))) bf16x8*)(kp+4096); kf[5]=*(const __attribute__((address_space(3))) bf16x8*)(kp+4608);
  kf[6]=*(const __attribute__((address_space(3))) bf16x8*)(kp+6144); kf[7]=*(const __attribute__((address_space(3))) bf16x8*)(kp+6656);
}
__device__ __forceinline__ void kload2(bf16x8*kf,lds_cptr kp,int j){ kf[2*j]=*(const __attribute__((address_space(3))) bf16x8*)(kp+j*2048); kf[2*j+1]=*(const __attribute__((address_space(3))) bf16x8*)(kp+j*2048+512); }
__device__ __forceinline__ s16x4 vtr(lds_cptr p){ return __builtin_bit_cast(s16x4,__builtin_amdgcn_ds_read_tr16_b64_v4i16((__attribute__((address_space(3))) v4i16_t*)p)); }
__device__ __forceinline__ float rowmax(const f32x16&p0,const f32x16&p1){
  float a=max3f(p0[0],p0[1],p1[0]),b=max3f(p0[2],p0[3],p1[1]);a=max3f(a,p1[2],p1[3]);
  #pragma unroll
  for(int r=4;r<16;r+=4){a=max3f(a,p0[r],p0[r+1]);b=max3f(b,p0[r+2],p0[r+3]);a=max3f(a,p1[r],p1[r+1]);b=max3f(b,p1[r+2],p1[r+3]);}
  const float m=max2f(a,b);
  auto rr=__builtin_amdgcn_permlane32_swap(__float_as_uint(m),__float_as_uint(m),false,false);
  return max2f(__uint_as_float(rr[0]),__uint_as_float(rr[1]));
}
__device__ __forceinline__ void pv(f32x16*o,int vb,bf16x8 pa0,bf16x8 pa1,bf16x8 pa2,bf16x8 pa3){
  #pragma unroll
  for(int d0=0;d0<2;++d0){s16x4 lo[4],hi[4];
    #pragma unroll
    for(int ks=0;ks<4;++ks){
      asm volatile("ds_read_b64_tr_b16 %0,%1 offset:%c2":"=&v"(lo[ks]):"v"(vb),"i"(d0*4096+ks*1024):"memory");
      asm volatile("ds_read_b64_tr_b16 %0,%1 offset:%c2":"=&v"(hi[ks]):"v"(vb),"i"(d0*4096+ks*1024+512):"memory");}
    asm volatile("s_waitcnt lgkmcnt(0)":::"memory");SBAR();
    #define PK(k) (bf16x8){lo[k][0],lo[k][1],lo[k][2],lo[k][3],hi[k][0],hi[k][1],hi[k][2],hi[k][3]}
    o[d0]=__builtin_amdgcn_mfma_f32_32x32x16_bf16(pa0,PK(0),o[d0],0,0,0);
    o[d0]=__builtin_amdgcn_mfma_f32_32x32x16_bf16(pa1,PK(1),o[d0],0,0,0);
    o[d0]=__builtin_amdgcn_mfma_f32_32x32x16_bf16(pa2,PK(2),o[d0],0,0,0);
    o[d0]=__builtin_amdgcn_mfma_f32_32x32x16_bf16(pa3,PK(3),o[d0],0,0,0);
    #undef PK
  }
}

#ifndef ATTN_STORE16
#define ATTN_STORE16(p,v) (*(u32x4*)(p)=(v))
#endif
template<int THRL> __device__ __forceinline__ void attn_unit(int b,int h,int qb,const bf16*Q,const bf16*__restrict__ K,const bf16*__restrict__ V,bf16*O,char*shm,const __attribute__((address_space(3))) float*f2,const int tid){
  #define BIAS_H(P,off,g0) { f32x4 x_[2]; _Pragma("unroll") for(int g_=0;g_<2;++g_) x_[g_]=*(const __attribute__((address_space(3))) f32x4*)(fb_+(off)+8*((g0)+g_)); \
      _Pragma("unroll") for(int g_=0;g_<2;++g_) _Pragma("unroll") for(int i_=0;i_<4;++i_) P[4*((g0)+g_)+i_]-=x_[g_][i_]; asm volatile("":::"memory"); }
  #define BIAS(P0,P1,t) do{ const __attribute__((address_space(3))) float* fb_=f2+64*(t)+4*hi; \
    BIAS_H(P0,0,0) BIAS_H(P0,0,2) BIAS_H(P1,32,0) BIAS_H(P1,32,2) }while(0)
  const int lane=tid&63,r32=lane&31,hi=lane>>5; const int wid=__builtin_amdgcn_readfirstlane(tid>>6);
  const long rowbase=(long)b*SEQ; const int q0=qb*QB;
  const bf16*Qw=Q+(rowbase+q0+wid*QBLK)*DM+h*D;
  const bf16*Kh=K+rowbase*DM+h*D,*Vh=V+rowbase*DM+h*D;
  const unsigned lds0=(unsigned)(uintptr_t)shm;
  float*wsf=(float*)(shm+LDS_WS)+wid*64;
  const bf16*ksrc=Kh+(long)lane*DM+wid*8;
  const bf16*vsrc=Vh+(long)(16*(wid&3)+(lane>>2))*DM+(wid>>2)*32+(lane&3)*8;
  const unsigned kdst=lds0+LDS_K+wid*1024, vdst=lds0+LDS_V+wid*1024;
  #define DMA_K(t,slot) glds16(ksrc+(long)(t)*KVBLK*DM,(unsigned)__builtin_amdgcn_readfirstlane(kdst+(slot)))
  #define DMA_V(t,slot) glds16(vsrc+(long)(t)*KVBLK*DM,(unsigned)__builtin_amdgcn_readfirstlane(vdst+(slot)))
  const int vb0=(int)(lds0+LDS_V)+((lane>>4)&1)*32+(lane&3)*8+(4*hi+((lane&15)>>2))*64;
  const char*Kbase=shm+LDS_K; bf16x8 kf[8];
  const lds_cptr shm3=(lds_cptr)shm; const lds_cptr kp0=shm3+LDS_K+hi*1024+r32*16; const lds_cptr vp0=shm3+LDS_V+((lane>>4)&1)*32+(lane&3)*8+(4*hi+((lane&15)>>2))*64;
  const int NT=(q0+QB)/KVBLK;
  DMA_K(0,0);DMA_V(0,0);DMA_K(1,SLOTB);
  bf16x8 qr[4];
  #pragma unroll
  for(int d0=0;d0<4;++d0)qr[d0]=*reinterpret_cast<const bf16x8*>(&Qw[(long)r32*DM+d0*16+hi*8]);
  float mhat=0.f,l_reg=0.f;f32x16 o[2];f32x16 negm; { float z_=0.f; asm volatile("":"+v"(z_)); _Pragma("unroll") for(int r=0;r<16;++r){o[0][r]=z_;o[1][r]=z_;negm[r]=z_;} } asm volatile("":"+v"(negm));
  const int qrel=wid*QBLK+r32;
  #define CMASK(P0,P1,t) do{int jb_=(t)-(NT-4); if(jb_>=0)cmask(P0,P1,jb_,qrel,hi);}while(0)
  bool resc=false;
  #define START(P0,P1) do{ const float rm=rowmax(P0,P1); resc=false; \
    { const float dl=rm; mhat=fadd_s(mhat,dl); \
      _Pragma("unroll") for(int r=0;r<16;++r){P0[r]=fsub_s(P0[r],dl);P1[r]=fsub_s(P1[r],dl);} \
      _Pragma("unroll") for(int r=0;r<16;++r)negm[r]=-mhat; asm volatile("":"+v"(negm)); } \
    _Pragma("unroll") for(int r=0;r<16;++r)P0[r]=__builtin_amdgcn_exp2f(P0[r]); }while(0)
  #define RESC() do{ if(resc){ asm volatile("s_waitcnt lgkmcnt(0)":::"memory"); \
      _Pragma("unroll") for(int d_=0;d_<2;++d_) _Pragma("unroll") for(int r=0;r<16;++r)o[d_][r]*=wsf[crow(r,hi)]; } }while(0)
  f32x16 pA0,pA1,pB0,pB1;
  int sl_prev=0,sl_cur=0,sl_next=SLOTB;
  #define ROT() do{sl_prev=sl_cur;sl_cur=sl_next;sl_next=(sl_next==(NSLOT-1)*SLOTB)?0:sl_next+SLOTB;}while(0)
  DMA_K(2,2*SLOTB);
  WAIT_BAR(3);
  qkt(pA0,pA1,Kbase,qr,negm,r32,hi);asm volatile("s_nop 15\n\ts_nop 7":"+v"(pA0),"+v"(pA1));CMASK(pA0,pA1,0);BIAS(pA0,pA1,0);
  START(pA0,pA1);
  _Pragma("unroll") for(int r=0;r<16;++r)pA1[r]=__builtin_amdgcn_exp2f(pA1[r]);
  WAIT_BAR(0);
  DMA_K(3,0);DMA_V(1,SLOTB);
  ROT();
  kload8(kf,kp0+sl_cur);
  WAIT_BAR(2);
  s16x4 vlo[8],vhi[8]; u32x4 pw0,pw1,pw2,pw3;
  #define PKW(P,B) cvtpk_s(P[B],P[B+1])
  #define PAF(k) __builtin_bit_cast(bf16x8,pw##k)
  #define VFR(i) (bf16x8){vlo[i][0],vlo[i][1],vlo[i][2],vlo[i][3],vhi[i][0],vhi[i][1],vhi[i][2],vhi[i][3]}
  #define PIN(x) asm volatile("":"+v"(x))
  #define MX3(a,b,c) __builtin_fmaxf(__builtin_fmaxf((a),(b)),(c))
  #define GAPA(MF,A0,A1,A2,A3,W0,W1,PW) do{ MF; sacc+=A0; sacc+=A1; sacc+=A2; sacc+=A3; PIN(sacc); W0; W1; PIN(PW); SBAR(); }while(0)
  #define EX(v) __builtin_amdgcn_exp2f(v)
  #define GAPB(MF,X,B) do{ MF; X[B]=EX(X[B]); X[B+1]=EX(X[B+1]); X[B+2]=EX(X[B+2]); X[B+3]=EX(X[B+3]); PIN(X); SBAR(); }while(0)
  #define VRD(i) do{ vlo[i]=vtr(vp_+(((i)>>2)*4096+((i)&3)*1024)); vhi[i]=vtr(vp_+(((i)>>2)*4096+((i)&3)*1024+512)); }while(0)
  #define KRD(G,j) do{ if(G){ kload2(kf,kp0+sl_next,j); SBAR(); } }while(0)
  #define STEP(C0,C1,P0,P1,t,GK,GV,GL) do{ SBAR(); \
    const lds_cptr vp_=vp0+sl_prev; \
    VRD(0); SBAR(); float sacc=(P0[0]+P0[1]); \
    GAPA(C0=__builtin_amdgcn_mfma_f32_32x32x16_bf16(kf[0],qr[0],negm,0,0,0), P0[2],P0[3],P0[4],P0[5],     pw0[0]=PKW(P0,0), pw0[1]=PKW(P0,2), pw0); \
    VRD(4); SBAR(); GAPA(C1=__builtin_amdgcn_mfma_f32_32x32x16_bf16(kf[1],qr[0],negm,0,0,0), P0[6],P0[7],P0[8],P0[9],     pw0[2]=PKW(P0,4), pw0[3]=PKW(P0,6), pw0); \
    VRD(1); SBAR(); GAPA(C0=__builtin_amdgcn_mfma_f32_32x32x16_bf16(kf[2],qr[1],C0,0,0,0),   P0[10],P0[11],P0[12],P0[13], pw1[0]=PKW(P0,8), pw1[1]=PKW(P0,10), pw1); \
    VRD(5); SBAR(); GAPA(C1=__builtin_amdgcn_mfma_f32_32x32x16_bf16(kf[3],qr[1],C1,0,0,0),   P0[14],P0[15],P1[0],P1[1],   pw1[2]=PKW(P0,12),pw1[3]=PKW(P0,14), pw1); \
    VRD(2); SBAR(); GAPA(C0=__builtin_amdgcn_mfma_f32_32x32x16_bf16(kf[4],qr[2],C0,0,0,0),   P1[2],P1[3],P1[4],P1[5],     pw2[0]=PKW(P1,0), pw2[1]=PKW(P1,2), pw2); \
    VRD(6); SBAR(); GAPA(C1=__builtin_amdgcn_mfma_f32_32x32x16_bf16(kf[5],qr[2],C1,0,0,0),   P1[6],P1[7],P1[8],P1[9],     pw2[2]=PKW(P1,4), pw2[3]=PKW(P1,6), pw2); \
    VRD(3); SBAR(); GAPA(C0=__builtin_amdgcn_mfma_f32_32x32x16_bf16(kf[6],qr[3],C0,0,0,0),   P1[10],P1[11],P1[12],P1[13], pw3[0]=PKW(P1,8), pw3[1]=PKW(P1,10), pw3); \
    VRD(7); SBAR(); GAPA(C1=__builtin_amdgcn_mfma_f32_32x32x16_bf16(kf[7],qr[3],C1,0,0,0),   P1[14],P1[15],0.f,0.f,       pw3[2]=PKW(P1,12),pw3[3]=PKW(P1,14), pw3); \
    l_reg+=sacc; \
    if(GK){DMA_K((t)+3,sl_cur);} if(GV){DMA_V((t)+1,sl_next);} \
    CMASK(C0,C1,t); BIAS(C0,C1,t); \
    { float a=MX3(C0[0],C0[1],C1[0]),b=MX3(C0[2],C0[3],C1[1]); a=MX3(a,C1[2],C1[3]); \
      _Pragma("unroll") for(int r=4;r<16;r+=4){a=MX3(a,C0[r],C0[r+1]);b=MX3(b,C0[r+2],C0[r+3]);a=MX3(a,C1[r],C1[r+1]);b=MX3(b,C1[r+2],C1[r+3]);} \
      float rm=__builtin_fmaxf(a,b); { auto rr=__builtin_amdgcn_permlane32_swap(__float_as_uint(rm),__float_as_uint(rm),false,false); rm=__builtin_fmaxf(__uint_as_float(rr[0]),__uint_as_float(rr[1])); } \
      resc=false; \
      if(__builtin_expect(__any(rm>(float)THRL),0)){ const float dl=__builtin_fmaxf(rm,0.f); mhat+=dl; \
        _Pragma("unroll") for(int r=0;r<16;++r){C0[r]-=dl;C1[r]-=dl;} \
        _Pragma("unroll") for(int r=0;r<16;++r)negm[r]=-mhat; asm volatile("":"+v"(negm)); \
        const float f=__builtin_amdgcn_exp2f(-dl); l_reg*=f; if(hi==0)wsf[r32]=f; resc=true; } } \
    SBAR(); \
    GAPB(o[0]=__builtin_amdgcn_mfma_f32_32x32x16_bf16(PAF(0),VFR(0),o[0],0,0,0), C0,0); \
    GAPB(o[1]=__builtin_amdgcn_mfma_f32_32x32x16_bf16(PAF(0),VFR(4),o[1],0,0,0), C0,4); \
    KRD(GL,0); GAPB(o[0]=__builtin_amdgcn_mfma_f32_32x32x16_bf16(PAF(1),VFR(1),o[0],0,0,0), C0,8); \
    KRD(GL,1); GAPB(o[1]=__builtin_amdgcn_mfma_f32_32x32x16_bf16(PAF(1),VFR(5),o[1],0,0,0), C0,12); \
    KRD(GL,2); GAPB(o[0]=__builtin_amdgcn_mfma_f32_32x32x16_bf16(PAF(2),VFR(2),o[0],0,0,0), C1,0); \
    KRD(GL,3); GAPB(o[1]=__builtin_amdgcn_mfma_f32_32x32x16_bf16(PAF(2),VFR(6),o[1],0,0,0), C1,4); \
    GAPB(o[0]=__builtin_amdgcn_mfma_f32_32x32x16_bf16(PAF(3),VFR(3),o[0],0,0,0), C1,8); \
    GAPB(o[1]=__builtin_amdgcn_mfma_f32_32x32x16_bf16(PAF(3),VFR(7),o[1],0,0,0), C1,12); \
    }while(0)
  int t=1;
  #undef CMASK
  #define CMASK(P0,P1,t) do{}while(0)
  for(;t+5<NT;t+=2){
    STEP(pB0,pB1,pA0,pA1,t,true,true,true);     WAIT_BAR(2); RESC(); ROT();
    STEP(pA0,pA1,pB0,pB1,t+1,true,true,true);   WAIT_BAR(2); RESC(); ROT();
  }
  #undef CMASK
  #define CMASK(P0,P1,t) do{int jb_=(t)-(NT-4); if(jb_>=0)cmask(P0,P1,jb_,qrel,hi);}while(0)
  #define ENDW(tt) do{ if((tt)+3<NT){WAIT_BAR(2);} else if((tt)+2<NT){WAIT_BAR(1);} else {WAIT_BAR(0);} }while(0)
  for(;t+1<NT;t+=2){
    STEP(pB0,pB1,pA0,pA1,t,(t+3<NT),(t+1<NT),(t+1<NT));       ENDW(t);   RESC(); ROT();
    STEP(pA0,pA1,pB0,pB1,t+1,(t+4<NT),(t+2<NT),(t+2<NT));     ENDW(t+1); RESC(); ROT();
  }
  STEP(pB0,pB1,pA0,pA1,NT-1,false,false,false); RESC();
  { float sacc=pB0[0]+pB0[1]; _Pragma("unroll") for(int r=2;r<16;++r)sacc+=pB0[r]; _Pragma("unroll") for(int r=0;r<16;++r)sacc+=pB1[r]; l_reg+=sacc;
    pw0=(u32x4){PKW(pB0,0),PKW(pB0,2),PKW(pB0,4),PKW(pB0,6)};pw1=(u32x4){PKW(pB0,8),PKW(pB0,10),PKW(pB0,12),PKW(pB0,14)};pw2=(u32x4){PKW(pB1,0),PKW(pB1,2),PKW(pB1,4),PKW(pB1,6)};pw3=(u32x4){PKW(pB1,8),PKW(pB1,10),PKW(pB1,12),PKW(pB1,14)};
    SBAR(); pv(o,vb0+sl_cur,PAF(0),PAF(1),PAF(2),PAF(3)); }
  #undef PKW
  #undef PAF
  #undef VFR
  #undef PIN
  #undef MX3
  #undef GAPA
  #undef GAPB
  #undef EX
  #undef VRD
  #undef KRD
  #undef STEP
  #undef ENDW
  {auto rr=__builtin_amdgcn_permlane32_swap(__float_as_uint(l_reg),__float_as_uint(l_reg),false,false);l_reg=__uint_as_float(rr[0])+__uint_as_float(rr[1]);}
  if(hi==0)wsf[32+r32]=l_reg;asm volatile("s_waitcnt lgkmcnt(0)":::"memory");
  float rli[16];
  #pragma unroll
  for(int r=0;r<16;++r)rli[r]=__builtin_amdgcn_rcpf(wsf[32+crow(r,hi)]);
  { bf16*stg=(bf16*)(shm+LDS_OST)+wid*2048;
    #pragma unroll
    for(int r=0;r<16;++r){const int orow=crow(r,hi);
      #pragma unroll
      for(int d0=0;d0<2;++d0)stg[orow*64+d0*32+r32]=__float2bfloat16(o[d0][r]*rli[r]);}
    asm volatile("s_waitcnt lgkmcnt(0)":::"memory");
    unsigned char*O8w=(unsigned char*)O+(rowbase+q0+wid*QBLK)*DM+h*D;
    _Pragma("unroll") for(int i=0;i<4;++i){const int row=i*8+(lane>>3),ch=lane&7; const u32x4 v=*(const u32x4*)(stg+row*64+ch*8);
      u32x2 w8; w8.x=pg8::pack4_fp8(bflo(v.x)*SC_FOX,bfhi(v.x)*SC_FOX,bflo(v.y)*SC_FOX,bfhi(v.y)*SC_FOX); w8.y=pg8::pack4_fp8(bflo(v.z)*SC_FOX,bfhi(v.z)*SC_FOX,bflo(v.w)*SC_FOX,bfhi(v.w)*SC_FOX);
      *(u32x2*)(O8w+(long)row*DM+ch*8)=w8;} }
  asm volatile("s_waitcnt lgkmcnt(0)\n\ts_barrier":::"memory");
  #undef BIAS
  #undef BIAS_H
  #undef DMA_K
  #undef DMA_V
  #undef CMASK
  #undef START
  #undef RESC
  #undef ROT
}
constexpr int ATTN_LDS_BYTES=LDS_BYTES;
#undef SBAR
#undef WAIT_BAR
}


constexpr int NWAVES = 8;
constexpr int RING_OFF = 0, RING_BYTES = 131072;
constexpr int LDSCTL_OFF = RING_BYTES, MISC_OFF = LDSCTL_OFF + 320, TAB_OFF = LDSCTL_OFF + 1024;
constexpr int WTAB_OFF = LDSCTL_OFF + 2048;
constexpr int TOK_OFF = LDSCTL_OFF + 4096;
constexpr int LDS_BYTES = 147456;
typedef GAS unsigned gu32;
__device__ __forceinline__ unsigned hw_wave_key() { return (unsigned)__builtin_amdgcn_s_getreg((5 << 11) | 4) & 63u; }
#define RLX_AGENT __ATOMIC_RELAXED, __HIP_MEMORY_SCOPE_AGENT

#define XB_TMO      128
#define XB_XCNT(j)  (256  + 64 * (j))
#define XB_XSUB(j)  (1280 + 64 * (j))
#define XB_XGEN(j)  (2304 + 64 * (j))
#define XB_TOP      3328
#define XB_TOPGEN   3392
#define XCD_BAR_WORDS 3456
#define XB_SPIN_CAP (1u << 18)

__device__ __forceinline__ unsigned xb_ld(unsigned* p)              { return __hip_atomic_load(p, __ATOMIC_RELAXED, __HIP_MEMORY_SCOPE_AGENT); }
__device__ __forceinline__ unsigned xb_add(unsigned* p, unsigned v) { return __hip_atomic_fetch_add(p, v, __ATOMIC_RELAXED, __HIP_MEMORY_SCOPE_AGENT); }
__device__ __forceinline__ unsigned xb_xcc_id() { return (unsigned)__builtin_amdgcn_s_getreg((3 << 11) | 20) & 0xFu; }
#define XB_SPIN(cond, bar) do { unsigned _sp = 0; while (cond) { __builtin_amdgcn_s_sleep(1); \
    if ((++_sp & 255u) == 0u) { if (xb_ld(&(bar)[XB_TMO])) break; if (_sp > XB_SPIN_CAP) { atomicAdd(&(bar)[XB_TMO], 1u); break; } } } } while (0)

struct XcdBarrier {
    unsigned* bar; unsigned x;
    volatile LAS unsigned* st;
};

__device__ __forceinline__ XcdBarrier xcd_barrier_post(unsigned* bar, volatile LAS unsigned* st) {
    XcdBarrier b; b.bar = bar; b.x = xb_xcc_id(); b.st = st;
    if (threadIdx.x == 0) (void)xb_add(&bar[XB_XCNT(b.x)], 1u);
    return b;
}
__device__ __forceinline__ void xcd_barrier_complete(unsigned* bar, unsigned x, unsigned& nloc, unsigned& nx) {
    const unsigned G = gridDim.x * gridDim.y * gridDim.z;
    unsigned sum, cnt, mine, sp = 0u;
    for (;;) {
        sum = 0u; cnt = 0u; mine = 0u;
#pragma unroll
        for (unsigned j = 0; j < 16; ++j) { const unsigned c = xb_ld(&bar[XB_XCNT(j)]); sum += c; cnt += (c > 0u) ? 1u : 0u; mine = (j == x) ? c : mine; }
        if (sum == G) break;
        __builtin_amdgcn_s_sleep(1);
        if ((++sp & 255u) == 0u) { if (xb_ld(&bar[XB_TMO])) break; if (sp > XB_SPIN_CAP) { atomicAdd(&bar[XB_TMO], 1u); break; } }
    }
    nloc = mine > 0u ? mine : 1u; nx = cnt > 0u ? cnt : 1u;
}

__device__ __forceinline__ void xcd_barrier(const XcdBarrier& b) {
    asm volatile("s_waitcnt vmcnt(0)" ::: "memory");
    __syncthreads();
    if (threadIdx.x == 0) {
        unsigned* bar = b.bar;
        __builtin_amdgcn_s_waitcnt(0);
        unsigned nloc = b.st[0], nx = b.st[1];
        if (nloc == 0u) { xcd_barrier_complete(bar, b.x, nloc, nx); b.st[0] = nloc; b.st[1] = nx; }
        const unsigned old = xb_add(&bar[XB_XSUB(b.x)], 1u);
        const unsigned gen = old / nloc;
        if (old + 1u == (gen + 1u) * nloc) {
            __builtin_amdgcn_fence(__ATOMIC_RELEASE, "agent");
            asm volatile("s_waitcnt vmcnt(0)" ::: "memory");
            const unsigned og = xb_add(&bar[XB_TOP], 1u);
            const unsigned tg = og / nx;
            if (og + 1u == (tg + 1u) * nx) xb_add(&bar[XB_TOPGEN], 1u);
            else XB_SPIN(xb_ld(&bar[XB_TOPGEN]) == tg, bar);
            __builtin_amdgcn_fence(__ATOMIC_ACQUIRE, "agent");
            xb_add(&bar[XB_XGEN(b.x)], 1u);
            asm volatile("s_waitcnt vmcnt(0)" ::: "memory");
        } else {
            XB_SPIN(xb_ld(&bar[XB_XGEN(b.x)]) == gen, bar);
            __builtin_amdgcn_fence(__ATOMIC_ACQUIRE, "agent");
            asm volatile("s_waitcnt vmcnt(0)" ::: "memory");
        }
    }
    __syncthreads();
}


struct Args {
    const float *x, *ln_in_g, *ln_in_b, *w_in, *b_in, *w_fox, *lbl, *norm_g, *w_hgrn, *w_mix, *b_mix, *ln1_g, *ln1_b, *router_w, *router_b, *w1, *w3, *w2, *ln2_g, *ln2_b;
    float* out; unsigned char* ws; int ph_lo, ph_hi, use_bar, pad;
};
struct Frame { LAS unsigned char* lds; int tid, lane, wave, G, gw, ngw, bid; };
#define LOAD_ARGS() launder_args(args)
__device__ __forceinline__ Args launder_args(const Args& args) { Args a = args; size_t z_ = 0; asm volatile("" : "+s"(z_)); a.ws = args.ws + z_; return a; }

__device__ __forceinline__ void ln_rows16(f32x4 (&v)[4], const float* g, const float* bta, int lane) {
    float s = 0.f;
#pragma unroll
    for (int j = 0; j < 4; ++j) s += (v[j].x + v[j].y) + (v[j].z + v[j].w);
    const float mean = wave_sum(s) * (1.f / D); float s2 = 0.f;
#pragma unroll
    for (int j = 0; j < 4; ++j) { v[j] = v[j] - mean; s2 += (v[j].x * v[j].x + v[j].y * v[j].y) + (v[j].z * v[j].z + v[j].w * v[j].w); }
    const float rstd = rsqrtf(wave_sum(s2) * (1.f / D) + LN_EPS);
#pragma unroll
    for (int j = 0; j < 4; ++j) { const int c = 4 * lane + 256 * j; const f32x4 gg = *(const f32x4*)(g + c), bb = *(const f32x4*)(bta + c); v[j] = v[j] * rstd * gg + bb; }
}
__device__ __forceinline__ void store_row(const f32x4 (&v)[4], int lane, bf16_t* ores, unsigned char* obf, float* of32b) {
#pragma unroll
    for (int j = 0; j < 4; ++j) { const int c = 4 * lane + 256 * j;
        if (ores) { u32x2 w; w.x = pk2(v[j].x, v[j].y); w.y = pk2(v[j].z, v[j].w); *(u32x2*)(ores + c) = w; }
        if (of32b) *(f32x4*)(of32b + c) = v[j];
        if (obf) *(unsigned*)(obf + c) = pg8::pack4_fp8(v[j].x, v[j].y, v[j].z, v[j].w); }
}

struct CvtDesc { const float* W; int ldw, k0, srccol, nvalid; unsigned char* WT; int dstrow, dstk; };
__device__ __forceinline__ void cvt_load(const CvtDesc& d, f32x4 (&v)[8], int lane) {
    const int ks = lane >> 3, n4 = (lane & 7) * 4;
#pragma unroll
    for (int j = 0; j < 8; ++j) v[j] = (n4 < d.nvalid) ? *(const f32x4*)(d.W + (size_t)(d.k0 + 8 * j + ks) * d.ldw + d.srccol + n4) : (f32x4){0.f, 0.f, 0.f, 0.f};
}
__device__ __forceinline__ void cvt_store(const CvtDesc& d, const f32x4 (&v)[8], LAS float* scr, int lane) {
    const int ks = lane >> 3, n4 = (lane & 7) * 4;
#pragma unroll
    for (int j = 0; j < 8; ++j) { LAS float* p = scr + (8 * j + ks) * 33 + n4; p[0] = v[j][0]; p[1] = v[j][1]; p[2] = v[j][2]; p[3] = v[j][3]; }
    asm volatile("s_waitcnt lgkmcnt(0)" ::: "memory");
    const int c = lane & 7;
#pragma unroll
    for (int j = 0; j < 4; ++j) { const int n = (lane >> 3) + 8 * j; const LAS float* s = scr + (8 * c) * 33 + n;
        u32x2 o; o.x = pg8::pack4_fp8(s[0 * 33] * SC_W, s[1 * 33] * SC_W, s[2 * 33] * SC_W, s[3 * 33] * SC_W); o.y = pg8::pack4_fp8(s[4 * 33] * SC_W, s[5 * 33] * SC_W, s[6 * 33] * SC_W, s[7 * 33] * SC_W);
        *(u32x2*)(d.WT + (size_t)(d.dstrow + n) * 1024 + d.dstk + d.k0 + 8 * c) = o; }
    asm volatile("s_waitcnt lgkmcnt(0)" ::: "memory");
}
__device__ __forceinline__ CvtDesc cvt_decode(const Args& a, int l, int it) {
    unsigned char* WS_ = a.ws + wset(l);
    constexpr int I_IN = 16 * 176, I_BR = 8 * 32, I_MIX = 16 * 32, I_13 = 16 * 64 * NE;
    CvtDesc d; int r = it;
    if (r < I_IN) { const int kb = r / 176, nb = r % 176, n0 = nb * 32;
        const int src = (n0 < 1536) ? n0 : n0 + 8, nv = 32;
        d.W = a.w_in + (size_t)l * D * NIN; d.ldw = NIN; d.k0 = kb * 64; d.srccol = src; d.nvalid = nv; d.WT = WS_ + WO_WIN; d.dstrow = n0; d.dstk = 0; return d; } r -= I_IN;
    if (r < I_BR) { const int kb = r / 32, nb = r % 32; d.W = a.w_fox + (size_t)l * 512 * D; d.ldw = D; d.k0 = kb * 64; d.srccol = nb * 32; d.nvalid = 32; d.WT = WS_ + WO_WBR; d.dstrow = nb * 32; d.dstk = 0; return d; } r -= I_BR;
    if (r < I_BR) { const int kb = r / 32, nb = r % 32; d.W = a.w_hgrn + (size_t)l * 512 * D; d.ldw = D; d.k0 = kb * 64; d.srccol = nb * 32; d.nvalid = 32; d.WT = WS_ + WO_WBR; d.dstrow = nb * 32; d.dstk = 512; return d; } r -= I_BR;
    if (r < I_MIX) { const int kb = r / 32, nb = r % 32; d.W = a.w_mix + (size_t)l * D * D; d.ldw = D; d.k0 = kb * 64; d.srccol = nb * 32; d.nvalid = 32; d.WT = WS_ + WO_WMIX; d.dstrow = nb * 32; d.dstk = 0; return d; } r -= I_MIX;
    if (r < I_13) { const int e = r / 1024, q = r % 1024, kb = q / 64, nb = q % 64, n0 = nb * 32;
        const int j = n0 >> 8, rr = n0 & 255; d.W = (rr < 128 ? a.w1 : a.w3) + ((size_t)l * NE + e) * D * D; d.ldw = D; d.k0 = kb * 64; d.srccol = 128 * j + (rr & 127); d.nvalid = 32;
        d.WT = WS_ + WO_W13 + (size_t)e * 2048 * D; d.dstrow = n0; d.dstk = 0; return d; } r -= I_13;
    { const int e = r / 512, q = r % 512, kb = q / 32, nb = q % 32; d.W = a.w2 + ((size_t)l * NE + e) * D * D; d.ldw = D; d.k0 = kb * 64; d.srccol = nb * 32; d.nvalid = 32;
      d.WT = WS_ + WO_W2 + (size_t)e * D * D; d.dstrow = nb * 32; d.dstk = 0; return d; }
}
__device__ __forceinline__ void convert_layer(const Args& a, const Frame& F, int l, int gw, int ngw) {
    LAS float* scr = (LAS float*)(F.lds + RING_OFF + F.wave * 16384);
    const int lane = F.lane;
    constexpr int NITEMS = 16 * 176 + 2 * 8 * 32 + 16 * 32 + 16 * 64 * NE + 16 * 32 * NE;
    for (int it = gw; it < NITEMS; it += 2 * ngw) {
        const CvtDesc d0 = cvt_decode(a, l, it); f32x4 v0[8]; cvt_load(d0, v0, lane);
        const bool two = it + ngw < NITEMS;
        if (two) { const CvtDesc d1 = cvt_decode(a, l, it + ngw); f32x4 v1[8]; cvt_load(d1, v1, lane); cvt_store(d0, v0, scr, lane); cvt_store(d1, v1, scr, lane); }
        else cvt_store(d0, v0, scr, lane);
    }
    float* biasp = (float*)(a.ws + biasoff(l));
    for (int n = gw * 64 + lane; n < NINP; n += ngw * 64) {
        biasp[n] = (n < 1536) ? a.b_in[l * NIN + n] : a.b_in[l * NIN + n + 8]; }
}


constexpr int WFF_OFF = 65536 + 16384;
__device__ __forceinline__ void load_wff(const Args& a, const Frame& F, int l) {
    LAS float* wff = (LAS float*)(F.lds + RING_OFF + WFF_OFF);
    for (int i = F.tid; i < 8 * D; i += NWAVES * 64) { const int c = i >> 3, h = i & 7; wff[h * D + c] = a.w_in[((size_t)l * D + c) * NIN + 1536 + h]; }
}
__device__ __forceinline__ void fox_gates_row(const Args& a, const Frame& F, int l, const f32x4 (&v)[4], int row) {
    const LAS float* wff = (const LAS float*)(F.lds + RING_OFF + WFF_OFF); const int lane = F.lane;
    float p[8];
#pragma unroll
    for (int h = 0; h < 8; ++h) { float s = 0.f;
#pragma unroll
        for (int j = 0; j < 4; ++j) { const f32x4 r4 = *(const LAS f32x4*)(wff + h * D + 4 * lane + 256 * j); s += v[j].x * r4.x + v[j].y * r4.y + v[j].z * r4.z + v[j].w * r4.w; }
        p[h] = s; }
    const bool hi5 = (lane & 32) != 0;
#pragma unroll
    for (int k = 0; k < 4; ++k) { const float snd = hi5 ? p[k] : p[k + 4]; const float rcv = __shfl_xor(snd, 32); p[k] = (hi5 ? p[k + 4] : p[k]) + rcv; }
    const bool hi4 = (lane & 16) != 0;
#pragma unroll
    for (int k = 0; k < 2; ++k) { const float snd = hi4 ? p[k] : p[k + 2]; const float rcv = __shfl_xor(snd, 16); p[k] = (hi4 ? p[k + 2] : p[k]) + rcv; }
    const bool hi3 = (lane & 8) != 0;
    { const float snd = hi3 ? p[0] : p[1]; const float rcv = __shfl_xor(snd, 8); p[0] = (hi3 ? p[1] : p[0]) + rcv; }
    p[0] += __shfl_xor(p[0], 4); p[0] += __shfl_xor(p[0], 2); p[0] += __shfl_xor(p[0], 1);
    if ((lane & 7) == 0) { const int h = lane >> 3; ((float*)(a.ws + WS_FL))[(size_t)row * 8 + h] = logsigmoidf_(p[0] + a.b_in[l * NIN + 1536 + h]); }
}

__device__ __forceinline__ void phase_prep(const Args& a, const Frame& F) {
    if (F.bid == 0) {
        float* lb_all = (float*)(a.ws + WS_MISC);
        const int c = F.tid;
        float v[DEPTH], m = -1e30f;
#pragma unroll
        for (int l = 0; l < DEPTH; ++l) { v[l] = a.lbl[l * 512 + c]; m = fmaxf(m, v[l]); }
        float s = 0.f;
#pragma unroll
        for (int l = 0; l < DEPTH; ++l) { v[l] = __expf(v[l] - m); s += v[l]; }
        float cum = 0.f;
#pragma unroll
        for (int l = 0; l < DEPTH; ++l) { const float p = v[l] / s; cum += p; lb_all[l * 512 + c] = cum - v[0] / s; }
    }
    bf16_t* XRES = (bf16_t*)(a.ws + WS_XRES); unsigned char* XN = a.ws + WS_XN;
    load_wff(a, F, 0); __syncthreads();
    for (int row = F.gw; row < T; row += F.ngw) {
        f32x4 v[4];
#pragma unroll
        for (int j = 0; j < 4; ++j) v[j] = *(const f32x4*)(a.x + (size_t)row * D + 4 * F.lane + 256 * j);
        ln_rows16(v, a.ln_in_g, a.ln_in_b, F.lane);
        store_row(v, F.lane, XRES + (size_t)row * D, XN + (size_t)row * D, nullptr);
        fox_gates_row(a, F, 0, v, row);
    }
    __syncthreads();
    convert_layer(a, F, 0, F.gw, F.ngw);
}

__device__ __forceinline__ void phase_fscan(const Args& a, const Frame& F) {
    if (F.bid >= BATCH * NH) return;
    const float* FL = (const float*)(a.ws + WS_FL); float* F2 = (float*)(a.ws + WS_F2);
    LAS float* wsum = (LAS float*)(F.lds + RING_OFF);
    const int bh = F.bid, b = bh >> 3, h = bh & 7, tid = F.tid, lane = F.lane, w = F.wave;
    float v[4], run = 0.f;
#pragma unroll
    for (int i = 0; i < 4; ++i) { run += FL[((size_t)b * SEQ + tid * 4 + i) * 8 + h]; v[i] = run; }
    float incl = run;
#pragma unroll
    for (int o = 1; o < 64; o <<= 1) { const float u = __shfl_up(incl, o); if (lane >= o) incl += u; }
    if (lane == 63) wsum[w] = incl;
    __syncthreads();
    float base = incl - run; for (int i = 0; i < w; ++i) base += wsum[i];
#pragma unroll
    for (int i = 0; i < 4; ++i) F2[(size_t)bh * SEQ + tid * 4 + i] = (base + v[i]) * LOG2E;
    __syncthreads();
}

__device__ __forceinline__ void phase_attn_naive(const Args& a, const Frame& F) {
    const bf16_t* QO = (const bf16_t*)(a.ws + WS_QO); const bf16_t* KV = (const bf16_t*)(a.ws + WS_KV); const float* F2 = (const float*)(a.ws + WS_F2); bf16_t* O = (bf16_t*)(a.ws + WS_QO);
    LAS float* ps = (LAS float*)(F.lds + RING_OFF) + F.wave * 64;
    const int lane = F.lane;
    for (int gid = F.gw; gid < BATCH * NH * SEQ; gid += F.ngw) {
        const int bh = gid & 127, t = gid >> 7, b = bh >> 3, h = bh & 7;
        float q[64];
        { const bf16_t* qp = QO + ((size_t)b * SEQ + t) * 1024 + h * 64;
#pragma unroll
          for (int c = 0; c < 8; ++c) { const u32x4 u = *(const u32x4*)(qp + c * 8);
            q[c * 8 + 0] = bflo(u.x); q[c * 8 + 1] = bfhi(u.x); q[c * 8 + 2] = bflo(u.y); q[c * 8 + 3] = bfhi(u.y);
            q[c * 8 + 4] = bflo(u.z); q[c * 8 + 5] = bfhi(u.z); q[c * 8 + 6] = bflo(u.w); q[c * 8 + 7] = bfhi(u.w); } }
        float m = -1e30f, l = 0.f, o = 0.f;
        const float* f2 = F2 + (size_t)bh * SEQ;
        for (int s0 = 0; s0 <= t; s0 += 64) {
            const int s = s0 + lane; const bool valid = s <= t;
            float sc = -1e30f;
            if (valid) { const bf16_t* kp = KV + ((size_t)b * SEQ + s) * 1024 + h * 64; float d = 0.f;
#pragma unroll
                for (int c = 0; c < 8; ++c) { const u32x4 u = *(const u32x4*)(kp + c * 8);
                    d += q[c * 8 + 0] * bflo(u.x) + q[c * 8 + 1] * bfhi(u.x) + q[c * 8 + 2] * bflo(u.y) + q[c * 8 + 3] * bfhi(u.y)
                       + q[c * 8 + 4] * bflo(u.z) + q[c * 8 + 5] * bfhi(u.z) + q[c * 8 + 6] * bflo(u.w) + q[c * 8 + 7] * bfhi(u.w); }
                sc = d - f2[s]; }
            const float mn = fmaxf(m, wave_max(sc));
            const float p = valid ? exp2f(sc - mn) : 0.f;
            const float f = exp2f(m - mn);
            l = l * f + wave_sum(p); o *= f; m = mn;
            ps[lane] = p;
            asm volatile("s_waitcnt lgkmcnt(0)" ::: "memory");
            const int nk = min(64, t - s0 + 1);
            const bf16_t* vp = KV + ((size_t)b * SEQ + s0) * 1024 + 512 + h * 64 + lane;
            for (int j = 0; j < nk; ++j) o += ps[j] * bf2f(vp[(size_t)j * 1024]);
            asm volatile("s_waitcnt lgkmcnt(0)" ::: "memory");
        }
        O[((size_t)b * SEQ + t) * 1024 + h * 64 + lane] = (bf16_t)f2bf(o / l);
    }
}

__device__ __forceinline__ void phase_hgrn_naive(const Args& a, const Frame& F, int l) {
    if (F.bid >= BATCH * NH || F.wave != 0) return;
    const bf16_t* HB = (const bf16_t*)(a.ws + WS_HB); const float* LOGF = (const float*)(a.ws + WS_LOGF); const bf16_t* HG = (const bf16_t*)(a.ws + WS_HG); bf16_t* O = (bf16_t*)(a.ws + WS_QO);
    LAS float* Lf = (LAS float*)(F.lds + RING_OFF + 1024); LAS float* Lk = Lf + 4096; LAS float* Lq = Lk + 4096;
    const int bh = F.bid, b = bh >> 3, h = bh & 7, lane = F.lane;
    float Sx[64];
#pragma unroll
    for (int d = 0; d < 64; ++d) Sx[d] = 0.f;
    const float ng = a.norm_g[l * 512 + h * 64 + lane];
    for (int c0 = 0; c0 < SEQ; c0 += 64) {
        for (int tt = 0; tt < 64; ++tt) { const size_t row = (size_t)b * SEQ + c0 + tt;
            const float lf = LOGF[row * 512 + h * 64 + lane]; const float f = __expf(lf);
            Lf[tt * 64 + lane] = f; Lk[tt * 64 + lane] = 1.f - f; Lq[tt * 64 + lane] = bf2f(HB[row * 1024 + h * 64 + lane]); }
        asm volatile("s_waitcnt lgkmcnt(0)" ::: "memory");
        for (int tt = 0; tt < 64; ++tt) { const size_t row = (size_t)b * SEQ + c0 + tt;
            const float v = bf2f(HB[row * 1024 + 512 + h * 64 + lane]);
            float o = 0.f;
#pragma unroll
            for (int d = 0; d < 64; d += 4) { const f32x4 f4 = *(const LAS f32x4*)(Lf + tt * 64 + d), k4 = *(const LAS f32x4*)(Lk + tt * 64 + d), q4 = *(const LAS f32x4*)(Lq + tt * 64 + d);
                Sx[d] = f4.x * Sx[d] + k4.x * v; o += Sx[d] * q4.x; Sx[d + 1] = f4.y * Sx[d + 1] + k4.y * v; o += Sx[d + 1] * q4.y;
                Sx[d + 2] = f4.z * Sx[d + 2] + k4.z * v; o += Sx[d + 2] * q4.z; Sx[d + 3] = f4.w * Sx[d + 3] + k4.w * v; o += Sx[d + 3] * q4.w; }
            const float ss = wave_sum(o * o);
            const float r = o * rsqrtf(ss * (1.f / 64.f) + RMS_EPS) * ng * bf2f(HG[row * 512 + h * 64 + lane]);
            O[row * 1024 + 512 + h * 64 + lane] = (bf16_t)f2bf(r); }
        asm volatile("s_waitcnt lgkmcnt(0)" ::: "memory");
    }
}

constexpr int LN1_RW = 0, LN1_LG = 65536, LN1_ASG = LN1_LG + 8 * 16 * 16 * 4, LN1_BASE = LN1_ASG + 128 * 16;
__device__ __forceinline__ void phase_ln1_router(const Args& a, const Frame& F, int l) {
    const bf16_t* xres = (const bf16_t*)(a.ws + WS_XRES); bf16_t* x1 = (bf16_t*)(a.ws + WS_X1B); const unsigned char* mixed = a.ws + WS_MIXED;   unsigned char* xn = a.ws + WS_XN;
    unsigned* cnt = (unsigned*)(a.ws + WS_CTL) + CW_CNT + l * 64; int* list = (int*)(a.ws + WS_LIST); unsigned* tokinfo = (unsigned*)(a.ws + WS_TOK);
    const float* g = a.ln1_g + l * D; const float* bta = a.ln1_b + l * D;
    LAS float* rw = (LAS float*)(F.lds + RING_OFF + LN1_RW);
    LAS float* lgs = (LAS float*)(F.lds + RING_OFF + LN1_LG) + F.wave * 256;
    LAS u32x4* asg = (LAS u32x4*)(F.lds + RING_OFF + LN1_ASG);
    LAS unsigned* basep = (LAS unsigned*)(F.lds + RING_OFF + LN1_BASE);
    for (int i = F.tid; i < NE * D; i += NWAVES * 64) { const int c = i >> 4, e = i & 15; rw[e * D + c] = a.router_w[i]; }
    __syncthreads();
    const int lane = F.lane;
    for (int blk = F.bid; blk < T / 128; blk += F.G) {
        const int R0 = blk * 128 + F.wave * 16;
        u32x2 nx[4]; unsigned nm[4];
#pragma unroll
        for (int j = 0; j < 4; ++j) { const int c = 4 * lane + 256 * j; nx[j] = *(const u32x2*)(xres + (size_t)R0 * D + c); nm[j] = *(const unsigned*)(mixed + (size_t)R0 * D + c); }
        for (int i = 0; i < 16; ++i) { const int row = R0 + i;
            f32x4 v[4];
#pragma unroll
            for (int j = 0; j < 4; ++j) { const u32x2 xv = nx[j]; const f32x2 m01 = __builtin_amdgcn_cvt_pk_f32_fp8((int)nm[j], false), m23 = __builtin_amdgcn_cvt_pk_f32_fp8((int)nm[j], true);
                v[j].x = ALPHA * bflo(xv.x) + m01[0] * (1.f / SC_MIX); v[j].y = ALPHA * bfhi(xv.x) + m01[1] * (1.f / SC_MIX); v[j].z = ALPHA * bflo(xv.y) + m23[0] * (1.f / SC_MIX); v[j].w = ALPHA * bfhi(xv.y) + m23[1] * (1.f / SC_MIX); }
            { const int rn = (i < 15) ? row + 1 : row;
#pragma unroll
              for (int j = 0; j < 4; ++j) { const int c = 4 * lane + 256 * j; nx[j] = *(const u32x2*)(xres + (size_t)rn * D + c); nm[j] = *(const unsigned*)(mixed + (size_t)rn * D + c); } }
            ln_rows16(v, g, bta, lane);
            store_row(v, lane, x1 + (size_t)row * D, xn + (size_t)row * D, nullptr);
            float p[NE];
#pragma unroll
            for (int e = 0; e < NE; ++e) { float s = 0.f;
#pragma unroll
                for (int j = 0; j < 4; ++j) { const f32x4 r4 = *(const LAS f32x4*)(rw + e * D + 4 * lane + 256 * j); s += v[j].x * r4.x + v[j].y * r4.y + v[j].z * r4.z + v[j].w * r4.w; }
                p[e] = s; asm volatile("" ::: "memory"); }
            { const bool hi5 = (lane & 32) != 0;
#pragma unroll
              for (int k = 0; k < 8; ++k) { const float snd = hi5 ? p[k] : p[k + 8]; const float rcv = __shfl_xor(snd, 32); p[k] = (hi5 ? p[k + 8] : p[k]) + rcv; }
              const bool hi4 = (lane & 16) != 0;
#pragma unroll
              for (int k = 0; k < 4; ++k) { const float snd = hi4 ? p[k] : p[k + 4]; const float rcv = __shfl_xor(snd, 16); p[k] = (hi4 ? p[k + 4] : p[k]) + rcv; }
              const bool hi3 = (lane & 8) != 0;
#pragma unroll
              for (int k = 0; k < 2; ++k) { const float snd = hi3 ? p[k] : p[k + 2]; const float rcv = __shfl_xor(snd, 8); p[k] = (hi3 ? p[k + 2] : p[k]) + rcv; }
              const bool hi2 = (lane & 4) != 0;
              { const float snd = hi2 ? p[0] : p[1]; const float rcv = __shfl_xor(snd, 4); p[0] = (hi2 ? p[1] : p[0]) + rcv; }
              p[0] += __shfl_xor(p[0], 2); p[0] += __shfl_xor(p[0], 1);
              if ((lane & 3) == 0) lgs[i * 16 + (lane >> 2)] = p[0]; }
        }
        asm volatile("s_waitcnt lgkmcnt(0)" ::: "memory");
        if (lane < 16) {
            float lg[NE];
#pragma unroll
            for (int q = 0; q < 4; ++q) { const f32x4 t4 = *(const LAS f32x4*)(lgs + lane * 16 + 4 * q); lg[4 * q] = t4[0] + a.router_b[4 * q]; lg[4 * q + 1] = t4[1] + a.router_b[4 * q + 1]; lg[4 * q + 2] = t4[2] + a.router_b[4 * q + 2]; lg[4 * q + 3] = t4[3] + a.router_b[4 * q + 3]; }
            int gs = 0; float gbest = -3e38f;
#pragma unroll
            for (int gi = 0; gi < 4; ++gi) { const float mx = fmaxf(fmaxf(lg[gi * 4], lg[gi * 4 + 1]), fmaxf(lg[gi * 4 + 2], lg[gi * 4 + 3])); if (mx > gbest) { gbest = mx; gs = gi; } }
            float l4[4];
#pragma unroll
            for (int i = 0; i < 4; ++i) { float t0 = lg[i];
#pragma unroll
                for (int gi = 1; gi < 4; ++gi) t0 = (gs == gi) ? lg[gi * 4 + i] : t0; l4[i] = t0; }
            int i0 = 0; float b0 = l4[0];
#pragma unroll
            for (int i = 1; i < 4; ++i) if (l4[i] > b0) { b0 = l4[i]; i0 = i; }
            int i1 = 0; float b1 = -3e38f;
#pragma unroll
            for (int i = 0; i < 4; ++i) if (i != i0 && l4[i] > b1) { b1 = l4[i]; i1 = i; }
            const float e1 = __expf(b1 - b0); const float g0 = 1.f / (1.f + e1), g1 = e1 / (1.f + e1);
            u32x4 as; as.x = (unsigned)(gs * 4 + i0); as.y = (unsigned)(gs * 4 + i1); as.z = __float_as_uint(g0); as.w = __float_as_uint(g1);
            asg[F.wave * 16 + lane] = as;
        }
        __syncthreads();
        if (F.wave == 0) {
            const u32x4 A0 = asg[lane], A1 = asg[lane + 64];
            const unsigned ex[4] = {A0.x, A0.y, A1.x, A1.y};
            unsigned rank[4] = {0u, 0u, 0u, 0u}, mycount = 0u;
            const unsigned long long lt = (1ull << lane) - 1ull;
#pragma unroll 1
            for (unsigned e = 0; e < NE; ++e) { unsigned run = 0u;
#pragma unroll
                for (int s = 0; s < 4; ++s) { const unsigned long long m = __ballot(ex[s] == e); if (ex[s] == e) rank[s] = run + (unsigned)__popcll(m & lt); run += (unsigned)__popcll(m); }
                if ((unsigned)lane == e) mycount = run; }
            if (lane < NE) basep[lane] = atomicAdd(cnt + lane, mycount);
            asm volatile("s_waitcnt vmcnt(0) lgkmcnt(0)" ::: "memory");
            const unsigned p0 = basep[ex[0]] + rank[0], p1 = basep[ex[1]] + rank[1], p2 = basep[ex[2]] + rank[2], p3 = basep[ex[3]] + rank[3];
            const int ra = blk * 128 + lane, rb = ra + 64;
            list[ex[0] * T + p0] = ra; list[ex[1] * T + p1] = ra; list[ex[2] * T + p2] = rb; list[ex[3] * T + p3] = rb;
            u32x4 ta, tb; ta.x = (ex[0] << 24) | p0; ta.y = (ex[1] << 24) | p1; ta.z = A0.z; ta.w = A0.w; tb.x = (ex[2] << 24) | p2; tb.y = (ex[3] << 24) | p3; tb.z = A1.z; tb.w = A1.w;
            *(u32x4*)(tokinfo + (size_t)ra * 4) = ta; *(u32x4*)(tokinfo + (size_t)rb * 4) = tb;
        }
        __syncthreads();
    }
}

__device__ __forceinline__ void moe_table(const Args& a, const Frame& F, int l) {
    LAS int* tab = (LAS int*)(F.lds + TAB_OFF);
    const unsigned* cnt = (const unsigned*)(a.ws + WS_CTL) + CW_CNT + l * 64;
    if (F.tid == 0) { int ts = 0; for (int e = 0; e < NE; ++e) { const int c = (int)__hip_atomic_load(cnt + e, RLX_AGENT); tab[e] = ts; tab[NE + 1 + e] = c; ts += (c + TM - 1) / TM; } tab[NE] = ts; }
    __syncthreads();
}

__device__ __forceinline__ void phase_combine_ln2(const Args& a, const Frame& F, int l) {
    bf16_t* xres = (bf16_t*)(a.ws + WS_XRES); const bf16_t* x1 = (const bf16_t*)(a.ws + WS_X1B); const unsigned char* Y = a.ws + WS_Y;   const unsigned* tokinfo = (const unsigned*)(a.ws + WS_TOK); unsigned char* xn = a.ws + WS_XN;
    const float* g = a.ln2_g + l * D; const float* bta = a.ln2_b + l * D; float* out = (l == DEPTH - 1) ? a.out : nullptr;
    const LAS int* tab = (const LAS int*)(F.lds + TAB_OFF);
    const int lane = F.lane;
    for (int row = F.gw; row < T; row += F.ngw) {
        const unsigned i0 = tokinfo[row * 4], i1 = tokinfo[row * 4 + 1]; const float g0 = __uint_as_float(tokinfo[row * 4 + 2]), g1 = __uint_as_float(tokinfo[row * 4 + 3]);
        const size_t s0 = (size_t)tab[i0 >> 24] * TM + (i0 & 0xffffff), s1 = (size_t)tab[i1 >> 24] * TM + (i1 & 0xffffff);
        f32x4 v[4];
#pragma unroll
        for (int j = 0; j < 4; ++j) { const int c = 4 * lane + 256 * j; const u32x2 xw = *(const u32x2*)(x1 + (size_t)row * D + c); const f32x4 xv = {bflo(xw.x), bfhi(xw.x), bflo(xw.y), bfhi(xw.y)};
            const unsigned ya = *(const unsigned*)(Y + s0 * D + c), yb = *(const unsigned*)(Y + s1 * D + c);
            const f32x2 a01 = __builtin_amdgcn_cvt_pk_f32_fp8((int)ya, false), a23 = __builtin_amdgcn_cvt_pk_f32_fp8((int)ya, true), b01 = __builtin_amdgcn_cvt_pk_f32_fp8((int)yb, false), b23 = __builtin_amdgcn_cvt_pk_f32_fp8((int)yb, true);
            const float h0 = g0 * (1.f / SC_Y), h1 = g1 * (1.f / SC_Y);
            v[j].x = ALPHA * xv.x + h0 * a01[0] + h1 * b01[0]; v[j].y = ALPHA * xv.y + h0 * a01[1] + h1 * b01[1];
            v[j].z = ALPHA * xv.z + h0 * a23[0] + h1 * b23[0]; v[j].w = ALPHA * xv.w + h0 * a23[1] + h1 * b23[1]; }
        ln_rows16(v, g, bta, lane);
        store_row(v, lane, xres + (size_t)row * D, xn + (size_t)row * D, out ? out + (size_t)row * D : nullptr);
        if (l + 1 < DEPTH) fox_gates_row(a, F, l + 1, v, row);
    }
}


constexpr int ATT_F2_OFF = 86016;
__device__ __forceinline__ void phase_attn(const Args& a, const Frame& F, char* lds_generic) {
    const int c = F.bid, vcu = (F.G % 8 == 0) ? (c % 8) * (F.G / 8) + c / 8 : c;
    const attn_body::bf16* Q = (const attn_body::bf16*)(a.ws + WS_QO); const attn_body::bf16* K = (const attn_body::bf16*)(a.ws + WS_KV); const attn_body::bf16* V = K + 512;
    attn_body::bf16* O = (attn_body::bf16*)(a.ws + WS_OX8);
    const float* FL = (const float*)(a.ws + WS_FL);
    LAS float* f2 = (LAS float*)(F.lds + ATT_F2_OFF); LAS float* wsum = f2 + 2048;
    { const int bh = vcu >> 1; if (bh >= BATCH * NH) return;
        const int b = bh >> 3, h = bh & 7, tid = F.tid, lane = F.lane, w = F.wave;
        float v[4], run = 0.f;
#pragma unroll
        for (int i = 0; i < 4; ++i) { run += FL[((size_t)b * SEQ + tid * 4 + i) * 8 + h]; v[i] = run; }
        float incl = run;
#pragma unroll
        for (int o = 1; o < 64; o <<= 1) { const float u = __shfl_up(incl, o); if (lane >= o) incl += u; }
        if (lane == 63) wsum[w] = incl;
        __syncthreads();
        float base = incl - run; for (int i = 0; i < w; ++i) base += wsum[i];
        f32x4 o4; o4[0] = (base + v[0]) * LOG2E; o4[1] = (base + v[1]) * LOG2E; o4[2] = (base + v[2]) * LOG2E; o4[3] = (base + v[3]) * LOG2E;
        *(LAS f32x4*)(f2 + tid * 4) = o4;
        __syncthreads();
        const int nun = (vcu & 1) ? 6 : 2;
        for (int i = 0; i < nun; ++i) { const int qb = (vcu & 1) ? (6 - i) : ((i == 0) ? 7 : 0);
            int tid_u = F.tid; asm volatile("" : "+v"(tid_u));
            attn_body::attn_unit<40>(b, h, qb, Q, K, V, O, lds_generic + RING_OFF, f2, tid_u); }
        __syncthreads();
    }
}

namespace hg {
constexpr int PB = 144;
constexpr int O_QS = 0, O_KS = 9216, O_QI = 18432, O_KUT = 27648, O_VT = 36864, O_P = 46080, O_ST = 55296, O_TOT = 64512, O_EBL = 66560, O_RED = 66816, O_OS = 67328, BYTES = 67328 + 8 * 16 * 80;
__device__ __forceinline__ float ex(float v) { return __builtin_amdgcn_exp2f(v * LOG2E); }
__device__ __forceinline__ unsigned short bf1(float v) { return (unsigned short)pk2(v, v); }
}
__device__ __forceinline__ void phase_hgrn(const Args& a, const Frame& F, int l, int bh) {
    using namespace hg;
    const bf16_t* HB = (const bf16_t*)(a.ws + WS_HB); const float* LOGF = (const float*)(a.ws + WS_LOGF); const bf16_t* HG = (const bf16_t*)(a.ws + WS_HG); unsigned char* O8 = a.ws + WS_OX8;
    LAS unsigned char* L = F.lds + RING_OFF;
    const int b = bh >> 3, h = bh & 7, lane = F.lane, w = F.wave, tid = F.tid;
    const int fr = lane & 15, fq = lane >> 4;
    const int tr = w >> 1, tc0 = 2 * (w & 1);
    const float ng0 = a.norm_g[l * 512 + h * 64 + 16 * tc0 + fr], ng1 = a.norm_g[l * 512 + h * 64 + 16 * (tc0 + 1) + fr];
    f32x4 S0 = {0.f, 0.f, 0.f, 0.f}, S1 = {0.f, 0.f, 0.f, 0.f};
    for (int i = tid; i < 9216 / 4; i += NWAVES * 64) ((LAS unsigned*)(L + O_ST))[i] = 0u;
    const size_t rowbase = (size_t)b * SEQ;
    float g[8]; unsigned short qv[8], vv[8];
#pragma unroll
    for (int i = 0; i < 8; ++i) { const size_t row = rowbase + 8 * w + i; g[i] = LOGF[row * 512 + h * 64 + lane]; qv[i] = HB[row * 1024 + h * 64 + lane]; vv[i] = HB[row * 1024 + 512 + h * 64 + lane]; }
    const int orow = 16 * tr + (lane >> 2), ocol = 16 * tc0 + (lane & 3) * 8;
    u32x4 gv = *(const u32x4*)(HG + (rowbase + orow) * 512 + h * 64 + ocol);
    for (int c0 = 0; c0 < SEQ; c0 += 64) {
        float bc[8]; { float run = 0.f;
#pragma unroll
            for (int i = 0; i < 8; ++i) { run += g[i]; bc[i] = run; } }
        ((LAS float*)(L + O_TOT))[w * 64 + lane] = bc[7];
        float qf[8], kf[8];
#pragma unroll
        for (int i = 0; i < 8; ++i) { qf[i] = bf2f(qv[i]); kf[i] = 1.f - ex(g[i]); }
        { u32x4 pk; pk.x = (unsigned)vv[0] | ((unsigned)vv[1] << 16); pk.y = (unsigned)vv[2] | ((unsigned)vv[3] << 16); pk.z = (unsigned)vv[4] | ((unsigned)vv[5] << 16); pk.w = (unsigned)vv[6] | ((unsigned)vv[7] << 16);
          *(LAS u32x4*)(L + O_VT + lane * PB + 16 * w) = pk; }
        __syncthreads();
        float base = 0.f, bm = 0.f, bl = 0.f;
#pragma unroll
        for (int ww = 0; ww < 8; ++ww) { const float tv = ((LAS float*)(L + O_TOT))[ww * 64 + lane]; if (ww < w) base += tv; if (ww < 4) bm += tv; bl += tv; }
        const float ebm = ex(bm), eblm = ex(bl - bm);
        if (w == 0) ((LAS float*)(L + O_EBL))[lane] = ex(bl);
        unsigned short ku[8];
#pragma unroll
        for (int i = 0; i < 8; ++i) { const float x = bc[i] + base - bm; const float e1 = ex(fminf(x, 80.f)), e2 = ex(fminf(-x, 80.f));
            const float qs = qf[i] * e1, ks = kf[i] * e2; const int r = 8 * w + i;
            *(LAS unsigned short*)(L + O_QS + r * PB + 2 * lane) = bf1(qs); *(LAS unsigned short*)(L + O_QI + r * PB + 2 * lane) = bf1(qs * ebm);
            *(LAS unsigned short*)(L + O_KS + r * PB + 2 * lane) = bf1(ks); ku[i] = bf1(ks * eblm); }
        { u32x4 pk; pk.x = (unsigned)ku[0] | ((unsigned)ku[1] << 16); pk.y = (unsigned)ku[2] | ((unsigned)ku[3] << 16); pk.z = (unsigned)ku[4] | ((unsigned)ku[5] << 16); pk.w = (unsigned)ku[6] | ((unsigned)ku[7] << 16);
          *(LAS u32x4*)(L + O_KUT + lane * PB + 16 * w) = pk; }
        if (c0 + 64 < SEQ) {
#pragma unroll
            for (int i = 0; i < 8; ++i) { const size_t row = rowbase + c0 + 64 + 8 * w + i; g[i] = LOGF[row * 512 + h * 64 + lane]; qv[i] = HB[row * 1024 + h * 64 + lane]; vv[i] = HB[row * 1024 + 512 + h * 64 + lane]; }
        }
        __syncthreads();
#pragma unroll
        for (int k2 = 0; k2 < 2; ++k2) { const int idx = 2 * w + k2, ti = idx >> 2, sj = idx & 3;
            f32x4 sc = {0.f, 0.f, 0.f, 0.f};
            if (sj <= ti) {
#pragma unroll
                for (int kk = 0; kk < 2; ++kk) { const bf16x8 af = *(const LAS bf16x8*)(L + O_QS + (16 * ti + fr) * PB + (32 * kk + 8 * fq) * 2), bfr = *(const LAS bf16x8*)(L + O_KS + (16 * sj + fr) * PB + (32 * kk + 8 * fq) * 2);
                    sc = __builtin_amdgcn_mfma_f32_16x16x32_bf16(af, bfr, sc, 0, 0, 0); }
            }
#pragma unroll
            for (int j = 0; j < 4; ++j) { const int t = 16 * ti + 4 * fq + j, s = 16 * sj + fr; *(LAS unsigned short*)(L + O_P + t * PB + 2 * s) = bf1(s <= t ? sc[j] : 0.f); }
        }
        __syncthreads();
        f32x4 o0 = {0.f, 0.f, 0.f, 0.f}, o1 = {0.f, 0.f, 0.f, 0.f}, u0 = {0.f, 0.f, 0.f, 0.f}, u1 = {0.f, 0.f, 0.f, 0.f};
#pragma unroll
        for (int kk = 0; kk < 2; ++kk) { const int ko = (32 * kk + 8 * fq) * 2;
            const bf16x8 pa = *(const LAS bf16x8*)(L + O_P + (16 * tr + fr) * PB + ko), qa = *(const LAS bf16x8*)(L + O_QI + (16 * tr + fr) * PB + ko), ka = *(const LAS bf16x8*)(L + O_KUT + (16 * tr + fr) * PB + ko);
            const bf16x8 v0 = *(const LAS bf16x8*)(L + O_VT + (16 * tc0 + fr) * PB + ko), v1 = *(const LAS bf16x8*)(L + O_VT + (16 * (tc0 + 1) + fr) * PB + ko);
            const bf16x8 s0 = *(const LAS bf16x8*)(L + O_ST + (16 * tc0 + fr) * PB + ko), s1 = *(const LAS bf16x8*)(L + O_ST + (16 * (tc0 + 1) + fr) * PB + ko);
            o0 = __builtin_amdgcn_mfma_f32_16x16x32_bf16(pa, v0, o0, 0, 0, 0); o1 = __builtin_amdgcn_mfma_f32_16x16x32_bf16(pa, v1, o1, 0, 0, 0);
            o0 = __builtin_amdgcn_mfma_f32_16x16x32_bf16(qa, s0, o0, 0, 0, 0); o1 = __builtin_amdgcn_mfma_f32_16x16x32_bf16(qa, s1, o1, 0, 0, 0);
            u0 = __builtin_amdgcn_mfma_f32_16x16x32_bf16(ka, v0, u0, 0, 0, 0); u1 = __builtin_amdgcn_mfma_f32_16x16x32_bf16(ka, v1, u1, 0, 0, 0); }
        { const f32x4 dec = *(const LAS f32x4*)(L + O_EBL + (16 * tr + 4 * fq) * 4); S0 = S0 * dec + u0; S1 = S1 * dec + u1; }
        { f32x4 q2 = o0 * o0 + o1 * o1;
#pragma unroll
          for (int m = 1; m < 16; m <<= 1) { q2[0] += __shfl_xor(q2[0], m); q2[1] += __shfl_xor(q2[1], m); q2[2] += __shfl_xor(q2[2], m); q2[3] += __shfl_xor(q2[3], m); }
          if (fr == 0) {
#pragma unroll
              for (int j = 0; j < 4; ++j) ((LAS float*)(L + O_RED))[(16 * tr + 4 * fq + j) * 2 + (w & 1)] = q2[j]; } }
        __syncthreads();
        { u32x2 p0, p1; p0.x = pk2(S0[0], S0[1]); p0.y = pk2(S0[2], S0[3]); p1.x = pk2(S1[0], S1[1]); p1.y = pk2(S1[2], S1[3]);
          *(LAS u32x2*)(L + O_ST + (16 * tc0 + fr) * PB + (16 * tr + 4 * fq) * 2) = p0; *(LAS u32x2*)(L + O_ST + (16 * (tc0 + 1) + fr) * PB + (16 * tr + 4 * fq) * 2) = p1; }
        { LAS unsigned char* os = L + O_OS + w * (16 * 80);
#pragma unroll
          for (int j = 0; j < 4; ++j) { const int t = 16 * tr + 4 * fq + j; const f32x2 rr = *(const LAS f32x2*)(L + O_RED + t * 8); const float rs = rsqrtf((rr[0] + rr[1]) * (1.f / 64.f) + RMS_EPS);
              *(LAS unsigned short*)(os + (4 * fq + j) * 80 + 2 * fr) = bf1(o0[j] * rs * ng0); *(LAS unsigned short*)(os + (4 * fq + j) * 80 + 2 * (16 + fr)) = bf1(o1[j] * rs * ng1); }
          asm volatile("s_waitcnt lgkmcnt(0)" ::: "memory");
          const u32x4 ov = *(const LAS u32x4*)(os + (lane >> 2) * 80 + (lane & 3) * 16);
          const size_t row = rowbase + c0 + orow;
          u32x2 r; r.x = pg8::pack4_fp8(bflo(ov.x) * bflo(gv.x) * SC_HGRN, bfhi(ov.x) * bfhi(gv.x) * SC_HGRN, bflo(ov.y) * bflo(gv.y) * SC_HGRN, bfhi(ov.y) * bfhi(gv.y) * SC_HGRN);
          r.y = pg8::pack4_fp8(bflo(ov.z) * bflo(gv.z) * SC_HGRN, bfhi(ov.z) * bfhi(gv.z) * SC_HGRN, bflo(ov.w) * bflo(gv.w) * SC_HGRN, bfhi(ov.w) * bfhi(gv.w) * SC_HGRN);
          *(u32x2*)(O8 + row * 1024 + 512 + h * 64 + ocol) = r;
          if (c0 + 64 < SEQ) gv = *(const u32x4*)(HG + (rowbase + c0 + 64 + orow) * 512 + h * 64 + ocol);
          asm volatile("s_waitcnt lgkmcnt(0)" ::: "memory"); }
    }
}


constexpr int PH_PER_LAYER = 10, N_PHASES = 1 + DEPTH * PH_PER_LAYER;
#ifndef MK_ONE_LAUNCH
#define MK_ONE_LAUNCH 1
#endif
#ifndef MK_FAST_ATTN
#define MK_FAST_ATTN 0
#endif
#ifndef MK_FAST_HGRN
#define MK_FAST_HGRN 0
#endif


#ifdef DBG_DUMP
#ifndef DBG_WHAT
#define DBG_WHAT 0
#endif
__device__ __forceinline__ void dbg_dump(const Args& a, const Frame& F) {
    unsigned char* ws = a.ws;
    const bf16_t *QO = (bf16_t*)(ws + WS_QO), *KV = (bf16_t*)(ws + WS_KV), *HB = (bf16_t*)(ws + WS_HB), *HG = (bf16_t*)(ws + WS_HG), *G = (bf16_t*)(ws + WS_G);
    const bf16_t *U1 = (bf16_t*)(ws + WS_U1), *U = (bf16_t*)(ws + WS_U), *MIXED = (bf16_t*)(ws + WS_MIXED), *XN = (bf16_t*)(ws + WS_XN);
    const float *LOGF = (float*)(ws + WS_LOGF), *FL = (float*)(ws + WS_FL), *XRES = (float*)(ws + WS_XRES);
    for (size_t i = (size_t)F.bid * 512 + F.tid; i < (size_t)T * D; i += (size_t)gridDim.x * 512) {
        const size_t row = i >> 10; const int c = (int)(i & 1023);
        float v = 0.f;
        if (DBG_WHAT == 9) { v = bf2f(G[row * 2048 + c]) + bf2f(G[row * 2048 + 1024 + c]); }
        else if (DBG_DUMP == 1) { v = bf2f(KV[i]) + bf2f(HB[i]) + bf2f(G[row * 2048 + c]) + bf2f(G[row * 2048 + 1024 + c]);
            if (c < 512) v += LOGF[row * 512 + c] + bf2f(HG[row * 512 + c]) + bf2f(QO[i]); if (c < 8) v += FL[row * 8 + c]; }
        else if (DBG_DUMP == 2) { v = (c >= 512) ? bf2f(QO[i]) : 0.f; }
        else if (DBG_DUMP == 3) { v = bf2f(QO[i]); }
        else if (DBG_DUMP == 4) { v = bf2f(U1[i]); }
        else if (DBG_DUMP == 5) { v = bf2f(U[i]); }
        else if (DBG_DUMP == 6) { v = bf2f(MIXED[i]); }
        else if (DBG_DUMP == 7) { v = XRES[i] + bf2f(XN[i]); }
        a.out[i] = v;
    }
}
#endif
#define PH_BEGIN const Args a = LOAD_ARGS(); Frame F; F.lds = lds0; F.lane = (int)__builtin_amdgcn_mbcnt_hi(~0u, __builtin_amdgcn_mbcnt_lo(~0u, 0u)); asm volatile("" : "+v"(F.lane)); F.wave = __builtin_amdgcn_readfirstlane((int)((const volatile LAS unsigned*)(lds0 + WTAB_OFF))[hw_wave_key()]); F.tid = F.wave * 64 + F.lane; \
    F.G = gridDim.x; F.bid = blockIdx.x; asm volatile("" : "+s"(F.bid)); F.gw = F.bid * NWAVES + F.wave; F.ngw = F.G * NWAVES; unsigned char* const ws = a.ws; const LAS int* tab = (const LAS int*)(F.lds + TAB_OFF); (void)tab; (void)ws;
#ifdef DBG_DUMP
#define IN(k) (lo <= (k) && (k) < hi && (k) <= DBG_DUMP)
#else
#define IN(k) (lo <= (k) && (k) < hi)
#endif
#ifdef DBG_REPEAT
#define REP(k) for (int rep_ = 0; rep_ < ((DBG_REPEAT == (k) && !((k) == 9 && l == DEPTH - 1)) ? 2 : 1); ++rep_)
#else
#define REP(k)
#endif
#define SEAM(k) do { if (IN(k) && IN((k) + 1)) { XcdBarrier b2_ = bar; { size_t z_ = 0; asm volatile("" : "+s"(z_), "+s"(b2_.x)); b2_.bar = bar.bar + z_; } xcd_barrier(b2_); } } while (0)
template <int l>
__device__ __forceinline__ void layer_body(const Args& args, const int lo, const int hi, const XcdBarrier& bar, LAS unsigned char* const lds0, unsigned char* lds_raw) {
        const int pb = 1 + l * PH_PER_LAYER;

#ifdef DBG_DUMP
        if (l == 0 && lo <= DBG_DUMP + 1 && DBG_DUMP + 1 < hi) { PH_BEGIN dbg_dump(a, F); }
#endif
        if (IN(pb + 0)) REP(0) { PH_BEGIN
            pg8::Gemm g{(bf16_t*)(ws + WS_XN), (bf16_t*)(ws + wset(l) + WO_WIN), D / 2, D / 2, D / 2, E8_1, E8_W}; pg8::StaticOrder S; S.init(T, NINP, F.G, F.bid);
            pg8::EpiInproj E{ws, l};
            pg8::gemm_phase<pg8::EpiInproj, pg8::StaticOrder, true>(F.lds + RING_OFF, g, S, E, F.tid);
        }
        SEAM(pb + 0);
        if (IN(pb + 1)) REP(1) { PH_BEGIN
            const int vcu = (F.G % 8 == 0) ? (F.bid % 8) * (F.G / 8) + F.bid / 8 : F.bid;
            if ((vcu & 1) == 0 && (vcu >> 1) < BATCH * NH) { phase_hgrn(a, F, l, vcu >> 1); __syncthreads(); }
            phase_attn(a, F, (char*)lds_raw);
            if (l + 1 < DEPTH) { __syncthreads(); convert_layer(a, F, l + 1, F.gw, F.ngw); }
        }
        SEAM(pb + 1);
        if (IN(pb + 3)) REP(3) { PH_BEGIN
            pg8::Gemm g{(bf16_t*)(ws + WS_OX8), (bf16_t*)(ws + wset(l) + WO_WBR), D / 2, D / 2, 256, E8_FOX, E8_W}; pg8::StaticOrder S; S.init(T, D, F.G, F.bid);
            pg8::EpiGate<1> E{(bf16_t*)(ws + WS_U1), nullptr, (bf16_t*)(ws + WS_G), 2048, nullptr, 0.f};
            pg8::gemm_phase<pg8::EpiGate<1>, pg8::StaticOrder, true>(F.lds + RING_OFF, g, S, E, F.tid);
        }
        if (IN(pb + 3) && IN(pb + 4)) __syncthreads(); else SEAM(pb + 3);
        if (IN(pb + 4)) REP(4) { PH_BEGIN
            pg8::Gemm g{(bf16_t*)(ws + WS_OX8) + 256, (bf16_t*)(ws + wset(l) + WO_WBR) + 256, D / 2, D / 2, 256, E8_HGRN, E8_W}; pg8::StaticOrder S; S.init(T, D, F.G, F.bid);
            pg8::EpiGate<2> E{(bf16_t*)(ws + WS_U), nullptr, (bf16_t*)(ws + WS_G) + 1024, 2048, (bf16_t*)(ws + WS_U1), 0.f};
            pg8::gemm_phase<pg8::EpiGate<2>, pg8::StaticOrder, true>(F.lds + RING_OFF, g, S, E, F.tid);
        }
        SEAM(pb + 4);
        if (IN(pb + 5)) REP(5) { PH_BEGIN
            pg8::Gemm g{(bf16_t*)(ws + WS_U), (bf16_t*)(ws + wset(l) + WO_WMIX), D / 2, D / 2, D / 2, E8_U, E8_W}; pg8::StaticOrder S; S.init(T, D, F.G, F.bid);
            pg8::EpiGate<0> E{(bf16_t*)(ws + WS_MIXED), a.b_mix + l * D, nullptr, 0, nullptr, SC_MIX};
            pg8::gemm_phase<pg8::EpiGate<0>, pg8::StaticOrder, true>(F.lds + RING_OFF, g, S, E, F.tid);
        }
        SEAM(pb + 5);
        if (IN(pb + 6)) REP(6) { PH_BEGIN phase_ln1_router(a, F, l); }
        SEAM(pb + 6);
        if (IN(pb + 7)) REP(7) { PH_BEGIN
            moe_table(a, F, l);
            pg8::Gemm g{(bf16_t*)(ws + WS_XN), (bf16_t*)(ws + wset(l) + WO_W13), D / 2, D / 2, D / 2, E8_1, E8_W}; pg8::MoeOrder<true> S{F.G, F.bid, 8, tab, (const int*)(ws + WS_LIST), (size_t)2048 * (D / 2), (const LAS int*)(F.lds + TOK_OFF)};
            S.preload_tokens((LAS int*)(F.lds + TOK_OFF), F.tid); __syncthreads();
            pg8::EpiUp E{(bf16_t*)(ws + WS_H)};
            pg8::gemm_phase<pg8::EpiUp, pg8::MoeOrder<true>, true>(F.lds + RING_OFF, g, S, E, F.tid);
        }
        SEAM(pb + 7);
        if (IN(pb + 8)) REP(8) { PH_BEGIN
            moe_table(a, F, l);
            pg8::Gemm g{(bf16_t*)(ws + WS_H), (bf16_t*)(ws + wset(l) + WO_W2), D / 2, D / 2, D / 2, E8_H, E8_W}; pg8::MoeOrder<false> S{F.G, F.bid, 4, tab, nullptr, (size_t)D * (D / 2), nullptr};
            pg8::EpiGate<0> E{(bf16_t*)(ws + WS_Y), (const float*)(ws + WS_CTL + 524288)  , nullptr, 0, nullptr, SC_Y};
            pg8::gemm_phase<pg8::EpiGate<0>, pg8::MoeOrder<false>, true>(F.lds + RING_OFF, g, S, E, F.tid);
        }
        SEAM(pb + 8);
        if (IN(pb + 9)) REP(9) { PH_BEGIN
            if (l + 1 < DEPTH) load_wff(a, F, l + 1);
            moe_table(a, F, l);
            phase_combine_ln2(a, F, l);
        }
        SEAM(pb + 9);
    }

__global__ void __launch_bounds__(NWAVES * 64, 2) mk_fwd(Args args) {
    extern __shared__ __attribute__((aligned(16))) unsigned char lds_raw[];
    LAS unsigned char* const lds0 = (LAS unsigned char*)lds_raw;
    volatile LAS unsigned* MISC = (volatile LAS unsigned*)(lds0 + MISC_OFF);
    for (int u = threadIdx.x; u < (LDS_BYTES - LDSCTL_OFF) / 4; u += NWAVES * 64) ((LAS unsigned*)(lds0 + LDSCTL_OFF))[u] = 0u;
    __syncthreads();
    if ((threadIdx.x & 63) == 0) ((volatile LAS unsigned*)(lds0 + WTAB_OFF))[hw_wave_key()] = threadIdx.x >> 6;
    __syncthreads();
    unsigned* ctl = (unsigned*)(args.ws + WS_CTL);
    XcdBarrier bar; bar.bar = ctl + CW_BAR; bar.x = 0; bar.st = nullptr;
    if (args.use_bar) bar = xcd_barrier_post(ctl + CW_BAR, MISC + 8);
    const int lo = args.ph_lo, hi = args.ph_hi;


    if (IN(0)) { PH_BEGIN phase_prep(a, F); }
    SEAM(0);
    layer_body<0>(args, lo, hi, bar, lds0, lds_raw); layer_body<1>(args, lo, hi, bar, lds0, lds_raw); layer_body<2>(args, lo, hi, bar, lds0, lds_raw); layer_body<3>(args, lo, hi, bar, lds0, lds_raw);
#undef IN
#undef SEAM
}

extern "C" void kernel_launch(void* const* d_in, const int* in_sizes, int n_in, void* d_out, int out_size, void* d_ws, size_t ws_size, hipStream_t stream) {
    static int grid = 0;
    if (grid == 0) {
        if (n_in != 20 || in_sizes[0] != T * D || out_size != T * D || ws_size < WS_END) { fprintf(stderr, "kernel_launch: unexpected shapes (n_in %d, ws %zu)\n", n_in, ws_size); grid = -1; return; }
        int dev = 0, cus = 0, per_cu = 0;
        if (hipGetDevice(&dev) != hipSuccess || hipDeviceGetAttribute(&cus, hipDeviceAttributeMultiprocessorCount, dev) != hipSuccess) { grid = -1; return; }
        if (hipFuncSetAttribute((const void*)mk_fwd, hipFuncAttributeMaxDynamicSharedMemorySize, LDS_BYTES) != hipSuccess) { fprintf(stderr, "kernel_launch: hipFuncSetAttribute failed\n"); grid = -1; return; }
        if (hipOccupancyMaxActiveBlocksPerMultiprocessor(&per_cu, (const void*)mk_fwd, NWAVES * 64, LDS_BYTES) != hipSuccess || per_cu < 1)
            fprintf(stderr, "kernel_launch: note: occupancy query reports %d workgroups per CU\n", per_cu);
        (void)hipGetLastError();
        grid = cus;
    }
    if (grid < 0) return;
    if (hipMemsetAsync((char*)d_ws + WS_CTL, 0, CTL_BYTES, stream) != hipSuccess) return;
    Args a{};
    a.x = (const float*)d_in[0]; a.ln_in_g = (const float*)d_in[1]; a.ln_in_b = (const float*)d_in[2]; a.w_in = (const float*)d_in[3]; a.b_in = (const float*)d_in[4];
    a.w_fox = (const float*)d_in[5]; a.lbl = (const float*)d_in[6]; a.norm_g = (const float*)d_in[7]; a.w_hgrn = (const float*)d_in[8]; a.w_mix = (const float*)d_in[9];
    a.b_mix = (const float*)d_in[10]; a.ln1_g = (const float*)d_in[11]; a.ln1_b = (const float*)d_in[12]; a.router_w = (const float*)d_in[13]; a.router_b = (const float*)d_in[14];
    a.w1 = (const float*)d_in[15]; a.w3 = (const float*)d_in[16]; a.w2 = (const float*)d_in[17]; a.ln2_g = (const float*)d_in[18]; a.ln2_b = (const float*)d_in[19];
    a.out = (float*)d_out; a.ws = (unsigned char*)d_ws; a.pad = 0;
#if MK_ONE_LAUNCH
    a.ph_lo = 0; a.ph_hi = N_PHASES; a.use_bar = 1;
    hipLaunchKernelGGL(mk_fwd, dim3(grid), dim3(NWAVES * 64), LDS_BYTES, stream, a);
#else
#ifdef DBG_DUMP
    const int np_ = DBG_DUMP + 2;
#else
    const int np_ = N_PHASES;
#endif
    for (int p = 0; p < np_; ++p) { a.ph_lo = p; a.ph_hi = p + 1; a.use_bar = 0;
        hipLaunchKernelGGL(mk_fwd, dim3(grid), dim3(NWAVES * 64), LDS_BYTES, stream, a); }
#endif
    const hipError_t le = hipPeekAtLastError();
    if (le != hipSuccess) fprintf(stderr, "kernel_launch: launch failed: %s\n", hipGetErrorName(le));
}
```

```cpp
#define MK_ONE_LAUNCH 1
#define MK_FAST_ATTN 1
#define MK_FAST_HGRN 1
#define PG8_SPFORM 1
#include <hip/hip_runtime.h>
#include <cstdio>
#include <cstdint>

typedef unsigned short bf16_t;
typedef short bf16x8 __attribute__((ext_vector_type(8)));
typedef float f32x4 __attribute__((ext_vector_type(4)));
typedef float f32x2 __attribute__((ext_vector_type(2)));
typedef unsigned u32x4 __attribute__((ext_vector_type(4)));
typedef unsigned u32x2 __attribute__((ext_vector_type(2)));
#define LAS __attribute__((address_space(3)))
#define GAS __attribute__((address_space(1)))

constexpr int BATCH = 16, SEQ = 2048, T = BATCH * SEQ, D = 1024, DEPTH = 4, NH = 8, HD = 64, NIN = 5640, NINP = 5632, NE = 16;
constexpr float LN_EPS = 1e-5f, RMS_EPS = 1e-6f;
constexpr float ALPHA = 1.681792830507429f;
constexpr float LOG2E = 1.4426950408889634f;
constexpr float C2 = 0.125f * LOG2E;
constexpr float SC_W = 64.f, SC_FOX = 16.f, SC_HGRN = 4.f, SC_U = 64.f, SC_H = 8.f, SC_MIX = 32.f, SC_Y = 64.f, SC_G = 256.f;
constexpr int E8_1 = 0x7f7f7f7f, E8_W = 0x79797979, E8_FOX = 0x7b7b7b7b, E8_HGRN = 0x7d7d7d7d, E8_U = 0x79797979, E8_H = 0x7c7c7c7c;
constexpr int TM = 256;

constexpr size_t MiB = 1u << 20;
constexpr size_t WS_CTL = 0, CTL_BYTES = 1 * MiB;
constexpr size_t WS_MISC = 1 * MiB;
constexpr size_t WS_WSET = 2 * MiB, WSET_BYTES = 56 * MiB;
constexpr size_t WO_WIN = 0, WO_WBR = 6 * MiB, WO_WMIX = 7 * MiB, WO_W13 = 8 * MiB, WO_W2 = 40 * MiB;
__host__ __device__ constexpr size_t wset(int l) { return WS_WSET + (size_t)(l & 1) * WSET_BYTES; }
__host__ __device__ constexpr size_t biasoff(int l) { return WS_MISC + 16384 + (size_t)(l & 1) * 32768; }
constexpr size_t WS_XRES = 114 * MiB, WS_XN = 242 * MiB, WS_QO = 306 * MiB, WS_KV = 370 * MiB, WS_HB = 434 * MiB, WS_LOGF = 498 * MiB;
constexpr size_t WS_HG = 562 * MiB, WS_G = 594 * MiB, WS_FL = 722 * MiB, WS_F2 = 723 * MiB, WS_U1 = 724 * MiB, WS_U = 788 * MiB, WS_MIXED = 852 * MiB;
constexpr size_t WS_LIST = 916 * MiB, WS_TOK = 918 * MiB, WS_X1B = 920 * MiB, WS_END = 984 * MiB;
constexpr size_t WS_OX8 = 274 * MiB;
constexpr size_t WS_H = WS_QO, WS_Y = 442 * MiB;
constexpr int CW_CNT = 1024;
constexpr int CW_BAR = 4096;

__device__ __forceinline__ unsigned f2bf(float f) { unsigned u = __builtin_bit_cast(unsigned, f); return (u + 0x7fffu + ((u >> 16) & 1u)) >> 16; }
__device__ __forceinline__ float bf2f(unsigned h) { return __builtin_bit_cast(float, h << 16); }
__device__ __forceinline__ float bflo(unsigned w) { return __builtin_bit_cast(float, w << 16); }
__device__ __forceinline__ float bfhi(unsigned w) { return __builtin_bit_cast(float, w & 0xffff0000u); }
typedef __bf16 bf16x2v_t __attribute__((ext_vector_type(2)));
__device__ __forceinline__ unsigned pk2(float lo, float hi) { f32x2 v = {lo, hi}; bf16x2v_t b = __builtin_convertvector(v, bf16x2v_t); return __builtin_bit_cast(unsigned, b); }
template <int CTRL> __device__ __forceinline__ float dppmov(float v) { return __builtin_bit_cast(float, __builtin_amdgcn_update_dpp(0, __builtin_bit_cast(int, v), CTRL, 0xf, 0xf, true)); }
__device__ __forceinline__ float lane_xor1(float v) { return dppmov<0xB1>(v); }
__device__ __forceinline__ float lane_xor2(float v) { return dppmov<0x4E>(v); }
__device__ __forceinline__ float lane_xor4(float v) { return dppmov<0x1B>(dppmov<0x141>(v)); }
__device__ __forceinline__ float lane_xor8(float v) { return dppmov<0x128>(v); }
#ifndef RS32_A
#define RS32_A a
#define RS32_B b
#endif
#ifndef RS16_A
#define RS16_A a
#define RS16_B b
#endif
#ifdef DBG_OLD_RS16
__device__ __forceinline__ float rs_step16(float a, float b) { const bool hi = (__builtin_amdgcn_mbcnt_hi(~0u, __builtin_amdgcn_mbcnt_lo(~0u, 0u)) & 16) != 0; const float snd = hi ? a : b; const float rcv = __shfl_xor(snd, 16); return (hi ? b : a) + rcv; }
#else
__device__ __forceinline__ float rs_step16(float a, float b) { asm volatile("s_nop 1\n\tv_permlane16_swap_b32 %0, %1" : "+v"(a), "+v"(b)); return a + b; }
#endif
#ifdef DBG_OLD_RS32
__device__ __forceinline__ float rs_step32(float a, float b) { const bool hi = (__builtin_amdgcn_mbcnt_hi(~0u, __builtin_amdgcn_mbcnt_lo(~0u, 0u)) & 32) != 0; const float snd = hi ? a : b; const float rcv = __shfl_xor(snd, 32); return (hi ? b : a) + rcv; }
#else
__device__ __forceinline__ float rs_step32(float a, float b) { asm volatile("s_nop 1\n\tv_permlane32_swap_b32 %0, %1" : "+v"(a), "+v"(b)); return a + b; }
#endif
#ifdef DBG_OLD_X48
#undef DBG_OLD_X48
__device__ __forceinline__ float lane_xor4b(float v) { return __shfl_xor(v, 4); }
__device__ __forceinline__ float lane_xor8b(float v) { return __shfl_xor(v, 8); }
#define lane_xor4 lane_xor4b
#define lane_xor8 lane_xor8b
#endif
__device__ __forceinline__ float wave_sum(float v) {
    v += lane_xor1(v); v += lane_xor2(v); v += dppmov<0x124>(v); v += dppmov<0x128>(v);
    v = rs_step16(v, v); return rs_step32(v, v);
}
__device__ __forceinline__ float wave_max(float v) {
#pragma unroll
    for (int o = 1; o < 64; o <<= 1) v = fmaxf(v, __shfl_xor(v, o));
    return v;
}
__device__ __forceinline__ float fast_exp(float v) { return __builtin_amdgcn_exp2f(v * LOG2E); }
__device__ __forceinline__ float sigmoidf_(float v) { return __builtin_amdgcn_rcpf(1.0f + fast_exp(-v)); }
__device__ __forceinline__ float siluf_(float v) { return v * sigmoidf_(v); }
__device__ __forceinline__ float logsigmoidf_(float v) { return fminf(v, 0.f) - __logf(1.0f + fast_exp(-fabsf(v))); }

#ifndef PG8_ALIGN
#define PG8_ALIGN true
#endif
#ifndef PG8_SPFORM
#define PG8_SPFORM 0
#endif
namespace pg8 {
constexpr int BM = 256, BK = 64, HALF = 128, HTB = HALF * BK * 2  , STAGE_BYTES = 8 * HTB, NXCD = 8, WGM = 8;
__host__ __device__ __forceinline__ int lds_byte(int r, int c) { const int st = (r >> 4) * 2 + (c >> 5), rr = r & 15, cc = c & 31, ob = rr * 64 + cc * 2; return st * 1024 + (ob ^ (((ob >> 9) & 1) << 5)); }
__host__ __device__ __forceinline__ void stage_rc(int b, int& R, int& C) { const int st = b / 1024, sb = b % 1024, swz = sb ^ (((sb >> 9) & 1) << 5); R = (st >> 1) * 16 + swz / 64; C = (st & 1) * 32 + (swz % 64) / 2; }
__host__ __device__ __forceinline__ int perm32(int rho) { const int n = rho >> 4, i = rho & 15; return 8 * (i >> 2) + 4 * n + (i & 3); }

struct Unit { int pm, pn, e; };
struct Gemm { const bf16_t* A; const bf16_t* Bt; int lda, ldb, K; int sa, sb; };

struct StaticOrder {
    static constexpr bool GATHER = false;
    int nM, nN, nwg, G, c;
    __device__ void init(int M, int N, int G_, int c_) { nM = M / BM; nN = N / BM; nwg = nM * nN; G = G_; c = c_; }
    __device__ bool next(int i, Unit& u) const {
        const int L = i * G + c; if (L >= nwg) return false;
        int wgid = L; { const int q = nwg / NXCD, r = nwg % NXCD, xcd = wgid % NXCD, off = wgid / NXCD; wgid = (xcd < r ? xcd * (q + 1) : r * (q + 1) + (xcd - r) * q) + off; }
        const int nig = WGM * nN, gid = wgid / nig, fm = gid * WGM, gsz = (nM - fm) < WGM ? (nM - fm) : WGM;
        u.pm = fm + ((wgid % nig) % gsz); u.pn = (wgid % nig) / gsz; u.e = 0; return true;
    }
    __device__ __forceinline__ const char* a_tile(const Gemm& g, const Unit& u) const { return (const char*)g.A + (size_t)u.pm * BM * g.lda * 2; }
    __device__ __forceinline__ const char* b_tile(const Gemm& g, const Unit& u) const { return (const char*)g.Bt + (size_t)u.pn * BM * g.ldb * 2; }
    __device__ __forceinline__ void a_voff(const Gemm& g, const Unit&, int, const int (&R)[2], const int (&C)[2], unsigned (&v)[2][2]) const {
#pragma unroll
        for (int h = 0; h < 2; ++h)
#pragma unroll
            for (int i = 0; i < 2; ++i) v[h][i] = (unsigned)((h * HALF + R[i]) * g.lda + C[i]) * 2u;
    }
};
template <bool GATHER_> struct MoeOrder {
    static constexpr bool GATHER = GATHER_; static constexpr bool gather = GATHER_;
    int G, c, nN; const LAS int* tab; const int* list; size_t bstride; const LAS int* tok;
    __device__ bool next(int i, Unit& u) const {
        const int L = i * G + c; const int rt = L / nN; const int NT = tab[NE]; if (rt >= NT) return false;
        int e = 0;
#pragma unroll
        for (int k = 1; k < NE; ++k) e += (rt >= tab[k]) ? 1 : 0;
        u.pm = __builtin_amdgcn_readfirstlane(rt); u.pn = __builtin_amdgcn_readfirstlane(L % nN); u.e = __builtin_amdgcn_readfirstlane(e); return true;
    }
    __device__ __forceinline__ const char* a_tile(const Gemm& g, const Unit& u) const { return gather ? (const char*)g.A : (const char*)g.A + (size_t)u.pm * BM * g.lda * 2; }
    __device__ __forceinline__ const char* b_tile(const Gemm& g, const Unit& u) const { return (const char*)g.Bt + ((size_t)u.e * bstride + (size_t)u.pn * BM * g.ldb) * 2; }
    __device__ __forceinline__ void a_voff(const Gemm& g, const Unit& u, int ui, const int (&R)[2], const int (&C)[2], unsigned (&v)[2][2]) const {
#pragma unroll
        for (int h = 0; h < 2; ++h)
#pragma unroll
            for (int i = 0; i < 2; ++i) {
                if (gather) { const int tk = tok[ui * BM + h * HALF + R[i]]; v[h][i] = (unsigned)(tk * g.lda + C[i]) * 2u; }
                else v[h][i] = (unsigned)((h * HALF + R[i]) * g.lda + C[i]) * 2u;
            }
    }
    __device__ __forceinline__ void preload_tokens(LAS int* tokw, int tid) const {
        Unit u;
        for (int i = 0; next(i, u); ++i) { const int ts = tab[u.e], cn = tab[NE + 1 + u.e];
            for (int r = tid; r < BM; r += 512) { const int pos = (u.pm - ts) * BM + r; tokw[i * BM + r] = (pos < cn) ? list[u.e * T + pos] : 0; } }
    }
};

typedef __bf16 bf16x2_t __attribute__((ext_vector_type(2)));
__device__ __forceinline__ unsigned cvt_pk_bf16(float lo, float hi) { f32x2 v = {lo, hi}; bf16x2_t b = __builtin_convertvector(v, bf16x2_t); return __builtin_bit_cast(unsigned, b); }
__device__ __forceinline__ u32x4 pack8(const f32x4& v0, const f32x4& v1) { u32x4 w; w.x = cvt_pk_bf16(v0[0], v0[1]); w.y = cvt_pk_bf16(v0[2], v0[3]); w.z = cvt_pk_bf16(v1[0], v1[1]); w.w = cvt_pk_bf16(v1[2], v1[3]); return w; }
__device__ __forceinline__ void unpack8(const u32x4& w, f32x4& v0, f32x4& v1) { v0[0] = bflo(w.x); v0[1] = bfhi(w.x); v0[2] = bflo(w.y); v0[3] = bfhi(w.y); v1[0] = bflo(w.z); v1[1] = bfhi(w.z); v1[2] = bflo(w.w); v1[3] = bfhi(w.w); }
typedef int v8i __attribute__((ext_vector_type(8)));
typedef int v4i __attribute__((ext_vector_type(4)));
__device__ __forceinline__ u32x2 pack8_fp8(const f32x4& v0, const f32x4& v1) {
    u32x2 w; int t = 0; t = __builtin_amdgcn_cvt_pk_fp8_f32(v0[0], v0[1], t, false); t = __builtin_amdgcn_cvt_pk_fp8_f32(v0[2], v0[3], t, true); w.x = (unsigned)t;
    int t2 = 0; t2 = __builtin_amdgcn_cvt_pk_fp8_f32(v1[0], v1[1], t2, false); t2 = __builtin_amdgcn_cvt_pk_fp8_f32(v1[2], v1[3], t2, true); w.y = (unsigned)t2; return w; }
__device__ __forceinline__ unsigned pack4_fp8(float a, float b, float c, float d) { int t = 0; t = __builtin_amdgcn_cvt_pk_fp8_f32(a, b, t, false); t = __builtin_amdgcn_cvt_pk_fp8_f32(c, d, t, true); return (unsigned)t; }
__device__ __forceinline__ f32x4 sig4(const f32x4& v) { const f32x4 t = v * (-LOG2E); f32x4 e; e[0] = __builtin_amdgcn_exp2f(t[0]); e[1] = __builtin_amdgcn_exp2f(t[1]); e[2] = __builtin_amdgcn_exp2f(t[2]); e[3] = __builtin_amdgcn_exp2f(t[3]); const f32x4 d = e + 1.0f; f32x4 o; o[0] = __builtin_amdgcn_rcpf(d[0]); o[1] = __builtin_amdgcn_rcpf(d[1]); o[2] = __builtin_amdgcn_rcpf(d[2]); o[3] = __builtin_amdgcn_rcpf(d[3]); return o; }

__device__ __forceinline__ void gld16(f32x4& r, const void* p) { asm volatile("global_load_dwordx4 %0, %1, off" : "=v"(r) : "v"(p) : "memory"); }
__device__ __forceinline__ void gld16u(u32x4& r, const void* p) { asm volatile("global_load_dwordx4 %0, %1, off" : "=v"(r) : "v"(p) : "memory"); }
__device__ __forceinline__ void gld16u_nt(u32x4& r, const void* p) { asm volatile("global_load_dwordx4 %0, %1, off nt" : "=v"(r) : "v"(p) : "memory"); }
__device__ __forceinline__ void gld16x4s(u32x4& r0, u32x4& r1, u32x4& r2, u32x4& r3, const void* sbase, unsigned voff) {
    asm volatile("global_load_dwordx4 %0, %4, %5\n\tglobal_load_dwordx4 %1, %4, %5 offset:16\n\tglobal_load_dwordx4 %2, %4, %5 offset:512\n\tglobal_load_dwordx4 %3, %4, %5 offset:528"
                 : "=&v"(r0), "=&v"(r1), "=&v"(r2), "=&v"(r3) : "v"(voff), "s"(sbase) : "memory"); }
template <bool NT> __device__ __forceinline__ void gld16x2s(u32x4& r0, u32x4& r1, const void* sbase, unsigned voff) {
    if (NT) asm volatile("global_load_dwordx4 %0, %2, %3 nt\n\tglobal_load_dwordx4 %1, %2, %3 offset:256 nt" : "=&v"(r0), "=&v"(r1) : "v"(voff), "s"(sbase) : "memory");
    else    asm volatile("global_load_dwordx4 %0, %2, %3\n\tglobal_load_dwordx4 %1, %2, %3 offset:256" : "=&v"(r0), "=&v"(r1) : "v"(voff), "s"(sbase) : "memory"); }
#define PRE_PARAMS u32x4& p0, u32x4& p1, u32x4& p2, u32x4& p3, u32x2& e0, u32x2& e1, u32x2& e2, u32x2& e3, u32x2& e4, u32x2& e5, u32x2& e6, u32x2& e7, u32x2& e8, u32x2& e9, u32x2& e10, u32x2& e11, u32x2& e12, u32x2& e13, u32x2& e14, u32x2& e15
#define PRE_CPARAMS const u32x4& p0, const u32x4& p1, const u32x4& p2, const u32x4& p3, const u32x2& e0, const u32x2& e1, const u32x2& e2, const u32x2& e3, const u32x2& e4, const u32x2& e5, const u32x2& e6, const u32x2& e7, const u32x2& e8, const u32x2& e9, const u32x2& e10, const u32x2& e11, const u32x2& e12, const u32x2& e13, const u32x2& e14, const u32x2& e15
#define PRE_ARGS p0, p1, p2, p3, e0, e1, e2, e3, e4, e5, e6, e7, e8, e9, e10, e11, e12, e13, e14, e15
template <bool NT> __device__ __forceinline__ void gld8x2s(u32x2& r0, u32x2& r1, const void* sbase, unsigned voff) {
    if (NT) asm volatile("global_load_dwordx2 %0, %2, %3 nt\n\tglobal_load_dwordx2 %1, %2, %3 offset:128 nt" : "=&v"(r0), "=&v"(r1) : "v"(voff), "s"(sbase) : "memory");
    else    asm volatile("global_load_dwordx2 %0, %2, %3\n\tglobal_load_dwordx2 %1, %2, %3 offset:128" : "=&v"(r0), "=&v"(r1) : "v"(voff), "s"(sbase) : "memory"); }
#define GWAITE8(n, a, b, c, d, e, f, g, h) asm volatile("s_waitcnt vmcnt(" #n ")" : "+v"(a), "+v"(b), "+v"(c), "+v"(d), "+v"(e), "+v"(f), "+v"(g), "+v"(h) :: "memory")
__device__ __forceinline__ void unpack8_fp8(const u32x2& w, float sc, f32x4& v0, f32x4& v1) {
    const f32x2 a = __builtin_amdgcn_cvt_pk_f32_fp8((int)w.x, false), b = __builtin_amdgcn_cvt_pk_f32_fp8((int)w.x, true), c = __builtin_amdgcn_cvt_pk_f32_fp8((int)w.y, false), d = __builtin_amdgcn_cvt_pk_f32_fp8((int)w.y, true);
    v0 = (f32x4){a[0], a[1], b[0], b[1]} * sc; v1 = (f32x4){c[0], c[1], d[0], d[1]} * sc; }
#define GWAITN4(n, a, b, c, d) asm volatile("s_waitcnt vmcnt(" #n ")" : "+v"(a), "+v"(b), "+v"(c), "+v"(d) :: "memory")
#define GWAITN8(n, q) asm volatile("s_waitcnt vmcnt(" #n ")" : "+v"(q[0]), "+v"(q[1]), "+v"(q[2]), "+v"(q[3]), "+v"(q[4]), "+v"(q[5]), "+v"(q[6]), "+v"(q[7]) :: "memory")
#define GWAIT4F(a, b, c, d) asm volatile("s_waitcnt vmcnt(0)" : "+v"(a), "+v"(b), "+v"(c), "+v"(d) :: "memory")
#define GWAIT4U(a, b, c, d) asm volatile("s_waitcnt vmcnt(0)" : "+v"(a), "+v"(b), "+v"(c), "+v"(d) :: "memory")
#ifdef EPI_NT_INPROJ
#define EPI_ST_IN(T, addr, val) __builtin_nontemporal_store((val), (T*)(addr))
#else
#define EPI_ST_IN(T, addr, val) (*(T*)(addr) = (val))
#endif
struct EpiInproj {
    static constexpr bool PERM = true;
    static constexpr int DBGID = 0;
    static constexpr int NPRE = 4, NVM = 16;
    unsigned char* ws; int layer;
    __device__ __forceinline__ void prefetch(PRE_PARAMS, const Unit& u, int wr, int wc, int fr, int fq) const {
        gld16x4s(p0, p1, p2, p3, ws + biasoff(layer), (unsigned)(u.pn * BM + wc * 32 + 8 * fq) * 4u); }
    template <int KIND> __device__ __forceinline__ void tile(const f32x4 (&acc)[2][2][4][2], const Unit& u, int wr, int wc, int fr, int fq, unsigned char* w, const f32x4 (&bv)[2][2]) const {
        const int row0 = u.pm * BM + wr * 64 + fr, bcol0 = u.pn * BM + wc * 32 + 8 * fq;
        f32x4 lbv[2][2];
        if (KIND == 4) { const float* lb = (const float*)(w + WS_MISC) + layer * 512;
#pragma unroll
            for (int bj = 0; bj < 2; ++bj)
#pragma unroll
                for (int n = 0; n < 2; ++n) gld16(lbv[bj][n], lb + (bcol0 - 2048) + bj * HALF + 4 * n);
            GWAIT4F(lbv[0][0], lbv[0][1], lbv[1][0], lbv[1][1]); }
#pragma unroll
        for (int ai = 0; ai < 2; ++ai)
#pragma unroll
            for (int m = 0; m < 4; ++m) { const size_t row = (size_t)(row0 + ai * HALF + m * 16);
#pragma unroll
                for (int bj = 0; bj < 2; ++bj) { f32x4 v0 = acc[ai][bj][m][0] + bv[bj][0], v1 = acc[ai][bj][m][1] + bv[bj][1]; const int col = bcol0 + bj * HALF;
                    if (KIND == 0) { EPI_ST_IN(u32x4, (bf16_t*)(w + WS_QO) + row * 1024 + col, pack8(v0 * C2, v1 * C2)); }
                    else if (KIND == 1) { EPI_ST_IN(u32x4, (bf16_t*)(w + WS_KV) + row * 1024 + (col - 512), pack8(v0, v1)); }
                    else if (KIND == 2) { EPI_ST_IN(u32x4, (bf16_t*)(w + WS_KV) + row * 1024 + 512 + (col - 1024), pack8(v0, v1)); }
                    else if (KIND == 3) { EPI_ST_IN(u32x4, (bf16_t*)(w + WS_HB) + row * 1024 + (col - 1536), pack8(v0 * sig4(v0), v1 * sig4(v1))); }
                    else if (KIND == 4) { const int c = col - 2048; const f32x4 l0 = lbv[bj][0], l1 = lbv[bj][1];
                        f32x4 f0 = l0 + (1.f - l0) * sig4(v0), f1 = l1 + (1.f - l1) * sig4(v1);
#pragma unroll
                        for (int q = 0; q < 4; ++q) { f0[q] = __builtin_amdgcn_logf(f0[q]); f1[q] = __builtin_amdgcn_logf(f1[q]); }
                        float* LOGF = (float*)(w + WS_LOGF); EPI_ST_IN(f32x4, LOGF + row * 512 + c, f0); EPI_ST_IN(f32x4, LOGF + row * 512 + c + 4, f1); }
                    else if (KIND == 5) { EPI_ST_IN(u32x4, (bf16_t*)(w + WS_HB) + row * 1024 + 512 + (col - 2560), pack8(v0, v1)); }
                    else if (KIND == 6) { EPI_ST_IN(u32x4, (bf16_t*)(w + WS_HG) + row * 512 + (col - 3072), pack8(v0 * sig4(v0), v1 * sig4(v1))); }
                    else { f32x4 t0 = acc[ai][bj][m][0] * (-LOG2E) + bv[bj][0] * (-LOG2E), t1 = acc[ai][bj][m][1] * (-LOG2E) + bv[bj][1] * (-LOG2E);
#pragma unroll
                        for (int q = 0; q < 4; ++q) { t0[q] = __builtin_amdgcn_exp2f(t0[q]); t1[q] = __builtin_amdgcn_exp2f(t1[q]); }
                        t0 = t0 + 1.0f; t1 = t1 + 1.0f;
#pragma unroll
                        for (int q = 0; q < 4; ++q) { t0[q] = __builtin_amdgcn_rcpf(t0[q]); t1[q] = __builtin_amdgcn_rcpf(t1[q]); }
                        EPI_ST_IN(u32x2, (unsigned char*)(w + WS_G) + row * 2048 + (col - 3584), pack8_fp8(t0 * SC_G, t1 * SC_G)); }
                } }
    }
    __device__ __forceinline__ void operator()(const f32x4 (&acc)[2][2][4][2], const Unit& u, int wr, int wc, int fr, int fq, PRE_CPARAMS) const {
        f32x4 pre[2][2]; pre[0][0] = __builtin_bit_cast(f32x4, p0); pre[0][1] = __builtin_bit_cast(f32x4, p1); pre[1][0] = __builtin_bit_cast(f32x4, p2); pre[1][1] = __builtin_bit_cast(f32x4, p3);
        size_t z_ = 0; asm volatile("" : "+s"(z_)); unsigned char* w = ws + z_;
        const int ct = u.pn;
        if (ct < 2) tile<0>(acc, u, wr, wc, fr, fq, w, pre); else if (ct < 4) tile<1>(acc, u, wr, wc, fr, fq, w, pre); else if (ct < 6) tile<2>(acc, u, wr, wc, fr, fq, w, pre);
        else if (ct < 8) tile<3>(acc, u, wr, wc, fr, fq, w, pre); else if (ct < 10) tile<4>(acc, u, wr, wc, fr, fq, w, pre); else if (ct < 12) tile<5>(acc, u, wr, wc, fr, fq, w, pre);
        else if (ct < 14) tile<6>(acc, u, wr, wc, fr, fq, w, pre); else tile<7>(acc, u, wr, wc, fr, fq, w, pre);
    }
};
template <int MODE> struct EpiGate {
    static constexpr bool PERM = true;
    static constexpr int DBGID = 1 + MODE;
    static constexpr int NPRE = (MODE == 0) ? 4 : 16, NVM = 16;
    bf16_t* O; const float* bias; const unsigned char* G8; const unsigned char* P8; float osc;
    __device__ __forceinline__ void group(const f32x4 (&acc)[2][2][4][2], int g, int row0, int col0, const u32x2& g00, const u32x2& g01, const u32x2& g10, const u32x2& g11, const u32x2& q00, const u32x2& q01, const u32x2& q10, const u32x2& q11) const {
        const int ai = g >> 1;
#pragma unroll
        for (int mm = 0; mm < 2; ++mm)
#pragma unroll
            for (int bj = 0; bj < 2; ++bj) { const int m = (g & 1) * 2 + mm; const size_t row = (size_t)(row0 + ai * HALF + m * 16); const int col = col0 + bj * HALF;
                f32x4 v0 = acc[ai][bj][m][0], v1 = acc[ai][bj][m][1];
                f32x4 g0, g1; unpack8_fp8(mm ? (bj ? g11 : g10) : (bj ? g01 : g00), SC_U / SC_G, g0, g1); v0 *= g0; v1 *= g1;
                if (MODE == 2) { f32x4 q0, q1; unpack8_fp8(mm ? (bj ? q11 : q10) : (bj ? q01 : q00), 1.f, q0, q1); v0 += q0; v1 += q1; }
                *(u32x2*)((unsigned char*)O + row * 1024 + col) = pack8_fp8(v0, v1); }
    }
    __device__ __forceinline__ unsigned goff(int row0, int col0, int g, int mm) const { return (unsigned)(row0 + (g >> 1) * HALF + ((g & 1) * 2 + mm) * 16) * 2048u + (unsigned)col0; }
    __device__ __forceinline__ unsigned poff(int row0, int col0, int g, int mm) const { return (unsigned)(row0 + (g >> 1) * HALF + ((g & 1) * 2 + mm) * 16) * 1024u + (unsigned)col0; }
    __device__ __forceinline__ void prefetch(PRE_PARAMS, const Unit& u, int wr, int wc, int fr, int fq) const {
        const int row0 = u.pm * BM + wr * 64 + fr, col0 = u.pn * BM + wc * 32 + 8 * fq;
        if (MODE == 0) gld16x4s(p0, p1, p2, p3, bias, (unsigned)col0 * 4u);
        else if (MODE == 1) {
            gld8x2s<false>(e0, e1, G8, goff(row0, col0, 0, 0)); gld8x2s<false>(e2, e3, G8, goff(row0, col0, 0, 1)); gld8x2s<false>(e4, e5, G8, goff(row0, col0, 1, 0)); gld8x2s<false>(e6, e7, G8, goff(row0, col0, 1, 1));
            gld8x2s<false>(e8, e9, G8, goff(row0, col0, 2, 0)); gld8x2s<false>(e10, e11, G8, goff(row0, col0, 2, 1)); gld8x2s<false>(e12, e13, G8, goff(row0, col0, 3, 0)); gld8x2s<false>(e14, e15, G8, goff(row0, col0, 3, 1));
        } else {
            gld8x2s<false>(e0, e1, G8, goff(row0, col0, 0, 0)); gld8x2s<false>(e2, e3, G8, goff(row0, col0, 0, 1)); gld8x2s<false>(e4, e5, G8, goff(row0, col0, 1, 0)); gld8x2s<false>(e6, e7, G8, goff(row0, col0, 1, 1));
            gld8x2s<false>(e8, e9, G8, goff(row0, col0, 2, 0)); gld8x2s<false>(e10, e11, G8, goff(row0, col0, 2, 1)); gld8x2s<false>(e12, e13, G8, goff(row0, col0, 3, 0)); gld8x2s<false>(e14, e15, G8, goff(row0, col0, 3, 1));
        }
    }
    __device__ __forceinline__ void operator()(const f32x4 (&acc)[2][2][4][2], const Unit& u, int wr, int wc, int fr, int fq, PRE_CPARAMS) const {
        const int row0 = u.pm * BM + wr * 64 + fr, col0 = u.pn * BM + wc * 32 + 8 * fq;
        if (MODE == 0) {
            f32x4 bv[2][2]; bv[0][0] = __builtin_bit_cast(f32x4, p0); bv[0][1] = __builtin_bit_cast(f32x4, p1); bv[1][0] = __builtin_bit_cast(f32x4, p2); bv[1][1] = __builtin_bit_cast(f32x4, p3);
#pragma unroll
            for (int ai = 0; ai < 2; ++ai)
#pragma unroll
                for (int m = 0; m < 4; ++m)
#pragma unroll
                    for (int bj = 0; bj < 2; ++bj) { const size_t row = (size_t)(row0 + ai * HALF + m * 16); const int col = col0 + bj * HALF;
                        const f32x4 v0 = acc[ai][bj][m][0] + bv[bj][0], v1 = acc[ai][bj][m][1] + bv[bj][1];
                        if (osc != 0.f) *(u32x2*)((unsigned char*)O + row * 1024 + col) = pack8_fp8(v0 * osc, v1 * osc);
                        else *(u32x4*)(O + row * 1024 + col) = pack8(v0, v1); }
        } else if (MODE == 1) {
            group(acc, 0, row0, col0, e0, e1, e2, e3, e0, e0, e0, e0); group(acc, 1, row0, col0, e4, e5, e6, e7, e0, e0, e0, e0);
            group(acc, 2, row0, col0, e8, e9, e10, e11, e0, e0, e0, e0); group(acc, 3, row0, col0, e12, e13, e14, e15, e0, e0, e0, e0);
        } else {
            u32x2 a0, a1, a2, a3, a4, a5, a6, a7, b0, b1, b2, b3, b4, b5, b6, b7;
            gld8x2s<true>(a0, a1, P8, poff(row0, col0, 0, 0)); gld8x2s<true>(a2, a3, P8, poff(row0, col0, 0, 1)); gld8x2s<true>(a4, a5, P8, poff(row0, col0, 1, 0)); gld8x2s<true>(a6, a7, P8, poff(row0, col0, 1, 1));
            gld8x2s<true>(b0, b1, P8, poff(row0, col0, 2, 0)); gld8x2s<true>(b2, b3, P8, poff(row0, col0, 2, 1)); gld8x2s<true>(b4, b5, P8, poff(row0, col0, 3, 0)); gld8x2s<true>(b6, b7, P8, poff(row0, col0, 3, 1));
            GWAITN4(12, a0, a1, a2, a3); group(acc, 0, row0, col0, e0, e1, e2, e3, a0, a1, a2, a3);
            GWAITN4(12, a4, a5, a6, a7); group(acc, 1, row0, col0, e4, e5, e6, e7, a4, a5, a6, a7);
            GWAITN4(12, b0, b1, b2, b3); group(acc, 2, row0, col0, e8, e9, e10, e11, b0, b1, b2, b3);
            GWAITN4(12, b4, b5, b6, b7); group(acc, 3, row0, col0, e12, e13, e14, e15, b4, b5, b6, b7);
        }
    }
};
struct EpiUp {
    static constexpr bool PERM = true;
    static constexpr int DBGID = 4;
    static constexpr int NPRE = 0, NVM = 8;
    bf16_t* H;
    __device__ __forceinline__ void prefetch(PRE_PARAMS, const Unit&, int, int, int, int) const {}
    __device__ __forceinline__ void operator()(const f32x4 (&acc)[2][2][4][2], const Unit& u, int wr, int wc, int fr, int fq, PRE_CPARAMS) const {
        const int row0 = u.pm * BM + wr * 64 + fr, col = u.pn * HALF + wc * 32 + 8 * fq;
#pragma unroll
        for (int ai = 0; ai < 2; ++ai)
#pragma unroll
            for (int m = 0; m < 4; ++m) { const size_t row = (size_t)(row0 + ai * HALF + m * 16);
                const f32x4 a0 = acc[ai][0][m][0], a1 = acc[ai][0][m][1], b0 = acc[ai][1][m][0], b1 = acc[ai][1][m][1];
                *(u32x2*)((unsigned char*)H + row * 1024 + col) = pack8_fp8(a0 * sig4(a0) * b0 * SC_H, a1 * sig4(a1) * b1 * SC_H); }
    }
};

__device__ __forceinline__ void glds16s(const char* sbase, unsigned voff, unsigned lds_dst) {
    unsigned keep;
    asm volatile("s_mov_b32 %0, m0\n\ts_mov_b32 m0, %3\n\ts_nop 0\n\tglobal_load_lds_dwordx4 %1, %2\n\ts_mov_b32 m0, %0" : "=&s"(keep) : "v"(voff), "s"(sbase), "s"(lds_dst) : "memory");
}
template <class Epi, class Sched, bool ALIGN_EPI>
__device__ __forceinline__ void gemm_phase(LAS unsigned char* lds, const Gemm g, const Sched& S, const Epi& E, const int tid) {
    const int wid = __builtin_amdgcn_readfirstlane(tid >> 6), lane = tid & 63, wr = wid >> 2, wc = wid & 3, fr = lane & 15, fq = lane >> 4;
    int K = g.K; asm volatile("" : "+s"(K));
    const int nt = K / BK;
    int RA[2], CA[2]; unsigned voffB[2];
#pragma unroll
    for (int i = 0; i < 2; ++i) { int R, C; stage_rc(tid * 16 + i * 8192, R, C); const int Rb = Epi::PERM ? ((R & ~31) + perm32(R & 31)) : R;
        RA[i] = R; CA[i] = C; voffB[i] = (unsigned)(Rb * g.ldb + C) * 2u; }
    const size_t kstep = (size_t)(BK * 2);
    const size_t hstepB = (size_t)HALF * g.ldb * 2;
    const unsigned ldsw = (unsigned)wid * 1024u;
    const unsigned ldsb = (unsigned)__builtin_amdgcn_readfirstlane((int)((unsigned)(uintptr_t)lds + ldsw));
    const int aoff = lds_byte(wr * 64 + fr, fq * 8), boff = lds_byte(wc * 32 + fr, fq * 8);
#define PG8_SA(b, h) (((b) * 2 + (h)) * HTB)
#define PG8_SB(b, h) ((4 + (b) * 2 + (h)) * HTB)
#define PG8_STAGE(bufoff, gbase, voff) do { _Pragma("unroll") for (int _i = 0; _i < 2; ++_i) glds16s((const char*)(gbase), (voff)[_i], ldsb + (unsigned)((bufoff) + _i * 8192)); } while (0)
#define PG8_LD8(p) __builtin_shufflevector(*(const LAS v4i*)(p), *(const LAS v4i*)((p) + 1024), 0, 1, 2, 3, 4, 5, 6, 7)
#define PG8_LDA(dst, b, h) do { _Pragma("unroll") for (int m = 0; m < 4; ++m) dst[m] = PG8_LD8(lds + PG8_SA(b, h) + aoff + m * 2048); } while (0)
#define PG8_LDB(dst, b, h) do { _Pragma("unroll") for (int n = 0; n < 2; ++n) dst[n] = PG8_LD8(lds + PG8_SB(b, h) + boff + n * 2048); } while (0)
#ifndef PG8_PRIO
#define PG8_PRIO 1
#endif
#define PG8_MMA(ai, bj, At, Bt) do { if (PG8_PRIO) __builtin_amdgcn_s_setprio(1); _Pragma("unroll") for (int m = 0; m < 4; ++m) _Pragma("unroll") for (int n = 0; n < 2; ++n) \
        asm volatile("v_mfma_scale_f32_16x16x128_f8f6f4 %0, %1, %2, %0, %3, %4 op_sel_hi:[0,0,0]" : "+v"(acc[ai][bj][m][n]) : "v"(Bt[n]), "v"(At[m]), "v"(sbv), "v"(sav)); \
        if (PG8_PRIO) __builtin_amdgcn_s_setprio(0); } while (0)
#define PG8_WAIT_V(n) asm volatile("s_waitcnt vmcnt(" #n ")" ::: "memory")
#define PG8_WAIT_VS(n) do { const int n_ = (n); if (n_ == 12) PG8_WAIT_V(12); else if (n_ == 16) PG8_WAIT_V(16); else if (n_ == 20) PG8_WAIT_V(20); else if (n_ == 24) PG8_WAIT_V(24); else if (n_ == 28) PG8_WAIT_V(28); else PG8_WAIT_V(8); } while (0)
#define PG8_WAIT_VN(n) do { const int n_ = (n); if (n_ == 10) PG8_WAIT_V(10); else if (n_ == 14) PG8_WAIT_V(14); else if (n_ == 16) PG8_WAIT_V(16); else if (n_ == 20) PG8_WAIT_V(20); else if (n_ == 22) PG8_WAIT_V(22); else if (n_ == 24) PG8_WAIT_V(24); else if (n_ == 28) PG8_WAIT_V(28); else PG8_WAIT_V(6); } while (0)
#define PG8_WAIT_L(n) asm volatile("s_waitcnt lgkmcnt(" #n ")" ::: "memory")
#define PG8_BAR __builtin_amdgcn_s_barrier()
#ifdef DBG_SEG
#ifndef DBG_SEG_WAVE
#define DBG_SEG_WAVE 0
#endif
#define SEG_ME ((Epi::DBGID == DBG_SEG_SEL) && blockIdx.x == 0 && wid == DBG_SEG_WAVE)
#define SEG_BEGIN(k, cond) do { if ((k) == DBG_SEG && SEG_ME && (cond)) { asm volatile("s_memtime %0\n\ts_waitcnt lgkmcnt(0)" : "=s"(seg_t0) :: "memory"); } } while (0)
#define SEG_END(k, cond) do { if ((k) == DBG_SEG && SEG_ME && (cond)) { unsigned long long t1_; asm volatile("s_memtime %0\n\ts_waitcnt lgkmcnt(0)" : "=s"(t1_) :: "memory"); seg_sum += t1_ - seg_t0; seg_cnt += 1; } } while (0)
#else
#define SEG_BEGIN(k, cond) do {} while (0)
#define SEG_END(k, cond) do {} while (0)
#endif
#ifndef PG8_NOSCHED
#define PG8_SCHED __builtin_amdgcn_sched_barrier(0)
#else
#define PG8_SCHED do {} while (0)
#endif
    Unit cur, nxt; int ui = 0;
    if (!S.next(0, cur)) return;
#ifdef DBG_SEG
    unsigned long long seg_t0 = 0, seg_sum = 0; unsigned seg_cnt = 0;
#endif
    u32x4 p0 = {0u, 0u, 0u, 0u}, p1 = p0, p2 = p0, p3 = p0;
    u32x2 e0 = {0u, 0u}, e1 = e0, e2 = e0, e3 = e0, e4 = e0, e5 = e0, e6 = e0, e7 = e0, e8 = e0, e9 = e0, e10 = e0, e11 = e0, e12 = e0, e13 = e0, e14 = e0, e15 = e0;
    f32x4 acc[2][2][4][2];
#pragma unroll
    for (int a = 0; a < 2; ++a)
#pragma unroll
        for (int b = 0; b < 2; ++b)
#pragma unroll
            for (int m = 0; m < 4; ++m)
#pragma unroll
                for (int n = 0; n < 2; ++n) acc[a][b][m][n] = (f32x4){0.f, 0.f, 0.f, 0.f};
    int sav = g.sa, sbv = g.sb;
    v8i At[4], B0[2], B1[2];
    unsigned vA[2][2], nvA[2][2];
    S.a_voff(g, cur, 0, RA, CA, vA);
    const char* cA = S.a_tile(g, cur); const char* cB = S.b_tile(g, cur);
#if PG8_SPFORM
    PG8_STAGE(PG8_SB(0, 0), cB, voffB); PG8_STAGE(PG8_SB(0, 1), cB + hstepB, voffB); PG8_STAGE(PG8_SA(0, 0), cA, vA[0]); PG8_STAGE(PG8_SA(0, 1), cA, vA[1]);
    if (wr == 1) PG8_BAR;
    PG8_WAIT_V(2); PG8_BAR;
#else
    PG8_STAGE(PG8_SB(0, 0), cB, voffB); PG8_STAGE(PG8_SA(0, 0), cA, vA[0]); PG8_STAGE(PG8_SB(0, 1), cB + hstepB, voffB); PG8_STAGE(PG8_SA(0, 1), cA, vA[1]);
    if (wr == 1) PG8_BAR;
    PG8_WAIT_V(4); PG8_BAR;
#endif
    PG8_STAGE(PG8_SB(1, 0), cB + kstep, voffB); PG8_STAGE(PG8_SA(1, 0), cA + kstep, vA[0]); PG8_STAGE(PG8_SB(1, 1), cB + hstepB + kstep, voffB);
    PG8_WAIT_V(6); PG8_BAR;
    for (;;) {
        const bool has_next = S.next(ui + 1, nxt);
        const char* nA = has_next ? S.a_tile(g, nxt) : cA; const char* nB = has_next ? S.b_tile(g, nxt) : cB;
        if constexpr (Sched::GATHER) {
            if (has_next) { int RA2[2], CA2[2];
#pragma unroll
                for (int i = 0; i < 2; ++i) { int tq = tid; asm volatile("" : "+v"(tq)); stage_rc(tq * 16 + i * 8192, RA2[i], CA2[i]); }
                S.a_voff(g, nxt, ui + 1, RA2, CA2, nvA); }
            else {
#pragma unroll
                for (int h = 0; h < 2; ++h)
#pragma unroll
                    for (int i = 0; i < 2; ++i) nvA[h][i] = vA[h][i]; }
        }
#ifdef DBG_CLK
#ifdef DBG_CLK_SKIP1
#define DBG_CLK_SKIPN 2
#else
#define DBG_CLK_SKIPN 0
#endif
        const bool dbg_me_ = (Epi::DBGID == DBG_CLK_SEL) && blockIdx.x == 0 && wid == 0;
        unsigned long long dc0_ = 0, dr0_ = 0; if (dbg_me_) { dc0_ = __builtin_amdgcn_s_memtime(); dr0_ = __builtin_amdgcn_s_memrealtime(); }
#endif
#if PG8_SPFORM
        for (int t = 0; t < nt; t += 2) {
            const bool last = (t == nt - 2);
            const int xs = (ui > 0 && t == 0) ? Epi::NVM : 0, xp = (last && Epi::NPRE) ? Epi::NPRE : 0;
            const char* a1 = cA + (size_t)(t + 1) * kstep;
            const char* a2 = last ? nA : cA + (size_t)(t + 2) * kstep; const char* b2 = last ? nB : cB + (size_t)(t + 2) * kstep;
            const char* a3 = a2 + kstep; const char* b3 = b2 + kstep;
            unsigned wA0[2], wA1[2];
#pragma unroll
            for (int i = 0; i < 2; ++i) { if constexpr (Sched::GATHER) { wA0[i] = last ? nvA[0][i] : vA[0][i]; wA1[i] = last ? nvA[1][i] : vA[1][i]; } else { wA0[i] = vA[0][i]; wA1[i] = vA[1][i]; } }
            PG8_LDB(B0, 0, 0); PG8_LDB(B1, 0, 1); PG8_SCHED; PG8_LDA(At, 0, 0); PG8_STAGE(PG8_SA(1, 1), a1, vA[1]);
            if (Epi::NPRE) { if (last) E.prefetch(PRE_ARGS, cur, wr, wc, fr, fq); }
            PG8_WAIT_VS(8 + xs + xp); PG8_WAIT_L(0); PG8_BAR; PG8_MMA(0, 0, At, B0); PG8_MMA(0, 1, At, B1); PG8_BAR; PG8_SCHED;
            PG8_LDA(At, 0, 1); PG8_STAGE(PG8_SB(0, 0), b2, voffB); PG8_STAGE(PG8_SB(0, 1), b2 + hstepB, voffB); PG8_STAGE(PG8_SA(0, 0), a2, wA0);
            PG8_WAIT_VS(8 + xs + xp); PG8_WAIT_L(0); PG8_BAR; PG8_MMA(1, 0, At, B0); PG8_MMA(1, 1, At, B1); PG8_BAR; PG8_SCHED;
            PG8_LDB(B0, 1, 0); PG8_LDB(B1, 1, 1); PG8_SCHED; PG8_LDA(At, 1, 0); PG8_STAGE(PG8_SA(0, 1), a2, wA1);
            PG8_WAIT_VS(8 + xp); PG8_WAIT_L(0); PG8_BAR; PG8_MMA(0, 0, At, B0); PG8_MMA(0, 1, At, B1); PG8_BAR; PG8_SCHED;
            PG8_LDA(At, 1, 1); PG8_STAGE(PG8_SB(1, 0), b3, voffB); PG8_STAGE(PG8_SB(1, 1), b3 + hstepB, voffB); PG8_STAGE(PG8_SA(1, 0), a3, wA0);
            PG8_WAIT_V(8); PG8_WAIT_L(0); PG8_BAR; PG8_MMA(1, 0, At, B0); PG8_MMA(1, 1, At, B1); PG8_BAR; PG8_SCHED;
        }
        SEG_BEGIN(1, true);
#else
        for (int t = 0; t < nt; t += 2) {
            const bool last = (t == nt - 2), first = (ui > 0 && t == 0);
            SEG_END(3, first); SEG_BEGIN(4, first); SEG_BEGIN(7, first); SEG_BEGIN(8, t >= 2);
#if defined(DBG_CLK) && defined(DBG_CLK_SKIP1)
            if (dbg_me_ && t == 2) { dc0_ = __builtin_amdgcn_s_memtime(); dr0_ = __builtin_amdgcn_s_memrealtime(); }
#endif
            const int xp = (last && Epi::NPRE) ? Epi::NPRE : 0;
            const char* a1 = cA + (size_t)(t + 1) * kstep;
            const char* a2 = last ? nA : cA + (size_t)(t + 2) * kstep; const char* b2 = last ? nB : cB + (size_t)(t + 2) * kstep;
            const char* a3 = a2 + kstep; const char* b3 = b2 + kstep;
            unsigned wA0[2], wA1[2];
#pragma unroll
            for (int i = 0; i < 2; ++i) { if constexpr (Sched::GATHER) { wA0[i] = last ? nvA[0][i] : vA[0][i]; wA1[i] = last ? nvA[1][i] : vA[1][i]; } else { wA0[i] = vA[0][i]; wA1[i] = vA[1][i]; } }
            PG8_LDB(B0, 0, 0); PG8_SCHED; PG8_LDA(At, 0, 0); PG8_STAGE(PG8_SA(1, 1), a1, vA[1]);
            if (Epi::NPRE) { if (last) E.prefetch(PRE_ARGS, cur, wr, wc, fr, fq); }
            PG8_WAIT_L(8); PG8_BAR; PG8_WAIT_L(0); SEG_END(4, first); PG8_MMA(0, 0, At, B0); PG8_BAR; PG8_SCHED;
            PG8_LDB(B1, 0, 1); PG8_STAGE(PG8_SB(0, 0), b2, voffB);
            PG8_BAR; PG8_WAIT_L(0); PG8_MMA(0, 1, At, B1); PG8_BAR;
            PG8_LDA(At, 0, 1); PG8_STAGE(PG8_SA(0, 0), a2, wA0);
            PG8_BAR; PG8_WAIT_L(0); PG8_MMA(1, 0, At, B0); PG8_BAR; PG8_SCHED;
            PG8_STAGE(PG8_SB(0, 1), b2 + hstepB, voffB);
            SEG_BEGIN(5, first); PG8_WAIT_VN(first ? 8 + Epi::NVM + xp : 6 + xp); SEG_END(5, first); PG8_BAR; PG8_MMA(1, 1, At, B1); PG8_BAR;
            PG8_LDB(B0, 1, 0); PG8_SCHED; PG8_LDA(At, 1, 0); PG8_STAGE(PG8_SA(0, 1), a2, wA1);
            PG8_WAIT_L(8); PG8_BAR; PG8_WAIT_L(0); PG8_MMA(0, 0, At, B0); PG8_BAR; PG8_SCHED;
            PG8_LDB(B1, 1, 1); PG8_STAGE(PG8_SB(1, 0), b3, voffB);
            SEG_BEGIN(6, first); if (first) PG8_WAIT_VN(10 + xp); SEG_END(6, first);
            PG8_BAR; PG8_WAIT_L(0); PG8_MMA(0, 1, At, B1); PG8_BAR;
            PG8_LDA(At, 1, 1); PG8_STAGE(PG8_SA(1, 0), a3, wA0);
            PG8_BAR; PG8_WAIT_L(0); PG8_MMA(1, 0, At, B0); PG8_BAR; PG8_SCHED;
            PG8_STAGE(PG8_SB(1, 1), b3 + hstepB, voffB);
            PG8_WAIT_V(6); PG8_BAR; PG8_MMA(1, 1, At, B1); PG8_BAR;
            SEG_END(7, first); SEG_END(8, t >= 2);
        }
        SEG_BEGIN(1, true);
#endif
#ifdef DBG_CLK
        if (dbg_me_) { const unsigned long long dc1_ = __builtin_amdgcn_s_memtime(), dr1_ = __builtin_amdgcn_s_memrealtime();
            if (lane == 0) { volatile LAS unsigned long long* d_ = (volatile LAS unsigned long long*)(lds + 131072 + 512); d_[0] = d_[0] + (dc1_ - dc0_); d_[1] = d_[1] + (dr1_ - dr0_); d_[2] = d_[2] + (unsigned long long)(nt - DBG_CLK_SKIPN); } }
#endif
        if constexpr (ALIGN_EPI) { if (wr == 0) PG8_BAR; }
        asm volatile("s_nop 15\n\ts_nop 15" ::: "memory");
        if (Epi::NPRE == 4) asm volatile("" : "+v"(p0), "+v"(p1), "+v"(p2), "+v"(p3));
        if (Epi::NPRE == 16) { asm volatile("" : "+v"(e0), "+v"(e1), "+v"(e2), "+v"(e3), "+v"(e4), "+v"(e5), "+v"(e6), "+v"(e7)); asm volatile("" : "+v"(e8), "+v"(e9), "+v"(e10), "+v"(e11), "+v"(e12), "+v"(e13), "+v"(e14), "+v"(e15)); }
        SEG_END(1, true); SEG_BEGIN(2, true);
        E(acc, cur, wr, wc, fr, fq, PRE_ARGS);
        SEG_END(2, true); SEG_BEGIN(3, true);
        if (!has_next) break;
#pragma unroll
        for (int a = 0; a < 2; ++a)
#pragma unroll
            for (int b = 0; b < 2; ++b)
#pragma unroll
                for (int m = 0; m < 4; ++m)
#pragma unroll
                    for (int n = 0; n < 2; ++n) acc[a][b][m][n] = (f32x4){0.f, 0.f, 0.f, 0.f};
        cur = nxt; cA = nA; cB = nB; ++ui;
        if constexpr (Sched::GATHER) {
#pragma unroll
            for (int h = 0; h < 2; ++h)
#pragma unroll
                for (int i = 0; i < 2; ++i) vA[h][i] = nvA[h][i]; }
        if constexpr (ALIGN_EPI) { if (wr == 1) PG8_BAR; }
    }
#ifdef DBG_SEG
    if (SEG_ME && lane == 0) { volatile LAS unsigned long long* d_ = (volatile LAS unsigned long long*)(lds + 131072 + 512); d_[4] = d_[4] + seg_sum; d_[5] = d_[5] + seg_cnt; }
#endif
    PG8_WAIT_V(0);
    if constexpr (!ALIGN_EPI) { if (wr == 0) PG8_BAR; }
    PG8_BAR;
#undef PG8_SA
#undef PG8_SB
#undef PG8_STAGE
#undef PG8_LDA
#undef PG8_LDB
#undef PG8_MMA
#undef PG8_LD8
#undef PG8_WAIT_V
#undef PG8_WAIT_VN
#undef PG8_WAIT_VS
#undef PG8_WAIT_L
#undef PG8_BAR
#undef PG8_SCHED
}
}


#include <hip/hip_bf16.h>
#include <cmath>
namespace attn_body {
using bf16=__hip_bfloat16;
using bf16x8=__attribute__((ext_vector_type(8)))short;
using s16x4=__attribute__((ext_vector_type(4)))short;
using f32x16=__attribute__((ext_vector_type(16)))float;
using u32x4=__attribute__((ext_vector_type(4)))unsigned;
constexpr int BATCH=16,NHEAD=8,SEQ=2048,D=64,DM=1024;
constexpr int NW=8,QBLK=32,QB=QBLK*NW,KVBLK=64,NQB=SEQ/QB;
constexpr int ATTN_PITCH=DM, ATTN_UNIT_ROWS=QB;
__device__ __forceinline__ int crow(int r,int hi){return (r&3)+8*(r>>2)+4*hi;}
#define SBAR() __builtin_amdgcn_sched_barrier(0)
__device__ __forceinline__ void cmask(f32x16&p0,f32x16&p1,int jb,int qrel,int hi){
  const float NEG=-INFINITY; int kb=64*jb+4*hi;
  #pragma unroll
  for(int r=0;r<16;++r){int kv=kb+(r&3)+8*(r>>2); if(kv>qrel)p0[r]=NEG; if(kv+32>qrel)p1[r]=NEG;}
}

constexpr int NSLOT=3, SLOTB=8192;
constexpr int LDS_K=0, LDS_V=NSLOT*SLOTB, LDS_WS=2*NSLOT*SLOTB, LDS_OST=LDS_WS+NW*64*4, LDS_BYTES=LDS_OST+NW*4096;
constexpr float C2=0.125f*1.4426950408889634f;
__device__ __forceinline__ void glds16(const void*gsrc,unsigned lds_dst){unsigned keep;
  asm volatile("s_mov_b32 %0, m0\n\ts_mov_b32 m0, %2\n\ts_nop 0\n\tglobal_load_lds_dwordx4 %1, off\n\ts_mov_b32 m0, %0":"=&s"(keep):"v"(gsrc),"s"(lds_dst):"memory");}
__device__ __forceinline__ float max3f(float a,float b,float c){float r;asm("v_max3_f32 %0, %1, %2, %3":"=v"(r):"v"(a),"v"(b),"v"(c));return r;}
__device__ __forceinline__ float max2f(float a,float b){float r;asm("v_max_f32_e32 %0, %1, %2":"=v"(r):"v"(a),"v"(b));return r;}
__device__ __forceinline__ float fadd_s(float a,float b){float r;asm("v_add_f32_e32 %0, %1, %2":"=v"(r):"v"(a),"v"(b));return r;}
__device__ __forceinline__ float fsub_s(float a,float b){float r;asm("v_sub_f32_e32 %0, %1, %2":"=v"(r):"v"(a),"v"(b));return r;}
typedef float f32x2_t __attribute__((ext_vector_type(2))); typedef __bf16 bf16x2_t __attribute__((ext_vector_type(2)));
__device__ __forceinline__ unsigned cvtpk_s(float lo,float hi){f32x2_t v={lo,hi};bf16x2_t b=__builtin_convertvector(v,bf16x2_t);return __builtin_bit_cast(unsigned,b);}
#define WAIT_BAR(N) asm volatile("s_waitcnt vmcnt(" #N ") lgkmcnt(0)\n\ts_barrier":::"memory")

__device__ __forceinline__ void qkt(f32x16&p0,f32x16&p1,const char*Kslot,const bf16x8*qr,const f32x16&negm,int r32,int hi){
  const char*kb=Kslot+hi*1024+r32*16;
  #pragma unroll
  for(int d0=0;d0<4;++d0){
    const bf16x8 b0=*reinterpret_cast<const bf16x8*>(kb+d0*2048);
    const bf16x8 b1=*reinterpret_cast<const bf16x8*>(kb+d0*2048+512);
    if(d0==0){p0=__builtin_amdgcn_mfma_f32_32x32x16_bf16(b0,qr[0],negm,0,0,0);p1=__builtin_amdgcn_mfma_f32_32x32x16_bf16(b1,qr[0],negm,0,0,0);}
    else{p0=__builtin_amdgcn_mfma_f32_32x32x16_bf16(b0,qr[d0],p0,0,0,0);p1=__builtin_amdgcn_mfma_f32_32x32x16_bf16(b1,qr[d0],p1,0,0,0);}}
}
typedef __attribute__((address_space(3))) const char* lds_cptr;
typedef short v4i16_t __attribute__((ext_vector_type(4)));
__device__ __forceinline__ void kload8(bf16x8*kf,lds_cptr kp){
  kf[0]=*(const __attribute__((address_space(3))) bf16x8*)(kp);      kf[1]=*(const __attribute__((address_space(3))) bf16x8*)(kp+512);
  kf[2]=*(const __attribute__((address_space(3))) bf16x8*)(kp+2048); kf[3]=*(const __attribute__((address_space(3))) bf16x8*)(kp+2560);
  kf[4]=*(const __attribute__((address_space(3))) bf16x8*)(kp+4096); kf[5]=*(const __attribute__((address_space(3))) bf16x8*)(kp+4608);
  kf[6]=*(const __attribute__((address_space(3))) bf16x8*)(kp+6144); kf[7]=*(const __attribute__((address_space(3))) bf16x8*)(kp+6656);
}
__device__ __forceinline__ void kload2(bf16x8*kf,lds_cptr kp,int j){ kf[2*j]=*(const __attribute__((address_space(3))) bf16x8*)(kp+j*2048); kf[2*j+1]=*(const __attribute__((address_space(3))) bf16x8*)(kp+j*2048+512); }
__device__ __forceinline__ s16x4 vtr(lds_cptr p){ return __builtin_bit_cast(s16x4,__builtin_amdgcn_ds_read_tr16_b64_v4i16((__attribute__((address_space(3))) v4i16_t*)p)); }
__device__ __forceinline__ float rowmax(const f32x16&p0,const f32x16&p1){
  float a=max3f(p0[0],p0[1],p1[0]),b=max3f(p0[2],p0[3],p1[1]);a=max3f(a,p1[2],p1[3]);
  #pragma unroll
  for(int r=4;r<16;r+=4){a=max3f(a,p0[r],p0[r+1]);b=max3f(b,p0[r+2],p0[r+3]);a=max3f(a,p1[r],p1[r+1]);b=max3f(b,p1[r+2],p1[r+3]);}
  const float m=max2f(a,b);
  auto rr=__builtin_amdgcn_permlane32_swap(__float_as_uint(m),__float_as_uint(m),false,false);
  return max2f(__uint_as_float(rr[0]),__uint_as_float(rr[1]));
}
__device__ __forceinline__ void pv(f32x16*o,int vb,bf16x8 pa0,bf16x8 pa1,bf16x8 pa2,bf16x8 pa3){
  #pragma unroll
  for(int d0=0;d0<2;++d0){s16x4 lo[4],hi[4];
    #pragma unroll
    for(int ks=0;ks<4;++ks){
      asm volatile("ds_read_b64_tr_b16 %0,%1 offset:%c2":"=&v"(lo[ks]):"v"(vb),"i"(d0*4096+ks*1024):"memory");
      asm volatile("ds_read_b64_tr_b16 %0,%1 offset:%c2":"=&v"(hi[ks]):"v"(vb),"i"(d0*4096+ks*1024+512):"memory");}
    asm volatile("s_waitcnt lgkmcnt(0)":::"memory");SBAR();
    #define PK(k) (bf16x8){lo[k][0],lo[k][1],lo[k][2],lo[k][3],hi[k][0],hi[k][1],hi[k][2],hi[k][3]}
    o[d0]=__builtin_amdgcn_mfma_f32_32x32x16_bf16(pa0,PK(0),o[d0],0,0,0);
    o[d0]=__builtin_amdgcn_mfma_f32_32x32x16_bf16(pa1,PK(1),o[d0],0,0,0);
    o[d0]=__builtin_amdgcn_mfma_f32_32x32x16_bf16(pa2,PK(2),o[d0],0,0,0);
    o[d0]=__builtin_amdgcn_mfma_f32_32x32x16_bf16(pa3,PK(3),o[d0],0,0,0);
    #undef PK
  }
}

#ifndef ATTN_STORE16
#define ATTN_STORE16(p,v) (*(u32x4*)(p)=(v))
#endif
template<int THRL> __device__ __forceinline__ void attn_unit(int b,int h,int qb,const bf16*Q,const bf16*__restrict__ K,const bf16*__restrict__ V,bf16*O,char*shm,const __attribute__((address_space(3))) float*f2,const int tid){
  #define BIAS_H(P,off,g0) { f32x4 x_[2]; _Pragma("unroll") for(int g_=0;g_<2;++g_) x_[g_]=*(const __attribute__((address_space(3))) f32x4*)(fb_+(off)+8*((g0)+g_)); \
      _Pragma("unroll") for(int g_=0;g_<2;++g_) _Pragma("unroll") for(int i_=0;i_<4;++i_) P[4*((g0)+g_)+i_]-=x_[g_][i_]; asm volatile("":::"memory"); }
  #define BIAS(P0,P1,t) do{ const __attribute__((address_space(3))) float* fb_=f2+64*(t)+4*hi; \
    BIAS_H(P0,0,0) BIAS_H(P0,0,2) BIAS_H(P1,32,0) BIAS_H(P1,32,2) }while(0)
  const int lane=tid&63,r32=lane&31,hi=lane>>5; const int wid=__builtin_amdgcn_readfirstlane(tid>>6);
  const long rowbase=(long)b*SEQ; const int q0=qb*QB;
  const bf16*Qw=Q+(rowbase+q0+wid*QBLK)*DM+h*D;
  const bf16*Kh=K+rowbase*DM+h*D,*Vh=V+rowbase*DM+h*D;
  const unsigned lds0=(unsigned)(uintptr_t)shm;
  float*wsf=(float*)(shm+LDS_WS)+wid*64;
  const bf16*ksrc=Kh+(long)lane*DM+wid*8;
  const bf16*vsrc=Vh+(long)(16*(wid&3)+(lane>>2))*DM+(wid>>2)*32+(lane&3)*8;
  const unsigned kdst=lds0+LDS_K+wid*1024, vdst=lds0+LDS_V+wid*1024;
  #define DMA_K(t,slot) glds16(ksrc+(long)(t)*KVBLK*DM,(unsigned)__builtin_amdgcn_readfirstlane(kdst+(slot)))
  #define DMA_V(t,slot) glds16(vsrc+(long)(t)*KVBLK*DM,(unsigned)__builtin_amdgcn_readfirstlane(vdst+(slot)))
  const int vb0=(int)(lds0+LDS_V)+((lane>>4)&1)*32+(lane&3)*8+(4*hi+((lane&15)>>2))*64;
  const char*Kbase=shm+LDS_K; bf16x8 kf[8];
  const lds_cptr shm3=(lds_cptr)shm; const lds_cptr kp0=shm3+LDS_K+hi*1024+r32*16; const lds_cptr vp0=shm3+LDS_V+((lane>>4)&1)*32+(lane&3)*8+(4*hi+((lane&15)>>2))*64;
  const int NT=(q0+QB)/KVBLK;
  DMA_K(0,0);DMA_V(0,0);DMA_K(1,SLOTB);
  bf16x8 qr[4];
  #pragma unroll
  for(int d0=0;d0<4;++d0)qr[d0]=*reinterpret_cast<const bf16x8*>(&Qw[(long)r32*DM+d0*16+hi*8]);
  float mhat=0.f,l_reg=0.f;f32x16 o[2];f32x16 negm; { float z_=0.f; asm volatile("":"+v"(z_)); _Pragma("unroll") for(int r=0;r<16;++r){o[0][r]=z_;o[1][r]=z_;negm[r]=z_;} } asm volatile("":"+v"(negm));
  const int qrel=wid*QBLK+r32;
  #define CMASK(P0,P1,t) do{int jb_=(t)-(NT-4); if(jb_>=0)cmask(P0,P1,jb_,qrel,hi);}while(0)
  bool resc=false;
  #define START(P0,P1) do{ const float rm=rowmax(P0,P1); resc=false; \
    { const float dl=rm; mhat=fadd_s(mhat,dl); \
      _Pragma("unroll") for(int r=0;r<16;++r){P0[r]=fsub_s(P0[r],dl);P1[r]=fsub_s(P1[r],dl);} \
      _Pragma("unroll") for(int r=0;r<16;++r)negm[r]=-mhat; asm volatile("":"+v"(negm)); } \
    _Pragma("unroll") for(int r=0;r<16;++r)P0[r]=__builtin_amdgcn_exp2f(P0[r]); }while(0)
  #define RESC() do{ if(resc){ asm volatile("s_waitcnt lgkmcnt(0)":::"memory"); \
      _Pragma("unroll") for(int d_=0;d_<2;++d_) _Pragma("unroll") for(int r=0;r<16;++r)o[d_][r]*=wsf[crow(r,hi)]; } }while(0)
  f32x16 pA0,pA1,pB0,pB1;
  int sl_prev=0,sl_cur=0,sl_next=SLOTB;
  #define ROT() do{sl_prev=sl_cur;sl_cur=sl_next;sl_next=(sl_next==(NSLOT-1)*SLOTB)?0:sl_next+SLOTB;}while(0)
  DMA_K(2,2*SLOTB);
  WAIT_BAR(3);
  qkt(pA0,pA1,Kbase,qr,negm,r32,hi);asm volatile("s_nop 15\n\ts_nop 7":"+v"(pA0),"+v"(pA1));CMASK(pA0,pA1,0);BIAS(pA0,pA1,0);
  START(pA0,pA1);
  _Pragma("unroll") for(int r=0;r<16;++r)pA1[r]=__builtin_amdgcn_exp2f(pA1[r]);
  WAIT_BAR(0);
  DMA_K(3,0);DMA_V(1,SLOTB);
  ROT();
  kload8(kf,kp0+sl_cur);
  WAIT_BAR(2);
  s16x4 vlo[8],vhi[8]; u32x4 pw0,pw1,pw2,pw3;
  #define PKW(P,B) cvtpk_s(P[B],P[B+1])
  #define PAF(k) __builtin_bit_cast(bf16x8,pw##k)
  #define VFR(i) (bf16x8){vlo[i][0],vlo[i][1],vlo[i][2],vlo[i][3],vhi[i][0],vhi[i][1],vhi[i][2],vhi[i][3]}
  #define PIN(x) asm volatile("":"+v"(x))
  #define MX3(a,b,c) __builtin_fmaxf(__builtin_fmaxf((a),(b)),(c))
  #define GAPA(MF,A0,A1,A2,A3,W0,W1,PW) do{ MF; sacc+=A0; sacc+=A1; sacc+=A2; sacc+=A3; PIN(sacc); W0; W1; PIN(PW); SBAR(); }while(0)
  #define EX(v) __builtin_amdgcn_exp2f(v)
  #define GAPB(MF,X,B) do{ MF; X[B]=EX(X[B]); X[B+1]=EX(X[B+1]); X[B+2]=EX(X[B+2]); X[B+3]=EX(X[B+3]); PIN(X); SBAR(); }while(0)
  #define VRD(i) do{ vlo[i]=vtr(vp_+(((i)>>2)*4096+((i)&3)*1024)); vhi[i]=vtr(vp_+(((i)>>2)*4096+((i)&3)*1024+512)); }while(0)
  #define KRD(G,j) do{ if(G){ kload2(kf,kp0+sl_next,j); SBAR(); } }while(0)
  #define STEP(C0,C1,P0,P1,t,GK,GV,GL) do{ SBAR(); \
    const lds_cptr vp_=vp0+sl_prev; \
    VRD(0); SBAR(); float sacc=(P0[0]+P0[1]); \
    GAPA(C0=__builtin_amdgcn_mfma_f32_32x32x16_bf16(kf[0],qr[0],negm,0,0,0), P0[2],P0[3],P0[4],P0[5],     pw0[0]=PKW(P0,0), pw0[1]=PKW(P0,2), pw0); \
    VRD(4); SBAR(); GAPA(C1=__builtin_amdgcn_mfma_f32_32x32x16_bf16(kf[1],qr[0],negm,0,0,0), P0[6],P0[7],P0[8],P0[9],     pw0[2]=PKW(P0,4), pw0[3]=PKW(P0,6), pw0); \
    VRD(1); SBAR(); GAPA(C0=__builtin_amdgcn_mfma_f32_32x32x16_bf16(kf[2],qr[1],C0,0,0,0),   P0[10],P0[11],P0[12],P0[13], pw1[0]=PKW(P0,8), pw1[1]=PKW(P0,10), pw1); \
    VRD(5); SBAR(); GAPA(C1=__builtin_amdgcn_mfma_f32_32x32x16_bf16(kf[3],qr[1],C1,0,0,0),   P0[14],P0[15],P1[0],P1[1],   pw1[2]=PKW(P0,12),pw1[3]=PKW(P0,14), pw1); \
    VRD(2); SBAR(); GAPA(C0=__builtin_amdgcn_mfma_f32_32x32x16_bf16(kf[4],qr[2],C0,0,0,0),   P1[2],P1[3],P1[4],P1[5],     pw2[0]=PKW(P1,0), pw2[1]=PKW(P1,2), pw2); \
    VRD(6); SBAR(); GAPA(C1=__builtin_amdgcn_mfma_f32_32x32x16_bf16(kf[5],qr[2],C1,0,0,0),   P1[6],P1[7],P1[8],P1[9],     pw2[2]=PKW(P1,4), pw2[3]=PKW(P1,6), pw2); \
    VRD(3); SBAR(); GAPA(C0=__builtin_amdgcn_mfma_f32_32x32x16_bf16(kf[6],qr[3],C0,0,0,0),   P1[10],P1[11],P1[12],P1[13], pw3[0]=PKW(P1,8), pw3[1]=PKW(P1,10), pw3); \
    VRD(7); SBAR(); GAPA(C1=__builtin_amdgcn_mfma_f32_32x32x16_bf16(kf[7],qr[3],C1,0,0,0),   P1[14],P1[15],0.f,0.f,       pw3[2]=PKW(P1,12),pw3[3]=PKW(P1,14), pw3); \
    l_reg+=sacc; \
    if(GK){DMA_K((t)+3,sl_cur);} if(GV){DMA_V((t)+1,sl_next);} \
    CMASK(C0,C1,t); BIAS(C0,C1,t); \
    { float a=MX3(C0[0],C0[1],C1[0]),b=MX3(C0[2],C0[3],C1[1]); a=MX3(a,C1[2],C1[3]); \
      _Pragma("unroll") for(int r=4;r<16;r+=4){a=MX3(a,C0[r],C0[r+1]);b=MX3(b,C0[r+2],C0[r+3]);a=MX3(a,C1[r],C1[r+1]);b=MX3(b,C1[r+2],C1[r+3]);} \
      float rm=__builtin_fmaxf(a,b); { auto rr=__builtin_amdgcn_permlane32_swap(__float_as_uint(rm),__float_as_uint(rm),false,false); rm=__builtin_fmaxf(__uint_as_float(rr[0]),__uint_as_float(rr[1])); } \
      resc=false; \
      if(__builtin_expect(__any(rm>(float)THRL),0)){ const float dl=__builtin_fmaxf(rm,0.f); mhat+=dl; \
        _Pragma("unroll") for(int r=0;r<16;++r){C0[r]-=dl;C1[r]-=dl;} \
        _Pragma("unroll") for(int r=0;r<16;++r)negm[r]=-mhat; asm volatile("":"+v"(negm)); \
        const float f=__builtin_amdgcn_exp2f(-dl); l_reg*=f; if(hi==0)wsf[r32]=f; resc=true; } } \
    SBAR(); \
    GAPB(o[0]=__builtin_amdgcn_mfma_f32_32x32x16_bf16(PAF(0),VFR(0),o[0],0,0,0), C0,0); \
    GAPB(o[1]=__builtin_amdgcn_mfma_f32_32x32x16_bf16(PAF(0),VFR(4),o[1],0,0,0), C0,4); \
    KRD(GL,0); GAPB(o[0]=__builtin_amdgcn_mfma_f32_32x32x16_bf16(PAF(1),VFR(1),o[0],0,0,0), C0,8); \
    KRD(GL,1); GAPB(o[1]=__builtin_amdgcn_mfma_f32_32x32x16_bf16(PAF(1),VFR(5),o[1],0,0,0), C0,12); \
    KRD(GL,2); GAPB(o[0]=__builtin_amdgcn_mfma_f32_32x32x16_bf16(PAF(2),VFR(2),o[0],0,0,0), C1,0); \
    KRD(GL,3); GAPB(o[1]=__builtin_amdgcn_mfma_f32_32x32x16_bf16(PAF(2),VFR(6),o[1],0,0,0), C1,4); \
    GAPB(o[0]=__builtin_amdgcn_mfma_f32_32x32x16_bf16(PAF(3),VFR(3),o[0],0,0,0), C1,8); \
    GAPB(o[1]=__builtin_amdgcn_mfma_f32_32x32x16_bf16(PAF(3),VFR(7),o[1],0,0,0), C1,12); \
    }while(0)
  int t=1;
  #undef CMASK
  #define CMASK(P0,P1,t) do{}while(0)
  for(;t+5<NT;t+=2){
    STEP(pB0,pB1,pA0,pA1,t,true,true,true);     WAIT_BAR(2); RESC(); ROT();
    STEP(pA0,pA1,pB0,pB1,t+1,true,true,true);   WAIT_BAR(2); RESC(); ROT();
  }
  #undef CMASK
  #define CMASK(P0,P1,t) do{int jb_=(t)-(NT-4); if(jb_>=0)cmask(P0,P1,jb_,qrel,hi);}while(0)
  #define ENDW(tt) do{ if((tt)+3<NT){WAIT_BAR(2);} else if((tt)+2<NT){WAIT_BAR(1);} else {WAIT_BAR(0);} }while(0)
  for(;t+1<NT;t+=2){
    STEP(pB0,pB1,pA0,pA1,t,(t+3<NT),(t+1<NT),(t+1<NT));       ENDW(t);   RESC(); ROT();
    STEP(pA0,pA1,pB0,pB1,t+1,(t+4<NT),(t+2<NT),(t+2<NT));     ENDW(t+1); RESC(); ROT();
  }
  STEP(pB0,pB1,pA0,pA1,NT-1,false,false,false); RESC();
  { float sacc=pB0[0]+pB0[1]; _Pragma("unroll") for(int r=2;r<16;++r)sacc+=pB0[r]; _Pragma("unroll") for(int r=0;r<16;++r)sacc+=pB1[r]; l_reg+=sacc;
    pw0=(u32x4){PKW(pB0,0),PKW(pB0,2),PKW(pB0,4),PKW(pB0,6)};pw1=(u32x4){PKW(pB0,8),PKW(pB0,10),PKW(pB0,12),PKW(pB0,14)};pw2=(u32x4){PKW(pB1,0),PKW(pB1,2),PKW(pB1,4),PKW(pB1,6)};pw3=(u32x4){PKW(pB1,8),PKW(pB1,10),PKW(pB1,12),PKW(pB1,14)};
    SBAR(); pv(o,vb0+sl_cur,PAF(0),PAF(1),PAF(2),PAF(3)); }
  #undef PKW
  #undef PAF
  #undef VFR
  #undef PIN
  #undef MX3
  #undef GAPA
  #undef GAPB
  #undef EX
  #undef VRD
  #undef KRD
  #undef STEP
  #undef ENDW
  {auto rr=__builtin_amdgcn_permlane32_swap(__float_as_uint(l_reg),__float_as_uint(l_reg),false,false);l_reg=__uint_as_float(rr[0])+__uint_as_float(rr[1]);}
  if(hi==0)wsf[32+r32]=l_reg;asm volatile("s_waitcnt lgkmcnt(0)":::"memory");
  float rli[16];
  #pragma unroll
  for(int r=0;r<16;++r)rli[r]=__builtin_amdgcn_rcpf(wsf[32+crow(r,hi)]);
  { bf16*stg=(bf16*)(shm+LDS_OST)+wid*2048;
    #pragma unroll
    for(int r=0;r<16;++r){const int orow=crow(r,hi);
      #pragma unroll
      for(int d0=0;d0<2;++d0)stg[orow*64+d0*32+r32]=__float2bfloat16(o[d0][r]*rli[r]);}
    asm volatile("s_waitcnt lgkmcnt(0)":::"memory");
    unsigned char*O8w=(unsigned char*)O+(rowbase+q0+wid*QBLK)*DM+h*D;
    _Pragma("unroll") for(int i=0;i<4;++i){const int row=i*8+(lane>>3),ch=lane&7; const u32x4 v=*(const u32x4*)(stg+row*64+ch*8);
      u32x2 w8; w8.x=pg8::pack4_fp8(bflo(v.x)*SC_FOX,bfhi(v.x)*SC_FOX,bflo(v.y)*SC_FOX,bfhi(v.y)*SC_FOX); w8.y=pg8::pack4_fp8(bflo(v.z)*SC_FOX,bfhi(v.z)*SC_FOX,bflo(v.w)*SC_FOX,bfhi(v.w)*SC_FOX);
      *(u32x2*)(O8w+(long)row*DM+ch*8)=w8;} }
  asm volatile("s_waitcnt lgkmcnt(0)\n\ts_barrier":::"memory");
  #undef BIAS
  #undef BIAS_H
  #undef DMA_K
  #undef DMA_V
  #undef CMASK
  #undef START
  #undef RESC
  #undef ROT
}
constexpr int ATTN_LDS_BYTES=LDS_BYTES;
#undef SBAR
#undef WAIT_BAR
}


constexpr int NWAVES = 8;
constexpr int RING_OFF = 0, RING_BYTES = 131072;
constexpr int LDSCTL_OFF = RING_BYTES, MISC_OFF = LDSCTL_OFF + 320, TAB_OFF = LDSCTL_OFF + 1024;
constexpr int WTAB_OFF = LDSCTL_OFF + 2048;
constexpr int TOK_OFF = LDSCTL_OFF + 4096;
constexpr int LDS_BYTES = 147456;
typedef GAS unsigned gu32;
__device__ __forceinline__ unsigned hw_wave_key() { return (unsigned)__builtin_amdgcn_s_getreg((5 << 11) | 4) & 63u; }
#define RLX_AGENT __ATOMIC_RELAXED, __HIP_MEMORY_SCOPE_AGENT

#define XB_TMO      128
#define XB_XCNT(j)  (256  + 64 * (j))
#define XB_XSUB(j)  (1280 + 64 * (j))
#define XB_XGEN(j)  (2304 + 64 * (j))
#define XB_TOP      3328
#define XB_TOPGEN   3392
#define XCD_BAR_WORDS 3456
#define XB_SPIN_CAP (1u << 18)

__device__ __forceinline__ unsigned xb_ld(unsigned* p)              { return __hip_atomic_load(p, __ATOMIC_RELAXED, __HIP_MEMORY_SCOPE_AGENT); }
__device__ __forceinline__ unsigned xb_add(unsigned* p, unsigned v) { return __hip_atomic_fetch_add(p, v, __ATOMIC_RELAXED, __HIP_MEMORY_SCOPE_AGENT); }
__device__ __forceinline__ unsigned xb_xcc_id() { return (unsigned)__builtin_amdgcn_s_getreg((3 << 11) | 20) & 0xFu; }
#define XB_SPIN(cond, bar) do { unsigned _sp = 0; while (cond) { __builtin_amdgcn_s_sleep(1); \
    if ((++_sp & 255u) == 0u) { if (xb_ld(&(bar)[XB_TMO])) break; if (_sp > XB_SPIN_CAP) { atomicAdd(&(bar)[XB_TMO], 1u); break; } } } } while (0)

struct XcdBarrier {
    unsigned* bar; unsigned x;
    volatile LAS unsigned* st;
};

__device__ __forceinline__ XcdBarrier xcd_barrier_post(unsigned* bar, volatile LAS unsigned* st) {
    XcdBarrier b; b.bar = bar; b.x = xb_xcc_id(); b.st = st;
    if (threadIdx.x == 0) (void)xb_add(&bar[XB_XCNT(b.x)], 1u);
    return b;
}
__device__ __forceinline__ void xcd_barrier_complete(unsigned* bar, unsigned x, unsigned& nloc, unsigned& nx) {
    const unsigned G = gridDim.x * gridDim.y * gridDim.z;
    unsigned sum, cnt, mine, sp = 0u;
    for (;;) {
        sum = 0u; cnt = 0u; mine = 0u;
#pragma unroll
        for (unsigned j = 0; j < 16; ++j) { const unsigned c = xb_ld(&bar[XB_XCNT(j)]); sum += c; cnt += (c > 0u) ? 1u : 0u; mine = (j == x) ? c : mine; }
        if (sum == G) break;
        __builtin_amdgcn_s_sleep(1);
        if ((++sp & 255u) == 0u) { if (xb_ld(&bar[XB_TMO])) break; if (sp > XB_SPIN_CAP) { atomicAdd(&bar[XB_TMO], 1u); break; } }
    }
    nloc = mine > 0u ? mine : 1u; nx = cnt > 0u ? cnt : 1u;
}

__device__ __forceinline__ void xcd_barrier(const XcdBarrier& b) {
    asm volatile("s_waitcnt vmcnt(0)" ::: "memory");
    __syncthreads();
    if (threadIdx.x == 0) {
        unsigned* bar = b.bar;
        __builtin_amdgcn_s_waitcnt(0);
        unsigned nloc = b.st[0], nx = b.st[1];
        if (nloc == 0u) { xcd_barrier_complete(bar, b.x, nloc, nx); b.st[0] = nloc; b.st[1] = nx; }
        const unsigned old = xb_add(&bar[XB_XSUB(b.x)], 1u);
        const unsigned gen = old / nloc;
        if (old + 1u == (gen + 1u) * nloc) {
            __builtin_amdgcn_fence(__ATOMIC_RELEASE, "agent");
            asm volatile("s_waitcnt vmcnt(0)" ::: "memory");
            const unsigned og = xb_add(&bar[XB_TOP], 1u);
            const unsigned tg = og / nx;
            if (og + 1u == (tg + 1u) * nx) xb_add(&bar[XB_TOPGEN], 1u);
            else XB_SPIN(xb_ld(&bar[XB_TOPGEN]) == tg, bar);
            __builtin_amdgcn_fence(__ATOMIC_ACQUIRE, "agent");
            xb_add(&bar[XB_XGEN(b.x)], 1u);
            asm volatile("s_waitcnt vmcnt(0)" ::: "memory");
        } else {
            XB_SPIN(xb_ld(&bar[XB_XGEN(b.x)]) == gen, bar);
            __builtin_amdgcn_fence(__ATOMIC_ACQUIRE, "agent");
            asm volatile("s_waitcnt vmcnt(0)" ::: "memory");
        }
    }
    __syncthreads();
}


struct Args {
    const float *x, *ln_in_g, *ln_in_b, *w_in, *b_in, *w_fox, *lbl, *norm_g, *w_hgrn, *w_mix, *b_mix, *ln1_g, *ln1_b, *router_w, *router_b, *w1, *w3, *w2, *ln2_g, *ln2_b;
    float* out; unsigned char* ws; int ph_lo, ph_hi, use_bar, pad;
};
struct Frame { LAS unsigned char* lds; int tid, lane, wave, G, gw, ngw, bid; };
#define LOAD_ARGS() launder_args(args)
__device__ __forceinline__ Args launder_args(const Args& args) { Args a = args; size_t z_ = 0; asm volatile("" : "+s"(z_)); a.ws = args.ws + z_; return a; }

struct LnGB { f32x4 g[4], b[4]; };
__device__ __forceinline__ LnGB ln_load_gb(const float* g, const float* bta, int lane) { LnGB r;
#pragma unroll
    for (int j = 0; j < 4; ++j) { const int c = 4 * lane + 256 * j; r.g[j] = *(const f32x4*)(g + c); r.b[j] = *(const f32x4*)(bta + c); }
    return r; }
__device__ __forceinline__ void ln_rows16(f32x4 (&v)[4], const LnGB& gb, int lane) {
    float s = 0.f;
#pragma unroll
    for (int j = 0; j < 4; ++j) s += (v[j].x + v[j].y) + (v[j].z + v[j].w);
    const float mean = wave_sum(s) * (1.f / D); float s2 = 0.f;
#pragma unroll
    for (int j = 0; j < 4; ++j) { v[j] = v[j] - mean; s2 += (v[j].x * v[j].x + v[j].y * v[j].y) + (v[j].z * v[j].z + v[j].w * v[j].w); }
    const float rstd = rsqrtf(wave_sum(s2) * (1.f / D) + LN_EPS);
#pragma unroll
    for (int j = 0; j < 4; ++j) v[j] = v[j] * rstd * gb.g[j] + gb.b[j];
}
__device__ __forceinline__ void store_row(const f32x4 (&v)[4], int lane, bf16_t* ores, unsigned char* obf, float* of32b) {
#pragma unroll
    for (int j = 0; j < 4; ++j) { const int c = 4 * lane + 256 * j;
        if (ores) { u32x2 w; w.x = pk2(v[j].x, v[j].y); w.y = pk2(v[j].z, v[j].w); *(u32x2*)(ores + c) = w; }
        if (of32b) *(f32x4*)(of32b + c) = v[j];
        if (obf) *(unsigned*)(obf + c) = pg8::pack4_fp8(v[j].x, v[j].y, v[j].z, v[j].w); }
}

struct CvtDesc { const float* W; int ldw, k0, srccol, nvalid; unsigned char* WT; int dstrow, dstk; };
__device__ __forceinline__ void cvt_load(const CvtDesc& d, f32x4 (&v)[8], int lane) {
    const int ks = lane >> 3, n4 = (lane & 7) * 4;
#pragma unroll
    for (int j = 0; j < 8; ++j) v[j] = (n4 < d.nvalid) ? *(const f32x4*)(d.W + (size_t)(d.k0 + 8 * j + ks) * d.ldw + d.srccol + n4) : (f32x4){0.f, 0.f, 0.f, 0.f};
}
__device__ __forceinline__ void cvt_store(const CvtDesc& d, const f32x4 (&v)[8], LAS float* scr, int lane) {
    const int ks = lane >> 3, n4 = (lane & 7) * 4;
#pragma unroll
    for (int j = 0; j < 8; ++j) { LAS float* p = scr + (8 * j + ks) * 33 + n4; p[0] = v[j][0]; p[1] = v[j][1]; p[2] = v[j][2]; p[3] = v[j][3]; }
    asm volatile("s_waitcnt lgkmcnt(0)" ::: "memory");
    const int c = lane & 7;
#pragma unroll
    for (int j = 0; j < 4; ++j) { const int n = (lane >> 3) + 8 * j; const LAS float* s = scr + (8 * c) * 33 + n;
        u32x2 o; o.x = pg8::pack4_fp8(s[0 * 33] * SC_W, s[1 * 33] * SC_W, s[2 * 33] * SC_W, s[3 * 33] * SC_W); o.y = pg8::pack4_fp8(s[4 * 33] * SC_W, s[5 * 33] * SC_W, s[6 * 33] * SC_W, s[7 * 33] * SC_W);
        *(u32x2*)(d.WT + (size_t)(d.dstrow + n) * 1024 + d.dstk + d.k0 + 8 * c) = o; }
    asm volatile("s_waitcnt lgkmcnt(0)" ::: "memory");
}
__device__ __forceinline__ CvtDesc cvt_decode(const Args& a, int l, int it) {
    unsigned char* WS_ = a.ws + wset(l);
    constexpr int I_IN = 16 * 176, I_BR = 8 * 32, I_MIX = 16 * 32, I_13 = 16 * 64 * NE;
    CvtDesc d; int r = it;
    if (r < I_IN) { const int kb = r / 176, nb = r % 176, n0 = nb * 32;
        const int src = (n0 < 1536) ? n0 : n0 + 8, nv = 32;
        d.W = a.w_in + (size_t)l * D * NIN; d.ldw = NIN; d.k0 = kb * 64; d.srccol = src; d.nvalid = nv; d.WT = WS_ + WO_WIN; d.dstrow = n0; d.dstk = 0; return d; } r -= I_IN;
    if (r < I_BR) { const int kb = r / 32, nb = r % 32; d.W = a.w_fox + (size_t)l * 512 * D; d.ldw = D; d.k0 = kb * 64; d.srccol = nb * 32; d.nvalid = 32; d.WT = WS_ + WO_WBR; d.dstrow = nb * 32; d.dstk = 0; return d; } r -= I_BR;
    if (r < I_BR) { const int kb = r / 32, nb = r % 32; d.W = a.w_hgrn + (size_t)l * 512 * D; d.ldw = D; d.k0 = kb * 64; d.srccol = nb * 32; d.nvalid = 32; d.WT = WS_ + WO_WBR; d.dstrow = nb * 32; d.dstk = 512; return d; } r -= I_BR;
    if (r < I_MIX) { const int kb = r / 32, nb = r % 32; d.W = a.w_mix + (size_t)l * D * D; d.ldw = D; d.k0 = kb * 64; d.srccol = nb * 32; d.nvalid = 32; d.WT = WS_ + WO_WMIX; d.dstrow = nb * 32; d.dstk = 0; return d; } r -= I_MIX;
    if (r < I_13) { const int e = r / 1024, q = r % 1024, kb = q / 64, nb = q % 64, n0 = nb * 32;
        const int j = n0 >> 8, rr = n0 & 255; d.W = (rr < 128 ? a.w1 : a.w3) + ((size_t)l * NE + e) * D * D; d.ldw = D; d.k0 = kb * 64; d.srccol = 128 * j + (rr & 127); d.nvalid = 32;
        d.WT = WS_ + WO_W13 + (size_t)e * 2048 * D; d.dstrow = n0; d.dstk = 0; return d; } r -= I_13;
    { const int e = r / 512, q = r % 512, kb = q / 32, nb = q % 32; d.W = a.w2 + ((size_t)l * NE + e) * D * D; d.ldw = D; d.k0 = kb * 64; d.srccol = nb * 32; d.nvalid = 32;
      d.WT = WS_ + WO_W2 + (size_t)e * D * D; d.dstrow = nb * 32; d.dstk = 0; return d; }
}
__device__ __forceinline__ void convert_layer(const Args& a, const Frame& F, int l, int gw, int ngw) {
    LAS float* scr = (LAS float*)(F.lds + RING_OFF + F.wave * 16384);
    const int lane = F.lane;
    constexpr int NITEMS = 16 * 176 + 2 * 8 * 32 + 16 * 32 + 16 * 64 * NE + 16 * 32 * NE;
    for (int it = gw; it < NITEMS; it += 2 * ngw) {
        const CvtDesc d0 = cvt_decode(a, l, it); f32x4 v0[8]; cvt_load(d0, v0, lane);
        const bool two = it + ngw < NITEMS;
        if (two) { const CvtDesc d1 = cvt_decode(a, l, it + ngw); f32x4 v1[8]; cvt_load(d1, v1, lane); cvt_store(d0, v0, scr, lane); cvt_store(d1, v1, scr, lane); }
        else cvt_store(d0, v0, scr, lane);
    }
    float* biasp = (float*)(a.ws + biasoff(l));
    for (int n = gw * 64 + lane; n < NINP; n += ngw * 64) {
        biasp[n] = (n < 1536) ? a.b_in[l * NIN + n] : a.b_in[l * NIN + n + 8]; }
}


constexpr int WFF_OFF = 65536 + 16384;
__device__ __forceinline__ void load_wff(const Args& a, const Frame& F, int l) {
    LAS float* wff = (LAS float*)(F.lds + RING_OFF + WFF_OFF);
    for (int i = F.tid; i < 8 * D; i += NWAVES * 64) { const int c = i >> 3, h = i & 7; wff[h * D + c] = a.w_in[((size_t)l * D + c) * NIN + 1536 + h]; }
}
__device__ __forceinline__ void fox_gates_row(const Args& a, const Frame& F, int l, const f32x4 (&v)[4], int row, float hbias  ) {
    const LAS float* wff = (const LAS float*)(F.lds + RING_OFF + WFF_OFF); const int lane = F.lane;
    float p[8];
#pragma unroll
    for (int h = 0; h < 8; ++h) { float s = 0.f;
        f32x2 s2 = {0.f, 0.f};
#pragma unroll
        for (int j = 0; j < 4; ++j) { const f32x4 r4 = *(const LAS f32x4*)(wff + h * D + 4 * lane + 256 * j);
            s2 = s2 + __builtin_shufflevector(v[j], v[j], 0, 1) * __builtin_shufflevector(r4, r4, 0, 1); s2 = s2 + __builtin_shufflevector(v[j], v[j], 2, 3) * __builtin_shufflevector(r4, r4, 2, 3); }
        s = s2[0] + s2[1];
        p[h] = s; }
#pragma unroll
    for (int k = 0; k < 4; ++k) p[k] = rs_step32(p[k], p[k + 4]);
#pragma unroll
    for (int k = 0; k < 2; ++k) p[k] = rs_step16(p[k], p[k + 2]);
    const bool hi3 = (lane & 8) != 0;
    { const float snd = hi3 ? p[0] : p[1]; const float rcv = lane_xor8(snd); p[0] = (hi3 ? p[1] : p[0]) + rcv; }
    p[0] += lane_xor4(p[0]); p[0] += lane_xor2(p[0]); p[0] += lane_xor1(p[0]);
    if ((lane & 7) == 0) { const int h = lane >> 3; ((float*)(a.ws + WS_FL))[(size_t)row * 8 + h] = logsigmoidf_(p[0] + hbias); }
}

__device__ __forceinline__ void phase_prep(const Args& a, const Frame& F) {
    if (F.bid == 0) {
        float* lb_all = (float*)(a.ws + WS_MISC);
        const int c = F.tid;
        float v[DEPTH], m = -1e30f;
#pragma unroll
        for (int l = 0; l < DEPTH; ++l) { v[l] = a.lbl[l * 512 + c]; m = fmaxf(m, v[l]); }
        float s = 0.f;
#pragma unroll
        for (int l = 0; l < DEPTH; ++l) { v[l] = __expf(v[l] - m); s += v[l]; }
        float cum = 0.f;
#pragma unroll
        for (int l = 0; l < DEPTH; ++l) { const float p = v[l] / s; cum += p; lb_all[l * 512 + c] = cum - v[0] / s; }
    }
    bf16_t* XRES = (bf16_t*)(a.ws + WS_XRES); unsigned char* XN = a.ws + WS_XN;
    load_wff(a, F, 0); __syncthreads();
    const LnGB gb = ln_load_gb(a.ln_in_g, a.ln_in_b, F.lane); const float hbias = a.b_in[0 * NIN + 1536 + (F.lane >> 3)];
    f32x4 vn[4];
#pragma unroll
    for (int j = 0; j < 4; ++j) vn[j] = *(const f32x4*)(a.x + (size_t)F.gw * D + 4 * F.lane + 256 * j);
    for (int row = F.gw; row < T; row += F.ngw) {
        f32x4 v[4];
#pragma unroll
        for (int j = 0; j < 4; ++j) v[j] = vn[j];
        if (row + F.ngw < T) {
#pragma unroll
            for (int j = 0; j < 4; ++j) vn[j] = *(const f32x4*)(a.x + (size_t)(row + F.ngw) * D + 4 * F.lane + 256 * j); }
        ln_rows16(v, gb, F.lane);
        store_row(v, F.lane, XRES + (size_t)row * D, XN + (size_t)row * D, nullptr);
        fox_gates_row(a, F, 0, v, row, hbias);
    }
    __syncthreads();
    convert_layer(a, F, 0, F.gw, F.ngw);
}

__device__ __forceinline__ void phase_fscan(const Args& a, const Frame& F) {
    if (F.bid >= BATCH * NH) return;
    const float* FL = (const float*)(a.ws + WS_FL); float* F2 = (float*)(a.ws + WS_F2);
    LAS float* wsum = (LAS float*)(F.lds + RING_OFF);
    const int bh = F.bid, b = bh >> 3, h = bh & 7, tid = F.tid, lane = F.lane, w = F.wave;
    float v[4], run = 0.f;
#pragma unroll
    for (int i = 0; i < 4; ++i) { run += FL[((size_t)b * SEQ + tid * 4 + i) * 8 + h]; v[i] = run; }
    float incl = run;
#pragma unroll
    for (int o = 1; o < 64; o <<= 1) { const float u = __shfl_up(incl, o); if (lane >= o) incl += u; }
    if (lane == 63) wsum[w] = incl;
    __syncthreads();
    float base = incl - run; for (int i = 0; i < w; ++i) base += wsum[i];
#pragma unroll
    for (int i = 0; i < 4; ++i) F2[(size_t)bh * SEQ + tid * 4 + i] = (base + v[i]) * LOG2E;
    __syncthreads();
}

__device__ __forceinline__ void phase_attn_naive(const Args& a, const Frame& F) {
    const bf16_t* QO = (const bf16_t*)(a.ws + WS_QO); const bf16_t* KV = (const bf16_t*)(a.ws + WS_KV); const float* F2 = (const float*)(a.ws + WS_F2); bf16_t* O = (bf16_t*)(a.ws + WS_QO);
    LAS float* ps = (LAS float*)(F.lds + RING_OFF) + F.wave * 64;
    const int lane = F.lane;
    for (int gid = F.gw; gid < BATCH * NH * SEQ; gid += F.ngw) {
        const int bh = gid & 127, t = gid >> 7, b = bh >> 3, h = bh & 7;
        float q[64];
        { const bf16_t* qp = QO + ((size_t)b * SEQ + t) * 1024 + h * 64;
#pragma unroll
          for (int c = 0; c < 8; ++c) { const u32x4 u = *(const u32x4*)(qp + c * 8);
            q[c * 8 + 0] = bflo(u.x); q[c * 8 + 1] = bfhi(u.x); q[c * 8 + 2] = bflo(u.y); q[c * 8 + 3] = bfhi(u.y);
            q[c * 8 + 4] = bflo(u.z); q[c * 8 + 5] = bfhi(u.z); q[c * 8 + 6] = bflo(u.w); q[c * 8 + 7] = bfhi(u.w); } }
        float m = -1e30f, l = 0.f, o = 0.f;
        const float* f2 = F2 + (size_t)bh * SEQ;
        for (int s0 = 0; s0 <= t; s0 += 64) {
            const int s = s0 + lane; const bool valid = s <= t;
            float sc = -1e30f;
            if (valid) { const bf16_t* kp = KV + ((size_t)b * SEQ + s) * 1024 + h * 64; float d = 0.f;
#pragma unroll
                for (int c = 0; c < 8; ++c) { const u32x4 u = *(const u32x4*)(kp + c * 8);
                    d += q[c * 8 + 0] * bflo(u.x) + q[c * 8 + 1] * bfhi(u.x) + q[c * 8 + 2] * bflo(u.y) + q[c * 8 + 3] * bfhi(u.y)
                       + q[c * 8 + 4] * bflo(u.z) + q[c * 8 + 5] * bfhi(u.z) + q[c * 8 + 6] * bflo(u.w) + q[c * 8 + 7] * bfhi(u.w); }
                sc = d - f2[s]; }
            const float mn = fmaxf(m, wave_max(sc));
            const float p = valid ? exp2f(sc - mn) : 0.f;
            const float f = exp2f(m - mn);
            l = l * f + wave_sum(p); o *= f; m = mn;
            ps[lane] = p;
            asm volatile("s_waitcnt lgkmcnt(0)" ::: "memory");
            const int nk = min(64, t - s0 + 1);
            const bf16_t* vp = KV + ((size_t)b * SEQ + s0) * 1024 + 512 + h * 64 + lane;
            for (int j = 0; j < nk; ++j) o += ps[j] * bf2f(vp[(size_t)j * 1024]);
            asm volatile("s_waitcnt lgkmcnt(0)" ::: "memory");
        }
        O[((size_t)b * SEQ + t) * 1024 + h * 64 + lane] = (bf16_t)f2bf(o / l);
    }
}

__device__ __forceinline__ void phase_hgrn_naive(const Args& a, const Frame& F, int l) {
    if (F.bid >= BATCH * NH || F.wave != 0) return;
    const bf16_t* HB = (const bf16_t*)(a.ws + WS_HB); const float* LOGF = (const float*)(a.ws + WS_LOGF); const bf16_t* HG = (const bf16_t*)(a.ws + WS_HG); bf16_t* O = (bf16_t*)(a.ws + WS_QO);
    LAS float* Lf = (LAS float*)(F.lds + RING_OFF + 1024); LAS float* Lk = Lf + 4096; LAS float* Lq = Lk + 4096;
    const int bh = F.bid, b = bh >> 3, h = bh & 7, lane = F.lane;
    float Sx[64];
#pragma unroll
    for (int d = 0; d < 64; ++d) Sx[d] = 0.f;
    const float ng = a.norm_g[l * 512 + h * 64 + lane];
    for (int c0 = 0; c0 < SEQ; c0 += 64) {
        for (int tt = 0; tt < 64; ++tt) { const size_t row = (size_t)b * SEQ + c0 + tt;
            const float lf = LOGF[row * 512 + h * 64 + lane]; const float f = exp2f(lf);
            Lf[tt * 64 + lane] = f; Lk[tt * 64 + lane] = 1.f - f; Lq[tt * 64 + lane] = bf2f(HB[row * 1024 + h * 64 + lane]); }
        asm volatile("s_waitcnt lgkmcnt(0)" ::: "memory");
        for (int tt = 0; tt < 64; ++tt) { const size_t row = (size_t)b * SEQ + c0 + tt;
            const float v = bf2f(HB[row * 1024 + 512 + h * 64 + lane]);
            float o = 0.f;
#pragma unroll
            for (int d = 0; d < 64; d += 4) { const f32x4 f4 = *(const LAS f32x4*)(Lf + tt * 64 + d), k4 = *(const LAS f32x4*)(Lk + tt * 64 + d), q4 = *(const LAS f32x4*)(Lq + tt * 64 + d);
                Sx[d] = f4.x * Sx[d] + k4.x * v; o += Sx[d] * q4.x; Sx[d + 1] = f4.y * Sx[d + 1] + k4.y * v; o += Sx[d + 1] * q4.y;
                Sx[d + 2] = f4.z * Sx[d + 2] + k4.z * v; o += Sx[d + 2] * q4.z; Sx[d + 3] = f4.w * Sx[d + 3] + k4.w * v; o += Sx[d + 3] * q4.w; }
            const float ss = wave_sum(o * o);
            const float r = o * rsqrtf(ss * (1.f / 64.f) + RMS_EPS) * ng * bf2f(HG[row * 512 + h * 64 + lane]);
            O[row * 1024 + 512 + h * 64 + lane] = (bf16_t)f2bf(r); }
        asm volatile("s_waitcnt lgkmcnt(0)" ::: "memory");
    }
}

#ifndef LN1_MFMA
#define LN1_MFMA 0
#endif
#if LN1_MFMA
constexpr int LN1_WP = 2064, LN1_WH = 0, LN1_WL = 16 * LN1_WP, LN1_LG = 66560, LN1_ASG = LN1_LG + 8 * 16 * 16 * 4, LN1_BASE = LN1_ASG + 128 * 16, LN1_GB = 77824;
#else
constexpr int LN1_RW = 0, LN1_LG = 65536, LN1_ASG = LN1_LG + 8 * 16 * 16 * 4, LN1_BASE = LN1_ASG + 128 * 16;
#endif
__device__ __forceinline__ void phase_ln1_router(const Args& a, const Frame& F, int l) {
    const bf16_t* xres = (const bf16_t*)(a.ws + WS_XRES); bf16_t* x1 = (bf16_t*)(a.ws + WS_X1B); const unsigned char* mixed = a.ws + WS_MIXED;   unsigned char* xn = a.ws + WS_XN;
    unsigned* cnt = (unsigned*)(a.ws + WS_CTL) + CW_CNT + l * 64; int* list = (int*)(a.ws + WS_LIST); unsigned* tokinfo = (unsigned*)(a.ws + WS_TOK);
    const float* g = a.ln1_g + l * D; const float* bta = a.ln1_b + l * D;
    LAS float* lgs = (LAS float*)(F.lds + RING_OFF + LN1_LG) + F.wave * 256;
    LAS u32x4* asg = (LAS u32x4*)(F.lds + RING_OFF + LN1_ASG);
    LAS unsigned* basep = (LAS unsigned*)(F.lds + RING_OFF + LN1_BASE);
    const int lane = F.lane;
#if LN1_MFMA
    { LAS unsigned char* L = F.lds + RING_OFF;
      for (int i = F.tid; i < NE * D; i += NWAVES * 64) { const int c = i >> 4, e = i & 15; const float wv = a.router_w[i]; const unsigned hi = pk2(wv, 0.f) & 0xffffu; const float r = wv - bf2f(hi);
          *(LAS unsigned short*)(L + LN1_WH + e * LN1_WP + c * 2) = (unsigned short)hi; *(LAS unsigned short*)(L + LN1_WL + e * LN1_WP + c * 2) = (unsigned short)(pk2(r, 0.f) & 0xffffu); }
      for (int i = F.tid; i < D; i += NWAVES * 64) { ((LAS float*)(L + LN1_GB))[i] = g[i]; ((LAS float*)(L + LN1_GB))[D + i] = bta[i]; } }
    __syncthreads();
    for (int blk = F.bid; blk < T / 128; blk += F.G) {
        const int R0 = blk * 128 + F.wave * 16;
        { const int r = lane & 15, q = lane >> 4; const size_t rowg = (size_t)(R0 + r);
          const unsigned char* xrow = (const unsigned char*)xres + rowg * 2048 + q * 16; const unsigned char* mrow = mixed + rowg * 1024 + q * 8;
          unsigned char* x1row = (unsigned char*)x1 + rowg * 2048 + q * 16; unsigned char* xnrow = xn + rowg * 1024 + q * 8;
          const LAS unsigned char* L = F.lds + RING_OFF;
          float s1 = 0.f, s2 = 0.f;
          u32x4 xa[4], xb[4]; u32x2 ma[4], mb[4];
#pragma unroll
          for (int k = 0; k < 4; ++k) { xa[k] = *(const u32x4*)(xrow + k * 64); ma[k] = *(const u32x2*)(mrow + k * 32); }
          for (int s0 = 0; s0 < 32; s0 += 4) {
              const int sn = (s0 + 4 < 32) ? s0 + 4 : 0;
#pragma unroll
              for (int k = 0; k < 4; ++k) { xb[k] = *(const u32x4*)(xrow + (sn + k) * 64); mb[k] = *(const u32x2*)(mrow + (sn + k) * 32); }
#pragma unroll
              for (int k = 0; k < 4; ++k) { f32x4 x0, x1v, m0, m1; pg8::unpack8(xa[k], x0, x1v); pg8::unpack8_fp8(ma[k], 1.f / SC_MIX, m0, m1);
                  const f32x4 v0 = x0 * ALPHA + m0, v1 = x1v * ALPHA + m1; const f32x4 t = v0 + v1, u = v0 * v0 + v1 * v1;
                  s1 += (t[0] + t[1]) + (t[2] + t[3]); s2 += (u[0] + u[1]) + (u[2] + u[3]); }
#pragma unroll
              for (int k = 0; k < 4; ++k) { xa[k] = xb[k]; ma[k] = mb[k]; } }
          s1 = rs_step16(s1, s1); s1 = rs_step32(s1, s1); s2 = rs_step16(s2, s2); s2 = rs_step32(s2, s2);
          const float mean = s1 * (1.f / D); const float rstd = rsqrtf(fmaxf(s2 * (1.f / D) - mean * mean, 0.f) + LN_EPS); const float nmr = -mean * rstd;
          f32x4 acc = {0.f, 0.f, 0.f, 0.f};
          for (int s0 = 0; s0 < 32; s0 += 4) {
              if (s0 + 4 < 32) {
#pragma unroll
                  for (int k = 0; k < 4; ++k) { xb[k] = *(const u32x4*)(xrow + (s0 + 4 + k) * 64); mb[k] = *(const u32x2*)(mrow + (s0 + 4 + k) * 32); } }
#pragma unroll
              for (int k = 0; k < 4; ++k) { const int s = s0 + k; f32x4 x0, x1v, m0, m1; pg8::unpack8(xa[k], x0, x1v); pg8::unpack8_fp8(ma[k], 1.f / SC_MIX, m0, m1);
                  const LAS float* gp = (const LAS float*)(L + LN1_GB) + 32 * s + 8 * q;
                  const f32x4 g0 = *(const LAS f32x4*)gp, g1 = *(const LAS f32x4*)(gp + 4), b0 = *(const LAS f32x4*)(gp + D), b1 = *(const LAS f32x4*)(gp + D + 4);
                  const f32x4 y0 = ((x0 * ALPHA + m0) * rstd + nmr) * g0 + b0, y1 = ((x1v * ALPHA + m1) * rstd + nmr) * g1 + b1;
                  const u32x4 yh = pg8::pack8(y0, y1);
                  *(u32x4*)(x1row + s * 64) = yh;
                  *(u32x2*)(xnrow + s * 32) = pg8::pack8_fp8(y0, y1);
                  f32x4 h0, h1; pg8::unpack8(yh, h0, h1); const u32x4 yl = pg8::pack8(y0 - h0, y1 - h1);
                  const bf16x8 wh = *(const LAS bf16x8*)(L + LN1_WH + r * LN1_WP + (32 * s + 8 * q) * 2), wl = *(const LAS bf16x8*)(L + LN1_WL + r * LN1_WP + (32 * s + 8 * q) * 2);
                  const bf16x8 bh = __builtin_bit_cast(bf16x8, yh), bl = __builtin_bit_cast(bf16x8, yl);
                  acc = __builtin_amdgcn_mfma_f32_16x16x32_bf16(wh, bh, acc, 0, 0, 0); acc = __builtin_amdgcn_mfma_f32_16x16x32_bf16(wl, bh, acc, 0, 0, 0); acc = __builtin_amdgcn_mfma_f32_16x16x32_bf16(wh, bl, acc, 0, 0, 0); }
#pragma unroll
              for (int k = 0; k < 4; ++k) { xa[k] = xb[k]; ma[k] = mb[k]; } }
          *(LAS f32x4*)(lgs + r * 16 + 4 * q) = acc; }
#else
    LAS float* rw = (LAS float*)(F.lds + RING_OFF + LN1_RW);
    for (int i = F.tid; i < NE * D; i += NWAVES * 64) { const int c = i >> 4, e = i & 15; rw[e * D + c] = a.router_w[i]; }
    __syncthreads();
    const LnGB gb = ln_load_gb(g, bta, lane);
    for (int blk = F.bid; blk < T / 128; blk += F.G) {
        const int R0 = blk * 128 + F.wave * 16;
        u32x2 nx[4]; unsigned nm[4];
#pragma unroll
        for (int j = 0; j < 4; ++j) { const int c = 4 * lane + 256 * j; nx[j] = *(const u32x2*)(xres + (size_t)R0 * D + c); nm[j] = *(const unsigned*)(mixed + (size_t)R0 * D + c); }
        for (int i = 0; i < 16; ++i) { const int row = R0 + i;
            f32x4 v[4];
#pragma unroll
            for (int j = 0; j < 4; ++j) { const u32x2 xv = nx[j]; const f32x2 m01 = __builtin_amdgcn_cvt_pk_f32_fp8((int)nm[j], false), m23 = __builtin_amdgcn_cvt_pk_f32_fp8((int)nm[j], true);
                v[j].x = ALPHA * bflo(xv.x) + m01[0] * (1.f / SC_MIX); v[j].y = ALPHA * bfhi(xv.x) + m01[1] * (1.f / SC_MIX); v[j].z = ALPHA * bflo(xv.y) + m23[0] * (1.f / SC_MIX); v[j].w = ALPHA * bfhi(xv.y) + m23[1] * (1.f / SC_MIX); }
            { const int rn = (i < 15) ? row + 1 : row;
#pragma unroll
              for (int j = 0; j < 4; ++j) { const int c = 4 * lane + 256 * j; nx[j] = *(const u32x2*)(xres + (size_t)rn * D + c); nm[j] = *(const unsigned*)(mixed + (size_t)rn * D + c); } }
            ln_rows16(v, gb, lane);
            store_row(v, lane, x1 + (size_t)row * D, xn + (size_t)row * D, nullptr);
            float p[NE];
#pragma unroll
            for (int e = 0; e < NE; ++e) { float s = 0.f;
                f32x2 s2 = {0.f, 0.f};
#pragma unroll
                for (int j = 0; j < 4; ++j) { const f32x4 r4 = *(const LAS f32x4*)(rw + e * D + 4 * lane + 256 * j);
                    s2 = s2 + __builtin_shufflevector(v[j], v[j], 0, 1) * __builtin_shufflevector(r4, r4, 0, 1); s2 = s2 + __builtin_shufflevector(v[j], v[j], 2, 3) * __builtin_shufflevector(r4, r4, 2, 3); }
                s = s2[0] + s2[1];
                p[e] = s; asm volatile("" ::: "memory"); }
            {
#pragma unroll
              for (int k = 0; k < 8; ++k) p[k] = rs_step32(p[k], p[k + 8]);
#pragma unroll
              for (int k = 0; k < 4; ++k) p[k] = rs_step16(p[k], p[k + 4]);
              const bool hi3 = (lane & 8) != 0;
#pragma unroll
              for (int k = 0; k < 2; ++k) { const float snd = hi3 ? p[k] : p[k + 2]; const float rcv = lane_xor8(snd); p[k] = (hi3 ? p[k + 2] : p[k]) + rcv; }
              const bool hi2 = (lane & 4) != 0;
              { const float snd = hi2 ? p[0] : p[1]; const float rcv = lane_xor4(snd); p[0] = (hi2 ? p[1] : p[0]) + rcv; }
              p[0] += lane_xor2(p[0]); p[0] += lane_xor1(p[0]);
              if ((lane & 3) == 0) lgs[i * 16 + (lane >> 2)] = p[0]; }
        }
#endif
        asm volatile("s_waitcnt lgkmcnt(0)" ::: "memory");
        if (lane < 16) {
            float lg[NE];
#pragma unroll
            for (int q = 0; q < 4; ++q) { const f32x4 t4 = *(const LAS f32x4*)(lgs + lane * 16 + 4 * q); lg[4 * q] = t4[0] + a.router_b[4 * q]; lg[4 * q + 1] = t4[1] + a.router_b[4 * q + 1]; lg[4 * q + 2] = t4[2] + a.router_b[4 * q + 2]; lg[4 * q + 3] = t4[3] + a.router_b[4 * q + 3]; }
            int gs = 0; float gbest = -3e38f;
#pragma unroll
            for (int gi = 0; gi < 4; ++gi) { const float mx = fmaxf(fmaxf(lg[gi * 4], lg[gi * 4 + 1]), fmaxf(lg[gi * 4 + 2], lg[gi * 4 + 3])); if (mx > gbest) { gbest = mx; gs = gi; } }
            float l4[4];
#pragma unroll
            for (int i = 0; i < 4; ++i) { float t0 = lg[i];
#pragma unroll
                for (int gi = 1; gi < 4; ++gi) t0 = (gs == gi) ? lg[gi * 4 + i] : t0; l4[i] = t0; }
            int i0 = 0; float b0 = l4[0];
#pragma unroll
            for (int i = 1; i < 4; ++i) if (l4[i] > b0) { b0 = l4[i]; i0 = i; }
            int i1 = 0; float b1 = -3e38f;
#pragma unroll
            for (int i = 0; i < 4; ++i) if (i != i0 && l4[i] > b1) { b1 = l4[i]; i1 = i; }
            const float e1 = __expf(b1 - b0); const float g0 = 1.f / (1.f + e1), g1 = e1 / (1.f + e1);
            u32x4 as; as.x = (unsigned)(gs * 4 + i0); as.y = (unsigned)(gs * 4 + i1); as.z = __float_as_uint(g0); as.w = __float_as_uint(g1);
            asg[F.wave * 16 + lane] = as;
        }
        __syncthreads();
        if (F.wave == 0) {
            const u32x4 A0 = asg[lane], A1 = asg[lane + 64];
            const unsigned ex[4] = {A0.x, A0.y, A1.x, A1.y};
            unsigned rank[4] = {0u, 0u, 0u, 0u}, mycount = 0u;
            const unsigned long long lt = (1ull << lane) - 1ull;
#pragma unroll 1
            for (unsigned e = 0; e < NE; ++e) { unsigned run = 0u;
#pragma unroll
                for (int s = 0; s < 4; ++s) { const unsigned long long m = __ballot(ex[s] == e); if (ex[s] == e) rank[s] = run + (unsigned)__popcll(m & lt); run += (unsigned)__popcll(m); }
                if ((unsigned)lane == e) mycount = run; }
            if (lane < NE) basep[lane] = atomicAdd(cnt + lane, mycount);
            asm volatile("s_waitcnt vmcnt(0) lgkmcnt(0)" ::: "memory");
            const unsigned p0 = basep[ex[0]] + rank[0], p1 = basep[ex[1]] + rank[1], p2 = basep[ex[2]] + rank[2], p3 = basep[ex[3]] + rank[3];
            const int ra = blk * 128 + lane, rb = ra + 64;
            list[ex[0] * T + p0] = ra; list[ex[1] * T + p1] = ra; list[ex[2] * T + p2] = rb; list[ex[3] * T + p3] = rb;
            u32x4 ta, tb; ta.x = (ex[0] << 24) | p0; ta.y = (ex[1] << 24) | p1; ta.z = A0.z; ta.w = A0.w; tb.x = (ex[2] << 24) | p2; tb.y = (ex[3] << 24) | p3; tb.z = A1.z; tb.w = A1.w;
            *(u32x4*)(tokinfo + (size_t)ra * 4) = ta; *(u32x4*)(tokinfo + (size_t)rb * 4) = tb;
        }
        __syncthreads();
    }
}

__device__ __forceinline__ void moe_table(const Args& a, const Frame& F, int l) {
    LAS int* tab = (LAS int*)(F.lds + TAB_OFF);
    const unsigned* cnt = (const unsigned*)(a.ws + WS_CTL) + CW_CNT + l * 64;
    if (F.tid == 0) { int ts = 0; for (int e = 0; e < NE; ++e) { const int c = (int)__hip_atomic_load(cnt + e, RLX_AGENT); tab[e] = ts; tab[NE + 1 + e] = c; ts += (c + TM - 1) / TM; } tab[NE] = ts; }
    __syncthreads();
}

__device__ __forceinline__ void phase_combine_ln2(const Args& a, const Frame& F, int l) {
    bf16_t* xres = (bf16_t*)(a.ws + WS_XRES); const bf16_t* x1 = (const bf16_t*)(a.ws + WS_X1B); const unsigned char* Y = a.ws + WS_Y;   const unsigned* tokinfo = (const unsigned*)(a.ws + WS_TOK); unsigned char* xn = a.ws + WS_XN;
    const float* g = a.ln2_g + l * D; const float* bta = a.ln2_b + l * D; float* out = (l == DEPTH - 1) ? a.out : nullptr;
    const LAS int* tab = (const LAS int*)(F.lds + TAB_OFF);
    const int lane = F.lane;
    const LnGB gb = ln_load_gb(g, bta, lane); const float hbias = (l + 1 < DEPTH) ? a.b_in[(l + 1) * NIN + 1536 + (lane >> 3)] : 0.f;
    int row = F.gw;
    u32x4 tk = *(const u32x4*)(tokinfo + (size_t)row * 4), tkn = tk;
    u32x2 xa[4]; unsigned ya[4], yb[4]; float h0, h1;
    { const size_t s0 = (size_t)tab[tk.x >> 24] * TM + (tk.x & 0xffffff), s1 = (size_t)tab[tk.y >> 24] * TM + (tk.y & 0xffffff);
      h0 = __uint_as_float(tk.z) * (1.f / SC_Y); h1 = __uint_as_float(tk.w) * (1.f / SC_Y);
#pragma unroll
      for (int j = 0; j < 4; ++j) { const int c = 4 * lane + 256 * j; xa[j] = *(const u32x2*)(x1 + (size_t)row * D + c); ya[j] = *(const unsigned*)(Y + s0 * D + c); yb[j] = *(const unsigned*)(Y + s1 * D + c); } }
    if (row + F.ngw < T) tkn = *(const u32x4*)(tokinfo + (size_t)(row + F.ngw) * 4);
    for (; row < T; row += F.ngw) {
        const int rown = row + F.ngw; const bool hasn = rown < T;
        u32x2 xn_[4]; unsigned yan[4], ybn[4]; float h0n = 0.f, h1n = 0.f; u32x4 tknn = tkn;
        if (hasn) { const size_t s0 = (size_t)tab[tkn.x >> 24] * TM + (tkn.x & 0xffffff), s1 = (size_t)tab[tkn.y >> 24] * TM + (tkn.y & 0xffffff);
            h0n = __uint_as_float(tkn.z) * (1.f / SC_Y); h1n = __uint_as_float(tkn.w) * (1.f / SC_Y);
#pragma unroll
            for (int j = 0; j < 4; ++j) { const int c = 4 * lane + 256 * j; xn_[j] = *(const u32x2*)(x1 + (size_t)rown * D + c); yan[j] = *(const unsigned*)(Y + s0 * D + c); ybn[j] = *(const unsigned*)(Y + s1 * D + c); }
            if (rown + F.ngw < T) tknn = *(const u32x4*)(tokinfo + (size_t)(rown + F.ngw) * 4);
        } else {
#pragma unroll
            for (int j = 0; j < 4; ++j) { xn_[j] = xa[j]; yan[j] = ya[j]; ybn[j] = yb[j]; } }
        f32x4 v[4];
#pragma unroll
        for (int j = 0; j < 4; ++j) { const u32x2 xw = xa[j]; const f32x4 xv = {bflo(xw.x), bfhi(xw.x), bflo(xw.y), bfhi(xw.y)};
            const f32x2 a01 = __builtin_amdgcn_cvt_pk_f32_fp8((int)ya[j], false), a23 = __builtin_amdgcn_cvt_pk_f32_fp8((int)ya[j], true), b01 = __builtin_amdgcn_cvt_pk_f32_fp8((int)yb[j], false), b23 = __builtin_amdgcn_cvt_pk_f32_fp8((int)yb[j], true);
            v[j].x = ALPHA * xv.x + h0 * a01[0] + h1 * b01[0]; v[j].y = ALPHA * xv.y + h0 * a01[1] + h1 * b01[1];
            v[j].z = ALPHA * xv.z + h0 * a23[0] + h1 * b23[0]; v[j].w = ALPHA * xv.w + h0 * a23[1] + h1 * b23[1]; }
        ln_rows16(v, gb, lane);
        store_row(v, lane, xres + (size_t)row * D, xn + (size_t)row * D, out ? out + (size_t)row * D : nullptr);
        if (l + 1 < DEPTH) fox_gates_row(a, F, l + 1, v, row, hbias);
#pragma unroll
        for (int j = 0; j < 4; ++j) { xa[j] = xn_[j]; ya[j] = yan[j]; yb[j] = ybn[j]; }
        h0 = h0n; h1 = h1n; tkn = tknn;
    }
}


constexpr int ATT_F2_OFF = 86016;
__device__ __forceinline__ void phase_attn(const Args& a, const Frame& F, char* lds_generic) {
    const int c = F.bid, vcu = (F.G % 8 == 0) ? (c % 8) * (F.G / 8) + c / 8 : c;
    const attn_body::bf16* Q = (const attn_body::bf16*)(a.ws + WS_QO); const attn_body::bf16* K = (const attn_body::bf16*)(a.ws + WS_KV); const attn_body::bf16* V = K + 512;
    attn_body::bf16* O = (attn_body::bf16*)(a.ws + WS_OX8);
    const float* FL = (const float*)(a.ws + WS_FL);
    LAS float* f2 = (LAS float*)(F.lds + ATT_F2_OFF); LAS float* wsum = f2 + 2048;
    { const int bh = vcu >> 1; if (bh >= BATCH * NH) return;
        const int b = bh >> 3, h = bh & 7, tid = F.tid, lane = F.lane, w = F.wave;
        float v[4], run = 0.f;
#pragma unroll
        for (int i = 0; i < 4; ++i) { run += FL[((size_t)b * SEQ + tid * 4 + i) * 8 + h]; v[i] = run; }
        float incl = run;
#pragma unroll
        for (int o = 1; o < 64; o <<= 1) { const float u = __shfl_up(incl, o); if (lane >= o) incl += u; }
        if (lane == 63) wsum[w] = incl;
        __syncthreads();
        float base = incl - run; for (int i = 0; i < w; ++i) base += wsum[i];
        f32x4 o4; o4[0] = (base + v[0]) * LOG2E; o4[1] = (base + v[1]) * LOG2E; o4[2] = (base + v[2]) * LOG2E; o4[3] = (base + v[3]) * LOG2E;
        *(LAS f32x4*)(f2 + tid * 4) = o4;
        __syncthreads();
#ifndef ATT_SPLIT
#define ATT_SPLIT 1
#endif
        const int nun = (vcu & 1) ? 6 : 2; constexpr int ev2 = ATT_SPLIT;
        for (int i = 0; i < nun; ++i) { int qb; if (vcu & 1) { qb = 6 - i; if (qb <= ev2) qb -= 1; } else qb = (i == 0) ? 7 : ev2;
            int tid_u = F.tid; asm volatile("" : "+v"(tid_u));
            attn_body::attn_unit<40>(b, h, qb, Q, K, V, O, lds_generic + RING_OFF, f2, tid_u); }
        __syncthreads();
    }
}

namespace hg {
constexpr int PB = 144;
constexpr int O_QS = 0, O_KS = 9216, O_QI = 18432, O_KUT = 27648, O_VT = 36864, O_P = 46080, O_ST = 55296, O_TOT = 64512, O_EBL = 66560, O_RED = 66816, O_OS = 67328, BYTES = 67328 + 8 * 16 * 80;
__device__ __forceinline__ float ex(float v) { return __builtin_amdgcn_exp2f(v); }
__device__ __forceinline__ unsigned short bf1(float v) { return (unsigned short)pk2(v, v); }
}
__device__ __forceinline__ void phase_hgrn(const Args& a, const Frame& F, int l, int bh) {
    using namespace hg;
    const bf16_t* HB = (const bf16_t*)(a.ws + WS_HB); const float* LOGF = (const float*)(a.ws + WS_LOGF); const bf16_t* HG = (const bf16_t*)(a.ws + WS_HG); unsigned char* O8 = a.ws + WS_OX8;
    LAS unsigned char* L = F.lds + RING_OFF;
    const int b = bh >> 3, h = bh & 7, lane = F.lane, w = F.wave, tid = F.tid;
    const int fr = lane & 15, fq = lane >> 4;
    const int tr = w >> 1, tc0 = 2 * (w & 1);
    const float ng0 = a.norm_g[l * 512 + h * 64 + 16 * tc0 + fr], ng1 = a.norm_g[l * 512 + h * 64 + 16 * (tc0 + 1) + fr];
    f32x4 S0 = {0.f, 0.f, 0.f, 0.f}, S1 = {0.f, 0.f, 0.f, 0.f};
    for (int i = tid; i < 9216 / 4; i += NWAVES * 64) ((LAS unsigned*)(L + O_ST))[i] = 0u;
    const size_t rowbase = (size_t)b * SEQ;
    float g[8]; unsigned qv[8], vv[8];
#pragma unroll
    for (int i = 0; i < 8; ++i) { const size_t row = rowbase + 8 * w + i; g[i] = LOGF[row * 512 + h * 64 + lane]; qv[i] = HB[row * 1024 + h * 64 + lane]; vv[i] = HB[row * 1024 + 512 + h * 64 + lane]; }
    const int orow = 16 * tr + (lane >> 2), ocol = 16 * tc0 + (lane & 3) * 8;
    u32x4 gvn = *(const u32x4*)(HG + (rowbase + orow) * 512 + h * 64 + ocol);
    u32x2 rst = {0u, 0u}; size_t rowst = rowbase;
    for (int c0 = 0; c0 < SEQ; c0 += 64) {
        asm volatile("" : "+v"(g[0]), "+v"(g[1]), "+v"(g[2]), "+v"(g[3]), "+v"(g[4]), "+v"(g[5]), "+v"(g[6]), "+v"(g[7]));
        asm volatile("" : "+v"(qv[0]), "+v"(qv[1]), "+v"(qv[2]), "+v"(qv[3]), "+v"(qv[4]), "+v"(qv[5]), "+v"(qv[6]), "+v"(qv[7]));
        asm volatile("" : "+v"(vv[0]), "+v"(vv[1]), "+v"(vv[2]), "+v"(vv[3]), "+v"(vv[4]), "+v"(vv[5]), "+v"(vv[6]), "+v"(vv[7]));
        u32x4 gv = gvn; asm volatile("" : "+v"(gv));
        if (c0 > 0) *(u32x2*)(O8 + rowst * 1024 + 512 + h * 64 + ocol) = rst;
        float bc[8]; { float run = 0.f;
#pragma unroll
            for (int i = 0; i < 8; ++i) { run += g[i]; bc[i] = run; } }
        ((LAS float*)(L + O_TOT))[w * 64 + lane] = bc[7];
        float qf[8], kf[8];
#pragma unroll
        for (int i = 0; i < 8; ++i) { qf[i] = bf2f(qv[i]); kf[i] = 1.f - ex(g[i]); }
        { u32x4 pk; pk.x = vv[0] | (vv[1] << 16); pk.y = vv[2] | (vv[3] << 16); pk.z = vv[4] | (vv[5] << 16); pk.w = vv[6] | (vv[7] << 16);
          *(LAS u32x4*)(L + O_VT + lane * PB + 16 * w) = pk; }
        __syncthreads();
        float base = 0.f, bm = 0.f, bl = 0.f;
#pragma unroll
        for (int ww = 0; ww < 8; ++ww) { const float tv = ((LAS float*)(L + O_TOT))[ww * 64 + lane]; if (ww < w) base += tv; if (ww < 4) bm += tv; bl += tv; }
        const float ebm = ex(bm), eblm = ex(bl - bm);
        if (w == 0) ((LAS float*)(L + O_EBL))[lane] = ex(bl);
        unsigned short ku[8];
#pragma unroll
        for (int i = 0; i < 8; ++i) { const float x = bc[i] + base - bm; const float e1 = ex(fminf(x, 115.f)), e2 = ex(fminf(-x, 115.f));
            const float qs = qf[i] * e1, ks = kf[i] * e2; const int r = 8 * w + i;
            *(LAS unsigned short*)(L + O_QS + r * PB + 2 * lane) = bf1(qs); *(LAS unsigned short*)(L + O_QI + r * PB + 2 * lane) = bf1(qs * ebm);
            *(LAS unsigned short*)(L + O_KS + r * PB + 2 * lane) = bf1(ks); ku[i] = bf1(ks * eblm); }
        { u32x4 pk; pk.x = (unsigned)ku[0] | ((unsigned)ku[1] << 16); pk.y = (unsigned)ku[2] | ((unsigned)ku[3] << 16); pk.z = (unsigned)ku[4] | ((unsigned)ku[5] << 16); pk.w = (unsigned)ku[6] | ((unsigned)ku[7] << 16);
          *(LAS u32x4*)(L + O_KUT + lane * PB + 16 * w) = pk; }
        if (c0 + 64 < SEQ) {
            gvn = *(const u32x4*)(HG + (rowbase + c0 + 64 + orow) * 512 + h * 64 + ocol);
#pragma unroll
            for (int i = 0; i < 8; ++i) { const size_t row = rowbase + c0 + 64 + 8 * w + i; g[i] = LOGF[row * 512 + h * 64 + lane]; qv[i] = HB[row * 1024 + h * 64 + lane]; vv[i] = HB[row * 1024 + 512 + h * 64 + lane]; }
        }
        __syncthreads();
#pragma unroll
        for (int k2 = 0; k2 < 2; ++k2) { const int idx = 2 * w + k2, ti = idx >> 2, sj = idx & 3;
            f32x4 sc = {0.f, 0.f, 0.f, 0.f};
            if (sj <= ti) {
#pragma unroll
                for (int kk = 0; kk < 2; ++kk) { const bf16x8 af = *(const LAS bf16x8*)(L + O_QS + (16 * ti + fr) * PB + (32 * kk + 8 * fq) * 2), bfr = *(const LAS bf16x8*)(L + O_KS + (16 * sj + fr) * PB + (32 * kk + 8 * fq) * 2);
                    sc = __builtin_amdgcn_mfma_f32_16x16x32_bf16(af, bfr, sc, 0, 0, 0); }
            }
#pragma unroll
            for (int j = 0; j < 4; ++j) { const int t = 16 * ti + 4 * fq + j, s = 16 * sj + fr; *(LAS unsigned short*)(L + O_P + t * PB + 2 * s) = bf1(s <= t ? sc[j] : 0.f); }
        }
        __syncthreads();
        f32x4 o0 = {0.f, 0.f, 0.f, 0.f}, o1 = {0.f, 0.f, 0.f, 0.f}, u0 = {0.f, 0.f, 0.f, 0.f}, u1 = {0.f, 0.f, 0.f, 0.f};
#pragma unroll
        for (int kk = 0; kk < 2; ++kk) { const int ko = (32 * kk + 8 * fq) * 2;
            const bf16x8 pa = *(const LAS bf16x8*)(L + O_P + (16 * tr + fr) * PB + ko), qa = *(const LAS bf16x8*)(L + O_QI + (16 * tr + fr) * PB + ko), ka = *(const LAS bf16x8*)(L + O_KUT + (16 * tr + fr) * PB + ko);
            const bf16x8 v0 = *(const LAS bf16x8*)(L + O_VT + (16 * tc0 + fr) * PB + ko), v1 = *(const LAS bf16x8*)(L + O_VT + (16 * (tc0 + 1) + fr) * PB + ko);
            const bf16x8 s0 = *(const LAS bf16x8*)(L + O_ST + (16 * tc0 + fr) * PB + ko), s1 = *(const LAS bf16x8*)(L + O_ST + (16 * (tc0 + 1) + fr) * PB + ko);
            o0 = __builtin_amdgcn_mfma_f32_16x16x32_bf16(pa, v0, o0, 0, 0, 0); o1 = __builtin_amdgcn_mfma_f32_16x16x32_bf16(pa, v1, o1, 0, 0, 0);
            o0 = __builtin_amdgcn_mfma_f32_16x16x32_bf16(qa, s0, o0, 0, 0, 0); o1 = __builtin_amdgcn_mfma_f32_16x16x32_bf16(qa, s1, o1, 0, 0, 0);
            u0 = __builtin_amdgcn_mfma_f32_16x16x32_bf16(ka, v0, u0, 0, 0, 0); u1 = __builtin_amdgcn_mfma_f32_16x16x32_bf16(ka, v1, u1, 0, 0, 0); }
        { const f32x4 dec = *(const LAS f32x4*)(L + O_EBL + (16 * tr + 4 * fq) * 4); S0 = S0 * dec + u0; S1 = S1 * dec + u1; }
        { f32x4 q2 = o0 * o0 + o1 * o1;
#pragma unroll
          for (int j = 0; j < 4; ++j) { float t = q2[j]; t += lane_xor1(t); t += lane_xor2(t); t += dppmov<0x124>(t); t += dppmov<0x128>(t); q2[j] = t; }
          if (fr == 0) {
#pragma unroll
              for (int j = 0; j < 4; ++j) ((LAS float*)(L + O_RED))[(16 * tr + 4 * fq + j) * 2 + (w & 1)] = q2[j]; } }
        __syncthreads();
        { u32x2 p0, p1; p0.x = pk2(S0[0], S0[1]); p0.y = pk2(S0[2], S0[3]); p1.x = pk2(S1[0], S1[1]); p1.y = pk2(S1[2], S1[3]);
          *(LAS u32x2*)(L + O_ST + (16 * tc0 + fr) * PB + (16 * tr + 4 * fq) * 2) = p0; *(LAS u32x2*)(L + O_ST + (16 * (tc0 + 1) + fr) * PB + (16 * tr + 4 * fq) * 2) = p1; }
        { LAS unsigned char* os = L + O_OS + w * (16 * 80);
#pragma unroll
          for (int j = 0; j < 4; ++j) { const int t = 16 * tr + 4 * fq + j; const f32x2 rr = *(const LAS f32x2*)(L + O_RED + t * 8); const float rs = rsqrtf((rr[0] + rr[1]) * (1.f / 64.f) + RMS_EPS);
              *(LAS unsigned short*)(os + (4 * fq + j) * 80 + 2 * fr) = bf1(o0[j] * rs * ng0); *(LAS unsigned short*)(os + (4 * fq + j) * 80 + 2 * (16 + fr)) = bf1(o1[j] * rs * ng1); }
          asm volatile("s_waitcnt lgkmcnt(0)" ::: "memory");
          const u32x4 ov = *(const LAS u32x4*)(os + (lane >> 2) * 80 + (lane & 3) * 16);
          const size_t row = rowbase + c0 + orow;
          u32x2 r; r.x = pg8::pack4_fp8(bflo(ov.x) * bflo(gv.x) * SC_HGRN, bfhi(ov.x) * bfhi(gv.x) * SC_HGRN, bflo(ov.y) * bflo(gv.y) * SC_HGRN, bfhi(ov.y) * bfhi(gv.y) * SC_HGRN);
          r.y = pg8::pack4_fp8(bflo(ov.z) * bflo(gv.z) * SC_HGRN, bfhi(ov.z) * bfhi(gv.z) * SC_HGRN, bflo(ov.w) * bflo(gv.w) * SC_HGRN, bfhi(ov.w) * bfhi(gv.w) * SC_HGRN);
          rst = r; rowst = row;
          asm volatile("s_waitcnt lgkmcnt(0)" ::: "memory"); }
    }
    *(u32x2*)(O8 + rowst * 1024 + 512 + h * 64 + ocol) = rst;
}


constexpr int PH_PER_LAYER = 10, N_PHASES = 1 + DEPTH * PH_PER_LAYER;
#ifndef MK_ONE_LAUNCH
#define MK_ONE_LAUNCH 1
#endif
#ifndef MK_FAST_ATTN
#define MK_FAST_ATTN 0
#endif
#ifndef MK_FAST_HGRN
#define MK_FAST_HGRN 0
#endif


#ifdef DBG_DUMP
#ifndef DBG_WHAT
#define DBG_WHAT 0
#endif
__device__ __forceinline__ void dbg_dump(const Args& a, const Frame& F) {
    unsigned char* ws = a.ws;
    const bf16_t *QO = (bf16_t*)(ws + WS_QO), *KV = (bf16_t*)(ws + WS_KV), *HB = (bf16_t*)(ws + WS_HB), *HG = (bf16_t*)(ws + WS_HG), *G = (bf16_t*)(ws + WS_G);
    const bf16_t *U1 = (bf16_t*)(ws + WS_U1), *U = (bf16_t*)(ws + WS_U), *MIXED = (bf16_t*)(ws + WS_MIXED), *XN = (bf16_t*)(ws + WS_XN);
    const float *LOGF = (float*)(ws + WS_LOGF), *FL = (float*)(ws + WS_FL), *XRES = (float*)(ws + WS_XRES);
    for (size_t i = (size_t)F.bid * 512 + F.tid; i < (size_t)T * D; i += (size_t)gridDim.x * 512) {
        const size_t row = i >> 10; const int c = (int)(i & 1023);
        float v = 0.f;
        if (DBG_WHAT == 9) { v = bf2f(G[row * 2048 + c]) + bf2f(G[row * 2048 + 1024 + c]); }
        else if (DBG_DUMP == 1) { v = bf2f(KV[i]) + bf2f(HB[i]) + bf2f(G[row * 2048 + c]) + bf2f(G[row * 2048 + 1024 + c]);
            if (c < 512) v += LOGF[row * 512 + c] + bf2f(HG[row * 512 + c]) + bf2f(QO[i]); if (c < 8) v += FL[row * 8 + c]; }
        else if (DBG_DUMP == 2) { v = (c >= 512) ? bf2f(QO[i]) : 0.f; }
        else if (DBG_DUMP == 3) { v = bf2f(QO[i]); }
        else if (DBG_DUMP == 4) { v = bf2f(U1[i]); }
        else if (DBG_DUMP == 5) { v = bf2f(U[i]); }
        else if (DBG_DUMP == 6) { v = bf2f(MIXED[i]); }
        else if (DBG_DUMP == 7) { v = XRES[i] + bf2f(XN[i]); }
        a.out[i] = v;
    }
}
#endif
#define PH_BEGIN const Args a = LOAD_ARGS(); Frame F; F.lds = lds0; F.lane = (int)__builtin_amdgcn_mbcnt_hi(~0u, __builtin_amdgcn_mbcnt_lo(~0u, 0u)); asm volatile("" : "+v"(F.lane)); F.wave = __builtin_amdgcn_readfirstlane((int)((const volatile LAS unsigned*)(lds0 + WTAB_OFF))[hw_wave_key()]); F.tid = F.wave * 64 + F.lane; \
    F.G = gridDim.x; F.bid = blockIdx.x; asm volatile("" : "+s"(F.bid)); F.gw = F.bid * NWAVES + F.wave; F.ngw = F.G * NWAVES; unsigned char* const ws = a.ws; const LAS int* tab = (const LAS int*)(F.lds + TAB_OFF); (void)tab; (void)ws;
#ifdef DBG_DUMP
#define IN(k) (lo <= (k) && (k) < hi && (k) <= DBG_DUMP)
#else
#define IN(k) (lo <= (k) && (k) < hi)
#endif
#ifdef DBG_REPEAT
#define REP(k) for (int rep_ = 0; rep_ < ((DBG_REPEAT == (k) && !((k) == 9 && l == DEPTH - 1)) ? 2 : 1); ++rep_, __syncthreads())
#else
#define REP(k)
#endif
#define SEAM(k) do { if (IN(k) && IN((k) + 1)) { XcdBarrier b2_ = bar; { size_t z_ = 0; asm volatile("" : "+s"(z_), "+s"(b2_.x)); b2_.bar = bar.bar + z_; } xcd_barrier(b2_); } } while (0)
#ifdef DBG_MIX
#define MIX_STAMP(k) do { if (blockIdx.x == DBG_MIX_BID && threadIdx.x == 0) { const unsigned long long t_ = __builtin_amdgcn_s_memrealtime(); volatile LAS unsigned long long* d_ = (volatile LAS unsigned long long*)(lds0 + 131072 + 512); if ((k) > 0) d_[8 + (k)] = d_[8 + (k)] + (t_ - d_[8]); d_[8] = t_; } } while (0)
#else
#define MIX_STAMP(k) do {} while (0)
#endif
template <int l>
__device__ __forceinline__ void layer_body(const Args& args, const int lo, const int hi, const XcdBarrier& bar, LAS unsigned char* const lds0, unsigned char* lds_raw) {
        const int pb = 1 + l * PH_PER_LAYER;

#ifdef DBG_DUMP
        if (l == 0 && lo <= DBG_DUMP + 1 && DBG_DUMP + 1 < hi) { PH_BEGIN dbg_dump(a, F); }
#endif
        if (IN(pb + 0)) REP(0) { PH_BEGIN MIX_STAMP(0);
            pg8::Gemm g{(bf16_t*)(ws + WS_XN), (bf16_t*)(ws + wset(l) + WO_WIN), D / 2, D / 2, D / 2, E8_1, E8_W}; pg8::StaticOrder S; S.init(T, NINP, F.G, F.bid);
            pg8::EpiInproj E{ws, l};
            pg8::gemm_phase<pg8::EpiInproj, pg8::StaticOrder, PG8_ALIGN>(F.lds + RING_OFF, g, S, E, F.tid);
            MIX_STAMP(9);
        }
        SEAM(pb + 0);
        if (IN(pb + 1)) REP(1) { PH_BEGIN
            const int vcu = (F.G % 8 == 0) ? (F.bid % 8) * (F.G / 8) + F.bid / 8 : F.bid;
            MIX_STAMP(0);
            if ((vcu & 1) == 0 && (vcu >> 1) < BATCH * NH) { phase_hgrn(a, F, l, vcu >> 1); __syncthreads(); }
            MIX_STAMP(1);
            phase_attn(a, F, (char*)lds_raw);
            MIX_STAMP(2);
            if (l + 1 < DEPTH) { __syncthreads(); convert_layer(a, F, l + 1, F.gw, F.ngw); }
            MIX_STAMP(3);
        }
        SEAM(pb + 1);
        MIX_STAMP(4);
        if (IN(pb + 3)) REP(3) { PH_BEGIN
            pg8::Gemm g{(bf16_t*)(ws + WS_OX8), (bf16_t*)(ws + wset(l) + WO_WBR), D / 2, D / 2, 256, E8_FOX, E8_W}; pg8::StaticOrder S; S.init(T, D, F.G, F.bid);
            pg8::EpiGate<1> E{(bf16_t*)(ws + WS_U1), nullptr, ws + WS_G, nullptr, 0.f};
            pg8::gemm_phase<pg8::EpiGate<1>, pg8::StaticOrder, PG8_ALIGN>(F.lds + RING_OFF, g, S, E, F.tid);
        }
        if (IN(pb + 3) && IN(pb + 4)) __syncthreads(); else SEAM(pb + 3);
        if (IN(pb + 4)) REP(4) { PH_BEGIN
            pg8::Gemm g{(bf16_t*)(ws + WS_OX8) + 256, (bf16_t*)(ws + wset(l) + WO_WBR) + 256, D / 2, D / 2, 256, E8_HGRN, E8_W}; pg8::StaticOrder S; S.init(T, D, F.G, F.bid);
            pg8::EpiGate<2> E{(bf16_t*)(ws + WS_U), nullptr, ws + WS_G + 1024, ws + WS_U1, 0.f};
            pg8::gemm_phase<pg8::EpiGate<2>, pg8::StaticOrder, PG8_ALIGN>(F.lds + RING_OFF, g, S, E, F.tid);
        }
        SEAM(pb + 4);
        if (IN(pb + 5)) REP(5) { PH_BEGIN
            pg8::Gemm g{(bf16_t*)(ws + WS_U), (bf16_t*)(ws + wset(l) + WO_WMIX), D / 2, D / 2, D / 2, E8_U, E8_W}; pg8::StaticOrder S; S.init(T, D, F.G, F.bid);
            pg8::EpiGate<0> E{(bf16_t*)(ws + WS_MIXED), a.b_mix + l * D, nullptr, nullptr, SC_MIX};
            pg8::gemm_phase<pg8::EpiGate<0>, pg8::StaticOrder, PG8_ALIGN>(F.lds + RING_OFF, g, S, E, F.tid);
        }
        SEAM(pb + 5);
        if (IN(pb + 6)) REP(6) { PH_BEGIN MIX_STAMP(0); phase_ln1_router(a, F, l); MIX_STAMP(5); }
        SEAM(pb + 6);
        if (IN(pb + 7)) REP(7) { PH_BEGIN MIX_STAMP(0);
            moe_table(a, F, l);
            pg8::Gemm g{(bf16_t*)(ws + WS_XN), (bf16_t*)(ws + wset(l) + WO_W13), D / 2, D / 2, D / 2, E8_1, E8_W}; pg8::MoeOrder<true> S{F.G, F.bid, 8, tab, (const int*)(ws + WS_LIST), (size_t)2048 * (D / 2), (const LAS int*)(F.lds + TOK_OFF)};
            S.preload_tokens((LAS int*)(F.lds + TOK_OFF), F.tid); __syncthreads();
            pg8::EpiUp E{(bf16_t*)(ws + WS_H)};
            pg8::gemm_phase<pg8::EpiUp, pg8::MoeOrder<true>, PG8_ALIGN>(F.lds + RING_OFF, g, S, E, F.tid);
            MIX_STAMP(6);
        }
        SEAM(pb + 7);
        if (IN(pb + 8)) REP(8) { PH_BEGIN MIX_STAMP(0);
            moe_table(a, F, l);
            pg8::Gemm g{(bf16_t*)(ws + WS_H), (bf16_t*)(ws + wset(l) + WO_W2), D / 2, D / 2, D / 2, E8_H, E8_W}; pg8::MoeOrder<false> S{F.G, F.bid, 4, tab, nullptr, (size_t)D * (D / 2), nullptr};
            pg8::EpiGate<0> E{(bf16_t*)(ws + WS_Y), (const float*)(ws + WS_CTL + 524288)  , nullptr, nullptr, SC_Y};
            pg8::gemm_phase<pg8::EpiGate<0>, pg8::MoeOrder<false>, PG8_ALIGN>(F.lds + RING_OFF, g, S, E, F.tid);
            MIX_STAMP(7);
        }
        SEAM(pb + 8);
        if (IN(pb + 9)) REP(9) { PH_BEGIN MIX_STAMP(0);
            if (l + 1 < DEPTH) load_wff(a, F, l + 1);
            moe_table(a, F, l);
            phase_combine_ln2(a, F, l);
            MIX_STAMP(8);
        }
        SEAM(pb + 9);
    }

__global__ void __launch_bounds__(NWAVES * 64, 2) mk_fwd(Args args) {
    extern __shared__ __attribute__((aligned(16))) unsigned char lds_raw[];
    LAS unsigned char* const lds0 = (LAS unsigned char*)lds_raw;
    volatile LAS unsigned* MISC = (volatile LAS unsigned*)(lds0 + MISC_OFF);
    for (int u = threadIdx.x; u < (LDS_BYTES - LDSCTL_OFF) / 4; u += NWAVES * 64) ((LAS unsigned*)(lds0 + LDSCTL_OFF))[u] = 0u;
    __syncthreads();
    if ((threadIdx.x & 63) == 0) ((volatile LAS unsigned*)(lds0 + WTAB_OFF))[hw_wave_key()] = threadIdx.x >> 6;
    __syncthreads();
    unsigned* ctl = (unsigned*)(args.ws + WS_CTL);
    XcdBarrier bar; bar.bar = ctl + CW_BAR; bar.x = 0; bar.st = nullptr;
    if (args.use_bar) bar = xcd_barrier_post(ctl + CW_BAR, MISC + 8);
    const int lo = args.ph_lo, hi = args.ph_hi;


    if (IN(0)) { PH_BEGIN phase_prep(a, F); }
    SEAM(0);
    layer_body<0>(args, lo, hi, bar, lds0, lds_raw); layer_body<1>(args, lo, hi, bar, lds0, lds_raw); layer_body<2>(args, lo, hi, bar, lds0, lds_raw); layer_body<3>(args, lo, hi, bar, lds0, lds_raw);
#ifdef DBG_MIX
    if (blockIdx.x == DBG_MIX_BID && threadIdx.x == 0) { volatile LAS unsigned long long* d_ = (volatile LAS unsigned long long*)(lds0 + 131072 + 512); const unsigned long long val = d_[8 + DBG_MIX] / 100ull;
        const unsigned long long t0 = __builtin_amdgcn_s_memrealtime(); while (__builtin_amdgcn_s_memrealtime() - t0 < val * 100ull) __builtin_amdgcn_s_sleep(20); }
#endif
#ifdef DBG_SEG
    if (blockIdx.x == 0 && threadIdx.x == 0) { volatile LAS unsigned long long* d_ = (volatile LAS unsigned long long*)(lds0 + 131072 + 512); const unsigned long long cyc = d_[4], n = d_[5];
        const unsigned long long val = cyc / (n ? n : 1);
        const unsigned long long t0 = __builtin_amdgcn_s_memrealtime(); while (__builtin_amdgcn_s_memrealtime() - t0 < val * 100ull) __builtin_amdgcn_s_sleep(20); }
#endif
#ifdef DBG_CLK
    if (blockIdx.x == 0 && threadIdx.x == 0) { volatile LAS unsigned long long* d_ = (volatile LAS unsigned long long*)(lds0 + 131072 + 512); const unsigned long long cyc = d_[0], rt = d_[1], n = d_[2];
        const unsigned long long val = (DBG_CLK == 1) ? cyc / (n ? n : 1) : (DBG_CLK == 2) ? cyc * 100ull / (rt ? rt : 1) : rt / 100ull;
        const unsigned long long t0 = __builtin_amdgcn_s_memrealtime(); while (__builtin_amdgcn_s_memrealtime() - t0 < val * 100ull) __builtin_amdgcn_s_sleep(20); }
#endif
#undef IN
#undef SEAM
}

extern "C" void kernel_launch(void* const* d_in, const int* in_sizes, int n_in, void* d_out, int out_size, void* d_ws, size_t ws_size, hipStream_t stream) {
    static int grid = 0;
    if (grid == 0) {
        if (n_in != 20 || in_sizes[0] != T * D || out_size != T * D || ws_size < WS_END) { fprintf(stderr, "kernel_launch: unexpected shapes (n_in %d, ws %zu)\n", n_in, ws_size); grid = -1; return; }
        int dev = 0, cus = 0, per_cu = 0;
        if (hipGetDevice(&dev) != hipSuccess || hipDeviceGetAttribute(&cus, hipDeviceAttributeMultiprocessorCount, dev) != hipSuccess) { grid = -1; return; }
        if (hipFuncSetAttribute((const void*)mk_fwd, hipFuncAttributeMaxDynamicSharedMemorySize, LDS_BYTES) != hipSuccess) { fprintf(stderr, "kernel_launch: hipFuncSetAttribute failed\n"); grid = -1; return; }
        if (hipOccupancyMaxActiveBlocksPerMultiprocessor(&per_cu, (const void*)mk_fwd, NWAVES * 64, LDS_BYTES) != hipSuccess || per_cu < 1)
            fprintf(stderr, "kernel_launch: note: occupancy query reports %d workgroups per CU\n", per_cu);
        (void)hipGetLastError();
        grid = cus;
    }
    if (grid < 0) return;
    if (hipMemsetAsync((char*)d_ws + WS_CTL, 0, CTL_BYTES, stream) != hipSuccess) return;
    Args a{};
    a.x = (const float*)d_in[0]; a.ln_in_g = (const float*)d_in[1]; a.ln_in_b = (const float*)d_in[2]; a.w_in = (const float*)d_in[3]; a.b_in = (const float*)d_in[4];
    a.w_fox = (const float*)d_in[5]; a.lbl = (const float*)d_in[6]; a.norm_g = (const float*)d_in[7]; a.w_hgrn = (const float*)d_in[8]; a.w_mix = (const float*)d_in[9];
    a.b_mix = (const float*)d_in[10]; a.ln1_g = (const float*)d_in[11]; a.ln1_b = (const float*)d_in[12]; a.router_w = (const float*)d_in[13]; a.router_b = (const float*)d_in[14];
    a.w1 = (const float*)d_in[15]; a.w3 = (const float*)d_in[16]; a.w2 = (const float*)d_in[17]; a.ln2_g = (const float*)d_in[18]; a.ln2_b = (const float*)d_in[19];
    a.out = (float*)d_out; a.ws = (unsigned char*)d_ws; a.pad = 0;
#if MK_ONE_LAUNCH
    a.ph_lo = 0; a.ph_hi = N_PHASES; a.use_bar = 1;
    hipLaunchKernelGGL(mk_fwd, dim3(grid), dim3(NWAVES * 64), LDS_BYTES, stream, a);
#else
#ifdef DBG_DUMP
    const int np_ = DBG_DUMP + 2;
#else
    const int np_ = N_PHASES;
#endif
    for (int p = 0; p < np_; ++p) { a.ph_lo = p; a.ph_hi = p + 1; a.use_bar = 0;
        hipLaunchKernelGGL(mk_fwd, dim3(grid), dim3(NWAVES * 64), LDS_BYTES, stream, a); }
#endif
    const hipError_t le = hipPeekAtLastError();
    if (le != hipSuccess) fprintf(stderr, "kernel_launch: launch failed: %s\n", hipGetErrorName(le));
}
```

```cpp
#define MK_ONE_LAUNCH 1
#define MK_FAST_ATTN 1
#define MK_FAST_HGRN 1
#define PG8_SPFORM 1
#include <hip/hip_runtime.h>
#include <cstdio>
#include <cstdint>

typedef unsigned short bf16_t;
typedef short bf16x8 __attribute__((ext_vector_type(8)));
typedef float f32x4 __attribute__((ext_vector_type(4)));
typedef float f32x2 __attribute__((ext_vector_type(2)));
typedef unsigned u32x4 __attribute__((ext_vector_type(4)));
typedef unsigned u32x2 __attribute__((ext_vector_type(2)));
#define LAS __attribute__((address_space(3)))
#define GAS __attribute__((address_space(1)))

constexpr int BATCH = 16, SEQ = 2048, T = BATCH * SEQ, D = 1024, DEPTH = 4, NH = 8, HD = 64, NIN = 5640, NINP = 5632, NE = 16;
constexpr float LN_EPS = 1e-5f, RMS_EPS = 1e-6f;
constexpr float ALPHA = 1.681792830507429f;
constexpr float LOG2E = 1.4426950408889634f;
constexpr float C2 = 0.125f * LOG2E;
constexpr float SC_W = 64.f, SC_FOX = 16.f, SC_HGRN = 4.f, SC_U = 64.f, SC_H = 8.f, SC_MIX = 32.f, SC_Y = 64.f, SC_G = 256.f;
constexpr int E8_1 = 0x7f7f7f7f, E8_W = 0x79797979, E8_FOX = 0x7b7b7b7b, E8_HGRN = 0x7d7d7d7d, E8_U = 0x79797979, E8_H = 0x7c7c7c7c;
constexpr int TM = 256;

constexpr size_t MiB = 1u << 20;
constexpr size_t WS_CTL = 0, CTL_BYTES = 1 * MiB;
constexpr size_t WS_MISC = 1 * MiB;
constexpr size_t WS_WSET = 2 * MiB, WSET_BYTES = 56 * MiB;
constexpr size_t WO_WIN = 0, WO_WBR = 6 * MiB, WO_WMIX = 7 * MiB, WO_W13 = 8 * MiB, WO_W2 = 40 * MiB;
__host__ __device__ constexpr size_t wset(int l) { return WS_WSET + (size_t)(l & 1) * WSET_BYTES; }
__host__ __device__ constexpr size_t biasoff(int l) { return WS_MISC + 16384 + (size_t)(l & 1) * 32768; }
constexpr size_t WS_XRES = 114 * MiB, WS_XN = 242 * MiB, WS_QO = 306 * MiB, WS_KV = 370 * MiB, WS_HB = 434 * MiB, WS_LOGF = 498 * MiB;
constexpr size_t WS_HG = 562 * MiB, WS_G = 594 * MiB, WS_FL = 722 * MiB, WS_F2 = 723 * MiB, WS_U1 = 724 * MiB, WS_U = 788 * MiB, WS_MIXED = 852 * MiB;
constexpr size_t WS_LIST = 916 * MiB, WS_TOK = 918 * MiB, WS_X1B = 920 * MiB, WS_END = 984 * MiB;
constexpr size_t WS_OX8 = 274 * MiB;
constexpr size_t WS_H = WS_QO, WS_Y = 442 * MiB;
constexpr int CW_CNT = 1024;
constexpr int CW_BAR = 4096;

__device__ __forceinline__ unsigned f2bf(float f) { unsigned u = __builtin_bit_cast(unsigned, f); return (u + 0x7fffu + ((u >> 16) & 1u)) >> 16; }
__device__ __forceinline__ float bf2f(unsigned h) { return __builtin_bit_cast(float, h << 16); }
__device__ __forceinline__ float bflo(unsigned w) { return __builtin_bit_cast(float, w << 16); }
__device__ __forceinline__ float bfhi(unsigned w) { return __builtin_bit_cast(float, w & 0xffff0000u); }
typedef __bf16 bf16x2v_t __attribute__((ext_vector_type(2)));
__device__ __forceinline__ unsigned pk2(float lo, float hi) { f32x2 v = {lo, hi}; bf16x2v_t b = __builtin_convertvector(v, bf16x2v_t); return __builtin_bit_cast(unsigned, b); }
template <int CTRL> __device__ __forceinline__ float dppmov(float v) { return __builtin_bit_cast(float, __builtin_amdgcn_update_dpp(0, __builtin_bit_cast(int, v), CTRL, 0xf, 0xf, true)); }
__device__ __forceinline__ float lane_xor1(float v) { return dppmov<0xB1>(v); }
__device__ __forceinline__ float lane_xor2(float v) { return dppmov<0x4E>(v); }
__device__ __forceinline__ float lane_xor4(float v) { return dppmov<0x1B>(dppmov<0x141>(v)); }
__device__ __forceinline__ float lane_xor8(float v) { return dppmov<0x128>(v); }
#ifndef RS32_A
#define RS32_A a
#define RS32_B b
#endif
#ifndef RS16_A
#define RS16_A a
#define RS16_B b
#endif
#ifdef DBG_OLD_RS16
__device__ __forceinline__ float rs_step16(float a, float b) { const bool hi = (__builtin_amdgcn_mbcnt_hi(~0u, __builtin_amdgcn_mbcnt_lo(~0u, 0u)) & 16) != 0; const float snd = hi ? a : b; const float rcv = __shfl_xor(snd, 16); return (hi ? b : a) + rcv; }
#else
__device__ __forceinline__ float rs_step16(float a, float b) { asm volatile("s_nop 1\n\tv_permlane16_swap_b32 %0, %1" : "+v"(a), "+v"(b)); return a + b; }
#endif
#ifdef DBG_OLD_RS32
__device__ __forceinline__ float rs_step32(float a, float b) { const bool hi = (__builtin_amdgcn_mbcnt_hi(~0u, __builtin_amdgcn_mbcnt_lo(~0u, 0u)) & 32) != 0; const float snd = hi ? a : b; const float rcv = __shfl_xor(snd, 32); return (hi ? b : a) + rcv; }
#else
__device__ __forceinline__ float rs_step32(float a, float b) { asm volatile("s_nop 1\n\tv_permlane32_swap_b32 %0, %1" : "+v"(a), "+v"(b)); return a + b; }
#endif
#ifdef DBG_OLD_X48
#undef DBG_OLD_X48
__device__ __forceinline__ float lane_xor4b(float v) { return __shfl_xor(v, 4); }
__device__ __forceinline__ float lane_xor8b(float v) { return __shfl_xor(v, 8); }
#define lane_xor4 lane_xor4b
#define lane_xor8 lane_xor8b
#endif
__device__ __forceinline__ float wave_sum(float v) {
    v += lane_xor1(v); v += lane_xor2(v); v += dppmov<0x124>(v); v += dppmov<0x128>(v);
    v = rs_step16(v, v); return rs_step32(v, v);
}
__device__ __forceinline__ float wave_max(float v) {
#pragma unroll
    for (int o = 1; o < 64; o <<= 1) v = fmaxf(v, __shfl_xor(v, o));
    return v;
}
__device__ __forceinline__ float fast_exp(float v) { return __builtin_amdgcn_exp2f(v * LOG2E); }
__device__ __forceinline__ float sigmoidf_(float v) { return __builtin_amdgcn_rcpf(1.0f + fast_exp(-v)); }
__device__ __forceinline__ float siluf_(float v) { return v * sigmoidf_(v); }
__device__ __forceinline__ float logsigmoidf_(float v) { return fminf(v, 0.f) - __logf(1.0f + fast_exp(-fabsf(v))); }

#ifndef MOE_XCD_CHUNK
#define MOE_XCD_CHUNK 0
#endif
#ifndef P_NT
#define P_NT true
#endif
#ifndef PG8_ZC
#define PG8_ZC 1
#endif
#ifndef PG8_WGM
#define PG8_WGM 8
#endif
#ifndef PG8_ALIGN
#define PG8_ALIGN true
#endif
#ifndef PG8_SPFORM
#define PG8_SPFORM 0
#endif
namespace pg8 {
constexpr int BM = 256, BK = 64, HALF = 128, HTB = HALF * BK * 2  , STAGE_BYTES = 8 * HTB, NXCD = 8, WGM = PG8_WGM;
__host__ __device__ __forceinline__ int lds_byte(int r, int c) { const int st = (r >> 4) * 2 + (c >> 5), rr = r & 15, cc = c & 31, ob = rr * 64 + cc * 2; return st * 1024 + (ob ^ (((ob >> 9) & 1) << 5)); }
__host__ __device__ __forceinline__ void stage_rc(int b, int& R, int& C) { const int st = b / 1024, sb = b % 1024, swz = sb ^ (((sb >> 9) & 1) << 5); R = (st >> 1) * 16 + swz / 64; C = (st & 1) * 32 + (swz % 64) / 2; }
__host__ __device__ __forceinline__ int perm32(int rho) { const int n = rho >> 4, i = rho & 15; return 8 * (i >> 2) + 4 * n + (i & 3); }

struct Unit { int pm, pn, e; };
struct Gemm { const bf16_t* A; const bf16_t* Bt; int lda, ldb, K; int sa, sb; };

struct StaticOrder {
    static constexpr bool GATHER = false;
    int nM, nN, nwg, G, c;
    __device__ void init(int M, int N, int G_, int c_) { nM = M / BM; nN = N / BM; nwg = nM * nN; G = G_; c = c_; }
    __device__ bool next(int i, Unit& u) const {
        const int L = i * G + c; if (L >= nwg) return false;
        int wgid = L; { const int q = nwg / NXCD, r = nwg % NXCD, xcd = wgid % NXCD, off = wgid / NXCD; wgid = (xcd < r ? xcd * (q + 1) : r * (q + 1) + (xcd - r) * q) + off; }
        const int nig = WGM * nN, gid = wgid / nig, fm = gid * WGM, gsz = (nM - fm) < WGM ? (nM - fm) : WGM;
        u.pm = fm + ((wgid % nig) % gsz); u.pn = (wgid % nig) / gsz; u.e = 0; return true;
    }
    __device__ __forceinline__ const char* a_tile(const Gemm& g, const Unit& u) const { return (const char*)g.A + (size_t)u.pm * BM * g.lda * 2; }
    __device__ __forceinline__ const char* b_tile(const Gemm& g, const Unit& u) const { return (const char*)g.Bt + (size_t)u.pn * BM * g.ldb * 2; }
    __device__ __forceinline__ void a_voff(const Gemm& g, const Unit&, int, const int (&R)[2], const int (&C)[2], unsigned (&v)[2][2]) const {
#pragma unroll
        for (int h = 0; h < 2; ++h)
#pragma unroll
            for (int i = 0; i < 2; ++i) v[h][i] = (unsigned)((h * HALF + R[i]) * g.lda + C[i]) * 2u;
    }
};
template <bool GATHER_> struct MoeOrder {
    static constexpr bool GATHER = GATHER_; static constexpr bool gather = GATHER_;
    int G, c, nN; const LAS int* tab; const int* list; size_t bstride; const LAS int* tok;
    __device__ bool next(int i, Unit& u) const {
#if MOE_XCD_CHUNK
        const int NT = tab[NE]; int rt;
        if (G == 256) { const int x = c >> 5, j = c & 31; const int r0 = (x * NT) >> 3, r1 = ((x + 1) * NT) >> 3; const int Lx = i * 32 + j; rt = r0 + Lx / nN; if (rt >= r1) return false; u.pn = __builtin_amdgcn_readfirstlane(Lx % nN); }
        else { const int L = i * G + c; rt = L / nN; if (rt >= NT) return false; u.pn = __builtin_amdgcn_readfirstlane(L % nN); }
        int e = 0;
#pragma unroll
        for (int k = 1; k < NE; ++k) e += (rt >= tab[k]) ? 1 : 0;
        u.pm = __builtin_amdgcn_readfirstlane(rt); u.e = __builtin_amdgcn_readfirstlane(e); return true;
#else
        const int L = i * G + c; const int rt = L / nN; const int NT = tab[NE]; if (rt >= NT) return false;
        int e = 0;
#pragma unroll
        for (int k = 1; k < NE; ++k) e += (rt >= tab[k]) ? 1 : 0;
        u.pm = __builtin_amdgcn_readfirstlane(rt); u.pn = __builtin_amdgcn_readfirstlane(L % nN); u.e = __builtin_amdgcn_readfirstlane(e); return true;
#endif
    }
    __device__ __forceinline__ const char* a_tile(const Gemm& g, const Unit& u) const { return gather ? (const char*)g.A : (const char*)g.A + (size_t)u.pm * BM * g.lda * 2; }
    __device__ __forceinline__ const char* b_tile(const Gemm& g, const Unit& u) const { return (const char*)g.Bt + ((size_t)u.e * bstride + (size_t)u.pn * BM * g.ldb) * 2; }
    __device__ __forceinline__ void a_voff(const Gemm& g, const Unit& u, int ui, const int (&R)[2], const int (&C)[2], unsigned (&v)[2][2]) const {
#pragma unroll
        for (int h = 0; h < 2; ++h)
#pragma unroll
            for (int i = 0; i < 2; ++i) {
                if (gather) { const int tk = tok[ui * BM + h * HALF + R[i]]; v[h][i] = (unsigned)(tk * g.lda + C[i]) * 2u; }
                else v[h][i] = (unsigned)((h * HALF + R[i]) * g.lda + C[i]) * 2u;
            }
    }
    __device__ __forceinline__ void preload_tokens(LAS int* tokw, int tid) const {
        const int slot = __builtin_amdgcn_readfirstlane(tid >> 8), r = tid & 255;
        int v[5]; bool ok[5];
#pragma unroll
        for (int k = 0; k < 5; ++k) { Unit u; ok[k] = next(slot + 2 * k, u); v[k] = 0;
            if (ok[k]) { const int ts = tab[u.e], cn = tab[NE + 1 + u.e]; const int pos = (u.pm - ts) * BM + r; if (pos < cn) v[k] = list[u.e * T + pos]; } }
#pragma unroll
        for (int k = 0; k < 5; ++k) if (ok[k]) tokw[(slot + 2 * k) * BM + r] = v[k];
    }
};

typedef __bf16 bf16x2_t __attribute__((ext_vector_type(2)));
__device__ __forceinline__ unsigned cvt_pk_bf16(float lo, float hi) { f32x2 v = {lo, hi}; bf16x2_t b = __builtin_convertvector(v, bf16x2_t); return __builtin_bit_cast(unsigned, b); }
__device__ __forceinline__ u32x4 pack8(const f32x4& v0, const f32x4& v1) { u32x4 w; w.x = cvt_pk_bf16(v0[0], v0[1]); w.y = cvt_pk_bf16(v0[2], v0[3]); w.z = cvt_pk_bf16(v1[0], v1[1]); w.w = cvt_pk_bf16(v1[2], v1[3]); return w; }
__device__ __forceinline__ void unpack8(const u32x4& w, f32x4& v0, f32x4& v1) { v0[0] = bflo(w.x); v0[1] = bfhi(w.x); v0[2] = bflo(w.y); v0[3] = bfhi(w.y); v1[0] = bflo(w.z); v1[1] = bfhi(w.z); v1[2] = bflo(w.w); v1[3] = bfhi(w.w); }
typedef int v8i __attribute__((ext_vector_type(8)));
typedef int v4i __attribute__((ext_vector_type(4)));
__device__ __forceinline__ u32x2 pack8_fp8(const f32x4& v0, const f32x4& v1) {
    u32x2 w; int t = 0; t = __builtin_amdgcn_cvt_pk_fp8_f32(v0[0], v0[1], t, false); t = __builtin_amdgcn_cvt_pk_fp8_f32(v0[2], v0[3], t, true); w.x = (unsigned)t;
    int t2 = 0; t2 = __builtin_amdgcn_cvt_pk_fp8_f32(v1[0], v1[1], t2, false); t2 = __builtin_amdgcn_cvt_pk_fp8_f32(v1[2], v1[3], t2, true); w.y = (unsigned)t2; return w; }
__device__ __forceinline__ unsigned pack4_fp8(float a, float b, float c, float d) { int t = 0; t = __builtin_amdgcn_cvt_pk_fp8_f32(a, b, t, false); t = __builtin_amdgcn_cvt_pk_fp8_f32(c, d, t, true); return (unsigned)t; }
__device__ __forceinline__ f32x4 sig4(const f32x4& v) { const f32x4 t = v * (-LOG2E); f32x4 e; e[0] = __builtin_amdgcn_exp2f(t[0]); e[1] = __builtin_amdgcn_exp2f(t[1]); e[2] = __builtin_amdgcn_exp2f(t[2]); e[3] = __builtin_amdgcn_exp2f(t[3]); const f32x4 d = e + 1.0f; f32x4 o; o[0] = __builtin_amdgcn_rcpf(d[0]); o[1] = __builtin_amdgcn_rcpf(d[1]); o[2] = __builtin_amdgcn_rcpf(d[2]); o[3] = __builtin_amdgcn_rcpf(d[3]); return o; }
template <int LG> __device__ __forceinline__ f32x4 sig4s(const f32x4& v) {
    const f32x4 t = v * (-LOG2E) - (float)LG; f32x4 e; e[0] = __builtin_amdgcn_exp2f(t[0]); e[1] = __builtin_amdgcn_exp2f(t[1]); e[2] = __builtin_amdgcn_exp2f(t[2]); e[3] = __builtin_amdgcn_exp2f(t[3]);
    const f32x4 d = e + (1.0f / (float)(1 << LG)); f32x4 o; o[0] = __builtin_amdgcn_rcpf(d[0]); o[1] = __builtin_amdgcn_rcpf(d[1]); o[2] = __builtin_amdgcn_rcpf(d[2]); o[3] = __builtin_amdgcn_rcpf(d[3]); return o; }

__device__ __forceinline__ void gld16(f32x4& r, const void* p) { asm volatile("global_load_dwordx4 %0, %1, off" : "=v"(r) : "v"(p) : "memory"); }
__device__ __forceinline__ void gld16u(u32x4& r, const void* p) { asm volatile("global_load_dwordx4 %0, %1, off" : "=v"(r) : "v"(p) : "memory"); }
__device__ __forceinline__ void gld16u_nt(u32x4& r, const void* p) { asm volatile("global_load_dwordx4 %0, %1, off nt" : "=v"(r) : "v"(p) : "memory"); }
__device__ __forceinline__ void gld16x4s(u32x4& r0, u32x4& r1, u32x4& r2, u32x4& r3, const void* sbase, unsigned voff) {
    asm volatile("global_load_dwordx4 %0, %4, %5\n\tglobal_load_dwordx4 %1, %4, %5 offset:16\n\tglobal_load_dwordx4 %2, %4, %5 offset:512\n\tglobal_load_dwordx4 %3, %4, %5 offset:528"
                 : "=&v"(r0), "=&v"(r1), "=&v"(r2), "=&v"(r3) : "v"(voff), "s"(sbase) : "memory"); }
template <bool NT> __device__ __forceinline__ void gld16x2s(u32x4& r0, u32x4& r1, const void* sbase, unsigned voff) {
    if (NT) asm volatile("global_load_dwordx4 %0, %2, %3 nt\n\tglobal_load_dwordx4 %1, %2, %3 offset:256 nt" : "=&v"(r0), "=&v"(r1) : "v"(voff), "s"(sbase) : "memory");
    else    asm volatile("global_load_dwordx4 %0, %2, %3\n\tglobal_load_dwordx4 %1, %2, %3 offset:256" : "=&v"(r0), "=&v"(r1) : "v"(voff), "s"(sbase) : "memory"); }
#define PRE_PARAMS u32x4& p0, u32x4& p1, u32x4& p2, u32x4& p3, u32x2& e0, u32x2& e1, u32x2& e2, u32x2& e3, u32x2& e4, u32x2& e5, u32x2& e6, u32x2& e7, u32x2& e8, u32x2& e9, u32x2& e10, u32x2& e11, u32x2& e12, u32x2& e13, u32x2& e14, u32x2& e15
#define PRE_CPARAMS const u32x4& p0, const u32x4& p1, const u32x4& p2, const u32x4& p3, const u32x2& e0, const u32x2& e1, const u32x2& e2, const u32x2& e3, const u32x2& e4, const u32x2& e5, const u32x2& e6, const u32x2& e7, const u32x2& e8, const u32x2& e9, const u32x2& e10, const u32x2& e11, const u32x2& e12, const u32x2& e13, const u32x2& e14, const u32x2& e15
#define PRE_ARGS p0, p1, p2, p3, e0, e1, e2, e3, e4, e5, e6, e7, e8, e9, e10, e11, e12, e13, e14, e15
template <bool NT> __device__ __forceinline__ void gld8x2s(u32x2& r0, u32x2& r1, const void* sbase, unsigned voff) {
    if (NT) asm volatile("global_load_dwordx2 %0, %2, %3 nt\n\tglobal_load_dwordx2 %1, %2, %3 offset:128 nt" : "=&v"(r0), "=&v"(r1) : "v"(voff), "s"(sbase) : "memory");
    else    asm volatile("global_load_dwordx2 %0, %2, %3\n\tglobal_load_dwordx2 %1, %2, %3 offset:128" : "=&v"(r0), "=&v"(r1) : "v"(voff), "s"(sbase) : "memory"); }
#define GWAITE8(n, a, b, c, d, e, f, g, h) asm volatile("s_waitcnt vmcnt(" #n ")" : "+v"(a), "+v"(b), "+v"(c), "+v"(d), "+v"(e), "+v"(f), "+v"(g), "+v"(h) :: "memory")
__device__ __forceinline__ void unpack8_fp8(const u32x2& w, float sc, f32x4& v0, f32x4& v1) {
    const f32x2 a = __builtin_amdgcn_cvt_pk_f32_fp8((int)w.x, false), b = __builtin_amdgcn_cvt_pk_f32_fp8((int)w.x, true), c = __builtin_amdgcn_cvt_pk_f32_fp8((int)w.y, false), d = __builtin_amdgcn_cvt_pk_f32_fp8((int)w.y, true);
    v0 = (f32x4){a[0], a[1], b[0], b[1]} * sc; v1 = (f32x4){c[0], c[1], d[0], d[1]} * sc; }
#define GWAITN4(n, a, b, c, d) asm volatile("s_waitcnt vmcnt(" #n ")" : "+v"(a), "+v"(b), "+v"(c), "+v"(d) :: "memory")
#define GWAITN8(n, q) asm volatile("s_waitcnt vmcnt(" #n ")" : "+v"(q[0]), "+v"(q[1]), "+v"(q[2]), "+v"(q[3]), "+v"(q[4]), "+v"(q[5]), "+v"(q[6]), "+v"(q[7]) :: "memory")
#define GWAIT4F(a, b, c, d) asm volatile("s_waitcnt vmcnt(0)" : "+v"(a), "+v"(b), "+v"(c), "+v"(d) :: "memory")
#define GWAIT4U(a, b, c, d) asm volatile("s_waitcnt vmcnt(0)" : "+v"(a), "+v"(b), "+v"(c), "+v"(d) :: "memory")
#ifndef EPI_WT
#define EPI_WT 0
#endif
__device__ __forceinline__ void st8(void* p, const u32x2& v) {
    if (EPI_WT) __hip_atomic_store((unsigned long long*)p, __builtin_bit_cast(unsigned long long, v), __ATOMIC_RELAXED, __HIP_MEMORY_SCOPE_AGENT);
    else *(u32x2*)p = v; }
#ifdef EPI_NT_GATES
#define EPI_ST_G(T, addr, val) __builtin_nontemporal_store((val), (T*)(addr))
#else
#define EPI_ST_G(T, addr, val) (*(T*)(addr) = (val))
#endif
#ifdef EPI_NT_INPROJ
#define EPI_ST_IN(T, addr, val) __builtin_nontemporal_store((val), (T*)(addr))
#else
#define EPI_ST_IN(T, addr, val) (*(T*)(addr) = (val))
#endif
struct EpiInproj {
    static constexpr bool PERM = true;
    static constexpr int DBGID = 0;
    static constexpr int NPRE = 4, NVM = 16;
    unsigned char* ws; int layer;
    __device__ __forceinline__ void prefetch(PRE_PARAMS, const Unit& u, int wr, int wc, int fr, int fq) const {
        gld16x4s(p0, p1, p2, p3, ws + biasoff(layer), (unsigned)(u.pn * BM + wc * 32 + 8 * fq) * 4u); }
    template <int KIND> __device__ __forceinline__ void tile(const f32x4 (&acc)[2][2][4][2], const Unit& u, int wr, int wc, int fr, int fq, unsigned char* w, const f32x4 (&bv)[2][2]) const {
        const int row0 = u.pm * BM + wr * 64 + fr, bcol0 = u.pn * BM + wc * 32 + 8 * fq;
        f32x4 lbv[2][2];
        if (KIND == 4) { const float* lb = (const float*)(w + WS_MISC) + layer * 512;
#pragma unroll
            for (int bj = 0; bj < 2; ++bj)
#pragma unroll
                for (int n = 0; n < 2; ++n) gld16(lbv[bj][n], lb + (bcol0 - 2048) + bj * HALF + 4 * n);
            GWAIT4F(lbv[0][0], lbv[0][1], lbv[1][0], lbv[1][1]); }
#pragma unroll
        for (int ai = 0; ai < 2; ++ai)
#pragma unroll
            for (int m = 0; m < 4; ++m) { const size_t row = (size_t)(row0 + ai * HALF + m * 16);
#pragma unroll
                for (int bj = 0; bj < 2; ++bj) { f32x4 v0 = acc[ai][bj][m][0] + bv[bj][0], v1 = acc[ai][bj][m][1] + bv[bj][1]; const int col = bcol0 + bj * HALF;
                    if (KIND == 0) { EPI_ST_IN(u32x4, (bf16_t*)(w + WS_QO) + row * 1024 + col, pack8(v0 * C2, v1 * C2)); }
                    else if (KIND == 1) { EPI_ST_IN(u32x4, (bf16_t*)(w + WS_KV) + row * 1024 + (col - 512), pack8(v0, v1)); }
                    else if (KIND == 2) { EPI_ST_IN(u32x4, (bf16_t*)(w + WS_KV) + row * 1024 + 512 + (col - 1024), pack8(v0, v1)); }
                    else if (KIND == 3) { EPI_ST_IN(u32x4, (bf16_t*)(w + WS_HB) + row * 1024 + (col - 1536), pack8(v0 * sig4(v0), v1 * sig4(v1))); }
                    else if (KIND == 4) { const int c = col - 2048; const f32x4 l0 = lbv[bj][0], l1 = lbv[bj][1];
                        f32x4 f0 = l0 + (1.f - l0) * sig4(v0), f1 = l1 + (1.f - l1) * sig4(v1);
#pragma unroll
                        for (int q = 0; q < 4; ++q) { f0[q] = __builtin_amdgcn_logf(f0[q]); f1[q] = __builtin_amdgcn_logf(f1[q]); }
                        float* LOGF = (float*)(w + WS_LOGF); EPI_ST_IN(f32x4, LOGF + row * 512 + c, f0); EPI_ST_IN(f32x4, LOGF + row * 512 + c + 4, f1); }
                    else if (KIND == 5) { EPI_ST_IN(u32x4, (bf16_t*)(w + WS_HB) + row * 1024 + 512 + (col - 2560), pack8(v0, v1)); }
                    else if (KIND == 6) { EPI_ST_IN(u32x4, (bf16_t*)(w + WS_HG) + row * 512 + (col - 3072), pack8(v0 * sig4(v0), v1 * sig4(v1))); }
                    else { f32x4 t0 = acc[ai][bj][m][0] * (-LOG2E) + (bv[bj][0] * (-LOG2E) - 8.f), t1 = acc[ai][bj][m][1] * (-LOG2E) + (bv[bj][1] * (-LOG2E) - 8.f);
#pragma unroll
                        for (int q = 0; q < 4; ++q) { t0[q] = __builtin_amdgcn_exp2f(t0[q]); t1[q] = __builtin_amdgcn_exp2f(t1[q]); }
                        t0 = t0 + (1.0f / SC_G); t1 = t1 + (1.0f / SC_G);
#pragma unroll
                        for (int q = 0; q < 4; ++q) { t0[q] = __builtin_amdgcn_rcpf(t0[q]); t1[q] = __builtin_amdgcn_rcpf(t1[q]); }
                        EPI_ST_G(u32x2, (unsigned char*)(w + WS_G) + row * 2048 + (col - 3584), pack8_fp8(t0, t1)); }
                } }
    }
    __device__ __forceinline__ void operator()(const f32x4 (&acc)[2][2][4][2], const Unit& u, int wr, int wc, int fr, int fq, PRE_CPARAMS) const {
        f32x4 pre[2][2]; pre[0][0] = __builtin_bit_cast(f32x4, p0); pre[0][1] = __builtin_bit_cast(f32x4, p1); pre[1][0] = __builtin_bit_cast(f32x4, p2); pre[1][1] = __builtin_bit_cast(f32x4, p3);
        size_t z_ = 0; asm volatile("" : "+s"(z_)); unsigned char* w = ws + z_;
        const int ct = u.pn;
        if (ct < 2) tile<0>(acc, u, wr, wc, fr, fq, w, pre); else if (ct < 4) tile<1>(acc, u, wr, wc, fr, fq, w, pre); else if (ct < 6) tile<2>(acc, u, wr, wc, fr, fq, w, pre);
        else if (ct < 8) tile<3>(acc, u, wr, wc, fr, fq, w, pre); else if (ct < 10) tile<4>(acc, u, wr, wc, fr, fq, w, pre); else if (ct < 12) tile<5>(acc, u, wr, wc, fr, fq, w, pre);
        else if (ct < 14) tile<6>(acc, u, wr, wc, fr, fq, w, pre); else tile<7>(acc, u, wr, wc, fr, fq, w, pre);
    }
};
template <int MODE> struct EpiGate {
    static constexpr bool PERM = true;
    static constexpr int DBGID = 1 + MODE;
    static constexpr int NPRE = (MODE == 0) ? 4 : 16, NVM = 16;
    bf16_t* O; const float* bias; const unsigned char* G8; const unsigned char* P8; float osc;
    __device__ __forceinline__ void group(const f32x4 (&acc)[2][2][4][2], int g, int row0, int col0, const u32x2& g00, const u32x2& g01, const u32x2& g10, const u32x2& g11, const u32x2& q00, const u32x2& q01, const u32x2& q10, const u32x2& q11) const {
        const int ai = g >> 1;
#pragma unroll
        for (int mm = 0; mm < 2; ++mm)
#pragma unroll
            for (int bj = 0; bj < 2; ++bj) { const int m = (g & 1) * 2 + mm; const size_t row = (size_t)(row0 + ai * HALF + m * 16); const int col = col0 + bj * HALF;
                f32x4 v0 = acc[ai][bj][m][0], v1 = acc[ai][bj][m][1];
                f32x4 g0, g1; unpack8_fp8(mm ? (bj ? g11 : g10) : (bj ? g01 : g00), SC_U / SC_G, g0, g1); v0 *= g0; v1 *= g1;
                if (MODE == 2) { f32x4 q0, q1; unpack8_fp8(mm ? (bj ? q11 : q10) : (bj ? q01 : q00), 1.f, q0, q1); v0 += q0; v1 += q1; }
                st8((unsigned char*)O + row * 1024 + col, pack8_fp8(v0, v1)); }
    }
    __device__ __forceinline__ unsigned goff(int row0, int col0, int g, int mm) const { return (unsigned)(row0 + (g >> 1) * HALF + ((g & 1) * 2 + mm) * 16) * 2048u + (unsigned)col0; }
    __device__ __forceinline__ unsigned poff(int row0, int col0, int g, int mm) const { return (unsigned)(row0 + (g >> 1) * HALF + ((g & 1) * 2 + mm) * 16) * 1024u + (unsigned)col0; }
    __device__ __forceinline__ void prefetch(PRE_PARAMS, const Unit& u, int wr, int wc, int fr, int fq) const {
        const int row0 = u.pm * BM + wr * 64 + fr, col0 = u.pn * BM + wc * 32 + 8 * fq;
        if (MODE == 0) gld16x4s(p0, p1, p2, p3, bias, (unsigned)col0 * 4u);
        else if (MODE == 1) {
            gld8x2s<false>(e0, e1, G8, goff(row0, col0, 0, 0)); gld8x2s<false>(e2, e3, G8, goff(row0, col0, 0, 1)); gld8x2s<false>(e4, e5, G8, goff(row0, col0, 1, 0)); gld8x2s<false>(e6, e7, G8, goff(row0, col0, 1, 1));
            gld8x2s<false>(e8, e9, G8, goff(row0, col0, 2, 0)); gld8x2s<false>(e10, e11, G8, goff(row0, col0, 2, 1)); gld8x2s<false>(e12, e13, G8, goff(row0, col0, 3, 0)); gld8x2s<false>(e14, e15, G8, goff(row0, col0, 3, 1));
        } else {
            gld8x2s<false>(e0, e1, G8, goff(row0, col0, 0, 0)); gld8x2s<false>(e2, e3, G8, goff(row0, col0, 0, 1)); gld8x2s<false>(e4, e5, G8, goff(row0, col0, 1, 0)); gld8x2s<false>(e6, e7, G8, goff(row0, col0, 1, 1));
            gld8x2s<false>(e8, e9, G8, goff(row0, col0, 2, 0)); gld8x2s<false>(e10, e11, G8, goff(row0, col0, 2, 1)); gld8x2s<false>(e12, e13, G8, goff(row0, col0, 3, 0)); gld8x2s<false>(e14, e15, G8, goff(row0, col0, 3, 1));
        }
    }
    __device__ __forceinline__ void operator()(const f32x4 (&acc)[2][2][4][2], const Unit& u, int wr, int wc, int fr, int fq, PRE_CPARAMS) const {
        const int row0 = u.pm * BM + wr * 64 + fr, col0 = u.pn * BM + wc * 32 + 8 * fq;
        if (MODE == 0) {
            f32x4 bv[2][2]; bv[0][0] = __builtin_bit_cast(f32x4, p0); bv[0][1] = __builtin_bit_cast(f32x4, p1); bv[1][0] = __builtin_bit_cast(f32x4, p2); bv[1][1] = __builtin_bit_cast(f32x4, p3);
#pragma unroll
            for (int ai = 0; ai < 2; ++ai)
#pragma unroll
                for (int m = 0; m < 4; ++m)
#pragma unroll
                    for (int bj = 0; bj < 2; ++bj) { const size_t row = (size_t)(row0 + ai * HALF + m * 16); const int col = col0 + bj * HALF;
                        const f32x4 v0 = acc[ai][bj][m][0] + bv[bj][0], v1 = acc[ai][bj][m][1] + bv[bj][1];
                        if (osc != 0.f) st8((unsigned char*)O + row * 1024 + col, pack8_fp8(v0 * osc, v1 * osc));
                        else *(u32x4*)(O + row * 1024 + col) = pack8(v0, v1); }
        } else if (MODE == 1) {
            group(acc, 0, row0, col0, e0, e1, e2, e3, e0, e0, e0, e0); group(acc, 1, row0, col0, e4, e5, e6, e7, e0, e0, e0, e0);
            group(acc, 2, row0, col0, e8, e9, e10, e11, e0, e0, e0, e0); group(acc, 3, row0, col0, e12, e13, e14, e15, e0, e0, e0, e0);
        } else {
            u32x2 a0, a1, a2, a3, a4, a5, a6, a7, b0, b1, b2, b3, b4, b5, b6, b7;
            gld8x2s<P_NT>(a0, a1, P8, poff(row0, col0, 0, 0)); gld8x2s<P_NT>(a2, a3, P8, poff(row0, col0, 0, 1)); gld8x2s<P_NT>(a4, a5, P8, poff(row0, col0, 1, 0)); gld8x2s<P_NT>(a6, a7, P8, poff(row0, col0, 1, 1));
            gld8x2s<P_NT>(b0, b1, P8, poff(row0, col0, 2, 0)); gld8x2s<P_NT>(b2, b3, P8, poff(row0, col0, 2, 1)); gld8x2s<P_NT>(b4, b5, P8, poff(row0, col0, 3, 0)); gld8x2s<P_NT>(b6, b7, P8, poff(row0, col0, 3, 1));
            GWAITN4(12, a0, a1, a2, a3); group(acc, 0, row0, col0, e0, e1, e2, e3, a0, a1, a2, a3);
            GWAITN4(12, a4, a5, a6, a7); group(acc, 1, row0, col0, e4, e5, e6, e7, a4, a5, a6, a7);
            GWAITN4(12, b0, b1, b2, b3); group(acc, 2, row0, col0, e8, e9, e10, e11, b0, b1, b2, b3);
            GWAITN4(12, b4, b5, b6, b7); group(acc, 3, row0, col0, e12, e13, e14, e15, b4, b5, b6, b7);
        }
    }
};
struct EpiUp {
    static constexpr bool PERM = true;
    static constexpr int DBGID = 4;
    static constexpr int NPRE = 0, NVM = 8;
    bf16_t* H;
    __device__ __forceinline__ void prefetch(PRE_PARAMS, const Unit&, int, int, int, int) const {}
    __device__ __forceinline__ void operator()(const f32x4 (&acc)[2][2][4][2], const Unit& u, int wr, int wc, int fr, int fq, PRE_CPARAMS) const {
        const int row0 = u.pm * BM + wr * 64 + fr, col = u.pn * HALF + wc * 32 + 8 * fq;
#pragma unroll
        for (int ai = 0; ai < 2; ++ai)
#pragma unroll
            for (int m = 0; m < 4; ++m) { const size_t row = (size_t)(row0 + ai * HALF + m * 16);
                const f32x4 a0 = acc[ai][0][m][0], a1 = acc[ai][0][m][1], b0 = acc[ai][1][m][0], b1 = acc[ai][1][m][1];
                st8((unsigned char*)H + row * 1024 + col, pack8_fp8(a0 * sig4s<3>(a0) * b0, a1 * sig4s<3>(a1) * b1)); }
    }
};

__device__ __forceinline__ void glds16s(const char* sbase, unsigned voff, unsigned lds_dst) {
    unsigned keep;
    asm volatile("s_mov_b32 %0, m0\n\ts_mov_b32 m0, %3\n\ts_nop 0\n\tglobal_load_lds_dwordx4 %1, %2\n\ts_mov_b32 m0, %0" : "=&s"(keep) : "v"(voff), "s"(sbase), "s"(lds_dst) : "memory");
}
template <class Epi, class Sched, bool ALIGN_EPI>
__device__ __forceinline__ void gemm_phase(LAS unsigned char* lds, const Gemm g, const Sched& S, const Epi& E, const int tid) {
    const int wid = __builtin_amdgcn_readfirstlane(tid >> 6), lane = tid & 63, wr = wid >> 2, wc = wid & 3, fr = lane & 15, fq = lane >> 4;
    int K = g.K; asm volatile("" : "+s"(K));
    const int nt = K / BK;
    int RA[2], CA[2]; unsigned voffB[2];
#pragma unroll
    for (int i = 0; i < 2; ++i) { int R, C; stage_rc(tid * 16 + i * 8192, R, C); const int Rb = Epi::PERM ? ((R & ~31) + perm32(R & 31)) : R;
        RA[i] = R; CA[i] = C; voffB[i] = (unsigned)(Rb * g.ldb + C) * 2u; }
    const size_t kstep = (size_t)(BK * 2);
    const size_t hstepB = (size_t)HALF * g.ldb * 2;
    const unsigned ldsw = (unsigned)wid * 1024u;
    const unsigned ldsb = (unsigned)__builtin_amdgcn_readfirstlane((int)((unsigned)(uintptr_t)lds + ldsw));
    const int aoff = lds_byte(wr * 64 + fr, fq * 8), boff = lds_byte(wc * 32 + fr, fq * 8);
#define PG8_SA(b, h) (((b) * 2 + (h)) * HTB)
#define PG8_SB(b, h) ((4 + (b) * 2 + (h)) * HTB)
#define PG8_STAGE(bufoff, gbase, voff) do { _Pragma("unroll") for (int _i = 0; _i < 2; ++_i) glds16s((const char*)(gbase), (voff)[_i], ldsb + (unsigned)((bufoff) + _i * 8192)); } while (0)
#define PG8_LD8(p) __builtin_shufflevector(*(const LAS v4i*)(p), *(const LAS v4i*)((p) + 1024), 0, 1, 2, 3, 4, 5, 6, 7)
#define PG8_LDA(dst, b, h) do { _Pragma("unroll") for (int m = 0; m < 4; ++m) dst[m] = PG8_LD8(lds + PG8_SA(b, h) + aoff + m * 2048); } while (0)
#define PG8_LDB(dst, b, h) do { _Pragma("unroll") for (int n = 0; n < 2; ++n) dst[n] = PG8_LD8(lds + PG8_SB(b, h) + boff + n * 2048); } while (0)
#ifndef PG8_PRIO
#define PG8_PRIO 1
#endif
#define PG8_MMA(ai, bj, At, Bt) do { if (PG8_PRIO) __builtin_amdgcn_s_setprio(1); _Pragma("unroll") for (int m = 0; m < 4; ++m) _Pragma("unroll") for (int n = 0; n < 2; ++n) \
        asm volatile("v_mfma_scale_f32_16x16x128_f8f6f4 %0, %1, %2, %0, %3, %4 op_sel_hi:[0,0,0]" : "+v"(acc[ai][bj][m][n]) : "v"(Bt[n]), "v"(At[m]), "v"(sbv), "v"(sav)); \
        if (PG8_PRIO) __builtin_amdgcn_s_setprio(0); } while (0)
#define PG8_MMA0(ai, bj, At, Bt) do { if (PG8_PRIO) __builtin_amdgcn_s_setprio(1); _Pragma("unroll") for (int m = 0; m < 4; ++m) _Pragma("unroll") for (int n = 0; n < 2; ++n) \
        asm volatile("v_mfma_scale_f32_16x16x128_f8f6f4 %0, %1, %2, 0, %3, %4 op_sel_hi:[0,0,0]" : "=&v"(acc[ai][bj][m][n]) : "v"(Bt[n]), "v"(At[m]), "v"(sbv), "v"(sav)); \
        if (PG8_PRIO) __builtin_amdgcn_s_setprio(0); } while (0)
#define PG8_WAIT_V(n) asm volatile("s_waitcnt vmcnt(" #n ")" ::: "memory")
#define PG8_WAIT_VS(n) do { const int n_ = (n); if (n_ == 12) PG8_WAIT_V(12); else if (n_ == 16) PG8_WAIT_V(16); else if (n_ == 20) PG8_WAIT_V(20); else if (n_ == 24) PG8_WAIT_V(24); else if (n_ == 28) PG8_WAIT_V(28); else PG8_WAIT_V(8); } while (0)
#define PG8_WAIT_VN(n) do { const int n_ = (n); if (n_ == 10) PG8_WAIT_V(10); else if (n_ == 14) PG8_WAIT_V(14); else if (n_ == 16) PG8_WAIT_V(16); else if (n_ == 20) PG8_WAIT_V(20); else if (n_ == 22) PG8_WAIT_V(22); else if (n_ == 24) PG8_WAIT_V(24); else if (n_ == 28) PG8_WAIT_V(28); else PG8_WAIT_V(6); } while (0)
#define PG8_WAIT_L(n) asm volatile("s_waitcnt lgkmcnt(" #n ")" ::: "memory")
#define PG8_BAR __builtin_amdgcn_s_barrier()
#ifdef DBG_SEG
#ifndef DBG_SEG_WAVE
#define DBG_SEG_WAVE 0
#endif
#define SEG_ME ((Epi::DBGID == DBG_SEG_SEL) && blockIdx.x == 0 && wid == DBG_SEG_WAVE)
#define SEG_BEGIN(k, cond) do { if ((k) == DBG_SEG && SEG_ME && (cond)) { asm volatile("s_memtime %0\n\ts_waitcnt lgkmcnt(0)" : "=s"(seg_t0) :: "memory"); } } while (0)
#define SEG_END(k, cond) do { if ((k) == DBG_SEG && SEG_ME && (cond)) { unsigned long long t1_; asm volatile("s_memtime %0\n\ts_waitcnt lgkmcnt(0)" : "=s"(t1_) :: "memory"); seg_sum += t1_ - seg_t0; seg_cnt += 1; } } while (0)
#else
#define SEG_BEGIN(k, cond) do {} while (0)
#define SEG_END(k, cond) do {} while (0)
#endif
#ifndef PG8_NOSCHED
#define PG8_SCHED __builtin_amdgcn_sched_barrier(0)
#else
#define PG8_SCHED do {} while (0)
#endif
    Unit cur, nxt; int ui = 0;
    if (!S.next(0, cur)) return;
#ifdef DBG_SEG
    unsigned long long seg_t0 = 0, seg_sum = 0; unsigned seg_cnt = 0;
#endif
    u32x4 p0 = {0u, 0u, 0u, 0u}, p1 = p0, p2 = p0, p3 = p0;
    u32x2 e0 = {0u, 0u}, e1 = e0, e2 = e0, e3 = e0, e4 = e0, e5 = e0, e6 = e0, e7 = e0, e8 = e0, e9 = e0, e10 = e0, e11 = e0, e12 = e0, e13 = e0, e14 = e0, e15 = e0;
    f32x4 acc[2][2][4][2];
#if !(PG8_ZC && PG8_SPFORM)
#pragma unroll
    for (int a = 0; a < 2; ++a)
#pragma unroll
        for (int b = 0; b < 2; ++b)
#pragma unroll
            for (int m = 0; m < 4; ++m)
#pragma unroll
                for (int n = 0; n < 2; ++n) acc[a][b][m][n] = (f32x4){0.f, 0.f, 0.f, 0.f};
#endif
    int sav = g.sa, sbv = g.sb;
    v8i At[4], B0[2], B1[2];
    unsigned vA[2][2], nvA[2][2];
    S.a_voff(g, cur, 0, RA, CA, vA);
    const char* cA = S.a_tile(g, cur); const char* cB = S.b_tile(g, cur);
#if PG8_SPFORM
    PG8_STAGE(PG8_SB(0, 0), cB, voffB); PG8_STAGE(PG8_SB(0, 1), cB + hstepB, voffB); PG8_STAGE(PG8_SA(0, 0), cA, vA[0]); PG8_STAGE(PG8_SA(0, 1), cA, vA[1]);
    if (wr == 1) PG8_BAR;
    PG8_WAIT_V(2); PG8_BAR;
#else
    PG8_STAGE(PG8_SB(0, 0), cB, voffB); PG8_STAGE(PG8_SA(0, 0), cA, vA[0]); PG8_STAGE(PG8_SB(0, 1), cB + hstepB, voffB); PG8_STAGE(PG8_SA(0, 1), cA, vA[1]);
    if (wr == 1) PG8_BAR;
    PG8_WAIT_V(4); PG8_BAR;
#endif
    PG8_STAGE(PG8_SB(1, 0), cB + kstep, voffB); PG8_STAGE(PG8_SA(1, 0), cA + kstep, vA[0]); PG8_STAGE(PG8_SB(1, 1), cB + hstepB + kstep, voffB);
    PG8_WAIT_V(6); PG8_BAR;
    for (;;) {
        const bool has_next = S.next(ui + 1, nxt);
        const char* nA = has_next ? S.a_tile(g, nxt) : cA; const char* nB = has_next ? S.b_tile(g, nxt) : cB;
        if constexpr (Sched::GATHER) {
            if (has_next) { int RA2[2], CA2[2];
#pragma unroll
                for (int i = 0; i < 2; ++i) { int tq = tid; asm volatile("" : "+v"(tq)); stage_rc(tq * 16 + i * 8192, RA2[i], CA2[i]); }
                S.a_voff(g, nxt, ui + 1, RA2, CA2, nvA); }
            else {
#pragma unroll
                for (int h = 0; h < 2; ++h)
#pragma unroll
                    for (int i = 0; i < 2; ++i) nvA[h][i] = vA[h][i]; }
        }
#ifdef DBG_CLK
#ifdef DBG_CLK_SKIP1
#define DBG_CLK_SKIPN 2
#else
#define DBG_CLK_SKIPN 0
#endif
        const bool dbg_me_ = (Epi::DBGID == DBG_CLK_SEL) && blockIdx.x == 0 && wid == 0;
        unsigned long long dc0_ = 0, dr0_ = 0; if (dbg_me_) { dc0_ = __builtin_amdgcn_s_memtime(); dr0_ = __builtin_amdgcn_s_memrealtime(); }
#endif
#if PG8_SPFORM
        for (int t = 0; t < nt; t += 2) {
            const bool last = (t == nt - 2);
            const int xs = (ui > 0 && t == 0) ? Epi::NVM : 0, xp = (last && Epi::NPRE) ? Epi::NPRE : 0;
            const char* a1 = cA + (size_t)(t + 1) * kstep;
            const char* a2 = last ? nA : cA + (size_t)(t + 2) * kstep; const char* b2 = last ? nB : cB + (size_t)(t + 2) * kstep;
            const char* a3 = a2 + kstep; const char* b3 = b2 + kstep;
            unsigned wA0[2], wA1[2];
#pragma unroll
            for (int i = 0; i < 2; ++i) { if constexpr (Sched::GATHER) { wA0[i] = last ? nvA[0][i] : vA[0][i]; wA1[i] = last ? nvA[1][i] : vA[1][i]; } else { wA0[i] = vA[0][i]; wA1[i] = vA[1][i]; } }
            PG8_LDB(B0, 0, 0); PG8_LDB(B1, 0, 1); PG8_SCHED; PG8_LDA(At, 0, 0); PG8_STAGE(PG8_SA(1, 1), a1, vA[1]);
            if (Epi::NPRE) { if (last) E.prefetch(PRE_ARGS, cur, wr, wc, fr, fq); }
            PG8_WAIT_VS(8 + xs + xp); PG8_WAIT_L(0); PG8_BAR; if (PG8_ZC && t == 0) { PG8_MMA0(0, 0, At, B0); PG8_MMA0(0, 1, At, B1); } else { PG8_MMA(0, 0, At, B0); PG8_MMA(0, 1, At, B1); } PG8_BAR; PG8_SCHED;
            PG8_LDA(At, 0, 1); PG8_STAGE(PG8_SB(0, 0), b2, voffB); PG8_STAGE(PG8_SB(0, 1), b2 + hstepB, voffB); PG8_STAGE(PG8_SA(0, 0), a2, wA0);
            PG8_WAIT_VS(8 + xs + xp); PG8_WAIT_L(0); PG8_BAR; if (PG8_ZC && t == 0) { PG8_MMA0(1, 0, At, B0); PG8_MMA0(1, 1, At, B1); } else { PG8_MMA(1, 0, At, B0); PG8_MMA(1, 1, At, B1); } PG8_BAR; PG8_SCHED;
            PG8_LDB(B0, 1, 0); PG8_LDB(B1, 1, 1); PG8_SCHED; PG8_LDA(At, 1, 0); PG8_STAGE(PG8_SA(0, 1), a2, wA1);
            PG8_WAIT_VS(8 + xp); PG8_WAIT_L(0); PG8_BAR; PG8_MMA(0, 0, At, B0); PG8_MMA(0, 1, At, B1); PG8_BAR; PG8_SCHED;
            PG8_LDA(At, 1, 1); PG8_STAGE(PG8_SB(1, 0), b3, voffB); PG8_STAGE(PG8_SB(1, 1), b3 + hstepB, voffB); PG8_STAGE(PG8_SA(1, 0), a3, wA0);
            PG8_WAIT_V(8); PG8_WAIT_L(0); PG8_BAR; PG8_MMA(1, 0, At, B0); PG8_MMA(1, 1, At, B1); PG8_BAR; PG8_SCHED;
        }
        SEG_BEGIN(1, true);
#else
        for (int t = 0; t < nt; t += 2) {
            const bool last = (t == nt - 2), first = (ui > 0 && t == 0);
            SEG_END(3, first); SEG_BEGIN(4, first); SEG_BEGIN(7, first); SEG_BEGIN(8, t >= 2);
#if defined(DBG_CLK) && defined(DBG_CLK_SKIP1)
            if (dbg_me_ && t == 2) { dc0_ = __builtin_amdgcn_s_memtime(); dr0_ = __builtin_amdgcn_s_memrealtime(); }
#endif
            const int xp = (last && Epi::NPRE) ? Epi::NPRE : 0;
            const char* a1 = cA + (size_t)(t + 1) * kstep;
            const char* a2 = last ? nA : cA + (size_t)(t + 2) * kstep; const char* b2 = last ? nB : cB + (size_t)(t + 2) * kstep;
            const char* a3 = a2 + kstep; const char* b3 = b2 + kstep;
            unsigned wA0[2], wA1[2];
#pragma unroll
            for (int i = 0; i < 2; ++i) { if constexpr (Sched::GATHER) { wA0[i] = last ? nvA[0][i] : vA[0][i]; wA1[i] = last ? nvA[1][i] : vA[1][i]; } else { wA0[i] = vA[0][i]; wA1[i] = vA[1][i]; } }
            PG8_LDB(B0, 0, 0); PG8_SCHED; PG8_LDA(At, 0, 0); PG8_STAGE(PG8_SA(1, 1), a1, vA[1]);
            if (Epi::NPRE) { if (last) E.prefetch(PRE_ARGS, cur, wr, wc, fr, fq); }
            PG8_WAIT_L(8); PG8_BAR; PG8_WAIT_L(0); SEG_END(4, first); PG8_MMA(0, 0, At, B0); PG8_BAR; PG8_SCHED;
            PG8_LDB(B1, 0, 1); PG8_STAGE(PG8_SB(0, 0), b2, voffB);
            PG8_BAR; PG8_WAIT_L(0); PG8_MMA(0, 1, At, B1); PG8_BAR;
            PG8_LDA(At, 0, 1); PG8_STAGE(PG8_SA(0, 0), a2, wA0);
            PG8_BAR; PG8_WAIT_L(0); PG8_MMA(1, 0, At, B0); PG8_BAR; PG8_SCHED;
            PG8_STAGE(PG8_SB(0, 1), b2 + hstepB, voffB);
            SEG_BEGIN(5, first); PG8_WAIT_VN(first ? 8 + Epi::NVM + xp : 6 + xp); SEG_END(5, first); PG8_BAR; PG8_MMA(1, 1, At, B1); PG8_BAR;
            PG8_LDB(B0, 1, 0); PG8_SCHED; PG8_LDA(At, 1, 0); PG8_STAGE(PG8_SA(0, 1), a2, wA1);
            PG8_WAIT_L(8); PG8_BAR; PG8_WAIT_L(0); PG8_MMA(0, 0, At, B0); PG8_BAR; PG8_SCHED;
            PG8_LDB(B1, 1, 1); PG8_STAGE(PG8_SB(1, 0), b3, voffB);
            SEG_BEGIN(6, first); if (first) PG8_WAIT_VN(10 + xp); SEG_END(6, first);
            PG8_BAR; PG8_WAIT_L(0); PG8_MMA(0, 1, At, B1); PG8_BAR;
            PG8_LDA(At, 1, 1); PG8_STAGE(PG8_SA(1, 0), a3, wA0);
            PG8_BAR; PG8_WAIT_L(0); PG8_MMA(1, 0, At, B0); PG8_BAR; PG8_SCHED;
            PG8_STAGE(PG8_SB(1, 1), b3 + hstepB, voffB);
            PG8_WAIT_V(6); PG8_BAR; PG8_MMA(1, 1, At, B1); PG8_BAR;
            SEG_END(7, first); SEG_END(8, t >= 2);
        }
        SEG_BEGIN(1, true);
#endif
#ifdef DBG_CLK
        if (dbg_me_) { const unsigned long long dc1_ = __builtin_amdgcn_s_memtime(), dr1_ = __builtin_amdgcn_s_memrealtime();
            if (lane == 0) { volatile LAS unsigned long long* d_ = (volatile LAS unsigned long long*)(lds + 131072 + 512); d_[0] = d_[0] + (dc1_ - dc0_); d_[1] = d_[1] + (dr1_ - dr0_); d_[2] = d_[2] + (unsigned long long)(nt - DBG_CLK_SKIPN); } }
#endif
        if constexpr (ALIGN_EPI) { if (wr == 0) PG8_BAR; }
        asm volatile("s_nop 15\n\ts_nop 15" ::: "memory");
        if (Epi::NPRE == 4) asm volatile("" : "+v"(p0), "+v"(p1), "+v"(p2), "+v"(p3));
        if (Epi::NPRE == 16) { asm volatile("" : "+v"(e0), "+v"(e1), "+v"(e2), "+v"(e3), "+v"(e4), "+v"(e5), "+v"(e6), "+v"(e7)); asm volatile("" : "+v"(e8), "+v"(e9), "+v"(e10), "+v"(e11), "+v"(e12), "+v"(e13), "+v"(e14), "+v"(e15)); }
        SEG_END(1, true); SEG_BEGIN(2, true);
        E(acc, cur, wr, wc, fr, fq, PRE_ARGS);
        SEG_END(2, true); SEG_BEGIN(3, true);
        if (!has_next) break;
#if !(PG8_ZC && PG8_SPFORM)
#pragma unroll
        for (int a = 0; a < 2; ++a)
#pragma unroll
            for (int b = 0; b < 2; ++b)
#pragma unroll
                for (int m = 0; m < 4; ++m)
#pragma unroll
                    for (int n = 0; n < 2; ++n) acc[a][b][m][n] = (f32x4){0.f, 0.f, 0.f, 0.f};
#endif
        cur = nxt; cA = nA; cB = nB; ++ui;
        if constexpr (Sched::GATHER) {
#pragma unroll
            for (int h = 0; h < 2; ++h)
#pragma unroll
                for (int i = 0; i < 2; ++i) vA[h][i] = nvA[h][i]; }
        if constexpr (ALIGN_EPI) { if (wr == 1) PG8_BAR; }
    }
#ifdef DBG_SEG
    if (SEG_ME && lane == 0) { volatile LAS unsigned long long* d_ = (volatile LAS unsigned long long*)(lds + 131072 + 512); d_[4] = d_[4] + seg_sum; d_[5] = d_[5] + seg_cnt; }
#endif
    PG8_WAIT_V(0);
    if constexpr (!ALIGN_EPI) { if (wr == 0) PG8_BAR; }
    PG8_BAR;
#undef PG8_SA
#undef PG8_SB
#undef PG8_STAGE
#undef PG8_LDA
#undef PG8_LDB
#undef PG8_MMA
#undef PG8_MMA0
#undef PG8_LD8
#undef PG8_WAIT_V
#undef PG8_WAIT_VN
#undef PG8_WAIT_VS
#undef PG8_WAIT_L
#undef PG8_BAR
#undef PG8_SCHED
}
}


#include <hip/hip_bf16.h>
#include <cmath>
namespace attn_body {
using bf16=__hip_bfloat16;
using bf16x8=__attribute__((ext_vector_type(8)))short;
using s16x4=__attribute__((ext_vector_type(4)))short;
using f32x16=__attribute__((ext_vector_type(16)))float;
using u32x4=__attribute__((ext_vector_type(4)))unsigned;
constexpr int BATCH=16,NHEAD=8,SEQ=2048,D=64,DM=1024;
constexpr int NW=8,QBLK=32,QB=QBLK*NW,KVBLK=64,NQB=SEQ/QB;
constexpr int ATTN_PITCH=DM, ATTN_UNIT_ROWS=QB;
__device__ __forceinline__ int crow(int r,int hi){return (r&3)+8*(r>>2)+4*hi;}
#define SBAR() __builtin_amdgcn_sched_barrier(0)
__device__ __forceinline__ void cmask(f32x16&p0,f32x16&p1,int jb,int qrel,int hi){
  const float NEG=-INFINITY; int kb=64*jb+4*hi;
  #pragma unroll
  for(int r=0;r<16;++r){int kv=kb+(r&3)+8*(r>>2); if(kv>qrel)p0[r]=NEG; if(kv+32>qrel)p1[r]=NEG;}
}

constexpr int NSLOT=3, SLOTB=8192;
constexpr int LDS_K=0, LDS_V=NSLOT*SLOTB, LDS_WS=2*NSLOT*SLOTB, LDS_OST=LDS_WS+NW*64*4, LDS_BYTES=LDS_OST+NW*4096;
constexpr float C2=0.125f*1.4426950408889634f;
__device__ __forceinline__ void glds16(const void*gsrc,unsigned lds_dst){unsigned keep;
  asm volatile("s_mov_b32 %0, m0\n\ts_mov_b32 m0, %2\n\ts_nop 0\n\tglobal_load_lds_dwordx4 %1, off\n\ts_mov_b32 m0, %0":"=&s"(keep):"v"(gsrc),"s"(lds_dst):"memory");}
__device__ __forceinline__ float max3f(float a,float b,float c){float r;asm("v_max3_f32 %0, %1, %2, %3":"=v"(r):"v"(a),"v"(b),"v"(c));return r;}
__device__ __forceinline__ float max2f(float a,float b){float r;asm("v_max_f32_e32 %0, %1, %2":"=v"(r):"v"(a),"v"(b));return r;}
__device__ __forceinline__ float fadd_s(float a,float b){float r;asm("v_add_f32_e32 %0, %1, %2":"=v"(r):"v"(a),"v"(b));return r;}
__device__ __forceinline__ float fsub_s(float a,float b){float r;asm("v_sub_f32_e32 %0, %1, %2":"=v"(r):"v"(a),"v"(b));return r;}
typedef float f32x2_t __attribute__((ext_vector_type(2))); typedef __bf16 bf16x2_t __attribute__((ext_vector_type(2)));
__device__ __forceinline__ unsigned cvtpk_s(float lo,float hi){f32x2_t v={lo,hi};bf16x2_t b=__builtin_convertvector(v,bf16x2_t);return __builtin_bit_cast(unsigned,b);}
#define WAIT_BAR(N) asm volatile("s_waitcnt vmcnt(" #N ") lgkmcnt(0)\n\ts_barrier":::"memory")

__device__ __forceinline__ void qkt(f32x16&p0,f32x16&p1,const char*Kslot,const bf16x8*qr,const f32x16&negm,int r32,int hi){
  const char*kb=Kslot+hi*1024+r32*16;
  #pragma unroll
  for(int d0=0;d0<4;++d0){
    const bf16x8 b0=*reinterpret_cast<const bf16x8*>(kb+d0*2048);
    const bf16x8 b1=*reinterpret_cast<const bf16x8*>(kb+d0*2048+512);
    if(d0==0){p0=__builtin_amdgcn_mfma_f32_32x32x16_bf16(b0,qr[0],negm,0,0,0);p1=__builtin_amdgcn_mfma_f32_32x32x16_bf16(b1,qr[0],negm,0,0,0);}
    else{p0=__builtin_amdgcn_mfma_f32_32x32x16_bf16(b0,qr[d0],p0,0,0,0);p1=__builtin_amdgcn_mfma_f32_32x32x16_bf16(b1,qr[d0],p1,0,0,0);}}
}
typedef __attribute__((address_space(3))) const char* lds_cptr;
typedef short v4i16_t __attribute__((ext_vector_type(4)));
__device__ __forceinline__ void kload8(bf16x8*kf,lds_cptr kp){
  kf[0]=*(const __attribute__((address_space(3))) bf16x8*)(kp);      kf[1]=*(const __attribute__((address_space(3))) bf16x8*)(kp+512);
  kf[2]=*(const __attribute__((address_space(3))) bf16x8*)(kp+2048); kf[3]=*(const __attribute__((address_space(3))) bf16x8*)(kp+2560);
  kf[4]=*(const __attribute__((address_space(3))) bf16x8*)(kp+4096); kf[5]=*(const __attribute__((address_space(3))) bf16x8*)(kp+4608);
  kf[6]=*(const __attribute__((address_space(3))) bf16x8*)(kp+6144); kf[7]=*(const __attribute__((address_space(3))) bf16x8*)(kp+6656);
}
__device__ __forceinline__ void kload2(bf16x8*kf,lds_cptr kp,int j){ kf[2*j]=*(const __attribute__((address_space(3))) bf16x8*)(kp+j*2048); kf[2*j+1]=*(const __attribute__((address_space(3))) bf16x8*)(kp+j*2048+512); }
__device__ __forceinline__ s16x4 vtr(lds_cptr p){ return __builtin_bit_cast(s16x4,__builtin_amdgcn_ds_read_tr16_b64_v4i16((__attribute__((address_space(3))) v4i16_t*)p)); }
__device__ __forceinline__ float rowmax(const f32x16&p0,const f32x16&p1){
  float a=max3f(p0[0],p0[1],p1[0]),b=max3f(p0[2],p0[3],p1[1]);a=max3f(a,p1[2],p1[3]);
  #pragma unroll
  for(int r=4;r<16;r+=4){a=max3f(a,p0[r],p0[r+1]);b=max3f(b,p0[r+2],p0[r+3]);a=max3f(a,p1[r],p1[r+1]);b=max3f(b,p1[r+2],p1[r+3]);}
  const float m=max2f(a,b);
  auto rr=__builtin_amdgcn_permlane32_swap(__float_as_uint(m),__float_as_uint(m),false,false);
  return max2f(__uint_as_float(rr[0]),__uint_as_float(rr[1]));
}
__device__ __forceinline__ void pv(f32x16*o,int vb,bf16x8 pa0,bf16x8 pa1,bf16x8 pa2,bf16x8 pa3){
  #pragma unroll
  for(int d0=0;d0<2;++d0){s16x4 lo[4],hi[4];
    #pragma unroll
    for(int ks=0;ks<4;++ks){
      asm volatile("ds_read_b64_tr_b16 %0,%1 offset:%c2":"=&v"(lo[ks]):"v"(vb),"i"(d0*4096+ks*1024):"memory");
      asm volatile("ds_read_b64_tr_b16 %0,%1 offset:%c2":"=&v"(hi[ks]):"v"(vb),"i"(d0*4096+ks*1024+512):"memory");}
    asm volatile("s_waitcnt lgkmcnt(0)":::"memory");SBAR();
    #define PK(k) (bf16x8){lo[k][0],lo[k][1],lo[k][2],lo[k][3],hi[k][0],hi[k][1],hi[k][2],hi[k][3]}
    o[d0]=__builtin_amdgcn_mfma_f32_32x32x16_bf16(pa0,PK(0),o[d0],0,0,0);
    o[d0]=__builtin_amdgcn_mfma_f32_32x32x16_bf16(pa1,PK(1),o[d0],0,0,0);
    o[d0]=__builtin_amdgcn_mfma_f32_32x32x16_bf16(pa2,PK(2),o[d0],0,0,0);
    o[d0]=__builtin_amdgcn_mfma_f32_32x32x16_bf16(pa3,PK(3),o[d0],0,0,0);
    #undef PK
  }
}

#ifndef ATTN_STORE16
#define ATTN_STORE16(p,v) (*(u32x4*)(p)=(v))
#endif
template<int THRL> __device__ __forceinline__ void attn_unit(int b,int h,int qb,const bf16*Q,const bf16*__restrict__ K,const bf16*__restrict__ V,bf16*O,char*shm,const __attribute__((address_space(3))) float*f2,const int tid){
  #define BIAS_H(P,off,g0) { f32x4 x_[2]; _Pragma("unroll") for(int g_=0;g_<2;++g_) x_[g_]=*(const __attribute__((address_space(3))) f32x4*)(fb_+(off)+8*((g0)+g_)); \
      _Pragma("unroll") for(int g_=0;g_<2;++g_) _Pragma("unroll") for(int i_=0;i_<4;++i_) P[4*((g0)+g_)+i_]-=x_[g_][i_]; asm volatile("":::"memory"); }
  #define BIAS(P0,P1,t) do{ const __attribute__((address_space(3))) float* fb_=f2+64*(t)+4*hi; \
    BIAS_H(P0,0,0) BIAS_H(P0,0,2) BIAS_H(P1,32,0) BIAS_H(P1,32,2) }while(0)
  const int lane=tid&63,r32=lane&31,hi=lane>>5; const int wid=__builtin_amdgcn_readfirstlane(tid>>6);
  const long rowbase=(long)b*SEQ; const int q0=qb*QB;
  const bf16*Qw=Q+(rowbase+q0+wid*QBLK)*DM+h*D;
  const bf16*Kh=K+rowbase*DM+h*D,*Vh=V+rowbase*DM+h*D;
  const unsigned lds0=(unsigned)(uintptr_t)shm;
  float*wsf=(float*)(shm+LDS_WS)+wid*64;
  const bf16*ksrc=Kh+(long)lane*DM+wid*8;
  const bf16*vsrc=Vh+(long)(16*(wid&3)+(lane>>2))*DM+(wid>>2)*32+(lane&3)*8;
  const unsigned kdst=lds0+LDS_K+wid*1024, vdst=lds0+LDS_V+wid*1024;
  #define DMA_K(t,slot) glds16(ksrc+(long)(t)*KVBLK*DM,(unsigned)__builtin_amdgcn_readfirstlane(kdst+(slot)))
  #define DMA_V(t,slot) glds16(vsrc+(long)(t)*KVBLK*DM,(unsigned)__builtin_amdgcn_readfirstlane(vdst+(slot)))
  const int vb0=(int)(lds0+LDS_V)+((lane>>4)&1)*32+(lane&3)*8+(4*hi+((lane&15)>>2))*64;
  const char*Kbase=shm+LDS_K; bf16x8 kf[8];
  const lds_cptr shm3=(lds_cptr)shm; const lds_cptr kp0=shm3+LDS_K+hi*1024+r32*16; const lds_cptr vp0=shm3+LDS_V+((lane>>4)&1)*32+(lane&3)*8+(4*hi+((lane&15)>>2))*64;
  const int NT=(q0+QB)/KVBLK;
  DMA_K(0,0);DMA_V(0,0);DMA_K(1,SLOTB);
  bf16x8 qr[4];
  #pragma unroll
  for(int d0=0;d0<4;++d0)qr[d0]=*reinterpret_cast<const bf16x8*>(&Qw[(long)r32*DM+d0*16+hi*8]);
  float mhat=0.f,l_reg=0.f;f32x16 o[2];f32x16 negm; { float z_=0.f; asm volatile("":"+v"(z_)); _Pragma("unroll") for(int r=0;r<16;++r){o[0][r]=z_;o[1][r]=z_;negm[r]=z_;} } asm volatile("":"+v"(negm));
  const int qrel=wid*QBLK+r32;
  #define CMASK(P0,P1,t) do{int jb_=(t)-(NT-4); if(jb_>=0)cmask(P0,P1,jb_,qrel,hi);}while(0)
  bool resc=false;
  #define START(P0,P1) do{ const float rm=rowmax(P0,P1); resc=false; \
    { const float dl=rm; mhat=fadd_s(mhat,dl); \
      _Pragma("unroll") for(int r=0;r<16;++r){P0[r]=fsub_s(P0[r],dl);P1[r]=fsub_s(P1[r],dl);} \
      _Pragma("unroll") for(int r=0;r<16;++r)negm[r]=-mhat; asm volatile("":"+v"(negm)); } \
    _Pragma("unroll") for(int r=0;r<16;++r)P0[r]=__builtin_amdgcn_exp2f(P0[r]); }while(0)
  #define RESC() do{ if(resc){ asm volatile("s_waitcnt lgkmcnt(0)":::"memory"); \
      _Pragma("unroll") for(int d_=0;d_<2;++d_) _Pragma("unroll") for(int r=0;r<16;++r)o[d_][r]*=wsf[crow(r,hi)]; } }while(0)
  f32x16 pA0,pA1,pB0,pB1;
  int sl_prev=0,sl_cur=0,sl_next=SLOTB;
  #define ROT() do{sl_prev=sl_cur;sl_cur=sl_next;sl_next=(sl_next==(NSLOT-1)*SLOTB)?0:sl_next+SLOTB;}while(0)
  DMA_K(2,2*SLOTB);
  WAIT_BAR(3);
  qkt(pA0,pA1,Kbase,qr,negm,r32,hi);asm volatile("s_nop 15\n\ts_nop 7":"+v"(pA0),"+v"(pA1));CMASK(pA0,pA1,0);BIAS(pA0,pA1,0);
  START(pA0,pA1);
  _Pragma("unroll") for(int r=0;r<16;++r)pA1[r]=__builtin_amdgcn_exp2f(pA1[r]);
  WAIT_BAR(0);
  DMA_K(3,0);DMA_V(1,SLOTB);
  ROT();
  kload8(kf,kp0+sl_cur);
  WAIT_BAR(2);
  s16x4 vlo[8],vhi[8]; u32x4 pw0,pw1,pw2,pw3;
  #define PKW(P,B) cvtpk_s(P[B],P[B+1])
  #define PAF(k) __builtin_bit_cast(bf16x8,pw##k)
  #define VFR(i) (bf16x8){vlo[i][0],vlo[i][1],vlo[i][2],vlo[i][3],vhi[i][0],vhi[i][1],vhi[i][2],vhi[i][3]}
  #define PIN(x) asm volatile("":"+v"(x))
  #define MX3(a,b,c) __builtin_fmaxf(__builtin_fmaxf((a),(b)),(c))
  #define GAPA(MF,A0,A1,A2,A3,W0,W1,PW) do{ MF; sacc+=A0; sacc+=A1; sacc+=A2; sacc+=A3; PIN(sacc); W0; W1; PIN(PW); SBAR(); }while(0)
  #define EX(v) __builtin_amdgcn_exp2f(v)
  #define GAPB(MF,X,B) do{ MF; X[B]=EX(X[B]); X[B+1]=EX(X[B+1]); X[B+2]=EX(X[B+2]); X[B+3]=EX(X[B+3]); PIN(X); SBAR(); }while(0)
  #define VRD(i) do{ vlo[i]=vtr(vp_+(((i)>>2)*4096+((i)&3)*1024)); vhi[i]=vtr(vp_+(((i)>>2)*4096+((i)&3)*1024+512)); }while(0)
  #define KRD(G,j) do{ if(G){ kload2(kf,kp0+sl_next,j); SBAR(); } }while(0)
  #define STEP(C0,C1,P0,P1,t,GK,GV,GL) do{ SBAR(); \
    const lds_cptr vp_=vp0+sl_prev; \
    VRD(0); SBAR(); float sacc=(P0[0]+P0[1]); \
    GAPA(C0=__builtin_amdgcn_mfma_f32_32x32x16_bf16(kf[0],qr[0],negm,0,0,0), P0[2],P0[3],P0[4],P0[5],     pw0[0]=PKW(P0,0), pw0[1]=PKW(P0,2), pw0); \
    VRD(4); SBAR(); GAPA(C1=__builtin_amdgcn_mfma_f32_32x32x16_bf16(kf[1],qr[0],negm,0,0,0), P0[6],P0[7],P0[8],P0[9],     pw0[2]=PKW(P0,4), pw0[3]=PKW(P0,6), pw0); \
    VRD(1); SBAR(); GAPA(C0=__builtin_amdgcn_mfma_f32_32x32x16_bf16(kf[2],qr[1],C0,0,0,0),   P0[10],P0[11],P0[12],P0[13], pw1[0]=PKW(P0,8), pw1[1]=PKW(P0,10), pw1); \
    VRD(5); SBAR(); GAPA(C1=__builtin_amdgcn_mfma_f32_32x32x16_bf16(kf[3],qr[1],C1,0,0,0),   P0[14],P0[15],P1[0],P1[1],   pw1[2]=PKW(P0,12),pw1[3]=PKW(P0,14), pw1); \
    VRD(2); SBAR(); GAPA(C0=__builtin_amdgcn_mfma_f32_32x32x16_bf16(kf[4],qr[2],C0,0,0,0),   P1[2],P1[3],P1[4],P1[5],     pw2[0]=PKW(P1,0), pw2[1]=PKW(P1,2), pw2); \
    VRD(6); SBAR(); GAPA(C1=__builtin_amdgcn_mfma_f32_32x32x16_bf16(kf[5],qr[2],C1,0,0,0),   P1[6],P1[7],P1[8],P1[9],     pw2[2]=PKW(P1,4), pw2[3]=PKW(P1,6), pw2); \
    VRD(3); SBAR(); GAPA(C0=__builtin_amdgcn_mfma_f32_32x32x16_bf16(kf[6],qr[3],C0,0,0,0),   P1[10],P1[11],P1[12],P1[13], pw3[0]=PKW(P1,8), pw3[1]=PKW(P1,10), pw3); \
    VRD(7); SBAR(); GAPA(C1=__builtin_amdgcn_mfma_f32_32x32x16_bf16(kf[7],qr[3],C1,0,0,0),   P1[14],P1[15],0.f,0.f,       pw3[2]=PKW(P1,12),pw3[3]=PKW(P1,14), pw3); \
    l_reg+=sacc; \
    if(GK){DMA_K((t)+3,sl_cur);} if(GV){DMA_V((t)+1,sl_next);} \
    CMASK(C0,C1,t); BIAS(C0,C1,t); \
    { float a=MX3(C0[0],C0[1],C1[0]),b=MX3(C0[2],C0[3],C1[1]); a=MX3(a,C1[2],C1[3]); \
      _Pragma("unroll") for(int r=4;r<16;r+=4){a=MX3(a,C0[r],C0[r+1]);b=MX3(b,C0[r+2],C0[r+3]);a=MX3(a,C1[r],C1[r+1]);b=MX3(b,C1[r+2],C1[r+3]);} \
      float rm=__builtin_fmaxf(a,b); { auto rr=__builtin_amdgcn_permlane32_swap(__float_as_uint(rm),__float_as_uint(rm),false,false); rm=__builtin_fmaxf(__uint_as_float(rr[0]),__uint_as_float(rr[1])); } \
      resc=false; \
      if(__builtin_expect(__any(rm>(float)THRL),0)){ const float dl=__builtin_fmaxf(rm,0.f); mhat+=dl; \
        _Pragma("unroll") for(int r=0;r<16;++r){C0[r]-=dl;C1[r]-=dl;} \
        _Pragma("unroll") for(int r=0;r<16;++r)negm[r]=-mhat; asm volatile("":"+v"(negm)); \
        const float f=__builtin_amdgcn_exp2f(-dl); l_reg*=f; if(hi==0)wsf[r32]=f; resc=true; } } \
    SBAR(); \
    GAPB(o[0]=__builtin_amdgcn_mfma_f32_32x32x16_bf16(PAF(0),VFR(0),o[0],0,0,0), C0,0); \
    GAPB(o[1]=__builtin_amdgcn_mfma_f32_32x32x16_bf16(PAF(0),VFR(4),o[1],0,0,0), C0,4); \
    KRD(GL,0); GAPB(o[0]=__builtin_amdgcn_mfma_f32_32x32x16_bf16(PAF(1),VFR(1),o[0],0,0,0), C0,8); \
    KRD(GL,1); GAPB(o[1]=__builtin_amdgcn_mfma_f32_32x32x16_bf16(PAF(1),VFR(5),o[1],0,0,0), C0,12); \
    KRD(GL,2); GAPB(o[0]=__builtin_amdgcn_mfma_f32_32x32x16_bf16(PAF(2),VFR(2),o[0],0,0,0), C1,0); \
    KRD(GL,3); GAPB(o[1]=__builtin_amdgcn_mfma_f32_32x32x16_bf16(PAF(2),VFR(6),o[1],0,0,0), C1,4); \
    GAPB(o[0]=__builtin_amdgcn_mfma_f32_32x32x16_bf16(PAF(3),VFR(3),o[0],0,0,0), C1,8); \
    GAPB(o[1]=__builtin_amdgcn_mfma_f32_32x32x16_bf16(PAF(3),VFR(7),o[1],0,0,0), C1,12); \
    }while(0)
  int t=1;
  #undef CMASK
  #define CMASK(P0,P1,t) do{}while(0)
  for(;t+5<NT;t+=2){
    STEP(pB0,pB1,pA0,pA1,t,true,true,true);     WAIT_BAR(2); RESC(); ROT();
    STEP(pA0,pA1,pB0,pB1,t+1,true,true,true);   WAIT_BAR(2); RESC(); ROT();
  }
  #undef CMASK
  #define CMASK(P0,P1,t) do{int jb_=(t)-(NT-4); if(jb_>=0)cmask(P0,P1,jb_,qrel,hi);}while(0)
  #define ENDW(tt) do{ if((tt)+3<NT){WAIT_BAR(2);} else if((tt)+2<NT){WAIT_BAR(1);} else {WAIT_BAR(0);} }while(0)
  for(;t+1<NT;t+=2){
    STEP(pB0,pB1,pA0,pA1,t,(t+3<NT),(t+1<NT),(t+1<NT));       ENDW(t);   RESC(); ROT();
    STEP(pA0,pA1,pB0,pB1,t+1,(t+4<NT),(t+2<NT),(t+2<NT));     ENDW(t+1); RESC(); ROT();
  }
  STEP(pB0,pB1,pA0,pA1,NT-1,false,false,false); RESC();
  { float sacc=pB0[0]+pB0[1]; _Pragma("unroll") for(int r=2;r<16;++r)sacc+=pB0[r]; _Pragma("unroll") for(int r=0;r<16;++r)sacc+=pB1[r]; l_reg+=sacc;
    pw0=(u32x4){PKW(pB0,0),PKW(pB0,2),PKW(pB0,4),PKW(pB0,6)};pw1=(u32x4){PKW(pB0,8),PKW(pB0,10),PKW(pB0,12),PKW(pB0,14)};pw2=(u32x4){PKW(pB1,0),PKW(pB1,2),PKW(pB1,4),PKW(pB1,6)};pw3=(u32x4){PKW(pB1,8),PKW(pB1,10),PKW(pB1,12),PKW(pB1,14)};
    SBAR(); pv(o,vb0+sl_cur,PAF(0),PAF(1),PAF(2),PAF(3)); }
  #undef PKW
  #undef PAF
  #undef VFR
  #undef PIN
  #undef MX3
  #undef GAPA
  #undef GAPB
  #undef EX
  #undef VRD
  #undef KRD
  #undef STEP
  #undef ENDW
  {auto rr=__builtin_amdgcn_permlane32_swap(__float_as_uint(l_reg),__float_as_uint(l_reg),false,false);l_reg=__uint_as_float(rr[0])+__uint_as_float(rr[1]);}
  if(hi==0)wsf[32+r32]=l_reg;asm volatile("s_waitcnt lgkmcnt(0)":::"memory");
  float rli[16];
  #pragma unroll
  for(int r=0;r<16;++r)rli[r]=__builtin_amdgcn_rcpf(wsf[32+crow(r,hi)]);
  { bf16*stg=(bf16*)(shm+LDS_OST)+wid*2048;
    #pragma unroll
    for(int r=0;r<16;++r){const int orow=crow(r,hi);
      #pragma unroll
      for(int d0=0;d0<2;++d0)stg[orow*64+d0*32+r32]=__float2bfloat16(o[d0][r]*rli[r]);}
    asm volatile("s_waitcnt lgkmcnt(0)":::"memory");
    unsigned char*O8w=(unsigned char*)O+(rowbase+q0+wid*QBLK)*DM+h*D;
    _Pragma("unroll") for(int i=0;i<4;++i){const int row=i*8+(lane>>3),ch=lane&7; const u32x4 v=*(const u32x4*)(stg+row*64+ch*8);
      u32x2 w8; w8.x=pg8::pack4_fp8(bflo(v.x)*SC_FOX,bfhi(v.x)*SC_FOX,bflo(v.y)*SC_FOX,bfhi(v.y)*SC_FOX); w8.y=pg8::pack4_fp8(bflo(v.z)*SC_FOX,bfhi(v.z)*SC_FOX,bflo(v.w)*SC_FOX,bfhi(v.w)*SC_FOX);
      *(u32x2*)(O8w+(long)row*DM+ch*8)=w8;} }
  asm volatile("s_waitcnt lgkmcnt(0)\n\ts_barrier":::"memory");
  #undef BIAS
  #undef BIAS_H
  #undef DMA_K
  #undef DMA_V
  #undef CMASK
  #undef START
  #undef RESC
  #undef ROT
}
constexpr int ATTN_LDS_BYTES=LDS_BYTES;
#undef SBAR
#undef WAIT_BAR
}


constexpr int NWAVES = 8;
constexpr int RING_OFF = 0, RING_BYTES = 131072;
constexpr int LDSCTL_OFF = RING_BYTES, MISC_OFF = LDSCTL_OFF + 320, TAB_OFF = LDSCTL_OFF + 1024;
constexpr int WTAB_OFF = LDSCTL_OFF + 2048;
constexpr int TOK_OFF = LDSCTL_OFF + 4096;
constexpr int LDS_BYTES = 147456;
typedef GAS unsigned gu32;
__device__ __forceinline__ unsigned hw_wave_key() { return (unsigned)__builtin_amdgcn_s_getreg((5 << 11) | 4) & 63u; }
#define RLX_AGENT __ATOMIC_RELAXED, __HIP_MEMORY_SCOPE_AGENT

#define XB_TMO      128
#define XB_XCNT(j)  (256  + 64 * (j))
#define XB_XSUB(j)  (1280 + 64 * (j))
#define XB_XGEN(j)  (2304 + 64 * (j))
#define XB_TOP      3328
#define XB_TOPGEN   3392
#define XCD_BAR_WORDS 3456
#define XB_SPIN_CAP (1u << 18)

__device__ __forceinline__ unsigned xb_ld(unsigned* p)              { return __hip_atomic_load(p, __ATOMIC_RELAXED, __HIP_MEMORY_SCOPE_AGENT); }
__device__ __forceinline__ unsigned xb_add(unsigned* p, unsigned v) { return __hip_atomic_fetch_add(p, v, __ATOMIC_RELAXED, __HIP_MEMORY_SCOPE_AGENT); }
__device__ __forceinline__ unsigned xb_xcc_id() { return (unsigned)__builtin_amdgcn_s_getreg((3 << 11) | 20) & 0xFu; }
#define XB_SPIN(cond, bar) do { unsigned _sp = 0; while (cond) { __builtin_amdgcn_s_sleep(1); \
    if ((++_sp & 255u) == 0u) { if (xb_ld(&(bar)[XB_TMO])) break; if (_sp > XB_SPIN_CAP) { atomicAdd(&(bar)[XB_TMO], 1u); break; } } } } while (0)

struct XcdBarrier {
    unsigned* bar; unsigned x;
    volatile LAS unsigned* st;
};

__device__ __forceinline__ XcdBarrier xcd_barrier_post(unsigned* bar, volatile LAS unsigned* st) {
    XcdBarrier b; b.bar = bar; b.x = xb_xcc_id(); b.st = st;
    if (threadIdx.x == 0) (void)xb_add(&bar[XB_XCNT(b.x)], 1u);
    return b;
}
__device__ __forceinline__ void xcd_barrier_complete(unsigned* bar, unsigned x, unsigned& nloc, unsigned& nx) {
    const unsigned G = gridDim.x * gridDim.y * gridDim.z;
    unsigned sum, cnt, mine, sp = 0u;
    for (;;) {
        sum = 0u; cnt = 0u; mine = 0u;
#pragma unroll
        for (unsigned j = 0; j < 16; ++j) { const unsigned c = xb_ld(&bar[XB_XCNT(j)]); sum += c; cnt += (c > 0u) ? 1u : 0u; mine = (j == x) ? c : mine; }
        if (sum == G) break;
        __builtin_amdgcn_s_sleep(1);
        if ((++sp & 255u) == 0u) { if (xb_ld(&bar[XB_TMO])) break; if (sp > XB_SPIN_CAP) { atomicAdd(&bar[XB_TMO], 1u); break; } }
    }
    nloc = mine > 0u ? mine : 1u; nx = cnt > 0u ? cnt : 1u;
}

__device__ __forceinline__ void xcd_barrier(const XcdBarrier& b) {
    asm volatile("s_waitcnt vmcnt(0)" ::: "memory");
    __syncthreads();
    if (threadIdx.x == 0) {
        unsigned* bar = b.bar;
        __builtin_amdgcn_s_waitcnt(0);
        unsigned nloc = b.st[0], nx = b.st[1];
        if (nloc == 0u) { xcd_barrier_complete(bar, b.x, nloc, nx); b.st[0] = nloc; b.st[1] = nx; }
        const unsigned old = xb_add(&bar[XB_XSUB(b.x)], 1u);
        const unsigned gen = old / nloc;
        if (old + 1u == (gen + 1u) * nloc) {
            __builtin_amdgcn_fence(__ATOMIC_RELEASE, "agent");
            asm volatile("s_waitcnt vmcnt(0)" ::: "memory");
            const unsigned og = xb_add(&bar[XB_TOP], 1u);
            const unsigned tg = og / nx;
            if (og + 1u == (tg + 1u) * nx) xb_add(&bar[XB_TOPGEN], 1u);
            else XB_SPIN(xb_ld(&bar[XB_TOPGEN]) == tg, bar);
            __builtin_amdgcn_fence(__ATOMIC_ACQUIRE, "agent");
            xb_add(&bar[XB_XGEN(b.x)], 1u);
            asm volatile("s_waitcnt vmcnt(0)" ::: "memory");
        } else {
            XB_SPIN(xb_ld(&bar[XB_XGEN(b.x)]) == gen, bar);
            __builtin_amdgcn_fence(__ATOMIC_ACQUIRE, "agent");
            asm volatile("s_waitcnt vmcnt(0)" ::: "memory");
        }
    }
    __syncthreads();
}


struct Args {
    const float *x, *ln_in_g, *ln_in_b, *w_in, *b_in, *w_fox, *lbl, *norm_g, *w_hgrn, *w_mix, *b_mix, *ln1_g, *ln1_b, *router_w, *router_b, *w1, *w3, *w2, *ln2_g, *ln2_b;
    float* out; unsigned char* ws; int ph_lo, ph_hi, use_bar, pad;
};
struct Frame { LAS unsigned char* lds; int tid, lane, wave, G, gw, ngw, bid; };
#define LOAD_ARGS() launder_args(args)
__device__ __forceinline__ Args launder_args(const Args& args) { Args a = args; size_t z_ = 0; asm volatile("" : "+s"(z_)); a.ws = args.ws + z_; return a; }

struct LnGB { f32x4 g[4], b[4]; };
__device__ __forceinline__ LnGB ln_load_gb(const float* g, const float* bta, int lane) { LnGB r;
#pragma unroll
    for (int j = 0; j < 4; ++j) { const int c = 4 * lane + 256 * j; r.g[j] = *(const f32x4*)(g + c); r.b[j] = *(const f32x4*)(bta + c); }
    return r; }
__device__ __forceinline__ void ln_rows16(f32x4 (&v)[4], const LnGB& gb, int lane) {
    float s = 0.f;
#pragma unroll
    for (int j = 0; j < 4; ++j) s += (v[j].x + v[j].y) + (v[j].z + v[j].w);
    const float mean = wave_sum(s) * (1.f / D); float s2 = 0.f;
#pragma unroll
    for (int j = 0; j < 4; ++j) { v[j] = v[j] - mean; s2 += (v[j].x * v[j].x + v[j].y * v[j].y) + (v[j].z * v[j].z + v[j].w * v[j].w); }
    const float rstd = rsqrtf(wave_sum(s2) * (1.f / D) + LN_EPS);
#pragma unroll
    for (int j = 0; j < 4; ++j) v[j] = v[j] * rstd * gb.g[j] + gb.b[j];
}
__device__ __forceinline__ void store_row(const f32x4 (&v)[4], int lane, bf16_t* ores, unsigned char* obf, float* of32b) {
#pragma unroll
    for (int j = 0; j < 4; ++j) { const int c = 4 * lane + 256 * j;
#ifndef ROW_WT
#define ROW_WT 0
#endif
        if (ores) { u32x2 w; w.x = pk2(v[j].x, v[j].y); w.y = pk2(v[j].z, v[j].w);
            if (ROW_WT) __hip_atomic_store((unsigned long long*)(ores + c), __builtin_bit_cast(unsigned long long, w), __ATOMIC_RELAXED, __HIP_MEMORY_SCOPE_AGENT); else *(u32x2*)(ores + c) = w; }
        if (of32b) *(f32x4*)(of32b + c) = v[j];
        if (obf) { const unsigned q8 = pg8::pack4_fp8(v[j].x, v[j].y, v[j].z, v[j].w);
            if (ROW_WT) __hip_atomic_store((unsigned*)(obf + c), q8, __ATOMIC_RELAXED, __HIP_MEMORY_SCOPE_AGENT); else *(unsigned*)(obf + c) = q8; } }
}

struct CvtDesc { const float* W; int ldw, k0, srccol, nvalid; unsigned char* WT; int dstrow, dstk; };
#ifndef CVT_NT
#define CVT_NT 1
#endif
#if CVT_NT
#define CVT_LD(p) __builtin_nontemporal_load(p)
#else
#define CVT_LD(p) (*(p))
#endif
__device__ __forceinline__ void cvt_load(const CvtDesc& d, f32x4 (&v)[8], int lane) {
    const int ks = lane >> 3, n4 = (lane & 7) * 4;
#pragma unroll
    for (int j = 0; j < 8; ++j) v[j] = (n4 < d.nvalid) ? CVT_LD((const f32x4*)(d.W + (size_t)(d.k0 + 8 * j + ks) * d.ldw + d.srccol + n4)) : (f32x4){0.f, 0.f, 0.f, 0.f};
}
__device__ __forceinline__ void cvt_store(const CvtDesc& d, const f32x4 (&v)[8], LAS float* scr, int lane) {
    const int ks = lane >> 3, n4 = (lane & 7) * 4;
#pragma unroll
    for (int j = 0; j < 8; ++j) { LAS float* p = scr + (8 * j + ks) * 33 + n4; p[0] = v[j][0]; p[1] = v[j][1]; p[2] = v[j][2]; p[3] = v[j][3]; }
    asm volatile("s_waitcnt lgkmcnt(0)" ::: "memory");
    const int c = lane & 7;
#pragma unroll
    for (int j = 0; j < 4; ++j) { const int n = (lane >> 3) + 8 * j; const LAS float* s = scr + (8 * c) * 33 + n;
        u32x2 o; o.x = pg8::pack4_fp8(s[0 * 33] * SC_W, s[1 * 33] * SC_W, s[2 * 33] * SC_W, s[3 * 33] * SC_W); o.y = pg8::pack4_fp8(s[4 * 33] * SC_W, s[5 * 33] * SC_W, s[6 * 33] * SC_W, s[7 * 33] * SC_W);
        *(u32x2*)(d.WT + (size_t)(d.dstrow + n) * 1024 + d.dstk + d.k0 + 8 * c) = o; }
    asm volatile("s_waitcnt lgkmcnt(0)" ::: "memory");
}
__device__ __forceinline__ CvtDesc cvt_decode(const Args& a, int l, int it) {
    unsigned char* WS_ = a.ws + wset(l);
    constexpr int I_IN = 16 * 176, I_BR = 8 * 32, I_MIX = 16 * 32, I_13 = 16 * 64 * NE;
    CvtDesc d; int r = it;
    if (r < I_IN) { const int kb = r / 176, nb = r % 176, n0 = nb * 32;
        const int src = (n0 < 1536) ? n0 : n0 + 8, nv = 32;
        d.W = a.w_in + (size_t)l * D * NIN; d.ldw = NIN; d.k0 = kb * 64; d.srccol = src; d.nvalid = nv; d.WT = WS_ + WO_WIN; d.dstrow = n0; d.dstk = 0; return d; } r -= I_IN;
    if (r < I_BR) { const int kb = r / 32, nb = r % 32; d.W = a.w_fox + (size_t)l * 512 * D; d.ldw = D; d.k0 = kb * 64; d.srccol = nb * 32; d.nvalid = 32; d.WT = WS_ + WO_WBR; d.dstrow = nb * 32; d.dstk = 0; return d; } r -= I_BR;
    if (r < I_BR) { const int kb = r / 32, nb = r % 32; d.W = a.w_hgrn + (size_t)l * 512 * D; d.ldw = D; d.k0 = kb * 64; d.srccol = nb * 32; d.nvalid = 32; d.WT = WS_ + WO_WBR; d.dstrow = nb * 32; d.dstk = 512; return d; } r -= I_BR;
    if (r < I_MIX) { const int kb = r / 32, nb = r % 32; d.W = a.w_mix + (size_t)l * D * D; d.ldw = D; d.k0 = kb * 64; d.srccol = nb * 32; d.nvalid = 32; d.WT = WS_ + WO_WMIX; d.dstrow = nb * 32; d.dstk = 0; return d; } r -= I_MIX;
    if (r < I_13) { const int e = r / 1024, q = r % 1024, kb = q / 64, nb = q % 64, n0 = nb * 32;
        const int j = n0 >> 8, rr = n0 & 255; d.W = (rr < 128 ? a.w1 : a.w3) + ((size_t)l * NE + e) * D * D; d.ldw = D; d.k0 = kb * 64; d.srccol = 128 * j + (rr & 127); d.nvalid = 32;
        d.WT = WS_ + WO_W13 + (size_t)e * 2048 * D; d.dstrow = n0; d.dstk = 0; return d; } r -= I_13;
    { const int e = r / 512, q = r % 512, kb = q / 32, nb = q % 32; d.W = a.w2 + ((size_t)l * NE + e) * D * D; d.ldw = D; d.k0 = kb * 64; d.srccol = nb * 32; d.nvalid = 32;
      d.WT = WS_ + WO_W2 + (size_t)e * D * D; d.dstrow = nb * 32; d.dstk = 0; return d; }
}
constexpr int CVT_NITEMS = 16 * 176 + 2 * 8 * 32 + 16 * 32 + 16 * 64 * NE + 16 * 32 * NE;
#ifndef CVT_TAIL_ITEMS
#define CVT_TAIL_ITEMS 6
#endif
constexpr int CVT_N_A = 128 * NWAVES * CVT_TAIL_ITEMS, CVT_N_B = 192 * NWAVES * CVT_TAIL_ITEMS, CVT_N_C = CVT_NITEMS - CVT_N_A - CVT_N_B;
__device__ __forceinline__ void convert_items(const Args& a, const Frame& F, int l, int it0, int it1, int gw, int ngw) {
    LAS float* scr = (LAS float*)(F.lds + RING_OFF + F.wave * 16384);
    const int lane = F.lane;
    for (int it = it0 + gw; it < it1; it += 2 * ngw) {
        const CvtDesc d0 = cvt_decode(a, l, it); f32x4 v0[8]; cvt_load(d0, v0, lane);
        const bool two = it + ngw < it1;
        if (two) { const CvtDesc d1 = cvt_decode(a, l, it + ngw); f32x4 v1[8]; cvt_load(d1, v1, lane); cvt_store(d0, v0, scr, lane); cvt_store(d1, v1, scr, lane); }
        else cvt_store(d0, v0, scr, lane);
    }
}
__device__ __forceinline__ void convert_queue(const Args& a, const Frame& F, int l, int n, unsigned* qc) {
    LAS float* scr = (LAS float*)(F.lds + RING_OFF + F.wave * 16384);
    const int lane = F.lane;
    int it = 0; if (lane == 0) it = (int)atomicAdd(qc, 4u); it = __builtin_amdgcn_readfirstlane(it);
    while (it < n) {
        int nx = 0; if (lane == 0) nx = (int)atomicAdd(qc, 4u);
#pragma unroll
        for (int k = 0; k < 4; k += 2) { const int i0 = it + k;
            if (i0 < n) { const CvtDesc d0 = cvt_decode(a, l, i0); f32x4 v0[8]; cvt_load(d0, v0, lane);
                if (i0 + 1 < n) { const CvtDesc d1 = cvt_decode(a, l, i0 + 1); f32x4 v1[8]; cvt_load(d1, v1, lane); cvt_store(d0, v0, scr, lane); cvt_store(d1, v1, scr, lane); }
                else cvt_store(d0, v0, scr, lane); } }
        it = __builtin_amdgcn_readfirstlane(nx);
    }
}
__device__ __forceinline__ void convert_layer(const Args& a, const Frame& F, int l, int gw, int ngw, int nitems = CVT_NITEMS) {
    convert_items(a, F, l, 0, nitems, gw, ngw);
    const int lane = F.lane;
    float* biasp = (float*)(a.ws + biasoff(l));
    for (int n = gw * 64 + lane; n < NINP; n += ngw * 64) {
        biasp[n] = (n < 1536) ? a.b_in[l * NIN + n] : a.b_in[l * NIN + n + 8]; }
}


constexpr int WFF_OFF = 65536 + 16384;
__device__ __forceinline__ void load_wff(const Args& a, const Frame& F, int l) {
    LAS float* wff = (LAS float*)(F.lds + RING_OFF + WFF_OFF);
    { float t[16];
#pragma unroll
      for (int k = 0; k < 16; ++k) { const int i = F.tid + k * (NWAVES * 64); t[k] = a.w_in[((size_t)l * D + (i >> 3)) * NIN + 1536 + (i & 7)]; }
#pragma unroll
      for (int k = 0; k < 16; ++k) { const int i = F.tid + k * (NWAVES * 64); wff[(i & 7) * D + (i >> 3)] = t[k]; } }
}
__device__ __forceinline__ void fox_gates_row(const Args& a, const Frame& F, int l, const f32x4 (&v)[4], int row, float hbias  ) {
    const LAS float* wff = (const LAS float*)(F.lds + RING_OFF + WFF_OFF); const int lane = F.lane;
    float p[8];
#pragma unroll
    for (int h = 0; h < 8; ++h) { float s = 0.f;
        f32x2 s2 = {0.f, 0.f};
#pragma unroll
        for (int j = 0; j < 4; ++j) { const f32x4 r4 = *(const LAS f32x4*)(wff + h * D + 4 * lane + 256 * j);
            s2 = s2 + __builtin_shufflevector(v[j], v[j], 0, 1) * __builtin_shufflevector(r4, r4, 0, 1); s2 = s2 + __builtin_shufflevector(v[j], v[j], 2, 3) * __builtin_shufflevector(r4, r4, 2, 3); }
        s = s2[0] + s2[1];
        p[h] = s; }
#pragma unroll
    for (int k = 0; k < 4; ++k) p[k] = rs_step32(p[k], p[k + 4]);
#pragma unroll
    for (int k = 0; k < 2; ++k) p[k] = rs_step16(p[k], p[k + 2]);
    const bool hi3 = (lane & 8) != 0;
    { const float snd = hi3 ? p[0] : p[1]; const float rcv = lane_xor8(snd); p[0] = (hi3 ? p[1] : p[0]) + rcv; }
    p[0] += lane_xor4(p[0]); p[0] += lane_xor2(p[0]); p[0] += lane_xor1(p[0]);
    if ((lane & 7) == 0) { const int h = lane >> 3; ((float*)(a.ws + WS_FL))[(size_t)row * 8 + h] = logsigmoidf_(p[0] + hbias); }
}

#ifndef ROW_XCD
#define ROW_XCD 0
#endif
#ifndef LN1_XCD
#define LN1_XCD 0
#endif
#define ROWMAP(F) const bool rxcd_ = ROW_XCD && (F).G == 256; const int row0 = rxcd_ ? 4096 * ((F).bid & 7) + ((F).bid >> 3) * NWAVES + (F).wave : (F).gw, rstep = rxcd_ ? 256 : (F).ngw, rend = rxcd_ ? 4096 * (((F).bid & 7) + 1) : T;
__device__ __forceinline__ void phase_prep(const Args& a, const Frame& F) {
    if (F.bid == 0) {
        float* lb_all = (float*)(a.ws + WS_MISC);
        const int c = F.tid;
        float v[DEPTH], m = -1e30f;
#pragma unroll
        for (int l = 0; l < DEPTH; ++l) { v[l] = a.lbl[l * 512 + c]; m = fmaxf(m, v[l]); }
        float s = 0.f;
#pragma unroll
        for (int l = 0; l < DEPTH; ++l) { v[l] = __expf(v[l] - m); s += v[l]; }
        float cum = 0.f;
#pragma unroll
        for (int l = 0; l < DEPTH; ++l) { const float p = v[l] / s; cum += p; lb_all[l * 512 + c] = cum - v[0] / s; }
    }
    bf16_t* XRES = (bf16_t*)(a.ws + WS_XRES); unsigned char* XN = a.ws + WS_XN;
    load_wff(a, F, 0); __syncthreads();
    ROWMAP(F)
    const LnGB gb = ln_load_gb(a.ln_in_g, a.ln_in_b, F.lane); const float hbias = a.b_in[0 * NIN + 1536 + (F.lane >> 3)];
    f32x4 vn[4];
#pragma unroll
    for (int j = 0; j < 4; ++j) vn[j] = *(const f32x4*)(a.x + (size_t)row0 * D + 4 * F.lane + 256 * j);
    for (int row = row0; row < rend; row += rstep) {
        f32x4 v[4];
#pragma unroll
        for (int j = 0; j < 4; ++j) v[j] = vn[j];
        if (row + rstep < rend) {
#pragma unroll
            for (int j = 0; j < 4; ++j) vn[j] = *(const f32x4*)(a.x + (size_t)(row + rstep) * D + 4 * F.lane + 256 * j); }
        ln_rows16(v, gb, F.lane);
        store_row(v, F.lane, XRES + (size_t)row * D, XN + (size_t)row * D, nullptr);
        fox_gates_row(a, F, 0, v, row, hbias);
    }
    __syncthreads();
    convert_layer(a, F, 0, F.gw, F.ngw);
}

__device__ __forceinline__ void phase_fscan(const Args& a, const Frame& F) {
    if (F.bid >= BATCH * NH) return;
    const float* FL = (const float*)(a.ws + WS_FL); float* F2 = (float*)(a.ws + WS_F2);
    LAS float* wsum = (LAS float*)(F.lds + RING_OFF);
    const int bh = F.bid, b = bh >> 3, h = bh & 7, tid = F.tid, lane = F.lane, w = F.wave;
    float v[4], run = 0.f;
#pragma unroll
    for (int i = 0; i < 4; ++i) { run += FL[((size_t)b * SEQ + tid * 4 + i) * 8 + h]; v[i] = run; }
    float incl = run;
#pragma unroll
    for (int o = 1; o < 64; o <<= 1) { const float u = __shfl_up(incl, o); if (lane >= o) incl += u; }
    if (lane == 63) wsum[w] = incl;
    __syncthreads();
    float base = incl - run; for (int i = 0; i < w; ++i) base += wsum[i];
#pragma unroll
    for (int i = 0; i < 4; ++i) F2[(size_t)bh * SEQ + tid * 4 + i] = (base + v[i]) * LOG2E;
    __syncthreads();
}

__device__ __forceinline__ void phase_attn_naive(const Args& a, const Frame& F) {
    const bf16_t* QO = (const bf16_t*)(a.ws + WS_QO); const bf16_t* KV = (const bf16_t*)(a.ws + WS_KV); const float* F2 = (const float*)(a.ws + WS_F2); bf16_t* O = (bf16_t*)(a.ws + WS_QO);
    LAS float* ps = (LAS float*)(F.lds + RING_OFF) + F.wave * 64;
    const int lane = F.lane;
    for (int gid = F.gw; gid < BATCH * NH * SEQ; gid += F.ngw) {
        const int bh = gid & 127, t = gid >> 7, b = bh >> 3, h = bh & 7;
        float q[64];
        { const bf16_t* qp = QO + ((size_t)b * SEQ + t) * 1024 + h * 64;
#pragma unroll
          for (int c = 0; c < 8; ++c) { const u32x4 u = *(const u32x4*)(qp + c * 8);
            q[c * 8 + 0] = bflo(u.x); q[c * 8 + 1] = bfhi(u.x); q[c * 8 + 2] = bflo(u.y); q[c * 8 + 3] = bfhi(u.y);
            q[c * 8 + 4] = bflo(u.z); q[c * 8 + 5] = bfhi(u.z); q[c * 8 + 6] = bflo(u.w); q[c * 8 + 7] = bfhi(u.w); } }
        float m = -1e30f, l = 0.f, o = 0.f;
        const float* f2 = F2 + (size_t)bh * SEQ;
        for (int s0 = 0; s0 <= t; s0 += 64) {
            const int s = s0 + lane; const bool valid = s <= t;
            float sc = -1e30f;
            if (valid) { const bf16_t* kp = KV + ((size_t)b * SEQ + s) * 1024 + h * 64; float d = 0.f;
#pragma unroll
                for (int c = 0; c < 8; ++c) { const u32x4 u = *(const u32x4*)(kp + c * 8);
                    d += q[c * 8 + 0] * bflo(u.x) + q[c * 8 + 1] * bfhi(u.x) + q[c * 8 + 2] * bflo(u.y) + q[c * 8 + 3] * bfhi(u.y)
                       + q[c * 8 + 4] * bflo(u.z) + q[c * 8 + 5] * bfhi(u.z) + q[c * 8 + 6] * bflo(u.w) + q[c * 8 + 7] * bfhi(u.w); }
                sc = d - f2[s]; }
            const float mn = fmaxf(m, wave_max(sc));
            const float p = valid ? exp2f(sc - mn) : 0.f;
            const float f = exp2f(m - mn);
            l = l * f + wave_sum(p); o *= f; m = mn;
            ps[lane] = p;
            asm volatile("s_waitcnt lgkmcnt(0)" ::: "memory");
            const int nk = min(64, t - s0 + 1);
            const bf16_t* vp = KV + ((size_t)b * SEQ + s0) * 1024 + 512 + h * 64 + lane;
            for (int j = 0; j < nk; ++j) o += ps[j] * bf2f(vp[(size_t)j * 1024]);
            asm volatile("s_waitcnt lgkmcnt(0)" ::: "memory");
        }
        O[((size_t)b * SEQ + t) * 1024 + h * 64 + lane] = (bf16_t)f2bf(o / l);
    }
}

__device__ __forceinline__ void phase_hgrn_naive(const Args& a, const Frame& F, int l) {
    if (F.bid >= BATCH * NH || F.wave != 0) return;
    const bf16_t* HB = (const bf16_t*)(a.ws + WS_HB); const float* LOGF = (const float*)(a.ws + WS_LOGF); const bf16_t* HG = (const bf16_t*)(a.ws + WS_HG); bf16_t* O = (bf16_t*)(a.ws + WS_QO);
    LAS float* Lf = (LAS float*)(F.lds + RING_OFF + 1024); LAS float* Lk = Lf + 4096; LAS float* Lq = Lk + 4096;
    const int bh = F.bid, b = bh >> 3, h = bh & 7, lane = F.lane;
    float Sx[64];
#pragma unroll
    for (int d = 0; d < 64; ++d) Sx[d] = 0.f;
    const float ng = a.norm_g[l * 512 + h * 64 + lane];
    for (int c0 = 0; c0 < SEQ; c0 += 64) {
        for (int tt = 0; tt < 64; ++tt) { const size_t row = (size_t)b * SEQ + c0 + tt;
            const float lf = LOGF[row * 512 + h * 64 + lane]; const float f = exp2f(lf);
            Lf[tt * 64 + lane] = f; Lk[tt * 64 + lane] = 1.f - f; Lq[tt * 64 + lane] = bf2f(HB[row * 1024 + h * 64 + lane]); }
        asm volatile("s_waitcnt lgkmcnt(0)" ::: "memory");
        for (int tt = 0; tt < 64; ++tt) { const size_t row = (size_t)b * SEQ + c0 + tt;
            const float v = bf2f(HB[row * 1024 + 512 + h * 64 + lane]);
            float o = 0.f;
#pragma unroll
            for (int d = 0; d < 64; d += 4) { const f32x4 f4 = *(const LAS f32x4*)(Lf + tt * 64 + d), k4 = *(const LAS f32x4*)(Lk + tt * 64 + d), q4 = *(const LAS f32x4*)(Lq + tt * 64 + d);
                Sx[d] = f4.x * Sx[d] + k4.x * v; o += Sx[d] * q4.x; Sx[d + 1] = f4.y * Sx[d + 1] + k4.y * v; o += Sx[d + 1] * q4.y;
                Sx[d + 2] = f4.z * Sx[d + 2] + k4.z * v; o += Sx[d + 2] * q4.z; Sx[d + 3] = f4.w * Sx[d + 3] + k4.w * v; o += Sx[d + 3] * q4.w; }
            const float ss = wave_sum(o * o);
            const float r = o * rsqrtf(ss * (1.f / 64.f) + RMS_EPS) * ng * bf2f(HG[row * 512 + h * 64 + lane]);
            O[row * 1024 + 512 + h * 64 + lane] = (bf16_t)f2bf(r); }
        asm volatile("s_waitcnt lgkmcnt(0)" ::: "memory");
    }
}

#ifndef LN1_MFMA
#define LN1_MFMA 0
#endif
#if LN1_MFMA
constexpr int LN1_WP = 2064, LN1_WH = 0, LN1_WL = 16 * LN1_WP, LN1_LG = 66560, LN1_ASG = LN1_LG + 8 * 16 * 16 * 4, LN1_BASE = LN1_ASG + 128 * 16, LN1_GB = 77824;
#else
constexpr int LN1_RW = 0, LN1_LG = 65536, LN1_ASG = LN1_LG + 8 * 16 * 16 * 4, LN1_BASE = LN1_ASG + 128 * 16;
#endif
__device__ __forceinline__ void phase_ln1_router(const Args& a, const Frame& F, int l) {
    const bf16_t* xres = (const bf16_t*)(a.ws + WS_XRES); bf16_t* x1 = (bf16_t*)(a.ws + WS_X1B); const unsigned char* mixed = a.ws + WS_MIXED;   unsigned char* xn = a.ws + WS_XN;
    unsigned* cnt = (unsigned*)(a.ws + WS_CTL) + CW_CNT + l * 64; int* list = (int*)(a.ws + WS_LIST); unsigned* tokinfo = (unsigned*)(a.ws + WS_TOK);
    const float* g = a.ln1_g + l * D; const float* bta = a.ln1_b + l * D;
    LAS float* lgs = (LAS float*)(F.lds + RING_OFF + LN1_LG) + F.wave * 256;
    LAS u32x4* asg = (LAS u32x4*)(F.lds + RING_OFF + LN1_ASG);
    LAS unsigned* basep = (LAS unsigned*)(F.lds + RING_OFF + LN1_BASE);
    const int lane = F.lane;
#if LN1_MFMA
    { LAS unsigned char* L = F.lds + RING_OFF;
      for (int i = F.tid; i < NE * D; i += NWAVES * 64) { const int c = i >> 4, e = i & 15; const float wv = a.router_w[i]; const unsigned hi = pk2(wv, 0.f) & 0xffffu; const float r = wv - bf2f(hi);
          *(LAS unsigned short*)(L + LN1_WH + e * LN1_WP + c * 2) = (unsigned short)hi; *(LAS unsigned short*)(L + LN1_WL + e * LN1_WP + c * 2) = (unsigned short)(pk2(r, 0.f) & 0xffffu); }
      for (int i = F.tid; i < D; i += NWAVES * 64) { ((LAS float*)(L + LN1_GB))[i] = g[i]; ((LAS float*)(L + LN1_GB))[D + i] = bta[i]; } }
    __syncthreads();
    for (int blk = (LN1_XCD && F.G == 256) ? (F.bid & 7) * 32 + (F.bid >> 3) : F.bid; blk < T / 128; blk += F.G) {
        const int R0 = blk * 128 + F.wave * 16;
        { const int r = lane & 15, q = lane >> 4; const size_t rowg = (size_t)(R0 + r);
          const unsigned char* xrow = (const unsigned char*)xres + rowg * 2048 + q * 16; const unsigned char* mrow = mixed + rowg * 1024 + q * 8;
          unsigned char* x1row = (unsigned char*)x1 + rowg * 2048 + q * 16; unsigned char* xnrow = xn + rowg * 1024 + q * 8;
          const LAS unsigned char* L = F.lds + RING_OFF;
          float s1 = 0.f, s2 = 0.f;
          u32x4 xa[4], xb[4]; u32x2 ma[4], mb[4];
#pragma unroll
          for (int k = 0; k < 4; ++k) { xa[k] = *(const u32x4*)(xrow + k * 64); ma[k] = *(const u32x2*)(mrow + k * 32); }
          for (int s0 = 0; s0 < 32; s0 += 4) {
              const int sn = (s0 + 4 < 32) ? s0 + 4 : 0;
#pragma unroll
              for (int k = 0; k < 4; ++k) { xb[k] = *(const u32x4*)(xrow + (sn + k) * 64); mb[k] = *(const u32x2*)(mrow + (sn + k) * 32); }
#pragma unroll
              for (int k = 0; k < 4; ++k) { f32x4 x0, x1v, m0, m1; pg8::unpack8(xa[k], x0, x1v); pg8::unpack8_fp8(ma[k], 1.f / SC_MIX, m0, m1);
                  const f32x4 v0 = x0 * ALPHA + m0, v1 = x1v * ALPHA + m1; const f32x4 t = v0 + v1, u = v0 * v0 + v1 * v1;
                  s1 += (t[0] + t[1]) + (t[2] + t[3]); s2 += (u[0] + u[1]) + (u[2] + u[3]); }
#pragma unroll
              for (int k = 0; k < 4; ++k) { xa[k] = xb[k]; ma[k] = mb[k]; } }
          s1 = rs_step16(s1, s1); s1 = rs_step32(s1, s1); s2 = rs_step16(s2, s2); s2 = rs_step32(s2, s2);
          const float mean = s1 * (1.f / D); const float rstd = rsqrtf(fmaxf(s2 * (1.f / D) - mean * mean, 0.f) + LN_EPS); const float nmr = -mean * rstd;
          f32x4 acc = {0.f, 0.f, 0.f, 0.f};
          for (int s0 = 0; s0 < 32; s0 += 4) {
              if (s0 + 4 < 32) {
#pragma unroll
                  for (int k = 0; k < 4; ++k) { xb[k] = *(const u32x4*)(xrow + (s0 + 4 + k) * 64); mb[k] = *(const u32x2*)(mrow + (s0 + 4 + k) * 32); } }
#pragma unroll
              for (int k = 0; k < 4; ++k) { const int s = s0 + k; f32x4 x0, x1v, m0, m1; pg8::unpack8(xa[k], x0, x1v); pg8::unpack8_fp8(ma[k], 1.f / SC_MIX, m0, m1);
                  const LAS float* gp = (const LAS float*)(L + LN1_GB) + 32 * s + 8 * q;
                  const f32x4 g0 = *(const LAS f32x4*)gp, g1 = *(const LAS f32x4*)(gp + 4), b0 = *(const LAS f32x4*)(gp + D), b1 = *(const LAS f32x4*)(gp + D + 4);
                  const f32x4 y0 = ((x0 * ALPHA + m0) * rstd + nmr) * g0 + b0, y1 = ((x1v * ALPHA + m1) * rstd + nmr) * g1 + b1;
                  const u32x4 yh = pg8::pack8(y0, y1);
                  *(u32x4*)(x1row + s * 64) = yh;
                  *(u32x2*)(xnrow + s * 32) = pg8::pack8_fp8(y0, y1);
                  f32x4 h0, h1; pg8::unpack8(yh, h0, h1); const u32x4 yl = pg8::pack8(y0 - h0, y1 - h1);
                  const bf16x8 wh = *(const LAS bf16x8*)(L + LN1_WH + r * LN1_WP + (32 * s + 8 * q) * 2), wl = *(const LAS bf16x8*)(L + LN1_WL + r * LN1_WP + (32 * s + 8 * q) * 2);
                  const bf16x8 bh = __builtin_bit_cast(bf16x8, yh), bl = __builtin_bit_cast(bf16x8, yl);
                  acc = __builtin_amdgcn_mfma_f32_16x16x32_bf16(wh, bh, acc, 0, 0, 0); acc = __builtin_amdgcn_mfma_f32_16x16x32_bf16(wl, bh, acc, 0, 0, 0); acc = __builtin_amdgcn_mfma_f32_16x16x32_bf16(wh, bl, acc, 0, 0, 0); }
#pragma unroll
              for (int k = 0; k < 4; ++k) { xa[k] = xb[k]; ma[k] = mb[k]; } }
          *(LAS f32x4*)(lgs + r * 16 + 4 * q) = acc; }
#else
    LAS float* rw = (LAS float*)(F.lds + RING_OFF + LN1_RW);
    { float t[32];
#pragma unroll
      for (int k = 0; k < 32; ++k) t[k] = a.router_w[F.tid + k * (NWAVES * 64)];
#pragma unroll
      for (int k = 0; k < 32; ++k) { const int i = F.tid + k * (NWAVES * 64); rw[(i & 15) * D + (i >> 4)] = t[k]; } }
    __syncthreads();
    const LnGB gb = ln_load_gb(g, bta, lane);
    for (int blk = (LN1_XCD && F.G == 256) ? (F.bid & 7) * 32 + (F.bid >> 3) : F.bid; blk < T / 128; blk += F.G) {
        const int R0 = blk * 128 + F.wave * 16;
        u32x2 nx[4]; unsigned nm[4];
#pragma unroll
        for (int j = 0; j < 4; ++j) { const int c = 4 * lane + 256 * j; nx[j] = *(const u32x2*)(xres + (size_t)R0 * D + c); nm[j] = *(const unsigned*)(mixed + (size_t)R0 * D + c); }
        for (int i = 0; i < 16; ++i) { const int row = R0 + i;
            f32x4 v[4];
#pragma unroll
            for (int j = 0; j < 4; ++j) { const u32x2 xv = nx[j]; const f32x2 m01 = __builtin_amdgcn_cvt_pk_f32_fp8((int)nm[j], false), m23 = __builtin_amdgcn_cvt_pk_f32_fp8((int)nm[j], true);
                v[j].x = ALPHA * bflo(xv.x) + m01[0] * (1.f / SC_MIX); v[j].y = ALPHA * bfhi(xv.x) + m01[1] * (1.f / SC_MIX); v[j].z = ALPHA * bflo(xv.y) + m23[0] * (1.f / SC_MIX); v[j].w = ALPHA * bfhi(xv.y) + m23[1] * (1.f / SC_MIX); }
            { const int rn = (i < 15) ? row + 1 : row;
#pragma unroll
              for (int j = 0; j < 4; ++j) { const int c = 4 * lane + 256 * j; nx[j] = *(const u32x2*)(xres + (size_t)rn * D + c); nm[j] = *(const unsigned*)(mixed + (size_t)rn * D + c); } }
            ln_rows16(v, gb, lane);
            store_row(v, lane, x1 + (size_t)row * D, xn + (size_t)row * D, nullptr);
            float p[NE];
#pragma unroll
            for (int e = 0; e < NE; ++e) { float s = 0.f;
                f32x2 s2 = {0.f, 0.f};
#pragma unroll
                for (int j = 0; j < 4; ++j) { const f32x4 r4 = *(const LAS f32x4*)(rw + e * D + 4 * lane + 256 * j);
                    s2 = s2 + __builtin_shufflevector(v[j], v[j], 0, 1) * __builtin_shufflevector(r4, r4, 0, 1); s2 = s2 + __builtin_shufflevector(v[j], v[j], 2, 3) * __builtin_shufflevector(r4, r4, 2, 3); }
                s = s2[0] + s2[1];
                p[e] = s; asm volatile("" ::: "memory"); }
            {
#pragma unroll
              for (int k = 0; k < 8; ++k) p[k] = rs_step32(p[k], p[k + 8]);
#pragma unroll
              for (int k = 0; k < 4; ++k) p[k] = rs_step16(p[k], p[k + 4]);
              const bool hi3 = (lane & 8) != 0;
#pragma unroll
              for (int k = 0; k < 2; ++k) { const float snd = hi3 ? p[k] : p[k + 2]; const float rcv = lane_xor8(snd); p[k] = (hi3 ? p[k + 2] : p[k]) + rcv; }
              const bool hi2 = (lane & 4) != 0;
              { const float snd = hi2 ? p[0] : p[1]; const float rcv = lane_xor4(snd); p[0] = (hi2 ? p[1] : p[0]) + rcv; }
              p[0] += lane_xor2(p[0]); p[0] += lane_xor1(p[0]);
              if ((lane & 3) == 0) lgs[i * 16 + (lane >> 2)] = p[0]; }
        }
#endif
        asm volatile("s_waitcnt lgkmcnt(0)" ::: "memory");
        if (lane < 16) {
            float lg[NE];
#pragma unroll
            for (int q = 0; q < 4; ++q) { const f32x4 t4 = *(const LAS f32x4*)(lgs + lane * 16 + 4 * q); lg[4 * q] = t4[0] + a.router_b[4 * q]; lg[4 * q + 1] = t4[1] + a.router_b[4 * q + 1]; lg[4 * q + 2] = t4[2] + a.router_b[4 * q + 2]; lg[4 * q + 3] = t4[3] + a.router_b[4 * q + 3]; }
            int gs = 0; float gbest = -3e38f;
#pragma unroll
            for (int gi = 0; gi < 4; ++gi) { const float mx = fmaxf(fmaxf(lg[gi * 4], lg[gi * 4 + 1]), fmaxf(lg[gi * 4 + 2], lg[gi * 4 + 3])); if (mx > gbest) { gbest = mx; gs = gi; } }
            float l4[4];
#pragma unroll
            for (int i = 0; i < 4; ++i) { float t0 = lg[i];
#pragma unroll
                for (int gi = 1; gi < 4; ++gi) t0 = (gs == gi) ? lg[gi * 4 + i] : t0; l4[i] = t0; }
            int i0 = 0; float b0 = l4[0];
#pragma unroll
            for (int i = 1; i < 4; ++i) if (l4[i] > b0) { b0 = l4[i]; i0 = i; }
            int i1 = 0; float b1 = -3e38f;
#pragma unroll
            for (int i = 0; i < 4; ++i) if (i != i0 && l4[i] > b1) { b1 = l4[i]; i1 = i; }
            const float e1 = __expf(b1 - b0); const float g0 = 1.f / (1.f + e1), g1 = e1 / (1.f + e1);
            u32x4 as; as.x = (unsigned)(gs * 4 + i0); as.y = (unsigned)(gs * 4 + i1); as.z = __float_as_uint(g0); as.w = __float_as_uint(g1);
            asg[F.wave * 16 + lane] = as;
        }
        __syncthreads();
        if (F.wave == 0) {
            const u32x4 A0 = asg[lane], A1 = asg[lane + 64];
            const unsigned ex[4] = {A0.x, A0.y, A1.x, A1.y};
            unsigned rank[4] = {0u, 0u, 0u, 0u}, mycount = 0u;
            const unsigned long long lt = (1ull << lane) - 1ull;
#pragma unroll 1
            for (unsigned e = 0; e < NE; ++e) { unsigned run = 0u;
#pragma unroll
                for (int s = 0; s < 4; ++s) { const unsigned long long m = __ballot(ex[s] == e); if (ex[s] == e) rank[s] = run + (unsigned)__popcll(m & lt); run += (unsigned)__popcll(m); }
                if ((unsigned)lane == e) mycount = run; }
            if (lane < NE) basep[lane] = atomicAdd(cnt + lane, mycount);
            asm volatile("s_waitcnt vmcnt(0) lgkmcnt(0)" ::: "memory");
            const unsigned p0 = basep[ex[0]] + rank[0], p1 = basep[ex[1]] + rank[1], p2 = basep[ex[2]] + rank[2], p3 = basep[ex[3]] + rank[3];
            const int ra = blk * 128 + lane, rb = ra + 64;
            list[ex[0] * T + p0] = ra; list[ex[1] * T + p1] = ra; list[ex[2] * T + p2] = rb; list[ex[3] * T + p3] = rb;
            u32x4 ta, tb; ta.x = (ex[0] << 24) | p0; ta.y = (ex[1] << 24) | p1; ta.z = A0.z; ta.w = A0.w; tb.x = (ex[2] << 24) | p2; tb.y = (ex[3] << 24) | p3; tb.z = A1.z; tb.w = A1.w;
            *(u32x4*)(tokinfo + (size_t)ra * 4) = ta; *(u32x4*)(tokinfo + (size_t)rb * 4) = tb;
        }
        __syncthreads();
    }
}

__device__ __forceinline__ void moe_table(const Args& a, const Frame& F, int l) {
    LAS int* tab = (LAS int*)(F.lds + TAB_OFF);
    const unsigned* cnt = (const unsigned*)(a.ws + WS_CTL) + CW_CNT + l * 64;
    if (F.wave == 0) {
        const int e = F.lane & 15; const int c = (int)__hip_atomic_load(cnt + e, RLX_AGENT); const int nt = (c + TM - 1) / TM;
        int incl = nt;
#pragma unroll
        for (int o = 1; o < 16; o <<= 1) { const int u = __shfl_up(incl, o, 16); if (e >= o) incl += u; }
        if (F.lane < NE) { tab[e] = incl - nt; tab[NE + 1 + e] = c; if (e == NE - 1) tab[NE] = incl; } }
    __syncthreads();
}

__device__ __forceinline__ void phase_combine_ln2(const Args& a, const Frame& F, int l) {
    bf16_t* xres = (bf16_t*)(a.ws + WS_XRES); const bf16_t* x1 = (const bf16_t*)(a.ws + WS_X1B); const unsigned char* Y = a.ws + WS_Y;   const unsigned* tokinfo = (const unsigned*)(a.ws + WS_TOK); unsigned char* xn = a.ws + WS_XN;
    const float* g = a.ln2_g + l * D; const float* bta = a.ln2_b + l * D; float* out = (l == DEPTH - 1) ? a.out : nullptr;
    const LAS int* tab = (const LAS int*)(F.lds + TAB_OFF);
    const int lane = F.lane;
    const LnGB gb = ln_load_gb(g, bta, lane); const float hbias = (l + 1 < DEPTH) ? a.b_in[(l + 1) * NIN + 1536 + (lane >> 3)] : 0.f;
    ROWMAP(F)
    int row = row0;
    u32x4 tk = *(const u32x4*)(tokinfo + (size_t)row * 4), tkn = tk;
    u32x2 xa[4]; unsigned ya[4], yb[4]; float h0, h1;
    { const size_t s0 = (size_t)tab[tk.x >> 24] * TM + (tk.x & 0xffffff), s1 = (size_t)tab[tk.y >> 24] * TM + (tk.y & 0xffffff);
      h0 = __uint_as_float(tk.z) * (1.f / SC_Y); h1 = __uint_as_float(tk.w) * (1.f / SC_Y);
#pragma unroll
      for (int j = 0; j < 4; ++j) { const int c = 4 * lane + 256 * j; xa[j] = *(const u32x2*)(x1 + (size_t)row * D + c); ya[j] = *(const unsigned*)(Y + s0 * D + c); yb[j] = *(const unsigned*)(Y + s1 * D + c); } }
    if (row + rstep < rend) tkn = *(const u32x4*)(tokinfo + (size_t)(row + rstep) * 4);
    for (; row < rend; row += rstep) {
        const int rown = row + rstep; const bool hasn = rown < rend;
        u32x2 xn_[4]; unsigned yan[4], ybn[4]; float h0n = 0.f, h1n = 0.f; u32x4 tknn = tkn;
        if (hasn) { const size_t s0 = (size_t)tab[tkn.x >> 24] * TM + (tkn.x & 0xffffff), s1 = (size_t)tab[tkn.y >> 24] * TM + (tkn.y & 0xffffff);
            h0n = __uint_as_float(tkn.z) * (1.f / SC_Y); h1n = __uint_as_float(tkn.w) * (1.f / SC_Y);
#pragma unroll
            for (int j = 0; j < 4; ++j) { const int c = 4 * lane + 256 * j; xn_[j] = *(const u32x2*)(x1 + (size_t)rown * D + c); yan[j] = *(const unsigned*)(Y + s0 * D + c); ybn[j] = *(const unsigned*)(Y + s1 * D + c); }
            if (rown + rstep < rend) tknn = *(const u32x4*)(tokinfo + (size_t)(rown + rstep) * 4);
        } else {
#pragma unroll
            for (int j = 0; j < 4; ++j) { xn_[j] = xa[j]; yan[j] = ya[j]; ybn[j] = yb[j]; } }
        f32x4 v[4];
#pragma unroll
        for (int j = 0; j < 4; ++j) { const u32x2 xw = xa[j]; const f32x4 xv = {bflo(xw.x), bfhi(xw.x), bflo(xw.y), bfhi(xw.y)};
            const f32x2 a01 = __builtin_amdgcn_cvt_pk_f32_fp8((int)ya[j], false), a23 = __builtin_amdgcn_cvt_pk_f32_fp8((int)ya[j], true), b01 = __builtin_amdgcn_cvt_pk_f32_fp8((int)yb[j], false), b23 = __builtin_amdgcn_cvt_pk_f32_fp8((int)yb[j], true);
            v[j].x = ALPHA * xv.x + h0 * a01[0] + h1 * b01[0]; v[j].y = ALPHA * xv.y + h0 * a01[1] + h1 * b01[1];
            v[j].z = ALPHA * xv.z + h0 * a23[0] + h1 * b23[0]; v[j].w = ALPHA * xv.w + h0 * a23[1] + h1 * b23[1]; }
        ln_rows16(v, gb, lane);
        store_row(v, lane, xres + (size_t)row * D, xn + (size_t)row * D, out ? out + (size_t)row * D : nullptr);
        if (l + 1 < DEPTH) fox_gates_row(a, F, l + 1, v, row, hbias);
#pragma unroll
        for (int j = 0; j < 4; ++j) { xa[j] = xn_[j]; ya[j] = yan[j]; yb[j] = ybn[j]; }
        h0 = h0n; h1 = h1n; tkn = tknn;
    }
}


constexpr int ATT_F2_OFF = 86016;
#ifndef HG_MID
#define HG_MID 0
#endif
__device__ __forceinline__ void phase_hgrn(const Args& a, const Frame& F, int l, int bh);
__device__ __forceinline__ void phase_attn(const Args& a, const Frame& F, char* lds_generic, int l, int part = 0) {
    const int c = F.bid, vcu = (F.G % 8 == 0) ? (c % 8) * (F.G / 8) + c / 8 : c;
    const attn_body::bf16* Q = (const attn_body::bf16*)(a.ws + WS_QO); const attn_body::bf16* K = (const attn_body::bf16*)(a.ws + WS_KV); const attn_body::bf16* V = K + 512;
    attn_body::bf16* O = (attn_body::bf16*)(a.ws + WS_OX8);
    const float* FL = (const float*)(a.ws + WS_FL);
    LAS float* f2 = (LAS float*)(F.lds + ATT_F2_OFF); LAS float* wsum = f2 + 2048;
    { const int bh = vcu >> 1; if (bh >= BATCH * NH) return;
        const int b = bh >> 3, h = bh & 7, tid = F.tid, lane = F.lane, w = F.wave;
        if (part != 2) {
        float v[4], run = 0.f;
#pragma unroll
        for (int i = 0; i < 4; ++i) { run += FL[((size_t)b * SEQ + tid * 4 + i) * 8 + h]; v[i] = run; }
        float incl = run;
#pragma unroll
        for (int o = 1; o < 64; o <<= 1) { const float u = __shfl_up(incl, o); if (lane >= o) incl += u; }
        if (lane == 63) wsum[w] = incl;
        __syncthreads();
        float base = incl - run; for (int i = 0; i < w; ++i) base += wsum[i];
        f32x4 o4; o4[0] = (base + v[0]) * LOG2E; o4[1] = (base + v[1]) * LOG2E; o4[2] = (base + v[2]) * LOG2E; o4[3] = (base + v[3]) * LOG2E;
        *(LAS f32x4*)(f2 + tid * 4) = o4;
        __syncthreads(); }
#ifndef ATT_THRL
#define ATT_THRL 40
#endif
#ifndef ATT_SPLIT
#define ATT_SPLIT 1
#endif
        const int nun = (vcu & 1) ? 6 : 2; constexpr int ev2 = ATT_SPLIT;
#ifndef ATT_LATE
#define ATT_LATE 0
#endif
#ifndef ATT_PRIO
#define ATT_PRIO 1
#endif
        if (ATT_PRIO && w >= 4) __builtin_amdgcn_s_setprio(1);
        for (int i = (part == 2) ? 1 : 0; i < ((part == 1) ? 1 : nun); ++i) { int qb;
            if (HG_MID && !(vcu & 1) && i == 1) { __syncthreads(); phase_hgrn(a, F, l, vcu >> 1); __syncthreads(); }
            if (vcu & 1) { const int ii = ATT_LATE ? ((i == nun - 1) ? 0 : i + 1) : i; qb = 6 - ii; if (qb <= ev2) qb -= 1; }
            else qb = ((i == 0) != (ATT_LATE != 0)) ? 7 : ev2;
            int tid_u = F.tid; asm volatile("" : "+v"(tid_u));
            attn_body::attn_unit<ATT_THRL>(b, h, qb, Q, K, V, O, lds_generic + RING_OFF, f2, tid_u); }
        if (ATT_PRIO) __builtin_amdgcn_s_setprio(0);
        __syncthreads();
    }
}

#ifndef HG_NT
#define HG_NT 0
#endif
#if HG_NT
#define HG_LD(p) __builtin_nontemporal_load(p)
#else
#define HG_LD(p) (*(p))
#endif
namespace hg {
constexpr int PB = 144;
constexpr int O_QS = 0, O_KS = 9216, O_QI = 18432, O_KUT = 27648, O_VT = 36864, O_P = 46080, O_ST = 55296, O_TOT = 64512, O_EBL = 66560, O_RED = 66816, O_OS = 67328, BYTES = 67328 + 8 * 16 * 80;
__device__ __forceinline__ float ex(float v) { return __builtin_amdgcn_exp2f(v); }
__device__ __forceinline__ unsigned short bf1(float v) { return (unsigned short)pk2(v, v); }
}
__device__ __forceinline__ void phase_hgrn(const Args& a, const Frame& F, int l, int bh) {
    using namespace hg;
    const bf16_t* HB = (const bf16_t*)(a.ws + WS_HB); const float* LOGF = (const float*)(a.ws + WS_LOGF); const bf16_t* HG = (const bf16_t*)(a.ws + WS_HG); unsigned char* O8 = a.ws + WS_OX8;
    LAS unsigned char* L = F.lds + RING_OFF;
    const int b = bh >> 3, h = bh & 7, lane = F.lane, w = F.wave, tid = F.tid;
    const int fr = lane & 15, fq = lane >> 4;
    const int tr = w >> 1, tc0 = 2 * (w & 1);
    const float ng0 = a.norm_g[l * 512 + h * 64 + 16 * tc0 + fr], ng1 = a.norm_g[l * 512 + h * 64 + 16 * (tc0 + 1) + fr];
    f32x4 S0 = {0.f, 0.f, 0.f, 0.f}, S1 = {0.f, 0.f, 0.f, 0.f};
    for (int i = tid; i < 9216 / 4; i += NWAVES * 64) ((LAS unsigned*)(L + O_ST))[i] = 0u;
    const size_t rowbase = (size_t)b * SEQ;
    float g[8]; unsigned qv[8], vv[8];
#pragma unroll
    for (int i = 0; i < 8; ++i) { const size_t row = rowbase + 8 * w + i; g[i] = HG_LD(LOGF + row * 512 + h * 64 + lane); qv[i] = HG_LD(HB + row * 1024 + h * 64 + lane); vv[i] = HG_LD(HB + row * 1024 + 512 + h * 64 + lane); }
    const int orow = 16 * tr + (lane >> 2), ocol = 16 * tc0 + (lane & 3) * 8;
    u32x4 gvn = HG_LD((const u32x4*)(HG + (rowbase + orow) * 512 + h * 64 + ocol));
    u32x2 rst = {0u, 0u}; size_t rowst = rowbase;
    for (int c0 = 0; c0 < SEQ; c0 += 64) {
        asm volatile("" : "+v"(g[0]), "+v"(g[1]), "+v"(g[2]), "+v"(g[3]), "+v"(g[4]), "+v"(g[5]), "+v"(g[6]), "+v"(g[7]));
        asm volatile("" : "+v"(qv[0]), "+v"(qv[1]), "+v"(qv[2]), "+v"(qv[3]), "+v"(qv[4]), "+v"(qv[5]), "+v"(qv[6]), "+v"(qv[7]));
        asm volatile("" : "+v"(vv[0]), "+v"(vv[1]), "+v"(vv[2]), "+v"(vv[3]), "+v"(vv[4]), "+v"(vv[5]), "+v"(vv[6]), "+v"(vv[7]));
        u32x4 gv = gvn; asm volatile("" : "+v"(gv));
        if (c0 > 0) *(u32x2*)(O8 + rowst * 1024 + 512 + h * 64 + ocol) = rst;
        float bc[8]; { float run = 0.f;
#pragma unroll
            for (int i = 0; i < 8; ++i) { run += g[i]; bc[i] = run; } }
        ((LAS float*)(L + O_TOT))[w * 64 + lane] = bc[7];
        float qf[8], kf[8];
#pragma unroll
        for (int i = 0; i < 8; ++i) { qf[i] = bf2f(qv[i]); kf[i] = 1.f - ex(g[i]); }
        { u32x4 pk; pk.x = vv[0] | (vv[1] << 16); pk.y = vv[2] | (vv[3] << 16); pk.z = vv[4] | (vv[5] << 16); pk.w = vv[6] | (vv[7] << 16);
          *(LAS u32x4*)(L + O_VT + lane * PB + 16 * w) = pk; }
        __syncthreads();
        float base = 0.f, bm = 0.f, bl = 0.f;
#pragma unroll
        for (int ww = 0; ww < 8; ++ww) { const float tv = ((LAS float*)(L + O_TOT))[ww * 64 + lane]; if (ww < w) base += tv; if (ww < 4) bm += tv; bl += tv; }
        const float ebm = ex(bm), eblm = ex(bl - bm);
        if (w == 0) ((LAS float*)(L + O_EBL))[lane] = ex(bl);
        unsigned short ku[8];
#pragma unroll
        for (int i = 0; i < 8; ++i) { const float x = bc[i] + base - bm; const float e1 = ex(fminf(x, 115.f)), e2 = ex(fminf(-x, 115.f));
            const float qs = qf[i] * e1, ks = kf[i] * e2; const int r = 8 * w + i;
            *(LAS unsigned short*)(L + O_QS + r * PB + 2 * lane) = bf1(qs); *(LAS unsigned short*)(L + O_QI + r * PB + 2 * lane) = bf1(qs * ebm);
            *(LAS unsigned short*)(L + O_KS + r * PB + 2 * lane) = bf1(ks); ku[i] = bf1(ks * eblm); }
        { u32x4 pk; pk.x = (unsigned)ku[0] | ((unsigned)ku[1] << 16); pk.y = (unsigned)ku[2] | ((unsigned)ku[3] << 16); pk.z = (unsigned)ku[4] | ((unsigned)ku[5] << 16); pk.w = (unsigned)ku[6] | ((unsigned)ku[7] << 16);
          *(LAS u32x4*)(L + O_KUT + lane * PB + 16 * w) = pk; }
        if (c0 + 64 < SEQ) {
            gvn = HG_LD((const u32x4*)(HG + (rowbase + c0 + 64 + orow) * 512 + h * 64 + ocol));
#pragma unroll
            for (int i = 0; i < 8; ++i) { const size_t row = rowbase + c0 + 64 + 8 * w + i; g[i] = HG_LD(LOGF + row * 512 + h * 64 + lane); qv[i] = HG_LD(HB + row * 1024 + h * 64 + lane); vv[i] = HG_LD(HB + row * 1024 + 512 + h * 64 + lane); }
        }
        __syncthreads();
#pragma unroll
        for (int k2 = 0; k2 < 2; ++k2) { const int idx = 2 * w + k2, ti = idx >> 2, sj = idx & 3;
            f32x4 sc = {0.f, 0.f, 0.f, 0.f};
            if (sj <= ti) {
#pragma unroll
                for (int kk = 0; kk < 2; ++kk) { const bf16x8 af = *(const LAS bf16x8*)(L + O_QS + (16 * ti + fr) * PB + (32 * kk + 8 * fq) * 2), bfr = *(const LAS bf16x8*)(L + O_KS + (16 * sj + fr) * PB + (32 * kk + 8 * fq) * 2);
                    sc = __builtin_amdgcn_mfma_f32_16x16x32_bf16(af, bfr, sc, 0, 0, 0); }
            }
#pragma unroll
            for (int j = 0; j < 4; ++j) { const int t = 16 * ti + 4 * fq + j, s = 16 * sj + fr; *(LAS unsigned short*)(L + O_P + t * PB + 2 * s) = bf1(s <= t ? sc[j] : 0.f); }
        }
        __syncthreads();
        f32x4 o0 = {0.f, 0.f, 0.f, 0.f}, o1 = {0.f, 0.f, 0.f, 0.f}, u0 = {0.f, 0.f, 0.f, 0.f}, u1 = {0.f, 0.f, 0.f, 0.f};
#pragma unroll
        for (int kk = 0; kk < 2; ++kk) { const int ko = (32 * kk + 8 * fq) * 2;
            const bf16x8 pa = *(const LAS bf16x8*)(L + O_P + (16 * tr + fr) * PB + ko), qa = *(const LAS bf16x8*)(L + O_QI + (16 * tr + fr) * PB + ko), ka = *(const LAS bf16x8*)(L + O_KUT + (16 * tr + fr) * PB + ko);
            const bf16x8 v0 = *(const LAS bf16x8*)(L + O_VT + (16 * tc0 + fr) * PB + ko), v1 = *(const LAS bf16x8*)(L + O_VT + (16 * (tc0 + 1) + fr) * PB + ko);
            const bf16x8 s0 = *(const LAS bf16x8*)(L + O_ST + (16 * tc0 + fr) * PB + ko), s1 = *(const LAS bf16x8*)(L + O_ST + (16 * (tc0 + 1) + fr) * PB + ko);
            o0 = __builtin_amdgcn_mfma_f32_16x16x32_bf16(pa, v0, o0, 0, 0, 0); o1 = __builtin_amdgcn_mfma_f32_16x16x32_bf16(pa, v1, o1, 0, 0, 0);
            o0 = __builtin_amdgcn_mfma_f32_16x16x32_bf16(qa, s0, o0, 0, 0, 0); o1 = __builtin_amdgcn_mfma_f32_16x16x32_bf16(qa, s1, o1, 0, 0, 0);
            u0 = __builtin_amdgcn_mfma_f32_16x16x32_bf16(ka, v0, u0, 0, 0, 0); u1 = __builtin_amdgcn_mfma_f32_16x16x32_bf16(ka, v1, u1, 0, 0, 0); }
        { const f32x4 dec = *(const LAS f32x4*)(L + O_EBL + (16 * tr + 4 * fq) * 4); S0 = S0 * dec + u0; S1 = S1 * dec + u1; }
        { f32x4 q2 = o0 * o0 + o1 * o1;
#pragma unroll
          for (int j = 0; j < 4; ++j) { float t = q2[j]; t += lane_xor1(t); t += lane_xor2(t); t += dppmov<0x124>(t); t += dppmov<0x128>(t); q2[j] = t; }
          if (fr == 0) {
#pragma unroll
              for (int j = 0; j < 4; ++j) ((LAS float*)(L + O_RED))[(16 * tr + 4 * fq + j) * 2 + (w & 1)] = q2[j]; } }
        __syncthreads();
        { u32x2 p0, p1; p0.x = pk2(S0[0], S0[1]); p0.y = pk2(S0[2], S0[3]); p1.x = pk2(S1[0], S1[1]); p1.y = pk2(S1[2], S1[3]);
          *(LAS u32x2*)(L + O_ST + (16 * tc0 + fr) * PB + (16 * tr + 4 * fq) * 2) = p0; *(LAS u32x2*)(L + O_ST + (16 * (tc0 + 1) + fr) * PB + (16 * tr + 4 * fq) * 2) = p1; }
        { LAS unsigned char* os = L + O_OS + w * (16 * 80);
#pragma unroll
          for (int j = 0; j < 4; ++j) { const int t = 16 * tr + 4 * fq + j; const f32x2 rr = *(const LAS f32x2*)(L + O_RED + t * 8); const float rs = rsqrtf((rr[0] + rr[1]) * (1.f / 64.f) + RMS_EPS);
              *(LAS unsigned short*)(os + (4 * fq + j) * 80 + 2 * fr) = bf1(o0[j] * rs * ng0); *(LAS unsigned short*)(os + (4 * fq + j) * 80 + 2 * (16 + fr)) = bf1(o1[j] * rs * ng1); }
          asm volatile("s_waitcnt lgkmcnt(0)" ::: "memory");
          const u32x4 ov = *(const LAS u32x4*)(os + (lane >> 2) * 80 + (lane & 3) * 16);
          const size_t row = rowbase + c0 + orow;
          u32x2 r; r.x = pg8::pack4_fp8(bflo(ov.x) * bflo(gv.x) * SC_HGRN, bfhi(ov.x) * bfhi(gv.x) * SC_HGRN, bflo(ov.y) * bflo(gv.y) * SC_HGRN, bfhi(ov.y) * bfhi(gv.y) * SC_HGRN);
          r.y = pg8::pack4_fp8(bflo(ov.z) * bflo(gv.z) * SC_HGRN, bfhi(ov.z) * bfhi(gv.z) * SC_HGRN, bflo(ov.w) * bflo(gv.w) * SC_HGRN, bfhi(ov.w) * bfhi(gv.w) * SC_HGRN);
          rst = r; rowst = row;
          asm volatile("s_waitcnt lgkmcnt(0)" ::: "memory"); }
    }
    *(u32x2*)(O8 + rowst * 1024 + 512 + h * 64 + ocol) = rst;
}


constexpr int PH_PER_LAYER = 10, N_PHASES = 1 + DEPTH * PH_PER_LAYER;
#ifndef MK_ONE_LAUNCH
#define MK_ONE_LAUNCH 1
#endif
#ifndef MK_FAST_ATTN
#define MK_FAST_ATTN 0
#endif
#ifndef MK_FAST_HGRN
#define MK_FAST_HGRN 0
#endif


#ifdef DBG_DUMP
#ifndef DBG_WHAT
#define DBG_WHAT 0
#endif
__device__ __forceinline__ void dbg_dump(const Args& a, const Frame& F) {
    unsigned char* ws = a.ws;
    const bf16_t *QO = (bf16_t*)(ws + WS_QO), *KV = (bf16_t*)(ws + WS_KV), *HB = (bf16_t*)(ws + WS_HB), *HG = (bf16_t*)(ws + WS_HG), *G = (bf16_t*)(ws + WS_G);
    const bf16_t *U1 = (bf16_t*)(ws + WS_U1), *U = (bf16_t*)(ws + WS_U), *MIXED = (bf16_t*)(ws + WS_MIXED), *XN = (bf16_t*)(ws + WS_XN);
    const float *LOGF = (float*)(ws + WS_LOGF), *FL = (float*)(ws + WS_FL), *XRES = (float*)(ws + WS_XRES);
    for (size_t i = (size_t)F.bid * 512 + F.tid; i < (size_t)T * D; i += (size_t)gridDim.x * 512) {
        const size_t row = i >> 10; const int c = (int)(i & 1023);
        float v = 0.f;
        if (DBG_WHAT == 9) { v = bf2f(G[row * 2048 + c]) + bf2f(G[row * 2048 + 1024 + c]); }
        else if (DBG_DUMP == 1) { v = bf2f(KV[i]) + bf2f(HB[i]) + bf2f(G[row * 2048 + c]) + bf2f(G[row * 2048 + 1024 + c]);
            if (c < 512) v += LOGF[row * 512 + c] + bf2f(HG[row * 512 + c]) + bf2f(QO[i]); if (c < 8) v += FL[row * 8 + c]; }
        else if (DBG_DUMP == 2) { v = (c >= 512) ? bf2f(QO[i]) : 0.f; }
        else if (DBG_DUMP == 3) { v = bf2f(QO[i]); }
        else if (DBG_DUMP == 4) { v = bf2f(U1[i]); }
        else if (DBG_DUMP == 5) { v = bf2f(U[i]); }
        else if (DBG_DUMP == 6) { v = bf2f(MIXED[i]); }
        else if (DBG_DUMP == 7) { v = XRES[i] + bf2f(XN[i]); }
        a.out[i] = v;
    }
}
#endif
#define PH_BEGIN const Args a = LOAD_ARGS(); Frame F; F.lds = lds0; F.lane = (int)__builtin_amdgcn_mbcnt_hi(~0u, __builtin_amdgcn_mbcnt_lo(~0u, 0u)); asm volatile("" : "+v"(F.lane)); F.wave = __builtin_amdgcn_readfirstlane((int)((const volatile LAS unsigned*)(lds0 + WTAB_OFF))[hw_wave_key()]); F.tid = F.wave * 64 + F.lane; \
    F.G = gridDim.x; F.bid = blockIdx.x; asm volatile("" : "+s"(F.bid)); F.gw = F.bid * NWAVES + F.wave; F.ngw = F.G * NWAVES; unsigned char* const ws = a.ws; const LAS int* tab = (const LAS int*)(F.lds + TAB_OFF); (void)tab; (void)ws;
#ifdef DBG_DUMP
#define IN(k) (lo <= (k) && (k) < hi && (k) <= DBG_DUMP)
#else
#define IN(k) (lo <= (k) && (k) < hi)
#endif
#ifdef DBG_REPEAT
#define REP(k) for (int rep_ = 0; rep_ < ((DBG_REPEAT == (k) && !((k) == 9 && l == DEPTH - 1)) ? 2 : 1); ++rep_, __syncthreads())
#else
#define REP(k)
#endif
#define SEAM(k) do { if (IN(k) && IN((k) + 1)) { XcdBarrier b2_ = bar; { size_t z_ = 0; asm volatile("" : "+s"(z_), "+s"(b2_.x)); b2_.bar = bar.bar + z_; } xcd_barrier(b2_); } } while (0)
#ifdef DBG_MIX
#define MIX_STAMP(k) do { if (blockIdx.x == DBG_MIX_BID && threadIdx.x == 0) { const unsigned long long t_ = __builtin_amdgcn_s_memrealtime(); volatile LAS unsigned long long* d_ = (volatile LAS unsigned long long*)(lds0 + 131072 + 512); if ((k) > 0) d_[8 + (k)] = d_[8 + (k)] + (t_ - d_[8]); d_[8] = t_; } } while (0)
#else
#define MIX_STAMP(k) do {} while (0)
#endif
#ifndef MOE_XCD
#define MOE_XCD 1
#endif
#if MOE_XCD_CHUNK
#define MOE_IDLE(vc, J) (((vc) & 31) >= (J))
#define MOE_IDLE_ORD(vc, J) (((vc) >> 5) * (32 - (J)) + (((vc) & 31) - (J)))
#else
#define MOE_IDLE(vc, J) ((vc) >= 8 * (J))
#define MOE_IDLE_ORD(vc, J) ((vc) - 8 * (J))
#endif
#define MOE_VC(F) ((MOE_XCD && (F).G % 8 == 0) ? ((F).bid % 8) * ((F).G / 8) + (F).bid / 8 : (F).bid)
template <int l>
__device__ __forceinline__ void layer_body(const Args& args, const int lo, const int hi, const XcdBarrier& bar, LAS unsigned char* const lds0, unsigned char* lds_raw) {
        const int pb = 1 + l * PH_PER_LAYER;

#ifdef DBG_DUMP
        if (l == 0 && lo <= DBG_DUMP + 1 && DBG_DUMP + 1 < hi) { PH_BEGIN dbg_dump(a, F); }
#endif
        if (IN(pb + 0)) REP(0) { PH_BEGIN MIX_STAMP(0);
            pg8::Gemm g{(bf16_t*)(ws + WS_XN), (bf16_t*)(ws + wset(l) + WO_WIN), D / 2, D / 2, D / 2, E8_1, E8_W}; pg8::StaticOrder S; S.init(T, NINP, F.G, F.bid);
            pg8::EpiInproj E{ws, l};
            pg8::gemm_phase<pg8::EpiInproj, pg8::StaticOrder, PG8_ALIGN>(F.lds + RING_OFF, g, S, E, F.tid);
            MIX_STAMP(9);
        }
        SEAM(pb + 0);
        if (IN(pb + 1)) REP(1) { PH_BEGIN
            const int vcu = (F.G % 8 == 0) ? (F.bid % 8) * (F.G / 8) + F.bid / 8 : F.bid;
            MIX_STAMP(0);
#ifndef HG_SPLIT
#define HG_SPLIT 0
#endif
            const bool evn = (vcu & 1) == 0 && (vcu >> 1) < BATCH * NH;
            if (HG_SPLIT && evn) { phase_attn(a, F, (char*)lds_raw, l, 1); __syncthreads(); phase_hgrn(a, F, l, vcu >> 1); __syncthreads(); phase_attn(a, F, (char*)lds_raw, l, 2); }
            else {
            if (!HG_MID && evn) { phase_hgrn(a, F, l, vcu >> 1); __syncthreads(); }
            MIX_STAMP(1);
            phase_attn(a, F, (char*)lds_raw, l); }
            MIX_STAMP(2);
#ifndef CVT_QUEUE
#define CVT_QUEUE 0
#endif
            if (l + 1 < DEPTH) { __syncthreads();
                if (CVT_QUEUE) { convert_layer(a, F, l + 1, F.gw, F.ngw, 0); convert_queue(a, F, l + 1, (F.G == 256) ? CVT_N_C : CVT_NITEMS, (unsigned*)(a.ws + WS_CTL) + 2048 + l * 64); }
                else convert_layer(a, F, l + 1, F.gw, F.ngw, (F.G == 256) ? CVT_N_C : CVT_NITEMS); }
            MIX_STAMP(3);
        }
        SEAM(pb + 1);
        MIX_STAMP(4);
        if (IN(pb + 3)) REP(3) { PH_BEGIN
            pg8::Gemm g{(bf16_t*)(ws + WS_OX8), (bf16_t*)(ws + wset(l) + WO_WBR), D / 2, D / 2, 256, E8_FOX, E8_W}; pg8::StaticOrder S; S.init(T, D, F.G, F.bid);
            pg8::EpiGate<1> E{(bf16_t*)(ws + WS_U1), nullptr, ws + WS_G, nullptr, 0.f};
            pg8::gemm_phase<pg8::EpiGate<1>, pg8::StaticOrder, PG8_ALIGN>(F.lds + RING_OFF, g, S, E, F.tid);
        }
        if (IN(pb + 3) && IN(pb + 4)) __syncthreads(); else SEAM(pb + 3);
        if (IN(pb + 4)) REP(4) { PH_BEGIN
            pg8::Gemm g{(bf16_t*)(ws + WS_OX8) + 256, (bf16_t*)(ws + wset(l) + WO_WBR) + 256, D / 2, D / 2, 256, E8_HGRN, E8_W}; pg8::StaticOrder S; S.init(T, D, F.G, F.bid);
            pg8::EpiGate<2> E{(bf16_t*)(ws + WS_U), nullptr, ws + WS_G + 1024, ws + WS_U1, 0.f};
            pg8::gemm_phase<pg8::EpiGate<2>, pg8::StaticOrder, PG8_ALIGN>(F.lds + RING_OFF, g, S, E, F.tid);
        }
        SEAM(pb + 4);
        if (IN(pb + 5)) REP(5) { PH_BEGIN
            pg8::Gemm g{(bf16_t*)(ws + WS_U), (bf16_t*)(ws + wset(l) + WO_WMIX), D / 2, D / 2, D / 2, E8_U, E8_W}; pg8::StaticOrder S; S.init(T, D, F.G, F.bid);
            pg8::EpiGate<0> E{(bf16_t*)(ws + WS_MIXED), a.b_mix + l * D, nullptr, nullptr, SC_MIX};
            pg8::gemm_phase<pg8::EpiGate<0>, pg8::StaticOrder, PG8_ALIGN>(F.lds + RING_OFF, g, S, E, F.tid);
        }
        SEAM(pb + 5);
        if (IN(pb + 6)) REP(6) { PH_BEGIN MIX_STAMP(0); phase_ln1_router(a, F, l); MIX_STAMP(5); }
        SEAM(pb + 6);
        if (IN(pb + 7)) REP(7) { PH_BEGIN MIX_STAMP(0);
            moe_table(a, F, l);
            pg8::Gemm g{(bf16_t*)(ws + WS_XN), (bf16_t*)(ws + wset(l) + WO_W13), D / 2, D / 2, D / 2, E8_1, E8_W}; const int mvc = MOE_VC(F); pg8::MoeOrder<true> S{F.G, mvc, 8, tab, (const int*)(ws + WS_LIST), (size_t)2048 * (D / 2), (const LAS int*)(F.lds + TOK_OFF)};
            S.preload_tokens((LAS int*)(F.lds + TOK_OFF), F.tid); __syncthreads();
            pg8::EpiUp E{(bf16_t*)(ws + WS_H)};
            pg8::gemm_phase<pg8::EpiUp, pg8::MoeOrder<true>, PG8_ALIGN>(F.lds + RING_OFF, g, S, E, F.tid);
            if (l + 1 < DEPTH && F.G == 256 && MOE_IDLE(mvc, 16)) convert_items(a, F, l + 1, CVT_N_C, CVT_N_C + CVT_N_A, MOE_IDLE_ORD(mvc, 16) * NWAVES + F.wave, 128 * NWAVES);
            MIX_STAMP(6);
        }
        SEAM(pb + 7);
        if (IN(pb + 8)) REP(8) { PH_BEGIN MIX_STAMP(0);
            moe_table(a, F, l);
            pg8::Gemm g{(bf16_t*)(ws + WS_H), (bf16_t*)(ws + wset(l) + WO_W2), D / 2, D / 2, D / 2, E8_H, E8_W}; const int mvc = MOE_VC(F); pg8::MoeOrder<false> S{F.G, mvc, 4, tab, nullptr, (size_t)D * (D / 2), nullptr};
            pg8::EpiGate<0> E{(bf16_t*)(ws + WS_Y), (const float*)(ws + WS_CTL + 524288)  , nullptr, nullptr, SC_Y};
            pg8::gemm_phase<pg8::EpiGate<0>, pg8::MoeOrder<false>, PG8_ALIGN>(F.lds + RING_OFF, g, S, E, F.tid);
            if (l + 1 < DEPTH && F.G == 256 && MOE_IDLE(mvc, 8)) convert_items(a, F, l + 1, CVT_N_C + CVT_N_A, CVT_NITEMS, MOE_IDLE_ORD(mvc, 8) * NWAVES + F.wave, 192 * NWAVES);
            MIX_STAMP(7);
        }
        SEAM(pb + 8);
        if (IN(pb + 9)) REP(9) { PH_BEGIN MIX_STAMP(0);
            if (l + 1 < DEPTH) load_wff(a, F, l + 1);
            moe_table(a, F, l);
            phase_combine_ln2(a, F, l);
            MIX_STAMP(8);
        }
        SEAM(pb + 9);
    }

__global__ void __launch_bounds__(NWAVES * 64, 2) mk_fwd(Args args) {
    extern __shared__ __attribute__((aligned(16))) unsigned char lds_raw[];
    LAS unsigned char* const lds0 = (LAS unsigned char*)lds_raw;
    volatile LAS unsigned* MISC = (volatile LAS unsigned*)(lds0 + MISC_OFF);
    for (int u = threadIdx.x; u < (LDS_BYTES - LDSCTL_OFF) / 4; u += NWAVES * 64) ((LAS unsigned*)(lds0 + LDSCTL_OFF))[u] = 0u;
    __syncthreads();
    if ((threadIdx.x & 63) == 0) ((volatile LAS unsigned*)(lds0 + WTAB_OFF))[hw_wave_key()] = threadIdx.x >> 6;
    __syncthreads();
    unsigned* ctl = (unsigned*)(args.ws + WS_CTL);
    XcdBarrier bar; bar.bar = ctl + CW_BAR; bar.x = 0; bar.st = nullptr;
    if (args.use_bar) bar = xcd_barrier_post(ctl + CW_BAR, MISC + 8);
    const int lo = args.ph_lo, hi = args.ph_hi;


    if (IN(0)) { PH_BEGIN MIX_STAMP(0); phase_prep(a, F); MIX_STAMP(10); }
    SEAM(0);
    layer_body<0>(args, lo, hi, bar, lds0, lds_raw); layer_body<1>(args, lo, hi, bar, lds0, lds_raw); layer_body<2>(args, lo, hi, bar, lds0, lds_raw); layer_body<3>(args, lo, hi, bar, lds0, lds_raw);
#ifdef DBG_MIX
    if (blockIdx.x == DBG_MIX_BID && threadIdx.x == 0) { volatile LAS unsigned long long* d_ = (volatile LAS unsigned long long*)(lds0 + 131072 + 512); const unsigned long long val = d_[8 + DBG_MIX] / 100ull;
        const unsigned long long t0 = __builtin_amdgcn_s_memrealtime(); while (__builtin_amdgcn_s_memrealtime() - t0 < val * 100ull) __builtin_amdgcn_s_sleep(20); }
#endif
#ifdef DBG_SEG
    if (blockIdx.x == 0 && threadIdx.x == 0) { volatile LAS unsigned long long* d_ = (volatile LAS unsigned long long*)(lds0 + 131072 + 512); const unsigned long long cyc = d_[4], n = d_[5];
        const unsigned long long val = cyc / (n ? n : 1);
        const unsigned long long t0 = __builtin_amdgcn_s_memrealtime(); while (__builtin_amdgcn_s_memrealtime() - t0 < val * 100ull) __builtin_amdgcn_s_sleep(20); }
#endif
#ifdef DBG_CLK
    if (blockIdx.x == 0 && threadIdx.x == 0) { volatile LAS unsigned long long* d_ = (volatile LAS unsigned long long*)(lds0 + 131072 + 512); const unsigned long long cyc = d_[0], rt = d_[1], n = d_[2];
        const unsigned long long val = (DBG_CLK == 1) ? cyc / (n ? n : 1) : (DBG_CLK == 2) ? cyc * 100ull / (rt ? rt : 1) : rt / 100ull;
        const unsigned long long t0 = __builtin_amdgcn_s_memrealtime(); while (__builtin_amdgcn_s_memrealtime() - t0 < val * 100ull) __builtin_amdgcn_s_sleep(20); }
#endif
#undef IN
#undef SEAM
}

extern "C" void kernel_launch(void* const* d_in, const int* in_sizes, int n_in, void* d_out, int out_size, void* d_ws, size_t ws_size, hipStream_t stream) {
    static int grid = 0;
    if (grid == 0) {
        if (n_in != 20 || in_sizes[0] != T * D || out_size != T * D || ws_size < WS_END) { fprintf(stderr, "kernel_launch: unexpected shapes (n_in %d, ws %zu)\n", n_in, ws_size); grid = -1; return; }
        int dev = 0, cus = 0, per_cu = 0;
        if (hipGetDevice(&dev) != hipSuccess || hipDeviceGetAttribute(&cus, hipDeviceAttributeMultiprocessorCount, dev) != hipSuccess) { grid = -1; return; }
        if (hipFuncSetAttribute((const void*)mk_fwd, hipFuncAttributeMaxDynamicSharedMemorySize, LDS_BYTES) != hipSuccess) { fprintf(stderr, "kernel_launch: hipFuncSetAttribute failed\n"); grid = -1; return; }
        if (hipOccupancyMaxActiveBlocksPerMultiprocessor(&per_cu, (const void*)mk_fwd, NWAVES * 64, LDS_BYTES) != hipSuccess || per_cu < 1)
            fprintf(stderr, "kernel_launch: note: occupancy query reports %d workgroups per CU\n", per_cu);
        (void)hipGetLastError();
        grid = cus;
    }
    if (grid < 0) return;
    if (hipMemsetAsync((char*)d_ws + WS_CTL, 0, CTL_BYTES, stream) != hipSuccess) return;
    Args a{};
    a.x = (const float*)d_in[0]; a.ln_in_g = (const float*)d_in[1]; a.ln_in_b = (const float*)d_in[2]; a.w_in = (const float*)d_in[3]; a.b_in = (const float*)d_in[4];
    a.w_fox = (const float*)d_in[5]; a.lbl = (const float*)d_in[6]; a.norm_g = (const float*)d_in[7]; a.w_hgrn = (const float*)d_in[8]; a.w_mix = (const float*)d_in[9];
    a.b_mix = (const float*)d_in[10]; a.ln1_g = (const float*)d_in[11]; a.ln1_b = (const float*)d_in[12]; a.router_w = (const float*)d_in[13]; a.router_b = (const float*)d_in[14];
    a.w1 = (const float*)d_in[15]; a.w3 = (const float*)d_in[16]; a.w2 = (const float*)d_in[17]; a.ln2_g = (const float*)d_in[18]; a.ln2_b = (const float*)d_in[19];
    a.out = (float*)d_out; a.ws = (unsigned char*)d_ws; a.pad = 0;
#if MK_ONE_LAUNCH
    a.ph_lo = 0; a.ph_hi = N_PHASES; a.use_bar = 1;
    hipLaunchKernelGGL(mk_fwd, dim3(grid), dim3(NWAVES * 64), LDS_BYTES, stream, a);
#else
#ifdef DBG_DUMP
    const int np_ = DBG_DUMP + 2;
#else
    const int np_ = N_PHASES;
#endif
    for (int p = 0; p < np_; ++p) { a.ph_lo = p; a.ph_hi = p + 1; a.use_bar = 0;
        hipLaunchKernelGGL(mk_fwd, dim3(grid), dim3(NWAVES * 64), LDS_BYTES, stream, a); }
#endif
    const hipError_t le = hipPeekAtLastError();
    if (le != hipSuccess) fprintf(stderr, "kernel_launch: launch failed: %s\n", hipGetErrorName(le));
}
```
